# Optimizing an MI355X kernel written in HIP

```python
import math
import jax, jax.numpy as jnp
from jax import lax
import numpy as np

D_MODEL = 2048
BATCH = 4
SEQ = 8192
DEPTH = 4

HEAD_DIM = 128
N_HEADS = D_MODEL // HEAD_DIM
A_HEADS = N_HEADS // 2
NSA_HEADS = N_HEADS - A_HEADS
NSA_KV_GROUPS = 2
NSA_REP = NSA_HEADS // NSA_KV_GROUPS
A_WIDTH = A_HEADS * HEAD_DIM
NSA_WIDTH = NSA_HEADS * HEAD_DIM
KV_WIDTH = NSA_KV_GROUPS * HEAD_DIM
N_BRANCH = 3
IN_COLS = 3 * A_WIDTH + NSA_WIDTH + 2 * N_BRANCH * KV_WIDTH + N_BRANCH * NSA_HEADS
D_FF = 5632
DILATED_PATTERNS = ((128, 1), (512, 4), (2048, 16))
BAND = 128
CMP_STRIDE = 16
CMP_LEN = 2 * CMP_STRIDE
CMP_HIDDEN = 512
SLC_LEN = 64
SLC_TOPK = 16
WIN_LEN = 512
NSA_QBLK = 64
N_BUCKETS = 32
MAX_DISTANCE = 2048
FORCE_SCORE = 1e6
NEG_INF = -1e30
EPS = 1e-6

kernel_name = 'hybrid_dilated_nsa_macaron'


def rmsnorm(x, g):
    xf = x.astype(jnp.float32)
    y = xf * lax.rsqrt(jnp.mean(xf * xf, axis=-1, keepdims=True) + EPS)
    return (y * g.astype(jnp.float32)).astype(x.dtype)


def swiglu(x, w1, w3, w2):
    return (jax.nn.silu(x @ w1) * (x @ w3)) @ w2


def rel_bucket(dist):
    n = jnp.maximum(dist, 0)
    max_exact = N_BUCKETS // 2
    nf = jnp.maximum(n, 1).astype(jnp.float32)
    log_b = max_exact + (jnp.log(nf / max_exact) / math.log(MAX_DISTANCE / max_exact) * (N_BUCKETS - max_exact)).astype(jnp.int32)
    return jnp.where(n < max_exact, n, jnp.minimum(log_b, N_BUCKETS - 1))


def masked_probs(logits, mask):
    logits = jnp.where(mask, logits, NEG_INF)
    m = jnp.max(logits, axis=-1, keepdims=True)
    p = jnp.where(mask, jnp.exp(logits - m), 0.0)
    s = jnp.maximum(jnp.sum(p, axis=-1, keepdims=True), 1e-30)
    return p / s, (m + jnp.log(s))[..., 0]


def dilated_pattern(q, k, v, window, dilation, bias_table):
    B, S, H, Dh = q.shape
    span = dilation * BAND
    Sp = -(-S // span) * span
    nb = Sp // span

    def to_sub(t):
        t = jnp.pad(t, ((0, 0), (0, Sp - S), (0, 0), (0, 0)))
        return t.reshape(B, nb, BAND, dilation, H, Dh).transpose(0, 3, 4, 1, 2, 5)

    def with_prev(t):
        prev = jnp.pad(t, ((0, 0), (0, 0), (0, 0), (1, 0), (0, 0), (0, 0)))[:, :, :, :-1]
        return jnp.concatenate([prev, t], axis=4)

    qs = to_sub(q)
    kb = with_prev(to_sub(k))
    vb = with_prev(to_sub(v))
    logits = jnp.einsum('brhnqd,brhnkd->brhnqk', qs, kb).astype(jnp.float32)
    i = jnp.arange(BAND)
    j = jnp.arange(2 * BAND) - BAND
    diff = i[:, None] - j[None, :]
    mask = (diff >= 0) & (diff <= window // dilation)
    mask = mask[None] & ((jnp.arange(nb)[:, None, None] > 0) | (j >= 0)[None, None, :])
    bias = bias_table[rel_bucket(diff * dilation)].astype(jnp.float32).transpose(2, 0, 1)
    probs, lse = masked_probs(logits + bias[None, None, :, None], mask[None, None, None])
    out = jnp.einsum('brhnqk,brhnkd->brhnqd', probs.astype(v.dtype), vb)
    out = out.transpose(0, 3, 4, 1, 2, 5).reshape(B, Sp, H, Dh)[:, :S]
    lse = lse.transpose(0, 3, 4, 1, 2).reshape(B, Sp, H)[:, :S]
    return out, lse


def dilated_attention(q, k, v, bias_table):
    outs, lses = [], []
    for window, dilation in DILATED_PATTERNS:
        o, s = dilated_pattern(q, k, v, window, dilation, bias_table)
        outs.append(o)
        lses.append(s)
    w = jax.nn.softmax(jnp.stack(lses), axis=0)
    return jnp.einsum('pbsh,pbshd->bshd', w.astype(q.dtype), jnp.stack(outs))


def compress(t, pos, w1, w2):
    B, S, G, Dh = t.shape
    ch = t.reshape(B, S // CMP_STRIDE, CMP_STRIDE, G, Dh)
    blocks = jnp.concatenate([ch[:, :-1], ch[:, 1:]], axis=2) + pos[None, None, :, None, :]
    flat = blocks.transpose(0, 1, 3, 2, 4).reshape(B, S // CMP_STRIDE - 1, G, CMP_LEN * Dh)
    return jax.nn.gelu(flat @ w1) @ w2


def nsa_attention(q, kc, vc, ks, vs, kw, vw, gates, bias_table):
    B, S, H, Dh = q.shape
    G, R = NSA_KV_GROUPS, NSA_REP
    n_cmp = kc.shape[1]
    n_slc = S // SLC_LEN
    n_top = min(SLC_TOPK, n_slc)
    cmp_end = jnp.arange(n_cmp) * CMP_STRIDE + CMP_LEN - 1
    c_start = jnp.arange(n_cmp)[:, None] * CMP_STRIDE
    s_start = jnp.arange(n_slc)[None, :] * SLC_LEN
    overlap = ((c_start < s_start + SLC_LEN) & (c_start + CMP_LEN > s_start)).astype(jnp.float32)
    tbl = bias_table.astype(jnp.float32).reshape(N_BUCKETS, G, R).transpose(1, 0, 2)
    ks_t = ks.transpose(0, 2, 1, 3)
    vs_t = vs.transpose(0, 2, 1, 3)
    kw_p = jnp.pad(kw, ((0, 0), (WIN_LEN, 0), (0, 0), (0, 0)))
    vw_p = jnp.pad(vw, ((0, 0), (WIN_LEN, 0), (0, 0), (0, 0)))
    gather_tokens = jax.vmap(jax.vmap(lambda src, ix: src[ix]))
    per_group_bias = jax.vmap(lambda t, b: t[b], in_axes=(0, 1), out_axes=1)

    def block(qi):
        start = qi * NSA_QBLK
        tq = start + jnp.arange(NSA_QBLK)
        qg = lax.dynamic_slice_in_dim(q, start, NSA_QBLK, axis=1).reshape(B, NSA_QBLK, G, R, Dh)
        g = lax.dynamic_slice_in_dim(gates, start, NSA_QBLK, axis=1).reshape(B, NSA_QBLK, G, R, N_BRANCH)
        lc = jnp.einsum('bqgrd,bcgd->bgrqc', qg, kc).astype(jnp.float32)
        pc, _ = masked_probs(lc, cmp_end[None, :] <= tq[:, None])
        o_cmp = jnp.einsum('bgrqc,bcgd->bqgrd', pc.astype(vc.dtype), vc)
        imp = jnp.einsum('bgrqc,cn->bgqn', pc, overlap)
        blk = jnp.arange(n_slc)[None, :]
        cur = (tq // SLC_LEN)[:, None]
        valid = blk * SLC_LEN <= tq[:, None]
        forced = (blk == 0) | (blk == cur) | (blk == cur - 1)
        score = jnp.where(valid & forced, FORCE_SCORE, jnp.where(valid, imp, -1.0))
        _, top = lax.top_k(score, n_top)
        tok = (top[..., None] * SLC_LEN + jnp.arange(SLC_LEN)).reshape(B, G, NSA_QBLK, n_top * SLC_LEN)
        k_sel = gather_tokens(ks_t, tok)
        v_sel = gather_tokens(vs_t, tok)
        dist = tq[None, None, :, None] - tok
        b_sel = per_group_bias(tbl, rel_bucket(dist)).transpose(0, 1, 4, 2, 3)
        ls = jnp.einsum('bqgrd,bgqtd->bgrqt', qg, k_sel).astype(jnp.float32) + b_sel
        ps, _ = masked_probs(ls, (dist >= 0)[:, :, None])
        o_slc = jnp.einsum('bgrqt,bgqtd->bqgrd', ps.astype(vs.dtype), v_sel)
        k_win = lax.dynamic_slice_in_dim(kw_p, start, WIN_LEN + NSA_QBLK, axis=1)
        v_win = lax.dynamic_slice_in_dim(vw_p, start, WIN_LEN + NSA_QBLK, axis=1)
        kpos = start - WIN_LEN + jnp.arange(WIN_LEN + NSA_QBLK)
        dw = tq[:, None] - kpos[None, :]
        wmask = (dw >= 0) & (dw < WIN_LEN) & (kpos >= 0)[None, :]
        b_win = bias_table[rel_bucket(dw)].astype(jnp.float32).reshape(NSA_QBLK, WIN_LEN + NSA_QBLK, G, R).transpose(2, 3, 0, 1)
        lw = jnp.einsum('bqgrd,bkgd->bgrqk', qg, k_win).astype(jnp.float32) + b_win[None]
        pw, _ = masked_probs(lw, wmask)
        o_win = jnp.einsum('bgrqk,bkgd->bqgrd', pw.astype(vw.dtype), v_win)
        out = g[..., 0:1] * o_cmp + g[..., 1:2] * o_slc + g[..., 2:3] * o_win
        return out.reshape(B, NSA_QBLK, H * Dh)

    out = lax.map(block, jnp.arange(S // NSA_QBLK))
    return out.transpose(1, 0, 2, 3).reshape(B, S, H * Dh)


def setup_inputs(seed: int = 0) -> dict:
    key = jax.random.key(seed)
    ks = jax.random.split(key, 24)
    f32 = jnp.float32
    L = DEPTH

    def dense(k, shape, fan_in):
        return jax.random.normal(k, shape, f32) * fan_in ** -0.5

    def gain(k, shape):
        return 1.0 + 0.02 * jax.random.normal(k, shape, f32)

    return {
        'x': jax.random.normal(ks[0], (BATCH, SEQ, D_MODEL), f32),
        'ffn1_norm': gain(ks[1], (L, D_MODEL)),
        'ffn1_w1': dense(ks[2], (L, D_MODEL, D_FF), D_MODEL),
        'ffn1_w3': dense(ks[3], (L, D_MODEL, D_FF), D_MODEL),
        'ffn1_w2': dense(ks[4], (L, D_FF, D_MODEL), D_FF),
        'mix_norm': gain(ks[5], (L, D_MODEL)),
        'w_in': dense(ks[6], (L, D_MODEL, IN_COLS), D_MODEL),
        'gate_bias': 0.1 * jax.random.normal(ks[7], (L, N_BRANCH * NSA_HEADS), f32),
        'q_norm_a': gain(ks[8], (L, HEAD_DIM)),
        'k_norm_a': gain(ks[9], (L, HEAD_DIM)),
        'q_norm_nsa': gain(ks[10], (L, HEAD_DIM)),
        'k_norm_nsa': gain(ks[11], (L, HEAD_DIM)),
        'cmp_pos': 0.2 * jax.random.normal(ks[12], (L, CMP_LEN, HEAD_DIM), f32),
        'cmp_k_w1': dense(ks[13], (L, CMP_LEN * HEAD_DIM, CMP_HIDDEN), CMP_LEN * HEAD_DIM),
        'cmp_k_w2': dense(ks[14], (L, CMP_HIDDEN, HEAD_DIM), CMP_HIDDEN),
        'cmp_v_w1': dense(ks[15], (L, CMP_LEN * HEAD_DIM, CMP_HIDDEN), CMP_LEN * HEAD_DIM),
        'cmp_v_w2': dense(ks[16], (L, CMP_HIDDEN, HEAD_DIM), CMP_HIDDEN),
        'out_norm': gain(ks[17], (L, D_MODEL)),
        'w_out': dense(ks[18], (L, D_MODEL, D_MODEL), D_MODEL),
        'ffn2_norm': gain(ks[19], (L, D_MODEL)),
        'ffn2_w1': dense(ks[20], (L, D_MODEL, D_FF), D_MODEL),
        'ffn2_w3': dense(ks[21], (L, D_MODEL, D_FF), D_MODEL),
        'ffn2_w2': dense(ks[22], (L, D_FF, D_MODEL), D_FF),
        'rel_bias': 0.5 * jax.random.normal(ks[23], (N_BUCKETS, N_HEADS), f32),
    }


def reference(x, ffn1_norm, ffn1_w1, ffn1_w3, ffn1_w2, mix_norm, w_in, gate_bias,
              q_norm_a, k_norm_a, q_norm_nsa, k_norm_nsa, cmp_pos, cmp_k_w1, cmp_k_w2,
              cmp_v_w1, cmp_v_w2, out_norm, w_out, ffn2_norm, ffn2_w1, ffn2_w3, ffn2_w2, rel_bias):
    B, S, _ = x.shape
    scale = HEAD_DIM ** -0.5
    sizes = (A_WIDTH,) * 3 + (NSA_WIDTH,) + (KV_WIDTH,) * (2 * N_BRANCH) + (N_BRANCH * NSA_HEADS,)
    splits = np.cumsum(sizes)[:-1].tolist()

    def heads(t, n):
        return t.reshape(B, S, n, HEAD_DIM)

    for l in range(DEPTH):
        x = x + 0.5 * swiglu(rmsnorm(x, ffn1_norm[l]), ffn1_w1[l], ffn1_w3[l], ffn1_w2[l])
        h = rmsnorm(x, mix_norm[l])
        qa, ka, va, qn, kc, vc, k_s, v_s, k_w, v_w, gl = jnp.split(h @ w_in[l], splits, axis=-1)
        qa = rmsnorm(heads(qa, A_HEADS), q_norm_a[l]) * scale
        ka = rmsnorm(heads(ka, A_HEADS), k_norm_a[l])
        o_a = dilated_attention(qa, ka, heads(va, A_HEADS), rel_bias[:, :A_HEADS]).reshape(B, S, A_WIDTH)
        qn = rmsnorm(heads(qn, NSA_HEADS), q_norm_nsa[l]) * scale
        kc = rmsnorm(compress(heads(kc, NSA_KV_GROUPS), cmp_pos[l], cmp_k_w1[l], cmp_k_w2[l]), k_norm_nsa[l])
        vc = compress(heads(vc, NSA_KV_GROUPS), cmp_pos[l], cmp_v_w1[l], cmp_v_w2[l])
        k_s = rmsnorm(heads(k_s, NSA_KV_GROUPS), k_norm_nsa[l])
        k_w = rmsnorm(heads(k_w, NSA_KV_GROUPS), k_norm_nsa[l])
        gates = jax.nn.sigmoid(gl + gate_bias[l]).reshape(B, S, NSA_HEADS, N_BRANCH)
        o_n = nsa_attention(qn, kc, vc, k_s, heads(v_s, NSA_KV_GROUPS), k_w, heads(v_w, NSA_KV_GROUPS),
                            gates, rel_bias[:, A_HEADS:])
        y = jnp.concatenate([rmsnorm(o_a, out_norm[l, :A_WIDTH]), rmsnorm(o_n, out_norm[l, A_WIDTH:])], axis=-1)
        x = x + y @ w_out[l]
        x = x + 0.5 * swiglu(rmsnorm(x, ffn2_norm[l]), ffn2_w1[l], ffn2_w3[l], ffn2_w2[l])
    return x
```

```cpp
#include <hip/hip_runtime.h>
#include <cstdio>
#include <cstdint>

#define LAS __attribute__((address_space(3)))
typedef unsigned short bf16_t;
typedef short bf16x8 __attribute__((ext_vector_type(8)));
typedef short s16x4 __attribute__((ext_vector_type(4)));
typedef float f32x2 __attribute__((ext_vector_type(2)));
typedef float f32x4 __attribute__((ext_vector_type(4)));
typedef float f32x16 __attribute__((ext_vector_type(16)));
typedef unsigned u32x2 __attribute__((ext_vector_type(2)));
typedef unsigned u32x4 __attribute__((ext_vector_type(4)));

#ifndef PH_FFN
#define PH_FFN 1
#endif
#ifndef PH_INP
#define PH_INP 1
#endif
#ifndef PH_CMP
#define PH_CMP 1
#endif
#ifndef PH_DIL
#define PH_DIL 1
#endif
#ifndef PH_NSA
#define PH_NSA 1
#endif
#ifndef PH_OUT
#define PH_OUT 1
#endif
constexpr int BATCH = 4, SEQ = 8192, DM = 2048, DFF = 5632, NTOK = BATCH * SEQ, DEPTH = 4, HD = 128;
constexpr int IN_COLS = 5656, PC = 5888;
constexpr int C_QA = 0, C_KA = 1024, C_VA = 2048, C_QN = 3072, C_KC = 4096, C_VC = 4352, C_KS = 4608, C_VS = 4864, C_KW = 5120, C_VW = 5376, C_GL = 5632;
constexpr float EPS = 1e-6f, QSCALE = 0.08838834764831845f, LOG2E = 1.4426950408889634f;
constexpr int TBLS = 1704, TBL0 = 64;
constexpr int DTS = 320, DT0 = 96;
constexpr int NWAVES = 8, NTHR = 512;

constexpr size_t MiB = 1u << 20;
constexpr size_t WS_CTL = 0, CTL_ZERO_BYTES = 1 * MiB;
constexpr size_t WS_TBL = 1 * MiB;
constexpr size_t WS_WUP = 2 * MiB;
constexpr size_t WS_WDN = 46 * MiB;
constexpr size_t WS_WIN = 68 * MiB;
constexpr size_t WS_WOUT = 91 * MiB;
constexpr size_t WS_WC1 = 99 * MiB;
constexpr size_t WS_HB = 107 * MiB;
constexpr size_t WS_HP = 235 * MiB;
constexpr size_t WS_OA = 603 * MiB;
constexpr size_t WS_LSE = 667 * MiB;
constexpr size_t WS_ON = 668 * MiB;
constexpr size_t WS_ACMP = 796 * MiB;
constexpr size_t WS_CP = 860 * MiB;
constexpr size_t WS_KC = 924 * MiB;
constexpr size_t WS_VC = 925 * MiB;
constexpr size_t WS_END = 926 * MiB;
constexpr int CW_BAR = 4096;

__device__ __forceinline__ unsigned f2bf(float f) { unsigned u = __builtin_bit_cast(unsigned, f); return (u + 0x7fffu + ((u >> 16) & 1u)) >> 16; }
__device__ __forceinline__ unsigned pk2(float lo, float hi) { return f2bf(lo) | (f2bf(hi) << 16); }
__device__ __forceinline__ float bf2f(bf16_t b) { return __builtin_bit_cast(float, ((unsigned)b) << 16); }
__device__ __forceinline__ float bflo(unsigned w) { return __builtin_bit_cast(float, w << 16); }
__device__ __forceinline__ float bfhi(unsigned w) { return __builtin_bit_cast(float, w & 0xffff0000u); }
__device__ __forceinline__ unsigned cvtpk(float lo, float hi) { unsigned r; asm volatile("v_cvt_pk_bf16_f32 %0, %1, %2" : "=v"(r) : "v"(lo), "v"(hi)); return r; }
__device__ __forceinline__ float shx(float v, int m, int lane) { return __builtin_bit_cast(float, __builtin_amdgcn_ds_bpermute((lane ^ m) << 2, __builtin_bit_cast(int, v))); }
__device__ __forceinline__ float wave_sum(float v, int lane) {
#pragma unroll
    for (int o = 1; o < 64; o <<= 1) v += shx(v, o, lane);
    return v;
}
__device__ __forceinline__ LAS unsigned char* opq_lds(LAS unsigned char* p) { unsigned a = (unsigned)(uintptr_t)p; asm volatile("" : "+s"(a)); return (LAS unsigned char*)(uintptr_t)a; }
__device__ __forceinline__ int opq_tid(int wv) { int l; asm volatile("v_mbcnt_lo_u32_b32 %0, -1, 0\n\tv_mbcnt_hi_u32_b32 %0, -1, %0" : "=v"(l)); return wv * 64 + l; }
#define LDS_WAIT() asm volatile("s_waitcnt lgkmcnt(0)" ::: "memory")
#define VM_WAIT() asm volatile("s_waitcnt vmcnt(0)" ::: "memory")
#define SBAR() __builtin_amdgcn_sched_barrier(0)

#define XB_TMO      128
#define XB_XCNT(j)  (256  + 64 * (j))
#define XB_XSUB(j)  (1280 + 64 * (j))
#define XB_XGEN(j)  (2304 + 64 * (j))
#define XB_TOP      3328
#define XB_TOPGEN   3392
#define XCD_BAR_WORDS 3456
#define XB_SPIN_CAP (1u << 18)
__device__ __forceinline__ unsigned xb_ld(unsigned* p)              { return __hip_atomic_load(p, __ATOMIC_RELAXED, __HIP_MEMORY_SCOPE_AGENT); }
__device__ __forceinline__ unsigned xb_add(unsigned* p, unsigned v) { return __hip_atomic_fetch_add(p, v, __ATOMIC_RELAXED, __HIP_MEMORY_SCOPE_AGENT); }
__device__ __forceinline__ unsigned xb_xcc_id() { return (unsigned)__builtin_amdgcn_s_getreg((3 << 11) | 20) & 0xFu; }
#define XB_SPIN(cond, bar) do { unsigned _sp = 0; while (cond) { __builtin_amdgcn_s_sleep(1); \
    if ((++_sp & 255u) == 0u) { if (xb_ld(&(bar)[XB_TMO])) break; if (_sp > XB_SPIN_CAP) { atomicAdd(&(bar)[XB_TMO], 1u); break; } } } } while (0)
struct XcdBarrier { unsigned* bar; unsigned x; volatile LAS unsigned* st; };
__device__ __forceinline__ XcdBarrier xcd_barrier_post(unsigned* bar, volatile LAS unsigned* st) {
    XcdBarrier b; b.bar = bar; b.x = xb_xcc_id(); b.st = st;
    if (threadIdx.x == 0) (void)xb_add(&bar[XB_XCNT(b.x)], 1u);
    return b;
}
__device__ __forceinline__ void xcd_barrier_complete(unsigned* bar, unsigned x, unsigned& nloc, unsigned& nx) {
    const unsigned G = gridDim.x * gridDim.y * gridDim.z;
    unsigned sum, cnt, mine, sp = 0u;
    for (;;) {
        sum = 0u; cnt = 0u; mine = 0u;
#pragma unroll
        for (unsigned j = 0; j < 16; ++j) { const unsigned c = xb_ld(&bar[XB_XCNT(j)]); sum += c; cnt += (c > 0u) ? 1u : 0u; mine = (j == x) ? c : mine; }
        if (sum == G) break;
        __builtin_amdgcn_s_sleep(1);
        if ((++sp & 255u) == 0u) { if (xb_ld(&bar[XB_TMO])) break; if (sp > XB_SPIN_CAP) { atomicAdd(&bar[XB_TMO], 1u); break; } }
    }
    nloc = mine > 0u ? mine : 1u; nx = cnt > 0u ? cnt : 1u;
}
__device__ __forceinline__ void xcd_barrier(const XcdBarrier& b, const int wv) {
    asm volatile("s_waitcnt vmcnt(0)" ::: "memory");
    __syncthreads();
    if (opq_tid(wv) == 0) {
        unsigned* bar = b.bar; asm volatile("" : "+s"(bar));
        __builtin_amdgcn_s_waitcnt(0);
        unsigned nloc = b.st[0], nx = b.st[1];
        if (nloc == 0u) { xcd_barrier_complete(bar, b.x, nloc, nx); b.st[0] = nloc; b.st[1] = nx; }
        const unsigned old = xb_add(&bar[XB_XSUB(b.x)], 1u);
        const unsigned gen = old / nloc;
        if (old + 1u == (gen + 1u) * nloc) {
            __builtin_amdgcn_fence(__ATOMIC_RELEASE, "agent");
            asm volatile("s_waitcnt vmcnt(0)" ::: "memory");
            const unsigned og = xb_add(&bar[XB_TOP], 1u);
            const unsigned tg = og / nx;
            if (og + 1u == (tg + 1u) * nx) xb_add(&bar[XB_TOPGEN], 1u);
            else XB_SPIN(xb_ld(&bar[XB_TOPGEN]) == tg, bar);
            __builtin_amdgcn_fence(__ATOMIC_ACQUIRE, "agent");
            xb_add(&bar[XB_XGEN(b.x)], 1u);
            asm volatile("s_waitcnt vmcnt(0)" ::: "memory");
        } else {
            XB_SPIN(xb_ld(&bar[XB_XGEN(b.x)]) == gen, bar);
            __builtin_amdgcn_fence(__ATOMIC_ACQUIRE, "agent");
            asm volatile("s_waitcnt vmcnt(0)" ::: "memory");
        }
    }
    __syncthreads();
}

namespace pg8 {
constexpr int BM = 256, BK = 64, HALF = 128, HTB = HALF * BK * 2, STAGE_BYTES = 8 * HTB, NXCD = 8, WGM = 8;
__host__ __device__ __forceinline__ int lds_byte(int r, int c) { const int st = (r >> 4) * 2 + (c >> 5), rr = r & 15, cc = c & 31, ob = rr * 64 + cc * 2; return st * 1024 + (ob ^ (((ob >> 9) & 1) << 5)); }
__host__ __device__ __forceinline__ void stage_rc(int b, int& R, int& C) { const int st = b / 1024, sb = b % 1024, swz = sb ^ (((sb >> 9) & 1) << 5); R = (st >> 1) * 16 + swz / 64; C = (st & 1) * 32 + (swz % 64) / 2; }
__host__ __device__ __forceinline__ int perm32(int rho) { const int n = rho >> 4, i = rho & 15; return 8 * (i >> 2) + 4 * n + (i & 3); }
struct Unit { int pm, pn, z; };
struct Gemm { int lda, ldb, K; };
struct SchedStd {
    const char* A; const char* Bt; size_t atile, btile; int nM, nN, nwg, G, c;
    __device__ __forceinline__ void init(const void* A_, const void* Bt_, int M, int N, int lda, int ldb, int G_, int c_) {
        A = (const char*)A_; Bt = (const char*)Bt_; atile = (size_t)BM * lda * 2; btile = (size_t)BM * ldb * 2; nM = M / BM; nN = N / BM; nwg = nM * nN; G = G_; c = c_; }
    __device__ __forceinline__ bool next(int i, Unit& u) const {
        const long L = (long)i * G + c; if (L >= nwg) return false;
        int wgid = (int)L; { const int q = nwg / NXCD, r = nwg % NXCD, xcd = wgid % NXCD, off = wgid / NXCD; wgid = (xcd < r ? xcd * (q + 1) : r * (q + 1) + (xcd - r) * q) + off; }
        const int nig = WGM * nN, gid = wgid / nig, fm = gid * WGM, gsz = (nM - fm) < WGM ? (nM - fm) : WGM;
        u.pm = fm + ((wgid % nig) % gsz); u.pn = (wgid % nig) / gsz; u.z = 0; return true;
    }
    __device__ __forceinline__ const char* a_ptr(const Unit& u) const { return A + (size_t)u.pm * atile; }
    __device__ __forceinline__ const char* b_ptr(const Unit& u) const { return Bt + (size_t)u.pn * btile; }
};
struct SchedCmp {
    const char* A; const char* Bt; int G, c;
    __device__ __forceinline__ bool next(int i, Unit& u) const { const int L = i * G + c; if (L >= 256) return false; u.z = L >> 5; u.pm = (L & 31) >> 1; u.pn = L & 1; return true; }
    __device__ __forceinline__ const char* a_ptr(const Unit& u) const { const int kv = u.z >> 2, ks = u.z & 3; return A + ((size_t)(kv * 4096 + u.pm * 256) * 4096 + (size_t)ks * 1024) * 2; }
    __device__ __forceinline__ const char* b_ptr(const Unit& u) const { const int kv = u.z >> 2, ks = u.z & 3; return Bt + ((size_t)(kv * 512 + u.pn * 256) * 4096 + (size_t)ks * 1024) * 2; }
};
struct EpiBf16 {
    static constexpr bool PERM = true;
    bf16_t* O; int ldc;
    __device__ __forceinline__ void operator()(const f32x4 (&acc)[2][2][4][2], const Unit& u, int wr, int wc, int fr, int fq) const {
        const int row0 = u.pm * BM + wr * 64 + fr, col0 = u.pn * BM + wc * 32 + 8 * fq;
#pragma unroll
        for (int ai = 0; ai < 2; ++ai)
#pragma unroll
            for (int m = 0; m < 4; ++m) { bf16_t* rowp = O + (size_t)(row0 + ai * HALF + m * 16) * ldc + col0;
#pragma unroll
                for (int bj = 0; bj < 2; ++bj) { const f32x4 v0 = acc[ai][bj][m][0], v1 = acc[ai][bj][m][1];
                    u32x4 w; w.x = cvtpk(v0[0], v0[1]); w.y = cvtpk(v0[2], v0[3]); w.z = cvtpk(v1[0], v1[1]); w.w = cvtpk(v1[2], v1[3]);
                    *(u32x4*)(rowp + bj * HALF) = w; } }
    }
};
struct EpiSwiGLU {
    static constexpr bool PERM = true;
    bf16_t* O; int ldc;
    __device__ __forceinline__ void operator()(const f32x4 (&acc)[2][2][4][2], const Unit& u, int wr, int wc, int fr, int fq) const {
        const int row0 = u.pm * BM + wr * 64 + fr, col0 = u.pn * HALF + wc * 32 + 8 * fq;
#pragma unroll
        for (int ai = 0; ai < 2; ++ai)
#pragma unroll
            for (int m = 0; m < 4; ++m) { bf16_t* rowp = O + (size_t)(row0 + ai * HALF + m * 16) * ldc + col0;
                float v[8];
#pragma unroll
                for (int n = 0; n < 2; ++n)
#pragma unroll
                    for (int j = 0; j < 4; ++j) { const float g = acc[ai][0][m][n][j], up = acc[ai][1][m][n][j];
                        const float s = g * __builtin_amdgcn_rcpf(1.0f + __builtin_amdgcn_exp2f(-g * LOG2E)); v[n * 4 + j] = s * up; }
                u32x4 w; w.x = cvtpk(v[0], v[1]); w.y = cvtpk(v[2], v[3]); w.z = cvtpk(v[4], v[5]); w.w = cvtpk(v[6], v[7]);
                *(u32x4*)rowp = w; }
    }
};
struct EpiResid {
    static constexpr bool PERM = false;
    const float* base; float* out; int ldc; float alpha;
    __device__ __forceinline__ void operator()(const f32x4 (&acc)[2][2][4][2], const Unit& u, int wr, int wc, int fr, int fq) const {
        const int row0 = u.pm * BM + wr * 64 + fr, col0 = u.pn * BM + wc * 32 + 4 * fq;
#pragma unroll
        for (int ai = 0; ai < 2; ++ai)
#pragma unroll
            for (int m = 0; m < 4; ++m) { const size_t off = (size_t)(row0 + ai * HALF + m * 16) * ldc + col0;
#pragma unroll
                for (int bj = 0; bj < 2; ++bj)
#pragma unroll
                    for (int n = 0; n < 2; ++n) { const f32x4 bs = *(const f32x4*)(base + off + bj * HALF + n * 16);
                        *(f32x4*)(out + off + bj * HALF + n * 16) = bs + acc[ai][bj][m][n] * alpha; } }
    }
};
struct EpiF32Z {
    static constexpr bool PERM = false;
    float* C; int ldc; size_t zstride;
    __device__ __forceinline__ void operator()(const f32x4 (&acc)[2][2][4][2], const Unit& u, int wr, int wc, int fr, int fq) const {
        float* Cz = C + (size_t)u.z * zstride;
        const int row0 = u.pm * BM + wr * 64 + fr, col0 = u.pn * BM + wc * 32 + 4 * fq;
#pragma unroll
        for (int ai = 0; ai < 2; ++ai)
#pragma unroll
            for (int m = 0; m < 4; ++m) { float* rowp = Cz + (size_t)(row0 + ai * HALF + m * 16) * ldc + col0;
#pragma unroll
                for (int bj = 0; bj < 2; ++bj)
#pragma unroll
                    for (int n = 0; n < 2; ++n) *(f32x4*)(rowp + bj * HALF + n * 16) = acc[ai][bj][m][n]; }
    }
};

template <class Epi, class Sched>
__device__ __forceinline__ void gemm_phase(LAS unsigned char* lds, const Gemm g, const Sched& S, const Epi& E, const int wv) {
    const int tid = opq_tid(wv), wid = __builtin_amdgcn_readfirstlane(tid >> 6), lane = tid & 63, wr = wid >> 2, wc = wid & 3, fr = lane & 15, fq = lane >> 4;
    const int K = g.K, nt = K / BK;
    unsigned voffA[2], voffB[2];
#pragma unroll
    for (int i = 0; i < 2; ++i) { int R, C; stage_rc(tid * 16 + i * 8192, R, C); const int Rb = Epi::PERM ? ((R & ~31) + perm32(R & 31)) : R;
        voffA[i] = (unsigned)(R * g.lda + C) * 2u; voffB[i] = (unsigned)(Rb * g.ldb + C) * 2u; }
    const size_t kstep = (size_t)(BK * 2);
    const size_t hstepA = (size_t)HALF * g.lda * 2, hstepB = (size_t)HALF * g.ldb * 2;
    const unsigned ldsw = (unsigned)wid * 1024u;
    const int aoff = lds_byte(wr * 64 + fr, fq * 8), boff = lds_byte(wc * 32 + fr, fq * 8);
#define PG8_SA(b, h) (((b) * 2 + (h)) * HTB)
#define PG8_SB(b, h) ((4 + (b) * 2 + (h)) * HTB)
#define PG8_STAGE(bufoff, gbase, voff) do { _Pragma("unroll") for (int _i = 0; _i < 2; ++_i) \
        __builtin_amdgcn_global_load_lds((const unsigned*)((const char*)(gbase) + (voff)[_i]), (LAS unsigned*)(lds + (bufoff) + ldsw + _i * 8192), 16, 0, 0); } while (0)
#define PG8_LDA(dst, b, h) do { _Pragma("unroll") for (int m = 0; m < 4; ++m) _Pragma("unroll") for (int k = 0; k < 2; ++k) dst[m][k] = *(const LAS bf16x8*)(lds + PG8_SA(b, h) + aoff + m * 2048 + k * 1024); } while (0)
#define PG8_LDB(dst, b, h) do { _Pragma("unroll") for (int n = 0; n < 2; ++n) _Pragma("unroll") for (int k = 0; k < 2; ++k) dst[n][k] = *(const LAS bf16x8*)(lds + PG8_SB(b, h) + boff + n * 2048 + k * 1024); } while (0)
#define PG8_MMA(ai, bj, At, Bt) do { __builtin_amdgcn_s_setprio(1); _Pragma("unroll") for (int m = 0; m < 4; ++m) _Pragma("unroll") for (int n = 0; n < 2; ++n) _Pragma("unroll") for (int k = 0; k < 2; ++k) \
        acc[ai][bj][m][n] = __builtin_amdgcn_mfma_f32_16x16x32_bf16(Bt[n][k], At[m][k], acc[ai][bj][m][n], 0, 0, 0); __builtin_amdgcn_s_setprio(0); } while (0)
#define PG8_WAIT_V(n) asm volatile("s_waitcnt vmcnt(" #n ")" ::: "memory")
#define PG8_WAIT_L(n) asm volatile("s_waitcnt lgkmcnt(" #n ")" ::: "memory")
#define PG8_BAR __builtin_amdgcn_s_barrier()
#define PG8_SCHED __builtin_amdgcn_sched_barrier(0)
    Unit cur, nxt; int ui = 0;
    if (!S.next(0, cur)) return;
    f32x4 acc[2][2][4][2];
#pragma unroll
    for (int a = 0; a < 2; ++a)
#pragma unroll
        for (int b = 0; b < 2; ++b)
#pragma unroll
            for (int m = 0; m < 4; ++m)
#pragma unroll
                for (int n = 0; n < 2; ++n) acc[a][b][m][n] = (f32x4){0.f, 0.f, 0.f, 0.f};
    bf16x8 At[4][2], B0[2][2], B1[2][2];
    const char* cA = S.a_ptr(cur); const char* cB = S.b_ptr(cur);
    PG8_STAGE(PG8_SB(0, 0), cB, voffB); PG8_STAGE(PG8_SA(0, 0), cA, voffA); PG8_STAGE(PG8_SB(0, 1), cB + hstepB, voffB); PG8_STAGE(PG8_SA(0, 1), cA + hstepA, voffA);
    if (wr == 1) PG8_BAR;
    PG8_WAIT_V(4); PG8_BAR;
    PG8_STAGE(PG8_SB(1, 0), cB + kstep, voffB); PG8_STAGE(PG8_SA(1, 0), cA + kstep, voffA); PG8_STAGE(PG8_SB(1, 1), cB + hstepB + kstep, voffB);
    PG8_WAIT_V(6); PG8_BAR;
    for (;;) {
        const bool has_next = S.next(ui + 1, nxt);
        const char* nA = has_next ? S.a_ptr(nxt) : cA; const char* nB = has_next ? S.b_ptr(nxt) : cB;
        for (int t = 0; t < nt; t += 2) {
            const bool last = (t == nt - 2);
            const char* a1 = cA + (size_t)(t + 1) * kstep;
            const char* a2 = last ? nA : cA + (size_t)(t + 2) * kstep; const char* b2 = last ? nB : cB + (size_t)(t + 2) * kstep;
            const char* a3 = a2 + kstep; const char* b3 = b2 + kstep;
            PG8_LDB(B0, 0, 0); PG8_SCHED; PG8_LDA(At, 0, 0); PG8_STAGE(PG8_SA(1, 1), a1 + hstepA, voffA);
            PG8_WAIT_L(8); PG8_BAR; PG8_WAIT_L(0); PG8_MMA(0, 0, At, B0); PG8_BAR; PG8_SCHED;
            PG8_LDB(B1, 0, 1); PG8_STAGE(PG8_SB(0, 0), b2, voffB);
            PG8_BAR; PG8_WAIT_L(0); PG8_MMA(0, 1, At, B1); PG8_BAR;
            PG8_LDA(At, 0, 1); PG8_STAGE(PG8_SA(0, 0), a2, voffA);
            PG8_BAR; PG8_WAIT_L(0); PG8_MMA(1, 0, At, B0); PG8_BAR; PG8_SCHED;
            PG8_STAGE(PG8_SB(0, 1), b2 + hstepB, voffB);
            PG8_WAIT_V(6); PG8_BAR; PG8_MMA(1, 1, At, B1); PG8_BAR;
            PG8_LDB(B0, 1, 0); PG8_SCHED; PG8_LDA(At, 1, 0); PG8_STAGE(PG8_SA(0, 1), a2 + hstepA, voffA);
            PG8_WAIT_L(8); PG8_BAR; PG8_WAIT_L(0); PG8_MMA(0, 0, At, B0); PG8_BAR; PG8_SCHED;
            PG8_LDB(B1, 1, 1); PG8_STAGE(PG8_SB(1, 0), b3, voffB);
            PG8_BAR; PG8_WAIT_L(0); PG8_MMA(0, 1, At, B1); PG8_BAR;
            PG8_LDA(At, 1, 1); PG8_STAGE(PG8_SA(1, 0), a3, voffA);
            PG8_BAR; PG8_WAIT_L(0); PG8_MMA(1, 0, At, B0); PG8_BAR; PG8_SCHED;
            PG8_STAGE(PG8_SB(1, 1), b3 + hstepB, voffB);
            PG8_WAIT_V(6); PG8_BAR; PG8_MMA(1, 1, At, B1); PG8_BAR;
        }
        E(acc, cur, wr, wc, fr, fq);
        if (!has_next) break;
#pragma unroll
        for (int a = 0; a < 2; ++a)
#pragma unroll
            for (int b = 0; b < 2; ++b)
#pragma unroll
                for (int m = 0; m < 4; ++m)
#pragma unroll
                    for (int n = 0; n < 2; ++n) acc[a][b][m][n] = (f32x4){0.f, 0.f, 0.f, 0.f};
        cur = nxt; cA = nA; cB = nB; ++ui;
    }
    PG8_WAIT_V(0);
    if (wr == 0) PG8_BAR;
    PG8_BAR;
#undef PG8_SA
#undef PG8_SB
#undef PG8_STAGE
#undef PG8_LDA
#undef PG8_LDB
#undef PG8_MMA
#undef PG8_WAIT_V
#undef PG8_WAIT_L
#undef PG8_BAR
#undef PG8_SCHED
}
}

struct Args { const float* in[24]; float* out; unsigned char* ws; };
enum { I_X = 0, I_F1N, I_F1W1, I_F1W3, I_F1W2, I_MIXN, I_WIN, I_GB, I_QNA, I_KNA, I_QNN, I_KNN, I_POS, I_CKW1, I_CKW2, I_CVW1, I_CVW2, I_ON, I_WOUT, I_F2N, I_F2W1, I_F2W3, I_F2W2, I_RB };

__device__ __forceinline__ void transpose_item(const float* W, int K, int N, bf16_t* WT, int mode, int off, LAS float* scr, int item, int lane) {
    const int nblk = (N + 31) / 32, kb = item / nblk, nb = item % nblk, k0 = 64 * kb, n0 = 32 * nb;
    const int nn = n0 + (lane & 31);
#pragma unroll 8
    for (int i = 0; i < 32; ++i) { const int kk = 2 * i + (lane >> 5); scr[kk * 33 + (lane & 31)] = (nn < N) ? W[(size_t)(k0 + kk) * N + nn] : 0.f; }
    LDS_WAIT(); asm volatile("" ::: "memory");
    const int c = lane & 7;
#pragma unroll
    for (int j = 0; j < 4; ++j) { const int n = (lane >> 3) + 8 * j; const LAS float* s = scr + (8 * c) * 33 + n;
        u32x4 o; o.x = pk2(s[0 * 33], s[1 * 33]); o.y = pk2(s[2 * 33], s[3 * 33]); o.z = pk2(s[4 * 33], s[5 * 33]); o.w = pk2(s[6 * 33], s[7 * 33]);
        const int ng = n0 + n; const int dr = mode ? ((ng >> 7) * 256 + (ng & 127) + off) : (ng + off);
        if (ng < N) *(u32x4*)(WT + (size_t)dr * K + k0 + 8 * c) = o; }
    LDS_WAIT(); asm volatile("" ::: "memory");
}
__device__ __forceinline__ int rel_bucket_dev(int n) {
    if (n < 16) return n;
    const float v = logf((float)n / 16.0f) / 4.852030263919617f * 16.0f;
    int b = 16 + (int)v; return b < 31 ? b : 31;
}
__device__ __forceinline__ void norm_row(const float* xrow, const f32x4 (&gn)[8], bf16_t* orow, int lane) {
    const f32x4* xr = (const f32x4*)xrow + lane;
    f32x4 v[8]; float s = 0.f;
#pragma unroll
    for (int j = 0; j < 8; ++j) { v[j] = xr[64 * j]; s += (v[j].x * v[j].x + v[j].y * v[j].y) + (v[j].z * v[j].z + v[j].w * v[j].w); }
    const float rstd = 1.0f / sqrtf(wave_sum(s, lane) * (1.f / DM) + EPS);
    u32x2* o8 = (u32x2*)orow + lane;
#pragma unroll
    for (int j = 0; j < 8; ++j) { const f32x4 y = v[j] * rstd * gn[j]; u32x2 w; w.x = cvtpk(y.x, y.y); w.y = cvtpk(y.z, y.w); o8[64 * j] = w; }
}

namespace att {
constexpr int SHM_V = 16384, SHM_K = 16384;
constexpr int L_V = 0, L_K = 32768, L_WS = 65536, L_TBL = 67584, L_IMP = L_TBL + 4 * TBLS * 4  , L_SELM = L_IMP + 32768  , L_END = L_SELM + 1024;
static_assert(L_END <= 131072, "attention LDS map");
constexpr float THR = 8.f;
#define KSWZ(row, colB) ((row) * 256 + ((colB) ^ (((row) & 7) << 4)))
__device__ __forceinline__ int v_st(int k, int c) { const int kk = (k & ~0xC) | ((k & 4) << 1) | ((k & 8) >> 1); return ((kk >> 3) * 4 + (c >> 5)) * 512 + ((kk & 7) * 32 + (c & 31)) * 2; }
__device__ __forceinline__ int v_rd_base(int lane) { return ((lane & 3) << 3) | (((lane >> 2) & 3) << 6) | (((lane >> 4) & 1) << 5) | (((lane >> 5) & 1) << 8); }
__device__ __forceinline__ int crow(int r, int hi) { return (r & 3) + 8 * (r >> 2) + 4 * hi; }

__device__ __forceinline__ void partialSM(f32x16& p0, f32x16& p1, float& m_reg, float& mn, float& alpha) {
    float pmax = p0[0];
#pragma unroll
    for (int r = 1; r < 16; ++r) pmax = fmaxf(pmax, p0[r]);
#pragma unroll
    for (int r = 0; r < 16; ++r) pmax = fmaxf(pmax, p1[r]);
    { auto rr = __builtin_amdgcn_permlane32_swap(__float_as_uint(pmax), __float_as_uint(pmax), false, false);
      pmax = fmaxf(__uint_as_float(rr[0]), __uint_as_float(rr[1])); }
    if (__builtin_expect(__all((pmax - m_reg) <= THR), 1)) { mn = m_reg; alpha = 1.f; }
    else { mn = fmaxf(m_reg, pmax); alpha = __builtin_amdgcn_exp2f((m_reg - mn) * LOG2E); m_reg = mn; }
    const float mnL = -mn * LOG2E;
#pragma unroll
    for (int r = 0; r < 16; ++r) p0[r] = fmaf(p0[r], LOG2E, mnL);
#pragma unroll
    for (int r = 0; r < 16; ++r) p1[r] = fmaf(p1[r], LOG2E, mnL);
#pragma unroll
    for (int r = 0; r < 16; ++r) p0[r] = __builtin_amdgcn_exp2f(p0[r]);
}
#define PK4(P, B_, OUT) do { unsigned a0 = cvtpk(P[B_+0], P[B_+1]), a1 = cvtpk(P[B_+2], P[B_+3]);                          \
        unsigned b0 = cvtpk(P[B_+4], P[B_+5]), b1 = cvtpk(P[B_+6], P[B_+7]);                                             \
        auto r0 = __builtin_amdgcn_permlane32_swap(a0, b0, false, false); auto r1 = __builtin_amdgcn_permlane32_swap(a1, b1, false, false); \
        u32x4 w = {r0[0], r1[0], r0[1], r1[1]}; OUT = *reinterpret_cast<bf16x8*>(&w); } while (0)
__device__ __forceinline__ void finishSM(f32x16& p0, f32x16& p1, float alpha, float& l_reg, bf16x8& pa0, bf16x8& pa1, bf16x8& pa2, bf16x8& pa3) {
#pragma unroll
    for (int r = 0; r < 16; ++r) p1[r] = __builtin_amdgcn_exp2f(p1[r]);
    float ps = 0;
#pragma unroll
    for (int r = 0; r < 16; ++r) ps += p0[r];
#pragma unroll
    for (int r = 0; r < 16; ++r) ps += p1[r];
    { auto rr = __builtin_amdgcn_permlane32_swap(__float_as_uint(ps), __float_as_uint(ps), false, false);
      ps = __uint_as_float(rr[0]) + __uint_as_float(rr[1]); }
    l_reg = l_reg * alpha + ps;
    PK4(p0, 0, pa0); PK4(p0, 8, pa1); PK4(p1, 0, pa2); PK4(p1, 8, pa3);
}
__device__ __forceinline__ void qkt(f32x16& p0, f32x16& p1, const LAS char* Kb, int r32, int hi, const bf16x8 (&qr)[8]) {
    p0 = f32x16{}; p1 = f32x16{};
#pragma unroll
    for (int d0 = 0; d0 < 8; ++d0) { const LAS char* a = Kb + KSWZ(r32, (d0 * 16 + hi * 8) * 2);
        const bf16x8 b0 = *reinterpret_cast<const LAS bf16x8*>(a);
        const bf16x8 b1 = *reinterpret_cast<const LAS bf16x8*>(a + 32 * 256);
        p0 = __builtin_amdgcn_mfma_f32_32x32x16_bf16(b0, qr[d0], p0, 0, 0, 0);
        p1 = __builtin_amdgcn_mfma_f32_32x32x16_bf16(b1, qr[d0], p1, 0, 0, 0); }
}
__device__ __forceinline__ void pv_tile(f32x16 (&o)[4], int vb, bf16x8 pa0, bf16x8 pa1, bf16x8 pa2, bf16x8 pa3) {
#define TRRD(dst, off) asm volatile("ds_read_b64_tr_b16 %0, %1 offset:%2" : "=&v"(dst) : "v"(vb), "i"(off) : "memory")
#define PV_D0(d0) do { s16x4 l0, l1, l2, l3, h0, h1, h2, h3; constexpr int b_ = (d0) * 512; \
        TRRD(l0, b_); TRRD(h0, b_ + 2048); TRRD(l1, b_ + 4096); TRRD(h1, b_ + 6144); TRRD(l2, b_ + 8192); TRRD(h2, b_ + 10240); TRRD(l3, b_ + 12288); TRRD(h3, b_ + 14336); \
        asm volatile("s_waitcnt lgkmcnt(0)" ::: "memory"); SBAR(); \
        o[d0] = __builtin_amdgcn_mfma_f32_32x32x16_bf16(pa0, (bf16x8){l0[0], l0[1], l0[2], l0[3], h0[0], h0[1], h0[2], h0[3]}, o[d0], 0, 0, 0);   \
        o[d0] = __builtin_amdgcn_mfma_f32_32x32x16_bf16(pa1, (bf16x8){l1[0], l1[1], l1[2], l1[3], h1[0], h1[1], h1[2], h1[3]}, o[d0], 0, 0, 0);   \
        o[d0] = __builtin_amdgcn_mfma_f32_32x32x16_bf16(pa2, (bf16x8){l2[0], l2[1], l2[2], l2[3], h2[0], h2[1], h2[2], h2[3]}, o[d0], 0, 0, 0);   \
        o[d0] = __builtin_amdgcn_mfma_f32_32x32x16_bf16(pa3, (bf16x8){l3[0], l3[1], l3[2], l3[3], h3[0], h3[1], h3[2], h3[3]}, o[d0], 0, 0, 0); } while (0)
    PV_D0(0); PV_D0(1); PV_D0(2); PV_D0(3);
#undef PV_D0
#undef TRRD
}

template <class Cfg>
__device__ __forceinline__ void attn_tiles(const Cfg& c, LAS char* lds, const bf16x8 (&qr)[8], f32x16 (&o)[4], float& m_reg, float& l_reg, const int t_lo, const int t_hi, const int wv) {
    const int tid = opq_tid(wv), lane = tid & 63, wid = __builtin_amdgcn_readfirstlane(tid >> 6), r32 = lane & 31, hi = lane >> 5;
    LAS char* V_lds = lds + L_V; LAS char* K_lds = lds + L_K;
    LAS float* al_l = (LAS float*)(lds + L_WS) + wid * 64 + 32;
    const int sr = tid >> 4, sc = (tid & 15) * 8;
    const int vst0 = v_st(sr, sc), vst1 = v_st(32 + sr, sc), kws = KSWZ(sr, sc * 2);
    const int vb0 = (int)(unsigned)(uintptr_t)V_lds + v_rd_base(lane);
    bf16x8 sk0, sk1, sv0, sv1;
#define AT_LOAD(t) do { sk0 = *(const bf16x8*)(c.krow((t), sr) + sc); sk1 = *(const bf16x8*)(c.krow((t), sr + 32) + sc); \
        if constexpr (Cfg::MODE == 0) { sv0 = *(const bf16x8*)(c.vrow((t), sr) + sc); sv1 = *(const bf16x8*)(c.vrow((t), sr + 32) + sc); } \
        asm volatile("" ::: "memory"); SBAR(); } while (0)
#define AT_WRITE(t, bf) do { *(LAS bf16x8*)(K_lds + (bf) * SHM_K + kws) = sk0; *(LAS bf16x8*)(K_lds + (bf) * SHM_K + kws + 32 * 256) = sk1; \
        if constexpr (Cfg::MODE == 1) { \
            _Pragma("unroll") for (int i_ = 0; i_ < 8; ++i_) { const int n_ = sc + i_, c0_ = 64 * (t) + sr, c1_ = c0_ + 32; \
                sv0[i_] = (c0_ >= 4 * n_ - 1 && c0_ <= 4 * n_ + 3) ? (short)0x3F80 : (short)0; sv1[i_] = (c1_ >= 4 * n_ - 1 && c1_ <= 4 * n_ + 3) ? (short)0x3F80 : (short)0; } } \
        *(LAS bf16x8*)(V_lds + (bf) * SHM_V + vst0) = sv0; *(LAS bf16x8*)(V_lds + (bf) * SHM_V + vst1) = sv1; } while (0)
    __syncthreads();
    if (t_lo < t_hi) { AT_LOAD(t_lo); AT_WRITE(t_lo, 0); }
    __syncthreads();
    for (int t = t_lo; t < t_hi; ++t) {
        const int buf = (t - t_lo) & 1; const bool more = (t + 1 < t_hi);
        if (more) AT_LOAD(t + 1);
        if (c.active(t)) {
            f32x16 p0, p1;
            qkt(p0, p1, K_lds + buf * SHM_K, r32, hi, qr);
            c.mask(p0, p1, t);
            if constexpr (Cfg::MODE == 0) {
                float mn, alpha; bf16x8 pa0, pa1, pa2, pa3;
                partialSM(p0, p1, m_reg, mn, alpha);
                if (__any(alpha < 1.f)) { if (hi == 0) al_l[r32] = alpha; LDS_WAIT();
#pragma unroll
                    for (int d_ = 0; d_ < 4; ++d_)
#pragma unroll
                        for (int r = 0; r < 16; ++r) o[d_][r] *= al_l[crow(r, hi)]; }
                finishSM(p0, p1, alpha, l_reg, pa0, pa1, pa2, pa3); SBAR();
                pv_tile(o, vb0 + buf * SHM_V, pa0, pa1, pa2, pa3);
            } else {
                const float mL = -c.mfix * LOG2E; const float il = c.invl;
#pragma unroll
                for (int r = 0; r < 16; ++r) { p0[r] = __builtin_amdgcn_exp2f(fmaf(p0[r], LOG2E, mL)) * il; p1[r] = __builtin_amdgcn_exp2f(fmaf(p1[r], LOG2E, mL)) * il; }
                bf16x8 pa0, pa1, pa2, pa3;
                PK4(p0, 0, pa0); PK4(p0, 8, pa1); PK4(p1, 0, pa2); PK4(p1, 8, pa3); SBAR();
                pv_tile(o, vb0 + buf * SHM_V, pa0, pa1, pa2, pa3);
#pragma unroll
                for (int r = 0; r < 16; r += 2) { const unsigned a = cvtpk(p0[r], p0[r + 1]), b = cvtpk(p1[r], p1[r + 1]);
                    p0[r] -= bflo(a); p0[r + 1] -= bfhi(a); p1[r] -= bflo(b); p1[r + 1] -= bfhi(b); }
                PK4(p0, 0, pa0); PK4(p0, 8, pa1); PK4(p1, 0, pa2); PK4(p1, 8, pa3); SBAR();
                pv_tile(o, vb0 + buf * SHM_V, pa0, pa1, pa2, pa3);
            }
        }
        if (more) AT_WRITE(t + 1, buf ^ 1);
        __syncthreads();
    }
#undef AT_LOAD
#undef AT_WRITE
}

struct DilCfg {
    static constexpr int MODE = 0;
    const bf16_t* Kb; const bf16_t* Vb;
    const LAS float* tbl; int dshift, res, u, dqm, s0;
    __device__ __forceinline__ const bf16_t* krow(int t, int kk) const { int s = 256 * u - 128 + 64 * t + kk; s = s < 0 ? 0 : s; return Kb + (size_t)((s << dshift) + res) * PC; }
    __device__ __forceinline__ const bf16_t* vrow(int t, int kk) const { int s = 256 * u - 128 + 64 * t + kk; s = s < 0 ? 0 : s; return Vb + (size_t)((s << dshift) + res) * PC; }
    __device__ __forceinline__ bool active(int t) const { const int kb = 256 * u - 128 + 64 * t; return kb <= s0 + 31 && kb + 63 >= s0 - 128; }
    __device__ __forceinline__ void mask(f32x16& p0, f32x16& p1, int t) const {
        const int dq = dqm - (256 * u - 128 + 64 * t); const float NEG = -__builtin_inff();
        const LAS float* tb = tbl + (DT0 + dq - 63);
#pragma unroll
        for (int r = 0; r < 16; ++r) { const int cc = (r & 3) + 8 * (r >> 2); const unsigned d0 = (unsigned)(dq - cc), d1 = (unsigned)(dq - cc - 32);
            const float b0 = tb[63 - cc], b1 = tb[31 - cc];
            p0[r] = (d0 <= 128u) ? p0[r] + b0 : NEG; p1[r] = (d1 <= 128u) ? p1[r] + b1 : NEG; }
    }
};
struct CmpCfg {
    static constexpr int MODE = 0;
    const bf16_t* Kb; const bf16_t* Vb; int cmax, hi4;
    __device__ __forceinline__ const bf16_t* krow(int t, int kk) const { return Kb + (size_t)(64 * t + kk) * HD; }
    __device__ __forceinline__ const bf16_t* vrow(int t, int kk) const { return Vb + (size_t)(64 * t + kk) * HD; }
    __device__ __forceinline__ bool active(int) const { return true; }
    __device__ __forceinline__ void mask(f32x16& p0, f32x16& p1, int t) const {
        const int cb = 64 * t + hi4; const float NEG = -__builtin_inff();
#pragma unroll
        for (int r = 0; r < 16; ++r) { const int cc = cb + (r & 3) + 8 * (r >> 2); if (cc > cmax) p0[r] = NEG; if (cc + 32 > cmax) p1[r] = NEG; }
    }
};
struct CmpImpCfg {
    static constexpr int MODE = 1;
    const bf16_t* Kb; int cmax, hi4; float mfix, invl;
    __device__ __forceinline__ const bf16_t* krow(int t, int kk) const { return Kb + (size_t)(64 * t + kk) * HD; }
    __device__ __forceinline__ const bf16_t* vrow(int, int) const { return Kb; }
    __device__ __forceinline__ bool active(int) const { return true; }
    __device__ __forceinline__ void mask(f32x16& p0, f32x16& p1, int t) const {
        const int cb = 64 * t + hi4; const float NEG = -__builtin_inff();
#pragma unroll
        for (int r = 0; r < 16; ++r) { const int cc = cb + (r & 3) + 8 * (r >> 2); if (cc > cmax) p0[r] = NEG; if (cc + 32 > cmax) p1[r] = NEG; }
    }
};
struct SlcCfg {
    static constexpr int MODE = 0;
    const bf16_t* Kb; const bf16_t* Vb;
    const LAS float* tblh;
    unsigned s0, s1, s2, s3; int tqm, cur; float b31;
    __device__ __forceinline__ const bf16_t* krow(int t, int kk) const { return Kb + (size_t)(64 * t + kk) * PC; }
    __device__ __forceinline__ const bf16_t* vrow(int t, int kk) const { return Vb + (size_t)(64 * t + kk) * PC; }
    __device__ __forceinline__ bool selbit(int t) const { const unsigned q = (unsigned)t >> 5; const unsigned w = (q == 0u ? s0 + 0u : 0u) | (q == 1u ? s1 + 0u : 0u) | (q == 2u ? s2 + 0u : 0u) | (q == 3u ? s3 + 0u : 0u); return (w >> (t & 31)) & 1u; }
    __device__ __forceinline__ bool active(int t) const { return __any(selbit(t)); }
    __device__ __forceinline__ void mask(f32x16& p0, f32x16& p1, int t) const {
        const bool sel = selbit(t); const int dq = tqm - 64 * t; const float NEG = -__builtin_inff();
        if (64 * (cur - t) - 63 >= 1513) {
#pragma unroll
            for (int r = 0; r < 16; ++r) { p0[r] = sel ? p0[r] + b31 : NEG; p1[r] = sel ? p1[r] + b31 : NEG; }
        } else {
            const LAS float* tb = tblh + (TBL0 + dq - 63);
#pragma unroll
            for (int r = 0; r < 16; ++r) { const int cc = (r & 3) + 8 * (r >> 2); const int d0 = dq - cc, d1 = dq - cc - 32;
                const float b0 = tb[63 - cc], b1 = tb[31 - cc];
                p0[r] = (sel && d0 >= 0) ? p0[r] + b0 : NEG; p1[r] = (sel && d1 >= 0) ? p1[r] + b1 : NEG; }
        }
    }
};
struct WinCfg {
    static constexpr int MODE = 0;
    const bf16_t* Kb; const bf16_t* Vb; const LAS float* tblh; int tqm;
    __device__ __forceinline__ const bf16_t* krow(int t, int kk) const { return Kb + (size_t)(64 * t + kk) * PC; }
    __device__ __forceinline__ const bf16_t* vrow(int t, int kk) const { return Vb + (size_t)(64 * t + kk) * PC; }
    __device__ __forceinline__ bool active(int) const { return true; }
    __device__ __forceinline__ void mask(f32x16& p0, f32x16& p1, int t) const {
        const int dq = tqm - 64 * t; const float NEG = -__builtin_inff();
        const LAS float* tb = tblh + (TBL0 + dq - 63);
#pragma unroll
        for (int r = 0; r < 16; ++r) { const int cc = (r & 3) + 8 * (r >> 2); const unsigned d0 = (unsigned)(dq - cc), d1 = (unsigned)(dq - cc - 32);
            const float b0 = tb[63 - cc], b1 = tb[31 - cc];
            p0[r] = (d0 < 512u) ? p0[r] + b0 : NEG; p1[r] = (d1 < 512u) ? p1[r] + b1 : NEG; }
    }
};
}

__device__ __forceinline__ void dil_unit(LAS char* lds, const bf16_t* P, bf16_t* OA, float* LSE, const float* dilT, int pat, int dshift, int unit, const int wv) {
    using namespace att;
    const int tid = opq_tid(wv), lane = tid & 63, wid = __builtin_amdgcn_readfirstlane(tid >> 6), r32 = lane & 31, hi = lane >> 5;
    const int bh = unit >> 5, ru = unit & 31, b = bh >> 3, h = bh & 7;
    const int ncs = 5 - dshift, res = ru >> ncs, u = ru & ((1 << ncs) - 1);
    LAS float* tbl = (LAS float*)(lds + L_TBL);
    __syncthreads();
    if (tid < DTS) tbl[tid] = dilT[(pat * 8 + h) * DTS + tid];
    const int s0 = 256 * u + 32 * wid, s_row = s0 + r32;
    const size_t tokrow = (size_t)b * SEQ + (size_t)((s_row << dshift) + res);
    bf16x8 qr[8];
    { const bf16_t* qp = P + tokrow * PC + C_QA + h * HD + hi * 8;
#pragma unroll
      for (int d0 = 0; d0 < 8; ++d0) qr[d0] = *(const bf16x8*)(qp + d0 * 16); }
    f32x16 o[4]; float m_reg, l_reg;
    if (pat == 0) { m_reg = -1e30f; l_reg = 0.f;
#pragma unroll
        for (int d0 = 0; d0 < 4; ++d0) o[d0] = f32x16{}; }
    else { m_reg = LSE[tokrow * 8 + h]; l_reg = 1.f;
#pragma unroll
        for (int r = 0; r < 16; ++r) { const size_t tr = (size_t)b * SEQ + (size_t)(((s0 + crow(r, hi)) << dshift) + res); const bf16_t* op = OA + tr * 1024 + h * HD + r32;
#pragma unroll
            for (int d0 = 0; d0 < 4; ++d0) o[d0][r] = bf2f(op[d0 * 32]); } }
    DilCfg c; c.Kb = P + (size_t)b * SEQ * PC + C_KA + h * HD; c.Vb = P + (size_t)b * SEQ * PC + C_VA + h * HD; c.tbl = tbl; c.dshift = dshift; c.res = res; c.u = u; c.dqm = s_row - 4 * hi; c.s0 = s0;
    attn_tiles(c, lds, qr, o, m_reg, l_reg, (u == 0) ? 2 : 0, 6, wv);
    LAS float* li_l = (LAS float*)(lds + L_WS) + wid * 64;
    if (hi == 0) { li_l[r32] = l_reg; LSE[tokrow * 8 + h] = m_reg + logf(l_reg); }
    LDS_WAIT();
#pragma unroll
    for (int r = 0; r < 16; ++r) { const int orow = crow(r, hi); const float rl = 1.0f / li_l[orow];
        const size_t tr = (size_t)b * SEQ + (size_t)(((s0 + orow) << dshift) + res); bf16_t* op = OA + tr * 1024 + h * HD;
#pragma unroll
        for (int d0 = 0; d0 < 4; ++d0) { const float v = o[d0][r] * rl; const float vn = shx(v, 1, lane);
            if ((r32 & 1) == 0) *(unsigned*)(op + d0 * 32 + r32) = cvtpk(v, vn); } }
}

__device__ __forceinline__ void nsa_finalize(LAS char* lds, const f32x16 (&o)[4], float l_reg, const bf16_t* P, float* ON, const float* gb, int b, int g, int tok0, int br, bool first, const int wv) {
    using namespace att;
    const int tid = opq_tid(wv), lane = tid & 63, wid = __builtin_amdgcn_readfirstlane(tid >> 6), r32 = lane & 31, hi = lane >> 5;
    LAS float* li_l = (LAS float*)(lds + L_WS) + wid * 64;
    if (hi == 0) li_l[r32] = l_reg;
    LDS_WAIT();
#pragma unroll
    for (int r = 0; r < 16; ++r) { const int j = r & 3, k = r >> 2; const float lr = li_l[crow(r, hi)]; const float rl = lr > 0.f ? 1.0f / lr : 0.f;
        const size_t tok = (size_t)b * SEQ + tok0 + 2 * k + hi; const int hh = 4 * g + j;
        const float gl = bf2f(P[tok * PC + C_GL + hh * 3 + br]) + gb[hh * 3 + br];
        const float sc = rl * __builtin_amdgcn_rcpf(1.0f + __builtin_amdgcn_exp2f(-gl * LOG2E));
        float* op = ON + tok * 1024 + hh * HD + r32;
#pragma unroll
        for (int d0 = 0; d0 < 4; ++d0) { float v = o[d0][r] * sc; if (!first) v += op[d0 * 32]; op[d0 * 32] = v; }
        if ((r & 3) == 3) asm volatile("" ::: "memory"); }
}
__device__ __forceinline__ void nsa_unit(LAS char* lds, const bf16_t* P, const bf16_t* KC, const bf16_t* VC, float* ON, const float* nsaT, const float* gb, int b, int g, int qi, const int wv) {
    using namespace att;
    const int tid = opq_tid(wv), lane = tid & 63, wid = __builtin_amdgcn_readfirstlane(tid >> 6), r32 = lane & 31, hi = lane >> 5;
    LAS float* tbl = (LAS float*)(lds + L_TBL); LAS float* IMP = (LAS float*)(lds + L_IMP); LAS unsigned* SELM = (LAS unsigned*)(lds + L_SELM);
    __syncthreads();
    for (int i = tid; i < 4 * TBLS; i += NTHR) tbl[i] = nsaT[(size_t)(4 * g) * TBLS + i];
    const int tok0 = 64 * qi + 8 * wid, tq = tok0 + (r32 >> 2), hd = r32 & 3;
    const bf16_t* Pb = P + (size_t)b * SEQ * PC;
    bf16x8 qr[8];
    { const bf16_t* qp = Pb + (size_t)tq * PC + C_QN + (4 * g + hd) * HD + hi * 8;
#pragma unroll
      for (int d0 = 0; d0 < 8; ++d0) qr[d0] = *(const bf16x8*)(qp + d0 * 16); }
    const bf16_t* KCb = KC + (size_t)(b * 2 + g) * 512 * HD; const bf16_t* VCb = VC + (size_t)(b * 2 + g) * 512 * HD;
    const int ntc = (qi >> 4) + 1, cmax = (tq - 31) >> 4;
    f32x16 o[4]; float m_reg, l_reg;
#pragma unroll
    for (int d0 = 0; d0 < 4; ++d0) o[d0] = f32x16{};
    m_reg = -1e30f; l_reg = 0.f;
    { CmpCfg c; c.Kb = KCb; c.Vb = VCb; c.cmax = cmax; c.hi4 = 4 * hi; attn_tiles(c, lds, qr, o, m_reg, l_reg, 0, ntc, wv); }
    nsa_finalize(lds, o, l_reg, P, ON, gb, b, g, tok0, 0, true, wv);
    { CmpImpCfg c; c.Kb = KCb; c.cmax = cmax; c.hi4 = 4 * hi; c.mfix = m_reg; c.invl = l_reg > 0.f ? 1.0f / l_reg : 0.f;
#pragma unroll
      for (int d0 = 0; d0 < 4; ++d0) o[d0] = f32x16{};
      float md = 0.f, ld = 0.f; attn_tiles(c, lds, qr, o, md, ld, 0, ntc, wv); }
#pragma unroll
    for (int d0 = 0; d0 < 4; ++d0)
#pragma unroll
        for (int k = 0; k < 4; ++k) IMP[(8 * wid + 2 * k + hi) * 128 + 32 * d0 + r32] = (o[d0][4 * k] + o[d0][4 * k + 1]) + (o[d0][4 * k + 2] + o[d0][4 * k + 3]);
    __syncthreads();
    { const int cur = qi;
      for (int tl = 8 * wid; tl < 8 * wid + 8; ++tl) {
#pragma unroll
        for (int hf = 0; hf < 2; ++hf) { const int n = hf * 64 + lane; const float v = IMP[tl * 128 + n]; bool sel;
            if (cur <= 15) sel = (n <= cur);
            else { int rank = 0;
                for (int n4 = 0; n4 < 128; n4 += 4) { const f32x4 w = *(const LAS f32x4*)(IMP + tl * 128 + n4);
#pragma unroll
                    for (int j = 0; j < 4; ++j) { const int np = n4 + j; const bool cand = (np >= 1 && np <= cur - 2); rank += (cand && (w[j] > v || (w[j] == v && np < n))) ? 1 : 0; } }
                sel = (n == 0 || n == cur || n == cur - 1) || (n >= 1 && n <= cur - 2 && rank < 13); }
            const unsigned long long bal = __ballot(sel);
            if (lane == 0) { SELM[tl * 4 + hf * 2] = (unsigned)bal; SELM[tl * 4 + hf * 2 + 1] = (unsigned)(bal >> 32); } } } }
    __syncthreads();
    { SlcCfg c; c.Kb = Pb + C_KS + g * HD; c.Vb = Pb + C_VS + g * HD; c.tblh = tbl + hd * TBLS; c.tqm = tq - 4 * hi; c.cur = qi; c.b31 = tbl[hd * TBLS + TBL0 + 1600];
      const int tl = 8 * wid + (r32 >> 2); c.s0 = SELM[tl * 4 + 0]; c.s1 = SELM[tl * 4 + 1]; c.s2 = SELM[tl * 4 + 2]; c.s3 = SELM[tl * 4 + 3];
#pragma unroll
      for (int d0 = 0; d0 < 4; ++d0) o[d0] = f32x16{};
      m_reg = -1e30f; l_reg = 0.f;
      attn_tiles(c, lds, qr, o, m_reg, l_reg, 0, qi + 1, wv); }
    nsa_finalize(lds, o, l_reg, P, ON, gb, b, g, tok0, 1, false, wv);
    { WinCfg c; c.Kb = Pb + C_KW + g * HD; c.Vb = Pb + C_VW + g * HD; c.tblh = tbl + hd * TBLS; c.tqm = tq - 4 * hi;
#pragma unroll
      for (int d0 = 0; d0 < 4; ++d0) o[d0] = f32x16{};
      m_reg = -1e30f; l_reg = 0.f;
      attn_tiles(c, lds, qr, o, m_reg, l_reg, qi >= 8 ? qi - 8 : 0, qi + 1, wv); }
    nsa_finalize(lds, o, l_reg, P, ON, gb, b, g, tok0, 2, false, wv);
}

constexpr int LDS_BYTES = 147456;
constexpr int LDS_MISC = 131072;
constexpr int LDS_ARGS = LDS_MISC + 64;
__device__ __forceinline__ unsigned long long arg_u64(LAS unsigned char* lds, int i) {
    const LAS unsigned* p = (const LAS unsigned*)(lds + LDS_ARGS) + 2 * i;
    const unsigned lo = __builtin_amdgcn_readfirstlane(p[0]), hi = __builtin_amdgcn_readfirstlane(p[1]);
    return ((unsigned long long)hi << 32) | lo;
}
__device__ __forceinline__ const float* arg_in(LAS unsigned char* lds, int i) { return (const float*)arg_u64(lds, i); }
__device__ __forceinline__ float* arg_out(LAS unsigned char* lds) { return (float*)arg_u64(lds, 24); }
__device__ __forceinline__ unsigned char* arg_ws(LAS unsigned char* lds) { return (unsigned char*)arg_u64(lds, 25); }
__device__ __forceinline__ int opq_bx() { int b = blockIdx.x; asm volatile("" : "+s"(b)); return b; }
__device__ __forceinline__ int opq_g() { int b = gridDim.x; asm volatile("" : "+s"(b)); return b; }

__device__ __forceinline__ void ph_prep(LAS unsigned char* lds, int step, const int wv) {
    lds = opq_lds(lds);
    const int tid = opq_tid(wv), lane = tid & 63, wave = __builtin_amdgcn_readfirstlane(tid >> 6), G = opq_g(), bx = opq_bx();
    const int gw = bx * NWAVES + wave, NGW = G * NWAVES, l = step >> 1, half = step & 1;
    unsigned char* ws = arg_ws(lds);
    bf16_t* WUP = (bf16_t*)(ws + WS_WUP); bf16_t* WDN = (bf16_t*)(ws + WS_WDN); bf16_t* WIN = (bf16_t*)(ws + WS_WIN); bf16_t* WOUT = (bf16_t*)(ws + WS_WOUT); bf16_t* WC1 = (bf16_t*)(ws + WS_WC1);
    bf16_t* HB = (bf16_t*)(ws + WS_HB);
    LAS float* scr = (LAS float*)(lds + wave * 16384);
    const float* w1 = arg_in(lds, half ? I_F2W1 : I_F1W1) + (size_t)l * DM * DFF; const float* w3 = arg_in(lds, half ? I_F2W3 : I_F1W3) + (size_t)l * DM * DFF; const float* w2 = arg_in(lds, half ? I_F2W2 : I_F1W2) + (size_t)l * DFF * DM;
    constexpr int I_UP = 32 * 176, I_DN = 88 * 64, I_IN = 32 * 177, I_OUT = 32 * 64, I_C1 = 64 * 16, I_Z = 928;
    const int nitems = 2 * I_UP + I_DN + (half ? 0 : (I_IN + I_OUT + 2 * I_C1 + I_Z));
    for (int it = gw; it < nitems; it += NGW) {
        int r = it;
        if (r < I_UP) { transpose_item(w1, DM, DFF, WUP, 1, 0, scr, r, lane); continue; } r -= I_UP;
        if (r < I_UP) { transpose_item(w3, DM, DFF, WUP, 1, 128, scr, r, lane); continue; } r -= I_UP;
        if (r < I_DN) { transpose_item(w2, DFF, DM, WDN, 0, 0, scr, r, lane); continue; } r -= I_DN;
        if (r < I_IN) { transpose_item(arg_in(lds, I_WIN) + (size_t)l * DM * IN_COLS, DM, IN_COLS, WIN, 0, 0, scr, r, lane); continue; } r -= I_IN;
        if (r < I_OUT) { transpose_item(arg_in(lds, I_WOUT) + (size_t)l * DM * DM, DM, DM, WOUT, 0, 0, scr, r, lane); continue; } r -= I_OUT;
        if (r < I_C1) { transpose_item(arg_in(lds, I_CKW1) + (size_t)l * 4096 * 512, 4096, 512, WC1, 0, 0, scr, r, lane); continue; } r -= I_C1;
        if (r < I_C1) { transpose_item(arg_in(lds, I_CVW1) + (size_t)l * 4096 * 512, 4096, 512, WC1, 0, 512, scr, r, lane); continue; } r -= I_C1;
        { u32x4* z = (u32x4*)(WIN + (size_t)IN_COLS * DM) + (size_t)r * 64 + lane; unsigned zr = 0u; asm volatile("" : "+v"(zr)); *z = (u32x4){zr, zr, zr, zr}; }
    }
    const float* xs = (step == 0) ? arg_in(lds, I_X) : (const float*)arg_out(lds); const float* gn = arg_in(lds, half ? I_F2N : I_F1N) + (size_t)l * DM;
    f32x4 gv[8];
#pragma unroll
    for (int j = 0; j < 8; ++j) gv[j] = ((const f32x4*)gn)[64 * j + lane];
    for (int m = gw; m < NTOK; m += NGW) norm_row(xs + (size_t)m * DM, gv, HB + (size_t)m * DM, lane);
}
__device__ __forceinline__ void ph_mixnorm(LAS unsigned char* lds, int l, const int wv) {
    lds = opq_lds(lds);
    const int tid = opq_tid(wv), lane = tid & 63, wave = __builtin_amdgcn_readfirstlane(tid >> 6), G = opq_g(), bx = opq_bx();
    const int gw = bx * NWAVES + wave, NGW = G * NWAVES;
    bf16_t* HB = (bf16_t*)(arg_ws(lds) + WS_HB); const float* X = arg_out(lds);
    const float* gn = arg_in(lds, I_MIXN) + (size_t)l * DM; f32x4 gv[8];
#pragma unroll
    for (int j = 0; j < 8; ++j) gv[j] = ((const f32x4*)gn)[64 * j + lane];
    for (int m = gw; m < NTOK; m += NGW) norm_row(X + (size_t)m * DM, gv, HB + (size_t)m * DM, lane);
}
__device__ __forceinline__ void ph_headnorm(LAS unsigned char* lds, int l, const int wv) {
    lds = opq_lds(lds);
    const int tid = opq_tid(wv), lane = tid & 63, wave = __builtin_amdgcn_readfirstlane(tid >> 6), G = opq_g(), bx = opq_bx();
    const int gw = bx * NWAVES + wave, NGW = G * NWAVES;
    unsigned char* ws = arg_ws(lds); bf16_t* HP = (bf16_t*)(ws + WS_HP); bf16_t* ACMP = (bf16_t*)(ws + WS_ACMP);
    const float* qna = arg_in(lds, I_QNA) + l * HD; const float* kna = arg_in(lds, I_KNA) + l * HD; const float* qnn = arg_in(lds, I_QNN) + l * HD; const float* knn = arg_in(lds, I_KNN) + l * HD;
    const float* pos = arg_in(lds, I_POS) + (size_t)l * 32 * HD;
    const int e0 = (lane & 15) * 8;
    for (int m = gw; m < NTOK; m += NGW) {
        bf16_t* prow = HP + (size_t)m * PC;
#pragma unroll
        for (int ch = 0; ch < 7; ++ch) {
            int col; const float* gp; float sc = 1.f;
            if (ch < 2) { col = C_QA + ch * 512 + lane * 8; gp = qna; sc = QSCALE; }
            else if (ch < 4) { col = C_KA + (ch - 2) * 512 + lane * 8; gp = kna; }
            else if (ch < 6) { col = C_QN + (ch - 4) * 512 + lane * 8; gp = qnn; sc = QSCALE; }
            else { col = (lane < 32 ? C_KS + lane * 8 : C_KW + (lane - 32) * 8); gp = knn; }
            const u32x4 w = *(const u32x4*)(prow + col);
            float v[8] = {bflo(w.x), bfhi(w.x), bflo(w.y), bfhi(w.y), bflo(w.z), bfhi(w.z), bflo(w.w), bfhi(w.w)};
            float s = 0.f;
#pragma unroll
            for (int i = 0; i < 8; ++i) s += v[i] * v[i];
            s += shx(s, 1, lane); s += shx(s, 2, lane); s += shx(s, 4, lane); s += shx(s, 8, lane);
            const float rs = sc / sqrtf(s * (1.f / HD) + EPS);
            const f32x4 g0 = *(const f32x4*)(gp + e0), g1 = *(const f32x4*)(gp + e0 + 4);
            u32x4 o; o.x = cvtpk(v[0] * rs * g0.x, v[1] * rs * g0.y); o.y = cvtpk(v[2] * rs * g0.z, v[3] * rs * g0.w); o.z = cvtpk(v[4] * rs * g1.x, v[5] * rs * g1.y); o.w = cvtpk(v[6] * rs * g1.z, v[7] * rs * g1.w);
            *(u32x4*)(prow + col) = o;
        }
        { const int b = m / SEQ, t = m % SEQ, kv = lane >> 5, gg = (lane >> 4) & 1, c1 = t >> 4, j1 = t & 15;
          const u32x4 w = *(const u32x4*)(prow + C_KC + lane * 8);
          const float v[8] = {bflo(w.x), bfhi(w.x), bflo(w.y), bfhi(w.y), bflo(w.z), bfhi(w.z), bflo(w.w), bfhi(w.w)};
          bf16_t* abase = ACMP + ((size_t)kv * 4096 + (size_t)(b * 2 + gg) * 512) * 4096 + e0;
          if (c1 <= 510) { const f32x4 p0 = *(const f32x4*)(pos + j1 * HD + e0), p1 = *(const f32x4*)(pos + j1 * HD + e0 + 4);
              u32x4 o; o.x = cvtpk(v[0] + p0.x, v[1] + p0.y); o.y = cvtpk(v[2] + p0.z, v[3] + p0.w); o.z = cvtpk(v[4] + p1.x, v[5] + p1.y); o.w = cvtpk(v[6] + p1.z, v[7] + p1.w);
              *(u32x4*)(abase + (size_t)c1 * 4096 + j1 * HD) = o; }
          else { const u32x4 z = {0u, 0u, 0u, 0u}; *(u32x4*)(abase + (size_t)511 * 4096 + j1 * HD) = z; *(u32x4*)(abase + (size_t)511 * 4096 + (j1 + 16) * HD) = z; }
          if (c1 >= 1) { const int j2 = j1 + 16; const f32x4 p0 = *(const f32x4*)(pos + j2 * HD + e0), p1 = *(const f32x4*)(pos + j2 * HD + e0 + 4);
              u32x4 o; o.x = cvtpk(v[0] + p0.x, v[1] + p0.y); o.y = cvtpk(v[2] + p0.z, v[3] + p0.w); o.z = cvtpk(v[4] + p1.x, v[5] + p1.y); o.w = cvtpk(v[6] + p1.z, v[7] + p1.w);
              *(u32x4*)(abase + (size_t)(c1 - 1) * 4096 + j2 * HD) = o; } }
    }
}
__device__ __forceinline__ void ph_cmp2(LAS unsigned char* lds, int l, const int wv) {
    lds = opq_lds(lds);
    const int tid = opq_tid(wv), lane = tid & 63, wave = __builtin_amdgcn_readfirstlane(tid >> 6), G = opq_g(), bx = opq_bx();
    unsigned char* ws = arg_ws(lds); const float* CP = (const float*)(ws + WS_CP); bf16_t* KC = (bf16_t*)(ws + WS_KC); bf16_t* VC = (bf16_t*)(ws + WS_VC);
    LAS float* CH = (LAS float*)lds;
    LAS float* RED = (LAS float*)(lds + 32768);
    const float* knn = arg_in(lds, I_KNN) + l * HD;
    for (int it = bx; it < 512; it += G) {
        const int R0 = it * 16, kv = R0 >> 12, rl0 = R0 & 4095;
        __syncthreads();
        for (int idx = tid; idx < 16 * 512; idx += NTHR) { const int rr = idx >> 9, k = idx & 511; float v = 0.f;
#pragma unroll
            for (int ks = 0; ks < 4; ++ks) v += CP[((size_t)(kv * 4 + ks) * 4096 + rl0 + rr) * 512 + k];
            const float u3 = 0.7978845608028654f * (v + 0.044715f * v * v * v);
            const float th = 1.0f - 2.0f / (__expf(2.0f * u3) + 1.0f);
            CH[idx] = 0.5f * v * (1.0f + th); }
        __syncthreads();
        const int n = tid & 127, rq = tid >> 7;
        const float* w2 = arg_in(lds, kv ? I_CVW2 : I_CKW2) + (size_t)l * 512 * HD + n;
        float acc[4] = {0.f, 0.f, 0.f, 0.f};
        for (int k = 0; k < 512; ++k) { const float w = w2[(size_t)k * HD];
#pragma unroll
            for (int i = 0; i < 4; ++i) acc[i] += CH[(rq * 4 + i) * 512 + k] * w; }
        if (kv == 0) {
            float ss[4];
#pragma unroll
            for (int i = 0; i < 4; ++i) ss[i] = wave_sum(acc[i] * acc[i], lane);
            if (lane == 0) {
#pragma unroll
                for (int i = 0; i < 4; ++i) RED[wave * 4 + i] = ss[i]; }
            __syncthreads();
            const float gn = knn[n];
#pragma unroll
            for (int i = 0; i < 4; ++i) { const float tot = RED[(2 * rq) * 4 + i] + RED[(2 * rq + 1) * 4 + i]; acc[i] = acc[i] / sqrtf(tot * (1.f / HD) + EPS) * gn; }
        }
        bf16_t* dst = (bf16_t*)(ws + (kv ? WS_VC + 0 : WS_KC + 0)) + (size_t)(rl0 + rq * 4) * HD + n;
#pragma unroll
        for (int i = 0; i < 4; ++i) dst[(size_t)i * HD] = (bf16_t)f2bf(acc[i]);
    }
}
__device__ __forceinline__ void ph_outnorm(LAS unsigned char* lds, int l, const int wv) {
    lds = opq_lds(lds);
    const int tid = opq_tid(wv), lane = tid & 63, wave = __builtin_amdgcn_readfirstlane(tid >> 6), G = opq_g(), bx = opq_bx();
    const int gw = bx * NWAVES + wave, NGW = G * NWAVES;
    unsigned char* ws = arg_ws(lds); const bf16_t* OA = (const bf16_t*)(ws + WS_OA); const float* ON = (const float*)(ws + WS_ON); bf16_t* HB = (bf16_t*)(ws + WS_HB);
    const float* gn = arg_in(lds, I_ON) + (size_t)l * DM;
    for (int m = gw; m < NTOK; m += NGW) {
        const bf16_t* oa = OA + (size_t)m * 1024; const float* on = ON + (size_t)m * 1024; bf16_t* y = HB + (size_t)m * DM;
        const u32x4 wa = *(const u32x4*)(oa + lane * 8), wb = *(const u32x4*)(oa + 512 + lane * 8);
        float va[16] = {bflo(wa.x), bfhi(wa.x), bflo(wa.y), bfhi(wa.y), bflo(wa.z), bfhi(wa.z), bflo(wa.w), bfhi(wa.w), bflo(wb.x), bfhi(wb.x), bflo(wb.y), bfhi(wb.y), bflo(wb.z), bfhi(wb.z), bflo(wb.w), bfhi(wb.w)};
        float sa = 0.f;
#pragma unroll
        for (int i = 0; i < 16; ++i) sa += va[i] * va[i];
        const float ra = 1.0f / sqrtf(wave_sum(sa, lane) * (1.f / 1024.f) + EPS);
        { const f32x4 g0 = *(const f32x4*)(gn + lane * 8), g1 = *(const f32x4*)(gn + lane * 8 + 4), g2 = *(const f32x4*)(gn + 512 + lane * 8), g3 = *(const f32x4*)(gn + 512 + lane * 8 + 4);
          u32x4 o; o.x = cvtpk(va[0] * ra * g0.x, va[1] * ra * g0.y); o.y = cvtpk(va[2] * ra * g0.z, va[3] * ra * g0.w); o.z = cvtpk(va[4] * ra * g1.x, va[5] * ra * g1.y); o.w = cvtpk(va[6] * ra * g1.z, va[7] * ra * g1.w);
          *(u32x4*)(y + lane * 8) = o;
          o.x = cvtpk(va[8] * ra * g2.x, va[9] * ra * g2.y); o.y = cvtpk(va[10] * ra * g2.z, va[11] * ra * g2.w); o.z = cvtpk(va[12] * ra * g3.x, va[13] * ra * g3.y); o.w = cvtpk(va[14] * ra * g3.z, va[15] * ra * g3.w);
          *(u32x4*)(y + 512 + lane * 8) = o; }
        f32x4 vn[4]; float sn = 0.f;
#pragma unroll
        for (int j = 0; j < 4; ++j) { vn[j] = ((const f32x4*)on)[64 * j + lane]; sn += (vn[j].x * vn[j].x + vn[j].y * vn[j].y) + (vn[j].z * vn[j].z + vn[j].w * vn[j].w); }
        const float rn = 1.0f / sqrtf(wave_sum(sn, lane) * (1.f / 1024.f) + EPS);
#pragma unroll
        for (int j = 0; j < 4; ++j) { const f32x4 gg = ((const f32x4*)(gn + 1024))[64 * j + lane]; const f32x4 yy = vn[j] * rn * gg; u32x2 w; w.x = cvtpk(yy.x, yy.y); w.y = cvtpk(yy.z, yy.w);
            ((u32x2*)(y + 1024))[64 * j + lane] = w; }
    }
}

#define GRID_BAR() xcd_barrier(bar, wv)
__global__ void __launch_bounds__(NTHR, 2) mega_fwd(Args a) {
    extern __shared__ __attribute__((aligned(16))) unsigned char lds_raw[];
    LAS unsigned char* lds = (LAS unsigned char*)lds_raw;
    const int wv = __builtin_amdgcn_readfirstlane((int)threadIdx.x >> 6);
    {
        const int tid = threadIdx.x;
        for (int u = tid; u < (LDS_BYTES - LDS_MISC) / 4; u += NTHR) ((LAS unsigned*)(lds + LDS_MISC))[u] = 0u;
        __syncthreads();
        if (tid == 0) { LAS unsigned long long* t = (LAS unsigned long long*)(lds + LDS_ARGS);
#pragma unroll
            for (int i = 0; i < 24; ++i) t[i] = (unsigned long long)(uintptr_t)a.in[i];
            t[24] = (unsigned long long)(uintptr_t)a.out; t[25] = (unsigned long long)(uintptr_t)a.ws; }
        __syncthreads();
    }
    XcdBarrier bar = xcd_barrier_post((unsigned*)(arg_ws(lds) + WS_CTL) + CW_BAR, (volatile LAS unsigned*)(lds + LDS_MISC + 32));

    { const int tid = opq_tid(wv), G = opq_g(), bx = opq_bx(); const float* rb = arg_in(lds, I_RB); unsigned char* ws = arg_ws(lds);
      float* dilT = (float*)(ws + WS_TBL); float* nsaT = (float*)(ws + WS_TBL + 65536);
      for (int i = bx * NTHR + tid; i < 3 * 8 * DTS + 8 * TBLS; i += G * NTHR) {
          if (i < 3 * 8 * DTS) { const int p = i / (8 * DTS), h = (i / DTS) % 8, df = i % DTS - DT0; const int d = (p == 0) ? 1 : (p == 1 ? 4 : 16);
              dilT[i] = (df >= 0 && df <= 128) ? rb[rel_bucket_dev(df * d) * 16 + h] : 0.f; }
          else { const int j = i - 3 * 8 * DTS, hh = j / TBLS, ds = j % TBLS - TBL0; nsaT[j] = (ds >= 0) ? rb[rel_bucket_dev(ds) * 16 + 8 + hh] : 0.f; } } }

#pragma unroll 1
    for (int step = 0; step < 2 * DEPTH; ++step) {
        const int l = step >> 1, half = step & 1;
        ph_prep(lds, step, wv);
        GRID_BAR();
#if PH_FFN
        { unsigned char* ws = arg_ws(lds); const int G = opq_g(), bx = opq_bx();
          pg8::Gemm g{DM, DM, DM}; pg8::SchedStd S; S.init(ws + WS_HB, ws + WS_WUP, NTOK, 2 * DFF, DM, DM, G, bx); pg8::EpiSwiGLU E{(bf16_t*)(ws + WS_HP), DFF};
          pg8::gemm_phase<pg8::EpiSwiGLU, pg8::SchedStd>(opq_lds(lds), g, S, E, wv); }
        GRID_BAR();
        { unsigned char* ws = arg_ws(lds); const int G = opq_g(), bx = opq_bx(); float* X = arg_out(lds);
          pg8::Gemm g{DFF, DFF, DFF}; pg8::SchedStd S; S.init(ws + WS_HP, ws + WS_WDN, NTOK, DM, DFF, DFF, G, bx); pg8::EpiResid E{(step == 0) ? arg_in(lds, I_X) : (const float*)X, X, DM, 0.5f};
          pg8::gemm_phase<pg8::EpiResid, pg8::SchedStd>(opq_lds(lds), g, S, E, wv); }
#endif
        GRID_BAR();
        if (half == 0) {
            ph_mixnorm(lds, l, wv);
            GRID_BAR();
#if PH_INP
            { unsigned char* ws = arg_ws(lds); const int G = opq_g(), bx = opq_bx();
              pg8::Gemm g{DM, DM, DM}; pg8::SchedStd S; S.init(ws + WS_HB, ws + WS_WIN, NTOK, PC, DM, DM, G, bx); pg8::EpiBf16 E{(bf16_t*)(ws + WS_HP), PC};
              pg8::gemm_phase<pg8::EpiBf16, pg8::SchedStd>(opq_lds(lds), g, S, E, wv); }
#endif
            GRID_BAR();
            ph_headnorm(lds, l, wv);
            GRID_BAR();
#if PH_CMP
            { unsigned char* ws = arg_ws(lds); const int G = opq_g(), bx = opq_bx();
              pg8::Gemm g{4096, 4096, 1024}; pg8::SchedCmp S; S.A = (const char*)(ws + WS_ACMP); S.Bt = (const char*)(ws + WS_WC1); S.G = G; S.c = bx; pg8::EpiF32Z E{(float*)(ws + WS_CP), 512, (size_t)4096 * 512};
              pg8::gemm_phase<pg8::EpiF32Z, pg8::SchedCmp>(opq_lds(lds), g, S, E, wv); }
#endif
            GRID_BAR();
            ph_cmp2(lds, l, wv);
            GRID_BAR();
#pragma unroll 1
            for (int pat = 0; pat < 3; ++pat) {
#if PH_DIL
                { unsigned char* ws = arg_ws(lds); const int G = opq_g(), bx = opq_bx();
                  for (int unit = bx; unit < 1024; unit += G) dil_unit((LAS char*)opq_lds(lds), (const bf16_t*)(ws + WS_HP), (bf16_t*)(ws + WS_OA), (float*)(ws + WS_LSE), (const float*)(ws + WS_TBL), pat, 2 * pat, unit, wv); }
#endif
                GRID_BAR();
            }
#if PH_NSA
            { unsigned char* ws = arg_ws(lds); const int G = opq_g(), bx = opq_bx();
              const float* gb = arg_in(lds, I_GB) + l * 24;
#pragma unroll 1
              for (int i = 0; i < 4; ++i)
#pragma unroll 1
                  for (int w = bx; w < 256; w += G) { const int bg = w >> 5, j = w & 31; const int qi = (i == 0) ? 127 - j : (i == 1 ? j : (i == 2 ? 64 + j : 63 - j));
                      nsa_unit((LAS char*)opq_lds(lds), (const bf16_t*)(ws + WS_HP), (const bf16_t*)(ws + WS_KC), (const bf16_t*)(ws + WS_VC), (float*)(ws + WS_ON), (const float*)(ws + WS_TBL + 65536), gb, bg >> 1, bg & 1, qi, wv); } }
#endif
            GRID_BAR();
            ph_outnorm(lds, l, wv);
            GRID_BAR();
#if PH_OUT
            { unsigned char* ws = arg_ws(lds); const int G = opq_g(), bx = opq_bx(); float* X = arg_out(lds);
              pg8::Gemm g{DM, DM, DM}; pg8::SchedStd S; S.init(ws + WS_HB, ws + WS_WOUT, NTOK, DM, DM, DM, G, bx); pg8::EpiResid E{X, X, DM, 1.0f};
              pg8::gemm_phase<pg8::EpiResid, pg8::SchedStd>(opq_lds(lds), g, S, E, wv); }
#endif
            GRID_BAR();
        }
    }
}

extern "C" void kernel_launch(void* const* d_in, const int* in_sizes, int n_in, void* d_out, int out_size, void* d_ws, size_t ws_size, hipStream_t stream) {
    static int grid = 0;
    if (grid == 0) {
        if (n_in != 24 || in_sizes[0] != NTOK * DM || out_size != NTOK * DM || ws_size < WS_END) { fprintf(stderr, "kernel_launch: shape mismatch n_in %d in0 %d out %d ws %zu (need %zu)\n", n_in, n_in > 0 ? in_sizes[0] : -1, out_size, ws_size, (size_t)WS_END); grid = -1; return; }
        int dev = 0, cus = 0, per_cu = 0;
        if (hipGetDevice(&dev) != hipSuccess || hipDeviceGetAttribute(&cus, hipDeviceAttributeMultiprocessorCount, dev) != hipSuccess) { grid = -1; return; }
        if (hipFuncSetAttribute((const void*)mega_fwd, hipFuncAttributeMaxDynamicSharedMemorySize, LDS_BYTES) != hipSuccess) { fprintf(stderr, "kernel_launch: hipFuncSetAttribute failed\n"); grid = -1; return; }
        if (hipOccupancyMaxActiveBlocksPerMultiprocessor(&per_cu, (const void*)mega_fwd, NTHR, LDS_BYTES) != hipSuccess || per_cu < 1) { fprintf(stderr, "kernel_launch: occupancy query says %d\n", per_cu); (void)hipGetLastError(); if (per_cu < 1) { grid = -1; return; } }
        grid = cus;
    }
    if (grid < 0) return;
    if (hipMemsetAsync((char*)d_ws + WS_CTL, 0, CTL_ZERO_BYTES, stream) != hipSuccess) return;
    Args a{};
    for (int i = 0; i < 24; ++i) a.in[i] = (const float*)d_in[i];
    a.out = (float*)d_out; a.ws = (unsigned char*)d_ws;
    hipLaunchKernelGGL(mega_fwd, dim3(grid), dim3(NTHR), LDS_BYTES, stream, a);
    const hipError_t le = hipPeekAtLastError();
    if (le != hipSuccess) fprintf(stderr, "kernel_launch: launch failed: %s\n", hipGetErrorName(le));
}
```

```cpp
#include <hip/hip_runtime.h>
#include <cstdio>
#include <cstdint>

#define LAS __attribute__((address_space(3)))
typedef unsigned short bf16_t;
typedef short bf16x8 __attribute__((ext_vector_type(8)));
typedef short s16x4 __attribute__((ext_vector_type(4)));
typedef float f32x2 __attribute__((ext_vector_type(2)));
typedef float f32x4 __attribute__((ext_vector_type(4)));
typedef float f32x16 __attribute__((ext_vector_type(16)));
typedef unsigned u32x2 __attribute__((ext_vector_type(2)));
typedef unsigned u32x4 __attribute__((ext_vector_type(4)));

#ifndef DUP_GEMM
#define DUP_GEMM 0
#endif
#ifndef DUP_NSA
#define DUP_NSA 0
#endif
#ifndef DUP_DIL
#define DUP_DIL 0
#endif
#ifndef PH_FFN
#define PH_FFN 1
#endif
#ifndef PH_INP
#define PH_INP 1
#endif
#ifndef PH_CMP
#define PH_CMP 1
#endif
#ifndef PH_DIL
#define PH_DIL 1
#endif
#ifndef PH_NSA
#define PH_NSA 1
#endif
#ifndef PH_OUT
#define PH_OUT 1
#endif
constexpr int BATCH = 4, SEQ = 8192, DM = 2048, DFF = 5632, NTOK = BATCH * SEQ, DEPTH = 4, HD = 128;
constexpr int IN_COLS = 5656, PC = 5888;
constexpr int C_QA = 0, C_KA = 1024, C_VA = 2048, C_QN = 3072, C_KC = 4096, C_VC = 4352, C_KS = 4608, C_VS = 4864, C_KW = 5120, C_VW = 5376, C_GL = 5632;
constexpr float EPS = 1e-6f, QSCALE = 0.08838834764831845f, LOG2E = 1.4426950408889634f;
constexpr int TBLS = 1704, TBL0 = 64;
constexpr int DTS = 320, DT0 = 96;
constexpr int NWAVES = 8, NTHR = 512;

constexpr size_t MiB = 1u << 20;
constexpr size_t WS_CTL = 0, CTL_ZERO_BYTES = 1 * MiB;
constexpr size_t WS_TBL = 1 * MiB;
constexpr size_t WS_WUP = 2 * MiB;
constexpr size_t WS_WDN = 46 * MiB;
constexpr size_t WS_WIN = 68 * MiB;
constexpr size_t WS_WOUT = 91 * MiB;
constexpr size_t WS_WC1 = 99 * MiB;
constexpr size_t WS_HB = 107 * MiB;
constexpr size_t WS_HP = 235 * MiB;
constexpr size_t WS_OA = 603 * MiB;
constexpr size_t WS_LSE = 667 * MiB;
constexpr size_t WS_ON = 668 * MiB;
constexpr size_t WS_ACMP = 796 * MiB;
constexpr size_t WS_CP = 860 * MiB;
constexpr size_t WS_KC = 924 * MiB;
constexpr size_t WS_VC = 925 * MiB;
constexpr size_t WS_END = 926 * MiB;
constexpr int CW_BAR = 4096;

__device__ __forceinline__ unsigned f2bf(float f) { unsigned u = __builtin_bit_cast(unsigned, f); return (u + 0x7fffu + ((u >> 16) & 1u)) >> 16; }
__device__ __forceinline__ unsigned pk2(float lo, float hi) { return f2bf(lo) | (f2bf(hi) << 16); }
__device__ __forceinline__ float bf2f(bf16_t b) { return __builtin_bit_cast(float, ((unsigned)b) << 16); }
__device__ __forceinline__ float bflo(unsigned w) { return __builtin_bit_cast(float, w << 16); }
__device__ __forceinline__ float bfhi(unsigned w) { return __builtin_bit_cast(float, w & 0xffff0000u); }
__device__ __forceinline__ unsigned cvtpk(float lo, float hi) { unsigned r; asm volatile("v_cvt_pk_bf16_f32 %0, %1, %2" : "=v"(r) : "v"(lo), "v"(hi)); return r; }
__device__ __forceinline__ float shx(float v, int m, int lane) { return __builtin_bit_cast(float, __builtin_amdgcn_ds_bpermute((lane ^ m) << 2, __builtin_bit_cast(int, v))); }
__device__ __forceinline__ float wave_sum(float v, int lane) {
#pragma unroll
    for (int o = 1; o < 64; o <<= 1) v += shx(v, o, lane);
    return v;
}
__device__ __forceinline__ LAS unsigned char* opq_lds(LAS unsigned char* p) { unsigned a = (unsigned)(uintptr_t)p; asm volatile("" : "+s"(a)); return (LAS unsigned char*)(uintptr_t)a; }
__device__ __forceinline__ int opq_tid(int wv) { int l; asm volatile("v_mbcnt_lo_u32_b32 %0, -1, 0\n\tv_mbcnt_hi_u32_b32 %0, -1, %0" : "=v"(l)); return wv * 64 + l; }
#define LDS_WAIT() asm volatile("s_waitcnt lgkmcnt(0)" ::: "memory")
#define VM_WAIT() asm volatile("s_waitcnt vmcnt(0)" ::: "memory")
#define SBAR() __builtin_amdgcn_sched_barrier(0)

#define XB_TMO      128
#define XB_XCNT(j)  (256  + 64 * (j))
#define XB_XSUB(j)  (1280 + 64 * (j))
#define XB_XGEN(j)  (2304 + 64 * (j))
#define XB_TOP      3328
#define XB_TOPGEN   3392
#define XCD_BAR_WORDS 3456
#define XB_SPIN_CAP (1u << 18)
__device__ __forceinline__ unsigned xb_ld(unsigned* p)              { return __hip_atomic_load(p, __ATOMIC_RELAXED, __HIP_MEMORY_SCOPE_AGENT); }
__device__ __forceinline__ unsigned xb_add(unsigned* p, unsigned v) { return __hip_atomic_fetch_add(p, v, __ATOMIC_RELAXED, __HIP_MEMORY_SCOPE_AGENT); }
__device__ __forceinline__ unsigned xb_xcc_id() { return (unsigned)__builtin_amdgcn_s_getreg((3 << 11) | 20) & 0xFu; }
#define XB_SPIN(cond, bar) do { unsigned _sp = 0; while (cond) { __builtin_amdgcn_s_sleep(1); \
    if ((++_sp & 255u) == 0u) { if (xb_ld(&(bar)[XB_TMO])) break; if (_sp > XB_SPIN_CAP) { atomicAdd(&(bar)[XB_TMO], 1u); break; } } } } while (0)
struct XcdBarrier { unsigned* bar; unsigned x; volatile LAS unsigned* st; };
__device__ __forceinline__ XcdBarrier xcd_barrier_post(unsigned* bar, volatile LAS unsigned* st) {
    XcdBarrier b; b.bar = bar; b.x = xb_xcc_id(); b.st = st;
    if (threadIdx.x == 0) (void)xb_add(&bar[XB_XCNT(b.x)], 1u);
    return b;
}
__device__ __forceinline__ void xcd_barrier_complete(unsigned* bar, unsigned x, unsigned& nloc, unsigned& nx) {
    const unsigned G = gridDim.x * gridDim.y * gridDim.z;
    unsigned sum, cnt, mine, sp = 0u;
    for (;;) {
        sum = 0u; cnt = 0u; mine = 0u;
#pragma unroll
        for (unsigned j = 0; j < 16; ++j) { const unsigned c = xb_ld(&bar[XB_XCNT(j)]); sum += c; cnt += (c > 0u) ? 1u : 0u; mine = (j == x) ? c : mine; }
        if (sum == G) break;
        __builtin_amdgcn_s_sleep(1);
        if ((++sp & 255u) == 0u) { if (xb_ld(&bar[XB_TMO])) break; if (sp > XB_SPIN_CAP) { atomicAdd(&bar[XB_TMO], 1u); break; } }
    }
    nloc = mine > 0u ? mine : 1u; nx = cnt > 0u ? cnt : 1u;
}
__device__ __forceinline__ void xcd_barrier(const XcdBarrier& b, const int wv) {
    asm volatile("s_waitcnt vmcnt(0)" ::: "memory");
    __syncthreads();
    if (opq_tid(wv) == 0) {
        unsigned* bar = b.bar; asm volatile("" : "+s"(bar));
        __builtin_amdgcn_s_waitcnt(0);
        unsigned nloc = b.st[0], nx = b.st[1];
        if (nloc == 0u) { xcd_barrier_complete(bar, b.x, nloc, nx); b.st[0] = nloc; b.st[1] = nx; }
        const unsigned old = xb_add(&bar[XB_XSUB(b.x)], 1u);
        const unsigned gen = old / nloc;
        if (old + 1u == (gen + 1u) * nloc) {
            __builtin_amdgcn_fence(__ATOMIC_RELEASE, "agent");
            asm volatile("s_waitcnt vmcnt(0)" ::: "memory");
            const unsigned og = xb_add(&bar[XB_TOP], 1u);
            const unsigned tg = og / nx;
            if (og + 1u == (tg + 1u) * nx) xb_add(&bar[XB_TOPGEN], 1u);
            else XB_SPIN(xb_ld(&bar[XB_TOPGEN]) == tg, bar);
            __builtin_amdgcn_fence(__ATOMIC_ACQUIRE, "agent");
            xb_add(&bar[XB_XGEN(b.x)], 1u);
            asm volatile("s_waitcnt vmcnt(0)" ::: "memory");
        } else {
            XB_SPIN(xb_ld(&bar[XB_XGEN(b.x)]) == gen, bar);
            __builtin_amdgcn_fence(__ATOMIC_ACQUIRE, "agent");
            asm volatile("s_waitcnt vmcnt(0)" ::: "memory");
        }
    }
    __syncthreads();
}

namespace pg8 {
constexpr int BM = 256, BK = 64, HALF = 128, HTB = HALF * BK * 2, STAGE_BYTES = 8 * HTB, NXCD = 8, WGM = 8;
__host__ __device__ __forceinline__ int lds_byte(int r, int c) { const int st = (r >> 4) * 2 + (c >> 5), rr = r & 15, cc = c & 31, ob = rr * 64 + cc * 2; return st * 1024 + (ob ^ (((ob >> 9) & 1) << 5)); }
__host__ __device__ __forceinline__ void stage_rc(int b, int& R, int& C) { const int st = b / 1024, sb = b % 1024, swz = sb ^ (((sb >> 9) & 1) << 5); R = (st >> 1) * 16 + swz / 64; C = (st & 1) * 32 + (swz % 64) / 2; }
__host__ __device__ __forceinline__ int perm32(int rho) { const int n = rho >> 4, i = rho & 15; return 8 * (i >> 2) + 4 * n + (i & 3); }
struct Unit { int pm, pn, z; };
struct Gemm { int lda, ldb, K; };
struct SchedStd {
    const char* A; const char* Bt; size_t atile, btile; int nM, nN, nwg, G, c;
    __device__ __forceinline__ void init(const void* A_, const void* Bt_, int M, int N, int lda, int ldb, int G_, int c_) {
        A = (const char*)A_; Bt = (const char*)Bt_; atile = (size_t)BM * lda * 2; btile = (size_t)BM * ldb * 2; nM = M / BM; nN = N / BM; nwg = nM * nN; G = G_; c = c_; }
    __device__ __forceinline__ bool next(int i, Unit& u) const {
        const long L = (long)i * G + c; if (L >= nwg) return false;
        int wgid = (int)L; { const int q = nwg / NXCD, r = nwg % NXCD, xcd = wgid % NXCD, off = wgid / NXCD; wgid = (xcd < r ? xcd * (q + 1) : r * (q + 1) + (xcd - r) * q) + off; }
        const int nig = WGM * nN, gid = wgid / nig, fm = gid * WGM, gsz = (nM - fm) < WGM ? (nM - fm) : WGM;
        u.pm = fm + ((wgid % nig) % gsz); u.pn = (wgid % nig) / gsz; u.z = 0; return true;
    }
    __device__ __forceinline__ const char* a_ptr(const Unit& u) const { return A + (size_t)u.pm * atile; }
    __device__ __forceinline__ const char* b_ptr(const Unit& u) const { return Bt + (size_t)u.pn * btile; }
};
struct SchedCmp {
    const char* A; const char* Bt; int G, c;
    __device__ __forceinline__ bool next(int i, Unit& u) const { const int L = i * G + c; if (L >= 256) return false; u.z = L >> 5; u.pm = (L & 31) >> 1; u.pn = L & 1; return true; }
    __device__ __forceinline__ const char* a_ptr(const Unit& u) const { const int kv = u.z >> 2, ks = u.z & 3; return A + ((size_t)(kv * 4096 + u.pm * 256) * 4096 + (size_t)ks * 1024) * 2; }
    __device__ __forceinline__ const char* b_ptr(const Unit& u) const { const int kv = u.z >> 2, ks = u.z & 3; return Bt + ((size_t)(kv * 512 + u.pn * 256) * 4096 + (size_t)ks * 1024) * 2; }
};
struct EpiBf16 {
    static constexpr bool PERM = true;
    bf16_t* O; int ldc;
    __device__ __forceinline__ void operator()(const f32x4 (&acc)[2][2][4][2], const Unit& u, int wr, int wc, int fr, int fq) const {
        const int row0 = u.pm * BM + wr * 64 + fr, col0 = u.pn * BM + wc * 32 + 8 * fq;
#pragma unroll
        for (int ai = 0; ai < 2; ++ai)
#pragma unroll
            for (int m = 0; m < 4; ++m) { bf16_t* rowp = O + (size_t)(row0 + ai * HALF + m * 16) * ldc + col0;
#pragma unroll
                for (int bj = 0; bj < 2; ++bj) { const f32x4 v0 = acc[ai][bj][m][0], v1 = acc[ai][bj][m][1];
                    u32x4 w; w.x = cvtpk(v0[0], v0[1]); w.y = cvtpk(v0[2], v0[3]); w.z = cvtpk(v1[0], v1[1]); w.w = cvtpk(v1[2], v1[3]);
                    *(u32x4*)(rowp + bj * HALF) = w; } }
    }
};
struct EpiSwiGLU {
    static constexpr bool PERM = true;
    bf16_t* O; int ldc;
    __device__ __forceinline__ void operator()(const f32x4 (&acc)[2][2][4][2], const Unit& u, int wr, int wc, int fr, int fq) const {
        const int row0 = u.pm * BM + wr * 64 + fr, col0 = u.pn * HALF + wc * 32 + 8 * fq;
#pragma unroll
        for (int ai = 0; ai < 2; ++ai)
#pragma unroll
            for (int m = 0; m < 4; ++m) { bf16_t* rowp = O + (size_t)(row0 + ai * HALF + m * 16) * ldc + col0;
                float v[8];
#pragma unroll
                for (int n = 0; n < 2; ++n)
#pragma unroll
                    for (int j = 0; j < 4; ++j) { const float g = acc[ai][0][m][n][j], up = acc[ai][1][m][n][j];
                        const float s = g * __builtin_amdgcn_rcpf(1.0f + __builtin_amdgcn_exp2f(-g * LOG2E)); v[n * 4 + j] = s * up; }
                u32x4 w; w.x = cvtpk(v[0], v[1]); w.y = cvtpk(v[2], v[3]); w.z = cvtpk(v[4], v[5]); w.w = cvtpk(v[6], v[7]);
                *(u32x4*)rowp = w; }
    }
};
struct EpiResid {
    static constexpr bool PERM = false;
    const float* base; float* out; int ldc; float alpha;
    __device__ __forceinline__ void operator()(const f32x4 (&acc)[2][2][4][2], const Unit& u, int wr, int wc, int fr, int fq) const {
        const int row0 = u.pm * BM + wr * 64 + fr, col0 = u.pn * BM + wc * 32 + 4 * fq;
#pragma unroll
        for (int ai = 0; ai < 2; ++ai)
#pragma unroll
            for (int m = 0; m < 4; ++m) { const size_t off = (size_t)(row0 + ai * HALF + m * 16) * ldc + col0;
#pragma unroll
                for (int bj = 0; bj < 2; ++bj)
#pragma unroll
                    for (int n = 0; n < 2; ++n) { const f32x4 bs = *(const f32x4*)(base + off + bj * HALF + n * 16);
                        *(f32x4*)(out + off + bj * HALF + n * 16) = bs + acc[ai][bj][m][n] * alpha; } }
    }
};
struct EpiF32Z {
    static constexpr bool PERM = false;
    float* C; int ldc; size_t zstride;
    __device__ __forceinline__ void operator()(const f32x4 (&acc)[2][2][4][2], const Unit& u, int wr, int wc, int fr, int fq) const {
        float* Cz = C + (size_t)u.z * zstride;
        const int row0 = u.pm * BM + wr * 64 + fr, col0 = u.pn * BM + wc * 32 + 4 * fq;
#pragma unroll
        for (int ai = 0; ai < 2; ++ai)
#pragma unroll
            for (int m = 0; m < 4; ++m) { float* rowp = Cz + (size_t)(row0 + ai * HALF + m * 16) * ldc + col0;
#pragma unroll
                for (int bj = 0; bj < 2; ++bj)
#pragma unroll
                    for (int n = 0; n < 2; ++n) *(f32x4*)(rowp + bj * HALF + n * 16) = acc[ai][bj][m][n]; }
    }
};

template <class Epi, class Sched>
__device__ __forceinline__ void gemm_phase(LAS unsigned char* lds, const Gemm g, const Sched& S, const Epi& E, const int wv) {
    const int tid = opq_tid(wv), wid = __builtin_amdgcn_readfirstlane(tid >> 6), lane = tid & 63, wr = wid >> 2, wc = wid & 3, fr = lane & 15, fq = lane >> 4;
    const int K = g.K, nt = K / BK;
    unsigned voffA[2], voffB[2];
#pragma unroll
    for (int i = 0; i < 2; ++i) { int R, C; stage_rc(tid * 16 + i * 8192, R, C); const int Rb = Epi::PERM ? ((R & ~31) + perm32(R & 31)) : R;
        voffA[i] = (unsigned)(R * g.lda + C) * 2u; voffB[i] = (unsigned)(Rb * g.ldb + C) * 2u; }
    const size_t kstep = (size_t)(BK * 2);
    const size_t hstepA = (size_t)HALF * g.lda * 2, hstepB = (size_t)HALF * g.ldb * 2;
    const unsigned ldsw = (unsigned)wid * 1024u;
    const int aoff = lds_byte(wr * 64 + fr, fq * 8), boff = lds_byte(wc * 32 + fr, fq * 8);
#define PG8_SA(b, h) (((b) * 2 + (h)) * HTB)
#define PG8_SB(b, h) ((4 + (b) * 2 + (h)) * HTB)
#define PG8_STAGE(bufoff, gbase, voff) do { _Pragma("unroll") for (int _i = 0; _i < 2; ++_i) \
        __builtin_amdgcn_global_load_lds((const unsigned*)((const char*)(gbase) + (voff)[_i]), (LAS unsigned*)(lds + (bufoff) + ldsw + _i * 8192), 16, 0, 0); } while (0)
#define PG8_LDA(dst, b, h) do { _Pragma("unroll") for (int m = 0; m < 4; ++m) _Pragma("unroll") for (int k = 0; k < 2; ++k) dst[m][k] = *(const LAS bf16x8*)(lds + PG8_SA(b, h) + aoff + m * 2048 + k * 1024); } while (0)
#define PG8_LDB(dst, b, h) do { _Pragma("unroll") for (int n = 0; n < 2; ++n) _Pragma("unroll") for (int k = 0; k < 2; ++k) dst[n][k] = *(const LAS bf16x8*)(lds + PG8_SB(b, h) + boff + n * 2048 + k * 1024); } while (0)
#define PG8_MMA(ai, bj, At, Bt) do { __builtin_amdgcn_s_setprio(1); _Pragma("unroll") for (int m = 0; m < 4; ++m) _Pragma("unroll") for (int n = 0; n < 2; ++n) _Pragma("unroll") for (int k = 0; k < 2; ++k) \
        acc[ai][bj][m][n] = __builtin_amdgcn_mfma_f32_16x16x32_bf16(Bt[n][k], At[m][k], acc[ai][bj][m][n], 0, 0, 0); __builtin_amdgcn_s_setprio(0); } while (0)
#define PG8_WAIT_V(n) asm volatile("s_waitcnt vmcnt(" #n ")" ::: "memory")
#define PG8_WAIT_L(n) asm volatile("s_waitcnt lgkmcnt(" #n ")" ::: "memory")
#define PG8_BAR __builtin_amdgcn_s_barrier()
#define PG8_SCHED __builtin_amdgcn_sched_barrier(0)
    Unit cur, nxt; int ui = 0;
    if (!S.next(0, cur)) return;
    f32x4 acc[2][2][4][2];
#pragma unroll
    for (int a = 0; a < 2; ++a)
#pragma unroll
        for (int b = 0; b < 2; ++b)
#pragma unroll
            for (int m = 0; m < 4; ++m)
#pragma unroll
                for (int n = 0; n < 2; ++n) acc[a][b][m][n] = (f32x4){0.f, 0.f, 0.f, 0.f};
    bf16x8 At[4][2], B0[2][2], B1[2][2];
    const char* cA = S.a_ptr(cur); const char* cB = S.b_ptr(cur);
    PG8_STAGE(PG8_SB(0, 0), cB, voffB); PG8_STAGE(PG8_SA(0, 0), cA, voffA); PG8_STAGE(PG8_SB(0, 1), cB + hstepB, voffB); PG8_STAGE(PG8_SA(0, 1), cA + hstepA, voffA);
    if (wr == 1) PG8_BAR;
    PG8_WAIT_V(4); PG8_BAR;
    PG8_STAGE(PG8_SB(1, 0), cB + kstep, voffB); PG8_STAGE(PG8_SA(1, 0), cA + kstep, voffA); PG8_STAGE(PG8_SB(1, 1), cB + hstepB + kstep, voffB);
    PG8_WAIT_V(6); PG8_BAR;
    for (;;) {
        const bool has_next = S.next(ui + 1, nxt);
        const char* nA = has_next ? S.a_ptr(nxt) : cA; const char* nB = has_next ? S.b_ptr(nxt) : cB;
        for (int t = 0; t < nt; t += 2) {
            const bool last = (t == nt - 2);
            const char* a1 = cA + (size_t)(t + 1) * kstep;
            const char* a2 = last ? nA : cA + (size_t)(t + 2) * kstep; const char* b2 = last ? nB : cB + (size_t)(t + 2) * kstep;
            const char* a3 = a2 + kstep; const char* b3 = b2 + kstep;
            PG8_LDB(B0, 0, 0); PG8_SCHED; PG8_LDA(At, 0, 0); PG8_STAGE(PG8_SA(1, 1), a1 + hstepA, voffA);
            PG8_WAIT_L(8); PG8_BAR; PG8_WAIT_L(0); PG8_MMA(0, 0, At, B0); PG8_BAR; PG8_SCHED;
            PG8_LDB(B1, 0, 1); PG8_STAGE(PG8_SB(0, 0), b2, voffB);
            PG8_BAR; PG8_WAIT_L(0); PG8_MMA(0, 1, At, B1); PG8_BAR;
            PG8_LDA(At, 0, 1); PG8_STAGE(PG8_SA(0, 0), a2, voffA);
            PG8_BAR; PG8_WAIT_L(0); PG8_MMA(1, 0, At, B0); PG8_BAR; PG8_SCHED;
            PG8_STAGE(PG8_SB(0, 1), b2 + hstepB, voffB);
            PG8_WAIT_V(6); PG8_BAR; PG8_MMA(1, 1, At, B1); PG8_BAR;
            PG8_LDB(B0, 1, 0); PG8_SCHED; PG8_LDA(At, 1, 0); PG8_STAGE(PG8_SA(0, 1), a2 + hstepA, voffA);
            PG8_WAIT_L(8); PG8_BAR; PG8_WAIT_L(0); PG8_MMA(0, 0, At, B0); PG8_BAR; PG8_SCHED;
            PG8_LDB(B1, 1, 1); PG8_STAGE(PG8_SB(1, 0), b3, voffB);
            PG8_BAR; PG8_WAIT_L(0); PG8_MMA(0, 1, At, B1); PG8_BAR;
            PG8_LDA(At, 1, 1); PG8_STAGE(PG8_SA(1, 0), a3, voffA);
            PG8_BAR; PG8_WAIT_L(0); PG8_MMA(1, 0, At, B0); PG8_BAR; PG8_SCHED;
            PG8_STAGE(PG8_SB(1, 1), b3 + hstepB, voffB);
            PG8_WAIT_V(6); PG8_BAR; PG8_MMA(1, 1, At, B1); PG8_BAR;
        }
        E(acc, cur, wr, wc, fr, fq);
        if (!has_next) break;
#pragma unroll
        for (int a = 0; a < 2; ++a)
#pragma unroll
            for (int b = 0; b < 2; ++b)
#pragma unroll
                for (int m = 0; m < 4; ++m)
#pragma unroll
                    for (int n = 0; n < 2; ++n) acc[a][b][m][n] = (f32x4){0.f, 0.f, 0.f, 0.f};
        cur = nxt; cA = nA; cB = nB; ++ui;
    }
    PG8_WAIT_V(0);
    if (wr == 0) PG8_BAR;
    PG8_BAR;
#undef PG8_SA
#undef PG8_SB
#undef PG8_STAGE
#undef PG8_LDA
#undef PG8_LDB
#undef PG8_MMA
#undef PG8_WAIT_V
#undef PG8_WAIT_L
#undef PG8_BAR
#undef PG8_SCHED
}
}

struct Args { const float* in[24]; float* out; unsigned char* ws; };
enum { I_X = 0, I_F1N, I_F1W1, I_F1W3, I_F1W2, I_MIXN, I_WIN, I_GB, I_QNA, I_KNA, I_QNN, I_KNN, I_POS, I_CKW1, I_CKW2, I_CVW1, I_CVW2, I_ON, I_WOUT, I_F2N, I_F2W1, I_F2W3, I_F2W2, I_RB };

__device__ __forceinline__ void transpose_item(const float* W, int K, int N, bf16_t* WT, int mode, int off, LAS float* scr, int item, int lane) {
    const int nblk = (N + 31) / 32, kb = item / nblk, nb = item % nblk, k0 = 64 * kb, n0 = 32 * nb;
    const int nn = n0 + (lane & 31);
#pragma unroll
    for (int i = 0; i < 32; ++i) { const int kk = 2 * i + (lane >> 5); scr[kk * 33 + (lane & 31)] = (nn < N) ? W[(size_t)(k0 + kk) * N + nn] : 0.f; }
    LDS_WAIT(); asm volatile("" ::: "memory");
    const int c = lane & 7;
#pragma unroll
    for (int j = 0; j < 4; ++j) { const int n = (lane >> 3) + 8 * j; const LAS float* s = scr + (8 * c) * 33 + n;
        u32x4 o; o.x = pk2(s[0 * 33], s[1 * 33]); o.y = pk2(s[2 * 33], s[3 * 33]); o.z = pk2(s[4 * 33], s[5 * 33]); o.w = pk2(s[6 * 33], s[7 * 33]);
        const int ng = n0 + n; const int dr = mode ? ((ng >> 7) * 256 + (ng & 127) + off) : (ng + off);
        if (ng < N) *(u32x4*)(WT + (size_t)dr * K + k0 + 8 * c) = o; }
    LDS_WAIT(); asm volatile("" ::: "memory");
}
__device__ __forceinline__ int rel_bucket_dev(int n) {
    if (n < 16) return n;
    const float v = logf((float)n / 16.0f) / 4.852030263919617f * 16.0f;
    int b = 16 + (int)v; return b < 31 ? b : 31;
}
__device__ __forceinline__ void norm_row(const float* xrow, const f32x4 (&gn)[8], bf16_t* orow, int lane) {
    const f32x4* xr = (const f32x4*)xrow + lane;
    f32x4 v[8]; float s = 0.f;
#pragma unroll
    for (int j = 0; j < 8; ++j) { v[j] = xr[64 * j]; s += (v[j].x * v[j].x + v[j].y * v[j].y) + (v[j].z * v[j].z + v[j].w * v[j].w); }
    const float rstd = 1.0f / sqrtf(wave_sum(s, lane) * (1.f / DM) + EPS);
    u32x2* o8 = (u32x2*)orow + lane;
#pragma unroll
    for (int j = 0; j < 8; ++j) { const f32x4 y = v[j] * rstd * gn[j]; u32x2 w; w.x = cvtpk(y.x, y.y); w.y = cvtpk(y.z, y.w); o8[64 * j] = w; }
}

namespace att {
constexpr int SHM_V = 16384, SHM_K = 16384;
constexpr int L_V = 0, L_K = 32768, L_WS = 65536, L_TBL = 67584, L_IMP = L_TBL + 4 * TBLS * 4  , L_SELM = L_IMP + 32768  , L_END = L_SELM + 1024;
static_assert(L_END <= 131072, "attention LDS map");
constexpr float THR = 8.f;
#define KSWZ(row, colB) ((row) * 256 + ((colB) ^ (((row) & 7) << 4)))
__device__ __forceinline__ int v_st(int k, int c) { const int kk = (k & ~0xC) | ((k & 4) << 1) | ((k & 8) >> 1); return ((kk >> 3) * 4 + (c >> 5)) * 512 + ((kk & 7) * 32 + (c & 31)) * 2; }
__device__ __forceinline__ int v_rd_base(int lane) { return ((lane & 3) << 3) | (((lane >> 2) & 3) << 6) | (((lane >> 4) & 1) << 5) | (((lane >> 5) & 1) << 8); }
__device__ __forceinline__ int crow(int r, int hi) { return (r & 3) + 8 * (r >> 2) + 4 * hi; }

__device__ __forceinline__ void partialSM(f32x16& p0, f32x16& p1, float& m_reg, float& mn, float& alpha) {
    float pmax = p0[0];
#pragma unroll
    for (int r = 1; r < 16; ++r) pmax = fmaxf(pmax, p0[r]);
#pragma unroll
    for (int r = 0; r < 16; ++r) pmax = fmaxf(pmax, p1[r]);
    { auto rr = __builtin_amdgcn_permlane32_swap(__float_as_uint(pmax), __float_as_uint(pmax), false, false);
      pmax = fmaxf(__uint_as_float(rr[0]), __uint_as_float(rr[1])); }
    if (__builtin_expect(__all((pmax - m_reg) <= THR), 1)) { mn = m_reg; alpha = 1.f; }
    else { mn = fmaxf(m_reg, pmax); alpha = __builtin_amdgcn_exp2f((m_reg - mn) * LOG2E); m_reg = mn; }
    const float mnL = -mn * LOG2E;
#pragma unroll
    for (int r = 0; r < 16; ++r) p0[r] = fmaf(p0[r], LOG2E, mnL);
#pragma unroll
    for (int r = 0; r < 16; ++r) p1[r] = fmaf(p1[r], LOG2E, mnL);
#pragma unroll
    for (int r = 0; r < 16; ++r) p0[r] = __builtin_amdgcn_exp2f(p0[r]);
}
#define PK4(P, B_, OUT) do { unsigned a0 = cvtpk(P[B_+0], P[B_+1]), a1 = cvtpk(P[B_+2], P[B_+3]);                          \
        unsigned b0 = cvtpk(P[B_+4], P[B_+5]), b1 = cvtpk(P[B_+6], P[B_+7]);                                             \
        auto r0 = __builtin_amdgcn_permlane32_swap(a0, b0, false, false); auto r1 = __builtin_amdgcn_permlane32_swap(a1, b1, false, false); \
        u32x4 w = {r0[0], r1[0], r0[1], r1[1]}; OUT = *reinterpret_cast<bf16x8*>(&w); } while (0)
__device__ __forceinline__ void finishSM(f32x16& p0, f32x16& p1, float alpha, float& l_reg, bf16x8& pa0, bf16x8& pa1, bf16x8& pa2, bf16x8& pa3) {
#pragma unroll
    for (int r = 0; r < 16; ++r) p1[r] = __builtin_amdgcn_exp2f(p1[r]);
    float ps = 0;
#pragma unroll
    for (int r = 0; r < 16; ++r) ps += p0[r];
#pragma unroll
    for (int r = 0; r < 16; ++r) ps += p1[r];
    { auto rr = __builtin_amdgcn_permlane32_swap(__float_as_uint(ps), __float_as_uint(ps), false, false);
      ps = __uint_as_float(rr[0]) + __uint_as_float(rr[1]); }
    l_reg = l_reg * alpha + ps;
    PK4(p0, 0, pa0); PK4(p0, 8, pa1); PK4(p1, 0, pa2); PK4(p1, 8, pa3);
}
__device__ __forceinline__ void qkt(f32x16& p0, f32x16& p1, const LAS char* Kb, int r32, int hi, const bf16x8 (&qr)[8]) {
    p0 = f32x16{}; p1 = f32x16{};
#pragma unroll
    for (int d0 = 0; d0 < 8; ++d0) { const LAS char* a = Kb + KSWZ(r32, (d0 * 16 + hi * 8) * 2);
        const bf16x8 b0 = *reinterpret_cast<const LAS bf16x8*>(a);
        const bf16x8 b1 = *reinterpret_cast<const LAS bf16x8*>(a + 32 * 256);
        p0 = __builtin_amdgcn_mfma_f32_32x32x16_bf16(b0, qr[d0], p0, 0, 0, 0);
        p1 = __builtin_amdgcn_mfma_f32_32x32x16_bf16(b1, qr[d0], p1, 0, 0, 0); }
}
__device__ __forceinline__ void pv_tile(f32x16 (&o)[4], int vb, bf16x8 pa0, bf16x8 pa1, bf16x8 pa2, bf16x8 pa3) {
#define TRRD(dst, off) asm volatile("ds_read_b64_tr_b16 %0, %1 offset:%2" : "=&v"(dst) : "v"(vb), "i"(off) : "memory")
#define PV_D0(d0) do { s16x4 l0, l1, l2, l3, h0, h1, h2, h3; constexpr int b_ = (d0) * 512; \
        TRRD(l0, b_); TRRD(h0, b_ + 2048); TRRD(l1, b_ + 4096); TRRD(h1, b_ + 6144); TRRD(l2, b_ + 8192); TRRD(h2, b_ + 10240); TRRD(l3, b_ + 12288); TRRD(h3, b_ + 14336); \
        asm volatile("s_waitcnt lgkmcnt(0)" ::: "memory"); SBAR(); \
        o[d0] = __builtin_amdgcn_mfma_f32_32x32x16_bf16(pa0, (bf16x8){l0[0], l0[1], l0[2], l0[3], h0[0], h0[1], h0[2], h0[3]}, o[d0], 0, 0, 0);   \
        o[d0] = __builtin_amdgcn_mfma_f32_32x32x16_bf16(pa1, (bf16x8){l1[0], l1[1], l1[2], l1[3], h1[0], h1[1], h1[2], h1[3]}, o[d0], 0, 0, 0);   \
        o[d0] = __builtin_amdgcn_mfma_f32_32x32x16_bf16(pa2, (bf16x8){l2[0], l2[1], l2[2], l2[3], h2[0], h2[1], h2[2], h2[3]}, o[d0], 0, 0, 0);   \
        o[d0] = __builtin_amdgcn_mfma_f32_32x32x16_bf16(pa3, (bf16x8){l3[0], l3[1], l3[2], l3[3], h3[0], h3[1], h3[2], h3[3]}, o[d0], 0, 0, 0); } while (0)
    PV_D0(0); PV_D0(1); PV_D0(2); PV_D0(3);
#undef PV_D0
#undef TRRD
}

template <class Cfg>
__device__ __forceinline__ void attn_tiles(const Cfg& c, LAS char* lds, const bf16x8 (&qr)[8], f32x16 (&o)[4], float& m_reg, float& l_reg, const int t_lo, const int t_hi, const int wv) {
    const int tid = opq_tid(wv), lane = tid & 63, wid = __builtin_amdgcn_readfirstlane(tid >> 6), r32 = lane & 31, hi = lane >> 5;
    LAS char* V_lds = lds + L_V; LAS char* K_lds = lds + L_K;
    LAS float* al_l = (LAS float*)(lds + L_WS) + wid * 64 + 32;
    const int sr = tid >> 4, sc = (tid & 15) * 8;
    const int vst0 = v_st(sr, sc), vst1 = v_st(32 + sr, sc), kws = KSWZ(sr, sc * 2);
    const int vb0 = (int)(unsigned)(uintptr_t)V_lds + v_rd_base(lane);
    bf16x8 sk0, sk1, sv0, sv1;
#define AT_LOAD(t) do { sk0 = *(const bf16x8*)(c.krow((t), sr) + sc); sk1 = *(const bf16x8*)(c.krow((t), sr + 32) + sc); \
        if constexpr (Cfg::MODE == 0) { sv0 = *(const bf16x8*)(c.vrow((t), sr) + sc); sv1 = *(const bf16x8*)(c.vrow((t), sr + 32) + sc); } \
        asm volatile("" ::: "memory"); SBAR(); } while (0)
#define AT_WRITE(t, bf) do { *(LAS bf16x8*)(K_lds + (bf) * SHM_K + kws) = sk0; *(LAS bf16x8*)(K_lds + (bf) * SHM_K + kws + 32 * 256) = sk1; \
        if constexpr (Cfg::MODE == 1) { \
            _Pragma("unroll") for (int i_ = 0; i_ < 8; ++i_) { const int n_ = sc + i_, c0_ = 64 * (t) + sr, c1_ = c0_ + 32; \
                sv0[i_] = (c0_ >= 4 * n_ - 1 && c0_ <= 4 * n_ + 3) ? (short)0x3F80 : (short)0; sv1[i_] = (c1_ >= 4 * n_ - 1 && c1_ <= 4 * n_ + 3) ? (short)0x3F80 : (short)0; } } \
        *(LAS bf16x8*)(V_lds + (bf) * SHM_V + vst0) = sv0; *(LAS bf16x8*)(V_lds + (bf) * SHM_V + vst1) = sv1; } while (0)
    __syncthreads();
    if (t_lo < t_hi) { AT_LOAD(t_lo); AT_WRITE(t_lo, 0); }
    __syncthreads();
    for (int t = t_lo; t < t_hi; ++t) {
        const int buf = (t - t_lo) & 1; const bool more = (t + 1 < t_hi);
        if (more) AT_LOAD(t + 1);
        if (c.active(t)) {
            f32x16 p0, p1;
            qkt(p0, p1, K_lds + buf * SHM_K, r32, hi, qr);
            c.mask(p0, p1, t);
            if constexpr (Cfg::MODE == 0) {
                float mn, alpha; bf16x8 pa0, pa1, pa2, pa3;
                partialSM(p0, p1, m_reg, mn, alpha);
                if (__any(alpha < 1.f)) { if (hi == 0) al_l[r32] = alpha; LDS_WAIT();
#pragma unroll
                    for (int d_ = 0; d_ < 4; ++d_)
#pragma unroll
                        for (int r = 0; r < 16; ++r) o[d_][r] *= al_l[crow(r, hi)]; }
                finishSM(p0, p1, alpha, l_reg, pa0, pa1, pa2, pa3); SBAR();
                pv_tile(o, vb0 + buf * SHM_V, pa0, pa1, pa2, pa3);
            } else {
                const float mL = -c.mfix * LOG2E; const float il = c.invl;
#pragma unroll
                for (int r = 0; r < 16; ++r) { p0[r] = __builtin_amdgcn_exp2f(fmaf(p0[r], LOG2E, mL)) * il; p1[r] = __builtin_amdgcn_exp2f(fmaf(p1[r], LOG2E, mL)) * il; }
                bf16x8 pa0, pa1, pa2, pa3;
                PK4(p0, 0, pa0); PK4(p0, 8, pa1); PK4(p1, 0, pa2); PK4(p1, 8, pa3); SBAR();
                pv_tile(o, vb0 + buf * SHM_V, pa0, pa1, pa2, pa3);
#pragma unroll
                for (int r = 0; r < 16; r += 2) { const unsigned a = cvtpk(p0[r], p0[r + 1]), b = cvtpk(p1[r], p1[r + 1]);
                    p0[r] -= bflo(a); p0[r + 1] -= bfhi(a); p1[r] -= bflo(b); p1[r + 1] -= bfhi(b); }
                PK4(p0, 0, pa0); PK4(p0, 8, pa1); PK4(p1, 0, pa2); PK4(p1, 8, pa3); SBAR();
                pv_tile(o, vb0 + buf * SHM_V, pa0, pa1, pa2, pa3);
            }
        }
        if (more) AT_WRITE(t + 1, buf ^ 1);
        __syncthreads();
    }
#undef AT_LOAD
#undef AT_WRITE
}

struct DilCfg {
    static constexpr int MODE = 0;
    const bf16_t* Kb; const bf16_t* Vb;
    const LAS float* tbl; int dshift, res, u, dqm, s0;
    __device__ __forceinline__ const bf16_t* krow(int t, int kk) const { int s = 256 * u - 128 + 64 * t + kk; s = s < 0 ? 0 : s; return Kb + (size_t)((s << dshift) + res) * PC; }
    __device__ __forceinline__ const bf16_t* vrow(int t, int kk) const { int s = 256 * u - 128 + 64 * t + kk; s = s < 0 ? 0 : s; return Vb + (size_t)((s << dshift) + res) * PC; }
    __device__ __forceinline__ bool active(int t) const { const int kb = 256 * u - 128 + 64 * t; return kb <= s0 + 31 && kb + 63 >= s0 - 128; }
    __device__ __forceinline__ void mask(f32x16& p0, f32x16& p1, int t) const {
        const int dq = dqm - (256 * u - 128 + 64 * t); const float NEG = -__builtin_inff();
        const LAS float* tb = tbl + (DT0 + dq - 63);
#pragma unroll
        for (int r = 0; r < 16; ++r) { const int cc = (r & 3) + 8 * (r >> 2); const unsigned d0 = (unsigned)(dq - cc), d1 = (unsigned)(dq - cc - 32);
            const float b0 = tb[63 - cc], b1 = tb[31 - cc];
            p0[r] = (d0 <= 128u) ? p0[r] + b0 : NEG; p1[r] = (d1 <= 128u) ? p1[r] + b1 : NEG; }
    }
};
struct CmpCfg {
    static constexpr int MODE = 0;
    const bf16_t* Kb; const bf16_t* Vb; int cmax, hi4;
    __device__ __forceinline__ const bf16_t* krow(int t, int kk) const { return Kb + (size_t)(64 * t + kk) * HD; }
    __device__ __forceinline__ const bf16_t* vrow(int t, int kk) const { return Vb + (size_t)(64 * t + kk) * HD; }
    __device__ __forceinline__ bool active(int) const { return true; }
    __device__ __forceinline__ void mask(f32x16& p0, f32x16& p1, int t) const {
        const int cb = 64 * t + hi4; const float NEG = -__builtin_inff();
#pragma unroll
        for (int r = 0; r < 16; ++r) { const int cc = cb + (r & 3) + 8 * (r >> 2); if (cc > cmax) p0[r] = NEG; if (cc + 32 > cmax) p1[r] = NEG; }
    }
};
struct CmpImpCfg {
    static constexpr int MODE = 1;
    const bf16_t* Kb; int cmax, hi4; float mfix, invl;
    __device__ __forceinline__ const bf16_t* krow(int t, int kk) const { return Kb + (size_t)(64 * t + kk) * HD; }
    __device__ __forceinline__ const bf16_t* vrow(int, int) const { return Kb; }
    __device__ __forceinline__ bool active(int) const { return true; }
    __device__ __forceinline__ void mask(f32x16& p0, f32x16& p1, int t) const {
        const int cb = 64 * t + hi4; const float NEG = -__builtin_inff();
#pragma unroll
        for (int r = 0; r < 16; ++r) { const int cc = cb + (r & 3) + 8 * (r >> 2); if (cc > cmax) p0[r] = NEG; if (cc + 32 > cmax) p1[r] = NEG; }
    }
};
struct SlcCfg {
    static constexpr int MODE = 0;
    const bf16_t* Kb; const bf16_t* Vb;
    const LAS float* tblh;
    unsigned s0, s1, s2, s3; int tqm, cur; float b31;
    __device__ __forceinline__ const bf16_t* krow(int t, int kk) const { return Kb + (size_t)(64 * t + kk) * PC; }
    __device__ __forceinline__ const bf16_t* vrow(int t, int kk) const { return Vb + (size_t)(64 * t + kk) * PC; }
    __device__ __forceinline__ bool selbit(int t) const { const unsigned q = (unsigned)t >> 5; const unsigned w = (q == 0u ? s0 + 0u : 0u) | (q == 1u ? s1 + 0u : 0u) | (q == 2u ? s2 + 0u : 0u) | (q == 3u ? s3 + 0u : 0u); return (w >> (t & 31)) & 1u; }
    __device__ __forceinline__ bool active(int t) const { return __any(selbit(t)); }
    __device__ __forceinline__ void mask(f32x16& p0, f32x16& p1, int t) const {
        const bool sel = selbit(t); const int dq = tqm - 64 * t; const float NEG = -__builtin_inff();
        if (64 * (cur - t) - 63 >= 1513) {
#pragma unroll
            for (int r = 0; r < 16; ++r) { p0[r] = sel ? p0[r] + b31 : NEG; p1[r] = sel ? p1[r] + b31 : NEG; }
        } else {
            const LAS float* tb = tblh + (TBL0 + dq - 63);
#pragma unroll
            for (int r = 0; r < 16; ++r) { const int cc = (r & 3) + 8 * (r >> 2); const int d0 = dq - cc, d1 = dq - cc - 32;
                const float b0 = tb[63 - cc], b1 = tb[31 - cc];
                p0[r] = (sel && d0 >= 0) ? p0[r] + b0 : NEG; p1[r] = (sel && d1 >= 0) ? p1[r] + b1 : NEG; }
        }
    }
};
struct WinCfg {
    static constexpr int MODE = 0;
    const bf16_t* Kb; const bf16_t* Vb; const LAS float* tblh; int tqm;
    __device__ __forceinline__ const bf16_t* krow(int t, int kk) const { return Kb + (size_t)(64 * t + kk) * PC; }
    __device__ __forceinline__ const bf16_t* vrow(int t, int kk) const { return Vb + (size_t)(64 * t + kk) * PC; }
    __device__ __forceinline__ bool active(int) const { return true; }
    __device__ __forceinline__ void mask(f32x16& p0, f32x16& p1, int t) const {
        const int dq = tqm - 64 * t; const float NEG = -__builtin_inff();
        const LAS float* tb = tblh + (TBL0 + dq - 63);
#pragma unroll
        for (int r = 0; r < 16; ++r) { const int cc = (r & 3) + 8 * (r >> 2); const unsigned d0 = (unsigned)(dq - cc), d1 = (unsigned)(dq - cc - 32);
            const float b0 = tb[63 - cc], b1 = tb[31 - cc];
            p0[r] = (d0 < 512u) ? p0[r] + b0 : NEG; p1[r] = (d1 < 512u) ? p1[r] + b1 : NEG; }
    }
};
}

__device__ __forceinline__ void dil_unit(LAS char* lds, const bf16_t* P, bf16_t* OA, float* LSE, const float* dilT, int pat, int dshift, int unit, const int wv) {
    using namespace att;
    const int tid = opq_tid(wv), lane = tid & 63, wid = __builtin_amdgcn_readfirstlane(tid >> 6), r32 = lane & 31, hi = lane >> 5;
    const int bh = unit >> 5, ru = unit & 31, b = bh >> 3, h = bh & 7;
    const int ncs = 5 - dshift, res = ru >> ncs, u = ru & ((1 << ncs) - 1);
    LAS float* tbl = (LAS float*)(lds + L_TBL);
    __syncthreads();
    if (tid < DTS) tbl[tid] = dilT[(pat * 8 + h) * DTS + tid];
    const int s0 = 256 * u + 32 * wid, s_row = s0 + r32;
    const size_t tokrow = (size_t)b * SEQ + (size_t)((s_row << dshift) + res);
    bf16x8 qr[8];
    { const bf16_t* qp = P + tokrow * PC + C_QA + h * HD + hi * 8;
#pragma unroll
      for (int d0 = 0; d0 < 8; ++d0) qr[d0] = *(const bf16x8*)(qp + d0 * 16); }
    f32x16 o[4]; float m_reg, l_reg;
    if (pat == 0) { m_reg = -1e30f; l_reg = 0.f;
#pragma unroll
        for (int d0 = 0; d0 < 4; ++d0) o[d0] = f32x16{}; }
    else { m_reg = LSE[tokrow * 8 + h]; l_reg = 1.f;
#pragma unroll
        for (int r = 0; r < 16; ++r) { const size_t tr = (size_t)b * SEQ + (size_t)(((s0 + crow(r, hi)) << dshift) + res); const bf16_t* op = OA + tr * 1024 + h * HD + r32;
#pragma unroll
            for (int d0 = 0; d0 < 4; ++d0) o[d0][r] = bf2f(op[d0 * 32]); } }
    DilCfg c; c.Kb = P + (size_t)b * SEQ * PC + C_KA + h * HD; c.Vb = P + (size_t)b * SEQ * PC + C_VA + h * HD; c.tbl = tbl; c.dshift = dshift; c.res = res; c.u = u; c.dqm = s_row - 4 * hi; c.s0 = s0;
    attn_tiles(c, lds, qr, o, m_reg, l_reg, (u == 0) ? 2 : 0, 6, wv);
    LAS float* li_l = (LAS float*)(lds + L_WS) + wid * 64;
    if (hi == 0) { li_l[r32] = l_reg; LSE[tokrow * 8 + h] = m_reg + logf(l_reg); }
    LDS_WAIT();
#pragma unroll
    for (int r = 0; r < 16; ++r) { const int orow = crow(r, hi); const float rl = 1.0f / li_l[orow];
        const size_t tr = (size_t)b * SEQ + (size_t)(((s0 + orow) << dshift) + res); bf16_t* op = OA + tr * 1024 + h * HD;
#pragma unroll
        for (int d0 = 0; d0 < 4; ++d0) { const float v = o[d0][r] * rl; const float vn = shx(v, 1, lane);
            if ((r32 & 1) == 0) *(unsigned*)(op + d0 * 32 + r32) = cvtpk(v, vn); } }
}

__device__ __forceinline__ void nsa_finalize(LAS char* lds, const f32x16 (&o)[4], float l_reg, const bf16_t* P, float* ON, const float* gb, int b, int g, int tok0, int br, bool first, const int wv) {
    using namespace att;
    const int tid = opq_tid(wv), lane = tid & 63, wid = __builtin_amdgcn_readfirstlane(tid >> 6), r32 = lane & 31, hi = lane >> 5;
    LAS float* li_l = (LAS float*)(lds + L_WS) + wid * 64;
    if (hi == 0) li_l[r32] = l_reg;
    LDS_WAIT();
#pragma unroll
    for (int r = 0; r < 16; ++r) { const int j = r & 3, k = r >> 2; const float lr = li_l[crow(r, hi)]; const float rl = lr > 0.f ? 1.0f / lr : 0.f;
        const size_t tok = (size_t)b * SEQ + tok0 + 2 * k + hi; const int hh = 4 * g + j;
        const float gl = bf2f(P[tok * PC + C_GL + hh * 3 + br]) + gb[hh * 3 + br];
        const float sc = rl * __builtin_amdgcn_rcpf(1.0f + __builtin_amdgcn_exp2f(-gl * LOG2E));
        float* op = ON + tok * 1024 + hh * HD + r32;
#pragma unroll
        for (int d0 = 0; d0 < 4; ++d0) { float v = o[d0][r] * sc; if (!first) v += op[d0 * 32]; op[d0 * 32] = v; }
        if ((r & 3) == 3) asm volatile("" ::: "memory"); }
}
__device__ __forceinline__ void nsa_unit(LAS char* lds, const bf16_t* P, const bf16_t* KC, const bf16_t* VC, float* ON, const float* nsaT, const float* gb, int b, int g, int qi, const int wv) {
    using namespace att;
    const int tid = opq_tid(wv), lane = tid & 63, wid = __builtin_amdgcn_readfirstlane(tid >> 6), r32 = lane & 31, hi = lane >> 5;
    LAS float* tbl = (LAS float*)(lds + L_TBL); LAS float* IMP = (LAS float*)(lds + L_IMP); LAS unsigned* SELM = (LAS unsigned*)(lds + L_SELM);
    __syncthreads();
    for (int i = tid; i < 4 * TBLS; i += NTHR) tbl[i] = nsaT[(size_t)(4 * g) * TBLS + i];
    const int tok0 = 64 * qi + 8 * wid, tq = tok0 + (r32 >> 2), hd = r32 & 3;
    const bf16_t* Pb = P + (size_t)b * SEQ * PC;
    bf16x8 qr[8];
    { const bf16_t* qp = Pb + (size_t)tq * PC + C_QN + (4 * g + hd) * HD + hi * 8;
#pragma unroll
      for (int d0 = 0; d0 < 8; ++d0) qr[d0] = *(const bf16x8*)(qp + d0 * 16); }
    const bf16_t* KCb = KC + (size_t)(b * 2 + g) * 512 * HD; const bf16_t* VCb = VC + (size_t)(b * 2 + g) * 512 * HD;
    const int ntc = (qi >> 4) + 1, cmax = (tq - 31) >> 4;
    f32x16 o[4]; float m_reg, l_reg;
#pragma unroll
    for (int d0 = 0; d0 < 4; ++d0) o[d0] = f32x16{};
    m_reg = -1e30f; l_reg = 0.f;
    { CmpCfg c; c.Kb = KCb; c.Vb = VCb; c.cmax = cmax; c.hi4 = 4 * hi; attn_tiles(c, lds, qr, o, m_reg, l_reg, 0, ntc, wv); }
    nsa_finalize(lds, o, l_reg, P, ON, gb, b, g, tok0, 0, true, wv);
    { CmpImpCfg c; c.Kb = KCb; c.cmax = cmax; c.hi4 = 4 * hi; c.mfix = m_reg; c.invl = l_reg > 0.f ? 1.0f / l_reg : 0.f;
#pragma unroll
      for (int d0 = 0; d0 < 4; ++d0) o[d0] = f32x16{};
      float md = 0.f, ld = 0.f; attn_tiles(c, lds, qr, o, md, ld, 0, ntc, wv); }
#pragma unroll
    for (int d0 = 0; d0 < 4; ++d0)
#pragma unroll
        for (int k = 0; k < 4; ++k) IMP[(8 * wid + 2 * k + hi) * 128 + 32 * d0 + r32] = (o[d0][4 * k] + o[d0][4 * k + 1]) + (o[d0][4 * k + 2] + o[d0][4 * k + 3]);
    __syncthreads();
    { const int cur = qi;
      for (int tl = 8 * wid; tl < 8 * wid + 8; ++tl) {
#pragma unroll
        for (int hf = 0; hf < 2; ++hf) { const int n = hf * 64 + lane; const float v = IMP[tl * 128 + n]; bool sel;
            if (cur <= 15) sel = (n <= cur);
            else { int rank = 0;
                for (int n4 = 0; n4 < 128; n4 += 4) { const f32x4 w = *(const LAS f32x4*)(IMP + tl * 128 + n4);
#pragma unroll
                    for (int j = 0; j < 4; ++j) { const int np = n4 + j; const bool cand = (np >= 1 && np <= cur - 2); rank += (cand && (w[j] > v || (w[j] == v && np < n))) ? 1 : 0; } }
                sel = (n == 0 || n == cur || n == cur - 1) || (n >= 1 && n <= cur - 2 && rank < 13); }
            const unsigned long long bal = __ballot(sel);
            if (lane == 0) { SELM[tl * 4 + hf * 2] = (unsigned)bal; SELM[tl * 4 + hf * 2 + 1] = (unsigned)(bal >> 32); } } } }
    __syncthreads();
    { SlcCfg c; c.Kb = Pb + C_KS + g * HD; c.Vb = Pb + C_VS + g * HD; c.tblh = tbl + hd * TBLS; c.tqm = tq - 4 * hi; c.cur = qi; c.b31 = tbl[hd * TBLS + TBL0 + 1600];
      const int tl = 8 * wid + (r32 >> 2); c.s0 = SELM[tl * 4 + 0]; c.s1 = SELM[tl * 4 + 1]; c.s2 = SELM[tl * 4 + 2]; c.s3 = SELM[tl * 4 + 3];
#pragma unroll
      for (int d0 = 0; d0 < 4; ++d0) o[d0] = f32x16{};
      m_reg = -1e30f; l_reg = 0.f;
      attn_tiles(c, lds, qr, o, m_reg, l_reg, 0, qi + 1, wv); }
    nsa_finalize(lds, o, l_reg, P, ON, gb, b, g, tok0, 1, false, wv);
    { WinCfg c; c.Kb = Pb + C_KW + g * HD; c.Vb = Pb + C_VW + g * HD; c.tblh = tbl + hd * TBLS; c.tqm = tq - 4 * hi;
#pragma unroll
      for (int d0 = 0; d0 < 4; ++d0) o[d0] = f32x16{};
      m_reg = -1e30f; l_reg = 0.f;
      attn_tiles(c, lds, qr, o, m_reg, l_reg, qi >= 8 ? qi - 8 : 0, qi + 1, wv); }
    nsa_finalize(lds, o, l_reg, P, ON, gb, b, g, tok0, 2, false, wv);
}

constexpr int LDS_BYTES = 147456;
constexpr int LDS_MISC = 131072;
constexpr int LDS_ARGS = LDS_MISC + 64;
__device__ __forceinline__ unsigned long long arg_u64(LAS unsigned char* lds, int i) {
    const LAS unsigned* p = (const LAS unsigned*)(lds + LDS_ARGS) + 2 * i;
    const unsigned lo = __builtin_amdgcn_readfirstlane(p[0]), hi = __builtin_amdgcn_readfirstlane(p[1]);
    return ((unsigned long long)hi << 32) | lo;
}
#define GAS __attribute__((address_space(1)))
__device__ __forceinline__ const float* arg_in(LAS unsigned char* lds, int i) { return (const float*)(GAS const float*)arg_u64(lds, i); }
__device__ __forceinline__ float* arg_out(LAS unsigned char* lds) { return (float*)(GAS float*)arg_u64(lds, 24); }
__device__ __forceinline__ unsigned char* arg_ws(LAS unsigned char* lds) { return (unsigned char*)(GAS unsigned char*)arg_u64(lds, 25); }
__device__ __forceinline__ int opq_bx() { int b = blockIdx.x; asm volatile("" : "+s"(b)); return b; }
__device__ __forceinline__ int opq_g() { int b = gridDim.x; asm volatile("" : "+s"(b)); return b; }

__device__ __forceinline__ void ph_prep(LAS unsigned char* lds, int step, const int wv) {
    lds = opq_lds(lds);
    const int tid = opq_tid(wv), lane = tid & 63, wave = __builtin_amdgcn_readfirstlane(tid >> 6), G = opq_g(), bx = opq_bx();
    const int gw = bx * NWAVES + wave, NGW = G * NWAVES, l = step >> 1, half = step & 1;
    unsigned char* ws = arg_ws(lds);
    bf16_t* WUP = (bf16_t*)(ws + WS_WUP); bf16_t* WDN = (bf16_t*)(ws + WS_WDN); bf16_t* WIN = (bf16_t*)(ws + WS_WIN); bf16_t* WOUT = (bf16_t*)(ws + WS_WOUT); bf16_t* WC1 = (bf16_t*)(ws + WS_WC1);
    bf16_t* HB = (bf16_t*)(ws + WS_HB);
    LAS float* scr = (LAS float*)(lds + wave * 16384);
    const float* w1 = arg_in(lds, half ? I_F2W1 : I_F1W1) + (size_t)l * DM * DFF; const float* w3 = arg_in(lds, half ? I_F2W3 : I_F1W3) + (size_t)l * DM * DFF; const float* w2 = arg_in(lds, half ? I_F2W2 : I_F1W2) + (size_t)l * DFF * DM;
    constexpr int I_UP = 32 * 176, I_DN = 88 * 64, I_IN = 32 * 177, I_OUT = 32 * 64, I_C1 = 64 * 16, I_Z = 928;
    const int nitems = 2 * I_UP + I_DN + (half ? 0 : (I_IN + I_OUT + 2 * I_C1 + I_Z));
    for (int it = gw; it < nitems; it += NGW) {
        int r = it;
        if (r < I_UP) { transpose_item(w1, DM, DFF, WUP, 1, 0, scr, r, lane); continue; } r -= I_UP;
        if (r < I_UP) { transpose_item(w3, DM, DFF, WUP, 1, 128, scr, r, lane); continue; } r -= I_UP;
        if (r < I_DN) { transpose_item(w2, DFF, DM, WDN, 0, 0, scr, r, lane); continue; } r -= I_DN;
        if (r < I_IN) { transpose_item(arg_in(lds, I_WIN) + (size_t)l * DM * IN_COLS, DM, IN_COLS, WIN, 0, 0, scr, r, lane); continue; } r -= I_IN;
        if (r < I_OUT) { transpose_item(arg_in(lds, I_WOUT) + (size_t)l * DM * DM, DM, DM, WOUT, 0, 0, scr, r, lane); continue; } r -= I_OUT;
        if (r < I_C1) { transpose_item(arg_in(lds, I_CKW1) + (size_t)l * 4096 * 512, 4096, 512, WC1, 0, 0, scr, r, lane); continue; } r -= I_C1;
        if (r < I_C1) { transpose_item(arg_in(lds, I_CVW1) + (size_t)l * 4096 * 512, 4096, 512, WC1, 0, 512, scr, r, lane); continue; } r -= I_C1;
        { u32x4* z = (u32x4*)(WIN + (size_t)IN_COLS * DM) + (size_t)r * 64 + lane; unsigned zr = 0u; asm volatile("" : "+v"(zr)); *z = (u32x4){zr, zr, zr, zr}; }
    }
    const float* xs = (step == 0) ? arg_in(lds, I_X) : (const float*)arg_out(lds); const float* gn = arg_in(lds, half ? I_F2N : I_F1N) + (size_t)l * DM;
    f32x4 gv[8];
#pragma unroll
    for (int j = 0; j < 8; ++j) gv[j] = ((const f32x4*)gn)[64 * j + lane];
    for (int m = gw; m < NTOK; m += NGW) norm_row(xs + (size_t)m * DM, gv, HB + (size_t)m * DM, lane);
}
__device__ __forceinline__ void ph_mixnorm(LAS unsigned char* lds, int l, const int wv) {
    lds = opq_lds(lds);
    const int tid = opq_tid(wv), lane = tid & 63, wave = __builtin_amdgcn_readfirstlane(tid >> 6), G = opq_g(), bx = opq_bx();
    const int gw = bx * NWAVES + wave, NGW = G * NWAVES;
    bf16_t* HB = (bf16_t*)(arg_ws(lds) + WS_HB); const float* X = arg_out(lds);
    const float* gn = arg_in(lds, I_MIXN) + (size_t)l * DM; f32x4 gv[8];
#pragma unroll
    for (int j = 0; j < 8; ++j) gv[j] = ((const f32x4*)gn)[64 * j + lane];
    for (int m = gw; m < NTOK; m += NGW) norm_row(X + (size_t)m * DM, gv, HB + (size_t)m * DM, lane);
}
__device__ __forceinline__ void ph_headnorm(LAS unsigned char* lds, int l, const int wv) {
    lds = opq_lds(lds);
    const int tid = opq_tid(wv), lane = tid & 63, wave = __builtin_amdgcn_readfirstlane(tid >> 6), G = opq_g(), bx = opq_bx();
    const int gw = bx * NWAVES + wave, NGW = G * NWAVES;
    unsigned char* ws = arg_ws(lds); bf16_t* HP = (bf16_t*)(ws + WS_HP); bf16_t* ACMP = (bf16_t*)(ws + WS_ACMP);
    const float* qna = arg_in(lds, I_QNA) + l * HD; const float* kna = arg_in(lds, I_KNA) + l * HD; const float* qnn = arg_in(lds, I_QNN) + l * HD; const float* knn = arg_in(lds, I_KNN) + l * HD;
    const float* pos = arg_in(lds, I_POS) + (size_t)l * 32 * HD;
    const int e0 = (lane & 15) * 8;
    for (int m = gw; m < NTOK; m += NGW) {
        bf16_t* prow = HP + (size_t)m * PC;
#pragma unroll
        for (int ch = 0; ch < 7; ++ch) {
            int col; const float* gp; float sc = 1.f;
            if (ch < 2) { col = C_QA + ch * 512 + lane * 8; gp = qna; sc = QSCALE; }
            else if (ch < 4) { col = C_KA + (ch - 2) * 512 + lane * 8; gp = kna; }
            else if (ch < 6) { col = C_QN + (ch - 4) * 512 + lane * 8; gp = qnn; sc = QSCALE; }
            else { col = (lane < 32 ? C_KS + lane * 8 : C_KW + (lane - 32) * 8); gp = knn; }
            const u32x4 w = *(const u32x4*)(prow + col);
            float v[8] = {bflo(w.x), bfhi(w.x), bflo(w.y), bfhi(w.y), bflo(w.z), bfhi(w.z), bflo(w.w), bfhi(w.w)};
            float s = 0.f;
#pragma unroll
            for (int i = 0; i < 8; ++i) s += v[i] * v[i];
            s += shx(s, 1, lane); s += shx(s, 2, lane); s += shx(s, 4, lane); s += shx(s, 8, lane);
            const float rs = sc / sqrtf(s * (1.f / HD) + EPS);
            const f32x4 g0 = *(const f32x4*)(gp + e0), g1 = *(const f32x4*)(gp + e0 + 4);
            u32x4 o; o.x = cvtpk(v[0] * rs * g0.x, v[1] * rs * g0.y); o.y = cvtpk(v[2] * rs * g0.z, v[3] * rs * g0.w); o.z = cvtpk(v[4] * rs * g1.x, v[5] * rs * g1.y); o.w = cvtpk(v[6] * rs * g1.z, v[7] * rs * g1.w);
            *(u32x4*)(prow + col) = o;
        }
        { const int b = m / SEQ, t = m % SEQ, kv = lane >> 5, gg = (lane >> 4) & 1, c1 = t >> 4, j1 = t & 15;
          const u32x4 w = *(const u32x4*)(prow + C_KC + lane * 8);
          const float v[8] = {bflo(w.x), bfhi(w.x), bflo(w.y), bfhi(w.y), bflo(w.z), bfhi(w.z), bflo(w.w), bfhi(w.w)};
          bf16_t* abase = ACMP + ((size_t)kv * 4096 + (size_t)(b * 2 + gg) * 512) * 4096 + e0;
          if (c1 <= 510) { const f32x4 p0 = *(const f32x4*)(pos + j1 * HD + e0), p1 = *(const f32x4*)(pos + j1 * HD + e0 + 4);
              u32x4 o; o.x = cvtpk(v[0] + p0.x, v[1] + p0.y); o.y = cvtpk(v[2] + p0.z, v[3] + p0.w); o.z = cvtpk(v[4] + p1.x, v[5] + p1.y); o.w = cvtpk(v[6] + p1.z, v[7] + p1.w);
              *(u32x4*)(abase + (size_t)c1 * 4096 + j1 * HD) = o; }
          else { const u32x4 z = {0u, 0u, 0u, 0u}; *(u32x4*)(abase + (size_t)511 * 4096 + j1 * HD) = z; *(u32x4*)(abase + (size_t)511 * 4096 + (j1 + 16) * HD) = z; }
          if (c1 >= 1) { const int j2 = j1 + 16; const f32x4 p0 = *(const f32x4*)(pos + j2 * HD + e0), p1 = *(const f32x4*)(pos + j2 * HD + e0 + 4);
              u32x4 o; o.x = cvtpk(v[0] + p0.x, v[1] + p0.y); o.y = cvtpk(v[2] + p0.z, v[3] + p0.w); o.z = cvtpk(v[4] + p1.x, v[5] + p1.y); o.w = cvtpk(v[6] + p1.z, v[7] + p1.w);
              *(u32x4*)(abase + (size_t)(c1 - 1) * 4096 + j2 * HD) = o; } }
    }
}
__device__ __forceinline__ void ph_cmp2(LAS unsigned char* lds, int l, const int wv) {
    lds = opq_lds(lds);
    const int tid = opq_tid(wv), lane = tid & 63, wave = __builtin_amdgcn_readfirstlane(tid >> 6), G = opq_g(), bx = opq_bx();
    unsigned char* ws = arg_ws(lds); const float* CP = (const float*)(ws + WS_CP); bf16_t* KC = (bf16_t*)(ws + WS_KC); bf16_t* VC = (bf16_t*)(ws + WS_VC);
    LAS float* CH = (LAS float*)lds;
    LAS float* RED = (LAS float*)(lds + 32768);
    const float* knn = arg_in(lds, I_KNN) + l * HD;
    for (int it = bx; it < 512; it += G) {
        const int R0 = it * 16, kv = R0 >> 12, rl0 = R0 & 4095;
        __syncthreads();
        for (int idx = tid; idx < 16 * 512; idx += NTHR) { const int rr = idx >> 9, k = idx & 511; float v = 0.f;
#pragma unroll
            for (int ks = 0; ks < 4; ++ks) v += CP[((size_t)(kv * 4 + ks) * 4096 + rl0 + rr) * 512 + k];
            const float u3 = 0.7978845608028654f * (v + 0.044715f * v * v * v);
            const float th = 1.0f - 2.0f / (__expf(2.0f * u3) + 1.0f);
            CH[idx] = 0.5f * v * (1.0f + th); }
        __syncthreads();
        const int n = tid & 127, rq = tid >> 7;
        const float* w2 = arg_in(lds, kv ? I_CVW2 : I_CKW2) + (size_t)l * 512 * HD + n;
        float acc[4] = {0.f, 0.f, 0.f, 0.f};
#pragma unroll 16
        for (int k = 0; k < 512; ++k) { const float w = w2[(size_t)k * HD];
#pragma unroll
            for (int i = 0; i < 4; ++i) acc[i] += CH[(rq * 4 + i) * 512 + k] * w; }
        if (kv == 0) {
            float ss[4];
#pragma unroll
            for (int i = 0; i < 4; ++i) ss[i] = wave_sum(acc[i] * acc[i], lane);
            if (lane == 0) {
#pragma unroll
                for (int i = 0; i < 4; ++i) RED[wave * 4 + i] = ss[i]; }
            __syncthreads();
            const float gn = knn[n];
#pragma unroll
            for (int i = 0; i < 4; ++i) { const float tot = RED[(2 * rq) * 4 + i] + RED[(2 * rq + 1) * 4 + i]; acc[i] = acc[i] / sqrtf(tot * (1.f / HD) + EPS) * gn; }
        }
        bf16_t* dst = (bf16_t*)(ws + (kv ? WS_VC + 0 : WS_KC + 0)) + (size_t)(rl0 + rq * 4) * HD + n;
#pragma unroll
        for (int i = 0; i < 4; ++i) dst[(size_t)i * HD] = (bf16_t)f2bf(acc[i]);
    }
}
__device__ __forceinline__ void ph_outnorm(LAS unsigned char* lds, int l, const int wv) {
    lds = opq_lds(lds);
    const int tid = opq_tid(wv), lane = tid & 63, wave = __builtin_amdgcn_readfirstlane(tid >> 6), G = opq_g(), bx = opq_bx();
    const int gw = bx * NWAVES + wave, NGW = G * NWAVES;
    unsigned char* ws = arg_ws(lds); const bf16_t* OA = (const bf16_t*)(ws + WS_OA); const float* ON = (const float*)(ws + WS_ON); bf16_t* HB = (bf16_t*)(ws + WS_HB);
    const float* gn = arg_in(lds, I_ON) + (size_t)l * DM;
    for (int m = gw; m < NTOK; m += NGW) {
        const bf16_t* oa = OA + (size_t)m * 1024; const float* on = ON + (size_t)m * 1024; bf16_t* y = HB + (size_t)m * DM;
        const u32x4 wa = *(const u32x4*)(oa + lane * 8), wb = *(const u32x4*)(oa + 512 + lane * 8);
        float va[16] = {bflo(wa.x), bfhi(wa.x), bflo(wa.y), bfhi(wa.y), bflo(wa.z), bfhi(wa.z), bflo(wa.w), bfhi(wa.w), bflo(wb.x), bfhi(wb.x), bflo(wb.y), bfhi(wb.y), bflo(wb.z), bfhi(wb.z), bflo(wb.w), bfhi(wb.w)};
        float sa = 0.f;
#pragma unroll
        for (int i = 0; i < 16; ++i) sa += va[i] * va[i];
        const float ra = 1.0f / sqrtf(wave_sum(sa, lane) * (1.f / 1024.f) + EPS);
        { const f32x4 g0 = *(const f32x4*)(gn + lane * 8), g1 = *(const f32x4*)(gn + lane * 8 + 4), g2 = *(const f32x4*)(gn + 512 + lane * 8), g3 = *(const f32x4*)(gn + 512 + lane * 8 + 4);
          u32x4 o; o.x = cvtpk(va[0] * ra * g0.x, va[1] * ra * g0.y); o.y = cvtpk(va[2] * ra * g0.z, va[3] * ra * g0.w); o.z = cvtpk(va[4] * ra * g1.x, va[5] * ra * g1.y); o.w = cvtpk(va[6] * ra * g1.z, va[7] * ra * g1.w);
          *(u32x4*)(y + lane * 8) = o;
          o.x = cvtpk(va[8] * ra * g2.x, va[9] * ra * g2.y); o.y = cvtpk(va[10] * ra * g2.z, va[11] * ra * g2.w); o.z = cvtpk(va[12] * ra * g3.x, va[13] * ra * g3.y); o.w = cvtpk(va[14] * ra * g3.z, va[15] * ra * g3.w);
          *(u32x4*)(y + 512 + lane * 8) = o; }
        f32x4 vn[4]; float sn = 0.f;
#pragma unroll
        for (int j = 0; j < 4; ++j) { vn[j] = ((const f32x4*)on)[64 * j + lane]; sn += (vn[j].x * vn[j].x + vn[j].y * vn[j].y) + (vn[j].z * vn[j].z + vn[j].w * vn[j].w); }
        const float rn = 1.0f / sqrtf(wave_sum(sn, lane) * (1.f / 1024.f) + EPS);
#pragma unroll
        for (int j = 0; j < 4; ++j) { const f32x4 gg = ((const f32x4*)(gn + 1024))[64 * j + lane]; const f32x4 yy = vn[j] * rn * gg; u32x2 w; w.x = cvtpk(yy.x, yy.y); w.y = cvtpk(yy.z, yy.w);
            ((u32x2*)(y + 1024))[64 * j + lane] = w; }
    }
}

#define GRID_BAR() xcd_barrier(bar, wv)
__global__ void __launch_bounds__(NTHR, 2) mega_fwd(Args a) {
    extern __shared__ __attribute__((aligned(16))) unsigned char lds_raw[];
    LAS unsigned char* lds = (LAS unsigned char*)lds_raw;
    const int wv = __builtin_amdgcn_readfirstlane((int)threadIdx.x >> 6);
    {
        const int tid = threadIdx.x;
        for (int u = tid; u < (LDS_BYTES - LDS_MISC) / 4; u += NTHR) ((LAS unsigned*)(lds + LDS_MISC))[u] = 0u;
        __syncthreads();
        if (tid == 0) { LAS unsigned long long* t = (LAS unsigned long long*)(lds + LDS_ARGS);
#pragma unroll
            for (int i = 0; i < 24; ++i) t[i] = (unsigned long long)(uintptr_t)a.in[i];
            t[24] = (unsigned long long)(uintptr_t)a.out; t[25] = (unsigned long long)(uintptr_t)a.ws; }
        __syncthreads();
    }
    XcdBarrier bar = xcd_barrier_post((unsigned*)(arg_ws(lds) + WS_CTL) + CW_BAR, (volatile LAS unsigned*)(lds + LDS_MISC + 32));

    { const int tid = opq_tid(wv), G = opq_g(), bx = opq_bx(); const float* rb = arg_in(lds, I_RB); unsigned char* ws = arg_ws(lds);
      float* dilT = (float*)(ws + WS_TBL); float* nsaT = (float*)(ws + WS_TBL + 65536);
      for (int i = bx * NTHR + tid; i < 3 * 8 * DTS + 8 * TBLS; i += G * NTHR) {
          if (i < 3 * 8 * DTS) { const int p = i / (8 * DTS), h = (i / DTS) % 8, df = i % DTS - DT0; const int d = (p == 0) ? 1 : (p == 1 ? 4 : 16);
              dilT[i] = (df >= 0 && df <= 128) ? rb[rel_bucket_dev(df * d) * 16 + h] : 0.f; }
          else { const int j = i - 3 * 8 * DTS, hh = j / TBLS, ds = j % TBLS - TBL0; nsaT[j] = (ds >= 0) ? rb[rel_bucket_dev(ds) * 16 + 8 + hh] : 0.f; } } }

#pragma unroll 1
    for (int step = 0; step < 2 * DEPTH; ++step) {
        const int l = step >> 1, half = step & 1;
        ph_prep(lds, step, wv);
        GRID_BAR();
#if PH_FFN
        { unsigned char* ws = arg_ws(lds); const int G = opq_g(), bx = opq_bx();
          pg8::Gemm g{DM, DM, DM}; pg8::SchedStd S; S.init(ws + WS_HB, ws + WS_WUP, NTOK, 2 * DFF, DM, DM, G, bx); pg8::EpiSwiGLU E{(bf16_t*)(ws + WS_HP), DFF};
#pragma unroll 1
          for (int dup = 0; dup <= DUP_GEMM; ++dup) { pg8::gemm_phase<pg8::EpiSwiGLU, pg8::SchedStd>(opq_lds(lds), g, S, E, wv); if (DUP_GEMM) GRID_BAR(); } }
        GRID_BAR();
        { unsigned char* ws = arg_ws(lds); const int G = opq_g(), bx = opq_bx(); float* X = arg_out(lds);
          pg8::Gemm g{DFF, DFF, DFF}; pg8::SchedStd S; S.init(ws + WS_HP, ws + WS_WDN, NTOK, DM, DFF, DFF, G, bx); pg8::EpiResid E{(step == 0) ? arg_in(lds, I_X) : (const float*)X, X, DM, 0.5f};
#pragma unroll 1
          for (int dup = 0; dup <= DUP_GEMM; ++dup) { if (dup) { E.base = X; E.alpha = 0.f; } pg8::gemm_phase<pg8::EpiResid, pg8::SchedStd>(opq_lds(lds), g, S, E, wv); if (DUP_GEMM) GRID_BAR(); } }
#endif
        GRID_BAR();
        if (half == 0) {
            ph_mixnorm(lds, l, wv);
            GRID_BAR();
#if PH_INP
            { unsigned char* ws = arg_ws(lds); const int G = opq_g(), bx = opq_bx();
              pg8::Gemm g{DM, DM, DM}; pg8::SchedStd S; S.init(ws + WS_HB, ws + WS_WIN, NTOK, PC, DM, DM, G, bx); pg8::EpiBf16 E{(bf16_t*)(ws + WS_HP), PC};
#pragma unroll 1
              for (int dup = 0; dup <= DUP_GEMM; ++dup) { pg8::gemm_phase<pg8::EpiBf16, pg8::SchedStd>(opq_lds(lds), g, S, E, wv); if (DUP_GEMM) GRID_BAR(); } }
#endif
            GRID_BAR();
            ph_headnorm(lds, l, wv);
            GRID_BAR();
#if PH_CMP
            { unsigned char* ws = arg_ws(lds); const int G = opq_g(), bx = opq_bx();
              pg8::Gemm g{4096, 4096, 1024}; pg8::SchedCmp S; S.A = (const char*)(ws + WS_ACMP); S.Bt = (const char*)(ws + WS_WC1); S.G = G; S.c = bx; pg8::EpiF32Z E{(float*)(ws + WS_CP), 512, (size_t)4096 * 512};
              pg8::gemm_phase<pg8::EpiF32Z, pg8::SchedCmp>(opq_lds(lds), g, S, E, wv); }
#endif
            GRID_BAR();
            ph_cmp2(lds, l, wv);
            GRID_BAR();
#pragma unroll 1
            for (int pat3 = 0; pat3 < 3 * (1 + DUP_DIL); ++pat3) { const int pat = pat3 % 3;
#if PH_DIL
                { unsigned char* ws = arg_ws(lds); const int G = opq_g(), bx = opq_bx();
                  for (int unit = bx; unit < 1024; unit += G) dil_unit((LAS char*)opq_lds(lds), (const bf16_t*)(ws + WS_HP), (bf16_t*)(ws + WS_OA), (float*)(ws + WS_LSE), (const float*)(ws + WS_TBL), pat, 2 * pat, unit, wv); }
#endif
                GRID_BAR();
            }
#if PH_NSA
            { unsigned char* ws = arg_ws(lds); const int G = opq_g(), bx = opq_bx();
              const float* gb = arg_in(lds, I_GB) + l * 24;
#pragma unroll 1
              for (int i4 = 0; i4 < 4 * (1 + DUP_NSA); ++i4)
#pragma unroll 1
                  for (int w = bx; w < 256; w += G) { const int i = i4 & 3; const int bg = w >> 5, j = w & 31; const int qi = (i == 0) ? 127 - j : (i == 1 ? j : (i == 2 ? 64 + j : 63 - j));
                      nsa_unit((LAS char*)opq_lds(lds), (const bf16_t*)(ws + WS_HP), (const bf16_t*)(ws + WS_KC), (const bf16_t*)(ws + WS_VC), (float*)(ws + WS_ON), (const float*)(ws + WS_TBL + 65536), gb, bg >> 1, bg & 1, qi, wv); } }
#endif
            GRID_BAR();
            ph_outnorm(lds, l, wv);
            GRID_BAR();
#if PH_OUT
            { unsigned char* ws = arg_ws(lds); const int G = opq_g(), bx = opq_bx(); float* X = arg_out(lds);
              pg8::Gemm g{DM, DM, DM}; pg8::SchedStd S; S.init(ws + WS_HB, ws + WS_WOUT, NTOK, DM, DM, DM, G, bx); pg8::EpiResid E{X, X, DM, 1.0f};
#pragma unroll 1
              for (int dup = 0; dup <= DUP_GEMM; ++dup) { if (dup) E.alpha = 0.f; pg8::gemm_phase<pg8::EpiResid, pg8::SchedStd>(opq_lds(lds), g, S, E, wv); if (DUP_GEMM) GRID_BAR(); } }
#endif
            GRID_BAR();
        }
    }
}

extern "C" void kernel_launch(void* const* d_in, const int* in_sizes, int n_in, void* d_out, int out_size, void* d_ws, size_t ws_size, hipStream_t stream) {
    static int grid = 0;
    if (grid == 0) {
        if (n_in != 24 || in_sizes[0] != NTOK * DM || out_size != NTOK * DM || ws_size < WS_END) { fprintf(stderr, "kernel_launch: shape mismatch n_in %d in0 %d out %d ws %zu (need %zu)\n", n_in, n_in > 0 ? in_sizes[0] : -1, out_size, ws_size, (size_t)WS_END); grid = -1; return; }
        int dev = 0, cus = 0, per_cu = 0;
        if (hipGetDevice(&dev) != hipSuccess || hipDeviceGetAttribute(&cus, hipDeviceAttributeMultiprocessorCount, dev) != hipSuccess) { grid = -1; return; }
        if (hipFuncSetAttribute((const void*)mega_fwd, hipFuncAttributeMaxDynamicSharedMemorySize, LDS_BYTES) != hipSuccess) { fprintf(stderr, "kernel_launch: hipFuncSetAttribute failed\n"); grid = -1; return; }
        if (hipOccupancyMaxActiveBlocksPerMultiprocessor(&per_cu, (const void*)mega_fwd, NTHR, LDS_BYTES) != hipSuccess || per_cu < 1) { fprintf(stderr, "kernel_launch: occupancy query says %d\n", per_cu); (void)hipGetLastError(); if (per_cu < 1) { grid = -1; return; } }
        grid = cus;
    }
    if (grid < 0) return;
    if (hipMemsetAsync((char*)d_ws + WS_CTL, 0, CTL_ZERO_BYTES, stream) != hipSuccess) return;
    Args a{};
    for (int i = 0; i < 24; ++i) a.in[i] = (const float*)d_in[i];
    a.out = (float*)d_out; a.ws = (unsigned char*)d_ws;
    hipLaunchKernelGGL(mega_fwd, dim3(grid), dim3(NTHR), LDS_BYTES, stream, a);
    const hipError_t le = hipPeekAtLastError();
    if (le != hipSuccess) fprintf(stderr, "kernel_launch: launch failed: %s\n", hipGetErrorName(le));
}
```

```cpp
#include <hip/hip_runtime.h>
#include <cstdio>
#include <cstdint>

#define LAS __attribute__((address_space(3)))
typedef unsigned short bf16_t;
typedef short bf16x8 __attribute__((ext_vector_type(8)));
typedef short s16x4 __attribute__((ext_vector_type(4)));
typedef float f32x2 __attribute__((ext_vector_type(2)));
typedef float f32x4 __attribute__((ext_vector_type(4)));
typedef float f32x16 __attribute__((ext_vector_type(16)));
typedef unsigned u32x2 __attribute__((ext_vector_type(2)));
typedef unsigned u32x4 __attribute__((ext_vector_type(4)));

#ifndef DUP_GEMM
#define DUP_GEMM 0
#endif
#ifndef DUP_NSA
#define DUP_NSA 0
#endif
#ifndef DUP_DIL
#define DUP_DIL 0
#endif
#ifndef PH_FFN
#define PH_FFN 1
#endif
#ifndef PH_INP
#define PH_INP 1
#endif
#ifndef PH_CMP
#define PH_CMP 1
#endif
#ifndef PH_DIL
#define PH_DIL 1
#endif
#ifndef PH_NSA
#define PH_NSA 1
#endif
#ifndef PH_OUT
#define PH_OUT 1
#endif
constexpr int BATCH = 4, SEQ = 8192, DM = 2048, DFF = 5632, NTOK = BATCH * SEQ, DEPTH = 4, HD = 128;
constexpr int IN_COLS = 5656, PC = 5888;
constexpr int C_QA = 0, C_KA = 1024, C_VA = 2048, C_QN = 3072, C_KC = 4096, C_VC = 4352, C_KS = 4608, C_VS = 4864, C_KW = 5120, C_VW = 5376, C_GL = 5632;
constexpr float EPS = 1e-6f, QSCALE = 0.08838834764831845f, LOG2E = 1.4426950408889634f;
constexpr int TBLS = 1704, TBL0 = 64;
constexpr int DTS = 320, DT0 = 96;
constexpr int NWAVES = 8, NTHR = 512;

constexpr size_t MiB = 1u << 20;
constexpr size_t WS_CTL = 0, CTL_ZERO_BYTES = 1 * MiB;
constexpr size_t WS_TBL = 1 * MiB;
constexpr size_t WS_WUP = 2 * MiB;
constexpr size_t WS_WDN = 46 * MiB;
constexpr size_t WS_WIN = 68 * MiB;
constexpr size_t WS_WOUT = 91 * MiB;
constexpr size_t WS_WC1 = 99 * MiB;
constexpr size_t WS_HB = 107 * MiB;
constexpr size_t WS_HP = 235 * MiB;
constexpr size_t WS_OA = 603 * MiB;
constexpr size_t WS_LSE = 667 * MiB;
constexpr size_t WS_ON = 668 * MiB;
constexpr size_t WS_ACMP = 860 * MiB;
constexpr size_t WS_CP = 924 * MiB;
constexpr size_t WS_KC = 988 * MiB;
constexpr size_t WS_VC = 989 * MiB;
constexpr size_t WS_END = 990 * MiB;
constexpr int CW_BAR = 4096;

__device__ __forceinline__ unsigned f2bf(float f) { unsigned u = __builtin_bit_cast(unsigned, f); return (u + 0x7fffu + ((u >> 16) & 1u)) >> 16; }
__device__ __forceinline__ unsigned pk2(float lo, float hi) { return f2bf(lo) | (f2bf(hi) << 16); }
__device__ __forceinline__ float bf2f(bf16_t b) { return __builtin_bit_cast(float, ((unsigned)b) << 16); }
__device__ __forceinline__ float bflo(unsigned w) { return __builtin_bit_cast(float, w << 16); }
__device__ __forceinline__ float bfhi(unsigned w) { return __builtin_bit_cast(float, w & 0xffff0000u); }
__device__ __forceinline__ unsigned cvtpk(float lo, float hi) { unsigned r; asm volatile("v_cvt_pk_bf16_f32 %0, %1, %2" : "=v"(r) : "v"(lo), "v"(hi)); return r; }
__device__ __forceinline__ float shx(float v, int m, int lane) { return __builtin_bit_cast(float, __builtin_amdgcn_ds_bpermute((lane ^ m) << 2, __builtin_bit_cast(int, v))); }
__device__ __forceinline__ float wave_sum(float v, int lane) {
#pragma unroll
    for (int o = 1; o < 64; o <<= 1) v += shx(v, o, lane);
    return v;
}
__device__ __forceinline__ LAS unsigned char* opq_lds(LAS unsigned char* p) { unsigned a = (unsigned)(uintptr_t)p; asm volatile("" : "+s"(a)); return (LAS unsigned char*)(uintptr_t)a; }
__device__ __forceinline__ int opq_tid(int wv) { int l; asm volatile("v_mbcnt_lo_u32_b32 %0, -1, 0\n\tv_mbcnt_hi_u32_b32 %0, -1, %0" : "=v"(l)); return wv * 64 + l; }
#define LDS_WAIT() asm volatile("s_waitcnt lgkmcnt(0)" ::: "memory")
#define VM_WAIT() asm volatile("s_waitcnt vmcnt(0)" ::: "memory")
#define SBAR() __builtin_amdgcn_sched_barrier(0)

#define XB_TMO      128
#define XB_XCNT(j)  (256  + 64 * (j))
#define XB_XSUB(j)  (1280 + 64 * (j))
#define XB_XGEN(j)  (2304 + 64 * (j))
#define XB_TOP      3328
#define XB_TOPGEN   3392
#define XCD_BAR_WORDS 3456
#define XB_SPIN_CAP (1u << 18)
__device__ __forceinline__ unsigned xb_ld(unsigned* p)              { return __hip_atomic_load(p, __ATOMIC_RELAXED, __HIP_MEMORY_SCOPE_AGENT); }
__device__ __forceinline__ unsigned xb_add(unsigned* p, unsigned v) { return __hip_atomic_fetch_add(p, v, __ATOMIC_RELAXED, __HIP_MEMORY_SCOPE_AGENT); }
__device__ __forceinline__ unsigned xb_xcc_id() { return (unsigned)__builtin_amdgcn_s_getreg((3 << 11) | 20) & 0xFu; }
#define XB_SPIN(cond, bar) do { unsigned _sp = 0; while (cond) { __builtin_amdgcn_s_sleep(1); \
    if ((++_sp & 255u) == 0u) { if (xb_ld(&(bar)[XB_TMO])) break; if (_sp > XB_SPIN_CAP) { atomicAdd(&(bar)[XB_TMO], 1u); break; } } } } while (0)
struct XcdBarrier { unsigned* bar; unsigned x; volatile LAS unsigned* st; };
__device__ __forceinline__ XcdBarrier xcd_barrier_post(unsigned* bar, volatile LAS unsigned* st) {
    XcdBarrier b; b.bar = bar; b.x = xb_xcc_id(); b.st = st;
    if (threadIdx.x == 0) (void)xb_add(&bar[XB_XCNT(b.x)], 1u);
    return b;
}
__device__ __forceinline__ void xcd_barrier_complete(unsigned* bar, unsigned x, unsigned& nloc, unsigned& nx) {
    const unsigned G = gridDim.x * gridDim.y * gridDim.z;
    unsigned sum, cnt, mine, sp = 0u;
    for (;;) {
        sum = 0u; cnt = 0u; mine = 0u;
#pragma unroll
        for (unsigned j = 0; j < 16; ++j) { const unsigned c = xb_ld(&bar[XB_XCNT(j)]); sum += c; cnt += (c > 0u) ? 1u : 0u; mine = (j == x) ? c : mine; }
        if (sum == G) break;
        __builtin_amdgcn_s_sleep(1);
        if ((++sp & 255u) == 0u) { if (xb_ld(&bar[XB_TMO])) break; if (sp > XB_SPIN_CAP) { atomicAdd(&bar[XB_TMO], 1u); break; } }
    }
    nloc = mine > 0u ? mine : 1u; nx = cnt > 0u ? cnt : 1u;
}
__device__ __forceinline__ void xcd_barrier(const XcdBarrier& b, const int wv) {
    asm volatile("s_waitcnt vmcnt(0)" ::: "memory");
    __syncthreads();
    if (opq_tid(wv) == 0) {
        unsigned* bar = b.bar; asm volatile("" : "+s"(bar));
        __builtin_amdgcn_s_waitcnt(0);
        unsigned nloc = b.st[0], nx = b.st[1];
        if (nloc == 0u) { xcd_barrier_complete(bar, b.x, nloc, nx); b.st[0] = nloc; b.st[1] = nx; }
        const unsigned old = xb_add(&bar[XB_XSUB(b.x)], 1u);
        const unsigned gen = old / nloc;
        if (old + 1u == (gen + 1u) * nloc) {
            __builtin_amdgcn_fence(__ATOMIC_RELEASE, "agent");
            asm volatile("s_waitcnt vmcnt(0)" ::: "memory");
            const unsigned og = xb_add(&bar[XB_TOP], 1u);
            const unsigned tg = og / nx;
            if (og + 1u == (tg + 1u) * nx) xb_add(&bar[XB_TOPGEN], 1u);
            else XB_SPIN(xb_ld(&bar[XB_TOPGEN]) == tg, bar);
            __builtin_amdgcn_fence(__ATOMIC_ACQUIRE, "agent");
            xb_add(&bar[XB_XGEN(b.x)], 1u);
            asm volatile("s_waitcnt vmcnt(0)" ::: "memory");
        } else {
            XB_SPIN(xb_ld(&bar[XB_XGEN(b.x)]) == gen, bar);
            __builtin_amdgcn_fence(__ATOMIC_ACQUIRE, "agent");
            asm volatile("s_waitcnt vmcnt(0)" ::: "memory");
        }
    }
    __syncthreads();
}

namespace pg8 {
constexpr int BM = 256, BK = 64, HALF = 128, HTB = HALF * BK * 2, STAGE_BYTES = 8 * HTB, NXCD = 8, WGM = 8;
__host__ __device__ __forceinline__ int lds_byte(int r, int c) { const int st = (r >> 4) * 2 + (c >> 5), rr = r & 15, cc = c & 31, ob = rr * 64 + cc * 2; return st * 1024 + (ob ^ (((ob >> 9) & 1) << 5)); }
__host__ __device__ __forceinline__ void stage_rc(int b, int& R, int& C) { const int st = b / 1024, sb = b % 1024, swz = sb ^ (((sb >> 9) & 1) << 5); R = (st >> 1) * 16 + swz / 64; C = (st & 1) * 32 + (swz % 64) / 2; }
__host__ __device__ __forceinline__ int perm32(int rho) { const int n = rho >> 4, i = rho & 15; return 8 * (i >> 2) + 4 * n + (i & 3); }
struct Unit { int pm, pn, z; };
struct Gemm { int lda, ldb, K; };
struct SchedStd {
    const char* A; const char* Bt; size_t atile, btile; int nM, nN, nwg, G, c;
    __device__ __forceinline__ void init(const void* A_, const void* Bt_, int M, int N, int lda, int ldb, int G_, int c_) {
        A = (const char*)A_; Bt = (const char*)Bt_; atile = (size_t)BM * lda * 2; btile = (size_t)BM * ldb * 2; nM = M / BM; nN = N / BM; nwg = nM * nN; G = G_; c = c_; }
    __device__ __forceinline__ bool next(int i, Unit& u) const {
        const long L = (long)i * G + c; if (L >= nwg) return false;
        int wgid = (int)L; { const int q = nwg / NXCD, r = nwg % NXCD, xcd = wgid % NXCD, off = wgid / NXCD; wgid = (xcd < r ? xcd * (q + 1) : r * (q + 1) + (xcd - r) * q) + off; }
        const int nig = WGM * nN, gid = wgid / nig, fm = gid * WGM, gsz = (nM - fm) < WGM ? (nM - fm) : WGM;
        u.pm = fm + ((wgid % nig) % gsz); u.pn = (wgid % nig) / gsz; u.z = 0; return true;
    }
    __device__ __forceinline__ const char* a_ptr(const Unit& u) const { return A + (size_t)u.pm * atile; }
    __device__ __forceinline__ const char* b_ptr(const Unit& u) const { return Bt + (size_t)u.pn * btile; }
};
struct SchedCmp {
    const char* A; const char* Bt; int G, c;
    __device__ __forceinline__ bool next(int i, Unit& u) const { const int L = i * G + c; if (L >= 256) return false; u.z = L >> 5; u.pm = (L & 31) >> 1; u.pn = L & 1; return true; }
    __device__ __forceinline__ const char* a_ptr(const Unit& u) const { const int kv = u.z >> 2, ks = u.z & 3; return A + ((size_t)(kv * 4096 + u.pm * 256) * 4096 + (size_t)ks * 1024) * 2; }
    __device__ __forceinline__ const char* b_ptr(const Unit& u) const { const int kv = u.z >> 2, ks = u.z & 3; return Bt + ((size_t)(kv * 512 + u.pn * 256) * 4096 + (size_t)ks * 1024) * 2; }
};
struct EpiBf16 {
    static constexpr bool PERM = true;
    bf16_t* O; int ldc;
    __device__ __forceinline__ void operator()(const f32x4 (&acc)[2][2][4][2], const Unit& u, int wr, int wc, int fr, int fq) const {
        const int row0 = u.pm * BM + wr * 64 + fr, col0 = u.pn * BM + wc * 32 + 8 * fq;
#pragma unroll
        for (int ai = 0; ai < 2; ++ai)
#pragma unroll
            for (int m = 0; m < 4; ++m) { bf16_t* rowp = O + (size_t)(row0 + ai * HALF + m * 16) * ldc + col0;
#pragma unroll
                for (int bj = 0; bj < 2; ++bj) { const f32x4 v0 = acc[ai][bj][m][0], v1 = acc[ai][bj][m][1];
                    u32x4 w; w.x = cvtpk(v0[0], v0[1]); w.y = cvtpk(v0[2], v0[3]); w.z = cvtpk(v1[0], v1[1]); w.w = cvtpk(v1[2], v1[3]);
                    *(u32x4*)(rowp + bj * HALF) = w; } }
    }
};
struct EpiSwiGLU {
    static constexpr bool PERM = true;
    bf16_t* O; int ldc;
    __device__ __forceinline__ void operator()(const f32x4 (&acc)[2][2][4][2], const Unit& u, int wr, int wc, int fr, int fq) const {
        const int row0 = u.pm * BM + wr * 64 + fr, col0 = u.pn * HALF + wc * 32 + 8 * fq;
#pragma unroll
        for (int ai = 0; ai < 2; ++ai)
#pragma unroll
            for (int m = 0; m < 4; ++m) { bf16_t* rowp = O + (size_t)(row0 + ai * HALF + m * 16) * ldc + col0;
                float v[8];
#pragma unroll
                for (int n = 0; n < 2; ++n)
#pragma unroll
                    for (int j = 0; j < 4; ++j) { const float g = acc[ai][0][m][n][j], up = acc[ai][1][m][n][j];
                        const float s = g * __builtin_amdgcn_rcpf(1.0f + __builtin_amdgcn_exp2f(-g * LOG2E)); v[n * 4 + j] = s * up; }
                u32x4 w; w.x = cvtpk(v[0], v[1]); w.y = cvtpk(v[2], v[3]); w.z = cvtpk(v[4], v[5]); w.w = cvtpk(v[6], v[7]);
                *(u32x4*)rowp = w; }
    }
};
struct EpiResid {
    static constexpr bool PERM = false;
    const float* base; float* out; int ldc; float alpha;
    __device__ __forceinline__ void operator()(const f32x4 (&acc)[2][2][4][2], const Unit& u, int wr, int wc, int fr, int fq) const {
        const int row0 = u.pm * BM + wr * 64 + fr, col0 = u.pn * BM + wc * 32 + 4 * fq;
#pragma unroll
        for (int ai = 0; ai < 2; ++ai)
#pragma unroll
            for (int m = 0; m < 4; ++m) { const size_t off = (size_t)(row0 + ai * HALF + m * 16) * ldc + col0;
#pragma unroll
                for (int bj = 0; bj < 2; ++bj)
#pragma unroll
                    for (int n = 0; n < 2; ++n) { const f32x4 bs = *(const f32x4*)(base + off + bj * HALF + n * 16);
                        *(f32x4*)(out + off + bj * HALF + n * 16) = bs + acc[ai][bj][m][n] * alpha; } }
    }
};
struct EpiF32Z {
    static constexpr bool PERM = false;
    float* C; int ldc; size_t zstride;
    __device__ __forceinline__ void operator()(const f32x4 (&acc)[2][2][4][2], const Unit& u, int wr, int wc, int fr, int fq) const {
        float* Cz = C + (size_t)u.z * zstride;
        const int row0 = u.pm * BM + wr * 64 + fr, col0 = u.pn * BM + wc * 32 + 4 * fq;
#pragma unroll
        for (int ai = 0; ai < 2; ++ai)
#pragma unroll
            for (int m = 0; m < 4; ++m) { float* rowp = Cz + (size_t)(row0 + ai * HALF + m * 16) * ldc + col0;
#pragma unroll
                for (int bj = 0; bj < 2; ++bj)
#pragma unroll
                    for (int n = 0; n < 2; ++n) *(f32x4*)(rowp + bj * HALF + n * 16) = acc[ai][bj][m][n]; }
    }
};

template <class Epi, class Sched>
__device__ __forceinline__ void gemm_phase(LAS unsigned char* lds, const Gemm g, const Sched& S, const Epi& E, const int wv) {
    const int tid = opq_tid(wv), wid = __builtin_amdgcn_readfirstlane(tid >> 6), lane = tid & 63, wr = wid >> 2, wc = wid & 3, fr = lane & 15, fq = lane >> 4;
    const int K = g.K, nt = K / BK;
    unsigned voffA[2], voffB[2];
#pragma unroll
    for (int i = 0; i < 2; ++i) { int R, C; stage_rc(tid * 16 + i * 8192, R, C); const int Rb = Epi::PERM ? ((R & ~31) + perm32(R & 31)) : R;
        voffA[i] = (unsigned)(R * g.lda + C) * 2u; voffB[i] = (unsigned)(Rb * g.ldb + C) * 2u; }
    const size_t kstep = (size_t)(BK * 2);
    const size_t hstepA = (size_t)HALF * g.lda * 2, hstepB = (size_t)HALF * g.ldb * 2;
    const unsigned ldsw = (unsigned)wid * 1024u;
    const int aoff = lds_byte(wr * 64 + fr, fq * 8), boff = lds_byte(wc * 32 + fr, fq * 8);
#define PG8_SA(b, h) (((b) * 2 + (h)) * HTB)
#define PG8_SB(b, h) ((4 + (b) * 2 + (h)) * HTB)
#define PG8_STAGE(bufoff, gbase, voff) do { _Pragma("unroll") for (int _i = 0; _i < 2; ++_i) \
        __builtin_amdgcn_global_load_lds((const unsigned*)((const char*)(gbase) + (voff)[_i]), (LAS unsigned*)(lds + (bufoff) + ldsw + _i * 8192), 16, 0, 0); } while (0)
#define PG8_LDA(dst, b, h) do { _Pragma("unroll") for (int m = 0; m < 4; ++m) _Pragma("unroll") for (int k = 0; k < 2; ++k) dst[m][k] = *(const LAS bf16x8*)(lds + PG8_SA(b, h) + aoff + m * 2048 + k * 1024); } while (0)
#define PG8_LDB(dst, b, h) do { _Pragma("unroll") for (int n = 0; n < 2; ++n) _Pragma("unroll") for (int k = 0; k < 2; ++k) dst[n][k] = *(const LAS bf16x8*)(lds + PG8_SB(b, h) + boff + n * 2048 + k * 1024); } while (0)
#define PG8_MMA(ai, bj, At, Bt) do { __builtin_amdgcn_s_setprio(1); _Pragma("unroll") for (int m = 0; m < 4; ++m) _Pragma("unroll") for (int n = 0; n < 2; ++n) _Pragma("unroll") for (int k = 0; k < 2; ++k) \
        acc[ai][bj][m][n] = __builtin_amdgcn_mfma_f32_16x16x32_bf16(Bt[n][k], At[m][k], acc[ai][bj][m][n], 0, 0, 0); __builtin_amdgcn_s_setprio(0); } while (0)
#define PG8_WAIT_V(n) asm volatile("s_waitcnt vmcnt(" #n ")" ::: "memory")
#define PG8_WAIT_L(n) asm volatile("s_waitcnt lgkmcnt(" #n ")" ::: "memory")
#define PG8_BAR __builtin_amdgcn_s_barrier()
#define PG8_SCHED __builtin_amdgcn_sched_barrier(0)
    Unit cur, nxt; int ui = 0;
    if (!S.next(0, cur)) return;
    f32x4 acc[2][2][4][2];
#pragma unroll
    for (int a = 0; a < 2; ++a)
#pragma unroll
        for (int b = 0; b < 2; ++b)
#pragma unroll
            for (int m = 0; m < 4; ++m)
#pragma unroll
                for (int n = 0; n < 2; ++n) acc[a][b][m][n] = (f32x4){0.f, 0.f, 0.f, 0.f};
    bf16x8 At[4][2], B0[2][2], B1[2][2];
    const char* cA = S.a_ptr(cur); const char* cB = S.b_ptr(cur);
    PG8_STAGE(PG8_SB(0, 0), cB, voffB); PG8_STAGE(PG8_SA(0, 0), cA, voffA); PG8_STAGE(PG8_SB(0, 1), cB + hstepB, voffB); PG8_STAGE(PG8_SA(0, 1), cA + hstepA, voffA);
    if (wr == 1) PG8_BAR;
    PG8_WAIT_V(4); PG8_BAR;
    PG8_STAGE(PG8_SB(1, 0), cB + kstep, voffB); PG8_STAGE(PG8_SA(1, 0), cA + kstep, voffA); PG8_STAGE(PG8_SB(1, 1), cB + hstepB + kstep, voffB);
    PG8_WAIT_V(6); PG8_BAR;
    for (;;) {
        const bool has_next = S.next(ui + 1, nxt);
        const char* nA = has_next ? S.a_ptr(nxt) : cA; const char* nB = has_next ? S.b_ptr(nxt) : cB;
        for (int t = 0; t < nt; t += 2) {
            const bool last = (t == nt - 2);
            const char* a1 = cA + (size_t)(t + 1) * kstep;
            const char* a2 = last ? nA : cA + (size_t)(t + 2) * kstep; const char* b2 = last ? nB : cB + (size_t)(t + 2) * kstep;
            const char* a3 = a2 + kstep; const char* b3 = b2 + kstep;
            PG8_LDB(B0, 0, 0); PG8_SCHED; PG8_LDA(At, 0, 0); PG8_STAGE(PG8_SA(1, 1), a1 + hstepA, voffA);
            PG8_WAIT_L(8); PG8_BAR; PG8_WAIT_L(0); PG8_MMA(0, 0, At, B0); PG8_BAR; PG8_SCHED;
            PG8_LDB(B1, 0, 1); PG8_STAGE(PG8_SB(0, 0), b2, voffB);
            PG8_BAR; PG8_WAIT_L(0); PG8_MMA(0, 1, At, B1); PG8_BAR;
            PG8_LDA(At, 0, 1); PG8_STAGE(PG8_SA(0, 0), a2, voffA);
            PG8_BAR; PG8_WAIT_L(0); PG8_MMA(1, 0, At, B0); PG8_BAR; PG8_SCHED;
            PG8_STAGE(PG8_SB(0, 1), b2 + hstepB, voffB);
            PG8_WAIT_V(6); PG8_BAR; PG8_MMA(1, 1, At, B1); PG8_BAR;
            PG8_LDB(B0, 1, 0); PG8_SCHED; PG8_LDA(At, 1, 0); PG8_STAGE(PG8_SA(0, 1), a2 + hstepA, voffA);
            PG8_WAIT_L(8); PG8_BAR; PG8_WAIT_L(0); PG8_MMA(0, 0, At, B0); PG8_BAR; PG8_SCHED;
            PG8_LDB(B1, 1, 1); PG8_STAGE(PG8_SB(1, 0), b3, voffB);
            PG8_BAR; PG8_WAIT_L(0); PG8_MMA(0, 1, At, B1); PG8_BAR;
            PG8_LDA(At, 1, 1); PG8_STAGE(PG8_SA(1, 0), a3, voffA);
            PG8_BAR; PG8_WAIT_L(0); PG8_MMA(1, 0, At, B0); PG8_BAR; PG8_SCHED;
            PG8_STAGE(PG8_SB(1, 1), b3 + hstepB, voffB);
            PG8_WAIT_V(6); PG8_BAR; PG8_MMA(1, 1, At, B1); PG8_BAR;
        }
        E(acc, cur, wr, wc, fr, fq);
        if (!has_next) break;
#pragma unroll
        for (int a = 0; a < 2; ++a)
#pragma unroll
            for (int b = 0; b < 2; ++b)
#pragma unroll
                for (int m = 0; m < 4; ++m)
#pragma unroll
                    for (int n = 0; n < 2; ++n) acc[a][b][m][n] = (f32x4){0.f, 0.f, 0.f, 0.f};
        cur = nxt; cA = nA; cB = nB; ++ui;
    }
    PG8_WAIT_V(0);
    if (wr == 0) PG8_BAR;
    PG8_BAR;
#undef PG8_SA
#undef PG8_SB
#undef PG8_STAGE
#undef PG8_LDA
#undef PG8_LDB
#undef PG8_MMA
#undef PG8_WAIT_V
#undef PG8_WAIT_L
#undef PG8_BAR
#undef PG8_SCHED
}
}

struct Args { const float* in[24]; float* out; unsigned char* ws; };
enum { I_X = 0, I_F1N, I_F1W1, I_F1W3, I_F1W2, I_MIXN, I_WIN, I_GB, I_QNA, I_KNA, I_QNN, I_KNN, I_POS, I_CKW1, I_CKW2, I_CVW1, I_CVW2, I_ON, I_WOUT, I_F2N, I_F2W1, I_F2W3, I_F2W2, I_RB };

__device__ __forceinline__ void transpose_item(const float* W, int K, int N, bf16_t* WT, int mode, int off, LAS float* scr, int item, int lane) {
    const int nblk = (N + 31) / 32, kb = item / nblk, nb = item % nblk, k0 = 64 * kb, n0 = 32 * nb;
    const int nn = n0 + (lane & 31);
#pragma unroll
    for (int i = 0; i < 32; ++i) { const int kk = 2 * i + (lane >> 5); scr[kk * 33 + (lane & 31)] = (nn < N) ? W[(size_t)(k0 + kk) * N + nn] : 0.f; }
    LDS_WAIT(); asm volatile("" ::: "memory");
    const int c = lane & 7;
#pragma unroll
    for (int j = 0; j < 4; ++j) { const int n = (lane >> 3) + 8 * j; const LAS float* s = scr + (8 * c) * 33 + n;
        u32x4 o; o.x = pk2(s[0 * 33], s[1 * 33]); o.y = pk2(s[2 * 33], s[3 * 33]); o.z = pk2(s[4 * 33], s[5 * 33]); o.w = pk2(s[6 * 33], s[7 * 33]);
        const int ng = n0 + n; const int dr = mode ? ((ng >> 7) * 256 + (ng & 127) + off) : (ng + off);
        if (ng < N) *(u32x4*)(WT + (size_t)dr * K + k0 + 8 * c) = o; }
    LDS_WAIT(); asm volatile("" ::: "memory");
}
__device__ __forceinline__ int rel_bucket_dev(int n) {
    if (n < 16) return n;
    const float v = logf((float)n / 16.0f) / 4.852030263919617f * 16.0f;
    int b = 16 + (int)v; return b < 31 ? b : 31;
}
__device__ __forceinline__ void norm_row(const float* xrow, const f32x4 (&gn)[8], bf16_t* orow, int lane) {
    const f32x4* xr = (const f32x4*)xrow + lane;
    f32x4 v[8]; float s = 0.f;
#pragma unroll
    for (int j = 0; j < 8; ++j) { v[j] = xr[64 * j]; s += (v[j].x * v[j].x + v[j].y * v[j].y) + (v[j].z * v[j].z + v[j].w * v[j].w); }
    const float rstd = 1.0f / sqrtf(wave_sum(s, lane) * (1.f / DM) + EPS);
    u32x2* o8 = (u32x2*)orow + lane;
#pragma unroll
    for (int j = 0; j < 8; ++j) { const f32x4 y = v[j] * rstd * gn[j]; u32x2 w; w.x = cvtpk(y.x, y.y); w.y = cvtpk(y.z, y.w); o8[64 * j] = w; }
}

namespace att {
constexpr int SHM_V = 16384, SHM_K = 16384;
constexpr int L_V = 0, L_K = 32768, L_WS = 65536, L_TBL = 67584, L_IMP = L_TBL + 4 * TBLS * 4  , L_SELM = L_IMP + 32768  , L_END = L_SELM + 1024;
static_assert(L_END <= 131072, "attention LDS map");
constexpr float THR = 8.f;
#define KSWZ(row, colB) ((row) * 256 + ((colB) ^ (((row) & 7) << 4)))
__device__ __forceinline__ int v_st(int k, int c) { const int kk = (k & ~0xC) | ((k & 4) << 1) | ((k & 8) >> 1); return ((kk >> 3) * 4 + (c >> 5)) * 512 + ((kk & 7) * 32 + (c & 31)) * 2; }
__device__ __forceinline__ int v_rd_base(int lane) { return ((lane & 3) << 3) | (((lane >> 2) & 3) << 6) | (((lane >> 4) & 1) << 5) | (((lane >> 5) & 1) << 8); }
__device__ __forceinline__ int crow(int r, int hi) { return (r & 3) + 8 * (r >> 2) + 4 * hi; }

__device__ __forceinline__ void partialSM(f32x16& p0, f32x16& p1, float& m_reg, float& mn, float& alpha) {
    float pmax = p0[0];
#pragma unroll
    for (int r = 1; r < 16; ++r) pmax = fmaxf(pmax, p0[r]);
#pragma unroll
    for (int r = 0; r < 16; ++r) pmax = fmaxf(pmax, p1[r]);
    { auto rr = __builtin_amdgcn_permlane32_swap(__float_as_uint(pmax), __float_as_uint(pmax), false, false);
      pmax = fmaxf(__uint_as_float(rr[0]), __uint_as_float(rr[1])); }
    if (__builtin_expect(__all((pmax - m_reg) <= THR), 1)) { mn = m_reg; alpha = 1.f; }
    else { mn = fmaxf(m_reg, pmax); alpha = __builtin_amdgcn_exp2f((m_reg - mn) * LOG2E); m_reg = mn; }
    const float mnL = -mn * LOG2E;
#pragma unroll
    for (int r = 0; r < 16; ++r) p0[r] = fmaf(p0[r], LOG2E, mnL);
#pragma unroll
    for (int r = 0; r < 16; ++r) p1[r] = fmaf(p1[r], LOG2E, mnL);
#pragma unroll
    for (int r = 0; r < 16; ++r) p0[r] = __builtin_amdgcn_exp2f(p0[r]);
}
__device__ __forceinline__ void partialSM_row(f32x16& p0, f32x16& p1, float& m_reg, float& mn, float& alpha, bool ok, float bias) {
    float pmax = p0[0];
#pragma unroll
    for (int r = 1; r < 16; ++r) pmax = fmaxf(pmax, p0[r]);
#pragma unroll
    for (int r = 0; r < 16; ++r) pmax = fmaxf(pmax, p1[r]);
    { auto rr = __builtin_amdgcn_permlane32_swap(__float_as_uint(pmax), __float_as_uint(pmax), false, false);
      pmax = fmaxf(__uint_as_float(rr[0]), __uint_as_float(rr[1])); }
    pmax = ok ? pmax + bias : -__builtin_inff();
    if (__builtin_expect(__all((pmax - m_reg) <= THR), 1)) { mn = m_reg; alpha = 1.f; }
    else { mn = fmaxf(m_reg, pmax); alpha = __builtin_amdgcn_exp2f((m_reg - mn) * LOG2E); m_reg = mn; }
    const float mnL = ok ? (bias - mn) * LOG2E : -__builtin_inff();
#pragma unroll
    for (int r = 0; r < 16; ++r) p0[r] = fmaf(p0[r], LOG2E, mnL);
#pragma unroll
    for (int r = 0; r < 16; ++r) p1[r] = fmaf(p1[r], LOG2E, mnL);
#pragma unroll
    for (int r = 0; r < 16; ++r) p0[r] = __builtin_amdgcn_exp2f(p0[r]);
}
#define PK4(P, B_, OUT) do { unsigned a0 = cvtpk(P[B_+0], P[B_+1]), a1 = cvtpk(P[B_+2], P[B_+3]);                          \
        unsigned b0 = cvtpk(P[B_+4], P[B_+5]), b1 = cvtpk(P[B_+6], P[B_+7]);                                             \
        auto r0 = __builtin_amdgcn_permlane32_swap(a0, b0, false, false); auto r1 = __builtin_amdgcn_permlane32_swap(a1, b1, false, false); \
        u32x4 w = {r0[0], r1[0], r0[1], r1[1]}; OUT = *reinterpret_cast<bf16x8*>(&w); } while (0)
__device__ __forceinline__ void finishSM(f32x16& p0, f32x16& p1, float alpha, float& l_reg, bf16x8& pa0, bf16x8& pa1, bf16x8& pa2, bf16x8& pa3) {
#pragma unroll
    for (int r = 0; r < 16; ++r) p1[r] = __builtin_amdgcn_exp2f(p1[r]);
    float ps = 0;
#pragma unroll
    for (int r = 0; r < 16; ++r) ps += p0[r];
#pragma unroll
    for (int r = 0; r < 16; ++r) ps += p1[r];
    { auto rr = __builtin_amdgcn_permlane32_swap(__float_as_uint(ps), __float_as_uint(ps), false, false);
      ps = __uint_as_float(rr[0]) + __uint_as_float(rr[1]); }
    l_reg = l_reg * alpha + ps;
    PK4(p0, 0, pa0); PK4(p0, 8, pa1); PK4(p1, 0, pa2); PK4(p1, 8, pa3);
}
__device__ __forceinline__ void qkt(f32x16& p0, f32x16& p1, const LAS char* Kb, int r32, int hi, const bf16x8 (&qr)[8]) {
    p0 = f32x16{}; p1 = f32x16{};
    const LAS char* kb4[4];
#pragma unroll
    for (int dd = 0; dd < 4; ++dd) kb4[dd] = Kb + KSWZ(r32, (dd * 16 + hi * 8) * 2);
#pragma unroll
    for (int d0 = 0; d0 < 8; ++d0) { const LAS char* a = kb4[d0 & 3] + (d0 >> 2) * 128;
        const bf16x8 b0 = *reinterpret_cast<const LAS bf16x8*>(a);
        const bf16x8 b1 = *reinterpret_cast<const LAS bf16x8*>(a + 32 * 256);
        p0 = __builtin_amdgcn_mfma_f32_32x32x16_bf16(b0, qr[d0], p0, 0, 0, 0);
        p1 = __builtin_amdgcn_mfma_f32_32x32x16_bf16(b1, qr[d0], p1, 0, 0, 0); }
}
__device__ __forceinline__ void pv_tile(f32x16 (&o)[4], int vb, bf16x8 pa0, bf16x8 pa1, bf16x8 pa2, bf16x8 pa3) {
#define TRRD(dst, off) asm volatile("ds_read_b64_tr_b16 %0, %1 offset:%2" : "=&v"(dst) : "v"(vb), "i"(off) : "memory")
#define PV_D0(d0) do { s16x4 l0, l1, l2, l3, h0, h1, h2, h3; constexpr int b_ = (d0) * 512; \
        TRRD(l0, b_); TRRD(h0, b_ + 2048); TRRD(l1, b_ + 4096); TRRD(h1, b_ + 6144); TRRD(l2, b_ + 8192); TRRD(h2, b_ + 10240); TRRD(l3, b_ + 12288); TRRD(h3, b_ + 14336); \
        asm volatile("s_waitcnt lgkmcnt(0)" ::: "memory"); SBAR(); \
        o[d0] = __builtin_amdgcn_mfma_f32_32x32x16_bf16(pa0, (bf16x8){l0[0], l0[1], l0[2], l0[3], h0[0], h0[1], h0[2], h0[3]}, o[d0], 0, 0, 0);   \
        o[d0] = __builtin_amdgcn_mfma_f32_32x32x16_bf16(pa1, (bf16x8){l1[0], l1[1], l1[2], l1[3], h1[0], h1[1], h1[2], h1[3]}, o[d0], 0, 0, 0);   \
        o[d0] = __builtin_amdgcn_mfma_f32_32x32x16_bf16(pa2, (bf16x8){l2[0], l2[1], l2[2], l2[3], h2[0], h2[1], h2[2], h2[3]}, o[d0], 0, 0, 0);   \
        o[d0] = __builtin_amdgcn_mfma_f32_32x32x16_bf16(pa3, (bf16x8){l3[0], l3[1], l3[2], l3[3], h3[0], h3[1], h3[2], h3[3]}, o[d0], 0, 0, 0); } while (0)
    PV_D0(0); PV_D0(1); PV_D0(2); PV_D0(3);
#undef PV_D0
#undef TRRD
}

template <class Cfg>
__device__ __forceinline__ void attn_tiles(const Cfg& c, LAS char* lds, const bf16x8 (&qr)[8], f32x16 (&o)[4], float& m_reg, float& l_reg, const int t_lo, const int t_hi, const int wv) {
    const int tid = opq_tid(wv), lane = tid & 63, wid = __builtin_amdgcn_readfirstlane(tid >> 6), r32 = lane & 31, hi = lane >> 5;
    LAS char* V_lds = lds + L_V; LAS char* K_lds = lds + L_K;
    LAS float* al_l = (LAS float*)(lds + L_WS) + wid * 64 + 32;
    const int sr = tid >> 4, sc = (tid & 15) * 8;
    const int vst0 = v_st(sr, sc), vst1 = v_st(32 + sr, sc), kws = KSWZ(sr, sc * 2);
    const int vb0 = (int)(unsigned)(uintptr_t)V_lds + v_rd_base(lane);
    bf16x8 sk0, sk1, sv0, sv1;
#define AT_LOAD(t) do { sk0 = *(const bf16x8*)(c.krow((t), sr) + sc); sk1 = *(const bf16x8*)(c.krow((t), sr + 32) + sc); \
        if constexpr (Cfg::MODE == 0) { sv0 = *(const bf16x8*)(c.vrow((t), sr) + sc); sv1 = *(const bf16x8*)(c.vrow((t), sr + 32) + sc); } \
        asm volatile("" ::: "memory"); SBAR(); } while (0)
#define AT_WRITE(t, bf) do { *(LAS bf16x8*)(K_lds + (bf) * SHM_K + kws) = sk0; *(LAS bf16x8*)(K_lds + (bf) * SHM_K + kws + 32 * 256) = sk1; \
        if constexpr (Cfg::MODE == 1) { \
            _Pragma("unroll") for (int i_ = 0; i_ < 8; ++i_) { const int n_ = sc + i_, c0_ = 64 * (t) + sr, c1_ = c0_ + 32; \
                sv0[i_] = (c0_ >= 4 * n_ - 1 && c0_ <= 4 * n_ + 3) ? (short)0x3F80 : (short)0; sv1[i_] = (c1_ >= 4 * n_ - 1 && c1_ <= 4 * n_ + 3) ? (short)0x3F80 : (short)0; } } \
        *(LAS bf16x8*)(V_lds + (bf) * SHM_V + vst0) = sv0; *(LAS bf16x8*)(V_lds + (bf) * SHM_V + vst1) = sv1; } while (0)
    __syncthreads();
    if (t_lo < t_hi) { AT_LOAD(t_lo); AT_WRITE(t_lo, 0); }
    __syncthreads();
    for (int t = t_lo; t < t_hi; ++t) {
        const int buf = (t - t_lo) & 1; const bool more = (t + 1 < t_hi);
        if (more) AT_LOAD(t + 1);
        if (c.active(t)) {
            f32x16 p0, p1;
            qkt(p0, p1, K_lds + buf * SHM_K, r32, hi, qr);
            if constexpr (Cfg::MODE == 0) {
                float mn, alpha; bf16x8 pa0, pa1, pa2, pa3;
                bool rok; float rbias;
                if (c.rowconst(t, rok, rbias)) partialSM_row(p0, p1, m_reg, mn, alpha, rok, rbias);
                else { c.mask(p0, p1, t); partialSM(p0, p1, m_reg, mn, alpha); }
                if (__any(alpha < 1.f)) { if (hi == 0) al_l[r32] = alpha; LDS_WAIT();
#pragma unroll
                    for (int d_ = 0; d_ < 4; ++d_)
#pragma unroll
                        for (int r = 0; r < 16; ++r) o[d_][r] *= al_l[crow(r, hi)]; }
                finishSM(p0, p1, alpha, l_reg, pa0, pa1, pa2, pa3); SBAR();
                pv_tile(o, vb0 + buf * SHM_V, pa0, pa1, pa2, pa3);
            } else {
                c.mask(p0, p1, t);
                const float mL = -c.mfix * LOG2E; const float il = c.invl;
#pragma unroll
                for (int r = 0; r < 16; ++r) { p0[r] = __builtin_amdgcn_exp2f(fmaf(p0[r], LOG2E, mL)) * il; p1[r] = __builtin_amdgcn_exp2f(fmaf(p1[r], LOG2E, mL)) * il; }
                bf16x8 pa0, pa1, pa2, pa3;
                PK4(p0, 0, pa0); PK4(p0, 8, pa1); PK4(p1, 0, pa2); PK4(p1, 8, pa3); SBAR();
                pv_tile(o, vb0 + buf * SHM_V, pa0, pa1, pa2, pa3);
#pragma unroll
                for (int r = 0; r < 16; r += 2) { const unsigned a = cvtpk(p0[r], p0[r + 1]), b = cvtpk(p1[r], p1[r + 1]);
                    p0[r] -= bflo(a); p0[r + 1] -= bfhi(a); p1[r] -= bflo(b); p1[r + 1] -= bfhi(b); }
                PK4(p0, 0, pa0); PK4(p0, 8, pa1); PK4(p1, 0, pa2); PK4(p1, 8, pa3); SBAR();
                pv_tile(o, vb0 + buf * SHM_V, pa0, pa1, pa2, pa3);
            }
        }
        if (more) AT_WRITE(t + 1, buf ^ 1);
        __syncthreads();
    }
#undef AT_LOAD
#undef AT_WRITE
}

struct DilCfg {
    static constexpr int MODE = 0;
    const bf16_t* Kb; const bf16_t* Vb;
    const LAS float* tbl; int dshift, res, u, dqm, s0;
    __device__ __forceinline__ const bf16_t* krow(int t, int kk) const { int s = 256 * u - 128 + 64 * t + kk; s = s < 0 ? 0 : s; return Kb + (size_t)((s << dshift) + res) * PC; }
    __device__ __forceinline__ const bf16_t* vrow(int t, int kk) const { int s = 256 * u - 128 + 64 * t + kk; s = s < 0 ? 0 : s; return Vb + (size_t)((s << dshift) + res) * PC; }
    __device__ __forceinline__ bool active(int t) const { const int kb = 256 * u - 128 + 64 * t; return kb <= s0 + 31 && kb + 63 >= s0 - 128; }
    __device__ __forceinline__ bool rowconst(int, bool&, float&) const { return false; }
    __device__ __forceinline__ void mask(f32x16& p0, f32x16& p1, int t) const {
        const int dq = dqm - (256 * u - 128 + 64 * t); const float NEG = -__builtin_inff();
        const LAS float* tb = tbl + (DT0 + dq - 63);
#pragma unroll
        for (int r = 0; r < 16; ++r) { const int cc = (r & 3) + 8 * (r >> 2); const unsigned d0 = (unsigned)(dq - cc), d1 = (unsigned)(dq - cc - 32);
            const float b0 = tb[63 - cc], b1 = tb[31 - cc];
            p0[r] = (d0 <= 128u) ? p0[r] + b0 : NEG; p1[r] = (d1 <= 128u) ? p1[r] + b1 : NEG; }
    }
};
struct CmpCfg {
    static constexpr int MODE = 0;
    const bf16_t* Kb; const bf16_t* Vb; int cmax, hi4, cfull;
    __device__ __forceinline__ bool rowconst(int t, bool& ok, float& bias) const { ok = true; bias = 0.f; return 64 * t + 63 <= cfull; }
    __device__ __forceinline__ const bf16_t* krow(int t, int kk) const { return Kb + (size_t)(64 * t + kk) * HD; }
    __device__ __forceinline__ const bf16_t* vrow(int t, int kk) const { return Vb + (size_t)(64 * t + kk) * HD; }
    __device__ __forceinline__ bool active(int) const { return true; }
    __device__ __forceinline__ void mask(f32x16& p0, f32x16& p1, int t) const {
        const int cb = 64 * t + hi4; const float NEG = -__builtin_inff();
#pragma unroll
        for (int r = 0; r < 16; ++r) { const int cc = cb + (r & 3) + 8 * (r >> 2); if (cc > cmax) p0[r] = NEG; if (cc + 32 > cmax) p1[r] = NEG; }
    }
};
struct CmpImpCfg {
    static constexpr int MODE = 1;
    const bf16_t* Kb; int cmax, hi4; float mfix, invl;
    __device__ __forceinline__ const bf16_t* krow(int t, int kk) const { return Kb + (size_t)(64 * t + kk) * HD; }
    __device__ __forceinline__ const bf16_t* vrow(int, int) const { return Kb; }
    __device__ __forceinline__ bool active(int) const { return true; }
    __device__ __forceinline__ void mask(f32x16& p0, f32x16& p1, int t) const {
        const int cb = 64 * t + hi4; const float NEG = -__builtin_inff();
#pragma unroll
        for (int r = 0; r < 16; ++r) { const int cc = cb + (r & 3) + 8 * (r >> 2); if (cc > cmax) p0[r] = NEG; if (cc + 32 > cmax) p1[r] = NEG; }
    }
};
struct SlcCfg {
    static constexpr int MODE = 0;
    const bf16_t* Kb; const bf16_t* Vb;
    const LAS float* tblh;
    unsigned s0, s1, s2, s3; int tqm, cur; float b31;
    __device__ __forceinline__ const bf16_t* krow(int t, int kk) const { return Kb + (size_t)(64 * t + kk) * PC; }
    __device__ __forceinline__ const bf16_t* vrow(int t, int kk) const { return Vb + (size_t)(64 * t + kk) * PC; }
    __device__ __forceinline__ bool selbit(int t) const { const unsigned q = (unsigned)t >> 5; const unsigned w = (q == 0u ? s0 + 0u : 0u) | (q == 1u ? s1 + 0u : 0u) | (q == 2u ? s2 + 0u : 0u) | (q == 3u ? s3 + 0u : 0u); return (w >> (t & 31)) & 1u; }
    __device__ __forceinline__ bool active(int t) const { return __any(selbit(t)); }
    __device__ __forceinline__ bool rowconst(int t, bool& ok, float& bias) const { ok = selbit(t); bias = b31; return 64 * (cur - t) - 63 >= 1513; }
    __device__ __forceinline__ void mask(f32x16& p0, f32x16& p1, int t) const {
        const bool sel = selbit(t); const int dq = tqm - 64 * t; const float NEG = -__builtin_inff();
        const LAS float* tb = tblh + (TBL0 + dq - 63);
#pragma unroll
        for (int r = 0; r < 16; ++r) { const int cc = (r & 3) + 8 * (r >> 2); const int d0 = dq - cc, d1 = dq - cc - 32;
            const float b0 = tb[63 - cc], b1 = tb[31 - cc];
            p0[r] = (sel && d0 >= 0) ? p0[r] + b0 : NEG; p1[r] = (sel && d1 >= 0) ? p1[r] + b1 : NEG; }
    }
};
struct WinCfg {
    static constexpr int MODE = 0;
    const bf16_t* Kb; const bf16_t* Vb; const LAS float* tblh; int tqm;
    __device__ __forceinline__ bool rowconst(int, bool&, float&) const { return false; }
    __device__ __forceinline__ const bf16_t* krow(int t, int kk) const { return Kb + (size_t)(64 * t + kk) * PC; }
    __device__ __forceinline__ const bf16_t* vrow(int t, int kk) const { return Vb + (size_t)(64 * t + kk) * PC; }
    __device__ __forceinline__ bool active(int) const { return true; }
    __device__ __forceinline__ void mask(f32x16& p0, f32x16& p1, int t) const {
        const int dq = tqm - 64 * t; const float NEG = -__builtin_inff();
        const LAS float* tb = tblh + (TBL0 + dq - 63);
#pragma unroll
        for (int r = 0; r < 16; ++r) { const int cc = (r & 3) + 8 * (r >> 2); const unsigned d0 = (unsigned)(dq - cc), d1 = (unsigned)(dq - cc - 32);
            const float b0 = tb[63 - cc], b1 = tb[31 - cc];
            p0[r] = (d0 < 512u) ? p0[r] + b0 : NEG; p1[r] = (d1 < 512u) ? p1[r] + b1 : NEG; }
    }
};
}

__device__ __forceinline__ void dil_unit(LAS char* lds, const bf16_t* P, bf16_t* OA, float* LSE, const float* dilT, int pat, int dshift, int unit, const int wv) {
    using namespace att;
    const int tid = opq_tid(wv), lane = tid & 63, wid = __builtin_amdgcn_readfirstlane(tid >> 6), r32 = lane & 31, hi = lane >> 5;
    const int bh = unit >> 5, ru = unit & 31, b = bh >> 3, h = bh & 7;
    const int ncs = 5 - dshift, res = ru >> ncs, u = ru & ((1 << ncs) - 1);
    LAS float* tbl = (LAS float*)(lds + L_TBL);
    __syncthreads();
    if (tid < DTS) tbl[tid] = dilT[(pat * 8 + h) * DTS + tid];
    const int s0 = 256 * u + 32 * wid, s_row = s0 + r32;
    const size_t tokrow = (size_t)b * SEQ + (size_t)((s_row << dshift) + res);
    bf16x8 qr[8];
    { const bf16_t* qp = P + tokrow * PC + C_QA + h * HD + hi * 8;
#pragma unroll
      for (int d0 = 0; d0 < 8; ++d0) qr[d0] = *(const bf16x8*)(qp + d0 * 16); }
    f32x16 o[4]; float m_reg, l_reg;
    if (pat == 0) { m_reg = -1e30f; l_reg = 0.f;
#pragma unroll
        for (int d0 = 0; d0 < 4; ++d0) o[d0] = f32x16{}; }
    else { m_reg = LSE[tokrow * 8 + h]; l_reg = 1.f;
#pragma unroll
        for (int r = 0; r < 16; ++r) { const size_t tr = (size_t)b * SEQ + (size_t)(((s0 + crow(r, hi)) << dshift) + res); const bf16_t* op = OA + tr * 1024 + h * HD + r32;
#pragma unroll
            for (int d0 = 0; d0 < 4; ++d0) o[d0][r] = bf2f(op[d0 * 32]); } }
    DilCfg c; c.Kb = P + (size_t)b * SEQ * PC + C_KA + h * HD; c.Vb = P + (size_t)b * SEQ * PC + C_VA + h * HD; c.tbl = tbl; c.dshift = dshift; c.res = res; c.u = u; c.dqm = s_row - 4 * hi; c.s0 = s0;
    attn_tiles(c, lds, qr, o, m_reg, l_reg, (u == 0) ? 2 : 0, 6, wv);
    LAS float* li_l = (LAS float*)(lds + L_WS) + wid * 64;
    if (hi == 0) { li_l[r32] = l_reg; LSE[tokrow * 8 + h] = m_reg + logf(l_reg); }
    LDS_WAIT();
#pragma unroll
    for (int r = 0; r < 16; ++r) { const int orow = crow(r, hi); const float rl = 1.0f / li_l[orow];
        const size_t tr = (size_t)b * SEQ + (size_t)(((s0 + orow) << dshift) + res); bf16_t* op = OA + tr * 1024 + h * HD;
#pragma unroll
        for (int d0 = 0; d0 < 4; ++d0) { const float v = o[d0][r] * rl; const float vn = shx(v, 1, lane);
            if ((r32 & 1) == 0) *(unsigned*)(op + d0 * 32 + r32) = cvtpk(v, vn); } }
}

__device__ __forceinline__ void nsa_finalize(LAS char* lds, const f32x16 (&o)[4], float l_reg, const bf16_t* P, bf16_t* ON, const float* gb, int b, int g, int tok0, int br, const int wv) {
    using namespace att;
    const int tid = opq_tid(wv), lane = tid & 63, wid = __builtin_amdgcn_readfirstlane(tid >> 6), r32 = lane & 31, hi = lane >> 5;
    LAS float* li_l = (LAS float*)(lds + L_WS) + wid * 64;
    if (hi == 0) li_l[r32] = l_reg;
    LDS_WAIT();
    bf16_t* ONb = ON + (size_t)br * NTOK * 1024;
#pragma unroll
    for (int r = 0; r < 16; ++r) { const int j = r & 3, k = r >> 2; const float lr = li_l[crow(r, hi)]; const float rl = lr > 0.f ? 1.0f / lr : 0.f;
        const size_t tok = (size_t)b * SEQ + tok0 + 2 * k + hi; const int hh = 4 * g + j;
        const float gl = bf2f(P[tok * PC + C_GL + hh * 3 + br]) + gb[hh * 3 + br];
        const float sc = rl * __builtin_amdgcn_rcpf(1.0f + __builtin_amdgcn_exp2f(-gl * LOG2E));
        bf16_t* op = ONb + tok * 1024 + hh * HD;
#pragma unroll
        for (int d0 = 0; d0 < 4; ++d0) { const float v = o[d0][r] * sc; const float vn = shx(v, 1, lane);
            if ((r32 & 1) == 0) *(unsigned*)(op + d0 * 32 + r32) = cvtpk(v, vn); } }
}
__device__ __forceinline__ void nsa_unit(LAS char* lds, const bf16_t* P, const bf16_t* KC, const bf16_t* VC, bf16_t* ON, const float* nsaT, const float* gb, int b, int g, int qi, bool load_tbl, const int wv) {
    using namespace att;
    const int tid = opq_tid(wv), lane = tid & 63, wid = __builtin_amdgcn_readfirstlane(tid >> 6), r32 = lane & 31, hi = lane >> 5;
    LAS float* tbl = (LAS float*)(lds + L_TBL); LAS float* IMP = (LAS float*)(lds + L_IMP); LAS unsigned* SELM = (LAS unsigned*)(lds + L_SELM);
    __syncthreads();
    if (load_tbl) for (int i = tid; i < 4 * TBLS; i += NTHR) tbl[i] = nsaT[(size_t)(4 * g) * TBLS + i];
    const int tok0 = 64 * qi + 8 * wid, tq = tok0 + (r32 >> 2), hd = r32 & 3;
    const bf16_t* Pb = P + (size_t)b * SEQ * PC;
    bf16x8 qr[8];
    { const bf16_t* qp = Pb + (size_t)tq * PC + C_QN + (4 * g + hd) * HD + hi * 8;
#pragma unroll
      for (int d0 = 0; d0 < 8; ++d0) qr[d0] = *(const bf16x8*)(qp + d0 * 16); }
    const bf16_t* KCb = KC + (size_t)(b * 2 + g) * 512 * HD; const bf16_t* VCb = VC + (size_t)(b * 2 + g) * 512 * HD;
    const int ntc = (qi >> 4) + 1, cmax = (tq - 31) >> 4;
    f32x16 o[4]; float m_reg, l_reg;
#pragma unroll
    for (int d0 = 0; d0 < 4; ++d0) o[d0] = f32x16{};
    m_reg = -1e30f; l_reg = 0.f;
    { CmpCfg c; c.Kb = KCb; c.Vb = VCb; c.cmax = cmax; c.hi4 = 4 * hi; c.cfull = (64 * qi - 31) >> 4; attn_tiles(c, lds, qr, o, m_reg, l_reg, 0, ntc, wv); }
    nsa_finalize(lds, o, l_reg, P, ON, gb, b, g, tok0, 0, wv);
    { CmpImpCfg c; c.Kb = KCb; c.cmax = cmax; c.hi4 = 4 * hi; c.mfix = m_reg; c.invl = l_reg > 0.f ? 1.0f / l_reg : 0.f;
#pragma unroll
      for (int d0 = 0; d0 < 4; ++d0) o[d0] = f32x16{};
      float md = 0.f, ld = 0.f; attn_tiles(c, lds, qr, o, md, ld, 0, ntc, wv); }
#pragma unroll
    for (int d0 = 0; d0 < 4; ++d0)
#pragma unroll
        for (int k = 0; k < 4; ++k) IMP[(8 * wid + 2 * k + hi) * 128 + 32 * d0 + r32] = (o[d0][4 * k] + o[d0][4 * k + 1]) + (o[d0][4 * k + 2] + o[d0][4 * k + 3]);
    __syncthreads();
    { const int cur = qi;
#pragma unroll 1
      for (int tl = 8 * wid; tl < 8 * wid + 8; ++tl) {
        const int n0 = lane, n1 = 64 + lane; bool sel0, sel1;
        if (cur <= 15) { sel0 = (n0 <= cur); sel1 = false; }
        else {
            const float v0 = IMP[tl * 128 + n0], v1 = IMP[tl * 128 + n1];
            const unsigned u0 = (n0 >= 1 && n0 <= cur - 2) ? __float_as_uint(v0) + 1u : 0u, u1 = (n1 <= cur - 2) ? __float_as_uint(v1) + 1u : 0u;
            unsigned T = 0u;
#pragma unroll 1
            for (int bit = 30; bit >= 0; --bit) { const unsigned cand = T | (1u << bit);
                const int cnt = __builtin_popcountll(__ballot(u0 >= cand)) + __builtin_popcountll(__ballot(u1 >= cand));
                if (cnt >= 13) T = cand; }
            const bool gt0 = u0 > T, gt1 = u1 > T;
            const int need = 13 - (__builtin_popcountll(__ballot(gt0)) + __builtin_popcountll(__ballot(gt1)));
            const bool eq0 = (u0 == T), eq1 = (u1 == T);
            const unsigned long long m0 = __ballot(eq0), m1 = __ballot(eq1);
            const int pre0 = (int)__builtin_amdgcn_mbcnt_hi((unsigned)(m0 >> 32), __builtin_amdgcn_mbcnt_lo((unsigned)m0, 0u));
            const int pre1 = __builtin_popcountll(m0) + (int)__builtin_amdgcn_mbcnt_hi((unsigned)(m1 >> 32), __builtin_amdgcn_mbcnt_lo((unsigned)m1, 0u));
            sel0 = (n0 == 0 || n0 == cur || n0 == cur - 1) || gt0 || (eq0 && pre0 < need);
            sel1 = (n1 == cur || n1 == cur - 1) || gt1 || (eq1 && pre1 < need);
        }
        const unsigned long long b0 = __ballot(sel0), b1 = __ballot(sel1);
        if (lane == 0) { SELM[tl * 4 + 0] = (unsigned)b0; SELM[tl * 4 + 1] = (unsigned)(b0 >> 32); SELM[tl * 4 + 2] = (unsigned)b1; SELM[tl * 4 + 3] = (unsigned)(b1 >> 32); } } }
    __syncthreads();
    { SlcCfg c; c.Kb = Pb + C_KS + g * HD; c.Vb = Pb + C_VS + g * HD; c.tblh = tbl + hd * TBLS; c.tqm = tq - 4 * hi; c.cur = qi; c.b31 = tbl[hd * TBLS + TBL0 + 1600];
      const int tl = 8 * wid + (r32 >> 2); c.s0 = SELM[tl * 4 + 0]; c.s1 = SELM[tl * 4 + 1]; c.s2 = SELM[tl * 4 + 2]; c.s3 = SELM[tl * 4 + 3];
#pragma unroll
      for (int d0 = 0; d0 < 4; ++d0) o[d0] = f32x16{};
      m_reg = -1e30f; l_reg = 0.f;
      attn_tiles(c, lds, qr, o, m_reg, l_reg, 0, qi + 1, wv); }
    nsa_finalize(lds, o, l_reg, P, ON, gb, b, g, tok0, 1, wv);
    { WinCfg c; c.Kb = Pb + C_KW + g * HD; c.Vb = Pb + C_VW + g * HD; c.tblh = tbl + hd * TBLS; c.tqm = tq - 4 * hi;
#pragma unroll
      for (int d0 = 0; d0 < 4; ++d0) o[d0] = f32x16{};
      m_reg = -1e30f; l_reg = 0.f;
      attn_tiles(c, lds, qr, o, m_reg, l_reg, qi >= 8 ? qi - 8 : 0, qi + 1, wv); }
    nsa_finalize(lds, o, l_reg, P, ON, gb, b, g, tok0, 2, wv);
}

constexpr int LDS_BYTES = 147456;
constexpr int LDS_MISC = 131072;
constexpr int LDS_ARGS = LDS_MISC + 64;
__device__ __forceinline__ unsigned long long arg_u64(LAS unsigned char* lds, int i) {
    const LAS unsigned* p = (const LAS unsigned*)(lds + LDS_ARGS) + 2 * i;
    const unsigned lo = __builtin_amdgcn_readfirstlane(p[0]), hi = __builtin_amdgcn_readfirstlane(p[1]);
    return ((unsigned long long)hi << 32) | lo;
}
#define GAS __attribute__((address_space(1)))
__device__ __forceinline__ const float* arg_in(LAS unsigned char* lds, int i) { return (const float*)(GAS const float*)arg_u64(lds, i); }
__device__ __forceinline__ float* arg_out(LAS unsigned char* lds) { return (float*)(GAS float*)arg_u64(lds, 24); }
__device__ __forceinline__ unsigned char* arg_ws(LAS unsigned char* lds) { return (unsigned char*)(GAS unsigned char*)arg_u64(lds, 25); }
__device__ __forceinline__ int opq_bx() { int b = blockIdx.x; asm volatile("" : "+s"(b)); return b; }
__device__ __forceinline__ int opq_g() { int b = gridDim.x; asm volatile("" : "+s"(b)); return b; }

__device__ __forceinline__ void ph_prep(LAS unsigned char* lds, int step, const int wv) {
    lds = opq_lds(lds);
    const int tid = opq_tid(wv), lane = tid & 63, wave = __builtin_amdgcn_readfirstlane(tid >> 6), G = opq_g(), bx = opq_bx();
    const int gw = bx * NWAVES + wave, NGW = G * NWAVES, l = step >> 1, half = step & 1;
    unsigned char* ws = arg_ws(lds);
    bf16_t* WUP = (bf16_t*)(ws + WS_WUP); bf16_t* WDN = (bf16_t*)(ws + WS_WDN); bf16_t* WIN = (bf16_t*)(ws + WS_WIN); bf16_t* WOUT = (bf16_t*)(ws + WS_WOUT); bf16_t* WC1 = (bf16_t*)(ws + WS_WC1);
    bf16_t* HB = (bf16_t*)(ws + WS_HB);
    LAS float* scr = (LAS float*)(lds + wave * 16384);
    const float* w1 = arg_in(lds, half ? I_F2W1 : I_F1W1) + (size_t)l * DM * DFF; const float* w3 = arg_in(lds, half ? I_F2W3 : I_F1W3) + (size_t)l * DM * DFF; const float* w2 = arg_in(lds, half ? I_F2W2 : I_F1W2) + (size_t)l * DFF * DM;
    constexpr int I_UP = 32 * 176, I_DN = 88 * 64, I_IN = 32 * 177, I_OUT = 32 * 64, I_C1 = 64 * 16, I_Z = 928;
    const int nitems = 2 * I_UP + I_DN + (half ? 0 : (I_IN + I_OUT + 2 * I_C1 + I_Z));
    for (int it = gw; it < nitems; it += NGW) {
        int r = it;
        if (r < I_UP) { transpose_item(w1, DM, DFF, WUP, 1, 0, scr, r, lane); continue; } r -= I_UP;
        if (r < I_UP) { transpose_item(w3, DM, DFF, WUP, 1, 128, scr, r, lane); continue; } r -= I_UP;
        if (r < I_DN) { transpose_item(w2, DFF, DM, WDN, 0, 0, scr, r, lane); continue; } r -= I_DN;
        if (r < I_IN) { transpose_item(arg_in(lds, I_WIN) + (size_t)l * DM * IN_COLS, DM, IN_COLS, WIN, 0, 0, scr, r, lane); continue; } r -= I_IN;
        if (r < I_OUT) { transpose_item(arg_in(lds, I_WOUT) + (size_t)l * DM * DM, DM, DM, WOUT, 0, 0, scr, r, lane); continue; } r -= I_OUT;
        if (r < I_C1) { transpose_item(arg_in(lds, I_CKW1) + (size_t)l * 4096 * 512, 4096, 512, WC1, 0, 0, scr, r, lane); continue; } r -= I_C1;
        if (r < I_C1) { transpose_item(arg_in(lds, I_CVW1) + (size_t)l * 4096 * 512, 4096, 512, WC1, 0, 512, scr, r, lane); continue; } r -= I_C1;
        { u32x4* z = (u32x4*)(WIN + (size_t)IN_COLS * DM) + (size_t)r * 64 + lane; unsigned zr = 0u; asm volatile("" : "+v"(zr)); *z = (u32x4){zr, zr, zr, zr}; }
    }
    const float* xs = (step == 0) ? arg_in(lds, I_X) : (const float*)arg_out(lds); const float* gn = arg_in(lds, half ? I_F2N : I_F1N) + (size_t)l * DM;
    f32x4 gv[8];
#pragma unroll
    for (int j = 0; j < 8; ++j) gv[j] = ((const f32x4*)gn)[64 * j + lane];
    for (int m = gw; m < NTOK; m += NGW) norm_row(xs + (size_t)m * DM, gv, HB + (size_t)m * DM, lane);
}
__device__ __forceinline__ void ph_mixnorm(LAS unsigned char* lds, int l, const int wv) {
    lds = opq_lds(lds);
    const int tid = opq_tid(wv), lane = tid & 63, wave = __builtin_amdgcn_readfirstlane(tid >> 6), G = opq_g(), bx = opq_bx();
    const int gw = bx * NWAVES + wave, NGW = G * NWAVES;
    bf16_t* HB = (bf16_t*)(arg_ws(lds) + WS_HB); const float* X = arg_out(lds);
    const float* gn = arg_in(lds, I_MIXN) + (size_t)l * DM; f32x4 gv[8];
#pragma unroll
    for (int j = 0; j < 8; ++j) gv[j] = ((const f32x4*)gn)[64 * j + lane];
    for (int m = gw; m < NTOK; m += NGW) norm_row(X + (size_t)m * DM, gv, HB + (size_t)m * DM, lane);
}
__device__ __forceinline__ void ph_headnorm(LAS unsigned char* lds, int l, const int wv) {
    lds = opq_lds(lds);
    const int tid = opq_tid(wv), lane = tid & 63, wave = __builtin_amdgcn_readfirstlane(tid >> 6), G = opq_g(), bx = opq_bx();
    const int gw = bx * NWAVES + wave, NGW = G * NWAVES;
    unsigned char* ws = arg_ws(lds); bf16_t* HP = (bf16_t*)(ws + WS_HP); bf16_t* ACMP = (bf16_t*)(ws + WS_ACMP);
    const float* qna = arg_in(lds, I_QNA) + l * HD; const float* kna = arg_in(lds, I_KNA) + l * HD; const float* qnn = arg_in(lds, I_QNN) + l * HD; const float* knn = arg_in(lds, I_KNN) + l * HD;
    const float* pos = arg_in(lds, I_POS) + (size_t)l * 32 * HD;
    const int e0 = (lane & 15) * 8;
    for (int m = gw; m < NTOK; m += NGW) {
        bf16_t* prow = HP + (size_t)m * PC;
#pragma unroll
        for (int ch = 0; ch < 7; ++ch) {
            int col; const float* gp; float sc = 1.f;
            if (ch < 2) { col = C_QA + ch * 512 + lane * 8; gp = qna; sc = QSCALE; }
            else if (ch < 4) { col = C_KA + (ch - 2) * 512 + lane * 8; gp = kna; }
            else if (ch < 6) { col = C_QN + (ch - 4) * 512 + lane * 8; gp = qnn; sc = QSCALE; }
            else { col = (lane < 32 ? C_KS + lane * 8 : C_KW + (lane - 32) * 8); gp = knn; }
            const u32x4 w = *(const u32x4*)(prow + col);
            float v[8] = {bflo(w.x), bfhi(w.x), bflo(w.y), bfhi(w.y), bflo(w.z), bfhi(w.z), bflo(w.w), bfhi(w.w)};
            float s = 0.f;
#pragma unroll
            for (int i = 0; i < 8; ++i) s += v[i] * v[i];
            s += shx(s, 1, lane); s += shx(s, 2, lane); s += shx(s, 4, lane); s += shx(s, 8, lane);
            const float rs = sc / sqrtf(s * (1.f / HD) + EPS);
            const f32x4 g0 = *(const f32x4*)(gp + e0), g1 = *(const f32x4*)(gp + e0 + 4);
            u32x4 o; o.x = cvtpk(v[0] * rs * g0.x, v[1] * rs * g0.y); o.y = cvtpk(v[2] * rs * g0.z, v[3] * rs * g0.w); o.z = cvtpk(v[4] * rs * g1.x, v[5] * rs * g1.y); o.w = cvtpk(v[6] * rs * g1.z, v[7] * rs * g1.w);
            *(u32x4*)(prow + col) = o;
        }
        { const int b = m / SEQ, t = m % SEQ, kv = lane >> 5, gg = (lane >> 4) & 1, c1 = t >> 4, j1 = t & 15;
          const u32x4 w = *(const u32x4*)(prow + C_KC + lane * 8);
          const float v[8] = {bflo(w.x), bfhi(w.x), bflo(w.y), bfhi(w.y), bflo(w.z), bfhi(w.z), bflo(w.w), bfhi(w.w)};
          bf16_t* abase = ACMP + ((size_t)kv * 4096 + (size_t)(b * 2 + gg) * 512) * 4096 + e0;
          if (c1 <= 510) { const f32x4 p0 = *(const f32x4*)(pos + j1 * HD + e0), p1 = *(const f32x4*)(pos + j1 * HD + e0 + 4);
              u32x4 o; o.x = cvtpk(v[0] + p0.x, v[1] + p0.y); o.y = cvtpk(v[2] + p0.z, v[3] + p0.w); o.z = cvtpk(v[4] + p1.x, v[5] + p1.y); o.w = cvtpk(v[6] + p1.z, v[7] + p1.w);
              *(u32x4*)(abase + (size_t)c1 * 4096 + j1 * HD) = o; }
          else { const u32x4 z = {0u, 0u, 0u, 0u}; *(u32x4*)(abase + (size_t)511 * 4096 + j1 * HD) = z; *(u32x4*)(abase + (size_t)511 * 4096 + (j1 + 16) * HD) = z; }
          if (c1 >= 1) { const int j2 = j1 + 16; const f32x4 p0 = *(const f32x4*)(pos + j2 * HD + e0), p1 = *(const f32x4*)(pos + j2 * HD + e0 + 4);
              u32x4 o; o.x = cvtpk(v[0] + p0.x, v[1] + p0.y); o.y = cvtpk(v[2] + p0.z, v[3] + p0.w); o.z = cvtpk(v[4] + p1.x, v[5] + p1.y); o.w = cvtpk(v[6] + p1.z, v[7] + p1.w);
              *(u32x4*)(abase + (size_t)(c1 - 1) * 4096 + j2 * HD) = o; } }
    }
}
__device__ __forceinline__ void ph_cmp2(LAS unsigned char* lds, int l, const int wv) {
    lds = opq_lds(lds);
    const int tid = opq_tid(wv), lane = tid & 63, wave = __builtin_amdgcn_readfirstlane(tid >> 6), G = opq_g(), bx = opq_bx();
    unsigned char* ws = arg_ws(lds); const float* CP = (const float*)(ws + WS_CP); bf16_t* KC = (bf16_t*)(ws + WS_KC); bf16_t* VC = (bf16_t*)(ws + WS_VC);
    LAS float* CH = (LAS float*)lds;
    LAS float* RED = (LAS float*)(lds + 32768);
    const float* knn = arg_in(lds, I_KNN) + l * HD;
    for (int it = bx; it < 512; it += G) {
        const int R0 = it * 16, kv = R0 >> 12, rl0 = R0 & 4095;
        __syncthreads();
        for (int idx = tid; idx < 16 * 512; idx += NTHR) { const int rr = idx >> 9, k = idx & 511; float v = 0.f;
#pragma unroll
            for (int ks = 0; ks < 4; ++ks) v += CP[((size_t)(kv * 4 + ks) * 4096 + rl0 + rr) * 512 + k];
            const float u3 = 0.7978845608028654f * (v + 0.044715f * v * v * v);
            const float th = 1.0f - 2.0f / (__expf(2.0f * u3) + 1.0f);
            CH[idx] = 0.5f * v * (1.0f + th); }
        __syncthreads();
        const int n = tid & 127, rq = tid >> 7;
        const float* w2 = arg_in(lds, kv ? I_CVW2 : I_CKW2) + (size_t)l * 512 * HD + n;
        float acc[4] = {0.f, 0.f, 0.f, 0.f};
#pragma unroll 16
        for (int k = 0; k < 512; ++k) { const float w = w2[(size_t)k * HD];
#pragma unroll
            for (int i = 0; i < 4; ++i) acc[i] += CH[(rq * 4 + i) * 512 + k] * w; }
        if (kv == 0) {
            float ss[4];
#pragma unroll
            for (int i = 0; i < 4; ++i) ss[i] = wave_sum(acc[i] * acc[i], lane);
            if (lane == 0) {
#pragma unroll
                for (int i = 0; i < 4; ++i) RED[wave * 4 + i] = ss[i]; }
            __syncthreads();
            const float gn = knn[n];
#pragma unroll
            for (int i = 0; i < 4; ++i) { const float tot = RED[(2 * rq) * 4 + i] + RED[(2 * rq + 1) * 4 + i]; acc[i] = acc[i] / sqrtf(tot * (1.f / HD) + EPS) * gn; }
        }
        bf16_t* dst = (bf16_t*)(ws + (kv ? WS_VC + 0 : WS_KC + 0)) + (size_t)(rl0 + rq * 4) * HD + n;
#pragma unroll
        for (int i = 0; i < 4; ++i) dst[(size_t)i * HD] = (bf16_t)f2bf(acc[i]);
    }
}
__device__ __forceinline__ void ph_outnorm(LAS unsigned char* lds, int l, const int wv) {
    lds = opq_lds(lds);
    const int tid = opq_tid(wv), lane = tid & 63, wave = __builtin_amdgcn_readfirstlane(tid >> 6), G = opq_g(), bx = opq_bx();
    const int gw = bx * NWAVES + wave, NGW = G * NWAVES;
    unsigned char* ws = arg_ws(lds); const bf16_t* OA = (const bf16_t*)(ws + WS_OA); const bf16_t* ON = (const bf16_t*)(ws + WS_ON); bf16_t* HB = (bf16_t*)(ws + WS_HB);
    const float* gn = arg_in(lds, I_ON) + (size_t)l * DM;
    for (int m = gw; m < NTOK; m += NGW) {
        const bf16_t* oa = OA + (size_t)m * 1024; bf16_t* y = HB + (size_t)m * DM;
        const u32x4 wa = *(const u32x4*)(oa + lane * 8), wb = *(const u32x4*)(oa + 512 + lane * 8);
        float va[16] = {bflo(wa.x), bfhi(wa.x), bflo(wa.y), bfhi(wa.y), bflo(wa.z), bfhi(wa.z), bflo(wa.w), bfhi(wa.w), bflo(wb.x), bfhi(wb.x), bflo(wb.y), bfhi(wb.y), bflo(wb.z), bfhi(wb.z), bflo(wb.w), bfhi(wb.w)};
        float sa = 0.f;
#pragma unroll
        for (int i = 0; i < 16; ++i) sa += va[i] * va[i];
        const float ra = 1.0f / sqrtf(wave_sum(sa, lane) * (1.f / 1024.f) + EPS);
        { const f32x4 g0 = *(const f32x4*)(gn + lane * 8), g1 = *(const f32x4*)(gn + lane * 8 + 4), g2 = *(const f32x4*)(gn + 512 + lane * 8), g3 = *(const f32x4*)(gn + 512 + lane * 8 + 4);
          u32x4 o; o.x = cvtpk(va[0] * ra * g0.x, va[1] * ra * g0.y); o.y = cvtpk(va[2] * ra * g0.z, va[3] * ra * g0.w); o.z = cvtpk(va[4] * ra * g1.x, va[5] * ra * g1.y); o.w = cvtpk(va[6] * ra * g1.z, va[7] * ra * g1.w);
          *(u32x4*)(y + lane * 8) = o;
          o.x = cvtpk(va[8] * ra * g2.x, va[9] * ra * g2.y); o.y = cvtpk(va[10] * ra * g2.z, va[11] * ra * g2.w); o.z = cvtpk(va[12] * ra * g3.x, va[13] * ra * g3.y); o.w = cvtpk(va[14] * ra * g3.z, va[15] * ra * g3.w);
          *(u32x4*)(y + 512 + lane * 8) = o; }
        float vs[16]; float sn = 0.f;
#pragma unroll
        for (int i = 0; i < 16; ++i) vs[i] = 0.f;
#pragma unroll
        for (int br = 0; br < 3; ++br) { const bf16_t* onb = ON + ((size_t)br * NTOK + m) * 1024;
            const u32x4 wc = *(const u32x4*)(onb + lane * 8), wd = *(const u32x4*)(onb + 512 + lane * 8);
            vs[0] += bflo(wc.x); vs[1] += bfhi(wc.x); vs[2] += bflo(wc.y); vs[3] += bfhi(wc.y); vs[4] += bflo(wc.z); vs[5] += bfhi(wc.z); vs[6] += bflo(wc.w); vs[7] += bfhi(wc.w);
            vs[8] += bflo(wd.x); vs[9] += bfhi(wd.x); vs[10] += bflo(wd.y); vs[11] += bfhi(wd.y); vs[12] += bflo(wd.z); vs[13] += bfhi(wd.z); vs[14] += bflo(wd.w); vs[15] += bfhi(wd.w); }
#pragma unroll
        for (int i = 0; i < 16; ++i) sn += vs[i] * vs[i];
        const float rn = 1.0f / sqrtf(wave_sum(sn, lane) * (1.f / 1024.f) + EPS);
        { const float* g2 = gn + 1024; const f32x4 g0 = *(const f32x4*)(g2 + lane * 8), g1 = *(const f32x4*)(g2 + lane * 8 + 4), g2a = *(const f32x4*)(g2 + 512 + lane * 8), g3 = *(const f32x4*)(g2 + 512 + lane * 8 + 4);
          u32x4 o; o.x = cvtpk(vs[0] * rn * g0.x, vs[1] * rn * g0.y); o.y = cvtpk(vs[2] * rn * g0.z, vs[3] * rn * g0.w); o.z = cvtpk(vs[4] * rn * g1.x, vs[5] * rn * g1.y); o.w = cvtpk(vs[6] * rn * g1.z, vs[7] * rn * g1.w);
          *(u32x4*)(y + 1024 + lane * 8) = o;
          o.x = cvtpk(vs[8] * rn * g2a.x, vs[9] * rn * g2a.y); o.y = cvtpk(vs[10] * rn * g2a.z, vs[11] * rn * g2a.w); o.z = cvtpk(vs[12] * rn * g3.x, vs[13] * rn * g3.y); o.w = cvtpk(vs[14] * rn * g3.z, vs[15] * rn * g3.w);
          *(u32x4*)(y + 1536 + lane * 8) = o; }
    }
}

#define GRID_BAR() xcd_barrier(bar, wv)
__global__ void __launch_bounds__(NTHR, 2) mega_fwd(Args a) {
    extern __shared__ __attribute__((aligned(16))) unsigned char lds_raw[];
    LAS unsigned char* lds = (LAS unsigned char*)lds_raw;
    const int wv = __builtin_amdgcn_readfirstlane((int)threadIdx.x >> 6);
    {
        const int tid = threadIdx.x;
        for (int u = tid; u < (LDS_BYTES - LDS_MISC) / 4; u += NTHR) ((LAS unsigned*)(lds + LDS_MISC))[u] = 0u;
        __syncthreads();
        if (tid == 0) { LAS unsigned long long* t = (LAS unsigned long long*)(lds + LDS_ARGS);
#pragma unroll
            for (int i = 0; i < 24; ++i) t[i] = (unsigned long long)(uintptr_t)a.in[i];
            t[24] = (unsigned long long)(uintptr_t)a.out; t[25] = (unsigned long long)(uintptr_t)a.ws; }
        __syncthreads();
    }
    XcdBarrier bar = xcd_barrier_post((unsigned*)(arg_ws(lds) + WS_CTL) + CW_BAR, (volatile LAS unsigned*)(lds + LDS_MISC + 32));

    { const int tid = opq_tid(wv), G = opq_g(), bx = opq_bx(); const float* rb = arg_in(lds, I_RB); unsigned char* ws = arg_ws(lds);
      float* dilT = (float*)(ws + WS_TBL); float* nsaT = (float*)(ws + WS_TBL + 65536);
      for (int i = bx * NTHR + tid; i < 3 * 8 * DTS + 8 * TBLS; i += G * NTHR) {
          if (i < 3 * 8 * DTS) { const int p = i / (8 * DTS), h = (i / DTS) % 8, df = i % DTS - DT0; const int d = (p == 0) ? 1 : (p == 1 ? 4 : 16);
              dilT[i] = (df >= 0 && df <= 128) ? rb[rel_bucket_dev(df * d) * 16 + h] : 0.f; }
          else { const int j = i - 3 * 8 * DTS, hh = j / TBLS, ds = j % TBLS - TBL0; nsaT[j] = (ds >= 0) ? rb[rel_bucket_dev(ds) * 16 + 8 + hh] : 0.f; } } }

#pragma unroll 1
    for (int step = 0; step < 2 * DEPTH; ++step) {
        const int l = step >> 1, half = step & 1;
        ph_prep(lds, step, wv);
        GRID_BAR();
#if PH_FFN
        { unsigned char* ws = arg_ws(lds); const int G = opq_g(), bx = opq_bx();
          pg8::Gemm g{DM, DM, DM}; pg8::SchedStd S; S.init(ws + WS_HB, ws + WS_WUP, NTOK, 2 * DFF, DM, DM, G, bx); pg8::EpiSwiGLU E{(bf16_t*)(ws + WS_HP), DFF};
#pragma unroll 1
          for (int dup = 0; dup <= DUP_GEMM; ++dup) { pg8::gemm_phase<pg8::EpiSwiGLU, pg8::SchedStd>(opq_lds(lds), g, S, E, wv); if (DUP_GEMM) GRID_BAR(); } }
        GRID_BAR();
        { unsigned char* ws = arg_ws(lds); const int G = opq_g(), bx = opq_bx(); float* X = arg_out(lds);
          pg8::Gemm g{DFF, DFF, DFF}; pg8::SchedStd S; S.init(ws + WS_HP, ws + WS_WDN, NTOK, DM, DFF, DFF, G, bx); pg8::EpiResid E{(step == 0) ? arg_in(lds, I_X) : (const float*)X, X, DM, 0.5f};
#pragma unroll 1
          for (int dup = 0; dup <= DUP_GEMM; ++dup) { if (dup) { E.base = X; E.alpha = 0.f; } pg8::gemm_phase<pg8::EpiResid, pg8::SchedStd>(opq_lds(lds), g, S, E, wv); if (DUP_GEMM) GRID_BAR(); } }
#endif
        GRID_BAR();
        if (half == 0) {
            ph_mixnorm(lds, l, wv);
            GRID_BAR();
#if PH_INP
            { unsigned char* ws = arg_ws(lds); const int G = opq_g(), bx = opq_bx();
              pg8::Gemm g{DM, DM, DM}; pg8::SchedStd S; S.init(ws + WS_HB, ws + WS_WIN, NTOK, PC, DM, DM, G, bx); pg8::EpiBf16 E{(bf16_t*)(ws + WS_HP), PC};
#pragma unroll 1
              for (int dup = 0; dup <= DUP_GEMM; ++dup) { pg8::gemm_phase<pg8::EpiBf16, pg8::SchedStd>(opq_lds(lds), g, S, E, wv); if (DUP_GEMM) GRID_BAR(); } }
#endif
            GRID_BAR();
            ph_headnorm(lds, l, wv);
            GRID_BAR();
#if PH_CMP
            { unsigned char* ws = arg_ws(lds); const int G = opq_g(), bx = opq_bx();
              pg8::Gemm g{4096, 4096, 1024}; pg8::SchedCmp S; S.A = (const char*)(ws + WS_ACMP); S.Bt = (const char*)(ws + WS_WC1); S.G = G; S.c = bx; pg8::EpiF32Z E{(float*)(ws + WS_CP), 512, (size_t)4096 * 512};
              pg8::gemm_phase<pg8::EpiF32Z, pg8::SchedCmp>(opq_lds(lds), g, S, E, wv); }
#endif
            GRID_BAR();
            ph_cmp2(lds, l, wv);
            GRID_BAR();
#pragma unroll 1
            for (int pat3 = 0; pat3 < 3 * (1 + DUP_DIL); ++pat3) { const int pat = pat3 % 3;
#if PH_DIL
                { unsigned char* ws = arg_ws(lds); const int G = opq_g(), bx = opq_bx();
                  for (int unit = bx; unit < 1024; unit += G) dil_unit((LAS char*)opq_lds(lds), (const bf16_t*)(ws + WS_HP), (bf16_t*)(ws + WS_OA), (float*)(ws + WS_LSE), (const float*)(ws + WS_TBL), pat, 2 * pat, unit, wv); }
#endif
                GRID_BAR();
            }
#if PH_NSA
            { unsigned char* ws = arg_ws(lds); const int G = opq_g(), bx = opq_bx();
              const float* gb = arg_in(lds, I_GB) + l * 24;
              int last_bg = -1;
#pragma unroll 1
              for (int i4 = 0; i4 < 4 * (1 + DUP_NSA); ++i4)
#pragma unroll 1
                  for (int w = bx; w < 256; w += G) { const int i = i4 & 3; const int bg = w >> 5, j = w & 31; const int qi = (i == 0) ? 127 - j : (i == 1 ? j : (i == 2 ? 64 + j : 63 - j));
                      nsa_unit((LAS char*)opq_lds(lds), (const bf16_t*)(ws + WS_HP), (const bf16_t*)(ws + WS_KC), (const bf16_t*)(ws + WS_VC), (bf16_t*)(ws + WS_ON), (const float*)(ws + WS_TBL + 65536), gb, bg >> 1, bg & 1, qi, bg != last_bg, wv); last_bg = bg; } }
#endif
            GRID_BAR();
            ph_outnorm(lds, l, wv);
            GRID_BAR();
#if PH_OUT
            { unsigned char* ws = arg_ws(lds); const int G = opq_g(), bx = opq_bx(); float* X = arg_out(lds);
              pg8::Gemm g{DM, DM, DM}; pg8::SchedStd S; S.init(ws + WS_HB, ws + WS_WOUT, NTOK, DM, DM, DM, G, bx); pg8::EpiResid E{X, X, DM, 1.0f};
#pragma unroll 1
              for (int dup = 0; dup <= DUP_GEMM; ++dup) { if (dup) E.alpha = 0.f; pg8::gemm_phase<pg8::EpiResid, pg8::SchedStd>(opq_lds(lds), g, S, E, wv); if (DUP_GEMM) GRID_BAR(); } }
#endif
            GRID_BAR();
        }
    }
}

extern "C" void kernel_launch(void* const* d_in, const int* in_sizes, int n_in, void* d_out, int out_size, void* d_ws, size_t ws_size, hipStream_t stream) {
    static int grid = 0;
    if (grid == 0) {
        if (n_in != 24 || in_sizes[0] != NTOK * DM || out_size != NTOK * DM || ws_size < WS_END) { fprintf(stderr, "kernel_launch: shape mismatch n_in %d in0 %d out %d ws %zu (need %zu)\n", n_in, n_in > 0 ? in_sizes[0] : -1, out_size, ws_size, (size_t)WS_END); grid = -1; return; }
        int dev = 0, cus = 0, per_cu = 0;
        if (hipGetDevice(&dev) != hipSuccess || hipDeviceGetAttribute(&cus, hipDeviceAttributeMultiprocessorCount, dev) != hipSuccess) { grid = -1; return; }
        if (hipFuncSetAttribute((const void*)mega_fwd, hipFuncAttributeMaxDynamicSharedMemorySize, LDS_BYTES) != hipSuccess) { fprintf(stderr, "kernel_launch: hipFuncSetAttribute failed\n"); grid = -1; return; }
        if (hipOccupancyMaxActiveBlocksPerMultiprocessor(&per_cu, (const void*)mega_fwd, NTHR, LDS_BYTES) != hipSuccess || per_cu < 1) { fprintf(stderr, "kernel_launch: occupancy query says %d\n", per_cu); (void)hipGetLastError(); if (per_cu < 1) { grid = -1; return; } }
        grid = cus;
    }
    if (grid < 0) return;
    if (hipMemsetAsync((char*)d_ws + WS_CTL, 0, CTL_ZERO_BYTES, stream) != hipSuccess) return;
    Args a{};
    for (int i = 0; i < 24; ++i) a.in[i] = (const float*)d_in[i];
    a.out = (float*)d_out; a.ws = (unsigned char*)d_ws;
    hipLaunchKernelGGL(mega_fwd, dim3(grid), dim3(NTHR), LDS_BYTES, stream, a);
    const hipError_t le = hipPeekAtLastError();
    if (le != hipSuccess) fprintf(stderr, "kernel_launch: launch failed: %s\n", hipGetErrorName(le));
}
```

```cpp
#include <hip/hip_runtime.h>
#include <cstdio>
#include <cstdint>

#define LAS __attribute__((address_space(3)))
typedef unsigned short bf16_t;
typedef short bf16x8 __attribute__((ext_vector_type(8)));
typedef short s16x4 __attribute__((ext_vector_type(4)));
typedef float f32x2 __attribute__((ext_vector_type(2)));
typedef float f32x4 __attribute__((ext_vector_type(4)));
typedef float f32x16 __attribute__((ext_vector_type(16)));
typedef unsigned u32x2 __attribute__((ext_vector_type(2)));
typedef unsigned u32x4 __attribute__((ext_vector_type(4)));

#ifndef DUP_UP
#define DUP_UP 0
#endif
#ifndef DUP_DN
#define DUP_DN 0
#endif
#ifndef DUP_IN
#define DUP_IN 0
#endif
#ifndef DUP_OUT
#define DUP_OUT 0
#endif
#ifndef DUP_NSA
#define DUP_NSA 0
#endif
#ifndef DUP_DIL
#define DUP_DIL 0
#endif
#ifndef PH_FFN
#define PH_FFN 1
#endif
#ifndef PH_INP
#define PH_INP 1
#endif
#ifndef PH_CMP
#define PH_CMP 1
#endif
#ifndef PH_DIL
#define PH_DIL 1
#endif
#ifndef PH_NSA
#define PH_NSA 1
#endif
#ifndef PH_OUT
#define PH_OUT 1
#endif
constexpr int BATCH = 4, SEQ = 8192, DM = 2048, DFF = 5632, NTOK = BATCH * SEQ, DEPTH = 4, HD = 128;
constexpr int IN_COLS = 5656, PC = 5888;
constexpr int C_QA = 0, C_KA = 1024, C_VA = 2048, C_QN = 3072, C_KC = 4096, C_VC = 4352, C_KS = 4608, C_VS = 4864, C_KW = 5120, C_VW = 5376, C_GL = 5632;
constexpr float EPS = 1e-6f, QSCALE = 0.08838834764831845f, LOG2E = 1.4426950408889634f;
constexpr int TBLS = 1704, TBL0 = 64;
constexpr int DTS = 320, DT0 = 96;
constexpr int NWAVES = 8, NTHR = 512;

constexpr size_t MiB = 1u << 20;
constexpr size_t WS_CTL = 0, CTL_ZERO_BYTES = 1 * MiB;
constexpr size_t WS_TBL = 1 * MiB;
constexpr size_t SZ_WUP = 44 * MiB, SZ_WDN = 22 * MiB, SZ_WIN = 23 * MiB, SZ_WOUT = 8 * MiB, SZ_WC1 = 8 * MiB;
constexpr size_t WS_WUP = 2 * MiB;
constexpr size_t WS_WDN = WS_WUP + 8 * SZ_WUP;
constexpr size_t WS_WIN = WS_WDN + 8 * SZ_WDN;
constexpr size_t WS_WOUT = WS_WIN + 4 * SZ_WIN;
constexpr size_t WS_WC1 = WS_WOUT + 4 * SZ_WOUT;
constexpr size_t WS_HB = WS_WC1 + 4 * SZ_WC1;
constexpr size_t WS_HP = WS_HB + 128 * MiB;
constexpr size_t WS_OA = WS_HP + 368 * MiB;
constexpr size_t WS_LSE = WS_OA + 64 * MiB;
constexpr size_t WS_ON = WS_LSE + 1 * MiB;
constexpr size_t WS_ACMP = WS_ON + 192 * MiB;
constexpr size_t WS_CP = WS_ACMP + 64 * MiB;
constexpr size_t WS_KC = WS_CP + 64 * MiB;
constexpr size_t WS_VC = WS_KC + 1 * MiB;
constexpr size_t WS_SSQ = WS_VC + 1 * MiB;
constexpr size_t WS_RSTD = WS_SSQ + 4 * MiB;
constexpr size_t WS_END = WS_RSTD + 1 * MiB;
constexpr int CW_BAR = 4096;

__device__ __forceinline__ unsigned f2bf(float f) { unsigned u = __builtin_bit_cast(unsigned, f); return (u + 0x7fffu + ((u >> 16) & 1u)) >> 16; }
__device__ __forceinline__ unsigned pk2(float lo, float hi) { return f2bf(lo) | (f2bf(hi) << 16); }
__device__ __forceinline__ float bf2f(bf16_t b) { return __builtin_bit_cast(float, ((unsigned)b) << 16); }
__device__ __forceinline__ float bflo(unsigned w) { return __builtin_bit_cast(float, w << 16); }
__device__ __forceinline__ float bfhi(unsigned w) { return __builtin_bit_cast(float, w & 0xffff0000u); }
__device__ __forceinline__ unsigned cvtpk(float lo, float hi) { unsigned r; asm volatile("v_cvt_pk_bf16_f32 %0, %1, %2" : "=v"(r) : "v"(lo), "v"(hi)); return r; }
__device__ __forceinline__ float shx(float v, int m, int lane) { return __builtin_bit_cast(float, __builtin_amdgcn_ds_bpermute((lane ^ m) << 2, __builtin_bit_cast(int, v))); }
__device__ __forceinline__ float wave_sum(float v, int lane) {
#pragma unroll
    for (int o = 1; o < 64; o <<= 1) v += shx(v, o, lane);
    return v;
}
__device__ __forceinline__ LAS unsigned char* opq_lds(LAS unsigned char* p) { unsigned a = (unsigned)(uintptr_t)p; asm volatile("" : "+s"(a)); return (LAS unsigned char*)(uintptr_t)a; }
__device__ __forceinline__ int opq_tid(int wv) { int l; asm volatile("v_mbcnt_lo_u32_b32 %0, -1, 0\n\tv_mbcnt_hi_u32_b32 %0, -1, %0" : "=v"(l)); return wv * 64 + l; }
#define LDS_WAIT() asm volatile("s_waitcnt lgkmcnt(0)" ::: "memory")
#define VM_WAIT() asm volatile("s_waitcnt vmcnt(0)" ::: "memory")
#define SBAR() __builtin_amdgcn_sched_barrier(0)

#define XB_TMO      128
#define XB_XCNT(j)  (256  + 64 * (j))
#define XB_XSUB(j)  (1280 + 64 * (j))
#define XB_XGEN(j)  (2304 + 64 * (j))
#define XB_TOP      3328
#define XB_TOPGEN   3392
#define XCD_BAR_WORDS 3456
#define XB_SPIN_CAP (1u << 18)
__device__ __forceinline__ unsigned xb_ld(unsigned* p)              { return __hip_atomic_load(p, __ATOMIC_RELAXED, __HIP_MEMORY_SCOPE_AGENT); }
__device__ __forceinline__ unsigned xb_add(unsigned* p, unsigned v) { return __hip_atomic_fetch_add(p, v, __ATOMIC_RELAXED, __HIP_MEMORY_SCOPE_AGENT); }
__device__ __forceinline__ unsigned xb_xcc_id() { return (unsigned)__builtin_amdgcn_s_getreg((3 << 11) | 20) & 0xFu; }
#define XB_SPIN(cond, bar) do { unsigned _sp = 0; while (cond) { __builtin_amdgcn_s_sleep(1); \
    if ((++_sp & 255u) == 0u) { if (xb_ld(&(bar)[XB_TMO])) break; if (_sp > XB_SPIN_CAP) { atomicAdd(&(bar)[XB_TMO], 1u); break; } } } } while (0)
struct XcdBarrier { unsigned* bar; unsigned x; volatile LAS unsigned* st; };
__device__ __forceinline__ XcdBarrier xcd_barrier_post(unsigned* bar, volatile LAS unsigned* st) {
    XcdBarrier b; b.bar = bar; b.x = xb_xcc_id(); b.st = st;
    if (threadIdx.x == 0) (void)xb_add(&bar[XB_XCNT(b.x)], 1u);
    return b;
}
__device__ __forceinline__ void xcd_barrier_complete(unsigned* bar, unsigned x, unsigned& nloc, unsigned& nx) {
    const unsigned G = gridDim.x * gridDim.y * gridDim.z;
    unsigned sum, cnt, mine, sp = 0u;
    for (;;) {
        sum = 0u; cnt = 0u; mine = 0u;
#pragma unroll
        for (unsigned j = 0; j < 16; ++j) { const unsigned c = xb_ld(&bar[XB_XCNT(j)]); sum += c; cnt += (c > 0u) ? 1u : 0u; mine = (j == x) ? c : mine; }
        if (sum == G) break;
        __builtin_amdgcn_s_sleep(1);
        if ((++sp & 255u) == 0u) { if (xb_ld(&bar[XB_TMO])) break; if (sp > XB_SPIN_CAP) { atomicAdd(&bar[XB_TMO], 1u); break; } }
    }
    nloc = mine > 0u ? mine : 1u; nx = cnt > 0u ? cnt : 1u;
}
__device__ __forceinline__ void xcd_barrier(const XcdBarrier& b, const int wv) {
    asm volatile("s_waitcnt vmcnt(0)" ::: "memory");
    __syncthreads();
    if (opq_tid(wv) == 0) {
        unsigned* bar = b.bar; asm volatile("" : "+s"(bar));
        __builtin_amdgcn_s_waitcnt(0);
        unsigned nloc = b.st[0], nx = b.st[1];
        if (nloc == 0u) { xcd_barrier_complete(bar, b.x, nloc, nx); b.st[0] = nloc; b.st[1] = nx; }
        const unsigned old = xb_add(&bar[XB_XSUB(b.x)], 1u);
        const unsigned gen = old / nloc;
        if (old + 1u == (gen + 1u) * nloc) {
            __builtin_amdgcn_fence(__ATOMIC_RELEASE, "agent");
            asm volatile("s_waitcnt vmcnt(0)" ::: "memory");
            const unsigned og = xb_add(&bar[XB_TOP], 1u);
            const unsigned tg = og / nx;
            if (og + 1u == (tg + 1u) * nx) xb_add(&bar[XB_TOPGEN], 1u);
            else XB_SPIN(xb_ld(&bar[XB_TOPGEN]) == tg, bar);
            __builtin_amdgcn_fence(__ATOMIC_ACQUIRE, "agent");
            xb_add(&bar[XB_XGEN(b.x)], 1u);
            asm volatile("s_waitcnt vmcnt(0)" ::: "memory");
        } else {
            XB_SPIN(xb_ld(&bar[XB_XGEN(b.x)]) == gen, bar);
            __builtin_amdgcn_fence(__ATOMIC_ACQUIRE, "agent");
            asm volatile("s_waitcnt vmcnt(0)" ::: "memory");
        }
    }
    __syncthreads();
}

namespace pg8 {
constexpr int BM = 256, BK = 64, HALF = 128, HTB = HALF * BK * 2, STAGE_BYTES = 8 * HTB, NXCD = 8, WGM = 8;
__host__ __device__ __forceinline__ int lds_byte(int r, int c) { const int st = (r >> 4) * 2 + (c >> 5), rr = r & 15, cc = c & 31, ob = rr * 64 + cc * 2; return st * 1024 + (ob ^ (((ob >> 9) & 1) << 5)); }
__host__ __device__ __forceinline__ void stage_rc(int b, int& R, int& C) { const int st = b / 1024, sb = b % 1024, swz = sb ^ (((sb >> 9) & 1) << 5); R = (st >> 1) * 16 + swz / 64; C = (st & 1) * 32 + (swz % 64) / 2; }
__host__ __device__ __forceinline__ int perm32(int rho) { const int n = rho >> 4, i = rho & 15; return 8 * (i >> 2) + 4 * n + (i & 3); }
struct Unit { int pm, pn, z; };
struct Gemm { int lda, ldb, K; };
struct SchedStd {
    const char* A; const char* Bt; size_t atile, btile; int nM, nN, nwg, G, c;
    __device__ __forceinline__ void init(const void* A_, const void* Bt_, int M, int N, int lda, int ldb, int G_, int c_) {
        A = (const char*)A_; Bt = (const char*)Bt_; atile = (size_t)BM * lda * 2; btile = (size_t)BM * ldb * 2; nM = M / BM; nN = N / BM; nwg = nM * nN; G = G_; c = c_; }
    __device__ __forceinline__ bool next(int i, Unit& u) const {
        const long L = (long)i * G + c; if (L >= nwg) return false;
        int wgid = (int)L; { const int q = nwg / NXCD, r = nwg % NXCD, xcd = wgid % NXCD, off = wgid / NXCD; wgid = (xcd < r ? xcd * (q + 1) : r * (q + 1) + (xcd - r) * q) + off; }
        const int nig = WGM * nN, gid = wgid / nig, fm = gid * WGM, gsz = (nM - fm) < WGM ? (nM - fm) : WGM;
        u.pm = fm + ((wgid % nig) % gsz); u.pn = (wgid % nig) / gsz; u.z = 0; return true;
    }
    __device__ __forceinline__ const char* a_ptr(const Unit& u) const { return A + (size_t)u.pm * atile; }
    __device__ __forceinline__ const char* b_ptr(const Unit& u) const { return Bt + (size_t)u.pn * btile; }
};
struct SchedCmp {
    const char* A; const char* Bt; int G, c;
    __device__ __forceinline__ bool next(int i, Unit& u) const { const int L = i * G + c; if (L >= 256) return false; u.z = L >> 5; u.pm = (L & 31) >> 1; u.pn = L & 1; return true; }
    __device__ __forceinline__ const char* a_ptr(const Unit& u) const { const int kv = u.z >> 2, ks = u.z & 3; return A + ((size_t)(kv * 4096 + u.pm * 256) * 4096 + (size_t)ks * 1024) * 2; }
    __device__ __forceinline__ const char* b_ptr(const Unit& u) const { const int kv = u.z >> 2, ks = u.z & 3; return Bt + ((size_t)(kv * 512 + u.pn * 256) * 4096 + (size_t)ks * 1024) * 2; }
};
struct EpiBf16 {
    static constexpr bool PERM = true;
    bf16_t* O; int ldc; const float* rstd;
    __device__ __forceinline__ void prefetch(float (&pre)[8], const Unit& u, int wr, int fr) const {
#pragma unroll
        for (int i = 0; i < 8; ++i) pre[i] = rstd[u.pm * BM + wr * 64 + fr + (i >> 2) * HALF + (i & 3) * 16]; }
    __device__ __forceinline__ void operator()(const f32x4 (&acc)[2][2][4][2], const Unit& u, int wr, int wc, int fr, int fq, const float (&pre)[8]) const {
        const int row0 = u.pm * BM + wr * 64 + fr, col0 = u.pn * BM + wc * 32 + 8 * fq;
#pragma unroll
        for (int ai = 0; ai < 2; ++ai)
#pragma unroll
            for (int m = 0; m < 4; ++m) { bf16_t* rowp = O + (size_t)(row0 + ai * HALF + m * 16) * ldc + col0; const float rs = pre[ai * 4 + m];
#pragma unroll
                for (int bj = 0; bj < 2; ++bj) { const f32x4 v0 = acc[ai][bj][m][0] * rs, v1 = acc[ai][bj][m][1] * rs;
                    u32x4 w; w.x = cvtpk(v0[0], v0[1]); w.y = cvtpk(v0[2], v0[3]); w.z = cvtpk(v1[0], v1[1]); w.w = cvtpk(v1[2], v1[3]);
                    *(u32x4*)(rowp + bj * HALF) = w; } }
    }
};
struct EpiSwiGLU {
    static constexpr bool PERM = true;
    bf16_t* O; int ldc; const float* rstd;
    __device__ __forceinline__ void prefetch(float (&pre)[8], const Unit& u, int wr, int fr) const {
#pragma unroll
        for (int i = 0; i < 8; ++i) pre[i] = rstd[u.pm * BM + wr * 64 + fr + (i >> 2) * HALF + (i & 3) * 16]; }
    __device__ __forceinline__ void operator()(const f32x4 (&acc)[2][2][4][2], const Unit& u, int wr, int wc, int fr, int fq, const float (&pre)[8]) const {
        const int row0 = u.pm * BM + wr * 64 + fr, col0 = u.pn * HALF + wc * 32 + 8 * fq;
#pragma unroll
        for (int ai = 0; ai < 2; ++ai)
#pragma unroll
            for (int m = 0; m < 4; ++m) { bf16_t* rowp = O + (size_t)(row0 + ai * HALF + m * 16) * ldc + col0; const float rs = pre[ai * 4 + m];
                float v[8];
#pragma unroll
                for (int n = 0; n < 2; ++n)
#pragma unroll
                    for (int j = 0; j < 4; ++j) { const float g = acc[ai][0][m][n][j] * rs, up = acc[ai][1][m][n][j] * rs;
                        const float s = g * __builtin_amdgcn_rcpf(1.0f + __builtin_amdgcn_exp2f(-g * LOG2E)); v[n * 4 + j] = s * up; }
                u32x4 w; w.x = cvtpk(v[0], v[1]); w.y = cvtpk(v[2], v[3]); w.z = cvtpk(v[4], v[5]); w.w = cvtpk(v[6], v[7]);
                *(u32x4*)rowp = w; }
    }
};
struct EpiResid {
    static constexpr bool PERM = false;
    __device__ __forceinline__ void prefetch(float (&)[8], const Unit&, int, int) const {}
    const float* base; float* out; bf16_t* xb; float* ssq; int ldc; float alpha;
    __device__ __forceinline__ void operator()(const f32x4 (&acc)[2][2][4][2], const Unit& u, int wr, int wc, int fr, int fq, const float (&pre)[8]) const {
        const int row0 = u.pm * BM + wr * 64 + fr, col0 = u.pn * BM + wc * 32 + 4 * fq;
#pragma unroll
        for (int ai = 0; ai < 2; ++ai)
#pragma unroll
            for (int m = 0; m < 4; ++m) { const int row = row0 + ai * HALF + m * 16; const size_t off = (size_t)row * ldc + col0; float ss = 0.f;
#pragma unroll
                for (int bj = 0; bj < 2; ++bj)
#pragma unroll
                    for (int n = 0; n < 2; ++n) { const f32x4 bs = *(const f32x4*)(base + off + bj * HALF + n * 16); const f32x4 o = bs + acc[ai][bj][m][n] * alpha;
                        *(f32x4*)(out + off + bj * HALF + n * 16) = o; ss += (o.x * o.x + o.y * o.y) + (o.z * o.z + o.w * o.w);
                        u32x2 w; w.x = cvtpk(o.x, o.y); w.y = cvtpk(o.z, o.w); *(u32x2*)(xb + off + bj * HALF + n * 16) = w; }
                const int lane = fq * 16 + fr; ss += shx(ss, 16, lane); ss += shx(ss, 32, lane);
                if (fq == 0) ssq[(size_t)row * 32 + u.pn * 4 + wc] = ss; }
    }
};
struct EpiF32Z {
    static constexpr bool PERM = false;
    float* C; int ldc; size_t zstride;
    __device__ __forceinline__ void prefetch(float (&)[8], const Unit&, int, int) const {}
    __device__ __forceinline__ void operator()(const f32x4 (&acc)[2][2][4][2], const Unit& u, int wr, int wc, int fr, int fq, const float (&pre)[8]) const {
        float* Cz = C + (size_t)u.z * zstride;
        const int row0 = u.pm * BM + wr * 64 + fr, col0 = u.pn * BM + wc * 32 + 4 * fq;
#pragma unroll
        for (int ai = 0; ai < 2; ++ai)
#pragma unroll
            for (int m = 0; m < 4; ++m) { float* rowp = Cz + (size_t)(row0 + ai * HALF + m * 16) * ldc + col0;
#pragma unroll
                for (int bj = 0; bj < 2; ++bj)
#pragma unroll
                    for (int n = 0; n < 2; ++n) *(f32x4*)(rowp + bj * HALF + n * 16) = acc[ai][bj][m][n]; }
    }
};

template <class Epi, class Sched>
__device__ __forceinline__ void gemm_phase(LAS unsigned char* lds, const Gemm g, const Sched& S, const Epi& E, const int wv) {
    const int tid = opq_tid(wv), wid = __builtin_amdgcn_readfirstlane(tid >> 6), lane = tid & 63, wr = wid >> 2, wc = wid & 3, fr = lane & 15, fq = lane >> 4;
    const int K = g.K, nt = K / BK;
    unsigned voffA[2], voffB[2];
#pragma unroll
    for (int i = 0; i < 2; ++i) { int R, C; stage_rc(tid * 16 + i * 8192, R, C); const int Rb = Epi::PERM ? ((R & ~31) + perm32(R & 31)) : R;
        voffA[i] = (unsigned)(R * g.lda + C) * 2u; voffB[i] = (unsigned)(Rb * g.ldb + C) * 2u; }
    const size_t kstep = (size_t)(BK * 2);
    const size_t hstepA = (size_t)HALF * g.lda * 2, hstepB = (size_t)HALF * g.ldb * 2;
    const unsigned ldsw = (unsigned)wid * 1024u;
    const int aoff = lds_byte(wr * 64 + fr, fq * 8), boff = lds_byte(wc * 32 + fr, fq * 8);
#define PG8_SA(b, h) (((b) * 2 + (h)) * HTB)
#define PG8_SB(b, h) ((4 + (b) * 2 + (h)) * HTB)
#define PG8_STAGE(bufoff, gbase, voff) do { _Pragma("unroll") for (int _i = 0; _i < 2; ++_i) \
        __builtin_amdgcn_global_load_lds((const unsigned*)((const char*)(gbase) + (voff)[_i]), (LAS unsigned*)(lds + (bufoff) + ldsw + _i * 8192), 16, 0, 0); } while (0)
#define PG8_LDA(dst, b, h) do { _Pragma("unroll") for (int m = 0; m < 4; ++m) _Pragma("unroll") for (int k = 0; k < 2; ++k) dst[m][k] = *(const LAS bf16x8*)(lds + PG8_SA(b, h) + aoff + m * 2048 + k * 1024); } while (0)
#define PG8_LDB(dst, b, h) do { _Pragma("unroll") for (int n = 0; n < 2; ++n) _Pragma("unroll") for (int k = 0; k < 2; ++k) dst[n][k] = *(const LAS bf16x8*)(lds + PG8_SB(b, h) + boff + n * 2048 + k * 1024); } while (0)
#define PG8_MMA(ai, bj, At, Bt) do { __builtin_amdgcn_s_setprio(1); _Pragma("unroll") for (int m = 0; m < 4; ++m) _Pragma("unroll") for (int n = 0; n < 2; ++n) _Pragma("unroll") for (int k = 0; k < 2; ++k) \
        acc[ai][bj][m][n] = __builtin_amdgcn_mfma_f32_16x16x32_bf16(Bt[n][k], At[m][k], acc[ai][bj][m][n], 0, 0, 0); __builtin_amdgcn_s_setprio(0); } while (0)
#define PG8_WAIT_V(n) asm volatile("s_waitcnt vmcnt(" #n ")" ::: "memory")
#define PG8_WAIT_L(n) asm volatile("s_waitcnt lgkmcnt(" #n ")" ::: "memory")
#define PG8_BAR __builtin_amdgcn_s_barrier()
#define PG8_SCHED __builtin_amdgcn_sched_barrier(0)
    Unit cur, nxt; int ui = 0;
    if (!S.next(0, cur)) return;
    f32x4 acc[2][2][4][2];
#pragma unroll
    for (int a = 0; a < 2; ++a)
#pragma unroll
        for (int b = 0; b < 2; ++b)
#pragma unroll
            for (int m = 0; m < 4; ++m)
#pragma unroll
                for (int n = 0; n < 2; ++n) acc[a][b][m][n] = (f32x4){0.f, 0.f, 0.f, 0.f};
    bf16x8 At[4][2], B0[2][2], B1[2][2];
    const char* cA = S.a_ptr(cur); const char* cB = S.b_ptr(cur);
    float pre[8]; E.prefetch(pre, cur, wr, fr);
    PG8_STAGE(PG8_SB(0, 0), cB, voffB); PG8_STAGE(PG8_SA(0, 0), cA, voffA); PG8_STAGE(PG8_SB(0, 1), cB + hstepB, voffB); PG8_STAGE(PG8_SA(0, 1), cA + hstepA, voffA);
    if (wr == 1) PG8_BAR;
    PG8_WAIT_V(4); PG8_BAR;
    PG8_STAGE(PG8_SB(1, 0), cB + kstep, voffB); PG8_STAGE(PG8_SA(1, 0), cA + kstep, voffA); PG8_STAGE(PG8_SB(1, 1), cB + hstepB + kstep, voffB);
    PG8_WAIT_V(6); PG8_BAR;
    for (;;) {
        const bool has_next = S.next(ui + 1, nxt);
        const char* nA = has_next ? S.a_ptr(nxt) : cA; const char* nB = has_next ? S.b_ptr(nxt) : cB;
        for (int t = 0; t < nt; t += 2) {
            const bool last = (t == nt - 2);
            const char* a1 = cA + (size_t)(t + 1) * kstep;
            const char* a2 = last ? nA : cA + (size_t)(t + 2) * kstep; const char* b2 = last ? nB : cB + (size_t)(t + 2) * kstep;
            const char* a3 = a2 + kstep; const char* b3 = b2 + kstep;
            PG8_LDB(B0, 0, 0); PG8_SCHED; PG8_LDA(At, 0, 0); PG8_STAGE(PG8_SA(1, 1), a1 + hstepA, voffA);
            PG8_WAIT_L(8); PG8_BAR; PG8_WAIT_L(0); PG8_MMA(0, 0, At, B0); PG8_BAR; PG8_SCHED;
            PG8_LDB(B1, 0, 1); PG8_STAGE(PG8_SB(0, 0), b2, voffB);
            PG8_BAR; PG8_WAIT_L(0); PG8_MMA(0, 1, At, B1); PG8_BAR;
            PG8_LDA(At, 0, 1); PG8_STAGE(PG8_SA(0, 0), a2, voffA);
            PG8_BAR; PG8_WAIT_L(0); PG8_MMA(1, 0, At, B0); PG8_BAR; PG8_SCHED;
            PG8_STAGE(PG8_SB(0, 1), b2 + hstepB, voffB);
            PG8_WAIT_V(6); PG8_BAR; PG8_MMA(1, 1, At, B1); PG8_BAR;
            PG8_LDB(B0, 1, 0); PG8_SCHED; PG8_LDA(At, 1, 0); PG8_STAGE(PG8_SA(0, 1), a2 + hstepA, voffA);
            PG8_WAIT_L(8); PG8_BAR; PG8_WAIT_L(0); PG8_MMA(0, 0, At, B0); PG8_BAR; PG8_SCHED;
            PG8_LDB(B1, 1, 1); PG8_STAGE(PG8_SB(1, 0), b3, voffB);
            PG8_BAR; PG8_WAIT_L(0); PG8_MMA(0, 1, At, B1); PG8_BAR;
            PG8_LDA(At, 1, 1); PG8_STAGE(PG8_SA(1, 0), a3, voffA);
            PG8_BAR; PG8_WAIT_L(0); PG8_MMA(1, 0, At, B0); PG8_BAR; PG8_SCHED;
            PG8_STAGE(PG8_SB(1, 1), b3 + hstepB, voffB);
            PG8_WAIT_V(6); PG8_BAR; PG8_MMA(1, 1, At, B1); PG8_BAR;
        }
        E(acc, cur, wr, wc, fr, fq, pre);
        if (has_next) E.prefetch(pre, nxt, wr, fr);
        if (!has_next) break;
#pragma unroll
        for (int a = 0; a < 2; ++a)
#pragma unroll
            for (int b = 0; b < 2; ++b)
#pragma unroll
                for (int m = 0; m < 4; ++m)
#pragma unroll
                    for (int n = 0; n < 2; ++n) acc[a][b][m][n] = (f32x4){0.f, 0.f, 0.f, 0.f};
        cur = nxt; cA = nA; cB = nB; ++ui;
    }
    PG8_WAIT_V(0);
    if (wr == 0) PG8_BAR;
    PG8_BAR;
#undef PG8_SA
#undef PG8_SB
#undef PG8_STAGE
#undef PG8_LDA
#undef PG8_LDB
#undef PG8_MMA
#undef PG8_WAIT_V
#undef PG8_WAIT_L
#undef PG8_BAR
#undef PG8_SCHED
}
}

struct Args { const float* in[24]; float* out; unsigned char* ws; };
enum { I_X = 0, I_F1N, I_F1W1, I_F1W3, I_F1W2, I_MIXN, I_WIN, I_GB, I_QNA, I_KNA, I_QNN, I_KNN, I_POS, I_CKW1, I_CKW2, I_CVW1, I_CVW2, I_ON, I_WOUT, I_F2N, I_F2W1, I_F2W3, I_F2W2, I_RB };

__device__ __forceinline__ void transpose_item(const float* W, int K, int N, bf16_t* WT, int mode, int off, LAS float* scr, int item, int lane, const float* gain) {
    const int nblk = (N + 31) / 32, kb = item / nblk, nb = item % nblk, k0 = 64 * kb, n0 = 32 * nb;
    const int c4 = 4 * (lane & 7), nn = n0 + c4;
    f32x4 ld[8];
#pragma unroll
    for (int i = 0; i < 8; ++i) { const int kk = 8 * i + (lane >> 3); ld[i] = (nn < N) ? *(const f32x4*)(W + (size_t)(k0 + kk) * N + nn) : (f32x4){0.f, 0.f, 0.f, 0.f}; if (gain) ld[i] = ld[i] * gain[k0 + kk]; }
#pragma unroll
    for (int i = 0; i < 8; ++i) { const int kk = 8 * i + (lane >> 3); LAS float* d = scr + kk * 33 + c4; d[0] = ld[i].x; d[1] = ld[i].y; d[2] = ld[i].z; d[3] = ld[i].w; }
    LDS_WAIT(); asm volatile("" ::: "memory");
    const int c = lane & 7;
#pragma unroll
    for (int j = 0; j < 4; ++j) { const int n = (lane >> 3) + 8 * j; const LAS float* s = scr + (8 * c) * 33 + n;
        u32x4 o; o.x = pk2(s[0 * 33], s[1 * 33]); o.y = pk2(s[2 * 33], s[3 * 33]); o.z = pk2(s[4 * 33], s[5 * 33]); o.w = pk2(s[6 * 33], s[7 * 33]);
        const int ng = n0 + n; const int dr = mode ? ((ng >> 7) * 256 + (ng & 127) + off) : (ng + off);
        if (ng < N) *(u32x4*)(WT + (size_t)dr * K + k0 + 8 * c) = o; }
    LDS_WAIT(); asm volatile("" ::: "memory");
}
__device__ __forceinline__ int rel_bucket_dev(int n) {
    if (n < 16) return n;
    const float v = logf((float)n / 16.0f) / 4.852030263919617f * 16.0f;
    int b = 16 + (int)v; return b < 31 ? b : 31;
}
namespace att {
constexpr int SHM_V = 16384, SHM_K = 16384;
constexpr int L_V = 0, L_K = 32768, L_WS = 65536, L_TBL = 67584, L_IMP = L_TBL + 4 * TBLS * 4  , L_SELM = L_IMP + 32768  , L_END = L_SELM + 1024;
static_assert(L_END <= 131072, "attention LDS map");
constexpr float THR = 8.f;
#define KSWZ(row, colB) ((row) * 256 + ((colB) ^ (((row) & 7) << 4)))
__device__ __forceinline__ int v_st(int k, int c) { const int kk = (k & ~0xC) | ((k & 4) << 1) | ((k & 8) >> 1); return ((kk >> 3) * 4 + (c >> 5)) * 512 + ((kk & 7) * 32 + (c & 31)) * 2; }
__device__ __forceinline__ int v_rd_base(int lane) { return ((lane & 3) << 3) | (((lane >> 2) & 3) << 6) | (((lane >> 4) & 1) << 5) | (((lane >> 5) & 1) << 8); }
__device__ __forceinline__ int crow(int r, int hi) { return (r & 3) + 8 * (r >> 2) + 4 * hi; }

__device__ __forceinline__ void partialSM(f32x16& p0, f32x16& p1, float& m_reg, float& mn, float& alpha) {
    float pmax = p0[0];
#pragma unroll
    for (int r = 1; r < 16; ++r) pmax = fmaxf(pmax, p0[r]);
#pragma unroll
    for (int r = 0; r < 16; ++r) pmax = fmaxf(pmax, p1[r]);
    { auto rr = __builtin_amdgcn_permlane32_swap(__float_as_uint(pmax), __float_as_uint(pmax), false, false);
      pmax = fmaxf(__uint_as_float(rr[0]), __uint_as_float(rr[1])); }
    if (__builtin_expect(__all((pmax - m_reg) <= THR), 1)) { mn = m_reg; alpha = 1.f; }
    else { mn = fmaxf(m_reg, pmax); alpha = __builtin_amdgcn_exp2f((m_reg - mn) * LOG2E); m_reg = mn; }
    const float mnL = -mn * LOG2E;
#pragma unroll
    for (int r = 0; r < 16; ++r) p0[r] = fmaf(p0[r], LOG2E, mnL);
#pragma unroll
    for (int r = 0; r < 16; ++r) p1[r] = fmaf(p1[r], LOG2E, mnL);
#pragma unroll
    for (int r = 0; r < 16; ++r) p0[r] = __builtin_amdgcn_exp2f(p0[r]);
}
__device__ __forceinline__ void partialSM_row(f32x16& p0, f32x16& p1, float& m_reg, float& mn, float& alpha, bool ok, float bias) {
    float pmax = p0[0];
#pragma unroll
    for (int r = 1; r < 16; ++r) pmax = fmaxf(pmax, p0[r]);
#pragma unroll
    for (int r = 0; r < 16; ++r) pmax = fmaxf(pmax, p1[r]);
    { auto rr = __builtin_amdgcn_permlane32_swap(__float_as_uint(pmax), __float_as_uint(pmax), false, false);
      pmax = fmaxf(__uint_as_float(rr[0]), __uint_as_float(rr[1])); }
    pmax = ok ? pmax + bias : -__builtin_inff();
    if (__builtin_expect(__all((pmax - m_reg) <= THR), 1)) { mn = m_reg; alpha = 1.f; }
    else { mn = fmaxf(m_reg, pmax); alpha = __builtin_amdgcn_exp2f((m_reg - mn) * LOG2E); m_reg = mn; }
    const float mnL = ok ? (bias - mn) * LOG2E : -__builtin_inff();
#pragma unroll
    for (int r = 0; r < 16; ++r) p0[r] = fmaf(p0[r], LOG2E, mnL);
#pragma unroll
    for (int r = 0; r < 16; ++r) p1[r] = fmaf(p1[r], LOG2E, mnL);
#pragma unroll
    for (int r = 0; r < 16; ++r) p0[r] = __builtin_amdgcn_exp2f(p0[r]);
}
#define PK4(P, B_, OUT) do { unsigned a0 = cvtpk(P[B_+0], P[B_+1]), a1 = cvtpk(P[B_+2], P[B_+3]);                          \
        unsigned b0 = cvtpk(P[B_+4], P[B_+5]), b1 = cvtpk(P[B_+6], P[B_+7]);                                             \
        auto r0 = __builtin_amdgcn_permlane32_swap(a0, b0, false, false); auto r1 = __builtin_amdgcn_permlane32_swap(a1, b1, false, false); \
        u32x4 w = {r0[0], r1[0], r0[1], r1[1]}; OUT = *reinterpret_cast<bf16x8*>(&w); } while (0)
__device__ __forceinline__ void finishSM(f32x16& p0, f32x16& p1, float alpha, float& l_reg, bf16x8& pa0, bf16x8& pa1, bf16x8& pa2, bf16x8& pa3) {
#pragma unroll
    for (int r = 0; r < 16; ++r) p1[r] = __builtin_amdgcn_exp2f(p1[r]);
    float ps = 0;
#pragma unroll
    for (int r = 0; r < 16; ++r) ps += p0[r];
#pragma unroll
    for (int r = 0; r < 16; ++r) ps += p1[r];
    { auto rr = __builtin_amdgcn_permlane32_swap(__float_as_uint(ps), __float_as_uint(ps), false, false);
      ps = __uint_as_float(rr[0]) + __uint_as_float(rr[1]); }
    l_reg = l_reg * alpha + ps;
    PK4(p0, 0, pa0); PK4(p0, 8, pa1); PK4(p1, 0, pa2); PK4(p1, 8, pa3);
}
__device__ __forceinline__ void qkt(f32x16& p0, f32x16& p1, const LAS char* Kb, int r32, int hi, const bf16x8 (&qr)[8]) {
    p0 = f32x16{}; p1 = f32x16{};
    const LAS char* kb4[4];
#pragma unroll
    for (int dd = 0; dd < 4; ++dd) kb4[dd] = Kb + KSWZ(r32, (dd * 16 + hi * 8) * 2);
#pragma unroll
    for (int d0 = 0; d0 < 8; ++d0) { const LAS char* a = kb4[d0 & 3] + (d0 >> 2) * 128;
        const bf16x8 b0 = *reinterpret_cast<const LAS bf16x8*>(a);
        const bf16x8 b1 = *reinterpret_cast<const LAS bf16x8*>(a + 32 * 256);
        p0 = __builtin_amdgcn_mfma_f32_32x32x16_bf16(b0, qr[d0], p0, 0, 0, 0);
        p1 = __builtin_amdgcn_mfma_f32_32x32x16_bf16(b1, qr[d0], p1, 0, 0, 0); }
}
__device__ __forceinline__ void pv_tile(f32x16 (&o)[4], int vb, bf16x8 pa0, bf16x8 pa1, bf16x8 pa2, bf16x8 pa3) {
#define TRRD(dst, off) asm volatile("ds_read_b64_tr_b16 %0, %1 offset:%2" : "=&v"(dst) : "v"(vb), "i"(off) : "memory")
#define PV_D0(d0) do { s16x4 l0, l1, l2, l3, h0, h1, h2, h3; constexpr int b_ = (d0) * 512; \
        TRRD(l0, b_); TRRD(h0, b_ + 2048); TRRD(l1, b_ + 4096); TRRD(h1, b_ + 6144); TRRD(l2, b_ + 8192); TRRD(h2, b_ + 10240); TRRD(l3, b_ + 12288); TRRD(h3, b_ + 14336); \
        asm volatile("s_waitcnt lgkmcnt(0)" ::: "memory"); SBAR(); \
        o[d0] = __builtin_amdgcn_mfma_f32_32x32x16_bf16(pa0, (bf16x8){l0[0], l0[1], l0[2], l0[3], h0[0], h0[1], h0[2], h0[3]}, o[d0], 0, 0, 0);   \
        o[d0] = __builtin_amdgcn_mfma_f32_32x32x16_bf16(pa1, (bf16x8){l1[0], l1[1], l1[2], l1[3], h1[0], h1[1], h1[2], h1[3]}, o[d0], 0, 0, 0);   \
        o[d0] = __builtin_amdgcn_mfma_f32_32x32x16_bf16(pa2, (bf16x8){l2[0], l2[1], l2[2], l2[3], h2[0], h2[1], h2[2], h2[3]}, o[d0], 0, 0, 0);   \
        o[d0] = __builtin_amdgcn_mfma_f32_32x32x16_bf16(pa3, (bf16x8){l3[0], l3[1], l3[2], l3[3], h3[0], h3[1], h3[2], h3[3]}, o[d0], 0, 0, 0); } while (0)
    PV_D0(0); PV_D0(1); PV_D0(2); PV_D0(3);
#undef PV_D0
#undef TRRD
}

template <class Cfg>
__device__ __forceinline__ void attn_tiles(const Cfg& c, LAS char* lds, const bf16x8 (&qr)[8], f32x16 (&o)[4], float& m_reg, float& l_reg, const int t_lo, const int t_hi, const int wv) {
    const int tid = opq_tid(wv), lane = tid & 63, wid = __builtin_amdgcn_readfirstlane(tid >> 6), r32 = lane & 31, hi = lane >> 5;
    LAS char* V_lds = lds + L_V; LAS char* K_lds = lds + L_K;
    LAS float* al_l = (LAS float*)(lds + L_WS) + wid * 64 + 32;
    const int sr = tid >> 4, sc = (tid & 15) * 8;
    const int vst0 = v_st(sr, sc), vst1 = v_st(32 + sr, sc), kws = KSWZ(sr, sc * 2);
    const int vb0 = (int)(unsigned)(uintptr_t)V_lds + v_rd_base(lane);
    bf16x8 sk0, sk1, sv0, sv1;
#define AT_LOAD(t) do { sk0 = *(const bf16x8*)(c.krow((t), sr) + sc); sk1 = *(const bf16x8*)(c.krow((t), sr + 32) + sc); \
        if constexpr (Cfg::MODE == 0) { sv0 = *(const bf16x8*)(c.vrow((t), sr) + sc); sv1 = *(const bf16x8*)(c.vrow((t), sr + 32) + sc); } \
        asm volatile("" ::: "memory"); SBAR(); } while (0)
#define AT_WRITE(t, bf) do { *(LAS bf16x8*)(K_lds + (bf) * SHM_K + kws) = sk0; *(LAS bf16x8*)(K_lds + (bf) * SHM_K + kws + 32 * 256) = sk1; \
        if constexpr (Cfg::MODE == 1) { \
            _Pragma("unroll") for (int i_ = 0; i_ < 8; ++i_) { const int n_ = sc + i_, c0_ = 64 * (t) + sr, c1_ = c0_ + 32; \
                sv0[i_] = (c0_ >= 4 * n_ - 1 && c0_ <= 4 * n_ + 3) ? (short)0x3F80 : (short)0; sv1[i_] = (c1_ >= 4 * n_ - 1 && c1_ <= 4 * n_ + 3) ? (short)0x3F80 : (short)0; } } \
        *(LAS bf16x8*)(V_lds + (bf) * SHM_V + vst0) = sv0; *(LAS bf16x8*)(V_lds + (bf) * SHM_V + vst1) = sv1; } while (0)
    __syncthreads();
    if (t_lo < t_hi) { AT_LOAD(t_lo); AT_WRITE(t_lo, 0); }
    __syncthreads();
    for (int t = t_lo; t < t_hi; ++t) {
        const int buf = (t - t_lo) & 1; const bool more = (t + 1 < t_hi);
        if (more) AT_LOAD(t + 1);
        if (c.active(t)) {
            f32x16 p0, p1;
            qkt(p0, p1, K_lds + buf * SHM_K, r32, hi, qr);
            if constexpr (Cfg::MODE == 0) {
                float mn, alpha; bf16x8 pa0, pa1, pa2, pa3;
                bool rok; float rbias;
                if (c.rowconst(t, rok, rbias)) partialSM_row(p0, p1, m_reg, mn, alpha, rok, rbias);
                else { c.mask(p0, p1, t); partialSM(p0, p1, m_reg, mn, alpha); }
                if (__any(alpha < 1.f)) { if (hi == 0) al_l[r32] = alpha; LDS_WAIT();
#pragma unroll
                    for (int d_ = 0; d_ < 4; ++d_)
#pragma unroll
                        for (int r = 0; r < 16; ++r) o[d_][r] *= al_l[crow(r, hi)]; }
                finishSM(p0, p1, alpha, l_reg, pa0, pa1, pa2, pa3); SBAR();
                pv_tile(o, vb0 + buf * SHM_V, pa0, pa1, pa2, pa3);
            } else {
                c.mask(p0, p1, t);
                const float mL = -c.mfix * LOG2E; const float il = c.invl;
#pragma unroll
                for (int r = 0; r < 16; ++r) { p0[r] = __builtin_amdgcn_exp2f(fmaf(p0[r], LOG2E, mL)) * il; p1[r] = __builtin_amdgcn_exp2f(fmaf(p1[r], LOG2E, mL)) * il; }
                bf16x8 pa0, pa1, pa2, pa3;
                PK4(p0, 0, pa0); PK4(p0, 8, pa1); PK4(p1, 0, pa2); PK4(p1, 8, pa3); SBAR();
                pv_tile(o, vb0 + buf * SHM_V, pa0, pa1, pa2, pa3);
#pragma unroll
                for (int r = 0; r < 16; r += 2) { const unsigned a = cvtpk(p0[r], p0[r + 1]), b = cvtpk(p1[r], p1[r + 1]);
                    p0[r] -= bflo(a); p0[r + 1] -= bfhi(a); p1[r] -= bflo(b); p1[r + 1] -= bfhi(b); }
                PK4(p0, 0, pa0); PK4(p0, 8, pa1); PK4(p1, 0, pa2); PK4(p1, 8, pa3); SBAR();
                pv_tile(o, vb0 + buf * SHM_V, pa0, pa1, pa2, pa3);
            }
        }
        if (more) AT_WRITE(t + 1, buf ^ 1);
        __syncthreads();
    }
#undef AT_LOAD
#undef AT_WRITE
}

struct DilCfg {
    static constexpr int MODE = 0;
    const bf16_t* Kb; const bf16_t* Vb;
    const LAS float* tbl; int dshift, res, u, dqm, s0;
    __device__ __forceinline__ const bf16_t* krow(int t, int kk) const { int s = 256 * u - 128 + 64 * t + kk; s = s < 0 ? 0 : s; return Kb + (size_t)((s << dshift) + res) * PC; }
    __device__ __forceinline__ const bf16_t* vrow(int t, int kk) const { int s = 256 * u - 128 + 64 * t + kk; s = s < 0 ? 0 : s; return Vb + (size_t)((s << dshift) + res) * PC; }
    __device__ __forceinline__ bool active(int t) const { const int kb = 256 * u - 128 + 64 * t; return kb <= s0 + 31 && kb + 63 >= s0 - 128; }
    __device__ __forceinline__ bool rowconst(int, bool&, float&) const { return false; }
    __device__ __forceinline__ void mask(f32x16& p0, f32x16& p1, int t) const {
        const int dq = dqm - (256 * u - 128 + 64 * t); const float NEG = -__builtin_inff();
        const LAS float* tb = tbl + (DT0 + dq - 63);
#pragma unroll
        for (int r = 0; r < 16; ++r) { const int cc = (r & 3) + 8 * (r >> 2); const unsigned d0 = (unsigned)(dq - cc), d1 = (unsigned)(dq - cc - 32);
            const float b0 = tb[63 - cc], b1 = tb[31 - cc];
            p0[r] = (d0 <= 128u) ? p0[r] + b0 : NEG; p1[r] = (d1 <= 128u) ? p1[r] + b1 : NEG; }
    }
};
struct CmpCfg {
    static constexpr int MODE = 0;
    const bf16_t* Kb; const bf16_t* Vb; int cmax, hi4, cfull;
    __device__ __forceinline__ bool rowconst(int t, bool& ok, float& bias) const { ok = true; bias = 0.f; return 64 * t + 63 <= cfull; }
    __device__ __forceinline__ const bf16_t* krow(int t, int kk) const { return Kb + (size_t)(64 * t + kk) * HD; }
    __device__ __forceinline__ const bf16_t* vrow(int t, int kk) const { return Vb + (size_t)(64 * t + kk) * HD; }
    __device__ __forceinline__ bool active(int) const { return true; }
    __device__ __forceinline__ void mask(f32x16& p0, f32x16& p1, int t) const {
        const int cb = 64 * t + hi4; const float NEG = -__builtin_inff();
#pragma unroll
        for (int r = 0; r < 16; ++r) { const int cc = cb + (r & 3) + 8 * (r >> 2); if (cc > cmax) p0[r] = NEG; if (cc + 32 > cmax) p1[r] = NEG; }
    }
};
struct CmpImpCfg {
    static constexpr int MODE = 1;
    const bf16_t* Kb; int cmax, hi4; float mfix, invl;
    __device__ __forceinline__ const bf16_t* krow(int t, int kk) const { return Kb + (size_t)(64 * t + kk) * HD; }
    __device__ __forceinline__ const bf16_t* vrow(int, int) const { return Kb; }
    __device__ __forceinline__ bool active(int) const { return true; }
    __device__ __forceinline__ void mask(f32x16& p0, f32x16& p1, int t) const {
        const int cb = 64 * t + hi4; const float NEG = -__builtin_inff();
#pragma unroll
        for (int r = 0; r < 16; ++r) { const int cc = cb + (r & 3) + 8 * (r >> 2); if (cc > cmax) p0[r] = NEG; if (cc + 32 > cmax) p1[r] = NEG; }
    }
};
struct SlcCfg {
    static constexpr int MODE = 0;
    const bf16_t* Kb; const bf16_t* Vb;
    const LAS float* tblh;
    unsigned s0, s1, s2, s3; int tqm, cur; float b31;
    __device__ __forceinline__ const bf16_t* krow(int t, int kk) const { return Kb + (size_t)(64 * t + kk) * PC; }
    __device__ __forceinline__ const bf16_t* vrow(int t, int kk) const { return Vb + (size_t)(64 * t + kk) * PC; }
    __device__ __forceinline__ bool selbit(int t) const { const unsigned q = (unsigned)t >> 5; const unsigned w = (q == 0u ? s0 + 0u : 0u) | (q == 1u ? s1 + 0u : 0u) | (q == 2u ? s2 + 0u : 0u) | (q == 3u ? s3 + 0u : 0u); return (w >> (t & 31)) & 1u; }
    __device__ __forceinline__ bool active(int t) const { return __any(selbit(t)); }
    __device__ __forceinline__ bool rowconst(int t, bool& ok, float& bias) const { ok = selbit(t); bias = b31; return 64 * (cur - t) - 63 >= 1513; }
    __device__ __forceinline__ void mask(f32x16& p0, f32x16& p1, int t) const {
        const bool sel = selbit(t); const int dq = tqm - 64 * t; const float NEG = -__builtin_inff();
        const LAS float* tb = tblh + (TBL0 + dq - 63);
#pragma unroll
        for (int r = 0; r < 16; ++r) { const int cc = (r & 3) + 8 * (r >> 2); const int d0 = dq - cc, d1 = dq - cc - 32;
            const float b0 = tb[63 - cc], b1 = tb[31 - cc];
            p0[r] = (sel && d0 >= 0) ? p0[r] + b0 : NEG; p1[r] = (sel && d1 >= 0) ? p1[r] + b1 : NEG; }
    }
};
struct WinCfg {
    static constexpr int MODE = 0;
    const bf16_t* Kb; const bf16_t* Vb; const LAS float* tblh; int tqm;
    __device__ __forceinline__ bool rowconst(int, bool&, float&) const { return false; }
    __device__ __forceinline__ const bf16_t* krow(int t, int kk) const { return Kb + (size_t)(64 * t + kk) * PC; }
    __device__ __forceinline__ const bf16_t* vrow(int t, int kk) const { return Vb + (size_t)(64 * t + kk) * PC; }
    __device__ __forceinline__ bool active(int) const { return true; }
    __device__ __forceinline__ void mask(f32x16& p0, f32x16& p1, int t) const {
        const int dq = tqm - 64 * t; const float NEG = -__builtin_inff();
        const LAS float* tb = tblh + (TBL0 + dq - 63);
#pragma unroll
        for (int r = 0; r < 16; ++r) { const int cc = (r & 3) + 8 * (r >> 2); const unsigned d0 = (unsigned)(dq - cc), d1 = (unsigned)(dq - cc - 32);
            const float b0 = tb[63 - cc], b1 = tb[31 - cc];
            p0[r] = (d0 < 512u) ? p0[r] + b0 : NEG; p1[r] = (d1 < 512u) ? p1[r] + b1 : NEG; }
    }
};
}

__device__ __forceinline__ void dil_unit(LAS char* lds, const bf16_t* P, bf16_t* OA, float* LSE, const float* dilT, int pat, int dshift, int unit, const int wv) {
    using namespace att;
    const int tid = opq_tid(wv), lane = tid & 63, wid = __builtin_amdgcn_readfirstlane(tid >> 6), r32 = lane & 31, hi = lane >> 5;
    const int bh = unit >> 5, ru = unit & 31, b = bh >> 3, h = bh & 7;
    const int ncs = 5 - dshift, res = ru >> ncs, u = ru & ((1 << ncs) - 1);
    LAS float* tbl = (LAS float*)(lds + L_TBL);
    __syncthreads();
    if (tid < DTS) tbl[tid] = dilT[(pat * 8 + h) * DTS + tid];
    const int s0 = 256 * u + 32 * wid, s_row = s0 + r32;
    const size_t tokrow = (size_t)b * SEQ + (size_t)((s_row << dshift) + res);
    bf16x8 qr[8];
    { const bf16_t* qp = P + tokrow * PC + C_QA + h * HD + hi * 8;
#pragma unroll
      for (int d0 = 0; d0 < 8; ++d0) qr[d0] = *(const bf16x8*)(qp + d0 * 16); }
    f32x16 o[4]; float m_reg, l_reg;
    if (pat == 0) { m_reg = -1e30f; l_reg = 0.f;
#pragma unroll
        for (int d0 = 0; d0 < 4; ++d0) o[d0] = f32x16{}; }
    else { m_reg = LSE[tokrow * 8 + h]; l_reg = 1.f;
#pragma unroll
        for (int r = 0; r < 16; ++r) { const size_t tr = (size_t)b * SEQ + (size_t)(((s0 + crow(r, hi)) << dshift) + res); const bf16_t* op = OA + tr * 1024 + h * HD + r32;
#pragma unroll
            for (int d0 = 0; d0 < 4; ++d0) o[d0][r] = bf2f(op[d0 * 32]); } }
    DilCfg c; c.Kb = P + (size_t)b * SEQ * PC + C_KA + h * HD; c.Vb = P + (size_t)b * SEQ * PC + C_VA + h * HD; c.tbl = tbl; c.dshift = dshift; c.res = res; c.u = u; c.dqm = s_row - 4 * hi; c.s0 = s0;
    attn_tiles(c, lds, qr, o, m_reg, l_reg, (u == 0) ? 2 : 0, 6, wv);
    LAS float* li_l = (LAS float*)(lds + L_WS) + wid * 64;
    if (hi == 0) { li_l[r32] = l_reg; LSE[tokrow * 8 + h] = m_reg + logf(l_reg); }
    LDS_WAIT();
#pragma unroll
    for (int r = 0; r < 16; ++r) { const int orow = crow(r, hi); const float rl = 1.0f / li_l[orow];
        const size_t tr = (size_t)b * SEQ + (size_t)(((s0 + orow) << dshift) + res); bf16_t* op = OA + tr * 1024 + h * HD;
#pragma unroll
        for (int d0 = 0; d0 < 4; ++d0) { const float v = o[d0][r] * rl; const float vn = shx(v, 1, lane);
            if ((r32 & 1) == 0) *(unsigned*)(op + d0 * 32 + r32) = cvtpk(v, vn); } }
}

__device__ __forceinline__ void nsa_finalize(LAS char* lds, const f32x16 (&o)[4], float l_reg, const bf16_t* P, bf16_t* ON, const float* gb, int b, int g, int tok0, int br, const int wv) {
    using namespace att;
    const int tid = opq_tid(wv), lane = tid & 63, wid = __builtin_amdgcn_readfirstlane(tid >> 6), r32 = lane & 31, hi = lane >> 5;
    LAS float* li_l = (LAS float*)(lds + L_WS) + wid * 64;
    if (hi == 0) li_l[r32] = l_reg;
    LDS_WAIT();
    bf16_t* ONb = ON + (size_t)br * NTOK * 1024;
#pragma unroll
    for (int r = 0; r < 16; ++r) { const int j = r & 3, k = r >> 2; const float lr = li_l[crow(r, hi)]; const float rl = lr > 0.f ? 1.0f / lr : 0.f;
        const size_t tok = (size_t)b * SEQ + tok0 + 2 * k + hi; const int hh = 4 * g + j;
        const float gl = bf2f(P[tok * PC + C_GL + hh * 3 + br]) + gb[hh * 3 + br];
        const float sc = rl * __builtin_amdgcn_rcpf(1.0f + __builtin_amdgcn_exp2f(-gl * LOG2E));
        bf16_t* op = ONb + tok * 1024 + hh * HD;
#pragma unroll
        for (int d0 = 0; d0 < 4; ++d0) { const float v = o[d0][r] * sc; const float vn = shx(v, 1, lane);
            if ((r32 & 1) == 0) *(unsigned*)(op + d0 * 32 + r32) = cvtpk(v, vn); } }
}
__device__ __forceinline__ void nsa_unit(LAS char* lds, const bf16_t* P, const bf16_t* KC, const bf16_t* VC, bf16_t* ON, const float* nsaT, const float* gb, int b, int g, int qi, bool load_tbl, const int wv) {
    using namespace att;
    const int tid = opq_tid(wv), lane = tid & 63, wid = __builtin_amdgcn_readfirstlane(tid >> 6), r32 = lane & 31, hi = lane >> 5;
    LAS float* tbl = (LAS float*)(lds + L_TBL); LAS float* IMP = (LAS float*)(lds + L_IMP); LAS unsigned* SELM = (LAS unsigned*)(lds + L_SELM);
    __syncthreads();
    if (load_tbl) for (int i = tid; i < 4 * TBLS; i += NTHR) tbl[i] = nsaT[(size_t)(4 * g) * TBLS + i];
    const int tok0 = 64 * qi + 8 * wid, tq = tok0 + (r32 >> 2), hd = r32 & 3;
    const bf16_t* Pb = P + (size_t)b * SEQ * PC;
    bf16x8 qr[8];
    { const bf16_t* qp = Pb + (size_t)tq * PC + C_QN + (4 * g + hd) * HD + hi * 8;
#pragma unroll
      for (int d0 = 0; d0 < 8; ++d0) qr[d0] = *(const bf16x8*)(qp + d0 * 16); }
    const bf16_t* KCb = KC + (size_t)(b * 2 + g) * 512 * HD; const bf16_t* VCb = VC + (size_t)(b * 2 + g) * 512 * HD;
    const int ntc = (qi >> 4) + 1, cmax = (tq - 31) >> 4;
    f32x16 o[4]; float m_reg, l_reg;
#pragma unroll
    for (int d0 = 0; d0 < 4; ++d0) o[d0] = f32x16{};
    m_reg = -1e30f; l_reg = 0.f;
    { CmpCfg c; c.Kb = KCb; c.Vb = VCb; c.cmax = cmax; c.hi4 = 4 * hi; c.cfull = (64 * qi - 31) >> 4; attn_tiles(c, lds, qr, o, m_reg, l_reg, 0, ntc, wv); }
    nsa_finalize(lds, o, l_reg, P, ON, gb, b, g, tok0, 0, wv);
    { CmpImpCfg c; c.Kb = KCb; c.cmax = cmax; c.hi4 = 4 * hi; c.mfix = m_reg; c.invl = l_reg > 0.f ? 1.0f / l_reg : 0.f;
#pragma unroll
      for (int d0 = 0; d0 < 4; ++d0) o[d0] = f32x16{};
      float md = 0.f, ld = 0.f; attn_tiles(c, lds, qr, o, md, ld, 0, ntc, wv); }
#pragma unroll
    for (int d0 = 0; d0 < 4; ++d0)
#pragma unroll
        for (int k = 0; k < 4; ++k) IMP[(8 * wid + 2 * k + hi) * 128 + 32 * d0 + r32] = (o[d0][4 * k] + o[d0][4 * k + 1]) + (o[d0][4 * k + 2] + o[d0][4 * k + 3]);
    __syncthreads();
    { const int cur = qi;
#pragma unroll 1
      for (int tl = 8 * wid; tl < 8 * wid + 8; ++tl) {
        const int n0 = lane, n1 = 64 + lane; bool sel0, sel1;
        if (cur <= 15) { sel0 = (n0 <= cur); sel1 = false; }
        else {
            const float v0 = IMP[tl * 128 + n0], v1 = IMP[tl * 128 + n1];
            const unsigned u0 = (n0 >= 1 && n0 <= cur - 2) ? __float_as_uint(v0) + 1u : 0u, u1 = (n1 <= cur - 2) ? __float_as_uint(v1) + 1u : 0u;
            unsigned T = 0u;
#pragma unroll 1
            for (int bit = 30; bit >= 0; --bit) { const unsigned cand = T | (1u << bit);
                const int cnt = __builtin_popcountll(__ballot(u0 >= cand)) + __builtin_popcountll(__ballot(u1 >= cand));
                if (cnt >= 13) T = cand; }
            const bool gt0 = u0 > T, gt1 = u1 > T;
            const int need = 13 - (__builtin_popcountll(__ballot(gt0)) + __builtin_popcountll(__ballot(gt1)));
            const bool eq0 = (u0 == T), eq1 = (u1 == T);
            const unsigned long long m0 = __ballot(eq0), m1 = __ballot(eq1);
            const int pre0 = (int)__builtin_amdgcn_mbcnt_hi((unsigned)(m0 >> 32), __builtin_amdgcn_mbcnt_lo((unsigned)m0, 0u));
            const int pre1 = __builtin_popcountll(m0) + (int)__builtin_amdgcn_mbcnt_hi((unsigned)(m1 >> 32), __builtin_amdgcn_mbcnt_lo((unsigned)m1, 0u));
            sel0 = (n0 == 0 || n0 == cur || n0 == cur - 1) || gt0 || (eq0 && pre0 < need);
            sel1 = (n1 == cur || n1 == cur - 1) || gt1 || (eq1 && pre1 < need);
        }
        const unsigned long long b0 = __ballot(sel0), b1 = __ballot(sel1);
        if (lane == 0) { SELM[tl * 4 + 0] = (unsigned)b0; SELM[tl * 4 + 1] = (unsigned)(b0 >> 32); SELM[tl * 4 + 2] = (unsigned)b1; SELM[tl * 4 + 3] = (unsigned)(b1 >> 32); } } }
    __syncthreads();
    { SlcCfg c; c.Kb = Pb + C_KS + g * HD; c.Vb = Pb + C_VS + g * HD; c.tblh = tbl + hd * TBLS; c.tqm = tq - 4 * hi; c.cur = qi; c.b31 = tbl[hd * TBLS + TBL0 + 1600];
      const int tl = 8 * wid + (r32 >> 2); c.s0 = SELM[tl * 4 + 0]; c.s1 = SELM[tl * 4 + 1]; c.s2 = SELM[tl * 4 + 2]; c.s3 = SELM[tl * 4 + 3];
#pragma unroll
      for (int d0 = 0; d0 < 4; ++d0) o[d0] = f32x16{};
      m_reg = -1e30f; l_reg = 0.f;
      attn_tiles(c, lds, qr, o, m_reg, l_reg, 0, qi + 1, wv); }
    nsa_finalize(lds, o, l_reg, P, ON, gb, b, g, tok0, 1, wv);
    { WinCfg c; c.Kb = Pb + C_KW + g * HD; c.Vb = Pb + C_VW + g * HD; c.tblh = tbl + hd * TBLS; c.tqm = tq - 4 * hi;
#pragma unroll
      for (int d0 = 0; d0 < 4; ++d0) o[d0] = f32x16{};
      m_reg = -1e30f; l_reg = 0.f;
      attn_tiles(c, lds, qr, o, m_reg, l_reg, qi >= 8 ? qi - 8 : 0, qi + 1, wv); }
    nsa_finalize(lds, o, l_reg, P, ON, gb, b, g, tok0, 2, wv);
}

constexpr int LDS_BYTES = 147456;
constexpr int LDS_MISC = 131072;
constexpr int LDS_ARGS = LDS_MISC + 64;
__device__ __forceinline__ unsigned long long arg_u64(LAS unsigned char* lds, int i) {
    const LAS unsigned* p = (const LAS unsigned*)(lds + LDS_ARGS) + 2 * i;
    const unsigned lo = __builtin_amdgcn_readfirstlane(p[0]), hi = __builtin_amdgcn_readfirstlane(p[1]);
    return ((unsigned long long)hi << 32) | lo;
}
#define GAS __attribute__((address_space(1)))
__device__ __forceinline__ const float* arg_in(LAS unsigned char* lds, int i) { return (const float*)(GAS const float*)arg_u64(lds, i); }
__device__ __forceinline__ float* arg_out(LAS unsigned char* lds) { return (float*)(GAS float*)arg_u64(lds, 24); }
__device__ __forceinline__ unsigned char* arg_ws(LAS unsigned char* lds) { return (unsigned char*)(GAS unsigned char*)arg_u64(lds, 25); }
__device__ __forceinline__ int opq_bx() { int b = blockIdx.x; asm volatile("" : "+s"(b)); return b; }
__device__ __forceinline__ int opq_g() { int b = gridDim.x; asm volatile("" : "+s"(b)); return b; }

__device__ __forceinline__ void ph_prologue(LAS unsigned char* lds, const int wv) {
    lds = opq_lds(lds);
    const int tid = opq_tid(wv), lane = tid & 63, wave = __builtin_amdgcn_readfirstlane(tid >> 6), G = opq_g(), bx = opq_bx();
    const int gw = bx * NWAVES + wave, NGW = G * NWAVES;
    unsigned char* ws = arg_ws(lds);
    LAS float* scr = (LAS float*)(lds + wave * 16384);
    constexpr int I_UP = 32 * 176, I_DN = 88 * 64, I_IN = 32 * 177, I_OUT = 32 * 64, I_C1 = 64 * 16, I_Z = 928;
    constexpr int I_FFN = 2 * I_UP + I_DN, I_LAYER = 2 * I_FFN + I_IN + I_OUT + 2 * I_C1 + I_Z;
#pragma unroll 1
    for (int it = gw; it < DEPTH * I_LAYER; it += NGW) {
        const int l = it / I_LAYER; int r = it - l * I_LAYER;
        if (r < 2 * I_FFN) { const int half = r >= I_FFN; r -= half * I_FFN;
            bf16_t* WUP = (bf16_t*)(ws + WS_WUP + (size_t)(l * 2 + half) * SZ_WUP); bf16_t* WDN = (bf16_t*)(ws + WS_WDN + (size_t)(l * 2 + half) * SZ_WDN);
            const float* gn = arg_in(lds, half ? I_F2N : I_F1N) + (size_t)l * DM;
            if (r < I_UP) { transpose_item(arg_in(lds, half ? I_F2W1 : I_F1W1) + (size_t)l * DM * DFF, DM, DFF, WUP, 1, 0, scr, r, lane, gn); continue; } r -= I_UP;
            if (r < I_UP) { transpose_item(arg_in(lds, half ? I_F2W3 : I_F1W3) + (size_t)l * DM * DFF, DM, DFF, WUP, 1, 128, scr, r, lane, gn); continue; } r -= I_UP;
            transpose_item(arg_in(lds, half ? I_F2W2 : I_F1W2) + (size_t)l * DFF * DM, DFF, DM, WDN, 0, 0, scr, r, lane, nullptr); continue; }
        r -= 2 * I_FFN;
        bf16_t* WIN = (bf16_t*)(ws + WS_WIN + (size_t)l * SZ_WIN); bf16_t* WOUT = (bf16_t*)(ws + WS_WOUT + (size_t)l * SZ_WOUT); bf16_t* WC1 = (bf16_t*)(ws + WS_WC1 + (size_t)l * SZ_WC1);
        if (r < I_IN) { transpose_item(arg_in(lds, I_WIN) + (size_t)l * DM * IN_COLS, DM, IN_COLS, WIN, 0, 0, scr, r, lane, arg_in(lds, I_MIXN) + (size_t)l * DM); continue; } r -= I_IN;
        if (r < I_OUT) { transpose_item(arg_in(lds, I_WOUT) + (size_t)l * DM * DM, DM, DM, WOUT, 0, 0, scr, r, lane, nullptr); continue; } r -= I_OUT;
        if (r < I_C1) { transpose_item(arg_in(lds, I_CKW1) + (size_t)l * 4096 * 512, 4096, 512, WC1, 0, 0, scr, r, lane, nullptr); continue; } r -= I_C1;
        if (r < I_C1) { transpose_item(arg_in(lds, I_CVW1) + (size_t)l * 4096 * 512, 4096, 512, WC1, 0, 512, scr, r, lane, nullptr); continue; } r -= I_C1;
        { u32x4* z = (u32x4*)(WIN + (size_t)IN_COLS * DM) + (size_t)r * 64 + lane; unsigned zr = 0u; asm volatile("" : "+v"(zr)); *z = (u32x4){zr, zr, zr, zr}; }
    }
    const float* xs = arg_in(lds, I_X); bf16_t* XB = (bf16_t*)(ws + WS_HB); float* RSTD = (float*)(ws + WS_RSTD);
    for (int m = gw; m < NTOK; m += NGW) {
        const f32x4* xr = (const f32x4*)(xs + (size_t)m * DM) + lane; f32x4 v[8]; float s = 0.f;
#pragma unroll
        for (int j = 0; j < 8; ++j) { v[j] = xr[64 * j]; s += (v[j].x * v[j].x + v[j].y * v[j].y) + (v[j].z * v[j].z + v[j].w * v[j].w); }
        s = wave_sum(s, lane);
        u32x2* o8 = (u32x2*)(XB + (size_t)m * DM) + lane;
#pragma unroll
        for (int j = 0; j < 8; ++j) { u32x2 w; w.x = cvtpk(v[j].x, v[j].y); w.y = cvtpk(v[j].z, v[j].w); o8[64 * j] = w; }
        if (lane == 0) RSTD[m] = 1.0f / sqrtf(s * (1.f / DM) + EPS);
    }
}
__device__ __forceinline__ void ph_rstd(LAS unsigned char* lds, const int wv) {
    lds = opq_lds(lds);
    const int tid = opq_tid(wv), G = opq_g(), bx = opq_bx();
    unsigned char* ws = arg_ws(lds); const float* SSQ = (const float*)(ws + WS_SSQ); float* RSTD = (float*)(ws + WS_RSTD);
    for (int m = bx * NTHR + tid; m < NTOK; m += G * NTHR) { const f32x4* p = (const f32x4*)(SSQ + (size_t)m * 32); f32x4 a = p[0];
#pragma unroll
        for (int j = 1; j < 8; ++j) a = a + p[j];
        RSTD[m] = 1.0f / sqrtf(((a.x + a.y) + (a.z + a.w)) * (1.f / DM) + EPS); }
}
__device__ __forceinline__ void ph_headnorm(LAS unsigned char* lds, int l, const int wv) {
    lds = opq_lds(lds);
    const int tid = opq_tid(wv), lane = tid & 63, wave = __builtin_amdgcn_readfirstlane(tid >> 6), G = opq_g(), bx = opq_bx();
    const int gw = bx * NWAVES + wave, NGW = G * NWAVES;
    unsigned char* ws = arg_ws(lds); bf16_t* HP = (bf16_t*)(ws + WS_HP); bf16_t* ACMP = (bf16_t*)(ws + WS_ACMP);
    const float* qna = arg_in(lds, I_QNA) + l * HD; const float* kna = arg_in(lds, I_KNA) + l * HD; const float* qnn = arg_in(lds, I_QNN) + l * HD; const float* knn = arg_in(lds, I_KNN) + l * HD;
    const float* pos = arg_in(lds, I_POS) + (size_t)l * 32 * HD;
    const int e0 = (lane & 15) * 8;
    for (int m = gw; m < NTOK; m += NGW) {
        bf16_t* prow = HP + (size_t)m * PC;
        int cols[7]; u32x4 wl[7];
#pragma unroll
        for (int ch = 0; ch < 7; ++ch) { cols[ch] = (ch < 2) ? C_QA + ch * 512 + lane * 8 : (ch < 4) ? C_KA + (ch - 2) * 512 + lane * 8 : (ch < 6) ? C_QN + (ch - 4) * 512 + lane * 8 : (lane < 32 ? C_KS + lane * 8 : C_KW + (lane - 32) * 8);
            wl[ch] = *(const u32x4*)(prow + cols[ch]); }
        const u32x4 wcv = *(const u32x4*)(prow + C_KC + lane * 8);
#pragma unroll
        for (int ch = 0; ch < 7; ++ch) {
            const float* gp = (ch < 2) ? qna : (ch < 4) ? kna : (ch < 6) ? qnn : knn; const float sc = (ch < 2 || (ch >= 4 && ch < 6)) ? QSCALE : 1.f;
            const u32x4 w = wl[ch];
            float v[8] = {bflo(w.x), bfhi(w.x), bflo(w.y), bfhi(w.y), bflo(w.z), bfhi(w.z), bflo(w.w), bfhi(w.w)};
            float s = 0.f;
#pragma unroll
            for (int i = 0; i < 8; ++i) s += v[i] * v[i];
            s += shx(s, 1, lane); s += shx(s, 2, lane); s += shx(s, 4, lane); s += shx(s, 8, lane);
            const float rs = sc / sqrtf(s * (1.f / HD) + EPS);
            const f32x4 g0 = *(const f32x4*)(gp + e0), g1 = *(const f32x4*)(gp + e0 + 4);
            u32x4 o; o.x = cvtpk(v[0] * rs * g0.x, v[1] * rs * g0.y); o.y = cvtpk(v[2] * rs * g0.z, v[3] * rs * g0.w); o.z = cvtpk(v[4] * rs * g1.x, v[5] * rs * g1.y); o.w = cvtpk(v[6] * rs * g1.z, v[7] * rs * g1.w);
            *(u32x4*)(prow + cols[ch]) = o;
        }
        { const int b = m / SEQ, t = m % SEQ, kv = lane >> 5, gg = (lane >> 4) & 1, c1 = t >> 4, j1 = t & 15;
          const u32x4 w = wcv;
          const float v[8] = {bflo(w.x), bfhi(w.x), bflo(w.y), bfhi(w.y), bflo(w.z), bfhi(w.z), bflo(w.w), bfhi(w.w)};
          bf16_t* abase = ACMP + ((size_t)kv * 4096 + (size_t)(b * 2 + gg) * 512) * 4096 + e0;
          if (c1 <= 510) { const f32x4 p0 = *(const f32x4*)(pos + j1 * HD + e0), p1 = *(const f32x4*)(pos + j1 * HD + e0 + 4);
              u32x4 o; o.x = cvtpk(v[0] + p0.x, v[1] + p0.y); o.y = cvtpk(v[2] + p0.z, v[3] + p0.w); o.z = cvtpk(v[4] + p1.x, v[5] + p1.y); o.w = cvtpk(v[6] + p1.z, v[7] + p1.w);
              *(u32x4*)(abase + (size_t)c1 * 4096 + j1 * HD) = o; }
          else { const u32x4 z = {0u, 0u, 0u, 0u}; *(u32x4*)(abase + (size_t)511 * 4096 + j1 * HD) = z; *(u32x4*)(abase + (size_t)511 * 4096 + (j1 + 16) * HD) = z; }
          if (c1 >= 1) { const int j2 = j1 + 16; const f32x4 p0 = *(const f32x4*)(pos + j2 * HD + e0), p1 = *(const f32x4*)(pos + j2 * HD + e0 + 4);
              u32x4 o; o.x = cvtpk(v[0] + p0.x, v[1] + p0.y); o.y = cvtpk(v[2] + p0.z, v[3] + p0.w); o.z = cvtpk(v[4] + p1.x, v[5] + p1.y); o.w = cvtpk(v[6] + p1.z, v[7] + p1.w);
              *(u32x4*)(abase + (size_t)(c1 - 1) * 4096 + j2 * HD) = o; } }
    }
}
__device__ __forceinline__ void ph_cmp2(LAS unsigned char* lds, int l, const int wv) {
    lds = opq_lds(lds);
    const int tid = opq_tid(wv), lane = tid & 63, wave = __builtin_amdgcn_readfirstlane(tid >> 6), G = opq_g(), bx = opq_bx();
    unsigned char* ws = arg_ws(lds); const float* CP = (const float*)(ws + WS_CP); bf16_t* KC = (bf16_t*)(ws + WS_KC); bf16_t* VC = (bf16_t*)(ws + WS_VC);
    LAS float* CH = (LAS float*)lds;
    LAS float* RED = (LAS float*)(lds + 32768);
    const float* knn = arg_in(lds, I_KNN) + l * HD;
    for (int it = bx; it < 512; it += G) {
        const int R0 = it * 16, kv = R0 >> 12, rl0 = R0 & 4095;
        __syncthreads();
        for (int idx = tid; idx < 16 * 512; idx += NTHR) { const int rr = idx >> 9, k = idx & 511; float v = 0.f;
#pragma unroll
            for (int ks = 0; ks < 4; ++ks) v += CP[((size_t)(kv * 4 + ks) * 4096 + rl0 + rr) * 512 + k];
            const float u3 = 0.7978845608028654f * (v + 0.044715f * v * v * v);
            const float th = 1.0f - 2.0f / (__expf(2.0f * u3) + 1.0f);
            CH[idx] = 0.5f * v * (1.0f + th); }
        __syncthreads();
        const int n = tid & 127, rq = tid >> 7;
        const float* w2 = arg_in(lds, kv ? I_CVW2 : I_CKW2) + (size_t)l * 512 * HD + n;
        float acc[4] = {0.f, 0.f, 0.f, 0.f};
#pragma unroll 16
        for (int k = 0; k < 512; ++k) { const float w = w2[(size_t)k * HD];
#pragma unroll
            for (int i = 0; i < 4; ++i) acc[i] += CH[(rq * 4 + i) * 512 + k] * w; }
        if (kv == 0) {
            float ss[4];
#pragma unroll
            for (int i = 0; i < 4; ++i) ss[i] = wave_sum(acc[i] * acc[i], lane);
            if (lane == 0) {
#pragma unroll
                for (int i = 0; i < 4; ++i) RED[wave * 4 + i] = ss[i]; }
            __syncthreads();
            const float gn = knn[n];
#pragma unroll
            for (int i = 0; i < 4; ++i) { const float tot = RED[(2 * rq) * 4 + i] + RED[(2 * rq + 1) * 4 + i]; acc[i] = acc[i] / sqrtf(tot * (1.f / HD) + EPS) * gn; }
        }
        bf16_t* dst = (bf16_t*)(ws + (kv ? WS_VC + 0 : WS_KC + 0)) + (size_t)(rl0 + rq * 4) * HD + n;
#pragma unroll
        for (int i = 0; i < 4; ++i) dst[(size_t)i * HD] = (bf16_t)f2bf(acc[i]);
    }
}
__device__ __forceinline__ void ph_outnorm(LAS unsigned char* lds, int l, const int wv) {
    lds = opq_lds(lds);
    const int tid = opq_tid(wv), lane = tid & 63, wave = __builtin_amdgcn_readfirstlane(tid >> 6), G = opq_g(), bx = opq_bx();
    const int gw = bx * NWAVES + wave, NGW = G * NWAVES;
    unsigned char* ws = arg_ws(lds); const bf16_t* OA = (const bf16_t*)(ws + WS_OA); const bf16_t* ON = (const bf16_t*)(ws + WS_ON); bf16_t* HB = (bf16_t*)(ws + WS_HP);
    const float* gn = arg_in(lds, I_ON) + (size_t)l * DM;
    for (int m = gw; m < NTOK; m += NGW) {
        const bf16_t* oa = OA + (size_t)m * 1024; bf16_t* y = HB + (size_t)m * DM;
        const u32x4 wa = *(const u32x4*)(oa + lane * 8), wb = *(const u32x4*)(oa + 512 + lane * 8);
        u32x4 wn[6];
#pragma unroll
        for (int br = 0; br < 3; ++br) { const bf16_t* onb = ON + ((size_t)br * NTOK + m) * 1024; wn[2 * br] = *(const u32x4*)(onb + lane * 8); wn[2 * br + 1] = *(const u32x4*)(onb + 512 + lane * 8); }
        float va[16] = {bflo(wa.x), bfhi(wa.x), bflo(wa.y), bfhi(wa.y), bflo(wa.z), bfhi(wa.z), bflo(wa.w), bfhi(wa.w), bflo(wb.x), bfhi(wb.x), bflo(wb.y), bfhi(wb.y), bflo(wb.z), bfhi(wb.z), bflo(wb.w), bfhi(wb.w)};
        float sa = 0.f;
#pragma unroll
        for (int i = 0; i < 16; ++i) sa += va[i] * va[i];
        float vs[16]; float sn = 0.f;
#pragma unroll
        for (int i = 0; i < 16; ++i) vs[i] = 0.f;
#pragma unroll
        for (int br = 0; br < 3; ++br) { const u32x4 wc = wn[2 * br], wd = wn[2 * br + 1];
            vs[0] += bflo(wc.x); vs[1] += bfhi(wc.x); vs[2] += bflo(wc.y); vs[3] += bfhi(wc.y); vs[4] += bflo(wc.z); vs[5] += bfhi(wc.z); vs[6] += bflo(wc.w); vs[7] += bfhi(wc.w);
            vs[8] += bflo(wd.x); vs[9] += bfhi(wd.x); vs[10] += bflo(wd.y); vs[11] += bfhi(wd.y); vs[12] += bflo(wd.z); vs[13] += bfhi(wd.z); vs[14] += bflo(wd.w); vs[15] += bfhi(wd.w); }
        const float ra = 1.0f / sqrtf(wave_sum(sa, lane) * (1.f / 1024.f) + EPS);
        { const f32x4 g0 = *(const f32x4*)(gn + lane * 8), g1 = *(const f32x4*)(gn + lane * 8 + 4), g2 = *(const f32x4*)(gn + 512 + lane * 8), g3 = *(const f32x4*)(gn + 512 + lane * 8 + 4);
          u32x4 o; o.x = cvtpk(va[0] * ra * g0.x, va[1] * ra * g0.y); o.y = cvtpk(va[2] * ra * g0.z, va[3] * ra * g0.w); o.z = cvtpk(va[4] * ra * g1.x, va[5] * ra * g1.y); o.w = cvtpk(va[6] * ra * g1.z, va[7] * ra * g1.w);
          *(u32x4*)(y + lane * 8) = o;
          o.x = cvtpk(va[8] * ra * g2.x, va[9] * ra * g2.y); o.y = cvtpk(va[10] * ra * g2.z, va[11] * ra * g2.w); o.z = cvtpk(va[12] * ra * g3.x, va[13] * ra * g3.y); o.w = cvtpk(va[14] * ra * g3.z, va[15] * ra * g3.w);
          *(u32x4*)(y + 512 + lane * 8) = o; }
#pragma unroll
        for (int i = 0; i < 16; ++i) sn += vs[i] * vs[i];
        const float rn = 1.0f / sqrtf(wave_sum(sn, lane) * (1.f / 1024.f) + EPS);
        { const float* g2 = gn + 1024; const f32x4 g0 = *(const f32x4*)(g2 + lane * 8), g1 = *(const f32x4*)(g2 + lane * 8 + 4), g2a = *(const f32x4*)(g2 + 512 + lane * 8), g3 = *(const f32x4*)(g2 + 512 + lane * 8 + 4);
          u32x4 o; o.x = cvtpk(vs[0] * rn * g0.x, vs[1] * rn * g0.y); o.y = cvtpk(vs[2] * rn * g0.z, vs[3] * rn * g0.w); o.z = cvtpk(vs[4] * rn * g1.x, vs[5] * rn * g1.y); o.w = cvtpk(vs[6] * rn * g1.z, vs[7] * rn * g1.w);
          *(u32x4*)(y + 1024 + lane * 8) = o;
          o.x = cvtpk(vs[8] * rn * g2a.x, vs[9] * rn * g2a.y); o.y = cvtpk(vs[10] * rn * g2a.z, vs[11] * rn * g2a.w); o.z = cvtpk(vs[12] * rn * g3.x, vs[13] * rn * g3.y); o.w = cvtpk(vs[14] * rn * g3.z, vs[15] * rn * g3.w);
          *(u32x4*)(y + 1536 + lane * 8) = o; }
    }
}

#define GRID_BAR() xcd_barrier(bar, wv)
__global__ void __launch_bounds__(NTHR, 2) mega_fwd(Args a) {
    extern __shared__ __attribute__((aligned(16))) unsigned char lds_raw[];
    LAS unsigned char* lds = (LAS unsigned char*)lds_raw;
    const int wv = __builtin_amdgcn_readfirstlane((int)threadIdx.x >> 6);
    {
        const int tid = threadIdx.x;
        for (int u = tid; u < (LDS_BYTES - LDS_MISC) / 4; u += NTHR) ((LAS unsigned*)(lds + LDS_MISC))[u] = 0u;
        __syncthreads();
        if (tid == 0) { LAS unsigned long long* t = (LAS unsigned long long*)(lds + LDS_ARGS);
#pragma unroll
            for (int i = 0; i < 24; ++i) t[i] = (unsigned long long)(uintptr_t)a.in[i];
            t[24] = (unsigned long long)(uintptr_t)a.out; t[25] = (unsigned long long)(uintptr_t)a.ws; }
        __syncthreads();
    }
    XcdBarrier bar = xcd_barrier_post((unsigned*)(arg_ws(lds) + WS_CTL) + CW_BAR, (volatile LAS unsigned*)(lds + LDS_MISC + 32));

    { const int tid = opq_tid(wv), G = opq_g(), bx = opq_bx(); const float* rb = arg_in(lds, I_RB); unsigned char* ws = arg_ws(lds);
      float* dilT = (float*)(ws + WS_TBL); float* nsaT = (float*)(ws + WS_TBL + 65536);
      for (int i = bx * NTHR + tid; i < 3 * 8 * DTS + 8 * TBLS; i += G * NTHR) {
          if (i < 3 * 8 * DTS) { const int p = i / (8 * DTS), h = (i / DTS) % 8, df = i % DTS - DT0; const int d = (p == 0) ? 1 : (p == 1 ? 4 : 16);
              dilT[i] = (df >= 0 && df <= 128) ? rb[rel_bucket_dev(df * d) * 16 + h] : 0.f; }
          else { const int j = i - 3 * 8 * DTS, hh = j / TBLS, ds = j % TBLS - TBL0; nsaT[j] = (ds >= 0) ? rb[rel_bucket_dev(ds) * 16 + 8 + hh] : 0.f; } } }

    ph_prologue(lds, wv);
    GRID_BAR();
#pragma unroll 1
    for (int step = 0; step < 2 * DEPTH; ++step) {
        const int l = step >> 1, half = step & 1;
#if PH_FFN
        { unsigned char* ws = arg_ws(lds); const int G = opq_g(), bx = opq_bx();
          pg8::Gemm g{DM, DM, DM}; pg8::SchedStd S; S.init(ws + WS_HB, ws + WS_WUP + (size_t)step * SZ_WUP, NTOK, 2 * DFF, DM, DM, G, bx); const pg8::EpiSwiGLU E{(bf16_t*)(ws + WS_HP), DFF, (const float*)(ws + WS_RSTD)};
          pg8::gemm_phase<pg8::EpiSwiGLU, pg8::SchedStd>(opq_lds(lds), g, S, E, wv);
#if DUP_UP
          GRID_BAR(); pg8::gemm_phase<pg8::EpiSwiGLU, pg8::SchedStd>(opq_lds(lds), g, S, E, wv);
#endif
        }
        GRID_BAR();
        { unsigned char* ws = arg_ws(lds); const int G = opq_g(), bx = opq_bx(); float* X = arg_out(lds);
          pg8::Gemm g{DFF, DFF, DFF}; pg8::SchedStd S; S.init(ws + WS_HP, ws + WS_WDN + (size_t)step * SZ_WDN, NTOK, DM, DFF, DFF, G, bx);
          pg8::EpiResid E{(step == 0) ? arg_in(lds, I_X) : (const float*)X, X, (bf16_t*)(ws + WS_HB), (float*)(ws + WS_SSQ), DM, 0.5f};
          pg8::gemm_phase<pg8::EpiResid, pg8::SchedStd>(opq_lds(lds), g, S, E, wv);
#if DUP_DN
          { GRID_BAR(); const pg8::EpiResid E2{X, X, (bf16_t*)(ws + WS_HB), (float*)(ws + WS_SSQ), DM, 0.f}; pg8::gemm_phase<pg8::EpiResid, pg8::SchedStd>(opq_lds(lds), g, S, E2, wv); }
#endif
        }
#endif
        GRID_BAR();
        ph_rstd(lds, wv);
        GRID_BAR();
        if (half == 0) {
#if PH_INP
            { unsigned char* ws = arg_ws(lds); const int G = opq_g(), bx = opq_bx();
              pg8::Gemm g{DM, DM, DM}; pg8::SchedStd S; S.init(ws + WS_HB, ws + WS_WIN + (size_t)l * SZ_WIN, NTOK, PC, DM, DM, G, bx); const pg8::EpiBf16 E{(bf16_t*)(ws + WS_HP), PC, (const float*)(ws + WS_RSTD)};
              pg8::gemm_phase<pg8::EpiBf16, pg8::SchedStd>(opq_lds(lds), g, S, E, wv);
#if DUP_IN
              GRID_BAR(); pg8::gemm_phase<pg8::EpiBf16, pg8::SchedStd>(opq_lds(lds), g, S, E, wv);
#endif
            }
#endif
            GRID_BAR();
            ph_headnorm(lds, l, wv);
            GRID_BAR();
#pragma unroll 1
            for (int pat3 = 0; pat3 < 3 * (1 + DUP_DIL); ++pat3) { const int pat = pat3 % 3;
#if PH_CMP
                if (pat3 == 0) { unsigned char* ws = arg_ws(lds); const int G = opq_g(), bx = opq_bx();
                  pg8::Gemm g{4096, 4096, 1024}; pg8::SchedCmp S; S.A = (const char*)(ws + WS_ACMP); S.Bt = (const char*)(ws + WS_WC1 + (size_t)l * SZ_WC1); S.G = G; S.c = bx; pg8::EpiF32Z E{(float*)(ws + WS_CP), 512, (size_t)4096 * 512};
                  pg8::gemm_phase<pg8::EpiF32Z, pg8::SchedCmp>(opq_lds(lds), g, S, E, wv); }
#endif
                if (pat3 == 1) ph_cmp2(lds, l, wv);
#if PH_DIL
                { unsigned char* ws = arg_ws(lds); const int G = opq_g(), bx = opq_bx();
                  for (int u0 = bx; u0 < 1024; u0 += G) { const int w_ = u0 & 255, k_ = u0 >> 8; const int unit = (((w_ & 7) + 8 * k_) << 5) | (w_ >> 3);
                    dil_unit((LAS char*)opq_lds(lds), (const bf16_t*)(ws + WS_HP), (bf16_t*)(ws + WS_OA), (float*)(ws + WS_LSE), (const float*)(ws + WS_TBL), pat, 2 * pat, unit, wv); } }
#endif
                if (pat3 + 1 < 3 * (1 + DUP_DIL)) GRID_BAR();
            }
#if PH_NSA
            { unsigned char* ws = arg_ws(lds); const int G = opq_g(), bx = opq_bx();
              const float* gb = arg_in(lds, I_GB) + l * 24;
              int last_bg = -1;
#pragma unroll 1
              for (int i4 = 0; i4 < 4 * (1 + DUP_NSA); ++i4)
#pragma unroll 1
                  for (int w = bx; w < 256; w += G) { const int i = i4 & 3; const int bg = w & 7, j = w >> 3;
                      const int qi = (i == 0) ? 127 - j : (i == 1 ? j : (i == 2 ? 64 + j : 63 - j));
                      nsa_unit((LAS char*)opq_lds(lds), (const bf16_t*)(ws + WS_HP), (const bf16_t*)(ws + WS_KC), (const bf16_t*)(ws + WS_VC), (bf16_t*)(ws + WS_ON), (const float*)(ws + WS_TBL + 65536), gb, bg >> 1, bg & 1, qi, bg != last_bg, wv); last_bg = bg; } }
#endif
            GRID_BAR();
            ph_outnorm(lds, l, wv);
            GRID_BAR();
#if PH_OUT
            { unsigned char* ws = arg_ws(lds); const int G = opq_g(), bx = opq_bx(); float* X = arg_out(lds);
              pg8::Gemm g{DM, DM, DM}; pg8::SchedStd S; S.init(ws + WS_HP, ws + WS_WOUT + (size_t)l * SZ_WOUT, NTOK, DM, DM, DM, G, bx); pg8::EpiResid E{X, X, (bf16_t*)(ws + WS_HB), (float*)(ws + WS_SSQ), DM, 1.0f};
              pg8::gemm_phase<pg8::EpiResid, pg8::SchedStd>(opq_lds(lds), g, S, E, wv);
#if DUP_OUT
              { GRID_BAR(); const pg8::EpiResid E2{X, X, (bf16_t*)(ws + WS_HB), (float*)(ws + WS_SSQ), DM, 0.f}; pg8::gemm_phase<pg8::EpiResid, pg8::SchedStd>(opq_lds(lds), g, S, E2, wv); }
#endif
            }
#endif
            GRID_BAR();
            ph_rstd(lds, wv);
            GRID_BAR();
        }
    }
}

extern "C" void kernel_launch(void* const* d_in, const int* in_sizes, int n_in, void* d_out, int out_size, void* d_ws, size_t ws_size, hipStream_t stream) {
    static int grid = 0;
    if (grid == 0) {
        if (n_in != 24 || in_sizes[0] != NTOK * DM || out_size != NTOK * DM || ws_size < WS_END) { fprintf(stderr, "kernel_launch: shape mismatch n_in %d in0 %d out %d ws %zu (need %zu)\n", n_in, n_in > 0 ? in_sizes[0] : -1, out_size, ws_size, (size_t)WS_END); grid = -1; return; }
        int dev = 0, cus = 0, per_cu = 0;
        if (hipGetDevice(&dev) != hipSuccess || hipDeviceGetAttribute(&cus, hipDeviceAttributeMultiprocessorCount, dev) != hipSuccess) { grid = -1; return; }
        if (hipFuncSetAttribute((const void*)mega_fwd, hipFuncAttributeMaxDynamicSharedMemorySize, LDS_BYTES) != hipSuccess) { fprintf(stderr, "kernel_launch: hipFuncSetAttribute failed\n"); grid = -1; return; }
        if (hipOccupancyMaxActiveBlocksPerMultiprocessor(&per_cu, (const void*)mega_fwd, NTHR, LDS_BYTES) != hipSuccess || per_cu < 1) { fprintf(stderr, "kernel_launch: occupancy query says %d\n", per_cu); (void)hipGetLastError(); if (per_cu < 1) { grid = -1; return; } }
        grid = cus;
    }
    if (grid < 0) return;
    if (hipMemsetAsync((char*)d_ws + WS_CTL, 0, CTL_ZERO_BYTES, stream) != hipSuccess) return;
    Args a{};
    for (int i = 0; i < 24; ++i) a.in[i] = (const float*)d_in[i];
    a.out = (float*)d_out; a.ws = (unsigned char*)d_ws;
    hipLaunchKernelGGL(mega_fwd, dim3(grid), dim3(NTHR), LDS_BYTES, stream, a);
    const hipError_t le = hipPeekAtLastError();
    if (le != hipSuccess) fprintf(stderr, "kernel_launch: launch failed: %s\n", hipGetErrorName(le));
}
```

```cpp
#include <hip/hip_runtime.h>
#include <cstdio>
#include <cstdint>

#define LAS __attribute__((address_space(3)))
typedef unsigned short bf16_t;
typedef short bf16x8 __attribute__((ext_vector_type(8)));
typedef short s16x4 __attribute__((ext_vector_type(4)));
typedef float f32x2 __attribute__((ext_vector_type(2)));
typedef float f32x4 __attribute__((ext_vector_type(4)));
typedef float f32x16 __attribute__((ext_vector_type(16)));
typedef unsigned u32x2 __attribute__((ext_vector_type(2)));
typedef unsigned u32x4 __attribute__((ext_vector_type(4)));

#ifndef DUP_UP
#define DUP_UP 0
#endif
#ifndef DUP_DN
#define DUP_DN 0
#endif
#ifndef DUP_IN
#define DUP_IN 0
#endif
#ifndef DUP_OUT
#define DUP_OUT 0
#endif
#ifndef DUP_NSA
#define DUP_NSA 0
#endif
#ifndef DUP_DIL
#define DUP_DIL 0
#endif
#ifndef PH_FFN
#define PH_FFN 1
#endif
#ifndef PH_INP
#define PH_INP 1
#endif
#ifndef PH_CMP
#define PH_CMP 1
#endif
#ifndef PH_DIL
#define PH_DIL 1
#endif
#ifndef PH_NSA
#define PH_NSA 1
#endif
#ifndef PH_OUT
#define PH_OUT 1
#endif
constexpr int BATCH = 4, SEQ = 8192, DM = 2048, DFF = 5632, NTOK = BATCH * SEQ, DEPTH = 4, HD = 128;
constexpr int IN_COLS = 5656, PC = 5888;
constexpr int C_QA = 0, C_KA = 1024, C_VA = 2048, C_QN = 3072, C_KC = 4096, C_VC = 4352, C_KS = 4608, C_VS = 4864, C_KW = 5120, C_VW = 5376, C_GL = 5632;
constexpr float EPS = 1e-6f, QSCALE = 0.08838834764831845f, LOG2E = 1.4426950408889634f;
constexpr int TBLS = 1704, TBL0 = 64;
constexpr int DTS = 320, DT0 = 96;
constexpr int NWAVES = 8, NTHR = 512;

constexpr size_t MiB = 1u << 20;
constexpr size_t WS_CTL = 0, CTL_ZERO_BYTES = 1 * MiB;
constexpr size_t WS_TBL = 1 * MiB;
constexpr size_t SZ_WUP = 44 * MiB, SZ_WDN = 22 * MiB, SZ_WIN = 23 * MiB, SZ_WOUT = 8 * MiB, SZ_WC1 = 8 * MiB;
constexpr size_t WS_WUP = 2 * MiB;
constexpr size_t WS_WDN = WS_WUP + 8 * SZ_WUP;
constexpr size_t WS_WIN = WS_WDN + 8 * SZ_WDN;
constexpr size_t WS_WOUT = WS_WIN + 4 * SZ_WIN;
constexpr size_t WS_WC1 = WS_WOUT + 4 * SZ_WOUT;
constexpr size_t WS_HB = WS_WC1 + 4 * SZ_WC1;
constexpr size_t WS_HP = WS_HB + 128 * MiB;
constexpr size_t WS_OA = WS_HP + 368 * MiB;
constexpr size_t WS_LSE = WS_OA + 64 * MiB;
constexpr size_t WS_ON = WS_LSE + 1 * MiB;
constexpr size_t WS_ACMP = WS_ON + 192 * MiB;
constexpr size_t WS_CP = WS_ACMP + 64 * MiB;
constexpr size_t WS_KC = WS_CP + 64 * MiB;
constexpr size_t WS_VC = WS_KC + 1 * MiB;
constexpr size_t WS_SSQ = WS_VC + 1 * MiB;
constexpr size_t WS_RSTD = WS_SSQ + 4 * MiB;
constexpr size_t WS_END = WS_RSTD + 1 * MiB;
constexpr int CW_BAR = 4096;

__device__ __forceinline__ unsigned f2bf(float f) { unsigned u = __builtin_bit_cast(unsigned, f); return (u + 0x7fffu + ((u >> 16) & 1u)) >> 16; }
__device__ __forceinline__ unsigned pk2(float lo, float hi) { return f2bf(lo) | (f2bf(hi) << 16); }
__device__ __forceinline__ float bf2f(bf16_t b) { return __builtin_bit_cast(float, ((unsigned)b) << 16); }
__device__ __forceinline__ float bflo(unsigned w) { return __builtin_bit_cast(float, w << 16); }
__device__ __forceinline__ float bfhi(unsigned w) { return __builtin_bit_cast(float, w & 0xffff0000u); }
__device__ __forceinline__ unsigned cvtpk(float lo, float hi) { unsigned r; asm volatile("v_cvt_pk_bf16_f32 %0, %1, %2" : "=v"(r) : "v"(lo), "v"(hi)); return r; }
__device__ __forceinline__ float shx(float v, int m, int lane) { return __builtin_bit_cast(float, __builtin_amdgcn_ds_bpermute((lane ^ m) << 2, __builtin_bit_cast(int, v))); }
__device__ __forceinline__ float wave_sum(float v, int lane) {
#pragma unroll
    for (int o = 1; o < 64; o <<= 1) v += shx(v, o, lane);
    return v;
}
__device__ __forceinline__ LAS unsigned char* opq_lds(LAS unsigned char* p) { unsigned a = (unsigned)(uintptr_t)p; asm volatile("" : "+s"(a)); return (LAS unsigned char*)(uintptr_t)a; }
__device__ __forceinline__ int opq_tid(int wv) { int l; asm volatile("v_mbcnt_lo_u32_b32 %0, -1, 0\n\tv_mbcnt_hi_u32_b32 %0, -1, %0" : "=v"(l)); return wv * 64 + l; }
#define LDS_WAIT() asm volatile("s_waitcnt lgkmcnt(0)" ::: "memory")
#define VM_WAIT() asm volatile("s_waitcnt vmcnt(0)" ::: "memory")
#define SBAR() __builtin_amdgcn_sched_barrier(0)

#define XB_TMO      128
#define XB_XCNT(j)  (256  + 64 * (j))
#define XB_XSUB(j)  (1280 + 64 * (j))
#define XB_XGEN(j)  (2304 + 64 * (j))
#define XB_TOP      3328
#define XB_TOPGEN   3392
#define XCD_BAR_WORDS 3456
#define XB_SPIN_CAP (1u << 18)
__device__ __forceinline__ unsigned xb_ld(unsigned* p)              { return __hip_atomic_load(p, __ATOMIC_RELAXED, __HIP_MEMORY_SCOPE_AGENT); }
__device__ __forceinline__ unsigned xb_add(unsigned* p, unsigned v) { return __hip_atomic_fetch_add(p, v, __ATOMIC_RELAXED, __HIP_MEMORY_SCOPE_AGENT); }
__device__ __forceinline__ unsigned xb_xcc_id() { return (unsigned)__builtin_amdgcn_s_getreg((3 << 11) | 20) & 0xFu; }
#define XB_SPIN(cond, bar) do { unsigned _sp = 0; while (cond) { __builtin_amdgcn_s_sleep(1); \
    if ((++_sp & 255u) == 0u) { if (xb_ld(&(bar)[XB_TMO])) break; if (_sp > XB_SPIN_CAP) { atomicAdd(&(bar)[XB_TMO], 1u); break; } } } } while (0)
struct XcdBarrier { unsigned* bar; unsigned x; volatile LAS unsigned* st; };
__device__ __forceinline__ XcdBarrier xcd_barrier_post(unsigned* bar, volatile LAS unsigned* st) {
    XcdBarrier b; b.bar = bar; b.x = xb_xcc_id(); b.st = st;
    if (threadIdx.x == 0) (void)xb_add(&bar[XB_XCNT(b.x)], 1u);
    return b;
}
__device__ __forceinline__ void xcd_barrier_complete(unsigned* bar, unsigned x, unsigned& nloc, unsigned& nx) {
    const unsigned G = gridDim.x * gridDim.y * gridDim.z;
    unsigned sum, cnt, mine, sp = 0u;
    for (;;) {
        sum = 0u; cnt = 0u; mine = 0u;
#pragma unroll
        for (unsigned j = 0; j < 16; ++j) { const unsigned c = xb_ld(&bar[XB_XCNT(j)]); sum += c; cnt += (c > 0u) ? 1u : 0u; mine = (j == x) ? c : mine; }
        if (sum == G) break;
        __builtin_amdgcn_s_sleep(1);
        if ((++sp & 255u) == 0u) { if (xb_ld(&bar[XB_TMO])) break; if (sp > XB_SPIN_CAP) { atomicAdd(&bar[XB_TMO], 1u); break; } }
    }
    nloc = mine > 0u ? mine : 1u; nx = cnt > 0u ? cnt : 1u;
}
__device__ __forceinline__ void xcd_barrier(const XcdBarrier& b, const int wv) {
    asm volatile("s_waitcnt vmcnt(0)" ::: "memory");
    __syncthreads();
    if (opq_tid(wv) == 0) {
        unsigned* bar = b.bar; asm volatile("" : "+s"(bar));
        __builtin_amdgcn_s_waitcnt(0);
        unsigned nloc = b.st[0], nx = b.st[1];
        if (nloc == 0u) { xcd_barrier_complete(bar, b.x, nloc, nx); b.st[0] = nloc; b.st[1] = nx; }
        const unsigned old = xb_add(&bar[XB_XSUB(b.x)], 1u);
        const unsigned gen = old / nloc;
        if (old + 1u == (gen + 1u) * nloc) {
            __builtin_amdgcn_fence(__ATOMIC_RELEASE, "agent");
            asm volatile("s_waitcnt vmcnt(0)" ::: "memory");
            const unsigned og = xb_add(&bar[XB_TOP], 1u);
            const unsigned tg = og / nx;
            if (og + 1u == (tg + 1u) * nx) xb_add(&bar[XB_TOPGEN], 1u);
            else XB_SPIN(xb_ld(&bar[XB_TOPGEN]) == tg, bar);
            __builtin_amdgcn_fence(__ATOMIC_ACQUIRE, "agent");
            xb_add(&bar[XB_XGEN(b.x)], 1u);
            asm volatile("s_waitcnt vmcnt(0)" ::: "memory");
        } else {
            XB_SPIN(xb_ld(&bar[XB_XGEN(b.x)]) == gen, bar);
            __builtin_amdgcn_fence(__ATOMIC_ACQUIRE, "agent");
            asm volatile("s_waitcnt vmcnt(0)" ::: "memory");
        }
    }
    __syncthreads();
}

namespace pg8 {
constexpr int BM = 256, BK = 64, HALF = 128, HTB = HALF * BK * 2, STAGE_BYTES = 8 * HTB, NXCD = 8, WGM = 8;
__host__ __device__ __forceinline__ int lds_byte(int r, int c) { const int st = (r >> 4) * 2 + (c >> 5), rr = r & 15, cc = c & 31, ob = rr * 64 + cc * 2; return st * 1024 + (ob ^ (((ob >> 9) & 1) << 5)); }
__host__ __device__ __forceinline__ void stage_rc(int b, int& R, int& C) { const int st = b / 1024, sb = b % 1024, swz = sb ^ (((sb >> 9) & 1) << 5); R = (st >> 1) * 16 + swz / 64; C = (st & 1) * 32 + (swz % 64) / 2; }
__host__ __device__ __forceinline__ int perm32(int rho) { const int n = rho >> 4, i = rho & 15; return 8 * (i >> 2) + 4 * n + (i & 3); }
struct Unit { int pm, pn, z; };
struct Gemm { int lda, ldb, K; };
struct SchedStd {
    const char* A; const char* Bt; size_t atile, btile; int nM, nN, nwg, G, c;
    __device__ __forceinline__ void init(const void* A_, const void* Bt_, int M, int N, int lda, int ldb, int G_, int c_) {
        A = (const char*)A_; Bt = (const char*)Bt_; atile = (size_t)BM * lda * 2; btile = (size_t)BM * ldb * 2; nM = M / BM; nN = N / BM; nwg = nM * nN; G = G_; c = c_; }
    __device__ __forceinline__ bool next(int i, Unit& u) const {
        const long L = (long)i * G + c; if (L >= nwg) return false;
        int wgid = (int)L; { const int q = nwg / NXCD, r = nwg % NXCD, xcd = wgid % NXCD, off = wgid / NXCD; wgid = (xcd < r ? xcd * (q + 1) : r * (q + 1) + (xcd - r) * q) + off; }
        const int nig = WGM * nN, gid = wgid / nig, fm = gid * WGM, gsz = (nM - fm) < WGM ? (nM - fm) : WGM;
        u.pm = fm + ((wgid % nig) % gsz); u.pn = (wgid % nig) / gsz; u.z = 0; return true;
    }
    __device__ __forceinline__ const char* a_ptr(const Unit& u) const { return A + (size_t)u.pm * atile; }
    __device__ __forceinline__ const char* b_ptr(const Unit& u) const { return Bt + (size_t)u.pn * btile; }
};
struct SchedCmp {
    const char* A; const char* Bt; int G, c;
    __device__ __forceinline__ bool next(int i, Unit& u) const { const int L = i * G + c; if (L >= 256) return false; u.z = L >> 5; u.pm = (L & 31) >> 1; u.pn = L & 1; return true; }
    __device__ __forceinline__ const char* a_ptr(const Unit& u) const { const int kv = u.z >> 2, ks = u.z & 3; return A + ((size_t)(kv * 4096 + u.pm * 256) * 4096 + (size_t)ks * 1024) * 2; }
    __device__ __forceinline__ const char* b_ptr(const Unit& u) const { const int kv = u.z >> 2, ks = u.z & 3; return Bt + ((size_t)(kv * 512 + u.pn * 256) * 4096 + (size_t)ks * 1024) * 2; }
};
struct EpiBf16 {
    static constexpr bool PERM = true;
    bf16_t* O; int ldc; const float* rstd;
    __device__ __forceinline__ void prefetch(float (&pre)[8], const Unit& u, int wr, int fr) const {
#pragma unroll
        for (int i = 0; i < 8; ++i) pre[i] = rstd[u.pm * BM + wr * 64 + fr + (i >> 2) * HALF + (i & 3) * 16]; }
    __device__ __forceinline__ void operator()(const f32x4 (&acc)[2][2][4][2], const Unit& u, int wr, int wc, int fr, int fq, const float (&pre)[8]) const {
        const int row0 = u.pm * BM + wr * 64 + fr, col0 = u.pn * BM + wc * 32 + 8 * fq;
#pragma unroll
        for (int ai = 0; ai < 2; ++ai)
#pragma unroll
            for (int m = 0; m < 4; ++m) { bf16_t* rowp = O + (size_t)(row0 + ai * HALF + m * 16) * ldc + col0; const float rs = pre[ai * 4 + m];
#pragma unroll
                for (int bj = 0; bj < 2; ++bj) { const f32x4 v0 = acc[ai][bj][m][0] * rs, v1 = acc[ai][bj][m][1] * rs;
                    u32x4 w; w.x = cvtpk(v0[0], v0[1]); w.y = cvtpk(v0[2], v0[3]); w.z = cvtpk(v1[0], v1[1]); w.w = cvtpk(v1[2], v1[3]);
                    *(u32x4*)(rowp + bj * HALF) = w; } }
    }
};
struct EpiSwiGLU {
    static constexpr bool PERM = true;
    bf16_t* O; int ldc; const float* rstd;
    __device__ __forceinline__ void prefetch(float (&pre)[8], const Unit& u, int wr, int fr) const {
#pragma unroll
        for (int i = 0; i < 8; ++i) pre[i] = rstd[u.pm * BM + wr * 64 + fr + (i >> 2) * HALF + (i & 3) * 16]; }
    __device__ __forceinline__ void operator()(const f32x4 (&acc)[2][2][4][2], const Unit& u, int wr, int wc, int fr, int fq, const float (&pre)[8]) const {
        const int row0 = u.pm * BM + wr * 64 + fr, col0 = u.pn * HALF + wc * 32 + 8 * fq;
#pragma unroll
        for (int ai = 0; ai < 2; ++ai)
#pragma unroll
            for (int m = 0; m < 4; ++m) { bf16_t* rowp = O + (size_t)(row0 + ai * HALF + m * 16) * ldc + col0; const float rs = pre[ai * 4 + m];
                float v[8];
#pragma unroll
                for (int n = 0; n < 2; ++n)
#pragma unroll
                    for (int j = 0; j < 4; ++j) { const float g = acc[ai][0][m][n][j] * rs, up = acc[ai][1][m][n][j] * rs;
                        const float s = g * __builtin_amdgcn_rcpf(1.0f + __builtin_amdgcn_exp2f(-g * LOG2E)); v[n * 4 + j] = s * up; }
                u32x4 w; w.x = cvtpk(v[0], v[1]); w.y = cvtpk(v[2], v[3]); w.z = cvtpk(v[4], v[5]); w.w = cvtpk(v[6], v[7]);
                *(u32x4*)rowp = w; }
    }
};
struct EpiResid {
    static constexpr bool PERM = false;
    __device__ __forceinline__ void prefetch(float (&)[8], const Unit&, int, int) const {}
    const float* base; float* out; bf16_t* xb; float* ssq; int ldc; float alpha;
    __device__ __forceinline__ void operator()(const f32x4 (&acc)[2][2][4][2], const Unit& u, int wr, int wc, int fr, int fq, const float (&pre)[8]) const {
        const int row0 = u.pm * BM + wr * 64 + fr, col0 = u.pn * BM + wc * 32 + 4 * fq;
#pragma unroll
        for (int ai = 0; ai < 2; ++ai)
#pragma unroll
            for (int m = 0; m < 4; ++m) { const int row = row0 + ai * HALF + m * 16; const size_t off = (size_t)row * ldc + col0; float ss = 0.f;
#pragma unroll
                for (int bj = 0; bj < 2; ++bj)
#pragma unroll
                    for (int n = 0; n < 2; ++n) { const f32x4 bs = *(const f32x4*)(base + off + bj * HALF + n * 16); const f32x4 o = bs + acc[ai][bj][m][n] * alpha;
                        *(f32x4*)(out + off + bj * HALF + n * 16) = o; ss += (o.x * o.x + o.y * o.y) + (o.z * o.z + o.w * o.w);
                        u32x2 w; w.x = cvtpk(o.x, o.y); w.y = cvtpk(o.z, o.w); *(u32x2*)(xb + off + bj * HALF + n * 16) = w; }
                const int lane = fq * 16 + fr; ss += shx(ss, 16, lane); ss += shx(ss, 32, lane);
                if (fq == 0) ssq[(size_t)row * 32 + u.pn * 4 + wc] = ss; }
    }
};
struct EpiF32Z {
    static constexpr bool PERM = false;
    float* C; int ldc; size_t zstride;
    __device__ __forceinline__ void prefetch(float (&)[8], const Unit&, int, int) const {}
    __device__ __forceinline__ void operator()(const f32x4 (&acc)[2][2][4][2], const Unit& u, int wr, int wc, int fr, int fq, const float (&pre)[8]) const {
        float* Cz = C + (size_t)u.z * zstride;
        const int row0 = u.pm * BM + wr * 64 + fr, col0 = u.pn * BM + wc * 32 + 4 * fq;
#pragma unroll
        for (int ai = 0; ai < 2; ++ai)
#pragma unroll
            for (int m = 0; m < 4; ++m) { float* rowp = Cz + (size_t)(row0 + ai * HALF + m * 16) * ldc + col0;
#pragma unroll
                for (int bj = 0; bj < 2; ++bj)
#pragma unroll
                    for (int n = 0; n < 2; ++n) *(f32x4*)(rowp + bj * HALF + n * 16) = acc[ai][bj][m][n]; }
    }
};

template <class Epi, class Sched>
__device__ __forceinline__ void gemm_phase(LAS unsigned char* lds, const Gemm g, const Sched& S, const Epi& E, const int wv) {
    const int tid = opq_tid(wv), wid = __builtin_amdgcn_readfirstlane(tid >> 6), lane = tid & 63, wr = wid >> 2, wc = wid & 3, fr = lane & 15, fq = lane >> 4;
    const int K = g.K, nt = K / BK;
    unsigned voffA[2], voffB[2];
#pragma unroll
    for (int i = 0; i < 2; ++i) { int R, C; stage_rc(tid * 16 + i * 8192, R, C); const int Rb = Epi::PERM ? ((R & ~31) + perm32(R & 31)) : R;
        voffA[i] = (unsigned)(R * g.lda + C) * 2u; voffB[i] = (unsigned)(Rb * g.ldb + C) * 2u; }
    const size_t kstep = (size_t)(BK * 2);
    const size_t hstepA = (size_t)HALF * g.lda * 2, hstepB = (size_t)HALF * g.ldb * 2;
    const unsigned ldsw = (unsigned)wid * 1024u;
    const int aoff = lds_byte(wr * 64 + fr, fq * 8), boff = lds_byte(wc * 32 + fr, fq * 8);
#define PG8_SA(b, h) (((b) * 2 + (h)) * HTB)
#define PG8_SB(b, h) ((4 + (b) * 2 + (h)) * HTB)
#define PG8_STAGE(bufoff, gbase, voff) do { _Pragma("unroll") for (int _i = 0; _i < 2; ++_i) \
        __builtin_amdgcn_global_load_lds((const unsigned*)((const char*)(gbase) + (voff)[_i]), (LAS unsigned*)(lds + (bufoff) + ldsw + _i * 8192), 16, 0, 0); } while (0)
#define PG8_LDA(dst, b, h) do { _Pragma("unroll") for (int m = 0; m < 4; ++m) _Pragma("unroll") for (int k = 0; k < 2; ++k) dst[m][k] = *(const LAS bf16x8*)(lds + PG8_SA(b, h) + aoff + m * 2048 + k * 1024); } while (0)
#define PG8_LDB(dst, b, h) do { _Pragma("unroll") for (int n = 0; n < 2; ++n) _Pragma("unroll") for (int k = 0; k < 2; ++k) dst[n][k] = *(const LAS bf16x8*)(lds + PG8_SB(b, h) + boff + n * 2048 + k * 1024); } while (0)
#define PG8_MMA(ai, bj, At, Bt) do { __builtin_amdgcn_s_setprio(1); _Pragma("unroll") for (int m = 0; m < 4; ++m) _Pragma("unroll") for (int n = 0; n < 2; ++n) _Pragma("unroll") for (int k = 0; k < 2; ++k) \
        acc[ai][bj][m][n] = __builtin_amdgcn_mfma_f32_16x16x32_bf16(Bt[n][k], At[m][k], acc[ai][bj][m][n], 0, 0, 0); __builtin_amdgcn_s_setprio(0); } while (0)
#define PG8_WAIT_V(n) asm volatile("s_waitcnt vmcnt(" #n ")" ::: "memory")
#define PG8_WAIT_L(n) asm volatile("s_waitcnt lgkmcnt(" #n ")" ::: "memory")
#define PG8_BAR __builtin_amdgcn_s_barrier()
#define PG8_SCHED __builtin_amdgcn_sched_barrier(0)
    Unit cur, nxt; int ui = 0;
    if (!S.next(0, cur)) return;
    f32x4 acc[2][2][4][2];
#pragma unroll
    for (int a = 0; a < 2; ++a)
#pragma unroll
        for (int b = 0; b < 2; ++b)
#pragma unroll
            for (int m = 0; m < 4; ++m)
#pragma unroll
                for (int n = 0; n < 2; ++n) acc[a][b][m][n] = (f32x4){0.f, 0.f, 0.f, 0.f};
    bf16x8 At[4][2], B0[2][2], B1[2][2];
    const char* cA = S.a_ptr(cur); const char* cB = S.b_ptr(cur);
    float pre[8]; E.prefetch(pre, cur, wr, fr);
    PG8_STAGE(PG8_SB(0, 0), cB, voffB); PG8_STAGE(PG8_SA(0, 0), cA, voffA); PG8_STAGE(PG8_SB(0, 1), cB + hstepB, voffB); PG8_STAGE(PG8_SA(0, 1), cA + hstepA, voffA);
    if (wr == 1) PG8_BAR;
    PG8_WAIT_V(4); PG8_BAR;
    PG8_STAGE(PG8_SB(1, 0), cB + kstep, voffB); PG8_STAGE(PG8_SA(1, 0), cA + kstep, voffA); PG8_STAGE(PG8_SB(1, 1), cB + hstepB + kstep, voffB);
    PG8_WAIT_V(6); PG8_BAR;
    for (;;) {
        const bool has_next = S.next(ui + 1, nxt);
        const char* nA = has_next ? S.a_ptr(nxt) : cA; const char* nB = has_next ? S.b_ptr(nxt) : cB;
        for (int t = 0; t < nt; t += 2) {
            const bool last = (t == nt - 2);
            const char* a1 = cA + (size_t)(t + 1) * kstep;
            const char* a2 = last ? nA : cA + (size_t)(t + 2) * kstep; const char* b2 = last ? nB : cB + (size_t)(t + 2) * kstep;
            const char* a3 = a2 + kstep; const char* b3 = b2 + kstep;
            PG8_LDB(B0, 0, 0); PG8_SCHED; PG8_LDA(At, 0, 0); PG8_STAGE(PG8_SA(1, 1), a1 + hstepA, voffA);
            PG8_WAIT_L(8); PG8_BAR; PG8_WAIT_L(0); PG8_MMA(0, 0, At, B0); PG8_BAR; PG8_SCHED;
            PG8_LDB(B1, 0, 1); PG8_STAGE(PG8_SB(0, 0), b2, voffB);
            PG8_BAR; PG8_WAIT_L(0); PG8_MMA(0, 1, At, B1); PG8_BAR;
            PG8_LDA(At, 0, 1); PG8_STAGE(PG8_SA(0, 0), a2, voffA);
            PG8_BAR; PG8_WAIT_L(0); PG8_MMA(1, 0, At, B0); PG8_BAR; PG8_SCHED;
            PG8_STAGE(PG8_SB(0, 1), b2 + hstepB, voffB);
            PG8_WAIT_V(6); PG8_BAR; PG8_MMA(1, 1, At, B1); PG8_BAR;
            PG8_LDB(B0, 1, 0); PG8_SCHED; PG8_LDA(At, 1, 0); PG8_STAGE(PG8_SA(0, 1), a2 + hstepA, voffA);
            PG8_WAIT_L(8); PG8_BAR; PG8_WAIT_L(0); PG8_MMA(0, 0, At, B0); PG8_BAR; PG8_SCHED;
            PG8_LDB(B1, 1, 1); PG8_STAGE(PG8_SB(1, 0), b3, voffB);
            PG8_BAR; PG8_WAIT_L(0); PG8_MMA(0, 1, At, B1); PG8_BAR;
            PG8_LDA(At, 1, 1); PG8_STAGE(PG8_SA(1, 0), a3, voffA);
            PG8_BAR; PG8_WAIT_L(0); PG8_MMA(1, 0, At, B0); PG8_BAR; PG8_SCHED;
            PG8_STAGE(PG8_SB(1, 1), b3 + hstepB, voffB);
            PG8_WAIT_V(6); PG8_BAR; PG8_MMA(1, 1, At, B1); PG8_BAR;
        }
        E(acc, cur, wr, wc, fr, fq, pre);
        if (has_next) E.prefetch(pre, nxt, wr, fr);
        if (!has_next) break;
#pragma unroll
        for (int a = 0; a < 2; ++a)
#pragma unroll
            for (int b = 0; b < 2; ++b)
#pragma unroll
                for (int m = 0; m < 4; ++m)
#pragma unroll
                    for (int n = 0; n < 2; ++n) acc[a][b][m][n] = (f32x4){0.f, 0.f, 0.f, 0.f};
        cur = nxt; cA = nA; cB = nB; ++ui;
    }
    PG8_WAIT_V(0);
    if (wr == 0) PG8_BAR;
    PG8_BAR;
#undef PG8_SA
#undef PG8_SB
#undef PG8_STAGE
#undef PG8_LDA
#undef PG8_LDB
#undef PG8_MMA
#undef PG8_WAIT_V
#undef PG8_WAIT_L
#undef PG8_BAR
#undef PG8_SCHED
}
}

struct Args { const float* in[24]; float* out; unsigned char* ws; };
enum { I_X = 0, I_F1N, I_F1W1, I_F1W3, I_F1W2, I_MIXN, I_WIN, I_GB, I_QNA, I_KNA, I_QNN, I_KNN, I_POS, I_CKW1, I_CKW2, I_CVW1, I_CVW2, I_ON, I_WOUT, I_F2N, I_F2W1, I_F2W3, I_F2W2, I_RB };

__device__ __forceinline__ void transpose_item(const float* W, int K, int N, bf16_t* WT, int mode, int off, LAS float* scr, int item, int lane, const float* gain) {
    const int nblk = (N + 31) / 32, kb = item / nblk, nb = item % nblk, k0 = 64 * kb, n0 = 32 * nb;
    const int c4 = 4 * (lane & 7), nn = n0 + c4;
    f32x4 ld[8];
#pragma unroll
    for (int i = 0; i < 8; ++i) { const int kk = 8 * i + (lane >> 3); ld[i] = (nn < N) ? *(const f32x4*)(W + (size_t)(k0 + kk) * N + nn) : (f32x4){0.f, 0.f, 0.f, 0.f}; if (gain) ld[i] = ld[i] * gain[k0 + kk]; }
#pragma unroll
    for (int i = 0; i < 8; ++i) { const int kk = 8 * i + (lane >> 3); LAS float* d = scr + kk * 33 + c4; d[0] = ld[i].x; d[1] = ld[i].y; d[2] = ld[i].z; d[3] = ld[i].w; }
    LDS_WAIT(); asm volatile("" ::: "memory");
    const int c = lane & 7;
#pragma unroll
    for (int j = 0; j < 4; ++j) { const int n = (lane >> 3) + 8 * j; const LAS float* s = scr + (8 * c) * 33 + n;
        u32x4 o; o.x = pk2(s[0 * 33], s[1 * 33]); o.y = pk2(s[2 * 33], s[3 * 33]); o.z = pk2(s[4 * 33], s[5 * 33]); o.w = pk2(s[6 * 33], s[7 * 33]);
        const int ng = n0 + n; const int dr = mode ? ((ng >> 7) * 256 + (ng & 127) + off) : (ng + off);
        if (ng < N) *(u32x4*)(WT + (size_t)dr * K + k0 + 8 * c) = o; }
    LDS_WAIT(); asm volatile("" ::: "memory");
}
__device__ __forceinline__ int rel_bucket_dev(int n) {
    if (n < 16) return n;
    const float v = logf((float)n / 16.0f) / 4.852030263919617f * 16.0f;
    int b = 16 + (int)v; return b < 31 ? b : 31;
}
namespace att {
constexpr int SHM_V = 16384, SHM_K = 16384;
constexpr int L_V = 0, L_K = 32768, L_WS = 65536, L_TBL = 67584, L_IMP = L_TBL + 4 * TBLS * 4  , L_SELM = L_IMP + 32768  , L_END = L_SELM + 1024;
static_assert(L_END <= 131072, "attention LDS map");
constexpr float THR = 8.f;
#define KSWZ(row, colB) ((row) * 256 + ((colB) ^ (((row) & 7) << 4)))
__device__ __forceinline__ int v_st(int k, int c) { const int kk = (k & ~0xC) | ((k & 4) << 1) | ((k & 8) >> 1); return ((kk >> 3) * 4 + (c >> 5)) * 512 + ((kk & 7) * 32 + (c & 31)) * 2; }
__device__ __forceinline__ int v_rd_base(int lane) { return ((lane & 3) << 3) | (((lane >> 2) & 3) << 6) | (((lane >> 4) & 1) << 5) | (((lane >> 5) & 1) << 8); }
__device__ __forceinline__ int crow(int r, int hi) { return (r & 3) + 8 * (r >> 2) + 4 * hi; }

__device__ __forceinline__ void partialSM(f32x16& p0, f32x16& p1, float& m_reg, float& mn, float& alpha) {
    (void)m_reg; mn = 0.f; alpha = 1.f;
#pragma unroll
    for (int r = 0; r < 16; ++r) p0[r] = __builtin_amdgcn_exp2f(p0[r] * LOG2E);
#pragma unroll
    for (int r = 0; r < 16; ++r) p1[r] = p1[r] * LOG2E;
}
__device__ __forceinline__ void partialSM_row(f32x16& p0, f32x16& p1, float& m_reg, float& mn, float& alpha, bool ok, float bias) {
    (void)m_reg; mn = 0.f; alpha = 1.f;
    const float mnL = ok ? bias * LOG2E : -__builtin_inff();
#pragma unroll
    for (int r = 0; r < 16; ++r) p0[r] = __builtin_amdgcn_exp2f(fmaf(p0[r], LOG2E, mnL));
#pragma unroll
    for (int r = 0; r < 16; ++r) p1[r] = fmaf(p1[r], LOG2E, mnL);
}
#define PK4(P, B_, OUT) do { unsigned a0 = cvtpk(P[B_+0], P[B_+1]), a1 = cvtpk(P[B_+2], P[B_+3]);                          \
        unsigned b0 = cvtpk(P[B_+4], P[B_+5]), b1 = cvtpk(P[B_+6], P[B_+7]);                                             \
        auto r0 = __builtin_amdgcn_permlane32_swap(a0, b0, false, false); auto r1 = __builtin_amdgcn_permlane32_swap(a1, b1, false, false); \
        u32x4 w = {r0[0], r1[0], r0[1], r1[1]}; OUT = *reinterpret_cast<bf16x8*>(&w); } while (0)
__device__ __forceinline__ void finishSM(f32x16& p0, f32x16& p1, float alpha, float& l_reg, bf16x8& pa0, bf16x8& pa1, bf16x8& pa2, bf16x8& pa3) {
#pragma unroll
    for (int r = 0; r < 16; ++r) p1[r] = __builtin_amdgcn_exp2f(p1[r]);
    float ps = 0;
#pragma unroll
    for (int r = 0; r < 16; ++r) ps += p0[r];
#pragma unroll
    for (int r = 0; r < 16; ++r) ps += p1[r];
    { auto rr = __builtin_amdgcn_permlane32_swap(__float_as_uint(ps), __float_as_uint(ps), false, false);
      ps = __uint_as_float(rr[0]) + __uint_as_float(rr[1]); }
    l_reg = l_reg * alpha + ps;
    PK4(p0, 0, pa0); PK4(p0, 8, pa1); PK4(p1, 0, pa2); PK4(p1, 8, pa3);
}
__device__ __forceinline__ void qkt(f32x16& p0, f32x16& p1, const LAS char* Kb, int r32, int hi, const bf16x8 (&qr)[8]) {
    p0 = f32x16{}; p1 = f32x16{};
    const LAS char* kb4[4];
#pragma unroll
    for (int dd = 0; dd < 4; ++dd) kb4[dd] = Kb + KSWZ(r32, (dd * 16 + hi * 8) * 2);
#pragma unroll
    for (int d0 = 0; d0 < 8; ++d0) { const LAS char* a = kb4[d0 & 3] + (d0 >> 2) * 128;
        const bf16x8 b0 = *reinterpret_cast<const LAS bf16x8*>(a);
        const bf16x8 b1 = *reinterpret_cast<const LAS bf16x8*>(a + 32 * 256);
        p0 = __builtin_amdgcn_mfma_f32_32x32x16_bf16(b0, qr[d0], p0, 0, 0, 0);
        p1 = __builtin_amdgcn_mfma_f32_32x32x16_bf16(b1, qr[d0], p1, 0, 0, 0); }
}
__device__ __forceinline__ void pv_tile(f32x16 (&o)[4], int vb, bf16x8 pa0, bf16x8 pa1, bf16x8 pa2, bf16x8 pa3) {
#define TRRD(dst, off) asm volatile("ds_read_b64_tr_b16 %0, %1 offset:%2" : "=&v"(dst) : "v"(vb), "i"(off) : "memory")
#define PV_D0(d0) do { s16x4 l0, l1, l2, l3, h0, h1, h2, h3; constexpr int b_ = (d0) * 512; \
        TRRD(l0, b_); TRRD(h0, b_ + 2048); TRRD(l1, b_ + 4096); TRRD(h1, b_ + 6144); TRRD(l2, b_ + 8192); TRRD(h2, b_ + 10240); TRRD(l3, b_ + 12288); TRRD(h3, b_ + 14336); \
        asm volatile("s_waitcnt lgkmcnt(0)" ::: "memory"); SBAR(); \
        o[d0] = __builtin_amdgcn_mfma_f32_32x32x16_bf16(pa0, (bf16x8){l0[0], l0[1], l0[2], l0[3], h0[0], h0[1], h0[2], h0[3]}, o[d0], 0, 0, 0);   \
        o[d0] = __builtin_amdgcn_mfma_f32_32x32x16_bf16(pa1, (bf16x8){l1[0], l1[1], l1[2], l1[3], h1[0], h1[1], h1[2], h1[3]}, o[d0], 0, 0, 0);   \
        o[d0] = __builtin_amdgcn_mfma_f32_32x32x16_bf16(pa2, (bf16x8){l2[0], l2[1], l2[2], l2[3], h2[0], h2[1], h2[2], h2[3]}, o[d0], 0, 0, 0);   \
        o[d0] = __builtin_amdgcn_mfma_f32_32x32x16_bf16(pa3, (bf16x8){l3[0], l3[1], l3[2], l3[3], h3[0], h3[1], h3[2], h3[3]}, o[d0], 0, 0, 0); } while (0)
    PV_D0(0); PV_D0(1); PV_D0(2); PV_D0(3);
#undef PV_D0
#undef TRRD
}

template <class Cfg>
__device__ __forceinline__ void attn_tiles(const Cfg& c, LAS char* lds, const bf16x8 (&qr)[8], f32x16 (&o)[4], float& m_reg, float& l_reg, const int t_lo, const int t_hi, const int wv) {
    const int tid = opq_tid(wv), lane = tid & 63, wid = __builtin_amdgcn_readfirstlane(tid >> 6), r32 = lane & 31, hi = lane >> 5;
    LAS char* V_lds = lds + L_V; LAS char* K_lds = lds + L_K;
    LAS float* al_l = (LAS float*)(lds + L_WS) + wid * 64 + 32;
    const int sr = tid >> 4, sc = (tid & 15) * 8;
    const int vst0 = v_st(sr, sc), vst1 = v_st(32 + sr, sc), kws = KSWZ(sr, sc * 2);
    const int vb0 = (int)(unsigned)(uintptr_t)V_lds + v_rd_base(lane);
    bf16x8 sk0, sk1, sv0, sv1;
#define AT_LOAD(t) do { sk0 = *(const bf16x8*)(c.krow((t), sr) + sc); sk1 = *(const bf16x8*)(c.krow((t), sr + 32) + sc); \
        if constexpr (Cfg::MODE == 0) { sv0 = *(const bf16x8*)(c.vrow((t), sr) + sc); sv1 = *(const bf16x8*)(c.vrow((t), sr + 32) + sc); } \
        asm volatile("" ::: "memory"); SBAR(); } while (0)
#define AT_WRITE(t, bf) do { *(LAS bf16x8*)(K_lds + (bf) * SHM_K + kws) = sk0; *(LAS bf16x8*)(K_lds + (bf) * SHM_K + kws + 32 * 256) = sk1; \
        if constexpr (Cfg::MODE == 1) { \
            _Pragma("unroll") for (int i_ = 0; i_ < 8; ++i_) { const int n_ = sc + i_, c0_ = 64 * (t) + sr, c1_ = c0_ + 32; \
                sv0[i_] = (c0_ >= 4 * n_ - 1 && c0_ <= 4 * n_ + 3) ? (short)0x3F80 : (short)0; sv1[i_] = (c1_ >= 4 * n_ - 1 && c1_ <= 4 * n_ + 3) ? (short)0x3F80 : (short)0; } } \
        *(LAS bf16x8*)(V_lds + (bf) * SHM_V + vst0) = sv0; *(LAS bf16x8*)(V_lds + (bf) * SHM_V + vst1) = sv1; } while (0)
    __syncthreads();
    if (t_lo < t_hi) { AT_LOAD(t_lo); AT_WRITE(t_lo, 0); }
    __syncthreads();
    for (int t = t_lo; t < t_hi; ++t) {
        const int buf = (t - t_lo) & 1; const bool more = (t + 1 < t_hi);
        if (more) AT_LOAD(t + 1);
        if (c.active(t)) {
            f32x16 p0, p1;
            qkt(p0, p1, K_lds + buf * SHM_K, r32, hi, qr);
            if constexpr (Cfg::MODE == 0) {
                float mn, alpha; bf16x8 pa0, pa1, pa2, pa3;
                bool rok; float rbias;
                if (c.rowconst(t, rok, rbias)) partialSM_row(p0, p1, m_reg, mn, alpha, rok, rbias);
                else { c.mask(p0, p1, t); partialSM(p0, p1, m_reg, mn, alpha); }
                if (__any(alpha < 1.f)) { if (hi == 0) al_l[r32] = alpha; LDS_WAIT();
#pragma unroll
                    for (int d_ = 0; d_ < 4; ++d_)
#pragma unroll
                        for (int r = 0; r < 16; ++r) o[d_][r] *= al_l[crow(r, hi)]; }
                finishSM(p0, p1, alpha, l_reg, pa0, pa1, pa2, pa3); SBAR();
                pv_tile(o, vb0 + buf * SHM_V, pa0, pa1, pa2, pa3);
            } else {
                c.mask(p0, p1, t);
                const float mL = -c.mfix * LOG2E; const float il = c.invl;
#pragma unroll
                for (int r = 0; r < 16; ++r) { p0[r] = __builtin_amdgcn_exp2f(fmaf(p0[r], LOG2E, mL)) * il; p1[r] = __builtin_amdgcn_exp2f(fmaf(p1[r], LOG2E, mL)) * il; }
                bf16x8 pa0, pa1, pa2, pa3;
                PK4(p0, 0, pa0); PK4(p0, 8, pa1); PK4(p1, 0, pa2); PK4(p1, 8, pa3); SBAR();
                pv_tile(o, vb0 + buf * SHM_V, pa0, pa1, pa2, pa3);
#pragma unroll
                for (int r = 0; r < 16; r += 2) { const unsigned a = cvtpk(p0[r], p0[r + 1]), b = cvtpk(p1[r], p1[r + 1]);
                    p0[r] -= bflo(a); p0[r + 1] -= bfhi(a); p1[r] -= bflo(b); p1[r + 1] -= bfhi(b); }
                PK4(p0, 0, pa0); PK4(p0, 8, pa1); PK4(p1, 0, pa2); PK4(p1, 8, pa3); SBAR();
                pv_tile(o, vb0 + buf * SHM_V, pa0, pa1, pa2, pa3);
            }
        }
        if (more) AT_WRITE(t + 1, buf ^ 1);
        __syncthreads();
    }
#undef AT_LOAD
#undef AT_WRITE
}

struct DilCfg {
    static constexpr int MODE = 0;
    const bf16_t* Kb; const bf16_t* Vb;
    const LAS float* tbl; int dshift, res, u, dqm, s0;
    __device__ __forceinline__ const bf16_t* krow(int t, int kk) const { int s = 256 * u - 128 + 64 * t + kk; s = s < 0 ? 0 : s; return Kb + (size_t)((s << dshift) + res) * PC; }
    __device__ __forceinline__ const bf16_t* vrow(int t, int kk) const { int s = 256 * u - 128 + 64 * t + kk; s = s < 0 ? 0 : s; return Vb + (size_t)((s << dshift) + res) * PC; }
    __device__ __forceinline__ bool active(int t) const { const int kb = 256 * u - 128 + 64 * t; return kb <= s0 + 31 && kb + 63 >= s0 - 128; }
    __device__ __forceinline__ bool rowconst(int, bool&, float&) const { return false; }
    __device__ __forceinline__ void mask(f32x16& p0, f32x16& p1, int t) const {
        const int dq = dqm - (256 * u - 128 + 64 * t); const float NEG = -__builtin_inff();
        const LAS float* tb = tbl + (DT0 + dq - 63);
#pragma unroll
        for (int r = 0; r < 16; ++r) { const int cc = (r & 3) + 8 * (r >> 2); const unsigned d0 = (unsigned)(dq - cc), d1 = (unsigned)(dq - cc - 32);
            const float b0 = tb[63 - cc], b1 = tb[31 - cc];
            p0[r] = (d0 <= 128u) ? p0[r] + b0 : NEG; p1[r] = (d1 <= 128u) ? p1[r] + b1 : NEG; }
    }
};
struct CmpCfg {
    static constexpr int MODE = 0;
    const bf16_t* Kb; const bf16_t* Vb; int cmax, hi4, cfull;
    __device__ __forceinline__ bool rowconst(int t, bool& ok, float& bias) const { ok = true; bias = 0.f; return 64 * t + 63 <= cfull; }
    __device__ __forceinline__ const bf16_t* krow(int t, int kk) const { return Kb + (size_t)(64 * t + kk) * HD; }
    __device__ __forceinline__ const bf16_t* vrow(int t, int kk) const { return Vb + (size_t)(64 * t + kk) * HD; }
    __device__ __forceinline__ bool active(int) const { return true; }
    __device__ __forceinline__ void mask(f32x16& p0, f32x16& p1, int t) const {
        const int cb = 64 * t + hi4; const float NEG = -__builtin_inff();
#pragma unroll
        for (int r = 0; r < 16; ++r) { const int cc = cb + (r & 3) + 8 * (r >> 2); if (cc > cmax) p0[r] = NEG; if (cc + 32 > cmax) p1[r] = NEG; }
    }
};
struct CmpImpCfg {
    static constexpr int MODE = 1;
    const bf16_t* Kb; int cmax, hi4; float mfix, invl;
    __device__ __forceinline__ const bf16_t* krow(int t, int kk) const { return Kb + (size_t)(64 * t + kk) * HD; }
    __device__ __forceinline__ const bf16_t* vrow(int, int) const { return Kb; }
    __device__ __forceinline__ bool active(int) const { return true; }
    __device__ __forceinline__ void mask(f32x16& p0, f32x16& p1, int t) const {
        const int cb = 64 * t + hi4; const float NEG = -__builtin_inff();
#pragma unroll
        for (int r = 0; r < 16; ++r) { const int cc = cb + (r & 3) + 8 * (r >> 2); if (cc > cmax) p0[r] = NEG; if (cc + 32 > cmax) p1[r] = NEG; }
    }
};
struct SlcCfg {
    static constexpr int MODE = 0;
    const bf16_t* Kb; const bf16_t* Vb;
    const LAS float* tblh;
    unsigned s0, s1, s2, s3; int tqm, cur; float b31;
    __device__ __forceinline__ const bf16_t* krow(int t, int kk) const { return Kb + (size_t)(64 * t + kk) * PC; }
    __device__ __forceinline__ const bf16_t* vrow(int t, int kk) const { return Vb + (size_t)(64 * t + kk) * PC; }
    __device__ __forceinline__ bool selbit(int t) const { const unsigned q = (unsigned)t >> 5; const unsigned w = (q == 0u ? s0 + 0u : 0u) | (q == 1u ? s1 + 0u : 0u) | (q == 2u ? s2 + 0u : 0u) | (q == 3u ? s3 + 0u : 0u); return (w >> (t & 31)) & 1u; }
    __device__ __forceinline__ bool active(int t) const { return __any(selbit(t)); }
    __device__ __forceinline__ bool rowconst(int t, bool& ok, float& bias) const { ok = selbit(t); bias = b31; return 64 * (cur - t) - 63 >= 1513; }
    __device__ __forceinline__ void mask(f32x16& p0, f32x16& p1, int t) const {
        const bool sel = selbit(t); const int dq = tqm - 64 * t; const float NEG = -__builtin_inff();
        const LAS float* tb = tblh + (TBL0 + dq - 63);
#pragma unroll
        for (int r = 0; r < 16; ++r) { const int cc = (r & 3) + 8 * (r >> 2); const int d0 = dq - cc, d1 = dq - cc - 32;
            const float b0 = tb[63 - cc], b1 = tb[31 - cc];
            p0[r] = (sel && d0 >= 0) ? p0[r] + b0 : NEG; p1[r] = (sel && d1 >= 0) ? p1[r] + b1 : NEG; }
    }
};
struct WinCfg {
    static constexpr int MODE = 0;
    const bf16_t* Kb; const bf16_t* Vb; const LAS float* tblh; int tqm;
    __device__ __forceinline__ bool rowconst(int, bool&, float&) const { return false; }
    __device__ __forceinline__ const bf16_t* krow(int t, int kk) const { return Kb + (size_t)(64 * t + kk) * PC; }
    __device__ __forceinline__ const bf16_t* vrow(int t, int kk) const { return Vb + (size_t)(64 * t + kk) * PC; }
    __device__ __forceinline__ bool active(int) const { return true; }
    __device__ __forceinline__ void mask(f32x16& p0, f32x16& p1, int t) const {
        const int dq = tqm - 64 * t; const float NEG = -__builtin_inff();
        const LAS float* tb = tblh + (TBL0 + dq - 63);
#pragma unroll
        for (int r = 0; r < 16; ++r) { const int cc = (r & 3) + 8 * (r >> 2); const unsigned d0 = (unsigned)(dq - cc), d1 = (unsigned)(dq - cc - 32);
            const float b0 = tb[63 - cc], b1 = tb[31 - cc];
            p0[r] = (d0 < 512u) ? p0[r] + b0 : NEG; p1[r] = (d1 < 512u) ? p1[r] + b1 : NEG; }
    }
};
}

__device__ __forceinline__ void dil_unit(LAS char* lds, const bf16_t* P, bf16_t* OA, float* LSE, const float* dilT, int pat, int dshift, int unit, const int wv) {
    using namespace att;
    const int tid = opq_tid(wv), lane = tid & 63, wid = __builtin_amdgcn_readfirstlane(tid >> 6), r32 = lane & 31, hi = lane >> 5;
    const int bh = unit >> 5, ru = unit & 31, b = bh >> 3, h = bh & 7;
    const int ncs = 5 - dshift, res = ru >> ncs, u = ru & ((1 << ncs) - 1);
    LAS float* tbl = (LAS float*)(lds + L_TBL);
    __syncthreads();
    if (tid < DTS) tbl[tid] = dilT[(pat * 8 + h) * DTS + tid];
    const int s0 = 256 * u + 32 * wid, s_row = s0 + r32;
    const size_t tokrow = (size_t)b * SEQ + (size_t)((s_row << dshift) + res);
    bf16x8 qr[8];
    { const bf16_t* qp = P + tokrow * PC + C_QA + h * HD + hi * 8;
#pragma unroll
      for (int d0 = 0; d0 < 8; ++d0) qr[d0] = *(const bf16x8*)(qp + d0 * 16); }
    f32x16 o[4]; float m_reg, l_reg;
    m_reg = 0.f;
    if (pat == 0) { l_reg = 0.f;
#pragma unroll
        for (int d0 = 0; d0 < 4; ++d0) o[d0] = f32x16{}; }
    else { l_reg = LSE[tokrow * 8 + h];
#pragma unroll
        for (int r = 0; r < 16; ++r) { const size_t tr = (size_t)b * SEQ + (size_t)(((s0 + crow(r, hi)) << dshift) + res); const bf16_t* op = OA + tr * 1024 + h * HD + r32;
#pragma unroll
            for (int d0 = 0; d0 < 4; ++d0) o[d0][r] = bf2f(op[d0 * 32]); } }
    DilCfg c; c.Kb = P + (size_t)b * SEQ * PC + C_KA + h * HD; c.Vb = P + (size_t)b * SEQ * PC + C_VA + h * HD; c.tbl = tbl; c.dshift = dshift; c.res = res; c.u = u; c.dqm = s_row - 4 * hi; c.s0 = s0;
    attn_tiles(c, lds, qr, o, m_reg, l_reg, (u == 0) ? 2 : 0, 6, wv);
    LAS float* li_l = (LAS float*)(lds + L_WS) + wid * 64;
    if (hi == 0) { li_l[r32] = l_reg; LSE[tokrow * 8 + h] = l_reg; }
    LDS_WAIT();
#pragma unroll
    for (int r = 0; r < 16; ++r) { const int orow = crow(r, hi); const float rl = (pat == 2) ? 1.0f / li_l[orow] : 1.0f;
        const size_t tr = (size_t)b * SEQ + (size_t)(((s0 + orow) << dshift) + res); bf16_t* op = OA + tr * 1024 + h * HD;
#pragma unroll
        for (int d0 = 0; d0 < 4; ++d0) { const float v = o[d0][r] * rl; const float vn = shx(v, 1, lane);
            if ((r32 & 1) == 0) *(unsigned*)(op + d0 * 32 + r32) = cvtpk(v, vn); } }
}

__device__ __forceinline__ void nsa_finalize(LAS char* lds, const f32x16 (&o)[4], float l_reg, const bf16_t* P, bf16_t* ON, const float* gb, int b, int g, int tok0, int br, const int wv) {
    using namespace att;
    const int tid = opq_tid(wv), lane = tid & 63, wid = __builtin_amdgcn_readfirstlane(tid >> 6), r32 = lane & 31, hi = lane >> 5;
    LAS float* li_l = (LAS float*)(lds + L_WS) + wid * 64;
    if (hi == 0) li_l[r32] = l_reg;
    LDS_WAIT();
    bf16_t* ONb = ON + (size_t)br * NTOK * 1024;
#pragma unroll
    for (int r = 0; r < 16; ++r) { const int j = r & 3, k = r >> 2; const float lr = li_l[crow(r, hi)]; const float rl = lr > 0.f ? 1.0f / lr : 0.f;
        const size_t tok = (size_t)b * SEQ + tok0 + 2 * k + hi; const int hh = 4 * g + j;
        const float gl = bf2f(P[tok * PC + C_GL + hh * 3 + br]) + gb[hh * 3 + br];
        const float sc = rl * __builtin_amdgcn_rcpf(1.0f + __builtin_amdgcn_exp2f(-gl * LOG2E));
        bf16_t* op = ONb + tok * 1024 + hh * HD;
#pragma unroll
        for (int d0 = 0; d0 < 4; ++d0) { const float v = o[d0][r] * sc; const float vn = shx(v, 1, lane);
            if ((r32 & 1) == 0) *(unsigned*)(op + d0 * 32 + r32) = cvtpk(v, vn); } }
}
__device__ __forceinline__ void nsa_unit(LAS char* lds, const bf16_t* P, const bf16_t* KC, const bf16_t* VC, bf16_t* ON, const float* nsaT, const float* gb, int b, int g, int qi, bool load_tbl, const int wv) {
    using namespace att;
    const int tid = opq_tid(wv), lane = tid & 63, wid = __builtin_amdgcn_readfirstlane(tid >> 6), r32 = lane & 31, hi = lane >> 5;
    LAS float* tbl = (LAS float*)(lds + L_TBL); LAS float* IMP = (LAS float*)(lds + L_IMP); LAS unsigned* SELM = (LAS unsigned*)(lds + L_SELM);
    __syncthreads();
    if (load_tbl) for (int i = tid; i < 4 * TBLS; i += NTHR) tbl[i] = nsaT[(size_t)(4 * g) * TBLS + i];
    const int tok0 = 64 * qi + 8 * wid, tq = tok0 + (r32 >> 2), hd = r32 & 3;
    const bf16_t* Pb = P + (size_t)b * SEQ * PC;
    bf16x8 qr[8];
    { const bf16_t* qp = Pb + (size_t)tq * PC + C_QN + (4 * g + hd) * HD + hi * 8;
#pragma unroll
      for (int d0 = 0; d0 < 8; ++d0) qr[d0] = *(const bf16x8*)(qp + d0 * 16); }
    const bf16_t* KCb = KC + (size_t)(b * 2 + g) * 512 * HD; const bf16_t* VCb = VC + (size_t)(b * 2 + g) * 512 * HD;
    const int ntc = (qi >> 4) + 1, cmax = (tq - 31) >> 4;
    f32x16 o[4]; float m_reg, l_reg;
#pragma unroll
    for (int d0 = 0; d0 < 4; ++d0) o[d0] = f32x16{};
    m_reg = 0.f; l_reg = 0.f;
    { CmpCfg c; c.Kb = KCb; c.Vb = VCb; c.cmax = cmax; c.hi4 = 4 * hi; c.cfull = (64 * qi - 31) >> 4; attn_tiles(c, lds, qr, o, m_reg, l_reg, 0, ntc, wv); }
    nsa_finalize(lds, o, l_reg, P, ON, gb, b, g, tok0, 0, wv);
    { CmpImpCfg c; c.Kb = KCb; c.cmax = cmax; c.hi4 = 4 * hi; c.mfix = 0.f; c.invl = l_reg > 0.f ? 1.0f / l_reg : 0.f;
#pragma unroll
      for (int d0 = 0; d0 < 4; ++d0) o[d0] = f32x16{};
      float md = 0.f, ld = 0.f; attn_tiles(c, lds, qr, o, md, ld, 0, ntc, wv); }
#pragma unroll
    for (int d0 = 0; d0 < 4; ++d0)
#pragma unroll
        for (int k = 0; k < 4; ++k) IMP[(8 * wid + 2 * k + hi) * 128 + 32 * d0 + r32] = (o[d0][4 * k] + o[d0][4 * k + 1]) + (o[d0][4 * k + 2] + o[d0][4 * k + 3]);
    __syncthreads();
    { const int cur = qi;
#pragma unroll 1
      for (int tl = 8 * wid; tl < 8 * wid + 8; ++tl) {
        const int n0 = lane, n1 = 64 + lane; bool sel0, sel1;
        if (cur <= 15) { sel0 = (n0 <= cur); sel1 = false; }
        else {
            const float v0 = IMP[tl * 128 + n0], v1 = IMP[tl * 128 + n1];
            const unsigned u0 = (n0 >= 1 && n0 <= cur - 2) ? __float_as_uint(v0) + 1u : 0u, u1 = (n1 <= cur - 2) ? __float_as_uint(v1) + 1u : 0u;
            unsigned T = 0u;
#pragma unroll 1
            for (int bit = 30; bit >= 0; --bit) { const unsigned cand = T | (1u << bit);
                const int cnt = __builtin_popcountll(__ballot(u0 >= cand)) + __builtin_popcountll(__ballot(u1 >= cand));
                if (cnt >= 13) T = cand; }
            const bool gt0 = u0 > T, gt1 = u1 > T;
            const int need = 13 - (__builtin_popcountll(__ballot(gt0)) + __builtin_popcountll(__ballot(gt1)));
            const bool eq0 = (u0 == T), eq1 = (u1 == T);
            const unsigned long long m0 = __ballot(eq0), m1 = __ballot(eq1);
            const int pre0 = (int)__builtin_amdgcn_mbcnt_hi((unsigned)(m0 >> 32), __builtin_amdgcn_mbcnt_lo((unsigned)m0, 0u));
            const int pre1 = __builtin_popcountll(m0) + (int)__builtin_amdgcn_mbcnt_hi((unsigned)(m1 >> 32), __builtin_amdgcn_mbcnt_lo((unsigned)m1, 0u));
            sel0 = (n0 == 0 || n0 == cur || n0 == cur - 1) || gt0 || (eq0 && pre0 < need);
            sel1 = (n1 == cur || n1 == cur - 1) || gt1 || (eq1 && pre1 < need);
        }
        const unsigned long long b0 = __ballot(sel0), b1 = __ballot(sel1);
        if (lane == 0) { SELM[tl * 4 + 0] = (unsigned)b0; SELM[tl * 4 + 1] = (unsigned)(b0 >> 32); SELM[tl * 4 + 2] = (unsigned)b1; SELM[tl * 4 + 3] = (unsigned)(b1 >> 32); } } }
    __syncthreads();
    { SlcCfg c; c.Kb = Pb + C_KS + g * HD; c.Vb = Pb + C_VS + g * HD; c.tblh = tbl + hd * TBLS; c.tqm = tq - 4 * hi; c.cur = qi; c.b31 = tbl[hd * TBLS + TBL0 + 1600];
      const int tl = 8 * wid + (r32 >> 2); c.s0 = SELM[tl * 4 + 0]; c.s1 = SELM[tl * 4 + 1]; c.s2 = SELM[tl * 4 + 2]; c.s3 = SELM[tl * 4 + 3];
#pragma unroll
      for (int d0 = 0; d0 < 4; ++d0) o[d0] = f32x16{};
      m_reg = 0.f; l_reg = 0.f;
      attn_tiles(c, lds, qr, o, m_reg, l_reg, 0, qi + 1, wv); }
    nsa_finalize(lds, o, l_reg, P, ON, gb, b, g, tok0, 1, wv);
    { WinCfg c; c.Kb = Pb + C_KW + g * HD; c.Vb = Pb + C_VW + g * HD; c.tblh = tbl + hd * TBLS; c.tqm = tq - 4 * hi;
#pragma unroll
      for (int d0 = 0; d0 < 4; ++d0) o[d0] = f32x16{};
      m_reg = 0.f; l_reg = 0.f;
      attn_tiles(c, lds, qr, o, m_reg, l_reg, qi >= 8 ? qi - 8 : 0, qi + 1, wv); }
    nsa_finalize(lds, o, l_reg, P, ON, gb, b, g, tok0, 2, wv);
}

constexpr int LDS_BYTES = 147456;
constexpr int LDS_MISC = 131072;
constexpr int LDS_ARGS = LDS_MISC + 64;
__device__ __forceinline__ unsigned long long arg_u64(LAS unsigned char* lds, int i) {
    const LAS unsigned* p = (const LAS unsigned*)(lds + LDS_ARGS) + 2 * i;
    const unsigned lo = __builtin_amdgcn_readfirstlane(p[0]), hi = __builtin_amdgcn_readfirstlane(p[1]);
    return ((unsigned long long)hi << 32) | lo;
}
#define GAS __attribute__((address_space(1)))
__device__ __forceinline__ const float* arg_in(LAS unsigned char* lds, int i) { return (const float*)(GAS const float*)arg_u64(lds, i); }
__device__ __forceinline__ float* arg_out(LAS unsigned char* lds) { return (float*)(GAS float*)arg_u64(lds, 24); }
__device__ __forceinline__ unsigned char* arg_ws(LAS unsigned char* lds) { return (unsigned char*)(GAS unsigned char*)arg_u64(lds, 25); }
__device__ __forceinline__ int opq_bx() { int b = blockIdx.x; asm volatile("" : "+s"(b)); return b; }
__device__ __forceinline__ int opq_g() { int b = gridDim.x; asm volatile("" : "+s"(b)); return b; }

__device__ __forceinline__ void ph_prologue(LAS unsigned char* lds, const int wv) {
    lds = opq_lds(lds);
    const int tid = opq_tid(wv), lane = tid & 63, wave = __builtin_amdgcn_readfirstlane(tid >> 6), G = opq_g(), bx = opq_bx();
    const int gw = bx * NWAVES + wave, NGW = G * NWAVES;
    unsigned char* ws = arg_ws(lds);
    LAS float* scr = (LAS float*)(lds + wave * 16384);
    constexpr int I_UP = 32 * 176, I_DN = 88 * 64, I_IN = 32 * 177, I_OUT = 32 * 64, I_C1 = 64 * 16, I_Z = 928;
    constexpr int I_FFN = 2 * I_UP + I_DN, I_LAYER = 2 * I_FFN + I_IN + I_OUT + 2 * I_C1 + I_Z;
#pragma unroll 1
    for (int it = gw; it < DEPTH * I_LAYER; it += NGW) {
        const int l = it / I_LAYER; int r = it - l * I_LAYER;
        if (r < 2 * I_FFN) { const int half = r >= I_FFN; r -= half * I_FFN;
            bf16_t* WUP = (bf16_t*)(ws + WS_WUP + (size_t)(l * 2 + half) * SZ_WUP); bf16_t* WDN = (bf16_t*)(ws + WS_WDN + (size_t)(l * 2 + half) * SZ_WDN);
            const float* gn = arg_in(lds, half ? I_F2N : I_F1N) + (size_t)l * DM;
            if (r < I_UP) { transpose_item(arg_in(lds, half ? I_F2W1 : I_F1W1) + (size_t)l * DM * DFF, DM, DFF, WUP, 1, 0, scr, r, lane, gn); continue; } r -= I_UP;
            if (r < I_UP) { transpose_item(arg_in(lds, half ? I_F2W3 : I_F1W3) + (size_t)l * DM * DFF, DM, DFF, WUP, 1, 128, scr, r, lane, gn); continue; } r -= I_UP;
            transpose_item(arg_in(lds, half ? I_F2W2 : I_F1W2) + (size_t)l * DFF * DM, DFF, DM, WDN, 0, 0, scr, r, lane, nullptr); continue; }
        r -= 2 * I_FFN;
        bf16_t* WIN = (bf16_t*)(ws + WS_WIN + (size_t)l * SZ_WIN); bf16_t* WOUT = (bf16_t*)(ws + WS_WOUT + (size_t)l * SZ_WOUT); bf16_t* WC1 = (bf16_t*)(ws + WS_WC1 + (size_t)l * SZ_WC1);
        if (r < I_IN) { transpose_item(arg_in(lds, I_WIN) + (size_t)l * DM * IN_COLS, DM, IN_COLS, WIN, 0, 0, scr, r, lane, arg_in(lds, I_MIXN) + (size_t)l * DM); continue; } r -= I_IN;
        if (r < I_OUT) { transpose_item(arg_in(lds, I_WOUT) + (size_t)l * DM * DM, DM, DM, WOUT, 0, 0, scr, r, lane, nullptr); continue; } r -= I_OUT;
        if (r < I_C1) { transpose_item(arg_in(lds, I_CKW1) + (size_t)l * 4096 * 512, 4096, 512, WC1, 0, 0, scr, r, lane, nullptr); continue; } r -= I_C1;
        if (r < I_C1) { transpose_item(arg_in(lds, I_CVW1) + (size_t)l * 4096 * 512, 4096, 512, WC1, 0, 512, scr, r, lane, nullptr); continue; } r -= I_C1;
        { u32x4* z = (u32x4*)(WIN + (size_t)IN_COLS * DM) + (size_t)r * 64 + lane; unsigned zr = 0u; asm volatile("" : "+v"(zr)); *z = (u32x4){zr, zr, zr, zr}; }
    }
    const float* xs = arg_in(lds, I_X); bf16_t* XB = (bf16_t*)(ws + WS_HB); float* RSTD = (float*)(ws + WS_RSTD);
    for (int m = gw; m < NTOK; m += NGW) {
        const f32x4* xr = (const f32x4*)(xs + (size_t)m * DM) + lane; f32x4 v[8]; float s = 0.f;
#pragma unroll
        for (int j = 0; j < 8; ++j) { v[j] = xr[64 * j]; s += (v[j].x * v[j].x + v[j].y * v[j].y) + (v[j].z * v[j].z + v[j].w * v[j].w); }
        s = wave_sum(s, lane);
        u32x2* o8 = (u32x2*)(XB + (size_t)m * DM) + lane;
#pragma unroll
        for (int j = 0; j < 8; ++j) { u32x2 w; w.x = cvtpk(v[j].x, v[j].y); w.y = cvtpk(v[j].z, v[j].w); o8[64 * j] = w; }
        if (lane == 0) RSTD[m] = 1.0f / sqrtf(s * (1.f / DM) + EPS);
    }
}
__device__ __forceinline__ void ph_rstd(LAS unsigned char* lds, const int wv) {
    lds = opq_lds(lds);
    const int tid = opq_tid(wv), G = opq_g(), bx = opq_bx();
    unsigned char* ws = arg_ws(lds); const float* SSQ = (const float*)(ws + WS_SSQ); float* RSTD = (float*)(ws + WS_RSTD);
    for (int m = bx * NTHR + tid; m < NTOK; m += G * NTHR) { const f32x4* p = (const f32x4*)(SSQ + (size_t)m * 32); f32x4 a = p[0];
#pragma unroll
        for (int j = 1; j < 8; ++j) a = a + p[j];
        RSTD[m] = 1.0f / sqrtf(((a.x + a.y) + (a.z + a.w)) * (1.f / DM) + EPS); }
}
__device__ __forceinline__ void ph_headnorm(LAS unsigned char* lds, int l, const int wv) {
    lds = opq_lds(lds);
    const int tid = opq_tid(wv), lane = tid & 63, wave = __builtin_amdgcn_readfirstlane(tid >> 6), G = opq_g(), bx = opq_bx();
    const int gw = bx * NWAVES + wave, NGW = G * NWAVES;
    unsigned char* ws = arg_ws(lds); bf16_t* HP = (bf16_t*)(ws + WS_HP); bf16_t* ACMP = (bf16_t*)(ws + WS_ACMP);
    const float* qna = arg_in(lds, I_QNA) + l * HD; const float* kna = arg_in(lds, I_KNA) + l * HD; const float* qnn = arg_in(lds, I_QNN) + l * HD; const float* knn = arg_in(lds, I_KNN) + l * HD;
    const float* pos = arg_in(lds, I_POS) + (size_t)l * 32 * HD;
    const int e0 = (lane & 15) * 8;
    for (int m = gw; m < NTOK; m += NGW) {
        bf16_t* prow = HP + (size_t)m * PC;
        int cols[7]; u32x4 wl[7];
#pragma unroll
        for (int ch = 0; ch < 7; ++ch) { cols[ch] = (ch < 2) ? C_QA + ch * 512 + lane * 8 : (ch < 4) ? C_KA + (ch - 2) * 512 + lane * 8 : (ch < 6) ? C_QN + (ch - 4) * 512 + lane * 8 : (lane < 32 ? C_KS + lane * 8 : C_KW + (lane - 32) * 8);
            wl[ch] = *(const u32x4*)(prow + cols[ch]); }
        const u32x4 wcv = *(const u32x4*)(prow + C_KC + lane * 8);
#pragma unroll
        for (int ch = 0; ch < 7; ++ch) {
            const float* gp = (ch < 2) ? qna : (ch < 4) ? kna : (ch < 6) ? qnn : knn; const float sc = (ch < 2 || (ch >= 4 && ch < 6)) ? QSCALE : 1.f;
            const u32x4 w = wl[ch];
            float v[8] = {bflo(w.x), bfhi(w.x), bflo(w.y), bfhi(w.y), bflo(w.z), bfhi(w.z), bflo(w.w), bfhi(w.w)};
            float s = 0.f;
#pragma unroll
            for (int i = 0; i < 8; ++i) s += v[i] * v[i];
            s += shx(s, 1, lane); s += shx(s, 2, lane); s += shx(s, 4, lane); s += shx(s, 8, lane);
            const float rs = sc / sqrtf(s * (1.f / HD) + EPS);
            const f32x4 g0 = *(const f32x4*)(gp + e0), g1 = *(const f32x4*)(gp + e0 + 4);
            u32x4 o; o.x = cvtpk(v[0] * rs * g0.x, v[1] * rs * g0.y); o.y = cvtpk(v[2] * rs * g0.z, v[3] * rs * g0.w); o.z = cvtpk(v[4] * rs * g1.x, v[5] * rs * g1.y); o.w = cvtpk(v[6] * rs * g1.z, v[7] * rs * g1.w);
            *(u32x4*)(prow + cols[ch]) = o;
        }
        { const int b = m / SEQ, t = m % SEQ, kv = lane >> 5, gg = (lane >> 4) & 1, c1 = t >> 4, j1 = t & 15;
          const u32x4 w = wcv;
          const float v[8] = {bflo(w.x), bfhi(w.x), bflo(w.y), bfhi(w.y), bflo(w.z), bfhi(w.z), bflo(w.w), bfhi(w.w)};
          bf16_t* abase = ACMP + ((size_t)kv * 4096 + (size_t)(b * 2 + gg) * 512) * 4096 + e0;
          if (c1 <= 510) { const f32x4 p0 = *(const f32x4*)(pos + j1 * HD + e0), p1 = *(const f32x4*)(pos + j1 * HD + e0 + 4);
              u32x4 o; o.x = cvtpk(v[0] + p0.x, v[1] + p0.y); o.y = cvtpk(v[2] + p0.z, v[3] + p0.w); o.z = cvtpk(v[4] + p1.x, v[5] + p1.y); o.w = cvtpk(v[6] + p1.z, v[7] + p1.w);
              *(u32x4*)(abase + (size_t)c1 * 4096 + j1 * HD) = o; }
          else { const u32x4 z = {0u, 0u, 0u, 0u}; *(u32x4*)(abase + (size_t)511 * 4096 + j1 * HD) = z; *(u32x4*)(abase + (size_t)511 * 4096 + (j1 + 16) * HD) = z; }
          if (c1 >= 1) { const int j2 = j1 + 16; const f32x4 p0 = *(const f32x4*)(pos + j2 * HD + e0), p1 = *(const f32x4*)(pos + j2 * HD + e0 + 4);
              u32x4 o; o.x = cvtpk(v[0] + p0.x, v[1] + p0.y); o.y = cvtpk(v[2] + p0.z, v[3] + p0.w); o.z = cvtpk(v[4] + p1.x, v[5] + p1.y); o.w = cvtpk(v[6] + p1.z, v[7] + p1.w);
              *(u32x4*)(abase + (size_t)(c1 - 1) * 4096 + j2 * HD) = o; } }
    }
}
__device__ __forceinline__ float gelu_tanh(float v) { const float u3 = 0.7978845608028654f * (v + 0.044715f * v * v * v); return 0.5f * v * (2.0f - 2.0f / (__expf(2.0f * u3) + 1.0f)); }
__device__ __forceinline__ void ph_cmp2(LAS unsigned char* lds, int l, const int wv) {
    lds = opq_lds(lds);
    const int tid = opq_tid(wv), lane = tid & 63, wave = __builtin_amdgcn_readfirstlane(tid >> 6), G = opq_g(), bx = opq_bx();
    unsigned char* ws = arg_ws(lds); const float* CP = (const float*)(ws + WS_CP);
    LAS float* CH = (LAS float*)lds;
    LAS float* RED = (LAS float*)(lds + 65536);
    const float* knn = arg_in(lds, I_KNN) + l * HD;
    for (int it = bx; it < 256; it += G) {
        const int R0 = it * 32, kv = R0 >> 12, rl0 = R0 & 4095;
        __syncthreads();
        for (int i4 = tid; i4 < 32 * 128; i4 += NTHR) { const int rr = i4 >> 7, k4 = (i4 & 127) * 4; f32x4 v = {0.f, 0.f, 0.f, 0.f};
#pragma unroll
            for (int ks = 0; ks < 4; ++ks) v = v + *(const f32x4*)(CP + ((size_t)(kv * 4 + ks) * 4096 + rl0 + rr) * 512 + k4);
            f32x4 o; o.x = gelu_tanh(v.x); o.y = gelu_tanh(v.y); o.z = gelu_tanh(v.z); o.w = gelu_tanh(v.w);
            *(LAS f32x4*)(CH + rr * 512 + k4) = o; }
        __syncthreads();
        const int n = tid & 127, rq = tid >> 7;
        const float* w2 = arg_in(lds, kv ? I_CVW2 : I_CKW2) + (size_t)l * 512 * HD + n;
        float acc[8];
#pragma unroll
        for (int i = 0; i < 8; ++i) acc[i] = 0.f;
#pragma unroll 4
        for (int k = 0; k < 512; k += 4) { const float w0 = w2[(size_t)k * HD], w1 = w2[(size_t)(k + 1) * HD], w2v = w2[(size_t)(k + 2) * HD], w3 = w2[(size_t)(k + 3) * HD];
#pragma unroll
            for (int i = 0; i < 8; ++i) { const f32x4 c = *(const LAS f32x4*)(CH + (rq * 8 + i) * 512 + k); acc[i] += (c.x * w0 + c.y * w1) + (c.z * w2v + c.w * w3); } }
        if (kv == 0) {
            float ss[8];
#pragma unroll
            for (int i = 0; i < 8; ++i) ss[i] = wave_sum(acc[i] * acc[i], lane);
            if (lane == 0) {
#pragma unroll
                for (int i = 0; i < 8; ++i) RED[wave * 8 + i] = ss[i]; }
            __syncthreads();
            const float gn = knn[n];
#pragma unroll
            for (int i = 0; i < 8; ++i) { const float tot = RED[(2 * rq) * 8 + i] + RED[(2 * rq + 1) * 8 + i]; acc[i] = acc[i] / sqrtf(tot * (1.f / HD) + EPS) * gn; }
        }
        bf16_t* dst = (bf16_t*)(ws + (kv ? WS_VC + 0 : WS_KC + 0)) + (size_t)(rl0 + rq * 8) * HD + n;
#pragma unroll
        for (int i = 0; i < 8; ++i) dst[(size_t)i * HD] = (bf16_t)f2bf(acc[i]);
    }
}
__device__ __forceinline__ void ph_outnorm(LAS unsigned char* lds, int l, const int wv) {
    lds = opq_lds(lds);
    const int tid = opq_tid(wv), lane = tid & 63, wave = __builtin_amdgcn_readfirstlane(tid >> 6), G = opq_g(), bx = opq_bx();
    const int gw = bx * NWAVES + wave, NGW = G * NWAVES;
    unsigned char* ws = arg_ws(lds); const bf16_t* OA = (const bf16_t*)(ws + WS_OA); const bf16_t* ON = (const bf16_t*)(ws + WS_ON); bf16_t* HB = (bf16_t*)(ws + WS_HP);
    const float* gn = arg_in(lds, I_ON) + (size_t)l * DM;
    for (int m = gw; m < NTOK; m += NGW) {
        const bf16_t* oa = OA + (size_t)m * 1024; bf16_t* y = HB + (size_t)m * DM;
        const u32x4 wa = *(const u32x4*)(oa + lane * 8), wb = *(const u32x4*)(oa + 512 + lane * 8);
        u32x4 wn[6];
#pragma unroll
        for (int br = 0; br < 3; ++br) { const bf16_t* onb = ON + ((size_t)br * NTOK + m) * 1024; wn[2 * br] = *(const u32x4*)(onb + lane * 8); wn[2 * br + 1] = *(const u32x4*)(onb + 512 + lane * 8); }
        float va[16] = {bflo(wa.x), bfhi(wa.x), bflo(wa.y), bfhi(wa.y), bflo(wa.z), bfhi(wa.z), bflo(wa.w), bfhi(wa.w), bflo(wb.x), bfhi(wb.x), bflo(wb.y), bfhi(wb.y), bflo(wb.z), bfhi(wb.z), bflo(wb.w), bfhi(wb.w)};
        float sa = 0.f;
#pragma unroll
        for (int i = 0; i < 16; ++i) sa += va[i] * va[i];
        float vs[16]; float sn = 0.f;
#pragma unroll
        for (int i = 0; i < 16; ++i) vs[i] = 0.f;
#pragma unroll
        for (int br = 0; br < 3; ++br) { const u32x4 wc = wn[2 * br], wd = wn[2 * br + 1];
            vs[0] += bflo(wc.x); vs[1] += bfhi(wc.x); vs[2] += bflo(wc.y); vs[3] += bfhi(wc.y); vs[4] += bflo(wc.z); vs[5] += bfhi(wc.z); vs[6] += bflo(wc.w); vs[7] += bfhi(wc.w);
            vs[8] += bflo(wd.x); vs[9] += bfhi(wd.x); vs[10] += bflo(wd.y); vs[11] += bfhi(wd.y); vs[12] += bflo(wd.z); vs[13] += bfhi(wd.z); vs[14] += bflo(wd.w); vs[15] += bfhi(wd.w); }
        const float ra = 1.0f / sqrtf(wave_sum(sa, lane) * (1.f / 1024.f) + EPS);
        { const f32x4 g0 = *(const f32x4*)(gn + lane * 8), g1 = *(const f32x4*)(gn + lane * 8 + 4), g2 = *(const f32x4*)(gn + 512 + lane * 8), g3 = *(const f32x4*)(gn + 512 + lane * 8 + 4);
          u32x4 o; o.x = cvtpk(va[0] * ra * g0.x, va[1] * ra * g0.y); o.y = cvtpk(va[2] * ra * g0.z, va[3] * ra * g0.w); o.z = cvtpk(va[4] * ra * g1.x, va[5] * ra * g1.y); o.w = cvtpk(va[6] * ra * g1.z, va[7] * ra * g1.w);
          *(u32x4*)(y + lane * 8) = o;
          o.x = cvtpk(va[8] * ra * g2.x, va[9] * ra * g2.y); o.y = cvtpk(va[10] * ra * g2.z, va[11] * ra * g2.w); o.z = cvtpk(va[12] * ra * g3.x, va[13] * ra * g3.y); o.w = cvtpk(va[14] * ra * g3.z, va[15] * ra * g3.w);
          *(u32x4*)(y + 512 + lane * 8) = o; }
#pragma unroll
        for (int i = 0; i < 16; ++i) sn += vs[i] * vs[i];
        const float rn = 1.0f / sqrtf(wave_sum(sn, lane) * (1.f / 1024.f) + EPS);
        { const float* g2 = gn + 1024; const f32x4 g0 = *(const f32x4*)(g2 + lane * 8), g1 = *(const f32x4*)(g2 + lane * 8 + 4), g2a = *(const f32x4*)(g2 + 512 + lane * 8), g3 = *(const f32x4*)(g2 + 512 + lane * 8 + 4);
          u32x4 o; o.x = cvtpk(vs[0] * rn * g0.x, vs[1] * rn * g0.y); o.y = cvtpk(vs[2] * rn * g0.z, vs[3] * rn * g0.w); o.z = cvtpk(vs[4] * rn * g1.x, vs[5] * rn * g1.y); o.w = cvtpk(vs[6] * rn * g1.z, vs[7] * rn * g1.w);
          *(u32x4*)(y + 1024 + lane * 8) = o;
          o.x = cvtpk(vs[8] * rn * g2a.x, vs[9] * rn * g2a.y); o.y = cvtpk(vs[10] * rn * g2a.z, vs[11] * rn * g2a.w); o.z = cvtpk(vs[12] * rn * g3.x, vs[13] * rn * g3.y); o.w = cvtpk(vs[14] * rn * g3.z, vs[15] * rn * g3.w);
          *(u32x4*)(y + 1536 + lane * 8) = o; }
    }
}

#define GRID_BAR() xcd_barrier(bar, wv)
__global__ void __launch_bounds__(NTHR, 2) mega_fwd(Args a) {
    extern __shared__ __attribute__((aligned(16))) unsigned char lds_raw[];
    LAS unsigned char* lds = (LAS unsigned char*)lds_raw;
    const int wv = __builtin_amdgcn_readfirstlane((int)threadIdx.x >> 6);
    {
        const int tid = threadIdx.x;
        for (int u = tid; u < (LDS_BYTES - LDS_MISC) / 4; u += NTHR) ((LAS unsigned*)(lds + LDS_MISC))[u] = 0u;
        __syncthreads();
        if (tid == 0) { LAS unsigned long long* t = (LAS unsigned long long*)(lds + LDS_ARGS);
#pragma unroll
            for (int i = 0; i < 24; ++i) t[i] = (unsigned long long)(uintptr_t)a.in[i];
            t[24] = (unsigned long long)(uintptr_t)a.out; t[25] = (unsigned long long)(uintptr_t)a.ws; }
        __syncthreads();
    }
    XcdBarrier bar = xcd_barrier_post((unsigned*)(arg_ws(lds) + WS_CTL) + CW_BAR, (volatile LAS unsigned*)(lds + LDS_MISC + 32));

    { const int tid = opq_tid(wv), G = opq_g(), bx = opq_bx(); const float* rb = arg_in(lds, I_RB); unsigned char* ws = arg_ws(lds);
      float* dilT = (float*)(ws + WS_TBL); float* nsaT = (float*)(ws + WS_TBL + 65536);
      for (int i = bx * NTHR + tid; i < 3 * 8 * DTS + 8 * TBLS; i += G * NTHR) {
          if (i < 3 * 8 * DTS) { const int p = i / (8 * DTS), h = (i / DTS) % 8, df = i % DTS - DT0; const int d = (p == 0) ? 1 : (p == 1 ? 4 : 16);
              dilT[i] = (df >= 0 && df <= 128) ? rb[rel_bucket_dev(df * d) * 16 + h] : 0.f; }
          else { const int j = i - 3 * 8 * DTS, hh = j / TBLS, ds = j % TBLS - TBL0; nsaT[j] = (ds >= 0) ? rb[rel_bucket_dev(ds) * 16 + 8 + hh] : 0.f; } } }

    ph_prologue(lds, wv);
    GRID_BAR();
#pragma unroll 1
    for (int step = 0; step < 2 * DEPTH; ++step) {
        const int l = step >> 1, half = step & 1;
#if PH_FFN
        { unsigned char* ws = arg_ws(lds); const int G = opq_g(), bx = opq_bx();
          pg8::Gemm g{DM, DM, DM}; pg8::SchedStd S; S.init(ws + WS_HB, ws + WS_WUP + (size_t)step * SZ_WUP, NTOK, 2 * DFF, DM, DM, G, bx); const pg8::EpiSwiGLU E{(bf16_t*)(ws + WS_HP), DFF, (const float*)(ws + WS_RSTD)};
          pg8::gemm_phase<pg8::EpiSwiGLU, pg8::SchedStd>(opq_lds(lds), g, S, E, wv);
#if DUP_UP
          GRID_BAR(); pg8::gemm_phase<pg8::EpiSwiGLU, pg8::SchedStd>(opq_lds(lds), g, S, E, wv);
#endif
        }
        GRID_BAR();
        { unsigned char* ws = arg_ws(lds); const int G = opq_g(), bx = opq_bx(); float* X = arg_out(lds);
          pg8::Gemm g{DFF, DFF, DFF}; pg8::SchedStd S; S.init(ws + WS_HP, ws + WS_WDN + (size_t)step * SZ_WDN, NTOK, DM, DFF, DFF, G, bx);
          pg8::EpiResid E{(step == 0) ? arg_in(lds, I_X) : (const float*)X, X, (bf16_t*)(ws + WS_HB), (float*)(ws + WS_SSQ), DM, 0.5f};
          pg8::gemm_phase<pg8::EpiResid, pg8::SchedStd>(opq_lds(lds), g, S, E, wv);
#if DUP_DN
          { GRID_BAR(); const pg8::EpiResid E2{X, X, (bf16_t*)(ws + WS_HB), (float*)(ws + WS_SSQ), DM, 0.f}; pg8::gemm_phase<pg8::EpiResid, pg8::SchedStd>(opq_lds(lds), g, S, E2, wv); }
#endif
        }
#endif
        GRID_BAR();
        ph_rstd(lds, wv);
        GRID_BAR();
        if (half == 0) {
#if PH_INP
            { unsigned char* ws = arg_ws(lds); const int G = opq_g(), bx = opq_bx();
              pg8::Gemm g{DM, DM, DM}; pg8::SchedStd S; S.init(ws + WS_HB, ws + WS_WIN + (size_t)l * SZ_WIN, NTOK, PC, DM, DM, G, bx); const pg8::EpiBf16 E{(bf16_t*)(ws + WS_HP), PC, (const float*)(ws + WS_RSTD)};
              pg8::gemm_phase<pg8::EpiBf16, pg8::SchedStd>(opq_lds(lds), g, S, E, wv);
#if DUP_IN
              GRID_BAR(); pg8::gemm_phase<pg8::EpiBf16, pg8::SchedStd>(opq_lds(lds), g, S, E, wv);
#endif
            }
#endif
            GRID_BAR();
            ph_headnorm(lds, l, wv);
            GRID_BAR();
#pragma unroll 1
            for (int pat3 = 0; pat3 < 3 * (1 + DUP_DIL); ++pat3) { const int pat = pat3 % 3;
#if PH_CMP
                if (pat3 == 0) { unsigned char* ws = arg_ws(lds); const int G = opq_g(), bx = opq_bx();
                  pg8::Gemm g{4096, 4096, 1024}; pg8::SchedCmp S; S.A = (const char*)(ws + WS_ACMP); S.Bt = (const char*)(ws + WS_WC1 + (size_t)l * SZ_WC1); S.G = G; S.c = bx; pg8::EpiF32Z E{(float*)(ws + WS_CP), 512, (size_t)4096 * 512};
                  pg8::gemm_phase<pg8::EpiF32Z, pg8::SchedCmp>(opq_lds(lds), g, S, E, wv); }
#endif
                if (pat3 == 1) ph_cmp2(lds, l, wv);
#if PH_DIL
                { unsigned char* ws = arg_ws(lds); const int G = opq_g(), bx = opq_bx();
                  for (int u0 = bx; u0 < 1024; u0 += G) { const int w_ = u0 & 255, k_ = u0 >> 8; const int unit = (((w_ & 7) + 8 * k_) << 5) | (w_ >> 3);
                    dil_unit((LAS char*)opq_lds(lds), (const bf16_t*)(ws + WS_HP), (bf16_t*)(ws + WS_OA), (float*)(ws + WS_LSE), (const float*)(ws + WS_TBL), pat, 2 * pat, unit, wv); } }
#endif
                if (pat3 + 1 < 3 * (1 + DUP_DIL)) GRID_BAR();
            }
#if PH_NSA
            { unsigned char* ws = arg_ws(lds); const int G = opq_g(), bx = opq_bx();
              const float* gb = arg_in(lds, I_GB) + l * 24;
              int last_bg = -1;
#pragma unroll 1
              for (int i4 = 0; i4 < 4 * (1 + DUP_NSA); ++i4)
#pragma unroll 1
                  for (int w = bx; w < 256; w += G) { const int i = i4 & 3; const int bg = w & 7, j = w >> 3;
                      const int qi = (i == 0) ? 127 - j : (i == 1 ? j : (i == 2 ? 64 + j : 63 - j));
                      nsa_unit((LAS char*)opq_lds(lds), (const bf16_t*)(ws + WS_HP), (const bf16_t*)(ws + WS_KC), (const bf16_t*)(ws + WS_VC), (bf16_t*)(ws + WS_ON), (const float*)(ws + WS_TBL + 65536), gb, bg >> 1, bg & 1, qi, bg != last_bg, wv); last_bg = bg; } }
#endif
            GRID_BAR();
            ph_outnorm(lds, l, wv);
            GRID_BAR();
#if PH_OUT
            { unsigned char* ws = arg_ws(lds); const int G = opq_g(), bx = opq_bx(); float* X = arg_out(lds);
              pg8::Gemm g{DM, DM, DM}; pg8::SchedStd S; S.init(ws + WS_HP, ws + WS_WOUT + (size_t)l * SZ_WOUT, NTOK, DM, DM, DM, G, bx); pg8::EpiResid E{X, X, (bf16_t*)(ws + WS_HB), (float*)(ws + WS_SSQ), DM, 1.0f};
              pg8::gemm_phase<pg8::EpiResid, pg8::SchedStd>(opq_lds(lds), g, S, E, wv);
#if DUP_OUT
              { GRID_BAR(); const pg8::EpiResid E2{X, X, (bf16_t*)(ws + WS_HB), (float*)(ws + WS_SSQ), DM, 0.f}; pg8::gemm_phase<pg8::EpiResid, pg8::SchedStd>(opq_lds(lds), g, S, E2, wv); }
#endif
            }
#endif
            GRID_BAR();
            ph_rstd(lds, wv);
            GRID_BAR();
        }
    }
}

extern "C" void kernel_launch(void* const* d_in, const int* in_sizes, int n_in, void* d_out, int out_size, void* d_ws, size_t ws_size, hipStream_t stream) {
    static int grid = 0;
    if (grid == 0) {
        if (n_in != 24 || in_sizes[0] != NTOK * DM || out_size != NTOK * DM || ws_size < WS_END) { fprintf(stderr, "kernel_launch: shape mismatch n_in %d in0 %d out %d ws %zu (need %zu)\n", n_in, n_in > 0 ? in_sizes[0] : -1, out_size, ws_size, (size_t)WS_END); grid = -1; return; }
        int dev = 0, cus = 0, per_cu = 0;
        if (hipGetDevice(&dev) != hipSuccess || hipDeviceGetAttribute(&cus, hipDeviceAttributeMultiprocessorCount, dev) != hipSuccess) { grid = -1; return; }
        if (hipFuncSetAttribute((const void*)mega_fwd, hipFuncAttributeMaxDynamicSharedMemorySize, LDS_BYTES) != hipSuccess) { fprintf(stderr, "kernel_launch: hipFuncSetAttribute failed\n"); grid = -1; return; }
        if (hipOccupancyMaxActiveBlocksPerMultiprocessor(&per_cu, (const void*)mega_fwd, NTHR, LDS_BYTES) != hipSuccess || per_cu < 1) { fprintf(stderr, "kernel_launch: occupancy query says %d\n", per_cu); (void)hipGetLastError(); if (per_cu < 1) { grid = -1; return; } }
        grid = cus;
    }
    if (grid < 0) return;
    if (hipMemsetAsync((char*)d_ws + WS_CTL, 0, CTL_ZERO_BYTES, stream) != hipSuccess) return;
    Args a{};
    for (int i = 0; i < 24; ++i) a.in[i] = (const float*)d_in[i];
    a.out = (float*)d_out; a.ws = (unsigned char*)d_ws;
    hipLaunchKernelGGL(mega_fwd, dim3(grid), dim3(NTHR), LDS_BYTES, stream, a);
    const hipError_t le = hipPeekAtLastError();
    if (le != hipSuccess) fprintf(stderr, "kernel_launch: launch failed: %s\n", hipGetErrorName(le));
}
```

```cpp
#include <hip/hip_runtime.h>
#include <cstdio>
#include <cstdint>

#define LAS __attribute__((address_space(3)))
typedef unsigned short bf16_t;
typedef short bf16x8 __attribute__((ext_vector_type(8)));
typedef short s16x4 __attribute__((ext_vector_type(4)));
typedef float f32x2 __attribute__((ext_vector_type(2)));
typedef float f32x4 __attribute__((ext_vector_type(4)));
typedef float f32x16 __attribute__((ext_vector_type(16)));
typedef unsigned u32x2 __attribute__((ext_vector_type(2)));
typedef unsigned u32x4 __attribute__((ext_vector_type(4)));

#ifndef DUP_UP
#define DUP_UP 0
#endif
#ifndef DUP_DN
#define DUP_DN 0
#endif
#ifndef DUP_IN
#define DUP_IN 0
#endif
#ifndef DUP_OUT
#define DUP_OUT 0
#endif
#ifndef DUP_NSA
#define DUP_NSA 0
#endif
#ifndef DUP_DIL
#define DUP_DIL 0
#endif
#ifndef PH_FFN
#define PH_FFN 1
#endif
#ifndef PH_INP
#define PH_INP 1
#endif
#ifndef PH_CMP
#define PH_CMP 1
#endif
#ifndef PH_DIL
#define PH_DIL 1
#endif
#ifndef PH_NSA
#define PH_NSA 1
#endif
#ifndef PH_OUT
#define PH_OUT 1
#endif
constexpr int BATCH = 4, SEQ = 8192, DM = 2048, DFF = 5632, NTOK = BATCH * SEQ, DEPTH = 4, HD = 128;
constexpr int IN_COLS = 5656, PC = 5888;
constexpr int C_QA = 0, C_KA = 1024, C_VA = 2048, C_QN = 3072, C_KC = 4096, C_VC = 4352, C_KS = 4608, C_VS = 4864, C_KW = 5120, C_VW = 5376, C_GL = 5632;
constexpr float EPS = 1e-6f, QSCALE = 0.08838834764831845f, LOG2E = 1.4426950408889634f;
constexpr int TBLS = 1704, TBL0 = 64;
constexpr int DTS = 320, DT0 = 96;
constexpr int NWAVES = 8, NTHR = 512;

constexpr size_t MiB = 1u << 20;
constexpr size_t WS_CTL = 0, CTL_ZERO_BYTES = 1 * MiB;
constexpr size_t WS_TBL = 1 * MiB;
constexpr size_t SZ_WUP = 44 * MiB, SZ_WDN = 22 * MiB, SZ_WIN = 23 * MiB, SZ_WOUT = 8 * MiB, SZ_WC1 = 8 * MiB;
constexpr size_t WS_WUP = 2 * MiB;
constexpr size_t WS_WDN = WS_WUP + 8 * SZ_WUP;
constexpr size_t WS_WIN = WS_WDN + 8 * SZ_WDN;
constexpr size_t WS_WOUT = WS_WIN + 4 * SZ_WIN;
constexpr size_t WS_WC1 = WS_WOUT + 4 * SZ_WOUT;
constexpr size_t WS_HB = WS_WC1 + 4 * SZ_WC1;
constexpr size_t WS_HP = WS_HB + 128 * MiB;
constexpr size_t WS_OA = WS_HP + 368 * MiB;
constexpr size_t WS_LSE = WS_OA + 64 * MiB;
constexpr size_t WS_ON = WS_LSE + 1 * MiB;
constexpr size_t WS_ACMP = WS_ON + 192 * MiB;
constexpr size_t WS_CP = WS_ACMP + 64 * MiB;
constexpr size_t WS_KC = WS_CP + 64 * MiB;
constexpr size_t WS_VC = WS_KC + 1 * MiB;
constexpr size_t WS_SSQ = WS_VC + 1 * MiB;
constexpr size_t WS_RSTD = WS_SSQ + 4 * MiB;
constexpr size_t WS_END = WS_RSTD + 1 * MiB;
constexpr int CW_BAR = 4096;

__device__ __forceinline__ unsigned f2bf(float f) { unsigned u = __builtin_bit_cast(unsigned, f); return (u + 0x7fffu + ((u >> 16) & 1u)) >> 16; }
__device__ __forceinline__ unsigned pk2(float lo, float hi) { return f2bf(lo) | (f2bf(hi) << 16); }
__device__ __forceinline__ float bf2f(bf16_t b) { return __builtin_bit_cast(float, ((unsigned)b) << 16); }
__device__ __forceinline__ float bflo(unsigned w) { return __builtin_bit_cast(float, w << 16); }
__device__ __forceinline__ float bfhi(unsigned w) { return __builtin_bit_cast(float, w & 0xffff0000u); }
__device__ __forceinline__ unsigned cvtpk(float lo, float hi) { unsigned r; asm volatile("v_cvt_pk_bf16_f32 %0, %1, %2" : "=v"(r) : "v"(lo), "v"(hi)); return r; }
__device__ __forceinline__ float shx(float v, int m, int lane) { return __builtin_bit_cast(float, __builtin_amdgcn_ds_bpermute((lane ^ m) << 2, __builtin_bit_cast(int, v))); }
__device__ __forceinline__ float wave_sum(float v, int lane) {
#pragma unroll
    for (int o = 1; o < 64; o <<= 1) v += shx(v, o, lane);
    return v;
}
__device__ __forceinline__ LAS unsigned char* opq_lds(LAS unsigned char* p) { unsigned a = (unsigned)(uintptr_t)p; asm volatile("" : "+s"(a)); return (LAS unsigned char*)(uintptr_t)a; }
__device__ __forceinline__ int opq_tid(int wv) { int l; asm volatile("v_mbcnt_lo_u32_b32 %0, -1, 0\n\tv_mbcnt_hi_u32_b32 %0, -1, %0" : "=v"(l)); return wv * 64 + l; }
__device__ __forceinline__ size_t kt_off(int r, int k, int K) { return (((size_t)(r >> 8) * (K >> 6) + (k >> 6)) * 256 + (r & 255)) * 64 + (k & 63); }
#define LDS_WAIT() asm volatile("s_waitcnt lgkmcnt(0)" ::: "memory")
#define VM_WAIT() asm volatile("s_waitcnt vmcnt(0)" ::: "memory")
#define SBAR() __builtin_amdgcn_sched_barrier(0)

#define XB_TMO      128
#define XB_XCNT(j)  (256  + 64 * (j))
#define XB_XSUB(j)  (1280 + 64 * (j))
#define XB_XGEN(j)  (2304 + 64 * (j))
#define XB_TOP      3328
#define XB_TOPGEN   3392
#define XCD_BAR_WORDS 3456
#define XB_SPIN_CAP (1u << 18)
__device__ __forceinline__ unsigned xb_ld(unsigned* p)              { return __hip_atomic_load(p, __ATOMIC_RELAXED, __HIP_MEMORY_SCOPE_AGENT); }
__device__ __forceinline__ unsigned xb_add(unsigned* p, unsigned v) { return __hip_atomic_fetch_add(p, v, __ATOMIC_RELAXED, __HIP_MEMORY_SCOPE_AGENT); }
__device__ __forceinline__ unsigned xb_xcc_id() { return (unsigned)__builtin_amdgcn_s_getreg((3 << 11) | 20) & 0xFu; }
#define XB_SPIN(cond, bar) do { unsigned _sp = 0; while (cond) { __builtin_amdgcn_s_sleep(1); \
    if ((++_sp & 255u) == 0u) { if (xb_ld(&(bar)[XB_TMO])) break; if (_sp > XB_SPIN_CAP) { atomicAdd(&(bar)[XB_TMO], 1u); break; } } } } while (0)
struct XcdBarrier { unsigned* bar; unsigned x; volatile LAS unsigned* st; };
__device__ __forceinline__ XcdBarrier xcd_barrier_post(unsigned* bar, volatile LAS unsigned* st) {
    XcdBarrier b; b.bar = bar; b.x = xb_xcc_id(); b.st = st;
    if (threadIdx.x == 0) (void)xb_add(&bar[XB_XCNT(b.x)], 1u);
    return b;
}
__device__ __forceinline__ void xcd_barrier_complete(unsigned* bar, unsigned x, unsigned& nloc, unsigned& nx) {
    const unsigned G = gridDim.x * gridDim.y * gridDim.z;
    unsigned sum, cnt, mine, sp = 0u;
    for (;;) {
        sum = 0u; cnt = 0u; mine = 0u;
#pragma unroll
        for (unsigned j = 0; j < 16; ++j) { const unsigned c = xb_ld(&bar[XB_XCNT(j)]); sum += c; cnt += (c > 0u) ? 1u : 0u; mine = (j == x) ? c : mine; }
        if (sum == G) break;
        __builtin_amdgcn_s_sleep(1);
        if ((++sp & 255u) == 0u) { if (xb_ld(&bar[XB_TMO])) break; if (sp > XB_SPIN_CAP) { atomicAdd(&bar[XB_TMO], 1u); break; } }
    }
    nloc = mine > 0u ? mine : 1u; nx = cnt > 0u ? cnt : 1u;
}
__device__ __forceinline__ void xcd_barrier(const XcdBarrier& b, const int wv) {
    asm volatile("s_waitcnt vmcnt(0)" ::: "memory");
    __syncthreads();
    if (opq_tid(wv) == 0) {
        unsigned* bar = b.bar; asm volatile("" : "+s"(bar));
        __builtin_amdgcn_s_waitcnt(0);
        unsigned nloc = b.st[0], nx = b.st[1];
        if (nloc == 0u) { xcd_barrier_complete(bar, b.x, nloc, nx); b.st[0] = nloc; b.st[1] = nx; }
        const unsigned old = xb_add(&bar[XB_XSUB(b.x)], 1u);
        const unsigned gen = old / nloc;
        if (old + 1u == (gen + 1u) * nloc) {
            __builtin_amdgcn_fence(__ATOMIC_RELEASE, "agent");
            asm volatile("s_waitcnt vmcnt(0)" ::: "memory");
            const unsigned og = xb_add(&bar[XB_TOP], 1u);
            const unsigned tg = og / nx;
            if (og + 1u == (tg + 1u) * nx) xb_add(&bar[XB_TOPGEN], 1u);
            else XB_SPIN(xb_ld(&bar[XB_TOPGEN]) == tg, bar);
            __builtin_amdgcn_fence(__ATOMIC_ACQUIRE, "agent");
            xb_add(&bar[XB_XGEN(b.x)], 1u);
            asm volatile("s_waitcnt vmcnt(0)" ::: "memory");
        } else {
            XB_SPIN(xb_ld(&bar[XB_XGEN(b.x)]) == gen, bar);
            __builtin_amdgcn_fence(__ATOMIC_ACQUIRE, "agent");
            asm volatile("s_waitcnt vmcnt(0)" ::: "memory");
        }
    }
    __syncthreads();
}

namespace pg8 {
constexpr int BM = 256, BK = 64, HALF = 128, HTB = HALF * BK * 2, STAGE_BYTES = 8 * HTB, NXCD = 8, WGM = 8;
__host__ __device__ __forceinline__ int lds_byte(int r, int c) { const int st = (r >> 4) * 2 + (c >> 5), rr = r & 15, cc = c & 31, ob = rr * 64 + cc * 2; return st * 1024 + (ob ^ (((ob >> 9) & 1) << 5)); }
__host__ __device__ __forceinline__ void stage_rc(int b, int& R, int& C) { const int st = b / 1024, sb = b % 1024, swz = sb ^ (((sb >> 9) & 1) << 5); R = (st >> 1) * 16 + swz / 64; C = (st & 1) * 32 + (swz % 64) / 2; }
__host__ __device__ __forceinline__ int perm32(int rho) { const int n = rho >> 4, i = rho & 15; return 8 * (i >> 2) + 4 * n + (i & 3); }
struct Unit { int pm, pn, z; };
struct Gemm { int lda, ldb, K; };
struct SchedStd {
    const char* A; const char* Bt; size_t atile, btile; int nM, nN, nwg, G, c;
    __device__ __forceinline__ void init(const void* A_, const void* Bt_, int M, int N, int lda, int ldb, int G_, int c_) {
        A = (const char*)A_; Bt = (const char*)Bt_; atile = (size_t)BM * lda * 2; btile = (size_t)BM * ldb * 2; nM = M / BM; nN = N / BM; nwg = nM * nN; G = G_; c = c_; }
    __device__ __forceinline__ bool next(int i, Unit& u) const {
        const long L = (long)i * G + c; if (L >= nwg) return false;
        int wgid = (int)L; { const int q = nwg / NXCD, r = nwg % NXCD, xcd = wgid % NXCD, off = wgid / NXCD; wgid = (xcd < r ? xcd * (q + 1) : r * (q + 1) + (xcd - r) * q) + off; }
        const int nig = WGM * nN, gid = wgid / nig, fm = gid * WGM, gsz = (nM - fm) < WGM ? (nM - fm) : WGM;
        u.pm = fm + ((wgid % nig) % gsz); u.pn = (wgid % nig) / gsz; u.z = 0; return true;
    }
    __device__ __forceinline__ const char* a_ptr(const Unit& u) const { return A + (size_t)u.pm * atile; }
    __device__ __forceinline__ const char* b_ptr(const Unit& u) const { return Bt + (size_t)u.pn * btile; }
};
struct SchedCmp {
    const char* A; const char* Bt; int G, c;
    __device__ __forceinline__ bool next(int i, Unit& u) const { const int L = i * G + c; if (L >= 256) return false; u.z = L >> 5; u.pm = (L & 31) >> 1; u.pn = L & 1; return true; }
    __device__ __forceinline__ const char* a_ptr(const Unit& u) const { const int kv = u.z >> 2, ks = u.z & 3; return A + ((size_t)(kv * 16 + u.pm) * 64 + (size_t)ks * 16) * 32768; }
    __device__ __forceinline__ const char* b_ptr(const Unit& u) const { const int kv = u.z >> 2, ks = u.z & 3; return Bt + ((size_t)(kv * 2 + u.pn) * 64 + (size_t)ks * 16) * 32768; }
};
struct EpiBf16 {
    static constexpr bool PERM = true;
    bf16_t* O; int ldc; const float* rstd;
    __device__ __forceinline__ void prefetch(float (&pre)[8], const Unit& u, int wr, int fr) const {
#pragma unroll
        for (int i = 0; i < 8; ++i) pre[i] = rstd[u.pm * BM + wr * 64 + fr + (i >> 2) * HALF + (i & 3) * 16]; }
    __device__ __forceinline__ void operator()(const f32x4 (&acc)[2][2][4][2], const Unit& u, int wr, int wc, int fr, int fq, const float (&pre)[8]) const {
        const int row0 = u.pm * BM + wr * 64 + fr, col0 = u.pn * BM + wc * 32 + 8 * fq;
#pragma unroll
        for (int ai = 0; ai < 2; ++ai)
#pragma unroll
            for (int m = 0; m < 4; ++m) { bf16_t* rowp = O + (size_t)(row0 + ai * HALF + m * 16) * ldc + col0; const float rs = pre[ai * 4 + m];
#pragma unroll
                for (int bj = 0; bj < 2; ++bj) { const f32x4 v0 = acc[ai][bj][m][0] * rs, v1 = acc[ai][bj][m][1] * rs;
                    u32x4 w; w.x = cvtpk(v0[0], v0[1]); w.y = cvtpk(v0[2], v0[3]); w.z = cvtpk(v1[0], v1[1]); w.w = cvtpk(v1[2], v1[3]);
                    *(u32x4*)(rowp + bj * HALF) = w; } }
    }
};
struct EpiSwiGLU {
    static constexpr bool PERM = true;
    bf16_t* O; int ldc; const float* rstd;
    __device__ __forceinline__ void prefetch(float (&pre)[8], const Unit& u, int wr, int fr) const {
#pragma unroll
        for (int i = 0; i < 8; ++i) pre[i] = rstd[u.pm * BM + wr * 64 + fr + (i >> 2) * HALF + (i & 3) * 16]; }
    __device__ __forceinline__ void operator()(const f32x4 (&acc)[2][2][4][2], const Unit& u, int wr, int wc, int fr, int fq, const float (&pre)[8]) const {
        const int rowp0 = wr * 64 + fr, kt = 2 * u.pn + (wc >> 1), cit = (wc & 1) * 32 + 8 * fq;
        bf16_t* tile = O + ((size_t)u.pm * (ldc / 64) + kt) * (256 * 64) + cit;
#pragma unroll
        for (int ai = 0; ai < 2; ++ai)
#pragma unroll
            for (int m = 0; m < 4; ++m) { bf16_t* rowp = tile + (size_t)(rowp0 + ai * HALF + m * 16) * 64; const float rs = pre[ai * 4 + m];
                float v[8];
#pragma unroll
                for (int n = 0; n < 2; ++n)
#pragma unroll
                    for (int j = 0; j < 4; ++j) { const float g = acc[ai][0][m][n][j] * rs, up = acc[ai][1][m][n][j] * rs;
                        const float s = g * __builtin_amdgcn_rcpf(1.0f + __builtin_amdgcn_exp2f(-g * LOG2E)); v[n * 4 + j] = s * up; }
                u32x4 w; w.x = cvtpk(v[0], v[1]); w.y = cvtpk(v[2], v[3]); w.z = cvtpk(v[4], v[5]); w.w = cvtpk(v[6], v[7]);
                *(u32x4*)rowp = w; }
    }
};
struct EpiResid {
    static constexpr bool PERM = false;
    __device__ __forceinline__ void prefetch(float (&)[8], const Unit&, int, int) const {}
    const float* base; float* out; bf16_t* xb; float* ssq; int ldc; float alpha;
    __device__ __forceinline__ void operator()(const f32x4 (&acc)[2][2][4][2], const Unit& u, int wr, int wc, int fr, int fq, const float (&pre)[8]) const {
        const int row0 = u.pm * BM + wr * 64 + fr, col0 = u.pn * BM + wc * 32 + 4 * fq;
#pragma unroll
        for (int ai = 0; ai < 2; ++ai)
#pragma unroll
            for (int m = 0; m < 4; ++m) { const int row = row0 + ai * HALF + m * 16; const size_t off = (size_t)row * ldc + col0; float ss = 0.f;
#pragma unroll
                for (int bj = 0; bj < 2; ++bj)
#pragma unroll
                    for (int n = 0; n < 2; ++n) { const f32x4 bs = *(const f32x4*)(base + off + bj * HALF + n * 16); const f32x4 o = bs + acc[ai][bj][m][n] * alpha;
                        *(f32x4*)(out + off + bj * HALF + n * 16) = o; ss += (o.x * o.x + o.y * o.y) + (o.z * o.z + o.w * o.w);
                        u32x2 w; w.x = cvtpk(o.x, o.y); w.y = cvtpk(o.z, o.w); *(u32x2*)(xb + kt_off(row, col0 + bj * HALF + n * 16, ldc)) = w; }
                const int lane = fq * 16 + fr; ss += shx(ss, 16, lane); ss += shx(ss, 32, lane);
                if (fq == 0) ssq[(size_t)row * 32 + u.pn * 4 + wc] = ss; }
    }
};
struct EpiF32Z {
    static constexpr bool PERM = false;
    float* C; int ldc; size_t zstride;
    __device__ __forceinline__ void prefetch(float (&)[8], const Unit&, int, int) const {}
    __device__ __forceinline__ void operator()(const f32x4 (&acc)[2][2][4][2], const Unit& u, int wr, int wc, int fr, int fq, const float (&pre)[8]) const {
        float* Cz = C + (size_t)u.z * zstride;
        const int row0 = u.pm * BM + wr * 64 + fr, col0 = u.pn * BM + wc * 32 + 4 * fq;
#pragma unroll
        for (int ai = 0; ai < 2; ++ai)
#pragma unroll
            for (int m = 0; m < 4; ++m) { float* rowp = Cz + (size_t)(row0 + ai * HALF + m * 16) * ldc + col0;
#pragma unroll
                for (int bj = 0; bj < 2; ++bj)
#pragma unroll
                    for (int n = 0; n < 2; ++n) *(f32x4*)(rowp + bj * HALF + n * 16) = acc[ai][bj][m][n]; }
    }
};

template <class Epi, class Sched, int KSTEP_A = 128, int KSTEP_B = 128>
__device__ __forceinline__ void gemm_phase(LAS unsigned char* lds, const Gemm g, const Sched& S, const Epi& E, const int wv) {
    const int tid = opq_tid(wv), wid = __builtin_amdgcn_readfirstlane(tid >> 6), lane = tid & 63, wr = wid >> 2, wc = wid & 3, fr = lane & 15, fq = lane >> 4;
    const int K = g.K, nt = K / BK;
    unsigned voffA[2], voffB[2];
#pragma unroll
    for (int i = 0; i < 2; ++i) { int R, C; stage_rc(tid * 16 + i * 8192, R, C); const int Rb = Epi::PERM ? ((R & ~31) + perm32(R & 31)) : R;
        voffA[i] = (unsigned)(R * g.lda + C) * 2u; voffB[i] = (unsigned)(Rb * g.ldb + C) * 2u; }
    constexpr size_t kstepA = (size_t)KSTEP_A, kstepB = (size_t)KSTEP_B;
    const size_t hstepA = (size_t)HALF * g.lda * 2, hstepB = (size_t)HALF * g.ldb * 2;
    const unsigned ldsw = (unsigned)wid * 1024u;
    const int aoff = lds_byte(wr * 64 + fr, fq * 8), boff = lds_byte(wc * 32 + fr, fq * 8);
#define PG8_SA(b, h) (((b) * 2 + (h)) * HTB)
#define PG8_SB(b, h) ((4 + (b) * 2 + (h)) * HTB)
#define PG8_STAGE(bufoff, gbase, voff) do { _Pragma("unroll") for (int _i = 0; _i < 2; ++_i) \
        __builtin_amdgcn_global_load_lds((const unsigned*)((const char*)(gbase) + (voff)[_i]), (LAS unsigned*)(lds + (bufoff) + ldsw + _i * 8192), 16, 0, 0); } while (0)
#define PG8_LDA(dst, b, h) do { _Pragma("unroll") for (int m = 0; m < 4; ++m) _Pragma("unroll") for (int k = 0; k < 2; ++k) dst[m][k] = *(const LAS bf16x8*)(lds + PG8_SA(b, h) + aoff + m * 2048 + k * 1024); } while (0)
#define PG8_LDB(dst, b, h) do { _Pragma("unroll") for (int n = 0; n < 2; ++n) _Pragma("unroll") for (int k = 0; k < 2; ++k) dst[n][k] = *(const LAS bf16x8*)(lds + PG8_SB(b, h) + boff + n * 2048 + k * 1024); } while (0)
#define PG8_MMA(ai, bj, At, Bt) do { __builtin_amdgcn_s_setprio(1); _Pragma("unroll") for (int m = 0; m < 4; ++m) _Pragma("unroll") for (int n = 0; n < 2; ++n) _Pragma("unroll") for (int k = 0; k < 2; ++k) \
        acc[ai][bj][m][n] = __builtin_amdgcn_mfma_f32_16x16x32_bf16(Bt[n][k], At[m][k], acc[ai][bj][m][n], 0, 0, 0); __builtin_amdgcn_s_setprio(0); } while (0)
#define PG8_WAIT_V(n) asm volatile("s_waitcnt vmcnt(" #n ")" ::: "memory")
#define PG8_WAIT_L(n) asm volatile("s_waitcnt lgkmcnt(" #n ")" ::: "memory")
#define PG8_BAR __builtin_amdgcn_s_barrier()
#define PG8_SCHED __builtin_amdgcn_sched_barrier(0)
    Unit cur, nxt; int ui = 0;
    if (!S.next(0, cur)) return;
    f32x4 acc[2][2][4][2];
#pragma unroll
    for (int a = 0; a < 2; ++a)
#pragma unroll
        for (int b = 0; b < 2; ++b)
#pragma unroll
            for (int m = 0; m < 4; ++m)
#pragma unroll
                for (int n = 0; n < 2; ++n) acc[a][b][m][n] = (f32x4){0.f, 0.f, 0.f, 0.f};
    bf16x8 At[4][2], B0[2][2], B1[2][2];
    const char* cA = S.a_ptr(cur); const char* cB = S.b_ptr(cur);
    float pre[8]; E.prefetch(pre, cur, wr, fr);
    PG8_STAGE(PG8_SB(0, 0), cB, voffB); PG8_STAGE(PG8_SA(0, 0), cA, voffA); PG8_STAGE(PG8_SB(0, 1), cB + hstepB, voffB); PG8_STAGE(PG8_SA(0, 1), cA + hstepA, voffA);
    if (wr == 1) PG8_BAR;
    PG8_WAIT_V(4); PG8_BAR;
    PG8_STAGE(PG8_SB(1, 0), cB + kstepB, voffB); PG8_STAGE(PG8_SA(1, 0), cA + kstepA, voffA); PG8_STAGE(PG8_SB(1, 1), cB + hstepB + kstepB, voffB);
    PG8_WAIT_V(6); PG8_BAR;
    for (;;) {
        const bool has_next = S.next(ui + 1, nxt);
        const char* nA = has_next ? S.a_ptr(nxt) : cA; const char* nB = has_next ? S.b_ptr(nxt) : cB;
        for (int t = 0; t < nt; t += 2) {
            const bool last = (t == nt - 2);
            const char* a1 = cA + (size_t)(t + 1) * kstepA;
            const char* a2 = last ? nA : cA + (size_t)(t + 2) * kstepA; const char* b2 = last ? nB : cB + (size_t)(t + 2) * kstepB;
            const char* a3 = a2 + kstepA; const char* b3 = b2 + kstepB;
            PG8_LDB(B0, 0, 0); PG8_SCHED; PG8_LDA(At, 0, 0); PG8_STAGE(PG8_SA(1, 1), a1 + hstepA, voffA);
            PG8_WAIT_L(8); PG8_BAR; PG8_WAIT_L(0); PG8_MMA(0, 0, At, B0); PG8_BAR; PG8_SCHED;
            PG8_LDB(B1, 0, 1); PG8_STAGE(PG8_SB(0, 0), b2, voffB);
            PG8_BAR; PG8_WAIT_L(0); PG8_MMA(0, 1, At, B1); PG8_BAR;
            PG8_LDA(At, 0, 1); PG8_STAGE(PG8_SA(0, 0), a2, voffA);
            PG8_BAR; PG8_WAIT_L(0); PG8_MMA(1, 0, At, B0); PG8_BAR; PG8_SCHED;
            PG8_STAGE(PG8_SB(0, 1), b2 + hstepB, voffB);
            PG8_WAIT_V(6); PG8_BAR; PG8_MMA(1, 1, At, B1); PG8_BAR;
            PG8_LDB(B0, 1, 0); PG8_SCHED; PG8_LDA(At, 1, 0); PG8_STAGE(PG8_SA(0, 1), a2 + hstepA, voffA);
            PG8_WAIT_L(8); PG8_BAR; PG8_WAIT_L(0); PG8_MMA(0, 0, At, B0); PG8_BAR; PG8_SCHED;
            PG8_LDB(B1, 1, 1); PG8_STAGE(PG8_SB(1, 0), b3, voffB);
            PG8_BAR; PG8_WAIT_L(0); PG8_MMA(0, 1, At, B1); PG8_BAR;
            PG8_LDA(At, 1, 1); PG8_STAGE(PG8_SA(1, 0), a3, voffA);
            PG8_BAR; PG8_WAIT_L(0); PG8_MMA(1, 0, At, B0); PG8_BAR; PG8_SCHED;
            PG8_STAGE(PG8_SB(1, 1), b3 + hstepB, voffB);
            PG8_WAIT_V(6); PG8_BAR; PG8_MMA(1, 1, At, B1); PG8_BAR;
        }
        E(acc, cur, wr, wc, fr, fq, pre);
        if (has_next) E.prefetch(pre, nxt, wr, fr);
        if (!has_next) break;
#pragma unroll
        for (int a = 0; a < 2; ++a)
#pragma unroll
            for (int b = 0; b < 2; ++b)
#pragma unroll
                for (int m = 0; m < 4; ++m)
#pragma unroll
                    for (int n = 0; n < 2; ++n) acc[a][b][m][n] = (f32x4){0.f, 0.f, 0.f, 0.f};
        cur = nxt; cA = nA; cB = nB; ++ui;
    }
    PG8_WAIT_V(0);
    if (wr == 0) PG8_BAR;
    PG8_BAR;
#undef PG8_SA
#undef PG8_SB
#undef PG8_STAGE
#undef PG8_LDA
#undef PG8_LDB
#undef PG8_MMA
#undef PG8_WAIT_V
#undef PG8_WAIT_L
#undef PG8_BAR
#undef PG8_SCHED
}
}

struct Args { const float* in[24]; float* out; unsigned char* ws; };
enum { I_X = 0, I_F1N, I_F1W1, I_F1W3, I_F1W2, I_MIXN, I_WIN, I_GB, I_QNA, I_KNA, I_QNN, I_KNN, I_POS, I_CKW1, I_CKW2, I_CVW1, I_CVW2, I_ON, I_WOUT, I_F2N, I_F2W1, I_F2W3, I_F2W2, I_RB };

__device__ __forceinline__ void transpose_item(const float* W, int K, int N, bf16_t* WT, int mode, int off, LAS float* scr, int item, int lane, const float* gain) {
    const int nblk = (N + 31) / 32, kb = item / nblk, nb = item % nblk, k0 = 64 * kb, n0 = 32 * nb;
    const int c4 = 4 * (lane & 7), nn = n0 + c4;
    f32x4 ld[8];
#pragma unroll
    for (int i = 0; i < 8; ++i) { const int kk = 8 * i + (lane >> 3); ld[i] = (nn < N) ? *(const f32x4*)(W + (size_t)(k0 + kk) * N + nn) : (f32x4){0.f, 0.f, 0.f, 0.f}; if (gain) ld[i] = ld[i] * gain[k0 + kk]; }
#pragma unroll
    for (int i = 0; i < 8; ++i) { const int kk = 8 * i + (lane >> 3); LAS float* d = scr + kk * 33 + c4; d[0] = ld[i].x; d[1] = ld[i].y; d[2] = ld[i].z; d[3] = ld[i].w; }
    LDS_WAIT(); asm volatile("" ::: "memory");
    const int c = lane & 7;
#pragma unroll
    for (int j = 0; j < 4; ++j) { const int n = (lane >> 3) + 8 * j; const LAS float* s = scr + (8 * c) * 33 + n;
        u32x4 o; o.x = pk2(s[0 * 33], s[1 * 33]); o.y = pk2(s[2 * 33], s[3 * 33]); o.z = pk2(s[4 * 33], s[5 * 33]); o.w = pk2(s[6 * 33], s[7 * 33]);
        const int ng = n0 + n; const int dr = mode ? ((ng >> 7) * 256 + (ng & 127) + off) : (ng + off);
        if (ng < N) *(u32x4*)(WT + kt_off(dr, k0 + 8 * c, K)) = o; }
    LDS_WAIT(); asm volatile("" ::: "memory");
}
__device__ __forceinline__ int rel_bucket_dev(int n) {
    if (n < 16) return n;
    const float v = logf((float)n / 16.0f) / 4.852030263919617f * 16.0f;
    int b = 16 + (int)v; return b < 31 ? b : 31;
}
namespace att {
constexpr int SHM_V = 16384, SHM_K = 16384;
constexpr int L_V = 0, L_K = 32768, L_WS = 65536, L_TBL = 67584, L_IMP = L_TBL + 4 * TBLS * 4  , L_SELM = L_IMP + 32768  , L_END = L_SELM + 1024;
static_assert(L_END <= 131072, "attention LDS map");
constexpr float THR = 8.f;
#define KSWZ(row, colB) ((row) * 256 + ((colB) ^ (((row) & 7) << 4)))
__device__ __forceinline__ int v_st(int k, int c) { const int kk = (k & ~0xC) | ((k & 4) << 1) | ((k & 8) >> 1); return ((kk >> 3) * 4 + (c >> 5)) * 512 + ((kk & 7) * 32 + (c & 31)) * 2; }
__device__ __forceinline__ int v_rd_base(int lane) { return ((lane & 3) << 3) | (((lane >> 2) & 3) << 6) | (((lane >> 4) & 1) << 5) | (((lane >> 5) & 1) << 8); }
__device__ __forceinline__ int crow(int r, int hi) { return (r & 3) + 8 * (r >> 2) + 4 * hi; }

__device__ __forceinline__ void partialSM(f32x16& p0, f32x16& p1, float& m_reg, float& mn, float& alpha) {
    (void)m_reg; mn = 0.f; alpha = 1.f;
#pragma unroll
    for (int r = 0; r < 16; ++r) p0[r] = __builtin_amdgcn_exp2f(p0[r] * LOG2E);
#pragma unroll
    for (int r = 0; r < 16; ++r) p1[r] = p1[r] * LOG2E;
}
__device__ __forceinline__ void partialSM_row(f32x16& p0, f32x16& p1, float& m_reg, float& mn, float& alpha, bool ok, float bias) {
    (void)m_reg; mn = 0.f; alpha = 1.f;
    const float mnL = ok ? bias * LOG2E : -__builtin_inff();
#pragma unroll
    for (int r = 0; r < 16; ++r) p0[r] = __builtin_amdgcn_exp2f(fmaf(p0[r], LOG2E, mnL));
#pragma unroll
    for (int r = 0; r < 16; ++r) p1[r] = fmaf(p1[r], LOG2E, mnL);
}
#define PK4(P, B_, OUT) do { unsigned a0 = cvtpk(P[B_+0], P[B_+1]), a1 = cvtpk(P[B_+2], P[B_+3]);                          \
        unsigned b0 = cvtpk(P[B_+4], P[B_+5]), b1 = cvtpk(P[B_+6], P[B_+7]);                                             \
        auto r0 = __builtin_amdgcn_permlane32_swap(a0, b0, false, false); auto r1 = __builtin_amdgcn_permlane32_swap(a1, b1, false, false); \
        u32x4 w = {r0[0], r1[0], r0[1], r1[1]}; OUT = *reinterpret_cast<bf16x8*>(&w); } while (0)
__device__ __forceinline__ void finishSM(f32x16& p0, f32x16& p1, float alpha, float& l_reg, bf16x8& pa0, bf16x8& pa1, bf16x8& pa2, bf16x8& pa3) {
#pragma unroll
    for (int r = 0; r < 16; ++r) p1[r] = __builtin_amdgcn_exp2f(p1[r]);
    float ps = 0;
#pragma unroll
    for (int r = 0; r < 16; ++r) ps += p0[r];
#pragma unroll
    for (int r = 0; r < 16; ++r) ps += p1[r];
    { auto rr = __builtin_amdgcn_permlane32_swap(__float_as_uint(ps), __float_as_uint(ps), false, false);
      ps = __uint_as_float(rr[0]) + __uint_as_float(rr[1]); }
    l_reg = l_reg * alpha + ps;
    PK4(p0, 0, pa0); PK4(p0, 8, pa1); PK4(p1, 0, pa2); PK4(p1, 8, pa3);
}
__device__ __forceinline__ void qkt(f32x16& p0, f32x16& p1, const LAS char* Kb, int r32, int hi, const bf16x8 (&qr)[8]) {
    p0 = f32x16{}; p1 = f32x16{};
    const LAS char* kb4[4];
#pragma unroll
    for (int dd = 0; dd < 4; ++dd) kb4[dd] = Kb + KSWZ(r32, (dd * 16 + hi * 8) * 2);
#pragma unroll
    for (int d0 = 0; d0 < 8; ++d0) { const LAS char* a = kb4[d0 & 3] + (d0 >> 2) * 128;
        const bf16x8 b0 = *reinterpret_cast<const LAS bf16x8*>(a);
        const bf16x8 b1 = *reinterpret_cast<const LAS bf16x8*>(a + 32 * 256);
        p0 = __builtin_amdgcn_mfma_f32_32x32x16_bf16(b0, qr[d0], p0, 0, 0, 0);
        p1 = __builtin_amdgcn_mfma_f32_32x32x16_bf16(b1, qr[d0], p1, 0, 0, 0); }
}
__device__ __forceinline__ void pv_tile(f32x16 (&o)[4], int vb, bf16x8 pa0, bf16x8 pa1, bf16x8 pa2, bf16x8 pa3) {
#define TRRD(dst, off) asm volatile("ds_read_b64_tr_b16 %0, %1 offset:%2" : "=&v"(dst) : "v"(vb), "i"(off) : "memory")
#define PV_D0(d0) do { s16x4 l0, l1, l2, l3, h0, h1, h2, h3; constexpr int b_ = (d0) * 512; \
        TRRD(l0, b_); TRRD(h0, b_ + 2048); TRRD(l1, b_ + 4096); TRRD(h1, b_ + 6144); TRRD(l2, b_ + 8192); TRRD(h2, b_ + 10240); TRRD(l3, b_ + 12288); TRRD(h3, b_ + 14336); \
        asm volatile("s_waitcnt lgkmcnt(0)" ::: "memory"); SBAR(); \
        o[d0] = __builtin_amdgcn_mfma_f32_32x32x16_bf16(pa0, (bf16x8){l0[0], l0[1], l0[2], l0[3], h0[0], h0[1], h0[2], h0[3]}, o[d0], 0, 0, 0);   \
        o[d0] = __builtin_amdgcn_mfma_f32_32x32x16_bf16(pa1, (bf16x8){l1[0], l1[1], l1[2], l1[3], h1[0], h1[1], h1[2], h1[3]}, o[d0], 0, 0, 0);   \
        o[d0] = __builtin_amdgcn_mfma_f32_32x32x16_bf16(pa2, (bf16x8){l2[0], l2[1], l2[2], l2[3], h2[0], h2[1], h2[2], h2[3]}, o[d0], 0, 0, 0);   \
        o[d0] = __builtin_amdgcn_mfma_f32_32x32x16_bf16(pa3, (bf16x8){l3[0], l3[1], l3[2], l3[3], h3[0], h3[1], h3[2], h3[3]}, o[d0], 0, 0, 0); } while (0)
    PV_D0(0); PV_D0(1); PV_D0(2); PV_D0(3);
#undef PV_D0
#undef TRRD
}

template <class Cfg>
__device__ __forceinline__ void attn_tiles(const Cfg& c, LAS char* lds, const bf16x8 (&qr)[8], f32x16 (&o)[4], float& m_reg, float& l_reg, const int t_lo, const int t_hi, const int wv) {
    const int tid = opq_tid(wv), lane = tid & 63, wid = __builtin_amdgcn_readfirstlane(tid >> 6), r32 = lane & 31, hi = lane >> 5;
    LAS char* V_lds = lds + L_V; LAS char* K_lds = lds + L_K;
    LAS float* al_l = (LAS float*)(lds + L_WS) + wid * 64 + 32;
    const int sr = tid >> 4, sc = (tid & 15) * 8;
    const int vst0 = v_st(sr, sc), vst1 = v_st(32 + sr, sc), kws = KSWZ(sr, sc * 2);
    const int vb0 = (int)(unsigned)(uintptr_t)V_lds + v_rd_base(lane);
    bf16x8 sk0, sk1, sv0, sv1;
#define AT_LOAD(t) do { sk0 = *(const bf16x8*)(c.krow((t), sr) + sc); sk1 = *(const bf16x8*)(c.krow((t), sr + 32) + sc); \
        if constexpr (Cfg::MODE == 0) { sv0 = *(const bf16x8*)(c.vrow((t), sr) + sc); sv1 = *(const bf16x8*)(c.vrow((t), sr + 32) + sc); } \
        asm volatile("" ::: "memory"); SBAR(); } while (0)
#define AT_WRITE(t, bf) do { *(LAS bf16x8*)(K_lds + (bf) * SHM_K + kws) = sk0; *(LAS bf16x8*)(K_lds + (bf) * SHM_K + kws + 32 * 256) = sk1; \
        if constexpr (Cfg::MODE == 1) { \
            _Pragma("unroll") for (int i_ = 0; i_ < 8; ++i_) { const int n_ = sc + i_, c0_ = 64 * (t) + sr, c1_ = c0_ + 32; \
                sv0[i_] = (c0_ >= 4 * n_ - 1 && c0_ <= 4 * n_ + 3) ? (short)0x3F80 : (short)0; sv1[i_] = (c1_ >= 4 * n_ - 1 && c1_ <= 4 * n_ + 3) ? (short)0x3F80 : (short)0; } } \
        *(LAS bf16x8*)(V_lds + (bf) * SHM_V + vst0) = sv0; *(LAS bf16x8*)(V_lds + (bf) * SHM_V + vst1) = sv1; } while (0)
    __syncthreads();
    if (t_lo < t_hi) { AT_LOAD(t_lo); AT_WRITE(t_lo, 0); }
    __syncthreads();
    for (int t = t_lo; t < t_hi; ++t) {
        const int buf = (t - t_lo) & 1; const bool more = (t + 1 < t_hi);
        if (more) AT_LOAD(t + 1);
        if (c.active(t)) {
            f32x16 p0, p1;
            qkt(p0, p1, K_lds + buf * SHM_K, r32, hi, qr);
            if constexpr (Cfg::MODE == 0) {
                float mn, alpha; bf16x8 pa0, pa1, pa2, pa3;
                bool rok; float rbias;
                if (c.rowconst(t, rok, rbias)) partialSM_row(p0, p1, m_reg, mn, alpha, rok, rbias);
                else { c.mask(p0, p1, t); partialSM(p0, p1, m_reg, mn, alpha); }
                if (__any(alpha < 1.f)) { if (hi == 0) al_l[r32] = alpha; LDS_WAIT();
#pragma unroll
                    for (int d_ = 0; d_ < 4; ++d_)
#pragma unroll
                        for (int r = 0; r < 16; ++r) o[d_][r] *= al_l[crow(r, hi)]; }
                finishSM(p0, p1, alpha, l_reg, pa0, pa1, pa2, pa3); SBAR();
                pv_tile(o, vb0 + buf * SHM_V, pa0, pa1, pa2, pa3);
            } else {
                c.mask(p0, p1, t);
                const float mL = -c.mfix * LOG2E; const float il = c.invl;
#pragma unroll
                for (int r = 0; r < 16; ++r) { p0[r] = __builtin_amdgcn_exp2f(fmaf(p0[r], LOG2E, mL)) * il; p1[r] = __builtin_amdgcn_exp2f(fmaf(p1[r], LOG2E, mL)) * il; }
                bf16x8 pa0, pa1, pa2, pa3;
                PK4(p0, 0, pa0); PK4(p0, 8, pa1); PK4(p1, 0, pa2); PK4(p1, 8, pa3); SBAR();
                pv_tile(o, vb0 + buf * SHM_V, pa0, pa1, pa2, pa3);
#pragma unroll
                for (int r = 0; r < 16; r += 2) { const unsigned a = cvtpk(p0[r], p0[r + 1]), b = cvtpk(p1[r], p1[r + 1]);
                    p0[r] -= bflo(a); p0[r + 1] -= bfhi(a); p1[r] -= bflo(b); p1[r + 1] -= bfhi(b); }
                PK4(p0, 0, pa0); PK4(p0, 8, pa1); PK4(p1, 0, pa2); PK4(p1, 8, pa3); SBAR();
                pv_tile(o, vb0 + buf * SHM_V, pa0, pa1, pa2, pa3);
            }
        }
        if (more) AT_WRITE(t + 1, buf ^ 1);
        __syncthreads();
    }
#undef AT_LOAD
#undef AT_WRITE
}

struct DilCfg {
    static constexpr int MODE = 0;
    const bf16_t* Kb; const bf16_t* Vb;
    const LAS float* tbl; int dshift, res, u, dqm, s0;
    __device__ __forceinline__ const bf16_t* krow(int t, int kk) const { int s = 256 * u - 128 + 64 * t + kk; s = s < 0 ? 0 : s; return Kb + (size_t)((s << dshift) + res) * PC; }
    __device__ __forceinline__ const bf16_t* vrow(int t, int kk) const { int s = 256 * u - 128 + 64 * t + kk; s = s < 0 ? 0 : s; return Vb + (size_t)((s << dshift) + res) * PC; }
    __device__ __forceinline__ bool active(int t) const { const int kb = 256 * u - 128 + 64 * t; return kb <= s0 + 31 && kb + 63 >= s0 - 128; }
    __device__ __forceinline__ bool rowconst(int, bool&, float&) const { return false; }
    __device__ __forceinline__ void mask(f32x16& p0, f32x16& p1, int t) const {
        const int dq = dqm - (256 * u - 128 + 64 * t); const float NEG = -__builtin_inff();
        const LAS float* tb = tbl + (DT0 + dq - 63);
#pragma unroll
        for (int r = 0; r < 16; ++r) { const int cc = (r & 3) + 8 * (r >> 2); const unsigned d0 = (unsigned)(dq - cc), d1 = (unsigned)(dq - cc - 32);
            const float b0 = tb[63 - cc], b1 = tb[31 - cc];
            p0[r] = (d0 <= 128u) ? p0[r] + b0 : NEG; p1[r] = (d1 <= 128u) ? p1[r] + b1 : NEG; }
    }
};
struct CmpCfg {
    static constexpr int MODE = 0;
    const bf16_t* Kb; const bf16_t* Vb; int cmax, hi4, cfull;
    __device__ __forceinline__ bool rowconst(int t, bool& ok, float& bias) const { ok = true; bias = 0.f; return 64 * t + 63 <= cfull; }
    __device__ __forceinline__ const bf16_t* krow(int t, int kk) const { return Kb + (size_t)(64 * t + kk) * HD; }
    __device__ __forceinline__ const bf16_t* vrow(int t, int kk) const { return Vb + (size_t)(64 * t + kk) * HD; }
    __device__ __forceinline__ bool active(int) const { return true; }
    __device__ __forceinline__ void mask(f32x16& p0, f32x16& p1, int t) const {
        const int cb = 64 * t + hi4; const float NEG = -__builtin_inff();
#pragma unroll
        for (int r = 0; r < 16; ++r) { const int cc = cb + (r & 3) + 8 * (r >> 2); if (cc > cmax) p0[r] = NEG; if (cc + 32 > cmax) p1[r] = NEG; }
    }
};
struct CmpImpCfg {
    static constexpr int MODE = 1;
    const bf16_t* Kb; int cmax, hi4; float mfix, invl;
    __device__ __forceinline__ const bf16_t* krow(int t, int kk) const { return Kb + (size_t)(64 * t + kk) * HD; }
    __device__ __forceinline__ const bf16_t* vrow(int, int) const { return Kb; }
    __device__ __forceinline__ bool active(int) const { return true; }
    __device__ __forceinline__ void mask(f32x16& p0, f32x16& p1, int t) const {
        const int cb = 64 * t + hi4; const float NEG = -__builtin_inff();
#pragma unroll
        for (int r = 0; r < 16; ++r) { const int cc = cb + (r & 3) + 8 * (r >> 2); if (cc > cmax) p0[r] = NEG; if (cc + 32 > cmax) p1[r] = NEG; }
    }
};
struct SlcCfg {
    static constexpr int MODE = 0;
    const bf16_t* Kb; const bf16_t* Vb;
    const LAS float* tblh;
    unsigned s0, s1, s2, s3; int tqm, cur; float b31;
    __device__ __forceinline__ const bf16_t* krow(int t, int kk) const { return Kb + (size_t)(64 * t + kk) * PC; }
    __device__ __forceinline__ const bf16_t* vrow(int t, int kk) const { return Vb + (size_t)(64 * t + kk) * PC; }
    __device__ __forceinline__ bool selbit(int t) const { const unsigned q = (unsigned)t >> 5; const unsigned w = (q == 0u ? s0 + 0u : 0u) | (q == 1u ? s1 + 0u : 0u) | (q == 2u ? s2 + 0u : 0u) | (q == 3u ? s3 + 0u : 0u); return (w >> (t & 31)) & 1u; }
    __device__ __forceinline__ bool active(int t) const { return __any(selbit(t)); }
    __device__ __forceinline__ bool rowconst(int t, bool& ok, float& bias) const { ok = selbit(t); bias = b31; return 64 * (cur - t) - 63 >= 1513; }
    __device__ __forceinline__ void mask(f32x16& p0, f32x16& p1, int t) const {
        const bool sel = selbit(t); const int dq = tqm - 64 * t; const float NEG = -__builtin_inff();
        const LAS float* tb = tblh + (TBL0 + dq - 63);
#pragma unroll
        for (int r = 0; r < 16; ++r) { const int cc = (r & 3) + 8 * (r >> 2); const int d0 = dq - cc, d1 = dq - cc - 32;
            const float b0 = tb[63 - cc], b1 = tb[31 - cc];
            p0[r] = (sel && d0 >= 0) ? p0[r] + b0 : NEG; p1[r] = (sel && d1 >= 0) ? p1[r] + b1 : NEG; }
    }
};
struct WinCfg {
    static constexpr int MODE = 0;
    const bf16_t* Kb; const bf16_t* Vb; const LAS float* tblh; int tqm;
    __device__ __forceinline__ bool rowconst(int, bool&, float&) const { return false; }
    __device__ __forceinline__ const bf16_t* krow(int t, int kk) const { return Kb + (size_t)(64 * t + kk) * PC; }
    __device__ __forceinline__ const bf16_t* vrow(int t, int kk) const { return Vb + (size_t)(64 * t + kk) * PC; }
    __device__ __forceinline__ bool active(int) const { return true; }
    __device__ __forceinline__ void mask(f32x16& p0, f32x16& p1, int t) const {
        const int dq = tqm - 64 * t; const float NEG = -__builtin_inff();
        const LAS float* tb = tblh + (TBL0 + dq - 63);
#pragma unroll
        for (int r = 0; r < 16; ++r) { const int cc = (r & 3) + 8 * (r >> 2); const unsigned d0 = (unsigned)(dq - cc), d1 = (unsigned)(dq - cc - 32);
            const float b0 = tb[63 - cc], b1 = tb[31 - cc];
            p0[r] = (d0 < 512u) ? p0[r] + b0 : NEG; p1[r] = (d1 < 512u) ? p1[r] + b1 : NEG; }
    }
};
}

__device__ __forceinline__ void dil_unit(LAS char* lds, const bf16_t* P, bf16_t* OA, float* LSE, const float* dilT, int pat, int dshift, int unit, const int wv) {
    using namespace att;
    const int tid = opq_tid(wv), lane = tid & 63, wid = __builtin_amdgcn_readfirstlane(tid >> 6), r32 = lane & 31, hi = lane >> 5;
    const int bh = unit >> 5, ru = unit & 31, b = bh >> 3, h = bh & 7;
    const int ncs = 5 - dshift, res = ru >> ncs, u = ru & ((1 << ncs) - 1);
    LAS float* tbl = (LAS float*)(lds + L_TBL);
    __syncthreads();
    if (tid < DTS) tbl[tid] = dilT[(pat * 8 + h) * DTS + tid];
    const int s0 = 256 * u + 32 * wid, s_row = s0 + r32;
    const size_t tokrow = (size_t)b * SEQ + (size_t)((s_row << dshift) + res);
    bf16x8 qr[8];
    { const bf16_t* qp = P + tokrow * PC + C_QA + h * HD + hi * 8;
#pragma unroll
      for (int d0 = 0; d0 < 8; ++d0) qr[d0] = *(const bf16x8*)(qp + d0 * 16); }
    f32x16 o[4]; float m_reg, l_reg;
    m_reg = 0.f;
    if (pat == 0) { l_reg = 0.f;
#pragma unroll
        for (int d0 = 0; d0 < 4; ++d0) o[d0] = f32x16{}; }
    else { l_reg = LSE[tokrow * 8 + h];
#pragma unroll
        for (int r = 0; r < 16; ++r) { const size_t tr = (size_t)b * SEQ + (size_t)(((s0 + crow(r, hi)) << dshift) + res); const bf16_t* op = OA + tr * 1024 + h * HD + r32;
#pragma unroll
            for (int d0 = 0; d0 < 4; ++d0) o[d0][r] = bf2f(op[d0 * 32]); } }
    DilCfg c; c.Kb = P + (size_t)b * SEQ * PC + C_KA + h * HD; c.Vb = P + (size_t)b * SEQ * PC + C_VA + h * HD; c.tbl = tbl; c.dshift = dshift; c.res = res; c.u = u; c.dqm = s_row - 4 * hi; c.s0 = s0;
    attn_tiles(c, lds, qr, o, m_reg, l_reg, (u == 0) ? 2 : 0, 6, wv);
    LAS float* li_l = (LAS float*)(lds + L_WS) + wid * 64;
    if (hi == 0) { li_l[r32] = l_reg; LSE[tokrow * 8 + h] = l_reg; }
    LDS_WAIT();
#pragma unroll
    for (int r = 0; r < 16; ++r) { const int orow = crow(r, hi); const float rl = (pat == 2) ? 1.0f / li_l[orow] : 1.0f;
        const size_t tr = (size_t)b * SEQ + (size_t)(((s0 + orow) << dshift) + res); bf16_t* op = OA + tr * 1024 + h * HD;
#pragma unroll
        for (int d0 = 0; d0 < 4; ++d0) { const float v = o[d0][r] * rl; const float vn = shx(v, 1, lane);
            if ((r32 & 1) == 0) *(unsigned*)(op + d0 * 32 + r32) = cvtpk(v, vn); } }
}

__device__ __forceinline__ void nsa_finalize(LAS char* lds, const f32x16 (&o)[4], float l_reg, const bf16_t* P, bf16_t* ON, const float* gb, int b, int g, int tok0, int br, const int wv) {
    using namespace att;
    const int tid = opq_tid(wv), lane = tid & 63, wid = __builtin_amdgcn_readfirstlane(tid >> 6), r32 = lane & 31, hi = lane >> 5;
    LAS float* li_l = (LAS float*)(lds + L_WS) + wid * 64;
    if (hi == 0) li_l[r32] = l_reg;
    LDS_WAIT();
    bf16_t* ONb = ON + (size_t)br * NTOK * 1024;
#pragma unroll
    for (int r = 0; r < 16; ++r) { const int j = r & 3, k = r >> 2; const float lr = li_l[crow(r, hi)]; const float rl = lr > 0.f ? 1.0f / lr : 0.f;
        const size_t tok = (size_t)b * SEQ + tok0 + 2 * k + hi; const int hh = 4 * g + j;
        const float gl = bf2f(P[tok * PC + C_GL + hh * 3 + br]) + gb[hh * 3 + br];
        const float sc = rl * __builtin_amdgcn_rcpf(1.0f + __builtin_amdgcn_exp2f(-gl * LOG2E));
        bf16_t* op = ONb + tok * 1024 + hh * HD;
#pragma unroll
        for (int d0 = 0; d0 < 4; ++d0) { const float v = o[d0][r] * sc; const float vn = shx(v, 1, lane);
            if ((r32 & 1) == 0) *(unsigned*)(op + d0 * 32 + r32) = cvtpk(v, vn); } }
}
__device__ __forceinline__ void nsa_unit(LAS char* lds, const bf16_t* P, const bf16_t* KC, const bf16_t* VC, bf16_t* ON, const float* nsaT, const float* gb, int b, int g, int qi, bool load_tbl, const int wv) {
    using namespace att;
    const int tid = opq_tid(wv), lane = tid & 63, wid = __builtin_amdgcn_readfirstlane(tid >> 6), r32 = lane & 31, hi = lane >> 5;
    LAS float* tbl = (LAS float*)(lds + L_TBL); LAS float* IMP = (LAS float*)(lds + L_IMP); LAS unsigned* SELM = (LAS unsigned*)(lds + L_SELM);
    __syncthreads();
    if (load_tbl) for (int i = tid; i < 4 * TBLS; i += NTHR) tbl[i] = nsaT[(size_t)(4 * g) * TBLS + i];
    const int tok0 = 64 * qi + 8 * wid, tq = tok0 + (r32 >> 2), hd = r32 & 3;
    const bf16_t* Pb = P + (size_t)b * SEQ * PC;
    bf16x8 qr[8];
    { const bf16_t* qp = Pb + (size_t)tq * PC + C_QN + (4 * g + hd) * HD + hi * 8;
#pragma unroll
      for (int d0 = 0; d0 < 8; ++d0) qr[d0] = *(const bf16x8*)(qp + d0 * 16); }
    const bf16_t* KCb = KC + (size_t)(b * 2 + g) * 512 * HD; const bf16_t* VCb = VC + (size_t)(b * 2 + g) * 512 * HD;
    const int ntc = (qi >> 4) + 1, cmax = (tq - 31) >> 4;
    f32x16 o[4]; float m_reg, l_reg;
#pragma unroll
    for (int d0 = 0; d0 < 4; ++d0) o[d0] = f32x16{};
    m_reg = 0.f; l_reg = 0.f;
    { CmpCfg c; c.Kb = KCb; c.Vb = VCb; c.cmax = cmax; c.hi4 = 4 * hi; c.cfull = (64 * qi - 31) >> 4; attn_tiles(c, lds, qr, o, m_reg, l_reg, 0, ntc, wv); }
    nsa_finalize(lds, o, l_reg, P, ON, gb, b, g, tok0, 0, wv);
    { CmpImpCfg c; c.Kb = KCb; c.cmax = cmax; c.hi4 = 4 * hi; c.mfix = 0.f; c.invl = l_reg > 0.f ? 1.0f / l_reg : 0.f;
#pragma unroll
      for (int d0 = 0; d0 < 4; ++d0) o[d0] = f32x16{};
      float md = 0.f, ld = 0.f; attn_tiles(c, lds, qr, o, md, ld, 0, ntc, wv); }
#pragma unroll
    for (int d0 = 0; d0 < 4; ++d0)
#pragma unroll
        for (int k = 0; k < 4; ++k) IMP[(8 * wid + 2 * k + hi) * 128 + 32 * d0 + r32] = (o[d0][4 * k] + o[d0][4 * k + 1]) + (o[d0][4 * k + 2] + o[d0][4 * k + 3]);
    __syncthreads();
    { const int cur = qi;
#pragma unroll 1
      for (int tl = 8 * wid; tl < 8 * wid + 8; ++tl) {
        const int n0 = lane, n1 = 64 + lane; bool sel0, sel1;
        if (cur <= 15) { sel0 = (n0 <= cur); sel1 = false; }
        else {
            const float v0 = IMP[tl * 128 + n0], v1 = IMP[tl * 128 + n1];
            const unsigned u0 = (n0 >= 1 && n0 <= cur - 2) ? __float_as_uint(v0) + 1u : 0u, u1 = (n1 <= cur - 2) ? __float_as_uint(v1) + 1u : 0u;
            unsigned T = 0u;
#pragma unroll 1
            for (int bit = 30; bit >= 0; --bit) { const unsigned cand = T | (1u << bit);
                const int cnt = __builtin_popcountll(__ballot(u0 >= cand)) + __builtin_popcountll(__ballot(u1 >= cand));
                if (cnt >= 13) T = cand; }
            const bool gt0 = u0 > T, gt1 = u1 > T;
            const int need = 13 - (__builtin_popcountll(__ballot(gt0)) + __builtin_popcountll(__ballot(gt1)));
            const bool eq0 = (u0 == T), eq1 = (u1 == T);
            const unsigned long long m0 = __ballot(eq0), m1 = __ballot(eq1);
            const int pre0 = (int)__builtin_amdgcn_mbcnt_hi((unsigned)(m0 >> 32), __builtin_amdgcn_mbcnt_lo((unsigned)m0, 0u));
            const int pre1 = __builtin_popcountll(m0) + (int)__builtin_amdgcn_mbcnt_hi((unsigned)(m1 >> 32), __builtin_amdgcn_mbcnt_lo((unsigned)m1, 0u));
            sel0 = (n0 == 0 || n0 == cur || n0 == cur - 1) || gt0 || (eq0 && pre0 < need);
            sel1 = (n1 == cur || n1 == cur - 1) || gt1 || (eq1 && pre1 < need);
        }
        const unsigned long long b0 = __ballot(sel0), b1 = __ballot(sel1);
        if (lane == 0) { SELM[tl * 4 + 0] = (unsigned)b0; SELM[tl * 4 + 1] = (unsigned)(b0 >> 32); SELM[tl * 4 + 2] = (unsigned)b1; SELM[tl * 4 + 3] = (unsigned)(b1 >> 32); } } }
    __syncthreads();
    { SlcCfg c; c.Kb = Pb + C_KS + g * HD; c.Vb = Pb + C_VS + g * HD; c.tblh = tbl + hd * TBLS; c.tqm = tq - 4 * hi; c.cur = qi; c.b31 = tbl[hd * TBLS + TBL0 + 1600];
      const int tl = 8 * wid + (r32 >> 2); c.s0 = SELM[tl * 4 + 0]; c.s1 = SELM[tl * 4 + 1]; c.s2 = SELM[tl * 4 + 2]; c.s3 = SELM[tl * 4 + 3];
#pragma unroll
      for (int d0 = 0; d0 < 4; ++d0) o[d0] = f32x16{};
      m_reg = 0.f; l_reg = 0.f;
      attn_tiles(c, lds, qr, o, m_reg, l_reg, 0, qi + 1, wv); }
    nsa_finalize(lds, o, l_reg, P, ON, gb, b, g, tok0, 1, wv);
    { WinCfg c; c.Kb = Pb + C_KW + g * HD; c.Vb = Pb + C_VW + g * HD; c.tblh = tbl + hd * TBLS; c.tqm = tq - 4 * hi;
#pragma unroll
      for (int d0 = 0; d0 < 4; ++d0) o[d0] = f32x16{};
      m_reg = 0.f; l_reg = 0.f;
      attn_tiles(c, lds, qr, o, m_reg, l_reg, qi >= 8 ? qi - 8 : 0, qi + 1, wv); }
    nsa_finalize(lds, o, l_reg, P, ON, gb, b, g, tok0, 2, wv);
}

constexpr int LDS_BYTES = 147456;
constexpr int LDS_MISC = 131072;
constexpr int LDS_ARGS = LDS_MISC + 64;
__device__ __forceinline__ unsigned long long arg_u64(LAS unsigned char* lds, int i) {
    const LAS unsigned* p = (const LAS unsigned*)(opq_lds(lds) + LDS_ARGS) + 2 * i;
    const unsigned lo = __builtin_amdgcn_readfirstlane(p[0]), hi = __builtin_amdgcn_readfirstlane(p[1]);
    return ((unsigned long long)hi << 32) | lo;
}
#define GAS __attribute__((address_space(1)))
__device__ __forceinline__ const float* arg_in(LAS unsigned char* lds, int i) { return (const float*)(GAS const float*)arg_u64(lds, i); }
__device__ __forceinline__ float* arg_out(LAS unsigned char* lds) { return (float*)(GAS float*)arg_u64(lds, 24); }
__device__ __forceinline__ unsigned char* arg_ws(LAS unsigned char* lds) { return (unsigned char*)(GAS unsigned char*)arg_u64(lds, 25); }
__device__ __forceinline__ int opq_bx() { int b = blockIdx.x; asm volatile("" : "+s"(b)); return b; }
__device__ __forceinline__ int opq_g() { int b = gridDim.x; asm volatile("" : "+s"(b)); return b; }

__device__ __forceinline__ void ph_prologue(LAS unsigned char* lds, const int wv) {
    lds = opq_lds(lds);
    const int tid = opq_tid(wv), lane = tid & 63, wave = __builtin_amdgcn_readfirstlane(tid >> 6), G = opq_g(), bx = opq_bx();
    const int gw = bx * NWAVES + wave, NGW = G * NWAVES;
    unsigned char* ws = arg_ws(lds);
    LAS float* scr = (LAS float*)(lds + wave * 16384);
    constexpr int I_UP = 32 * 176, I_DN = 88 * 64, I_IN = 32 * 177, I_OUT = 32 * 64, I_C1 = 64 * 16, I_Z = 928;
    constexpr int I_FFN = 2 * I_UP + I_DN, I_LAYER = 2 * I_FFN + I_IN + I_OUT + 2 * I_C1 + I_Z;
#pragma unroll 1
    for (int it = gw; it < DEPTH * I_LAYER; it += NGW) {
        const int l = it / I_LAYER; int r = it - l * I_LAYER;
        if (r < 2 * I_FFN) { const int half = r >= I_FFN; r -= half * I_FFN;
            bf16_t* WUP = (bf16_t*)(ws + WS_WUP + (size_t)(l * 2 + half) * SZ_WUP); bf16_t* WDN = (bf16_t*)(ws + WS_WDN + (size_t)(l * 2 + half) * SZ_WDN);
            const float* gn = arg_in(lds, half ? I_F2N : I_F1N) + (size_t)l * DM;
            if (r < I_UP) { transpose_item(arg_in(lds, half ? I_F2W1 : I_F1W1) + (size_t)l * DM * DFF, DM, DFF, WUP, 1, 0, scr, r, lane, gn); continue; } r -= I_UP;
            if (r < I_UP) { transpose_item(arg_in(lds, half ? I_F2W3 : I_F1W3) + (size_t)l * DM * DFF, DM, DFF, WUP, 1, 128, scr, r, lane, gn); continue; } r -= I_UP;
            transpose_item(arg_in(lds, half ? I_F2W2 : I_F1W2) + (size_t)l * DFF * DM, DFF, DM, WDN, 0, 0, scr, r, lane, nullptr); continue; }
        r -= 2 * I_FFN;
        bf16_t* WIN = (bf16_t*)(ws + WS_WIN + (size_t)l * SZ_WIN); bf16_t* WOUT = (bf16_t*)(ws + WS_WOUT + (size_t)l * SZ_WOUT); bf16_t* WC1 = (bf16_t*)(ws + WS_WC1 + (size_t)l * SZ_WC1);
        if (r < I_IN) { transpose_item(arg_in(lds, I_WIN) + (size_t)l * DM * IN_COLS, DM, IN_COLS, WIN, 0, 0, scr, r, lane, arg_in(lds, I_MIXN) + (size_t)l * DM); continue; } r -= I_IN;
        if (r < I_OUT) { transpose_item(arg_in(lds, I_WOUT) + (size_t)l * DM * DM, DM, DM, WOUT, 0, 0, scr, r, lane, nullptr); continue; } r -= I_OUT;
        if (r < I_C1) { transpose_item(arg_in(lds, I_CKW1) + (size_t)l * 4096 * 512, 4096, 512, WC1, 0, 0, scr, r, lane, nullptr); continue; } r -= I_C1;
        if (r < I_C1) { transpose_item(arg_in(lds, I_CVW1) + (size_t)l * 4096 * 512, 4096, 512, WC1, 0, 512, scr, r, lane, nullptr); continue; } r -= I_C1;
        { const int q = r * 64 + lane, kt = q / 1856, rem = q - kt * 1856; u32x4* z = (u32x4*)(WIN + ((size_t)(22 * 32 + kt) * 256 + 24) * 64) + rem; unsigned zr = 0u; asm volatile("" : "+v"(zr)); *z = (u32x4){zr, zr, zr, zr}; }
    }
    const float* xs = arg_in(lds, I_X); bf16_t* XB = (bf16_t*)(ws + WS_HB); float* RSTD = (float*)(ws + WS_RSTD);
    for (int m = gw; m < NTOK; m += NGW) {
        const f32x4* xr = (const f32x4*)(xs + (size_t)m * DM) + lane; f32x4 v[8]; float s = 0.f;
#pragma unroll
        for (int j = 0; j < 8; ++j) { v[j] = xr[64 * j]; s += (v[j].x * v[j].x + v[j].y * v[j].y) + (v[j].z * v[j].z + v[j].w * v[j].w); }
        s = wave_sum(s, lane);
#pragma unroll
        for (int j = 0; j < 8; ++j) { u32x2 w; w.x = cvtpk(v[j].x, v[j].y); w.y = cvtpk(v[j].z, v[j].w); *(u32x2*)(XB + kt_off(m, 256 * j + 4 * lane, DM)) = w; }
        if (lane == 0) RSTD[m] = 1.0f / sqrtf(s * (1.f / DM) + EPS);
    }
}
__device__ __forceinline__ void ph_rstd(LAS unsigned char* lds, const int wv) {
    lds = opq_lds(lds);
    const int tid = opq_tid(wv), G = opq_g(), bx = opq_bx();
    unsigned char* ws = arg_ws(lds); const float* SSQ = (const float*)(ws + WS_SSQ); float* RSTD = (float*)(ws + WS_RSTD);
    for (int m = bx * NTHR + tid; m < NTOK; m += G * NTHR) { const f32x4* p = (const f32x4*)(SSQ + (size_t)m * 32); f32x4 a = p[0];
#pragma unroll
        for (int j = 1; j < 8; ++j) a = a + p[j];
        RSTD[m] = 1.0f / sqrtf(((a.x + a.y) + (a.z + a.w)) * (1.f / DM) + EPS); }
}
__device__ __forceinline__ void ph_headnorm(LAS unsigned char* lds, int l, const int wv) {
    lds = opq_lds(lds);
    const int tid = opq_tid(wv), lane = tid & 63, wave = __builtin_amdgcn_readfirstlane(tid >> 6), G = opq_g(), bx = opq_bx();
    const int gw = bx * NWAVES + wave, NGW = G * NWAVES;
    unsigned char* ws = arg_ws(lds); bf16_t* HP = (bf16_t*)(ws + WS_HP); bf16_t* ACMP = (bf16_t*)(ws + WS_ACMP);
    const float* qna = arg_in(lds, I_QNA) + l * HD; const float* kna = arg_in(lds, I_KNA) + l * HD; const float* qnn = arg_in(lds, I_QNN) + l * HD; const float* knn = arg_in(lds, I_KNN) + l * HD;
    const float* pos = arg_in(lds, I_POS) + (size_t)l * 32 * HD;
    const int e0 = (lane & 15) * 8;
    for (int m = gw; m < NTOK; m += NGW) {
        bf16_t* prow = HP + (size_t)m * PC;
        int cols[7]; u32x4 wl[7];
#pragma unroll
        for (int ch = 0; ch < 7; ++ch) { cols[ch] = (ch < 2) ? C_QA + ch * 512 + lane * 8 : (ch < 4) ? C_KA + (ch - 2) * 512 + lane * 8 : (ch < 6) ? C_QN + (ch - 4) * 512 + lane * 8 : (lane < 32 ? C_KS + lane * 8 : C_KW + (lane - 32) * 8);
            wl[ch] = *(const u32x4*)(prow + cols[ch]); }
        const u32x4 wcv = *(const u32x4*)(prow + C_KC + lane * 8);
#pragma unroll
        for (int ch = 0; ch < 7; ++ch) {
            const float* gp = (ch < 2) ? qna : (ch < 4) ? kna : (ch < 6) ? qnn : knn; const float sc = (ch < 2 || (ch >= 4 && ch < 6)) ? QSCALE : 1.f;
            const u32x4 w = wl[ch];
            float v[8] = {bflo(w.x), bfhi(w.x), bflo(w.y), bfhi(w.y), bflo(w.z), bfhi(w.z), bflo(w.w), bfhi(w.w)};
            float s = 0.f;
#pragma unroll
            for (int i = 0; i < 8; ++i) s += v[i] * v[i];
            s += shx(s, 1, lane); s += shx(s, 2, lane); s += shx(s, 4, lane); s += shx(s, 8, lane);
            const float rs = sc / sqrtf(s * (1.f / HD) + EPS);
            const f32x4 g0 = *(const f32x4*)(gp + e0), g1 = *(const f32x4*)(gp + e0 + 4);
            u32x4 o; o.x = cvtpk(v[0] * rs * g0.x, v[1] * rs * g0.y); o.y = cvtpk(v[2] * rs * g0.z, v[3] * rs * g0.w); o.z = cvtpk(v[4] * rs * g1.x, v[5] * rs * g1.y); o.w = cvtpk(v[6] * rs * g1.z, v[7] * rs * g1.w);
            *(u32x4*)(prow + cols[ch]) = o;
        }
        { const int b = m / SEQ, t = m % SEQ, kv = lane >> 5, gg = (lane >> 4) & 1, c1 = t >> 4, j1 = t & 15;
          const u32x4 w = wcv;
          const float v[8] = {bflo(w.x), bfhi(w.x), bflo(w.y), bfhi(w.y), bflo(w.z), bfhi(w.z), bflo(w.w), bfhi(w.w)};
          const int arow0 = kv * 4096 + (b * 2 + gg) * 512;
          if (c1 <= 510) { const f32x4 p0 = *(const f32x4*)(pos + j1 * HD + e0), p1 = *(const f32x4*)(pos + j1 * HD + e0 + 4);
              u32x4 o; o.x = cvtpk(v[0] + p0.x, v[1] + p0.y); o.y = cvtpk(v[2] + p0.z, v[3] + p0.w); o.z = cvtpk(v[4] + p1.x, v[5] + p1.y); o.w = cvtpk(v[6] + p1.z, v[7] + p1.w);
              *(u32x4*)(ACMP + kt_off(arow0 + c1, j1 * HD + e0, 4096)) = o; }
          else { const u32x4 z = {0u, 0u, 0u, 0u}; *(u32x4*)(ACMP + kt_off(arow0 + 511, j1 * HD + e0, 4096)) = z; *(u32x4*)(ACMP + kt_off(arow0 + 511, (j1 + 16) * HD + e0, 4096)) = z; }
          if (c1 >= 1) { const int j2 = j1 + 16; const f32x4 p0 = *(const f32x4*)(pos + j2 * HD + e0), p1 = *(const f32x4*)(pos + j2 * HD + e0 + 4);
              u32x4 o; o.x = cvtpk(v[0] + p0.x, v[1] + p0.y); o.y = cvtpk(v[2] + p0.z, v[3] + p0.w); o.z = cvtpk(v[4] + p1.x, v[5] + p1.y); o.w = cvtpk(v[6] + p1.z, v[7] + p1.w);
              *(u32x4*)(ACMP + kt_off(arow0 + c1 - 1, j2 * HD + e0, 4096)) = o; } }
    }
}
__device__ __forceinline__ float gelu_tanh(float v) { const float u3 = 0.7978845608028654f * (v + 0.044715f * v * v * v); return 0.5f * v * (2.0f - 2.0f / (__expf(2.0f * u3) + 1.0f)); }
__device__ __forceinline__ void ph_cmp2(LAS unsigned char* lds, int l, const int wv) {
    lds = opq_lds(lds);
    const int tid = opq_tid(wv), lane = tid & 63, wave = __builtin_amdgcn_readfirstlane(tid >> 6), G = opq_g(), bx = opq_bx();
    unsigned char* ws = arg_ws(lds); const float* CP = (const float*)(ws + WS_CP);
    LAS float* CH = (LAS float*)lds;
    LAS float* RED = (LAS float*)(lds + 65536);
    const float* knn = arg_in(lds, I_KNN) + l * HD;
    for (int it = bx; it < 256; it += G) {
        const int R0 = it * 32, kv = R0 >> 12, rl0 = R0 & 4095;
        __syncthreads();
        for (int i4 = tid; i4 < 32 * 128; i4 += NTHR) { const int rr = i4 >> 7, k4 = (i4 & 127) * 4; f32x4 v = {0.f, 0.f, 0.f, 0.f};
#pragma unroll
            for (int ks = 0; ks < 4; ++ks) v = v + *(const f32x4*)(CP + ((size_t)(kv * 4 + ks) * 4096 + rl0 + rr) * 512 + k4);
            f32x4 o; o.x = gelu_tanh(v.x); o.y = gelu_tanh(v.y); o.z = gelu_tanh(v.z); o.w = gelu_tanh(v.w);
            *(LAS f32x4*)(CH + rr * 512 + k4) = o; }
        __syncthreads();
        const int n = tid & 127, rq = tid >> 7;
        const float* w2 = arg_in(lds, kv ? I_CVW2 : I_CKW2) + (size_t)l * 512 * HD + n;
        float acc[8];
#pragma unroll
        for (int i = 0; i < 8; ++i) acc[i] = 0.f;
#pragma unroll 4
        for (int k = 0; k < 512; k += 4) { const float w0 = w2[(size_t)k * HD], w1 = w2[(size_t)(k + 1) * HD], w2v = w2[(size_t)(k + 2) * HD], w3 = w2[(size_t)(k + 3) * HD];
#pragma unroll
            for (int i = 0; i < 8; ++i) { const f32x4 c = *(const LAS f32x4*)(CH + (rq * 8 + i) * 512 + k); acc[i] += (c.x * w0 + c.y * w1) + (c.z * w2v + c.w * w3); } }
        if (kv == 0) {
            float ss[8];
#pragma unroll
            for (int i = 0; i < 8; ++i) ss[i] = wave_sum(acc[i] * acc[i], lane);
            if (lane == 0) {
#pragma unroll
                for (int i = 0; i < 8; ++i) RED[wave * 8 + i] = ss[i]; }
            __syncthreads();
            const float gn = knn[n];
#pragma unroll
            for (int i = 0; i < 8; ++i) { const float tot = RED[(2 * rq) * 8 + i] + RED[(2 * rq + 1) * 8 + i]; acc[i] = acc[i] / sqrtf(tot * (1.f / HD) + EPS) * gn; }
        }
        bf16_t* dst = (bf16_t*)(ws + (kv ? WS_VC + 0 : WS_KC + 0)) + (size_t)(rl0 + rq * 8) * HD + n;
#pragma unroll
        for (int i = 0; i < 8; ++i) dst[(size_t)i * HD] = (bf16_t)f2bf(acc[i]);
    }
}
__device__ __forceinline__ void ph_outnorm(LAS unsigned char* lds, int l, const int wv) {
    lds = opq_lds(lds);
    const int tid = opq_tid(wv), lane = tid & 63, wave = __builtin_amdgcn_readfirstlane(tid >> 6), G = opq_g(), bx = opq_bx();
    const int gw = bx * NWAVES + wave, NGW = G * NWAVES;
    unsigned char* ws = arg_ws(lds); const bf16_t* OA = (const bf16_t*)(ws + WS_OA); const bf16_t* ON = (const bf16_t*)(ws + WS_ON); bf16_t* HB = (bf16_t*)(ws + WS_HP);
    const float* gn = arg_in(lds, I_ON) + (size_t)l * DM;
    for (int m = gw; m < NTOK; m += NGW) {
        const bf16_t* oa = OA + (size_t)m * 1024; bf16_t* y = HB;
        const u32x4 wa = *(const u32x4*)(oa + lane * 8), wb = *(const u32x4*)(oa + 512 + lane * 8);
        u32x4 wn[6];
#pragma unroll
        for (int br = 0; br < 3; ++br) { const bf16_t* onb = ON + ((size_t)br * NTOK + m) * 1024; wn[2 * br] = *(const u32x4*)(onb + lane * 8); wn[2 * br + 1] = *(const u32x4*)(onb + 512 + lane * 8); }
        float va[16] = {bflo(wa.x), bfhi(wa.x), bflo(wa.y), bfhi(wa.y), bflo(wa.z), bfhi(wa.z), bflo(wa.w), bfhi(wa.w), bflo(wb.x), bfhi(wb.x), bflo(wb.y), bfhi(wb.y), bflo(wb.z), bfhi(wb.z), bflo(wb.w), bfhi(wb.w)};
        float sa = 0.f;
#pragma unroll
        for (int i = 0; i < 16; ++i) sa += va[i] * va[i];
        float vs[16]; float sn = 0.f;
#pragma unroll
        for (int i = 0; i < 16; ++i) vs[i] = 0.f;
#pragma unroll
        for (int br = 0; br < 3; ++br) { const u32x4 wc = wn[2 * br], wd = wn[2 * br + 1];
            vs[0] += bflo(wc.x); vs[1] += bfhi(wc.x); vs[2] += bflo(wc.y); vs[3] += bfhi(wc.y); vs[4] += bflo(wc.z); vs[5] += bfhi(wc.z); vs[6] += bflo(wc.w); vs[7] += bfhi(wc.w);
            vs[8] += bflo(wd.x); vs[9] += bfhi(wd.x); vs[10] += bflo(wd.y); vs[11] += bfhi(wd.y); vs[12] += bflo(wd.z); vs[13] += bfhi(wd.z); vs[14] += bflo(wd.w); vs[15] += bfhi(wd.w); }
        const float ra = 1.0f / sqrtf(wave_sum(sa, lane) * (1.f / 1024.f) + EPS);
        { const f32x4 g0 = *(const f32x4*)(gn + lane * 8), g1 = *(const f32x4*)(gn + lane * 8 + 4), g2 = *(const f32x4*)(gn + 512 + lane * 8), g3 = *(const f32x4*)(gn + 512 + lane * 8 + 4);
          u32x4 o; o.x = cvtpk(va[0] * ra * g0.x, va[1] * ra * g0.y); o.y = cvtpk(va[2] * ra * g0.z, va[3] * ra * g0.w); o.z = cvtpk(va[4] * ra * g1.x, va[5] * ra * g1.y); o.w = cvtpk(va[6] * ra * g1.z, va[7] * ra * g1.w);
          *(u32x4*)(y + kt_off(m, lane * 8, DM)) = o;
          o.x = cvtpk(va[8] * ra * g2.x, va[9] * ra * g2.y); o.y = cvtpk(va[10] * ra * g2.z, va[11] * ra * g2.w); o.z = cvtpk(va[12] * ra * g3.x, va[13] * ra * g3.y); o.w = cvtpk(va[14] * ra * g3.z, va[15] * ra * g3.w);
          *(u32x4*)(y + kt_off(m, 512 + lane * 8, DM)) = o; }
#pragma unroll
        for (int i = 0; i < 16; ++i) sn += vs[i] * vs[i];
        const float rn = 1.0f / sqrtf(wave_sum(sn, lane) * (1.f / 1024.f) + EPS);
        { const float* g2 = gn + 1024; const f32x4 g0 = *(const f32x4*)(g2 + lane * 8), g1 = *(const f32x4*)(g2 + lane * 8 + 4), g2a = *(const f32x4*)(g2 + 512 + lane * 8), g3 = *(const f32x4*)(g2 + 512 + lane * 8 + 4);
          u32x4 o; o.x = cvtpk(vs[0] * rn * g0.x, vs[1] * rn * g0.y); o.y = cvtpk(vs[2] * rn * g0.z, vs[3] * rn * g0.w); o.z = cvtpk(vs[4] * rn * g1.x, vs[5] * rn * g1.y); o.w = cvtpk(vs[6] * rn * g1.z, vs[7] * rn * g1.w);
          *(u32x4*)(y + kt_off(m, 1024 + lane * 8, DM)) = o;
          o.x = cvtpk(vs[8] * rn * g2a.x, vs[9] * rn * g2a.y); o.y = cvtpk(vs[10] * rn * g2a.z, vs[11] * rn * g2a.w); o.z = cvtpk(vs[12] * rn * g3.x, vs[13] * rn * g3.y); o.w = cvtpk(vs[14] * rn * g3.z, vs[15] * rn * g3.w);
          *(u32x4*)(y + kt_off(m, 1536 + lane * 8, DM)) = o; }
    }
}

#define GRID_BAR() do { XcdBarrier bar_; bar_.bar = (unsigned*)(arg_ws(lds) + WS_CTL) + CW_BAR; bar_.x = xb_xcc_id(); bar_.st = (volatile LAS unsigned*)(opq_lds(lds) + LDS_MISC + 32); xcd_barrier(bar_, wv); } while (0)
__global__ void __launch_bounds__(NTHR, 2) mega_fwd(Args a) {
    extern __shared__ __attribute__((aligned(16))) unsigned char lds_raw[];
    LAS unsigned char* lds = (LAS unsigned char*)lds_raw;
    const int wv = __builtin_amdgcn_readfirstlane((int)threadIdx.x >> 6);
    {
        const int tid = threadIdx.x;
        for (int u = tid; u < (LDS_BYTES - LDS_MISC) / 4; u += NTHR) ((LAS unsigned*)(lds + LDS_MISC))[u] = 0u;
        __syncthreads();
        if (tid == 0) { LAS unsigned long long* t = (LAS unsigned long long*)(lds + LDS_ARGS);
#pragma unroll
            for (int i = 0; i < 24; ++i) t[i] = (unsigned long long)(uintptr_t)a.in[i];
            t[24] = (unsigned long long)(uintptr_t)a.out; t[25] = (unsigned long long)(uintptr_t)a.ws; }
        __syncthreads();
    }
    (void)xcd_barrier_post((unsigned*)(arg_ws(lds) + WS_CTL) + CW_BAR, (volatile LAS unsigned*)(lds + LDS_MISC + 32));

    { const int tid = opq_tid(wv), G = opq_g(), bx = opq_bx(); const float* rb = arg_in(lds, I_RB); unsigned char* ws = arg_ws(lds);
      float* dilT = (float*)(ws + WS_TBL); float* nsaT = (float*)(ws + WS_TBL + 65536);
      for (int i = bx * NTHR + tid; i < 3 * 8 * DTS + 8 * TBLS; i += G * NTHR) {
          if (i < 3 * 8 * DTS) { const int p = i / (8 * DTS), h = (i / DTS) % 8, df = i % DTS - DT0; const int d = (p == 0) ? 1 : (p == 1 ? 4 : 16);
              dilT[i] = (df >= 0 && df <= 128) ? rb[rel_bucket_dev(df * d) * 16 + h] : 0.f; }
          else { const int j = i - 3 * 8 * DTS, hh = j / TBLS, ds = j % TBLS - TBL0; nsaT[j] = (ds >= 0) ? rb[rel_bucket_dev(ds) * 16 + 8 + hh] : 0.f; } } }

    ph_prologue(lds, wv);
    GRID_BAR();
#pragma unroll 1
    for (int step = 0; step < 2 * DEPTH; ++step) {
        const int l = step >> 1, half = step & 1;
#if PH_FFN
        { unsigned char* ws = arg_ws(lds); const int G = opq_g(), bx = opq_bx();
          pg8::Gemm g{64, 64, DM}; pg8::SchedStd S; S.init(ws + WS_HB, ws + WS_WUP + (size_t)step * SZ_WUP, NTOK, 2 * DFF, DM, DM, G, bx); const pg8::EpiSwiGLU E{(bf16_t*)(ws + WS_HP), DFF, (const float*)(ws + WS_RSTD)};
          pg8::gemm_phase<pg8::EpiSwiGLU, pg8::SchedStd, 32768, 32768>(opq_lds(lds), g, S, E, wv);
#if DUP_UP
          GRID_BAR(); pg8::gemm_phase<pg8::EpiSwiGLU, pg8::SchedStd, 32768, 32768>(opq_lds(lds), g, S, E, wv);
#endif
        }
        GRID_BAR();
        { unsigned char* ws = arg_ws(lds); const int G = opq_g(), bx = opq_bx(); float* X = arg_out(lds);
          pg8::Gemm g{64, 64, DFF}; pg8::SchedStd S; S.init(ws + WS_HP, ws + WS_WDN + (size_t)step * SZ_WDN, NTOK, DM, DFF, DFF, G, bx);
          pg8::EpiResid E{(step == 0) ? arg_in(lds, I_X) : (const float*)X, X, (bf16_t*)(ws + WS_HB), (float*)(ws + WS_SSQ), DM, 0.5f};
          pg8::gemm_phase<pg8::EpiResid, pg8::SchedStd, 32768, 32768>(opq_lds(lds), g, S, E, wv);
#if DUP_DN
          { GRID_BAR(); const pg8::EpiResid E2{X, X, (bf16_t*)(ws + WS_HB), (float*)(ws + WS_SSQ), DM, 0.f}; pg8::gemm_phase<pg8::EpiResid, pg8::SchedStd, 32768, 32768>(opq_lds(lds), g, S, E2, wv); }
#endif
        }
#endif
        GRID_BAR();
        ph_rstd(lds, wv);
        GRID_BAR();
        if (half == 0) {
#if PH_INP
            { unsigned char* ws = arg_ws(lds); const int G = opq_g(), bx = opq_bx();
              pg8::Gemm g{64, 64, DM}; pg8::SchedStd S; S.init(ws + WS_HB, ws + WS_WIN + (size_t)l * SZ_WIN, NTOK, PC, DM, DM, G, bx); const pg8::EpiBf16 E{(bf16_t*)(ws + WS_HP), PC, (const float*)(ws + WS_RSTD)};
              pg8::gemm_phase<pg8::EpiBf16, pg8::SchedStd, 32768, 32768>(opq_lds(lds), g, S, E, wv);
#if DUP_IN
              GRID_BAR(); pg8::gemm_phase<pg8::EpiBf16, pg8::SchedStd, 32768, 32768>(opq_lds(lds), g, S, E, wv);
#endif
            }
#endif
            GRID_BAR();
            ph_headnorm(lds, l, wv);
            GRID_BAR();
#pragma unroll 1
            for (int pat3 = 0; pat3 < 3 * (1 + DUP_DIL); ++pat3) { const int pat = pat3 % 3;
#if PH_CMP
                if (pat3 == 0) { unsigned char* ws = arg_ws(lds); const int G = opq_g(), bx = opq_bx();
                  pg8::Gemm g{64, 64, 1024}; pg8::SchedCmp S; S.A = (const char*)(ws + WS_ACMP); S.Bt = (const char*)(ws + WS_WC1 + (size_t)l * SZ_WC1); S.G = G; S.c = bx; pg8::EpiF32Z E{(float*)(ws + WS_CP), 512, (size_t)4096 * 512};
                  pg8::gemm_phase<pg8::EpiF32Z, pg8::SchedCmp, 32768, 32768>(opq_lds(lds), g, S, E, wv); }
#endif
                if (pat3 == 1) ph_cmp2(lds, l, wv);
#if PH_DIL
                { unsigned char* ws = arg_ws(lds); const int G = opq_g(), bx = opq_bx();
                  for (int u0 = bx; u0 < 1024; u0 += G) { const int w_ = u0 & 255, k_ = u0 >> 8; const int unit = (((w_ & 7) + 8 * k_) << 5) | (w_ >> 3);
                    dil_unit((LAS char*)opq_lds(lds), (const bf16_t*)(ws + WS_HP), (bf16_t*)(ws + WS_OA), (float*)(ws + WS_LSE), (const float*)(ws + WS_TBL), pat, 2 * pat, unit, wv); } }
#endif
                if (pat3 + 1 < 3 * (1 + DUP_DIL)) GRID_BAR();
            }
#if PH_NSA
            { unsigned char* ws = arg_ws(lds); const int G = opq_g(), bx = opq_bx();
              const float* gb = arg_in(lds, I_GB) + l * 24;
              int last_bg = -1;
#pragma unroll 1
              for (int i4 = 0; i4 < 4 * (1 + DUP_NSA); ++i4)
#pragma unroll 1
                  for (int w = bx; w < 256; w += G) { const int i = i4 & 3; const int bg = w & 7, j = w >> 3;
                      const int qi = (i == 0) ? 127 - j : (i == 1 ? j : (i == 2 ? 64 + j : 63 - j));
                      nsa_unit((LAS char*)opq_lds(lds), (const bf16_t*)(ws + WS_HP), (const bf16_t*)(ws + WS_KC), (const bf16_t*)(ws + WS_VC), (bf16_t*)(ws + WS_ON), (const float*)(ws + WS_TBL + 65536), gb, bg >> 1, bg & 1, qi, bg != last_bg, wv); last_bg = bg; } }
#endif
            GRID_BAR();
            ph_outnorm(lds, l, wv);
            GRID_BAR();
#if PH_OUT
            { unsigned char* ws = arg_ws(lds); const int G = opq_g(), bx = opq_bx(); float* X = arg_out(lds);
              pg8::Gemm g{64, 64, DM}; pg8::SchedStd S; S.init(ws + WS_HP, ws + WS_WOUT + (size_t)l * SZ_WOUT, NTOK, DM, DM, DM, G, bx); pg8::EpiResid E{X, X, (bf16_t*)(ws + WS_HB), (float*)(ws + WS_SSQ), DM, 1.0f};
              pg8::gemm_phase<pg8::EpiResid, pg8::SchedStd, 32768, 32768>(opq_lds(lds), g, S, E, wv);
#if DUP_OUT
              { GRID_BAR(); const pg8::EpiResid E2{X, X, (bf16_t*)(ws + WS_HB), (float*)(ws + WS_SSQ), DM, 0.f}; pg8::gemm_phase<pg8::EpiResid, pg8::SchedStd, 32768, 32768>(opq_lds(lds), g, S, E2, wv); }
#endif
            }
#endif
            GRID_BAR();
            ph_rstd(lds, wv);
            GRID_BAR();
        }
    }
}

extern "C" void kernel_launch(void* const* d_in, const int* in_sizes, int n_in, void* d_out, int out_size, void* d_ws, size_t ws_size, hipStream_t stream) {
    static int grid = 0;
    if (grid == 0) {
        if (n_in != 24 || in_sizes[0] != NTOK * DM || out_size != NTOK * DM || ws_size < WS_END) { fprintf(stderr, "kernel_launch: shape mismatch n_in %d in0 %d out %d ws %zu (need %zu)\n", n_in, n_in > 0 ? in_sizes[0] : -1, out_size, ws_size, (size_t)WS_END); grid = -1; return; }
        int dev = 0, cus = 0, per_cu = 0;
        if (hipGetDevice(&dev) != hipSuccess || hipDeviceGetAttribute(&cus, hipDeviceAttributeMultiprocessorCount, dev) != hipSuccess) { grid = -1; return; }
        if (hipFuncSetAttribute((const void*)mega_fwd, hipFuncAttributeMaxDynamicSharedMemorySize, LDS_BYTES) != hipSuccess) { fprintf(stderr, "kernel_launch: hipFuncSetAttribute failed\n"); grid = -1; return; }
        if (hipOccupancyMaxActiveBlocksPerMultiprocessor(&per_cu, (const void*)mega_fwd, NTHR, LDS_BYTES) != hipSuccess || per_cu < 1) { fprintf(stderr, "kernel_launch: occupancy query says %d\n", per_cu); (void)hipGetLastError(); if (per_cu < 1) { grid = -1; return; } }
        grid = cus;
    }
    if (grid < 0) return;
    if (hipMemsetAsync((char*)d_ws + WS_CTL, 0, CTL_ZERO_BYTES, stream) != hipSuccess) return;
    Args a{};
    for (int i = 0; i < 24; ++i) a.in[i] = (const float*)d_in[i];
    a.out = (float*)d_out; a.ws = (unsigned char*)d_ws;
    hipLaunchKernelGGL(mega_fwd, dim3(grid), dim3(NTHR), LDS_BYTES, stream, a);
    const hipError_t le = hipPeekAtLastError();
    if (le != hipSuccess) fprintf(stderr, "kernel_launch: launch failed: %s\n", hipGetErrorName(le));
}
```

```cpp
#include <hip/hip_runtime.h>
#include <cstdio>
#include <cstdint>

#define LAS __attribute__((address_space(3)))
typedef unsigned short bf16_t;
typedef short bf16x8 __attribute__((ext_vector_type(8)));
typedef short s16x4 __attribute__((ext_vector_type(4)));
typedef float f32x2 __attribute__((ext_vector_type(2)));
typedef float f32x4 __attribute__((ext_vector_type(4)));
typedef float f32x16 __attribute__((ext_vector_type(16)));
typedef unsigned u32x2 __attribute__((ext_vector_type(2)));
typedef unsigned u32x4 __attribute__((ext_vector_type(4)));

#ifndef DUP_UP
#define DUP_UP 0
#endif
#ifndef DUP_DN
#define DUP_DN 0
#endif
#ifndef DUP_IN
#define DUP_IN 0
#endif
#ifndef DUP_OUT
#define DUP_OUT 0
#endif
#ifndef DUP_NSA
#define DUP_NSA 0
#endif
#ifndef DUP_DIL
#define DUP_DIL 0
#endif
#ifndef PH_FFN
#define PH_FFN 1
#endif
#ifndef PH_INP
#define PH_INP 1
#endif
#ifndef PH_CMP
#define PH_CMP 1
#endif
#ifndef PH_DIL
#define PH_DIL 1
#endif
#ifndef PH_NSA
#define PH_NSA 1
#endif
#ifndef PH_OUT
#define PH_OUT 1
#endif
constexpr int BATCH = 4, SEQ = 8192, DM = 2048, DFF = 5632, NTOK = BATCH * SEQ, DEPTH = 4, HD = 128;
constexpr int IN_COLS = 5656, PC = 5888;
constexpr int C_QA = 0, C_KA = 1024, C_VA = 2048, C_QN = 3072, C_KC = 4096, C_VC = 4352, C_KS = 4608, C_VS = 4864, C_KW = 5120, C_VW = 5376, C_GL = 5632;
constexpr float EPS = 1e-6f, QSCALE = 0.08838834764831845f, LOG2E = 1.4426950408889634f;
constexpr int TBLS = 1704, TBL0 = 64;
constexpr int DTS = 320, DT0 = 96;
constexpr int NWAVES = 8, NTHR = 512;

constexpr size_t MiB = 1u << 20;
constexpr size_t WS_CTL = 0, CTL_ZERO_BYTES = 1 * MiB;
constexpr size_t WS_TBL = 1 * MiB;
constexpr size_t SZ_WUP = 44 * MiB, SZ_WDN = 22 * MiB, SZ_WIN = 23 * MiB, SZ_WOUT = 8 * MiB, SZ_WC1 = 8 * MiB;
constexpr size_t WS_WUP = 2 * MiB;
constexpr size_t WS_WDN = WS_WUP + 8 * SZ_WUP;
constexpr size_t WS_WIN = WS_WDN + 8 * SZ_WDN;
constexpr size_t WS_WOUT = WS_WIN + 4 * SZ_WIN;
constexpr size_t WS_WC1 = WS_WOUT + 4 * SZ_WOUT;
constexpr size_t WS_HB = WS_WC1 + 4 * SZ_WC1;
constexpr size_t WS_HP = WS_HB + 128 * MiB;
constexpr size_t WS_OA = WS_HP + 368 * MiB;
constexpr size_t WS_LSE = WS_OA + 64 * MiB;
constexpr size_t WS_ON = WS_LSE + 1 * MiB;
constexpr size_t WS_ACMP = WS_ON + 192 * MiB;
constexpr size_t WS_CP = WS_ACMP + 64 * MiB;
constexpr size_t WS_KC = WS_CP + 64 * MiB;
constexpr size_t WS_VC = WS_KC + 1 * MiB;
constexpr size_t WS_SSQ = WS_VC + 1 * MiB;
constexpr size_t WS_RSTD = WS_SSQ + 4 * MiB;
constexpr size_t WS_END = WS_RSTD + 1 * MiB;
constexpr int CW_BAR = 4096;

__device__ __forceinline__ unsigned f2bf(float f) { unsigned u = __builtin_bit_cast(unsigned, f); return (u + 0x7fffu + ((u >> 16) & 1u)) >> 16; }
__device__ __forceinline__ unsigned pk2(float lo, float hi) { return f2bf(lo) | (f2bf(hi) << 16); }
__device__ __forceinline__ float bf2f(bf16_t b) { return __builtin_bit_cast(float, ((unsigned)b) << 16); }
__device__ __forceinline__ float bflo(unsigned w) { return __builtin_bit_cast(float, w << 16); }
__device__ __forceinline__ float bfhi(unsigned w) { return __builtin_bit_cast(float, w & 0xffff0000u); }
__device__ __forceinline__ unsigned cvtpk(float lo, float hi) { unsigned r; asm volatile("v_cvt_pk_bf16_f32 %0, %1, %2" : "=v"(r) : "v"(lo), "v"(hi)); return r; }
__device__ __forceinline__ float shx(float v, int m, int lane) { return __builtin_bit_cast(float, __builtin_amdgcn_ds_bpermute((lane ^ m) << 2, __builtin_bit_cast(int, v))); }
__device__ __forceinline__ float wave_sum(float v, int lane) {
#pragma unroll
    for (int o = 1; o < 64; o <<= 1) v += shx(v, o, lane);
    return v;
}
__device__ __forceinline__ LAS unsigned char* opq_lds(LAS unsigned char* p) { unsigned a = (unsigned)(uintptr_t)p; asm volatile("" : "+s"(a)); return (LAS unsigned char*)(uintptr_t)a; }
__device__ __forceinline__ int opq_tid(int wv) { int l; asm volatile("v_mbcnt_lo_u32_b32 %0, -1, 0\n\tv_mbcnt_hi_u32_b32 %0, -1, %0" : "=v"(l)); return wv * 64 + l; }
__device__ __forceinline__ size_t kt_off(int r, int k, int K) { return (((size_t)(r >> 8) * (K >> 6) + (k >> 6)) * 256 + (r & 255)) * 64 + (k & 63); }
#define LDS_WAIT() asm volatile("s_waitcnt lgkmcnt(0)" ::: "memory")
#define VM_WAIT() asm volatile("s_waitcnt vmcnt(0)" ::: "memory")
#define SBAR() __builtin_amdgcn_sched_barrier(0)

#define XB_TMO      128
#define XB_XCNT(j)  (256  + 64 * (j))
#define XB_XSUB(j)  (1280 + 64 * (j))
#define XB_XGEN(j)  (2304 + 64 * (j))
#define XB_TOP      3328
#define XB_TOPGEN   3392
#define XCD_BAR_WORDS 3456
#define XB_SPIN_CAP (1u << 18)
__device__ __forceinline__ unsigned xb_ld(unsigned* p)              { return __hip_atomic_load(p, __ATOMIC_RELAXED, __HIP_MEMORY_SCOPE_AGENT); }
__device__ __forceinline__ unsigned xb_add(unsigned* p, unsigned v) { return __hip_atomic_fetch_add(p, v, __ATOMIC_RELAXED, __HIP_MEMORY_SCOPE_AGENT); }
__device__ __forceinline__ unsigned xb_xcc_id() { return (unsigned)__builtin_amdgcn_s_getreg((3 << 11) | 20) & 0xFu; }
#define XB_SPIN(cond, bar) do { unsigned _sp = 0; while (cond) { __builtin_amdgcn_s_sleep(1); \
    if ((++_sp & 255u) == 0u) { if (xb_ld(&(bar)[XB_TMO])) break; if (_sp > XB_SPIN_CAP) { atomicAdd(&(bar)[XB_TMO], 1u); break; } } } } while (0)
struct XcdBarrier { unsigned* bar; unsigned x; volatile LAS unsigned* st; };
__device__ __forceinline__ XcdBarrier xcd_barrier_post(unsigned* bar, volatile LAS unsigned* st) {
    XcdBarrier b; b.bar = bar; b.x = xb_xcc_id(); b.st = st;
    if (threadIdx.x == 0) (void)xb_add(&bar[XB_XCNT(b.x)], 1u);
    return b;
}
__device__ __forceinline__ void xcd_barrier_complete(unsigned* bar, unsigned x, unsigned& nloc, unsigned& nx) {
    const unsigned G = gridDim.x * gridDim.y * gridDim.z;
    unsigned sum, cnt, mine, sp = 0u;
    for (;;) {
        sum = 0u; cnt = 0u; mine = 0u;
#pragma unroll
        for (unsigned j = 0; j < 16; ++j) { const unsigned c = xb_ld(&bar[XB_XCNT(j)]); sum += c; cnt += (c > 0u) ? 1u : 0u; mine = (j == x) ? c : mine; }
        if (sum == G) break;
        __builtin_amdgcn_s_sleep(1);
        if ((++sp & 255u) == 0u) { if (xb_ld(&bar[XB_TMO])) break; if (sp > XB_SPIN_CAP) { atomicAdd(&bar[XB_TMO], 1u); break; } }
    }
    nloc = mine > 0u ? mine : 1u; nx = cnt > 0u ? cnt : 1u;
}
__device__ __forceinline__ void xcd_barrier(const XcdBarrier& b, const int wv) {
    asm volatile("s_waitcnt vmcnt(0)" ::: "memory");
    __syncthreads();
    if (opq_tid(wv) == 0) {
        unsigned* bar = b.bar; asm volatile("" : "+s"(bar));
        __builtin_amdgcn_s_waitcnt(0);
        unsigned nloc = b.st[0], nx = b.st[1];
        if (nloc == 0u) { xcd_barrier_complete(bar, b.x, nloc, nx); b.st[0] = nloc; b.st[1] = nx; }
        const unsigned old = xb_add(&bar[XB_XSUB(b.x)], 1u);
        const unsigned gen = old / nloc;
        if (old + 1u == (gen + 1u) * nloc) {
            __builtin_amdgcn_fence(__ATOMIC_RELEASE, "agent");
            asm volatile("s_waitcnt vmcnt(0)" ::: "memory");
            const unsigned og = xb_add(&bar[XB_TOP], 1u);
            const unsigned tg = og / nx;
            if (og + 1u == (tg + 1u) * nx) xb_add(&bar[XB_TOPGEN], 1u);
            else XB_SPIN(xb_ld(&bar[XB_TOPGEN]) == tg, bar);
            __builtin_amdgcn_fence(__ATOMIC_ACQUIRE, "agent");
            xb_add(&bar[XB_XGEN(b.x)], 1u);
            asm volatile("s_waitcnt vmcnt(0)" ::: "memory");
        } else {
            XB_SPIN(xb_ld(&bar[XB_XGEN(b.x)]) == gen, bar);
            __builtin_amdgcn_fence(__ATOMIC_ACQUIRE, "agent");
            asm volatile("s_waitcnt vmcnt(0)" ::: "memory");
        }
    }
    __syncthreads();
}

namespace pg8 {
constexpr int BM = 256, BK = 64, HALF = 128, HTB = HALF * BK * 2, STAGE_BYTES = 8 * HTB, NXCD = 8, WGM = 8;
__host__ __device__ __forceinline__ int lds_byte(int r, int c) { const int st = (r >> 4) * 2 + (c >> 5), rr = r & 15, cc = c & 31, ob = rr * 64 + cc * 2; return st * 1024 + (ob ^ (((ob >> 9) & 1) << 5)); }
__host__ __device__ __forceinline__ void stage_rc(int b, int& R, int& C) { const int st = b / 1024, sb = b % 1024, swz = sb ^ (((sb >> 9) & 1) << 5); R = (st >> 1) * 16 + swz / 64; C = (st & 1) * 32 + (swz % 64) / 2; }
__host__ __device__ __forceinline__ int perm32(int rho) { const int n = rho >> 4, i = rho & 15; return 8 * (i >> 2) + 4 * n + (i & 3); }
struct Unit { int pm, pn, z; };
struct Gemm { int lda, ldb, K; };
struct SchedStd {
    const char* A; const char* Bt; size_t atile, btile; int nM, nN, nwg, G, c, wgm;
    __device__ __forceinline__ void init(const void* A_, const void* Bt_, int M, int N, int lda, int ldb, int G_, int c_, int wgm_ = WGM) { wgm = wgm_;
        A = (const char*)A_; Bt = (const char*)Bt_; atile = (size_t)BM * lda * 2; btile = (size_t)BM * ldb * 2; nM = M / BM; nN = N / BM; nwg = nM * nN; G = G_; c = c_; }
    __device__ __forceinline__ bool next(int i, Unit& u) const {
        const long L = (long)i * G + c; if (L >= nwg) return false;
        int wgid = (int)L; { const int q = nwg / NXCD, r = nwg % NXCD, xcd = wgid % NXCD, off = wgid / NXCD; wgid = (xcd < r ? xcd * (q + 1) : r * (q + 1) + (xcd - r) * q) + off; }
        const int nig = wgm * nN, gid = wgid / nig, fm = gid * wgm, gsz = (nM - fm) < wgm ? (nM - fm) : wgm;
        u.pm = fm + ((wgid % nig) % gsz); u.pn = (wgid % nig) / gsz; u.z = 0; return true;
    }
    __device__ __forceinline__ const char* a_ptr(const Unit& u) const { return A + (size_t)u.pm * atile; }
    __device__ __forceinline__ const char* b_ptr(const Unit& u) const { return Bt + (size_t)u.pn * btile; }
};
struct SchedCmp {
    const char* A; const char* Bt; int G, c;
    __device__ __forceinline__ bool next(int i, Unit& u) const { const int L = i * G + c; if (L >= 256) return false; u.z = L >> 5; u.pm = (L & 31) >> 1; u.pn = L & 1; return true; }
    __device__ __forceinline__ const char* a_ptr(const Unit& u) const { const int kv = u.z >> 2, ks = u.z & 3; return A + ((size_t)(kv * 16 + u.pm) * 64 + (size_t)ks * 16) * 32768; }
    __device__ __forceinline__ const char* b_ptr(const Unit& u) const { const int kv = u.z >> 2, ks = u.z & 3; return Bt + ((size_t)(kv * 2 + u.pn) * 64 + (size_t)ks * 16) * 32768; }
};
struct EpiBf16 {
    static constexpr bool PERM = true;
    bf16_t* O; int ldc; const float* rstd;
    __device__ __forceinline__ void prefetch(float (&pre)[8], const Unit& u, int wr, int fr) const {
#pragma unroll
        for (int i = 0; i < 8; ++i) pre[i] = rstd[u.pm * BM + wr * 64 + fr + (i >> 2) * HALF + (i & 3) * 16]; }
    __device__ __forceinline__ void operator()(const f32x4 (&acc)[2][2][4][2], const Unit& u, int wr, int wc, int fr, int fq, const float (&pre)[8]) const {
        const int row0 = u.pm * BM + wr * 64 + fr, col0 = u.pn * BM + wc * 32 + 8 * fq;
#pragma unroll
        for (int ai = 0; ai < 2; ++ai)
#pragma unroll
            for (int m = 0; m < 4; ++m) { bf16_t* rowp = O + (size_t)(row0 + ai * HALF + m * 16) * ldc + col0; const float rs = pre[ai * 4 + m];
#pragma unroll
                for (int bj = 0; bj < 2; ++bj) { const f32x4 v0 = acc[ai][bj][m][0] * rs, v1 = acc[ai][bj][m][1] * rs;
                    u32x4 w; w.x = cvtpk(v0[0], v0[1]); w.y = cvtpk(v0[2], v0[3]); w.z = cvtpk(v1[0], v1[1]); w.w = cvtpk(v1[2], v1[3]);
                    *(u32x4*)(rowp + bj * HALF) = w; } }
    }
};
struct EpiSwiGLU {
    static constexpr bool PERM = true;
    bf16_t* O; int ldc; const float* rstd;
    __device__ __forceinline__ void prefetch(float (&pre)[8], const Unit& u, int wr, int fr) const {
#pragma unroll
        for (int i = 0; i < 8; ++i) pre[i] = rstd[u.pm * BM + wr * 64 + fr + (i >> 2) * HALF + (i & 3) * 16]; }
    __device__ __forceinline__ void operator()(const f32x4 (&acc)[2][2][4][2], const Unit& u, int wr, int wc, int fr, int fq, const float (&pre)[8]) const {
        const int rowp0 = wr * 64 + fr, kt = 2 * u.pn + (wc >> 1), cit = (wc & 1) * 32 + 8 * fq;
        bf16_t* tile = O + ((size_t)u.pm * (ldc / 64) + kt) * (256 * 64) + cit;
#pragma unroll
        for (int ai = 0; ai < 2; ++ai)
#pragma unroll
            for (int m = 0; m < 4; ++m) { bf16_t* rowp = tile + (size_t)(rowp0 + ai * HALF + m * 16) * 64; const float rs = pre[ai * 4 + m];
                float v[8];
#pragma unroll
                for (int n = 0; n < 2; ++n)
#pragma unroll
                    for (int j = 0; j < 4; ++j) { const float g = acc[ai][0][m][n][j] * rs, up = acc[ai][1][m][n][j] * rs;
                        const float s = g * __builtin_amdgcn_rcpf(1.0f + __builtin_amdgcn_exp2f(-g * LOG2E)); v[n * 4 + j] = s * up; }
                u32x4 w; w.x = cvtpk(v[0], v[1]); w.y = cvtpk(v[2], v[3]); w.z = cvtpk(v[4], v[5]); w.w = cvtpk(v[6], v[7]);
                *(u32x4*)rowp = w; }
    }
};
struct EpiResid {
    static constexpr bool PERM = false;
    __device__ __forceinline__ void prefetch(float (&)[8], const Unit&, int, int) const {}
    float* out; bf16_t* xb; float* ssq; int ldc; float alpha;
    __device__ __forceinline__ void operator()(const f32x4 (&acc)[2][2][4][2], const Unit& u, int wr, int wc, int fr, int fq, const float (&pre)[8]) const {
        const int row0 = u.pm * BM + wr * 64 + fr, col0 = u.pn * BM + wc * 32 + 4 * fq;
        u32x2 bs[4][4];
#define ER_LOAD(g) do { const int row_ = row0 + ((g) >> 2) * HALF + ((g) & 3) * 16; \
        _Pragma("unroll") for (int q_ = 0; q_ < 4; ++q_) bs[(g) & 3][q_] = *(const u32x2*)(xb + kt_off(row_, col0 + (q_ >> 1) * HALF + (q_ & 1) * 16, ldc)); } while (0)
        ER_LOAD(0); ER_LOAD(1); ER_LOAD(2); ER_LOAD(3);
#pragma unroll
        for (int g = 0; g < 8; ++g) { const int ai = g >> 2, m = g & 3; const int row = row0 + ai * HALF + m * 16; float ss = 0.f;
#pragma unroll
            for (int q = 0; q < 4; ++q) { const int bj = q >> 1, n = q & 1; const u32x2 b = bs[g & 3][q];
                const f32x4 o = (f32x4){bflo(b.x), bfhi(b.x), bflo(b.y), bfhi(b.y)} + acc[ai][bj][m][n] * alpha;
                ss += (o.x * o.x + o.y * o.y) + (o.z * o.z + o.w * o.w);
                u32x2 w; w.x = cvtpk(o.x, o.y); w.y = cvtpk(o.z, o.w); *(u32x2*)(xb + kt_off(row, col0 + bj * HALF + n * 16, ldc)) = w;
                if (out) *(f32x4*)(out + (size_t)row * ldc + col0 + bj * HALF + n * 16) = o; }
            if (g + 4 < 8) ER_LOAD(g + 4);
            const int lane = fq * 16 + fr; ss += shx(ss, 16, lane); ss += shx(ss, 32, lane);
            if (fq == 0) ssq[(size_t)row * 32 + u.pn * 4 + wc] = ss; }
#undef ER_LOAD
    }
};
struct EpiF32Z {
    static constexpr bool PERM = false;
    float* C; int ldc; size_t zstride;
    __device__ __forceinline__ void prefetch(float (&)[8], const Unit&, int, int) const {}
    __device__ __forceinline__ void operator()(const f32x4 (&acc)[2][2][4][2], const Unit& u, int wr, int wc, int fr, int fq, const float (&pre)[8]) const {
        float* Cz = C + (size_t)u.z * zstride;
        const int row0 = u.pm * BM + wr * 64 + fr, col0 = u.pn * BM + wc * 32 + 4 * fq;
#pragma unroll
        for (int ai = 0; ai < 2; ++ai)
#pragma unroll
            for (int m = 0; m < 4; ++m) { float* rowp = Cz + (size_t)(row0 + ai * HALF + m * 16) * ldc + col0;
#pragma unroll
                for (int bj = 0; bj < 2; ++bj)
#pragma unroll
                    for (int n = 0; n < 2; ++n) *(f32x4*)(rowp + bj * HALF + n * 16) = acc[ai][bj][m][n]; }
    }
};

template <class Epi, class Sched, int KSTEP_A = 128, int KSTEP_B = 128>
__device__ __forceinline__ void gemm_phase(LAS unsigned char* lds, const Gemm g, const Sched& S, const Epi& E, const int wv) {
    const int tid = opq_tid(wv), wid = __builtin_amdgcn_readfirstlane(tid >> 6), lane = tid & 63, wr = wid >> 2, wc = wid & 3, fr = lane & 15, fq = lane >> 4;
    const int K = g.K, nt = K / BK;
    unsigned voffA[2], voffB[2];
#pragma unroll
    for (int i = 0; i < 2; ++i) { int R, C; stage_rc(tid * 16 + i * 8192, R, C); const int Rb = Epi::PERM ? ((R & ~31) + perm32(R & 31)) : R;
        voffA[i] = (unsigned)(R * g.lda + C) * 2u; voffB[i] = (unsigned)(Rb * g.ldb + C) * 2u; }
    constexpr size_t kstepA = (size_t)KSTEP_A, kstepB = (size_t)KSTEP_B;
    const size_t hstepA = (size_t)HALF * g.lda * 2, hstepB = (size_t)HALF * g.ldb * 2;
    const unsigned ldsw = (unsigned)wid * 1024u;
    const int aoff = lds_byte(wr * 64 + fr, fq * 8), boff = lds_byte(wc * 32 + fr, fq * 8);
#define PG8_SA(b, h) (((b) * 2 + (h)) * HTB)
#define PG8_SB(b, h) ((4 + (b) * 2 + (h)) * HTB)
#define PG8_STAGE(bufoff, gbase, voff) do { _Pragma("unroll") for (int _i = 0; _i < 2; ++_i) \
        __builtin_amdgcn_global_load_lds((const unsigned*)((const char*)(gbase) + (voff)[_i]), (LAS unsigned*)(lds + (bufoff) + ldsw + _i * 8192), 16, 0, 0); } while (0)
#define PG8_LDA(dst, b, h) do { _Pragma("unroll") for (int m = 0; m < 4; ++m) _Pragma("unroll") for (int k = 0; k < 2; ++k) dst[m][k] = *(const LAS bf16x8*)(lds + PG8_SA(b, h) + aoff + m * 2048 + k * 1024); } while (0)
#define PG8_LDB(dst, b, h) do { _Pragma("unroll") for (int n = 0; n < 2; ++n) _Pragma("unroll") for (int k = 0; k < 2; ++k) dst[n][k] = *(const LAS bf16x8*)(lds + PG8_SB(b, h) + boff + n * 2048 + k * 1024); } while (0)
#define PG8_MMA(ai, bj, At, Bt) do { __builtin_amdgcn_s_setprio(1); _Pragma("unroll") for (int m = 0; m < 4; ++m) _Pragma("unroll") for (int n = 0; n < 2; ++n) _Pragma("unroll") for (int k = 0; k < 2; ++k) \
        acc[ai][bj][m][n] = __builtin_amdgcn_mfma_f32_16x16x32_bf16(Bt[n][k], At[m][k], acc[ai][bj][m][n], 0, 0, 0); __builtin_amdgcn_s_setprio(0); } while (0)
#define PG8_WAIT_V(n) asm volatile("s_waitcnt vmcnt(" #n ")" ::: "memory")
#define PG8_WAIT_L(n) asm volatile("s_waitcnt lgkmcnt(" #n ")" ::: "memory")
#define PG8_BAR __builtin_amdgcn_s_barrier()
#define PG8_SCHED __builtin_amdgcn_sched_barrier(0)
    Unit cur, nxt; int ui = 0;
    if (!S.next(0, cur)) return;
    f32x4 acc[2][2][4][2];
#pragma unroll
    for (int a = 0; a < 2; ++a)
#pragma unroll
        for (int b = 0; b < 2; ++b)
#pragma unroll
            for (int m = 0; m < 4; ++m)
#pragma unroll
                for (int n = 0; n < 2; ++n) acc[a][b][m][n] = (f32x4){0.f, 0.f, 0.f, 0.f};
    bf16x8 At[4][2], B0[2][2], B1[2][2];
    const char* cA = S.a_ptr(cur); const char* cB = S.b_ptr(cur);
    float pre[8]; E.prefetch(pre, cur, wr, fr);
    PG8_STAGE(PG8_SB(0, 0), cB, voffB); PG8_STAGE(PG8_SA(0, 0), cA, voffA); PG8_STAGE(PG8_SB(0, 1), cB + hstepB, voffB); PG8_STAGE(PG8_SA(0, 1), cA + hstepA, voffA);
    if (wr == 1) PG8_BAR;
    PG8_WAIT_V(4); PG8_BAR;
    PG8_STAGE(PG8_SB(1, 0), cB + kstepB, voffB); PG8_STAGE(PG8_SA(1, 0), cA + kstepA, voffA); PG8_STAGE(PG8_SB(1, 1), cB + hstepB + kstepB, voffB);
    PG8_WAIT_V(6); PG8_BAR;
    for (;;) {
        const bool has_next = S.next(ui + 1, nxt);
        const char* nA = has_next ? S.a_ptr(nxt) : cA; const char* nB = has_next ? S.b_ptr(nxt) : cB;
        for (int t = 0; t < nt; t += 2) {
            const bool last = (t == nt - 2);
            const char* a1 = cA + (size_t)(t + 1) * kstepA;
            const char* a2 = last ? nA : cA + (size_t)(t + 2) * kstepA; const char* b2 = last ? nB : cB + (size_t)(t + 2) * kstepB;
            const char* a3 = a2 + kstepA; const char* b3 = b2 + kstepB;
            PG8_LDB(B0, 0, 0); PG8_SCHED; PG8_LDA(At, 0, 0); PG8_STAGE(PG8_SA(1, 1), a1 + hstepA, voffA);
            PG8_WAIT_L(8); PG8_BAR; PG8_WAIT_L(0); PG8_MMA(0, 0, At, B0); PG8_BAR; PG8_SCHED;
            PG8_LDB(B1, 0, 1); PG8_STAGE(PG8_SB(0, 0), b2, voffB);
            PG8_BAR; PG8_WAIT_L(0); PG8_MMA(0, 1, At, B1); PG8_BAR;
            PG8_LDA(At, 0, 1); PG8_STAGE(PG8_SA(0, 0), a2, voffA);
            PG8_BAR; PG8_WAIT_L(0); PG8_MMA(1, 0, At, B0); PG8_BAR; PG8_SCHED;
            PG8_STAGE(PG8_SB(0, 1), b2 + hstepB, voffB);
            PG8_WAIT_V(6); PG8_BAR; PG8_MMA(1, 1, At, B1); PG8_BAR;
            PG8_LDB(B0, 1, 0); PG8_SCHED; PG8_LDA(At, 1, 0); PG8_STAGE(PG8_SA(0, 1), a2 + hstepA, voffA);
            PG8_WAIT_L(8); PG8_BAR; PG8_WAIT_L(0); PG8_MMA(0, 0, At, B0); PG8_BAR; PG8_SCHED;
            PG8_LDB(B1, 1, 1); PG8_STAGE(PG8_SB(1, 0), b3, voffB);
            PG8_BAR; PG8_WAIT_L(0); PG8_MMA(0, 1, At, B1); PG8_BAR;
            PG8_LDA(At, 1, 1); PG8_STAGE(PG8_SA(1, 0), a3, voffA);
            PG8_BAR; PG8_WAIT_L(0); PG8_MMA(1, 0, At, B0); PG8_BAR; PG8_SCHED;
            PG8_STAGE(PG8_SB(1, 1), b3 + hstepB, voffB);
            PG8_WAIT_V(6); PG8_BAR; PG8_MMA(1, 1, At, B1); PG8_BAR;
        }
        E(acc, cur, wr, wc, fr, fq, pre);
        if (has_next) E.prefetch(pre, nxt, wr, fr);
        if (!has_next) break;
#pragma unroll
        for (int a = 0; a < 2; ++a)
#pragma unroll
            for (int b = 0; b < 2; ++b)
#pragma unroll
                for (int m = 0; m < 4; ++m)
#pragma unroll
                    for (int n = 0; n < 2; ++n) acc[a][b][m][n] = (f32x4){0.f, 0.f, 0.f, 0.f};
        cur = nxt; cA = nA; cB = nB; ++ui;
    }
    PG8_WAIT_V(0);
    if (wr == 0) PG8_BAR;
    PG8_BAR;
#undef PG8_SA
#undef PG8_SB
#undef PG8_STAGE
#undef PG8_LDA
#undef PG8_LDB
#undef PG8_MMA
#undef PG8_WAIT_V
#undef PG8_WAIT_L
#undef PG8_BAR
#undef PG8_SCHED
}
}

struct Args { const float* in[24]; float* out; unsigned char* ws; };
enum { I_X = 0, I_F1N, I_F1W1, I_F1W3, I_F1W2, I_MIXN, I_WIN, I_GB, I_QNA, I_KNA, I_QNN, I_KNN, I_POS, I_CKW1, I_CKW2, I_CVW1, I_CVW2, I_ON, I_WOUT, I_F2N, I_F2W1, I_F2W3, I_F2W2, I_RB };

__device__ __forceinline__ void transpose_item(const float* W, int K, int N, bf16_t* WT, int mode, int off, LAS float* scr, int item, int lane, const float* gain) {
    const int nblk = (N + 31) / 32, kb = item / nblk, nb = item % nblk, k0 = 64 * kb, n0 = 32 * nb;
    const int c4 = 4 * (lane & 7), nn = n0 + c4;
    f32x4 ld[8];
#pragma unroll
    for (int i = 0; i < 8; ++i) { const int kk = 8 * i + (lane >> 3); ld[i] = (nn < N) ? *(const f32x4*)(W + (size_t)(k0 + kk) * N + nn) : (f32x4){0.f, 0.f, 0.f, 0.f}; if (gain) ld[i] = ld[i] * gain[k0 + kk]; }
#pragma unroll
    for (int i = 0; i < 8; ++i) { const int kk = 8 * i + (lane >> 3); LAS float* d = scr + kk * 33 + c4; d[0] = ld[i].x; d[1] = ld[i].y; d[2] = ld[i].z; d[3] = ld[i].w; }
    LDS_WAIT(); asm volatile("" ::: "memory");
    const int c = lane & 7;
#pragma unroll
    for (int j = 0; j < 4; ++j) { const int n = (lane >> 3) + 8 * j; const LAS float* s = scr + (8 * c) * 33 + n;
        u32x4 o; o.x = pk2(s[0 * 33], s[1 * 33]); o.y = pk2(s[2 * 33], s[3 * 33]); o.z = pk2(s[4 * 33], s[5 * 33]); o.w = pk2(s[6 * 33], s[7 * 33]);
        const int ng = n0 + n; const int dr = mode ? ((ng >> 7) * 256 + (ng & 127) + off) : (ng + off);
        if (ng < N) *(u32x4*)(WT + kt_off(dr, k0 + 8 * c, K)) = o; }
    LDS_WAIT(); asm volatile("" ::: "memory");
}
__device__ __forceinline__ int rel_bucket_dev(int n) {
    if (n < 16) return n;
    const float v = logf((float)n / 16.0f) / 4.852030263919617f * 16.0f;
    int b = 16 + (int)v; return b < 31 ? b : 31;
}
namespace att {
constexpr int SHM_V = 16384, SHM_K = 16384;
constexpr int L_V = 0  , L_K = 49152  , L_WS = 81920, L_TBL = 83968, L_SELM = L_TBL + 4 * TBLS * 4  , L_END = L_SELM + 1024;
constexpr int L_IMP = 0;
static_assert(L_END <= 131072, "attention LDS map");
constexpr float THR = 8.f;
#define KSWZ(row, colB) ((row) * 256 + ((colB) ^ (((row) & 7) << 4)))
__device__ __forceinline__ int v_st(int k, int c) { const int kk = (k & ~0xC) | ((k & 4) << 1) | ((k & 8) >> 1); return ((kk >> 3) * 4 + (c >> 5)) * 512 + ((kk & 7) * 32 + (c & 31)) * 2; }
__device__ __forceinline__ int v_rd_base(int lane) { return ((lane & 3) << 3) | (((lane >> 2) & 3) << 6) | (((lane >> 4) & 1) << 5) | (((lane >> 5) & 1) << 8); }
__device__ __forceinline__ int crow(int r, int hi) { return (r & 3) + 8 * (r >> 2) + 4 * hi; }

__device__ __forceinline__ void partialSM(f32x16& p0, f32x16& p1, float& m_reg, float& mn, float& alpha) {
    (void)m_reg; mn = 0.f; alpha = 1.f;
#pragma unroll
    for (int r = 0; r < 16; ++r) p0[r] = __builtin_amdgcn_exp2f(p0[r] * LOG2E);
#pragma unroll
    for (int r = 0; r < 16; ++r) p1[r] = p1[r] * LOG2E;
}
__device__ __forceinline__ void partialSM_row(f32x16& p0, f32x16& p1, float& m_reg, float& mn, float& alpha, bool ok, float bias) {
    (void)m_reg; mn = 0.f; alpha = 1.f;
    const float mnL = ok ? bias * LOG2E : -__builtin_inff();
#pragma unroll
    for (int r = 0; r < 16; ++r) p0[r] = __builtin_amdgcn_exp2f(fmaf(p0[r], LOG2E, mnL));
#pragma unroll
    for (int r = 0; r < 16; ++r) p1[r] = fmaf(p1[r], LOG2E, mnL);
}
#define PK4(P, B_, OUT) do { unsigned a0 = cvtpk(P[B_+0], P[B_+1]), a1 = cvtpk(P[B_+2], P[B_+3]);                          \
        unsigned b0 = cvtpk(P[B_+4], P[B_+5]), b1 = cvtpk(P[B_+6], P[B_+7]);                                             \
        auto r0 = __builtin_amdgcn_permlane32_swap(a0, b0, false, false); auto r1 = __builtin_amdgcn_permlane32_swap(a1, b1, false, false); \
        u32x4 w = {r0[0], r1[0], r0[1], r1[1]}; OUT = *reinterpret_cast<bf16x8*>(&w); } while (0)
__device__ __forceinline__ void finishSM(f32x16& p0, f32x16& p1, float alpha, float& l_reg, bf16x8& pa0, bf16x8& pa1, bf16x8& pa2, bf16x8& pa3) {
#pragma unroll
    for (int r = 0; r < 16; ++r) p1[r] = __builtin_amdgcn_exp2f(p1[r]);
    float ps = 0;
#pragma unroll
    for (int r = 0; r < 16; ++r) ps += p0[r];
#pragma unroll
    for (int r = 0; r < 16; ++r) ps += p1[r];
    { auto rr = __builtin_amdgcn_permlane32_swap(__float_as_uint(ps), __float_as_uint(ps), false, false);
      ps = __uint_as_float(rr[0]) + __uint_as_float(rr[1]); }
    l_reg = l_reg * alpha + ps;
    PK4(p0, 0, pa0); PK4(p0, 8, pa1); PK4(p1, 0, pa2); PK4(p1, 8, pa3);
}
__device__ __forceinline__ void qkt(f32x16& p0, f32x16& p1, const LAS char* Kb, int r32, int hi, const bf16x8 (&qr)[8]) {
    p0 = f32x16{}; p1 = f32x16{};
    const LAS char* kb4[4];
#pragma unroll
    for (int dd = 0; dd < 4; ++dd) kb4[dd] = Kb + KSWZ(r32, (dd * 16 + hi * 8) * 2);
#pragma unroll
    for (int d0 = 0; d0 < 8; ++d0) { const LAS char* a = kb4[d0 & 3] + (d0 >> 2) * 128;
        const bf16x8 b0 = *reinterpret_cast<const LAS bf16x8*>(a);
        const bf16x8 b1 = *reinterpret_cast<const LAS bf16x8*>(a + 32 * 256);
        p0 = __builtin_amdgcn_mfma_f32_32x32x16_bf16(b0, qr[d0], p0, 0, 0, 0);
        p1 = __builtin_amdgcn_mfma_f32_32x32x16_bf16(b1, qr[d0], p1, 0, 0, 0); }
}
__device__ __forceinline__ void pv_tile(f32x16 (&o)[4], int vb, bf16x8 pa0, bf16x8 pa1, bf16x8 pa2, bf16x8 pa3) {
#define TRRD(dst, off) asm volatile("ds_read_b64_tr_b16 %0, %1 offset:%2" : "=&v"(dst) : "v"(vb), "i"(off) : "memory")
#define PV_D0(d0) do { s16x4 l0, l1, l2, l3, h0, h1, h2, h3; constexpr int b_ = (d0) * 512; \
        TRRD(l0, b_); TRRD(h0, b_ + 2048); TRRD(l1, b_ + 4096); TRRD(h1, b_ + 6144); TRRD(l2, b_ + 8192); TRRD(h2, b_ + 10240); TRRD(l3, b_ + 12288); TRRD(h3, b_ + 14336); \
        asm volatile("s_waitcnt lgkmcnt(0)" ::: "memory"); SBAR(); \
        o[d0] = __builtin_amdgcn_mfma_f32_32x32x16_bf16(pa0, (bf16x8){l0[0], l0[1], l0[2], l0[3], h0[0], h0[1], h0[2], h0[3]}, o[d0], 0, 0, 0);   \
        o[d0] = __builtin_amdgcn_mfma_f32_32x32x16_bf16(pa1, (bf16x8){l1[0], l1[1], l1[2], l1[3], h1[0], h1[1], h1[2], h1[3]}, o[d0], 0, 0, 0);   \
        o[d0] = __builtin_amdgcn_mfma_f32_32x32x16_bf16(pa2, (bf16x8){l2[0], l2[1], l2[2], l2[3], h2[0], h2[1], h2[2], h2[3]}, o[d0], 0, 0, 0);   \
        o[d0] = __builtin_amdgcn_mfma_f32_32x32x16_bf16(pa3, (bf16x8){l3[0], l3[1], l3[2], l3[3], h3[0], h3[1], h3[2], h3[3]}, o[d0], 0, 0, 0); } while (0)
    PV_D0(0); PV_D0(1); PV_D0(2); PV_D0(3);
#undef PV_D0
#undef TRRD
}

template <class Cfg>
__device__ __forceinline__ void attn_tiles(const Cfg& c, LAS char* lds, const bf16x8 (&qr)[8], f32x16 (&o)[4], float& m_reg, float& l_reg, const int t_lo, const int t_hi, const int wv) {
    const int tid = opq_tid(wv), lane = tid & 63, wid = __builtin_amdgcn_readfirstlane(tid >> 6), r32 = lane & 31, hi = lane >> 5;
    LAS char* V_lds = lds + L_V; LAS char* K_lds = lds + L_K;
    LAS float* al_l = (LAS float*)(lds + L_WS) + wid * 64 + 32;
    const int sr = tid >> 4, sc = (tid & 15) * 8;
    const int vst0 = v_st(sr, sc), vst1 = v_st(32 + sr, sc), kws = KSWZ(sr, sc * 2);
    const int vb0 = (int)(unsigned)(uintptr_t)V_lds + v_rd_base(lane);
    bf16x8 sk0, sk1, sv0, sv1;
    const bf16_t *gk0 = nullptr, *gk1 = nullptr, *gv0 = nullptr, *gv1 = nullptr;
#define AT_LOAD(t) do { gk0 = c.krow((t), sr) + sc; gk1 = c.krow((t), sr + 32) + sc; sk0 = *(const bf16x8*)gk0; sk1 = *(const bf16x8*)gk1; \
        if constexpr (Cfg::MODE == 0) { gv0 = c.vrow((t), sr) + sc; gv1 = c.vrow((t), sr + 32) + sc; sv0 = *(const bf16x8*)gv0; sv1 = *(const bf16x8*)gv1; } \
        asm volatile("" ::: "memory"); SBAR(); } while (0)
#define AT_WRITE(t, bf) do { asm volatile("" :: "v"(gk0), "v"(gk1), "v"(gv0), "v"(gv1)); *(LAS bf16x8*)(K_lds + (bf) * SHM_K + kws) = sk0; *(LAS bf16x8*)(K_lds + (bf) * SHM_K + kws + 32 * 256) = sk1; \
        if constexpr (Cfg::MODE == 1) { \
            _Pragma("unroll") for (int i_ = 0; i_ < 8; ++i_) { const int n_ = sc + i_, c0_ = 64 * (t) + sr, c1_ = c0_ + 32; \
                sv0[i_] = (c0_ >= 4 * n_ - 1 && c0_ <= 4 * n_ + 3) ? (short)0x3F80 : (short)0; sv1[i_] = (c1_ >= 4 * n_ - 1 && c1_ <= 4 * n_ + 3) ? (short)0x3F80 : (short)0; } } \
        *(LAS bf16x8*)(V_lds + (bf) * SHM_V + vst0) = sv0; *(LAS bf16x8*)(V_lds + (bf) * SHM_V + vst1) = sv1; } while (0)
    __builtin_amdgcn_s_waitcnt(0x0F70);
    __syncthreads();
    if (t_lo < t_hi) { AT_LOAD(t_lo); AT_WRITE(t_lo, 0); }
    __syncthreads();
    for (int t = t_lo; t < t_hi; ++t) {
        const int buf = (t - t_lo) & 1; const bool more = (t + 1 < t_hi);
        if (more) AT_LOAD(t + 1);
        if (c.active(t)) {
            f32x16 p0, p1;
            qkt(p0, p1, K_lds + buf * SHM_K, r32, hi, qr);
            if constexpr (Cfg::MODE == 0) {
                float mn, alpha; bf16x8 pa0, pa1, pa2, pa3;
                bool rok; float rbias;
                if (c.rowconst(t, rok, rbias)) partialSM_row(p0, p1, m_reg, mn, alpha, rok, rbias);
                else { c.mask(p0, p1, t); partialSM(p0, p1, m_reg, mn, alpha); }
                if (__any(alpha < 1.f)) { if (hi == 0) al_l[r32] = alpha; LDS_WAIT();
#pragma unroll
                    for (int d_ = 0; d_ < 4; ++d_)
#pragma unroll
                        for (int r = 0; r < 16; ++r) o[d_][r] *= al_l[crow(r, hi)]; }
                finishSM(p0, p1, alpha, l_reg, pa0, pa1, pa2, pa3); SBAR();
                pv_tile(o, vb0 + buf * SHM_V, pa0, pa1, pa2, pa3);
            } else {
                c.mask(p0, p1, t);
                const float mL = -c.mfix * LOG2E; const float il = c.invl;
#pragma unroll
                for (int r = 0; r < 16; ++r) { p0[r] = __builtin_amdgcn_exp2f(fmaf(p0[r], LOG2E, mL)) * il; p1[r] = __builtin_amdgcn_exp2f(fmaf(p1[r], LOG2E, mL)) * il; }
                bf16x8 pa0, pa1, pa2, pa3;
                PK4(p0, 0, pa0); PK4(p0, 8, pa1); PK4(p1, 0, pa2); PK4(p1, 8, pa3); SBAR();
                pv_tile(o, vb0 + buf * SHM_V, pa0, pa1, pa2, pa3);
#pragma unroll
                for (int r = 0; r < 16; r += 2) { const unsigned a = cvtpk(p0[r], p0[r + 1]), b = cvtpk(p1[r], p1[r + 1]);
                    p0[r] -= bflo(a); p0[r + 1] -= bfhi(a); p1[r] -= bflo(b); p1[r + 1] -= bfhi(b); }
                PK4(p0, 0, pa0); PK4(p0, 8, pa1); PK4(p1, 0, pa2); PK4(p1, 8, pa3); SBAR();
                pv_tile(o, vb0 + buf * SHM_V, pa0, pa1, pa2, pa3);
            }
        }
        if (more) AT_WRITE(t + 1, buf ^ 1);
        __syncthreads();
    }
#undef AT_LOAD
#undef AT_WRITE
}

template <class Cfg>
__device__ __forceinline__ void attn_tiles_s(const Cfg& c, LAS char* lds, const bf16x8 (&qr)[8], f32x16 (&o)[4], float& m_reg, float& l_reg, const int t_lo, const int t_hi, const int wv) {
    static_assert(Cfg::MODE == 0, "fixed-shift softmax tiles only");
    (void)m_reg;
    const int tid = opq_tid(wv), lane = tid & 63, wid = __builtin_amdgcn_readfirstlane(tid >> 6), r32 = lane & 31, hi = lane >> 5;
    LAS char* V_lds = lds + L_V; LAS char* K_lds = lds + L_K;
    const int sr = tid >> 4, sc = (tid & 15) * 8;
    const int vst0 = v_st(sr, sc), vst1 = v_st(32 + sr, sc), kws = KSWZ(sr, sc * 2);
    const int vb0 = (int)(unsigned)(uintptr_t)V_lds + v_rd_base(lane);
    bf16x8 sk0, sk1, sv0, sv1, pa0, pa1, pa2, pa3;
    const bf16_t *gk0 = nullptr, *gk1 = nullptr, *gv0 = nullptr, *gv1 = nullptr;
#define AS_LOAD(t) do { gk0 = c.krow((t), sr) + sc; gk1 = c.krow((t), sr + 32) + sc; sk0 = *(const bf16x8*)gk0; sk1 = *(const bf16x8*)gk1; \
        gv0 = c.vrow((t), sr) + sc; gv1 = c.vrow((t), sr + 32) + sc; sv0 = *(const bf16x8*)gv0; sv1 = *(const bf16x8*)gv1; asm volatile("" ::: "memory"); SBAR(); } while (0)
#define AS_WRITE(kbf, vbf) do { asm volatile("" :: "v"(gk0), "v"(gk1), "v"(gv0), "v"(gv1)); *(LAS bf16x8*)(K_lds + (kbf) * SHM_K + kws) = sk0; *(LAS bf16x8*)(K_lds + (kbf) * SHM_K + kws + 32 * 256) = sk1; \
        *(LAS bf16x8*)(V_lds + (vbf) * SHM_V + vst0) = sv0; *(LAS bf16x8*)(V_lds + (vbf) * SHM_V + vst1) = sv1; } while (0)
#define AS_SCORE(t, kbf) do { f32x16 p0, p1; float mz_ = 0.f, mn_, al_; bool rok_; float rb_; \
        qkt(p0, p1, K_lds + (kbf) * SHM_K, r32, hi, qr); \
        if (c.rowconst((t), rok_, rb_)) partialSM_row(p0, p1, mz_, mn_, al_, rok_, rb_); else { c.mask(p0, p1, (t)); partialSM(p0, p1, mz_, mn_, al_); } \
        finishSM(p0, p1, 1.f, l_reg, pa0, pa1, pa2, pa3); SBAR(); } while (0)
    if (t_lo >= t_hi) return;
    __builtin_amdgcn_s_waitcnt(0x0F70);
    __syncthreads();
    AS_LOAD(t_lo); AS_WRITE(0, 0);
    __syncthreads();
    int kb = 0, vb = 0;
    if (wid < 4) {
        for (int t = t_lo; t < t_hi; ++t) {
            const bool more = (t + 1 < t_hi); const int vn = (vb == 2) ? 0 : vb + 1;
            if (more) AS_LOAD(t + 1);
            if (c.active(t)) { AS_SCORE(t, kb); pv_tile(o, vb0 + vb * SHM_V, pa0, pa1, pa2, pa3); }
            if (more) AS_WRITE(kb ^ 1, vn);
            __syncthreads();
            kb ^= 1; vb = vn;
        }
    } else {
        bool pend = false; int vp = 0;
        for (int t = t_lo; t < t_hi; ++t) {
            const bool more = (t + 1 < t_hi); const int vn = (vb == 2) ? 0 : vb + 1;
            if (more) AS_LOAD(t + 1);
            if (pend) pv_tile(o, vb0 + vp * SHM_V, pa0, pa1, pa2, pa3);
            const bool act = c.active(t);
            if (act) AS_SCORE(t, kb);
            pend = act; vp = vb;
            if (more) AS_WRITE(kb ^ 1, vn);
            __syncthreads();
            kb ^= 1; vb = vn;
        }
        if (pend) pv_tile(o, vb0 + vp * SHM_V, pa0, pa1, pa2, pa3);
    }
#undef AS_LOAD
#undef AS_WRITE
#undef AS_SCORE
}

struct DilCfg {
    static constexpr int MODE = 0;
    const bf16_t* Kb; const bf16_t* Vb;
    const LAS float* tbl; int dshift, res, u, dqm, s0;
    __device__ __forceinline__ const bf16_t* krow(int t, int kk) const { int s = 256 * u - 128 + 64 * t + kk; s = s < 0 ? 0 : s; return Kb + (size_t)((s << dshift) + res) * PC; }
    __device__ __forceinline__ const bf16_t* vrow(int t, int kk) const { int s = 256 * u - 128 + 64 * t + kk; s = s < 0 ? 0 : s; return Vb + (size_t)((s << dshift) + res) * PC; }
    __device__ __forceinline__ bool active(int t) const { const int kb = 256 * u - 128 + 64 * t; return kb <= s0 + 31 && kb + 63 >= s0 - 128; }
    __device__ __forceinline__ bool rowconst(int, bool&, float&) const { return false; }
    __device__ __forceinline__ void mask(f32x16& p0, f32x16& p1, int t) const {
        const int dq = dqm - (256 * u - 128 + 64 * t); const float NEG = -__builtin_inff();
        const LAS float* tb = tbl + (DT0 + dq - 63);
        float bb0[16], bb1[16];
#pragma unroll
        for (int r = 0; r < 16; ++r) { const int cc = (r & 3) + 8 * (r >> 2); bb0[r] = tb[63 - cc]; bb1[r] = tb[31 - cc]; }
#pragma unroll
        for (int r = 0; r < 16; ++r) asm volatile("" : "+v"(bb0[r]), "+v"(bb1[r]));
#pragma unroll
        for (int r = 0; r < 16; ++r) { const int cc = (r & 3) + 8 * (r >> 2); const unsigned d0 = (unsigned)(dq - cc), d1 = (unsigned)(dq - cc - 32);
            p0[r] = (d0 <= 128u) ? p0[r] + bb0[r] : NEG; p1[r] = (d1 <= 128u) ? p1[r] + bb1[r] : NEG; }
    }
};
struct CmpCfg {
    static constexpr int MODE = 0;
    const bf16_t* Kb; const bf16_t* Vb; int cmax, hi4, cfull;
    __device__ __forceinline__ bool rowconst(int t, bool& ok, float& bias) const { ok = true; bias = 0.f; return 64 * t + 63 <= cfull; }
    __device__ __forceinline__ const bf16_t* krow(int t, int kk) const { return Kb + (size_t)(64 * t + kk) * HD; }
    __device__ __forceinline__ const bf16_t* vrow(int t, int kk) const { return Vb + (size_t)(64 * t + kk) * HD; }
    __device__ __forceinline__ bool active(int) const { return true; }
    __device__ __forceinline__ void mask(f32x16& p0, f32x16& p1, int t) const {
        const int cb = 64 * t + hi4; const float NEG = -__builtin_inff();
#pragma unroll
        for (int r = 0; r < 16; ++r) { const int cc = cb + (r & 3) + 8 * (r >> 2); if (cc > cmax) p0[r] = NEG; if (cc + 32 > cmax) p1[r] = NEG; }
    }
};
struct CmpImpCfg {
    static constexpr int MODE = 1;
    const bf16_t* Kb; int cmax, hi4; float mfix, invl;
    __device__ __forceinline__ const bf16_t* krow(int t, int kk) const { return Kb + (size_t)(64 * t + kk) * HD; }
    __device__ __forceinline__ const bf16_t* vrow(int, int) const { return Kb; }
    __device__ __forceinline__ bool active(int) const { return true; }
    __device__ __forceinline__ void mask(f32x16& p0, f32x16& p1, int t) const {
        const int cb = 64 * t + hi4; const float NEG = -__builtin_inff();
#pragma unroll
        for (int r = 0; r < 16; ++r) { const int cc = cb + (r & 3) + 8 * (r >> 2); if (cc > cmax) p0[r] = NEG; if (cc + 32 > cmax) p1[r] = NEG; }
    }
};
struct SlcCfg {
    static constexpr int MODE = 0;
    const bf16_t* Kb; const bf16_t* Vb;
    const LAS float* tblh;
    unsigned s0, s1, s2, s3; int tqm, cur; float b31;
    __device__ __forceinline__ const bf16_t* krow(int t, int kk) const { return Kb + (size_t)(64 * t + kk) * PC; }
    __device__ __forceinline__ const bf16_t* vrow(int t, int kk) const { return Vb + (size_t)(64 * t + kk) * PC; }
    __device__ __forceinline__ bool selbit(int t) const { const unsigned q = (unsigned)t >> 5; const unsigned w = (q == 0u ? s0 + 0u : 0u) | (q == 1u ? s1 + 0u : 0u) | (q == 2u ? s2 + 0u : 0u) | (q == 3u ? s3 + 0u : 0u); return (w >> (t & 31)) & 1u; }
    __device__ __forceinline__ bool active(int t) const { return __any(selbit(t)); }
    __device__ __forceinline__ bool rowconst(int t, bool& ok, float& bias) const { ok = selbit(t); bias = b31; return 64 * (cur - t) - 63 >= 1513; }
    __device__ __forceinline__ void mask(f32x16& p0, f32x16& p1, int t) const {
        const bool sel = selbit(t); const int dq = tqm - 64 * t; const float NEG = -__builtin_inff();
        const LAS float* tb = tblh + (TBL0 + dq - 63);
        float bb0[16], bb1[16];
#pragma unroll
        for (int r = 0; r < 16; ++r) { const int cc = (r & 3) + 8 * (r >> 2); bb0[r] = tb[63 - cc]; bb1[r] = tb[31 - cc]; }
#pragma unroll
        for (int r = 0; r < 16; ++r) asm volatile("" : "+v"(bb0[r]), "+v"(bb1[r]));
#pragma unroll
        for (int r = 0; r < 16; ++r) { const int cc = (r & 3) + 8 * (r >> 2); const int d0 = dq - cc, d1 = dq - cc - 32;
            p0[r] = (sel && d0 >= 0) ? p0[r] + bb0[r] : NEG; p1[r] = (sel && d1 >= 0) ? p1[r] + bb1[r] : NEG; }
    }
};
struct WinCfg {
    static constexpr int MODE = 0;
    const bf16_t* Kb; const bf16_t* Vb; const LAS float* tblh; int tqm;
    __device__ __forceinline__ bool rowconst(int, bool&, float&) const { return false; }
    __device__ __forceinline__ const bf16_t* krow(int t, int kk) const { return Kb + (size_t)(64 * t + kk) * PC; }
    __device__ __forceinline__ const bf16_t* vrow(int t, int kk) const { return Vb + (size_t)(64 * t + kk) * PC; }
    __device__ __forceinline__ bool active(int) const { return true; }
    __device__ __forceinline__ void mask(f32x16& p0, f32x16& p1, int t) const {
        const int dq = tqm - 64 * t; const float NEG = -__builtin_inff();
        const LAS float* tb = tblh + (TBL0 + dq - 63);
        float bb0[16], bb1[16];
#pragma unroll
        for (int r = 0; r < 16; ++r) { const int cc = (r & 3) + 8 * (r >> 2); bb0[r] = tb[63 - cc]; bb1[r] = tb[31 - cc]; }
#pragma unroll
        for (int r = 0; r < 16; ++r) asm volatile("" : "+v"(bb0[r]), "+v"(bb1[r]));
#pragma unroll
        for (int r = 0; r < 16; ++r) { const int cc = (r & 3) + 8 * (r >> 2); const unsigned d0 = (unsigned)(dq - cc), d1 = (unsigned)(dq - cc - 32);
            p0[r] = (d0 < 512u) ? p0[r] + bb0[r] : NEG; p1[r] = (d1 < 512u) ? p1[r] + bb1[r] : NEG; }
    }
};
}

__device__ __forceinline__ void dil_unit(LAS char* lds, const bf16_t* P, bf16_t* OA, float* LSE, const float* dilT, int pat, int dshift, int unit, const int wv) {
    using namespace att;
    const int tid = opq_tid(wv), lane = tid & 63, wid = __builtin_amdgcn_readfirstlane(tid >> 6), r32 = lane & 31, hi = lane >> 5;
    const int bh = unit >> 5, ru = unit & 31, b = bh >> 3, h = bh & 7;
    const int ncs = 5 - dshift, res = ru >> ncs, u = ru & ((1 << ncs) - 1);
    LAS float* tbl = (LAS float*)(lds + L_TBL);
    __syncthreads();
    if (tid < DTS) tbl[tid] = dilT[(pat * 8 + h) * DTS + tid];
    const int s0 = 256 * u + 32 * wid, s_row = s0 + r32;
    const size_t tokrow = (size_t)b * SEQ + (size_t)((s_row << dshift) + res);
    bf16x8 qr[8];
    { const bf16_t* qp = P + tokrow * PC + C_QA + h * HD + hi * 8;
#pragma unroll
      for (int d0 = 0; d0 < 8; ++d0) qr[d0] = *(const bf16x8*)(qp + d0 * 16); }
    f32x16 o[4]; float m_reg, l_reg;
    m_reg = 0.f;
    if (pat == 0) { l_reg = 0.f;
#pragma unroll
        for (int d0 = 0; d0 < 4; ++d0) o[d0] = f32x16{}; }
    else { l_reg = LSE[tokrow * 8 + h];
#pragma unroll
        for (int r = 0; r < 16; ++r) { const size_t tr = (size_t)b * SEQ + (size_t)(((s0 + crow(r, hi)) << dshift) + res); const bf16_t* op = OA + tr * 1024 + h * HD + r32;
#pragma unroll
            for (int d0 = 0; d0 < 4; ++d0) o[d0][r] = bf2f(op[d0 * 32]); } }
    DilCfg c; c.Kb = P + (size_t)b * SEQ * PC + C_KA + h * HD; c.Vb = P + (size_t)b * SEQ * PC + C_VA + h * HD; c.tbl = tbl; c.dshift = dshift; c.res = res; c.u = u; c.dqm = s_row - 4 * hi; c.s0 = s0;
    attn_tiles(c, lds, qr, o, m_reg, l_reg, (u == 0) ? 2 : 0, 6, wv);
    LAS float* li_l = (LAS float*)(lds + L_WS) + wid * 64;
    if (hi == 0) { li_l[r32] = l_reg; LSE[tokrow * 8 + h] = l_reg; }
    LDS_WAIT();
#pragma unroll
    for (int r = 0; r < 16; ++r) { const int orow = crow(r, hi); const float rl = (pat == 2) ? 1.0f / li_l[orow] : 1.0f;
        const size_t tr = (size_t)b * SEQ + (size_t)(((s0 + orow) << dshift) + res); bf16_t* op = OA + tr * 1024 + h * HD;
#pragma unroll
        for (int d0 = 0; d0 < 4; ++d0) { const float v = o[d0][r] * rl; const float vn = shx(v, 1, lane);
            if ((r32 & 1) == 0) *(unsigned*)(op + d0 * 32 + r32) = cvtpk(v, vn); } }
}

__device__ __forceinline__ void nsa_finalize(LAS char* lds, const f32x16 (&o)[4], float l_reg, const bf16_t* P, bf16_t* ON, const float* gb, int b, int g, int tok0, int br, const int wv) {
    using namespace att;
    const int tid = opq_tid(wv), lane = tid & 63, wid = __builtin_amdgcn_readfirstlane(tid >> 6), r32 = lane & 31, hi = lane >> 5;
    LAS float* li_l = (LAS float*)(lds + L_WS) + wid * 64;
    if (hi == 0) li_l[r32] = l_reg;
    LDS_WAIT();
    bf16_t* ONb = ON + (size_t)br * NTOK * 1024;
#pragma unroll
    for (int r = 0; r < 16; ++r) { const int j = r & 3, k = r >> 2; const float lr = li_l[crow(r, hi)]; const float rl = lr > 0.f ? 1.0f / lr : 0.f;
        const size_t tok = (size_t)b * SEQ + tok0 + 2 * k + hi; const int hh = 4 * g + j;
        const float gl = bf2f(P[tok * PC + C_GL + hh * 3 + br]) + gb[hh * 3 + br];
        const float sc = rl * __builtin_amdgcn_rcpf(1.0f + __builtin_amdgcn_exp2f(-gl * LOG2E));
        bf16_t* op = ONb + tok * 1024 + hh * HD;
#pragma unroll
        for (int d0 = 0; d0 < 4; ++d0) { const float v = o[d0][r] * sc; const float vn = shx(v, 1, lane);
            if ((r32 & 1) == 0) *(unsigned*)(op + d0 * 32 + r32) = cvtpk(v, vn); } }
}
__device__ __forceinline__ void nsa_unit(LAS char* lds, const bf16_t* P, const bf16_t* KC, const bf16_t* VC, bf16_t* ON, const float* nsaT, const float* gb, int b, int g, int qi, bool load_tbl, const int wv) {
    using namespace att;
    const int tid = opq_tid(wv), lane = tid & 63, wid = __builtin_amdgcn_readfirstlane(tid >> 6), r32 = lane & 31, hi = lane >> 5;
    LAS float* tbl = (LAS float*)(lds + L_TBL); LAS float* IMP = (LAS float*)(lds + L_IMP); LAS unsigned* SELM = (LAS unsigned*)(lds + L_SELM);
    __syncthreads();
    if (load_tbl) for (int i = tid; i < 4 * TBLS; i += NTHR) tbl[i] = nsaT[(size_t)(4 * g) * TBLS + i];
    const int tok0 = 64 * qi + 8 * wid, tq = tok0 + (r32 >> 2), hd = r32 & 3;
    const bf16_t* Pb = P + (size_t)b * SEQ * PC;
    bf16x8 qr[8];
    { const bf16_t* qp = Pb + (size_t)tq * PC + C_QN + (4 * g + hd) * HD + hi * 8;
#pragma unroll
      for (int d0 = 0; d0 < 8; ++d0) qr[d0] = *(const bf16x8*)(qp + d0 * 16); }
    const bf16_t* KCb = KC + (size_t)(b * 2 + g) * 512 * HD; const bf16_t* VCb = VC + (size_t)(b * 2 + g) * 512 * HD;
    const int ntc = (qi >> 4) + 1, cmax = (tq - 31) >> 4;
    f32x16 o[4]; float m_reg, l_reg;
#pragma unroll
    for (int d0 = 0; d0 < 4; ++d0) o[d0] = f32x16{};
    m_reg = 0.f; l_reg = 0.f;
    { CmpCfg c; c.Kb = KCb; c.Vb = VCb; c.cmax = cmax; c.hi4 = 4 * hi; c.cfull = (64 * qi - 31) >> 4; attn_tiles_s(c, lds, qr, o, m_reg, l_reg, 0, ntc, wv); }
    nsa_finalize(lds, o, l_reg, P, ON, gb, b, g, tok0, 0, wv);
    { CmpImpCfg c; c.Kb = KCb; c.cmax = cmax; c.hi4 = 4 * hi; c.mfix = 0.f; c.invl = l_reg > 0.f ? 1.0f / l_reg : 0.f;
#pragma unroll
      for (int d0 = 0; d0 < 4; ++d0) o[d0] = f32x16{};
      float md = 0.f, ld = 0.f; attn_tiles(c, lds, qr, o, md, ld, 0, ntc, wv); }
#pragma unroll
    for (int d0 = 0; d0 < 4; ++d0)
#pragma unroll
        for (int k = 0; k < 4; ++k) IMP[(8 * wid + 2 * k + hi) * 128 + 32 * d0 + r32] = (o[d0][4 * k] + o[d0][4 * k + 1]) + (o[d0][4 * k + 2] + o[d0][4 * k + 3]);
    __syncthreads();
    { const int cur = qi;
#pragma unroll 1
      for (int tl = 8 * wid; tl < 8 * wid + 8; ++tl) {
        const int n0 = lane, n1 = 64 + lane; bool sel0, sel1;
        if (cur <= 15) { sel0 = (n0 <= cur); sel1 = false; }
        else {
            const float v0 = IMP[tl * 128 + n0], v1 = IMP[tl * 128 + n1];
            const unsigned u0 = (n0 >= 1 && n0 <= cur - 2) ? __float_as_uint(v0) + 1u : 0u, u1 = (n1 <= cur - 2) ? __float_as_uint(v1) + 1u : 0u;
            unsigned T = 0u;
#pragma unroll 1
            for (int bit = 30; bit >= 0; --bit) { const unsigned cand = T | (1u << bit);
                const int cnt = __builtin_popcountll(__ballot(u0 >= cand)) + __builtin_popcountll(__ballot(u1 >= cand));
                if (cnt >= 13) T = cand; }
            const bool gt0 = u0 > T, gt1 = u1 > T;
            const int need = 13 - (__builtin_popcountll(__ballot(gt0)) + __builtin_popcountll(__ballot(gt1)));
            const bool eq0 = (u0 == T), eq1 = (u1 == T);
            const unsigned long long m0 = __ballot(eq0), m1 = __ballot(eq1);
            const int pre0 = (int)__builtin_amdgcn_mbcnt_hi((unsigned)(m0 >> 32), __builtin_amdgcn_mbcnt_lo((unsigned)m0, 0u));
            const int pre1 = __builtin_popcountll(m0) + (int)__builtin_amdgcn_mbcnt_hi((unsigned)(m1 >> 32), __builtin_amdgcn_mbcnt_lo((unsigned)m1, 0u));
            sel0 = (n0 == 0 || n0 == cur || n0 == cur - 1) || gt0 || (eq0 && pre0 < need);
            sel1 = (n1 == cur || n1 == cur - 1) || gt1 || (eq1 && pre1 < need);
        }
        const unsigned long long b0 = __ballot(sel0), b1 = __ballot(sel1);
        if (lane == 0) { SELM[tl * 4 + 0] = (unsigned)b0; SELM[tl * 4 + 1] = (unsigned)(b0 >> 32); SELM[tl * 4 + 2] = (unsigned)b1; SELM[tl * 4 + 3] = (unsigned)(b1 >> 32); } } }
    __syncthreads();
    { SlcCfg c; c.Kb = Pb + C_KS + g * HD; c.Vb = Pb + C_VS + g * HD; c.tblh = tbl + hd * TBLS; c.tqm = tq - 4 * hi; c.cur = qi; c.b31 = tbl[hd * TBLS + TBL0 + 1600];
      const int tl = 8 * wid + (r32 >> 2); c.s0 = SELM[tl * 4 + 0]; c.s1 = SELM[tl * 4 + 1]; c.s2 = SELM[tl * 4 + 2]; c.s3 = SELM[tl * 4 + 3];
#pragma unroll
      for (int d0 = 0; d0 < 4; ++d0) o[d0] = f32x16{};
      m_reg = 0.f; l_reg = 0.f;
      attn_tiles_s(c, lds, qr, o, m_reg, l_reg, 0, qi + 1, wv); }
    nsa_finalize(lds, o, l_reg, P, ON, gb, b, g, tok0, 1, wv);
    { WinCfg c; c.Kb = Pb + C_KW + g * HD; c.Vb = Pb + C_VW + g * HD; c.tblh = tbl + hd * TBLS; c.tqm = tq - 4 * hi;
#pragma unroll
      for (int d0 = 0; d0 < 4; ++d0) o[d0] = f32x16{};
      m_reg = 0.f; l_reg = 0.f;
      attn_tiles_s(c, lds, qr, o, m_reg, l_reg, qi >= 8 ? qi - 8 : 0, qi + 1, wv); }
    nsa_finalize(lds, o, l_reg, P, ON, gb, b, g, tok0, 2, wv);
}

constexpr int LDS_BYTES = 147456;
constexpr int LDS_MISC = 131072;
constexpr int LDS_ARGS = LDS_MISC + 64;
__device__ __forceinline__ unsigned long long arg_u64(LAS unsigned char* lds, int i) {
    const LAS unsigned* p = (const LAS unsigned*)(opq_lds(lds) + LDS_ARGS) + 2 * i;
    const unsigned lo = __builtin_amdgcn_readfirstlane(p[0]), hi = __builtin_amdgcn_readfirstlane(p[1]);
    return ((unsigned long long)hi << 32) | lo;
}
#define GAS __attribute__((address_space(1)))
__device__ __forceinline__ const float* arg_in(LAS unsigned char* lds, int i) { return (const float*)(GAS const float*)arg_u64(lds, i); }
__device__ __forceinline__ float* arg_out(LAS unsigned char* lds) { return (float*)(GAS float*)arg_u64(lds, 24); }
__device__ __forceinline__ unsigned char* arg_ws(LAS unsigned char* lds) { return (unsigned char*)(GAS unsigned char*)arg_u64(lds, 25); }
__device__ __forceinline__ int opq_bx() { int b = blockIdx.x; asm volatile("" : "+s"(b)); return b; }
__device__ __forceinline__ int opq_g() { int b = gridDim.x; asm volatile("" : "+s"(b)); return b; }

__device__ __forceinline__ void ph_prologue(LAS unsigned char* lds, const int wv) {
    lds = opq_lds(lds);
    const int tid = opq_tid(wv), lane = tid & 63, wave = __builtin_amdgcn_readfirstlane(tid >> 6), G = opq_g(), bx = opq_bx();
    const int gw = bx * NWAVES + wave, NGW = G * NWAVES;
    unsigned char* ws = arg_ws(lds);
    LAS float* scr = (LAS float*)(lds + wave * 16384);
    constexpr int I_UP = 32 * 176, I_DN = 88 * 64, I_IN = 32 * 177, I_OUT = 32 * 64, I_C1 = 64 * 16, I_Z = 928;
    constexpr int I_FFN = 2 * I_UP + I_DN, I_LAYER = 2 * I_FFN + I_IN + I_OUT + 2 * I_C1 + I_Z;
#pragma unroll 1
    for (int it = gw; it < DEPTH * I_LAYER; it += NGW) {
        const int l = it / I_LAYER; int r = it - l * I_LAYER;
        if (r < 2 * I_FFN) { const int half = r >= I_FFN; r -= half * I_FFN;
            bf16_t* WUP = (bf16_t*)(ws + WS_WUP + (size_t)(l * 2 + half) * SZ_WUP); bf16_t* WDN = (bf16_t*)(ws + WS_WDN + (size_t)(l * 2 + half) * SZ_WDN);
            const float* gn = arg_in(lds, half ? I_F2N : I_F1N) + (size_t)l * DM;
            if (r < I_UP) { transpose_item(arg_in(lds, half ? I_F2W1 : I_F1W1) + (size_t)l * DM * DFF, DM, DFF, WUP, 1, 0, scr, r, lane, gn); continue; } r -= I_UP;
            if (r < I_UP) { transpose_item(arg_in(lds, half ? I_F2W3 : I_F1W3) + (size_t)l * DM * DFF, DM, DFF, WUP, 1, 128, scr, r, lane, gn); continue; } r -= I_UP;
            transpose_item(arg_in(lds, half ? I_F2W2 : I_F1W2) + (size_t)l * DFF * DM, DFF, DM, WDN, 0, 0, scr, r, lane, nullptr); continue; }
        r -= 2 * I_FFN;
        bf16_t* WIN = (bf16_t*)(ws + WS_WIN + (size_t)l * SZ_WIN); bf16_t* WOUT = (bf16_t*)(ws + WS_WOUT + (size_t)l * SZ_WOUT); bf16_t* WC1 = (bf16_t*)(ws + WS_WC1 + (size_t)l * SZ_WC1);
        if (r < I_IN) { transpose_item(arg_in(lds, I_WIN) + (size_t)l * DM * IN_COLS, DM, IN_COLS, WIN, 0, 0, scr, r, lane, arg_in(lds, I_MIXN) + (size_t)l * DM); continue; } r -= I_IN;
        if (r < I_OUT) { transpose_item(arg_in(lds, I_WOUT) + (size_t)l * DM * DM, DM, DM, WOUT, 0, 0, scr, r, lane, nullptr); continue; } r -= I_OUT;
        if (r < I_C1) { transpose_item(arg_in(lds, I_CKW1) + (size_t)l * 4096 * 512, 4096, 512, WC1, 0, 0, scr, r, lane, nullptr); continue; } r -= I_C1;
        if (r < I_C1) { transpose_item(arg_in(lds, I_CVW1) + (size_t)l * 4096 * 512, 4096, 512, WC1, 0, 512, scr, r, lane, nullptr); continue; } r -= I_C1;
        { const int q = r * 64 + lane, kt = q / 1856, rem = q - kt * 1856; u32x4* z = (u32x4*)(WIN + ((size_t)(22 * 32 + kt) * 256 + 24) * 64) + rem; unsigned zr = 0u; asm volatile("" : "+v"(zr)); *z = (u32x4){zr, zr, zr, zr}; }
    }
    const float* xs = arg_in(lds, I_X); bf16_t* XB = (bf16_t*)(ws + WS_HB); float* RSTD = (float*)(ws + WS_RSTD);
    for (int m = gw; m < NTOK; m += NGW) {
        const f32x4* xr = (const f32x4*)(xs + (size_t)m * DM) + lane; f32x4 v[8]; float s = 0.f;
#pragma unroll
        for (int j = 0; j < 8; ++j) { v[j] = xr[64 * j]; s += (v[j].x * v[j].x + v[j].y * v[j].y) + (v[j].z * v[j].z + v[j].w * v[j].w); }
        s = wave_sum(s, lane);
#pragma unroll
        for (int j = 0; j < 8; ++j) { u32x2 w; w.x = cvtpk(v[j].x, v[j].y); w.y = cvtpk(v[j].z, v[j].w); *(u32x2*)(XB + kt_off(m, 256 * j + 4 * lane, DM)) = w; }
        if (lane == 0) RSTD[m] = 1.0f / sqrtf(s * (1.f / DM) + EPS);
    }
}
__device__ __forceinline__ void ph_rstd(LAS unsigned char* lds, const int wv) {
    lds = opq_lds(lds);
    const int tid = opq_tid(wv), G = opq_g(), bx = opq_bx();
    unsigned char* ws = arg_ws(lds); const float* SSQ = (const float*)(ws + WS_SSQ); float* RSTD = (float*)(ws + WS_RSTD);
    for (int m = bx * NTHR + tid; m < NTOK; m += G * NTHR) { const f32x4* p = (const f32x4*)(SSQ + (size_t)m * 32); f32x4 a = p[0];
#pragma unroll
        for (int j = 1; j < 8; ++j) a = a + p[j];
        RSTD[m] = 1.0f / sqrtf(((a.x + a.y) + (a.z + a.w)) * (1.f / DM) + EPS); }
}
__device__ __forceinline__ void ph_headnorm(LAS unsigned char* lds, int l, const int wv) {
    lds = opq_lds(lds);
    const int tid = opq_tid(wv), lane = tid & 63, wave = __builtin_amdgcn_readfirstlane(tid >> 6), G = opq_g(), bx = opq_bx();
    const int gw = bx * NWAVES + wave, NGW = G * NWAVES;
    unsigned char* ws = arg_ws(lds); bf16_t* HP = (bf16_t*)(ws + WS_HP); bf16_t* ACMP = (bf16_t*)(ws + WS_ACMP);
    const float* qna = arg_in(lds, I_QNA) + l * HD; const float* kna = arg_in(lds, I_KNA) + l * HD; const float* qnn = arg_in(lds, I_QNN) + l * HD; const float* knn = arg_in(lds, I_KNN) + l * HD;
    const float* pos = arg_in(lds, I_POS) + (size_t)l * 32 * HD;
    const int e0 = (lane & 15) * 8;
    for (int m = gw; m < NTOK; m += NGW) {
        bf16_t* prow = HP + (size_t)m * PC;
        int cols[7]; u32x4 wl[7];
#pragma unroll
        for (int ch = 0; ch < 7; ++ch) { cols[ch] = (ch < 2) ? C_QA + ch * 512 + lane * 8 : (ch < 4) ? C_KA + (ch - 2) * 512 + lane * 8 : (ch < 6) ? C_QN + (ch - 4) * 512 + lane * 8 : (lane < 32 ? C_KS + lane * 8 : C_KW + (lane - 32) * 8);
            wl[ch] = *(const u32x4*)(prow + cols[ch]); }
        const u32x4 wcv = *(const u32x4*)(prow + C_KC + lane * 8);
#pragma unroll
        for (int ch = 0; ch < 7; ++ch) {
            const float* gp = (ch < 2) ? qna : (ch < 4) ? kna : (ch < 6) ? qnn : knn; const float sc = (ch < 2 || (ch >= 4 && ch < 6)) ? QSCALE : 1.f;
            const u32x4 w = wl[ch];
            float v[8] = {bflo(w.x), bfhi(w.x), bflo(w.y), bfhi(w.y), bflo(w.z), bfhi(w.z), bflo(w.w), bfhi(w.w)};
            float s = 0.f;
#pragma unroll
            for (int i = 0; i < 8; ++i) s += v[i] * v[i];
            s += shx(s, 1, lane); s += shx(s, 2, lane); s += shx(s, 4, lane); s += shx(s, 8, lane);
            const float rs = sc / sqrtf(s * (1.f / HD) + EPS);
            const f32x4 g0 = *(const f32x4*)(gp + e0), g1 = *(const f32x4*)(gp + e0 + 4);
            u32x4 o; o.x = cvtpk(v[0] * rs * g0.x, v[1] * rs * g0.y); o.y = cvtpk(v[2] * rs * g0.z, v[3] * rs * g0.w); o.z = cvtpk(v[4] * rs * g1.x, v[5] * rs * g1.y); o.w = cvtpk(v[6] * rs * g1.z, v[7] * rs * g1.w);
            *(u32x4*)(prow + cols[ch]) = o;
        }
        { const int b = m / SEQ, t = m % SEQ, kv = lane >> 5, gg = (lane >> 4) & 1, c1 = t >> 4, j1 = t & 15;
          const u32x4 w = wcv;
          const float v[8] = {bflo(w.x), bfhi(w.x), bflo(w.y), bfhi(w.y), bflo(w.z), bfhi(w.z), bflo(w.w), bfhi(w.w)};
          const int arow0 = kv * 4096 + (b * 2 + gg) * 512;
          if (c1 <= 510) { const f32x4 p0 = *(const f32x4*)(pos + j1 * HD + e0), p1 = *(const f32x4*)(pos + j1 * HD + e0 + 4);
              u32x4 o; o.x = cvtpk(v[0] + p0.x, v[1] + p0.y); o.y = cvtpk(v[2] + p0.z, v[3] + p0.w); o.z = cvtpk(v[4] + p1.x, v[5] + p1.y); o.w = cvtpk(v[6] + p1.z, v[7] + p1.w);
              *(u32x4*)(ACMP + kt_off(arow0 + c1, j1 * HD + e0, 4096)) = o; }
          else { const u32x4 z = {0u, 0u, 0u, 0u}; *(u32x4*)(ACMP + kt_off(arow0 + 511, j1 * HD + e0, 4096)) = z; *(u32x4*)(ACMP + kt_off(arow0 + 511, (j1 + 16) * HD + e0, 4096)) = z; }
          if (c1 >= 1) { const int j2 = j1 + 16; const f32x4 p0 = *(const f32x4*)(pos + j2 * HD + e0), p1 = *(const f32x4*)(pos + j2 * HD + e0 + 4);
              u32x4 o; o.x = cvtpk(v[0] + p0.x, v[1] + p0.y); o.y = cvtpk(v[2] + p0.z, v[3] + p0.w); o.z = cvtpk(v[4] + p1.x, v[5] + p1.y); o.w = cvtpk(v[6] + p1.z, v[7] + p1.w);
              *(u32x4*)(ACMP + kt_off(arow0 + c1 - 1, j2 * HD + e0, 4096)) = o; } }
    }
}
__device__ __forceinline__ float gelu_tanh(float v) { const float u3 = 0.7978845608028654f * (v + 0.044715f * v * v * v); return 0.5f * v * (2.0f - 2.0f / (__expf(2.0f * u3) + 1.0f)); }
__device__ __forceinline__ void ph_cmp2(LAS unsigned char* lds, int l, const int wv) {
    lds = opq_lds(lds);
    const int tid = opq_tid(wv), lane = tid & 63, wave = __builtin_amdgcn_readfirstlane(tid >> 6), G = opq_g(), bx = opq_bx();
    unsigned char* ws = arg_ws(lds); const float* CP = (const float*)(ws + WS_CP);
    LAS float* CH = (LAS float*)lds;
    LAS float* RED = (LAS float*)(lds + 65536);
    const float* knn = arg_in(lds, I_KNN) + l * HD;
    for (int it = bx; it < 256; it += G) {
        const int R0 = it * 32, kv = R0 >> 12, rl0 = R0 & 4095;
        __syncthreads();
        for (int i4 = tid; i4 < 32 * 128; i4 += NTHR) { const int rr = i4 >> 7, k4 = (i4 & 127) * 4; f32x4 v = {0.f, 0.f, 0.f, 0.f};
#pragma unroll
            for (int ks = 0; ks < 4; ++ks) v = v + *(const f32x4*)(CP + ((size_t)(kv * 4 + ks) * 4096 + rl0 + rr) * 512 + k4);
            f32x4 o; o.x = gelu_tanh(v.x); o.y = gelu_tanh(v.y); o.z = gelu_tanh(v.z); o.w = gelu_tanh(v.w);
            *(LAS f32x4*)(CH + rr * 512 + k4) = o; }
        __syncthreads();
        const int n = tid & 127, rq = tid >> 7;
        const float* w2 = arg_in(lds, kv ? I_CVW2 : I_CKW2) + (size_t)l * 512 * HD + n;
        float acc[8];
#pragma unroll
        for (int i = 0; i < 8; ++i) acc[i] = 0.f;
#pragma unroll 4
        for (int k = 0; k < 512; k += 4) { const float w0 = w2[(size_t)k * HD], w1 = w2[(size_t)(k + 1) * HD], w2v = w2[(size_t)(k + 2) * HD], w3 = w2[(size_t)(k + 3) * HD];
#pragma unroll
            for (int i = 0; i < 8; ++i) { const f32x4 c = *(const LAS f32x4*)(CH + (rq * 8 + i) * 512 + k); acc[i] += (c.x * w0 + c.y * w1) + (c.z * w2v + c.w * w3); } }
        if (kv == 0) {
            float ss[8];
#pragma unroll
            for (int i = 0; i < 8; ++i) ss[i] = wave_sum(acc[i] * acc[i], lane);
            if (lane == 0) {
#pragma unroll
                for (int i = 0; i < 8; ++i) RED[wave * 8 + i] = ss[i]; }
            __syncthreads();
            const float gn = knn[n];
#pragma unroll
            for (int i = 0; i < 8; ++i) { const float tot = RED[(2 * rq) * 8 + i] + RED[(2 * rq + 1) * 8 + i]; acc[i] = acc[i] / sqrtf(tot * (1.f / HD) + EPS) * gn; }
        }
        bf16_t* dst = (bf16_t*)(ws + (kv ? WS_VC + 0 : WS_KC + 0)) + (size_t)(rl0 + rq * 8) * HD + n;
#pragma unroll
        for (int i = 0; i < 8; ++i) dst[(size_t)i * HD] = (bf16_t)f2bf(acc[i]);
    }
}
__device__ __forceinline__ void ph_outnorm(LAS unsigned char* lds, int l, const int wv) {
    lds = opq_lds(lds);
    const int tid = opq_tid(wv), lane = tid & 63, wave = __builtin_amdgcn_readfirstlane(tid >> 6), G = opq_g(), bx = opq_bx();
    const int gw = bx * NWAVES + wave, NGW = G * NWAVES;
    unsigned char* ws = arg_ws(lds); const bf16_t* OA = (const bf16_t*)(ws + WS_OA); const bf16_t* ON = (const bf16_t*)(ws + WS_ON); bf16_t* HB = (bf16_t*)(ws + WS_HP);
    const float* gn = arg_in(lds, I_ON) + (size_t)l * DM;
    for (int m = gw; m < NTOK; m += NGW) {
        const bf16_t* oa = OA + (size_t)m * 1024; bf16_t* y = HB;
        const u32x4 wa = *(const u32x4*)(oa + lane * 8), wb = *(const u32x4*)(oa + 512 + lane * 8);
        u32x4 wn[6];
#pragma unroll
        for (int br = 0; br < 3; ++br) { const bf16_t* onb = ON + ((size_t)br * NTOK + m) * 1024; wn[2 * br] = *(const u32x4*)(onb + lane * 8); wn[2 * br + 1] = *(const u32x4*)(onb + 512 + lane * 8); }
        float va[16] = {bflo(wa.x), bfhi(wa.x), bflo(wa.y), bfhi(wa.y), bflo(wa.z), bfhi(wa.z), bflo(wa.w), bfhi(wa.w), bflo(wb.x), bfhi(wb.x), bflo(wb.y), bfhi(wb.y), bflo(wb.z), bfhi(wb.z), bflo(wb.w), bfhi(wb.w)};
        float sa = 0.f;
#pragma unroll
        for (int i = 0; i < 16; ++i) sa += va[i] * va[i];
        float vs[16]; float sn = 0.f;
#pragma unroll
        for (int i = 0; i < 16; ++i) vs[i] = 0.f;
#pragma unroll
        for (int br = 0; br < 3; ++br) { const u32x4 wc = wn[2 * br], wd = wn[2 * br + 1];
            vs[0] += bflo(wc.x); vs[1] += bfhi(wc.x); vs[2] += bflo(wc.y); vs[3] += bfhi(wc.y); vs[4] += bflo(wc.z); vs[5] += bfhi(wc.z); vs[6] += bflo(wc.w); vs[7] += bfhi(wc.w);
            vs[8] += bflo(wd.x); vs[9] += bfhi(wd.x); vs[10] += bflo(wd.y); vs[11] += bfhi(wd.y); vs[12] += bflo(wd.z); vs[13] += bfhi(wd.z); vs[14] += bflo(wd.w); vs[15] += bfhi(wd.w); }
        const float ra = 1.0f / sqrtf(wave_sum(sa, lane) * (1.f / 1024.f) + EPS);
        { const f32x4 g0 = *(const f32x4*)(gn + lane * 8), g1 = *(const f32x4*)(gn + lane * 8 + 4), g2 = *(const f32x4*)(gn + 512 + lane * 8), g3 = *(const f32x4*)(gn + 512 + lane * 8 + 4);
          u32x4 o; o.x = cvtpk(va[0] * ra * g0.x, va[1] * ra * g0.y); o.y = cvtpk(va[2] * ra * g0.z, va[3] * ra * g0.w); o.z = cvtpk(va[4] * ra * g1.x, va[5] * ra * g1.y); o.w = cvtpk(va[6] * ra * g1.z, va[7] * ra * g1.w);
          *(u32x4*)(y + kt_off(m, lane * 8, DM)) = o;
          o.x = cvtpk(va[8] * ra * g2.x, va[9] * ra * g2.y); o.y = cvtpk(va[10] * ra * g2.z, va[11] * ra * g2.w); o.z = cvtpk(va[12] * ra * g3.x, va[13] * ra * g3.y); o.w = cvtpk(va[14] * ra * g3.z, va[15] * ra * g3.w);
          *(u32x4*)(y + kt_off(m, 512 + lane * 8, DM)) = o; }
#pragma unroll
        for (int i = 0; i < 16; ++i) sn += vs[i] * vs[i];
        const float rn = 1.0f / sqrtf(wave_sum(sn, lane) * (1.f / 1024.f) + EPS);
        { const float* g2 = gn + 1024; const f32x4 g0 = *(const f32x4*)(g2 + lane * 8), g1 = *(const f32x4*)(g2 + lane * 8 + 4), g2a = *(const f32x4*)(g2 + 512 + lane * 8), g3 = *(const f32x4*)(g2 + 512 + lane * 8 + 4);
          u32x4 o; o.x = cvtpk(vs[0] * rn * g0.x, vs[1] * rn * g0.y); o.y = cvtpk(vs[2] * rn * g0.z, vs[3] * rn * g0.w); o.z = cvtpk(vs[4] * rn * g1.x, vs[5] * rn * g1.y); o.w = cvtpk(vs[6] * rn * g1.z, vs[7] * rn * g1.w);
          *(u32x4*)(y + kt_off(m, 1024 + lane * 8, DM)) = o;
          o.x = cvtpk(vs[8] * rn * g2a.x, vs[9] * rn * g2a.y); o.y = cvtpk(vs[10] * rn * g2a.z, vs[11] * rn * g2a.w); o.z = cvtpk(vs[12] * rn * g3.x, vs[13] * rn * g3.y); o.w = cvtpk(vs[14] * rn * g3.z, vs[15] * rn * g3.w);
          *(u32x4*)(y + kt_off(m, 1536 + lane * 8, DM)) = o; }
    }
}

#define GRID_BAR() do { XcdBarrier bar_; bar_.bar = (unsigned*)(arg_ws(lds) + WS_CTL) + CW_BAR; bar_.x = xb_xcc_id(); bar_.st = (volatile LAS unsigned*)(opq_lds(lds) + LDS_MISC + 32); xcd_barrier(bar_, wv); } while (0)
__global__ void __launch_bounds__(NTHR, 2) mega_fwd(Args a) {
    extern __shared__ __attribute__((aligned(16))) unsigned char lds_raw[];
    LAS unsigned char* lds = (LAS unsigned char*)lds_raw;
    const int wv = __builtin_amdgcn_readfirstlane((int)threadIdx.x >> 6);
    {
        const int tid = threadIdx.x;
        for (int u = tid; u < (LDS_BYTES - LDS_MISC) / 4; u += NTHR) ((LAS unsigned*)(lds + LDS_MISC))[u] = 0u;
        __syncthreads();
        if (tid == 0) { LAS unsigned long long* t = (LAS unsigned long long*)(lds + LDS_ARGS);
#pragma unroll
            for (int i = 0; i < 24; ++i) t[i] = (unsigned long long)(uintptr_t)a.in[i];
            t[24] = (unsigned long long)(uintptr_t)a.out; t[25] = (unsigned long long)(uintptr_t)a.ws; }
        __syncthreads();
    }
    (void)xcd_barrier_post((unsigned*)(arg_ws(lds) + WS_CTL) + CW_BAR, (volatile LAS unsigned*)(lds + LDS_MISC + 32));

    { const int tid = opq_tid(wv), G = opq_g(), bx = opq_bx(); const float* rb = arg_in(lds, I_RB); unsigned char* ws = arg_ws(lds);
      float* dilT = (float*)(ws + WS_TBL); float* nsaT = (float*)(ws + WS_TBL + 65536);
      for (int i = bx * NTHR + tid; i < 3 * 8 * DTS + 8 * TBLS; i += G * NTHR) {
          if (i < 3 * 8 * DTS) { const int p = i / (8 * DTS), h = (i / DTS) % 8, df = i % DTS - DT0; const int d = (p == 0) ? 1 : (p == 1 ? 4 : 16);
              dilT[i] = (df >= 0 && df <= 128) ? rb[rel_bucket_dev(df * d) * 16 + h] : 0.f; }
          else { const int j = i - 3 * 8 * DTS, hh = j / TBLS, ds = j % TBLS - TBL0; nsaT[j] = (ds >= 0) ? rb[rel_bucket_dev(ds) * 16 + 8 + hh] : 0.f; } } }

    ph_prologue(lds, wv);
    GRID_BAR();
#pragma unroll 1
    for (int step = 0; step < 2 * DEPTH; ++step) {
        const int l = step >> 1, half = step & 1;
#if PH_FFN
        { unsigned char* ws = arg_ws(lds); const int G = opq_g(), bx = opq_bx();
          pg8::Gemm g{64, 64, DM}; pg8::SchedStd S; S.init(ws + WS_HB, ws + WS_WUP + (size_t)step * SZ_WUP, NTOK, 2 * DFF, DM, DM, G, bx); const pg8::EpiSwiGLU E{(bf16_t*)(ws + WS_HP), DFF, (const float*)(ws + WS_RSTD)};
          pg8::gemm_phase<pg8::EpiSwiGLU, pg8::SchedStd, 32768, 32768>(opq_lds(lds), g, S, E, wv);
#if DUP_UP
          GRID_BAR(); pg8::gemm_phase<pg8::EpiSwiGLU, pg8::SchedStd, 32768, 32768>(opq_lds(lds), g, S, E, wv);
#endif
        }
        GRID_BAR();
        { unsigned char* ws = arg_ws(lds); const int G = opq_g(), bx = opq_bx(); float* X = arg_out(lds);
          pg8::Gemm g{64, 64, DFF}; pg8::SchedStd S; S.init(ws + WS_HP, ws + WS_WDN + (size_t)step * SZ_WDN, NTOK, DM, DFF, DFF, G, bx, 4);
          pg8::EpiResid E{(step == 2 * DEPTH - 1) ? X : (float*)nullptr, (bf16_t*)(ws + WS_HB), (float*)(ws + WS_SSQ), DM, 0.5f};
          pg8::gemm_phase<pg8::EpiResid, pg8::SchedStd, 32768, 32768>(opq_lds(lds), g, S, E, wv);
#if DUP_DN
          { GRID_BAR(); const pg8::EpiResid E2{(step == 2 * DEPTH - 1) ? X : (float*)nullptr, (bf16_t*)(ws + WS_HB), (float*)(ws + WS_SSQ), DM, 0.f}; pg8::gemm_phase<pg8::EpiResid, pg8::SchedStd, 32768, 32768>(opq_lds(lds), g, S, E2, wv); }
#endif
        }
#endif
        GRID_BAR();
        ph_rstd(lds, wv);
        GRID_BAR();
        if (half == 0) {
#if PH_INP
            { unsigned char* ws = arg_ws(lds); const int G = opq_g(), bx = opq_bx();
              pg8::Gemm g{64, 64, DM}; pg8::SchedStd S; S.init(ws + WS_HB, ws + WS_WIN + (size_t)l * SZ_WIN, NTOK, PC, DM, DM, G, bx); const pg8::EpiBf16 E{(bf16_t*)(ws + WS_HP), PC, (const float*)(ws + WS_RSTD)};
              pg8::gemm_phase<pg8::EpiBf16, pg8::SchedStd, 32768, 32768>(opq_lds(lds), g, S, E, wv);
#if DUP_IN
              GRID_BAR(); pg8::gemm_phase<pg8::EpiBf16, pg8::SchedStd, 32768, 32768>(opq_lds(lds), g, S, E, wv);
#endif
            }
#endif
            GRID_BAR();
            ph_headnorm(lds, l, wv);
            GRID_BAR();
#pragma unroll 1
            for (int pat3 = 0; pat3 < 3 * (1 + DUP_DIL); ++pat3) { const int pat = pat3 % 3;
#if PH_CMP
                if (pat3 == 0) { unsigned char* ws = arg_ws(lds); const int G = opq_g(), bx = opq_bx();
                  pg8::Gemm g{64, 64, 1024}; pg8::SchedCmp S; S.A = (const char*)(ws + WS_ACMP); S.Bt = (const char*)(ws + WS_WC1 + (size_t)l * SZ_WC1); S.G = G; S.c = bx; pg8::EpiF32Z E{(float*)(ws + WS_CP), 512, (size_t)4096 * 512};
                  pg8::gemm_phase<pg8::EpiF32Z, pg8::SchedCmp, 32768, 32768>(opq_lds(lds), g, S, E, wv); }
#endif
                if (pat3 == 1) ph_cmp2(lds, l, wv);
#if PH_DIL
                { unsigned char* ws = arg_ws(lds); const int G = opq_g(), bx = opq_bx();
                  for (int u0 = bx; u0 < 1024; u0 += G) { const int w_ = u0 & 255, k_ = u0 >> 8; const int unit = (((w_ & 7) + 8 * k_) << 5) | (w_ >> 3);
                    dil_unit((LAS char*)opq_lds(lds), (const bf16_t*)(ws + WS_HP), (bf16_t*)(ws + WS_OA), (float*)(ws + WS_LSE), (const float*)(ws + WS_TBL), pat, 2 * pat, unit, wv); } }
#endif
                if (pat3 + 1 < 3 * (1 + DUP_DIL)) GRID_BAR();
            }
#if PH_NSA
            { unsigned char* ws = arg_ws(lds); const int G = opq_g(), bx = opq_bx();
              const float* gb = arg_in(lds, I_GB) + l * 24;
              int last_bg = -1;
#pragma unroll 1
              for (int i4 = 0; i4 < 4 * (1 + DUP_NSA); ++i4)
#pragma unroll 1
                  for (int w = bx; w < 256; w += G) { const int i = i4 & 3; const int bg = w & 7, j = w >> 3;
                      const int qi = (i == 0) ? 127 - j : (i == 1 ? j : (i == 2 ? 64 + j : 63 - j));
                      nsa_unit((LAS char*)opq_lds(lds), (const bf16_t*)(ws + WS_HP), (const bf16_t*)(ws + WS_KC), (const bf16_t*)(ws + WS_VC), (bf16_t*)(ws + WS_ON), (const float*)(ws + WS_TBL + 65536), gb, bg >> 1, bg & 1, qi, bg != last_bg, wv); last_bg = bg; } }
#endif
            GRID_BAR();
            ph_outnorm(lds, l, wv);
            GRID_BAR();
#if PH_OUT
            { unsigned char* ws = arg_ws(lds); const int G = opq_g(), bx = opq_bx(); float* X = arg_out(lds);
              pg8::Gemm g{64, 64, DM}; pg8::SchedStd S; S.init(ws + WS_HP, ws + WS_WOUT + (size_t)l * SZ_WOUT, NTOK, DM, DM, DM, G, bx, 4); pg8::EpiResid E{(float*)nullptr, (bf16_t*)(ws + WS_HB), (float*)(ws + WS_SSQ), DM, 1.0f};
              pg8::gemm_phase<pg8::EpiResid, pg8::SchedStd, 32768, 32768>(opq_lds(lds), g, S, E, wv);
#if DUP_OUT
              { GRID_BAR(); const pg8::EpiResid E2{(step == 2 * DEPTH - 1) ? X : (float*)nullptr, (bf16_t*)(ws + WS_HB), (float*)(ws + WS_SSQ), DM, 0.f}; pg8::gemm_phase<pg8::EpiResid, pg8::SchedStd, 32768, 32768>(opq_lds(lds), g, S, E2, wv); }
#endif
            }
#endif
            GRID_BAR();
            ph_rstd(lds, wv);
            GRID_BAR();
        }
    }
}

extern "C" void kernel_launch(void* const* d_in, const int* in_sizes, int n_in, void* d_out, int out_size, void* d_ws, size_t ws_size, hipStream_t stream) {
    static int grid = 0;
    if (grid == 0) {
        if (n_in != 24 || in_sizes[0] != NTOK * DM || out_size != NTOK * DM || ws_size < WS_END) { fprintf(stderr, "kernel_launch: shape mismatch n_in %d in0 %d out %d ws %zu (need %zu)\n", n_in, n_in > 0 ? in_sizes[0] : -1, out_size, ws_size, (size_t)WS_END); grid = -1; return; }
        int dev = 0, cus = 0, per_cu = 0;
        if (hipGetDevice(&dev) != hipSuccess || hipDeviceGetAttribute(&cus, hipDeviceAttributeMultiprocessorCount, dev) != hipSuccess) { grid = -1; return; }
        if (hipFuncSetAttribute((const void*)mega_fwd, hipFuncAttributeMaxDynamicSharedMemorySize, LDS_BYTES) != hipSuccess) { fprintf(stderr, "kernel_launch: hipFuncSetAttribute failed\n"); grid = -1; return; }
        if (hipOccupancyMaxActiveBlocksPerMultiprocessor(&per_cu, (const void*)mega_fwd, NTHR, LDS_BYTES) != hipSuccess || per_cu < 1) { fprintf(stderr, "kernel_launch: occupancy query says %d\n", per_cu); (void)hipGetLastError(); if (per_cu < 1) { grid = -1; return; } }
        grid = cus;
    }
    if (grid < 0) return;
    if (hipMemsetAsync((char*)d_ws + WS_CTL, 0, CTL_ZERO_BYTES, stream) != hipSuccess) return;
    Args a{};
    for (int i = 0; i < 24; ++i) a.in[i] = (const float*)d_in[i];
    a.out = (float*)d_out; a.ws = (unsigned char*)d_ws;
    hipLaunchKernelGGL(mega_fwd, dim3(grid), dim3(NTHR), LDS_BYTES, stream, a);
    const hipError_t le = hipPeekAtLastError();
    if (le != hipSuccess) fprintf(stderr, "kernel_launch: launch failed: %s\n", hipGetErrorName(le));
}
```

```cpp
#include <hip/hip_runtime.h>
#include <cstdio>
#include <cstdint>

#define LAS __attribute__((address_space(3)))
typedef unsigned short bf16_t;
typedef short bf16x8 __attribute__((ext_vector_type(8)));
typedef short s16x4 __attribute__((ext_vector_type(4)));
typedef float f32x2 __attribute__((ext_vector_type(2)));
typedef float f32x4 __attribute__((ext_vector_type(4)));
typedef float f32x16 __attribute__((ext_vector_type(16)));
typedef unsigned u32x2 __attribute__((ext_vector_type(2)));
typedef unsigned u32x4 __attribute__((ext_vector_type(4)));

constexpr int BATCH = 4, SEQ = 8192, DM = 2048, DFF = 5632, NTOK = BATCH * SEQ, DEPTH = 4, HD = 128;
constexpr int IN_COLS = 5656, PC = 5888;
constexpr int C_QA = 0, C_KA = 1024, C_VA = 2048, C_QN = 3072, C_KC = 4096, C_VC = 4352, C_KS = 4608, C_VS = 4864, C_KW = 5120, C_VW = 5376, C_GL = 5632;
constexpr float EPS = 1e-6f, QSCALE = 0.08838834764831845f, LOG2E = 1.4426950408889634f;
constexpr int TBLS = 1704, TBL0 = 64;
constexpr int DTS = 320, DT0 = 96;
constexpr int NWAVES = 8, NTHR = 512;

constexpr size_t MiB = 1u << 20;
constexpr size_t WS_CTL = 0, CTL_ZERO_BYTES = 1 * MiB;
constexpr size_t WS_TBL = 1 * MiB;
constexpr size_t SZ_WUP = 44 * MiB, SZ_WDN = 22 * MiB, SZ_WIN = 23 * MiB, SZ_WOUT = 8 * MiB, SZ_WC1 = 8 * MiB;
constexpr size_t WS_WUP = 2 * MiB;
constexpr size_t WS_WDN = WS_WUP + 8 * SZ_WUP;
constexpr size_t WS_WIN = WS_WDN + 8 * SZ_WDN;
constexpr size_t WS_WOUT = WS_WIN + 4 * SZ_WIN;
constexpr size_t WS_WC1 = WS_WOUT + 4 * SZ_WOUT;
constexpr size_t WS_HB = WS_WC1 + 4 * SZ_WC1;
constexpr size_t WS_HP = WS_HB + 128 * MiB;
constexpr size_t WS_OA = WS_HP + 368 * MiB;
constexpr size_t WS_LSE = WS_OA + 64 * MiB;
constexpr size_t WS_ON = WS_LSE + 1 * MiB;
constexpr size_t WS_ACMP = WS_ON + 192 * MiB;
constexpr size_t WS_CP = WS_ACMP + 64 * MiB;
constexpr size_t WS_KC = WS_CP + 64 * MiB;
constexpr size_t WS_VC = WS_KC + 1 * MiB;
constexpr size_t WS_SSQ = WS_VC + 1 * MiB;
constexpr size_t WS_RSTD = WS_SSQ + 4 * MiB;
constexpr size_t WS_END = WS_RSTD + 1 * MiB;
constexpr int CW_BAR = 4096;

__device__ __forceinline__ unsigned f2bf(float f) { unsigned u = __builtin_bit_cast(unsigned, f); return (u + 0x7fffu + ((u >> 16) & 1u)) >> 16; }
__device__ __forceinline__ unsigned pk2(float lo, float hi) { return f2bf(lo) | (f2bf(hi) << 16); }
__device__ __forceinline__ float bf2f(bf16_t b) { return __builtin_bit_cast(float, ((unsigned)b) << 16); }
__device__ __forceinline__ float bflo(unsigned w) { return __builtin_bit_cast(float, w << 16); }
__device__ __forceinline__ float bfhi(unsigned w) { return __builtin_bit_cast(float, w & 0xffff0000u); }
__device__ __forceinline__ unsigned cvtpk(float lo, float hi) { unsigned r; asm volatile("v_cvt_pk_bf16_f32 %0, %1, %2" : "=v"(r) : "v"(lo), "v"(hi)); return r; }
__device__ __forceinline__ float shx(float v, int m, int lane) { return __builtin_bit_cast(float, __builtin_amdgcn_ds_bpermute((lane ^ m) << 2, __builtin_bit_cast(int, v))); }
__device__ __forceinline__ float wave_sum(float v, int lane) {
#pragma unroll
    for (int o = 1; o < 64; o <<= 1) v += shx(v, o, lane);
    return v;
}
__device__ __forceinline__ LAS unsigned char* opq_lds(LAS unsigned char* p) { unsigned a = (unsigned)(uintptr_t)p; asm volatile("" : "+s"(a)); return (LAS unsigned char*)(uintptr_t)a; }
__device__ __forceinline__ int opq_tid(int wv) { int l; asm volatile("v_mbcnt_lo_u32_b32 %0, -1, 0\n\tv_mbcnt_hi_u32_b32 %0, -1, %0" : "=v"(l)); return wv * 64 + l; }
__device__ __forceinline__ size_t kt_off(int r, int k, int K) { return (((size_t)(r >> 8) * (K >> 6) + (k >> 6)) * 256 + (r & 255)) * 64 + (k & 63); }
#define LDS_WAIT() asm volatile("s_waitcnt lgkmcnt(0)" ::: "memory")
#define VM_WAIT() asm volatile("s_waitcnt vmcnt(0)" ::: "memory")
#define SBAR() __builtin_amdgcn_sched_barrier(0)

#define XB_TMO      128
#define XB_XCNT(j)  (256  + 64 * (j))
#define XB_XSUB(j)  (1280 + 64 * (j))
#define XB_XGEN(j)  (2304 + 64 * (j))
#define XB_TOP      3328
#define XB_TOPGEN   3392
#define XCD_BAR_WORDS 3456
#define XB_SPIN_CAP (1u << 18)
__device__ __forceinline__ unsigned xb_ld(unsigned* p)              { return __hip_atomic_load(p, __ATOMIC_RELAXED, __HIP_MEMORY_SCOPE_AGENT); }
__device__ __forceinline__ unsigned xb_add(unsigned* p, unsigned v) { return __hip_atomic_fetch_add(p, v, __ATOMIC_RELAXED, __HIP_MEMORY_SCOPE_AGENT); }
__device__ __forceinline__ unsigned xb_xcc_id() { return (unsigned)__builtin_amdgcn_s_getreg((3 << 11) | 20) & 0xFu; }
#define XB_SPIN(cond, bar) do { unsigned _sp = 0; while (cond) { __builtin_amdgcn_s_sleep(1); \
    if ((++_sp & 255u) == 0u) { if (xb_ld(&(bar)[XB_TMO])) break; if (_sp > XB_SPIN_CAP) { atomicAdd(&(bar)[XB_TMO], 1u); break; } } } } while (0)
struct XcdBarrier { unsigned* bar; unsigned x; volatile LAS unsigned* st; };
__device__ __forceinline__ XcdBarrier xcd_barrier_post(unsigned* bar, volatile LAS unsigned* st) {
    XcdBarrier b; b.bar = bar; b.x = xb_xcc_id(); b.st = st;
    if (threadIdx.x == 0) (void)xb_add(&bar[XB_XCNT(b.x)], 1u);
    return b;
}
__device__ __forceinline__ void xcd_barrier_complete(unsigned* bar, unsigned x, unsigned& nloc, unsigned& nx) {
    const unsigned G = gridDim.x * gridDim.y * gridDim.z;
    unsigned sum, cnt, mine, sp = 0u;
    for (;;) {
        sum = 0u; cnt = 0u; mine = 0u;
#pragma unroll
        for (unsigned j = 0; j < 16; ++j) { const unsigned c = xb_ld(&bar[XB_XCNT(j)]); sum += c; cnt += (c > 0u) ? 1u : 0u; mine = (j == x) ? c : mine; }
        if (sum == G) break;
        __builtin_amdgcn_s_sleep(1);
        if ((++sp & 255u) == 0u) { if (xb_ld(&bar[XB_TMO])) break; if (sp > XB_SPIN_CAP) { atomicAdd(&bar[XB_TMO], 1u); break; } }
    }
    nloc = mine > 0u ? mine : 1u; nx = cnt > 0u ? cnt : 1u;
}
__device__ __forceinline__ void xcd_barrier(const XcdBarrier& b, const int wv) {
    asm volatile("s_waitcnt vmcnt(0)" ::: "memory");
    __syncthreads();
    if (opq_tid(wv) == 0) {
        unsigned* bar = b.bar; asm volatile("" : "+s"(bar));
        __builtin_amdgcn_s_waitcnt(0);
        unsigned nloc = b.st[0], nx = b.st[1];
        if (nloc == 0u) { xcd_barrier_complete(bar, b.x, nloc, nx); b.st[0] = nloc; b.st[1] = nx; }
        const unsigned old = xb_add(&bar[XB_XSUB(b.x)], 1u);
        const unsigned gen = old / nloc;
        if (old + 1u == (gen + 1u) * nloc) {
            __builtin_amdgcn_fence(__ATOMIC_RELEASE, "agent");
            asm volatile("s_waitcnt vmcnt(0)" ::: "memory");
            const unsigned og = xb_add(&bar[XB_TOP], 1u);
            const unsigned tg = og / nx;
            if (og + 1u == (tg + 1u) * nx) xb_add(&bar[XB_TOPGEN], 1u);
            else XB_SPIN(xb_ld(&bar[XB_TOPGEN]) == tg, bar);
            __builtin_amdgcn_fence(__ATOMIC_ACQUIRE, "agent");
            xb_add(&bar[XB_XGEN(b.x)], 1u);
            asm volatile("s_waitcnt vmcnt(0)" ::: "memory");
        } else {
            XB_SPIN(xb_ld(&bar[XB_XGEN(b.x)]) == gen, bar);
            __builtin_amdgcn_fence(__ATOMIC_ACQUIRE, "agent");
            asm volatile("s_waitcnt vmcnt(0)" ::: "memory");
        }
    }
    __syncthreads();
}

namespace pg8 {
constexpr int BM = 256, BK = 64, HALF = 128, HTB = HALF * BK * 2, STAGE_BYTES = 8 * HTB, NXCD = 8, WGM = 8;
__host__ __device__ __forceinline__ int lds_byte(int r, int c) { const int st = (r >> 4) * 2 + (c >> 5), rr = r & 15, cc = c & 31, ob = rr * 64 + cc * 2; return st * 1024 + (ob ^ (((ob >> 9) & 1) << 5)); }
__host__ __device__ __forceinline__ void stage_rc(int b, int& R, int& C) { const int st = b / 1024, sb = b % 1024, swz = sb ^ (((sb >> 9) & 1) << 5); R = (st >> 1) * 16 + swz / 64; C = (st & 1) * 32 + (swz % 64) / 2; }
__host__ __device__ __forceinline__ int perm32(int rho) { const int n = rho >> 4, i = rho & 15; return 8 * (i >> 2) + 4 * n + (i & 3); }
struct Unit { int pm, pn, z; };
struct Gemm { int lda, ldb, K; };
struct SchedStd {
    const char* A; const char* Bt; size_t atile, btile; int nM, nN, nwg, G, c, wgm;
    __device__ __forceinline__ void init(const void* A_, const void* Bt_, int M, int N, int lda, int ldb, int G_, int c_, int wgm_ = WGM) { wgm = wgm_;
        A = (const char*)A_; Bt = (const char*)Bt_; atile = (size_t)BM * lda * 2; btile = (size_t)BM * ldb * 2; nM = M / BM; nN = N / BM; nwg = nM * nN; G = G_; c = c_; }
    __device__ __forceinline__ bool next(int i, Unit& u) const {
        const long L = (long)i * G + c; if (L >= nwg) return false;
        int wgid = (int)L; { const int q = nwg / NXCD, r = nwg % NXCD, xcd = wgid % NXCD, off = wgid / NXCD; wgid = (xcd < r ? xcd * (q + 1) : r * (q + 1) + (xcd - r) * q) + off; }
        const int nig = wgm * nN, gid = wgid / nig, fm = gid * wgm, gsz = (nM - fm) < wgm ? (nM - fm) : wgm;
        u.pm = fm + ((wgid % nig) % gsz); u.pn = (wgid % nig) / gsz; u.z = 0; return true;
    }
    __device__ __forceinline__ const char* a_ptr(const Unit& u) const { return A + (size_t)u.pm * atile; }
    __device__ __forceinline__ const char* b_ptr(const Unit& u) const { return Bt + (size_t)u.pn * btile; }
};
struct SchedCmp {
    const char* A; const char* Bt; int G, c;
    __device__ __forceinline__ bool next(int i, Unit& u) const { const int L = i * G + c; if (L >= 256) return false; u.z = L >> 5; u.pm = (L & 31) >> 1; u.pn = L & 1; return true; }
    __device__ __forceinline__ const char* a_ptr(const Unit& u) const { const int kv = u.z >> 2, ks = u.z & 3; return A + ((size_t)(kv * 16 + u.pm) * 64 + (size_t)ks * 16) * 32768; }
    __device__ __forceinline__ const char* b_ptr(const Unit& u) const { const int kv = u.z >> 2, ks = u.z & 3; return Bt + ((size_t)(kv * 2 + u.pn) * 64 + (size_t)ks * 16) * 32768; }
};
struct EpiBf16 {
    static constexpr bool PERM = true;
    bf16_t* O; int ldc; const float* rstd;
    __device__ __forceinline__ void prefetch(float (&pre)[8], const Unit& u, int wr, int fr) const {
#pragma unroll
        for (int i = 0; i < 8; ++i) pre[i] = rstd[u.pm * BM + wr * 64 + fr + (i >> 2) * HALF + (i & 3) * 16]; }
    __device__ __forceinline__ void operator()(const f32x4 (&acc)[2][2][4][2], const Unit& u, int wr, int wc, int fr, int fq, const float (&pre)[8]) const {
        const int row0 = u.pm * BM + wr * 64 + fr, col0 = u.pn * BM + wc * 32 + 8 * fq;
#pragma unroll
        for (int ai = 0; ai < 2; ++ai)
#pragma unroll
            for (int m = 0; m < 4; ++m) { bf16_t* rowp = O + (size_t)(row0 + ai * HALF + m * 16) * ldc + col0; const float rs = pre[ai * 4 + m];
#pragma unroll
                for (int bj = 0; bj < 2; ++bj) { const f32x4 v0 = acc[ai][bj][m][0] * rs, v1 = acc[ai][bj][m][1] * rs;
                    u32x4 w; w.x = cvtpk(v0[0], v0[1]); w.y = cvtpk(v0[2], v0[3]); w.z = cvtpk(v1[0], v1[1]); w.w = cvtpk(v1[2], v1[3]);
                    *(u32x4*)(rowp + bj * HALF) = w; } }
    }
};
struct EpiSwiGLU {
    static constexpr bool PERM = true;
    bf16_t* O; int ldc; const float* rstd;
    __device__ __forceinline__ void prefetch(float (&pre)[8], const Unit& u, int wr, int fr) const {
#pragma unroll
        for (int i = 0; i < 8; ++i) pre[i] = rstd[u.pm * BM + wr * 64 + fr + (i >> 2) * HALF + (i & 3) * 16]; }
    __device__ __forceinline__ void operator()(const f32x4 (&acc)[2][2][4][2], const Unit& u, int wr, int wc, int fr, int fq, const float (&pre)[8]) const {
        const int rowp0 = wr * 64 + fr, kt = 2 * u.pn + (wc >> 1), cit = (wc & 1) * 32 + 8 * fq;
        bf16_t* tile = O + ((size_t)u.pm * (ldc / 64) + kt) * (256 * 64) + cit;
#pragma unroll
        for (int ai = 0; ai < 2; ++ai)
#pragma unroll
            for (int m = 0; m < 4; ++m) { bf16_t* rowp = tile + (size_t)(rowp0 + ai * HALF + m * 16) * 64; const float rs = pre[ai * 4 + m];
                float v[8];
#pragma unroll
                for (int n = 0; n < 2; ++n)
#pragma unroll
                    for (int j = 0; j < 4; ++j) { const float g = acc[ai][0][m][n][j] * rs, up = acc[ai][1][m][n][j] * rs;
                        const float s = g * __builtin_amdgcn_rcpf(1.0f + __builtin_amdgcn_exp2f(-g * LOG2E)); v[n * 4 + j] = s * up; }
                u32x4 w; w.x = cvtpk(v[0], v[1]); w.y = cvtpk(v[2], v[3]); w.z = cvtpk(v[4], v[5]); w.w = cvtpk(v[6], v[7]);
                *(u32x4*)rowp = w; }
    }
};
struct EpiResid {
    static constexpr bool PERM = false;
    __device__ __forceinline__ void prefetch(float (&)[8], const Unit&, int, int) const {}
    float* out; bf16_t* xb; float* ssq; int ldc; float alpha;
    __device__ __forceinline__ void operator()(const f32x4 (&acc)[2][2][4][2], const Unit& u, int wr, int wc, int fr, int fq, const float (&pre)[8]) const {
        const int row0 = u.pm * BM + wr * 64 + fr, col0 = u.pn * BM + wc * 32 + 4 * fq;
        u32x2 bs[4][4];
#define ER_LOAD(g) do { const int row_ = row0 + ((g) >> 2) * HALF + ((g) & 3) * 16; \
        _Pragma("unroll") for (int q_ = 0; q_ < 4; ++q_) bs[(g) & 3][q_] = *(const u32x2*)(xb + kt_off(row_, col0 + (q_ >> 1) * HALF + (q_ & 1) * 16, ldc)); } while (0)
        ER_LOAD(0); ER_LOAD(1); ER_LOAD(2); ER_LOAD(3);
#pragma unroll
        for (int g = 0; g < 8; ++g) { const int ai = g >> 2, m = g & 3; const int row = row0 + ai * HALF + m * 16; float ss = 0.f;
#pragma unroll
            for (int q = 0; q < 4; ++q) { const int bj = q >> 1, n = q & 1; const u32x2 b = bs[g & 3][q];
                const f32x4 o = (f32x4){bflo(b.x), bfhi(b.x), bflo(b.y), bfhi(b.y)} + acc[ai][bj][m][n] * alpha;
                ss += (o.x * o.x + o.y * o.y) + (o.z * o.z + o.w * o.w);
                u32x2 w; w.x = cvtpk(o.x, o.y); w.y = cvtpk(o.z, o.w); *(u32x2*)(xb + kt_off(row, col0 + bj * HALF + n * 16, ldc)) = w;
                if (out) *(f32x4*)(out + (size_t)row * ldc + col0 + bj * HALF + n * 16) = o; }
            if (g + 4 < 8) ER_LOAD(g + 4);
            const int lane = fq * 16 + fr; ss += shx(ss, 16, lane); ss += shx(ss, 32, lane);
            if (fq == 0) ssq[(size_t)row * 32 + u.pn * 4 + wc] = ss; }
#undef ER_LOAD
    }
};
struct EpiF32Z {
    static constexpr bool PERM = false;
    float* C; int ldc; size_t zstride;
    __device__ __forceinline__ void prefetch(float (&)[8], const Unit&, int, int) const {}
    __device__ __forceinline__ void operator()(const f32x4 (&acc)[2][2][4][2], const Unit& u, int wr, int wc, int fr, int fq, const float (&pre)[8]) const {
        float* Cz = C + (size_t)u.z * zstride;
        const int row0 = u.pm * BM + wr * 64 + fr, col0 = u.pn * BM + wc * 32 + 4 * fq;
#pragma unroll
        for (int ai = 0; ai < 2; ++ai)
#pragma unroll
            for (int m = 0; m < 4; ++m) { float* rowp = Cz + (size_t)(row0 + ai * HALF + m * 16) * ldc + col0;
#pragma unroll
                for (int bj = 0; bj < 2; ++bj)
#pragma unroll
                    for (int n = 0; n < 2; ++n) *(f32x4*)(rowp + bj * HALF + n * 16) = acc[ai][bj][m][n]; }
    }
};

template <class Epi, class Sched, int KSTEP_A = 128, int KSTEP_B = 128>
__device__ __forceinline__ void gemm_phase(LAS unsigned char* lds, const Gemm g, const Sched& S, const Epi& E, const int wv) {
    const int tid = opq_tid(wv), wid = __builtin_amdgcn_readfirstlane(tid >> 6), lane = tid & 63, wr = wid >> 2, wc = wid & 3, fr = lane & 15, fq = lane >> 4;
    const int K = g.K, nt = K / BK;
    unsigned voffA[2], voffB[2];
#pragma unroll
    for (int i = 0; i < 2; ++i) { int R, C; stage_rc(tid * 16 + i * 8192, R, C); const int Rb = Epi::PERM ? ((R & ~31) + perm32(R & 31)) : R;
        voffA[i] = (unsigned)(R * g.lda + C) * 2u; voffB[i] = (unsigned)(Rb * g.ldb + C) * 2u; }
    constexpr size_t kstepA = (size_t)KSTEP_A, kstepB = (size_t)KSTEP_B;
    const size_t hstepA = (size_t)HALF * g.lda * 2, hstepB = (size_t)HALF * g.ldb * 2;
    const unsigned ldsw = (unsigned)wid * 1024u;
    const int aoff = lds_byte(wr * 64 + fr, fq * 8), boff = lds_byte(wc * 32 + fr, fq * 8);
#define PG8_SA(b, h) (((b) * 2 + (h)) * HTB)
#define PG8_SB(b, h) ((4 + (b) * 2 + (h)) * HTB)
#define PG8_STAGE(bufoff, gbase, voff) do { _Pragma("unroll") for (int _i = 0; _i < 2; ++_i) \
        __builtin_amdgcn_global_load_lds((const unsigned*)((const char*)(gbase) + (voff)[_i]), (LAS unsigned*)(lds + (bufoff) + ldsw + _i * 8192), 16, 0, 0); } while (0)
#define PG8_LDA(dst, b, h) do { _Pragma("unroll") for (int m = 0; m < 4; ++m) _Pragma("unroll") for (int k = 0; k < 2; ++k) dst[m][k] = *(const LAS bf16x8*)(lds + PG8_SA(b, h) + aoff + m * 2048 + k * 1024); } while (0)
#define PG8_LDB(dst, b, h) do { _Pragma("unroll") for (int n = 0; n < 2; ++n) _Pragma("unroll") for (int k = 0; k < 2; ++k) dst[n][k] = *(const LAS bf16x8*)(lds + PG8_SB(b, h) + boff + n * 2048 + k * 1024); } while (0)
#define PG8_MMA(ai, bj, At, Bt) do { __builtin_amdgcn_s_setprio(1); _Pragma("unroll") for (int m = 0; m < 4; ++m) _Pragma("unroll") for (int n = 0; n < 2; ++n) _Pragma("unroll") for (int k = 0; k < 2; ++k) \
        acc[ai][bj][m][n] = __builtin_amdgcn_mfma_f32_16x16x32_bf16(Bt[n][k], At[m][k], acc[ai][bj][m][n], 0, 0, 0); __builtin_amdgcn_s_setprio(0); } while (0)
#define PG8_WAIT_V(n) asm volatile("s_waitcnt vmcnt(" #n ")" ::: "memory")
#define PG8_WAIT_L(n) asm volatile("s_waitcnt lgkmcnt(" #n ")" ::: "memory")
#define PG8_BAR __builtin_amdgcn_s_barrier()
#define PG8_SCHED __builtin_amdgcn_sched_barrier(0)
    Unit cur, nxt; int ui = 0;
    if (!S.next(0, cur)) return;
    f32x4 acc[2][2][4][2];
#pragma unroll
    for (int a = 0; a < 2; ++a)
#pragma unroll
        for (int b = 0; b < 2; ++b)
#pragma unroll
            for (int m = 0; m < 4; ++m)
#pragma unroll
                for (int n = 0; n < 2; ++n) acc[a][b][m][n] = (f32x4){0.f, 0.f, 0.f, 0.f};
    bf16x8 At[4][2], B0[2][2], B1[2][2];
    const char* cA = S.a_ptr(cur); const char* cB = S.b_ptr(cur);
    float pre[8]; E.prefetch(pre, cur, wr, fr);
    PG8_STAGE(PG8_SB(0, 0), cB, voffB); PG8_STAGE(PG8_SA(0, 0), cA, voffA); PG8_STAGE(PG8_SB(0, 1), cB + hstepB, voffB); PG8_STAGE(PG8_SA(0, 1), cA + hstepA, voffA);
    if (wr == 1) PG8_BAR;
    PG8_WAIT_V(4); PG8_BAR;
    PG8_STAGE(PG8_SB(1, 0), cB + kstepB, voffB); PG8_STAGE(PG8_SA(1, 0), cA + kstepA, voffA); PG8_STAGE(PG8_SB(1, 1), cB + hstepB + kstepB, voffB);
    PG8_WAIT_V(6); PG8_BAR;
    for (;;) {
        const bool has_next = S.next(ui + 1, nxt);
        const char* nA = has_next ? S.a_ptr(nxt) : cA; const char* nB = has_next ? S.b_ptr(nxt) : cB;
        for (int t = 0; t < nt; t += 2) {
            const bool last = (t == nt - 2);
            const char* a1 = cA + (size_t)(t + 1) * kstepA;
            const char* a2 = last ? nA : cA + (size_t)(t + 2) * kstepA; const char* b2 = last ? nB : cB + (size_t)(t + 2) * kstepB;
            const char* a3 = a2 + kstepA; const char* b3 = b2 + kstepB;
            PG8_LDB(B0, 0, 0); PG8_SCHED; PG8_LDA(At, 0, 0); PG8_STAGE(PG8_SA(1, 1), a1 + hstepA, voffA);
            PG8_WAIT_L(8); PG8_BAR; PG8_WAIT_L(0); PG8_MMA(0, 0, At, B0); PG8_BAR; PG8_SCHED;
            PG8_LDB(B1, 0, 1); PG8_STAGE(PG8_SB(0, 0), b2, voffB);
            PG8_BAR; PG8_WAIT_L(0); PG8_MMA(0, 1, At, B1); PG8_BAR;
            PG8_LDA(At, 0, 1); PG8_STAGE(PG8_SA(0, 0), a2, voffA);
            PG8_BAR; PG8_WAIT_L(0); PG8_MMA(1, 0, At, B0); PG8_BAR; PG8_SCHED;
            PG8_STAGE(PG8_SB(0, 1), b2 + hstepB, voffB);
            PG8_WAIT_V(6); PG8_BAR; PG8_MMA(1, 1, At, B1); PG8_BAR;
            PG8_LDB(B0, 1, 0); PG8_SCHED; PG8_LDA(At, 1, 0); PG8_STAGE(PG8_SA(0, 1), a2 + hstepA, voffA);
            PG8_WAIT_L(8); PG8_BAR; PG8_WAIT_L(0); PG8_MMA(0, 0, At, B0); PG8_BAR; PG8_SCHED;
            PG8_LDB(B1, 1, 1); PG8_STAGE(PG8_SB(1, 0), b3, voffB);
            PG8_BAR; PG8_WAIT_L(0); PG8_MMA(0, 1, At, B1); PG8_BAR;
            PG8_LDA(At, 1, 1); PG8_STAGE(PG8_SA(1, 0), a3, voffA);
            PG8_BAR; PG8_WAIT_L(0); PG8_MMA(1, 0, At, B0); PG8_BAR; PG8_SCHED;
            PG8_STAGE(PG8_SB(1, 1), b3 + hstepB, voffB);
            PG8_WAIT_V(6); PG8_BAR; PG8_MMA(1, 1, At, B1); PG8_BAR;
        }
        E(acc, cur, wr, wc, fr, fq, pre);
        if (has_next) E.prefetch(pre, nxt, wr, fr);
        if (!has_next) break;
#pragma unroll
        for (int a = 0; a < 2; ++a)
#pragma unroll
            for (int b = 0; b < 2; ++b)
#pragma unroll
                for (int m = 0; m < 4; ++m)
#pragma unroll
                    for (int n = 0; n < 2; ++n) acc[a][b][m][n] = (f32x4){0.f, 0.f, 0.f, 0.f};
        cur = nxt; cA = nA; cB = nB; ++ui;
    }
    PG8_WAIT_V(0);
    if (wr == 0) PG8_BAR;
    PG8_BAR;
#undef PG8_SA
#undef PG8_SB
#undef PG8_STAGE
#undef PG8_LDA
#undef PG8_LDB
#undef PG8_MMA
#undef PG8_WAIT_V
#undef PG8_WAIT_L
#undef PG8_BAR
#undef PG8_SCHED
}
}

struct Args { const float* in[24]; float* out; unsigned char* ws; };
enum { I_X = 0, I_F1N, I_F1W1, I_F1W3, I_F1W2, I_MIXN, I_WIN, I_GB, I_QNA, I_KNA, I_QNN, I_KNN, I_POS, I_CKW1, I_CKW2, I_CVW1, I_CVW2, I_ON, I_WOUT, I_F2N, I_F2W1, I_F2W3, I_F2W2, I_RB };

__device__ __forceinline__ void transpose_item(const float* W, int K, int N, bf16_t* WT, int mode, int off, LAS float* scr, int item, int lane, const float* gain) {
    const int nblk = (N + 31) / 32, kb = item / nblk, nb = item % nblk, k0 = 64 * kb, n0 = 32 * nb;
    const int c4 = 4 * (lane & 7), nn = n0 + c4;
    f32x4 ld[8];
#pragma unroll
    for (int i = 0; i < 8; ++i) { const int kk = 8 * i + (lane >> 3); ld[i] = (nn < N) ? *(const f32x4*)(W + (size_t)(k0 + kk) * N + nn) : (f32x4){0.f, 0.f, 0.f, 0.f}; if (gain) ld[i] = ld[i] * gain[k0 + kk]; }
#pragma unroll
    for (int i = 0; i < 8; ++i) { const int kk = 8 * i + (lane >> 3); LAS float* d = scr + kk * 33 + c4; d[0] = ld[i].x; d[1] = ld[i].y; d[2] = ld[i].z; d[3] = ld[i].w; }
    LDS_WAIT(); asm volatile("" ::: "memory");
    const int c = lane & 7;
#pragma unroll
    for (int j = 0; j < 4; ++j) { const int n = (lane >> 3) + 8 * j; const LAS float* s = scr + (8 * c) * 33 + n;
        u32x4 o; o.x = pk2(s[0 * 33], s[1 * 33]); o.y = pk2(s[2 * 33], s[3 * 33]); o.z = pk2(s[4 * 33], s[5 * 33]); o.w = pk2(s[6 * 33], s[7 * 33]);
        const int ng = n0 + n; const int dr = mode ? ((ng >> 7) * 256 + (ng & 127) + off) : (ng + off);
        if (ng < N) *(u32x4*)(WT + kt_off(dr, k0 + 8 * c, K)) = o; }
    LDS_WAIT(); asm volatile("" ::: "memory");
}
__device__ __forceinline__ int rel_bucket_dev(int n) {
    if (n < 16) return n;
    const float v = logf((float)n / 16.0f) / 4.852030263919617f * 16.0f;
    int b = 16 + (int)v; return b < 31 ? b : 31;
}
namespace att {
constexpr int SHM_V = 16384, SHM_K = 16384;
constexpr int L_V = 0  , L_K = 49152  , L_WS = 81920, L_TBL = 83968, L_SELM = L_TBL + 4 * TBLS * 4  , L_END = L_SELM + 1024;
constexpr int L_IMP = 0;
static_assert(L_END <= 131072, "attention LDS map");
constexpr float THR = 8.f;
#define KSWZ(row, colB) ((row) * 256 + ((colB) ^ (((row) & 7) << 4)))
__device__ __forceinline__ int v_st(int k, int c) { const int kk = (k & ~0xC) | ((k & 4) << 1) | ((k & 8) >> 1); return ((kk >> 3) * 4 + (c >> 5)) * 512 + ((kk & 7) * 32 + (c & 31)) * 2; }
__device__ __forceinline__ int v_rd_base(int lane) { return ((lane & 3) << 3) | (((lane >> 2) & 3) << 6) | (((lane >> 4) & 1) << 5) | (((lane >> 5) & 1) << 8); }
__device__ __forceinline__ int crow(int r, int hi) { return (r & 3) + 8 * (r >> 2) + 4 * hi; }

__device__ __forceinline__ void partialSM(f32x16& p0, f32x16& p1, float& m_reg, float& mn, float& alpha) {
    (void)m_reg; mn = 0.f; alpha = 1.f;
#pragma unroll
    for (int r = 0; r < 16; ++r) p0[r] = __builtin_amdgcn_exp2f(p0[r] * LOG2E);
#pragma unroll
    for (int r = 0; r < 16; ++r) p1[r] = p1[r] * LOG2E;
}
__device__ __forceinline__ void partialSM_row(f32x16& p0, f32x16& p1, float& m_reg, float& mn, float& alpha, bool ok, float bias) {
    (void)m_reg; mn = 0.f; alpha = 1.f;
    const float mnL = ok ? bias * LOG2E : -__builtin_inff();
#pragma unroll
    for (int r = 0; r < 16; ++r) p0[r] = __builtin_amdgcn_exp2f(fmaf(p0[r], LOG2E, mnL));
#pragma unroll
    for (int r = 0; r < 16; ++r) p1[r] = fmaf(p1[r], LOG2E, mnL);
}
#define PK4(P, B_, OUT) do { unsigned a0 = cvtpk(P[B_+0], P[B_+1]), a1 = cvtpk(P[B_+2], P[B_+3]);                          \
        unsigned b0 = cvtpk(P[B_+4], P[B_+5]), b1 = cvtpk(P[B_+6], P[B_+7]);                                             \
        auto r0 = __builtin_amdgcn_permlane32_swap(a0, b0, false, false); auto r1 = __builtin_amdgcn_permlane32_swap(a1, b1, false, false); \
        u32x4 w = {r0[0], r1[0], r0[1], r1[1]}; OUT = *reinterpret_cast<bf16x8*>(&w); } while (0)
__device__ __forceinline__ void finishSM(f32x16& p0, f32x16& p1, float alpha, float& l_reg, bf16x8& pa0, bf16x8& pa1, bf16x8& pa2, bf16x8& pa3) {
#pragma unroll
    for (int r = 0; r < 16; ++r) p1[r] = __builtin_amdgcn_exp2f(p1[r]);
    float ps = 0;
#pragma unroll
    for (int r = 0; r < 16; ++r) ps += p0[r];
#pragma unroll
    for (int r = 0; r < 16; ++r) ps += p1[r];
    { auto rr = __builtin_amdgcn_permlane32_swap(__float_as_uint(ps), __float_as_uint(ps), false, false);
      ps = __uint_as_float(rr[0]) + __uint_as_float(rr[1]); }
    l_reg = l_reg * alpha + ps;
    PK4(p0, 0, pa0); PK4(p0, 8, pa1); PK4(p1, 0, pa2); PK4(p1, 8, pa3);
}
__device__ __forceinline__ void qkt(f32x16& p0, f32x16& p1, const LAS char* Kb, int r32, int hi, const bf16x8 (&qr)[8]) {
    p0 = f32x16{}; p1 = f32x16{};
    const LAS char* kb4[4];
#pragma unroll
    for (int dd = 0; dd < 4; ++dd) kb4[dd] = Kb + KSWZ(r32, (dd * 16 + hi * 8) * 2);
#pragma unroll
    for (int d0 = 0; d0 < 8; ++d0) { const LAS char* a = kb4[d0 & 3] + (d0 >> 2) * 128;
        const bf16x8 b0 = *reinterpret_cast<const LAS bf16x8*>(a);
        const bf16x8 b1 = *reinterpret_cast<const LAS bf16x8*>(a + 32 * 256);
        p0 = __builtin_amdgcn_mfma_f32_32x32x16_bf16(b0, qr[d0], p0, 0, 0, 0);
        p1 = __builtin_amdgcn_mfma_f32_32x32x16_bf16(b1, qr[d0], p1, 0, 0, 0); }
}
__device__ __forceinline__ void pv_tile(f32x16 (&o)[4], int vb, bf16x8 pa0, bf16x8 pa1, bf16x8 pa2, bf16x8 pa3) {
#define TRRD(dst, off) asm volatile("ds_read_b64_tr_b16 %0, %1 offset:%2" : "=&v"(dst) : "v"(vb), "i"(off) : "memory")
#define PV_D0(d0) do { s16x4 l0, l1, l2, l3, h0, h1, h2, h3; constexpr int b_ = (d0) * 512; \
        TRRD(l0, b_); TRRD(h0, b_ + 2048); TRRD(l1, b_ + 4096); TRRD(h1, b_ + 6144); TRRD(l2, b_ + 8192); TRRD(h2, b_ + 10240); TRRD(l3, b_ + 12288); TRRD(h3, b_ + 14336); \
        asm volatile("s_waitcnt lgkmcnt(0)" ::: "memory"); SBAR(); \
        o[d0] = __builtin_amdgcn_mfma_f32_32x32x16_bf16(pa0, (bf16x8){l0[0], l0[1], l0[2], l0[3], h0[0], h0[1], h0[2], h0[3]}, o[d0], 0, 0, 0);   \
        o[d0] = __builtin_amdgcn_mfma_f32_32x32x16_bf16(pa1, (bf16x8){l1[0], l1[1], l1[2], l1[3], h1[0], h1[1], h1[2], h1[3]}, o[d0], 0, 0, 0);   \
        o[d0] = __builtin_amdgcn_mfma_f32_32x32x16_bf16(pa2, (bf16x8){l2[0], l2[1], l2[2], l2[3], h2[0], h2[1], h2[2], h2[3]}, o[d0], 0, 0, 0);   \
        o[d0] = __builtin_amdgcn_mfma_f32_32x32x16_bf16(pa3, (bf16x8){l3[0], l3[1], l3[2], l3[3], h3[0], h3[1], h3[2], h3[3]}, o[d0], 0, 0, 0); } while (0)
    PV_D0(0); PV_D0(1); PV_D0(2); PV_D0(3);
#undef PV_D0
#undef TRRD
}

template <class Cfg>
__device__ __forceinline__ void attn_tiles(const Cfg& c, LAS char* lds, const bf16x8 (&qr)[8], f32x16 (&o)[4], float& m_reg, float& l_reg, const int t_lo, const int t_hi, const int wv) {
    const int tid = opq_tid(wv), lane = tid & 63, wid = __builtin_amdgcn_readfirstlane(tid >> 6), r32 = lane & 31, hi = lane >> 5;
    LAS char* V_lds = lds + L_V; LAS char* K_lds = lds + L_K;
    LAS float* al_l = (LAS float*)(lds + L_WS) + wid * 64 + 32;
    const int sr = tid >> 4, sc = (tid & 15) * 8;
    const int vst0 = v_st(sr, sc), vst1 = v_st(32 + sr, sc), kws = KSWZ(sr, sc * 2);
    const int vb0 = (int)(unsigned)(uintptr_t)V_lds + v_rd_base(lane);
    bf16x8 sk0, sk1, sv0, sv1;
    const bf16_t *gk0 = nullptr, *gk1 = nullptr, *gv0 = nullptr, *gv1 = nullptr;
#define AT_LOAD(t) do { gk0 = c.krow((t), sr) + sc; gk1 = c.krow((t), sr + 32) + sc; sk0 = *(const bf16x8*)gk0; sk1 = *(const bf16x8*)gk1; \
        if constexpr (Cfg::MODE == 0) { gv0 = c.vrow((t), sr) + sc; gv1 = c.vrow((t), sr + 32) + sc; sv0 = *(const bf16x8*)gv0; sv1 = *(const bf16x8*)gv1; } \
        asm volatile("" ::: "memory"); SBAR(); } while (0)
#define AT_WRITE(t, bf) do { asm volatile("" :: "v"(gk0), "v"(gk1), "v"(gv0), "v"(gv1)); *(LAS bf16x8*)(K_lds + (bf) * SHM_K + kws) = sk0; *(LAS bf16x8*)(K_lds + (bf) * SHM_K + kws + 32 * 256) = sk1; \
        if constexpr (Cfg::MODE == 1) { \
            _Pragma("unroll") for (int i_ = 0; i_ < 8; ++i_) { const int n_ = sc + i_, c0_ = 64 * (t) + sr, c1_ = c0_ + 32; \
                sv0[i_] = (c0_ >= 4 * n_ - 1 && c0_ <= 4 * n_ + 3) ? (short)0x3F80 : (short)0; sv1[i_] = (c1_ >= 4 * n_ - 1 && c1_ <= 4 * n_ + 3) ? (short)0x3F80 : (short)0; } } \
        *(LAS bf16x8*)(V_lds + (bf) * SHM_V + vst0) = sv0; *(LAS bf16x8*)(V_lds + (bf) * SHM_V + vst1) = sv1; } while (0)
    __builtin_amdgcn_s_waitcnt(0x0F70);
    __syncthreads();
    if (t_lo < t_hi) { AT_LOAD(t_lo); AT_WRITE(t_lo, 0); }
    __syncthreads();
    for (int t = t_lo; t < t_hi; ++t) {
        const int buf = (t - t_lo) & 1; const bool more = (t + 1 < t_hi);
        if (more) AT_LOAD(t + 1);
        if (c.active(t)) {
            f32x16 p0, p1;
            qkt(p0, p1, K_lds + buf * SHM_K, r32, hi, qr);
            if constexpr (Cfg::MODE == 0) {
                float mn, alpha; bf16x8 pa0, pa1, pa2, pa3;
                bool rok; float rbias;
                if (c.rowconst(t, rok, rbias)) partialSM_row(p0, p1, m_reg, mn, alpha, rok, rbias);
                else { c.mask(p0, p1, t); partialSM(p0, p1, m_reg, mn, alpha); }
                if (__any(alpha < 1.f)) { if (hi == 0) al_l[r32] = alpha; LDS_WAIT();
#pragma unroll
                    for (int d_ = 0; d_ < 4; ++d_)
#pragma unroll
                        for (int r = 0; r < 16; ++r) o[d_][r] *= al_l[crow(r, hi)]; }
                finishSM(p0, p1, alpha, l_reg, pa0, pa1, pa2, pa3); SBAR();
                pv_tile(o, vb0 + buf * SHM_V, pa0, pa1, pa2, pa3);
            } else {
                c.mask(p0, p1, t);
                const float mL = -c.mfix * LOG2E; const float il = c.invl;
#pragma unroll
                for (int r = 0; r < 16; ++r) { p0[r] = __builtin_amdgcn_exp2f(fmaf(p0[r], LOG2E, mL)) * il; p1[r] = __builtin_amdgcn_exp2f(fmaf(p1[r], LOG2E, mL)) * il; }
                bf16x8 pa0, pa1, pa2, pa3;
                PK4(p0, 0, pa0); PK4(p0, 8, pa1); PK4(p1, 0, pa2); PK4(p1, 8, pa3); SBAR();
                pv_tile(o, vb0 + buf * SHM_V, pa0, pa1, pa2, pa3);
#pragma unroll
                for (int r = 0; r < 16; r += 2) { const unsigned a = cvtpk(p0[r], p0[r + 1]), b = cvtpk(p1[r], p1[r + 1]);
                    p0[r] -= bflo(a); p0[r + 1] -= bfhi(a); p1[r] -= bflo(b); p1[r + 1] -= bfhi(b); }
                PK4(p0, 0, pa0); PK4(p0, 8, pa1); PK4(p1, 0, pa2); PK4(p1, 8, pa3); SBAR();
                pv_tile(o, vb0 + buf * SHM_V, pa0, pa1, pa2, pa3);
            }
        }
        if (more) AT_WRITE(t + 1, buf ^ 1);
        __syncthreads();
    }
#undef AT_LOAD
#undef AT_WRITE
}

template <class Cfg>
__device__ __forceinline__ void attn_tiles_s(const Cfg& c, LAS char* lds, const bf16x8 (&qr)[8], f32x16 (&o)[4], float& m_reg, float& l_reg, const int t_lo, const int t_hi, const int wv) {
    static_assert(Cfg::MODE == 0, "fixed-shift softmax tiles only");
    (void)m_reg;
    const int tid = opq_tid(wv), lane = tid & 63, wid = __builtin_amdgcn_readfirstlane(tid >> 6), r32 = lane & 31, hi = lane >> 5;
    LAS char* V_lds = lds + L_V; LAS char* K_lds = lds + L_K;
    const int sr = tid >> 4, sc = (tid & 15) * 8;
    const int vst0 = v_st(sr, sc), vst1 = v_st(32 + sr, sc), kws = KSWZ(sr, sc * 2);
    const int vb0 = (int)(unsigned)(uintptr_t)V_lds + v_rd_base(lane);
    bf16x8 sk0, sk1, sv0, sv1, pa0, pa1, pa2, pa3;
    const bf16_t *gk0 = nullptr, *gk1 = nullptr, *gv0 = nullptr, *gv1 = nullptr;
#define AS_LOAD(t) do { gk0 = c.krow((t), sr) + sc; gk1 = c.krow((t), sr + 32) + sc; sk0 = *(const bf16x8*)gk0; sk1 = *(const bf16x8*)gk1; \
        gv0 = c.vrow((t), sr) + sc; gv1 = c.vrow((t), sr + 32) + sc; sv0 = *(const bf16x8*)gv0; sv1 = *(const bf16x8*)gv1; asm volatile("" ::: "memory"); SBAR(); } while (0)
#define AS_WRITE(kbf, vbf) do { asm volatile("" :: "v"(gk0), "v"(gk1), "v"(gv0), "v"(gv1)); *(LAS bf16x8*)(K_lds + (kbf) * SHM_K + kws) = sk0; *(LAS bf16x8*)(K_lds + (kbf) * SHM_K + kws + 32 * 256) = sk1; \
        *(LAS bf16x8*)(V_lds + (vbf) * SHM_V + vst0) = sv0; *(LAS bf16x8*)(V_lds + (vbf) * SHM_V + vst1) = sv1; } while (0)
#define AS_SCORE(t, kbf) do { f32x16 p0, p1; float mz_ = 0.f, mn_, al_; bool rok_; float rb_; \
        qkt(p0, p1, K_lds + (kbf) * SHM_K, r32, hi, qr); \
        if (c.rowconst((t), rok_, rb_)) partialSM_row(p0, p1, mz_, mn_, al_, rok_, rb_); else { c.mask(p0, p1, (t)); partialSM(p0, p1, mz_, mn_, al_); } \
        finishSM(p0, p1, 1.f, l_reg, pa0, pa1, pa2, pa3); SBAR(); } while (0)
    if (t_lo >= t_hi) return;
    __builtin_amdgcn_s_waitcnt(0x0F70);
    __syncthreads();
    AS_LOAD(t_lo); AS_WRITE(0, 0);
    __syncthreads();
    int kb = 0, vb = 0;
    if (wid < 4) {
        for (int t = t_lo; t < t_hi; ++t) {
            const bool more = (t + 1 < t_hi); const int vn = (vb == 2) ? 0 : vb + 1;
            if (more) AS_LOAD(t + 1);
            if (c.active(t)) { AS_SCORE(t, kb); pv_tile(o, vb0 + vb * SHM_V, pa0, pa1, pa2, pa3); }
            if (more) AS_WRITE(kb ^ 1, vn);
            __syncthreads();
            kb ^= 1; vb = vn;
        }
    } else {
        bool pend = false; int vp = 0;
        for (int t = t_lo; t < t_hi; ++t) {
            const bool more = (t + 1 < t_hi); const int vn = (vb == 2) ? 0 : vb + 1;
            if (more) AS_LOAD(t + 1);
            if (pend) pv_tile(o, vb0 + vp * SHM_V, pa0, pa1, pa2, pa3);
            const bool act = c.active(t);
            if (act) AS_SCORE(t, kb);
            pend = act; vp = vb;
            if (more) AS_WRITE(kb ^ 1, vn);
            __syncthreads();
            kb ^= 1; vb = vn;
        }
        if (pend) pv_tile(o, vb0 + vp * SHM_V, pa0, pa1, pa2, pa3);
    }
#undef AS_LOAD
#undef AS_WRITE
#undef AS_SCORE
}

struct DilCfg {
    static constexpr int MODE = 0;
    const bf16_t* Kb; const bf16_t* Vb;
    const LAS float* tbl; int dshift, res, u, dqm, s0;
    __device__ __forceinline__ const bf16_t* krow(int t, int kk) const { int s = 256 * u - 128 + 64 * t + kk; s = s < 0 ? 0 : s; return Kb + (size_t)((s << dshift) + res) * PC; }
    __device__ __forceinline__ const bf16_t* vrow(int t, int kk) const { int s = 256 * u - 128 + 64 * t + kk; s = s < 0 ? 0 : s; return Vb + (size_t)((s << dshift) + res) * PC; }
    __device__ __forceinline__ bool active(int t) const { const int kb = 256 * u - 128 + 64 * t; return kb <= s0 + 31 && kb + 63 >= s0 - 128; }
    __device__ __forceinline__ bool rowconst(int, bool&, float&) const { return false; }
    __device__ __forceinline__ void mask(f32x16& p0, f32x16& p1, int t) const {
        const int dq = dqm - (256 * u - 128 + 64 * t); const float NEG = -__builtin_inff();
        const LAS float* tb = tbl + (DT0 + dq - 63);
        float bb0[16], bb1[16];
#pragma unroll
        for (int r = 0; r < 16; ++r) { const int cc = (r & 3) + 8 * (r >> 2); bb0[r] = tb[63 - cc]; bb1[r] = tb[31 - cc]; }
#pragma unroll
        for (int r = 0; r < 16; ++r) asm volatile("" : "+v"(bb0[r]), "+v"(bb1[r]));
#pragma unroll
        for (int r = 0; r < 16; ++r) { const int cc = (r & 3) + 8 * (r >> 2); const unsigned d0 = (unsigned)(dq - cc), d1 = (unsigned)(dq - cc - 32);
            p0[r] = (d0 <= 128u) ? p0[r] + bb0[r] : NEG; p1[r] = (d1 <= 128u) ? p1[r] + bb1[r] : NEG; }
    }
};
struct CmpCfg {
    static constexpr int MODE = 0;
    const bf16_t* Kb; const bf16_t* Vb; int cmax, hi4, cfull;
    __device__ __forceinline__ bool rowconst(int t, bool& ok, float& bias) const { ok = true; bias = 0.f; return 64 * t + 63 <= cfull; }
    __device__ __forceinline__ const bf16_t* krow(int t, int kk) const { return Kb + (size_t)(64 * t + kk) * HD; }
    __device__ __forceinline__ const bf16_t* vrow(int t, int kk) const { return Vb + (size_t)(64 * t + kk) * HD; }
    __device__ __forceinline__ bool active(int) const { return true; }
    __device__ __forceinline__ void mask(f32x16& p0, f32x16& p1, int t) const {
        const int cb = 64 * t + hi4; const float NEG = -__builtin_inff();
#pragma unroll
        for (int r = 0; r < 16; ++r) { const int cc = cb + (r & 3) + 8 * (r >> 2); if (cc > cmax) p0[r] = NEG; if (cc + 32 > cmax) p1[r] = NEG; }
    }
};
struct CmpImpCfg {
    static constexpr int MODE = 1;
    const bf16_t* Kb; int cmax, hi4; float mfix, invl;
    __device__ __forceinline__ const bf16_t* krow(int t, int kk) const { return Kb + (size_t)(64 * t + kk) * HD; }
    __device__ __forceinline__ const bf16_t* vrow(int, int) const { return Kb; }
    __device__ __forceinline__ bool active(int) const { return true; }
    __device__ __forceinline__ void mask(f32x16& p0, f32x16& p1, int t) const {
        const int cb = 64 * t + hi4; const float NEG = -__builtin_inff();
#pragma unroll
        for (int r = 0; r < 16; ++r) { const int cc = cb + (r & 3) + 8 * (r >> 2); if (cc > cmax) p0[r] = NEG; if (cc + 32 > cmax) p1[r] = NEG; }
    }
};
struct SlcCfg {
    static constexpr int MODE = 0;
    const bf16_t* Kb; const bf16_t* Vb;
    const LAS float* tblh;
    unsigned s0, s1, s2, s3; int tqm, cur; float b31;
    __device__ __forceinline__ const bf16_t* krow(int t, int kk) const { return Kb + (size_t)(64 * t + kk) * PC; }
    __device__ __forceinline__ const bf16_t* vrow(int t, int kk) const { return Vb + (size_t)(64 * t + kk) * PC; }
    __device__ __forceinline__ bool selbit(int t) const { const unsigned q = (unsigned)t >> 5; const unsigned w = (q == 0u ? s0 + 0u : 0u) | (q == 1u ? s1 + 0u : 0u) | (q == 2u ? s2 + 0u : 0u) | (q == 3u ? s3 + 0u : 0u); return (w >> (t & 31)) & 1u; }
    __device__ __forceinline__ bool active(int t) const { return __any(selbit(t)); }
    __device__ __forceinline__ bool rowconst(int t, bool& ok, float& bias) const { ok = selbit(t); bias = b31; return 64 * (cur - t) - 63 >= 1513; }
    __device__ __forceinline__ void mask(f32x16& p0, f32x16& p1, int t) const {
        const bool sel = selbit(t); const int dq = tqm - 64 * t; const float NEG = -__builtin_inff();
        const LAS float* tb = tblh + (TBL0 + dq - 63);
        float bb0[16], bb1[16];
#pragma unroll
        for (int r = 0; r < 16; ++r) { const int cc = (r & 3) + 8 * (r >> 2); bb0[r] = tb[63 - cc]; bb1[r] = tb[31 - cc]; }
#pragma unroll
        for (int r = 0; r < 16; ++r) asm volatile("" : "+v"(bb0[r]), "+v"(bb1[r]));
#pragma unroll
        for (int r = 0; r < 16; ++r) { const int cc = (r & 3) + 8 * (r >> 2); const int d0 = dq - cc, d1 = dq - cc - 32;
            p0[r] = (sel && d0 >= 0) ? p0[r] + bb0[r] : NEG; p1[r] = (sel && d1 >= 0) ? p1[r] + bb1[r] : NEG; }
    }
};
struct WinCfg {
    static constexpr int MODE = 0;
    const bf16_t* Kb; const bf16_t* Vb; const LAS float* tblh; int tqm;
    __device__ __forceinline__ bool rowconst(int, bool&, float&) const { return false; }
    __device__ __forceinline__ const bf16_t* krow(int t, int kk) const { return Kb + (size_t)(64 * t + kk) * PC; }
    __device__ __forceinline__ const bf16_t* vrow(int t, int kk) const { return Vb + (size_t)(64 * t + kk) * PC; }
    __device__ __forceinline__ bool active(int) const { return true; }
    __device__ __forceinline__ void mask(f32x16& p0, f32x16& p1, int t) const {
        const int dq = tqm - 64 * t; const float NEG = -__builtin_inff();
        const LAS float* tb = tblh + (TBL0 + dq - 63);
        float bb0[16], bb1[16];
#pragma unroll
        for (int r = 0; r < 16; ++r) { const int cc = (r & 3) + 8 * (r >> 2); bb0[r] = tb[63 - cc]; bb1[r] = tb[31 - cc]; }
#pragma unroll
        for (int r = 0; r < 16; ++r) asm volatile("" : "+v"(bb0[r]), "+v"(bb1[r]));
#pragma unroll
        for (int r = 0; r < 16; ++r) { const int cc = (r & 3) + 8 * (r >> 2); const unsigned d0 = (unsigned)(dq - cc), d1 = (unsigned)(dq - cc - 32);
            p0[r] = (d0 < 512u) ? p0[r] + bb0[r] : NEG; p1[r] = (d1 < 512u) ? p1[r] + bb1[r] : NEG; }
    }
};
}

__device__ __forceinline__ void load_q_normed(const bf16_t* qp  , const float* gain  , bf16x8 (&qr)[8]) {
    u32x4 raw[8];
#pragma unroll
    for (int d0 = 0; d0 < 8; ++d0) raw[d0] = *(const u32x4*)(qp + d0 * 16);
    float ss = 0.f;
#pragma unroll
    for (int d0 = 0; d0 < 8; ++d0) { const u32x4 w = raw[d0]; const float a0 = bflo(w.x), a1 = bfhi(w.x), a2 = bflo(w.y), a3 = bfhi(w.y), a4 = bflo(w.z), a5 = bfhi(w.z), a6 = bflo(w.w), a7 = bfhi(w.w);
        ss += ((a0 * a0 + a1 * a1) + (a2 * a2 + a3 * a3)) + ((a4 * a4 + a5 * a5) + (a6 * a6 + a7 * a7)); }
    { auto rr = __builtin_amdgcn_permlane32_swap(__float_as_uint(ss), __float_as_uint(ss), false, false); ss = __uint_as_float(rr[0]) + __uint_as_float(rr[1]); }
    const float rs = QSCALE / sqrtf(ss * (1.f / HD) + EPS);
#pragma unroll
    for (int d0 = 0; d0 < 8; ++d0) { const u32x4 w = raw[d0]; const f32x4 g0 = *(const f32x4*)(gain + d0 * 16), g1 = *(const f32x4*)(gain + d0 * 16 + 4);
        u32x4 o; o.x = cvtpk(bflo(w.x) * rs * g0.x, bfhi(w.x) * rs * g0.y); o.y = cvtpk(bflo(w.y) * rs * g0.z, bfhi(w.y) * rs * g0.w);
        o.z = cvtpk(bflo(w.z) * rs * g1.x, bfhi(w.z) * rs * g1.y); o.w = cvtpk(bflo(w.w) * rs * g1.z, bfhi(w.w) * rs * g1.w);
        qr[d0] = *reinterpret_cast<bf16x8*>(&o); }
}

__device__ __forceinline__ void dil_unit(LAS char* lds, const bf16_t* P, bf16_t* OA, float* LSE, const float* dilT, const float* qgain, int pat, int dshift, int unit, const int wv) {
    using namespace att;
    const int tid = opq_tid(wv), lane = tid & 63, wid = __builtin_amdgcn_readfirstlane(tid >> 6), r32 = lane & 31, hi = lane >> 5;
    const int bh = unit >> 5, ru = unit & 31, b = bh >> 3, h = bh & 7;
    const int ncs = 5 - dshift, res = ru >> ncs, u = ru & ((1 << ncs) - 1);
    LAS float* tbl = (LAS float*)(lds + L_TBL);
    __syncthreads();
    if (tid < DTS) tbl[tid] = dilT[(pat * 8 + h) * DTS + tid];
    const int s0 = 256 * u + 32 * wid, s_row = s0 + r32;
    const size_t tokrow = (size_t)b * SEQ + (size_t)((s_row << dshift) + res);
    bf16x8 qr[8];
    load_q_normed(P + tokrow * PC + C_QA + h * HD + hi * 8, qgain + hi * 8, qr);
    f32x16 o[4]; float m_reg, l_reg;
    m_reg = 0.f;
    if (pat == 0) { l_reg = 0.f;
#pragma unroll
        for (int d0 = 0; d0 < 4; ++d0) o[d0] = f32x16{}; }
    else { l_reg = LSE[tokrow * 8 + h];
#pragma unroll
        for (int r = 0; r < 16; ++r) { const size_t tr = (size_t)b * SEQ + (size_t)(((s0 + crow(r, hi)) << dshift) + res); const bf16_t* op = OA + tr * 1024 + h * HD + r32;
#pragma unroll
            for (int d0 = 0; d0 < 4; ++d0) o[d0][r] = bf2f(op[d0 * 32]); } }
    DilCfg c; c.Kb = P + (size_t)b * SEQ * PC + C_KA + h * HD; c.Vb = P + (size_t)b * SEQ * PC + C_VA + h * HD; c.tbl = tbl; c.dshift = dshift; c.res = res; c.u = u; c.dqm = s_row - 4 * hi; c.s0 = s0;
    attn_tiles(c, lds, qr, o, m_reg, l_reg, (u == 0) ? 2 : 0, 6, wv);
    LAS float* li_l = (LAS float*)(lds + L_WS) + wid * 64;
    if (hi == 0) { li_l[r32] = l_reg; LSE[tokrow * 8 + h] = l_reg; }
    LDS_WAIT();
#pragma unroll
    for (int r = 0; r < 16; ++r) { const int orow = crow(r, hi); const float rl = (pat == 2) ? 1.0f / li_l[orow] : 1.0f;
        const size_t tr = (size_t)b * SEQ + (size_t)(((s0 + orow) << dshift) + res); bf16_t* op = OA + tr * 1024 + h * HD;
#pragma unroll
        for (int d0 = 0; d0 < 4; ++d0) { const float v = o[d0][r] * rl; const float vn = shx(v, 1, lane);
            if ((r32 & 1) == 0) *(unsigned*)(op + d0 * 32 + r32) = cvtpk(v, vn); } }
}

__device__ __forceinline__ void nsa_finalize(LAS char* lds, const f32x16 (&o)[4], float l_reg, const bf16_t* P, bf16_t* ON, const float* gb, int b, int g, int tok0, int br, const int wv) {
    using namespace att;
    const int tid = opq_tid(wv), lane = tid & 63, wid = __builtin_amdgcn_readfirstlane(tid >> 6), r32 = lane & 31, hi = lane >> 5;
    LAS float* li_l = (LAS float*)(lds + L_WS) + wid * 64;
    if (hi == 0) li_l[r32] = l_reg;
    LDS_WAIT();
    bf16_t* ONb = ON + (size_t)br * NTOK * 1024;
#pragma unroll
    for (int r = 0; r < 16; ++r) { const int j = r & 3, k = r >> 2; const float lr = li_l[crow(r, hi)]; const float rl = lr > 0.f ? 1.0f / lr : 0.f;
        const size_t tok = (size_t)b * SEQ + tok0 + 2 * k + hi; const int hh = 4 * g + j;
        const float gl = bf2f(P[tok * PC + C_GL + hh * 3 + br]) + gb[hh * 3 + br];
        const float sc = rl * __builtin_amdgcn_rcpf(1.0f + __builtin_amdgcn_exp2f(-gl * LOG2E));
        bf16_t* op = ONb + tok * 1024 + hh * HD;
#pragma unroll
        for (int d0 = 0; d0 < 4; ++d0) { const float v = o[d0][r] * sc; const float vn = shx(v, 1, lane);
            if ((r32 & 1) == 0) *(unsigned*)(op + d0 * 32 + r32) = cvtpk(v, vn); } }
}
__device__ __forceinline__ void nsa_unit(LAS char* lds, const bf16_t* P, const bf16_t* KC, const bf16_t* VC, bf16_t* ON, const float* nsaT, const float* gb, const float* qgain, int b, int g, int qi, bool load_tbl, const int wv) {
    using namespace att;
    const int tid = opq_tid(wv), lane = tid & 63, wid = __builtin_amdgcn_readfirstlane(tid >> 6), r32 = lane & 31, hi = lane >> 5;
    LAS float* tbl = (LAS float*)(lds + L_TBL); LAS float* IMP = (LAS float*)(lds + L_IMP); LAS unsigned* SELM = (LAS unsigned*)(lds + L_SELM);
    __syncthreads();
    if (load_tbl) for (int i = tid; i < 4 * TBLS; i += NTHR) tbl[i] = nsaT[(size_t)(4 * g) * TBLS + i];
    const int tok0 = 64 * qi + 8 * wid, tq = tok0 + (r32 >> 2), hd = r32 & 3;
    const bf16_t* Pb = P + (size_t)b * SEQ * PC;
    bf16x8 qr[8];
    load_q_normed(Pb + (size_t)tq * PC + C_QN + (4 * g + hd) * HD + hi * 8, qgain + hi * 8, qr);
    const bf16_t* KCb = KC + (size_t)(b * 2 + g) * 512 * HD; const bf16_t* VCb = VC + (size_t)(b * 2 + g) * 512 * HD;
    const int ntc = (qi >> 4) + 1, cmax = (tq - 31) >> 4;
    f32x16 o[4]; float m_reg, l_reg;
#pragma unroll
    for (int d0 = 0; d0 < 4; ++d0) o[d0] = f32x16{};
    m_reg = 0.f; l_reg = 0.f;
    { CmpCfg c; c.Kb = KCb; c.Vb = VCb; c.cmax = cmax; c.hi4 = 4 * hi; c.cfull = (64 * qi - 31) >> 4; attn_tiles_s(c, lds, qr, o, m_reg, l_reg, 0, ntc, wv); }
    nsa_finalize(lds, o, l_reg, P, ON, gb, b, g, tok0, 0, wv);
    { CmpImpCfg c; c.Kb = KCb; c.cmax = cmax; c.hi4 = 4 * hi; c.mfix = 0.f; c.invl = l_reg > 0.f ? 1.0f / l_reg : 0.f;
#pragma unroll
      for (int d0 = 0; d0 < 4; ++d0) o[d0] = f32x16{};
      float md = 0.f, ld = 0.f; attn_tiles(c, lds, qr, o, md, ld, 0, ntc, wv); }
#pragma unroll
    for (int d0 = 0; d0 < 4; ++d0)
#pragma unroll
        for (int k = 0; k < 4; ++k) IMP[(8 * wid + 2 * k + hi) * 128 + 32 * d0 + r32] = (o[d0][4 * k] + o[d0][4 * k + 1]) + (o[d0][4 * k + 2] + o[d0][4 * k + 3]);
    __syncthreads();
    { const int cur = qi;
#pragma unroll 1
      for (int tl = 8 * wid; tl < 8 * wid + 8; ++tl) {
        const int n0 = lane, n1 = 64 + lane; bool sel0, sel1;
        if (cur <= 15) { sel0 = (n0 <= cur); sel1 = false; }
        else {
            const float v0 = IMP[tl * 128 + n0], v1 = IMP[tl * 128 + n1];
            const unsigned u0 = (n0 >= 1 && n0 <= cur - 2) ? __float_as_uint(v0) + 1u : 0u, u1 = (n1 <= cur - 2) ? __float_as_uint(v1) + 1u : 0u;
            unsigned T = 0u;
#pragma unroll 1
            for (int bit = 30; bit >= 0; --bit) { const unsigned cand = T | (1u << bit);
                const int cnt = __builtin_popcountll(__ballot(u0 >= cand)) + __builtin_popcountll(__ballot(u1 >= cand));
                if (cnt >= 13) T = cand; }
            const bool gt0 = u0 > T, gt1 = u1 > T;
            const int need = 13 - (__builtin_popcountll(__ballot(gt0)) + __builtin_popcountll(__ballot(gt1)));
            const bool eq0 = (u0 == T), eq1 = (u1 == T);
            const unsigned long long m0 = __ballot(eq0), m1 = __ballot(eq1);
            const int pre0 = (int)__builtin_amdgcn_mbcnt_hi((unsigned)(m0 >> 32), __builtin_amdgcn_mbcnt_lo((unsigned)m0, 0u));
            const int pre1 = __builtin_popcountll(m0) + (int)__builtin_amdgcn_mbcnt_hi((unsigned)(m1 >> 32), __builtin_amdgcn_mbcnt_lo((unsigned)m1, 0u));
            sel0 = (n0 == 0 || n0 == cur || n0 == cur - 1) || gt0 || (eq0 && pre0 < need);
            sel1 = (n1 == cur || n1 == cur - 1) || gt1 || (eq1 && pre1 < need);
        }
        const unsigned long long b0 = __ballot(sel0), b1 = __ballot(sel1);
        if (lane == 0) { SELM[tl * 4 + 0] = (unsigned)b0; SELM[tl * 4 + 1] = (unsigned)(b0 >> 32); SELM[tl * 4 + 2] = (unsigned)b1; SELM[tl * 4 + 3] = (unsigned)(b1 >> 32); } } }
    __syncthreads();
    int r32s = r32; asm volatile("" : "+v"(r32s));
    { SlcCfg c; c.Kb = Pb + C_KS + g * HD; c.Vb = Pb + C_VS + g * HD; c.tblh = tbl + (r32s & 3) * TBLS; c.tqm = tok0 + (r32s >> 2) - 4 * hi; c.cur = qi; c.b31 = tbl[(r32s & 3) * TBLS + TBL0 + 1600];
      const int tl = 8 * wid + (r32s >> 2); c.s0 = SELM[tl * 4 + 0]; c.s1 = SELM[tl * 4 + 1]; c.s2 = SELM[tl * 4 + 2]; c.s3 = SELM[tl * 4 + 3];
#pragma unroll
      for (int d0 = 0; d0 < 4; ++d0) o[d0] = f32x16{};
      m_reg = 0.f; l_reg = 0.f;
      attn_tiles_s(c, lds, qr, o, m_reg, l_reg, 0, qi + 1, wv); }
    nsa_finalize(lds, o, l_reg, P, ON, gb, b, g, tok0, 1, wv);
    int r32w = r32; asm volatile("" : "+v"(r32w));
    { WinCfg c; c.Kb = Pb + C_KW + g * HD; c.Vb = Pb + C_VW + g * HD; c.tblh = tbl + (r32w & 3) * TBLS; c.tqm = tok0 + (r32w >> 2) - 4 * hi;
#pragma unroll
      for (int d0 = 0; d0 < 4; ++d0) o[d0] = f32x16{};
      m_reg = 0.f; l_reg = 0.f;
      attn_tiles_s(c, lds, qr, o, m_reg, l_reg, qi >= 8 ? qi - 8 : 0, qi + 1, wv); }
    nsa_finalize(lds, o, l_reg, P, ON, gb, b, g, tok0, 2, wv);
}

constexpr int LDS_BYTES = 147456;
constexpr int LDS_MISC = 131072;
constexpr int LDS_ARGS = LDS_MISC + 64;
__device__ __forceinline__ unsigned long long arg_u64(LAS unsigned char* lds, int i) {
    const LAS unsigned* p = (const LAS unsigned*)(opq_lds(lds) + LDS_ARGS) + 2 * i;
    const unsigned lo = __builtin_amdgcn_readfirstlane(p[0]), hi = __builtin_amdgcn_readfirstlane(p[1]);
    return ((unsigned long long)hi << 32) | lo;
}
#define GAS __attribute__((address_space(1)))
__device__ __forceinline__ const float* arg_in(LAS unsigned char* lds, int i) { return (const float*)(GAS const float*)arg_u64(lds, i); }
__device__ __forceinline__ float* arg_out(LAS unsigned char* lds) { return (float*)(GAS float*)arg_u64(lds, 24); }
__device__ __forceinline__ unsigned char* arg_ws(LAS unsigned char* lds) { return (unsigned char*)(GAS unsigned char*)arg_u64(lds, 25); }
__device__ __forceinline__ int opq_bx() { int b = blockIdx.x; asm volatile("" : "+s"(b)); return b; }
__device__ __forceinline__ int opq_g() { int b = gridDim.x; asm volatile("" : "+s"(b)); return b; }

__device__ __forceinline__ void ph_prologue(LAS unsigned char* lds, const int wv) {
    lds = opq_lds(lds);
    const int tid = opq_tid(wv), lane = tid & 63, wave = __builtin_amdgcn_readfirstlane(tid >> 6), G = opq_g(), bx = opq_bx();
    const int gw = bx * NWAVES + wave, NGW = G * NWAVES;
    unsigned char* ws = arg_ws(lds);
    LAS float* scr = (LAS float*)(lds + wave * 16384);
    constexpr int I_UP = 32 * 176, I_DN = 88 * 64, I_IN = 32 * 177, I_OUT = 32 * 64, I_C1 = 64 * 16, I_Z = 928;
    constexpr int I_FFN = 2 * I_UP + I_DN, I_LAYER = 2 * I_FFN + I_IN + I_OUT + 2 * I_C1 + I_Z;
#pragma unroll 1
    for (int it = gw; it < DEPTH * I_LAYER; it += NGW) {
        const int l = it / I_LAYER; int r = it - l * I_LAYER;
        if (r < 2 * I_FFN) { const int half = r >= I_FFN; r -= half * I_FFN;
            bf16_t* WUP = (bf16_t*)(ws + WS_WUP + (size_t)(l * 2 + half) * SZ_WUP); bf16_t* WDN = (bf16_t*)(ws + WS_WDN + (size_t)(l * 2 + half) * SZ_WDN);
            const float* gn = arg_in(lds, half ? I_F2N : I_F1N) + (size_t)l * DM;
            if (r < I_UP) { transpose_item(arg_in(lds, half ? I_F2W1 : I_F1W1) + (size_t)l * DM * DFF, DM, DFF, WUP, 1, 0, scr, r, lane, gn); continue; } r -= I_UP;
            if (r < I_UP) { transpose_item(arg_in(lds, half ? I_F2W3 : I_F1W3) + (size_t)l * DM * DFF, DM, DFF, WUP, 1, 128, scr, r, lane, gn); continue; } r -= I_UP;
            transpose_item(arg_in(lds, half ? I_F2W2 : I_F1W2) + (size_t)l * DFF * DM, DFF, DM, WDN, 0, 0, scr, r, lane, nullptr); continue; }
        r -= 2 * I_FFN;
        bf16_t* WIN = (bf16_t*)(ws + WS_WIN + (size_t)l * SZ_WIN); bf16_t* WOUT = (bf16_t*)(ws + WS_WOUT + (size_t)l * SZ_WOUT); bf16_t* WC1 = (bf16_t*)(ws + WS_WC1 + (size_t)l * SZ_WC1);
        if (r < I_IN) { transpose_item(arg_in(lds, I_WIN) + (size_t)l * DM * IN_COLS, DM, IN_COLS, WIN, 0, 0, scr, r, lane, arg_in(lds, I_MIXN) + (size_t)l * DM); continue; } r -= I_IN;
        if (r < I_OUT) { transpose_item(arg_in(lds, I_WOUT) + (size_t)l * DM * DM, DM, DM, WOUT, 0, 0, scr, r, lane, nullptr); continue; } r -= I_OUT;
        if (r < I_C1) { transpose_item(arg_in(lds, I_CKW1) + (size_t)l * 4096 * 512, 4096, 512, WC1, 0, 0, scr, r, lane, nullptr); continue; } r -= I_C1;
        if (r < I_C1) { transpose_item(arg_in(lds, I_CVW1) + (size_t)l * 4096 * 512, 4096, 512, WC1, 0, 512, scr, r, lane, nullptr); continue; } r -= I_C1;
        { const int q = r * 64 + lane, kt = q / 1856, rem = q - kt * 1856; u32x4* z = (u32x4*)(WIN + ((size_t)(22 * 32 + kt) * 256 + 24) * 64) + rem; unsigned zr = 0u; asm volatile("" : "+v"(zr)); *z = (u32x4){zr, zr, zr, zr}; }
    }
    const float* xs = arg_in(lds, I_X); bf16_t* XB = (bf16_t*)(ws + WS_HB); float* RSTD = (float*)(ws + WS_RSTD);
    for (int m = gw; m < NTOK; m += NGW) {
        const f32x4* xr = (const f32x4*)(xs + (size_t)m * DM) + lane; f32x4 v[8]; float s = 0.f;
#pragma unroll
        for (int j = 0; j < 8; ++j) { v[j] = xr[64 * j]; s += (v[j].x * v[j].x + v[j].y * v[j].y) + (v[j].z * v[j].z + v[j].w * v[j].w); }
        s = wave_sum(s, lane);
#pragma unroll
        for (int j = 0; j < 8; ++j) { u32x2 w; w.x = cvtpk(v[j].x, v[j].y); w.y = cvtpk(v[j].z, v[j].w); *(u32x2*)(XB + kt_off(m, 256 * j + 4 * lane, DM)) = w; }
        if (lane == 0) RSTD[m] = 1.0f / sqrtf(s * (1.f / DM) + EPS);
    }
}
__device__ __forceinline__ void ph_rstd(LAS unsigned char* lds, const int wv) {
    lds = opq_lds(lds);
    const int tid = opq_tid(wv), G = opq_g(), bx = opq_bx();
    unsigned char* ws = arg_ws(lds); const float* SSQ = (const float*)(ws + WS_SSQ); float* RSTD = (float*)(ws + WS_RSTD);
    for (int m = bx * NTHR + tid; m < NTOK; m += G * NTHR) { const f32x4* p = (const f32x4*)(SSQ + (size_t)m * 32); f32x4 a = p[0];
#pragma unroll
        for (int j = 1; j < 8; ++j) a = a + p[j];
        RSTD[m] = 1.0f / sqrtf(((a.x + a.y) + (a.z + a.w)) * (1.f / DM) + EPS); }
}
__device__ __forceinline__ void ph_headnorm(LAS unsigned char* lds, int l, const int wv) {
    lds = opq_lds(lds);
    const int tid = opq_tid(wv), lane = tid & 63, wave = __builtin_amdgcn_readfirstlane(tid >> 6), G = opq_g(), bx = opq_bx();
    const int gw = bx * NWAVES + wave, NGW = G * NWAVES;
    unsigned char* ws = arg_ws(lds); bf16_t* HP = (bf16_t*)(ws + WS_HP); bf16_t* ACMP = (bf16_t*)(ws + WS_ACMP);
    const float* qna = arg_in(lds, I_QNA) + l * HD; const float* kna = arg_in(lds, I_KNA) + l * HD; const float* qnn = arg_in(lds, I_QNN) + l * HD; const float* knn = arg_in(lds, I_KNN) + l * HD;
    const float* pos = arg_in(lds, I_POS) + (size_t)l * 32 * HD;
    const int e0 = (lane & 15) * 8;
    for (int m = gw; m < NTOK; m += NGW) {
        bf16_t* prow = HP + (size_t)m * PC;
        int cols[3]; u32x4 wl[3];
#pragma unroll
        for (int ch = 0; ch < 3; ++ch) { cols[ch] = (ch < 2) ? C_KA + ch * 512 + lane * 8 : (lane < 32 ? C_KS + lane * 8 : C_KW + (lane - 32) * 8);
            wl[ch] = *(const u32x4*)(prow + cols[ch]); }
        const u32x4 wcv = *(const u32x4*)(prow + C_KC + lane * 8);
#pragma unroll
        for (int ch = 0; ch < 3; ++ch) {
            const float* gp = (ch < 2) ? kna : knn; const float sc = 1.f;
            const u32x4 w = wl[ch];
            float v[8] = {bflo(w.x), bfhi(w.x), bflo(w.y), bfhi(w.y), bflo(w.z), bfhi(w.z), bflo(w.w), bfhi(w.w)};
            float s = 0.f;
#pragma unroll
            for (int i = 0; i < 8; ++i) s += v[i] * v[i];
            s += shx(s, 1, lane); s += shx(s, 2, lane); s += shx(s, 4, lane); s += shx(s, 8, lane);
            const float rs = sc / sqrtf(s * (1.f / HD) + EPS);
            const f32x4 g0 = *(const f32x4*)(gp + e0), g1 = *(const f32x4*)(gp + e0 + 4);
            u32x4 o; o.x = cvtpk(v[0] * rs * g0.x, v[1] * rs * g0.y); o.y = cvtpk(v[2] * rs * g0.z, v[3] * rs * g0.w); o.z = cvtpk(v[4] * rs * g1.x, v[5] * rs * g1.y); o.w = cvtpk(v[6] * rs * g1.z, v[7] * rs * g1.w);
            *(u32x4*)(prow + cols[ch]) = o;
        }
        { const int b = m / SEQ, t = m % SEQ, kv = lane >> 5, gg = (lane >> 4) & 1, c1 = t >> 4, j1 = t & 15;
          const u32x4 w = wcv;
          const float v[8] = {bflo(w.x), bfhi(w.x), bflo(w.y), bfhi(w.y), bflo(w.z), bfhi(w.z), bflo(w.w), bfhi(w.w)};
          const int arow0 = kv * 4096 + (b * 2 + gg) * 512;
          if (c1 <= 510) { const f32x4 p0 = *(const f32x4*)(pos + j1 * HD + e0), p1 = *(const f32x4*)(pos + j1 * HD + e0 + 4);
              u32x4 o; o.x = cvtpk(v[0] + p0.x, v[1] + p0.y); o.y = cvtpk(v[2] + p0.z, v[3] + p0.w); o.z = cvtpk(v[4] + p1.x, v[5] + p1.y); o.w = cvtpk(v[6] + p1.z, v[7] + p1.w);
              *(u32x4*)(ACMP + kt_off(arow0 + c1, j1 * HD + e0, 4096)) = o; }
          else { const u32x4 z = {0u, 0u, 0u, 0u}; *(u32x4*)(ACMP + kt_off(arow0 + 511, j1 * HD + e0, 4096)) = z; *(u32x4*)(ACMP + kt_off(arow0 + 511, (j1 + 16) * HD + e0, 4096)) = z; }
          if (c1 >= 1) { const int j2 = j1 + 16; const f32x4 p0 = *(const f32x4*)(pos + j2 * HD + e0), p1 = *(const f32x4*)(pos + j2 * HD + e0 + 4);
              u32x4 o; o.x = cvtpk(v[0] + p0.x, v[1] + p0.y); o.y = cvtpk(v[2] + p0.z, v[3] + p0.w); o.z = cvtpk(v[4] + p1.x, v[5] + p1.y); o.w = cvtpk(v[6] + p1.z, v[7] + p1.w);
              *(u32x4*)(ACMP + kt_off(arow0 + c1 - 1, j2 * HD + e0, 4096)) = o; } }
    }
}
__device__ __forceinline__ float gelu_tanh(float v) { const float u3 = 0.7978845608028654f * (v + 0.044715f * v * v * v); return 0.5f * v * (2.0f - 2.0f / (__expf(2.0f * u3) + 1.0f)); }
__device__ __forceinline__ void ph_cmp2(LAS unsigned char* lds, int l, const int wv) {
    lds = opq_lds(lds);
    const int tid = opq_tid(wv), lane = tid & 63, wave = __builtin_amdgcn_readfirstlane(tid >> 6), G = opq_g(), bx = opq_bx();
    unsigned char* ws = arg_ws(lds); const float* CP = (const float*)(ws + WS_CP);
    LAS float* CH = (LAS float*)lds;
    LAS float* RED = (LAS float*)(lds + 65536);
    const float* knn = arg_in(lds, I_KNN) + l * HD;
    for (int it = bx; it < 256; it += G) {
        const int R0 = it * 32, kv = R0 >> 12, rl0 = R0 & 4095;
        __syncthreads();
        for (int i4 = tid; i4 < 32 * 128; i4 += NTHR) { const int rr = i4 >> 7, k4 = (i4 & 127) * 4; f32x4 v = {0.f, 0.f, 0.f, 0.f};
#pragma unroll
            for (int ks = 0; ks < 4; ++ks) v = v + *(const f32x4*)(CP + ((size_t)(kv * 4 + ks) * 4096 + rl0 + rr) * 512 + k4);
            f32x4 o; o.x = gelu_tanh(v.x); o.y = gelu_tanh(v.y); o.z = gelu_tanh(v.z); o.w = gelu_tanh(v.w);
            *(LAS f32x4*)(CH + rr * 512 + k4) = o; }
        __syncthreads();
        const int n = tid & 127, rq = tid >> 7;
        const float* w2 = arg_in(lds, kv ? I_CVW2 : I_CKW2) + (size_t)l * 512 * HD + n;
        float acc[8];
#pragma unroll
        for (int i = 0; i < 8; ++i) acc[i] = 0.f;
#pragma unroll 4
        for (int k = 0; k < 512; k += 4) { const float w0 = w2[(size_t)k * HD], w1 = w2[(size_t)(k + 1) * HD], w2v = w2[(size_t)(k + 2) * HD], w3 = w2[(size_t)(k + 3) * HD];
#pragma unroll
            for (int i = 0; i < 8; ++i) { const f32x4 c = *(const LAS f32x4*)(CH + (rq * 8 + i) * 512 + k); acc[i] += (c.x * w0 + c.y * w1) + (c.z * w2v + c.w * w3); } }
        if (kv == 0) {
            float ss[8];
#pragma unroll
            for (int i = 0; i < 8; ++i) ss[i] = wave_sum(acc[i] * acc[i], lane);
            if (lane == 0) {
#pragma unroll
                for (int i = 0; i < 8; ++i) RED[wave * 8 + i] = ss[i]; }
            __syncthreads();
            const float gn = knn[n];
#pragma unroll
            for (int i = 0; i < 8; ++i) { const float tot = RED[(2 * rq) * 8 + i] + RED[(2 * rq + 1) * 8 + i]; acc[i] = acc[i] / sqrtf(tot * (1.f / HD) + EPS) * gn; }
        }
        bf16_t* dst = (bf16_t*)(ws + (kv ? WS_VC + 0 : WS_KC + 0)) + (size_t)(rl0 + rq * 8) * HD + n;
#pragma unroll
        for (int i = 0; i < 8; ++i) dst[(size_t)i * HD] = (bf16_t)f2bf(acc[i]);
    }
}
__device__ __forceinline__ void ph_outnorm(LAS unsigned char* lds, int l, const int wv) {
    lds = opq_lds(lds);
    const int tid = opq_tid(wv), lane = tid & 63, wave = __builtin_amdgcn_readfirstlane(tid >> 6), G = opq_g(), bx = opq_bx();
    const int gw = bx * NWAVES + wave, NGW = G * NWAVES;
    unsigned char* ws = arg_ws(lds); const bf16_t* OA = (const bf16_t*)(ws + WS_OA); const bf16_t* ON = (const bf16_t*)(ws + WS_ON); bf16_t* HB = (bf16_t*)(ws + WS_HP);
    const float* gn = arg_in(lds, I_ON) + (size_t)l * DM;
    for (int m = gw; m < NTOK; m += NGW) {
        const bf16_t* oa = OA + (size_t)m * 1024; bf16_t* y = HB;
        const u32x4 wa = *(const u32x4*)(oa + lane * 8), wb = *(const u32x4*)(oa + 512 + lane * 8);
        u32x4 wn[6];
#pragma unroll
        for (int br = 0; br < 3; ++br) { const bf16_t* onb = ON + ((size_t)br * NTOK + m) * 1024; wn[2 * br] = *(const u32x4*)(onb + lane * 8); wn[2 * br + 1] = *(const u32x4*)(onb + 512 + lane * 8); }
        float va[16] = {bflo(wa.x), bfhi(wa.x), bflo(wa.y), bfhi(wa.y), bflo(wa.z), bfhi(wa.z), bflo(wa.w), bfhi(wa.w), bflo(wb.x), bfhi(wb.x), bflo(wb.y), bfhi(wb.y), bflo(wb.z), bfhi(wb.z), bflo(wb.w), bfhi(wb.w)};
        float sa = 0.f;
#pragma unroll
        for (int i = 0; i < 16; ++i) sa += va[i] * va[i];
        float vs[16]; float sn = 0.f;
#pragma unroll
        for (int i = 0; i < 16; ++i) vs[i] = 0.f;
#pragma unroll
        for (int br = 0; br < 3; ++br) { const u32x4 wc = wn[2 * br], wd = wn[2 * br + 1];
            vs[0] += bflo(wc.x); vs[1] += bfhi(wc.x); vs[2] += bflo(wc.y); vs[3] += bfhi(wc.y); vs[4] += bflo(wc.z); vs[5] += bfhi(wc.z); vs[6] += bflo(wc.w); vs[7] += bfhi(wc.w);
            vs[8] += bflo(wd.x); vs[9] += bfhi(wd.x); vs[10] += bflo(wd.y); vs[11] += bfhi(wd.y); vs[12] += bflo(wd.z); vs[13] += bfhi(wd.z); vs[14] += bflo(wd.w); vs[15] += bfhi(wd.w); }
        const float ra = 1.0f / sqrtf(wave_sum(sa, lane) * (1.f / 1024.f) + EPS);
        { const f32x4 g0 = *(const f32x4*)(gn + lane * 8), g1 = *(const f32x4*)(gn + lane * 8 + 4), g2 = *(const f32x4*)(gn + 512 + lane * 8), g3 = *(const f32x4*)(gn + 512 + lane * 8 + 4);
          u32x4 o; o.x = cvtpk(va[0] * ra * g0.x, va[1] * ra * g0.y); o.y = cvtpk(va[2] * ra * g0.z, va[3] * ra * g0.w); o.z = cvtpk(va[4] * ra * g1.x, va[5] * ra * g1.y); o.w = cvtpk(va[6] * ra * g1.z, va[7] * ra * g1.w);
          *(u32x4*)(y + kt_off(m, lane * 8, DM)) = o;
          o.x = cvtpk(va[8] * ra * g2.x, va[9] * ra * g2.y); o.y = cvtpk(va[10] * ra * g2.z, va[11] * ra * g2.w); o.z = cvtpk(va[12] * ra * g3.x, va[13] * ra * g3.y); o.w = cvtpk(va[14] * ra * g3.z, va[15] * ra * g3.w);
          *(u32x4*)(y + kt_off(m, 512 + lane * 8, DM)) = o; }
#pragma unroll
        for (int i = 0; i < 16; ++i) sn += vs[i] * vs[i];
        const float rn = 1.0f / sqrtf(wave_sum(sn, lane) * (1.f / 1024.f) + EPS);
        { const float* g2 = gn + 1024; const f32x4 g0 = *(const f32x4*)(g2 + lane * 8), g1 = *(const f32x4*)(g2 + lane * 8 + 4), g2a = *(const f32x4*)(g2 + 512 + lane * 8), g3 = *(const f32x4*)(g2 + 512 + lane * 8 + 4);
          u32x4 o; o.x = cvtpk(vs[0] * rn * g0.x, vs[1] * rn * g0.y); o.y = cvtpk(vs[2] * rn * g0.z, vs[3] * rn * g0.w); o.z = cvtpk(vs[4] * rn * g1.x, vs[5] * rn * g1.y); o.w = cvtpk(vs[6] * rn * g1.z, vs[7] * rn * g1.w);
          *(u32x4*)(y + kt_off(m, 1024 + lane * 8, DM)) = o;
          o.x = cvtpk(vs[8] * rn * g2a.x, vs[9] * rn * g2a.y); o.y = cvtpk(vs[10] * rn * g2a.z, vs[11] * rn * g2a.w); o.z = cvtpk(vs[12] * rn * g3.x, vs[13] * rn * g3.y); o.w = cvtpk(vs[14] * rn * g3.z, vs[15] * rn * g3.w);
          *(u32x4*)(y + kt_off(m, 1536 + lane * 8, DM)) = o; }
    }
}

#define GRID_BAR() do { XcdBarrier bar_; bar_.bar = (unsigned*)(arg_ws(lds) + WS_CTL) + CW_BAR; bar_.x = xb_xcc_id(); bar_.st = (volatile LAS unsigned*)(opq_lds(lds) + LDS_MISC + 32); xcd_barrier(bar_, wv); } while (0)
__global__ void __launch_bounds__(NTHR, 2) mega_fwd(Args a) {
    extern __shared__ __attribute__((aligned(16))) unsigned char lds_raw[];
    LAS unsigned char* lds = (LAS unsigned char*)lds_raw;
    const int wv = __builtin_amdgcn_readfirstlane((int)threadIdx.x >> 6);
    {
        const int tid = threadIdx.x;
        for (int u = tid; u < (LDS_BYTES - LDS_MISC) / 4; u += NTHR) ((LAS unsigned*)(lds + LDS_MISC))[u] = 0u;
        __syncthreads();
        if (tid == 0) { LAS unsigned long long* t = (LAS unsigned long long*)(lds + LDS_ARGS);
#pragma unroll
            for (int i = 0; i < 24; ++i) t[i] = (unsigned long long)(uintptr_t)a.in[i];
            t[24] = (unsigned long long)(uintptr_t)a.out; t[25] = (unsigned long long)(uintptr_t)a.ws; }
        __syncthreads();
    }
    (void)xcd_barrier_post((unsigned*)(arg_ws(lds) + WS_CTL) + CW_BAR, (volatile LAS unsigned*)(lds + LDS_MISC + 32));

    { const int tid = opq_tid(wv), G = opq_g(), bx = opq_bx(); const float* rb = arg_in(lds, I_RB); unsigned char* ws = arg_ws(lds);
      float* dilT = (float*)(ws + WS_TBL); float* nsaT = (float*)(ws + WS_TBL + 65536);
      for (int i = bx * NTHR + tid; i < 3 * 8 * DTS + 8 * TBLS; i += G * NTHR) {
          if (i < 3 * 8 * DTS) { const int p = i / (8 * DTS), h = (i / DTS) % 8, df = i % DTS - DT0; const int d = (p == 0) ? 1 : (p == 1 ? 4 : 16);
              dilT[i] = (df >= 0 && df <= 128) ? rb[rel_bucket_dev(df * d) * 16 + h] : 0.f; }
          else { const int j = i - 3 * 8 * DTS, hh = j / TBLS, ds = j % TBLS - TBL0; nsaT[j] = (ds >= 0) ? rb[rel_bucket_dev(ds) * 16 + 8 + hh] : 0.f; } } }

    ph_prologue(lds, wv);
    GRID_BAR();
#pragma unroll 1
    for (int step = 0; step < 2 * DEPTH; ++step) {
        const int l = step >> 1, half = step & 1;
        { unsigned char* ws = arg_ws(lds); const int G = opq_g(), bx = opq_bx();
          pg8::Gemm g{64, 64, DM}; pg8::SchedStd S; S.init(ws + WS_HB, ws + WS_WUP + (size_t)step * SZ_WUP, NTOK, 2 * DFF, DM, DM, G, bx); const pg8::EpiSwiGLU E{(bf16_t*)(ws + WS_HP), DFF, (const float*)(ws + WS_RSTD)};
          pg8::gemm_phase<pg8::EpiSwiGLU, pg8::SchedStd, 32768, 32768>(opq_lds(lds), g, S, E, wv);
        }
        GRID_BAR();
        { unsigned char* ws = arg_ws(lds); const int G = opq_g(), bx = opq_bx(); float* X = arg_out(lds);
          pg8::Gemm g{64, 64, DFF}; pg8::SchedStd S; S.init(ws + WS_HP, ws + WS_WDN + (size_t)step * SZ_WDN, NTOK, DM, DFF, DFF, G, bx, 4);
          pg8::EpiResid E{(step == 2 * DEPTH - 1) ? X : (float*)nullptr, (bf16_t*)(ws + WS_HB), (float*)(ws + WS_SSQ), DM, 0.5f};
          pg8::gemm_phase<pg8::EpiResid, pg8::SchedStd, 32768, 32768>(opq_lds(lds), g, S, E, wv);
        }
        GRID_BAR();
        ph_rstd(lds, wv);
        GRID_BAR();
        if (half == 0) {
            { unsigned char* ws = arg_ws(lds); const int G = opq_g(), bx = opq_bx();
              pg8::Gemm g{64, 64, DM}; pg8::SchedStd S; S.init(ws + WS_HB, ws + WS_WIN + (size_t)l * SZ_WIN, NTOK, PC, DM, DM, G, bx); const pg8::EpiBf16 E{(bf16_t*)(ws + WS_HP), PC, (const float*)(ws + WS_RSTD)};
              pg8::gemm_phase<pg8::EpiBf16, pg8::SchedStd, 32768, 32768>(opq_lds(lds), g, S, E, wv);
            }
            GRID_BAR();
            ph_headnorm(lds, l, wv);
            GRID_BAR();
#pragma unroll 1
            for (int pat3 = 0; pat3 < 3; ++pat3) { const int pat = pat3 % 3;
                if (pat3 == 0) { unsigned char* ws = arg_ws(lds); const int G = opq_g(), bx = opq_bx();
                  pg8::Gemm g{64, 64, 1024}; pg8::SchedCmp S; S.A = (const char*)(ws + WS_ACMP); S.Bt = (const char*)(ws + WS_WC1 + (size_t)l * SZ_WC1); S.G = G; S.c = bx; pg8::EpiF32Z E{(float*)(ws + WS_CP), 512, (size_t)4096 * 512};
                  pg8::gemm_phase<pg8::EpiF32Z, pg8::SchedCmp, 32768, 32768>(opq_lds(lds), g, S, E, wv); }
                if (pat3 == 1) ph_cmp2(lds, l, wv);
                { unsigned char* ws = arg_ws(lds); const int G = opq_g(), bx = opq_bx();
                  for (int u0 = bx; u0 < 1024; u0 += G) { const int w_ = u0 & 255, k_ = u0 >> 8; const int unit = (((w_ & 7) + 8 * k_) << 5) | (w_ >> 3);
                    dil_unit((LAS char*)opq_lds(lds), (const bf16_t*)(ws + WS_HP), (bf16_t*)(ws + WS_OA), (float*)(ws + WS_LSE), (const float*)(ws + WS_TBL), arg_in(lds, I_QNA) + l * HD, pat, 2 * pat, unit, wv); } }
                if (pat3 + 1 < 3) GRID_BAR();
            }
            { unsigned char* ws = arg_ws(lds); const int G = opq_g(), bx = opq_bx();
              const float* gb = arg_in(lds, I_GB) + l * 24; const float* qgn = arg_in(lds, I_QNN) + l * HD;
              int last_bg = -1;
#pragma unroll 1
              for (int i4 = 0; i4 < 4; ++i4)
#pragma unroll 1
                  for (int w = bx; w < 256; w += G) { const int i = i4 & 3; const int bg = w & 7, j = w >> 3;
                      const int qi = (i == 0) ? 127 - j : (i == 1 ? j : (i == 2 ? 64 + j : 63 - j));
                      nsa_unit((LAS char*)opq_lds(lds), (const bf16_t*)(ws + WS_HP), (const bf16_t*)(ws + WS_KC), (const bf16_t*)(ws + WS_VC), (bf16_t*)(ws + WS_ON), (const float*)(ws + WS_TBL + 65536), gb, qgn, bg >> 1, bg & 1, qi, bg != last_bg, wv); last_bg = bg; } }
            GRID_BAR();
            ph_outnorm(lds, l, wv);
            GRID_BAR();
            { unsigned char* ws = arg_ws(lds); const int G = opq_g(), bx = opq_bx(); float* X = arg_out(lds);
              pg8::Gemm g{64, 64, DM}; pg8::SchedStd S; S.init(ws + WS_HP, ws + WS_WOUT + (size_t)l * SZ_WOUT, NTOK, DM, DM, DM, G, bx, 4); pg8::EpiResid E{(float*)nullptr, (bf16_t*)(ws + WS_HB), (float*)(ws + WS_SSQ), DM, 1.0f};
              pg8::gemm_phase<pg8::EpiResid, pg8::SchedStd, 32768, 32768>(opq_lds(lds), g, S, E, wv);
            }
            GRID_BAR();
            ph_rstd(lds, wv);
            GRID_BAR();
        }
    }
}

extern "C" void kernel_launch(void* const* d_in, const int* in_sizes, int n_in, void* d_out, int out_size, void* d_ws, size_t ws_size, hipStream_t stream) {
    static int grid = 0;
    if (grid == 0) {
        if (n_in != 24 || in_sizes[0] != NTOK * DM || out_size != NTOK * DM || ws_size < WS_END) { fprintf(stderr, "kernel_launch: shape mismatch n_in %d in0 %d out %d ws %zu (need %zu)\n", n_in, n_in > 0 ? in_sizes[0] : -1, out_size, ws_size, (size_t)WS_END); grid = -1; return; }
        int dev = 0, cus = 0, per_cu = 0;
        if (hipGetDevice(&dev) != hipSuccess || hipDeviceGetAttribute(&cus, hipDeviceAttributeMultiprocessorCount, dev) != hipSuccess) { grid = -1; return; }
        if (hipFuncSetAttribute((const void*)mega_fwd, hipFuncAttributeMaxDynamicSharedMemorySize, LDS_BYTES) != hipSuccess) { fprintf(stderr, "kernel_launch: hipFuncSetAttribute failed\n"); grid = -1; return; }
        if (hipOccupancyMaxActiveBlocksPerMultiprocessor(&per_cu, (const void*)mega_fwd, NTHR, LDS_BYTES) != hipSuccess || per_cu < 1) { fprintf(stderr, "kernel_launch: occupancy query says %d\n", per_cu); (void)hipGetLastError(); if (per_cu < 1) { grid = -1; return; } }
        grid = cus;
    }
    if (grid < 0) return;
    if (hipMemsetAsync((char*)d_ws + WS_CTL, 0, CTL_ZERO_BYTES, stream) != hipSuccess) return;
    Args a{};
    for (int i = 0; i < 24; ++i) a.in[i] = (const float*)d_in[i];
    a.out = (float*)d_out; a.ws = (unsigned char*)d_ws;
    hipLaunchKernelGGL(mega_fwd, dim3(grid), dim3(NTHR), LDS_BYTES, stream, a);
    const hipError_t le = hipPeekAtLastError();
    if (le != hipSuccess) fprintf(stderr, "kernel_launch: launch failed: %s\n", hipGetErrorName(le));
}
```

```cpp
#include <hip/hip_runtime.h>
#include <cstdio>
#include <cstdint>

#define LAS __attribute__((address_space(3)))
typedef unsigned short bf16_t;
typedef short bf16x8 __attribute__((ext_vector_type(8)));
typedef short s16x4 __attribute__((ext_vector_type(4)));
typedef float f32x2 __attribute__((ext_vector_type(2)));
typedef float f32x4 __attribute__((ext_vector_type(4)));
typedef float f32x16 __attribute__((ext_vector_type(16)));
typedef unsigned u32x2 __attribute__((ext_vector_type(2)));
typedef unsigned u32x4 __attribute__((ext_vector_type(4)));

constexpr int BATCH = 4, SEQ = 8192, DM = 2048, DFF = 5632, NTOK = BATCH * SEQ, DEPTH = 4, HD = 128;
constexpr int IN_COLS = 5656, PC = 5888;
constexpr int C_QA = 0, C_KA = 1024, C_VA = 2048, C_QN = 3072, C_KC = 4096, C_VC = 4352, C_KS = 4608, C_VS = 4864, C_KW = 5120, C_VW = 5376, C_GL = 5632;
constexpr float EPS = 1e-6f, QSCALE = 0.08838834764831845f, LOG2E = 1.4426950408889634f;
constexpr int TBLS = 1704, TBL0 = 64;
constexpr int DTS = 320, DT0 = 96;
constexpr int NWAVES = 8, NTHR = 512;

constexpr size_t MiB = 1u << 20;
constexpr size_t WS_CTL = 0, CTL_ZERO_BYTES = 1 * MiB;
constexpr size_t WS_TBL = 1 * MiB;
constexpr size_t SZ_WUP = 44 * MiB, SZ_WDN = 22 * MiB, SZ_WIN = 23 * MiB, SZ_WOUT = 8 * MiB, SZ_WC1 = 8 * MiB;
constexpr size_t WS_WUP = 2 * MiB;
constexpr size_t WS_WDN = WS_WUP + 8 * SZ_WUP;
constexpr size_t WS_WIN = WS_WDN + 8 * SZ_WDN;
constexpr size_t WS_WOUT = WS_WIN + 4 * SZ_WIN;
constexpr size_t WS_WC1 = WS_WOUT + 4 * SZ_WOUT;
constexpr size_t WS_HB = WS_WC1 + 4 * SZ_WC1;
constexpr size_t WS_HP = WS_HB + 128 * MiB;
constexpr size_t WS_OA = WS_HP + 368 * MiB;
constexpr size_t WS_LSE = WS_OA + 64 * MiB;
constexpr size_t WS_ON = WS_LSE + 1 * MiB;
constexpr size_t WS_ACMP = WS_ON + 192 * MiB;
constexpr size_t WS_CP = WS_ACMP + 64 * MiB;
constexpr size_t WS_KC = WS_CP + 64 * MiB;
constexpr size_t WS_VC = WS_KC + 1 * MiB;
constexpr size_t WS_SSQ = WS_VC + 1 * MiB;
constexpr size_t WS_RSTD = WS_SSQ + 4 * MiB;
constexpr size_t WS_END = WS_RSTD + 1 * MiB;
constexpr int CW_BAR = 4096;

__device__ __forceinline__ unsigned f2bf(float f) { unsigned u = __builtin_bit_cast(unsigned, f); return (u + 0x7fffu + ((u >> 16) & 1u)) >> 16; }
__device__ __forceinline__ unsigned pk2(float lo, float hi) { return f2bf(lo) | (f2bf(hi) << 16); }
__device__ __forceinline__ float bf2f(bf16_t b) { return __builtin_bit_cast(float, ((unsigned)b) << 16); }
__device__ __forceinline__ float bflo(unsigned w) { return __builtin_bit_cast(float, w << 16); }
__device__ __forceinline__ float bfhi(unsigned w) { return __builtin_bit_cast(float, w & 0xffff0000u); }
__device__ __forceinline__ unsigned cvtpk(float lo, float hi) { unsigned r; asm volatile("v_cvt_pk_bf16_f32 %0, %1, %2" : "=v"(r) : "v"(lo), "v"(hi)); return r; }
__device__ __forceinline__ float shx(float v, int m, int lane) { return __builtin_bit_cast(float, __builtin_amdgcn_ds_bpermute((lane ^ m) << 2, __builtin_bit_cast(int, v))); }
__device__ __forceinline__ float wave_sum(float v, int lane) {
#pragma unroll
    for (int o = 1; o < 64; o <<= 1) v += shx(v, o, lane);
    return v;
}
__device__ __forceinline__ LAS unsigned char* opq_lds(LAS unsigned char* p) { unsigned a = (unsigned)(uintptr_t)p; asm volatile("" : "+s"(a)); return (LAS unsigned char*)(uintptr_t)a; }
__device__ __forceinline__ int opq_tid(int wv) { int l; asm volatile("v_mbcnt_lo_u32_b32 %0, -1, 0\n\tv_mbcnt_hi_u32_b32 %0, -1, %0" : "=v"(l)); return wv * 64 + l; }
__device__ __forceinline__ size_t kt_off(int r, int k, int K) { return (((size_t)(r >> 8) * (K >> 6) + (k >> 6)) * 256 + (r & 255)) * 64 + (k & 63); }
#define LDS_WAIT() asm volatile("s_waitcnt lgkmcnt(0)" ::: "memory")
#define VM_WAIT() asm volatile("s_waitcnt vmcnt(0)" ::: "memory")
#define SBAR() __builtin_amdgcn_sched_barrier(0)

#define XB_TMO      128
#define XB_XCNT(j)  (256  + 64 * (j))
#define XB_XSUB(j)  (1280 + 64 * (j))
#define XB_XGEN(j)  (2304 + 64 * (j))
#define XB_TOP      3328
#define XB_TOPGEN   3392
#define XCD_BAR_WORDS 3456
#define XB_SPIN_CAP (1u << 18)
__device__ __forceinline__ unsigned xb_ld(unsigned* p)              { return __hip_atomic_load(p, __ATOMIC_RELAXED, __HIP_MEMORY_SCOPE_AGENT); }
__device__ __forceinline__ unsigned xb_add(unsigned* p, unsigned v) { return __hip_atomic_fetch_add(p, v, __ATOMIC_RELAXED, __HIP_MEMORY_SCOPE_AGENT); }
__device__ __forceinline__ unsigned xb_xcc_id() { return (unsigned)__builtin_amdgcn_s_getreg((3 << 11) | 20) & 0xFu; }
#define XB_SPIN(cond, bar) do { unsigned _sp = 0; while (cond) { __builtin_amdgcn_s_sleep(1); \
    if ((++_sp & 255u) == 0u) { if (xb_ld(&(bar)[XB_TMO])) break; if (_sp > XB_SPIN_CAP) { atomicAdd(&(bar)[XB_TMO], 1u); break; } } } } while (0)
struct XcdBarrier { unsigned* bar; unsigned x; volatile LAS unsigned* st; };
__device__ __forceinline__ XcdBarrier xcd_barrier_post(unsigned* bar, volatile LAS unsigned* st) {
    XcdBarrier b; b.bar = bar; b.x = xb_xcc_id(); b.st = st;
    if (threadIdx.x == 0) (void)xb_add(&bar[XB_XCNT(b.x)], 1u);
    return b;
}
__device__ __forceinline__ void xcd_barrier_complete(unsigned* bar, unsigned x, unsigned& nloc, unsigned& nx) {
    const unsigned G = gridDim.x * gridDim.y * gridDim.z;
    unsigned sum, cnt, mine, sp = 0u;
    for (;;) {
        sum = 0u; cnt = 0u; mine = 0u;
#pragma unroll
        for (unsigned j = 0; j < 16; ++j) { const unsigned c = xb_ld(&bar[XB_XCNT(j)]); sum += c; cnt += (c > 0u) ? 1u : 0u; mine = (j == x) ? c : mine; }
        if (sum == G) break;
        __builtin_amdgcn_s_sleep(1);
        if ((++sp & 255u) == 0u) { if (xb_ld(&bar[XB_TMO])) break; if (sp > XB_SPIN_CAP) { atomicAdd(&bar[XB_TMO], 1u); break; } }
    }
    nloc = mine > 0u ? mine : 1u; nx = cnt > 0u ? cnt : 1u;
}
__device__ __forceinline__ void xcd_barrier(const XcdBarrier& b, const int wv) {
    asm volatile("s_waitcnt vmcnt(0)" ::: "memory");
    __syncthreads();
    if (opq_tid(wv) == 0) {
        unsigned* bar = b.bar; asm volatile("" : "+s"(bar));
        __builtin_amdgcn_s_waitcnt(0);
        unsigned nloc = b.st[0], nx = b.st[1];
        if (nloc == 0u) { xcd_barrier_complete(bar, b.x, nloc, nx); b.st[0] = nloc; b.st[1] = nx; }
        const unsigned old = xb_add(&bar[XB_XSUB(b.x)], 1u);
        const unsigned gen = old / nloc;
        if (old + 1u == (gen + 1u) * nloc) {
            __builtin_amdgcn_fence(__ATOMIC_RELEASE, "agent");
            asm volatile("s_waitcnt vmcnt(0)" ::: "memory");
            const unsigned og = xb_add(&bar[XB_TOP], 1u);
            const unsigned tg = og / nx;
            if (og + 1u == (tg + 1u) * nx) xb_add(&bar[XB_TOPGEN], 1u);
            else XB_SPIN(xb_ld(&bar[XB_TOPGEN]) == tg, bar);
            __builtin_amdgcn_fence(__ATOMIC_ACQUIRE, "agent");
            xb_add(&bar[XB_XGEN(b.x)], 1u);
            asm volatile("s_waitcnt vmcnt(0)" ::: "memory");
        } else {
            XB_SPIN(xb_ld(&bar[XB_XGEN(b.x)]) == gen, bar);
            __builtin_amdgcn_fence(__ATOMIC_ACQUIRE, "agent");
            asm volatile("s_waitcnt vmcnt(0)" ::: "memory");
        }
    }
    __syncthreads();
}

namespace pg8 {
constexpr int BM = 256, BK = 64, HALF = 128, HTB = HALF * BK * 2, STAGE_BYTES = 8 * HTB, NXCD = 8, WGM = 8;
__host__ __device__ __forceinline__ int lds_byte(int r, int c) { const int st = (r >> 4) * 2 + (c >> 5), rr = r & 15, cc = c & 31, ob = rr * 64 + cc * 2; return st * 1024 + (ob ^ (((ob >> 9) & 1) << 5)); }
__host__ __device__ __forceinline__ void stage_rc(int b, int& R, int& C) { const int st = b / 1024, sb = b % 1024, swz = sb ^ (((sb >> 9) & 1) << 5); R = (st >> 1) * 16 + swz / 64; C = (st & 1) * 32 + (swz % 64) / 2; }
__host__ __device__ __forceinline__ int perm32(int rho) { const int n = rho >> 4, i = rho & 15; return 8 * (i >> 2) + 4 * n + (i & 3); }
struct Unit { int pm, pn, z; };
struct Gemm { int lda, ldb, K; };
struct SchedStd {
    const char* A; const char* Bt; size_t atile, btile; int nM, nN, nwg, G, c, wgm;
    __device__ __forceinline__ void init(const void* A_, const void* Bt_, int M, int N, int lda, int ldb, int G_, int c_, int wgm_ = WGM) { wgm = wgm_;
        A = (const char*)A_; Bt = (const char*)Bt_; atile = (size_t)BM * lda * 2; btile = (size_t)BM * ldb * 2; nM = M / BM; nN = N / BM; nwg = nM * nN; G = G_; c = c_; }
    __device__ __forceinline__ bool next(int i, Unit& u) const {
        const long L = (long)i * G + c; if (L >= nwg) return false;
        int wgid = (int)L; { const int q = nwg / NXCD, r = nwg % NXCD, xcd = wgid % NXCD, off = wgid / NXCD; wgid = (xcd < r ? xcd * (q + 1) : r * (q + 1) + (xcd - r) * q) + off; }
        const int nig = wgm * nN, gid = wgid / nig, fm = gid * wgm, gsz = (nM - fm) < wgm ? (nM - fm) : wgm;
        u.pm = fm + ((wgid % nig) % gsz); u.pn = (wgid % nig) / gsz; u.z = 0; return true;
    }
    __device__ __forceinline__ const char* a_ptr(const Unit& u) const { return A + (size_t)u.pm * atile; }
    __device__ __forceinline__ const char* b_ptr(const Unit& u) const { return Bt + (size_t)u.pn * btile; }
};
struct SchedCmp {
    const char* A; const char* Bt; int G, c;
    __device__ __forceinline__ bool next(int i, Unit& u) const { const int L = i * G + c; if (L >= 256) return false; u.z = L >> 5; u.pm = (L & 31) >> 1; u.pn = L & 1; return true; }
    __device__ __forceinline__ const char* a_ptr(const Unit& u) const { const int kv = u.z >> 2, ks = u.z & 3; return A + ((size_t)(kv * 16 + u.pm) * 64 + (size_t)ks * 16) * 32768; }
    __device__ __forceinline__ const char* b_ptr(const Unit& u) const { const int kv = u.z >> 2, ks = u.z & 3; return Bt + ((size_t)(kv * 2 + u.pn) * 64 + (size_t)ks * 16) * 32768; }
};
struct EpiBf16 {
    static constexpr bool PERM = true;
    bf16_t* O; int ldc; const float* rstd;
    __device__ __forceinline__ void prefetch(float (&pre)[8], const Unit& u, int wr, int fr) const {
#pragma unroll
        for (int i = 0; i < 8; ++i) pre[i] = rstd[u.pm * BM + wr * 64 + fr + (i >> 2) * HALF + (i & 3) * 16]; }
    __device__ __forceinline__ void operator()(const f32x4 (&acc)[2][2][4][2], const Unit& u, int wr, int wc, int fr, int fq, const float (&pre)[8]) const {
        const int row0 = u.pm * BM + wr * 64 + fr, col0 = u.pn * BM + wc * 32 + 8 * fq;
#pragma unroll
        for (int ai = 0; ai < 2; ++ai)
#pragma unroll
            for (int m = 0; m < 4; ++m) { bf16_t* rowp = O + (size_t)(row0 + ai * HALF + m * 16) * ldc + col0; const float rs = pre[ai * 4 + m];
#pragma unroll
                for (int bj = 0; bj < 2; ++bj) { const f32x4 v0 = acc[ai][bj][m][0] * rs, v1 = acc[ai][bj][m][1] * rs;
                    u32x4 w; w.x = cvtpk(v0[0], v0[1]); w.y = cvtpk(v0[2], v0[3]); w.z = cvtpk(v1[0], v1[1]); w.w = cvtpk(v1[2], v1[3]);
                    *(u32x4*)(rowp + bj * HALF) = w; } }
    }
};
struct EpiSwiGLU {
    static constexpr bool PERM = true;
    bf16_t* O; int ldc; const float* rstd;
    __device__ __forceinline__ void prefetch(float (&pre)[8], const Unit& u, int wr, int fr) const {
#pragma unroll
        for (int i = 0; i < 8; ++i) pre[i] = rstd[u.pm * BM + wr * 64 + fr + (i >> 2) * HALF + (i & 3) * 16]; }
    __device__ __forceinline__ void operator()(const f32x4 (&acc)[2][2][4][2], const Unit& u, int wr, int wc, int fr, int fq, const float (&pre)[8]) const {
        const int rowp0 = wr * 64 + fr, kt = 2 * u.pn + (wc >> 1), cit = (wc & 1) * 32 + 8 * fq;
        bf16_t* tile = O + ((size_t)u.pm * (ldc / 64) + kt) * (256 * 64) + cit;
#pragma unroll
        for (int ai = 0; ai < 2; ++ai)
#pragma unroll
            for (int m = 0; m < 4; ++m) { bf16_t* rowp = tile + (size_t)(rowp0 + ai * HALF + m * 16) * 64; const float rs = pre[ai * 4 + m];
                float v[8];
#pragma unroll
                for (int n = 0; n < 2; ++n)
#pragma unroll
                    for (int j = 0; j < 4; ++j) { const float g = acc[ai][0][m][n][j] * rs, up = acc[ai][1][m][n][j] * rs;
                        const float s = g * __builtin_amdgcn_rcpf(1.0f + __builtin_amdgcn_exp2f(-g * LOG2E)); v[n * 4 + j] = s * up; }
                u32x4 w; w.x = cvtpk(v[0], v[1]); w.y = cvtpk(v[2], v[3]); w.z = cvtpk(v[4], v[5]); w.w = cvtpk(v[6], v[7]);
                *(u32x4*)rowp = w; }
    }
};
struct EpiResid {
    static constexpr bool PERM = false;
    __device__ __forceinline__ void prefetch(float (&)[8], const Unit&, int, int) const {}
    float* out; bf16_t* xb; float* ssq; int ldc; float alpha;
    __device__ __forceinline__ void operator()(const f32x4 (&acc)[2][2][4][2], const Unit& u, int wr, int wc, int fr, int fq, const float (&pre)[8]) const {
        const int row0 = u.pm * BM + wr * 64 + fr, col0 = u.pn * BM + wc * 32 + 4 * fq;
        u32x2 bs[4][4];
#define ER_LOAD(g) do { const int row_ = row0 + ((g) >> 2) * HALF + ((g) & 3) * 16; \
        _Pragma("unroll") for (int q_ = 0; q_ < 4; ++q_) bs[(g) & 3][q_] = *(const u32x2*)(xb + kt_off(row_, col0 + (q_ >> 1) * HALF + (q_ & 1) * 16, ldc)); } while (0)
        ER_LOAD(0); ER_LOAD(1); ER_LOAD(2); ER_LOAD(3);
#pragma unroll
        for (int g = 0; g < 8; ++g) { const int ai = g >> 2, m = g & 3; const int row = row0 + ai * HALF + m * 16; float ss = 0.f;
#pragma unroll
            for (int q = 0; q < 4; ++q) { const int bj = q >> 1, n = q & 1; const u32x2 b = bs[g & 3][q];
                const f32x4 o = (f32x4){bflo(b.x), bfhi(b.x), bflo(b.y), bfhi(b.y)} + acc[ai][bj][m][n] * alpha;
                ss += (o.x * o.x + o.y * o.y) + (o.z * o.z + o.w * o.w);
                u32x2 w; w.x = cvtpk(o.x, o.y); w.y = cvtpk(o.z, o.w); *(u32x2*)(xb + kt_off(row, col0 + bj * HALF + n * 16, ldc)) = w;
                if (out) *(f32x4*)(out + (size_t)row * ldc + col0 + bj * HALF + n * 16) = o; }
            if (g + 4 < 8) ER_LOAD(g + 4);
            const int lane = fq * 16 + fr; ss += shx(ss, 16, lane); ss += shx(ss, 32, lane);
            if (fq == 0) ssq[(size_t)row * 32 + u.pn * 4 + wc] = ss; }
#undef ER_LOAD
    }
};
struct EpiF32Z {
    static constexpr bool PERM = false;
    float* C; int ldc; size_t zstride;
    __device__ __forceinline__ void prefetch(float (&)[8], const Unit&, int, int) const {}
    __device__ __forceinline__ void operator()(const f32x4 (&acc)[2][2][4][2], const Unit& u, int wr, int wc, int fr, int fq, const float (&pre)[8]) const {
        float* Cz = C + (size_t)u.z * zstride;
        const int row0 = u.pm * BM + wr * 64 + fr, col0 = u.pn * BM + wc * 32 + 4 * fq;
#pragma unroll
        for (int ai = 0; ai < 2; ++ai)
#pragma unroll
            for (int m = 0; m < 4; ++m) { float* rowp = Cz + (size_t)(row0 + ai * HALF + m * 16) * ldc + col0;
#pragma unroll
                for (int bj = 0; bj < 2; ++bj)
#pragma unroll
                    for (int n = 0; n < 2; ++n) *(f32x4*)(rowp + bj * HALF + n * 16) = acc[ai][bj][m][n]; }
    }
};

template <class Epi, class Sched, int KSTEP_A = 128, int KSTEP_B = 128>
__device__ __forceinline__ void gemm_phase(LAS unsigned char* lds, const Gemm g, const Sched& S, const Epi& E, const int wv) {
    const int tid = opq_tid(wv), wid = __builtin_amdgcn_readfirstlane(tid >> 6), lane = tid & 63, wr = wid >> 2, wc = wid & 3, fr = lane & 15, fq = lane >> 4;
    const int K = g.K, nt = K / BK;
    unsigned voffA[2], voffB[2];
#pragma unroll
    for (int i = 0; i < 2; ++i) { int R, C; stage_rc(tid * 16 + i * 8192, R, C); const int Rb = Epi::PERM ? ((R & ~31) + perm32(R & 31)) : R;
        voffA[i] = (unsigned)(R * g.lda + C) * 2u; voffB[i] = (unsigned)(Rb * g.ldb + C) * 2u; }
    constexpr size_t kstepA = (size_t)KSTEP_A, kstepB = (size_t)KSTEP_B;
    const size_t hstepA = (size_t)HALF * g.lda * 2, hstepB = (size_t)HALF * g.ldb * 2;
    const unsigned ldsw = (unsigned)wid * 1024u;
    const int aoff = lds_byte(wr * 64 + fr, fq * 8), boff = lds_byte(wc * 32 + fr, fq * 8);
#define PG8_SA(b, h) (((b) * 2 + (h)) * HTB)
#define PG8_SB(b, h) ((4 + (b) * 2 + (h)) * HTB)
#define PG8_STAGE(bufoff, gbase, voff) do { _Pragma("unroll") for (int _i = 0; _i < 2; ++_i) \
        __builtin_amdgcn_global_load_lds((const unsigned*)((const char*)(gbase) + (voff)[_i]), (LAS unsigned*)(lds + (bufoff) + ldsw + _i * 8192), 16, 0, 0); } while (0)
#define PG8_LDA(dst, b, h) do { _Pragma("unroll") for (int m = 0; m < 4; ++m) _Pragma("unroll") for (int k = 0; k < 2; ++k) dst[m][k] = *(const LAS bf16x8*)(lds + PG8_SA(b, h) + aoff + m * 2048 + k * 1024); } while (0)
#define PG8_LDB(dst, b, h) do { _Pragma("unroll") for (int n = 0; n < 2; ++n) _Pragma("unroll") for (int k = 0; k < 2; ++k) dst[n][k] = *(const LAS bf16x8*)(lds + PG8_SB(b, h) + boff + n * 2048 + k * 1024); } while (0)
#define PG8_MMA(ai, bj, At, Bt) do { __builtin_amdgcn_s_setprio(1); _Pragma("unroll") for (int m = 0; m < 4; ++m) _Pragma("unroll") for (int n = 0; n < 2; ++n) _Pragma("unroll") for (int k = 0; k < 2; ++k) \
        acc[ai][bj][m][n] = __builtin_amdgcn_mfma_f32_16x16x32_bf16(Bt[n][k], At[m][k], acc[ai][bj][m][n], 0, 0, 0); __builtin_amdgcn_s_setprio(0); } while (0)
#define PG8_WAIT_V(n) asm volatile("s_waitcnt vmcnt(" #n ")" ::: "memory")
#define PG8_WAIT_L(n) asm volatile("s_waitcnt lgkmcnt(" #n ")" ::: "memory")
#define PG8_BAR __builtin_amdgcn_s_barrier()
#define PG8_SCHED __builtin_amdgcn_sched_barrier(0)
    Unit cur, nxt; int ui = 0;
    if (!S.next(0, cur)) return;
    f32x4 acc[2][2][4][2];
#pragma unroll
    for (int a = 0; a < 2; ++a)
#pragma unroll
        for (int b = 0; b < 2; ++b)
#pragma unroll
            for (int m = 0; m < 4; ++m)
#pragma unroll
                for (int n = 0; n < 2; ++n) acc[a][b][m][n] = (f32x4){0.f, 0.f, 0.f, 0.f};
    bf16x8 At[4][2], B0[2][2], B1[2][2];
    const char* cA = S.a_ptr(cur); const char* cB = S.b_ptr(cur);
    float pre[8]; E.prefetch(pre, cur, wr, fr);
    PG8_STAGE(PG8_SB(0, 0), cB, voffB); PG8_STAGE(PG8_SA(0, 0), cA, voffA); PG8_STAGE(PG8_SB(0, 1), cB + hstepB, voffB); PG8_STAGE(PG8_SA(0, 1), cA + hstepA, voffA);
    if (wr == 1) PG8_BAR;
    PG8_WAIT_V(4); PG8_BAR;
    PG8_STAGE(PG8_SB(1, 0), cB + kstepB, voffB); PG8_STAGE(PG8_SA(1, 0), cA + kstepA, voffA); PG8_STAGE(PG8_SB(1, 1), cB + hstepB + kstepB, voffB);
    PG8_WAIT_V(6); PG8_BAR;
    for (;;) {
        const bool has_next = S.next(ui + 1, nxt);
        const char* nA = has_next ? S.a_ptr(nxt) : cA; const char* nB = has_next ? S.b_ptr(nxt) : cB;
        for (int t = 0; t < nt; t += 2) {
            const bool last = (t == nt - 2);
            const char* a1 = cA + (size_t)(t + 1) * kstepA;
            const char* a2 = last ? nA : cA + (size_t)(t + 2) * kstepA; const char* b2 = last ? nB : cB + (size_t)(t + 2) * kstepB;
            const char* a3 = a2 + kstepA; const char* b3 = b2 + kstepB;
            PG8_LDB(B0, 0, 0); PG8_SCHED; PG8_LDA(At, 0, 0); PG8_STAGE(PG8_SA(1, 1), a1 + hstepA, voffA);
            PG8_WAIT_L(8); PG8_BAR; PG8_WAIT_L(0); PG8_MMA(0, 0, At, B0); PG8_BAR; PG8_SCHED;
            PG8_LDB(B1, 0, 1); PG8_STAGE(PG8_SB(0, 0), b2, voffB);
            PG8_BAR; PG8_WAIT_L(0); PG8_MMA(0, 1, At, B1); PG8_BAR;
            PG8_LDA(At, 0, 1); PG8_STAGE(PG8_SA(0, 0), a2, voffA);
            PG8_BAR; PG8_WAIT_L(0); PG8_MMA(1, 0, At, B0); PG8_BAR; PG8_SCHED;
            PG8_STAGE(PG8_SB(0, 1), b2 + hstepB, voffB);
            PG8_WAIT_V(6); PG8_BAR; PG8_MMA(1, 1, At, B1); PG8_BAR;
            PG8_LDB(B0, 1, 0); PG8_SCHED; PG8_LDA(At, 1, 0); PG8_STAGE(PG8_SA(0, 1), a2 + hstepA, voffA);
            PG8_WAIT_L(8); PG8_BAR; PG8_WAIT_L(0); PG8_MMA(0, 0, At, B0); PG8_BAR; PG8_SCHED;
            PG8_LDB(B1, 1, 1); PG8_STAGE(PG8_SB(1, 0), b3, voffB);
            PG8_BAR; PG8_WAIT_L(0); PG8_MMA(0, 1, At, B1); PG8_BAR;
            PG8_LDA(At, 1, 1); PG8_STAGE(PG8_SA(1, 0), a3, voffA);
            PG8_BAR; PG8_WAIT_L(0); PG8_MMA(1, 0, At, B0); PG8_BAR; PG8_SCHED;
            PG8_STAGE(PG8_SB(1, 1), b3 + hstepB, voffB);
            PG8_WAIT_V(6); PG8_BAR; PG8_MMA(1, 1, At, B1); PG8_BAR;
        }
        E(acc, cur, wr, wc, fr, fq, pre);
        if (has_next) E.prefetch(pre, nxt, wr, fr);
        if (!has_next) break;
#pragma unroll
        for (int a = 0; a < 2; ++a)
#pragma unroll
            for (int b = 0; b < 2; ++b)
#pragma unroll
                for (int m = 0; m < 4; ++m)
#pragma unroll
                    for (int n = 0; n < 2; ++n) acc[a][b][m][n] = (f32x4){0.f, 0.f, 0.f, 0.f};
        cur = nxt; cA = nA; cB = nB; ++ui;
    }
    PG8_WAIT_V(0);
    if (wr == 0) PG8_BAR;
    PG8_BAR;
#undef PG8_SA
#undef PG8_SB
#undef PG8_STAGE
#undef PG8_LDA
#undef PG8_LDB
#undef PG8_MMA
#undef PG8_WAIT_V
#undef PG8_WAIT_L
#undef PG8_BAR
#undef PG8_SCHED
}
}

struct Args { const float* in[24]; float* out; unsigned char* ws; };
enum { I_X = 0, I_F1N, I_F1W1, I_F1W3, I_F1W2, I_MIXN, I_WIN, I_GB, I_QNA, I_KNA, I_QNN, I_KNN, I_POS, I_CKW1, I_CKW2, I_CVW1, I_CVW2, I_ON, I_WOUT, I_F2N, I_F2W1, I_F2W3, I_F2W2, I_RB };

__device__ __forceinline__ void transpose_item(const float* W, int K, int N, bf16_t* WT, int mode, int off, LAS float* scr, int item, int lane, const float* gain) {
    const int nblk = (N + 31) / 32, kb = item / nblk, nb = item % nblk, k0 = 64 * kb, n0 = 32 * nb;
    const int c4 = 4 * (lane & 7), nn = n0 + c4;
    f32x4 ld[8];
#pragma unroll
    for (int i = 0; i < 8; ++i) { const int kk = 8 * i + (lane >> 3); ld[i] = (nn < N) ? *(const f32x4*)(W + (size_t)(k0 + kk) * N + nn) : (f32x4){0.f, 0.f, 0.f, 0.f}; if (gain) ld[i] = ld[i] * gain[k0 + kk]; }
#pragma unroll
    for (int i = 0; i < 8; ++i) { const int kk = 8 * i + (lane >> 3); LAS float* d = scr + kk * 33 + c4; d[0] = ld[i].x; d[1] = ld[i].y; d[2] = ld[i].z; d[3] = ld[i].w; }
    LDS_WAIT(); asm volatile("" ::: "memory");
    const int c = lane & 7;
#pragma unroll
    for (int j = 0; j < 4; ++j) { const int n = (lane >> 3) + 8 * j; const LAS float* s = scr + (8 * c) * 33 + n;
        u32x4 o; o.x = pk2(s[0 * 33], s[1 * 33]); o.y = pk2(s[2 * 33], s[3 * 33]); o.z = pk2(s[4 * 33], s[5 * 33]); o.w = pk2(s[6 * 33], s[7 * 33]);
        const int ng = n0 + n; const int dr = mode ? ((ng >> 7) * 256 + (ng & 127) + off) : (ng + off);
        if (ng < N) *(u32x4*)(WT + kt_off(dr, k0 + 8 * c, K)) = o; }
    LDS_WAIT(); asm volatile("" ::: "memory");
}
__device__ __forceinline__ int rel_bucket_dev(int n) {
    if (n < 16) return n;
    const float v = logf((float)n / 16.0f) / 4.852030263919617f * 16.0f;
    int b = 16 + (int)v; return b < 31 ? b : 31;
}
namespace att {
constexpr int SHM_V = 16384, SHM_K = 16384;
constexpr int L_V = 0  , L_K = 49152  , L_WS = 98304, L_TBL = 100352, L_SELM = L_TBL + 4 * TBLS * 4  , L_END = L_SELM + 1024;
constexpr int L_IMP = 0;
static_assert(L_END <= 131072, "attention LDS map");
constexpr float THR = 8.f;
#define KSWZ(row, colB) ((row) * 256 + ((colB) ^ (((row) & 7) << 4)))
__device__ __forceinline__ int v_st(int k, int c) { const int kk = (k & ~0xC) | ((k & 4) << 1) | ((k & 8) >> 1); return ((kk >> 3) * 4 + (c >> 5)) * 512 + ((kk & 7) * 32 + (c & 31)) * 2; }
__device__ __forceinline__ int v_rd_base(int lane) { return ((lane & 3) << 3) | (((lane >> 2) & 3) << 6) | (((lane >> 4) & 1) << 5) | (((lane >> 5) & 1) << 8); }
__device__ __forceinline__ int crow(int r, int hi) { return (r & 3) + 8 * (r >> 2) + 4 * hi; }

__device__ __forceinline__ void partialSM(f32x16& p0, f32x16& p1, float& m_reg, float& mn, float& alpha) {
    (void)m_reg; mn = 0.f; alpha = 1.f;
#pragma unroll
    for (int r = 0; r < 16; ++r) p0[r] = __builtin_amdgcn_exp2f(p0[r] * LOG2E);
#pragma unroll
    for (int r = 0; r < 16; ++r) p1[r] = p1[r] * LOG2E;
}
__device__ __forceinline__ void partialSM_row(f32x16& p0, f32x16& p1, float& m_reg, float& mn, float& alpha, bool ok, float bias) {
    (void)m_reg; mn = 0.f; alpha = 1.f;
    const float mnL = ok ? bias * LOG2E : -__builtin_inff();
#pragma unroll
    for (int r = 0; r < 16; ++r) p0[r] = __builtin_amdgcn_exp2f(fmaf(p0[r], LOG2E, mnL));
#pragma unroll
    for (int r = 0; r < 16; ++r) p1[r] = fmaf(p1[r], LOG2E, mnL);
}
#define PK4(P, B_, OUT) do { unsigned a0 = cvtpk(P[B_+0], P[B_+1]), a1 = cvtpk(P[B_+2], P[B_+3]);                          \
        unsigned b0 = cvtpk(P[B_+4], P[B_+5]), b1 = cvtpk(P[B_+6], P[B_+7]);                                             \
        auto r0 = __builtin_amdgcn_permlane32_swap(a0, b0, false, false); auto r1 = __builtin_amdgcn_permlane32_swap(a1, b1, false, false); \
        u32x4 w = {r0[0], r1[0], r0[1], r1[1]}; OUT = *reinterpret_cast<bf16x8*>(&w); } while (0)
__device__ __forceinline__ void finishSM(f32x16& p0, f32x16& p1, float alpha, float& l_reg, bf16x8& pa0, bf16x8& pa1, bf16x8& pa2, bf16x8& pa3) {
#pragma unroll
    for (int r = 0; r < 16; ++r) p1[r] = __builtin_amdgcn_exp2f(p1[r]);
    float ps = 0;
#pragma unroll
    for (int r = 0; r < 16; ++r) ps += p0[r];
#pragma unroll
    for (int r = 0; r < 16; ++r) ps += p1[r];
    { auto rr = __builtin_amdgcn_permlane32_swap(__float_as_uint(ps), __float_as_uint(ps), false, false);
      ps = __uint_as_float(rr[0]) + __uint_as_float(rr[1]); }
    l_reg = l_reg * alpha + ps;
    PK4(p0, 0, pa0); PK4(p0, 8, pa1); PK4(p1, 0, pa2); PK4(p1, 8, pa3);
}
__device__ __forceinline__ void qkt(f32x16& p0, f32x16& p1, const LAS char* Kb, int r32, int hi, const bf16x8 (&qr)[8]) {
    p0 = f32x16{}; p1 = f32x16{};
    const LAS char* kb4[4];
#pragma unroll
    for (int dd = 0; dd < 4; ++dd) kb4[dd] = Kb + KSWZ(r32, (dd * 16 + hi * 8) * 2);
#pragma unroll
    for (int d0 = 0; d0 < 8; ++d0) { const LAS char* a = kb4[d0 & 3] + (d0 >> 2) * 128;
        const bf16x8 b0 = *reinterpret_cast<const LAS bf16x8*>(a);
        const bf16x8 b1 = *reinterpret_cast<const LAS bf16x8*>(a + 32 * 256);
        p0 = __builtin_amdgcn_mfma_f32_32x32x16_bf16(b0, qr[d0], p0, 0, 0, 0);
        p1 = __builtin_amdgcn_mfma_f32_32x32x16_bf16(b1, qr[d0], p1, 0, 0, 0); }
}
__device__ __forceinline__ void pv_tile(f32x16 (&o)[4], int vb, bf16x8 pa0, bf16x8 pa1, bf16x8 pa2, bf16x8 pa3) {
#define TRRD(dst, off) asm volatile("ds_read_b64_tr_b16 %0, %1 offset:%2" : "=&v"(dst) : "v"(vb), "i"(off) : "memory")
#define PV_D0(d0) do { s16x4 l0, l1, l2, l3, h0, h1, h2, h3; constexpr int b_ = (d0) * 512; \
        TRRD(l0, b_); TRRD(h0, b_ + 2048); TRRD(l1, b_ + 4096); TRRD(h1, b_ + 6144); TRRD(l2, b_ + 8192); TRRD(h2, b_ + 10240); TRRD(l3, b_ + 12288); TRRD(h3, b_ + 14336); \
        asm volatile("s_waitcnt lgkmcnt(0)" ::: "memory"); SBAR(); \
        o[d0] = __builtin_amdgcn_mfma_f32_32x32x16_bf16(pa0, (bf16x8){l0[0], l0[1], l0[2], l0[3], h0[0], h0[1], h0[2], h0[3]}, o[d0], 0, 0, 0);   \
        o[d0] = __builtin_amdgcn_mfma_f32_32x32x16_bf16(pa1, (bf16x8){l1[0], l1[1], l1[2], l1[3], h1[0], h1[1], h1[2], h1[3]}, o[d0], 0, 0, 0);   \
        o[d0] = __builtin_amdgcn_mfma_f32_32x32x16_bf16(pa2, (bf16x8){l2[0], l2[1], l2[2], l2[3], h2[0], h2[1], h2[2], h2[3]}, o[d0], 0, 0, 0);   \
        o[d0] = __builtin_amdgcn_mfma_f32_32x32x16_bf16(pa3, (bf16x8){l3[0], l3[1], l3[2], l3[3], h3[0], h3[1], h3[2], h3[3]}, o[d0], 0, 0, 0); } while (0)
    PV_D0(0); PV_D0(1); PV_D0(2); PV_D0(3);
#undef PV_D0
#undef TRRD
}

template <class Cfg>
__device__ __forceinline__ void attn_tiles(const Cfg& c, LAS char* lds, const bf16x8 (&qr)[8], f32x16 (&o)[4], float& m_reg, float& l_reg, const int t_lo, const int t_hi, const int wv) {
    const int tid = opq_tid(wv), lane = tid & 63, wid = __builtin_amdgcn_readfirstlane(tid >> 6), r32 = lane & 31, hi = lane >> 5;
    LAS char* V_lds = lds + L_V; LAS char* K_lds = lds + L_K;
    LAS float* al_l = (LAS float*)(lds + L_WS) + wid * 64 + 32;
    const int sr = tid >> 4, sc = (tid & 15) * 8;
    const int vst0 = v_st(sr, sc), vst1 = v_st(32 + sr, sc), kws = KSWZ(sr, sc * 2);
    const int vb0 = (int)(unsigned)(uintptr_t)V_lds + v_rd_base(lane);
    bf16x8 sk0, sk1, sv0, sv1;
    const bf16_t *gk0 = nullptr, *gk1 = nullptr, *gv0 = nullptr, *gv1 = nullptr;
#define AT_LOAD(t) do { gk0 = c.krow((t), sr) + sc; gk1 = c.krow((t), sr + 32) + sc; sk0 = *(const bf16x8*)gk0; sk1 = *(const bf16x8*)gk1; \
        if constexpr (Cfg::MODE == 0) { gv0 = c.vrow((t), sr) + sc; gv1 = c.vrow((t), sr + 32) + sc; sv0 = *(const bf16x8*)gv0; sv1 = *(const bf16x8*)gv1; } \
        asm volatile("" ::: "memory"); SBAR(); } while (0)
#define AT_WRITE(t, bf) do { asm volatile("" :: "v"(gk0), "v"(gk1), "v"(gv0), "v"(gv1)); *(LAS bf16x8*)(K_lds + (bf) * SHM_K + kws) = sk0; *(LAS bf16x8*)(K_lds + (bf) * SHM_K + kws + 32 * 256) = sk1; \
        if constexpr (Cfg::MODE == 1) { \
            _Pragma("unroll") for (int i_ = 0; i_ < 8; ++i_) { const int n_ = sc + i_, c0_ = 64 * (t) + sr, c1_ = c0_ + 32; \
                sv0[i_] = (c0_ >= 4 * n_ - 1 && c0_ <= 4 * n_ + 3) ? (short)0x3F80 : (short)0; sv1[i_] = (c1_ >= 4 * n_ - 1 && c1_ <= 4 * n_ + 3) ? (short)0x3F80 : (short)0; } } \
        *(LAS bf16x8*)(V_lds + (bf) * SHM_V + vst0) = sv0; *(LAS bf16x8*)(V_lds + (bf) * SHM_V + vst1) = sv1; } while (0)
    __builtin_amdgcn_s_waitcnt(0x0F70);
    __syncthreads();
    if (t_lo < t_hi) { AT_LOAD(t_lo); AT_WRITE(t_lo, 0); }
    __syncthreads();
    for (int t = t_lo; t < t_hi; ++t) {
        const int buf = (t - t_lo) & 1; const bool more = (t + 1 < t_hi);
        if (more) AT_LOAD(t + 1);
        if (c.active(t)) {
            f32x16 p0, p1;
            qkt(p0, p1, K_lds + buf * SHM_K, r32, hi, qr);
            if constexpr (Cfg::MODE == 0) {
                float mn, alpha; bf16x8 pa0, pa1, pa2, pa3;
                bool rok; float rbias;
                if (c.rowconst(t, rok, rbias)) partialSM_row(p0, p1, m_reg, mn, alpha, rok, rbias);
                else { c.mask(p0, p1, t); partialSM(p0, p1, m_reg, mn, alpha); }
                if (__any(alpha < 1.f)) { if (hi == 0) al_l[r32] = alpha; LDS_WAIT();
#pragma unroll
                    for (int d_ = 0; d_ < 4; ++d_)
#pragma unroll
                        for (int r = 0; r < 16; ++r) o[d_][r] *= al_l[crow(r, hi)]; }
                finishSM(p0, p1, alpha, l_reg, pa0, pa1, pa2, pa3); SBAR();
                pv_tile(o, vb0 + buf * SHM_V, pa0, pa1, pa2, pa3);
            } else {
                c.mask(p0, p1, t);
                const float mL = -c.mfix * LOG2E; const float il = c.invl;
#pragma unroll
                for (int r = 0; r < 16; ++r) { p0[r] = __builtin_amdgcn_exp2f(fmaf(p0[r], LOG2E, mL)) * il; p1[r] = __builtin_amdgcn_exp2f(fmaf(p1[r], LOG2E, mL)) * il; }
                bf16x8 pa0, pa1, pa2, pa3;
                PK4(p0, 0, pa0); PK4(p0, 8, pa1); PK4(p1, 0, pa2); PK4(p1, 8, pa3); SBAR();
                pv_tile(o, vb0 + buf * SHM_V, pa0, pa1, pa2, pa3);
#pragma unroll
                for (int r = 0; r < 16; r += 2) { const unsigned a = cvtpk(p0[r], p0[r + 1]), b = cvtpk(p1[r], p1[r + 1]);
                    p0[r] -= bflo(a); p0[r + 1] -= bfhi(a); p1[r] -= bflo(b); p1[r + 1] -= bfhi(b); }
                PK4(p0, 0, pa0); PK4(p0, 8, pa1); PK4(p1, 0, pa2); PK4(p1, 8, pa3); SBAR();
                pv_tile(o, vb0 + buf * SHM_V, pa0, pa1, pa2, pa3);
            }
        }
        if (more) AT_WRITE(t + 1, buf ^ 1);
        __syncthreads();
    }
#undef AT_LOAD
#undef AT_WRITE
}

template <class Cfg>
__device__ __forceinline__ void attn_tiles_s(const Cfg& c, LAS char* lds, const bf16x8 (&qr)[8], f32x16 (&o)[4], float& m_reg, float& l_reg, const int t_lo, const int t_hi, const int wv) {
    static_assert(Cfg::MODE == 0, "fixed-shift softmax tiles only");
    (void)m_reg;
    const int tid = opq_tid(wv), lane = tid & 63, wid = __builtin_amdgcn_readfirstlane(tid >> 6), r32 = lane & 31, hi = lane >> 5;
    LAS char* V_lds = lds + L_V; LAS char* K_lds = lds + L_K;
    const int sr = tid >> 4, sc = (tid & 15) * 8;
    const int vst0 = v_st(sr, sc), vst1 = v_st(32 + sr, sc), kws = KSWZ(sr, sc * 2);
    const int vb0 = (int)(unsigned)(uintptr_t)V_lds + v_rd_base(lane);
    bf16x8 sk0, sk1, sv0, sv1, pa0, pa1, pa2, pa3;
    const bf16_t *gk0 = nullptr, *gk1 = nullptr, *gv0 = nullptr, *gv1 = nullptr;
#define AS_LOAD(t) do { gk0 = c.krow((t), sr) + sc; gk1 = c.krow((t), sr + 32) + sc; sk0 = *(const bf16x8*)gk0; sk1 = *(const bf16x8*)gk1; \
        gv0 = c.vrow((t), sr) + sc; gv1 = c.vrow((t), sr + 32) + sc; sv0 = *(const bf16x8*)gv0; sv1 = *(const bf16x8*)gv1; asm volatile("" ::: "memory"); SBAR(); } while (0)
#define AS_WRITE(kbf, vbf) do { asm volatile("" :: "v"(gk0), "v"(gk1), "v"(gv0), "v"(gv1)); *(LAS bf16x8*)(K_lds + (kbf) * SHM_K + kws) = sk0; *(LAS bf16x8*)(K_lds + (kbf) * SHM_K + kws + 32 * 256) = sk1; \
        *(LAS bf16x8*)(V_lds + (vbf) * SHM_V + vst0) = sv0; *(LAS bf16x8*)(V_lds + (vbf) * SHM_V + vst1) = sv1; } while (0)
#define AS_SCORE(t, kbf) do { f32x16 p0, p1; float mz_ = 0.f, mn_, al_; bool rok_; float rb_; \
        qkt(p0, p1, K_lds + (kbf) * SHM_K, r32, hi, qr); \
        if (c.rowconst((t), rok_, rb_)) partialSM_row(p0, p1, mz_, mn_, al_, rok_, rb_); else { c.mask(p0, p1, (t)); partialSM(p0, p1, mz_, mn_, al_); } \
        finishSM(p0, p1, 1.f, l_reg, pa0, pa1, pa2, pa3); SBAR(); } while (0)
    if (t_lo >= t_hi) return;
    __builtin_amdgcn_s_waitcnt(0x0F70);
    __syncthreads();
    AS_LOAD(t_lo); AS_WRITE(0, 0);
    __syncthreads();
    int kb = 0, vb = 0;
    if (wid < 4) {
        for (int t = t_lo; t < t_hi; ++t) {
            const bool more = (t + 1 < t_hi); const int vn = (vb == 2) ? 0 : vb + 1;
            if (more) AS_LOAD(t + 1);
            if (c.active(t)) { AS_SCORE(t, kb); pv_tile(o, vb0 + vb * SHM_V, pa0, pa1, pa2, pa3); }
            if (more) AS_WRITE(kb ^ 1, vn);
            __syncthreads();
            kb ^= 1; vb = vn;
        }
    } else {
        bool pend = false; int vp = 0;
        for (int t = t_lo; t < t_hi; ++t) {
            const bool more = (t + 1 < t_hi); const int vn = (vb == 2) ? 0 : vb + 1;
            if (more) AS_LOAD(t + 1);
            if (pend) pv_tile(o, vb0 + vp * SHM_V, pa0, pa1, pa2, pa3);
            const bool act = c.active(t);
            if (act) AS_SCORE(t, kb);
            pend = act; vp = vb;
            if (more) AS_WRITE(kb ^ 1, vn);
            __syncthreads();
            kb ^= 1; vb = vn;
        }
        if (pend) pv_tile(o, vb0 + vp * SHM_V, pa0, pa1, pa2, pa3);
    }
#undef AS_LOAD
#undef AS_WRITE
#undef AS_SCORE
}

struct DilCfg {
    static constexpr int MODE = 0;
    const bf16_t* Kb; const bf16_t* Vb;
    const LAS float* tbl; int dshift, res, u, dqm, s0;
    __device__ __forceinline__ const bf16_t* krow(int t, int kk) const { int s = 256 * u - 128 + 64 * t + kk; s = s < 0 ? 0 : s; return Kb + (size_t)((s << dshift) + res) * PC; }
    __device__ __forceinline__ const bf16_t* vrow(int t, int kk) const { int s = 256 * u - 128 + 64 * t + kk; s = s < 0 ? 0 : s; return Vb + (size_t)((s << dshift) + res) * PC; }
    __device__ __forceinline__ bool active(int t) const { const int kb = 256 * u - 128 + 64 * t; return kb <= s0 + 31 && kb + 63 >= s0 - 128; }
    __device__ __forceinline__ bool rowconst(int, bool&, float&) const { return false; }
    __device__ __forceinline__ void mask(f32x16& p0, f32x16& p1, int t) const {
        const int dq = dqm - (256 * u - 128 + 64 * t); const float NEG = -__builtin_inff();
        const LAS float* tb = tbl + (DT0 + dq - 63);
        float bb0[16], bb1[16];
#pragma unroll
        for (int r = 0; r < 16; ++r) { const int cc = (r & 3) + 8 * (r >> 2); bb0[r] = tb[63 - cc]; bb1[r] = tb[31 - cc]; }
#pragma unroll
        for (int r = 0; r < 16; ++r) asm volatile("" : "+v"(bb0[r]), "+v"(bb1[r]));
#pragma unroll
        for (int r = 0; r < 16; ++r) { const int cc = (r & 3) + 8 * (r >> 2); const unsigned d0 = (unsigned)(dq - cc), d1 = (unsigned)(dq - cc - 32);
            p0[r] = (d0 <= 128u) ? p0[r] + bb0[r] : NEG; p1[r] = (d1 <= 128u) ? p1[r] + bb1[r] : NEG; }
    }
};
struct CmpCfg {
    static constexpr int MODE = 0;
    const bf16_t* Kb; const bf16_t* Vb; int cmax, hi4, cfull;
    __device__ __forceinline__ bool rowconst(int t, bool& ok, float& bias) const { ok = true; bias = 0.f; return 64 * t + 63 <= cfull; }
    __device__ __forceinline__ const bf16_t* krow(int t, int kk) const { return Kb + (size_t)(64 * t + kk) * HD; }
    __device__ __forceinline__ const bf16_t* vrow(int t, int kk) const { return Vb + (size_t)(64 * t + kk) * HD; }
    __device__ __forceinline__ bool active(int) const { return true; }
    __device__ __forceinline__ void mask(f32x16& p0, f32x16& p1, int t) const {
        const int cb = 64 * t + hi4; const float NEG = -__builtin_inff();
#pragma unroll
        for (int r = 0; r < 16; ++r) { const int cc = cb + (r & 3) + 8 * (r >> 2); if (cc > cmax) p0[r] = NEG; if (cc + 32 > cmax) p1[r] = NEG; }
    }
};
struct CmpImpCfg {
    static constexpr int MODE = 1;
    const bf16_t* Kb; int cmax, hi4; float mfix, invl;
    __device__ __forceinline__ const bf16_t* krow(int t, int kk) const { return Kb + (size_t)(64 * t + kk) * HD; }
    __device__ __forceinline__ const bf16_t* vrow(int, int) const { return Kb; }
    __device__ __forceinline__ bool active(int) const { return true; }
    __device__ __forceinline__ void mask(f32x16& p0, f32x16& p1, int t) const {
        const int cb = 64 * t + hi4; const float NEG = -__builtin_inff();
#pragma unroll
        for (int r = 0; r < 16; ++r) { const int cc = cb + (r & 3) + 8 * (r >> 2); if (cc > cmax) p0[r] = NEG; if (cc + 32 > cmax) p1[r] = NEG; }
    }
};
struct SlcCfg {
    static constexpr int MODE = 0;
    const bf16_t* Kb; const bf16_t* Vb;
    const LAS float* tblh;
    unsigned s0, s1, s2, s3; int tqm, cur; float b31;
    __device__ __forceinline__ const bf16_t* krow(int t, int kk) const { return Kb + (size_t)(64 * t + kk) * PC; }
    __device__ __forceinline__ const bf16_t* vrow(int t, int kk) const { return Vb + (size_t)(64 * t + kk) * PC; }
    __device__ __forceinline__ bool selbit(int t) const { const unsigned q = (unsigned)t >> 5; const unsigned w = (q == 0u ? s0 + 0u : 0u) | (q == 1u ? s1 + 0u : 0u) | (q == 2u ? s2 + 0u : 0u) | (q == 3u ? s3 + 0u : 0u); return (w >> (t & 31)) & 1u; }
    __device__ __forceinline__ bool active(int t) const { return __any(selbit(t)); }
    __device__ __forceinline__ bool rowconst(int t, bool& ok, float& bias) const { ok = selbit(t); bias = b31; return 64 * (cur - t) - 63 >= 1513; }
    __device__ __forceinline__ void mask(f32x16& p0, f32x16& p1, int t) const {
        const bool sel = selbit(t); const int dq = tqm - 64 * t; const float NEG = -__builtin_inff();
        const LAS float* tb = tblh + (TBL0 + dq - 63);
        float bb0[16], bb1[16];
#pragma unroll
        for (int r = 0; r < 16; ++r) { const int cc = (r & 3) + 8 * (r >> 2); bb0[r] = tb[63 - cc]; bb1[r] = tb[31 - cc]; }
#pragma unroll
        for (int r = 0; r < 16; ++r) asm volatile("" : "+v"(bb0[r]), "+v"(bb1[r]));
#pragma unroll
        for (int r = 0; r < 16; ++r) { const int cc = (r & 3) + 8 * (r >> 2); const int d0 = dq - cc, d1 = dq - cc - 32;
            p0[r] = (sel && d0 >= 0) ? p0[r] + bb0[r] : NEG; p1[r] = (sel && d1 >= 0) ? p1[r] + bb1[r] : NEG; }
    }
};
struct WinCfg {
    static constexpr int MODE = 0;
    const bf16_t* Kb; const bf16_t* Vb; const LAS float* tblh; int tqm;
    __device__ __forceinline__ bool rowconst(int, bool&, float&) const { return false; }
    __device__ __forceinline__ const bf16_t* krow(int t, int kk) const { return Kb + (size_t)(64 * t + kk) * PC; }
    __device__ __forceinline__ const bf16_t* vrow(int t, int kk) const { return Vb + (size_t)(64 * t + kk) * PC; }
    __device__ __forceinline__ bool active(int) const { return true; }
    __device__ __forceinline__ void mask(f32x16& p0, f32x16& p1, int t) const {
        const int dq = tqm - 64 * t; const float NEG = -__builtin_inff();
        const LAS float* tb = tblh + (TBL0 + dq - 63);
        float bb0[16], bb1[16];
#pragma unroll
        for (int r = 0; r < 16; ++r) { const int cc = (r & 3) + 8 * (r >> 2); bb0[r] = tb[63 - cc]; bb1[r] = tb[31 - cc]; }
#pragma unroll
        for (int r = 0; r < 16; ++r) asm volatile("" : "+v"(bb0[r]), "+v"(bb1[r]));
#pragma unroll
        for (int r = 0; r < 16; ++r) { const int cc = (r & 3) + 8 * (r >> 2); const unsigned d0 = (unsigned)(dq - cc), d1 = (unsigned)(dq - cc - 32);
            p0[r] = (d0 < 512u) ? p0[r] + bb0[r] : NEG; p1[r] = (d1 < 512u) ? p1[r] + bb1[r] : NEG; }
    }
};
}

__device__ __forceinline__ void load_q_normed(const bf16_t* qp  , const float* gain  , bf16x8 (&qr)[8]) {
    u32x4 raw[8];
#pragma unroll
    for (int d0 = 0; d0 < 8; ++d0) raw[d0] = *(const u32x4*)(qp + d0 * 16);
    float ss = 0.f;
#pragma unroll
    for (int d0 = 0; d0 < 8; ++d0) { const u32x4 w = raw[d0]; const float a0 = bflo(w.x), a1 = bfhi(w.x), a2 = bflo(w.y), a3 = bfhi(w.y), a4 = bflo(w.z), a5 = bfhi(w.z), a6 = bflo(w.w), a7 = bfhi(w.w);
        ss += ((a0 * a0 + a1 * a1) + (a2 * a2 + a3 * a3)) + ((a4 * a4 + a5 * a5) + (a6 * a6 + a7 * a7)); }
    { auto rr = __builtin_amdgcn_permlane32_swap(__float_as_uint(ss), __float_as_uint(ss), false, false); ss = __uint_as_float(rr[0]) + __uint_as_float(rr[1]); }
    const float rs = QSCALE / sqrtf(ss * (1.f / HD) + EPS);
#pragma unroll
    for (int d0 = 0; d0 < 8; ++d0) { const u32x4 w = raw[d0]; const f32x4 g0 = *(const f32x4*)(gain + d0 * 16), g1 = *(const f32x4*)(gain + d0 * 16 + 4);
        u32x4 o; o.x = cvtpk(bflo(w.x) * rs * g0.x, bfhi(w.x) * rs * g0.y); o.y = cvtpk(bflo(w.y) * rs * g0.z, bfhi(w.y) * rs * g0.w);
        o.z = cvtpk(bflo(w.z) * rs * g1.x, bfhi(w.z) * rs * g1.y); o.w = cvtpk(bflo(w.w) * rs * g1.z, bfhi(w.w) * rs * g1.w);
        qr[d0] = *reinterpret_cast<bf16x8*>(&o); }
}

__device__ __forceinline__ void dil_tiles(const att::DilCfg& c, LAS char* lds, const bf16x8 (&qr)[8], f32x16 (&o)[4], float& l_reg, const int wv) {
    using namespace att;
    const int tid = opq_tid(wv), lane = tid & 63, wid = __builtin_amdgcn_readfirstlane(tid >> 6), r32 = lane & 31, hi = lane >> 5;
    LAS char* V_lds = lds + L_V; LAS char* K_lds = lds + L_K;
    const int sr = tid >> 4, sc = (tid & 15) * 8;
    const int vst0 = v_st(sr, sc), vst1 = v_st(32 + sr, sc), kws = KSWZ(sr, sc * 2);
    const int vb0 = (int)(unsigned)(uintptr_t)V_lds + v_rd_base(lane);
    bf16x8 sk0, sk1, sv0, sv1;
    const bf16_t *gk0 = nullptr, *gk1 = nullptr, *gv0 = nullptr, *gv1 = nullptr;
#define DT_LOAD(t) do { gk0 = c.krow((t), sr) + sc; gk1 = c.krow((t), sr + 32) + sc; sk0 = *(const bf16x8*)gk0; sk1 = *(const bf16x8*)gk1; \
        gv0 = c.vrow((t), sr) + sc; gv1 = c.vrow((t), sr + 32) + sc; sv0 = *(const bf16x8*)gv0; sv1 = *(const bf16x8*)gv1; asm volatile("" ::: "memory"); SBAR(); } while (0)
#define DT_WRITE(slot) do { asm volatile("" :: "v"(gk0), "v"(gk1), "v"(gv0), "v"(gv1)); *(LAS bf16x8*)(K_lds + (slot) * SHM_K + kws) = sk0; *(LAS bf16x8*)(K_lds + (slot) * SHM_K + kws + 32 * 256) = sk1; \
        *(LAS bf16x8*)(V_lds + (slot) * SHM_V + vst0) = sv0; *(LAS bf16x8*)(V_lds + (slot) * SHM_V + vst1) = sv1; } while (0)
#define DT_COMP(t, slot) do { f32x16 p0, p1; float mz_ = 0.f, mn_, al_; bf16x8 pa0, pa1, pa2, pa3; \
        qkt(p0, p1, K_lds + (slot) * SHM_K, r32, hi, qr); c.mask(p0, p1, (t)); partialSM(p0, p1, mz_, mn_, al_); \
        finishSM(p0, p1, 1.f, l_reg, pa0, pa1, pa2, pa3); SBAR(); pv_tile(o, vb0 + (slot) * SHM_V, pa0, pa1, pa2, pa3); } while (0)
    const bool first = (c.u == 0);
    __builtin_amdgcn_s_waitcnt(0x0F70);
    __syncthreads();
    if (!first) { DT_LOAD(1); DT_WRITE(0); }
    DT_LOAD(4); DT_WRITE(1);
    __syncthreads();
    DT_LOAD(2);
    if (wid < 4) { if (!first) DT_COMP(1, 0); } else DT_COMP(4, 1);
    DT_WRITE(2);
    __syncthreads();
    DT_LOAD(3);
    if (wid < 6) DT_COMP(2, 2);
    DT_WRITE(0);
    __syncthreads();
    DT_LOAD(5);
    if (wid >= 2) DT_COMP(3, 0);
    DT_WRITE(1);
    if (!first) { DT_LOAD(0); DT_WRITE(2); }
    __syncthreads();
    if (wid < 2) { if (!first) DT_COMP(0, 2); } else if (wid >= 6) DT_COMP(5, 1);
#undef DT_LOAD
#undef DT_WRITE
#undef DT_COMP
}

__device__ __forceinline__ void dil_unit(LAS char* lds, const bf16_t* P, bf16_t* OA, float* LSE, const float* dilT, const float* qgain, int pat, int dshift, int unit, const int wv) {
    using namespace att;
    const int tid = opq_tid(wv), lane = tid & 63, wid = __builtin_amdgcn_readfirstlane(tid >> 6), r32 = lane & 31, hi = lane >> 5;
    const int bh = unit >> 5, ru = unit & 31, b = bh >> 3, h = bh & 7;
    const int ncs = 5 - dshift, res = ru >> ncs, u = ru & ((1 << ncs) - 1);
    LAS float* tbl = (LAS float*)(lds + L_TBL);
    __syncthreads();
    if (tid < DTS) tbl[tid] = dilT[(pat * 8 + h) * DTS + tid];
    const int s0 = 256 * u + 32 * wid, s_row = s0 + r32;
    const size_t tokrow = (size_t)b * SEQ + (size_t)((s_row << dshift) + res);
    bf16x8 qr[8];
    load_q_normed(P + tokrow * PC + C_QA + h * HD + hi * 8, qgain + hi * 8, qr);
    f32x16 o[4]; float m_reg, l_reg;
    m_reg = 0.f;
    if (pat == 0) { l_reg = 0.f;
#pragma unroll
        for (int d0 = 0; d0 < 4; ++d0) o[d0] = f32x16{}; }
    else { l_reg = LSE[tokrow * 8 + h];
#pragma unroll
        for (int r = 0; r < 16; ++r) { const size_t tr = (size_t)b * SEQ + (size_t)(((s0 + crow(r, hi)) << dshift) + res); const bf16_t* op = OA + tr * 1024 + h * HD + r32;
#pragma unroll
            for (int d0 = 0; d0 < 4; ++d0) o[d0][r] = bf2f(op[d0 * 32]); } }
    DilCfg c; c.Kb = P + (size_t)b * SEQ * PC + C_KA + h * HD; c.Vb = P + (size_t)b * SEQ * PC + C_VA + h * HD; c.tbl = tbl; c.dshift = dshift; c.res = res; c.u = u; c.dqm = s_row - 4 * hi; c.s0 = s0;
    dil_tiles(c, lds, qr, o, l_reg, wv);
    LAS float* li_l = (LAS float*)(lds + L_WS) + wid * 64;
    if (hi == 0) { li_l[r32] = l_reg; LSE[tokrow * 8 + h] = l_reg; }
    LDS_WAIT();
#pragma unroll
    for (int r = 0; r < 16; ++r) { const int orow = crow(r, hi); const float rl = (pat == 2) ? 1.0f / li_l[orow] : 1.0f;
        const size_t tr = (size_t)b * SEQ + (size_t)(((s0 + orow) << dshift) + res); bf16_t* op = OA + tr * 1024 + h * HD;
#pragma unroll
        for (int d0 = 0; d0 < 4; ++d0) { const float v = o[d0][r] * rl; const float vn = shx(v, 1, lane);
            if ((r32 & 1) == 0) *(unsigned*)(op + d0 * 32 + r32) = cvtpk(v, vn); } }
}

__device__ __forceinline__ void nsa_finalize(LAS char* lds, const f32x16 (&o)[4], float l_reg, const bf16_t* P, bf16_t* ON, const float* gb, int b, int g, int tok0, int br, const int wv) {
    using namespace att;
    const int tid = opq_tid(wv), lane = tid & 63, wid = __builtin_amdgcn_readfirstlane(tid >> 6), r32 = lane & 31, hi = lane >> 5;
    LAS float* li_l = (LAS float*)(lds + L_WS) + wid * 64;
    if (hi == 0) li_l[r32] = l_reg;
    LDS_WAIT();
    bf16_t* ONb = ON + (size_t)br * NTOK * 1024;
#pragma unroll
    for (int r = 0; r < 16; ++r) { const int j = r & 3, k = r >> 2; const float lr = li_l[crow(r, hi)]; const float rl = lr > 0.f ? 1.0f / lr : 0.f;
        const size_t tok = (size_t)b * SEQ + tok0 + 2 * k + hi; const int hh = 4 * g + j;
        const float gl = bf2f(P[tok * PC + C_GL + hh * 3 + br]) + gb[hh * 3 + br];
        const float sc = rl * __builtin_amdgcn_rcpf(1.0f + __builtin_amdgcn_exp2f(-gl * LOG2E));
        bf16_t* op = ONb + tok * 1024 + hh * HD;
#pragma unroll
        for (int d0 = 0; d0 < 4; ++d0) { const float v = o[d0][r] * sc; const float vn = shx(v, 1, lane);
            if ((r32 & 1) == 0) *(unsigned*)(op + d0 * 32 + r32) = cvtpk(v, vn); } }
}
__device__ __forceinline__ void nsa_unit(LAS char* lds, const bf16_t* P, const bf16_t* KC, const bf16_t* VC, bf16_t* ON, const float* nsaT, const float* gb, const float* qgain, int b, int g, int qi, bool load_tbl, const int wv) {
    using namespace att;
    const int tid = opq_tid(wv), lane = tid & 63, wid = __builtin_amdgcn_readfirstlane(tid >> 6), r32 = lane & 31, hi = lane >> 5;
    LAS float* tbl = (LAS float*)(lds + L_TBL); LAS float* IMP = (LAS float*)(lds + L_IMP); LAS unsigned* SELM = (LAS unsigned*)(lds + L_SELM);
    __syncthreads();
    if (load_tbl) for (int i = tid; i < 4 * TBLS; i += NTHR) tbl[i] = nsaT[(size_t)(4 * g) * TBLS + i];
    const int tok0 = 64 * qi + 8 * wid, tq = tok0 + (r32 >> 2), hd = r32 & 3;
    const bf16_t* Pb = P + (size_t)b * SEQ * PC;
    bf16x8 qr[8];
    load_q_normed(Pb + (size_t)tq * PC + C_QN + (4 * g + hd) * HD + hi * 8, qgain + hi * 8, qr);
    const bf16_t* KCb = KC + (size_t)(b * 2 + g) * 512 * HD; const bf16_t* VCb = VC + (size_t)(b * 2 + g) * 512 * HD;
    const int ntc = (qi >> 4) + 1, cmax = (tq - 31) >> 4;
    f32x16 o[4]; float m_reg, l_reg;
#pragma unroll
    for (int d0 = 0; d0 < 4; ++d0) o[d0] = f32x16{};
    m_reg = 0.f; l_reg = 0.f;
    { CmpCfg c; c.Kb = KCb; c.Vb = VCb; c.cmax = cmax; c.hi4 = 4 * hi; c.cfull = (64 * qi - 31) >> 4; attn_tiles_s(c, lds, qr, o, m_reg, l_reg, 0, ntc, wv); }
    nsa_finalize(lds, o, l_reg, P, ON, gb, b, g, tok0, 0, wv);
    { CmpImpCfg c; c.Kb = KCb; c.cmax = cmax; c.hi4 = 4 * hi; c.mfix = 0.f; c.invl = l_reg > 0.f ? 1.0f / l_reg : 0.f;
#pragma unroll
      for (int d0 = 0; d0 < 4; ++d0) o[d0] = f32x16{};
      float md = 0.f, ld = 0.f; attn_tiles(c, lds, qr, o, md, ld, 0, ntc, wv); }
#pragma unroll
    for (int d0 = 0; d0 < 4; ++d0)
#pragma unroll
        for (int k = 0; k < 4; ++k) IMP[(8 * wid + 2 * k + hi) * 128 + 32 * d0 + r32] = (o[d0][4 * k] + o[d0][4 * k + 1]) + (o[d0][4 * k + 2] + o[d0][4 * k + 3]);
    __syncthreads();
    { const int cur = qi;
#pragma unroll 1
      for (int tl = 8 * wid; tl < 8 * wid + 8; ++tl) {
        const int n0 = lane, n1 = 64 + lane; bool sel0, sel1;
        if (cur <= 15) { sel0 = (n0 <= cur); sel1 = false; }
        else {
            const float v0 = IMP[tl * 128 + n0], v1 = IMP[tl * 128 + n1];
            const unsigned u0 = (n0 >= 1 && n0 <= cur - 2) ? __float_as_uint(v0) + 1u : 0u, u1 = (n1 <= cur - 2) ? __float_as_uint(v1) + 1u : 0u;
            unsigned T = 0u;
#pragma unroll 1
            for (int bit = 30; bit >= 0; --bit) { const unsigned cand = T | (1u << bit);
                const int cnt = __builtin_popcountll(__ballot(u0 >= cand)) + __builtin_popcountll(__ballot(u1 >= cand));
                if (cnt >= 13) T = cand; }
            const bool gt0 = u0 > T, gt1 = u1 > T;
            const int need = 13 - (__builtin_popcountll(__ballot(gt0)) + __builtin_popcountll(__ballot(gt1)));
            const bool eq0 = (u0 == T), eq1 = (u1 == T);
            const unsigned long long m0 = __ballot(eq0), m1 = __ballot(eq1);
            const int pre0 = (int)__builtin_amdgcn_mbcnt_hi((unsigned)(m0 >> 32), __builtin_amdgcn_mbcnt_lo((unsigned)m0, 0u));
            const int pre1 = __builtin_popcountll(m0) + (int)__builtin_amdgcn_mbcnt_hi((unsigned)(m1 >> 32), __builtin_amdgcn_mbcnt_lo((unsigned)m1, 0u));
            sel0 = (n0 == 0 || n0 == cur || n0 == cur - 1) || gt0 || (eq0 && pre0 < need);
            sel1 = (n1 == cur || n1 == cur - 1) || gt1 || (eq1 && pre1 < need);
        }
        const unsigned long long b0 = __ballot(sel0), b1 = __ballot(sel1);
        if (lane == 0) { SELM[tl * 4 + 0] = (unsigned)b0; SELM[tl * 4 + 1] = (unsigned)(b0 >> 32); SELM[tl * 4 + 2] = (unsigned)b1; SELM[tl * 4 + 3] = (unsigned)(b1 >> 32); } } }
    __syncthreads();
    int r32s = r32; asm volatile("" : "+v"(r32s));
    { SlcCfg c; c.Kb = Pb + C_KS + g * HD; c.Vb = Pb + C_VS + g * HD; c.tblh = tbl + (r32s & 3) * TBLS; c.tqm = tok0 + (r32s >> 2) - 4 * hi; c.cur = qi; c.b31 = tbl[(r32s & 3) * TBLS + TBL0 + 1600];
      const int tl = 8 * wid + (r32s >> 2); c.s0 = SELM[tl * 4 + 0]; c.s1 = SELM[tl * 4 + 1]; c.s2 = SELM[tl * 4 + 2]; c.s3 = SELM[tl * 4 + 3];
#pragma unroll
      for (int d0 = 0; d0 < 4; ++d0) o[d0] = f32x16{};
      m_reg = 0.f; l_reg = 0.f;
      attn_tiles_s(c, lds, qr, o, m_reg, l_reg, 0, qi + 1, wv); }
    nsa_finalize(lds, o, l_reg, P, ON, gb, b, g, tok0, 1, wv);
    int r32w = r32; asm volatile("" : "+v"(r32w));
    { WinCfg c; c.Kb = Pb + C_KW + g * HD; c.Vb = Pb + C_VW + g * HD; c.tblh = tbl + (r32w & 3) * TBLS; c.tqm = tok0 + (r32w >> 2) - 4 * hi;
#pragma unroll
      for (int d0 = 0; d0 < 4; ++d0) o[d0] = f32x16{};
      m_reg = 0.f; l_reg = 0.f;
      attn_tiles_s(c, lds, qr, o, m_reg, l_reg, qi >= 8 ? qi - 8 : 0, qi + 1, wv); }
    nsa_finalize(lds, o, l_reg, P, ON, gb, b, g, tok0, 2, wv);
}

constexpr int LDS_BYTES = 147456;
constexpr int LDS_MISC = 131072;
constexpr int LDS_ARGS = LDS_MISC + 64;
__device__ __forceinline__ unsigned long long arg_u64(LAS unsigned char* lds, int i) {
    const LAS unsigned* p = (const LAS unsigned*)(opq_lds(lds) + LDS_ARGS) + 2 * i;
    const unsigned lo = __builtin_amdgcn_readfirstlane(p[0]), hi = __builtin_amdgcn_readfirstlane(p[1]);
    return ((unsigned long long)hi << 32) | lo;
}
#define GAS __attribute__((address_space(1)))
__device__ __forceinline__ const float* arg_in(LAS unsigned char* lds, int i) { return (const float*)(GAS const float*)arg_u64(lds, i); }
__device__ __forceinline__ float* arg_out(LAS unsigned char* lds) { return (float*)(GAS float*)arg_u64(lds, 24); }
__device__ __forceinline__ unsigned char* arg_ws(LAS unsigned char* lds) { return (unsigned char*)(GAS unsigned char*)arg_u64(lds, 25); }
__device__ __forceinline__ int opq_bx() { int b = blockIdx.x; asm volatile("" : "+s"(b)); return b; }
__device__ __forceinline__ int opq_g() { int b = gridDim.x; asm volatile("" : "+s"(b)); return b; }

__device__ __forceinline__ void ph_prologue(LAS unsigned char* lds, const int wv) {
    lds = opq_lds(lds);
    const int tid = opq_tid(wv), lane = tid & 63, wave = __builtin_amdgcn_readfirstlane(tid >> 6), G = opq_g(), bx = opq_bx();
    const int gw = bx * NWAVES + wave, NGW = G * NWAVES;
    unsigned char* ws = arg_ws(lds);
    LAS float* scr = (LAS float*)(lds + wave * 16384);
    constexpr int I_UP = 32 * 176, I_DN = 88 * 64, I_IN = 32 * 177, I_OUT = 32 * 64, I_C1 = 64 * 16, I_Z = 928;
    constexpr int I_FFN = 2 * I_UP + I_DN, I_LAYER = 2 * I_FFN + I_IN + I_OUT + 2 * I_C1 + I_Z;
#pragma unroll 1
    for (int it = gw; it < DEPTH * I_LAYER; it += NGW) {
        const int l = it / I_LAYER; int r = it - l * I_LAYER;
        if (r < 2 * I_FFN) { const int half = r >= I_FFN; r -= half * I_FFN;
            bf16_t* WUP = (bf16_t*)(ws + WS_WUP + (size_t)(l * 2 + half) * SZ_WUP); bf16_t* WDN = (bf16_t*)(ws + WS_WDN + (size_t)(l * 2 + half) * SZ_WDN);
            const float* gn = arg_in(lds, half ? I_F2N : I_F1N) + (size_t)l * DM;
            if (r < I_UP) { transpose_item(arg_in(lds, half ? I_F2W1 : I_F1W1) + (size_t)l * DM * DFF, DM, DFF, WUP, 1, 0, scr, r, lane, gn); continue; } r -= I_UP;
            if (r < I_UP) { transpose_item(arg_in(lds, half ? I_F2W3 : I_F1W3) + (size_t)l * DM * DFF, DM, DFF, WUP, 1, 128, scr, r, lane, gn); continue; } r -= I_UP;
            transpose_item(arg_in(lds, half ? I_F2W2 : I_F1W2) + (size_t)l * DFF * DM, DFF, DM, WDN, 0, 0, scr, r, lane, nullptr); continue; }
        r -= 2 * I_FFN;
        bf16_t* WIN = (bf16_t*)(ws + WS_WIN + (size_t)l * SZ_WIN); bf16_t* WOUT = (bf16_t*)(ws + WS_WOUT + (size_t)l * SZ_WOUT); bf16_t* WC1 = (bf16_t*)(ws + WS_WC1 + (size_t)l * SZ_WC1);
        if (r < I_IN) { transpose_item(arg_in(lds, I_WIN) + (size_t)l * DM * IN_COLS, DM, IN_COLS, WIN, 0, 0, scr, r, lane, arg_in(lds, I_MIXN) + (size_t)l * DM); continue; } r -= I_IN;
        if (r < I_OUT) { transpose_item(arg_in(lds, I_WOUT) + (size_t)l * DM * DM, DM, DM, WOUT, 0, 0, scr, r, lane, nullptr); continue; } r -= I_OUT;
        if (r < I_C1) { transpose_item(arg_in(lds, I_CKW1) + (size_t)l * 4096 * 512, 4096, 512, WC1, 0, 0, scr, r, lane, nullptr); continue; } r -= I_C1;
        if (r < I_C1) { transpose_item(arg_in(lds, I_CVW1) + (size_t)l * 4096 * 512, 4096, 512, WC1, 0, 512, scr, r, lane, nullptr); continue; } r -= I_C1;
        { const int q = r * 64 + lane, kt = q / 1856, rem = q - kt * 1856; u32x4* z = (u32x4*)(WIN + ((size_t)(22 * 32 + kt) * 256 + 24) * 64) + rem; unsigned zr = 0u; asm volatile("" : "+v"(zr)); *z = (u32x4){zr, zr, zr, zr}; }
    }
    const float* xs = arg_in(lds, I_X); bf16_t* XB = (bf16_t*)(ws + WS_HB); float* RSTD = (float*)(ws + WS_RSTD);
    for (int m = gw; m < NTOK; m += NGW) {
        const f32x4* xr = (const f32x4*)(xs + (size_t)m * DM) + lane; f32x4 v[8]; float s = 0.f;
#pragma unroll
        for (int j = 0; j < 8; ++j) { v[j] = xr[64 * j]; s += (v[j].x * v[j].x + v[j].y * v[j].y) + (v[j].z * v[j].z + v[j].w * v[j].w); }
        s = wave_sum(s, lane);
#pragma unroll
        for (int j = 0; j < 8; ++j) { u32x2 w; w.x = cvtpk(v[j].x, v[j].y); w.y = cvtpk(v[j].z, v[j].w); *(u32x2*)(XB + kt_off(m, 256 * j + 4 * lane, DM)) = w; }
        if (lane == 0) RSTD[m] = 1.0f / sqrtf(s * (1.f / DM) + EPS);
    }
}
__device__ __forceinline__ void ph_rstd(LAS unsigned char* lds, const int wv) {
    lds = opq_lds(lds);
    const int tid = opq_tid(wv), G = opq_g(), bx = opq_bx();
    unsigned char* ws = arg_ws(lds); const float* SSQ = (const float*)(ws + WS_SSQ); float* RSTD = (float*)(ws + WS_RSTD);
    for (int m = bx * NTHR + tid; m < NTOK; m += G * NTHR) { const f32x4* p = (const f32x4*)(SSQ + (size_t)m * 32); f32x4 a = p[0];
#pragma unroll
        for (int j = 1; j < 8; ++j) a = a + p[j];
        RSTD[m] = 1.0f / sqrtf(((a.x + a.y) + (a.z + a.w)) * (1.f / DM) + EPS); }
}
__device__ __forceinline__ void ph_headnorm(LAS unsigned char* lds, int l, const int wv) {
    lds = opq_lds(lds);
    const int tid = opq_tid(wv), lane = tid & 63, wave = __builtin_amdgcn_readfirstlane(tid >> 6), G = opq_g(), bx = opq_bx();
    const int gw = bx * NWAVES + wave, NGW = G * NWAVES;
    unsigned char* ws = arg_ws(lds); bf16_t* HP = (bf16_t*)(ws + WS_HP); bf16_t* ACMP = (bf16_t*)(ws + WS_ACMP);
    const float* qna = arg_in(lds, I_QNA) + l * HD; const float* kna = arg_in(lds, I_KNA) + l * HD; const float* qnn = arg_in(lds, I_QNN) + l * HD; const float* knn = arg_in(lds, I_KNN) + l * HD;
    const float* pos = arg_in(lds, I_POS) + (size_t)l * 32 * HD;
    const int e0 = (lane & 15) * 8;
    for (int m = gw; m < NTOK; m += NGW) {
        bf16_t* prow = HP + (size_t)m * PC;
        int cols[3]; u32x4 wl[3];
#pragma unroll
        for (int ch = 0; ch < 3; ++ch) { cols[ch] = (ch < 2) ? C_KA + ch * 512 + lane * 8 : (lane < 32 ? C_KS + lane * 8 : C_KW + (lane - 32) * 8);
            wl[ch] = *(const u32x4*)(prow + cols[ch]); }
        const u32x4 wcv = *(const u32x4*)(prow + C_KC + lane * 8);
#pragma unroll
        for (int ch = 0; ch < 3; ++ch) {
            const float* gp = (ch < 2) ? kna : knn; const float sc = 1.f;
            const u32x4 w = wl[ch];
            float v[8] = {bflo(w.x), bfhi(w.x), bflo(w.y), bfhi(w.y), bflo(w.z), bfhi(w.z), bflo(w.w), bfhi(w.w)};
            float s = 0.f;
#pragma unroll
            for (int i = 0; i < 8; ++i) s += v[i] * v[i];
            s += shx(s, 1, lane); s += shx(s, 2, lane); s += shx(s, 4, lane); s += shx(s, 8, lane);
            const float rs = sc / sqrtf(s * (1.f / HD) + EPS);
            const f32x4 g0 = *(const f32x4*)(gp + e0), g1 = *(const f32x4*)(gp + e0 + 4);
            u32x4 o; o.x = cvtpk(v[0] * rs * g0.x, v[1] * rs * g0.y); o.y = cvtpk(v[2] * rs * g0.z, v[3] * rs * g0.w); o.z = cvtpk(v[4] * rs * g1.x, v[5] * rs * g1.y); o.w = cvtpk(v[6] * rs * g1.z, v[7] * rs * g1.w);
            *(u32x4*)(prow + cols[ch]) = o;
        }
        { const int b = m / SEQ, t = m % SEQ, kv = lane >> 5, gg = (lane >> 4) & 1, c1 = t >> 4, j1 = t & 15;
          const u32x4 w = wcv;
          const float v[8] = {bflo(w.x), bfhi(w.x), bflo(w.y), bfhi(w.y), bflo(w.z), bfhi(w.z), bflo(w.w), bfhi(w.w)};
          const int arow0 = kv * 4096 + (b * 2 + gg) * 512;
          if (c1 <= 510) { const f32x4 p0 = *(const f32x4*)(pos + j1 * HD + e0), p1 = *(const f32x4*)(pos + j1 * HD + e0 + 4);
              u32x4 o; o.x = cvtpk(v[0] + p0.x, v[1] + p0.y); o.y = cvtpk(v[2] + p0.z, v[3] + p0.w); o.z = cvtpk(v[4] + p1.x, v[5] + p1.y); o.w = cvtpk(v[6] + p1.z, v[7] + p1.w);
              *(u32x4*)(ACMP + kt_off(arow0 + c1, j1 * HD + e0, 4096)) = o; }
          else { const u32x4 z = {0u, 0u, 0u, 0u}; *(u32x4*)(ACMP + kt_off(arow0 + 511, j1 * HD + e0, 4096)) = z; *(u32x4*)(ACMP + kt_off(arow0 + 511, (j1 + 16) * HD + e0, 4096)) = z; }
          if (c1 >= 1) { const int j2 = j1 + 16; const f32x4 p0 = *(const f32x4*)(pos + j2 * HD + e0), p1 = *(const f32x4*)(pos + j2 * HD + e0 + 4);
              u32x4 o; o.x = cvtpk(v[0] + p0.x, v[1] + p0.y); o.y = cvtpk(v[2] + p0.z, v[3] + p0.w); o.z = cvtpk(v[4] + p1.x, v[5] + p1.y); o.w = cvtpk(v[6] + p1.z, v[7] + p1.w);
              *(u32x4*)(ACMP + kt_off(arow0 + c1 - 1, j2 * HD + e0, 4096)) = o; } }
    }
}
__device__ __forceinline__ float gelu_tanh(float v) { const float u3 = 0.7978845608028654f * (v + 0.044715f * v * v * v); return 0.5f * v * (2.0f - 2.0f / (__expf(2.0f * u3) + 1.0f)); }
__device__ __forceinline__ void ph_cmp2(LAS unsigned char* lds, int l, const int wv) {
    lds = opq_lds(lds);
    const int tid = opq_tid(wv), lane = tid & 63, wave = __builtin_amdgcn_readfirstlane(tid >> 6), G = opq_g(), bx = opq_bx();
    unsigned char* ws = arg_ws(lds); const float* CP = (const float*)(ws + WS_CP);
    LAS float* CH = (LAS float*)lds;
    LAS float* RED = (LAS float*)(lds + 65536);
    const float* knn = arg_in(lds, I_KNN) + l * HD;
    for (int it = bx; it < 256; it += G) {
        const int R0 = it * 32, kv = R0 >> 12, rl0 = R0 & 4095;
        __syncthreads();
        for (int i4 = tid; i4 < 32 * 128; i4 += NTHR) { const int rr = i4 >> 7, k4 = (i4 & 127) * 4; f32x4 v = {0.f, 0.f, 0.f, 0.f};
#pragma unroll
            for (int ks = 0; ks < 4; ++ks) v = v + *(const f32x4*)(CP + ((size_t)(kv * 4 + ks) * 4096 + rl0 + rr) * 512 + k4);
            f32x4 o; o.x = gelu_tanh(v.x); o.y = gelu_tanh(v.y); o.z = gelu_tanh(v.z); o.w = gelu_tanh(v.w);
            *(LAS f32x4*)(CH + rr * 512 + k4) = o; }
        __syncthreads();
        const int n = tid & 127, rq = tid >> 7;
        const float* w2 = arg_in(lds, kv ? I_CVW2 : I_CKW2) + (size_t)l * 512 * HD + n;
        float acc[8];
#pragma unroll
        for (int i = 0; i < 8; ++i) acc[i] = 0.f;
#pragma unroll 4
        for (int k = 0; k < 512; k += 4) { const float w0 = w2[(size_t)k * HD], w1 = w2[(size_t)(k + 1) * HD], w2v = w2[(size_t)(k + 2) * HD], w3 = w2[(size_t)(k + 3) * HD];
#pragma unroll
            for (int i = 0; i < 8; ++i) { const f32x4 c = *(const LAS f32x4*)(CH + (rq * 8 + i) * 512 + k); acc[i] += (c.x * w0 + c.y * w1) + (c.z * w2v + c.w * w3); } }
        if (kv == 0) {
            float ss[8];
#pragma unroll
            for (int i = 0; i < 8; ++i) ss[i] = wave_sum(acc[i] * acc[i], lane);
            if (lane == 0) {
#pragma unroll
                for (int i = 0; i < 8; ++i) RED[wave * 8 + i] = ss[i]; }
            __syncthreads();
            const float gn = knn[n];
#pragma unroll
            for (int i = 0; i < 8; ++i) { const float tot = RED[(2 * rq) * 8 + i] + RED[(2 * rq + 1) * 8 + i]; acc[i] = acc[i] / sqrtf(tot * (1.f / HD) + EPS) * gn; }
        }
        bf16_t* dst = (bf16_t*)(ws + (kv ? WS_VC + 0 : WS_KC + 0)) + (size_t)(rl0 + rq * 8) * HD + n;
#pragma unroll
        for (int i = 0; i < 8; ++i) dst[(size_t)i * HD] = (bf16_t)f2bf(acc[i]);
    }
}
__device__ __forceinline__ void ph_outnorm(LAS unsigned char* lds, int l, const int wv) {
    lds = opq_lds(lds);
    const int tid = opq_tid(wv), lane = tid & 63, wave = __builtin_amdgcn_readfirstlane(tid >> 6), G = opq_g(), bx = opq_bx();
    const int gw = bx * NWAVES + wave, NGW = G * NWAVES;
    unsigned char* ws = arg_ws(lds); const bf16_t* OA = (const bf16_t*)(ws + WS_OA); const bf16_t* ON = (const bf16_t*)(ws + WS_ON); bf16_t* HB = (bf16_t*)(ws + WS_HP);
    const float* gn = arg_in(lds, I_ON) + (size_t)l * DM;
    for (int m = gw; m < NTOK; m += NGW) {
        const bf16_t* oa = OA + (size_t)m * 1024; bf16_t* y = HB;
        const u32x4 wa = *(const u32x4*)(oa + lane * 8), wb = *(const u32x4*)(oa + 512 + lane * 8);
        u32x4 wn[6];
#pragma unroll
        for (int br = 0; br < 3; ++br) { const bf16_t* onb = ON + ((size_t)br * NTOK + m) * 1024; wn[2 * br] = *(const u32x4*)(onb + lane * 8); wn[2 * br + 1] = *(const u32x4*)(onb + 512 + lane * 8); }
        float va[16] = {bflo(wa.x), bfhi(wa.x), bflo(wa.y), bfhi(wa.y), bflo(wa.z), bfhi(wa.z), bflo(wa.w), bfhi(wa.w), bflo(wb.x), bfhi(wb.x), bflo(wb.y), bfhi(wb.y), bflo(wb.z), bfhi(wb.z), bflo(wb.w), bfhi(wb.w)};
        float sa = 0.f;
#pragma unroll
        for (int i = 0; i < 16; ++i) sa += va[i] * va[i];
        float vs[16]; float sn = 0.f;
#pragma unroll
        for (int i = 0; i < 16; ++i) vs[i] = 0.f;
#pragma unroll
        for (int br = 0; br < 3; ++br) { const u32x4 wc = wn[2 * br], wd = wn[2 * br + 1];
            vs[0] += bflo(wc.x); vs[1] += bfhi(wc.x); vs[2] += bflo(wc.y); vs[3] += bfhi(wc.y); vs[4] += bflo(wc.z); vs[5] += bfhi(wc.z); vs[6] += bflo(wc.w); vs[7] += bfhi(wc.w);
            vs[8] += bflo(wd.x); vs[9] += bfhi(wd.x); vs[10] += bflo(wd.y); vs[11] += bfhi(wd.y); vs[12] += bflo(wd.z); vs[13] += bfhi(wd.z); vs[14] += bflo(wd.w); vs[15] += bfhi(wd.w); }
        const float ra = 1.0f / sqrtf(wave_sum(sa, lane) * (1.f / 1024.f) + EPS);
        { const f32x4 g0 = *(const f32x4*)(gn + lane * 8), g1 = *(const f32x4*)(gn + lane * 8 + 4), g2 = *(const f32x4*)(gn + 512 + lane * 8), g3 = *(const f32x4*)(gn + 512 + lane * 8 + 4);
          u32x4 o; o.x = cvtpk(va[0] * ra * g0.x, va[1] * ra * g0.y); o.y = cvtpk(va[2] * ra * g0.z, va[3] * ra * g0.w); o.z = cvtpk(va[4] * ra * g1.x, va[5] * ra * g1.y); o.w = cvtpk(va[6] * ra * g1.z, va[7] * ra * g1.w);
          *(u32x4*)(y + kt_off(m, lane * 8, DM)) = o;
          o.x = cvtpk(va[8] * ra * g2.x, va[9] * ra * g2.y); o.y = cvtpk(va[10] * ra * g2.z, va[11] * ra * g2.w); o.z = cvtpk(va[12] * ra * g3.x, va[13] * ra * g3.y); o.w = cvtpk(va[14] * ra * g3.z, va[15] * ra * g3.w);
          *(u32x4*)(y + kt_off(m, 512 + lane * 8, DM)) = o; }
#pragma unroll
        for (int i = 0; i < 16; ++i) sn += vs[i] * vs[i];
        const float rn = 1.0f / sqrtf(wave_sum(sn, lane) * (1.f / 1024.f) + EPS);
        { const float* g2 = gn + 1024; const f32x4 g0 = *(const f32x4*)(g2 + lane * 8), g1 = *(const f32x4*)(g2 + lane * 8 + 4), g2a = *(const f32x4*)(g2 + 512 + lane * 8), g3 = *(const f32x4*)(g2 + 512 + lane * 8 + 4);
          u32x4 o; o.x = cvtpk(vs[0] * rn * g0.x, vs[1] * rn * g0.y); o.y = cvtpk(vs[2] * rn * g0.z, vs[3] * rn * g0.w); o.z = cvtpk(vs[4] * rn * g1.x, vs[5] * rn * g1.y); o.w = cvtpk(vs[6] * rn * g1.z, vs[7] * rn * g1.w);
          *(u32x4*)(y + kt_off(m, 1024 + lane * 8, DM)) = o;
          o.x = cvtpk(vs[8] * rn * g2a.x, vs[9] * rn * g2a.y); o.y = cvtpk(vs[10] * rn * g2a.z, vs[11] * rn * g2a.w); o.z = cvtpk(vs[12] * rn * g3.x, vs[13] * rn * g3.y); o.w = cvtpk(vs[14] * rn * g3.z, vs[15] * rn * g3.w);
          *(u32x4*)(y + kt_off(m, 1536 + lane * 8, DM)) = o; }
    }
}

#define GRID_BAR() do { XcdBarrier bar_; bar_.bar = (unsigned*)(arg_ws(lds) + WS_CTL) + CW_BAR; bar_.x = xb_xcc_id(); bar_.st = (volatile LAS unsigned*)(opq_lds(lds) + LDS_MISC + 32); xcd_barrier(bar_, wv); } while (0)
__global__ void __launch_bounds__(NTHR, 2) mega_fwd(Args a) {
    extern __shared__ __attribute__((aligned(16))) unsigned char lds_raw[];
    LAS unsigned char* lds = (LAS unsigned char*)lds_raw;
    const int wv = __builtin_amdgcn_readfirstlane((int)threadIdx.x >> 6);
    {
        const int tid = threadIdx.x;
        for (int u = tid; u < (LDS_BYTES - LDS_MISC) / 4; u += NTHR) ((LAS unsigned*)(lds + LDS_MISC))[u] = 0u;
        __syncthreads();
        if (tid == 0) { LAS unsigned long long* t = (LAS unsigned long long*)(lds + LDS_ARGS);
#pragma unroll
            for (int i = 0; i < 24; ++i) t[i] = (unsigned long long)(uintptr_t)a.in[i];
            t[24] = (unsigned long long)(uintptr_t)a.out; t[25] = (unsigned long long)(uintptr_t)a.ws; }
        __syncthreads();
    }
    (void)xcd_barrier_post((unsigned*)(arg_ws(lds) + WS_CTL) + CW_BAR, (volatile LAS unsigned*)(lds + LDS_MISC + 32));

    { const int tid = opq_tid(wv), G = opq_g(), bx = opq_bx(); const float* rb = arg_in(lds, I_RB); unsigned char* ws = arg_ws(lds);
      float* dilT = (float*)(ws + WS_TBL); float* nsaT = (float*)(ws + WS_TBL + 65536);
      for (int i = bx * NTHR + tid; i < 3 * 8 * DTS + 8 * TBLS; i += G * NTHR) {
          if (i < 3 * 8 * DTS) { const int p = i / (8 * DTS), h = (i / DTS) % 8, df = i % DTS - DT0; const int d = (p == 0) ? 1 : (p == 1 ? 4 : 16);
              dilT[i] = (df >= 0 && df <= 128) ? rb[rel_bucket_dev(df * d) * 16 + h] : 0.f; }
          else { const int j = i - 3 * 8 * DTS, hh = j / TBLS, ds = j % TBLS - TBL0; nsaT[j] = (ds >= 0) ? rb[rel_bucket_dev(ds) * 16 + 8 + hh] : 0.f; } } }

    ph_prologue(lds, wv);
    GRID_BAR();
#pragma unroll 1
    for (int step = 0; step < 2 * DEPTH; ++step) {
        const int l = step >> 1, half = step & 1;
        { unsigned char* ws = arg_ws(lds); const int G = opq_g(), bx = opq_bx();
          pg8::Gemm g{64, 64, DM}; pg8::SchedStd S; S.init(ws + WS_HB, ws + WS_WUP + (size_t)step * SZ_WUP, NTOK, 2 * DFF, DM, DM, G, bx); const pg8::EpiSwiGLU E{(bf16_t*)(ws + WS_HP), DFF, (const float*)(ws + WS_RSTD)};
          pg8::gemm_phase<pg8::EpiSwiGLU, pg8::SchedStd, 32768, 32768>(opq_lds(lds), g, S, E, wv);
        }
        GRID_BAR();
        { unsigned char* ws = arg_ws(lds); const int G = opq_g(), bx = opq_bx(); float* X = arg_out(lds);
          pg8::Gemm g{64, 64, DFF}; pg8::SchedStd S; S.init(ws + WS_HP, ws + WS_WDN + (size_t)step * SZ_WDN, NTOK, DM, DFF, DFF, G, bx, 4);
          pg8::EpiResid E{(step == 2 * DEPTH - 1) ? X : (float*)nullptr, (bf16_t*)(ws + WS_HB), (float*)(ws + WS_SSQ), DM, 0.5f};
          pg8::gemm_phase<pg8::EpiResid, pg8::SchedStd, 32768, 32768>(opq_lds(lds), g, S, E, wv);
        }
        GRID_BAR();
        ph_rstd(lds, wv);
        GRID_BAR();
        if (half == 0) {
            { unsigned char* ws = arg_ws(lds); const int G = opq_g(), bx = opq_bx();
              pg8::Gemm g{64, 64, DM}; pg8::SchedStd S; S.init(ws + WS_HB, ws + WS_WIN + (size_t)l * SZ_WIN, NTOK, PC, DM, DM, G, bx); const pg8::EpiBf16 E{(bf16_t*)(ws + WS_HP), PC, (const float*)(ws + WS_RSTD)};
              pg8::gemm_phase<pg8::EpiBf16, pg8::SchedStd, 32768, 32768>(opq_lds(lds), g, S, E, wv);
            }
            GRID_BAR();
            ph_headnorm(lds, l, wv);
            GRID_BAR();
#pragma unroll 1
            for (int pat3 = 0; pat3 < 3; ++pat3) { const int pat = pat3 % 3;
                if (pat3 == 0) { unsigned char* ws = arg_ws(lds); const int G = opq_g(), bx = opq_bx();
                  pg8::Gemm g{64, 64, 1024}; pg8::SchedCmp S; S.A = (const char*)(ws + WS_ACMP); S.Bt = (const char*)(ws + WS_WC1 + (size_t)l * SZ_WC1); S.G = G; S.c = bx; pg8::EpiF32Z E{(float*)(ws + WS_CP), 512, (size_t)4096 * 512};
                  pg8::gemm_phase<pg8::EpiF32Z, pg8::SchedCmp, 32768, 32768>(opq_lds(lds), g, S, E, wv); }
                if (pat3 == 1) ph_cmp2(lds, l, wv);
                { unsigned char* ws = arg_ws(lds); const int G = opq_g(), bx = opq_bx();
                  for (int u0 = bx; u0 < 1024; u0 += G) { const int w_ = u0 & 255, k_ = u0 >> 8; const int unit = (((w_ & 7) + 8 * k_) << 5) | (w_ >> 3);
                    dil_unit((LAS char*)opq_lds(lds), (const bf16_t*)(ws + WS_HP), (bf16_t*)(ws + WS_OA), (float*)(ws + WS_LSE), (const float*)(ws + WS_TBL), arg_in(lds, I_QNA) + l * HD, pat, 2 * pat, unit, wv); } }
                if (pat3 + 1 < 3) GRID_BAR();
            }
            { unsigned char* ws = arg_ws(lds); const int G = opq_g(), bx = opq_bx();
              const float* gb = arg_in(lds, I_GB) + l * 24; const float* qgn = arg_in(lds, I_QNN) + l * HD;
              int last_bg = -1;
#pragma unroll 1
              for (int i4 = 0; i4 < 4; ++i4)
#pragma unroll 1
                  for (int w = bx; w < 256; w += G) { const int i = i4 & 3; const int bg = w & 7, j = w >> 3;
                      const int qi = (i == 0) ? 127 - j : (i == 1 ? j : (i == 2 ? 64 + j : 63 - j));
                      nsa_unit((LAS char*)opq_lds(lds), (const bf16_t*)(ws + WS_HP), (const bf16_t*)(ws + WS_KC), (const bf16_t*)(ws + WS_VC), (bf16_t*)(ws + WS_ON), (const float*)(ws + WS_TBL + 65536), gb, qgn, bg >> 1, bg & 1, qi, bg != last_bg, wv); last_bg = bg; } }
            GRID_BAR();
            ph_outnorm(lds, l, wv);
            GRID_BAR();
            { unsigned char* ws = arg_ws(lds); const int G = opq_g(), bx = opq_bx(); float* X = arg_out(lds);
              pg8::Gemm g{64, 64, DM}; pg8::SchedStd S; S.init(ws + WS_HP, ws + WS_WOUT + (size_t)l * SZ_WOUT, NTOK, DM, DM, DM, G, bx, 4); pg8::EpiResid E{(float*)nullptr, (bf16_t*)(ws + WS_HB), (float*)(ws + WS_SSQ), DM, 1.0f};
              pg8::gemm_phase<pg8::EpiResid, pg8::SchedStd, 32768, 32768>(opq_lds(lds), g, S, E, wv);
            }
            GRID_BAR();
            ph_rstd(lds, wv);
            GRID_BAR();
        }
    }
}

extern "C" void kernel_launch(void* const* d_in, const int* in_sizes, int n_in, void* d_out, int out_size, void* d_ws, size_t ws_size, hipStream_t stream) {
    static int grid = 0;
    if (grid == 0) {
        if (n_in != 24 || in_sizes[0] != NTOK * DM || out_size != NTOK * DM || ws_size < WS_END) { fprintf(stderr, "kernel_launch: shape mismatch n_in %d in0 %d out %d ws %zu (need %zu)\n", n_in, n_in > 0 ? in_sizes[0] : -1, out_size, ws_size, (size_t)WS_END); grid = -1; return; }
        int dev = 0, cus = 0, per_cu = 0;
        if (hipGetDevice(&dev) != hipSuccess || hipDeviceGetAttribute(&cus, hipDeviceAttributeMultiprocessorCount, dev) != hipSuccess) { grid = -1; return; }
        if (hipFuncSetAttribute((const void*)mega_fwd, hipFuncAttributeMaxDynamicSharedMemorySize, LDS_BYTES) != hipSuccess) { fprintf(stderr, "kernel_launch: hipFuncSetAttribute failed\n"); grid = -1; return; }
        if (hipOccupancyMaxActiveBlocksPerMultiprocessor(&per_cu, (const void*)mega_fwd, NTHR, LDS_BYTES) != hipSuccess || per_cu < 1) { fprintf(stderr, "kernel_launch: occupancy query says %d\n", per_cu); (void)hipGetLastError(); if (per_cu < 1) { grid = -1; return; } }
        grid = cus;
    }
    if (grid < 0) return;
    if (hipMemsetAsync((char*)d_ws + WS_CTL, 0, CTL_ZERO_BYTES, stream) != hipSuccess) return;
    Args a{};
    for (int i = 0; i < 24; ++i) a.in[i] = (const float*)d_in[i];
    a.out = (float*)d_out; a.ws = (unsigned char*)d_ws;
    hipLaunchKernelGGL(mega_fwd, dim3(grid), dim3(NTHR), LDS_BYTES, stream, a);
    const hipError_t le = hipPeekAtLastError();
    if (le != hipSuccess) fprintf(stderr, "kernel_launch: launch failed: %s\n", hipGetErrorName(le));
}
```

```cpp
#include <hip/hip_runtime.h>
#include <cstdio>
#include <cstdint>

#define LAS __attribute__((address_space(3)))
typedef unsigned short bf16_t;
typedef short bf16x8 __attribute__((ext_vector_type(8)));
typedef short s16x4 __attribute__((ext_vector_type(4)));
typedef float f32x2 __attribute__((ext_vector_type(2)));
typedef float f32x4 __attribute__((ext_vector_type(4)));
typedef float f32x16 __attribute__((ext_vector_type(16)));
typedef unsigned u32x2 __attribute__((ext_vector_type(2)));
typedef unsigned u32x4 __attribute__((ext_vector_type(4)));

constexpr int BATCH = 4, SEQ = 8192, DM = 2048, DFF = 5632, NTOK = BATCH * SEQ, DEPTH = 4, HD = 128;
constexpr int IN_COLS = 5656, PC = 5888;
constexpr int C_QA = 0, C_KA = 1024, C_VA = 2048, C_QN = 3072, C_KC = 4096, C_VC = 4352, C_KS = 4608, C_VS = 4864, C_KW = 5120, C_VW = 5376, C_GL = 5632;
constexpr float EPS = 1e-6f, QSCALE = 0.08838834764831845f, LOG2E = 1.4426950408889634f;
constexpr int TBLS = 1704, TBL0 = 64;
constexpr int DTS = 320, DT0 = 96;
constexpr int NWAVES = 8, NTHR = 512;

constexpr size_t MiB = 1u << 20;
constexpr size_t WS_CTL = 0, CTL_ZERO_BYTES = 1 * MiB;
constexpr size_t WS_TBL = 1 * MiB;
constexpr size_t SZ_WUP = 44 * MiB, SZ_WDN = 22 * MiB, SZ_WIN = 23 * MiB, SZ_WOUT = 8 * MiB, SZ_WC1 = 8 * MiB;
constexpr size_t WS_WUP = 2 * MiB;
constexpr size_t WS_WDN = WS_WUP + 8 * SZ_WUP;
constexpr size_t WS_WIN = WS_WDN + 8 * SZ_WDN;
constexpr size_t WS_WOUT = WS_WIN + 4 * SZ_WIN;
constexpr size_t WS_WC1 = WS_WOUT + 4 * SZ_WOUT;
constexpr size_t WS_HB = WS_WC1 + 4 * SZ_WC1;
constexpr size_t WS_HP = WS_HB + 128 * MiB;
constexpr size_t WS_OA = WS_HP + 368 * MiB;
constexpr size_t WS_LSE = WS_OA + 64 * MiB;
constexpr size_t WS_ON = WS_LSE + 1 * MiB;
constexpr size_t WS_ACMP = WS_ON + 192 * MiB;
constexpr size_t WS_CP = WS_ACMP + 64 * MiB;
constexpr size_t WS_KC = WS_CP + 64 * MiB;
constexpr size_t WS_VC = WS_KC + 1 * MiB;
constexpr size_t WS_SSQ = WS_VC + 1 * MiB;
constexpr size_t WS_RSTD = WS_SSQ + 4 * MiB;
constexpr size_t WS_END = WS_RSTD + 1 * MiB;
constexpr int CW_BAR = 4096;

__device__ __forceinline__ unsigned f2bf(float f) { unsigned u = __builtin_bit_cast(unsigned, f); return (u + 0x7fffu + ((u >> 16) & 1u)) >> 16; }
__device__ __forceinline__ unsigned pk2(float lo, float hi) { return f2bf(lo) | (f2bf(hi) << 16); }
__device__ __forceinline__ float bf2f(bf16_t b) { return __builtin_bit_cast(float, ((unsigned)b) << 16); }
__device__ __forceinline__ float bflo(unsigned w) { return __builtin_bit_cast(float, w << 16); }
__device__ __forceinline__ float bfhi(unsigned w) { return __builtin_bit_cast(float, w & 0xffff0000u); }
__device__ __forceinline__ unsigned cvtpk(float lo, float hi) { unsigned r; asm volatile("v_cvt_pk_bf16_f32 %0, %1, %2" : "=v"(r) : "v"(lo), "v"(hi)); return r; }
__device__ __forceinline__ float shx(float v, int m, int lane) { return __builtin_bit_cast(float, __builtin_amdgcn_ds_bpermute((lane ^ m) << 2, __builtin_bit_cast(int, v))); }
__device__ __forceinline__ float wave_sum(float v, int lane) {
#pragma unroll
    for (int o = 1; o < 64; o <<= 1) v += shx(v, o, lane);
    return v;
}
__device__ __forceinline__ LAS unsigned char* opq_lds(LAS unsigned char* p) { unsigned a = (unsigned)(uintptr_t)p; asm volatile("" : "+s"(a)); return (LAS unsigned char*)(uintptr_t)a; }
__device__ __forceinline__ int opq_tid(int wv) { int l; asm volatile("v_mbcnt_lo_u32_b32 %0, -1, 0\n\tv_mbcnt_hi_u32_b32 %0, -1, %0" : "=v"(l)); return wv * 64 + l; }
__device__ __forceinline__ size_t kt_off(int r, int k, int K) { return (((size_t)(r >> 8) * (K >> 6) + (k >> 6)) * 256 + (r & 255)) * 64 + (k & 63); }
#define LDS_WAIT() asm volatile("s_waitcnt lgkmcnt(0)" ::: "memory")
#define VM_WAIT() asm volatile("s_waitcnt vmcnt(0)" ::: "memory")
#define SBAR() __builtin_amdgcn_sched_barrier(0)

#define XB_TMO      128
#define XB_XCNT(j)  (256  + 64 * (j))
#define XB_XSUB(j)  (1280 + 64 * (j))
#define XB_XGEN(j)  (2304 + 64 * (j))
#define XB_TOP      3328
#define XB_TOPGEN   3392
#define XCD_BAR_WORDS 3456
#define XB_SPIN_CAP (1u << 18)
__device__ __forceinline__ unsigned xb_ld(unsigned* p)              { return __hip_atomic_load(p, __ATOMIC_RELAXED, __HIP_MEMORY_SCOPE_AGENT); }
__device__ __forceinline__ unsigned xb_add(unsigned* p, unsigned v) { return __hip_atomic_fetch_add(p, v, __ATOMIC_RELAXED, __HIP_MEMORY_SCOPE_AGENT); }
__device__ __forceinline__ unsigned xb_xcc_id() { return (unsigned)__builtin_amdgcn_s_getreg((3 << 11) | 20) & 0xFu; }
#define XB_SPIN(cond, bar) do { unsigned _sp = 0; while (cond) { __builtin_amdgcn_s_sleep(1); \
    if ((++_sp & 255u) == 0u) { if (xb_ld(&(bar)[XB_TMO])) break; if (_sp > XB_SPIN_CAP) { atomicAdd(&(bar)[XB_TMO], 1u); break; } } } } while (0)
struct XcdBarrier { unsigned* bar; unsigned x; volatile LAS unsigned* st; };
__device__ __forceinline__ XcdBarrier xcd_barrier_post(unsigned* bar, volatile LAS unsigned* st) {
    XcdBarrier b; b.bar = bar; b.x = xb_xcc_id(); b.st = st;
    if (threadIdx.x == 0) (void)xb_add(&bar[XB_XCNT(b.x)], 1u);
    return b;
}
__device__ __forceinline__ void xcd_barrier_complete(unsigned* bar, unsigned x, unsigned& nloc, unsigned& nx) {
    const unsigned G = gridDim.x * gridDim.y * gridDim.z;
    unsigned sum, cnt, mine, sp = 0u;
    for (;;) {
        sum = 0u; cnt = 0u; mine = 0u;
#pragma unroll
        for (unsigned j = 0; j < 16; ++j) { const unsigned c = xb_ld(&bar[XB_XCNT(j)]); sum += c; cnt += (c > 0u) ? 1u : 0u; mine = (j == x) ? c : mine; }
        if (sum == G) break;
        __builtin_amdgcn_s_sleep(1);
        if ((++sp & 255u) == 0u) { if (xb_ld(&bar[XB_TMO])) break; if (sp > XB_SPIN_CAP) { atomicAdd(&bar[XB_TMO], 1u); break; } }
    }
    nloc = mine > 0u ? mine : 1u; nx = cnt > 0u ? cnt : 1u;
}
__device__ __forceinline__ void xcd_barrier(const XcdBarrier& b, const int wv) {
    asm volatile("s_waitcnt vmcnt(0)" ::: "memory");
    __syncthreads();
    if (opq_tid(wv) == 0) {
        unsigned* bar = b.bar; asm volatile("" : "+s"(bar));
        __builtin_amdgcn_s_waitcnt(0);
        unsigned nloc = b.st[0], nx = b.st[1];
        if (nloc == 0u) { xcd_barrier_complete(bar, b.x, nloc, nx); b.st[0] = nloc; b.st[1] = nx; }
        const unsigned old = xb_add(&bar[XB_XSUB(b.x)], 1u);
        const unsigned gen = old / nloc;
        if (old + 1u == (gen + 1u) * nloc) {
            __builtin_amdgcn_fence(__ATOMIC_RELEASE, "agent");
            asm volatile("s_waitcnt vmcnt(0)" ::: "memory");
            const unsigned og = xb_add(&bar[XB_TOP], 1u);
            const unsigned tg = og / nx;
            if (og + 1u == (tg + 1u) * nx) xb_add(&bar[XB_TOPGEN], 1u);
            else XB_SPIN(xb_ld(&bar[XB_TOPGEN]) == tg, bar);
            __builtin_amdgcn_fence(__ATOMIC_ACQUIRE, "agent");
            xb_add(&bar[XB_XGEN(b.x)], 1u);
            asm volatile("s_waitcnt vmcnt(0)" ::: "memory");
        } else {
            XB_SPIN(xb_ld(&bar[XB_XGEN(b.x)]) == gen, bar);
            __builtin_amdgcn_fence(__ATOMIC_ACQUIRE, "agent");
            asm volatile("s_waitcnt vmcnt(0)" ::: "memory");
        }
    }
    __syncthreads();
}

namespace pg8 {
constexpr int BM = 256, BK = 64, HALF = 128, HTB = HALF * BK * 2, STAGE_BYTES = 8 * HTB, NXCD = 8, WGM = 8;
__host__ __device__ __forceinline__ int lds_byte(int r, int c) { const int st = (r >> 4) * 2 + (c >> 5), rr = r & 15, cc = c & 31, ob = rr * 64 + cc * 2; return st * 1024 + (ob ^ (((ob >> 9) & 1) << 5)); }
__host__ __device__ __forceinline__ void stage_rc(int b, int& R, int& C) { const int st = b / 1024, sb = b % 1024, swz = sb ^ (((sb >> 9) & 1) << 5); R = (st >> 1) * 16 + swz / 64; C = (st & 1) * 32 + (swz % 64) / 2; }
__host__ __device__ __forceinline__ int perm32(int rho) { const int n = rho >> 4, i = rho & 15; return 8 * (i >> 2) + 4 * n + (i & 3); }
struct Unit { int pm, pn, z; };
struct Gemm { int lda, ldb, K; };
struct SchedStd {
    const char* A; const char* Bt; size_t atile, btile; int nM, nN, nwg, G, c, wgm;
    __device__ __forceinline__ void init(const void* A_, const void* Bt_, int M, int N, int lda, int ldb, int G_, int c_, int wgm_ = WGM) { wgm = wgm_;
        A = (const char*)A_; Bt = (const char*)Bt_; atile = (size_t)BM * lda * 2; btile = (size_t)BM * ldb * 2; nM = M / BM; nN = N / BM; nwg = nM * nN; G = G_; c = c_; }
    __device__ __forceinline__ bool next(int i, Unit& u) const {
        const long L = (long)i * G + c; if (L >= nwg) return false;
        int wgid = (int)L; { const int q = nwg / NXCD, r = nwg % NXCD, xcd = wgid % NXCD, off = wgid / NXCD; wgid = (xcd < r ? xcd * (q + 1) : r * (q + 1) + (xcd - r) * q) + off; }
        const int nig = wgm * nN, gid = wgid / nig, fm = gid * wgm, gsz = (nM - fm) < wgm ? (nM - fm) : wgm;
        u.pm = fm + ((wgid % nig) % gsz); u.pn = (wgid % nig) / gsz; u.z = 0; return true;
    }
    __device__ __forceinline__ const char* a_ptr(const Unit& u) const { return A + (size_t)u.pm * atile; }
    __device__ __forceinline__ const char* b_ptr(const Unit& u) const { return Bt + (size_t)u.pn * btile; }
};
struct SchedCmp {
    const char* A; const char* Bt; int G, c;
    __device__ __forceinline__ bool next(int i, Unit& u) const { const int L = i * G + c; if (L >= 256) return false; u.z = L >> 5; u.pm = (L & 31) >> 1; u.pn = L & 1; return true; }
    __device__ __forceinline__ const char* a_ptr(const Unit& u) const { const int kv = u.z >> 2, ks = u.z & 3; return A + ((size_t)(kv * 16 + u.pm) * 64 + (size_t)ks * 16) * 32768; }
    __device__ __forceinline__ const char* b_ptr(const Unit& u) const { const int kv = u.z >> 2, ks = u.z & 3; return Bt + ((size_t)(kv * 2 + u.pn) * 64 + (size_t)ks * 16) * 32768; }
};
struct EpiBf16 {
    static constexpr bool PERM = true;
    bf16_t* O; int ldc; const float* rstd;
    __device__ __forceinline__ void prefetch(float (&pre)[8], const Unit& u, int wr, int fr) const {
#pragma unroll
        for (int i = 0; i < 8; ++i) pre[i] = rstd[u.pm * BM + wr * 64 + fr + (i >> 2) * HALF + (i & 3) * 16]; }
    __device__ __forceinline__ void operator()(const f32x4 (&acc)[2][2][4][2], const Unit& u, int wr, int wc, int fr, int fq, const float (&pre)[8]) const {
        const int row0 = u.pm * BM + wr * 64 + fr, col0 = u.pn * BM + wc * 32 + 8 * fq;
#pragma unroll
        for (int ai = 0; ai < 2; ++ai)
#pragma unroll
            for (int m = 0; m < 4; ++m) { bf16_t* rowp = O + (size_t)(row0 + ai * HALF + m * 16) * ldc + col0; const float rs = pre[ai * 4 + m];
#pragma unroll
                for (int bj = 0; bj < 2; ++bj) { const f32x4 v0 = acc[ai][bj][m][0] * rs, v1 = acc[ai][bj][m][1] * rs;
                    u32x4 w; w.x = cvtpk(v0[0], v0[1]); w.y = cvtpk(v0[2], v0[3]); w.z = cvtpk(v1[0], v1[1]); w.w = cvtpk(v1[2], v1[3]);
                    *(u32x4*)(rowp + bj * HALF) = w; } }
    }
};
struct EpiSwiGLU {
    static constexpr bool PERM = true;
    bf16_t* O; int ldc; const float* rstd;
    __device__ __forceinline__ void prefetch(float (&pre)[8], const Unit& u, int wr, int fr) const {
#pragma unroll
        for (int i = 0; i < 8; ++i) pre[i] = rstd[u.pm * BM + wr * 64 + fr + (i >> 2) * HALF + (i & 3) * 16]; }
    __device__ __forceinline__ void operator()(const f32x4 (&acc)[2][2][4][2], const Unit& u, int wr, int wc, int fr, int fq, const float (&pre)[8]) const {
        const int rowp0 = wr * 64 + fr, kt = 2 * u.pn + (wc >> 1), cit = (wc & 1) * 32 + 8 * fq;
        bf16_t* tile = O + ((size_t)u.pm * (ldc / 64) + kt) * (256 * 64) + cit;
#pragma unroll
        for (int ai = 0; ai < 2; ++ai)
#pragma unroll
            for (int m = 0; m < 4; ++m) { bf16_t* rowp = tile + (size_t)(rowp0 + ai * HALF + m * 16) * 64; const float rs = pre[ai * 4 + m];
                float v[8];
#pragma unroll
                for (int n = 0; n < 2; ++n)
#pragma unroll
                    for (int j = 0; j < 4; ++j) { const float g = acc[ai][0][m][n][j] * rs, up = acc[ai][1][m][n][j] * rs;
                        const float s = g * __builtin_amdgcn_rcpf(1.0f + __builtin_amdgcn_exp2f(-g * LOG2E)); v[n * 4 + j] = s * up; }
                u32x4 w; w.x = cvtpk(v[0], v[1]); w.y = cvtpk(v[2], v[3]); w.z = cvtpk(v[4], v[5]); w.w = cvtpk(v[6], v[7]);
                *(u32x4*)rowp = w; }
    }
};
struct EpiResid {
    static constexpr bool PERM = false;
    __device__ __forceinline__ void prefetch(float (&)[8], const Unit&, int, int) const {}
    float* out; bf16_t* xb; float* ssq; int ldc; float alpha;
    __device__ __forceinline__ void operator()(const f32x4 (&acc)[2][2][4][2], const Unit& u, int wr, int wc, int fr, int fq, const float (&pre)[8]) const {
        const int row0 = u.pm * BM + wr * 64 + fr, col0 = u.pn * BM + wc * 32 + 4 * fq;
        u32x2 bs[4][4];
#define ER_LOAD(g) do { const int row_ = row0 + ((g) >> 2) * HALF + ((g) & 3) * 16; \
        _Pragma("unroll") for (int q_ = 0; q_ < 4; ++q_) bs[(g) & 3][q_] = *(const u32x2*)(xb + kt_off(row_, col0 + (q_ >> 1) * HALF + (q_ & 1) * 16, ldc)); } while (0)
        ER_LOAD(0); ER_LOAD(1); ER_LOAD(2); ER_LOAD(3);
#pragma unroll
        for (int g = 0; g < 8; ++g) { const int ai = g >> 2, m = g & 3; const int row = row0 + ai * HALF + m * 16; float ss = 0.f;
#pragma unroll
            for (int q = 0; q < 4; ++q) { const int bj = q >> 1, n = q & 1; const u32x2 b = bs[g & 3][q];
                const f32x4 o = (f32x4){bflo(b.x), bfhi(b.x), bflo(b.y), bfhi(b.y)} + acc[ai][bj][m][n] * alpha;
                ss += (o.x * o.x + o.y * o.y) + (o.z * o.z + o.w * o.w);
                u32x2 w; w.x = cvtpk(o.x, o.y); w.y = cvtpk(o.z, o.w); *(u32x2*)(xb + kt_off(row, col0 + bj * HALF + n * 16, ldc)) = w;
                if (out) *(f32x4*)(out + (size_t)row * ldc + col0 + bj * HALF + n * 16) = o; }
            if (g + 4 < 8) ER_LOAD(g + 4);
            const int lane = fq * 16 + fr; ss += shx(ss, 16, lane); ss += shx(ss, 32, lane);
            if (fq == 0) ssq[(size_t)row * 32 + u.pn * 4 + wc] = ss; }
#undef ER_LOAD
    }
};
struct EpiF32Z {
    static constexpr bool PERM = false;
    float* C; int ldc; size_t zstride;
    __device__ __forceinline__ void prefetch(float (&)[8], const Unit&, int, int) const {}
    __device__ __forceinline__ void operator()(const f32x4 (&acc)[2][2][4][2], const Unit& u, int wr, int wc, int fr, int fq, const float (&pre)[8]) const {
        float* Cz = C + (size_t)u.z * zstride;
        const int row0 = u.pm * BM + wr * 64 + fr, col0 = u.pn * BM + wc * 32 + 4 * fq;
#pragma unroll
        for (int ai = 0; ai < 2; ++ai)
#pragma unroll
            for (int m = 0; m < 4; ++m) { float* rowp = Cz + (size_t)(row0 + ai * HALF + m * 16) * ldc + col0;
#pragma unroll
                for (int bj = 0; bj < 2; ++bj)
#pragma unroll
                    for (int n = 0; n < 2; ++n) *(f32x4*)(rowp + bj * HALF + n * 16) = acc[ai][bj][m][n]; }
    }
};

template <class Epi, class Sched, int KSTEP_A = 128, int KSTEP_B = 128>
__device__ __forceinline__ void gemm_phase(LAS unsigned char* lds, const Gemm g, const Sched& S, const Epi& E, const int wv) {
    const int tid = opq_tid(wv), wid = __builtin_amdgcn_readfirstlane(tid >> 6), lane = tid & 63, wr = wid >> 2, wc = wid & 3, fr = lane & 15, fq = lane >> 4;
    const int K = g.K, nt = K / BK;
    unsigned voffA[2], voffB[2];
#pragma unroll
    for (int i = 0; i < 2; ++i) { int R, C; stage_rc(tid * 16 + i * 8192, R, C); const int Rb = Epi::PERM ? ((R & ~31) + perm32(R & 31)) : R;
        voffA[i] = (unsigned)(R * g.lda + C) * 2u; voffB[i] = (unsigned)(Rb * g.ldb + C) * 2u; }
    constexpr size_t kstepA = (size_t)KSTEP_A, kstepB = (size_t)KSTEP_B;
    const size_t hstepA = (size_t)HALF * g.lda * 2, hstepB = (size_t)HALF * g.ldb * 2;
    const unsigned ldsw = (unsigned)wid * 1024u;
    const int aoff = lds_byte(wr * 64 + fr, fq * 8), boff = lds_byte(wc * 32 + fr, fq * 8);
#define PG8_SA(b, h) (((b) * 2 + (h)) * HTB)
#define PG8_SB(b, h) ((4 + (b) * 2 + (h)) * HTB)
#define PG8_STAGE(bufoff, gbase, voff) do { _Pragma("unroll") for (int _i = 0; _i < 2; ++_i) \
        __builtin_amdgcn_global_load_lds((const unsigned*)((const char*)(gbase) + (voff)[_i]), (LAS unsigned*)(lds + (bufoff) + ldsw + _i * 8192), 16, 0, 0); } while (0)
#define PG8_LDA(dst, b, h) do { _Pragma("unroll") for (int m = 0; m < 4; ++m) _Pragma("unroll") for (int k = 0; k < 2; ++k) dst[m][k] = *(const LAS bf16x8*)(lds + PG8_SA(b, h) + aoff + m * 2048 + k * 1024); } while (0)
#define PG8_LDB(dst, b, h) do { _Pragma("unroll") for (int n = 0; n < 2; ++n) _Pragma("unroll") for (int k = 0; k < 2; ++k) dst[n][k] = *(const LAS bf16x8*)(lds + PG8_SB(b, h) + boff + n * 2048 + k * 1024); } while (0)
#define PG8_MMA(ai, bj, At, Bt) do { __builtin_amdgcn_s_setprio(1); _Pragma("unroll") for (int m = 0; m < 4; ++m) _Pragma("unroll") for (int n = 0; n < 2; ++n) _Pragma("unroll") for (int k = 0; k < 2; ++k) \
        acc[ai][bj][m][n] = __builtin_amdgcn_mfma_f32_16x16x32_bf16(Bt[n][k], At[m][k], acc[ai][bj][m][n], 0, 0, 0); __builtin_amdgcn_s_setprio(0); } while (0)
#define PG8_WAIT_V(n) asm volatile("s_waitcnt vmcnt(" #n ")" ::: "memory")
#define PG8_WAIT_L(n) asm volatile("s_waitcnt lgkmcnt(" #n ")" ::: "memory")
#define PG8_BAR __builtin_amdgcn_s_barrier()
#define PG8_SCHED __builtin_amdgcn_sched_barrier(0)
    Unit cur, nxt; int ui = 0;
    if (!S.next(0, cur)) return;
    f32x4 acc[2][2][4][2];
#pragma unroll
    for (int a = 0; a < 2; ++a)
#pragma unroll
        for (int b = 0; b < 2; ++b)
#pragma unroll
            for (int m = 0; m < 4; ++m)
#pragma unroll
                for (int n = 0; n < 2; ++n) acc[a][b][m][n] = (f32x4){0.f, 0.f, 0.f, 0.f};
    bf16x8 At[4][2], B0[2][2], B1[2][2];
    const char* cA = S.a_ptr(cur); const char* cB = S.b_ptr(cur);
    float pre[8]; E.prefetch(pre, cur, wr, fr);
    PG8_STAGE(PG8_SB(0, 0), cB, voffB); PG8_STAGE(PG8_SA(0, 0), cA, voffA); PG8_STAGE(PG8_SB(0, 1), cB + hstepB, voffB); PG8_STAGE(PG8_SA(0, 1), cA + hstepA, voffA);
    if (wr == 1) PG8_BAR;
    PG8_WAIT_V(4); PG8_BAR;
    PG8_STAGE(PG8_SB(1, 0), cB + kstepB, voffB); PG8_STAGE(PG8_SA(1, 0), cA + kstepA, voffA); PG8_STAGE(PG8_SB(1, 1), cB + hstepB + kstepB, voffB);
    PG8_WAIT_V(6); PG8_BAR;
    for (;;) {
        const bool has_next = S.next(ui + 1, nxt);
        const char* nA = has_next ? S.a_ptr(nxt) : cA; const char* nB = has_next ? S.b_ptr(nxt) : cB;
        for (int t = 0; t < nt; t += 2) {
            const bool last = (t == nt - 2);
            const char* a1 = cA + (size_t)(t + 1) * kstepA;
            const char* a2 = last ? nA : cA + (size_t)(t + 2) * kstepA; const char* b2 = last ? nB : cB + (size_t)(t + 2) * kstepB;
            const char* a3 = a2 + kstepA; const char* b3 = b2 + kstepB;
            PG8_LDB(B0, 0, 0); PG8_SCHED; PG8_LDA(At, 0, 0); PG8_STAGE(PG8_SA(1, 1), a1 + hstepA, voffA);
            PG8_WAIT_L(8); PG8_BAR; PG8_WAIT_L(0); PG8_MMA(0, 0, At, B0); PG8_BAR; PG8_SCHED;
            PG8_LDB(B1, 0, 1); PG8_STAGE(PG8_SB(0, 0), b2, voffB);
            PG8_BAR; PG8_WAIT_L(0); PG8_MMA(0, 1, At, B1); PG8_BAR;
            PG8_LDA(At, 0, 1); PG8_STAGE(PG8_SA(0, 0), a2, voffA);
            PG8_BAR; PG8_WAIT_L(0); PG8_MMA(1, 0, At, B0); PG8_BAR; PG8_SCHED;
            PG8_STAGE(PG8_SB(0, 1), b2 + hstepB, voffB);
            PG8_WAIT_V(6); PG8_BAR; PG8_MMA(1, 1, At, B1); PG8_BAR;
            PG8_LDB(B0, 1, 0); PG8_SCHED; PG8_LDA(At, 1, 0); PG8_STAGE(PG8_SA(0, 1), a2 + hstepA, voffA);
            PG8_WAIT_L(8); PG8_BAR; PG8_WAIT_L(0); PG8_MMA(0, 0, At, B0); PG8_BAR; PG8_SCHED;
            PG8_LDB(B1, 1, 1); PG8_STAGE(PG8_SB(1, 0), b3, voffB);
            PG8_BAR; PG8_WAIT_L(0); PG8_MMA(0, 1, At, B1); PG8_BAR;
            PG8_LDA(At, 1, 1); PG8_STAGE(PG8_SA(1, 0), a3, voffA);
            PG8_BAR; PG8_WAIT_L(0); PG8_MMA(1, 0, At, B0); PG8_BAR; PG8_SCHED;
            PG8_STAGE(PG8_SB(1, 1), b3 + hstepB, voffB);
            PG8_WAIT_V(6); PG8_BAR; PG8_MMA(1, 1, At, B1); PG8_BAR;
        }
        E(acc, cur, wr, wc, fr, fq, pre);
        if (has_next) E.prefetch(pre, nxt, wr, fr);
        if (!has_next) break;
#pragma unroll
        for (int a = 0; a < 2; ++a)
#pragma unroll
            for (int b = 0; b < 2; ++b)
#pragma unroll
                for (int m = 0; m < 4; ++m)
#pragma unroll
                    for (int n = 0; n < 2; ++n) acc[a][b][m][n] = (f32x4){0.f, 0.f, 0.f, 0.f};
        cur = nxt; cA = nA; cB = nB; ++ui;
    }
    PG8_WAIT_V(0);
    if (wr == 0) PG8_BAR;
    PG8_BAR;
#undef PG8_SA
#undef PG8_SB
#undef PG8_STAGE
#undef PG8_LDA
#undef PG8_LDB
#undef PG8_MMA
#undef PG8_WAIT_V
#undef PG8_WAIT_L
#undef PG8_BAR
#undef PG8_SCHED
}
}

struct Args { const float* in[24]; float* out; unsigned char* ws; };
enum { I_X = 0, I_F1N, I_F1W1, I_F1W3, I_F1W2, I_MIXN, I_WIN, I_GB, I_QNA, I_KNA, I_QNN, I_KNN, I_POS, I_CKW1, I_CKW2, I_CVW1, I_CVW2, I_ON, I_WOUT, I_F2N, I_F2W1, I_F2W3, I_F2W2, I_RB };

__device__ __forceinline__ void transpose_item(const float* W, int K, int N, bf16_t* WT, int mode, int off, LAS float* scr, int item, int lane, const float* gain) {
    const int nblk = (N + 31) / 32, kb = item / nblk, nb = item % nblk, k0 = 64 * kb, n0 = 32 * nb;
    const int c4 = 4 * (lane & 7), nn = n0 + c4;
    f32x4 ld[8];
#pragma unroll
    for (int i = 0; i < 8; ++i) { const int kk = 8 * i + (lane >> 3); ld[i] = (nn < N) ? *(const f32x4*)(W + (size_t)(k0 + kk) * N + nn) : (f32x4){0.f, 0.f, 0.f, 0.f}; if (gain) ld[i] = ld[i] * gain[k0 + kk]; }
#pragma unroll
    for (int i = 0; i < 8; ++i) { const int kk = 8 * i + (lane >> 3); LAS float* d = scr + kk * 33 + c4; d[0] = ld[i].x; d[1] = ld[i].y; d[2] = ld[i].z; d[3] = ld[i].w; }
    LDS_WAIT(); asm volatile("" ::: "memory");
    const int c = lane & 7;
#pragma unroll
    for (int j = 0; j < 4; ++j) { const int n = (lane >> 3) + 8 * j; const LAS float* s = scr + (8 * c) * 33 + n;
        u32x4 o; o.x = pk2(s[0 * 33], s[1 * 33]); o.y = pk2(s[2 * 33], s[3 * 33]); o.z = pk2(s[4 * 33], s[5 * 33]); o.w = pk2(s[6 * 33], s[7 * 33]);
        const int ng = n0 + n; const int dr = mode ? ((ng >> 7) * 256 + (ng & 127) + off) : (ng + off);
        if (ng < N) *(u32x4*)(WT + kt_off(dr, k0 + 8 * c, K)) = o; }
    LDS_WAIT(); asm volatile("" ::: "memory");
}
__device__ __forceinline__ int rel_bucket_dev(int n) {
    if (n < 16) return n;
    const float v = logf((float)n / 16.0f) / 4.852030263919617f * 16.0f;
    int b = 16 + (int)v; return b < 31 ? b : 31;
}
namespace att {
constexpr int SHM_V = 16384, SHM_K = 16384;
constexpr int L_V = 0  , L_K = 49152  , L_WS = 98304, L_TBL = 100352, L_SELM = L_TBL + 4 * TBLS * 4  , L_END = L_SELM + 1024;
constexpr int L_IMP = 0;
static_assert(L_END <= 131072, "attention LDS map");
constexpr float THR = 8.f;
#define KSWZ(row, colB) ((row) * 256 + ((colB) ^ (((row) & 7) << 4)))
__device__ __forceinline__ int v_st(int k, int c) { const int kk = (k & ~0xC) | ((k & 4) << 1) | ((k & 8) >> 1); return ((kk >> 3) * 4 + (c >> 5)) * 512 + ((kk & 7) * 32 + (c & 31)) * 2; }
__device__ __forceinline__ int v_rd_base(int lane) { return ((lane & 3) << 3) | (((lane >> 2) & 3) << 6) | (((lane >> 4) & 1) << 5) | (((lane >> 5) & 1) << 8); }
__device__ __forceinline__ int crow(int r, int hi) { return (r & 3) + 8 * (r >> 2) + 4 * hi; }

__device__ __forceinline__ void partialSM(f32x16& p0, f32x16& p1, float& m_reg, float& mn, float& alpha) {
    (void)m_reg; mn = 0.f; alpha = 1.f;
#pragma unroll
    for (int r = 0; r < 16; ++r) p0[r] = __builtin_amdgcn_exp2f(p0[r] * LOG2E);
#pragma unroll
    for (int r = 0; r < 16; ++r) p1[r] = p1[r] * LOG2E;
}
__device__ __forceinline__ void partialSM_row(f32x16& p0, f32x16& p1, float& m_reg, float& mn, float& alpha, bool ok, float bias) {
    (void)m_reg; mn = 0.f; alpha = 1.f;
    const float mnL = ok ? bias * LOG2E : -__builtin_inff();
#pragma unroll
    for (int r = 0; r < 16; ++r) p0[r] = __builtin_amdgcn_exp2f(fmaf(p0[r], LOG2E, mnL));
#pragma unroll
    for (int r = 0; r < 16; ++r) p1[r] = fmaf(p1[r], LOG2E, mnL);
}
#define PK4(P, B_, OUT) do { unsigned a0 = cvtpk(P[B_+0], P[B_+1]), a1 = cvtpk(P[B_+2], P[B_+3]);                          \
        unsigned b0 = cvtpk(P[B_+4], P[B_+5]), b1 = cvtpk(P[B_+6], P[B_+7]);                                             \
        auto r0 = __builtin_amdgcn_permlane32_swap(a0, b0, false, false); auto r1 = __builtin_amdgcn_permlane32_swap(a1, b1, false, false); \
        u32x4 w = {r0[0], r1[0], r0[1], r1[1]}; OUT = *reinterpret_cast<bf16x8*>(&w); } while (0)
__device__ __forceinline__ void finishSM(f32x16& p0, f32x16& p1, float alpha, float& l_reg, bf16x8& pa0, bf16x8& pa1, bf16x8& pa2, bf16x8& pa3) {
#pragma unroll
    for (int r = 0; r < 16; ++r) p1[r] = __builtin_amdgcn_exp2f(p1[r]);
    float ps = 0;
#pragma unroll
    for (int r = 0; r < 16; ++r) ps += p0[r];
#pragma unroll
    for (int r = 0; r < 16; ++r) ps += p1[r];
    { auto rr = __builtin_amdgcn_permlane32_swap(__float_as_uint(ps), __float_as_uint(ps), false, false);
      ps = __uint_as_float(rr[0]) + __uint_as_float(rr[1]); }
    l_reg = l_reg * alpha + ps;
    PK4(p0, 0, pa0); PK4(p0, 8, pa1); PK4(p1, 0, pa2); PK4(p1, 8, pa3);
}
__device__ __forceinline__ void qkt(f32x16& p0, f32x16& p1, const LAS char* Kb, int r32, int hi, const bf16x8 (&qr)[8]) {
    p0 = f32x16{}; p1 = f32x16{};
    const LAS char* kb4[4];
#pragma unroll
    for (int dd = 0; dd < 4; ++dd) kb4[dd] = Kb + KSWZ(r32, (dd * 16 + hi * 8) * 2);
#pragma unroll
    for (int d0 = 0; d0 < 8; ++d0) { const LAS char* a = kb4[d0 & 3] + (d0 >> 2) * 128;
        const bf16x8 b0 = *reinterpret_cast<const LAS bf16x8*>(a);
        const bf16x8 b1 = *reinterpret_cast<const LAS bf16x8*>(a + 32 * 256);
        p0 = __builtin_amdgcn_mfma_f32_32x32x16_bf16(b0, qr[d0], p0, 0, 0, 0);
        p1 = __builtin_amdgcn_mfma_f32_32x32x16_bf16(b1, qr[d0], p1, 0, 0, 0); }
}
__device__ __forceinline__ void pv_tile(f32x16 (&o)[4], int vb, bf16x8 pa0, bf16x8 pa1, bf16x8 pa2, bf16x8 pa3) {
#define TRRD(dst, off) asm volatile("ds_read_b64_tr_b16 %0, %1 offset:%2" : "=&v"(dst) : "v"(vb), "i"(off) : "memory")
#define PV_D0(d0) do { s16x4 l0, l1, l2, l3, h0, h1, h2, h3; constexpr int b_ = (d0) * 512; \
        TRRD(l0, b_); TRRD(h0, b_ + 2048); TRRD(l1, b_ + 4096); TRRD(h1, b_ + 6144); TRRD(l2, b_ + 8192); TRRD(h2, b_ + 10240); TRRD(l3, b_ + 12288); TRRD(h3, b_ + 14336); \
        asm volatile("s_waitcnt lgkmcnt(0)" ::: "memory"); SBAR(); \
        o[d0] = __builtin_amdgcn_mfma_f32_32x32x16_bf16(pa0, (bf16x8){l0[0], l0[1], l0[2], l0[3], h0[0], h0[1], h0[2], h0[3]}, o[d0], 0, 0, 0);   \
        o[d0] = __builtin_amdgcn_mfma_f32_32x32x16_bf16(pa1, (bf16x8){l1[0], l1[1], l1[2], l1[3], h1[0], h1[1], h1[2], h1[3]}, o[d0], 0, 0, 0);   \
        o[d0] = __builtin_amdgcn_mfma_f32_32x32x16_bf16(pa2, (bf16x8){l2[0], l2[1], l2[2], l2[3], h2[0], h2[1], h2[2], h2[3]}, o[d0], 0, 0, 0);   \
        o[d0] = __builtin_amdgcn_mfma_f32_32x32x16_bf16(pa3, (bf16x8){l3[0], l3[1], l3[2], l3[3], h3[0], h3[1], h3[2], h3[3]}, o[d0], 0, 0, 0); } while (0)
    PV_D0(0); PV_D0(1); PV_D0(2); PV_D0(3);
#undef PV_D0
#undef TRRD
}

template <class Cfg>
__device__ __forceinline__ void attn_tiles(const Cfg& c, LAS char* lds, const bf16x8 (&qr)[8], f32x16 (&o)[4], float& m_reg, float& l_reg, const int t_lo, const int t_hi, const int wv) {
    const int tid = opq_tid(wv), lane = tid & 63, wid = __builtin_amdgcn_readfirstlane(tid >> 6), r32 = lane & 31, hi = lane >> 5;
    LAS char* V_lds = lds + L_V; LAS char* K_lds = lds + L_K;
    LAS float* al_l = (LAS float*)(lds + L_WS) + wid * 64 + 32;
    const int sr = tid >> 4, sc = (tid & 15) * 8;
    const int vst0 = v_st(sr, sc), vst1 = v_st(32 + sr, sc), kws = KSWZ(sr, sc * 2);
    const int vb0 = (int)(unsigned)(uintptr_t)V_lds + v_rd_base(lane);
    bf16x8 sk0, sk1, sv0, sv1;
    const bf16_t *gk0 = nullptr, *gk1 = nullptr, *gv0 = nullptr, *gv1 = nullptr;
#define AT_LOAD(t) do { gk0 = c.krow((t), sr) + sc; gk1 = c.krow((t), sr + 32) + sc; sk0 = *(const bf16x8*)gk0; sk1 = *(const bf16x8*)gk1; \
        if constexpr (Cfg::MODE == 0) { gv0 = c.vrow((t), sr) + sc; gv1 = c.vrow((t), sr + 32) + sc; sv0 = *(const bf16x8*)gv0; sv1 = *(const bf16x8*)gv1; } \
        asm volatile("" ::: "memory"); SBAR(); } while (0)
#define AT_WRITE(t, bf) do { asm volatile("" :: "v"(gk0), "v"(gk1), "v"(gv0), "v"(gv1)); *(LAS bf16x8*)(K_lds + (bf) * SHM_K + kws) = sk0; *(LAS bf16x8*)(K_lds + (bf) * SHM_K + kws + 32 * 256) = sk1; \
        if constexpr (Cfg::MODE == 1) { \
            _Pragma("unroll") for (int i_ = 0; i_ < 8; ++i_) { const int n_ = sc + i_, c0_ = 64 * (t) + sr, c1_ = c0_ + 32; \
                sv0[i_] = (c0_ >= 4 * n_ - 1 && c0_ <= 4 * n_ + 3) ? (short)0x3F80 : (short)0; sv1[i_] = (c1_ >= 4 * n_ - 1 && c1_ <= 4 * n_ + 3) ? (short)0x3F80 : (short)0; } } \
        *(LAS bf16x8*)(V_lds + (bf) * SHM_V + vst0) = sv0; *(LAS bf16x8*)(V_lds + (bf) * SHM_V + vst1) = sv1; } while (0)
    __builtin_amdgcn_s_waitcnt(0x0F70);
    __syncthreads();
    if (t_lo < t_hi) { AT_LOAD(t_lo); AT_WRITE(t_lo, 0); }
    __syncthreads();
    for (int t = t_lo; t < t_hi; ++t) {
        const int buf = (t - t_lo) & 1; const bool more = (t + 1 < t_hi);
        if (more) AT_LOAD(t + 1);
        if (c.active(t)) {
            f32x16 p0, p1;
            qkt(p0, p1, K_lds + buf * SHM_K, r32, hi, qr);
            if constexpr (Cfg::MODE == 0) {
                float mn, alpha; bf16x8 pa0, pa1, pa2, pa3;
                bool rok; float rbias;
                if (c.rowconst(t, rok, rbias)) partialSM_row(p0, p1, m_reg, mn, alpha, rok, rbias);
                else { c.mask(p0, p1, t); partialSM(p0, p1, m_reg, mn, alpha); }
                if (__any(alpha < 1.f)) { if (hi == 0) al_l[r32] = alpha; LDS_WAIT();
#pragma unroll
                    for (int d_ = 0; d_ < 4; ++d_)
#pragma unroll
                        for (int r = 0; r < 16; ++r) o[d_][r] *= al_l[crow(r, hi)]; }
                finishSM(p0, p1, alpha, l_reg, pa0, pa1, pa2, pa3); SBAR();
                pv_tile(o, vb0 + buf * SHM_V, pa0, pa1, pa2, pa3);
            } else {
                c.mask(p0, p1, t);
                const float mL = -c.mfix * LOG2E; const float il = c.invl;
#pragma unroll
                for (int r = 0; r < 16; ++r) { p0[r] = __builtin_amdgcn_exp2f(fmaf(p0[r], LOG2E, mL)) * il; p1[r] = __builtin_amdgcn_exp2f(fmaf(p1[r], LOG2E, mL)) * il; }
                bf16x8 pa0, pa1, pa2, pa3;
                PK4(p0, 0, pa0); PK4(p0, 8, pa1); PK4(p1, 0, pa2); PK4(p1, 8, pa3); SBAR();
                pv_tile(o, vb0 + buf * SHM_V, pa0, pa1, pa2, pa3);
#pragma unroll
                for (int r = 0; r < 16; r += 2) { const unsigned a = cvtpk(p0[r], p0[r + 1]), b = cvtpk(p1[r], p1[r + 1]);
                    p0[r] -= bflo(a); p0[r + 1] -= bfhi(a); p1[r] -= bflo(b); p1[r + 1] -= bfhi(b); }
                PK4(p0, 0, pa0); PK4(p0, 8, pa1); PK4(p1, 0, pa2); PK4(p1, 8, pa3); SBAR();
                pv_tile(o, vb0 + buf * SHM_V, pa0, pa1, pa2, pa3);
            }
        }
        if (more) AT_WRITE(t + 1, buf ^ 1);
        __syncthreads();
    }
#undef AT_LOAD
#undef AT_WRITE
}

template <class Cfg>
__device__ __forceinline__ void attn_tiles_s(const Cfg& c, LAS char* lds, const bf16x8 (&qr)[8], f32x16 (&o)[4], float& m_reg, float& l_reg, const int t_lo, const int t_hi, const int wv) {
    static_assert(Cfg::MODE == 0, "fixed-shift softmax tiles only");
    (void)m_reg;
    const int tid = opq_tid(wv), lane = tid & 63, wid = __builtin_amdgcn_readfirstlane(tid >> 6), r32 = lane & 31, hi = lane >> 5;
    LAS char* V_lds = lds + L_V; LAS char* K_lds = lds + L_K;
    const int sr = tid >> 4, sc = (tid & 15) * 8;
    const int vst0 = v_st(sr, sc), vst1 = v_st(32 + sr, sc), kws = KSWZ(sr, sc * 2);
    const int vb0 = (int)(unsigned)(uintptr_t)V_lds + v_rd_base(lane);
    bf16x8 sk0, sk1, sv0, sv1, pa0, pa1, pa2, pa3;
    const bf16_t *gk0 = nullptr, *gk1 = nullptr, *gv0 = nullptr, *gv1 = nullptr;
#define AS_LOAD(t) do { gk0 = c.krow((t), sr) + sc; gk1 = c.krow((t), sr + 32) + sc; sk0 = *(const bf16x8*)gk0; sk1 = *(const bf16x8*)gk1; \
        gv0 = c.vrow((t), sr) + sc; gv1 = c.vrow((t), sr + 32) + sc; sv0 = *(const bf16x8*)gv0; sv1 = *(const bf16x8*)gv1; asm volatile("" ::: "memory"); SBAR(); } while (0)
#define AS_WRITE(kbf, vbf) do { asm volatile("" :: "v"(gk0), "v"(gk1), "v"(gv0), "v"(gv1)); *(LAS bf16x8*)(K_lds + (kbf) * SHM_K + kws) = sk0; *(LAS bf16x8*)(K_lds + (kbf) * SHM_K + kws + 32 * 256) = sk1; \
        *(LAS bf16x8*)(V_lds + (vbf) * SHM_V + vst0) = sv0; *(LAS bf16x8*)(V_lds + (vbf) * SHM_V + vst1) = sv1; } while (0)
#define AS_SCORE(t, kbf) do { f32x16 p0, p1; float mz_ = 0.f, mn_, al_; bool rok_; float rb_; \
        qkt(p0, p1, K_lds + (kbf) * SHM_K, r32, hi, qr); \
        if (c.rowconst((t), rok_, rb_)) partialSM_row(p0, p1, mz_, mn_, al_, rok_, rb_); else { c.mask(p0, p1, (t)); partialSM(p0, p1, mz_, mn_, al_); } \
        finishSM(p0, p1, 1.f, l_reg, pa0, pa1, pa2, pa3); SBAR(); } while (0)
    if (t_lo >= t_hi) return;
    __builtin_amdgcn_s_waitcnt(0x0F70);
    __syncthreads();
    AS_LOAD(t_lo); AS_WRITE(0, 0);
    __syncthreads();
    int kb = 0, vb = 0;
    if (wid < 4) {
        for (int t = t_lo; t < t_hi; ++t) {
            const bool more = (t + 1 < t_hi); const int vn = (vb == 2) ? 0 : vb + 1;
            if (more) AS_LOAD(t + 1);
            if (c.active(t)) { AS_SCORE(t, kb); pv_tile(o, vb0 + vb * SHM_V, pa0, pa1, pa2, pa3); }
            if (more) AS_WRITE(kb ^ 1, vn);
            __syncthreads();
            kb ^= 1; vb = vn;
        }
    } else {
        bool pend = false; int vp = 0;
        for (int t = t_lo; t < t_hi; ++t) {
            const bool more = (t + 1 < t_hi); const int vn = (vb == 2) ? 0 : vb + 1;
            if (more) AS_LOAD(t + 1);
            if (pend) pv_tile(o, vb0 + vp * SHM_V, pa0, pa1, pa2, pa3);
            const bool act = c.active(t);
            if (act) AS_SCORE(t, kb);
            pend = act; vp = vb;
            if (more) AS_WRITE(kb ^ 1, vn);
            __syncthreads();
            kb ^= 1; vb = vn;
        }
        if (pend) pv_tile(o, vb0 + vp * SHM_V, pa0, pa1, pa2, pa3);
    }
#undef AS_LOAD
#undef AS_WRITE
#undef AS_SCORE
}

struct DilCfg {
    static constexpr int MODE = 0;
    const bf16_t* Kb; const bf16_t* Vb;
    const LAS float* tbl; int dshift, res, u, dqm, s0;
    __device__ __forceinline__ const bf16_t* krow(int t, int kk) const { int s = 256 * u - 128 + 64 * t + kk; s = s < 0 ? 0 : s; return Kb + (size_t)((s << dshift) + res) * PC; }
    __device__ __forceinline__ const bf16_t* vrow(int t, int kk) const { int s = 256 * u - 128 + 64 * t + kk; s = s < 0 ? 0 : s; return Vb + (size_t)((s << dshift) + res) * PC; }
    __device__ __forceinline__ bool active(int t) const { const int kb = 256 * u - 128 + 64 * t; return kb <= s0 + 31 && kb + 63 >= s0 - 128; }
    __device__ __forceinline__ bool rowconst(int, bool&, float&) const { return false; }
    __device__ __forceinline__ void mask(f32x16& p0, f32x16& p1, int t) const {
        const int dq = dqm - (256 * u - 128 + 64 * t); const float NEG = -__builtin_inff();
        const LAS float* tb = tbl + (DT0 + dq - 63);
        float bb0[16], bb1[16];
#pragma unroll
        for (int r = 0; r < 16; ++r) { const int cc = (r & 3) + 8 * (r >> 2); bb0[r] = tb[63 - cc]; bb1[r] = tb[31 - cc]; }
#pragma unroll
        for (int r = 0; r < 16; ++r) asm volatile("" : "+v"(bb0[r]), "+v"(bb1[r]));
#pragma unroll
        for (int r = 0; r < 16; ++r) { const int cc = (r & 3) + 8 * (r >> 2); const unsigned d0 = (unsigned)(dq - cc), d1 = (unsigned)(dq - cc - 32);
            p0[r] = (d0 <= 128u) ? p0[r] + bb0[r] : NEG; p1[r] = (d1 <= 128u) ? p1[r] + bb1[r] : NEG; }
    }
};
struct CmpCfg {
    static constexpr int MODE = 0;
    const bf16_t* Kb; const bf16_t* Vb; int cmax, hi4, cfull;
    __device__ __forceinline__ bool rowconst(int t, bool& ok, float& bias) const { ok = true; bias = 0.f; return 64 * t + 63 <= cfull; }
    __device__ __forceinline__ const bf16_t* krow(int t, int kk) const { return Kb + (size_t)(64 * t + kk) * HD; }
    __device__ __forceinline__ const bf16_t* vrow(int t, int kk) const { return Vb + (size_t)(64 * t + kk) * HD; }
    __device__ __forceinline__ bool active(int) const { return true; }
    __device__ __forceinline__ void mask(f32x16& p0, f32x16& p1, int t) const {
        const int cb = 64 * t + hi4; const float NEG = -__builtin_inff();
#pragma unroll
        for (int r = 0; r < 16; ++r) { const int cc = cb + (r & 3) + 8 * (r >> 2); if (cc > cmax) p0[r] = NEG; if (cc + 32 > cmax) p1[r] = NEG; }
    }
};
struct CmpImpCfg {
    static constexpr int MODE = 1;
    const bf16_t* Kb; int cmax, hi4; float mfix, invl;
    __device__ __forceinline__ const bf16_t* krow(int t, int kk) const { return Kb + (size_t)(64 * t + kk) * HD; }
    __device__ __forceinline__ const bf16_t* vrow(int, int) const { return Kb; }
    __device__ __forceinline__ bool active(int) const { return true; }
    __device__ __forceinline__ void mask(f32x16& p0, f32x16& p1, int t) const {
        const int cb = 64 * t + hi4; const float NEG = -__builtin_inff();
#pragma unroll
        for (int r = 0; r < 16; ++r) { const int cc = cb + (r & 3) + 8 * (r >> 2); if (cc > cmax) p0[r] = NEG; if (cc + 32 > cmax) p1[r] = NEG; }
    }
};
struct SlcCfg {
    static constexpr int MODE = 0;
    const bf16_t* Kb; const bf16_t* Vb;
    const LAS float* tblh;
    unsigned s0, s1, s2, s3; int tqm, cur; float b31;
    __device__ __forceinline__ const bf16_t* krow(int t, int kk) const { return Kb + (size_t)(64 * t + kk) * PC; }
    __device__ __forceinline__ const bf16_t* vrow(int t, int kk) const { return Vb + (size_t)(64 * t + kk) * PC; }
    __device__ __forceinline__ bool selbit(int t) const { const unsigned q = (unsigned)t >> 5; const unsigned w = (q == 0u ? s0 + 0u : 0u) | (q == 1u ? s1 + 0u : 0u) | (q == 2u ? s2 + 0u : 0u) | (q == 3u ? s3 + 0u : 0u); return (w >> (t & 31)) & 1u; }
    __device__ __forceinline__ bool active(int t) const { return __any(selbit(t)); }
    __device__ __forceinline__ bool rowconst(int t, bool& ok, float& bias) const { ok = selbit(t); bias = b31; return 64 * (cur - t) - 63 >= 1513; }
    __device__ __forceinline__ void mask(f32x16& p0, f32x16& p1, int t) const {
        const bool sel = selbit(t); const int dq = tqm - 64 * t; const float NEG = -__builtin_inff();
        const LAS float* tb = tblh + (TBL0 + dq - 63);
        float bb0[16], bb1[16];
#pragma unroll
        for (int r = 0; r < 16; ++r) { const int cc = (r & 3) + 8 * (r >> 2); bb0[r] = tb[63 - cc]; bb1[r] = tb[31 - cc]; }
#pragma unroll
        for (int r = 0; r < 16; ++r) asm volatile("" : "+v"(bb0[r]), "+v"(bb1[r]));
#pragma unroll
        for (int r = 0; r < 16; ++r) { const int cc = (r & 3) + 8 * (r >> 2); const int d0 = dq - cc, d1 = dq - cc - 32;
            p0[r] = (sel && d0 >= 0) ? p0[r] + bb0[r] : NEG; p1[r] = (sel && d1 >= 0) ? p1[r] + bb1[r] : NEG; }
    }
};
struct WinCfg {
    static constexpr int MODE = 0;
    const bf16_t* Kb; const bf16_t* Vb; const LAS float* tblh; int tqm;
    __device__ __forceinline__ bool rowconst(int, bool&, float&) const { return false; }
    __device__ __forceinline__ const bf16_t* krow(int t, int kk) const { return Kb + (size_t)(64 * t + kk) * PC; }
    __device__ __forceinline__ const bf16_t* vrow(int t, int kk) const { return Vb + (size_t)(64 * t + kk) * PC; }
    __device__ __forceinline__ bool active(int) const { return true; }
    __device__ __forceinline__ void mask(f32x16& p0, f32x16& p1, int t) const {
        const int dq = tqm - 64 * t; const float NEG = -__builtin_inff();
        const LAS float* tb = tblh + (TBL0 + dq - 63);
        float bb0[16], bb1[16];
#pragma unroll
        for (int r = 0; r < 16; ++r) { const int cc = (r & 3) + 8 * (r >> 2); bb0[r] = tb[63 - cc]; bb1[r] = tb[31 - cc]; }
#pragma unroll
        for (int r = 0; r < 16; ++r) asm volatile("" : "+v"(bb0[r]), "+v"(bb1[r]));
#pragma unroll
        for (int r = 0; r < 16; ++r) { const int cc = (r & 3) + 8 * (r >> 2); const unsigned d0 = (unsigned)(dq - cc), d1 = (unsigned)(dq - cc - 32);
            p0[r] = (d0 < 512u) ? p0[r] + bb0[r] : NEG; p1[r] = (d1 < 512u) ? p1[r] + bb1[r] : NEG; }
    }
};
}

__device__ __forceinline__ void load_q_normed(const bf16_t* qp  , const float* gain  , bf16x8 (&qr)[8]) {
    u32x4 raw[8];
#pragma unroll
    for (int d0 = 0; d0 < 8; ++d0) raw[d0] = *(const u32x4*)(qp + d0 * 16);
    float ss = 0.f;
#pragma unroll
    for (int d0 = 0; d0 < 8; ++d0) { const u32x4 w = raw[d0]; const float a0 = bflo(w.x), a1 = bfhi(w.x), a2 = bflo(w.y), a3 = bfhi(w.y), a4 = bflo(w.z), a5 = bfhi(w.z), a6 = bflo(w.w), a7 = bfhi(w.w);
        ss += ((a0 * a0 + a1 * a1) + (a2 * a2 + a3 * a3)) + ((a4 * a4 + a5 * a5) + (a6 * a6 + a7 * a7)); }
    { auto rr = __builtin_amdgcn_permlane32_swap(__float_as_uint(ss), __float_as_uint(ss), false, false); ss = __uint_as_float(rr[0]) + __uint_as_float(rr[1]); }
    const float rs = QSCALE / sqrtf(ss * (1.f / HD) + EPS);
#pragma unroll
    for (int d0 = 0; d0 < 8; ++d0) { const u32x4 w = raw[d0]; const f32x4 g0 = *(const f32x4*)(gain + d0 * 16), g1 = *(const f32x4*)(gain + d0 * 16 + 4);
        u32x4 o; o.x = cvtpk(bflo(w.x) * rs * g0.x, bfhi(w.x) * rs * g0.y); o.y = cvtpk(bflo(w.y) * rs * g0.z, bfhi(w.y) * rs * g0.w);
        o.z = cvtpk(bflo(w.z) * rs * g1.x, bfhi(w.z) * rs * g1.y); o.w = cvtpk(bflo(w.w) * rs * g1.z, bfhi(w.w) * rs * g1.w);
        qr[d0] = *reinterpret_cast<bf16x8*>(&o); }
}

__device__ __forceinline__ void dil_tiles(const att::DilCfg& c, LAS char* lds, const bf16x8 (&qr)[8], f32x16 (&o)[4], float& l_reg, const int wv) {
    using namespace att;
    const int tid = opq_tid(wv), lane = tid & 63, wid = __builtin_amdgcn_readfirstlane(tid >> 6), r32 = lane & 31, hi = lane >> 5;
    LAS char* V_lds = lds + L_V; LAS char* K_lds = lds + L_K;
    const int sr = tid >> 4, sc = (tid & 15) * 8;
    const int vst0 = v_st(sr, sc), vst1 = v_st(32 + sr, sc), kws = KSWZ(sr, sc * 2);
    const int vb0 = (int)(unsigned)(uintptr_t)V_lds + v_rd_base(lane);
    bf16x8 sk0, sk1, sv0, sv1;
    const bf16_t *gk0 = nullptr, *gk1 = nullptr, *gv0 = nullptr, *gv1 = nullptr;
#define DT_LOAD(t) do { gk0 = c.krow((t), sr) + sc; gk1 = c.krow((t), sr + 32) + sc; sk0 = *(const bf16x8*)gk0; sk1 = *(const bf16x8*)gk1; \
        gv0 = c.vrow((t), sr) + sc; gv1 = c.vrow((t), sr + 32) + sc; sv0 = *(const bf16x8*)gv0; sv1 = *(const bf16x8*)gv1; asm volatile("" ::: "memory"); SBAR(); } while (0)
#define DT_WRITE(slot) do { asm volatile("" :: "v"(gk0), "v"(gk1), "v"(gv0), "v"(gv1)); *(LAS bf16x8*)(K_lds + (slot) * SHM_K + kws) = sk0; *(LAS bf16x8*)(K_lds + (slot) * SHM_K + kws + 32 * 256) = sk1; \
        *(LAS bf16x8*)(V_lds + (slot) * SHM_V + vst0) = sv0; *(LAS bf16x8*)(V_lds + (slot) * SHM_V + vst1) = sv1; } while (0)
#define DT_COMP(t, slot) do { f32x16 p0, p1; float mz_ = 0.f, mn_, al_; bf16x8 pa0, pa1, pa2, pa3; \
        qkt(p0, p1, K_lds + (slot) * SHM_K, r32, hi, qr); c.mask(p0, p1, (t)); partialSM(p0, p1, mz_, mn_, al_); \
        finishSM(p0, p1, 1.f, l_reg, pa0, pa1, pa2, pa3); SBAR(); pv_tile(o, vb0 + (slot) * SHM_V, pa0, pa1, pa2, pa3); } while (0)
    const bool first = (c.u == 0);
    __builtin_amdgcn_s_waitcnt(0x0F70);
    __syncthreads();
    if (!first) { DT_LOAD(1); DT_WRITE(0); }
    DT_LOAD(4); DT_WRITE(1);
    __syncthreads();
    DT_LOAD(2);
    if (wid < 4) { if (!first) DT_COMP(1, 0); } else DT_COMP(4, 1);
    DT_WRITE(2);
    __syncthreads();
    DT_LOAD(3);
    if (wid < 6) DT_COMP(2, 2);
    DT_WRITE(0);
    __syncthreads();
    DT_LOAD(5);
    if (wid >= 2) DT_COMP(3, 0);
    DT_WRITE(1);
    if (!first) { DT_LOAD(0); DT_WRITE(2); }
    __syncthreads();
    if (wid < 2) { if (!first) DT_COMP(0, 2); } else if (wid >= 6) DT_COMP(5, 1);
#undef DT_LOAD
#undef DT_WRITE
#undef DT_COMP
}

__device__ __forceinline__ void dil_unit(LAS char* lds, const bf16_t* P, bf16_t* OA, float* LSE, const float* dilT, const float* qgain, int pat, int dshift, int unit, const int wv) {
    using namespace att;
    const int tid = opq_tid(wv), lane = tid & 63, wid = __builtin_amdgcn_readfirstlane(tid >> 6), r32 = lane & 31, hi = lane >> 5;
    const int bh = unit >> 5, ru = unit & 31, b = bh >> 3, h = bh & 7;
    const int ncs = 5 - dshift, res = ru >> ncs, u = ru & ((1 << ncs) - 1);
    LAS float* tbl = (LAS float*)(lds + L_TBL);
    __syncthreads();
    if (tid < DTS) tbl[tid] = dilT[(pat * 8 + h) * DTS + tid];
    const int s0 = 256 * u + 32 * wid, s_row = s0 + r32;
    const size_t tokrow = (size_t)b * SEQ + (size_t)((s_row << dshift) + res);
    bf16x8 qr[8];
    load_q_normed(P + tokrow * PC + C_QA + h * HD + hi * 8, qgain + hi * 8, qr);
    f32x16 o[4]; float m_reg, l_reg;
    m_reg = 0.f;
    if (pat == 0) { l_reg = 0.f;
#pragma unroll
        for (int d0 = 0; d0 < 4; ++d0) o[d0] = f32x16{}; }
    else { l_reg = LSE[tokrow * 8 + h];
#pragma unroll
        for (int r = 0; r < 16; ++r) { const size_t tr = (size_t)b * SEQ + (size_t)(((s0 + crow(r, hi)) << dshift) + res); const bf16_t* op = OA + tr * 1024 + h * HD + r32;
#pragma unroll
            for (int d0 = 0; d0 < 4; ++d0) o[d0][r] = bf2f(op[d0 * 32]); } }
    DilCfg c; c.Kb = P + (size_t)b * SEQ * PC + C_KA + h * HD; c.Vb = P + (size_t)b * SEQ * PC + C_VA + h * HD; c.tbl = tbl; c.dshift = dshift; c.res = res; c.u = u; c.dqm = s_row - 4 * hi; c.s0 = s0;
    dil_tiles(c, lds, qr, o, l_reg, wv);
    LAS float* li_l = (LAS float*)(lds + L_WS) + wid * 64;
    if (hi == 0) { li_l[r32] = l_reg; LSE[tokrow * 8 + h] = l_reg; }
    LDS_WAIT();
#pragma unroll
    for (int r = 0; r < 16; ++r) { const int orow = crow(r, hi); const float rl = (pat == 2) ? 1.0f / li_l[orow] : 1.0f;
        const size_t tr = (size_t)b * SEQ + (size_t)(((s0 + orow) << dshift) + res); bf16_t* op = OA + tr * 1024 + h * HD;
#pragma unroll
        for (int d0 = 0; d0 < 4; ++d0) { const float v = o[d0][r] * rl; const float vn = shx(v, 1, lane);
            if ((r32 & 1) == 0) *(unsigned*)(op + d0 * 32 + r32) = cvtpk(v, vn); } }
}

__device__ __forceinline__ void nsa_finalize(LAS char* lds, const f32x16 (&o)[4], float l_reg, const bf16_t* P, bf16_t* ON, const float* gb, int b, int g, int tok0, int br, const int wv) {
    using namespace att;
    const int tid = opq_tid(wv), lane = tid & 63, wid = __builtin_amdgcn_readfirstlane(tid >> 6), r32 = lane & 31, hi = lane >> 5;
    LAS float* li_l = (LAS float*)(lds + L_WS) + wid * 64;
    if (hi == 0) li_l[r32] = l_reg;
    LDS_WAIT();
    bf16_t* ONb = ON + (size_t)br * NTOK * 1024;
#pragma unroll
    for (int r = 0; r < 16; ++r) { const int j = r & 3, k = r >> 2; const float lr = li_l[crow(r, hi)]; const float rl = lr > 0.f ? 1.0f / lr : 0.f;
        const size_t tok = (size_t)b * SEQ + tok0 + 2 * k + hi; const int hh = 4 * g + j;
        const float gl = bf2f(P[tok * PC + C_GL + hh * 3 + br]) + gb[hh * 3 + br];
        const float sc = rl * __builtin_amdgcn_rcpf(1.0f + __builtin_amdgcn_exp2f(-gl * LOG2E));
        bf16_t* op = ONb + tok * 1024 + hh * HD;
#pragma unroll
        for (int d0 = 0; d0 < 4; ++d0) { const float v = o[d0][r] * sc; const float vn = shx(v, 1, lane);
            if ((r32 & 1) == 0) *(unsigned*)(op + d0 * 32 + r32) = cvtpk(v, vn); } }
}
__device__ __forceinline__ void nsa_unit(LAS char* lds, const bf16_t* P, const bf16_t* KC, const bf16_t* VC, bf16_t* ON, const float* nsaT, const float* gb, const float* qgain, int b, int g, int qi, bool load_tbl, const int wv) {
    using namespace att;
    const int tid = opq_tid(wv), lane = tid & 63, wid = __builtin_amdgcn_readfirstlane(tid >> 6), r32 = lane & 31, hi = lane >> 5;
    LAS float* tbl = (LAS float*)(lds + L_TBL); LAS float* IMP = (LAS float*)(lds + L_IMP); LAS unsigned* SELM = (LAS unsigned*)(lds + L_SELM);
    __syncthreads();
    if (load_tbl) for (int i = tid; i < 4 * TBLS; i += NTHR) tbl[i] = nsaT[(size_t)(4 * g) * TBLS + i];
    const int tok0 = 64 * qi + 8 * wid, tq = tok0 + (r32 >> 2), hd = r32 & 3;
    const bf16_t* Pb = P + (size_t)b * SEQ * PC;
    bf16x8 qr[8];
    load_q_normed(Pb + (size_t)tq * PC + C_QN + (4 * g + hd) * HD + hi * 8, qgain + hi * 8, qr);
    const bf16_t* KCb = KC + (size_t)(b * 2 + g) * 512 * HD; const bf16_t* VCb = VC + (size_t)(b * 2 + g) * 512 * HD;
    const int ntc = (qi >> 4) + 1, cmax = (tq - 31) >> 4;
    f32x16 o[4]; float m_reg, l_reg;
#pragma unroll
    for (int d0 = 0; d0 < 4; ++d0) o[d0] = f32x16{};
    m_reg = 0.f; l_reg = 0.f;
    { CmpCfg c; c.Kb = KCb; c.Vb = VCb; c.cmax = cmax; c.hi4 = 4 * hi; c.cfull = (64 * qi - 31) >> 4; attn_tiles_s(c, lds, qr, o, m_reg, l_reg, 0, ntc, wv); }
    nsa_finalize(lds, o, l_reg, P, ON, gb, b, g, tok0, 0, wv);
    { CmpImpCfg c; c.Kb = KCb; c.cmax = cmax; c.hi4 = 4 * hi; c.mfix = 0.f; c.invl = l_reg > 0.f ? 1.0f / l_reg : 0.f;
#pragma unroll
      for (int d0 = 0; d0 < 4; ++d0) o[d0] = f32x16{};
      float md = 0.f, ld = 0.f; attn_tiles(c, lds, qr, o, md, ld, 0, ntc, wv); }
#pragma unroll
    for (int d0 = 0; d0 < 4; ++d0)
#pragma unroll
        for (int k = 0; k < 4; ++k) IMP[(8 * wid + 2 * k + hi) * 128 + 32 * d0 + r32] = (o[d0][4 * k] + o[d0][4 * k + 1]) + (o[d0][4 * k + 2] + o[d0][4 * k + 3]);
    __syncthreads();
    { const int cur = qi;
#pragma unroll 1
      for (int tl = 8 * wid; tl < 8 * wid + 8; ++tl) {
        const int n0 = lane, n1 = 64 + lane; bool sel0, sel1;
        if (cur <= 15) { sel0 = (n0 <= cur); sel1 = false; }
        else {
            const float v0 = IMP[tl * 128 + n0], v1 = IMP[tl * 128 + n1];
            const unsigned u0 = (n0 >= 1 && n0 <= cur - 2) ? __float_as_uint(v0) + 1u : 0u, u1 = (n1 <= cur - 2) ? __float_as_uint(v1) + 1u : 0u;
            unsigned T = 0u;
#pragma unroll 1
            for (int bit = 30; bit >= 0; --bit) { const unsigned cand = T | (1u << bit);
                const int cnt = __builtin_popcountll(__ballot(u0 >= cand)) + __builtin_popcountll(__ballot(u1 >= cand));
                if (cnt >= 13) T = cand; }
            const bool gt0 = u0 > T, gt1 = u1 > T;
            const int need = 13 - (__builtin_popcountll(__ballot(gt0)) + __builtin_popcountll(__ballot(gt1)));
            const bool eq0 = (u0 == T), eq1 = (u1 == T);
            const unsigned long long m0 = __ballot(eq0), m1 = __ballot(eq1);
            const int pre0 = (int)__builtin_amdgcn_mbcnt_hi((unsigned)(m0 >> 32), __builtin_amdgcn_mbcnt_lo((unsigned)m0, 0u));
            const int pre1 = __builtin_popcountll(m0) + (int)__builtin_amdgcn_mbcnt_hi((unsigned)(m1 >> 32), __builtin_amdgcn_mbcnt_lo((unsigned)m1, 0u));
            sel0 = (n0 == 0 || n0 == cur || n0 == cur - 1) || gt0 || (eq0 && pre0 < need);
            sel1 = (n1 == cur || n1 == cur - 1) || gt1 || (eq1 && pre1 < need);
        }
        const unsigned long long b0 = __ballot(sel0), b1 = __ballot(sel1);
        if (lane == 0) { SELM[tl * 4 + 0] = (unsigned)b0; SELM[tl * 4 + 1] = (unsigned)(b0 >> 32); SELM[tl * 4 + 2] = (unsigned)b1; SELM[tl * 4 + 3] = (unsigned)(b1 >> 32); } } }
    __syncthreads();
    int r32s = r32; asm volatile("" : "+v"(r32s));
    { SlcCfg c; c.Kb = Pb + C_KS + g * HD; c.Vb = Pb + C_VS + g * HD; c.tblh = tbl + (r32s & 3) * TBLS; c.tqm = tok0 + (r32s >> 2) - 4 * hi; c.cur = qi; c.b31 = tbl[(r32s & 3) * TBLS + TBL0 + 1600];
      const int tl = 8 * wid + (r32s >> 2); c.s0 = SELM[tl * 4 + 0]; c.s1 = SELM[tl * 4 + 1]; c.s2 = SELM[tl * 4 + 2]; c.s3 = SELM[tl * 4 + 3];
#pragma unroll
      for (int d0 = 0; d0 < 4; ++d0) o[d0] = f32x16{};
      m_reg = 0.f; l_reg = 0.f;
      attn_tiles_s(c, lds, qr, o, m_reg, l_reg, 0, qi + 1, wv); }
    nsa_finalize(lds, o, l_reg, P, ON, gb, b, g, tok0, 1, wv);
    int r32w = r32; asm volatile("" : "+v"(r32w));
    { WinCfg c; c.Kb = Pb + C_KW + g * HD; c.Vb = Pb + C_VW + g * HD; c.tblh = tbl + (r32w & 3) * TBLS; c.tqm = tok0 + (r32w >> 2) - 4 * hi;
#pragma unroll
      for (int d0 = 0; d0 < 4; ++d0) o[d0] = f32x16{};
      m_reg = 0.f; l_reg = 0.f;
      attn_tiles_s(c, lds, qr, o, m_reg, l_reg, qi >= 8 ? qi - 8 : 0, qi + 1, wv); }
    nsa_finalize(lds, o, l_reg, P, ON, gb, b, g, tok0, 2, wv);
}

constexpr int LDS_BYTES = 147456;
constexpr int LDS_MISC = 131072;
constexpr int LDS_ARGS = LDS_MISC + 64;
__device__ __forceinline__ unsigned long long arg_u64(LAS unsigned char* lds, int i) {
    const LAS unsigned* p = (const LAS unsigned*)(opq_lds(lds) + LDS_ARGS) + 2 * i;
    const unsigned lo = __builtin_amdgcn_readfirstlane(p[0]), hi = __builtin_amdgcn_readfirstlane(p[1]);
    return ((unsigned long long)hi << 32) | lo;
}
#define GAS __attribute__((address_space(1)))
__device__ __forceinline__ const float* arg_in(LAS unsigned char* lds, int i) { return (const float*)(GAS const float*)arg_u64(lds, i); }
__device__ __forceinline__ float* arg_out(LAS unsigned char* lds) { return (float*)(GAS float*)arg_u64(lds, 24); }
__device__ __forceinline__ unsigned char* arg_ws(LAS unsigned char* lds) { return (unsigned char*)(GAS unsigned char*)arg_u64(lds, 25); }
__device__ __forceinline__ int opq_bx() { int b = blockIdx.x; asm volatile("" : "+s"(b)); return b; }
__device__ __forceinline__ int opq_g() { int b = gridDim.x; asm volatile("" : "+s"(b)); return b; }

__device__ __forceinline__ void ph_prologue(LAS unsigned char* lds, const int wv) {
    lds = opq_lds(lds);
    const int tid = opq_tid(wv), lane = tid & 63, wave = __builtin_amdgcn_readfirstlane(tid >> 6), G = opq_g(), bx = opq_bx();
    const int gw = bx * NWAVES + wave, NGW = G * NWAVES;
    unsigned char* ws = arg_ws(lds);
    LAS float* scr = (LAS float*)(lds + wave * 16384);
    constexpr int I_UP = 32 * 176, I_DN = 88 * 64, I_IN = 32 * 177, I_OUT = 32 * 64, I_C1 = 64 * 16, I_Z = 928;
    constexpr int I_FFN = 2 * I_UP + I_DN, I_LAYER = 2 * I_FFN + I_IN + I_OUT + 2 * I_C1 + I_Z;
#pragma unroll 1
    for (int it = gw; it < DEPTH * I_LAYER; it += NGW) {
        const int l = it / I_LAYER; int r = it - l * I_LAYER;
        if (r < 2 * I_FFN) { const int half = r >= I_FFN; r -= half * I_FFN;
            bf16_t* WUP = (bf16_t*)(ws + WS_WUP + (size_t)(l * 2 + half) * SZ_WUP); bf16_t* WDN = (bf16_t*)(ws + WS_WDN + (size_t)(l * 2 + half) * SZ_WDN);
            const float* gn = arg_in(lds, half ? I_F2N : I_F1N) + (size_t)l * DM;
            if (r < I_UP) { transpose_item(arg_in(lds, half ? I_F2W1 : I_F1W1) + (size_t)l * DM * DFF, DM, DFF, WUP, 1, 0, scr, r, lane, gn); continue; } r -= I_UP;
            if (r < I_UP) { transpose_item(arg_in(lds, half ? I_F2W3 : I_F1W3) + (size_t)l * DM * DFF, DM, DFF, WUP, 1, 128, scr, r, lane, gn); continue; } r -= I_UP;
            transpose_item(arg_in(lds, half ? I_F2W2 : I_F1W2) + (size_t)l * DFF * DM, DFF, DM, WDN, 0, 0, scr, r, lane, nullptr); continue; }
        r -= 2 * I_FFN;
        bf16_t* WIN = (bf16_t*)(ws + WS_WIN + (size_t)l * SZ_WIN); bf16_t* WOUT = (bf16_t*)(ws + WS_WOUT + (size_t)l * SZ_WOUT); bf16_t* WC1 = (bf16_t*)(ws + WS_WC1 + (size_t)l * SZ_WC1);
        if (r < I_IN) { transpose_item(arg_in(lds, I_WIN) + (size_t)l * DM * IN_COLS, DM, IN_COLS, WIN, 0, 0, scr, r, lane, arg_in(lds, I_MIXN) + (size_t)l * DM); continue; } r -= I_IN;
        if (r < I_OUT) { transpose_item(arg_in(lds, I_WOUT) + (size_t)l * DM * DM, DM, DM, WOUT, 0, 0, scr, r, lane, nullptr); continue; } r -= I_OUT;
        if (r < I_C1) { transpose_item(arg_in(lds, I_CKW1) + (size_t)l * 4096 * 512, 4096, 512, WC1, 0, 0, scr, r, lane, nullptr); continue; } r -= I_C1;
        if (r < I_C1) { transpose_item(arg_in(lds, I_CVW1) + (size_t)l * 4096 * 512, 4096, 512, WC1, 0, 512, scr, r, lane, nullptr); continue; } r -= I_C1;
        { const int q = r * 64 + lane, kt = q / 1856, rem = q - kt * 1856; u32x4* z = (u32x4*)(WIN + ((size_t)(22 * 32 + kt) * 256 + 24) * 64) + rem; unsigned zr = 0u; asm volatile("" : "+v"(zr)); *z = (u32x4){zr, zr, zr, zr}; }
    }
    const float* xs = arg_in(lds, I_X); bf16_t* XB = (bf16_t*)(ws + WS_HB); float* RSTD = (float*)(ws + WS_RSTD);
    for (int m = gw; m < NTOK; m += NGW) {
        const f32x4* xr = (const f32x4*)(xs + (size_t)m * DM) + lane; f32x4 v[8]; float s = 0.f;
#pragma unroll
        for (int j = 0; j < 8; ++j) { v[j] = xr[64 * j]; s += (v[j].x * v[j].x + v[j].y * v[j].y) + (v[j].z * v[j].z + v[j].w * v[j].w); }
        s = wave_sum(s, lane);
#pragma unroll
        for (int j = 0; j < 8; ++j) { u32x2 w; w.x = cvtpk(v[j].x, v[j].y); w.y = cvtpk(v[j].z, v[j].w); *(u32x2*)(XB + kt_off(m, 256 * j + 4 * lane, DM)) = w; }
        if (lane == 0) RSTD[m] = 1.0f / sqrtf(s * (1.f / DM) + EPS);
    }
}
__device__ __forceinline__ void ph_rstd(LAS unsigned char* lds, const int wv) {
    lds = opq_lds(lds);
    const int tid = opq_tid(wv), G = opq_g(), bx = opq_bx();
    unsigned char* ws = arg_ws(lds); const float* SSQ = (const float*)(ws + WS_SSQ); float* RSTD = (float*)(ws + WS_RSTD);
    for (int m = bx * NTHR + tid; m < NTOK; m += G * NTHR) { const f32x4* p = (const f32x4*)(SSQ + (size_t)m * 32); f32x4 a = p[0];
#pragma unroll
        for (int j = 1; j < 8; ++j) a = a + p[j];
        RSTD[m] = 1.0f / sqrtf(((a.x + a.y) + (a.z + a.w)) * (1.f / DM) + EPS); }
}
__device__ __forceinline__ void ph_headnorm(LAS unsigned char* lds, int l, const int wv) {
    lds = opq_lds(lds);
    const int tid = opq_tid(wv), lane = tid & 63, wave = __builtin_amdgcn_readfirstlane(tid >> 6), G = opq_g(), bx = opq_bx();
    const int gw = bx * NWAVES + wave, NGW = G * NWAVES;
    unsigned char* ws = arg_ws(lds); bf16_t* HP = (bf16_t*)(ws + WS_HP); bf16_t* ACMP = (bf16_t*)(ws + WS_ACMP);
    const float* qna = arg_in(lds, I_QNA) + l * HD; const float* kna = arg_in(lds, I_KNA) + l * HD; const float* qnn = arg_in(lds, I_QNN) + l * HD; const float* knn = arg_in(lds, I_KNN) + l * HD;
    const float* pos = arg_in(lds, I_POS) + (size_t)l * 32 * HD;
    const int e0 = (lane & 15) * 8;
    for (int m = gw; m < NTOK; m += NGW) {
        bf16_t* prow = HP + (size_t)m * PC;
        int cols[3]; u32x4 wl[3];
#pragma unroll
        for (int ch = 0; ch < 3; ++ch) { cols[ch] = (ch < 2) ? C_KA + ch * 512 + lane * 8 : (lane < 32 ? C_KS + lane * 8 : C_KW + (lane - 32) * 8);
            wl[ch] = *(const u32x4*)(prow + cols[ch]); }
        const u32x4 wcv = *(const u32x4*)(prow + C_KC + lane * 8);
#pragma unroll
        for (int ch = 0; ch < 3; ++ch) {
            const float* gp = (ch < 2) ? kna : knn; const float sc = 1.f;
            const u32x4 w = wl[ch];
            float v[8] = {bflo(w.x), bfhi(w.x), bflo(w.y), bfhi(w.y), bflo(w.z), bfhi(w.z), bflo(w.w), bfhi(w.w)};
            float s = 0.f;
#pragma unroll
            for (int i = 0; i < 8; ++i) s += v[i] * v[i];
            s += shx(s, 1, lane); s += shx(s, 2, lane); s += shx(s, 4, lane); s += shx(s, 8, lane);
            const float rs = sc / sqrtf(s * (1.f / HD) + EPS);
            const f32x4 g0 = *(const f32x4*)(gp + e0), g1 = *(const f32x4*)(gp + e0 + 4);
            u32x4 o; o.x = cvtpk(v[0] * rs * g0.x, v[1] * rs * g0.y); o.y = cvtpk(v[2] * rs * g0.z, v[3] * rs * g0.w); o.z = cvtpk(v[4] * rs * g1.x, v[5] * rs * g1.y); o.w = cvtpk(v[6] * rs * g1.z, v[7] * rs * g1.w);
            *(u32x4*)(prow + cols[ch]) = o;
        }
        { const int b = m / SEQ, t = m % SEQ, kv = lane >> 5, gg = (lane >> 4) & 1, c1 = t >> 4, j1 = t & 15;
          const u32x4 w = wcv;
          const float v[8] = {bflo(w.x), bfhi(w.x), bflo(w.y), bfhi(w.y), bflo(w.z), bfhi(w.z), bflo(w.w), bfhi(w.w)};
          const int arow0 = kv * 4096 + (b * 2 + gg) * 512;
          if (c1 <= 510) { const f32x4 p0 = *(const f32x4*)(pos + j1 * HD + e0), p1 = *(const f32x4*)(pos + j1 * HD + e0 + 4);
              u32x4 o; o.x = cvtpk(v[0] + p0.x, v[1] + p0.y); o.y = cvtpk(v[2] + p0.z, v[3] + p0.w); o.z = cvtpk(v[4] + p1.x, v[5] + p1.y); o.w = cvtpk(v[6] + p1.z, v[7] + p1.w);
              *(u32x4*)(ACMP + kt_off(arow0 + c1, j1 * HD + e0, 4096)) = o; }
          else { const u32x4 z = {0u, 0u, 0u, 0u}; *(u32x4*)(ACMP + kt_off(arow0 + 511, j1 * HD + e0, 4096)) = z; *(u32x4*)(ACMP + kt_off(arow0 + 511, (j1 + 16) * HD + e0, 4096)) = z; }
          if (c1 >= 1) { const int j2 = j1 + 16; const f32x4 p0 = *(const f32x4*)(pos + j2 * HD + e0), p1 = *(const f32x4*)(pos + j2 * HD + e0 + 4);
              u32x4 o; o.x = cvtpk(v[0] + p0.x, v[1] + p0.y); o.y = cvtpk(v[2] + p0.z, v[3] + p0.w); o.z = cvtpk(v[4] + p1.x, v[5] + p1.y); o.w = cvtpk(v[6] + p1.z, v[7] + p1.w);
              *(u32x4*)(ACMP + kt_off(arow0 + c1 - 1, j2 * HD + e0, 4096)) = o; } }
    }
}
__device__ __forceinline__ float gelu_tanh(float v) { const float u3 = 0.7978845608028654f * (v + 0.044715f * v * v * v); return 0.5f * v * (2.0f - 2.0f / (__expf(2.0f * u3) + 1.0f)); }
__device__ __forceinline__ void ph_cmp2(LAS unsigned char* lds, int l, const int wv) {
    lds = opq_lds(lds);
    const int tid = opq_tid(wv), lane = tid & 63, wave = __builtin_amdgcn_readfirstlane(tid >> 6), G = opq_g(), bx = opq_bx();
    unsigned char* ws = arg_ws(lds); const float* CP = (const float*)(ws + WS_CP);
    LAS float* CH = (LAS float*)lds;
    LAS float* RED = (LAS float*)(lds + 65536);
    const float* knn = arg_in(lds, I_KNN) + l * HD;
    for (int it = bx; it < 256; it += G) {
        const int R0 = it * 32, kv = R0 >> 12, rl0 = R0 & 4095;
        __syncthreads();
        for (int i4 = tid; i4 < 32 * 128; i4 += NTHR) { const int rr = i4 >> 7, k4 = (i4 & 127) * 4; f32x4 v = {0.f, 0.f, 0.f, 0.f};
#pragma unroll
            for (int ks = 0; ks < 4; ++ks) v = v + *(const f32x4*)(CP + ((size_t)(kv * 4 + ks) * 4096 + rl0 + rr) * 512 + k4);
            f32x4 o; o.x = gelu_tanh(v.x); o.y = gelu_tanh(v.y); o.z = gelu_tanh(v.z); o.w = gelu_tanh(v.w);
            *(LAS f32x4*)(CH + rr * 512 + k4) = o; }
        __syncthreads();
        const int n = tid & 127, rq = tid >> 7;
        const float* w2 = arg_in(lds, kv ? I_CVW2 : I_CKW2) + (size_t)l * 512 * HD + n;
        float acc[8];
#pragma unroll
        for (int i = 0; i < 8; ++i) acc[i] = 0.f;
#pragma unroll 4
        for (int k = 0; k < 512; k += 4) { const float w0 = w2[(size_t)k * HD], w1 = w2[(size_t)(k + 1) * HD], w2v = w2[(size_t)(k + 2) * HD], w3 = w2[(size_t)(k + 3) * HD];
#pragma unroll
            for (int i = 0; i < 8; ++i) { const f32x4 c = *(const LAS f32x4*)(CH + (rq * 8 + i) * 512 + k); acc[i] += (c.x * w0 + c.y * w1) + (c.z * w2v + c.w * w3); } }
        if (kv == 0) {
            float ss[8];
#pragma unroll
            for (int i = 0; i < 8; ++i) ss[i] = wave_sum(acc[i] * acc[i], lane);
            if (lane == 0) {
#pragma unroll
                for (int i = 0; i < 8; ++i) RED[wave * 8 + i] = ss[i]; }
            __syncthreads();
            const float gn = knn[n];
#pragma unroll
            for (int i = 0; i < 8; ++i) { const float tot = RED[(2 * rq) * 8 + i] + RED[(2 * rq + 1) * 8 + i]; acc[i] = acc[i] / sqrtf(tot * (1.f / HD) + EPS) * gn; }
        }
        bf16_t* dst = (bf16_t*)(ws + (kv ? WS_VC + 0 : WS_KC + 0)) + (size_t)(rl0 + rq * 8) * HD + n;
#pragma unroll
        for (int i = 0; i < 8; ++i) dst[(size_t)i * HD] = (bf16_t)f2bf(acc[i]);
    }
}
__device__ __forceinline__ void ph_outnorm(LAS unsigned char* lds, int l, const int wv) {
    lds = opq_lds(lds);
    const int tid = opq_tid(wv), lane = tid & 63, wave = __builtin_amdgcn_readfirstlane(tid >> 6), G = opq_g(), bx = opq_bx();
    const int gw = bx * NWAVES + wave, NGW = G * NWAVES;
    unsigned char* ws = arg_ws(lds); const bf16_t* OA = (const bf16_t*)(ws + WS_OA); const bf16_t* ON = (const bf16_t*)(ws + WS_ON); bf16_t* HB = (bf16_t*)(ws + WS_HP);
    const float* gn = arg_in(lds, I_ON) + (size_t)l * DM;
    for (int m = gw; m < NTOK; m += NGW) {
        const bf16_t* oa = OA + (size_t)m * 1024; bf16_t* y = HB;
        const u32x4 wa = *(const u32x4*)(oa + lane * 8), wb = *(const u32x4*)(oa + 512 + lane * 8);
        u32x4 wn[6];
#pragma unroll
        for (int br = 0; br < 3; ++br) { const bf16_t* onb = ON + ((size_t)br * NTOK + m) * 1024; wn[2 * br] = *(const u32x4*)(onb + lane * 8); wn[2 * br + 1] = *(const u32x4*)(onb + 512 + lane * 8); }
        float va[16] = {bflo(wa.x), bfhi(wa.x), bflo(wa.y), bfhi(wa.y), bflo(wa.z), bfhi(wa.z), bflo(wa.w), bfhi(wa.w), bflo(wb.x), bfhi(wb.x), bflo(wb.y), bfhi(wb.y), bflo(wb.z), bfhi(wb.z), bflo(wb.w), bfhi(wb.w)};
        float sa = 0.f;
#pragma unroll
        for (int i = 0; i < 16; ++i) sa += va[i] * va[i];
        float vs[16]; float sn = 0.f;
#pragma unroll
        for (int i = 0; i < 16; ++i) vs[i] = 0.f;
#pragma unroll
        for (int br = 0; br < 3; ++br) { const u32x4 wc = wn[2 * br], wd = wn[2 * br + 1];
            vs[0] += bflo(wc.x); vs[1] += bfhi(wc.x); vs[2] += bflo(wc.y); vs[3] += bfhi(wc.y); vs[4] += bflo(wc.z); vs[5] += bfhi(wc.z); vs[6] += bflo(wc.w); vs[7] += bfhi(wc.w);
            vs[8] += bflo(wd.x); vs[9] += bfhi(wd.x); vs[10] += bflo(wd.y); vs[11] += bfhi(wd.y); vs[12] += bflo(wd.z); vs[13] += bfhi(wd.z); vs[14] += bflo(wd.w); vs[15] += bfhi(wd.w); }
        const float ra = 1.0f / sqrtf(wave_sum(sa, lane) * (1.f / 1024.f) + EPS);
        { const f32x4 g0 = *(const f32x4*)(gn + lane * 8), g1 = *(const f32x4*)(gn + lane * 8 + 4), g2 = *(const f32x4*)(gn + 512 + lane * 8), g3 = *(const f32x4*)(gn + 512 + lane * 8 + 4);
          u32x4 o; o.x = cvtpk(va[0] * ra * g0.x, va[1] * ra * g0.y); o.y = cvtpk(va[2] * ra * g0.z, va[3] * ra * g0.w); o.z = cvtpk(va[4] * ra * g1.x, va[5] * ra * g1.y); o.w = cvtpk(va[6] * ra * g1.z, va[7] * ra * g1.w);
          *(u32x4*)(y + kt_off(m, lane * 8, DM)) = o;
          o.x = cvtpk(va[8] * ra * g2.x, va[9] * ra * g2.y); o.y = cvtpk(va[10] * ra * g2.z, va[11] * ra * g2.w); o.z = cvtpk(va[12] * ra * g3.x, va[13] * ra * g3.y); o.w = cvtpk(va[14] * ra * g3.z, va[15] * ra * g3.w);
          *(u32x4*)(y + kt_off(m, 512 + lane * 8, DM)) = o; }
#pragma unroll
        for (int i = 0; i < 16; ++i) sn += vs[i] * vs[i];
        const float rn = 1.0f / sqrtf(wave_sum(sn, lane) * (1.f / 1024.f) + EPS);
        { const float* g2 = gn + 1024; const f32x4 g0 = *(const f32x4*)(g2 + lane * 8), g1 = *(const f32x4*)(g2 + lane * 8 + 4), g2a = *(const f32x4*)(g2 + 512 + lane * 8), g3 = *(const f32x4*)(g2 + 512 + lane * 8 + 4);
          u32x4 o; o.x = cvtpk(vs[0] * rn * g0.x, vs[1] * rn * g0.y); o.y = cvtpk(vs[2] * rn * g0.z, vs[3] * rn * g0.w); o.z = cvtpk(vs[4] * rn * g1.x, vs[5] * rn * g1.y); o.w = cvtpk(vs[6] * rn * g1.z, vs[7] * rn * g1.w);
          *(u32x4*)(y + kt_off(m, 1024 + lane * 8, DM)) = o;
          o.x = cvtpk(vs[8] * rn * g2a.x, vs[9] * rn * g2a.y); o.y = cvtpk(vs[10] * rn * g2a.z, vs[11] * rn * g2a.w); o.z = cvtpk(vs[12] * rn * g3.x, vs[13] * rn * g3.y); o.w = cvtpk(vs[14] * rn * g3.z, vs[15] * rn * g3.w);
          *(u32x4*)(y + kt_off(m, 1536 + lane * 8, DM)) = o; }
    }
}

#define GRID_BAR() do { XcdBarrier bar_; bar_.bar = (unsigned*)(arg_ws(lds) + WS_CTL) + CW_BAR; bar_.x = xb_xcc_id(); bar_.st = (volatile LAS unsigned*)(opq_lds(lds) + LDS_MISC + 32); xcd_barrier(bar_, wv); } while (0)
__global__ void __launch_bounds__(NTHR, 2) mega_fwd(Args a) {
    extern __shared__ __attribute__((aligned(16))) unsigned char lds_raw[];
    LAS unsigned char* lds = (LAS unsigned char*)lds_raw;
    const int wv = __builtin_amdgcn_readfirstlane((int)threadIdx.x >> 6);
    {
        const int tid = threadIdx.x;
        for (int u = tid; u < (LDS_BYTES - LDS_MISC) / 4; u += NTHR) ((LAS unsigned*)(lds + LDS_MISC))[u] = 0u;
        __syncthreads();
        if (tid == 0) { LAS unsigned long long* t = (LAS unsigned long long*)(lds + LDS_ARGS);
#pragma unroll
            for (int i = 0; i < 24; ++i) t[i] = (unsigned long long)(uintptr_t)a.in[i];
            t[24] = (unsigned long long)(uintptr_t)a.out; t[25] = (unsigned long long)(uintptr_t)a.ws; }
        __syncthreads();
    }
    (void)xcd_barrier_post((unsigned*)(arg_ws(lds) + WS_CTL) + CW_BAR, (volatile LAS unsigned*)(lds + LDS_MISC + 32));

    { const int tid = opq_tid(wv), G = opq_g(), bx = opq_bx(); const float* rb = arg_in(lds, I_RB); unsigned char* ws = arg_ws(lds);
      float* dilT = (float*)(ws + WS_TBL); float* nsaT = (float*)(ws + WS_TBL + 65536);
      for (int i = bx * NTHR + tid; i < 3 * 8 * DTS + 8 * TBLS; i += G * NTHR) {
          if (i < 3 * 8 * DTS) { const int p = i / (8 * DTS), h = (i / DTS) % 8, df = i % DTS - DT0; const int d = (p == 0) ? 1 : (p == 1 ? 4 : 16);
              dilT[i] = (df >= 0 && df <= 128) ? rb[rel_bucket_dev(df * d) * 16 + h] : 0.f; }
          else { const int j = i - 3 * 8 * DTS, hh = j / TBLS, ds = j % TBLS - TBL0; nsaT[j] = (ds >= 0) ? rb[rel_bucket_dev(ds) * 16 + 8 + hh] : 0.f; } } }

    ph_prologue(lds, wv);
    GRID_BAR();
#pragma unroll 1
    for (int step = 0; step < 2 * DEPTH; ++step) {
        const int l = step >> 1, half = step & 1;
        { unsigned char* ws = arg_ws(lds); const int G = opq_g(), bx = opq_bx();
          pg8::Gemm g{64, 64, DM}; pg8::SchedStd S; S.init(ws + WS_HB, ws + WS_WUP + (size_t)step * SZ_WUP, NTOK, 2 * DFF, DM, DM, G, bx); const pg8::EpiSwiGLU E{(bf16_t*)(ws + WS_HP), DFF, (const float*)(ws + WS_RSTD)};
          pg8::gemm_phase<pg8::EpiSwiGLU, pg8::SchedStd, 32768, 32768>(opq_lds(lds), g, S, E, wv);
        }
        GRID_BAR();
        { unsigned char* ws = arg_ws(lds); const int G = opq_g(), bx = opq_bx(); float* X = arg_out(lds);
          pg8::Gemm g{64, 64, DFF}; pg8::SchedStd S; S.init(ws + WS_HP, ws + WS_WDN + (size_t)step * SZ_WDN, NTOK, DM, DFF, DFF, G, bx, 4);
          pg8::EpiResid E{(step == 2 * DEPTH - 1) ? X : (float*)nullptr, (bf16_t*)(ws + WS_HB), (float*)(ws + WS_SSQ), DM, 0.5f};
          pg8::gemm_phase<pg8::EpiResid, pg8::SchedStd, 32768, 32768>(opq_lds(lds), g, S, E, wv);
        }
        if (step == 2 * DEPTH - 1) break;
        GRID_BAR();
        ph_rstd(lds, wv);
        GRID_BAR();
        if (half == 0) {
            { unsigned char* ws = arg_ws(lds); const int G = opq_g(), bx = opq_bx();
              pg8::Gemm g{64, 64, DM}; pg8::SchedStd S; S.init(ws + WS_HB, ws + WS_WIN + (size_t)l * SZ_WIN, NTOK, PC, DM, DM, G, bx); const pg8::EpiBf16 E{(bf16_t*)(ws + WS_HP), PC, (const float*)(ws + WS_RSTD)};
              pg8::gemm_phase<pg8::EpiBf16, pg8::SchedStd, 32768, 32768>(opq_lds(lds), g, S, E, wv);
            }
            GRID_BAR();
            ph_headnorm(lds, l, wv);
            GRID_BAR();
#pragma unroll 1
            for (int pat3 = 0; pat3 < 3; ++pat3) { const int pat = pat3 % 3;
                if (pat3 == 0) { unsigned char* ws = arg_ws(lds); const int G = opq_g(), bx = opq_bx();
                  pg8::Gemm g{64, 64, 1024}; pg8::SchedCmp S; S.A = (const char*)(ws + WS_ACMP); S.Bt = (const char*)(ws + WS_WC1 + (size_t)l * SZ_WC1); S.G = G; S.c = bx; pg8::EpiF32Z E{(float*)(ws + WS_CP), 512, (size_t)4096 * 512};
                  pg8::gemm_phase<pg8::EpiF32Z, pg8::SchedCmp, 32768, 32768>(opq_lds(lds), g, S, E, wv); }
                if (pat3 == 1) ph_cmp2(lds, l, wv);
                { unsigned char* ws = arg_ws(lds); const int G = opq_g(), bx = opq_bx();
                  for (int u0 = bx; u0 < 1024; u0 += G) { const int w_ = u0 & 255, k_ = u0 >> 8; const int unit = (((w_ & 7) + 8 * k_) << 5) | (w_ >> 3);
                    dil_unit((LAS char*)opq_lds(lds), (const bf16_t*)(ws + WS_HP), (bf16_t*)(ws + WS_OA), (float*)(ws + WS_LSE), (const float*)(ws + WS_TBL), arg_in(lds, I_QNA) + l * HD, pat, 2 * pat, unit, wv); } }
                if (pat3 + 1 < 3) GRID_BAR();
            }
            { unsigned char* ws = arg_ws(lds); const int G = opq_g(), bx = opq_bx();
              const float* gb = arg_in(lds, I_GB) + l * 24; const float* qgn = arg_in(lds, I_QNN) + l * HD;
              int last_bg = -1;
#pragma unroll 1
              for (int i4 = 0; i4 < 4; ++i4)
#pragma unroll 1
                  for (int w = bx; w < 256; w += G) { const int i = i4 & 3; const int bg = w & 7, j = w >> 3;
                      const int qi = (i == 0) ? 127 - j : (i == 1 ? j : (i == 2 ? 64 + j : 63 - j));
                      nsa_unit((LAS char*)opq_lds(lds), (const bf16_t*)(ws + WS_HP), (const bf16_t*)(ws + WS_KC), (const bf16_t*)(ws + WS_VC), (bf16_t*)(ws + WS_ON), (const float*)(ws + WS_TBL + 65536), gb, qgn, bg >> 1, bg & 1, qi, bg != last_bg, wv); last_bg = bg; } }
            GRID_BAR();
            ph_outnorm(lds, l, wv);
            GRID_BAR();
            { unsigned char* ws = arg_ws(lds); const int G = opq_g(), bx = opq_bx(); float* X = arg_out(lds);
              pg8::Gemm g{64, 64, DM}; pg8::SchedStd S; S.init(ws + WS_HP, ws + WS_WOUT + (size_t)l * SZ_WOUT, NTOK, DM, DM, DM, G, bx, 4); pg8::EpiResid E{(float*)nullptr, (bf16_t*)(ws + WS_HB), (float*)(ws + WS_SSQ), DM, 1.0f};
              pg8::gemm_phase<pg8::EpiResid, pg8::SchedStd, 32768, 32768>(opq_lds(lds), g, S, E, wv);
            }
            GRID_BAR();
            ph_rstd(lds, wv);
            GRID_BAR();
        }
    }
}

extern "C" void kernel_launch(void* const* d_in, const int* in_sizes, int n_in, void* d_out, int out_size, void* d_ws, size_t ws_size, hipStream_t stream) {
    static int grid = 0;
    if (grid == 0) {
        if (n_in != 24 || in_sizes[0] != NTOK * DM || out_size != NTOK * DM || ws_size < WS_END) { fprintf(stderr, "kernel_launch: shape mismatch n_in %d in0 %d out %d ws %zu (need %zu)\n", n_in, n_in > 0 ? in_sizes[0] : -1, out_size, ws_size, (size_t)WS_END); grid = -1; return; }
        int dev = 0, cus = 0, per_cu = 0;
        if (hipGetDevice(&dev) != hipSuccess || hipDeviceGetAttribute(&cus, hipDeviceAttributeMultiprocessorCount, dev) != hipSuccess) { grid = -1; return; }
        if (hipFuncSetAttribute((const void*)mega_fwd, hipFuncAttributeMaxDynamicSharedMemorySize, LDS_BYTES) != hipSuccess) { fprintf(stderr, "kernel_launch: hipFuncSetAttribute failed\n"); grid = -1; return; }
        if (hipOccupancyMaxActiveBlocksPerMultiprocessor(&per_cu, (const void*)mega_fwd, NTHR, LDS_BYTES) != hipSuccess || per_cu < 1) { fprintf(stderr, "kernel_launch: occupancy query says %d\n", per_cu); (void)hipGetLastError(); if (per_cu < 1) { grid = -1; return; } }
        grid = cus;
    }
    if (grid < 0) return;
    if (hipMemsetAsync((char*)d_ws + WS_CTL, 0, CTL_ZERO_BYTES, stream) != hipSuccess) return;
    Args a{};
    for (int i = 0; i < 24; ++i) a.in[i] = (const float*)d_in[i];
    a.out = (float*)d_out; a.ws = (unsigned char*)d_ws;
    hipLaunchKernelGGL(mega_fwd, dim3(grid), dim3(NTHR), LDS_BYTES, stream, a);
    const hipError_t le = hipPeekAtLastError();
    if (le != hipSuccess) fprintf(stderr, "kernel_launch: launch failed: %s\n", hipGetErrorName(le));
}
```

```cpp
#include <hip/hip_runtime.h>
#include <cstdio>
#include <cstdint>

#define LAS __attribute__((address_space(3)))
typedef unsigned short bf16_t;
typedef short bf16x8 __attribute__((ext_vector_type(8)));
typedef short s16x4 __attribute__((ext_vector_type(4)));
typedef float f32x2 __attribute__((ext_vector_type(2)));
typedef float f32x4 __attribute__((ext_vector_type(4)));
typedef float f32x16 __attribute__((ext_vector_type(16)));
typedef unsigned u32x2 __attribute__((ext_vector_type(2)));
typedef unsigned u32x4 __attribute__((ext_vector_type(4)));

constexpr int BATCH = 4, SEQ = 8192, DM = 2048, DFF = 5632, NTOK = BATCH * SEQ, DEPTH = 4, HD = 128;
constexpr int IN_COLS = 5656, PC = 5888;
constexpr int C_QA = 0, C_KA = 1024, C_VA = 2048, C_QN = 3072, C_KC = 4096, C_VC = 4352, C_KS = 4608, C_VS = 4864, C_KW = 5120, C_VW = 5376, C_GL = 5632;
constexpr float EPS = 1e-6f, QSCALE = 0.08838834764831845f, LOG2E = 1.4426950408889634f;
constexpr int TBLS = 1704, TBL0 = 64;
constexpr int DTS = 320, DT0 = 96;
constexpr int NWAVES = 8, NTHR = 512;

constexpr size_t MiB = 1u << 20;
constexpr size_t WS_CTL = 0, CTL_ZERO_BYTES = 1 * MiB;
constexpr size_t WS_TBL = 1 * MiB;
constexpr size_t SZ_WUP = 44 * MiB, SZ_WDN = 22 * MiB, SZ_WIN = 23 * MiB, SZ_WOUT = 8 * MiB, SZ_WC1 = 8 * MiB;
constexpr size_t WS_WUP = 2 * MiB;
constexpr size_t WS_WDN = WS_WUP + 8 * SZ_WUP;
constexpr size_t WS_WIN = WS_WDN + 8 * SZ_WDN;
constexpr size_t WS_WOUT = WS_WIN + 4 * SZ_WIN;
constexpr size_t WS_WC1 = WS_WOUT + 4 * SZ_WOUT;
constexpr size_t WS_HB = WS_WC1 + 4 * SZ_WC1;
constexpr size_t WS_HP = WS_HB + 128 * MiB;
constexpr size_t WS_OA = WS_HP + 368 * MiB;
constexpr size_t WS_LSE = WS_OA + 64 * MiB;
constexpr size_t WS_ON = WS_LSE + 1 * MiB;
constexpr size_t WS_ACMP = WS_ON + 192 * MiB;
constexpr size_t WS_CP = WS_ACMP + 64 * MiB;
constexpr size_t WS_KC = WS_CP + 64 * MiB;
constexpr size_t WS_VC = WS_KC + 1 * MiB;
constexpr size_t WS_SSQ = WS_VC + 1 * MiB;
constexpr size_t WS_RSTD = WS_SSQ + 4 * MiB;
constexpr size_t WS_END = WS_RSTD + 1 * MiB;
constexpr int CW_BAR = 4096;

__device__ __forceinline__ unsigned f2bf(float f) { unsigned u = __builtin_bit_cast(unsigned, f); return (u + 0x7fffu + ((u >> 16) & 1u)) >> 16; }
__device__ __forceinline__ unsigned pk2(float lo, float hi) { return f2bf(lo) | (f2bf(hi) << 16); }
__device__ __forceinline__ float bf2f(bf16_t b) { return __builtin_bit_cast(float, ((unsigned)b) << 16); }
__device__ __forceinline__ float bflo(unsigned w) { return __builtin_bit_cast(float, w << 16); }
__device__ __forceinline__ float bfhi(unsigned w) { return __builtin_bit_cast(float, w & 0xffff0000u); }
__device__ __forceinline__ unsigned cvtpk(float lo, float hi) { unsigned r; asm volatile("v_cvt_pk_bf16_f32 %0, %1, %2" : "=v"(r) : "v"(lo), "v"(hi)); return r; }
__device__ __forceinline__ float shx(float v, int m, int lane) { return __builtin_bit_cast(float, __builtin_amdgcn_ds_bpermute((lane ^ m) << 2, __builtin_bit_cast(int, v))); }
__device__ __forceinline__ float wave_sum(float v, int lane) {
#pragma unroll
    for (int o = 1; o < 64; o <<= 1) v += shx(v, o, lane);
    return v;
}
__device__ __forceinline__ LAS unsigned char* opq_lds(LAS unsigned char* p) { unsigned a = (unsigned)(uintptr_t)p; asm volatile("" : "+s"(a)); return (LAS unsigned char*)(uintptr_t)a; }
__device__ __forceinline__ int opq_tid(int wv) { int l; asm volatile("v_mbcnt_lo_u32_b32 %0, -1, 0\n\tv_mbcnt_hi_u32_b32 %0, -1, %0" : "=v"(l)); return wv * 64 + l; }
__device__ __forceinline__ size_t kt_off(int r, int k, int K) { return (((size_t)(r >> 8) * (K >> 6) + (k >> 6)) * 256 + (r & 255)) * 64 + (k & 63); }
#define LDS_WAIT() asm volatile("s_waitcnt lgkmcnt(0)" ::: "memory")
#define VM_WAIT() asm volatile("s_waitcnt vmcnt(0)" ::: "memory")
#define SBAR() __builtin_amdgcn_sched_barrier(0)

#define XB_TMO      128
#define XB_XCNT(j)  (256  + 64 * (j))
#define XB_XSUB(j)  (1280 + 64 * (j))
#define XB_XGEN(j)  (2304 + 64 * (j))
#define XB_TOP      3328
#define XB_TOPGEN   3392
#define XCD_BAR_WORDS 3456
#define XB_SPIN_CAP (1u << 18)
__device__ __forceinline__ unsigned xb_ld(unsigned* p)              { return __hip_atomic_load(p, __ATOMIC_RELAXED, __HIP_MEMORY_SCOPE_AGENT); }
__device__ __forceinline__ unsigned xb_add(unsigned* p, unsigned v) { return __hip_atomic_fetch_add(p, v, __ATOMIC_RELAXED, __HIP_MEMORY_SCOPE_AGENT); }
__device__ __forceinline__ unsigned xb_xcc_id() { return (unsigned)__builtin_amdgcn_s_getreg((3 << 11) | 20) & 0xFu; }
#define XB_SPIN(cond, bar) do { unsigned _sp = 0; while (cond) { __builtin_amdgcn_s_sleep(1); \
    if ((++_sp & 255u) == 0u) { if (xb_ld(&(bar)[XB_TMO])) break; if (_sp > XB_SPIN_CAP) { atomicAdd(&(bar)[XB_TMO], 1u); break; } } } } while (0)
struct XcdBarrier { unsigned* bar; unsigned x; volatile LAS unsigned* st; };
__device__ __forceinline__ XcdBarrier xcd_barrier_post(unsigned* bar, volatile LAS unsigned* st) {
    XcdBarrier b; b.bar = bar; b.x = xb_xcc_id(); b.st = st;
    if (threadIdx.x == 0) (void)xb_add(&bar[XB_XCNT(b.x)], 1u);
    return b;
}
__device__ __forceinline__ void xcd_barrier_complete(unsigned* bar, unsigned x, unsigned& nloc, unsigned& nx) {
    const unsigned G = gridDim.x * gridDim.y * gridDim.z;
    unsigned sum, cnt, mine, sp = 0u;
    for (;;) {
        sum = 0u; cnt = 0u; mine = 0u;
#pragma unroll
        for (unsigned j = 0; j < 16; ++j) { const unsigned c = xb_ld(&bar[XB_XCNT(j)]); sum += c; cnt += (c > 0u) ? 1u : 0u; mine = (j == x) ? c : mine; }
        if (sum == G) break;
        __builtin_amdgcn_s_sleep(1);
        if ((++sp & 255u) == 0u) { if (xb_ld(&bar[XB_TMO])) break; if (sp > XB_SPIN_CAP) { atomicAdd(&bar[XB_TMO], 1u); break; } }
    }
    nloc = mine > 0u ? mine : 1u; nx = cnt > 0u ? cnt : 1u;
}
__device__ __forceinline__ void xcd_barrier(const XcdBarrier& b, const int wv) {
    asm volatile("s_waitcnt vmcnt(0)" ::: "memory");
    __syncthreads();
    if (opq_tid(wv) == 0) {
        unsigned* bar = b.bar; asm volatile("" : "+s"(bar));
        __builtin_amdgcn_s_waitcnt(0);
        unsigned nloc = b.st[0], nx = b.st[1];
        if (nloc == 0u) { xcd_barrier_complete(bar, b.x, nloc, nx); b.st[0] = nloc; b.st[1] = nx; }
        const unsigned old = xb_add(&bar[XB_XSUB(b.x)], 1u);
        const unsigned gen = old / nloc;
        if (old + 1u == (gen + 1u) * nloc) {
            __builtin_amdgcn_fence(__ATOMIC_RELEASE, "agent");
            asm volatile("s_waitcnt vmcnt(0)" ::: "memory");
            const unsigned og = xb_add(&bar[XB_TOP], 1u);
            const unsigned tg = og / nx;
            if (og + 1u == (tg + 1u) * nx) xb_add(&bar[XB_TOPGEN], 1u);
            else XB_SPIN(xb_ld(&bar[XB_TOPGEN]) == tg, bar);
            __builtin_amdgcn_fence(__ATOMIC_ACQUIRE, "agent");
            xb_add(&bar[XB_XGEN(b.x)], 1u);
            asm volatile("s_waitcnt vmcnt(0)" ::: "memory");
        } else {
            XB_SPIN(xb_ld(&bar[XB_XGEN(b.x)]) == gen, bar);
            __builtin_amdgcn_fence(__ATOMIC_ACQUIRE, "agent");
            asm volatile("s_waitcnt vmcnt(0)" ::: "memory");
        }
    }
    __syncthreads();
}

namespace pg8 {
constexpr int BM = 256, BK = 64, HALF = 128, HTB = HALF * BK * 2, STAGE_BYTES = 8 * HTB, NXCD = 8, WGM = 8;
__host__ __device__ __forceinline__ int lds_byte(int r, int c) { const int st = (r >> 4) * 2 + (c >> 5), rr = r & 15, cc = c & 31, ob = rr * 64 + cc * 2; return st * 1024 + (ob ^ (((ob >> 9) & 1) << 5)); }
__host__ __device__ __forceinline__ void stage_rc(int b, int& R, int& C) { const int st = b / 1024, sb = b % 1024, swz = sb ^ (((sb >> 9) & 1) << 5); R = (st >> 1) * 16 + swz / 64; C = (st & 1) * 32 + (swz % 64) / 2; }
__host__ __device__ __forceinline__ int perm32(int rho) { const int n = rho >> 4, i = rho & 15; return 8 * (i >> 2) + 4 * n + (i & 3); }
struct Unit { int pm, pn, z; };
struct Gemm { int lda, ldb, K; };
struct SchedStd {
    const char* A; const char* Bt; size_t atile, btile; int nM, nN, nwg, G, c, wgm;
    __device__ __forceinline__ void init(const void* A_, const void* Bt_, int M, int N, int lda, int ldb, int G_, int c_, int wgm_ = WGM) { wgm = wgm_;
        A = (const char*)A_; Bt = (const char*)Bt_; atile = (size_t)BM * lda * 2; btile = (size_t)BM * ldb * 2; nM = M / BM; nN = N / BM; nwg = nM * nN; G = G_; c = c_; }
    __device__ __forceinline__ bool next(int i, Unit& u) const {
        const long L = (long)i * G + c; if (L >= nwg) return false;
        int wgid = (int)L; { const int q = nwg / NXCD, r = nwg % NXCD, xcd = wgid % NXCD, off = wgid / NXCD; wgid = (xcd < r ? xcd * (q + 1) : r * (q + 1) + (xcd - r) * q) + off; }
        const int nig = wgm * nN, gid = wgid / nig, fm = gid * wgm, gsz = (nM - fm) < wgm ? (nM - fm) : wgm;
        u.pm = fm + ((wgid % nig) % gsz); u.pn = (wgid % nig) / gsz; u.z = 0; return true;
    }
    __device__ __forceinline__ const char* a_ptr(const Unit& u) const { return A + (size_t)u.pm * atile; }
    __device__ __forceinline__ const char* b_ptr(const Unit& u) const { return Bt + (size_t)u.pn * btile; }
};
struct SchedCmp {
    const char* A; const char* Bt; int G, c;
    __device__ __forceinline__ bool next(int i, Unit& u) const { const int L = i * G + c; if (L >= 256) return false; u.z = L >> 5; u.pm = (L & 31) >> 1; u.pn = L & 1; return true; }
    __device__ __forceinline__ const char* a_ptr(const Unit& u) const { const int kv = u.z >> 2, ks = u.z & 3; return A + ((size_t)(kv * 16 + u.pm) * 64 + (size_t)ks * 16) * 32768; }
    __device__ __forceinline__ const char* b_ptr(const Unit& u) const { const int kv = u.z >> 2, ks = u.z & 3; return Bt + ((size_t)(kv * 2 + u.pn) * 64 + (size_t)ks * 16) * 32768; }
};
struct EpiBf16 {
    static constexpr bool PERM = true;
    bf16_t* O; int ldc; const float* rstd;
    __device__ __forceinline__ void prefetch(float (&pre)[8], const Unit& u, int wr, int fr) const {
#pragma unroll
        for (int i = 0; i < 8; ++i) pre[i] = rstd[u.pm * BM + wr * 64 + fr + (i >> 2) * HALF + (i & 3) * 16]; }
    __device__ __forceinline__ void operator()(const f32x4 (&acc)[2][2][4][2], const Unit& u, int wr, int wc, int fr, int fq, const float (&pre)[8]) const {
        const int row0 = u.pm * BM + wr * 64 + fr, col0 = u.pn * BM + wc * 32 + 8 * fq;
#pragma unroll
        for (int ai = 0; ai < 2; ++ai)
#pragma unroll
            for (int m = 0; m < 4; ++m) { bf16_t* rowp = O + (size_t)(row0 + ai * HALF + m * 16) * ldc + col0; const float rs = pre[ai * 4 + m];
#pragma unroll
                for (int bj = 0; bj < 2; ++bj) { const f32x4 v0 = acc[ai][bj][m][0] * rs, v1 = acc[ai][bj][m][1] * rs;
                    u32x4 w; w.x = cvtpk(v0[0], v0[1]); w.y = cvtpk(v0[2], v0[3]); w.z = cvtpk(v1[0], v1[1]); w.w = cvtpk(v1[2], v1[3]);
                    *(u32x4*)(rowp + bj * HALF) = w; } }
    }
};
struct EpiSwiGLU {
    static constexpr bool PERM = true;
    bf16_t* O; int ldc; const float* rstd;
    __device__ __forceinline__ void prefetch(float (&pre)[8], const Unit& u, int wr, int fr) const {
#pragma unroll
        for (int i = 0; i < 8; ++i) pre[i] = rstd[u.pm * BM + wr * 64 + fr + (i >> 2) * HALF + (i & 3) * 16]; }
    __device__ __forceinline__ void operator()(const f32x4 (&acc)[2][2][4][2], const Unit& u, int wr, int wc, int fr, int fq, const float (&pre)[8]) const {
        const int rowp0 = wr * 64 + fr, kt = 2 * u.pn + (wc >> 1), cit = (wc & 1) * 32 + 8 * fq;
        bf16_t* tile = O + ((size_t)u.pm * (ldc / 64) + kt) * (256 * 64) + cit;
#pragma unroll
        for (int ai = 0; ai < 2; ++ai)
#pragma unroll
            for (int m = 0; m < 4; ++m) { bf16_t* rowp = tile + (size_t)(rowp0 + ai * HALF + m * 16) * 64; const float rs = pre[ai * 4 + m];
                float v[8];
#pragma unroll
                for (int n = 0; n < 2; ++n)
#pragma unroll
                    for (int j = 0; j < 4; ++j) { const float g = acc[ai][0][m][n][j] * rs, up = acc[ai][1][m][n][j] * rs;
                        const float s = g * __builtin_amdgcn_rcpf(1.0f + __builtin_amdgcn_exp2f(-g * LOG2E)); v[n * 4 + j] = s * up; }
                u32x4 w; w.x = cvtpk(v[0], v[1]); w.y = cvtpk(v[2], v[3]); w.z = cvtpk(v[4], v[5]); w.w = cvtpk(v[6], v[7]);
                *(u32x4*)rowp = w; }
    }
};
struct EpiResid {
    static constexpr bool PERM = false;
    __device__ __forceinline__ void prefetch(float (&)[8], const Unit&, int, int) const {}
    float* out; bf16_t* xb; float* ssq; int ldc; float alpha;
    __device__ __forceinline__ void operator()(const f32x4 (&acc)[2][2][4][2], const Unit& u, int wr, int wc, int fr, int fq, const float (&pre)[8]) const {
        const int row0 = u.pm * BM + wr * 64 + fr, col0 = u.pn * BM + wc * 32 + 4 * fq;
        u32x2 bs[4][4];
#define ER_LOAD(g) do { const int row_ = row0 + ((g) >> 2) * HALF + ((g) & 3) * 16; \
        _Pragma("unroll") for (int q_ = 0; q_ < 4; ++q_) bs[(g) & 3][q_] = *(const u32x2*)(xb + kt_off(row_, col0 + (q_ >> 1) * HALF + (q_ & 1) * 16, ldc)); } while (0)
        ER_LOAD(0); ER_LOAD(1); ER_LOAD(2); ER_LOAD(3);
#pragma unroll
        for (int g = 0; g < 8; ++g) { const int ai = g >> 2, m = g & 3; const int row = row0 + ai * HALF + m * 16; float ss = 0.f;
#pragma unroll
            for (int q = 0; q < 4; ++q) { const int bj = q >> 1, n = q & 1; const u32x2 b = bs[g & 3][q];
                const f32x4 o = (f32x4){bflo(b.x), bfhi(b.x), bflo(b.y), bfhi(b.y)} + acc[ai][bj][m][n] * alpha;
                ss += (o.x * o.x + o.y * o.y) + (o.z * o.z + o.w * o.w);
                u32x2 w; w.x = cvtpk(o.x, o.y); w.y = cvtpk(o.z, o.w); *(u32x2*)(xb + kt_off(row, col0 + bj * HALF + n * 16, ldc)) = w;
                if (out) *(f32x4*)(out + (size_t)row * ldc + col0 + bj * HALF + n * 16) = o; }
            if (g + 4 < 8) ER_LOAD(g + 4);
            const int lane = fq * 16 + fr; ss += shx(ss, 16, lane); ss += shx(ss, 32, lane);
            if (fq == 0) ssq[(size_t)row * 32 + u.pn * 4 + wc] = ss; }
#undef ER_LOAD
    }
};
struct EpiF32Z {
    static constexpr bool PERM = false;
    float* C; int ldc; size_t zstride;
    __device__ __forceinline__ void prefetch(float (&)[8], const Unit&, int, int) const {}
    __device__ __forceinline__ void operator()(const f32x4 (&acc)[2][2][4][2], const Unit& u, int wr, int wc, int fr, int fq, const float (&pre)[8]) const {
        float* Cz = C + (size_t)u.z * zstride;
        const int row0 = u.pm * BM + wr * 64 + fr, col0 = u.pn * BM + wc * 32 + 4 * fq;
#pragma unroll
        for (int ai = 0; ai < 2; ++ai)
#pragma unroll
            for (int m = 0; m < 4; ++m) { float* rowp = Cz + (size_t)(row0 + ai * HALF + m * 16) * ldc + col0;
#pragma unroll
                for (int bj = 0; bj < 2; ++bj)
#pragma unroll
                    for (int n = 0; n < 2; ++n) *(f32x4*)(rowp + bj * HALF + n * 16) = acc[ai][bj][m][n]; }
    }
};

template <class Epi, class Sched, int KSTEP_A = 128, int KSTEP_B = 128>
__device__ __forceinline__ void gemm_phase(LAS unsigned char* lds, const Gemm g, const Sched& S, const Epi& E, const int wv) {
    const int tid = opq_tid(wv), wid = __builtin_amdgcn_readfirstlane(tid >> 6), lane = tid & 63, wr = wid >> 2, wc = wid & 3, fr = lane & 15, fq = lane >> 4;
    const int K = g.K, nt = K / BK;
    unsigned voffA[2], voffB[2];
#pragma unroll
    for (int i = 0; i < 2; ++i) { int R, C; stage_rc(tid * 16 + i * 8192, R, C); const int Rb = Epi::PERM ? ((R & ~31) + perm32(R & 31)) : R;
        voffA[i] = (unsigned)(R * g.lda + C) * 2u; voffB[i] = (unsigned)(Rb * g.ldb + C) * 2u; }
    constexpr size_t kstepA = (size_t)KSTEP_A, kstepB = (size_t)KSTEP_B;
    const size_t hstepA = (size_t)HALF * g.lda * 2, hstepB = (size_t)HALF * g.ldb * 2;
    const unsigned ldsw = (unsigned)wid * 1024u;
    const int aoff = lds_byte(wr * 64 + fr, fq * 8), boff = lds_byte(wc * 32 + fr, fq * 8);
#define PG8_SA(b, h) (((b) * 2 + (h)) * HTB)
#define PG8_SB(b, h) ((4 + (b) * 2 + (h)) * HTB)
#define PG8_STAGE(bufoff, gbase, voff) do { _Pragma("unroll") for (int _i = 0; _i < 2; ++_i) \
        __builtin_amdgcn_global_load_lds((const unsigned*)((const char*)(gbase) + (voff)[_i]), (LAS unsigned*)(lds + (bufoff) + ldsw + _i * 8192), 16, 0, 0); } while (0)
#define PG8_LDA(dst, b, h) do { _Pragma("unroll") for (int m = 0; m < 4; ++m) _Pragma("unroll") for (int k = 0; k < 2; ++k) dst[m][k] = *(const LAS bf16x8*)(lds + PG8_SA(b, h) + aoff + m * 2048 + k * 1024); } while (0)
#define PG8_LDB(dst, b, h) do { _Pragma("unroll") for (int n = 0; n < 2; ++n) _Pragma("unroll") for (int k = 0; k < 2; ++k) dst[n][k] = *(const LAS bf16x8*)(lds + PG8_SB(b, h) + boff + n * 2048 + k * 1024); } while (0)
#define PG8_MMA(ai, bj, At, Bt) do { __builtin_amdgcn_s_setprio(1); _Pragma("unroll") for (int m = 0; m < 4; ++m) _Pragma("unroll") for (int n = 0; n < 2; ++n) _Pragma("unroll") for (int k = 0; k < 2; ++k) \
        acc[ai][bj][m][n] = __builtin_amdgcn_mfma_f32_16x16x32_bf16(Bt[n][k], At[m][k], acc[ai][bj][m][n], 0, 0, 0); __builtin_amdgcn_s_setprio(0); } while (0)
#define PG8_WAIT_V(n) asm volatile("s_waitcnt vmcnt(" #n ")" ::: "memory")
#define PG8_WAIT_L(n) asm volatile("s_waitcnt lgkmcnt(" #n ")" ::: "memory")
#define PG8_BAR __builtin_amdgcn_s_barrier()
#define PG8_SCHED __builtin_amdgcn_sched_barrier(0)
    Unit cur, nxt; int ui = 0;
    if (!S.next(0, cur)) return;
    f32x4 acc[2][2][4][2];
#pragma unroll
    for (int a = 0; a < 2; ++a)
#pragma unroll
        for (int b = 0; b < 2; ++b)
#pragma unroll
            for (int m = 0; m < 4; ++m)
#pragma unroll
                for (int n = 0; n < 2; ++n) acc[a][b][m][n] = (f32x4){0.f, 0.f, 0.f, 0.f};
    bf16x8 At[4][2], B0[2][2], B1[2][2];
    const char* cA = S.a_ptr(cur); const char* cB = S.b_ptr(cur);
    float pre[8]; E.prefetch(pre, cur, wr, fr);
    PG8_STAGE(PG8_SB(0, 0), cB, voffB); PG8_STAGE(PG8_SA(0, 0), cA, voffA); PG8_STAGE(PG8_SB(0, 1), cB + hstepB, voffB); PG8_STAGE(PG8_SA(0, 1), cA + hstepA, voffA);
    if (wr == 1) PG8_BAR;
    PG8_WAIT_V(4); PG8_BAR;
    PG8_STAGE(PG8_SB(1, 0), cB + kstepB, voffB); PG8_STAGE(PG8_SA(1, 0), cA + kstepA, voffA); PG8_STAGE(PG8_SB(1, 1), cB + hstepB + kstepB, voffB);
    PG8_WAIT_V(6); PG8_BAR;
    for (;;) {
        const bool has_next = S.next(ui + 1, nxt);
        const char* nA = has_next ? S.a_ptr(nxt) : cA; const char* nB = has_next ? S.b_ptr(nxt) : cB;
        for (int t = 0; t < nt; t += 2) {
            const bool last = (t == nt - 2);
            const char* a1 = cA + (size_t)(t + 1) * kstepA;
            const char* a2 = last ? nA : cA + (size_t)(t + 2) * kstepA; const char* b2 = last ? nB : cB + (size_t)(t + 2) * kstepB;
            const char* a3 = a2 + kstepA; const char* b3 = b2 + kstepB;
            PG8_LDB(B0, 0, 0); PG8_SCHED; PG8_LDA(At, 0, 0); PG8_STAGE(PG8_SA(1, 1), a1 + hstepA, voffA);
            PG8_WAIT_L(8); PG8_BAR; PG8_WAIT_L(0); PG8_MMA(0, 0, At, B0); PG8_BAR; PG8_SCHED;
            PG8_LDB(B1, 0, 1); PG8_STAGE(PG8_SB(0, 0), b2, voffB);
            PG8_BAR; PG8_WAIT_L(0); PG8_MMA(0, 1, At, B1); PG8_BAR;
            PG8_LDA(At, 0, 1); PG8_STAGE(PG8_SA(0, 0), a2, voffA);
            PG8_BAR; PG8_WAIT_L(0); PG8_MMA(1, 0, At, B0); PG8_BAR; PG8_SCHED;
            PG8_STAGE(PG8_SB(0, 1), b2 + hstepB, voffB);
            PG8_WAIT_V(6); PG8_BAR; PG8_MMA(1, 1, At, B1); PG8_BAR;
            PG8_LDB(B0, 1, 0); PG8_SCHED; PG8_LDA(At, 1, 0); PG8_STAGE(PG8_SA(0, 1), a2 + hstepA, voffA);
            PG8_WAIT_L(8); PG8_BAR; PG8_WAIT_L(0); PG8_MMA(0, 0, At, B0); PG8_BAR; PG8_SCHED;
            PG8_LDB(B1, 1, 1); PG8_STAGE(PG8_SB(1, 0), b3, voffB);
            PG8_BAR; PG8_WAIT_L(0); PG8_MMA(0, 1, At, B1); PG8_BAR;
            PG8_LDA(At, 1, 1); PG8_STAGE(PG8_SA(1, 0), a3, voffA);
            PG8_BAR; PG8_WAIT_L(0); PG8_MMA(1, 0, At, B0); PG8_BAR; PG8_SCHED;
            PG8_STAGE(PG8_SB(1, 1), b3 + hstepB, voffB);
            PG8_WAIT_V(6); PG8_BAR; PG8_MMA(1, 1, At, B1); PG8_BAR;
        }
        E(acc, cur, wr, wc, fr, fq, pre);
        if (has_next) E.prefetch(pre, nxt, wr, fr);
        if (!has_next) break;
#pragma unroll
        for (int a = 0; a < 2; ++a)
#pragma unroll
            for (int b = 0; b < 2; ++b)
#pragma unroll
                for (int m = 0; m < 4; ++m)
#pragma unroll
                    for (int n = 0; n < 2; ++n) acc[a][b][m][n] = (f32x4){0.f, 0.f, 0.f, 0.f};
        cur = nxt; cA = nA; cB = nB; ++ui;
    }
    PG8_WAIT_V(0);
    if (wr == 0) PG8_BAR;
    PG8_BAR;
#undef PG8_SA
#undef PG8_SB
#undef PG8_STAGE
#undef PG8_LDA
#undef PG8_LDB
#undef PG8_MMA
#undef PG8_WAIT_V
#undef PG8_WAIT_L
#undef PG8_BAR
#undef PG8_SCHED
}
}

struct Args { const float* in[24]; float* out; unsigned char* ws; };
enum { I_X = 0, I_F1N, I_F1W1, I_F1W3, I_F1W2, I_MIXN, I_WIN, I_GB, I_QNA, I_KNA, I_QNN, I_KNN, I_POS, I_CKW1, I_CKW2, I_CVW1, I_CVW2, I_ON, I_WOUT, I_F2N, I_F2W1, I_F2W3, I_F2W2, I_RB };

__device__ __forceinline__ void transpose_item(const float* W, int K, int N, bf16_t* WT, int mode, int off, LAS float* scr, int item, int lane, const float* gain) {
    const int nblk = (N + 31) / 32, kb = item / nblk, nb = item % nblk, k0 = 64 * kb, n0 = 32 * nb;
    const int c4 = 4 * (lane & 7), nn = n0 + c4;
    f32x4 ld[8];
#pragma unroll
    for (int i = 0; i < 8; ++i) { const int kk = 8 * i + (lane >> 3); ld[i] = (nn < N) ? *(const f32x4*)(W + (size_t)(k0 + kk) * N + nn) : (f32x4){0.f, 0.f, 0.f, 0.f}; if (gain) ld[i] = ld[i] * gain[k0 + kk]; }
#pragma unroll
    for (int i = 0; i < 8; ++i) { const int kk = 8 * i + (lane >> 3); LAS float* d = scr + kk * 33 + c4; d[0] = ld[i].x; d[1] = ld[i].y; d[2] = ld[i].z; d[3] = ld[i].w; }
    LDS_WAIT(); asm volatile("" ::: "memory");
    const int c = lane & 7;
#pragma unroll
    for (int j = 0; j < 4; ++j) { const int n = (lane >> 3) + 8 * j; const LAS float* s = scr + (8 * c) * 33 + n;
        u32x4 o; o.x = pk2(s[0 * 33], s[1 * 33]); o.y = pk2(s[2 * 33], s[3 * 33]); o.z = pk2(s[4 * 33], s[5 * 33]); o.w = pk2(s[6 * 33], s[7 * 33]);
        const int ng = n0 + n; const int dr = mode ? ((ng >> 7) * 256 + (ng & 127) + off) : (ng + off);
        if (ng < N) *(u32x4*)(WT + kt_off(dr, k0 + 8 * c, K)) = o; }
    LDS_WAIT(); asm volatile("" ::: "memory");
}
__device__ __forceinline__ int rel_bucket_dev(int n) {
    if (n < 16) return n;
    const float v = logf((float)n / 16.0f) / 4.852030263919617f * 16.0f;
    int b = 16 + (int)v; return b < 31 ? b : 31;
}
namespace att {
constexpr int SHM_V = 16384, SHM_K = 16384;
constexpr int L_V = 0  , L_K = 49152  , L_WS = 98304, L_TBL = 100352, L_SELM = L_TBL + 4 * TBLS * 4  , L_END = L_SELM + 1024;
constexpr int L_IMP = 0;
static_assert(L_END <= 131072, "attention LDS map");
constexpr float THR = 8.f;
#define KSWZ(row, colB) ((row) * 256 + ((colB) ^ (((row) & 7) << 4)))
__device__ __forceinline__ int v_st(int k, int c) { const int kk = (k & ~0xC) | ((k & 4) << 1) | ((k & 8) >> 1); return ((kk >> 3) * 4 + (c >> 5)) * 512 + ((kk & 7) * 32 + (c & 31)) * 2; }
__device__ __forceinline__ int v_rd_base(int lane) { return ((lane & 3) << 3) | (((lane >> 2) & 3) << 6) | (((lane >> 4) & 1) << 5) | (((lane >> 5) & 1) << 8); }
__device__ __forceinline__ int crow(int r, int hi) { return (r & 3) + 8 * (r >> 2) + 4 * hi; }

__device__ __forceinline__ void partialSM(f32x16& p0, f32x16& p1, float& m_reg, float& mn, float& alpha) {
    (void)m_reg; mn = 0.f; alpha = 1.f;
#pragma unroll
    for (int r = 0; r < 16; ++r) p0[r] = __builtin_amdgcn_exp2f(p0[r] * LOG2E);
#pragma unroll
    for (int r = 0; r < 16; ++r) p1[r] = p1[r] * LOG2E;
}
__device__ __forceinline__ void partialSM_row(f32x16& p0, f32x16& p1, float& m_reg, float& mn, float& alpha, bool ok, float bias) {
    (void)m_reg; mn = 0.f; alpha = 1.f;
    const float mnL = ok ? bias * LOG2E : -__builtin_inff();
#pragma unroll
    for (int r = 0; r < 16; ++r) p0[r] = __builtin_amdgcn_exp2f(fmaf(p0[r], LOG2E, mnL));
#pragma unroll
    for (int r = 0; r < 16; ++r) p1[r] = fmaf(p1[r], LOG2E, mnL);
}
#define PK4(P, B_, OUT) do { unsigned a0 = cvtpk(P[B_+0], P[B_+1]), a1 = cvtpk(P[B_+2], P[B_+3]);                          \
        unsigned b0 = cvtpk(P[B_+4], P[B_+5]), b1 = cvtpk(P[B_+6], P[B_+7]);                                             \
        auto r0 = __builtin_amdgcn_permlane32_swap(a0, b0, false, false); auto r1 = __builtin_amdgcn_permlane32_swap(a1, b1, false, false); \
        u32x4 w = {r0[0], r1[0], r0[1], r1[1]}; OUT = *reinterpret_cast<bf16x8*>(&w); } while (0)
__device__ __forceinline__ void finishSM(f32x16& p0, f32x16& p1, float alpha, float& l_reg, bf16x8& pa0, bf16x8& pa1, bf16x8& pa2, bf16x8& pa3) {
#pragma unroll
    for (int r = 0; r < 16; ++r) p1[r] = __builtin_amdgcn_exp2f(p1[r]);
    float ps = 0;
#pragma unroll
    for (int r = 0; r < 16; ++r) ps += p0[r];
#pragma unroll
    for (int r = 0; r < 16; ++r) ps += p1[r];
    { auto rr = __builtin_amdgcn_permlane32_swap(__float_as_uint(ps), __float_as_uint(ps), false, false);
      ps = __uint_as_float(rr[0]) + __uint_as_float(rr[1]); }
    l_reg = l_reg * alpha + ps;
    PK4(p0, 0, pa0); PK4(p0, 8, pa1); PK4(p1, 0, pa2); PK4(p1, 8, pa3);
}
__device__ __forceinline__ void qkt(f32x16& p0, f32x16& p1, const LAS char* Kb, int r32, int hi, const bf16x8 (&qr)[8]) {
    p0 = f32x16{}; p1 = f32x16{};
    const LAS char* kb4[4];
#pragma unroll
    for (int dd = 0; dd < 4; ++dd) kb4[dd] = Kb + KSWZ(r32, (dd * 16 + hi * 8) * 2);
#pragma unroll
    for (int d0 = 0; d0 < 8; ++d0) { const LAS char* a = kb4[d0 & 3] + (d0 >> 2) * 128;
        const bf16x8 b0 = *reinterpret_cast<const LAS bf16x8*>(a);
        const bf16x8 b1 = *reinterpret_cast<const LAS bf16x8*>(a + 32 * 256);
        p0 = __builtin_amdgcn_mfma_f32_32x32x16_bf16(b0, qr[d0], p0, 0, 0, 0);
        p1 = __builtin_amdgcn_mfma_f32_32x32x16_bf16(b1, qr[d0], p1, 0, 0, 0); }
}
__device__ __forceinline__ void pv_tile(f32x16 (&o)[4], int vb, bf16x8 pa0, bf16x8 pa1, bf16x8 pa2, bf16x8 pa3) {
#define TRRD(dst, off) asm volatile("ds_read_b64_tr_b16 %0, %1 offset:%2" : "=&v"(dst) : "v"(vb), "i"(off) : "memory")
#define PV_D0(d0) do { s16x4 l0, l1, l2, l3, h0, h1, h2, h3; constexpr int b_ = (d0) * 512; \
        TRRD(l0, b_); TRRD(h0, b_ + 2048); TRRD(l1, b_ + 4096); TRRD(h1, b_ + 6144); TRRD(l2, b_ + 8192); TRRD(h2, b_ + 10240); TRRD(l3, b_ + 12288); TRRD(h3, b_ + 14336); \
        asm volatile("s_waitcnt lgkmcnt(0)" ::: "memory"); SBAR(); \
        o[d0] = __builtin_amdgcn_mfma_f32_32x32x16_bf16(pa0, (bf16x8){l0[0], l0[1], l0[2], l0[3], h0[0], h0[1], h0[2], h0[3]}, o[d0], 0, 0, 0);   \
        o[d0] = __builtin_amdgcn_mfma_f32_32x32x16_bf16(pa1, (bf16x8){l1[0], l1[1], l1[2], l1[3], h1[0], h1[1], h1[2], h1[3]}, o[d0], 0, 0, 0);   \
        o[d0] = __builtin_amdgcn_mfma_f32_32x32x16_bf16(pa2, (bf16x8){l2[0], l2[1], l2[2], l2[3], h2[0], h2[1], h2[2], h2[3]}, o[d0], 0, 0, 0);   \
        o[d0] = __builtin_amdgcn_mfma_f32_32x32x16_bf16(pa3, (bf16x8){l3[0], l3[1], l3[2], l3[3], h3[0], h3[1], h3[2], h3[3]}, o[d0], 0, 0, 0); } while (0)
    PV_D0(0); PV_D0(1); PV_D0(2); PV_D0(3);
#undef PV_D0
#undef TRRD
}

template <class Cfg>
__device__ __forceinline__ void attn_tiles(const Cfg& c, LAS char* lds, const bf16x8 (&qr)[8], f32x16 (&o)[4], float& m_reg, float& l_reg, const int t_lo, const int t_hi, const int wv) {
    const int tid = opq_tid(wv), lane = tid & 63, wid = __builtin_amdgcn_readfirstlane(tid >> 6), r32 = lane & 31, hi = lane >> 5;
    LAS char* V_lds = lds + L_V; LAS char* K_lds = lds + L_K;
    LAS float* al_l = (LAS float*)(lds + L_WS) + wid * 64 + 32;
    const int sr = tid >> 4, sc = (tid & 15) * 8;
    const int vst0 = v_st(sr, sc), vst1 = v_st(32 + sr, sc), kws = KSWZ(sr, sc * 2);
    const int vb0 = (int)(unsigned)(uintptr_t)V_lds + v_rd_base(lane);
    bf16x8 sk0, sk1, sv0, sv1;
    const bf16_t *gk0 = nullptr, *gk1 = nullptr, *gv0 = nullptr, *gv1 = nullptr;
#define AT_LOAD(t) do { gk0 = c.krow((t), sr) + sc; gk1 = c.krow((t), sr + 32) + sc; sk0 = *(const bf16x8*)gk0; sk1 = *(const bf16x8*)gk1; \
        if constexpr (Cfg::MODE == 0) { gv0 = c.vrow((t), sr) + sc; gv1 = c.vrow((t), sr + 32) + sc; sv0 = *(const bf16x8*)gv0; sv1 = *(const bf16x8*)gv1; } \
        asm volatile("" ::: "memory"); SBAR(); } while (0)
#define AT_WRITE(t, bf) do { asm volatile("" :: "v"(gk0), "v"(gk1), "v"(gv0), "v"(gv1)); *(LAS bf16x8*)(K_lds + (bf) * SHM_K + kws) = sk0; *(LAS bf16x8*)(K_lds + (bf) * SHM_K + kws + 32 * 256) = sk1; \
        if constexpr (Cfg::MODE == 1) { \
            _Pragma("unroll") for (int i_ = 0; i_ < 8; ++i_) { const int n_ = sc + i_, c0_ = 64 * (t) + sr, c1_ = c0_ + 32; \
                sv0[i_] = (c0_ >= 4 * n_ - 1 && c0_ <= 4 * n_ + 3) ? (short)0x3F80 : (short)0; sv1[i_] = (c1_ >= 4 * n_ - 1 && c1_ <= 4 * n_ + 3) ? (short)0x3F80 : (short)0; } } \
        *(LAS bf16x8*)(V_lds + (bf) * SHM_V + vst0) = sv0; *(LAS bf16x8*)(V_lds + (bf) * SHM_V + vst1) = sv1; } while (0)
    __builtin_amdgcn_s_waitcnt(0x0F70);
    __syncthreads();
    if (t_lo < t_hi) { AT_LOAD(t_lo); AT_WRITE(t_lo, 0); }
    __syncthreads();
    for (int t = t_lo; t < t_hi; ++t) {
        const int buf = (t - t_lo) & 1; const bool more = (t + 1 < t_hi);
        if (more) AT_LOAD(t + 1);
        if (c.active(t)) {
            f32x16 p0, p1;
            qkt(p0, p1, K_lds + buf * SHM_K, r32, hi, qr);
            if constexpr (Cfg::MODE == 0) {
                float mn, alpha; bf16x8 pa0, pa1, pa2, pa3;
                bool rok; float rbias;
                if (c.rowconst(t, rok, rbias)) partialSM_row(p0, p1, m_reg, mn, alpha, rok, rbias);
                else { c.mask(p0, p1, t); partialSM(p0, p1, m_reg, mn, alpha); }
                if (__any(alpha < 1.f)) { if (hi == 0) al_l[r32] = alpha; LDS_WAIT();
#pragma unroll
                    for (int d_ = 0; d_ < 4; ++d_)
#pragma unroll
                        for (int r = 0; r < 16; ++r) o[d_][r] *= al_l[crow(r, hi)]; }
                finishSM(p0, p1, alpha, l_reg, pa0, pa1, pa2, pa3); SBAR();
                pv_tile(o, vb0 + buf * SHM_V, pa0, pa1, pa2, pa3);
            } else {
                c.mask(p0, p1, t);
                const float mL = -c.mfix * LOG2E; const float il = c.invl;
#pragma unroll
                for (int r = 0; r < 16; ++r) { p0[r] = __builtin_amdgcn_exp2f(fmaf(p0[r], LOG2E, mL)) * il; p1[r] = __builtin_amdgcn_exp2f(fmaf(p1[r], LOG2E, mL)) * il; }
                bf16x8 pa0, pa1, pa2, pa3;
                PK4(p0, 0, pa0); PK4(p0, 8, pa1); PK4(p1, 0, pa2); PK4(p1, 8, pa3); SBAR();
                pv_tile(o, vb0 + buf * SHM_V, pa0, pa1, pa2, pa3);
#pragma unroll
                for (int r = 0; r < 16; r += 2) { const unsigned a = cvtpk(p0[r], p0[r + 1]), b = cvtpk(p1[r], p1[r + 1]);
                    p0[r] -= bflo(a); p0[r + 1] -= bfhi(a); p1[r] -= bflo(b); p1[r + 1] -= bfhi(b); }
                PK4(p0, 0, pa0); PK4(p0, 8, pa1); PK4(p1, 0, pa2); PK4(p1, 8, pa3); SBAR();
                pv_tile(o, vb0 + buf * SHM_V, pa0, pa1, pa2, pa3);
            }
        }
        if (more) AT_WRITE(t + 1, buf ^ 1);
        __syncthreads();
    }
#undef AT_LOAD
#undef AT_WRITE
}

template <class Cfg>
__device__ __forceinline__ void attn_tiles_s(const Cfg& c, LAS char* lds, const bf16x8 (&qr)[8], f32x16 (&o)[4], float& m_reg, float& l_reg, const int t_lo, const int t_hi, const int wv) {
    static_assert(Cfg::MODE == 0, "fixed-shift softmax tiles only");
    (void)m_reg;
    const int tid = opq_tid(wv), lane = tid & 63, wid = __builtin_amdgcn_readfirstlane(tid >> 6), r32 = lane & 31, hi = lane >> 5;
    LAS char* V_lds = lds + L_V; LAS char* K_lds = lds + L_K;
    const int sr = tid >> 4, sc = (tid & 15) * 8;
    const int vst0 = v_st(sr, sc), vst1 = v_st(32 + sr, sc), kws = KSWZ(sr, sc * 2);
    const int vb0 = (int)(unsigned)(uintptr_t)V_lds + v_rd_base(lane);
    bf16x8 sk0, sk1, sv0, sv1, pa0, pa1, pa2, pa3;
    const bf16_t *gk0 = nullptr, *gk1 = nullptr, *gv0 = nullptr, *gv1 = nullptr;
#define AS_LOAD(t) do { gk0 = c.krow((t), sr) + sc; gk1 = c.krow((t), sr + 32) + sc; sk0 = *(const bf16x8*)gk0; sk1 = *(const bf16x8*)gk1; \
        gv0 = c.vrow((t), sr) + sc; gv1 = c.vrow((t), sr + 32) + sc; sv0 = *(const bf16x8*)gv0; sv1 = *(const bf16x8*)gv1; asm volatile("" ::: "memory"); SBAR(); } while (0)
#define AS_WRITE(kbf, vbf) do { asm volatile("" :: "v"(gk0), "v"(gk1), "v"(gv0), "v"(gv1)); *(LAS bf16x8*)(K_lds + (kbf) * SHM_K + kws) = sk0; *(LAS bf16x8*)(K_lds + (kbf) * SHM_K + kws + 32 * 256) = sk1; \
        *(LAS bf16x8*)(V_lds + (vbf) * SHM_V + vst0) = sv0; *(LAS bf16x8*)(V_lds + (vbf) * SHM_V + vst1) = sv1; } while (0)
#define AS_SCORE(t, kbf) do { f32x16 p0, p1; float mz_ = 0.f, mn_, al_; bool rok_; float rb_; \
        qkt(p0, p1, K_lds + (kbf) * SHM_K, r32, hi, qr); \
        if (c.rowconst((t), rok_, rb_)) partialSM_row(p0, p1, mz_, mn_, al_, rok_, rb_); else { c.mask(p0, p1, (t)); partialSM(p0, p1, mz_, mn_, al_); } \
        finishSM(p0, p1, 1.f, l_reg, pa0, pa1, pa2, pa3); SBAR(); } while (0)
    if (t_lo >= t_hi) return;
    __builtin_amdgcn_s_waitcnt(0x0F70);
    __syncthreads();
    AS_LOAD(t_lo); AS_WRITE(0, 0);
    __syncthreads();
    int kb = 0, vb = 0;
    if (wid < 4) {
        for (int t = t_lo; t < t_hi; ++t) {
            const bool more = (t + 1 < t_hi); const int vn = (vb == 2) ? 0 : vb + 1;
            if (more) AS_LOAD(t + 1);
            if (c.active(t)) { AS_SCORE(t, kb); pv_tile(o, vb0 + vb * SHM_V, pa0, pa1, pa2, pa3); }
            if (more) AS_WRITE(kb ^ 1, vn);
            __syncthreads();
            kb ^= 1; vb = vn;
        }
    } else {
        bool pend = false; int vp = 0;
        for (int t = t_lo; t < t_hi; ++t) {
            const bool more = (t + 1 < t_hi); const int vn = (vb == 2) ? 0 : vb + 1;
            if (more) AS_LOAD(t + 1);
            if (pend) pv_tile(o, vb0 + vp * SHM_V, pa0, pa1, pa2, pa3);
            const bool act = c.active(t);
            if (act) AS_SCORE(t, kb);
            pend = act; vp = vb;
            if (more) AS_WRITE(kb ^ 1, vn);
            __syncthreads();
            kb ^= 1; vb = vn;
        }
        if (pend) pv_tile(o, vb0 + vp * SHM_V, pa0, pa1, pa2, pa3);
    }
#undef AS_LOAD
#undef AS_WRITE
#undef AS_SCORE
}

struct DilCfg {
    static constexpr int MODE = 0;
    const bf16_t* Kb; const bf16_t* Vb;
    const LAS float* tbl; int dshift, res, u, dqm, s0;
    __device__ __forceinline__ const bf16_t* krow(int t, int kk) const { int s = 256 * u - 128 + 64 * t + kk; s = s < 0 ? 0 : s; return Kb + (size_t)((s << dshift) + res) * PC; }
    __device__ __forceinline__ const bf16_t* vrow(int t, int kk) const { int s = 256 * u - 128 + 64 * t + kk; s = s < 0 ? 0 : s; return Vb + (size_t)((s << dshift) + res) * PC; }
    __device__ __forceinline__ bool active(int t) const { const int kb = 256 * u - 128 + 64 * t; return kb <= s0 + 31 && kb + 63 >= s0 - 128; }
    __device__ __forceinline__ bool rowconst(int, bool&, float&) const { return false; }
    __device__ __forceinline__ void mask(f32x16& p0, f32x16& p1, int t) const {
        const int dq = dqm - (256 * u - 128 + 64 * t); const float NEG = -__builtin_inff();
        const LAS float* tb = tbl + (DT0 + dq - 63);
        float bb0[16], bb1[16];
#pragma unroll
        for (int r = 0; r < 16; ++r) { const int cc = (r & 3) + 8 * (r >> 2); bb0[r] = tb[63 - cc]; bb1[r] = tb[31 - cc]; }
#pragma unroll
        for (int r = 0; r < 16; ++r) asm volatile("" : "+v"(bb0[r]), "+v"(bb1[r]));
#pragma unroll
        for (int r = 0; r < 16; ++r) { const int cc = (r & 3) + 8 * (r >> 2); const unsigned d0 = (unsigned)(dq - cc), d1 = (unsigned)(dq - cc - 32);
            p0[r] = (d0 <= 128u) ? p0[r] + bb0[r] : NEG; p1[r] = (d1 <= 128u) ? p1[r] + bb1[r] : NEG; }
    }
};
struct CmpCfg {
    static constexpr int MODE = 0;
    const bf16_t* Kb; const bf16_t* Vb; int cmax, hi4, cfull;
    __device__ __forceinline__ bool rowconst(int t, bool& ok, float& bias) const { ok = true; bias = 0.f; return 64 * t + 63 <= cfull; }
    __device__ __forceinline__ const bf16_t* krow(int t, int kk) const { return Kb + (size_t)(64 * t + kk) * HD; }
    __device__ __forceinline__ const bf16_t* vrow(int t, int kk) const { return Vb + (size_t)(64 * t + kk) * HD; }
    __device__ __forceinline__ bool active(int) const { return true; }
    __device__ __forceinline__ void mask(f32x16& p0, f32x16& p1, int t) const {
        const int cb = 64 * t + hi4; const float NEG = -__builtin_inff();
#pragma unroll
        for (int r = 0; r < 16; ++r) { const int cc = cb + (r & 3) + 8 * (r >> 2); if (cc > cmax) p0[r] = NEG; if (cc + 32 > cmax) p1[r] = NEG; }
    }
};
struct CmpImpCfg {
    static constexpr int MODE = 1;
    const bf16_t* Kb; int cmax, hi4; float mfix, invl;
    __device__ __forceinline__ const bf16_t* krow(int t, int kk) const { return Kb + (size_t)(64 * t + kk) * HD; }
    __device__ __forceinline__ const bf16_t* vrow(int, int) const { return Kb; }
    __device__ __forceinline__ bool active(int) const { return true; }
    __device__ __forceinline__ void mask(f32x16& p0, f32x16& p1, int t) const {
        const int cb = 64 * t + hi4; const float NEG = -__builtin_inff();
#pragma unroll
        for (int r = 0; r < 16; ++r) { const int cc = cb + (r & 3) + 8 * (r >> 2); if (cc > cmax) p0[r] = NEG; if (cc + 32 > cmax) p1[r] = NEG; }
    }
};
struct SlcCfg {
    static constexpr int MODE = 0;
    const bf16_t* Kb; const bf16_t* Vb;
    const LAS float* tblh;
    unsigned s0, s1, s2, s3; int tqm, cur; float b31;
    __device__ __forceinline__ const bf16_t* krow(int t, int kk) const { return Kb + (size_t)(64 * t + kk) * PC; }
    __device__ __forceinline__ const bf16_t* vrow(int t, int kk) const { return Vb + (size_t)(64 * t + kk) * PC; }
    __device__ __forceinline__ bool selbit(int t) const { const unsigned q = (unsigned)t >> 5; const unsigned w = (q == 0u ? s0 + 0u : 0u) | (q == 1u ? s1 + 0u : 0u) | (q == 2u ? s2 + 0u : 0u) | (q == 3u ? s3 + 0u : 0u); return (w >> (t & 31)) & 1u; }
    __device__ __forceinline__ bool active(int t) const { return __any(selbit(t)); }
    __device__ __forceinline__ bool rowconst(int t, bool& ok, float& bias) const { ok = selbit(t); bias = b31; return 64 * (cur - t) - 63 >= 1513; }
    __device__ __forceinline__ void mask(f32x16& p0, f32x16& p1, int t) const {
        const bool sel = selbit(t); const int dq = tqm - 64 * t; const float NEG = -__builtin_inff();
        const LAS float* tb = tblh + (TBL0 + dq - 63);
        float bb0[16], bb1[16];
#pragma unroll
        for (int r = 0; r < 16; ++r) { const int cc = (r & 3) + 8 * (r >> 2); bb0[r] = tb[63 - cc]; bb1[r] = tb[31 - cc]; }
#pragma unroll
        for (int r = 0; r < 16; ++r) asm volatile("" : "+v"(bb0[r]), "+v"(bb1[r]));
#pragma unroll
        for (int r = 0; r < 16; ++r) { const int cc = (r & 3) + 8 * (r >> 2); const int d0 = dq - cc, d1 = dq - cc - 32;
            p0[r] = (sel && d0 >= 0) ? p0[r] + bb0[r] : NEG; p1[r] = (sel && d1 >= 0) ? p1[r] + bb1[r] : NEG; }
    }
};
struct WinCfg {
    static constexpr int MODE = 0;
    const bf16_t* Kb; const bf16_t* Vb; const LAS float* tblh; int tqm;
    __device__ __forceinline__ bool rowconst(int, bool&, float&) const { return false; }
    __device__ __forceinline__ const bf16_t* krow(int t, int kk) const { return Kb + (size_t)(64 * t + kk) * PC; }
    __device__ __forceinline__ const bf16_t* vrow(int t, int kk) const { return Vb + (size_t)(64 * t + kk) * PC; }
    __device__ __forceinline__ bool active(int) const { return true; }
    __device__ __forceinline__ void mask(f32x16& p0, f32x16& p1, int t) const {
        const int dq = tqm - 64 * t; const float NEG = -__builtin_inff();
        const LAS float* tb = tblh + (TBL0 + dq - 63);
        float bb0[16], bb1[16];
#pragma unroll
        for (int r = 0; r < 16; ++r) { const int cc = (r & 3) + 8 * (r >> 2); bb0[r] = tb[63 - cc]; bb1[r] = tb[31 - cc]; }
#pragma unroll
        for (int r = 0; r < 16; ++r) asm volatile("" : "+v"(bb0[r]), "+v"(bb1[r]));
#pragma unroll
        for (int r = 0; r < 16; ++r) { const int cc = (r & 3) + 8 * (r >> 2); const unsigned d0 = (unsigned)(dq - cc), d1 = (unsigned)(dq - cc - 32);
            p0[r] = (d0 < 512u) ? p0[r] + bb0[r] : NEG; p1[r] = (d1 < 512u) ? p1[r] + bb1[r] : NEG; }
    }
};
}

__device__ __forceinline__ void load_q_normed(const bf16_t* qp  , const float* gain  , bf16x8 (&qr)[8]) {
    u32x4 raw[8];
#pragma unroll
    for (int d0 = 0; d0 < 8; ++d0) raw[d0] = *(const u32x4*)(qp + d0 * 16);
    float ss = 0.f;
#pragma unroll
    for (int d0 = 0; d0 < 8; ++d0) { const u32x4 w = raw[d0]; const float a0 = bflo(w.x), a1 = bfhi(w.x), a2 = bflo(w.y), a3 = bfhi(w.y), a4 = bflo(w.z), a5 = bfhi(w.z), a6 = bflo(w.w), a7 = bfhi(w.w);
        ss += ((a0 * a0 + a1 * a1) + (a2 * a2 + a3 * a3)) + ((a4 * a4 + a5 * a5) + (a6 * a6 + a7 * a7)); }
    { auto rr = __builtin_amdgcn_permlane32_swap(__float_as_uint(ss), __float_as_uint(ss), false, false); ss = __uint_as_float(rr[0]) + __uint_as_float(rr[1]); }
    const float rs = QSCALE / sqrtf(ss * (1.f / HD) + EPS);
#pragma unroll
    for (int d0 = 0; d0 < 8; ++d0) { const u32x4 w = raw[d0]; const f32x4 g0 = *(const f32x4*)(gain + d0 * 16), g1 = *(const f32x4*)(gain + d0 * 16 + 4);
        u32x4 o; o.x = cvtpk(bflo(w.x) * rs * g0.x, bfhi(w.x) * rs * g0.y); o.y = cvtpk(bflo(w.y) * rs * g0.z, bfhi(w.y) * rs * g0.w);
        o.z = cvtpk(bflo(w.z) * rs * g1.x, bfhi(w.z) * rs * g1.y); o.w = cvtpk(bflo(w.w) * rs * g1.z, bfhi(w.w) * rs * g1.w);
        qr[d0] = *reinterpret_cast<bf16x8*>(&o); }
}

__device__ __forceinline__ void dil_tiles(const att::DilCfg& c, LAS char* lds, const bf16x8 (&qr)[8], f32x16 (&o)[4], float& l_reg, const int wv) {
    using namespace att;
    const int tid = opq_tid(wv), lane = tid & 63, wid = __builtin_amdgcn_readfirstlane(tid >> 6), r32 = lane & 31, hi = lane >> 5;
    LAS char* V_lds = lds + L_V; LAS char* K_lds = lds + L_K;
    const int sr = tid >> 4, sc = (tid & 15) * 8;
    const int vst0 = v_st(sr, sc), vst1 = v_st(32 + sr, sc), kws = KSWZ(sr, sc * 2);
    const int vb0 = (int)(unsigned)(uintptr_t)V_lds + v_rd_base(lane);
    bf16x8 sk0, sk1, sv0, sv1;
    const bf16_t *gk0 = nullptr, *gk1 = nullptr, *gv0 = nullptr, *gv1 = nullptr;
#define DT_LOAD(t) do { gk0 = c.krow((t), sr) + sc; gk1 = c.krow((t), sr + 32) + sc; sk0 = *(const bf16x8*)gk0; sk1 = *(const bf16x8*)gk1; \
        gv0 = c.vrow((t), sr) + sc; gv1 = c.vrow((t), sr + 32) + sc; sv0 = *(const bf16x8*)gv0; sv1 = *(const bf16x8*)gv1; asm volatile("" ::: "memory"); SBAR(); } while (0)
#define DT_WRITE(slot) do { asm volatile("" :: "v"(gk0), "v"(gk1), "v"(gv0), "v"(gv1)); *(LAS bf16x8*)(K_lds + (slot) * SHM_K + kws) = sk0; *(LAS bf16x8*)(K_lds + (slot) * SHM_K + kws + 32 * 256) = sk1; \
        *(LAS bf16x8*)(V_lds + (slot) * SHM_V + vst0) = sv0; *(LAS bf16x8*)(V_lds + (slot) * SHM_V + vst1) = sv1; } while (0)
#define DT_COMP(t, slot) do { f32x16 p0, p1; float mz_ = 0.f, mn_, al_; bf16x8 pa0, pa1, pa2, pa3; \
        qkt(p0, p1, K_lds + (slot) * SHM_K, r32, hi, qr); c.mask(p0, p1, (t)); partialSM(p0, p1, mz_, mn_, al_); \
        finishSM(p0, p1, 1.f, l_reg, pa0, pa1, pa2, pa3); SBAR(); pv_tile(o, vb0 + (slot) * SHM_V, pa0, pa1, pa2, pa3); } while (0)
    const bool first = (c.u == 0);
    __builtin_amdgcn_s_waitcnt(0x0F70);
    __syncthreads();
    if (!first) { DT_LOAD(1); DT_WRITE(0); }
    DT_LOAD(4); DT_WRITE(1);
    __syncthreads();
    DT_LOAD(2);
    if (wid < 4) { if (!first) DT_COMP(1, 0); } else DT_COMP(4, 1);
    DT_WRITE(2);
    __syncthreads();
    DT_LOAD(3);
    if (wid < 6) DT_COMP(2, 2);
    DT_WRITE(0);
    __syncthreads();
    DT_LOAD(5);
    if (wid >= 2) DT_COMP(3, 0);
    DT_WRITE(1);
    if (!first) { DT_LOAD(0); DT_WRITE(2); }
    __syncthreads();
    if (wid < 2) { if (!first) DT_COMP(0, 2); } else if (wid >= 6) DT_COMP(5, 1);
#undef DT_LOAD
#undef DT_WRITE
#undef DT_COMP
}

__device__ __forceinline__ void dil_unit(LAS char* lds, const bf16_t* P, bf16_t* OA, float* LSE, const float* dilT, const float* qgain, int pat, int dshift, int unit, const int wv) {
    using namespace att;
    const int tid = opq_tid(wv), lane = tid & 63, wid = __builtin_amdgcn_readfirstlane(tid >> 6), r32 = lane & 31, hi = lane >> 5;
    const int bh = unit >> 5, ru = unit & 31, b = bh >> 3, h = bh & 7;
    const int ncs = 5 - dshift, res = ru >> ncs, u = ru & ((1 << ncs) - 1);
    LAS float* tbl = (LAS float*)(lds + L_TBL);
    __syncthreads();
    if (tid < DTS) tbl[tid] = dilT[(pat * 8 + h) * DTS + tid];
    const int s0 = 256 * u + 32 * wid, s_row = s0 + r32;
    const size_t tokrow = (size_t)b * SEQ + (size_t)((s_row << dshift) + res);
    bf16x8 qr[8];
    load_q_normed(P + tokrow * PC + C_QA + h * HD + hi * 8, qgain + hi * 8, qr);
    f32x16 o[4]; float m_reg, l_reg;
    m_reg = 0.f;
    if (pat == 0) { l_reg = 0.f;
#pragma unroll
        for (int d0 = 0; d0 < 4; ++d0) o[d0] = f32x16{}; }
    else { l_reg = LSE[tokrow * 8 + h];
#pragma unroll
        for (int r = 0; r < 16; ++r) { const size_t tr = (size_t)b * SEQ + (size_t)(((s0 + crow(r, hi)) << dshift) + res); const bf16_t* op = OA + tr * 1024 + h * HD + r32;
#pragma unroll
            for (int d0 = 0; d0 < 4; ++d0) o[d0][r] = bf2f(op[d0 * 32]); } }
    DilCfg c; c.Kb = P + (size_t)b * SEQ * PC + C_KA + h * HD; c.Vb = P + (size_t)b * SEQ * PC + C_VA + h * HD; c.tbl = tbl; c.dshift = dshift; c.res = res; c.u = u; c.dqm = s_row - 4 * hi; c.s0 = s0;
    dil_tiles(c, lds, qr, o, l_reg, wv);
    LAS float* li_l = (LAS float*)(lds + L_WS) + wid * 64;
    if (hi == 0) { li_l[r32] = l_reg; LSE[tokrow * 8 + h] = l_reg; }
    LDS_WAIT();
#pragma unroll
    for (int r = 0; r < 16; ++r) { const int orow = crow(r, hi); const float rl = (pat == 2) ? 1.0f / li_l[orow] : 1.0f;
        const size_t tr = (size_t)b * SEQ + (size_t)(((s0 + orow) << dshift) + res); bf16_t* op = OA + tr * 1024 + h * HD;
#pragma unroll
        for (int d0 = 0; d0 < 4; ++d0) { const float v = o[d0][r] * rl; const float vn = shx(v, 1, lane);
            if ((r32 & 1) == 0) *(unsigned*)(op + d0 * 32 + r32) = cvtpk(v, vn); } }
}

__device__ __forceinline__ void nsa_finalize(LAS char* lds, const f32x16 (&o)[4], float l_reg, const bf16_t* P, bf16_t* ON, const float* gb, int b, int g, int tok0, int br, const int wv) {
    using namespace att;
    const int tid = opq_tid(wv), lane = tid & 63, wid = __builtin_amdgcn_readfirstlane(tid >> 6), r32 = lane & 31, hi = lane >> 5;
    LAS float* li_l = (LAS float*)(lds + L_WS) + wid * 64;
    if (hi == 0) li_l[r32] = l_reg;
    LDS_WAIT();
    bf16_t* ONb = ON + (size_t)br * NTOK * 1024;
    float glv[16], gbv[4];
#pragma unroll
    for (int j = 0; j < 4; ++j) gbv[j] = gb[(4 * g + j) * 3 + br];
#pragma unroll
    for (int r = 0; r < 16; ++r) { const int j = r & 3, k = r >> 2; const size_t tok = (size_t)b * SEQ + tok0 + 2 * k + hi; glv[r] = bf2f(P[tok * PC + C_GL + (4 * g + j) * 3 + br]); }
#pragma unroll
    for (int r = 0; r < 16; ++r) asm volatile("" : "+v"(glv[r]));
#pragma unroll
    for (int r = 0; r < 16; ++r) { const int j = r & 3, k = r >> 2; const float lr = li_l[crow(r, hi)]; const float rl = lr > 0.f ? 1.0f / lr : 0.f;
        const size_t tok = (size_t)b * SEQ + tok0 + 2 * k + hi; const int hh = 4 * g + j;
        const float gl = glv[r] + gbv[j];
        const float sc = rl * __builtin_amdgcn_rcpf(1.0f + __builtin_amdgcn_exp2f(-gl * LOG2E));
        bf16_t* op = ONb + tok * 1024 + hh * HD;
#pragma unroll
        for (int d0 = 0; d0 < 4; ++d0) { const float v = o[d0][r] * sc; const float vn = shx(v, 1, lane);
            if ((r32 & 1) == 0) *(unsigned*)(op + d0 * 32 + r32) = cvtpk(v, vn); } }
}
__device__ __forceinline__ void nsa_unit(LAS char* lds, const bf16_t* P, const bf16_t* KC, const bf16_t* VC, bf16_t* ON, const float* nsaT, const float* gb, const float* qgain, int b, int g, int qi, bool load_tbl, const int wv) {
    using namespace att;
    const int tid = opq_tid(wv), lane = tid & 63, wid = __builtin_amdgcn_readfirstlane(tid >> 6), r32 = lane & 31, hi = lane >> 5;
    LAS float* tbl = (LAS float*)(lds + L_TBL); LAS float* IMP = (LAS float*)(lds + L_IMP); LAS unsigned* SELM = (LAS unsigned*)(lds + L_SELM);
    __syncthreads();
    if (load_tbl) for (int i = tid; i < 4 * TBLS; i += NTHR) tbl[i] = nsaT[(size_t)(4 * g) * TBLS + i];
    const int tok0 = 64 * qi + 8 * wid, tq = tok0 + (r32 >> 2), hd = r32 & 3;
    const bf16_t* Pb = P + (size_t)b * SEQ * PC;
    bf16x8 qr[8];
    load_q_normed(Pb + (size_t)tq * PC + C_QN + (4 * g + hd) * HD + hi * 8, qgain + hi * 8, qr);
    const bf16_t* KCb = KC + (size_t)(b * 2 + g) * 512 * HD; const bf16_t* VCb = VC + (size_t)(b * 2 + g) * 512 * HD;
    const int ntc = (qi >> 4) + 1, cmax = (tq - 31) >> 4;
    f32x16 o[4]; float m_reg, l_reg;
#pragma unroll
    for (int d0 = 0; d0 < 4; ++d0) o[d0] = f32x16{};
    m_reg = 0.f; l_reg = 0.f;
    { CmpCfg c; c.Kb = KCb; c.Vb = VCb; c.cmax = cmax; c.hi4 = 4 * hi; c.cfull = (64 * qi - 31) >> 4; attn_tiles_s(c, lds, qr, o, m_reg, l_reg, 0, ntc, wv); }
    nsa_finalize(lds, o, l_reg, P, ON, gb, b, g, tok0, 0, wv);
    { CmpImpCfg c; c.Kb = KCb; c.cmax = cmax; c.hi4 = 4 * hi; c.mfix = 0.f; c.invl = l_reg > 0.f ? 1.0f / l_reg : 0.f;
#pragma unroll
      for (int d0 = 0; d0 < 4; ++d0) o[d0] = f32x16{};
      float md = 0.f, ld = 0.f; attn_tiles(c, lds, qr, o, md, ld, 0, ntc, wv); }
#pragma unroll
    for (int d0 = 0; d0 < 4; ++d0)
#pragma unroll
        for (int k = 0; k < 4; ++k) IMP[(8 * wid + 2 * k + hi) * 128 + 32 * d0 + r32] = (o[d0][4 * k] + o[d0][4 * k + 1]) + (o[d0][4 * k + 2] + o[d0][4 * k + 3]);
    __syncthreads();
    { const int cur = qi;
#pragma unroll 1
      for (int tl = 8 * wid; tl < 8 * wid + 8; ++tl) {
        const int n0 = lane, n1 = 64 + lane; bool sel0, sel1;
        if (cur <= 15) { sel0 = (n0 <= cur); sel1 = false; }
        else {
            const float v0 = IMP[tl * 128 + n0], v1 = IMP[tl * 128 + n1];
            const unsigned u0 = (n0 >= 1 && n0 <= cur - 2) ? __float_as_uint(v0) + 1u : 0u, u1 = (n1 <= cur - 2) ? __float_as_uint(v1) + 1u : 0u;
            unsigned T = 0u;
#pragma unroll 1
            for (int bit = 30; bit >= 0; --bit) { const unsigned cand = T | (1u << bit);
                const int cnt = __builtin_popcountll(__ballot(u0 >= cand)) + __builtin_popcountll(__ballot(u1 >= cand));
                if (cnt >= 13) T = cand; }
            const bool gt0 = u0 > T, gt1 = u1 > T;
            const int need = 13 - (__builtin_popcountll(__ballot(gt0)) + __builtin_popcountll(__ballot(gt1)));
            const bool eq0 = (u0 == T), eq1 = (u1 == T);
            const unsigned long long m0 = __ballot(eq0), m1 = __ballot(eq1);
            const int pre0 = (int)__builtin_amdgcn_mbcnt_hi((unsigned)(m0 >> 32), __builtin_amdgcn_mbcnt_lo((unsigned)m0, 0u));
            const int pre1 = __builtin_popcountll(m0) + (int)__builtin_amdgcn_mbcnt_hi((unsigned)(m1 >> 32), __builtin_amdgcn_mbcnt_lo((unsigned)m1, 0u));
            sel0 = (n0 == 0 || n0 == cur || n0 == cur - 1) || gt0 || (eq0 && pre0 < need);
            sel1 = (n1 == cur || n1 == cur - 1) || gt1 || (eq1 && pre1 < need);
        }
        const unsigned long long b0 = __ballot(sel0), b1 = __ballot(sel1);
        if (lane == 0) { SELM[tl * 4 + 0] = (unsigned)b0; SELM[tl * 4 + 1] = (unsigned)(b0 >> 32); SELM[tl * 4 + 2] = (unsigned)b1; SELM[tl * 4 + 3] = (unsigned)(b1 >> 32); } } }
    __syncthreads();
    int r32s = r32; asm volatile("" : "+v"(r32s));
    { SlcCfg c; c.Kb = Pb + C_KS + g * HD; c.Vb = Pb + C_VS + g * HD; c.tblh = tbl + (r32s & 3) * TBLS; c.tqm = tok0 + (r32s >> 2) - 4 * hi; c.cur = qi; c.b31 = tbl[(r32s & 3) * TBLS + TBL0 + 1600];
      const int tl = 8 * wid + (r32s >> 2); c.s0 = SELM[tl * 4 + 0]; c.s1 = SELM[tl * 4 + 1]; c.s2 = SELM[tl * 4 + 2]; c.s3 = SELM[tl * 4 + 3];
#pragma unroll
      for (int d0 = 0; d0 < 4; ++d0) o[d0] = f32x16{};
      m_reg = 0.f; l_reg = 0.f;
      attn_tiles_s(c, lds, qr, o, m_reg, l_reg, 0, qi + 1, wv); }
    nsa_finalize(lds, o, l_reg, P, ON, gb, b, g, tok0, 1, wv);
    int r32w = r32; asm volatile("" : "+v"(r32w));
    { WinCfg c; c.Kb = Pb + C_KW + g * HD; c.Vb = Pb + C_VW + g * HD; c.tblh = tbl + (r32w & 3) * TBLS; c.tqm = tok0 + (r32w >> 2) - 4 * hi;
#pragma unroll
      for (int d0 = 0; d0 < 4; ++d0) o[d0] = f32x16{};
      m_reg = 0.f; l_reg = 0.f;
      attn_tiles_s(c, lds, qr, o, m_reg, l_reg, qi >= 8 ? qi - 8 : 0, qi + 1, wv); }
    nsa_finalize(lds, o, l_reg, P, ON, gb, b, g, tok0, 2, wv);
}

constexpr int LDS_BYTES = 147456;
constexpr int LDS_MISC = 131072;
constexpr int LDS_ARGS = LDS_MISC + 64;
__device__ __forceinline__ unsigned long long arg_u64(LAS unsigned char* lds, int i) {
    const LAS unsigned* p = (const LAS unsigned*)(opq_lds(lds) + LDS_ARGS) + 2 * i;
    const unsigned lo = __builtin_amdgcn_readfirstlane(p[0]), hi = __builtin_amdgcn_readfirstlane(p[1]);
    return ((unsigned long long)hi << 32) | lo;
}
#define GAS __attribute__((address_space(1)))
__device__ __forceinline__ const float* arg_in(LAS unsigned char* lds, int i) { return (const float*)(GAS const float*)arg_u64(lds, i); }
__device__ __forceinline__ float* arg_out(LAS unsigned char* lds) { return (float*)(GAS float*)arg_u64(lds, 24); }
__device__ __forceinline__ unsigned char* arg_ws(LAS unsigned char* lds) { return (unsigned char*)(GAS unsigned char*)arg_u64(lds, 25); }
__device__ __forceinline__ int opq_bx() { int b = blockIdx.x; asm volatile("" : "+s"(b)); return b; }
__device__ __forceinline__ int opq_g() { int b = gridDim.x; asm volatile("" : "+s"(b)); return b; }

__device__ __forceinline__ void ph_prologue(LAS unsigned char* lds, const int wv) {
    lds = opq_lds(lds);
    const int tid = opq_tid(wv), lane = tid & 63, wave = __builtin_amdgcn_readfirstlane(tid >> 6), G = opq_g(), bx = opq_bx();
    const int gw = bx * NWAVES + wave, NGW = G * NWAVES;
    unsigned char* ws = arg_ws(lds);
    LAS float* scr = (LAS float*)(lds + wave * 16384);
    constexpr int I_UP = 32 * 176, I_DN = 88 * 64, I_IN = 32 * 177, I_OUT = 32 * 64, I_C1 = 64 * 16, I_Z = 928;
    constexpr int I_FFN = 2 * I_UP + I_DN, I_LAYER = 2 * I_FFN + I_IN + I_OUT + 2 * I_C1 + I_Z;
#pragma unroll 1
    for (int it = gw; it < DEPTH * I_LAYER; it += NGW) {
        const int l = it / I_LAYER; int r = it - l * I_LAYER;
        if (r < 2 * I_FFN) { const int half = r >= I_FFN; r -= half * I_FFN;
            bf16_t* WUP = (bf16_t*)(ws + WS_WUP + (size_t)(l * 2 + half) * SZ_WUP); bf16_t* WDN = (bf16_t*)(ws + WS_WDN + (size_t)(l * 2 + half) * SZ_WDN);
            const float* gn = arg_in(lds, half ? I_F2N : I_F1N) + (size_t)l * DM;
            if (r < I_UP) { transpose_item(arg_in(lds, half ? I_F2W1 : I_F1W1) + (size_t)l * DM * DFF, DM, DFF, WUP, 1, 0, scr, r, lane, gn); continue; } r -= I_UP;
            if (r < I_UP) { transpose_item(arg_in(lds, half ? I_F2W3 : I_F1W3) + (size_t)l * DM * DFF, DM, DFF, WUP, 1, 128, scr, r, lane, gn); continue; } r -= I_UP;
            transpose_item(arg_in(lds, half ? I_F2W2 : I_F1W2) + (size_t)l * DFF * DM, DFF, DM, WDN, 0, 0, scr, r, lane, nullptr); continue; }
        r -= 2 * I_FFN;
        bf16_t* WIN = (bf16_t*)(ws + WS_WIN + (size_t)l * SZ_WIN); bf16_t* WOUT = (bf16_t*)(ws + WS_WOUT + (size_t)l * SZ_WOUT); bf16_t* WC1 = (bf16_t*)(ws + WS_WC1 + (size_t)l * SZ_WC1);
        if (r < I_IN) { transpose_item(arg_in(lds, I_WIN) + (size_t)l * DM * IN_COLS, DM, IN_COLS, WIN, 0, 0, scr, r, lane, arg_in(lds, I_MIXN) + (size_t)l * DM); continue; } r -= I_IN;
        if (r < I_OUT) { transpose_item(arg_in(lds, I_WOUT) + (size_t)l * DM * DM, DM, DM, WOUT, 0, 0, scr, r, lane, nullptr); continue; } r -= I_OUT;
        if (r < I_C1) { transpose_item(arg_in(lds, I_CKW1) + (size_t)l * 4096 * 512, 4096, 512, WC1, 0, 0, scr, r, lane, nullptr); continue; } r -= I_C1;
        if (r < I_C1) { transpose_item(arg_in(lds, I_CVW1) + (size_t)l * 4096 * 512, 4096, 512, WC1, 0, 512, scr, r, lane, nullptr); continue; } r -= I_C1;
        { const int q = r * 64 + lane, kt = q / 1856, rem = q - kt * 1856; u32x4* z = (u32x4*)(WIN + ((size_t)(22 * 32 + kt) * 256 + 24) * 64) + rem; unsigned zr = 0u; asm volatile("" : "+v"(zr)); *z = (u32x4){zr, zr, zr, zr}; }
    }
    const float* xs = arg_in(lds, I_X); bf16_t* XB = (bf16_t*)(ws + WS_HB); float* RSTD = (float*)(ws + WS_RSTD);
    for (int m = gw; m < NTOK; m += NGW) {
        const f32x4* xr = (const f32x4*)(xs + (size_t)m * DM) + lane; f32x4 v[8]; float s = 0.f;
#pragma unroll
        for (int j = 0; j < 8; ++j) { v[j] = xr[64 * j]; s += (v[j].x * v[j].x + v[j].y * v[j].y) + (v[j].z * v[j].z + v[j].w * v[j].w); }
        s = wave_sum(s, lane);
#pragma unroll
        for (int j = 0; j < 8; ++j) { u32x2 w; w.x = cvtpk(v[j].x, v[j].y); w.y = cvtpk(v[j].z, v[j].w); *(u32x2*)(XB + kt_off(m, 256 * j + 4 * lane, DM)) = w; }
        if (lane == 0) RSTD[m] = 1.0f / sqrtf(s * (1.f / DM) + EPS);
    }
}
__device__ __forceinline__ void ph_rstd(LAS unsigned char* lds, const int wv) {
    lds = opq_lds(lds);
    const int tid = opq_tid(wv), G = opq_g(), bx = opq_bx();
    unsigned char* ws = arg_ws(lds); const float* SSQ = (const float*)(ws + WS_SSQ); float* RSTD = (float*)(ws + WS_RSTD);
    for (int m = bx * NTHR + tid; m < NTOK; m += G * NTHR) { const f32x4* p = (const f32x4*)(SSQ + (size_t)m * 32); f32x4 a = p[0];
#pragma unroll
        for (int j = 1; j < 8; ++j) a = a + p[j];
        RSTD[m] = 1.0f / sqrtf(((a.x + a.y) + (a.z + a.w)) * (1.f / DM) + EPS); }
}
__device__ __forceinline__ void ph_headnorm(LAS unsigned char* lds, int l, const int wv) {
    lds = opq_lds(lds);
    const int tid = opq_tid(wv), lane = tid & 63, wave = __builtin_amdgcn_readfirstlane(tid >> 6), G = opq_g(), bx = opq_bx();
    const int gw = bx * NWAVES + wave, NGW = G * NWAVES;
    unsigned char* ws = arg_ws(lds); bf16_t* HP = (bf16_t*)(ws + WS_HP); bf16_t* ACMP = (bf16_t*)(ws + WS_ACMP);
    const float* qna = arg_in(lds, I_QNA) + l * HD; const float* kna = arg_in(lds, I_KNA) + l * HD; const float* qnn = arg_in(lds, I_QNN) + l * HD; const float* knn = arg_in(lds, I_KNN) + l * HD;
    const float* pos = arg_in(lds, I_POS) + (size_t)l * 32 * HD;
    const int e0 = (lane & 15) * 8;
    for (int m = gw; m < NTOK; m += NGW) {
        bf16_t* prow = HP + (size_t)m * PC;
        int cols[3]; u32x4 wl[3];
#pragma unroll
        for (int ch = 0; ch < 3; ++ch) { cols[ch] = (ch < 2) ? C_KA + ch * 512 + lane * 8 : (lane < 32 ? C_KS + lane * 8 : C_KW + (lane - 32) * 8);
            wl[ch] = *(const u32x4*)(prow + cols[ch]); }
        const u32x4 wcv = *(const u32x4*)(prow + C_KC + lane * 8);
#pragma unroll
        for (int ch = 0; ch < 3; ++ch) {
            const float* gp = (ch < 2) ? kna : knn; const float sc = 1.f;
            const u32x4 w = wl[ch];
            float v[8] = {bflo(w.x), bfhi(w.x), bflo(w.y), bfhi(w.y), bflo(w.z), bfhi(w.z), bflo(w.w), bfhi(w.w)};
            float s = 0.f;
#pragma unroll
            for (int i = 0; i < 8; ++i) s += v[i] * v[i];
            s += shx(s, 1, lane); s += shx(s, 2, lane); s += shx(s, 4, lane); s += shx(s, 8, lane);
            const float rs = sc / sqrtf(s * (1.f / HD) + EPS);
            const f32x4 g0 = *(const f32x4*)(gp + e0), g1 = *(const f32x4*)(gp + e0 + 4);
            u32x4 o; o.x = cvtpk(v[0] * rs * g0.x, v[1] * rs * g0.y); o.y = cvtpk(v[2] * rs * g0.z, v[3] * rs * g0.w); o.z = cvtpk(v[4] * rs * g1.x, v[5] * rs * g1.y); o.w = cvtpk(v[6] * rs * g1.z, v[7] * rs * g1.w);
            *(u32x4*)(prow + cols[ch]) = o;
        }
        { const int b = m / SEQ, t = m % SEQ, kv = lane >> 5, gg = (lane >> 4) & 1, c1 = t >> 4, j1 = t & 15;
          const u32x4 w = wcv;
          const float v[8] = {bflo(w.x), bfhi(w.x), bflo(w.y), bfhi(w.y), bflo(w.z), bfhi(w.z), bflo(w.w), bfhi(w.w)};
          const int arow0 = kv * 4096 + (b * 2 + gg) * 512;
          if (c1 <= 510) { const f32x4 p0 = *(const f32x4*)(pos + j1 * HD + e0), p1 = *(const f32x4*)(pos + j1 * HD + e0 + 4);
              u32x4 o; o.x = cvtpk(v[0] + p0.x, v[1] + p0.y); o.y = cvtpk(v[2] + p0.z, v[3] + p0.w); o.z = cvtpk(v[4] + p1.x, v[5] + p1.y); o.w = cvtpk(v[6] + p1.z, v[7] + p1.w);
              *(u32x4*)(ACMP + kt_off(arow0 + c1, j1 * HD + e0, 4096)) = o; }
          else { const u32x4 z = {0u, 0u, 0u, 0u}; *(u32x4*)(ACMP + kt_off(arow0 + 511, j1 * HD + e0, 4096)) = z; *(u32x4*)(ACMP + kt_off(arow0 + 511, (j1 + 16) * HD + e0, 4096)) = z; }
          if (c1 >= 1) { const int j2 = j1 + 16; const f32x4 p0 = *(const f32x4*)(pos + j2 * HD + e0), p1 = *(const f32x4*)(pos + j2 * HD + e0 + 4);
              u32x4 o; o.x = cvtpk(v[0] + p0.x, v[1] + p0.y); o.y = cvtpk(v[2] + p0.z, v[3] + p0.w); o.z = cvtpk(v[4] + p1.x, v[5] + p1.y); o.w = cvtpk(v[6] + p1.z, v[7] + p1.w);
              *(u32x4*)(ACMP + kt_off(arow0 + c1 - 1, j2 * HD + e0, 4096)) = o; } }
    }
}
__device__ __forceinline__ float gelu_tanh(float v) { const float u3 = 0.7978845608028654f * (v + 0.044715f * v * v * v); return 0.5f * v * (2.0f - 2.0f / (__expf(2.0f * u3) + 1.0f)); }
__device__ __forceinline__ void ph_cmp2(LAS unsigned char* lds, int l, const int wv) {
    lds = opq_lds(lds);
    const int tid = opq_tid(wv), lane = tid & 63, wave = __builtin_amdgcn_readfirstlane(tid >> 6), G = opq_g(), bx = opq_bx();
    unsigned char* ws = arg_ws(lds); const float* CP = (const float*)(ws + WS_CP);
    LAS float* CH = (LAS float*)lds;
    LAS float* RED = (LAS float*)(lds + 65536);
    const float* knn = arg_in(lds, I_KNN) + l * HD;
    for (int it = bx; it < 256; it += G) {
        const int R0 = it * 32, kv = R0 >> 12, rl0 = R0 & 4095;
        __syncthreads();
        for (int i4 = tid; i4 < 32 * 128; i4 += NTHR) { const int rr = i4 >> 7, k4 = (i4 & 127) * 4; f32x4 v = {0.f, 0.f, 0.f, 0.f};
#pragma unroll
            for (int ks = 0; ks < 4; ++ks) v = v + *(const f32x4*)(CP + ((size_t)(kv * 4 + ks) * 4096 + rl0 + rr) * 512 + k4);
            f32x4 o; o.x = gelu_tanh(v.x); o.y = gelu_tanh(v.y); o.z = gelu_tanh(v.z); o.w = gelu_tanh(v.w);
            *(LAS f32x4*)(CH + rr * 512 + k4) = o; }
        __syncthreads();
        const int n = tid & 127, rq = tid >> 7;
        const float* w2 = arg_in(lds, kv ? I_CVW2 : I_CKW2) + (size_t)l * 512 * HD + n;
        float acc[8];
#pragma unroll
        for (int i = 0; i < 8; ++i) acc[i] = 0.f;
#pragma unroll 4
        for (int k = 0; k < 512; k += 4) { const float w0 = w2[(size_t)k * HD], w1 = w2[(size_t)(k + 1) * HD], w2v = w2[(size_t)(k + 2) * HD], w3 = w2[(size_t)(k + 3) * HD];
#pragma unroll
            for (int i = 0; i < 8; ++i) { const f32x4 c = *(const LAS f32x4*)(CH + (rq * 8 + i) * 512 + k); acc[i] += (c.x * w0 + c.y * w1) + (c.z * w2v + c.w * w3); } }
        if (kv == 0) {
            float ss[8];
#pragma unroll
            for (int i = 0; i < 8; ++i) ss[i] = wave_sum(acc[i] * acc[i], lane);
            if (lane == 0) {
#pragma unroll
                for (int i = 0; i < 8; ++i) RED[wave * 8 + i] = ss[i]; }
            __syncthreads();
            const float gn = knn[n];
#pragma unroll
            for (int i = 0; i < 8; ++i) { const float tot = RED[(2 * rq) * 8 + i] + RED[(2 * rq + 1) * 8 + i]; acc[i] = acc[i] / sqrtf(tot * (1.f / HD) + EPS) * gn; }
        }
        bf16_t* dst = (bf16_t*)(ws + (kv ? WS_VC + 0 : WS_KC + 0)) + (size_t)(rl0 + rq * 8) * HD + n;
#pragma unroll
        for (int i = 0; i < 8; ++i) dst[(size_t)i * HD] = (bf16_t)f2bf(acc[i]);
    }
}
__device__ __forceinline__ void ph_outnorm(LAS unsigned char* lds, int l, const int wv) {
    lds = opq_lds(lds);
    const int tid = opq_tid(wv), lane = tid & 63, wave = __builtin_amdgcn_readfirstlane(tid >> 6), G = opq_g(), bx = opq_bx();
    const int gw = bx * NWAVES + wave, NGW = G * NWAVES;
    unsigned char* ws = arg_ws(lds); const bf16_t* OA = (const bf16_t*)(ws + WS_OA); const bf16_t* ON = (const bf16_t*)(ws + WS_ON); bf16_t* HB = (bf16_t*)(ws + WS_HP);
    const float* gn = arg_in(lds, I_ON) + (size_t)l * DM;
    for (int m = gw; m < NTOK; m += NGW) {
        const bf16_t* oa = OA + (size_t)m * 1024; bf16_t* y = HB;
        const u32x4 wa = *(const u32x4*)(oa + lane * 8), wb = *(const u32x4*)(oa + 512 + lane * 8);
        u32x4 wn[6];
#pragma unroll
        for (int br = 0; br < 3; ++br) { const bf16_t* onb = ON + ((size_t)br * NTOK + m) * 1024; wn[2 * br] = *(const u32x4*)(onb + lane * 8); wn[2 * br + 1] = *(const u32x4*)(onb + 512 + lane * 8); }
        float va[16] = {bflo(wa.x), bfhi(wa.x), bflo(wa.y), bfhi(wa.y), bflo(wa.z), bfhi(wa.z), bflo(wa.w), bfhi(wa.w), bflo(wb.x), bfhi(wb.x), bflo(wb.y), bfhi(wb.y), bflo(wb.z), bfhi(wb.z), bflo(wb.w), bfhi(wb.w)};
        float sa = 0.f;
#pragma unroll
        for (int i = 0; i < 16; ++i) sa += va[i] * va[i];
        float vs[16]; float sn = 0.f;
#pragma unroll
        for (int i = 0; i < 16; ++i) vs[i] = 0.f;
#pragma unroll
        for (int br = 0; br < 3; ++br) { const u32x4 wc = wn[2 * br], wd = wn[2 * br + 1];
            vs[0] += bflo(wc.x); vs[1] += bfhi(wc.x); vs[2] += bflo(wc.y); vs[3] += bfhi(wc.y); vs[4] += bflo(wc.z); vs[5] += bfhi(wc.z); vs[6] += bflo(wc.w); vs[7] += bfhi(wc.w);
            vs[8] += bflo(wd.x); vs[9] += bfhi(wd.x); vs[10] += bflo(wd.y); vs[11] += bfhi(wd.y); vs[12] += bflo(wd.z); vs[13] += bfhi(wd.z); vs[14] += bflo(wd.w); vs[15] += bfhi(wd.w); }
        const float ra = 1.0f / sqrtf(wave_sum(sa, lane) * (1.f / 1024.f) + EPS);
        { const f32x4 g0 = *(const f32x4*)(gn + lane * 8), g1 = *(const f32x4*)(gn + lane * 8 + 4), g2 = *(const f32x4*)(gn + 512 + lane * 8), g3 = *(const f32x4*)(gn + 512 + lane * 8 + 4);
          u32x4 o; o.x = cvtpk(va[0] * ra * g0.x, va[1] * ra * g0.y); o.y = cvtpk(va[2] * ra * g0.z, va[3] * ra * g0.w); o.z = cvtpk(va[4] * ra * g1.x, va[5] * ra * g1.y); o.w = cvtpk(va[6] * ra * g1.z, va[7] * ra * g1.w);
          *(u32x4*)(y + kt_off(m, lane * 8, DM)) = o;
          o.x = cvtpk(va[8] * ra * g2.x, va[9] * ra * g2.y); o.y = cvtpk(va[10] * ra * g2.z, va[11] * ra * g2.w); o.z = cvtpk(va[12] * ra * g3.x, va[13] * ra * g3.y); o.w = cvtpk(va[14] * ra * g3.z, va[15] * ra * g3.w);
          *(u32x4*)(y + kt_off(m, 512 + lane * 8, DM)) = o; }
#pragma unroll
        for (int i = 0; i < 16; ++i) sn += vs[i] * vs[i];
        const float rn = 1.0f / sqrtf(wave_sum(sn, lane) * (1.f / 1024.f) + EPS);
        { const float* g2 = gn + 1024; const f32x4 g0 = *(const f32x4*)(g2 + lane * 8), g1 = *(const f32x4*)(g2 + lane * 8 + 4), g2a = *(const f32x4*)(g2 + 512 + lane * 8), g3 = *(const f32x4*)(g2 + 512 + lane * 8 + 4);
          u32x4 o; o.x = cvtpk(vs[0] * rn * g0.x, vs[1] * rn * g0.y); o.y = cvtpk(vs[2] * rn * g0.z, vs[3] * rn * g0.w); o.z = cvtpk(vs[4] * rn * g1.x, vs[5] * rn * g1.y); o.w = cvtpk(vs[6] * rn * g1.z, vs[7] * rn * g1.w);
          *(u32x4*)(y + kt_off(m, 1024 + lane * 8, DM)) = o;
          o.x = cvtpk(vs[8] * rn * g2a.x, vs[9] * rn * g2a.y); o.y = cvtpk(vs[10] * rn * g2a.z, vs[11] * rn * g2a.w); o.z = cvtpk(vs[12] * rn * g3.x, vs[13] * rn * g3.y); o.w = cvtpk(vs[14] * rn * g3.z, vs[15] * rn * g3.w);
          *(u32x4*)(y + kt_off(m, 1536 + lane * 8, DM)) = o; }
    }
}

#define GRID_BAR() do { XcdBarrier bar_; bar_.bar = (unsigned*)(arg_ws(lds) + WS_CTL) + CW_BAR; bar_.x = xb_xcc_id(); bar_.st = (volatile LAS unsigned*)(opq_lds(lds) + LDS_MISC + 32); xcd_barrier(bar_, wv); } while (0)
__global__ void __launch_bounds__(NTHR, 2) mega_fwd(Args a) {
    extern __shared__ __attribute__((aligned(16))) unsigned char lds_raw[];
    LAS unsigned char* lds = (LAS unsigned char*)lds_raw;
    const int wv = __builtin_amdgcn_readfirstlane((int)threadIdx.x >> 6);
    {
        const int tid = threadIdx.x;
        for (int u = tid; u < (LDS_BYTES - LDS_MISC) / 4; u += NTHR) ((LAS unsigned*)(lds + LDS_MISC))[u] = 0u;
        __syncthreads();
        if (tid == 0) { LAS unsigned long long* t = (LAS unsigned long long*)(lds + LDS_ARGS);
#pragma unroll
            for (int i = 0; i < 24; ++i) t[i] = (unsigned long long)(uintptr_t)a.in[i];
            t[24] = (unsigned long long)(uintptr_t)a.out; t[25] = (unsigned long long)(uintptr_t)a.ws; }
        __syncthreads();
    }
    (void)xcd_barrier_post((unsigned*)(arg_ws(lds) + WS_CTL) + CW_BAR, (volatile LAS unsigned*)(lds + LDS_MISC + 32));

    { const int tid = opq_tid(wv), G = opq_g(), bx = opq_bx(); const float* rb = arg_in(lds, I_RB); unsigned char* ws = arg_ws(lds);
      float* dilT = (float*)(ws + WS_TBL); float* nsaT = (float*)(ws + WS_TBL + 65536);
      for (int i = bx * NTHR + tid; i < 3 * 8 * DTS + 8 * TBLS; i += G * NTHR) {
          if (i < 3 * 8 * DTS) { const int p = i / (8 * DTS), h = (i / DTS) % 8, df = i % DTS - DT0; const int d = (p == 0) ? 1 : (p == 1 ? 4 : 16);
              dilT[i] = (df >= 0 && df <= 128) ? rb[rel_bucket_dev(df * d) * 16 + h] : 0.f; }
          else { const int j = i - 3 * 8 * DTS, hh = j / TBLS, ds = j % TBLS - TBL0; nsaT[j] = (ds >= 0) ? rb[rel_bucket_dev(ds) * 16 + 8 + hh] : 0.f; } } }

    ph_prologue(lds, wv);
    GRID_BAR();
#pragma unroll 1
    for (int step = 0; step < 2 * DEPTH; ++step) {
        const int l = step >> 1, half = step & 1;
        { unsigned char* ws = arg_ws(lds); const int G = opq_g(), bx = opq_bx();
          pg8::Gemm g{64, 64, DM}; pg8::SchedStd S; S.init(ws + WS_HB, ws + WS_WUP + (size_t)step * SZ_WUP, NTOK, 2 * DFF, DM, DM, G, bx); const pg8::EpiSwiGLU E{(bf16_t*)(ws + WS_HP), DFF, (const float*)(ws + WS_RSTD)};
          pg8::gemm_phase<pg8::EpiSwiGLU, pg8::SchedStd, 32768, 32768>(opq_lds(lds), g, S, E, wv);
        }
        GRID_BAR();
        { unsigned char* ws = arg_ws(lds); const int G = opq_g(), bx = opq_bx(); float* X = arg_out(lds);
          pg8::Gemm g{64, 64, DFF}; pg8::SchedStd S; S.init(ws + WS_HP, ws + WS_WDN + (size_t)step * SZ_WDN, NTOK, DM, DFF, DFF, G, bx, 4);
          pg8::EpiResid E{(step == 2 * DEPTH - 1) ? X : (float*)nullptr, (bf16_t*)(ws + WS_HB), (float*)(ws + WS_SSQ), DM, 0.5f};
          pg8::gemm_phase<pg8::EpiResid, pg8::SchedStd, 32768, 32768>(opq_lds(lds), g, S, E, wv);
        }
        if (step == 2 * DEPTH - 1) break;
        GRID_BAR();
        ph_rstd(lds, wv);
        GRID_BAR();
        if (half == 0) {
            { unsigned char* ws = arg_ws(lds); const int G = opq_g(), bx = opq_bx();
              pg8::Gemm g{64, 64, DM}; pg8::SchedStd S; S.init(ws + WS_HB, ws + WS_WIN + (size_t)l * SZ_WIN, NTOK, PC, DM, DM, G, bx); const pg8::EpiBf16 E{(bf16_t*)(ws + WS_HP), PC, (const float*)(ws + WS_RSTD)};
              pg8::gemm_phase<pg8::EpiBf16, pg8::SchedStd, 32768, 32768>(opq_lds(lds), g, S, E, wv);
            }
            GRID_BAR();
            ph_headnorm(lds, l, wv);
            GRID_BAR();
#pragma unroll 1
            for (int pat3 = 0; pat3 < 3; ++pat3) { const int pat = pat3 % 3;
                if (pat3 == 0) { unsigned char* ws = arg_ws(lds); const int G = opq_g(), bx = opq_bx();
                  pg8::Gemm g{64, 64, 1024}; pg8::SchedCmp S; S.A = (const char*)(ws + WS_ACMP); S.Bt = (const char*)(ws + WS_WC1 + (size_t)l * SZ_WC1); S.G = G; S.c = bx; pg8::EpiF32Z E{(float*)(ws + WS_CP), 512, (size_t)4096 * 512};
                  pg8::gemm_phase<pg8::EpiF32Z, pg8::SchedCmp, 32768, 32768>(opq_lds(lds), g, S, E, wv); }
                if (pat3 == 1) ph_cmp2(lds, l, wv);
                { unsigned char* ws = arg_ws(lds); const int G = opq_g(), bx = opq_bx();
                  for (int u0 = bx; u0 < 1024; u0 += G) { const int w_ = u0 & 255, k_ = u0 >> 8; const int unit = (((w_ & 7) + 8 * k_) << 5) | (w_ >> 3);
                    dil_unit((LAS char*)opq_lds(lds), (const bf16_t*)(ws + WS_HP), (bf16_t*)(ws + WS_OA), (float*)(ws + WS_LSE), (const float*)(ws + WS_TBL), arg_in(lds, I_QNA) + l * HD, pat, 2 * pat, unit, wv); } }
                if (pat3 + 1 < 3) GRID_BAR();
            }
            { unsigned char* ws = arg_ws(lds); const int G = opq_g(), bx = opq_bx();
              const float* gb = arg_in(lds, I_GB) + l * 24; const float* qgn = arg_in(lds, I_QNN) + l * HD;
              int last_bg = -1;
#pragma unroll 1
              for (int i4 = 0; i4 < 4; ++i4)
#pragma unroll 1
                  for (int w = bx; w < 256; w += G) { const int i = i4 & 3; const int bg = w & 7, j = w >> 3;
                      const int qi = (i == 0) ? 127 - j : (i == 1 ? j : (i == 2 ? 64 + j : 63 - j));
                      nsa_unit((LAS char*)opq_lds(lds), (const bf16_t*)(ws + WS_HP), (const bf16_t*)(ws + WS_KC), (const bf16_t*)(ws + WS_VC), (bf16_t*)(ws + WS_ON), (const float*)(ws + WS_TBL + 65536), gb, qgn, bg >> 1, bg & 1, qi, bg != last_bg, wv); last_bg = bg; } }
            GRID_BAR();
            ph_outnorm(lds, l, wv);
            GRID_BAR();
            { unsigned char* ws = arg_ws(lds); const int G = opq_g(), bx = opq_bx(); float* X = arg_out(lds);
              pg8::Gemm g{64, 64, DM}; pg8::SchedStd S; S.init(ws + WS_HP, ws + WS_WOUT + (size_t)l * SZ_WOUT, NTOK, DM, DM, DM, G, bx, 4); pg8::EpiResid E{(float*)nullptr, (bf16_t*)(ws + WS_HB), (float*)(ws + WS_SSQ), DM, 1.0f};
              pg8::gemm_phase<pg8::EpiResid, pg8::SchedStd, 32768, 32768>(opq_lds(lds), g, S, E, wv);
            }
            GRID_BAR();
            ph_rstd(lds, wv);
            GRID_BAR();
        }
    }
}

extern "C" void kernel_launch(void* const* d_in, const int* in_sizes, int n_in, void* d_out, int out_size, void* d_ws, size_t ws_size, hipStream_t stream) {
    static int grid = 0;
    if (grid == 0) {
        if (n_in != 24 || in_sizes[0] != NTOK * DM || out_size != NTOK * DM || ws_size < WS_END) { fprintf(stderr, "kernel_launch: shape mismatch n_in %d in0 %d out %d ws %zu (need %zu)\n", n_in, n_in > 0 ? in_sizes[0] : -1, out_size, ws_size, (size_t)WS_END); grid = -1; return; }
        int dev = 0, cus = 0, per_cu = 0;
        if (hipGetDevice(&dev) != hipSuccess || hipDeviceGetAttribute(&cus, hipDeviceAttributeMultiprocessorCount, dev) != hipSuccess) { grid = -1; return; }
        if (hipFuncSetAttribute((const void*)mega_fwd, hipFuncAttributeMaxDynamicSharedMemorySize, LDS_BYTES) != hipSuccess) { fprintf(stderr, "kernel_launch: hipFuncSetAttribute failed\n"); grid = -1; return; }
        if (hipOccupancyMaxActiveBlocksPerMultiprocessor(&per_cu, (const void*)mega_fwd, NTHR, LDS_BYTES) != hipSuccess || per_cu < 1) { fprintf(stderr, "kernel_launch: occupancy query says %d\n", per_cu); (void)hipGetLastError(); if (per_cu < 1) { grid = -1; return; } }
        grid = cus;
    }
    if (grid < 0) return;
    if (hipMemsetAsync((char*)d_ws + WS_CTL, 0, CTL_ZERO_BYTES, stream) != hipSuccess) return;
    Args a{};
    for (int i = 0; i < 24; ++i) a.in[i] = (const float*)d_in[i];
    a.out = (float*)d_out; a.ws = (unsigned char*)d_ws;
    hipLaunchKernelGGL(mega_fwd, dim3(grid), dim3(NTHR), LDS_BYTES, stream, a);
    const hipError_t le = hipPeekAtLastError();
    if (le != hipSuccess) fprintf(stderr, "kernel_launch: launch failed: %s\n", hipGetErrorName(le));
}
```

```cpp
#include <hip/hip_runtime.h>
#include <cstdio>
#include <cstdint>

#define LAS __attribute__((address_space(3)))
typedef unsigned short bf16_t;
typedef short bf16x8 __attribute__((ext_vector_type(8)));
typedef short s16x4 __attribute__((ext_vector_type(4)));
typedef float f32x2 __attribute__((ext_vector_type(2)));
typedef float f32x4 __attribute__((ext_vector_type(4)));
typedef float f32x16 __attribute__((ext_vector_type(16)));
typedef unsigned u32x2 __attribute__((ext_vector_type(2)));
typedef unsigned u32x4 __attribute__((ext_vector_type(4)));

constexpr int BATCH = 4, SEQ = 8192, DM = 2048, DFF = 5632, NTOK = BATCH * SEQ, DEPTH = 4, HD = 128;
constexpr int IN_COLS = 5656, PC = 5888;
constexpr int C_QA = 0, C_KA = 1024, C_VA = 2048, C_QN = 3072, C_KC = 4096, C_VC = 4352, C_KS = 4608, C_VS = 4864, C_KW = 5120, C_VW = 5376, C_GL = 5632;
constexpr float EPS = 1e-6f, QSCALE = 0.08838834764831845f, LOG2E = 1.4426950408889634f;
constexpr int TBLS = 1704, TBL0 = 64;
constexpr int DTS = 320, DT0 = 96;
constexpr int NWAVES = 8, NTHR = 512;

constexpr size_t MiB = 1u << 20;
constexpr size_t WS_CTL = 0, CTL_ZERO_BYTES = 1 * MiB;
constexpr size_t WS_TBL = 1 * MiB;
constexpr size_t SZ_WUP = 44 * MiB, SZ_WDN = 22 * MiB, SZ_WIN = 23 * MiB, SZ_WOUT = 8 * MiB, SZ_WC1 = 8 * MiB;
constexpr size_t WS_WUP = 2 * MiB;
constexpr size_t WS_WDN = WS_WUP + 8 * SZ_WUP;
constexpr size_t WS_WIN = WS_WDN + 8 * SZ_WDN;
constexpr size_t WS_WOUT = WS_WIN + 4 * SZ_WIN;
constexpr size_t WS_WC1 = WS_WOUT + 4 * SZ_WOUT;
constexpr size_t WS_HB = WS_WC1 + 4 * SZ_WC1;
constexpr size_t WS_HP = WS_HB + 128 * MiB;
constexpr size_t WS_OA = WS_HP + 368 * MiB;
constexpr size_t WS_LSE = WS_OA + 64 * MiB;
constexpr size_t WS_ON = WS_LSE + 1 * MiB;
constexpr size_t WS_ACMP = WS_ON + 192 * MiB;
constexpr size_t WS_CP = WS_ACMP + 64 * MiB;
constexpr size_t WS_KC = WS_CP + 64 * MiB;
constexpr size_t WS_VC = WS_KC + 1 * MiB;
constexpr size_t WS_SSQ = WS_VC + 1 * MiB;
constexpr size_t WS_RSTD = WS_SSQ + 4 * MiB;
constexpr size_t WS_END = WS_RSTD + 1 * MiB;
constexpr int CW_BAR = 4096;

__device__ __forceinline__ unsigned f2bf(float f) { unsigned u = __builtin_bit_cast(unsigned, f); return (u + 0x7fffu + ((u >> 16) & 1u)) >> 16; }
__device__ __forceinline__ unsigned pk2(float lo, float hi) { return f2bf(lo) | (f2bf(hi) << 16); }
__device__ __forceinline__ float bf2f(bf16_t b) { return __builtin_bit_cast(float, ((unsigned)b) << 16); }
__device__ __forceinline__ float bflo(unsigned w) { return __builtin_bit_cast(float, w << 16); }
__device__ __forceinline__ float bfhi(unsigned w) { return __builtin_bit_cast(float, w & 0xffff0000u); }
__device__ __forceinline__ unsigned cvtpk(float lo, float hi) { unsigned r; asm volatile("v_cvt_pk_bf16_f32 %0, %1, %2" : "=v"(r) : "v"(lo), "v"(hi)); return r; }
__device__ __forceinline__ float shx(float v, int m, int lane) { return __builtin_bit_cast(float, __builtin_amdgcn_ds_bpermute((lane ^ m) << 2, __builtin_bit_cast(int, v))); }
__device__ __forceinline__ float wave_sum(float v, int lane) {
#pragma unroll
    for (int o = 1; o < 64; o <<= 1) v += shx(v, o, lane);
    return v;
}
__device__ __forceinline__ LAS unsigned char* opq_lds(LAS unsigned char* p) { unsigned a = (unsigned)(uintptr_t)p; asm volatile("" : "+s"(a)); return (LAS unsigned char*)(uintptr_t)a; }
__device__ __forceinline__ int opq_tid(int wv) { int l; asm volatile("v_mbcnt_lo_u32_b32 %0, -1, 0\n\tv_mbcnt_hi_u32_b32 %0, -1, %0" : "=v"(l)); return wv * 64 + l; }
__device__ __forceinline__ size_t kt_off(int r, int k, int K) { return (((size_t)(r >> 8) * (K >> 6) + (k >> 6)) * 256 + (r & 255)) * 64 + (k & 63); }
#define LDS_WAIT() asm volatile("s_waitcnt lgkmcnt(0)" ::: "memory")
#define VM_WAIT() asm volatile("s_waitcnt vmcnt(0)" ::: "memory")
#define SBAR() __builtin_amdgcn_sched_barrier(0)

#define XB_TMO      128
#define XB_XCNT(j)  (256  + 64 * (j))
#define XB_XSUB(j)  (1280 + 64 * (j))
#define XB_XGEN(j)  (2304 + 64 * (j))
#define XB_TOP      3328
#define XB_TOPGEN   3392
#define XCD_BAR_WORDS 3456
#define XB_SPIN_CAP (1u << 18)
__device__ __forceinline__ unsigned xb_ld(unsigned* p)              { return __hip_atomic_load(p, __ATOMIC_RELAXED, __HIP_MEMORY_SCOPE_AGENT); }
__device__ __forceinline__ unsigned xb_add(unsigned* p, unsigned v) { return __hip_atomic_fetch_add(p, v, __ATOMIC_RELAXED, __HIP_MEMORY_SCOPE_AGENT); }
__device__ __forceinline__ unsigned xb_xcc_id() { return (unsigned)__builtin_amdgcn_s_getreg((3 << 11) | 20) & 0xFu; }
#define XB_SPIN(cond, bar) do { unsigned _sp = 0; while (cond) { __builtin_amdgcn_s_sleep(1); \
    if ((++_sp & 255u) == 0u) { if (xb_ld(&(bar)[XB_TMO])) break; if (_sp > XB_SPIN_CAP) { atomicAdd(&(bar)[XB_TMO], 1u); break; } } } } while (0)
struct XcdBarrier { unsigned* bar; unsigned x; volatile LAS unsigned* st; };
__device__ __forceinline__ XcdBarrier xcd_barrier_post(unsigned* bar, volatile LAS unsigned* st) {
    XcdBarrier b; b.bar = bar; b.x = xb_xcc_id(); b.st = st;
    if (threadIdx.x == 0) (void)xb_add(&bar[XB_XCNT(b.x)], 1u);
    return b;
}
__device__ __forceinline__ void xcd_barrier_complete(unsigned* bar, unsigned x, unsigned& nloc, unsigned& nx) {
    const unsigned G = gridDim.x * gridDim.y * gridDim.z;
    unsigned sum, cnt, mine, sp = 0u;
    for (;;) {
        sum = 0u; cnt = 0u; mine = 0u;
#pragma unroll
        for (unsigned j = 0; j < 16; ++j) { const unsigned c = xb_ld(&bar[XB_XCNT(j)]); sum += c; cnt += (c > 0u) ? 1u : 0u; mine = (j == x) ? c : mine; }
        if (sum == G) break;
        __builtin_amdgcn_s_sleep(1);
        if ((++sp & 255u) == 0u) { if (xb_ld(&bar[XB_TMO])) break; if (sp > XB_SPIN_CAP) { atomicAdd(&bar[XB_TMO], 1u); break; } }
    }
    nloc = mine > 0u ? mine : 1u; nx = cnt > 0u ? cnt : 1u;
}
__device__ __forceinline__ void xcd_barrier(const XcdBarrier& b, const int wv) {
    asm volatile("s_waitcnt vmcnt(0)" ::: "memory");
    __syncthreads();
    if (opq_tid(wv) == 0) {
        unsigned* bar = b.bar; asm volatile("" : "+s"(bar));
        __builtin_amdgcn_s_waitcnt(0);
        unsigned nloc = b.st[0], nx = b.st[1];
        if (nloc == 0u) { xcd_barrier_complete(bar, b.x, nloc, nx); b.st[0] = nloc; b.st[1] = nx; }
        const unsigned old = xb_add(&bar[XB_XSUB(b.x)], 1u);
        const unsigned gen = old / nloc;
        if (old + 1u == (gen + 1u) * nloc) {
            __builtin_amdgcn_fence(__ATOMIC_RELEASE, "agent");
            asm volatile("s_waitcnt vmcnt(0)" ::: "memory");
            const unsigned og = xb_add(&bar[XB_TOP], 1u);
            const unsigned tg = og / nx;
            if (og + 1u == (tg + 1u) * nx) xb_add(&bar[XB_TOPGEN], 1u);
            else XB_SPIN(xb_ld(&bar[XB_TOPGEN]) == tg, bar);
            __builtin_amdgcn_fence(__ATOMIC_ACQUIRE, "agent");
            xb_add(&bar[XB_XGEN(b.x)], 1u);
            asm volatile("s_waitcnt vmcnt(0)" ::: "memory");
        } else {
            XB_SPIN(xb_ld(&bar[XB_XGEN(b.x)]) == gen, bar);
            __builtin_amdgcn_fence(__ATOMIC_ACQUIRE, "agent");
            asm volatile("s_waitcnt vmcnt(0)" ::: "memory");
        }
    }
    __syncthreads();
}

namespace pg8 {
constexpr int BM = 256, BK = 64, HALF = 128, HTB = HALF * BK * 2, STAGE_BYTES = 8 * HTB, NXCD = 8, WGM = 8;
__host__ __device__ __forceinline__ int lds_byte(int r, int c) { const int st = (r >> 4) * 2 + (c >> 5), rr = r & 15, cc = c & 31, ob = rr * 64 + cc * 2; return st * 1024 + (ob ^ (((ob >> 9) & 1) << 5)); }
__host__ __device__ __forceinline__ void stage_rc(int b, int& R, int& C) { const int st = b / 1024, sb = b % 1024, swz = sb ^ (((sb >> 9) & 1) << 5); R = (st >> 1) * 16 + swz / 64; C = (st & 1) * 32 + (swz % 64) / 2; }
__host__ __device__ __forceinline__ int perm32(int rho) { const int n = rho >> 4, i = rho & 15; return 8 * (i >> 2) + 4 * n + (i & 3); }
struct Unit { int pm, pn, z; };
struct Gemm { int lda, ldb, K; };
struct SchedStd {
    const char* A; const char* Bt; size_t atile, btile; int nM, nN, nwg, G, c, wgm;
    __device__ __forceinline__ void init(const void* A_, const void* Bt_, int M, int N, int lda, int ldb, int G_, int c_, int wgm_ = WGM) { wgm = wgm_;
        A = (const char*)A_; Bt = (const char*)Bt_; atile = (size_t)BM * lda * 2; btile = (size_t)BM * ldb * 2; nM = M / BM; nN = N / BM; nwg = nM * nN; G = G_; c = c_; }
    __device__ __forceinline__ bool next(int i, Unit& u) const {
        const long L = (long)i * G + c; if (L >= nwg) return false;
        int wgid = (int)L; { const int q = nwg / NXCD, r = nwg % NXCD, xcd = wgid % NXCD, off = wgid / NXCD; wgid = (xcd < r ? xcd * (q + 1) : r * (q + 1) + (xcd - r) * q) + off; }
        const int nig = wgm * nN, gid = wgid / nig, fm = gid * wgm, gsz = (nM - fm) < wgm ? (nM - fm) : wgm;
        u.pm = fm + ((wgid % nig) % gsz); u.pn = (wgid % nig) / gsz; u.z = 0; return true;
    }
    __device__ __forceinline__ const char* a_ptr(const Unit& u) const { return A + (size_t)u.pm * atile; }
    __device__ __forceinline__ const char* b_ptr(const Unit& u) const { return Bt + (size_t)u.pn * btile; }
};
struct SchedCmp {
    const char* A; const char* Bt; int G, c;
    __device__ __forceinline__ bool next(int i, Unit& u) const { const int L = i * G + c; if (L >= 256) return false; u.z = L >> 5; u.pm = (L & 31) >> 1; u.pn = L & 1; return true; }
    __device__ __forceinline__ const char* a_ptr(const Unit& u) const { const int kv = u.z >> 2, ks = u.z & 3; return A + ((size_t)(kv * 16 + u.pm) * 64 + (size_t)ks * 16) * 32768; }
    __device__ __forceinline__ const char* b_ptr(const Unit& u) const { const int kv = u.z >> 2, ks = u.z & 3; return Bt + ((size_t)(kv * 2 + u.pn) * 64 + (size_t)ks * 16) * 32768; }
};
struct EpiBf16 {
    static constexpr bool PERM = true;
    bf16_t* O; int ldc; const float* rstd;
    __device__ __forceinline__ void prefetch(float (&pre)[8], const Unit& u, int wr, int fr) const {
#pragma unroll
        for (int i = 0; i < 8; ++i) pre[i] = rstd[u.pm * BM + wr * 64 + fr + (i >> 2) * HALF + (i & 3) * 16]; }
    __device__ __forceinline__ void operator()(const f32x4 (&acc)[2][2][4][2], const Unit& u, int wr, int wc, int fr, int fq, const float (&pre)[8]) const {
        const int row0 = u.pm * BM + wr * 64 + fr, col0 = u.pn * BM + wc * 32 + 8 * fq;
#pragma unroll
        for (int ai = 0; ai < 2; ++ai)
#pragma unroll
            for (int m = 0; m < 4; ++m) { bf16_t* rowp = O + (size_t)(row0 + ai * HALF + m * 16) * ldc + col0; const float rs = pre[ai * 4 + m];
#pragma unroll
                for (int bj = 0; bj < 2; ++bj) { const f32x4 v0 = acc[ai][bj][m][0] * rs, v1 = acc[ai][bj][m][1] * rs;
                    u32x4 w; w.x = cvtpk(v0[0], v0[1]); w.y = cvtpk(v0[2], v0[3]); w.z = cvtpk(v1[0], v1[1]); w.w = cvtpk(v1[2], v1[3]);
                    *(u32x4*)(rowp + bj * HALF) = w; } }
    }
};
struct EpiSwiGLU {
    static constexpr bool PERM = true;
    bf16_t* O; int ldc; const float* rstd;
    __device__ __forceinline__ void prefetch(float (&pre)[8], const Unit& u, int wr, int fr) const {
#pragma unroll
        for (int i = 0; i < 8; ++i) pre[i] = rstd[u.pm * BM + wr * 64 + fr + (i >> 2) * HALF + (i & 3) * 16]; }
    __device__ __forceinline__ void operator()(const f32x4 (&acc)[2][2][4][2], const Unit& u, int wr, int wc, int fr, int fq, const float (&pre)[8]) const {
        const int rowp0 = wr * 64 + fr, kt = 2 * u.pn + (wc >> 1), cit = (wc & 1) * 32 + 8 * fq;
        bf16_t* tile = O + ((size_t)u.pm * (ldc / 64) + kt) * (256 * 64) + cit;
#pragma unroll
        for (int ai = 0; ai < 2; ++ai)
#pragma unroll
            for (int m = 0; m < 4; ++m) { bf16_t* rowp = tile + (size_t)(rowp0 + ai * HALF + m * 16) * 64; const float rs = pre[ai * 4 + m];
                float v[8];
#pragma unroll
                for (int n = 0; n < 2; ++n)
#pragma unroll
                    for (int j = 0; j < 4; ++j) { const float g = acc[ai][0][m][n][j] * rs, up = acc[ai][1][m][n][j] * rs;
                        const float s = g * __builtin_amdgcn_rcpf(1.0f + __builtin_amdgcn_exp2f(-g * LOG2E)); v[n * 4 + j] = s * up; }
                u32x4 w; w.x = cvtpk(v[0], v[1]); w.y = cvtpk(v[2], v[3]); w.z = cvtpk(v[4], v[5]); w.w = cvtpk(v[6], v[7]);
                *(u32x4*)rowp = w; }
    }
};
struct EpiResid {
    static constexpr bool PERM = false;
    __device__ __forceinline__ void prefetch(float (&)[8], const Unit&, int, int) const {}
    float* out; bf16_t* xb; float* ssq; int ldc; float alpha;
    __device__ __forceinline__ void operator()(const f32x4 (&acc)[2][2][4][2], const Unit& u, int wr, int wc, int fr, int fq, const float (&pre)[8]) const {
        const int row0 = u.pm * BM + wr * 64 + fr, col0 = u.pn * BM + wc * 32 + 4 * fq;
        u32x2 bs[4][4];
#define ER_LOAD(g) do { const int row_ = row0 + ((g) >> 2) * HALF + ((g) & 3) * 16; \
        _Pragma("unroll") for (int q_ = 0; q_ < 4; ++q_) bs[(g) & 3][q_] = *(const u32x2*)(xb + kt_off(row_, col0 + (q_ >> 1) * HALF + (q_ & 1) * 16, ldc)); } while (0)
        ER_LOAD(0); ER_LOAD(1); ER_LOAD(2); ER_LOAD(3);
#pragma unroll
        for (int g = 0; g < 8; ++g) { const int ai = g >> 2, m = g & 3; const int row = row0 + ai * HALF + m * 16; float ss = 0.f;
#pragma unroll
            for (int q = 0; q < 4; ++q) { const int bj = q >> 1, n = q & 1; const u32x2 b = bs[g & 3][q];
                const f32x4 o = (f32x4){bflo(b.x), bfhi(b.x), bflo(b.y), bfhi(b.y)} + acc[ai][bj][m][n] * alpha;
                ss += (o.x * o.x + o.y * o.y) + (o.z * o.z + o.w * o.w);
                u32x2 w; w.x = cvtpk(o.x, o.y); w.y = cvtpk(o.z, o.w); *(u32x2*)(xb + kt_off(row, col0 + bj * HALF + n * 16, ldc)) = w;
                if (out) *(f32x4*)(out + (size_t)row * ldc + col0 + bj * HALF + n * 16) = o; }
            if (g + 4 < 8) ER_LOAD(g + 4);
            const int lane = fq * 16 + fr; ss += shx(ss, 16, lane); ss += shx(ss, 32, lane);
            if (fq == 0) ssq[(size_t)row * 32 + u.pn * 4 + wc] = ss; }
#undef ER_LOAD
    }
};
struct EpiF32Z {
    static constexpr bool PERM = false;
    float* C; int ldc; size_t zstride;
    __device__ __forceinline__ void prefetch(float (&)[8], const Unit&, int, int) const {}
    __device__ __forceinline__ void operator()(const f32x4 (&acc)[2][2][4][2], const Unit& u, int wr, int wc, int fr, int fq, const float (&pre)[8]) const {
        float* Cz = C + (size_t)u.z * zstride;
        const int row0 = u.pm * BM + wr * 64 + fr, col0 = u.pn * BM + wc * 32 + 4 * fq;
#pragma unroll
        for (int ai = 0; ai < 2; ++ai)
#pragma unroll
            for (int m = 0; m < 4; ++m) { float* rowp = Cz + (size_t)(row0 + ai * HALF + m * 16) * ldc + col0;
#pragma unroll
                for (int bj = 0; bj < 2; ++bj)
#pragma unroll
                    for (int n = 0; n < 2; ++n) *(f32x4*)(rowp + bj * HALF + n * 16) = acc[ai][bj][m][n]; }
    }
};

template <class Epi, class Sched, int KSTEP_A = 128, int KSTEP_B = 128>
__device__ __forceinline__ void gemm_phase(LAS unsigned char* lds, const Gemm g, const Sched& S, const Epi& E, const int wv) {
    const int tid = opq_tid(wv), wid = __builtin_amdgcn_readfirstlane(tid >> 6), lane = tid & 63, wr = wid >> 2, wc = wid & 3, fr = lane & 15, fq = lane >> 4;
    const int K = g.K, nt = K / BK;
    unsigned voffA[2], voffB[2];
#pragma unroll
    for (int i = 0; i < 2; ++i) { int R, C; stage_rc(tid * 16 + i * 8192, R, C); const int Rb = Epi::PERM ? ((R & ~31) + perm32(R & 31)) : R;
        voffA[i] = (unsigned)(R * g.lda + C) * 2u; voffB[i] = (unsigned)(Rb * g.ldb + C) * 2u; }
    constexpr size_t kstepA = (size_t)KSTEP_A, kstepB = (size_t)KSTEP_B;
    const size_t hstepA = (size_t)HALF * g.lda * 2, hstepB = (size_t)HALF * g.ldb * 2;
    const unsigned ldsw = (unsigned)wid * 1024u;
    const int aoff = lds_byte(wr * 64 + fr, fq * 8), boff = lds_byte(wc * 32 + fr, fq * 8);
#define PG8_SA(b, h) (((b) * 2 + (h)) * HTB)
#define PG8_SB(b, h) ((4 + (b) * 2 + (h)) * HTB)
#define PG8_STAGE(bufoff, gbase, voff) do { _Pragma("unroll") for (int _i = 0; _i < 2; ++_i) \
        __builtin_amdgcn_global_load_lds((const unsigned*)((const char*)(gbase) + (voff)[_i]), (LAS unsigned*)(lds + (bufoff) + ldsw + _i * 8192), 16, 0, 0); } while (0)
#define PG8_LDA(dst, b, h) do { _Pragma("unroll") for (int m = 0; m < 4; ++m) _Pragma("unroll") for (int k = 0; k < 2; ++k) dst[m][k] = *(const LAS bf16x8*)(lds + PG8_SA(b, h) + aoff + m * 2048 + k * 1024); } while (0)
#define PG8_LDB(dst, b, h) do { _Pragma("unroll") for (int n = 0; n < 2; ++n) _Pragma("unroll") for (int k = 0; k < 2; ++k) dst[n][k] = *(const LAS bf16x8*)(lds + PG8_SB(b, h) + boff + n * 2048 + k * 1024); } while (0)
#define PG8_MMA(ai, bj, At, Bt) do { __builtin_amdgcn_s_setprio(1); _Pragma("unroll") for (int m = 0; m < 4; ++m) _Pragma("unroll") for (int n = 0; n < 2; ++n) _Pragma("unroll") for (int k = 0; k < 2; ++k) \
        acc[ai][bj][m][n] = __builtin_amdgcn_mfma_f32_16x16x32_bf16(Bt[n][k], At[m][k], acc[ai][bj][m][n], 0, 0, 0); __builtin_amdgcn_s_setprio(0); } while (0)
#define PG8_WAIT_V(n) asm volatile("s_waitcnt vmcnt(" #n ")" ::: "memory")
#define PG8_WAIT_L(n) asm volatile("s_waitcnt lgkmcnt(" #n ")" ::: "memory")
#define PG8_BAR __builtin_amdgcn_s_barrier()
#define PG8_SCHED __builtin_amdgcn_sched_barrier(0)
    Unit cur, nxt; int ui = 0;
    if (!S.next(0, cur)) return;
    f32x4 acc[2][2][4][2];
#pragma unroll
    for (int a = 0; a < 2; ++a)
#pragma unroll
        for (int b = 0; b < 2; ++b)
#pragma unroll
            for (int m = 0; m < 4; ++m)
#pragma unroll
                for (int n = 0; n < 2; ++n) acc[a][b][m][n] = (f32x4){0.f, 0.f, 0.f, 0.f};
    bf16x8 At[4][2], B0[2][2], B1[2][2];
    const char* cA = S.a_ptr(cur); const char* cB = S.b_ptr(cur);
    float pre[8]; E.prefetch(pre, cur, wr, fr);
    PG8_STAGE(PG8_SB(0, 0), cB, voffB); PG8_STAGE(PG8_SA(0, 0), cA, voffA); PG8_STAGE(PG8_SB(0, 1), cB + hstepB, voffB); PG8_STAGE(PG8_SA(0, 1), cA + hstepA, voffA);
    if (wr == 1) PG8_BAR;
    PG8_WAIT_V(4); PG8_BAR;
    PG8_STAGE(PG8_SB(1, 0), cB + kstepB, voffB); PG8_STAGE(PG8_SA(1, 0), cA + kstepA, voffA); PG8_STAGE(PG8_SB(1, 1), cB + hstepB + kstepB, voffB);
    PG8_WAIT_V(6); PG8_BAR;
    for (;;) {
        const bool has_next = S.next(ui + 1, nxt);
        const char* nA = has_next ? S.a_ptr(nxt) : cA; const char* nB = has_next ? S.b_ptr(nxt) : cB;
        for (int t = 0; t < nt; t += 2) {
            const bool last = (t == nt - 2);
            const char* a1 = cA + (size_t)(t + 1) * kstepA;
            const char* a2 = last ? nA : cA + (size_t)(t + 2) * kstepA; const char* b2 = last ? nB : cB + (size_t)(t + 2) * kstepB;
            const char* a3 = a2 + kstepA; const char* b3 = b2 + kstepB;
            PG8_LDB(B0, 0, 0); PG8_SCHED; PG8_LDA(At, 0, 0); PG8_STAGE(PG8_SA(1, 1), a1 + hstepA, voffA);
            PG8_WAIT_L(8); PG8_BAR; PG8_WAIT_L(0); PG8_MMA(0, 0, At, B0); PG8_BAR; PG8_SCHED;
            PG8_LDB(B1, 0, 1); PG8_STAGE(PG8_SB(0, 0), b2, voffB);
            PG8_BAR; PG8_WAIT_L(0); PG8_MMA(0, 1, At, B1); PG8_BAR;
            PG8_LDA(At, 0, 1); PG8_STAGE(PG8_SA(0, 0), a2, voffA);
            PG8_BAR; PG8_WAIT_L(0); PG8_MMA(1, 0, At, B0); PG8_BAR; PG8_SCHED;
            PG8_STAGE(PG8_SB(0, 1), b2 + hstepB, voffB);
            PG8_WAIT_V(6); PG8_BAR; PG8_MMA(1, 1, At, B1); PG8_BAR;
            PG8_LDB(B0, 1, 0); PG8_SCHED; PG8_LDA(At, 1, 0); PG8_STAGE(PG8_SA(0, 1), a2 + hstepA, voffA);
            PG8_WAIT_L(8); PG8_BAR; PG8_WAIT_L(0); PG8_MMA(0, 0, At, B0); PG8_BAR; PG8_SCHED;
            PG8_LDB(B1, 1, 1); PG8_STAGE(PG8_SB(1, 0), b3, voffB);
            PG8_BAR; PG8_WAIT_L(0); PG8_MMA(0, 1, At, B1); PG8_BAR;
            PG8_LDA(At, 1, 1); PG8_STAGE(PG8_SA(1, 0), a3, voffA);
            PG8_BAR; PG8_WAIT_L(0); PG8_MMA(1, 0, At, B0); PG8_BAR; PG8_SCHED;
            PG8_STAGE(PG8_SB(1, 1), b3 + hstepB, voffB);
            PG8_WAIT_V(6); PG8_BAR; PG8_MMA(1, 1, At, B1); PG8_BAR;
        }
        E(acc, cur, wr, wc, fr, fq, pre);
        if (has_next) E.prefetch(pre, nxt, wr, fr);
        if (!has_next) break;
#pragma unroll
        for (int a = 0; a < 2; ++a)
#pragma unroll
            for (int b = 0; b < 2; ++b)
#pragma unroll
                for (int m = 0; m < 4; ++m)
#pragma unroll
                    for (int n = 0; n < 2; ++n) acc[a][b][m][n] = (f32x4){0.f, 0.f, 0.f, 0.f};
        cur = nxt; cA = nA; cB = nB; ++ui;
    }
    PG8_WAIT_V(0);
    if (wr == 0) PG8_BAR;
    PG8_BAR;
#undef PG8_SA
#undef PG8_SB
#undef PG8_STAGE
#undef PG8_LDA
#undef PG8_LDB
#undef PG8_MMA
#undef PG8_WAIT_V
#undef PG8_WAIT_L
#undef PG8_BAR
#undef PG8_SCHED
}
}

struct Args { const float* in[24]; float* out; unsigned char* ws; };
enum { I_X = 0, I_F1N, I_F1W1, I_F1W3, I_F1W2, I_MIXN, I_WIN, I_GB, I_QNA, I_KNA, I_QNN, I_KNN, I_POS, I_CKW1, I_CKW2, I_CVW1, I_CVW2, I_ON, I_WOUT, I_F2N, I_F2W1, I_F2W3, I_F2W2, I_RB };

__device__ __forceinline__ void transpose_item(const float* W, int K, int N, bf16_t* WT, int mode, int off, LAS float* scr, int item, int lane, const float* gain) {
    const int nblk = (N + 31) / 32, kb = item / nblk, nb = item % nblk, k0 = 64 * kb, n0 = 32 * nb;
    const int c4 = 4 * (lane & 7), nn = n0 + c4;
    f32x4 ld[8];
#pragma unroll
    for (int i = 0; i < 8; ++i) { const int kk = 8 * i + (lane >> 3); ld[i] = (nn < N) ? *(const f32x4*)(W + (size_t)(k0 + kk) * N + nn) : (f32x4){0.f, 0.f, 0.f, 0.f}; if (gain) ld[i] = ld[i] * gain[k0 + kk]; }
#pragma unroll
    for (int i = 0; i < 8; ++i) { const int kk = 8 * i + (lane >> 3); LAS float* d = scr + kk * 33 + c4; d[0] = ld[i].x; d[1] = ld[i].y; d[2] = ld[i].z; d[3] = ld[i].w; }
    LDS_WAIT(); asm volatile("" ::: "memory");
    const int c = lane & 7;
#pragma unroll
    for (int j = 0; j < 4; ++j) { const int n = (lane >> 3) + 8 * j; const LAS float* s = scr + (8 * c) * 33 + n;
        u32x4 o; o.x = pk2(s[0 * 33], s[1 * 33]); o.y = pk2(s[2 * 33], s[3 * 33]); o.z = pk2(s[4 * 33], s[5 * 33]); o.w = pk2(s[6 * 33], s[7 * 33]);
        const int ng = n0 + n; const int dr = mode ? ((ng >> 7) * 256 + (ng & 127) + off) : (ng + off);
        if (ng < N) *(u32x4*)(WT + kt_off(dr, k0 + 8 * c, K)) = o; }
    LDS_WAIT(); asm volatile("" ::: "memory");
}
__device__ __forceinline__ int rel_bucket_dev(int n) {
    if (n < 16) return n;
    const float v = logf((float)n / 16.0f) / 4.852030263919617f * 16.0f;
    int b = 16 + (int)v; return b < 31 ? b : 31;
}
namespace att {
constexpr int SHM_V = 16384, SHM_K = 16384;
constexpr int L_V = 0  , L_K = 49152  , L_WS = 98304, L_TBL = 100352, L_SELM = L_TBL + 4 * TBLS * 4  , L_END = L_SELM + 1024;
constexpr int L_IMP = 0;
static_assert(L_END <= 131072, "attention LDS map");
constexpr float THR = 8.f;
#define KSWZ(row, colB) ((row) * 256 + ((colB) ^ (((row) & 7) << 4)))
__device__ __forceinline__ int v_st(int k, int c) { const int kk = (k & ~0xC) | ((k & 4) << 1) | ((k & 8) >> 1); return ((kk >> 3) * 4 + (c >> 5)) * 512 + ((kk & 7) * 32 + (c & 31)) * 2; }
__device__ __forceinline__ int v_rd_base(int lane) { return ((lane & 3) << 3) | (((lane >> 2) & 3) << 6) | (((lane >> 4) & 1) << 5) | (((lane >> 5) & 1) << 8); }
__device__ __forceinline__ int crow(int r, int hi) { return (r & 3) + 8 * (r >> 2) + 4 * hi; }

__device__ __forceinline__ void partialSM(f32x16& p0, f32x16& p1, float& m_reg, float& mn, float& alpha) {
    (void)m_reg; mn = 0.f; alpha = 1.f;
#pragma unroll
    for (int r = 0; r < 16; ++r) p0[r] = __builtin_amdgcn_exp2f(p0[r] * LOG2E);
#pragma unroll
    for (int r = 0; r < 16; ++r) p1[r] = p1[r] * LOG2E;
}
__device__ __forceinline__ void partialSM_row(f32x16& p0, f32x16& p1, float& m_reg, float& mn, float& alpha, bool ok, float bias) {
    (void)m_reg; mn = 0.f; alpha = 1.f;
    const float mnL = ok ? bias * LOG2E : -__builtin_inff();
#pragma unroll
    for (int r = 0; r < 16; ++r) p0[r] = __builtin_amdgcn_exp2f(fmaf(p0[r], LOG2E, mnL));
#pragma unroll
    for (int r = 0; r < 16; ++r) p1[r] = fmaf(p1[r], LOG2E, mnL);
}
#define PK4(P, B_, OUT) do { unsigned a0 = cvtpk(P[B_+0], P[B_+1]), a1 = cvtpk(P[B_+2], P[B_+3]);                          \
        unsigned b0 = cvtpk(P[B_+4], P[B_+5]), b1 = cvtpk(P[B_+6], P[B_+7]);                                             \
        auto r0 = __builtin_amdgcn_permlane32_swap(a0, b0, false, false); auto r1 = __builtin_amdgcn_permlane32_swap(a1, b1, false, false); \
        u32x4 w = {r0[0], r1[0], r0[1], r1[1]}; OUT = *reinterpret_cast<bf16x8*>(&w); } while (0)
__device__ __forceinline__ void finishSM(f32x16& p0, f32x16& p1, float alpha, float& l_reg, bf16x8& pa0, bf16x8& pa1, bf16x8& pa2, bf16x8& pa3) {
#pragma unroll
    for (int r = 0; r < 16; ++r) p1[r] = __builtin_amdgcn_exp2f(p1[r]);
    float ps = 0;
#pragma unroll
    for (int r = 0; r < 16; ++r) ps += p0[r];
#pragma unroll
    for (int r = 0; r < 16; ++r) ps += p1[r];
    { auto rr = __builtin_amdgcn_permlane32_swap(__float_as_uint(ps), __float_as_uint(ps), false, false);
      ps = __uint_as_float(rr[0]) + __uint_as_float(rr[1]); }
    l_reg = l_reg * alpha + ps;
    PK4(p0, 0, pa0); PK4(p0, 8, pa1); PK4(p1, 0, pa2); PK4(p1, 8, pa3);
}
__device__ __forceinline__ void qkt(f32x16& p0, f32x16& p1, const LAS char* Kb, int r32, int hi, const bf16x8 (&qr)[8]) {
    p0 = f32x16{}; p1 = f32x16{};
    const LAS char* kb4[4];
#pragma unroll
    for (int dd = 0; dd < 4; ++dd) kb4[dd] = Kb + KSWZ(r32, (dd * 16 + hi * 8) * 2);
#pragma unroll
    for (int d0 = 0; d0 < 8; ++d0) { const LAS char* a = kb4[d0 & 3] + (d0 >> 2) * 128;
        const bf16x8 b0 = *reinterpret_cast<const LAS bf16x8*>(a);
        const bf16x8 b1 = *reinterpret_cast<const LAS bf16x8*>(a + 32 * 256);
        p0 = __builtin_amdgcn_mfma_f32_32x32x16_bf16(b0, qr[d0], p0, 0, 0, 0);
        p1 = __builtin_amdgcn_mfma_f32_32x32x16_bf16(b1, qr[d0], p1, 0, 0, 0); }
}
__device__ __forceinline__ void pv_tile(f32x16 (&o)[4], int vb, bf16x8 pa0, bf16x8 pa1, bf16x8 pa2, bf16x8 pa3) {
#define TRRD(dst, off) asm volatile("ds_read_b64_tr_b16 %0, %1 offset:%2" : "=&v"(dst) : "v"(vb), "i"(off) : "memory")
#define PV_D0(d0) do { s16x4 l0, l1, l2, l3, h0, h1, h2, h3; constexpr int b_ = (d0) * 512; \
        TRRD(l0, b_); TRRD(h0, b_ + 2048); TRRD(l1, b_ + 4096); TRRD(h1, b_ + 6144); TRRD(l2, b_ + 8192); TRRD(h2, b_ + 10240); TRRD(l3, b_ + 12288); TRRD(h3, b_ + 14336); \
        asm volatile("s_waitcnt lgkmcnt(0)" ::: "memory"); SBAR(); \
        o[d0] = __builtin_amdgcn_mfma_f32_32x32x16_bf16(pa0, (bf16x8){l0[0], l0[1], l0[2], l0[3], h0[0], h0[1], h0[2], h0[3]}, o[d0], 0, 0, 0);   \
        o[d0] = __builtin_amdgcn_mfma_f32_32x32x16_bf16(pa1, (bf16x8){l1[0], l1[1], l1[2], l1[3], h1[0], h1[1], h1[2], h1[3]}, o[d0], 0, 0, 0);   \
        o[d0] = __builtin_amdgcn_mfma_f32_32x32x16_bf16(pa2, (bf16x8){l2[0], l2[1], l2[2], l2[3], h2[0], h2[1], h2[2], h2[3]}, o[d0], 0, 0, 0);   \
        o[d0] = __builtin_amdgcn_mfma_f32_32x32x16_bf16(pa3, (bf16x8){l3[0], l3[1], l3[2], l3[3], h3[0], h3[1], h3[2], h3[3]}, o[d0], 0, 0, 0); } while (0)
    PV_D0(0); PV_D0(1); PV_D0(2); PV_D0(3);
#undef PV_D0
#undef TRRD
}

template <class Cfg>
__device__ __forceinline__ void attn_tiles(const Cfg& c, LAS char* lds, const bf16x8 (&qr)[8], f32x16 (&o)[4], float& m_reg, float& l_reg, const int t_lo, const int t_hi, const int wv) {
    const int tid = opq_tid(wv), lane = tid & 63, wid = __builtin_amdgcn_readfirstlane(tid >> 6), r32 = lane & 31, hi = lane >> 5;
    LAS char* V_lds = lds + L_V; LAS char* K_lds = lds + L_K;
    LAS float* al_l = (LAS float*)(lds + L_WS) + wid * 64 + 32;
    const int sr = tid >> 4, sc = (tid & 15) * 8;
    const int vst0 = v_st(sr, sc), vst1 = v_st(32 + sr, sc), kws = KSWZ(sr, sc * 2);
    const int vb0 = (int)(unsigned)(uintptr_t)V_lds + v_rd_base(lane);
    bf16x8 sk0, sk1, sv0, sv1;
    const bf16_t *gk0 = nullptr, *gk1 = nullptr, *gv0 = nullptr, *gv1 = nullptr;
#define AT_LOAD(t) do { gk0 = c.krow((t), sr) + sc; gk1 = c.krow((t), sr + 32) + sc; sk0 = *(const bf16x8*)gk0; sk1 = *(const bf16x8*)gk1; \
        if constexpr (Cfg::MODE == 0) { gv0 = c.vrow((t), sr) + sc; gv1 = c.vrow((t), sr + 32) + sc; sv0 = *(const bf16x8*)gv0; sv1 = *(const bf16x8*)gv1; } \
        asm volatile("" ::: "memory"); SBAR(); } while (0)
#define AT_WRITE(t, bf) do { asm volatile("" :: "v"(gk0), "v"(gk1), "v"(gv0), "v"(gv1)); *(LAS bf16x8*)(K_lds + (bf) * SHM_K + kws) = sk0; *(LAS bf16x8*)(K_lds + (bf) * SHM_K + kws + 32 * 256) = sk1; \
        if constexpr (Cfg::MODE == 1) { \
            _Pragma("unroll") for (int i_ = 0; i_ < 8; ++i_) { const int n_ = sc + i_, c0_ = 64 * (t) + sr, c1_ = c0_ + 32; \
                sv0[i_] = (c0_ >= 4 * n_ - 1 && c0_ <= 4 * n_ + 3) ? (short)0x3F80 : (short)0; sv1[i_] = (c1_ >= 4 * n_ - 1 && c1_ <= 4 * n_ + 3) ? (short)0x3F80 : (short)0; } } \
        *(LAS bf16x8*)(V_lds + (bf) * SHM_V + vst0) = sv0; *(LAS bf16x8*)(V_lds + (bf) * SHM_V + vst1) = sv1; } while (0)
    __builtin_amdgcn_s_waitcnt(0x0F70);
    __syncthreads();
    if (t_lo < t_hi) { AT_LOAD(t_lo); AT_WRITE(t_lo, 0); }
    __syncthreads();
    for (int t = t_lo; t < t_hi; ++t) {
        const int buf = (t - t_lo) & 1; const bool more = (t + 1 < t_hi);
        if (more) AT_LOAD(t + 1);
        if (c.active(t)) {
            f32x16 p0, p1;
            qkt(p0, p1, K_lds + buf * SHM_K, r32, hi, qr);
            if constexpr (Cfg::MODE == 0) {
                float mn, alpha; bf16x8 pa0, pa1, pa2, pa3;
                bool rok; float rbias;
                if (c.rowconst(t, rok, rbias)) partialSM_row(p0, p1, m_reg, mn, alpha, rok, rbias);
                else { c.mask(p0, p1, t); partialSM(p0, p1, m_reg, mn, alpha); }
                if (__any(alpha < 1.f)) { if (hi == 0) al_l[r32] = alpha; LDS_WAIT();
#pragma unroll
                    for (int d_ = 0; d_ < 4; ++d_)
#pragma unroll
                        for (int r = 0; r < 16; ++r) o[d_][r] *= al_l[crow(r, hi)]; }
                finishSM(p0, p1, alpha, l_reg, pa0, pa1, pa2, pa3); SBAR();
                pv_tile(o, vb0 + buf * SHM_V, pa0, pa1, pa2, pa3);
            } else {
                c.mask(p0, p1, t);
                const float mL = -c.mfix * LOG2E; const float il = c.invl;
#pragma unroll
                for (int r = 0; r < 16; ++r) { p0[r] = __builtin_amdgcn_exp2f(fmaf(p0[r], LOG2E, mL)) * il; p1[r] = __builtin_amdgcn_exp2f(fmaf(p1[r], LOG2E, mL)) * il; }
                bf16x8 pa0, pa1, pa2, pa3;
                PK4(p0, 0, pa0); PK4(p0, 8, pa1); PK4(p1, 0, pa2); PK4(p1, 8, pa3); SBAR();
                pv_tile(o, vb0 + buf * SHM_V, pa0, pa1, pa2, pa3);
#pragma unroll
                for (int r = 0; r < 16; r += 2) { const unsigned a = cvtpk(p0[r], p0[r + 1]), b = cvtpk(p1[r], p1[r + 1]);
                    p0[r] -= bflo(a); p0[r + 1] -= bfhi(a); p1[r] -= bflo(b); p1[r + 1] -= bfhi(b); }
                PK4(p0, 0, pa0); PK4(p0, 8, pa1); PK4(p1, 0, pa2); PK4(p1, 8, pa3); SBAR();
                pv_tile(o, vb0 + buf * SHM_V, pa0, pa1, pa2, pa3);
            }
        }
        if (more) AT_WRITE(t + 1, buf ^ 1);
        __syncthreads();
    }
#undef AT_LOAD
#undef AT_WRITE
}

template <class Cfg>
__device__ __forceinline__ void attn_tiles_s(const Cfg& c, LAS char* lds, const bf16x8 (&qr)[8], f32x16 (&o)[4], float& m_reg, float& l_reg, const int t_lo, const int t_hi, const int wv) {
    static_assert(Cfg::MODE == 0, "fixed-shift softmax tiles only");
    (void)m_reg;
    const int tid = opq_tid(wv), lane = tid & 63, wid = __builtin_amdgcn_readfirstlane(tid >> 6), r32 = lane & 31, hi = lane >> 5;
    LAS char* V_lds = lds + L_V; LAS char* K_lds = lds + L_K;
    const int sr = tid >> 4, sc = (tid & 15) * 8;
    const int vst0 = v_st(sr, sc), vst1 = v_st(32 + sr, sc), kws = KSWZ(sr, sc * 2);
    const int vb0 = (int)(unsigned)(uintptr_t)V_lds + v_rd_base(lane);
    bf16x8 sk0, sk1, sv0, sv1, pa0, pa1, pa2, pa3;
    const bf16_t *gk0 = nullptr, *gk1 = nullptr, *gv0 = nullptr, *gv1 = nullptr;
#define AS_LOAD(t) do { gk0 = c.krow((t), sr) + sc; gk1 = c.krow((t), sr + 32) + sc; sk0 = *(const bf16x8*)gk0; sk1 = *(const bf16x8*)gk1; \
        gv0 = c.vrow((t), sr) + sc; gv1 = c.vrow((t), sr + 32) + sc; sv0 = *(const bf16x8*)gv0; sv1 = *(const bf16x8*)gv1; asm volatile("" ::: "memory"); SBAR(); } while (0)
#define AS_WRITE(kbf, vbf) do { asm volatile("" :: "v"(gk0), "v"(gk1), "v"(gv0), "v"(gv1)); *(LAS bf16x8*)(K_lds + (kbf) * SHM_K + kws) = sk0; *(LAS bf16x8*)(K_lds + (kbf) * SHM_K + kws + 32 * 256) = sk1; \
        *(LAS bf16x8*)(V_lds + (vbf) * SHM_V + vst0) = sv0; *(LAS bf16x8*)(V_lds + (vbf) * SHM_V + vst1) = sv1; } while (0)
#define AS_SCORE(t, kbf) do { f32x16 p0, p1; float mz_ = 0.f, mn_, al_; bool rok_; float rb_; \
        qkt(p0, p1, K_lds + (kbf) * SHM_K, r32, hi, qr); \
        if (c.rowconst((t), rok_, rb_)) partialSM_row(p0, p1, mz_, mn_, al_, rok_, rb_); else { c.mask(p0, p1, (t)); partialSM(p0, p1, mz_, mn_, al_); } \
        finishSM(p0, p1, 1.f, l_reg, pa0, pa1, pa2, pa3); SBAR(); } while (0)
    if (t_lo >= t_hi) return;
    __builtin_amdgcn_s_waitcnt(0x0F70);
    __syncthreads();
    AS_LOAD(t_lo); AS_WRITE(0, 0);
    __syncthreads();
    int kb = 0, vb = 0;
    if (wid < 4) {
        for (int t = t_lo; t < t_hi; ++t) {
            const bool more = (t + 1 < t_hi); const int vn = (vb == 2) ? 0 : vb + 1;
            if (more) AS_LOAD(t + 1);
            if (c.active(t)) { AS_SCORE(t, kb); pv_tile(o, vb0 + vb * SHM_V, pa0, pa1, pa2, pa3); }
            if (more) AS_WRITE(kb ^ 1, vn);
            __syncthreads();
            kb ^= 1; vb = vn;
        }
    } else {
        bool pend = false; int vp = 0;
        for (int t = t_lo; t < t_hi; ++t) {
            const bool more = (t + 1 < t_hi); const int vn = (vb == 2) ? 0 : vb + 1;
            if (more) AS_LOAD(t + 1);
            if (pend) pv_tile(o, vb0 + vp * SHM_V, pa0, pa1, pa2, pa3);
            const bool act = c.active(t);
            if (act) AS_SCORE(t, kb);
            pend = act; vp = vb;
            if (more) AS_WRITE(kb ^ 1, vn);
            __syncthreads();
            kb ^= 1; vb = vn;
        }
        if (pend) pv_tile(o, vb0 + vp * SHM_V, pa0, pa1, pa2, pa3);
    }
#undef AS_LOAD
#undef AS_WRITE
#undef AS_SCORE
}

struct DilCfg {
    static constexpr int MODE = 0;
    const bf16_t* Kb; const bf16_t* Vb;
    const LAS float* tbl; int dshift, res, u, dqm, s0;
    __device__ __forceinline__ const bf16_t* krow(int t, int kk) const { int s = 256 * u - 128 + 64 * t + kk; s = s < 0 ? 0 : s; return Kb + (size_t)((s << dshift) + res) * PC; }
    __device__ __forceinline__ const bf16_t* vrow(int t, int kk) const { int s = 256 * u - 128 + 64 * t + kk; s = s < 0 ? 0 : s; return Vb + (size_t)((s << dshift) + res) * PC; }
    __device__ __forceinline__ bool active(int t) const { const int kb = 256 * u - 128 + 64 * t; return kb <= s0 + 31 && kb + 63 >= s0 - 128; }
    __device__ __forceinline__ bool rowconst(int, bool&, float&) const { return false; }
    __device__ __forceinline__ void mask(f32x16& p0, f32x16& p1, int t) const {
        const int dq = dqm - (256 * u - 128 + 64 * t); const float NEG = -__builtin_inff();
        const LAS float* tb = tbl + (DT0 + dq - 63);
        float bb0[16], bb1[16];
#pragma unroll
        for (int r = 0; r < 16; ++r) { const int cc = (r & 3) + 8 * (r >> 2); bb0[r] = tb[63 - cc]; bb1[r] = tb[31 - cc]; }
#pragma unroll
        for (int r = 0; r < 16; ++r) asm volatile("" : "+v"(bb0[r]), "+v"(bb1[r]));
#pragma unroll
        for (int r = 0; r < 16; ++r) { const int cc = (r & 3) + 8 * (r >> 2); const unsigned d0 = (unsigned)(dq - cc), d1 = (unsigned)(dq - cc - 32);
            p0[r] = (d0 <= 128u) ? p0[r] + bb0[r] : NEG; p1[r] = (d1 <= 128u) ? p1[r] + bb1[r] : NEG; }
    }
};
struct CmpCfg {
    static constexpr int MODE = 0;
    const bf16_t* Kb; const bf16_t* Vb; int cmax, hi4, cfull;
    __device__ __forceinline__ bool rowconst(int t, bool& ok, float& bias) const { ok = true; bias = 0.f; return 64 * t + 63 <= cfull; }
    __device__ __forceinline__ const bf16_t* krow(int t, int kk) const { return Kb + (size_t)(64 * t + kk) * HD; }
    __device__ __forceinline__ const bf16_t* vrow(int t, int kk) const { return Vb + (size_t)(64 * t + kk) * HD; }
    __device__ __forceinline__ bool active(int) const { return true; }
    __device__ __forceinline__ void mask(f32x16& p0, f32x16& p1, int t) const {
        const int cb = 64 * t + hi4; const float NEG = -__builtin_inff();
#pragma unroll
        for (int r = 0; r < 16; ++r) { const int cc = cb + (r & 3) + 8 * (r >> 2); if (cc > cmax) p0[r] = NEG; if (cc + 32 > cmax) p1[r] = NEG; }
    }
};
struct CmpImpCfg {
    static constexpr int MODE = 1;
    const bf16_t* Kb; int cmax, hi4; float mfix, invl;
    __device__ __forceinline__ const bf16_t* krow(int t, int kk) const { return Kb + (size_t)(64 * t + kk) * HD; }
    __device__ __forceinline__ const bf16_t* vrow(int, int) const { return Kb; }
    __device__ __forceinline__ bool active(int) const { return true; }
    __device__ __forceinline__ void mask(f32x16& p0, f32x16& p1, int t) const {
        const int cb = 64 * t + hi4; const float NEG = -__builtin_inff();
#pragma unroll
        for (int r = 0; r < 16; ++r) { const int cc = cb + (r & 3) + 8 * (r >> 2); if (cc > cmax) p0[r] = NEG; if (cc + 32 > cmax) p1[r] = NEG; }
    }
};
struct SlcCfg {
    static constexpr int MODE = 0;
    const bf16_t* Kb; const bf16_t* Vb;
    const LAS float* tblh;
    unsigned s0, s1, s2, s3; int tqm, cur; float b31;
    __device__ __forceinline__ const bf16_t* krow(int t, int kk) const { return Kb + (size_t)(64 * t + kk) * PC; }
    __device__ __forceinline__ const bf16_t* vrow(int t, int kk) const { return Vb + (size_t)(64 * t + kk) * PC; }
    __device__ __forceinline__ bool selbit(int t) const { const unsigned q = (unsigned)t >> 5; const unsigned w = (q == 0u ? s0 + 0u : 0u) | (q == 1u ? s1 + 0u : 0u) | (q == 2u ? s2 + 0u : 0u) | (q == 3u ? s3 + 0u : 0u); return (w >> (t & 31)) & 1u; }
    __device__ __forceinline__ bool active(int t) const { return __any(selbit(t)); }
    __device__ __forceinline__ bool rowconst(int t, bool& ok, float& bias) const { ok = selbit(t); bias = b31; return 64 * (cur - t) - 63 >= 1513; }
    __device__ __forceinline__ void mask(f32x16& p0, f32x16& p1, int t) const {
        const bool sel = selbit(t); const int dq = tqm - 64 * t; const float NEG = -__builtin_inff();
        const LAS float* tb = tblh + (TBL0 + dq - 63);
        float bb0[16], bb1[16];
#pragma unroll
        for (int r = 0; r < 16; ++r) { const int cc = (r & 3) + 8 * (r >> 2); bb0[r] = tb[63 - cc]; bb1[r] = tb[31 - cc]; }
#pragma unroll
        for (int r = 0; r < 16; ++r) asm volatile("" : "+v"(bb0[r]), "+v"(bb1[r]));
#pragma unroll
        for (int r = 0; r < 16; ++r) { const int cc = (r & 3) + 8 * (r >> 2); const int d0 = dq - cc, d1 = dq - cc - 32;
            p0[r] = (sel && d0 >= 0) ? p0[r] + bb0[r] : NEG; p1[r] = (sel && d1 >= 0) ? p1[r] + bb1[r] : NEG; }
    }
};
struct WinCfg {
    static constexpr int MODE = 0;
    const bf16_t* Kb; const bf16_t* Vb; const LAS float* tblh; int tqm;
    __device__ __forceinline__ bool rowconst(int, bool&, float&) const { return false; }
    __device__ __forceinline__ const bf16_t* krow(int t, int kk) const { return Kb + (size_t)(64 * t + kk) * PC; }
    __device__ __forceinline__ const bf16_t* vrow(int t, int kk) const { return Vb + (size_t)(64 * t + kk) * PC; }
    __device__ __forceinline__ bool active(int) const { return true; }
    __device__ __forceinline__ void mask(f32x16& p0, f32x16& p1, int t) const {
        const int dq = tqm - 64 * t; const float NEG = -__builtin_inff();
        const LAS float* tb = tblh + (TBL0 + dq - 63);
        float bb0[16], bb1[16];
#pragma unroll
        for (int r = 0; r < 16; ++r) { const int cc = (r & 3) + 8 * (r >> 2); bb0[r] = tb[63 - cc]; bb1[r] = tb[31 - cc]; }
#pragma unroll
        for (int r = 0; r < 16; ++r) asm volatile("" : "+v"(bb0[r]), "+v"(bb1[r]));
#pragma unroll
        for (int r = 0; r < 16; ++r) { const int cc = (r & 3) + 8 * (r >> 2); const unsigned d0 = (unsigned)(dq - cc), d1 = (unsigned)(dq - cc - 32);
            p0[r] = (d0 < 512u) ? p0[r] + bb0[r] : NEG; p1[r] = (d1 < 512u) ? p1[r] + bb1[r] : NEG; }
    }
};
}

__device__ __forceinline__ void load_q_normed(const bf16_t* qp  , const float* gain  , bf16x8 (&qr)[8]) {
    u32x4 raw[8];
#pragma unroll
    for (int d0 = 0; d0 < 8; ++d0) raw[d0] = *(const u32x4*)(qp + d0 * 16);
    float ss = 0.f;
#pragma unroll
    for (int d0 = 0; d0 < 8; ++d0) { const u32x4 w = raw[d0]; const float a0 = bflo(w.x), a1 = bfhi(w.x), a2 = bflo(w.y), a3 = bfhi(w.y), a4 = bflo(w.z), a5 = bfhi(w.z), a6 = bflo(w.w), a7 = bfhi(w.w);
        ss += ((a0 * a0 + a1 * a1) + (a2 * a2 + a3 * a3)) + ((a4 * a4 + a5 * a5) + (a6 * a6 + a7 * a7)); }
    { auto rr = __builtin_amdgcn_permlane32_swap(__float_as_uint(ss), __float_as_uint(ss), false, false); ss = __uint_as_float(rr[0]) + __uint_as_float(rr[1]); }
    const float rs = QSCALE / sqrtf(ss * (1.f / HD) + EPS);
#pragma unroll
    for (int d0 = 0; d0 < 8; ++d0) { const u32x4 w = raw[d0]; const f32x4 g0 = *(const f32x4*)(gain + d0 * 16), g1 = *(const f32x4*)(gain + d0 * 16 + 4);
        u32x4 o; o.x = cvtpk(bflo(w.x) * rs * g0.x, bfhi(w.x) * rs * g0.y); o.y = cvtpk(bflo(w.y) * rs * g0.z, bfhi(w.y) * rs * g0.w);
        o.z = cvtpk(bflo(w.z) * rs * g1.x, bfhi(w.z) * rs * g1.y); o.w = cvtpk(bflo(w.w) * rs * g1.z, bfhi(w.w) * rs * g1.w);
        qr[d0] = *reinterpret_cast<bf16x8*>(&o); }
}

__device__ __forceinline__ void dil_tiles(const att::DilCfg& c, LAS char* lds, const bf16x8 (&qr)[8], f32x16 (&o)[4], float& l_reg, const int wv) {
    using namespace att;
    const int tid = opq_tid(wv), lane = tid & 63, wid = __builtin_amdgcn_readfirstlane(tid >> 6), r32 = lane & 31, hi = lane >> 5;
    LAS char* V_lds = lds + L_V; LAS char* K_lds = lds + L_K;
    const int sr = tid >> 4, sc = (tid & 15) * 8;
    const int vst0 = v_st(sr, sc), vst1 = v_st(32 + sr, sc), kws = KSWZ(sr, sc * 2);
    const int vb0 = (int)(unsigned)(uintptr_t)V_lds + v_rd_base(lane);
    bf16x8 sk0, sk1, sv0, sv1;
    const bf16_t *gk0 = nullptr, *gk1 = nullptr, *gv0 = nullptr, *gv1 = nullptr;
#define DT_LOAD(t) do { gk0 = c.krow((t), sr) + sc; gk1 = c.krow((t), sr + 32) + sc; sk0 = *(const bf16x8*)gk0; sk1 = *(const bf16x8*)gk1; \
        gv0 = c.vrow((t), sr) + sc; gv1 = c.vrow((t), sr + 32) + sc; sv0 = *(const bf16x8*)gv0; sv1 = *(const bf16x8*)gv1; asm volatile("" ::: "memory"); SBAR(); } while (0)
#define DT_WRITE(slot) do { asm volatile("" :: "v"(gk0), "v"(gk1), "v"(gv0), "v"(gv1)); *(LAS bf16x8*)(K_lds + (slot) * SHM_K + kws) = sk0; *(LAS bf16x8*)(K_lds + (slot) * SHM_K + kws + 32 * 256) = sk1; \
        *(LAS bf16x8*)(V_lds + (slot) * SHM_V + vst0) = sv0; *(LAS bf16x8*)(V_lds + (slot) * SHM_V + vst1) = sv1; } while (0)
#define DT_COMP(t, slot) do { f32x16 p0, p1; float mz_ = 0.f, mn_, al_; bf16x8 pa0, pa1, pa2, pa3; \
        qkt(p0, p1, K_lds + (slot) * SHM_K, r32, hi, qr); c.mask(p0, p1, (t)); partialSM(p0, p1, mz_, mn_, al_); \
        finishSM(p0, p1, 1.f, l_reg, pa0, pa1, pa2, pa3); SBAR(); pv_tile(o, vb0 + (slot) * SHM_V, pa0, pa1, pa2, pa3); } while (0)
    const bool first = (c.u == 0);
    __builtin_amdgcn_s_waitcnt(0x0F70);
    __syncthreads();
    if (!first) { DT_LOAD(1); DT_WRITE(0); }
    DT_LOAD(4); DT_WRITE(1);
    __syncthreads();
    DT_LOAD(2);
    if (wid < 4) { if (!first) DT_COMP(1, 0); } else DT_COMP(4, 1);
    DT_WRITE(2);
    __syncthreads();
    DT_LOAD(3);
    if (wid < 6) DT_COMP(2, 2);
    DT_WRITE(0);
    __syncthreads();
    DT_LOAD(5);
    if (wid >= 2) DT_COMP(3, 0);
    DT_WRITE(1);
    if (!first) { DT_LOAD(0); DT_WRITE(2); }
    __syncthreads();
    if (wid < 2) { if (!first) DT_COMP(0, 2); } else if (wid >= 6) DT_COMP(5, 1);
#undef DT_LOAD
#undef DT_WRITE
#undef DT_COMP
}

__device__ __forceinline__ void dil_unit(LAS char* lds, const bf16_t* P, bf16_t* OA, float* LSE, const float* dilT, const float* qgain, int pat, int dshift, int unit, const int wv) {
    using namespace att;
    const int tid = opq_tid(wv), lane = tid & 63, wid = __builtin_amdgcn_readfirstlane(tid >> 6), r32 = lane & 31, hi = lane >> 5;
    const int bh = unit >> 5, ru = unit & 31, b = bh >> 3, h = bh & 7;
    const int ncs = 5 - dshift, res = ru >> ncs, u = ru & ((1 << ncs) - 1);
    LAS float* tbl = (LAS float*)(lds + L_TBL);
    __syncthreads();
    if (tid < DTS) tbl[tid] = dilT[(pat * 8 + h) * DTS + tid];
    const int s0 = 256 * u + 32 * wid, s_row = s0 + r32;
    const size_t tokrow = (size_t)b * SEQ + (size_t)((s_row << dshift) + res);
    bf16x8 qr[8];
    load_q_normed(P + tokrow * PC + C_QA + h * HD + hi * 8, qgain + hi * 8, qr);
    f32x16 o[4]; float m_reg, l_reg;
    m_reg = 0.f;
    if (pat == 0) { l_reg = 0.f;
#pragma unroll
        for (int d0 = 0; d0 < 4; ++d0) o[d0] = f32x16{}; }
    else { l_reg = LSE[tokrow * 8 + h];
#pragma unroll
        for (int r = 0; r < 16; ++r) { const size_t tr = (size_t)b * SEQ + (size_t)(((s0 + crow(r, hi)) << dshift) + res); const bf16_t* op = OA + tr * 1024 + h * HD + r32;
#pragma unroll
            for (int d0 = 0; d0 < 4; ++d0) o[d0][r] = bf2f(op[d0 * 32]); } }
    DilCfg c; c.Kb = P + (size_t)b * SEQ * PC + C_KA + h * HD; c.Vb = P + (size_t)b * SEQ * PC + C_VA + h * HD; c.tbl = tbl; c.dshift = dshift; c.res = res; c.u = u; c.dqm = s_row - 4 * hi; c.s0 = s0;
    dil_tiles(c, lds, qr, o, l_reg, wv);
    LAS float* li_l = (LAS float*)(lds + L_WS) + wid * 64;
    if (hi == 0) { li_l[r32] = l_reg; LSE[tokrow * 8 + h] = l_reg; }
    LDS_WAIT();
#pragma unroll
    for (int r = 0; r < 16; ++r) { const int orow = crow(r, hi); const float rl = (pat == 2) ? 1.0f / li_l[orow] : 1.0f;
        const size_t tr = (size_t)b * SEQ + (size_t)(((s0 + orow) << dshift) + res); bf16_t* op = OA + tr * 1024 + h * HD;
#pragma unroll
        for (int d0 = 0; d0 < 4; ++d0) { const float v = o[d0][r] * rl; const float vn = shx(v, 1, lane);
            if ((r32 & 1) == 0) *(unsigned*)(op + d0 * 32 + r32) = cvtpk(v, vn); } }
}

__device__ __forceinline__ void nsa_finalize(LAS char* lds, const f32x16 (&o)[4], float l_reg, const bf16_t* P, bf16_t* ON, const float* gb, int b, int g, int tok0, int br, const int wv) {
    using namespace att;
    const int tid = opq_tid(wv), lane = tid & 63, wid = __builtin_amdgcn_readfirstlane(tid >> 6), r32 = lane & 31, hi = lane >> 5;
    LAS float* li_l = (LAS float*)(lds + L_WS) + wid * 64;
    if (hi == 0) li_l[r32] = l_reg;
    LDS_WAIT();
    bf16_t* ONb = ON + (size_t)br * NTOK * 1024;
    float glv[16], gbv[4];
#pragma unroll
    for (int j = 0; j < 4; ++j) gbv[j] = gb[(4 * g + j) * 3 + br];
#pragma unroll
    for (int r = 0; r < 16; ++r) { const int j = r & 3, k = r >> 2; const size_t tok = (size_t)b * SEQ + tok0 + 2 * k + hi; glv[r] = bf2f(P[tok * PC + C_GL + (4 * g + j) * 3 + br]); }
#pragma unroll
    for (int r = 0; r < 16; ++r) asm volatile("" : "+v"(glv[r]));
#pragma unroll
    for (int r = 0; r < 16; ++r) { const int j = r & 3, k = r >> 2; const float lr = li_l[crow(r, hi)]; const float rl = lr > 0.f ? 1.0f / lr : 0.f;
        const size_t tok = (size_t)b * SEQ + tok0 + 2 * k + hi; const int hh = 4 * g + j;
        const float gl = glv[r] + gbv[j];
        const float sc = rl * __builtin_amdgcn_rcpf(1.0f + __builtin_amdgcn_exp2f(-gl * LOG2E));
        bf16_t* op = ONb + tok * 1024 + hh * HD;
#pragma unroll
        for (int d0 = 0; d0 < 4; ++d0) { const float v = o[d0][r] * sc; const float vn = shx(v, 1, lane);
            if ((r32 & 1) == 0) *(unsigned*)(op + d0 * 32 + r32) = cvtpk(v, vn); } }
}
__device__ __forceinline__ void nsa_unit(LAS char* lds, const bf16_t* P, const bf16_t* KC, const bf16_t* VC, bf16_t* ON, const float* nsaT, const float* gb, const float* qgain, int b, int g, int qi, bool load_tbl, const int wv) {
    using namespace att;
    const int tid = opq_tid(wv), lane = tid & 63, wid = __builtin_amdgcn_readfirstlane(tid >> 6), r32 = lane & 31, hi = lane >> 5;
    LAS float* tbl = (LAS float*)(lds + L_TBL); LAS float* IMP = (LAS float*)(lds + L_IMP); LAS unsigned* SELM = (LAS unsigned*)(lds + L_SELM);
    __syncthreads();
    if (load_tbl) for (int i = tid; i < 4 * TBLS; i += NTHR) tbl[i] = nsaT[(size_t)(4 * g) * TBLS + i];
    const int tok0 = 64 * qi + 8 * wid, tq = tok0 + (r32 >> 2), hd = r32 & 3;
    const bf16_t* Pb = P + (size_t)b * SEQ * PC;
    bf16x8 qr[8];
    load_q_normed(Pb + (size_t)tq * PC + C_QN + (4 * g + hd) * HD + hi * 8, qgain + hi * 8, qr);
    const bf16_t* KCb = KC + (size_t)(b * 2 + g) * 512 * HD; const bf16_t* VCb = VC + (size_t)(b * 2 + g) * 512 * HD;
    const int ntc = (qi >> 4) + 1, cmax = (tq - 31) >> 4;
    f32x16 o[4]; float m_reg, l_reg;
#pragma unroll
    for (int d0 = 0; d0 < 4; ++d0) o[d0] = f32x16{};
    m_reg = 0.f; l_reg = 0.f;
    { CmpCfg c; c.Kb = KCb; c.Vb = VCb; c.cmax = cmax; c.hi4 = 4 * hi; c.cfull = (64 * qi - 31) >> 4; attn_tiles_s(c, lds, qr, o, m_reg, l_reg, 0, ntc, wv); }
    nsa_finalize(lds, o, l_reg, P, ON, gb, b, g, tok0, 0, wv);
    { CmpImpCfg c; c.Kb = KCb; c.cmax = cmax; c.hi4 = 4 * hi; c.mfix = 0.f; c.invl = l_reg > 0.f ? 1.0f / l_reg : 0.f;
#pragma unroll
      for (int d0 = 0; d0 < 4; ++d0) o[d0] = f32x16{};
      float md = 0.f, ld = 0.f; attn_tiles(c, lds, qr, o, md, ld, 0, ntc, wv); }
#pragma unroll
    for (int d0 = 0; d0 < 4; ++d0)
#pragma unroll
        for (int k = 0; k < 4; ++k) IMP[(8 * wid + 2 * k + hi) * 128 + 32 * d0 + r32] = (o[d0][4 * k] + o[d0][4 * k + 1]) + (o[d0][4 * k + 2] + o[d0][4 * k + 3]);
    __syncthreads();
    { const int cur = qi;
#pragma unroll 1
      for (int tl = 8 * wid; tl < 8 * wid + 8; ++tl) {
        const int n0 = lane, n1 = 64 + lane; bool sel0, sel1;
        if (cur <= 15) { sel0 = (n0 <= cur); sel1 = false; }
        else {
            const float v0 = IMP[tl * 128 + n0], v1 = IMP[tl * 128 + n1];
            const unsigned u0 = (n0 >= 1 && n0 <= cur - 2) ? __float_as_uint(v0) + 1u : 0u, u1 = (n1 <= cur - 2) ? __float_as_uint(v1) + 1u : 0u;
            unsigned T = 0u;
#pragma unroll 1
            for (int bit = 30; bit >= 0; --bit) { const unsigned cand = T | (1u << bit);
                const int cnt = __builtin_popcountll(__ballot(u0 >= cand)) + __builtin_popcountll(__ballot(u1 >= cand));
                if (cnt >= 13) T = cand; }
            const bool gt0 = u0 > T, gt1 = u1 > T;
            const int need = 13 - (__builtin_popcountll(__ballot(gt0)) + __builtin_popcountll(__ballot(gt1)));
            const bool eq0 = (u0 == T), eq1 = (u1 == T);
            const unsigned long long m0 = __ballot(eq0), m1 = __ballot(eq1);
            const int pre0 = (int)__builtin_amdgcn_mbcnt_hi((unsigned)(m0 >> 32), __builtin_amdgcn_mbcnt_lo((unsigned)m0, 0u));
            const int pre1 = __builtin_popcountll(m0) + (int)__builtin_amdgcn_mbcnt_hi((unsigned)(m1 >> 32), __builtin_amdgcn_mbcnt_lo((unsigned)m1, 0u));
            sel0 = (n0 == 0 || n0 == cur || n0 == cur - 1) || gt0 || (eq0 && pre0 < need);
            sel1 = (n1 == cur || n1 == cur - 1) || gt1 || (eq1 && pre1 < need);
        }
        const unsigned long long b0 = __ballot(sel0), b1 = __ballot(sel1);
        if (lane == 0) { SELM[tl * 4 + 0] = (unsigned)b0; SELM[tl * 4 + 1] = (unsigned)(b0 >> 32); SELM[tl * 4 + 2] = (unsigned)b1; SELM[tl * 4 + 3] = (unsigned)(b1 >> 32); } } }
    __syncthreads();
    int r32s = r32; asm volatile("" : "+v"(r32s));
    { SlcCfg c; c.Kb = Pb + C_KS + g * HD; c.Vb = Pb + C_VS + g * HD; c.tblh = tbl + (r32s & 3) * TBLS; c.tqm = tok0 + (r32s >> 2) - 4 * hi; c.cur = qi; c.b31 = tbl[(r32s & 3) * TBLS + TBL0 + 1600];
      const int tl = 8 * wid + (r32s >> 2); c.s0 = SELM[tl * 4 + 0]; c.s1 = SELM[tl * 4 + 1]; c.s2 = SELM[tl * 4 + 2]; c.s3 = SELM[tl * 4 + 3];
#pragma unroll
      for (int d0 = 0; d0 < 4; ++d0) o[d0] = f32x16{};
      m_reg = 0.f; l_reg = 0.f;
      attn_tiles_s(c, lds, qr, o, m_reg, l_reg, 0, qi + 1, wv); }
    nsa_finalize(lds, o, l_reg, P, ON, gb, b, g, tok0, 1, wv);
    int r32w = r32; asm volatile("" : "+v"(r32w));
    { WinCfg c; c.Kb = Pb + C_KW + g * HD; c.Vb = Pb + C_VW + g * HD; c.tblh = tbl + (r32w & 3) * TBLS; c.tqm = tok0 + (r32w >> 2) - 4 * hi;
#pragma unroll
      for (int d0 = 0; d0 < 4; ++d0) o[d0] = f32x16{};
      m_reg = 0.f; l_reg = 0.f;
      attn_tiles_s(c, lds, qr, o, m_reg, l_reg, qi >= 8 ? qi - 8 : 0, qi + 1, wv); }
    nsa_finalize(lds, o, l_reg, P, ON, gb, b, g, tok0, 2, wv);
}

constexpr int LDS_BYTES = 147456;
constexpr int LDS_MISC = 131072;
constexpr int LDS_ARGS = LDS_MISC + 64;
__device__ __forceinline__ unsigned long long arg_u64(LAS unsigned char* lds, int i) {
    const LAS unsigned* p = (const LAS unsigned*)(opq_lds(lds) + LDS_ARGS) + 2 * i;
    const unsigned lo = __builtin_amdgcn_readfirstlane(p[0]), hi = __builtin_amdgcn_readfirstlane(p[1]);
    return ((unsigned long long)hi << 32) | lo;
}
#define GAS __attribute__((address_space(1)))
__device__ __forceinline__ const float* arg_in(LAS unsigned char* lds, int i) { return (const float*)(GAS const float*)arg_u64(lds, i); }
__device__ __forceinline__ float* arg_out(LAS unsigned char* lds) { return (float*)(GAS float*)arg_u64(lds, 24); }
__device__ __forceinline__ unsigned char* arg_ws(LAS unsigned char* lds) { return (unsigned char*)(GAS unsigned char*)arg_u64(lds, 25); }
__device__ __forceinline__ int opq_bx() { int b = blockIdx.x; asm volatile("" : "+s"(b)); return b; }
__device__ __forceinline__ int opq_g() { int b = gridDim.x; asm volatile("" : "+s"(b)); return b; }

__device__ __forceinline__ void ph_prologue(LAS unsigned char* lds, const int wv) {
    lds = opq_lds(lds);
    const int tid = opq_tid(wv), lane = tid & 63, wave = __builtin_amdgcn_readfirstlane(tid >> 6), G = opq_g(), bx = opq_bx();
    const int gw = bx * NWAVES + wave, NGW = G * NWAVES;
    unsigned char* ws = arg_ws(lds);
    LAS float* scr = (LAS float*)(lds + wave * 16384);
    constexpr int I_UP = 32 * 176, I_DN = 88 * 64, I_IN = 32 * 177, I_OUT = 32 * 64, I_C1 = 64 * 16, I_Z = 928;
    constexpr int I_FFN = 2 * I_UP + I_DN, I_LAYER = 2 * I_FFN + I_IN + I_OUT + 2 * I_C1 + I_Z;
#pragma unroll 1
    for (int it = gw; it < DEPTH * I_LAYER; it += NGW) {
        const int l = it / I_LAYER; int r = it - l * I_LAYER;
        if (r < 2 * I_FFN) { const int half = r >= I_FFN; r -= half * I_FFN;
            bf16_t* WUP = (bf16_t*)(ws + WS_WUP + (size_t)(l * 2 + half) * SZ_WUP); bf16_t* WDN = (bf16_t*)(ws + WS_WDN + (size_t)(l * 2 + half) * SZ_WDN);
            const float* gn = arg_in(lds, half ? I_F2N : I_F1N) + (size_t)l * DM;
            if (r < I_UP) { transpose_item(arg_in(lds, half ? I_F2W1 : I_F1W1) + (size_t)l * DM * DFF, DM, DFF, WUP, 1, 0, scr, r, lane, gn); continue; } r -= I_UP;
            if (r < I_UP) { transpose_item(arg_in(lds, half ? I_F2W3 : I_F1W3) + (size_t)l * DM * DFF, DM, DFF, WUP, 1, 128, scr, r, lane, gn); continue; } r -= I_UP;
            transpose_item(arg_in(lds, half ? I_F2W2 : I_F1W2) + (size_t)l * DFF * DM, DFF, DM, WDN, 0, 0, scr, r, lane, nullptr); continue; }
        r -= 2 * I_FFN;
        bf16_t* WIN = (bf16_t*)(ws + WS_WIN + (size_t)l * SZ_WIN); bf16_t* WOUT = (bf16_t*)(ws + WS_WOUT + (size_t)l * SZ_WOUT); bf16_t* WC1 = (bf16_t*)(ws + WS_WC1 + (size_t)l * SZ_WC1);
        if (r < I_IN) { transpose_item(arg_in(lds, I_WIN) + (size_t)l * DM * IN_COLS, DM, IN_COLS, WIN, 0, 0, scr, r, lane, arg_in(lds, I_MIXN) + (size_t)l * DM); continue; } r -= I_IN;
        if (r < I_OUT) { transpose_item(arg_in(lds, I_WOUT) + (size_t)l * DM * DM, DM, DM, WOUT, 0, 0, scr, r, lane, nullptr); continue; } r -= I_OUT;
        if (r < I_C1) { transpose_item(arg_in(lds, I_CKW1) + (size_t)l * 4096 * 512, 4096, 512, WC1, 0, 0, scr, r, lane, nullptr); continue; } r -= I_C1;
        if (r < I_C1) { transpose_item(arg_in(lds, I_CVW1) + (size_t)l * 4096 * 512, 4096, 512, WC1, 0, 512, scr, r, lane, nullptr); continue; } r -= I_C1;
        { const int q = r * 64 + lane, kt = q / 1856, rem = q - kt * 1856; u32x4* z = (u32x4*)(WIN + ((size_t)(22 * 32 + kt) * 256 + 24) * 64) + rem; unsigned zr = 0u; asm volatile("" : "+v"(zr)); *z = (u32x4){zr, zr, zr, zr}; }
    }
    const float* xs = arg_in(lds, I_X); bf16_t* XB = (bf16_t*)(ws + WS_HB); float* RSTD = (float*)(ws + WS_RSTD);
    for (int m = gw; m < NTOK; m += NGW) {
        const f32x4* xr = (const f32x4*)(xs + (size_t)m * DM) + lane; f32x4 v[8]; float s = 0.f;
#pragma unroll
        for (int j = 0; j < 8; ++j) { v[j] = xr[64 * j]; s += (v[j].x * v[j].x + v[j].y * v[j].y) + (v[j].z * v[j].z + v[j].w * v[j].w); }
        s = wave_sum(s, lane);
#pragma unroll
        for (int j = 0; j < 8; ++j) { u32x2 w; w.x = cvtpk(v[j].x, v[j].y); w.y = cvtpk(v[j].z, v[j].w); *(u32x2*)(XB + kt_off(m, 256 * j + 4 * lane, DM)) = w; }
        if (lane == 0) RSTD[m] = 1.0f / sqrtf(s * (1.f / DM) + EPS);
    }
}
__device__ __forceinline__ void ph_rstd(LAS unsigned char* lds, const int wv) {
    lds = opq_lds(lds);
    const int tid = opq_tid(wv), G = opq_g(), bx = opq_bx();
    unsigned char* ws = arg_ws(lds); const float* SSQ = (const float*)(ws + WS_SSQ); float* RSTD = (float*)(ws + WS_RSTD);
    for (int m = bx * NTHR + tid; m < NTOK; m += G * NTHR) { const f32x4* p = (const f32x4*)(SSQ + (size_t)m * 32); f32x4 a = p[0];
#pragma unroll
        for (int j = 1; j < 8; ++j) a = a + p[j];
        RSTD[m] = 1.0f / sqrtf(((a.x + a.y) + (a.z + a.w)) * (1.f / DM) + EPS); }
}
__device__ __forceinline__ void ph_headnorm(LAS unsigned char* lds, int l, const int wv) {
    lds = opq_lds(lds);
    const int tid = opq_tid(wv), lane = tid & 63, wave = __builtin_amdgcn_readfirstlane(tid >> 6), G = opq_g(), bx = opq_bx();
    const int gw = bx * NWAVES + wave, NGW = G * NWAVES;
    unsigned char* ws = arg_ws(lds); bf16_t* HP = (bf16_t*)(ws + WS_HP); bf16_t* ACMP = (bf16_t*)(ws + WS_ACMP);
    const float* qna = arg_in(lds, I_QNA) + l * HD; const float* kna = arg_in(lds, I_KNA) + l * HD; const float* qnn = arg_in(lds, I_QNN) + l * HD; const float* knn = arg_in(lds, I_KNN) + l * HD;
    const float* pos = arg_in(lds, I_POS) + (size_t)l * 32 * HD;
    const int e0 = (lane & 15) * 8;
    const f32x4 ga0 = *(const f32x4*)(kna + e0), ga1 = *(const f32x4*)(kna + e0 + 4), gn0 = *(const f32x4*)(knn + e0), gn1 = *(const f32x4*)(knn + e0 + 4);
    for (int m = gw; m < NTOK; m += NGW) {
        bf16_t* prow = HP + (size_t)m * PC;
        const int jt = m & 15;
        const f32x4 pa0 = *(const f32x4*)(pos + jt * HD + e0), pa1 = *(const f32x4*)(pos + jt * HD + e0 + 4), pb0 = *(const f32x4*)(pos + (jt + 16) * HD + e0), pb1 = *(const f32x4*)(pos + (jt + 16) * HD + e0 + 4);
        int cols[3]; u32x4 wl[3];
#pragma unroll
        for (int ch = 0; ch < 3; ++ch) { cols[ch] = (ch < 2) ? C_KA + ch * 512 + lane * 8 : (lane < 32 ? C_KS + lane * 8 : C_KW + (lane - 32) * 8);
            wl[ch] = *(const u32x4*)(prow + cols[ch]); }
        const u32x4 wcv = *(const u32x4*)(prow + C_KC + lane * 8);
#pragma unroll
        for (int ch = 0; ch < 3; ++ch) {
            const float sc = 1.f;
            const u32x4 w = wl[ch];
            float v[8] = {bflo(w.x), bfhi(w.x), bflo(w.y), bfhi(w.y), bflo(w.z), bfhi(w.z), bflo(w.w), bfhi(w.w)};
            float s = 0.f;
#pragma unroll
            for (int i = 0; i < 8; ++i) s += v[i] * v[i];
            s += shx(s, 1, lane); s += shx(s, 2, lane); s += shx(s, 4, lane); s += shx(s, 8, lane);
            const float rs = sc / sqrtf(s * (1.f / HD) + EPS);
            const f32x4 g0 = (ch < 2) ? ga0 : gn0, g1 = (ch < 2) ? ga1 : gn1;
            u32x4 o; o.x = cvtpk(v[0] * rs * g0.x, v[1] * rs * g0.y); o.y = cvtpk(v[2] * rs * g0.z, v[3] * rs * g0.w); o.z = cvtpk(v[4] * rs * g1.x, v[5] * rs * g1.y); o.w = cvtpk(v[6] * rs * g1.z, v[7] * rs * g1.w);
            *(u32x4*)(prow + cols[ch]) = o;
        }
        { const int b = m / SEQ, t = m % SEQ, kv = lane >> 5, gg = (lane >> 4) & 1, c1 = t >> 4, j1 = t & 15;
          const u32x4 w = wcv;
          const float v[8] = {bflo(w.x), bfhi(w.x), bflo(w.y), bfhi(w.y), bflo(w.z), bfhi(w.z), bflo(w.w), bfhi(w.w)};
          const int arow0 = kv * 4096 + (b * 2 + gg) * 512;
          if (c1 <= 510) { const f32x4 p0 = pa0, p1 = pa1;
              u32x4 o; o.x = cvtpk(v[0] + p0.x, v[1] + p0.y); o.y = cvtpk(v[2] + p0.z, v[3] + p0.w); o.z = cvtpk(v[4] + p1.x, v[5] + p1.y); o.w = cvtpk(v[6] + p1.z, v[7] + p1.w);
              *(u32x4*)(ACMP + kt_off(arow0 + c1, j1 * HD + e0, 4096)) = o; }
          else { const u32x4 z = {0u, 0u, 0u, 0u}; *(u32x4*)(ACMP + kt_off(arow0 + 511, j1 * HD + e0, 4096)) = z; *(u32x4*)(ACMP + kt_off(arow0 + 511, (j1 + 16) * HD + e0, 4096)) = z; }
          if (c1 >= 1) { const int j2 = j1 + 16; const f32x4 p0 = pb0, p1 = pb1;
              u32x4 o; o.x = cvtpk(v[0] + p0.x, v[1] + p0.y); o.y = cvtpk(v[2] + p0.z, v[3] + p0.w); o.z = cvtpk(v[4] + p1.x, v[5] + p1.y); o.w = cvtpk(v[6] + p1.z, v[7] + p1.w);
              *(u32x4*)(ACMP + kt_off(arow0 + c1 - 1, j2 * HD + e0, 4096)) = o; } }
    }
}
__device__ __forceinline__ float gelu_tanh(float v) { const float u3 = 0.7978845608028654f * (v + 0.044715f * v * v * v); return 0.5f * v * (2.0f - 2.0f / (__expf(2.0f * u3) + 1.0f)); }
__device__ __forceinline__ void ph_cmp2(LAS unsigned char* lds, int l, const int wv) {
    lds = opq_lds(lds);
    const int tid = opq_tid(wv), lane = tid & 63, wave = __builtin_amdgcn_readfirstlane(tid >> 6), G = opq_g(), bx = opq_bx();
    unsigned char* ws = arg_ws(lds); const float* CP = (const float*)(ws + WS_CP);
    LAS float* CH = (LAS float*)lds;
    LAS float* RED = (LAS float*)(lds + 65536);
    const float* knn = arg_in(lds, I_KNN) + l * HD;
    for (int it = bx; it < 256; it += G) {
        const int R0 = it * 32, kv = R0 >> 12, rl0 = R0 & 4095;
        __syncthreads();
        for (int i4 = tid; i4 < 32 * 128; i4 += NTHR) { const int rr = i4 >> 7, k4 = (i4 & 127) * 4; f32x4 v = {0.f, 0.f, 0.f, 0.f};
#pragma unroll
            for (int ks = 0; ks < 4; ++ks) v = v + *(const f32x4*)(CP + ((size_t)(kv * 4 + ks) * 4096 + rl0 + rr) * 512 + k4);
            f32x4 o; o.x = gelu_tanh(v.x); o.y = gelu_tanh(v.y); o.z = gelu_tanh(v.z); o.w = gelu_tanh(v.w);
            *(LAS f32x4*)(CH + rr * 512 + k4) = o; }
        __syncthreads();
        const int n = tid & 127, rq = tid >> 7;
        const float* w2 = arg_in(lds, kv ? I_CVW2 : I_CKW2) + (size_t)l * 512 * HD + n;
        float acc[8];
#pragma unroll
        for (int i = 0; i < 8; ++i) acc[i] = 0.f;
#pragma unroll 4
        for (int k = 0; k < 512; k += 4) { const float w0 = w2[(size_t)k * HD], w1 = w2[(size_t)(k + 1) * HD], w2v = w2[(size_t)(k + 2) * HD], w3 = w2[(size_t)(k + 3) * HD];
#pragma unroll
            for (int i = 0; i < 8; ++i) { const f32x4 c = *(const LAS f32x4*)(CH + (rq * 8 + i) * 512 + k); acc[i] += (c.x * w0 + c.y * w1) + (c.z * w2v + c.w * w3); } }
        if (kv == 0) {
            float ss[8];
#pragma unroll
            for (int i = 0; i < 8; ++i) ss[i] = wave_sum(acc[i] * acc[i], lane);
            if (lane == 0) {
#pragma unroll
                for (int i = 0; i < 8; ++i) RED[wave * 8 + i] = ss[i]; }
            __syncthreads();
            const float gn = knn[n];
#pragma unroll
            for (int i = 0; i < 8; ++i) { const float tot = RED[(2 * rq) * 8 + i] + RED[(2 * rq + 1) * 8 + i]; acc[i] = acc[i] / sqrtf(tot * (1.f / HD) + EPS) * gn; }
        }
        bf16_t* dst = (bf16_t*)(ws + (kv ? WS_VC + 0 : WS_KC + 0)) + (size_t)(rl0 + rq * 8) * HD + n;
#pragma unroll
        for (int i = 0; i < 8; ++i) dst[(size_t)i * HD] = (bf16_t)f2bf(acc[i]);
    }
}
__device__ __forceinline__ void ph_outnorm(LAS unsigned char* lds, int l, const int wv) {
    lds = opq_lds(lds);
    const int tid = opq_tid(wv), lane = tid & 63, wave = __builtin_amdgcn_readfirstlane(tid >> 6), G = opq_g(), bx = opq_bx();
    const int gw = bx * NWAVES + wave, NGW = G * NWAVES;
    unsigned char* ws = arg_ws(lds); const bf16_t* OA = (const bf16_t*)(ws + WS_OA); const bf16_t* ON = (const bf16_t*)(ws + WS_ON); bf16_t* HB = (bf16_t*)(ws + WS_HP);
    const float* gn = arg_in(lds, I_ON) + (size_t)l * DM;
    const f32x4 ga0 = *(const f32x4*)(gn + lane * 8), ga1 = *(const f32x4*)(gn + lane * 8 + 4), ga2 = *(const f32x4*)(gn + 512 + lane * 8), ga3 = *(const f32x4*)(gn + 512 + lane * 8 + 4);
    const f32x4 gb0 = *(const f32x4*)(gn + 1024 + lane * 8), gb1 = *(const f32x4*)(gn + 1024 + lane * 8 + 4), gb2 = *(const f32x4*)(gn + 1536 + lane * 8), gb3 = *(const f32x4*)(gn + 1536 + lane * 8 + 4);
    for (int m = gw; m < NTOK; m += NGW) {
        const bf16_t* oa = OA + (size_t)m * 1024; bf16_t* y = HB;
        const u32x4 wa = *(const u32x4*)(oa + lane * 8), wb = *(const u32x4*)(oa + 512 + lane * 8);
        u32x4 wn[6];
#pragma unroll
        for (int br = 0; br < 3; ++br) { const bf16_t* onb = ON + ((size_t)br * NTOK + m) * 1024; wn[2 * br] = *(const u32x4*)(onb + lane * 8); wn[2 * br + 1] = *(const u32x4*)(onb + 512 + lane * 8); }
        float va[16] = {bflo(wa.x), bfhi(wa.x), bflo(wa.y), bfhi(wa.y), bflo(wa.z), bfhi(wa.z), bflo(wa.w), bfhi(wa.w), bflo(wb.x), bfhi(wb.x), bflo(wb.y), bfhi(wb.y), bflo(wb.z), bfhi(wb.z), bflo(wb.w), bfhi(wb.w)};
        float sa = 0.f;
#pragma unroll
        for (int i = 0; i < 16; ++i) sa += va[i] * va[i];
        float vs[16]; float sn = 0.f;
#pragma unroll
        for (int i = 0; i < 16; ++i) vs[i] = 0.f;
#pragma unroll
        for (int br = 0; br < 3; ++br) { const u32x4 wc = wn[2 * br], wd = wn[2 * br + 1];
            vs[0] += bflo(wc.x); vs[1] += bfhi(wc.x); vs[2] += bflo(wc.y); vs[3] += bfhi(wc.y); vs[4] += bflo(wc.z); vs[5] += bfhi(wc.z); vs[6] += bflo(wc.w); vs[7] += bfhi(wc.w);
            vs[8] += bflo(wd.x); vs[9] += bfhi(wd.x); vs[10] += bflo(wd.y); vs[11] += bfhi(wd.y); vs[12] += bflo(wd.z); vs[13] += bfhi(wd.z); vs[14] += bflo(wd.w); vs[15] += bfhi(wd.w); }
        const float ra = 1.0f / sqrtf(wave_sum(sa, lane) * (1.f / 1024.f) + EPS);
        { const f32x4 g0 = ga0, g1 = ga1, g2 = ga2, g3 = ga3;
          u32x4 o; o.x = cvtpk(va[0] * ra * g0.x, va[1] * ra * g0.y); o.y = cvtpk(va[2] * ra * g0.z, va[3] * ra * g0.w); o.z = cvtpk(va[4] * ra * g1.x, va[5] * ra * g1.y); o.w = cvtpk(va[6] * ra * g1.z, va[7] * ra * g1.w);
          *(u32x4*)(y + kt_off(m, lane * 8, DM)) = o;
          o.x = cvtpk(va[8] * ra * g2.x, va[9] * ra * g2.y); o.y = cvtpk(va[10] * ra * g2.z, va[11] * ra * g2.w); o.z = cvtpk(va[12] * ra * g3.x, va[13] * ra * g3.y); o.w = cvtpk(va[14] * ra * g3.z, va[15] * ra * g3.w);
          *(u32x4*)(y + kt_off(m, 512 + lane * 8, DM)) = o; }
#pragma unroll
        for (int i = 0; i < 16; ++i) sn += vs[i] * vs[i];
        const float rn = 1.0f / sqrtf(wave_sum(sn, lane) * (1.f / 1024.f) + EPS);
        { const f32x4 g0 = gb0, g1 = gb1, g2a = gb2, g3 = gb3;
          u32x4 o; o.x = cvtpk(vs[0] * rn * g0.x, vs[1] * rn * g0.y); o.y = cvtpk(vs[2] * rn * g0.z, vs[3] * rn * g0.w); o.z = cvtpk(vs[4] * rn * g1.x, vs[5] * rn * g1.y); o.w = cvtpk(vs[6] * rn * g1.z, vs[7] * rn * g1.w);
          *(u32x4*)(y + kt_off(m, 1024 + lane * 8, DM)) = o;
          o.x = cvtpk(vs[8] * rn * g2a.x, vs[9] * rn * g2a.y); o.y = cvtpk(vs[10] * rn * g2a.z, vs[11] * rn * g2a.w); o.z = cvtpk(vs[12] * rn * g3.x, vs[13] * rn * g3.y); o.w = cvtpk(vs[14] * rn * g3.z, vs[15] * rn * g3.w);
          *(u32x4*)(y + kt_off(m, 1536 + lane * 8, DM)) = o; }
    }
}

#define GRID_BAR() do { XcdBarrier bar_; bar_.bar = (unsigned*)(arg_ws(lds) + WS_CTL) + CW_BAR; bar_.x = xb_xcc_id(); bar_.st = (volatile LAS unsigned*)(opq_lds(lds) + LDS_MISC + 32); xcd_barrier(bar_, wv); } while (0)
__global__ void __launch_bounds__(NTHR, 2) mega_fwd(Args a) {
    extern __shared__ __attribute__((aligned(16))) unsigned char lds_raw[];
    LAS unsigned char* lds = (LAS unsigned char*)lds_raw;
    const int wv = __builtin_amdgcn_readfirstlane((int)threadIdx.x >> 6);
    {
        const int tid = threadIdx.x;
        for (int u = tid; u < (LDS_BYTES - LDS_MISC) / 4; u += NTHR) ((LAS unsigned*)(lds + LDS_MISC))[u] = 0u;
        __syncthreads();
        if (tid == 0) { LAS unsigned long long* t = (LAS unsigned long long*)(lds + LDS_ARGS);
#pragma unroll
            for (int i = 0; i < 24; ++i) t[i] = (unsigned long long)(uintptr_t)a.in[i];
            t[24] = (unsigned long long)(uintptr_t)a.out; t[25] = (unsigned long long)(uintptr_t)a.ws; }
        __syncthreads();
    }
    (void)xcd_barrier_post((unsigned*)(arg_ws(lds) + WS_CTL) + CW_BAR, (volatile LAS unsigned*)(lds + LDS_MISC + 32));

    { const int tid = opq_tid(wv), G = opq_g(), bx = opq_bx(); const float* rb = arg_in(lds, I_RB); unsigned char* ws = arg_ws(lds);
      float* dilT = (float*)(ws + WS_TBL); float* nsaT = (float*)(ws + WS_TBL + 65536);
      for (int i = bx * NTHR + tid; i < 3 * 8 * DTS + 8 * TBLS; i += G * NTHR) {
          if (i < 3 * 8 * DTS) { const int p = i / (8 * DTS), h = (i / DTS) % 8, df = i % DTS - DT0; const int d = (p == 0) ? 1 : (p == 1 ? 4 : 16);
              dilT[i] = (df >= 0 && df <= 128) ? rb[rel_bucket_dev(df * d) * 16 + h] : 0.f; }
          else { const int j = i - 3 * 8 * DTS, hh = j / TBLS, ds = j % TBLS - TBL0; nsaT[j] = (ds >= 0) ? rb[rel_bucket_dev(ds) * 16 + 8 + hh] : 0.f; } } }

    ph_prologue(lds, wv);
    GRID_BAR();
#pragma unroll 1
    for (int step = 0; step < 2 * DEPTH; ++step) {
        const int l = step >> 1, half = step & 1;
        { unsigned char* ws = arg_ws(lds); const int G = opq_g(), bx = opq_bx();
          pg8::Gemm g{64, 64, DM}; pg8::SchedStd S; S.init(ws + WS_HB, ws + WS_WUP + (size_t)step * SZ_WUP, NTOK, 2 * DFF, DM, DM, G, bx); const pg8::EpiSwiGLU E{(bf16_t*)(ws + WS_HP), DFF, (const float*)(ws + WS_RSTD)};
          pg8::gemm_phase<pg8::EpiSwiGLU, pg8::SchedStd, 32768, 32768>(opq_lds(lds), g, S, E, wv);
        }
        GRID_BAR();
        { unsigned char* ws = arg_ws(lds); const int G = opq_g(), bx = opq_bx(); float* X = arg_out(lds);
          pg8::Gemm g{64, 64, DFF}; pg8::SchedStd S; S.init(ws + WS_HP, ws + WS_WDN + (size_t)step * SZ_WDN, NTOK, DM, DFF, DFF, G, bx, 4);
          pg8::EpiResid E{(step == 2 * DEPTH - 1) ? X : (float*)nullptr, (bf16_t*)(ws + WS_HB), (float*)(ws + WS_SSQ), DM, 0.5f};
          pg8::gemm_phase<pg8::EpiResid, pg8::SchedStd, 32768, 32768>(opq_lds(lds), g, S, E, wv);
        }
        if (step == 2 * DEPTH - 1) break;
        GRID_BAR();
        ph_rstd(lds, wv);
        GRID_BAR();
        if (half == 0) {
            { unsigned char* ws = arg_ws(lds); const int G = opq_g(), bx = opq_bx();
              pg8::Gemm g{64, 64, DM}; pg8::SchedStd S; S.init(ws + WS_HB, ws + WS_WIN + (size_t)l * SZ_WIN, NTOK, PC, DM, DM, G, bx); const pg8::EpiBf16 E{(bf16_t*)(ws + WS_HP), PC, (const float*)(ws + WS_RSTD)};
              pg8::gemm_phase<pg8::EpiBf16, pg8::SchedStd, 32768, 32768>(opq_lds(lds), g, S, E, wv);
            }
            GRID_BAR();
            ph_headnorm(lds, l, wv);
            GRID_BAR();
#pragma unroll 1
            for (int pat3 = 0; pat3 < 3; ++pat3) { const int pat = pat3 % 3;
                if (pat3 == 0) { unsigned char* ws = arg_ws(lds); const int G = opq_g(), bx = opq_bx();
                  pg8::Gemm g{64, 64, 1024}; pg8::SchedCmp S; S.A = (const char*)(ws + WS_ACMP); S.Bt = (const char*)(ws + WS_WC1 + (size_t)l * SZ_WC1); S.G = G; S.c = bx; pg8::EpiF32Z E{(float*)(ws + WS_CP), 512, (size_t)4096 * 512};
                  pg8::gemm_phase<pg8::EpiF32Z, pg8::SchedCmp, 32768, 32768>(opq_lds(lds), g, S, E, wv); }
                if (pat3 == 1) ph_cmp2(lds, l, wv);
                { unsigned char* ws = arg_ws(lds); const int G = opq_g(), bx = opq_bx();
                  for (int u0 = bx; u0 < 1024; u0 += G) { const int w_ = u0 & 255, k_ = u0 >> 8; const int unit = (((w_ & 7) + 8 * k_) << 5) | (w_ >> 3);
                    dil_unit((LAS char*)opq_lds(lds), (const bf16_t*)(ws + WS_HP), (bf16_t*)(ws + WS_OA), (float*)(ws + WS_LSE), (const float*)(ws + WS_TBL), arg_in(lds, I_QNA) + l * HD, pat, 2 * pat, unit, wv); } }
                if (pat3 + 1 < 3) GRID_BAR();
            }
            { unsigned char* ws = arg_ws(lds); const int G = opq_g(), bx = opq_bx();
              const float* gb = arg_in(lds, I_GB) + l * 24; const float* qgn = arg_in(lds, I_QNN) + l * HD;
              int last_bg = -1;
#pragma unroll 1
              for (int i4 = 0; i4 < 4; ++i4)
#pragma unroll 1
                  for (int w = bx; w < 256; w += G) { const int i = i4 & 3; const int bg = w & 7, j = w >> 3;
                      const int qi = (i == 0) ? 127 - j : (i == 1 ? j : (i == 2 ? 64 + j : 63 - j));
                      nsa_unit((LAS char*)opq_lds(lds), (const bf16_t*)(ws + WS_HP), (const bf16_t*)(ws + WS_KC), (const bf16_t*)(ws + WS_VC), (bf16_t*)(ws + WS_ON), (const float*)(ws + WS_TBL + 65536), gb, qgn, bg >> 1, bg & 1, qi, bg != last_bg, wv); last_bg = bg; } }
            GRID_BAR();
            ph_outnorm(lds, l, wv);
            GRID_BAR();
            { unsigned char* ws = arg_ws(lds); const int G = opq_g(), bx = opq_bx(); float* X = arg_out(lds);
              pg8::Gemm g{64, 64, DM}; pg8::SchedStd S; S.init(ws + WS_HP, ws + WS_WOUT + (size_t)l * SZ_WOUT, NTOK, DM, DM, DM, G, bx, 4); pg8::EpiResid E{(float*)nullptr, (bf16_t*)(ws + WS_HB), (float*)(ws + WS_SSQ), DM, 1.0f};
              pg8::gemm_phase<pg8::EpiResid, pg8::SchedStd, 32768, 32768>(opq_lds(lds), g, S, E, wv);
            }
            GRID_BAR();
            ph_rstd(lds, wv);
            GRID_BAR();
        }
    }
}

extern "C" void kernel_launch(void* const* d_in, const int* in_sizes, int n_in, void* d_out, int out_size, void* d_ws, size_t ws_size, hipStream_t stream) {
    static int grid = 0;
    if (grid == 0) {
        if (n_in != 24 || in_sizes[0] != NTOK * DM || out_size != NTOK * DM || ws_size < WS_END) { fprintf(stderr, "kernel_launch: shape mismatch n_in %d in0 %d out %d ws %zu (need %zu)\n", n_in, n_in > 0 ? in_sizes[0] : -1, out_size, ws_size, (size_t)WS_END); grid = -1; return; }
        int dev = 0, cus = 0, per_cu = 0;
        if (hipGetDevice(&dev) != hipSuccess || hipDeviceGetAttribute(&cus, hipDeviceAttributeMultiprocessorCount, dev) != hipSuccess) { grid = -1; return; }
        if (hipFuncSetAttribute((const void*)mega_fwd, hipFuncAttributeMaxDynamicSharedMemorySize, LDS_BYTES) != hipSuccess) { fprintf(stderr, "kernel_launch: hipFuncSetAttribute failed\n"); grid = -1; return; }
        if (hipOccupancyMaxActiveBlocksPerMultiprocessor(&per_cu, (const void*)mega_fwd, NTHR, LDS_BYTES) != hipSuccess || per_cu < 1) { fprintf(stderr, "kernel_launch: occupancy query says %d\n", per_cu); (void)hipGetLastError(); if (per_cu < 1) { grid = -1; return; } }
        grid = cus;
    }
    if (grid < 0) return;
    if (hipMemsetAsync((char*)d_ws + WS_CTL, 0, CTL_ZERO_BYTES, stream) != hipSuccess) return;
    Args a{};
    for (int i = 0; i < 24; ++i) a.in[i] = (const float*)d_in[i];
    a.out = (float*)d_out; a.ws = (unsigned char*)d_ws;
    hipLaunchKernelGGL(mega_fwd, dim3(grid), dim3(NTHR), LDS_BYTES, stream, a);
    const hipError_t le = hipPeekAtLastError();
    if (le != hipSuccess) fprintf(stderr, "kernel_launch: launch failed: %s\n", hipGetErrorName(le));
}
```

```cpp
#include <hip/hip_runtime.h>
#include <cstdio>
#include <cstdint>

#define LAS __attribute__((address_space(3)))
typedef unsigned short bf16_t;
typedef short bf16x8 __attribute__((ext_vector_type(8)));
typedef short s16x4 __attribute__((ext_vector_type(4)));
typedef float f32x2 __attribute__((ext_vector_type(2)));
typedef float f32x4 __attribute__((ext_vector_type(4)));
typedef float f32x16 __attribute__((ext_vector_type(16)));
typedef unsigned u32x2 __attribute__((ext_vector_type(2)));
typedef unsigned u32x4 __attribute__((ext_vector_type(4)));

constexpr int BATCH = 4, SEQ = 8192, DM = 2048, DFF = 5632, NTOK = BATCH * SEQ, DEPTH = 4, HD = 128;
constexpr int IN_COLS = 5656, PC = 5888;
constexpr int C_QA = 0, C_KA = 1024, C_VA = 2048, C_QN = 3072, C_KC = 4096, C_VC = 4352, C_KS = 4608, C_VS = 4864, C_KW = 5120, C_VW = 5376, C_GL = 5632;
constexpr float EPS = 1e-6f, QSCALE = 0.08838834764831845f, LOG2E = 1.4426950408889634f;
constexpr int TBLS = 1704, TBL0 = 64;
constexpr int DTS = 320, DT0 = 96;
constexpr int NWAVES = 8, NTHR = 512;

constexpr size_t MiB = 1u << 20;
constexpr size_t WS_CTL = 0, CTL_ZERO_BYTES = 1 * MiB;
constexpr size_t WS_TBL = 1 * MiB;
constexpr size_t SZ_WUP = 44 * MiB, SZ_WDN = 22 * MiB, SZ_WIN = 23 * MiB, SZ_WOUT = 8 * MiB, SZ_WC1 = 8 * MiB;
constexpr size_t WS_WUP = 2 * MiB;
constexpr size_t WS_WDN = WS_WUP + 8 * SZ_WUP;
constexpr size_t WS_WIN = WS_WDN + 8 * SZ_WDN;
constexpr size_t WS_WOUT = WS_WIN + 4 * SZ_WIN;
constexpr size_t WS_WC1 = WS_WOUT + 4 * SZ_WOUT;
constexpr size_t WS_HB = WS_WC1 + 4 * SZ_WC1;
constexpr size_t WS_HP = WS_HB + 128 * MiB;
constexpr size_t WS_OA = WS_HP + 368 * MiB;
constexpr size_t WS_LSE = WS_OA + 64 * MiB;
constexpr size_t WS_ON = WS_LSE + 1 * MiB;
constexpr size_t WS_ACMP = WS_ON + 192 * MiB;
constexpr size_t WS_CP = WS_ACMP + 64 * MiB;
constexpr size_t WS_KC = WS_CP + 64 * MiB;
constexpr size_t WS_VC = WS_KC + 1 * MiB;
constexpr size_t WS_SSQ = WS_VC + 1 * MiB;
constexpr size_t WS_RSTD = WS_SSQ + 4 * MiB;
constexpr size_t WS_END = WS_RSTD + 1 * MiB;
constexpr int CW_BAR = 4096;

__device__ __forceinline__ unsigned f2bf(float f) { unsigned u = __builtin_bit_cast(unsigned, f); return (u + 0x7fffu + ((u >> 16) & 1u)) >> 16; }
__device__ __forceinline__ unsigned pk2(float lo, float hi) { return f2bf(lo) | (f2bf(hi) << 16); }
__device__ __forceinline__ float bf2f(bf16_t b) { return __builtin_bit_cast(float, ((unsigned)b) << 16); }
__device__ __forceinline__ float bflo(unsigned w) { return __builtin_bit_cast(float, w << 16); }
__device__ __forceinline__ float bfhi(unsigned w) { return __builtin_bit_cast(float, w & 0xffff0000u); }
__device__ __forceinline__ unsigned cvtpk(float lo, float hi) { unsigned r; asm volatile("v_cvt_pk_bf16_f32 %0, %1, %2" : "=v"(r) : "v"(lo), "v"(hi)); return r; }
__device__ __forceinline__ float shx(float v, int m, int lane) { return __builtin_bit_cast(float, __builtin_amdgcn_ds_bpermute((lane ^ m) << 2, __builtin_bit_cast(int, v))); }
__device__ __forceinline__ float wave_sum(float v, int lane) {
#pragma unroll
    for (int o = 1; o < 64; o <<= 1) v += shx(v, o, lane);
    return v;
}
__device__ __forceinline__ LAS unsigned char* opq_lds(LAS unsigned char* p) { unsigned a = (unsigned)(uintptr_t)p; asm volatile("" : "+s"(a)); return (LAS unsigned char*)(uintptr_t)a; }
__device__ __forceinline__ int opq_tid(int wv) { int l; asm volatile("v_mbcnt_lo_u32_b32 %0, -1, 0\n\tv_mbcnt_hi_u32_b32 %0, -1, %0" : "=v"(l)); return wv * 64 + l; }
__device__ __forceinline__ size_t kt_off(int r, int k, int K) { return (((size_t)(r >> 8) * (K >> 6) + (k >> 6)) * 256 + (r & 255)) * 64 + (k & 63); }
#define LDS_WAIT() asm volatile("s_waitcnt lgkmcnt(0)" ::: "memory")
#define VM_WAIT() asm volatile("s_waitcnt vmcnt(0)" ::: "memory")
#define SBAR() __builtin_amdgcn_sched_barrier(0)

#define XB_TMO      128
#define XB_XCNT(j)  (256  + 64 * (j))
#define XB_XSUB(j)  (1280 + 64 * (j))
#define XB_XGEN(j)  (2304 + 64 * (j))
#define XB_TOP      3328
#define XB_TOPGEN   3392
#define XCD_BAR_WORDS 3456
#define XB_SPIN_CAP (1u << 18)
__device__ __forceinline__ unsigned xb_ld(unsigned* p)              { return __hip_atomic_load(p, __ATOMIC_RELAXED, __HIP_MEMORY_SCOPE_AGENT); }
__device__ __forceinline__ unsigned xb_add(unsigned* p, unsigned v) { return __hip_atomic_fetch_add(p, v, __ATOMIC_RELAXED, __HIP_MEMORY_SCOPE_AGENT); }
__device__ __forceinline__ unsigned xb_xcc_id() { return (unsigned)__builtin_amdgcn_s_getreg((3 << 11) | 20) & 0xFu; }
#define XB_SPIN(cond, bar) do { unsigned _sp = 0; while (cond) { __builtin_amdgcn_s_sleep(1); \
    if ((++_sp & 255u) == 0u) { if (xb_ld(&(bar)[XB_TMO])) break; if (_sp > XB_SPIN_CAP) { atomicAdd(&(bar)[XB_TMO], 1u); break; } } } } while (0)
struct XcdBarrier { unsigned* bar; unsigned x; volatile LAS unsigned* st; };
__device__ __forceinline__ XcdBarrier xcd_barrier_post(unsigned* bar, volatile LAS unsigned* st) {
    XcdBarrier b; b.bar = bar; b.x = xb_xcc_id(); b.st = st;
    if (threadIdx.x == 0) (void)xb_add(&bar[XB_XCNT(b.x)], 1u);
    return b;
}
__device__ __forceinline__ void xcd_barrier_complete(unsigned* bar, unsigned x, unsigned& nloc, unsigned& nx) {
    const unsigned G = gridDim.x * gridDim.y * gridDim.z;
    unsigned sum, cnt, mine, sp = 0u;
    for (;;) {
        sum = 0u; cnt = 0u; mine = 0u;
#pragma unroll
        for (unsigned j = 0; j < 16; ++j) { const unsigned c = xb_ld(&bar[XB_XCNT(j)]); sum += c; cnt += (c > 0u) ? 1u : 0u; mine = (j == x) ? c : mine; }
        if (sum == G) break;
        __builtin_amdgcn_s_sleep(1);
        if ((++sp & 255u) == 0u) { if (xb_ld(&bar[XB_TMO])) break; if (sp > XB_SPIN_CAP) { atomicAdd(&bar[XB_TMO], 1u); break; } }
    }
    nloc = mine > 0u ? mine : 1u; nx = cnt > 0u ? cnt : 1u;
}
__device__ __forceinline__ void xcd_barrier(const XcdBarrier& b, const int wv) {
    asm volatile("s_waitcnt vmcnt(0)" ::: "memory");
    __syncthreads();
    if (opq_tid(wv) == 0) {
        unsigned* bar = b.bar; asm volatile("" : "+s"(bar));
        __builtin_amdgcn_s_waitcnt(0);
        unsigned nloc = b.st[0], nx = b.st[1];
        if (nloc == 0u) { xcd_barrier_complete(bar, b.x, nloc, nx); b.st[0] = nloc; b.st[1] = nx; }
        const unsigned old = xb_add(&bar[XB_XSUB(b.x)], 1u);
        const unsigned gen = old / nloc;
        if (old + 1u == (gen + 1u) * nloc) {
            __builtin_amdgcn_fence(__ATOMIC_RELEASE, "agent");
            asm volatile("s_waitcnt vmcnt(0)" ::: "memory");
            const unsigned og = xb_add(&bar[XB_TOP], 1u);
            const unsigned tg = og / nx;
            if (og + 1u == (tg + 1u) * nx) xb_add(&bar[XB_TOPGEN], 1u);
            else XB_SPIN(xb_ld(&bar[XB_TOPGEN]) == tg, bar);
            __builtin_amdgcn_fence(__ATOMIC_ACQUIRE, "agent");
            xb_add(&bar[XB_XGEN(b.x)], 1u);
            asm volatile("s_waitcnt vmcnt(0)" ::: "memory");
        } else {
            XB_SPIN(xb_ld(&bar[XB_XGEN(b.x)]) == gen, bar);
            __builtin_amdgcn_fence(__ATOMIC_ACQUIRE, "agent");
            asm volatile("s_waitcnt vmcnt(0)" ::: "memory");
        }
    }
    __syncthreads();
}

namespace pg8 {
constexpr int BM = 256, BK = 64, HALF = 128, HTB = HALF * BK * 2, STAGE_BYTES = 8 * HTB, NXCD = 8, WGM = 8;
__host__ __device__ __forceinline__ int lds_byte(int r, int c) { const int st = (r >> 4) * 2 + (c >> 5), rr = r & 15, cc = c & 31, ob = rr * 64 + cc * 2; return st * 1024 + (ob ^ (((ob >> 9) & 1) << 5)); }
__host__ __device__ __forceinline__ void stage_rc(int b, int& R, int& C) { const int st = b / 1024, sb = b % 1024, swz = sb ^ (((sb >> 9) & 1) << 5); R = (st >> 1) * 16 + swz / 64; C = (st & 1) * 32 + (swz % 64) / 2; }
__host__ __device__ __forceinline__ int perm32(int rho) { const int n = rho >> 4, i = rho & 15; return 8 * (i >> 2) + 4 * n + (i & 3); }
struct Unit { int pm, pn, z; };
struct Gemm { int lda, ldb, K; };
struct SchedStd {
    const char* A; const char* Bt; size_t atile, btile; int nM, nN, nwg, G, c, wgm, flip;
    __device__ __forceinline__ void init(const void* A_, const void* Bt_, int M, int N, int lda, int ldb, int G_, int c_, int wgm_ = WGM, int flip_ = 0) { wgm = wgm_; flip = flip_;
        A = (const char*)A_; Bt = (const char*)Bt_; atile = (size_t)BM * lda * 2; btile = (size_t)BM * ldb * 2; nM = M / BM; nN = N / BM; nwg = nM * nN; G = G_; c = c_; }
    __device__ __forceinline__ bool next(int i, Unit& u) const {
        const long L = (long)i * G + c; if (L >= nwg) return false;
        int wgid = (int)L; { const int q = nwg / NXCD, r = nwg % NXCD, xcd = wgid % NXCD, off = wgid / NXCD; wgid = (xcd < r ? xcd * (q + 1) : r * (q + 1) + (xcd - r) * q) + off; }
        const int nig = wgm * nN, gid = wgid / nig, fm = gid * wgm, gsz = (nM - fm) < wgm ? (nM - fm) : wgm;
        u.pm = fm + ((wgid % nig) % gsz); u.pn = (wgid % nig) / gsz; u.z = 0; if (flip) u.pm = nM - 1 - u.pm; return true;
    }
    __device__ __forceinline__ const char* a_ptr(const Unit& u) const { return A + (size_t)u.pm * atile; }
    __device__ __forceinline__ const char* b_ptr(const Unit& u) const { return Bt + (size_t)u.pn * btile; }
};
struct SchedCmp {
    const char* A; const char* Bt; int G, c;
    __device__ __forceinline__ bool next(int i, Unit& u) const { const int L = i * G + c; if (L >= 256) return false; u.z = L >> 5; u.pm = (L & 31) >> 1; u.pn = L & 1; return true; }
    __device__ __forceinline__ const char* a_ptr(const Unit& u) const { const int kv = u.z >> 2, ks = u.z & 3; return A + ((size_t)(kv * 16 + u.pm) * 64 + (size_t)ks * 16) * 32768; }
    __device__ __forceinline__ const char* b_ptr(const Unit& u) const { const int kv = u.z >> 2, ks = u.z & 3; return Bt + ((size_t)(kv * 2 + u.pn) * 64 + (size_t)ks * 16) * 32768; }
};
struct EpiBf16 {
    static constexpr bool PERM = true;
    bf16_t* O; int ldc; const float* rstd;
    __device__ __forceinline__ void prefetch(float (&pre)[8], const Unit& u, int wr, int fr) const {
#pragma unroll
        for (int i = 0; i < 8; ++i) pre[i] = rstd[u.pm * BM + wr * 64 + fr + (i >> 2) * HALF + (i & 3) * 16]; }
    __device__ __forceinline__ void operator()(const f32x4 (&acc)[2][2][4][2], const Unit& u, int wr, int wc, int fr, int fq, const float (&pre)[8]) const {
        const int row0 = u.pm * BM + wr * 64 + fr, col0 = u.pn * BM + wc * 32 + 8 * fq;
#pragma unroll
        for (int ai = 0; ai < 2; ++ai)
#pragma unroll
            for (int m = 0; m < 4; ++m) { bf16_t* rowp = O + (size_t)(row0 + ai * HALF + m * 16) * ldc + col0; const float rs = pre[ai * 4 + m];
#pragma unroll
                for (int bj = 0; bj < 2; ++bj) { const f32x4 v0 = acc[ai][bj][m][0] * rs, v1 = acc[ai][bj][m][1] * rs;
                    u32x4 w; w.x = cvtpk(v0[0], v0[1]); w.y = cvtpk(v0[2], v0[3]); w.z = cvtpk(v1[0], v1[1]); w.w = cvtpk(v1[2], v1[3]);
                    *(u32x4*)(rowp + bj * HALF) = w; } }
    }
};
struct EpiSwiGLU {
    static constexpr bool PERM = true;
    bf16_t* O; int ldc; const float* rstd;
    __device__ __forceinline__ void prefetch(float (&pre)[8], const Unit& u, int wr, int fr) const {
#pragma unroll
        for (int i = 0; i < 8; ++i) pre[i] = rstd[u.pm * BM + wr * 64 + fr + (i >> 2) * HALF + (i & 3) * 16]; }
    __device__ __forceinline__ void operator()(const f32x4 (&acc)[2][2][4][2], const Unit& u, int wr, int wc, int fr, int fq, const float (&pre)[8]) const {
        const int rowp0 = wr * 64 + fr, kt = 2 * u.pn + (wc >> 1), cit = (wc & 1) * 32 + 8 * fq;
        bf16_t* tile = O + ((size_t)u.pm * (ldc / 64) + kt) * (256 * 64) + cit;
#pragma unroll
        for (int ai = 0; ai < 2; ++ai)
#pragma unroll
            for (int m = 0; m < 4; ++m) { bf16_t* rowp = tile + (size_t)(rowp0 + ai * HALF + m * 16) * 64; const float rs = pre[ai * 4 + m];
                float v[8];
#pragma unroll
                for (int n = 0; n < 2; ++n)
#pragma unroll
                    for (int j = 0; j < 4; ++j) { const float g = acc[ai][0][m][n][j] * rs, up = acc[ai][1][m][n][j] * rs;
                        const float s = g * __builtin_amdgcn_rcpf(1.0f + __builtin_amdgcn_exp2f(-g * LOG2E)); v[n * 4 + j] = s * up; }
                u32x4 w; w.x = cvtpk(v[0], v[1]); w.y = cvtpk(v[2], v[3]); w.z = cvtpk(v[4], v[5]); w.w = cvtpk(v[6], v[7]);
                *(u32x4*)rowp = w; }
    }
};
struct EpiResid {
    static constexpr bool PERM = false;
    __device__ __forceinline__ void prefetch(float (&)[8], const Unit&, int, int) const {}
    float* out; bf16_t* xb; float* ssq; int ldc; float alpha;
    __device__ __forceinline__ void operator()(const f32x4 (&acc)[2][2][4][2], const Unit& u, int wr, int wc, int fr, int fq, const float (&pre)[8]) const {
        const int row0 = u.pm * BM + wr * 64 + fr, col0 = u.pn * BM + wc * 32 + 4 * fq;
        u32x2 bs[4][4];
#define ER_LOAD(g) do { const int row_ = row0 + ((g) >> 2) * HALF + ((g) & 3) * 16; \
        _Pragma("unroll") for (int q_ = 0; q_ < 4; ++q_) bs[(g) & 3][q_] = *(const u32x2*)(xb + kt_off(row_, col0 + (q_ >> 1) * HALF + (q_ & 1) * 16, ldc)); } while (0)
        ER_LOAD(0); ER_LOAD(1); ER_LOAD(2); ER_LOAD(3);
#pragma unroll
        for (int g = 0; g < 8; ++g) { const int ai = g >> 2, m = g & 3; const int row = row0 + ai * HALF + m * 16; float ss = 0.f;
#pragma unroll
            for (int q = 0; q < 4; ++q) { const int bj = q >> 1, n = q & 1; const u32x2 b = bs[g & 3][q];
                const f32x4 o = (f32x4){bflo(b.x), bfhi(b.x), bflo(b.y), bfhi(b.y)} + acc[ai][bj][m][n] * alpha;
                ss += (o.x * o.x + o.y * o.y) + (o.z * o.z + o.w * o.w);
                u32x2 w; w.x = cvtpk(o.x, o.y); w.y = cvtpk(o.z, o.w); *(u32x2*)(xb + kt_off(row, col0 + bj * HALF + n * 16, ldc)) = w;
                if (out) *(f32x4*)(out + (size_t)row * ldc + col0 + bj * HALF + n * 16) = o; }
            if (g + 4 < 8) ER_LOAD(g + 4);
            const int lane = fq * 16 + fr; ss += shx(ss, 16, lane); ss += shx(ss, 32, lane);
            if (fq == 0) ssq[(size_t)row * 32 + u.pn * 4 + wc] = ss; }
#undef ER_LOAD
    }
};
struct EpiF32Z {
    static constexpr bool PERM = false;
    float* C; int ldc; size_t zstride;
    __device__ __forceinline__ void prefetch(float (&)[8], const Unit&, int, int) const {}
    __device__ __forceinline__ void operator()(const f32x4 (&acc)[2][2][4][2], const Unit& u, int wr, int wc, int fr, int fq, const float (&pre)[8]) const {
        float* Cz = C + (size_t)u.z * zstride;
        const int row0 = u.pm * BM + wr * 64 + fr, col0 = u.pn * BM + wc * 32 + 4 * fq;
#pragma unroll
        for (int ai = 0; ai < 2; ++ai)
#pragma unroll
            for (int m = 0; m < 4; ++m) { float* rowp = Cz + (size_t)(row0 + ai * HALF + m * 16) * ldc + col0;
#pragma unroll
                for (int bj = 0; bj < 2; ++bj)
#pragma unroll
                    for (int n = 0; n < 2; ++n) *(f32x4*)(rowp + bj * HALF + n * 16) = acc[ai][bj][m][n]; }
    }
};

template <class Epi, class Sched, int KSTEP_A = 128, int KSTEP_B = 128>
__device__ __forceinline__ void gemm_phase(LAS unsigned char* lds, const Gemm g, const Sched& S, const Epi& E, const int wv) {
    const int tid = opq_tid(wv), wid = __builtin_amdgcn_readfirstlane(tid >> 6), lane = tid & 63, wr = wid >> 2, wc = wid & 3, fr = lane & 15, fq = lane >> 4;
    const int K = g.K, nt = K / BK;
    unsigned voffA[2], voffB[2];
#pragma unroll
    for (int i = 0; i < 2; ++i) { int R, C; stage_rc(tid * 16 + i * 8192, R, C); const int Rb = Epi::PERM ? ((R & ~31) + perm32(R & 31)) : R;
        voffA[i] = (unsigned)(R * g.lda + C) * 2u; voffB[i] = (unsigned)(Rb * g.ldb + C) * 2u; }
    constexpr size_t kstepA = (size_t)KSTEP_A, kstepB = (size_t)KSTEP_B;
    const size_t hstepA = (size_t)HALF * g.lda * 2, hstepB = (size_t)HALF * g.ldb * 2;
    const unsigned ldsw = (unsigned)wid * 1024u;
    const int aoff = lds_byte(wr * 64 + fr, fq * 8), boff = lds_byte(wc * 32 + fr, fq * 8);
#define PG8_SA(b, h) (((b) * 2 + (h)) * HTB)
#define PG8_SB(b, h) ((4 + (b) * 2 + (h)) * HTB)
#define PG8_STAGE(bufoff, gbase, voff) do { _Pragma("unroll") for (int _i = 0; _i < 2; ++_i) \
        __builtin_amdgcn_global_load_lds((const unsigned*)((const char*)(gbase) + (voff)[_i]), (LAS unsigned*)(lds + (bufoff) + ldsw + _i * 8192), 16, 0, 0); } while (0)
#define PG8_LDA(dst, b, h) do { _Pragma("unroll") for (int m = 0; m < 4; ++m) _Pragma("unroll") for (int k = 0; k < 2; ++k) dst[m][k] = *(const LAS bf16x8*)(lds + PG8_SA(b, h) + aoff + m * 2048 + k * 1024); } while (0)
#define PG8_LDB(dst, b, h) do { _Pragma("unroll") for (int n = 0; n < 2; ++n) _Pragma("unroll") for (int k = 0; k < 2; ++k) dst[n][k] = *(const LAS bf16x8*)(lds + PG8_SB(b, h) + boff + n * 2048 + k * 1024); } while (0)
#define PG8_MMA(ai, bj, At, Bt) do { __builtin_amdgcn_s_setprio(1); _Pragma("unroll") for (int m = 0; m < 4; ++m) _Pragma("unroll") for (int n = 0; n < 2; ++n) _Pragma("unroll") for (int k = 0; k < 2; ++k) \
        acc[ai][bj][m][n] = __builtin_amdgcn_mfma_f32_16x16x32_bf16(Bt[n][k], At[m][k], acc[ai][bj][m][n], 0, 0, 0); __builtin_amdgcn_s_setprio(0); } while (0)
#define PG8_WAIT_V(n) asm volatile("s_waitcnt vmcnt(" #n ")" ::: "memory")
#define PG8_WAIT_L(n) asm volatile("s_waitcnt lgkmcnt(" #n ")" ::: "memory")
#define PG8_BAR __builtin_amdgcn_s_barrier()
#define PG8_SCHED __builtin_amdgcn_sched_barrier(0)
    Unit cur, nxt; int ui = 0;
    if (!S.next(0, cur)) return;
    f32x4 acc[2][2][4][2];
#pragma unroll
    for (int a = 0; a < 2; ++a)
#pragma unroll
        for (int b = 0; b < 2; ++b)
#pragma unroll
            for (int m = 0; m < 4; ++m)
#pragma unroll
                for (int n = 0; n < 2; ++n) acc[a][b][m][n] = (f32x4){0.f, 0.f, 0.f, 0.f};
    bf16x8 At[4][2], B0[2][2], B1[2][2];
    const char* cA = S.a_ptr(cur); const char* cB = S.b_ptr(cur);
    float pre[8]; E.prefetch(pre, cur, wr, fr);
    PG8_STAGE(PG8_SB(0, 0), cB, voffB); PG8_STAGE(PG8_SA(0, 0), cA, voffA); PG8_STAGE(PG8_SB(0, 1), cB + hstepB, voffB); PG8_STAGE(PG8_SA(0, 1), cA + hstepA, voffA);
    if (wr == 1) PG8_BAR;
    PG8_WAIT_V(4); PG8_BAR;
    PG8_STAGE(PG8_SB(1, 0), cB + kstepB, voffB); PG8_STAGE(PG8_SA(1, 0), cA + kstepA, voffA); PG8_STAGE(PG8_SB(1, 1), cB + hstepB + kstepB, voffB);
    PG8_WAIT_V(6); PG8_BAR;
    for (;;) {
        const bool has_next = S.next(ui + 1, nxt);
        const char* nA = has_next ? S.a_ptr(nxt) : cA; const char* nB = has_next ? S.b_ptr(nxt) : cB;
        for (int t = 0; t < nt; t += 2) {
            const bool last = (t == nt - 2);
            const char* a1 = cA + (size_t)(t + 1) * kstepA;
            const char* a2 = last ? nA : cA + (size_t)(t + 2) * kstepA; const char* b2 = last ? nB : cB + (size_t)(t + 2) * kstepB;
            const char* a3 = a2 + kstepA; const char* b3 = b2 + kstepB;
            PG8_LDB(B0, 0, 0); PG8_SCHED; PG8_LDA(At, 0, 0); PG8_STAGE(PG8_SA(1, 1), a1 + hstepA, voffA);
            PG8_WAIT_L(8); PG8_BAR; PG8_WAIT_L(0); PG8_MMA(0, 0, At, B0); PG8_BAR; PG8_SCHED;
            PG8_LDB(B1, 0, 1); PG8_STAGE(PG8_SB(0, 0), b2, voffB);
            PG8_BAR; PG8_WAIT_L(0); PG8_MMA(0, 1, At, B1); PG8_BAR;
            PG8_LDA(At, 0, 1); PG8_STAGE(PG8_SA(0, 0), a2, voffA);
            PG8_BAR; PG8_WAIT_L(0); PG8_MMA(1, 0, At, B0); PG8_BAR; PG8_SCHED;
            PG8_STAGE(PG8_SB(0, 1), b2 + hstepB, voffB);
            PG8_WAIT_V(6); PG8_BAR; PG8_MMA(1, 1, At, B1); PG8_BAR;
            PG8_LDB(B0, 1, 0); PG8_SCHED; PG8_LDA(At, 1, 0); PG8_STAGE(PG8_SA(0, 1), a2 + hstepA, voffA);
            PG8_WAIT_L(8); PG8_BAR; PG8_WAIT_L(0); PG8_MMA(0, 0, At, B0); PG8_BAR; PG8_SCHED;
            PG8_LDB(B1, 1, 1); PG8_STAGE(PG8_SB(1, 0), b3, voffB);
            PG8_BAR; PG8_WAIT_L(0); PG8_MMA(0, 1, At, B1); PG8_BAR;
            PG8_LDA(At, 1, 1); PG8_STAGE(PG8_SA(1, 0), a3, voffA);
            PG8_BAR; PG8_WAIT_L(0); PG8_MMA(1, 0, At, B0); PG8_BAR; PG8_SCHED;
            PG8_STAGE(PG8_SB(1, 1), b3 + hstepB, voffB);
            PG8_WAIT_V(6); PG8_BAR; PG8_MMA(1, 1, At, B1); PG8_BAR;
        }
        E(acc, cur, wr, wc, fr, fq, pre);
        if (has_next) E.prefetch(pre, nxt, wr, fr);
        if (!has_next) break;
#pragma unroll
        for (int a = 0; a < 2; ++a)
#pragma unroll
            for (int b = 0; b < 2; ++b)
#pragma unroll
                for (int m = 0; m < 4; ++m)
#pragma unroll
                    for (int n = 0; n < 2; ++n) acc[a][b][m][n] = (f32x4){0.f, 0.f, 0.f, 0.f};
        cur = nxt; cA = nA; cB = nB; ++ui;
    }
    PG8_WAIT_V(0);
    if (wr == 0) PG8_BAR;
    PG8_BAR;
#undef PG8_SA
#undef PG8_SB
#undef PG8_STAGE
#undef PG8_LDA
#undef PG8_LDB
#undef PG8_MMA
#undef PG8_WAIT_V
#undef PG8_WAIT_L
#undef PG8_BAR
#undef PG8_SCHED
}
}

struct Args { const float* in[24]; float* out; unsigned char* ws; };
enum { I_X = 0, I_F1N, I_F1W1, I_F1W3, I_F1W2, I_MIXN, I_WIN, I_GB, I_QNA, I_KNA, I_QNN, I_KNN, I_POS, I_CKW1, I_CKW2, I_CVW1, I_CVW2, I_ON, I_WOUT, I_F2N, I_F2W1, I_F2W3, I_F2W2, I_RB };

__device__ __forceinline__ void transpose_item(const float* W, int K, int N, bf16_t* WT, int mode, int off, LAS float* scr, int item, int lane, const float* gain) {
    const int nblk = (N + 31) / 32, kb = item / nblk, nb = item % nblk, k0 = 64 * kb, n0 = 32 * nb;
    const int c4 = 4 * (lane & 7), nn = n0 + c4;
    f32x4 ld[8];
#pragma unroll
    for (int i = 0; i < 8; ++i) { const int kk = 8 * i + (lane >> 3); ld[i] = (nn < N) ? *(const f32x4*)(W + (size_t)(k0 + kk) * N + nn) : (f32x4){0.f, 0.f, 0.f, 0.f}; if (gain) ld[i] = ld[i] * gain[k0 + kk]; }
#pragma unroll
    for (int i = 0; i < 8; ++i) { const int kk = 8 * i + (lane >> 3); LAS float* d = scr + kk * 33 + c4; d[0] = ld[i].x; d[1] = ld[i].y; d[2] = ld[i].z; d[3] = ld[i].w; }
    LDS_WAIT(); asm volatile("" ::: "memory");
    const int c = lane & 7;
#pragma unroll
    for (int j = 0; j < 4; ++j) { const int n = (lane >> 3) + 8 * j; const LAS float* s = scr + (8 * c) * 33 + n;
        u32x4 o; o.x = pk2(s[0 * 33], s[1 * 33]); o.y = pk2(s[2 * 33], s[3 * 33]); o.z = pk2(s[4 * 33], s[5 * 33]); o.w = pk2(s[6 * 33], s[7 * 33]);
        const int ng = n0 + n; const int dr = mode ? ((ng >> 7) * 256 + (ng & 127) + off) : (ng + off);
        if (ng < N) *(u32x4*)(WT + kt_off(dr, k0 + 8 * c, K)) = o; }
    LDS_WAIT(); asm volatile("" ::: "memory");
}
__device__ __forceinline__ int rel_bucket_dev(int n) {
    if (n < 16) return n;
    const float v = logf((float)n / 16.0f) / 4.852030263919617f * 16.0f;
    int b = 16 + (int)v; return b < 31 ? b : 31;
}
namespace att {
constexpr int SHM_V = 16384, SHM_K = 16384;
constexpr int L_V = 0  , L_K = 49152  , L_WS = 98304, L_TBL = 100352, L_SELM = L_TBL + 4 * TBLS * 4  , L_END = L_SELM + 1024;
constexpr int L_IMP = 0;
static_assert(L_END <= 131072, "attention LDS map");
constexpr float THR = 8.f;
#define KSWZ(row, colB) ((row) * 256 + ((colB) ^ (((row) & 7) << 4)))
__device__ __forceinline__ int v_st(int k, int c) { const int kk = (k & ~0xC) | ((k & 4) << 1) | ((k & 8) >> 1); return ((kk >> 3) * 4 + (c >> 5)) * 512 + ((kk & 7) * 32 + (c & 31)) * 2; }
__device__ __forceinline__ int v_rd_base(int lane) { return ((lane & 3) << 3) | (((lane >> 2) & 3) << 6) | (((lane >> 4) & 1) << 5) | (((lane >> 5) & 1) << 8); }
__device__ __forceinline__ int crow(int r, int hi) { return (r & 3) + 8 * (r >> 2) + 4 * hi; }

__device__ __forceinline__ void partialSM(f32x16& p0, f32x16& p1, float& m_reg, float& mn, float& alpha) {
    (void)m_reg; mn = 0.f; alpha = 1.f;
#pragma unroll
    for (int r = 0; r < 16; ++r) p0[r] = __builtin_amdgcn_exp2f(p0[r] * LOG2E);
#pragma unroll
    for (int r = 0; r < 16; ++r) p1[r] = p1[r] * LOG2E;
}
__device__ __forceinline__ void partialSM_row(f32x16& p0, f32x16& p1, float& m_reg, float& mn, float& alpha, bool ok, float bias) {
    (void)m_reg; mn = 0.f; alpha = 1.f;
    const float mnL = ok ? bias * LOG2E : -__builtin_inff();
#pragma unroll
    for (int r = 0; r < 16; ++r) p0[r] = __builtin_amdgcn_exp2f(fmaf(p0[r], LOG2E, mnL));
#pragma unroll
    for (int r = 0; r < 16; ++r) p1[r] = fmaf(p1[r], LOG2E, mnL);
}
#define PK4(P, B_, OUT) do { unsigned a0 = cvtpk(P[B_+0], P[B_+1]), a1 = cvtpk(P[B_+2], P[B_+3]);                          \
        unsigned b0 = cvtpk(P[B_+4], P[B_+5]), b1 = cvtpk(P[B_+6], P[B_+7]);                                             \
        auto r0 = __builtin_amdgcn_permlane32_swap(a0, b0, false, false); auto r1 = __builtin_amdgcn_permlane32_swap(a1, b1, false, false); \
        u32x4 w = {r0[0], r1[0], r0[1], r1[1]}; OUT = *reinterpret_cast<bf16x8*>(&w); } while (0)
__device__ __forceinline__ void finishSM(f32x16& p0, f32x16& p1, float alpha, float& l_reg, bf16x8& pa0, bf16x8& pa1, bf16x8& pa2, bf16x8& pa3) {
#pragma unroll
    for (int r = 0; r < 16; ++r) p1[r] = __builtin_amdgcn_exp2f(p1[r]);
    float ps = 0;
#pragma unroll
    for (int r = 0; r < 16; ++r) ps += p0[r];
#pragma unroll
    for (int r = 0; r < 16; ++r) ps += p1[r];
    { auto rr = __builtin_amdgcn_permlane32_swap(__float_as_uint(ps), __float_as_uint(ps), false, false);
      ps = __uint_as_float(rr[0]) + __uint_as_float(rr[1]); }
    l_reg = l_reg * alpha + ps;
    PK4(p0, 0, pa0); PK4(p0, 8, pa1); PK4(p1, 0, pa2); PK4(p1, 8, pa3);
}
__device__ __forceinline__ void qkt(f32x16& p0, f32x16& p1, const LAS char* Kb, int r32, int hi, const bf16x8 (&qr)[8]) {
    p0 = f32x16{}; p1 = f32x16{};
    const LAS char* kb4[4];
#pragma unroll
    for (int dd = 0; dd < 4; ++dd) kb4[dd] = Kb + KSWZ(r32, (dd * 16 + hi * 8) * 2);
#pragma unroll
    for (int d0 = 0; d0 < 8; ++d0) { const LAS char* a = kb4[d0 & 3] + (d0 >> 2) * 128;
        const bf16x8 b0 = *reinterpret_cast<const LAS bf16x8*>(a);
        const bf16x8 b1 = *reinterpret_cast<const LAS bf16x8*>(a + 32 * 256);
        p0 = __builtin_amdgcn_mfma_f32_32x32x16_bf16(b0, qr[d0], p0, 0, 0, 0);
        p1 = __builtin_amdgcn_mfma_f32_32x32x16_bf16(b1, qr[d0], p1, 0, 0, 0); }
}
__device__ __forceinline__ void pv_tile(f32x16 (&o)[4], int vb, bf16x8 pa0, bf16x8 pa1, bf16x8 pa2, bf16x8 pa3) {
#define TRRD(dst, off) asm volatile("ds_read_b64_tr_b16 %0, %1 offset:%2" : "=&v"(dst) : "v"(vb), "i"(off) : "memory")
#define PV_D0(d0) do { s16x4 l0, l1, l2, l3, h0, h1, h2, h3; constexpr int b_ = (d0) * 512; \
        TRRD(l0, b_); TRRD(h0, b_ + 2048); TRRD(l1, b_ + 4096); TRRD(h1, b_ + 6144); TRRD(l2, b_ + 8192); TRRD(h2, b_ + 10240); TRRD(l3, b_ + 12288); TRRD(h3, b_ + 14336); \
        asm volatile("s_waitcnt lgkmcnt(0)" ::: "memory"); SBAR(); \
        o[d0] = __builtin_amdgcn_mfma_f32_32x32x16_bf16(pa0, (bf16x8){l0[0], l0[1], l0[2], l0[3], h0[0], h0[1], h0[2], h0[3]}, o[d0], 0, 0, 0);   \
        o[d0] = __builtin_amdgcn_mfma_f32_32x32x16_bf16(pa1, (bf16x8){l1[0], l1[1], l1[2], l1[3], h1[0], h1[1], h1[2], h1[3]}, o[d0], 0, 0, 0);   \
        o[d0] = __builtin_amdgcn_mfma_f32_32x32x16_bf16(pa2, (bf16x8){l2[0], l2[1], l2[2], l2[3], h2[0], h2[1], h2[2], h2[3]}, o[d0], 0, 0, 0);   \
        o[d0] = __builtin_amdgcn_mfma_f32_32x32x16_bf16(pa3, (bf16x8){l3[0], l3[1], l3[2], l3[3], h3[0], h3[1], h3[2], h3[3]}, o[d0], 0, 0, 0); } while (0)
    PV_D0(0); PV_D0(1); PV_D0(2); PV_D0(3);
#undef PV_D0
#undef TRRD
}

template <class Cfg>
__device__ __forceinline__ void attn_tiles(const Cfg& c, LAS char* lds, const bf16x8 (&qr)[8], f32x16 (&o)[4], float& m_reg, float& l_reg, const int t_lo, const int t_hi, const int wv) {
    const int tid = opq_tid(wv), lane = tid & 63, wid = __builtin_amdgcn_readfirstlane(tid >> 6), r32 = lane & 31, hi = lane >> 5;
    LAS char* V_lds = lds + L_V; LAS char* K_lds = lds + L_K;
    LAS float* al_l = (LAS float*)(lds + L_WS) + wid * 64 + 32;
    const int sr = tid >> 4, sc = (tid & 15) * 8;
    const int vst0 = v_st(sr, sc), vst1 = v_st(32 + sr, sc), kws = KSWZ(sr, sc * 2);
    const int vb0 = (int)(unsigned)(uintptr_t)V_lds + v_rd_base(lane);
    bf16x8 sk0, sk1, sv0, sv1;
    const bf16_t *gk0 = nullptr, *gk1 = nullptr, *gv0 = nullptr, *gv1 = nullptr;
#define AT_LOAD(t) do { gk0 = c.krow((t), sr) + sc; gk1 = c.krow((t), sr + 32) + sc; sk0 = *(const bf16x8*)gk0; sk1 = *(const bf16x8*)gk1; \
        if constexpr (Cfg::MODE == 0) { gv0 = c.vrow((t), sr) + sc; gv1 = c.vrow((t), sr + 32) + sc; sv0 = *(const bf16x8*)gv0; sv1 = *(const bf16x8*)gv1; } \
        asm volatile("" ::: "memory"); SBAR(); } while (0)
#define AT_WRITE(t, bf) do { asm volatile("" :: "v"(gk0), "v"(gk1), "v"(gv0), "v"(gv1)); *(LAS bf16x8*)(K_lds + (bf) * SHM_K + kws) = sk0; *(LAS bf16x8*)(K_lds + (bf) * SHM_K + kws + 32 * 256) = sk1; \
        if constexpr (Cfg::MODE == 1) { \
            _Pragma("unroll") for (int i_ = 0; i_ < 8; ++i_) { const int n_ = sc + i_, c0_ = 64 * (t) + sr, c1_ = c0_ + 32; \
                sv0[i_] = (c0_ >= 4 * n_ - 1 && c0_ <= 4 * n_ + 3) ? (short)0x3F80 : (short)0; sv1[i_] = (c1_ >= 4 * n_ - 1 && c1_ <= 4 * n_ + 3) ? (short)0x3F80 : (short)0; } } \
        *(LAS bf16x8*)(V_lds + (bf) * SHM_V + vst0) = sv0; *(LAS bf16x8*)(V_lds + (bf) * SHM_V + vst1) = sv1; } while (0)
    __builtin_amdgcn_s_waitcnt(0x0F70);
    __syncthreads();
    if (t_lo < t_hi) { AT_LOAD(t_lo); AT_WRITE(t_lo, 0); }
    __syncthreads();
    for (int t = t_lo; t < t_hi; ++t) {
        const int buf = (t - t_lo) & 1; const bool more = (t + 1 < t_hi);
        if (more) AT_LOAD(t + 1);
        if (c.active(t)) {
            f32x16 p0, p1;
            qkt(p0, p1, K_lds + buf * SHM_K, r32, hi, qr);
            if constexpr (Cfg::MODE == 0) {
                float mn, alpha; bf16x8 pa0, pa1, pa2, pa3;
                bool rok; float rbias;
                if (c.rowconst(t, rok, rbias)) partialSM_row(p0, p1, m_reg, mn, alpha, rok, rbias);
                else { c.mask(p0, p1, t); partialSM(p0, p1, m_reg, mn, alpha); }
                if (__any(alpha < 1.f)) { if (hi == 0) al_l[r32] = alpha; LDS_WAIT();
#pragma unroll
                    for (int d_ = 0; d_ < 4; ++d_)
#pragma unroll
                        for (int r = 0; r < 16; ++r) o[d_][r] *= al_l[crow(r, hi)]; }
                finishSM(p0, p1, alpha, l_reg, pa0, pa1, pa2, pa3); SBAR();
                pv_tile(o, vb0 + buf * SHM_V, pa0, pa1, pa2, pa3);
            } else {
                c.mask(p0, p1, t);
                const float mL = -c.mfix * LOG2E; const float il = c.invl;
#pragma unroll
                for (int r = 0; r < 16; ++r) { p0[r] = __builtin_amdgcn_exp2f(fmaf(p0[r], LOG2E, mL)) * il; p1[r] = __builtin_amdgcn_exp2f(fmaf(p1[r], LOG2E, mL)) * il; }
                bf16x8 pa0, pa1, pa2, pa3;
                PK4(p0, 0, pa0); PK4(p0, 8, pa1); PK4(p1, 0, pa2); PK4(p1, 8, pa3); SBAR();
                pv_tile(o, vb0 + buf * SHM_V, pa0, pa1, pa2, pa3);
#pragma unroll
                for (int r = 0; r < 16; r += 2) { const unsigned a = cvtpk(p0[r], p0[r + 1]), b = cvtpk(p1[r], p1[r + 1]);
                    p0[r] -= bflo(a); p0[r + 1] -= bfhi(a); p1[r] -= bflo(b); p1[r + 1] -= bfhi(b); }
                PK4(p0, 0, pa0); PK4(p0, 8, pa1); PK4(p1, 0, pa2); PK4(p1, 8, pa3); SBAR();
                pv_tile(o, vb0 + buf * SHM_V, pa0, pa1, pa2, pa3);
            }
        }
        if (more) AT_WRITE(t + 1, buf ^ 1);
        __syncthreads();
    }
#undef AT_LOAD
#undef AT_WRITE
}

template <class Cfg>
__device__ __forceinline__ void attn_tiles_s(const Cfg& c, LAS char* lds, const bf16x8 (&qr)[8], f32x16 (&o)[4], float& m_reg, float& l_reg, const int t_lo, const int t_hi, const int wv) {
    static_assert(Cfg::MODE == 0, "fixed-shift softmax tiles only");
    (void)m_reg;
    const int tid = opq_tid(wv), lane = tid & 63, wid = __builtin_amdgcn_readfirstlane(tid >> 6), r32 = lane & 31, hi = lane >> 5;
    LAS char* V_lds = lds + L_V; LAS char* K_lds = lds + L_K;
    const int sr = tid >> 4, sc = (tid & 15) * 8;
    const int vst0 = v_st(sr, sc), vst1 = v_st(32 + sr, sc), kws = KSWZ(sr, sc * 2);
    const int vb0 = (int)(unsigned)(uintptr_t)V_lds + v_rd_base(lane);
    bf16x8 sk0, sk1, sv0, sv1, pa0, pa1, pa2, pa3;
    const bf16_t *gk0 = nullptr, *gk1 = nullptr, *gv0 = nullptr, *gv1 = nullptr;
#define AS_LOAD(t) do { gk0 = c.krow((t), sr) + sc; gk1 = c.krow((t), sr + 32) + sc; sk0 = *(const bf16x8*)gk0; sk1 = *(const bf16x8*)gk1; \
        gv0 = c.vrow((t), sr) + sc; gv1 = c.vrow((t), sr + 32) + sc; sv0 = *(const bf16x8*)gv0; sv1 = *(const bf16x8*)gv1; asm volatile("" ::: "memory"); SBAR(); } while (0)
#define AS_WRITE(kbf, vbf) do { asm volatile("" :: "v"(gk0), "v"(gk1), "v"(gv0), "v"(gv1)); *(LAS bf16x8*)(K_lds + (kbf) * SHM_K + kws) = sk0; *(LAS bf16x8*)(K_lds + (kbf) * SHM_K + kws + 32 * 256) = sk1; \
        *(LAS bf16x8*)(V_lds + (vbf) * SHM_V + vst0) = sv0; *(LAS bf16x8*)(V_lds + (vbf) * SHM_V + vst1) = sv1; } while (0)
#define AS_SCORE(t, kbf) do { f32x16 p0, p1; float mz_ = 0.f, mn_, al_; bool rok_; float rb_; \
        qkt(p0, p1, K_lds + (kbf) * SHM_K, r32, hi, qr); \
        if (c.rowconst((t), rok_, rb_)) partialSM_row(p0, p1, mz_, mn_, al_, rok_, rb_); else { c.mask(p0, p1, (t)); partialSM(p0, p1, mz_, mn_, al_); } \
        finishSM(p0, p1, 1.f, l_reg, pa0, pa1, pa2, pa3); SBAR(); } while (0)
    if (t_lo >= t_hi) return;
    __builtin_amdgcn_s_waitcnt(0x0F70);
    __syncthreads();
    AS_LOAD(t_lo); AS_WRITE(0, 0);
    __syncthreads();
    int kb = 0, vb = 0;
    if (wid < 4) {
        for (int t = t_lo; t < t_hi; ++t) {
            const bool more = (t + 1 < t_hi); const int vn = (vb == 2) ? 0 : vb + 1;
            if (more) AS_LOAD(t + 1);
            if (c.active(t)) { AS_SCORE(t, kb); pv_tile(o, vb0 + vb * SHM_V, pa0, pa1, pa2, pa3); }
            if (more) AS_WRITE(kb ^ 1, vn);
            __syncthreads();
            kb ^= 1; vb = vn;
        }
    } else {
        bool pend = false; int vp = 0;
        for (int t = t_lo; t < t_hi; ++t) {
            const bool more = (t + 1 < t_hi); const int vn = (vb == 2) ? 0 : vb + 1;
            if (more) AS_LOAD(t + 1);
            if (pend) pv_tile(o, vb0 + vp * SHM_V, pa0, pa1, pa2, pa3);
            const bool act = c.active(t);
            if (act) AS_SCORE(t, kb);
            pend = act; vp = vb;
            if (more) AS_WRITE(kb ^ 1, vn);
            __syncthreads();
            kb ^= 1; vb = vn;
        }
        if (pend) pv_tile(o, vb0 + vp * SHM_V, pa0, pa1, pa2, pa3);
    }
#undef AS_LOAD
#undef AS_WRITE
#undef AS_SCORE
}

struct DilCfg {
    static constexpr int MODE = 0;
    const bf16_t* Kb; const bf16_t* Vb;
    const LAS float* tbl; int dshift, res, u, dqm, s0;
    __device__ __forceinline__ const bf16_t* krow(int t, int kk) const { int s = 256 * u - 128 + 64 * t + kk; s = s < 0 ? 0 : s; return Kb + (size_t)((s << dshift) + res) * PC; }
    __device__ __forceinline__ const bf16_t* vrow(int t, int kk) const { int s = 256 * u - 128 + 64 * t + kk; s = s < 0 ? 0 : s; return Vb + (size_t)((s << dshift) + res) * PC; }
    __device__ __forceinline__ bool active(int t) const { const int kb = 256 * u - 128 + 64 * t; return kb <= s0 + 31 && kb + 63 >= s0 - 128; }
    __device__ __forceinline__ bool rowconst(int, bool&, float&) const { return false; }
    __device__ __forceinline__ void mask(f32x16& p0, f32x16& p1, int t) const {
        const int dq = dqm - (256 * u - 128 + 64 * t); const float NEG = -__builtin_inff();
        const LAS float* tb = tbl + (DT0 + dq - 63);
        float bb0[16], bb1[16];
#pragma unroll
        for (int r = 0; r < 16; ++r) { const int cc = (r & 3) + 8 * (r >> 2); bb0[r] = tb[63 - cc]; bb1[r] = tb[31 - cc]; }
#pragma unroll
        for (int r = 0; r < 16; ++r) asm volatile("" : "+v"(bb0[r]), "+v"(bb1[r]));
#pragma unroll
        for (int r = 0; r < 16; ++r) { const int cc = (r & 3) + 8 * (r >> 2); const unsigned d0 = (unsigned)(dq - cc), d1 = (unsigned)(dq - cc - 32);
            p0[r] = (d0 <= 128u) ? p0[r] + bb0[r] : NEG; p1[r] = (d1 <= 128u) ? p1[r] + bb1[r] : NEG; }
    }
};
struct CmpCfg {
    static constexpr int MODE = 0;
    const bf16_t* Kb; const bf16_t* Vb; int cmax, hi4, cfull;
    __device__ __forceinline__ bool rowconst(int t, bool& ok, float& bias) const { ok = true; bias = 0.f; return 64 * t + 63 <= cfull; }
    __device__ __forceinline__ const bf16_t* krow(int t, int kk) const { return Kb + (size_t)(64 * t + kk) * HD; }
    __device__ __forceinline__ const bf16_t* vrow(int t, int kk) const { return Vb + (size_t)(64 * t + kk) * HD; }
    __device__ __forceinline__ bool active(int) const { return true; }
    __device__ __forceinline__ void mask(f32x16& p0, f32x16& p1, int t) const {
        const int cb = 64 * t + hi4; const float NEG = -__builtin_inff();
#pragma unroll
        for (int r = 0; r < 16; ++r) { const int cc = cb + (r & 3) + 8 * (r >> 2); if (cc > cmax) p0[r] = NEG; if (cc + 32 > cmax) p1[r] = NEG; }
    }
};
struct CmpImpCfg {
    static constexpr int MODE = 1;
    const bf16_t* Kb; int cmax, hi4; float mfix, invl;
    __device__ __forceinline__ const bf16_t* krow(int t, int kk) const { return Kb + (size_t)(64 * t + kk) * HD; }
    __device__ __forceinline__ const bf16_t* vrow(int, int) const { return Kb; }
    __device__ __forceinline__ bool active(int) const { return true; }
    __device__ __forceinline__ void mask(f32x16& p0, f32x16& p1, int t) const {
        const int cb = 64 * t + hi4; const float NEG = -__builtin_inff();
#pragma unroll
        for (int r = 0; r < 16; ++r) { const int cc = cb + (r & 3) + 8 * (r >> 2); if (cc > cmax) p0[r] = NEG; if (cc + 32 > cmax) p1[r] = NEG; }
    }
};
struct SlcCfg {
    static constexpr int MODE = 0;
    const bf16_t* Kb; const bf16_t* Vb;
    const LAS float* tblh;
    unsigned s0, s1, s2, s3; int tqm, cur; float b31;
    __device__ __forceinline__ const bf16_t* krow(int t, int kk) const { return Kb + (size_t)(64 * t + kk) * PC; }
    __device__ __forceinline__ const bf16_t* vrow(int t, int kk) const { return Vb + (size_t)(64 * t + kk) * PC; }
    __device__ __forceinline__ bool selbit(int t) const { const unsigned q = (unsigned)t >> 5; const unsigned w = (q == 0u ? s0 + 0u : 0u) | (q == 1u ? s1 + 0u : 0u) | (q == 2u ? s2 + 0u : 0u) | (q == 3u ? s3 + 0u : 0u); return (w >> (t & 31)) & 1u; }
    __device__ __forceinline__ bool active(int t) const { return __any(selbit(t)); }
    __device__ __forceinline__ bool rowconst(int t, bool& ok, float& bias) const { ok = selbit(t); bias = b31; return 64 * (cur - t) - 63 >= 1513; }
    __device__ __forceinline__ void mask(f32x16& p0, f32x16& p1, int t) const {
        const bool sel = selbit(t); const int dq = tqm - 64 * t; const float NEG = -__builtin_inff();
        const LAS float* tb = tblh + (TBL0 + dq - 63);
        float bb0[16], bb1[16];
#pragma unroll
        for (int r = 0; r < 16; ++r) { const int cc = (r & 3) + 8 * (r >> 2); bb0[r] = tb[63 - cc]; bb1[r] = tb[31 - cc]; }
#pragma unroll
        for (int r = 0; r < 16; ++r) asm volatile("" : "+v"(bb0[r]), "+v"(bb1[r]));
#pragma unroll
        for (int r = 0; r < 16; ++r) { const int cc = (r & 3) + 8 * (r >> 2); const int d0 = dq - cc, d1 = dq - cc - 32;
            p0[r] = (sel && d0 >= 0) ? p0[r] + bb0[r] : NEG; p1[r] = (sel && d1 >= 0) ? p1[r] + bb1[r] : NEG; }
    }
};
struct WinCfg {
    static constexpr int MODE = 0;
    const bf16_t* Kb; const bf16_t* Vb; const LAS float* tblh; int tqm;
    __device__ __forceinline__ bool rowconst(int, bool&, float&) const { return false; }
    __device__ __forceinline__ const bf16_t* krow(int t, int kk) const { return Kb + (size_t)(64 * t + kk) * PC; }
    __device__ __forceinline__ const bf16_t* vrow(int t, int kk) const { return Vb + (size_t)(64 * t + kk) * PC; }
    __device__ __forceinline__ bool active(int) const { return true; }
    __device__ __forceinline__ void mask(f32x16& p0, f32x16& p1, int t) const {
        const int dq = tqm - 64 * t; const float NEG = -__builtin_inff();
        const LAS float* tb = tblh + (TBL0 + dq - 63);
        float bb0[16], bb1[16];
#pragma unroll
        for (int r = 0; r < 16; ++r) { const int cc = (r & 3) + 8 * (r >> 2); bb0[r] = tb[63 - cc]; bb1[r] = tb[31 - cc]; }
#pragma unroll
        for (int r = 0; r < 16; ++r) asm volatile("" : "+v"(bb0[r]), "+v"(bb1[r]));
#pragma unroll
        for (int r = 0; r < 16; ++r) { const int cc = (r & 3) + 8 * (r >> 2); const unsigned d0 = (unsigned)(dq - cc), d1 = (unsigned)(dq - cc - 32);
            p0[r] = (d0 < 512u) ? p0[r] + bb0[r] : NEG; p1[r] = (d1 < 512u) ? p1[r] + bb1[r] : NEG; }
    }
};
}

__device__ __forceinline__ void load_q_normed(const bf16_t* qp  , const float* gain  , bf16x8 (&qr)[8]) {
    u32x4 raw[8];
#pragma unroll
    for (int d0 = 0; d0 < 8; ++d0) raw[d0] = *(const u32x4*)(qp + d0 * 16);
    float ss = 0.f;
#pragma unroll
    for (int d0 = 0; d0 < 8; ++d0) { const u32x4 w = raw[d0]; const float a0 = bflo(w.x), a1 = bfhi(w.x), a2 = bflo(w.y), a3 = bfhi(w.y), a4 = bflo(w.z), a5 = bfhi(w.z), a6 = bflo(w.w), a7 = bfhi(w.w);
        ss += ((a0 * a0 + a1 * a1) + (a2 * a2 + a3 * a3)) + ((a4 * a4 + a5 * a5) + (a6 * a6 + a7 * a7)); }
    { auto rr = __builtin_amdgcn_permlane32_swap(__float_as_uint(ss), __float_as_uint(ss), false, false); ss = __uint_as_float(rr[0]) + __uint_as_float(rr[1]); }
    const float rs = QSCALE / sqrtf(ss * (1.f / HD) + EPS);
#pragma unroll
    for (int d0 = 0; d0 < 8; ++d0) { const u32x4 w = raw[d0]; const f32x4 g0 = *(const f32x4*)(gain + d0 * 16), g1 = *(const f32x4*)(gain + d0 * 16 + 4);
        u32x4 o; o.x = cvtpk(bflo(w.x) * rs * g0.x, bfhi(w.x) * rs * g0.y); o.y = cvtpk(bflo(w.y) * rs * g0.z, bfhi(w.y) * rs * g0.w);
        o.z = cvtpk(bflo(w.z) * rs * g1.x, bfhi(w.z) * rs * g1.y); o.w = cvtpk(bflo(w.w) * rs * g1.z, bfhi(w.w) * rs * g1.w);
        qr[d0] = *reinterpret_cast<bf16x8*>(&o); }
}

__device__ __forceinline__ void dil_tiles(const att::DilCfg& c, LAS char* lds, const bf16x8 (&qr)[8], f32x16 (&o)[4], float& l_reg, const int wv) {
    using namespace att;
    const int tid = opq_tid(wv), lane = tid & 63, wid = __builtin_amdgcn_readfirstlane(tid >> 6), r32 = lane & 31, hi = lane >> 5;
    LAS char* V_lds = lds + L_V; LAS char* K_lds = lds + L_K;
    const int sr = tid >> 4, sc = (tid & 15) * 8;
    const int vst0 = v_st(sr, sc), vst1 = v_st(32 + sr, sc), kws = KSWZ(sr, sc * 2);
    const int vb0 = (int)(unsigned)(uintptr_t)V_lds + v_rd_base(lane);
    bf16x8 sk0, sk1, sv0, sv1;
    const bf16_t *gk0 = nullptr, *gk1 = nullptr, *gv0 = nullptr, *gv1 = nullptr;
#define DT_LOAD(t) do { gk0 = c.krow((t), sr) + sc; gk1 = c.krow((t), sr + 32) + sc; sk0 = *(const bf16x8*)gk0; sk1 = *(const bf16x8*)gk1; \
        gv0 = c.vrow((t), sr) + sc; gv1 = c.vrow((t), sr + 32) + sc; sv0 = *(const bf16x8*)gv0; sv1 = *(const bf16x8*)gv1; asm volatile("" ::: "memory"); SBAR(); } while (0)
#define DT_WRITE(slot) do { asm volatile("" :: "v"(gk0), "v"(gk1), "v"(gv0), "v"(gv1)); *(LAS bf16x8*)(K_lds + (slot) * SHM_K + kws) = sk0; *(LAS bf16x8*)(K_lds + (slot) * SHM_K + kws + 32 * 256) = sk1; \
        *(LAS bf16x8*)(V_lds + (slot) * SHM_V + vst0) = sv0; *(LAS bf16x8*)(V_lds + (slot) * SHM_V + vst1) = sv1; } while (0)
#define DT_COMP(t, slot) do { f32x16 p0, p1; float mz_ = 0.f, mn_, al_; bf16x8 pa0, pa1, pa2, pa3; \
        qkt(p0, p1, K_lds + (slot) * SHM_K, r32, hi, qr); c.mask(p0, p1, (t)); partialSM(p0, p1, mz_, mn_, al_); \
        finishSM(p0, p1, 1.f, l_reg, pa0, pa1, pa2, pa3); SBAR(); pv_tile(o, vb0 + (slot) * SHM_V, pa0, pa1, pa2, pa3); } while (0)
    const bool first = (c.u == 0);
    __builtin_amdgcn_s_waitcnt(0x0F70);
    __syncthreads();
    if (!first) { DT_LOAD(1); DT_WRITE(0); }
    DT_LOAD(4); DT_WRITE(1);
    __syncthreads();
    DT_LOAD(2);
    if (wid < 4) { if (!first) DT_COMP(1, 0); } else DT_COMP(4, 1);
    DT_WRITE(2);
    __syncthreads();
    DT_LOAD(3);
    if (wid < 6) DT_COMP(2, 2);
    DT_WRITE(0);
    __syncthreads();
    DT_LOAD(5);
    if (wid >= 2) DT_COMP(3, 0);
    DT_WRITE(1);
    if (!first) { DT_LOAD(0); DT_WRITE(2); }
    __syncthreads();
    if (wid < 2) { if (!first) DT_COMP(0, 2); } else if (wid >= 6) DT_COMP(5, 1);
#undef DT_LOAD
#undef DT_WRITE
#undef DT_COMP
}

__device__ __forceinline__ void dil_unit(LAS char* lds, const bf16_t* P, bf16_t* OA, float* LSE, const float* dilT, const float* qgain, int pat, int dshift, int unit, const int wv) {
    using namespace att;
    const int tid = opq_tid(wv), lane = tid & 63, wid = __builtin_amdgcn_readfirstlane(tid >> 6), r32 = lane & 31, hi = lane >> 5;
    const int bh = unit >> 5, ru = unit & 31, b = bh >> 3, h = bh & 7;
    const int ncs = 5 - dshift, res = ru >> ncs, u = ru & ((1 << ncs) - 1);
    LAS float* tbl = (LAS float*)(lds + L_TBL);
    __syncthreads();
    if (tid < DTS) tbl[tid] = dilT[(pat * 8 + h) * DTS + tid];
    const int s0 = 256 * u + 32 * wid, s_row = s0 + r32;
    const size_t tokrow = (size_t)b * SEQ + (size_t)((s_row << dshift) + res);
    bf16x8 qr[8];
    load_q_normed(P + tokrow * PC + C_QA + h * HD + hi * 8, qgain + hi * 8, qr);
    f32x16 o[4]; float m_reg, l_reg;
    m_reg = 0.f;
    if (pat == 0) { l_reg = 0.f;
#pragma unroll
        for (int d0 = 0; d0 < 4; ++d0) o[d0] = f32x16{}; }
    else { l_reg = LSE[tokrow * 8 + h];
#pragma unroll
        for (int r = 0; r < 16; ++r) { const size_t tr = (size_t)b * SEQ + (size_t)(((s0 + crow(r, hi)) << dshift) + res); const bf16_t* op = OA + tr * 1024 + h * HD + r32;
#pragma unroll
            for (int d0 = 0; d0 < 4; ++d0) o[d0][r] = bf2f(op[d0 * 32]); } }
    DilCfg c; c.Kb = P + (size_t)b * SEQ * PC + C_KA + h * HD; c.Vb = P + (size_t)b * SEQ * PC + C_VA + h * HD; c.tbl = tbl; c.dshift = dshift; c.res = res; c.u = u; c.dqm = s_row - 4 * hi; c.s0 = s0;
    dil_tiles(c, lds, qr, o, l_reg, wv);
    LAS float* li_l = (LAS float*)(lds + L_WS) + wid * 64;
    if (hi == 0) { li_l[r32] = l_reg; LSE[tokrow * 8 + h] = l_reg; }
    LDS_WAIT();
#pragma unroll
    for (int r = 0; r < 16; ++r) { const int orow = crow(r, hi); const float rl = (pat == 2) ? 1.0f / li_l[orow] : 1.0f;
        const size_t tr = (size_t)b * SEQ + (size_t)(((s0 + orow) << dshift) + res); bf16_t* op = OA + tr * 1024 + h * HD;
#pragma unroll
        for (int d0 = 0; d0 < 4; ++d0) { const float v = o[d0][r] * rl; const float vn = shx(v, 1, lane);
            if ((r32 & 1) == 0) *(unsigned*)(op + d0 * 32 + r32) = cvtpk(v, vn); } }
}

__device__ __forceinline__ void nsa_finalize(LAS char* lds, const f32x16 (&o)[4], float l_reg, const bf16_t* P, bf16_t* ON, const float* gb, int b, int g, int tok0, int br, const int wv) {
    using namespace att;
    const int tid = opq_tid(wv), lane = tid & 63, wid = __builtin_amdgcn_readfirstlane(tid >> 6), r32 = lane & 31, hi = lane >> 5;
    LAS float* li_l = (LAS float*)(lds + L_WS) + wid * 64;
    if (hi == 0) li_l[r32] = l_reg;
    LDS_WAIT();
    bf16_t* ONb = ON + (size_t)br * NTOK * 1024;
    float glv[16], gbv[4];
#pragma unroll
    for (int j = 0; j < 4; ++j) gbv[j] = gb[(4 * g + j) * 3 + br];
#pragma unroll
    for (int r = 0; r < 16; ++r) { const int j = r & 3, k = r >> 2; const size_t tok = (size_t)b * SEQ + tok0 + 2 * k + hi; glv[r] = bf2f(P[tok * PC + C_GL + (4 * g + j) * 3 + br]); }
#pragma unroll
    for (int r = 0; r < 16; ++r) asm volatile("" : "+v"(glv[r]));
#pragma unroll
    for (int r = 0; r < 16; ++r) { const int j = r & 3, k = r >> 2; const float lr = li_l[crow(r, hi)]; const float rl = lr > 0.f ? 1.0f / lr : 0.f;
        const size_t tok = (size_t)b * SEQ + tok0 + 2 * k + hi; const int hh = 4 * g + j;
        const float gl = glv[r] + gbv[j];
        const float sc = rl * __builtin_amdgcn_rcpf(1.0f + __builtin_amdgcn_exp2f(-gl * LOG2E));
        bf16_t* op = ONb + tok * 1024 + hh * HD;
#pragma unroll
        for (int d0 = 0; d0 < 4; ++d0) { const float v = o[d0][r] * sc; const float vn = shx(v, 1, lane);
            if ((r32 & 1) == 0) *(unsigned*)(op + d0 * 32 + r32) = cvtpk(v, vn); } }
}
__device__ __forceinline__ void nsa_unit(LAS char* lds, const bf16_t* P, const bf16_t* KC, const bf16_t* VC, bf16_t* ON, const float* nsaT, const float* gb, const float* qgain, int b, int g, int qi, bool load_tbl, const int wv) {
    using namespace att;
    const int tid = opq_tid(wv), lane = tid & 63, wid = __builtin_amdgcn_readfirstlane(tid >> 6), r32 = lane & 31, hi = lane >> 5;
    LAS float* tbl = (LAS float*)(lds + L_TBL); LAS float* IMP = (LAS float*)(lds + L_IMP); LAS unsigned* SELM = (LAS unsigned*)(lds + L_SELM);
    __syncthreads();
    if (load_tbl) for (int i = tid; i < 4 * TBLS; i += NTHR) tbl[i] = nsaT[(size_t)(4 * g) * TBLS + i];
    const int tok0 = 64 * qi + 8 * wid, tq = tok0 + (r32 >> 2), hd = r32 & 3;
    const bf16_t* Pb = P + (size_t)b * SEQ * PC;
    bf16x8 qr[8];
    load_q_normed(Pb + (size_t)tq * PC + C_QN + (4 * g + hd) * HD + hi * 8, qgain + hi * 8, qr);
    const bf16_t* KCb = KC + (size_t)(b * 2 + g) * 512 * HD; const bf16_t* VCb = VC + (size_t)(b * 2 + g) * 512 * HD;
    const int ntc = (qi >> 4) + 1, cmax = (tq - 31) >> 4;
    f32x16 o[4]; float m_reg, l_reg;
#pragma unroll
    for (int d0 = 0; d0 < 4; ++d0) o[d0] = f32x16{};
    m_reg = 0.f; l_reg = 0.f;
    { CmpCfg c; c.Kb = KCb; c.Vb = VCb; c.cmax = cmax; c.hi4 = 4 * hi; c.cfull = (64 * qi - 31) >> 4; attn_tiles_s(c, lds, qr, o, m_reg, l_reg, 0, ntc, wv); }
    nsa_finalize(lds, o, l_reg, P, ON, gb, b, g, tok0, 0, wv);
    { CmpImpCfg c; c.Kb = KCb; c.cmax = cmax; c.hi4 = 4 * hi; c.mfix = 0.f; c.invl = l_reg > 0.f ? 1.0f / l_reg : 0.f;
#pragma unroll
      for (int d0 = 0; d0 < 4; ++d0) o[d0] = f32x16{};
      float md = 0.f, ld = 0.f; attn_tiles(c, lds, qr, o, md, ld, 0, ntc, wv); }
#pragma unroll
    for (int d0 = 0; d0 < 4; ++d0)
#pragma unroll
        for (int k = 0; k < 4; ++k) IMP[(8 * wid + 2 * k + hi) * 128 + 32 * d0 + r32] = (o[d0][4 * k] + o[d0][4 * k + 1]) + (o[d0][4 * k + 2] + o[d0][4 * k + 3]);
    __syncthreads();
    { const int cur = qi;
#pragma unroll 1
      for (int tl = 8 * wid; tl < 8 * wid + 8; ++tl) {
        const int n0 = lane, n1 = 64 + lane; bool sel0, sel1;
        if (cur <= 15) { sel0 = (n0 <= cur); sel1 = false; }
        else {
            const float v0 = IMP[tl * 128 + n0], v1 = IMP[tl * 128 + n1];
            const unsigned u0 = (n0 >= 1 && n0 <= cur - 2) ? __float_as_uint(v0) + 1u : 0u, u1 = (n1 <= cur - 2) ? __float_as_uint(v1) + 1u : 0u;
            unsigned T = 0u;
#pragma unroll 1
            for (int bit = 30; bit >= 0; --bit) { const unsigned cand = T | (1u << bit);
                const int cnt = __builtin_popcountll(__ballot(u0 >= cand)) + __builtin_popcountll(__ballot(u1 >= cand));
                if (cnt >= 13) T = cand; }
            const bool gt0 = u0 > T, gt1 = u1 > T;
            const int need = 13 - (__builtin_popcountll(__ballot(gt0)) + __builtin_popcountll(__ballot(gt1)));
            const bool eq0 = (u0 == T), eq1 = (u1 == T);
            const unsigned long long m0 = __ballot(eq0), m1 = __ballot(eq1);
            const int pre0 = (int)__builtin_amdgcn_mbcnt_hi((unsigned)(m0 >> 32), __builtin_amdgcn_mbcnt_lo((unsigned)m0, 0u));
            const int pre1 = __builtin_popcountll(m0) + (int)__builtin_amdgcn_mbcnt_hi((unsigned)(m1 >> 32), __builtin_amdgcn_mbcnt_lo((unsigned)m1, 0u));
            sel0 = (n0 == 0 || n0 == cur || n0 == cur - 1) || gt0 || (eq0 && pre0 < need);
            sel1 = (n1 == cur || n1 == cur - 1) || gt1 || (eq1 && pre1 < need);
        }
        const unsigned long long b0 = __ballot(sel0), b1 = __ballot(sel1);
        if (lane == 0) { SELM[tl * 4 + 0] = (unsigned)b0; SELM[tl * 4 + 1] = (unsigned)(b0 >> 32); SELM[tl * 4 + 2] = (unsigned)b1; SELM[tl * 4 + 3] = (unsigned)(b1 >> 32); } } }
    __syncthreads();
    int r32s = r32; asm volatile("" : "+v"(r32s));
    { SlcCfg c; c.Kb = Pb + C_KS + g * HD; c.Vb = Pb + C_VS + g * HD; c.tblh = tbl + (r32s & 3) * TBLS; c.tqm = tok0 + (r32s >> 2) - 4 * hi; c.cur = qi; c.b31 = tbl[(r32s & 3) * TBLS + TBL0 + 1600];
      const int tl = 8 * wid + (r32s >> 2); c.s0 = SELM[tl * 4 + 0]; c.s1 = SELM[tl * 4 + 1]; c.s2 = SELM[tl * 4 + 2]; c.s3 = SELM[tl * 4 + 3];
#pragma unroll
      for (int d0 = 0; d0 < 4; ++d0) o[d0] = f32x16{};
      m_reg = 0.f; l_reg = 0.f;
      attn_tiles_s(c, lds, qr, o, m_reg, l_reg, 0, qi + 1, wv); }
    nsa_finalize(lds, o, l_reg, P, ON, gb, b, g, tok0, 1, wv);
    int r32w = r32; asm volatile("" : "+v"(r32w));
    { WinCfg c; c.Kb = Pb + C_KW + g * HD; c.Vb = Pb + C_VW + g * HD; c.tblh = tbl + (r32w & 3) * TBLS; c.tqm = tok0 + (r32w >> 2) - 4 * hi;
#pragma unroll
      for (int d0 = 0; d0 < 4; ++d0) o[d0] = f32x16{};
      m_reg = 0.f; l_reg = 0.f;
      attn_tiles_s(c, lds, qr, o, m_reg, l_reg, qi >= 8 ? qi - 8 : 0, qi + 1, wv); }
    nsa_finalize(lds, o, l_reg, P, ON, gb, b, g, tok0, 2, wv);
}

constexpr int LDS_BYTES = 147456;
constexpr int LDS_MISC = 131072;
constexpr int LDS_ARGS = LDS_MISC + 64;
__device__ __forceinline__ unsigned long long arg_u64(LAS unsigned char* lds, int i) {
    const LAS unsigned* p = (const LAS unsigned*)(opq_lds(lds) + LDS_ARGS) + 2 * i;
    const unsigned lo = __builtin_amdgcn_readfirstlane(p[0]), hi = __builtin_amdgcn_readfirstlane(p[1]);
    return ((unsigned long long)hi << 32) | lo;
}
#define GAS __attribute__((address_space(1)))
__device__ __forceinline__ const float* arg_in(LAS unsigned char* lds, int i) { return (const float*)(GAS const float*)arg_u64(lds, i); }
__device__ __forceinline__ float* arg_out(LAS unsigned char* lds) { return (float*)(GAS float*)arg_u64(lds, 24); }
__device__ __forceinline__ unsigned char* arg_ws(LAS unsigned char* lds) { return (unsigned char*)(GAS unsigned char*)arg_u64(lds, 25); }
__device__ __forceinline__ int opq_bx() { int b = blockIdx.x; asm volatile("" : "+s"(b)); return b; }
__device__ __forceinline__ int opq_g() { int b = gridDim.x; asm volatile("" : "+s"(b)); return b; }

__device__ __forceinline__ void ph_prologue(LAS unsigned char* lds, const int wv) {
    lds = opq_lds(lds);
    const int tid = opq_tid(wv), lane = tid & 63, wave = __builtin_amdgcn_readfirstlane(tid >> 6), G = opq_g(), bx = opq_bx();
    const int gw = bx * NWAVES + wave, NGW = G * NWAVES;
    unsigned char* ws = arg_ws(lds);
    LAS float* scr = (LAS float*)(lds + wave * 16384);
    constexpr int I_UP = 32 * 176, I_DN = 88 * 64, I_IN = 32 * 177, I_OUT = 32 * 64, I_C1 = 64 * 16, I_Z = 928;
    constexpr int I_FFN = 2 * I_UP + I_DN, I_LAYER = 2 * I_FFN + I_IN + I_OUT + 2 * I_C1 + I_Z;
#pragma unroll 1
    for (int it = gw; it < DEPTH * I_LAYER; it += NGW) {
        const int l = it / I_LAYER; int r = it - l * I_LAYER;
        if (r < 2 * I_FFN) { const int half = r >= I_FFN; r -= half * I_FFN;
            bf16_t* WUP = (bf16_t*)(ws + WS_WUP + (size_t)(l * 2 + half) * SZ_WUP); bf16_t* WDN = (bf16_t*)(ws + WS_WDN + (size_t)(l * 2 + half) * SZ_WDN);
            const float* gn = arg_in(lds, half ? I_F2N : I_F1N) + (size_t)l * DM;
            if (r < I_UP) { transpose_item(arg_in(lds, half ? I_F2W1 : I_F1W1) + (size_t)l * DM * DFF, DM, DFF, WUP, 1, 0, scr, r, lane, gn); continue; } r -= I_UP;
            if (r < I_UP) { transpose_item(arg_in(lds, half ? I_F2W3 : I_F1W3) + (size_t)l * DM * DFF, DM, DFF, WUP, 1, 128, scr, r, lane, gn); continue; } r -= I_UP;
            transpose_item(arg_in(lds, half ? I_F2W2 : I_F1W2) + (size_t)l * DFF * DM, DFF, DM, WDN, 0, 0, scr, r, lane, nullptr); continue; }
        r -= 2 * I_FFN;
        bf16_t* WIN = (bf16_t*)(ws + WS_WIN + (size_t)l * SZ_WIN); bf16_t* WOUT = (bf16_t*)(ws + WS_WOUT + (size_t)l * SZ_WOUT); bf16_t* WC1 = (bf16_t*)(ws + WS_WC1 + (size_t)l * SZ_WC1);
        if (r < I_IN) { transpose_item(arg_in(lds, I_WIN) + (size_t)l * DM * IN_COLS, DM, IN_COLS, WIN, 0, 0, scr, r, lane, arg_in(lds, I_MIXN) + (size_t)l * DM); continue; } r -= I_IN;
        if (r < I_OUT) { transpose_item(arg_in(lds, I_WOUT) + (size_t)l * DM * DM, DM, DM, WOUT, 0, 0, scr, r, lane, nullptr); continue; } r -= I_OUT;
        if (r < I_C1) { transpose_item(arg_in(lds, I_CKW1) + (size_t)l * 4096 * 512, 4096, 512, WC1, 0, 0, scr, r, lane, nullptr); continue; } r -= I_C1;
        if (r < I_C1) { transpose_item(arg_in(lds, I_CVW1) + (size_t)l * 4096 * 512, 4096, 512, WC1, 0, 512, scr, r, lane, nullptr); continue; } r -= I_C1;
        { const int q = r * 64 + lane, kt = q / 1856, rem = q - kt * 1856; u32x4* z = (u32x4*)(WIN + ((size_t)(22 * 32 + kt) * 256 + 24) * 64) + rem; unsigned zr = 0u; asm volatile("" : "+v"(zr)); *z = (u32x4){zr, zr, zr, zr}; }
    }
    const float* xs = arg_in(lds, I_X); bf16_t* XB = (bf16_t*)(ws + WS_HB); float* RSTD = (float*)(ws + WS_RSTD);
    for (int m = gw; m < NTOK; m += NGW) {
        const f32x4* xr = (const f32x4*)(xs + (size_t)m * DM) + lane; f32x4 v[8]; float s = 0.f;
#pragma unroll
        for (int j = 0; j < 8; ++j) { v[j] = xr[64 * j]; s += (v[j].x * v[j].x + v[j].y * v[j].y) + (v[j].z * v[j].z + v[j].w * v[j].w); }
        s = wave_sum(s, lane);
#pragma unroll
        for (int j = 0; j < 8; ++j) { u32x2 w; w.x = cvtpk(v[j].x, v[j].y); w.y = cvtpk(v[j].z, v[j].w); *(u32x2*)(XB + kt_off(m, 256 * j + 4 * lane, DM)) = w; }
        if (lane == 0) RSTD[m] = 1.0f / sqrtf(s * (1.f / DM) + EPS);
    }
}
__device__ __forceinline__ void ph_rstd(LAS unsigned char* lds, const int wv) {
    lds = opq_lds(lds);
    const int tid = opq_tid(wv), G = opq_g(), bx = opq_bx();
    unsigned char* ws = arg_ws(lds); const float* SSQ = (const float*)(ws + WS_SSQ); float* RSTD = (float*)(ws + WS_RSTD);
    for (int m = bx * NTHR + tid; m < NTOK; m += G * NTHR) { const f32x4* p = (const f32x4*)(SSQ + (size_t)m * 32); f32x4 a = p[0];
#pragma unroll
        for (int j = 1; j < 8; ++j) a = a + p[j];
        RSTD[m] = 1.0f / sqrtf(((a.x + a.y) + (a.z + a.w)) * (1.f / DM) + EPS); }
}
__device__ __forceinline__ void ph_headnorm(LAS unsigned char* lds, int l, const int wv) {
    lds = opq_lds(lds);
    const int tid = opq_tid(wv), lane = tid & 63, wave = __builtin_amdgcn_readfirstlane(tid >> 6), G = opq_g(), bx = opq_bx();
    const int gw = bx * NWAVES + wave, NGW = G * NWAVES;
    unsigned char* ws = arg_ws(lds); bf16_t* HP = (bf16_t*)(ws + WS_HP); bf16_t* ACMP = (bf16_t*)(ws + WS_ACMP);
    const float* qna = arg_in(lds, I_QNA) + l * HD; const float* kna = arg_in(lds, I_KNA) + l * HD; const float* qnn = arg_in(lds, I_QNN) + l * HD; const float* knn = arg_in(lds, I_KNN) + l * HD;
    const float* pos = arg_in(lds, I_POS) + (size_t)l * 32 * HD;
    const int e0 = (lane & 15) * 8;
    const f32x4 ga0 = *(const f32x4*)(kna + e0), ga1 = *(const f32x4*)(kna + e0 + 4), gn0 = *(const f32x4*)(knn + e0), gn1 = *(const f32x4*)(knn + e0 + 4);
    for (int m = gw; m < NTOK; m += NGW) {
        bf16_t* prow = HP + (size_t)m * PC;
        const int jt = m & 15;
        const f32x4 pa0 = *(const f32x4*)(pos + jt * HD + e0), pa1 = *(const f32x4*)(pos + jt * HD + e0 + 4), pb0 = *(const f32x4*)(pos + (jt + 16) * HD + e0), pb1 = *(const f32x4*)(pos + (jt + 16) * HD + e0 + 4);
        int cols[3]; u32x4 wl[3];
#pragma unroll
        for (int ch = 0; ch < 3; ++ch) { cols[ch] = (ch < 2) ? C_KA + ch * 512 + lane * 8 : (lane < 32 ? C_KS + lane * 8 : C_KW + (lane - 32) * 8);
            wl[ch] = *(const u32x4*)(prow + cols[ch]); }
        const u32x4 wcv = *(const u32x4*)(prow + C_KC + lane * 8);
#pragma unroll
        for (int ch = 0; ch < 3; ++ch) {
            const float sc = 1.f;
            const u32x4 w = wl[ch];
            float v[8] = {bflo(w.x), bfhi(w.x), bflo(w.y), bfhi(w.y), bflo(w.z), bfhi(w.z), bflo(w.w), bfhi(w.w)};
            float s = 0.f;
#pragma unroll
            for (int i = 0; i < 8; ++i) s += v[i] * v[i];
            s += shx(s, 1, lane); s += shx(s, 2, lane); s += shx(s, 4, lane); s += shx(s, 8, lane);
            const float rs = sc / sqrtf(s * (1.f / HD) + EPS);
            const f32x4 g0 = (ch < 2) ? ga0 : gn0, g1 = (ch < 2) ? ga1 : gn1;
            u32x4 o; o.x = cvtpk(v[0] * rs * g0.x, v[1] * rs * g0.y); o.y = cvtpk(v[2] * rs * g0.z, v[3] * rs * g0.w); o.z = cvtpk(v[4] * rs * g1.x, v[5] * rs * g1.y); o.w = cvtpk(v[6] * rs * g1.z, v[7] * rs * g1.w);
            *(u32x4*)(prow + cols[ch]) = o;
        }
        { const int b = m / SEQ, t = m % SEQ, kv = lane >> 5, gg = (lane >> 4) & 1, c1 = t >> 4, j1 = t & 15;
          const u32x4 w = wcv;
          const float v[8] = {bflo(w.x), bfhi(w.x), bflo(w.y), bfhi(w.y), bflo(w.z), bfhi(w.z), bflo(w.w), bfhi(w.w)};
          const int arow0 = kv * 4096 + (b * 2 + gg) * 512;
          if (c1 <= 510) { const f32x4 p0 = pa0, p1 = pa1;
              u32x4 o; o.x = cvtpk(v[0] + p0.x, v[1] + p0.y); o.y = cvtpk(v[2] + p0.z, v[3] + p0.w); o.z = cvtpk(v[4] + p1.x, v[5] + p1.y); o.w = cvtpk(v[6] + p1.z, v[7] + p1.w);
              *(u32x4*)(ACMP + kt_off(arow0 + c1, j1 * HD + e0, 4096)) = o; }
          else { const u32x4 z = {0u, 0u, 0u, 0u}; *(u32x4*)(ACMP + kt_off(arow0 + 511, j1 * HD + e0, 4096)) = z; *(u32x4*)(ACMP + kt_off(arow0 + 511, (j1 + 16) * HD + e0, 4096)) = z; }
          if (c1 >= 1) { const int j2 = j1 + 16; const f32x4 p0 = pb0, p1 = pb1;
              u32x4 o; o.x = cvtpk(v[0] + p0.x, v[1] + p0.y); o.y = cvtpk(v[2] + p0.z, v[3] + p0.w); o.z = cvtpk(v[4] + p1.x, v[5] + p1.y); o.w = cvtpk(v[6] + p1.z, v[7] + p1.w);
              *(u32x4*)(ACMP + kt_off(arow0 + c1 - 1, j2 * HD + e0, 4096)) = o; } }
    }
}
__device__ __forceinline__ float gelu_tanh(float v) { const float u3 = 0.7978845608028654f * (v + 0.044715f * v * v * v); return 0.5f * v * (2.0f - 2.0f / (__expf(2.0f * u3) + 1.0f)); }
__device__ __forceinline__ void ph_cmp2(LAS unsigned char* lds, int l, const int wv) {
    lds = opq_lds(lds);
    const int tid = opq_tid(wv), lane = tid & 63, wave = __builtin_amdgcn_readfirstlane(tid >> 6), G = opq_g(), bx = opq_bx();
    unsigned char* ws = arg_ws(lds); const float* CP = (const float*)(ws + WS_CP);
    LAS float* CH = (LAS float*)lds;
    LAS float* RED = (LAS float*)(lds + 65536);
    const float* knn = arg_in(lds, I_KNN) + l * HD;
    for (int it = bx; it < 256; it += G) {
        const int R0 = it * 32, kv = R0 >> 12, rl0 = R0 & 4095;
        __syncthreads();
        for (int i4 = tid; i4 < 32 * 128; i4 += NTHR) { const int rr = i4 >> 7, k4 = (i4 & 127) * 4; f32x4 v = {0.f, 0.f, 0.f, 0.f};
#pragma unroll
            for (int ks = 0; ks < 4; ++ks) v = v + *(const f32x4*)(CP + ((size_t)(kv * 4 + ks) * 4096 + rl0 + rr) * 512 + k4);
            f32x4 o; o.x = gelu_tanh(v.x); o.y = gelu_tanh(v.y); o.z = gelu_tanh(v.z); o.w = gelu_tanh(v.w);
            *(LAS f32x4*)(CH + rr * 512 + k4) = o; }
        __syncthreads();
        const int n = tid & 127, rq = tid >> 7;
        const float* w2 = arg_in(lds, kv ? I_CVW2 : I_CKW2) + (size_t)l * 512 * HD + n;
        float acc[8];
#pragma unroll
        for (int i = 0; i < 8; ++i) acc[i] = 0.f;
#pragma unroll 4
        for (int k = 0; k < 512; k += 4) { const float w0 = w2[(size_t)k * HD], w1 = w2[(size_t)(k + 1) * HD], w2v = w2[(size_t)(k + 2) * HD], w3 = w2[(size_t)(k + 3) * HD];
#pragma unroll
            for (int i = 0; i < 8; ++i) { const f32x4 c = *(const LAS f32x4*)(CH + (rq * 8 + i) * 512 + k); acc[i] += (c.x * w0 + c.y * w1) + (c.z * w2v + c.w * w3); } }
        if (kv == 0) {
            float ss[8];
#pragma unroll
            for (int i = 0; i < 8; ++i) ss[i] = wave_sum(acc[i] * acc[i], lane);
            if (lane == 0) {
#pragma unroll
                for (int i = 0; i < 8; ++i) RED[wave * 8 + i] = ss[i]; }
            __syncthreads();
            const float gn = knn[n];
#pragma unroll
            for (int i = 0; i < 8; ++i) { const float tot = RED[(2 * rq) * 8 + i] + RED[(2 * rq + 1) * 8 + i]; acc[i] = acc[i] / sqrtf(tot * (1.f / HD) + EPS) * gn; }
        }
        bf16_t* dst = (bf16_t*)(ws + (kv ? WS_VC + 0 : WS_KC + 0)) + (size_t)(rl0 + rq * 8) * HD + n;
#pragma unroll
        for (int i = 0; i < 8; ++i) dst[(size_t)i * HD] = (bf16_t)f2bf(acc[i]);
    }
}
__device__ __forceinline__ void ph_outnorm(LAS unsigned char* lds, int l, const int wv) {
    lds = opq_lds(lds);
    const int tid = opq_tid(wv), lane = tid & 63, wave = __builtin_amdgcn_readfirstlane(tid >> 6), G = opq_g(), bx = opq_bx();
    const int gw = bx * NWAVES + wave, NGW = G * NWAVES;
    unsigned char* ws = arg_ws(lds); const bf16_t* OA = (const bf16_t*)(ws + WS_OA); const bf16_t* ON = (const bf16_t*)(ws + WS_ON); bf16_t* HB = (bf16_t*)(ws + WS_HP);
    const float* gn = arg_in(lds, I_ON) + (size_t)l * DM;
    const f32x4 ga0 = *(const f32x4*)(gn + lane * 8), ga1 = *(const f32x4*)(gn + lane * 8 + 4), ga2 = *(const f32x4*)(gn + 512 + lane * 8), ga3 = *(const f32x4*)(gn + 512 + lane * 8 + 4);
    const f32x4 gb0 = *(const f32x4*)(gn + 1024 + lane * 8), gb1 = *(const f32x4*)(gn + 1024 + lane * 8 + 4), gb2 = *(const f32x4*)(gn + 1536 + lane * 8), gb3 = *(const f32x4*)(gn + 1536 + lane * 8 + 4);
    for (int m = gw; m < NTOK; m += NGW) {
        const bf16_t* oa = OA + (size_t)m * 1024; bf16_t* y = HB;
        const u32x4 wa = *(const u32x4*)(oa + lane * 8), wb = *(const u32x4*)(oa + 512 + lane * 8);
        u32x4 wn[6];
#pragma unroll
        for (int br = 0; br < 3; ++br) { const bf16_t* onb = ON + ((size_t)br * NTOK + m) * 1024; wn[2 * br] = *(const u32x4*)(onb + lane * 8); wn[2 * br + 1] = *(const u32x4*)(onb + 512 + lane * 8); }
        float va[16] = {bflo(wa.x), bfhi(wa.x), bflo(wa.y), bfhi(wa.y), bflo(wa.z), bfhi(wa.z), bflo(wa.w), bfhi(wa.w), bflo(wb.x), bfhi(wb.x), bflo(wb.y), bfhi(wb.y), bflo(wb.z), bfhi(wb.z), bflo(wb.w), bfhi(wb.w)};
        float sa = 0.f;
#pragma unroll
        for (int i = 0; i < 16; ++i) sa += va[i] * va[i];
        float vs[16]; float sn = 0.f;
#pragma unroll
        for (int i = 0; i < 16; ++i) vs[i] = 0.f;
#pragma unroll
        for (int br = 0; br < 3; ++br) { const u32x4 wc = wn[2 * br], wd = wn[2 * br + 1];
            vs[0] += bflo(wc.x); vs[1] += bfhi(wc.x); vs[2] += bflo(wc.y); vs[3] += bfhi(wc.y); vs[4] += bflo(wc.z); vs[5] += bfhi(wc.z); vs[6] += bflo(wc.w); vs[7] += bfhi(wc.w);
            vs[8] += bflo(wd.x); vs[9] += bfhi(wd.x); vs[10] += bflo(wd.y); vs[11] += bfhi(wd.y); vs[12] += bflo(wd.z); vs[13] += bfhi(wd.z); vs[14] += bflo(wd.w); vs[15] += bfhi(wd.w); }
        const float ra = 1.0f / sqrtf(wave_sum(sa, lane) * (1.f / 1024.f) + EPS);
        { const f32x4 g0 = ga0, g1 = ga1, g2 = ga2, g3 = ga3;
          u32x4 o; o.x = cvtpk(va[0] * ra * g0.x, va[1] * ra * g0.y); o.y = cvtpk(va[2] * ra * g0.z, va[3] * ra * g0.w); o.z = cvtpk(va[4] * ra * g1.x, va[5] * ra * g1.y); o.w = cvtpk(va[6] * ra * g1.z, va[7] * ra * g1.w);
          *(u32x4*)(y + kt_off(m, lane * 8, DM)) = o;
          o.x = cvtpk(va[8] * ra * g2.x, va[9] * ra * g2.y); o.y = cvtpk(va[10] * ra * g2.z, va[11] * ra * g2.w); o.z = cvtpk(va[12] * ra * g3.x, va[13] * ra * g3.y); o.w = cvtpk(va[14] * ra * g3.z, va[15] * ra * g3.w);
          *(u32x4*)(y + kt_off(m, 512 + lane * 8, DM)) = o; }
#pragma unroll
        for (int i = 0; i < 16; ++i) sn += vs[i] * vs[i];
        const float rn = 1.0f / sqrtf(wave_sum(sn, lane) * (1.f / 1024.f) + EPS);
        { const f32x4 g0 = gb0, g1 = gb1, g2a = gb2, g3 = gb3;
          u32x4 o; o.x = cvtpk(vs[0] * rn * g0.x, vs[1] * rn * g0.y); o.y = cvtpk(vs[2] * rn * g0.z, vs[3] * rn * g0.w); o.z = cvtpk(vs[4] * rn * g1.x, vs[5] * rn * g1.y); o.w = cvtpk(vs[6] * rn * g1.z, vs[7] * rn * g1.w);
          *(u32x4*)(y + kt_off(m, 1024 + lane * 8, DM)) = o;
          o.x = cvtpk(vs[8] * rn * g2a.x, vs[9] * rn * g2a.y); o.y = cvtpk(vs[10] * rn * g2a.z, vs[11] * rn * g2a.w); o.z = cvtpk(vs[12] * rn * g3.x, vs[13] * rn * g3.y); o.w = cvtpk(vs[14] * rn * g3.z, vs[15] * rn * g3.w);
          *(u32x4*)(y + kt_off(m, 1536 + lane * 8, DM)) = o; }
    }
}

#define GRID_BAR() do { XcdBarrier bar_; bar_.bar = (unsigned*)(arg_ws(lds) + WS_CTL) + CW_BAR; bar_.x = xb_xcc_id(); bar_.st = (volatile LAS unsigned*)(opq_lds(lds) + LDS_MISC + 32); xcd_barrier(bar_, wv); } while (0)
__global__ void __launch_bounds__(NTHR, 2) mega_fwd(Args a) {
    extern __shared__ __attribute__((aligned(16))) unsigned char lds_raw[];
    LAS unsigned char* lds = (LAS unsigned char*)lds_raw;
    const int wv = __builtin_amdgcn_readfirstlane((int)threadIdx.x >> 6);
    {
        const int tid = threadIdx.x;
        for (int u = tid; u < (LDS_BYTES - LDS_MISC) / 4; u += NTHR) ((LAS unsigned*)(lds + LDS_MISC))[u] = 0u;
        __syncthreads();
        if (tid == 0) { LAS unsigned long long* t = (LAS unsigned long long*)(lds + LDS_ARGS);
#pragma unroll
            for (int i = 0; i < 24; ++i) t[i] = (unsigned long long)(uintptr_t)a.in[i];
            t[24] = (unsigned long long)(uintptr_t)a.out; t[25] = (unsigned long long)(uintptr_t)a.ws; }
        __syncthreads();
    }
    (void)xcd_barrier_post((unsigned*)(arg_ws(lds) + WS_CTL) + CW_BAR, (volatile LAS unsigned*)(lds + LDS_MISC + 32));

    { const int tid = opq_tid(wv), G = opq_g(), bx = opq_bx(); const float* rb = arg_in(lds, I_RB); unsigned char* ws = arg_ws(lds);
      float* dilT = (float*)(ws + WS_TBL); float* nsaT = (float*)(ws + WS_TBL + 65536);
      for (int i = bx * NTHR + tid; i < 3 * 8 * DTS + 8 * TBLS; i += G * NTHR) {
          if (i < 3 * 8 * DTS) { const int p = i / (8 * DTS), h = (i / DTS) % 8, df = i % DTS - DT0; const int d = (p == 0) ? 1 : (p == 1 ? 4 : 16);
              dilT[i] = (df >= 0 && df <= 128) ? rb[rel_bucket_dev(df * d) * 16 + h] : 0.f; }
          else { const int j = i - 3 * 8 * DTS, hh = j / TBLS, ds = j % TBLS - TBL0; nsaT[j] = (ds >= 0) ? rb[rel_bucket_dev(ds) * 16 + 8 + hh] : 0.f; } } }

    ph_prologue(lds, wv);
    GRID_BAR();
#pragma unroll 1
    for (int step = 0; step < 2 * DEPTH; ++step) {
        const int l = step >> 1, half = step & 1;
        { unsigned char* ws = arg_ws(lds); const int G = opq_g(), bx = opq_bx();
          pg8::Gemm g{64, 64, DM}; pg8::SchedStd S; S.init(ws + WS_HB, ws + WS_WUP + (size_t)step * SZ_WUP, NTOK, 2 * DFF, DM, DM, G, bx); const pg8::EpiSwiGLU E{(bf16_t*)(ws + WS_HP), DFF, (const float*)(ws + WS_RSTD)};
          pg8::gemm_phase<pg8::EpiSwiGLU, pg8::SchedStd, 32768, 32768>(opq_lds(lds), g, S, E, wv);
        }
        GRID_BAR();
        { unsigned char* ws = arg_ws(lds); const int G = opq_g(), bx = opq_bx(); float* X = arg_out(lds);
          pg8::Gemm g{64, 64, DFF}; pg8::SchedStd S; S.init(ws + WS_HP, ws + WS_WDN + (size_t)step * SZ_WDN, NTOK, DM, DFF, DFF, G, bx, 4, 1);
          pg8::EpiResid E{(step == 2 * DEPTH - 1) ? X : (float*)nullptr, (bf16_t*)(ws + WS_HB), (float*)(ws + WS_SSQ), DM, 0.5f};
          pg8::gemm_phase<pg8::EpiResid, pg8::SchedStd, 32768, 32768>(opq_lds(lds), g, S, E, wv);
        }
        if (step == 2 * DEPTH - 1) break;
        GRID_BAR();
        ph_rstd(lds, wv);
        GRID_BAR();
        if (half == 0) {
            { unsigned char* ws = arg_ws(lds); const int G = opq_g(), bx = opq_bx();
              pg8::Gemm g{64, 64, DM}; pg8::SchedStd S; S.init(ws + WS_HB, ws + WS_WIN + (size_t)l * SZ_WIN, NTOK, PC, DM, DM, G, bx); const pg8::EpiBf16 E{(bf16_t*)(ws + WS_HP), PC, (const float*)(ws + WS_RSTD)};
              pg8::gemm_phase<pg8::EpiBf16, pg8::SchedStd, 32768, 32768>(opq_lds(lds), g, S, E, wv);
            }
            GRID_BAR();
            ph_headnorm(lds, l, wv);
            GRID_BAR();
#pragma unroll 1
            for (int pat3 = 0; pat3 < 3; ++pat3) { const int pat = pat3 % 3;
                if (pat3 == 0) { unsigned char* ws = arg_ws(lds); const int G = opq_g(), bx = opq_bx();
                  pg8::Gemm g{64, 64, 1024}; pg8::SchedCmp S; S.A = (const char*)(ws + WS_ACMP); S.Bt = (const char*)(ws + WS_WC1 + (size_t)l * SZ_WC1); S.G = G; S.c = bx; pg8::EpiF32Z E{(float*)(ws + WS_CP), 512, (size_t)4096 * 512};
                  pg8::gemm_phase<pg8::EpiF32Z, pg8::SchedCmp, 32768, 32768>(opq_lds(lds), g, S, E, wv); }
                if (pat3 == 1) ph_cmp2(lds, l, wv);
                { unsigned char* ws = arg_ws(lds); const int G = opq_g(), bx = opq_bx();
                  for (int u0 = bx; u0 < 1024; u0 += G) { const int w_ = u0 & 255, k_ = u0 >> 8; const int unit = (((w_ & 7) + 8 * k_) << 5) | (w_ >> 3);
                    dil_unit((LAS char*)opq_lds(lds), (const bf16_t*)(ws + WS_HP), (bf16_t*)(ws + WS_OA), (float*)(ws + WS_LSE), (const float*)(ws + WS_TBL), arg_in(lds, I_QNA) + l * HD, pat, 2 * pat, unit, wv); } }
                if (pat3 + 1 < 3) GRID_BAR();
            }
            { unsigned char* ws = arg_ws(lds); const int G = opq_g(), bx = opq_bx();
              const float* gb = arg_in(lds, I_GB) + l * 24; const float* qgn = arg_in(lds, I_QNN) + l * HD;
              int last_bg = -1;
#pragma unroll 1
              for (int i4 = 0; i4 < 4; ++i4)
#pragma unroll 1
                  for (int w = bx; w < 256; w += G) { const int i = i4 & 3; const int bg = w & 7, j = w >> 3;
                      const int qi = (i == 0) ? 127 - j : (i == 1 ? j : (i == 2 ? 64 + j : 63 - j));
                      nsa_unit((LAS char*)opq_lds(lds), (const bf16_t*)(ws + WS_HP), (const bf16_t*)(ws + WS_KC), (const bf16_t*)(ws + WS_VC), (bf16_t*)(ws + WS_ON), (const float*)(ws + WS_TBL + 65536), gb, qgn, bg >> 1, bg & 1, qi, bg != last_bg, wv); last_bg = bg; } }
            GRID_BAR();
            ph_outnorm(lds, l, wv);
            GRID_BAR();
            { unsigned char* ws = arg_ws(lds); const int G = opq_g(), bx = opq_bx(); float* X = arg_out(lds);
              pg8::Gemm g{64, 64, DM}; pg8::SchedStd S; S.init(ws + WS_HP, ws + WS_WOUT + (size_t)l * SZ_WOUT, NTOK, DM, DM, DM, G, bx, 4); pg8::EpiResid E{(float*)nullptr, (bf16_t*)(ws + WS_HB), (float*)(ws + WS_SSQ), DM, 1.0f};
              pg8::gemm_phase<pg8::EpiResid, pg8::SchedStd, 32768, 32768>(opq_lds(lds), g, S, E, wv);
            }
            GRID_BAR();
            ph_rstd(lds, wv);
            GRID_BAR();
        }
    }
}

extern "C" void kernel_launch(void* const* d_in, const int* in_sizes, int n_in, void* d_out, int out_size, void* d_ws, size_t ws_size, hipStream_t stream) {
    static int grid = 0;
    if (grid == 0) {
        if (n_in != 24 || in_sizes[0] != NTOK * DM || out_size != NTOK * DM || ws_size < WS_END) { fprintf(stderr, "kernel_launch: shape mismatch n_in %d in0 %d out %d ws %zu (need %zu)\n", n_in, n_in > 0 ? in_sizes[0] : -1, out_size, ws_size, (size_t)WS_END); grid = -1; return; }
        int dev = 0, cus = 0, per_cu = 0;
        if (hipGetDevice(&dev) != hipSuccess || hipDeviceGetAttribute(&cus, hipDeviceAttributeMultiprocessorCount, dev) != hipSuccess) { grid = -1; return; }
        if (hipFuncSetAttribute((const void*)mega_fwd, hipFuncAttributeMaxDynamicSharedMemorySize, LDS_BYTES) != hipSuccess) { fprintf(stderr, "kernel_launch: hipFuncSetAttribute failed\n"); grid = -1; return; }
        if (hipOccupancyMaxActiveBlocksPerMultiprocessor(&per_cu, (const void*)mega_fwd, NTHR, LDS_BYTES) != hipSuccess || per_cu < 1) { fprintf(stderr, "kernel_launch: occupancy query says %d\n", per_cu); (void)hipGetLastError(); if (per_cu < 1) { grid = -1; return; } }
        grid = cus;
    }
    if (grid < 0) return;
    if (hipMemsetAsync((char*)d_ws + WS_CTL, 0, CTL_ZERO_BYTES, stream) != hipSuccess) return;
    Args a{};
    for (int i = 0; i < 24; ++i) a.in[i] = (const float*)d_in[i];
    a.out = (float*)d_out; a.ws = (unsigned char*)d_ws;
    hipLaunchKernelGGL(mega_fwd, dim3(grid), dim3(NTHR), LDS_BYTES, stream, a);
    const hipError_t le = hipPeekAtLastError();
    if (le != hipSuccess) fprintf(stderr, "kernel_launch: launch failed: %s\n", hipGetErrorName(le));
}
```

```cpp
#include <hip/hip_runtime.h>
#include <cstdio>
#include <cstdint>

#define LAS __attribute__((address_space(3)))
typedef unsigned short bf16_t;
typedef short bf16x8 __attribute__((ext_vector_type(8)));
typedef short s16x4 __attribute__((ext_vector_type(4)));
typedef float f32x2 __attribute__((ext_vector_type(2)));
typedef float f32x4 __attribute__((ext_vector_type(4)));
typedef float f32x16 __attribute__((ext_vector_type(16)));
typedef unsigned u32x2 __attribute__((ext_vector_type(2)));
typedef unsigned u32x4 __attribute__((ext_vector_type(4)));

constexpr int BATCH = 4, SEQ = 8192, DM = 2048, DFF = 5632, NTOK = BATCH * SEQ, DEPTH = 4, HD = 128;
constexpr int IN_COLS = 5656, PC = 5888;
constexpr int C_QA = 0, C_KA = 1024, C_VA = 2048, C_QN = 3072, C_KC = 4096, C_VC = 4352, C_KS = 4608, C_VS = 4864, C_KW = 5120, C_VW = 5376, C_GL = 5632;
constexpr float EPS = 1e-6f, QSCALE = 0.08838834764831845f, LOG2E = 1.4426950408889634f;
constexpr int TBLS = 1704, TBL0 = 64;
constexpr int DTS = 320, DT0 = 96;
constexpr int NWAVES = 8, NTHR = 512;

constexpr size_t MiB = 1u << 20;
constexpr size_t WS_CTL = 0, CTL_ZERO_BYTES = 1 * MiB;
constexpr size_t WS_TBL = 1 * MiB;
constexpr size_t SZ_WUP = 44 * MiB, SZ_WDN = 22 * MiB, SZ_WIN = 23 * MiB, SZ_WOUT = 8 * MiB, SZ_WC1 = 8 * MiB;
constexpr size_t WS_WUP = 2 * MiB;
constexpr size_t WS_WDN = WS_WUP + 8 * SZ_WUP;
constexpr size_t WS_WIN = WS_WDN + 8 * SZ_WDN;
constexpr size_t WS_WOUT = WS_WIN + 4 * SZ_WIN;
constexpr size_t WS_WC1 = WS_WOUT + 4 * SZ_WOUT;
constexpr size_t WS_HB = WS_WC1 + 4 * SZ_WC1;
constexpr size_t WS_HP = WS_HB + 128 * MiB;
constexpr size_t WS_OA = WS_HP + 368 * MiB;
constexpr size_t WS_LSE = WS_OA + 64 * MiB;
constexpr size_t WS_ON = WS_LSE + 1 * MiB;
constexpr size_t WS_ACMP = WS_ON + 192 * MiB;
constexpr size_t WS_CP = WS_ACMP + 64 * MiB;
constexpr size_t WS_KC = WS_CP + 64 * MiB;
constexpr size_t WS_VC = WS_KC + 1 * MiB;
constexpr size_t WS_SSQ = WS_VC + 1 * MiB;
constexpr size_t WS_RSTD = WS_SSQ + 4 * MiB;
constexpr size_t WS_END = WS_RSTD + 1 * MiB;
constexpr int CW_BAR = 4096;

__device__ __forceinline__ unsigned f2bf(float f) { unsigned u = __builtin_bit_cast(unsigned, f); return (u + 0x7fffu + ((u >> 16) & 1u)) >> 16; }
__device__ __forceinline__ unsigned pk2(float lo, float hi) { return f2bf(lo) | (f2bf(hi) << 16); }
__device__ __forceinline__ float bf2f(bf16_t b) { return __builtin_bit_cast(float, ((unsigned)b) << 16); }
__device__ __forceinline__ float bflo(unsigned w) { return __builtin_bit_cast(float, w << 16); }
__device__ __forceinline__ float bfhi(unsigned w) { return __builtin_bit_cast(float, w & 0xffff0000u); }
__device__ __forceinline__ unsigned cvtpk(float lo, float hi) { unsigned r; asm volatile("v_cvt_pk_bf16_f32 %0, %1, %2" : "=v"(r) : "v"(lo), "v"(hi)); return r; }
__device__ __forceinline__ float shx(float v, int m, int lane) { return __builtin_bit_cast(float, __builtin_amdgcn_ds_bpermute((lane ^ m) << 2, __builtin_bit_cast(int, v))); }
__device__ __forceinline__ float wave_sum(float v, int lane) {
#pragma unroll
    for (int o = 1; o < 64; o <<= 1) v += shx(v, o, lane);
    return v;
}
__device__ __forceinline__ LAS unsigned char* opq_lds(LAS unsigned char* p) { unsigned a = (unsigned)(uintptr_t)p; asm volatile("" : "+s"(a)); return (LAS unsigned char*)(uintptr_t)a; }
__device__ __forceinline__ int opq_tid(int wv) { int l; asm volatile("v_mbcnt_lo_u32_b32 %0, -1, 0\n\tv_mbcnt_hi_u32_b32 %0, -1, %0" : "=v"(l)); return wv * 64 + l; }
__device__ __forceinline__ size_t kt_off(int r, int k, int K) { return (((size_t)(r >> 8) * (K >> 6) + (k >> 6)) * 256 + (r & 255)) * 64 + (k & 63); }
#define LDS_WAIT() asm volatile("s_waitcnt lgkmcnt(0)" ::: "memory")
#define VM_WAIT() asm volatile("s_waitcnt vmcnt(0)" ::: "memory")
#define SBAR() __builtin_amdgcn_sched_barrier(0)

#define XB_TMO      128
#define XB_XCNT(j)  (256  + 64 * (j))
#define XB_XSUB(j)  (1280 + 64 * (j))
#define XB_XGEN(j)  (2304 + 64 * (j))
#define XB_TOP      3328
#define XB_TOPGEN   3392
#define XCD_BAR_WORDS 3456
#define XB_SPIN_CAP (1u << 18)
__device__ __forceinline__ unsigned xb_ld(unsigned* p)              { return __hip_atomic_load(p, __ATOMIC_RELAXED, __HIP_MEMORY_SCOPE_AGENT); }
__device__ __forceinline__ unsigned xb_add(unsigned* p, unsigned v) { return __hip_atomic_fetch_add(p, v, __ATOMIC_RELAXED, __HIP_MEMORY_SCOPE_AGENT); }
__device__ __forceinline__ unsigned xb_xcc_id() { return (unsigned)__builtin_amdgcn_s_getreg((3 << 11) | 20) & 0xFu; }
#define XB_SPIN(cond, bar) do { unsigned _sp = 0; while (cond) { __builtin_amdgcn_s_sleep(1); \
    if ((++_sp & 255u) == 0u) { if (xb_ld(&(bar)[XB_TMO])) break; if (_sp > XB_SPIN_CAP) { atomicAdd(&(bar)[XB_TMO], 1u); break; } } } } while (0)
struct XcdBarrier { unsigned* bar; unsigned x; volatile LAS unsigned* st; };
__device__ __forceinline__ XcdBarrier xcd_barrier_post(unsigned* bar, volatile LAS unsigned* st) {
    XcdBarrier b; b.bar = bar; b.x = xb_xcc_id(); b.st = st;
    if (threadIdx.x == 0) (void)xb_add(&bar[XB_XCNT(b.x)], 1u);
    return b;
}
__device__ __forceinline__ void xcd_barrier_complete(unsigned* bar, unsigned x, unsigned& nloc, unsigned& nx) {
    const unsigned G = gridDim.x * gridDim.y * gridDim.z;
    unsigned sum, cnt, mine, sp = 0u;
    for (;;) {
        sum = 0u; cnt = 0u; mine = 0u;
#pragma unroll
        for (unsigned j = 0; j < 16; ++j) { const unsigned c = xb_ld(&bar[XB_XCNT(j)]); sum += c; cnt += (c > 0u) ? 1u : 0u; mine = (j == x) ? c : mine; }
        if (sum == G) break;
        __builtin_amdgcn_s_sleep(1);
        if ((++sp & 255u) == 0u) { if (xb_ld(&bar[XB_TMO])) break; if (sp > XB_SPIN_CAP) { atomicAdd(&bar[XB_TMO], 1u); break; } }
    }
    nloc = mine > 0u ? mine : 1u; nx = cnt > 0u ? cnt : 1u;
}
__device__ __forceinline__ void xcd_barrier(const XcdBarrier& b, const int wv) {
    asm volatile("s_waitcnt vmcnt(0)" ::: "memory");
    __syncthreads();
    if (opq_tid(wv) == 0) {
        unsigned* bar = b.bar; asm volatile("" : "+s"(bar));
        __builtin_amdgcn_s_waitcnt(0);
        unsigned nloc = b.st[0], nx = b.st[1];
        if (nloc == 0u) { xcd_barrier_complete(bar, b.x, nloc, nx); b.st[0] = nloc; b.st[1] = nx; }
        const unsigned old = xb_add(&bar[XB_XSUB(b.x)], 1u);
        const unsigned gen = old / nloc;
        if (old + 1u == (gen + 1u) * nloc) {
            __builtin_amdgcn_fence(__ATOMIC_RELEASE, "agent");
            asm volatile("s_waitcnt vmcnt(0)" ::: "memory");
            const unsigned og = xb_add(&bar[XB_TOP], 1u);
            const unsigned tg = og / nx;
            if (og + 1u == (tg + 1u) * nx) xb_add(&bar[XB_TOPGEN], 1u);
            else XB_SPIN(xb_ld(&bar[XB_TOPGEN]) == tg, bar);
            __builtin_amdgcn_fence(__ATOMIC_ACQUIRE, "agent");
            xb_add(&bar[XB_XGEN(b.x)], 1u);
            asm volatile("s_waitcnt vmcnt(0)" ::: "memory");
        } else {
            XB_SPIN(xb_ld(&bar[XB_XGEN(b.x)]) == gen, bar);
            __builtin_amdgcn_fence(__ATOMIC_ACQUIRE, "agent");
            asm volatile("s_waitcnt vmcnt(0)" ::: "memory");
        }
    }
    __syncthreads();
}

namespace pg8 {
constexpr int BM = 256, BK = 64, HALF = 128, HTB = HALF * BK * 2, STAGE_BYTES = 8 * HTB, NXCD = 8, WGM = 8;
__host__ __device__ __forceinline__ int lds_byte(int r, int c) { const int st = (r >> 4) * 2 + (c >> 5), rr = r & 15, cc = c & 31, ob = rr * 64 + cc * 2; return st * 1024 + (ob ^ (((ob >> 9) & 1) << 5)); }
__host__ __device__ __forceinline__ void stage_rc(int b, int& R, int& C) { const int st = b / 1024, sb = b % 1024, swz = sb ^ (((sb >> 9) & 1) << 5); R = (st >> 1) * 16 + swz / 64; C = (st & 1) * 32 + (swz % 64) / 2; }
__host__ __device__ __forceinline__ int perm32(int rho) { const int n = rho >> 4, i = rho & 15; return 8 * (i >> 2) + 4 * n + (i & 3); }
struct Unit { int pm, pn, z; };
struct Gemm { int lda, ldb, K; };
struct SchedStd {
    const char* A; const char* Bt; size_t atile, btile; int nM, nN, nwg, G, c, wgm, flip;
    __device__ __forceinline__ void init(const void* A_, const void* Bt_, int M, int N, int lda, int ldb, int G_, int c_, int wgm_ = WGM, int flip_ = 0) { wgm = wgm_; flip = flip_;
        A = (const char*)A_; Bt = (const char*)Bt_; atile = (size_t)BM * lda * 2; btile = (size_t)BM * ldb * 2; nM = M / BM; nN = N / BM; nwg = nM * nN; G = G_; c = c_; }
    __device__ __forceinline__ bool next(int i, Unit& u) const {
        const long L = (long)i * G + c; if (L >= nwg) return false;
        int wgid = (int)L; { const int q = nwg / NXCD, r = nwg % NXCD, xcd = wgid % NXCD, off = wgid / NXCD; wgid = (xcd < r ? xcd * (q + 1) : r * (q + 1) + (xcd - r) * q) + off; }
        const int nig = wgm * nN, gid = wgid / nig, fm = gid * wgm, gsz = (nM - fm) < wgm ? (nM - fm) : wgm;
        u.pm = fm + ((wgid % nig) % gsz); u.pn = (wgid % nig) / gsz; u.z = 0; if (flip) u.pm = nM - 1 - u.pm; return true;
    }
    __device__ __forceinline__ const char* a_ptr(const Unit& u) const { return A + (size_t)u.pm * atile; }
    __device__ __forceinline__ const char* b_ptr(const Unit& u) const { return Bt + (size_t)u.pn * btile; }
};
struct SchedCmp {
    const char* A; const char* Bt; int G, c;
    __device__ __forceinline__ bool next(int i, Unit& u) const { const int L = i * G + c; if (L >= 256) return false; u.z = L >> 5; u.pm = (L & 31) >> 1; u.pn = L & 1; return true; }
    __device__ __forceinline__ const char* a_ptr(const Unit& u) const { const int kv = u.z >> 2, ks = u.z & 3; return A + ((size_t)(kv * 16 + u.pm) * 64 + (size_t)ks * 16) * 32768; }
    __device__ __forceinline__ const char* b_ptr(const Unit& u) const { const int kv = u.z >> 2, ks = u.z & 3; return Bt + ((size_t)(kv * 2 + u.pn) * 64 + (size_t)ks * 16) * 32768; }
};
struct EpiBf16 {
    static constexpr bool PERM = true;
    static constexpr bool ROWS = true;
    bf16_t* O; int ldc; const float* ssq;
    __device__ __forceinline__ void operator()(const f32x4 (&acc)[2][2][4][2], const Unit& u, int wr, int wc, int fr, int fq, const float (&pre)[8]) const {
        const int row0 = u.pm * BM + wr * 64 + fr, col0 = u.pn * BM + wc * 32 + 8 * fq;
#pragma unroll
        for (int ai = 0; ai < 2; ++ai)
#pragma unroll
            for (int m = 0; m < 4; ++m) { bf16_t* rowp = O + (size_t)(row0 + ai * HALF + m * 16) * ldc + col0; const float rs = pre[ai * 4 + m];
#pragma unroll
                for (int bj = 0; bj < 2; ++bj) { const f32x4 v0 = acc[ai][bj][m][0] * rs, v1 = acc[ai][bj][m][1] * rs;
                    u32x4 w; w.x = cvtpk(v0[0], v0[1]); w.y = cvtpk(v0[2], v0[3]); w.z = cvtpk(v1[0], v1[1]); w.w = cvtpk(v1[2], v1[3]);
                    *(u32x4*)(rowp + bj * HALF) = w; } }
    }
};
struct EpiSwiGLU {
    static constexpr bool PERM = true;
    static constexpr bool ROWS = true;
    bf16_t* O; int ldc; const float* ssq;
    __device__ __forceinline__ void operator()(const f32x4 (&acc)[2][2][4][2], const Unit& u, int wr, int wc, int fr, int fq, const float (&pre)[8]) const {
        const int rowp0 = wr * 64 + fr, kt = 2 * u.pn + (wc >> 1), cit = (wc & 1) * 32 + 8 * fq;
        bf16_t* tile = O + ((size_t)u.pm * (ldc / 64) + kt) * (256 * 64) + cit;
#pragma unroll
        for (int ai = 0; ai < 2; ++ai)
#pragma unroll
            for (int m = 0; m < 4; ++m) { bf16_t* rowp = tile + (size_t)(rowp0 + ai * HALF + m * 16) * 64; const float rs = pre[ai * 4 + m];
                float v[8];
#pragma unroll
                for (int n = 0; n < 2; ++n)
#pragma unroll
                    for (int j = 0; j < 4; ++j) { const float g = acc[ai][0][m][n][j] * rs, up = acc[ai][1][m][n][j] * rs;
                        const float s = g * __builtin_amdgcn_rcpf(1.0f + __builtin_amdgcn_exp2f(-g * LOG2E)); v[n * 4 + j] = s * up; }
                u32x4 w; w.x = cvtpk(v[0], v[1]); w.y = cvtpk(v[2], v[3]); w.z = cvtpk(v[4], v[5]); w.w = cvtpk(v[6], v[7]);
                *(u32x4*)rowp = w; }
    }
};
struct EpiResid {
    static constexpr bool PERM = false;
    static constexpr bool ROWS = false;
    float* out; bf16_t* xb; float* ssq; int ldc; float alpha;
    __device__ __forceinline__ void operator()(const f32x4 (&acc)[2][2][4][2], const Unit& u, int wr, int wc, int fr, int fq, const float (&pre)[8]) const {
        const int row0 = u.pm * BM + wr * 64 + fr, col0 = u.pn * BM + wc * 32 + 4 * fq;
        u32x2 bs[4][4];
#define ER_LOAD(g) do { const int row_ = row0 + ((g) >> 2) * HALF + ((g) & 3) * 16; \
        _Pragma("unroll") for (int q_ = 0; q_ < 4; ++q_) bs[(g) & 3][q_] = *(const u32x2*)(xb + kt_off(row_, col0 + (q_ >> 1) * HALF + (q_ & 1) * 16, ldc)); } while (0)
        ER_LOAD(0); ER_LOAD(1); ER_LOAD(2); ER_LOAD(3);
#pragma unroll
        for (int g = 0; g < 8; ++g) { const int ai = g >> 2, m = g & 3; const int row = row0 + ai * HALF + m * 16; float ss = 0.f;
#pragma unroll
            for (int q = 0; q < 4; ++q) { const int bj = q >> 1, n = q & 1; const u32x2 b = bs[g & 3][q];
                const f32x4 o = (f32x4){bflo(b.x), bfhi(b.x), bflo(b.y), bfhi(b.y)} + acc[ai][bj][m][n] * alpha;
                ss += (o.x * o.x + o.y * o.y) + (o.z * o.z + o.w * o.w);
                u32x2 w; w.x = cvtpk(o.x, o.y); w.y = cvtpk(o.z, o.w); *(u32x2*)(xb + kt_off(row, col0 + bj * HALF + n * 16, ldc)) = w;
                if (out) *(f32x4*)(out + (size_t)row * ldc + col0 + bj * HALF + n * 16) = o; }
            if (g + 4 < 8) ER_LOAD(g + 4);
            const int lane = fq * 16 + fr; ss += shx(ss, 16, lane); ss += shx(ss, 32, lane);
            if (fq == 0) ssq[(size_t)row * 32 + u.pn * 4 + wc] = ss; }
#undef ER_LOAD
    }
};
struct EpiF32Z {
    static constexpr bool PERM = false;
    float* C; int ldc; size_t zstride;
    static constexpr bool ROWS = false;
    __device__ __forceinline__ void operator()(const f32x4 (&acc)[2][2][4][2], const Unit& u, int wr, int wc, int fr, int fq, const float (&pre)[8]) const {
        float* Cz = C + (size_t)u.z * zstride;
        const int row0 = u.pm * BM + wr * 64 + fr, col0 = u.pn * BM + wc * 32 + 4 * fq;
#pragma unroll
        for (int ai = 0; ai < 2; ++ai)
#pragma unroll
            for (int m = 0; m < 4; ++m) { float* rowp = Cz + (size_t)(row0 + ai * HALF + m * 16) * ldc + col0;
#pragma unroll
                for (int bj = 0; bj < 2; ++bj)
#pragma unroll
                    for (int n = 0; n < 2; ++n) *(f32x4*)(rowp + bj * HALF + n * 16) = acc[ai][bj][m][n]; }
    }
};

constexpr int RS_LDS = 131072 + 1024;
__device__ __forceinline__ void rows_to_lds(LAS unsigned char* lds, const float* ssq, int pm, int slot, int tid) {
    const int row = tid >> 1, half = tid & 1;
    const f32x4* p = (const f32x4*)(ssq + ((size_t)pm * BM + row) * 32 + half * 16);
    f32x4 a = p[0]; a = a + p[1]; a = a + p[2]; a = a + p[3];
    float s = (a.x + a.y) + (a.z + a.w); s += shx(s, 1, tid & 63);
    const float rs = 1.0f / sqrtf(s * (1.f / 2048.f) + 1e-6f);
    if (half == 0) *(LAS float*)(lds + RS_LDS + slot * 1024 + row * 4) = rs;
}
template <class Epi, class Sched, int KSTEP_A = 128, int KSTEP_B = 128>
__device__ __forceinline__ void gemm_phase(LAS unsigned char* lds, const Gemm g, const Sched& S, const Epi& E, const int wv) {
    const int tid = opq_tid(wv), wid = __builtin_amdgcn_readfirstlane(tid >> 6), lane = tid & 63, wr = wid >> 2, wc = wid & 3, fr = lane & 15, fq = lane >> 4;
    const int K = g.K, nt = K / BK;
    unsigned voffA[2], voffB[2];
#pragma unroll
    for (int i = 0; i < 2; ++i) { int R, C; stage_rc(tid * 16 + i * 8192, R, C); const int Rb = Epi::PERM ? ((R & ~31) + perm32(R & 31)) : R;
        voffA[i] = (unsigned)(R * g.lda + C) * 2u; voffB[i] = (unsigned)(Rb * g.ldb + C) * 2u; }
    constexpr size_t kstepA = (size_t)KSTEP_A, kstepB = (size_t)KSTEP_B;
    const size_t hstepA = (size_t)HALF * g.lda * 2, hstepB = (size_t)HALF * g.ldb * 2;
    const unsigned ldsw = (unsigned)wid * 1024u;
    const int aoff = lds_byte(wr * 64 + fr, fq * 8), boff = lds_byte(wc * 32 + fr, fq * 8);
#define PG8_SA(b, h) (((b) * 2 + (h)) * HTB)
#define PG8_SB(b, h) ((4 + (b) * 2 + (h)) * HTB)
#define PG8_STAGE(bufoff, gbase, voff) do { _Pragma("unroll") for (int _i = 0; _i < 2; ++_i) \
        __builtin_amdgcn_global_load_lds((const unsigned*)((const char*)(gbase) + (voff)[_i]), (LAS unsigned*)(lds + (bufoff) + ldsw + _i * 8192), 16, 0, 0); } while (0)
#define PG8_LDA(dst, b, h) do { _Pragma("unroll") for (int m = 0; m < 4; ++m) _Pragma("unroll") for (int k = 0; k < 2; ++k) dst[m][k] = *(const LAS bf16x8*)(lds + PG8_SA(b, h) + aoff + m * 2048 + k * 1024); } while (0)
#define PG8_LDB(dst, b, h) do { _Pragma("unroll") for (int n = 0; n < 2; ++n) _Pragma("unroll") for (int k = 0; k < 2; ++k) dst[n][k] = *(const LAS bf16x8*)(lds + PG8_SB(b, h) + boff + n * 2048 + k * 1024); } while (0)
#define PG8_MMA(ai, bj, At, Bt) do { __builtin_amdgcn_s_setprio(1); _Pragma("unroll") for (int m = 0; m < 4; ++m) _Pragma("unroll") for (int n = 0; n < 2; ++n) _Pragma("unroll") for (int k = 0; k < 2; ++k) \
        acc[ai][bj][m][n] = __builtin_amdgcn_mfma_f32_16x16x32_bf16(Bt[n][k], At[m][k], acc[ai][bj][m][n], 0, 0, 0); __builtin_amdgcn_s_setprio(0); } while (0)
#define PG8_WAIT_V(n) asm volatile("s_waitcnt vmcnt(" #n ")" ::: "memory")
#define PG8_WAIT_L(n) asm volatile("s_waitcnt lgkmcnt(" #n ")" ::: "memory")
#define PG8_BAR __builtin_amdgcn_s_barrier()
#define PG8_SCHED __builtin_amdgcn_sched_barrier(0)
    Unit cur, nxt; int ui = 0;
    if (!S.next(0, cur)) return;
    f32x4 acc[2][2][4][2];
#pragma unroll
    for (int a = 0; a < 2; ++a)
#pragma unroll
        for (int b = 0; b < 2; ++b)
#pragma unroll
            for (int m = 0; m < 4; ++m)
#pragma unroll
                for (int n = 0; n < 2; ++n) acc[a][b][m][n] = (f32x4){0.f, 0.f, 0.f, 0.f};
    bf16x8 At[4][2], B0[2][2], B1[2][2];
    const char* cA = S.a_ptr(cur); const char* cB = S.b_ptr(cur);
    float pre[8]; int rslot = 0; if constexpr (Epi::ROWS) rows_to_lds(lds, E.ssq, cur.pm, 0, tid);
    PG8_STAGE(PG8_SB(0, 0), cB, voffB); PG8_STAGE(PG8_SA(0, 0), cA, voffA); PG8_STAGE(PG8_SB(0, 1), cB + hstepB, voffB); PG8_STAGE(PG8_SA(0, 1), cA + hstepA, voffA);
    if (wr == 1) PG8_BAR;
    PG8_WAIT_V(4); PG8_BAR;
    PG8_STAGE(PG8_SB(1, 0), cB + kstepB, voffB); PG8_STAGE(PG8_SA(1, 0), cA + kstepA, voffA); PG8_STAGE(PG8_SB(1, 1), cB + hstepB + kstepB, voffB);
    PG8_WAIT_V(6); PG8_BAR;
    for (;;) {
        const bool has_next = S.next(ui + 1, nxt);
        const char* nA = has_next ? S.a_ptr(nxt) : cA; const char* nB = has_next ? S.b_ptr(nxt) : cB;
        for (int t = 0; t < nt; t += 2) {
            const bool last = (t == nt - 2);
            const char* a1 = cA + (size_t)(t + 1) * kstepA;
            const char* a2 = last ? nA : cA + (size_t)(t + 2) * kstepA; const char* b2 = last ? nB : cB + (size_t)(t + 2) * kstepB;
            const char* a3 = a2 + kstepA; const char* b3 = b2 + kstepB;
            PG8_LDB(B0, 0, 0); PG8_SCHED; PG8_LDA(At, 0, 0); PG8_STAGE(PG8_SA(1, 1), a1 + hstepA, voffA);
            PG8_WAIT_L(8); PG8_BAR; PG8_WAIT_L(0); PG8_MMA(0, 0, At, B0); PG8_BAR; PG8_SCHED;
            PG8_LDB(B1, 0, 1); PG8_STAGE(PG8_SB(0, 0), b2, voffB);
            PG8_BAR; PG8_WAIT_L(0); PG8_MMA(0, 1, At, B1); PG8_BAR;
            PG8_LDA(At, 0, 1); PG8_STAGE(PG8_SA(0, 0), a2, voffA);
            PG8_BAR; PG8_WAIT_L(0); PG8_MMA(1, 0, At, B0); PG8_BAR; PG8_SCHED;
            PG8_STAGE(PG8_SB(0, 1), b2 + hstepB, voffB);
            PG8_WAIT_V(6); PG8_BAR; PG8_MMA(1, 1, At, B1); PG8_BAR;
            PG8_LDB(B0, 1, 0); PG8_SCHED; PG8_LDA(At, 1, 0); PG8_STAGE(PG8_SA(0, 1), a2 + hstepA, voffA);
            PG8_WAIT_L(8); PG8_BAR; PG8_WAIT_L(0); PG8_MMA(0, 0, At, B0); PG8_BAR; PG8_SCHED;
            PG8_LDB(B1, 1, 1); PG8_STAGE(PG8_SB(1, 0), b3, voffB);
            PG8_BAR; PG8_WAIT_L(0); PG8_MMA(0, 1, At, B1); PG8_BAR;
            PG8_LDA(At, 1, 1); PG8_STAGE(PG8_SA(1, 0), a3, voffA);
            PG8_BAR; PG8_WAIT_L(0); PG8_MMA(1, 0, At, B0); PG8_BAR; PG8_SCHED;
            PG8_STAGE(PG8_SB(1, 1), b3 + hstepB, voffB);
            PG8_WAIT_V(6); PG8_BAR; PG8_MMA(1, 1, At, B1); PG8_BAR;
        }
        if constexpr (Epi::ROWS) {
#pragma unroll
            for (int i = 0; i < 8; ++i) pre[i] = *(const LAS float*)(lds + RS_LDS + rslot * 1024 + (wr * 64 + fr + (i >> 2) * HALF + (i & 3) * 16) * 4); }
        E(acc, cur, wr, wc, fr, fq, pre);
        if constexpr (Epi::ROWS) { if (has_next && nxt.pm != cur.pm) { rslot ^= 1; rows_to_lds(lds, E.ssq, nxt.pm, rslot, tid); } }
        if (!has_next) break;
#pragma unroll
        for (int a = 0; a < 2; ++a)
#pragma unroll
            for (int b = 0; b < 2; ++b)
#pragma unroll
                for (int m = 0; m < 4; ++m)
#pragma unroll
                    for (int n = 0; n < 2; ++n) acc[a][b][m][n] = (f32x4){0.f, 0.f, 0.f, 0.f};
        cur = nxt; cA = nA; cB = nB; ++ui;
    }
    PG8_WAIT_V(0);
    if (wr == 0) PG8_BAR;
    PG8_BAR;
#undef PG8_SA
#undef PG8_SB
#undef PG8_STAGE
#undef PG8_LDA
#undef PG8_LDB
#undef PG8_MMA
#undef PG8_WAIT_V
#undef PG8_WAIT_L
#undef PG8_BAR
#undef PG8_SCHED
}
}

struct Args { const float* in[24]; float* out; unsigned char* ws; };
enum { I_X = 0, I_F1N, I_F1W1, I_F1W3, I_F1W2, I_MIXN, I_WIN, I_GB, I_QNA, I_KNA, I_QNN, I_KNN, I_POS, I_CKW1, I_CKW2, I_CVW1, I_CVW2, I_ON, I_WOUT, I_F2N, I_F2W1, I_F2W3, I_F2W2, I_RB };

__device__ __forceinline__ void transpose_item(const float* W, int K, int N, bf16_t* WT, int mode, int off, LAS float* scr, int item, int lane, const float* gain) {
    const int nblk = (N + 31) / 32, kb = item / nblk, nb = item % nblk, k0 = 64 * kb, n0 = 32 * nb;
    const int c4 = 4 * (lane & 7), nn = n0 + c4;
    f32x4 ld[8];
#pragma unroll
    for (int i = 0; i < 8; ++i) { const int kk = 8 * i + (lane >> 3); ld[i] = (nn < N) ? *(const f32x4*)(W + (size_t)(k0 + kk) * N + nn) : (f32x4){0.f, 0.f, 0.f, 0.f}; if (gain) ld[i] = ld[i] * gain[k0 + kk]; }
#pragma unroll
    for (int i = 0; i < 8; ++i) { const int kk = 8 * i + (lane >> 3); LAS float* d = scr + kk * 33 + c4; d[0] = ld[i].x; d[1] = ld[i].y; d[2] = ld[i].z; d[3] = ld[i].w; }
    LDS_WAIT(); asm volatile("" ::: "memory");
    const int c = lane & 7;
#pragma unroll
    for (int j = 0; j < 4; ++j) { const int n = (lane >> 3) + 8 * j; const LAS float* s = scr + (8 * c) * 33 + n;
        u32x4 o; o.x = pk2(s[0 * 33], s[1 * 33]); o.y = pk2(s[2 * 33], s[3 * 33]); o.z = pk2(s[4 * 33], s[5 * 33]); o.w = pk2(s[6 * 33], s[7 * 33]);
        const int ng = n0 + n; const int dr = mode ? ((ng >> 7) * 256 + (ng & 127) + off) : (ng + off);
        if (ng < N) *(u32x4*)(WT + kt_off(dr, k0 + 8 * c, K)) = o; }
    LDS_WAIT(); asm volatile("" ::: "memory");
}
__device__ __forceinline__ int rel_bucket_dev(int n) {
    if (n < 16) return n;
    const float v = logf((float)n / 16.0f) / 4.852030263919617f * 16.0f;
    int b = 16 + (int)v; return b < 31 ? b : 31;
}
namespace att {
constexpr int SHM_V = 16384, SHM_K = 16384;
constexpr int L_V = 0  , L_K = 49152  , L_WS = 98304, L_TBL = 100352, L_SELM = L_TBL + 4 * TBLS * 4  , L_END = L_SELM + 1024;
constexpr int L_IMP = 0;
static_assert(L_END <= 131072, "attention LDS map");
constexpr float THR = 8.f;
#define KSWZ(row, colB) ((row) * 256 + ((colB) ^ (((row) & 7) << 4)))
__device__ __forceinline__ int v_st(int k, int c) { const int kk = (k & ~0xC) | ((k & 4) << 1) | ((k & 8) >> 1); return ((kk >> 3) * 4 + (c >> 5)) * 512 + ((kk & 7) * 32 + (c & 31)) * 2; }
__device__ __forceinline__ int v_rd_base(int lane) { return ((lane & 3) << 3) | (((lane >> 2) & 3) << 6) | (((lane >> 4) & 1) << 5) | (((lane >> 5) & 1) << 8); }
__device__ __forceinline__ int crow(int r, int hi) { return (r & 3) + 8 * (r >> 2) + 4 * hi; }

__device__ __forceinline__ void partialSM(f32x16& p0, f32x16& p1, float& m_reg, float& mn, float& alpha) {
    (void)m_reg; mn = 0.f; alpha = 1.f;
#pragma unroll
    for (int r = 0; r < 16; ++r) p0[r] = __builtin_amdgcn_exp2f(p0[r] * LOG2E);
#pragma unroll
    for (int r = 0; r < 16; ++r) p1[r] = p1[r] * LOG2E;
}
__device__ __forceinline__ void partialSM_row(f32x16& p0, f32x16& p1, float& m_reg, float& mn, float& alpha, bool ok, float bias) {
    (void)m_reg; mn = 0.f; alpha = 1.f;
    const float mnL = ok ? bias * LOG2E : -__builtin_inff();
#pragma unroll
    for (int r = 0; r < 16; ++r) p0[r] = __builtin_amdgcn_exp2f(fmaf(p0[r], LOG2E, mnL));
#pragma unroll
    for (int r = 0; r < 16; ++r) p1[r] = fmaf(p1[r], LOG2E, mnL);
}
#define PK4(P, B_, OUT) do { unsigned a0 = cvtpk(P[B_+0], P[B_+1]), a1 = cvtpk(P[B_+2], P[B_+3]);                          \
        unsigned b0 = cvtpk(P[B_+4], P[B_+5]), b1 = cvtpk(P[B_+6], P[B_+7]);                                             \
        auto r0 = __builtin_amdgcn_permlane32_swap(a0, b0, false, false); auto r1 = __builtin_amdgcn_permlane32_swap(a1, b1, false, false); \
        u32x4 w = {r0[0], r1[0], r0[1], r1[1]}; OUT = *reinterpret_cast<bf16x8*>(&w); } while (0)
__device__ __forceinline__ void finishSM(f32x16& p0, f32x16& p1, float alpha, float& l_reg, bf16x8& pa0, bf16x8& pa1, bf16x8& pa2, bf16x8& pa3) {
#pragma unroll
    for (int r = 0; r < 16; ++r) p1[r] = __builtin_amdgcn_exp2f(p1[r]);
    float ps = 0;
#pragma unroll
    for (int r = 0; r < 16; ++r) ps += p0[r];
#pragma unroll
    for (int r = 0; r < 16; ++r) ps += p1[r];
    { auto rr = __builtin_amdgcn_permlane32_swap(__float_as_uint(ps), __float_as_uint(ps), false, false);
      ps = __uint_as_float(rr[0]) + __uint_as_float(rr[1]); }
    l_reg = l_reg * alpha + ps;
    PK4(p0, 0, pa0); PK4(p0, 8, pa1); PK4(p1, 0, pa2); PK4(p1, 8, pa3);
}
__device__ __forceinline__ void qkt(f32x16& p0, f32x16& p1, const LAS char* Kb, int r32, int hi, const bf16x8 (&qr)[8]) {
    p0 = f32x16{}; p1 = f32x16{};
    const LAS char* kb4[4];
#pragma unroll
    for (int dd = 0; dd < 4; ++dd) kb4[dd] = Kb + KSWZ(r32, (dd * 16 + hi * 8) * 2);
#pragma unroll
    for (int d0 = 0; d0 < 8; ++d0) { const LAS char* a = kb4[d0 & 3] + (d0 >> 2) * 128;
        const bf16x8 b0 = *reinterpret_cast<const LAS bf16x8*>(a);
        const bf16x8 b1 = *reinterpret_cast<const LAS bf16x8*>(a + 32 * 256);
        p0 = __builtin_amdgcn_mfma_f32_32x32x16_bf16(b0, qr[d0], p0, 0, 0, 0);
        p1 = __builtin_amdgcn_mfma_f32_32x32x16_bf16(b1, qr[d0], p1, 0, 0, 0); }
}
__device__ __forceinline__ void pv_tile(f32x16 (&o)[4], int vb, bf16x8 pa0, bf16x8 pa1, bf16x8 pa2, bf16x8 pa3) {
#define TRRD(dst, off) asm volatile("ds_read_b64_tr_b16 %0, %1 offset:%2" : "=&v"(dst) : "v"(vb), "i"(off) : "memory")
#define PV_D0(d0) do { s16x4 l0, l1, l2, l3, h0, h1, h2, h3; constexpr int b_ = (d0) * 512; \
        TRRD(l0, b_); TRRD(h0, b_ + 2048); TRRD(l1, b_ + 4096); TRRD(h1, b_ + 6144); TRRD(l2, b_ + 8192); TRRD(h2, b_ + 10240); TRRD(l3, b_ + 12288); TRRD(h3, b_ + 14336); \
        asm volatile("s_waitcnt lgkmcnt(0)" ::: "memory"); SBAR(); \
        o[d0] = __builtin_amdgcn_mfma_f32_32x32x16_bf16(pa0, (bf16x8){l0[0], l0[1], l0[2], l0[3], h0[0], h0[1], h0[2], h0[3]}, o[d0], 0, 0, 0);   \
        o[d0] = __builtin_amdgcn_mfma_f32_32x32x16_bf16(pa1, (bf16x8){l1[0], l1[1], l1[2], l1[3], h1[0], h1[1], h1[2], h1[3]}, o[d0], 0, 0, 0);   \
        o[d0] = __builtin_amdgcn_mfma_f32_32x32x16_bf16(pa2, (bf16x8){l2[0], l2[1], l2[2], l2[3], h2[0], h2[1], h2[2], h2[3]}, o[d0], 0, 0, 0);   \
        o[d0] = __builtin_amdgcn_mfma_f32_32x32x16_bf16(pa3, (bf16x8){l3[0], l3[1], l3[2], l3[3], h3[0], h3[1], h3[2], h3[3]}, o[d0], 0, 0, 0); } while (0)
    PV_D0(0); PV_D0(1); PV_D0(2); PV_D0(3);
#undef PV_D0
#undef TRRD
}

template <class Cfg>
__device__ __forceinline__ void attn_tiles(const Cfg& c, LAS char* lds, const bf16x8 (&qr)[8], f32x16 (&o)[4], float& m_reg, float& l_reg, const int t_lo, const int t_hi, const int wv) {
    const int tid = opq_tid(wv), lane = tid & 63, wid = __builtin_amdgcn_readfirstlane(tid >> 6), r32 = lane & 31, hi = lane >> 5;
    LAS char* V_lds = lds + L_V; LAS char* K_lds = lds + L_K;
    LAS float* al_l = (LAS float*)(lds + L_WS) + wid * 64 + 32;
    const int sr = tid >> 4, sc = (tid & 15) * 8;
    const int vst0 = v_st(sr, sc), vst1 = v_st(32 + sr, sc), kws = KSWZ(sr, sc * 2);
    const int vb0 = (int)(unsigned)(uintptr_t)V_lds + v_rd_base(lane);
    bf16x8 sk0, sk1, sv0, sv1;
    const bf16_t *gk0 = nullptr, *gk1 = nullptr, *gv0 = nullptr, *gv1 = nullptr;
#define AT_LOAD(t) do { gk0 = c.krow((t), sr) + sc; gk1 = c.krow((t), sr + 32) + sc; sk0 = *(const bf16x8*)gk0; sk1 = *(const bf16x8*)gk1; \
        if constexpr (Cfg::MODE == 0) { gv0 = c.vrow((t), sr) + sc; gv1 = c.vrow((t), sr + 32) + sc; sv0 = *(const bf16x8*)gv0; sv1 = *(const bf16x8*)gv1; } \
        asm volatile("" ::: "memory"); SBAR(); } while (0)
#define AT_WRITE(t, bf) do { asm volatile("" :: "v"(gk0), "v"(gk1), "v"(gv0), "v"(gv1)); *(LAS bf16x8*)(K_lds + (bf) * SHM_K + kws) = sk0; *(LAS bf16x8*)(K_lds + (bf) * SHM_K + kws + 32 * 256) = sk1; \
        if constexpr (Cfg::MODE == 1) { \
            _Pragma("unroll") for (int i_ = 0; i_ < 8; ++i_) { const int n_ = sc + i_, c0_ = 64 * (t) + sr, c1_ = c0_ + 32; \
                sv0[i_] = (c0_ >= 4 * n_ - 1 && c0_ <= 4 * n_ + 3) ? (short)0x3F80 : (short)0; sv1[i_] = (c1_ >= 4 * n_ - 1 && c1_ <= 4 * n_ + 3) ? (short)0x3F80 : (short)0; } } \
        *(LAS bf16x8*)(V_lds + (bf) * SHM_V + vst0) = sv0; *(LAS bf16x8*)(V_lds + (bf) * SHM_V + vst1) = sv1; } while (0)
    __builtin_amdgcn_s_waitcnt(0x0F70);
    __syncthreads();
    if (t_lo < t_hi) { AT_LOAD(t_lo); AT_WRITE(t_lo, 0); }
    __syncthreads();
    for (int t = t_lo; t < t_hi; ++t) {
        const int buf = (t - t_lo) & 1; const bool more = (t + 1 < t_hi);
        if (more) AT_LOAD(t + 1);
        if (c.active(t)) {
            f32x16 p0, p1;
            qkt(p0, p1, K_lds + buf * SHM_K, r32, hi, qr);
            if constexpr (Cfg::MODE == 0) {
                float mn, alpha; bf16x8 pa0, pa1, pa2, pa3;
                bool rok; float rbias;
                if (c.rowconst(t, rok, rbias)) partialSM_row(p0, p1, m_reg, mn, alpha, rok, rbias);
                else { c.mask(p0, p1, t); partialSM(p0, p1, m_reg, mn, alpha); }
                if (__any(alpha < 1.f)) { if (hi == 0) al_l[r32] = alpha; LDS_WAIT();
#pragma unroll
                    for (int d_ = 0; d_ < 4; ++d_)
#pragma unroll
                        for (int r = 0; r < 16; ++r) o[d_][r] *= al_l[crow(r, hi)]; }
                finishSM(p0, p1, alpha, l_reg, pa0, pa1, pa2, pa3); SBAR();
                pv_tile(o, vb0 + buf * SHM_V, pa0, pa1, pa2, pa3);
            } else {
                c.mask(p0, p1, t);
                const float mL = -c.mfix * LOG2E; const float il = c.invl;
#pragma unroll
                for (int r = 0; r < 16; ++r) { p0[r] = __builtin_amdgcn_exp2f(fmaf(p0[r], LOG2E, mL)) * il; p1[r] = __builtin_amdgcn_exp2f(fmaf(p1[r], LOG2E, mL)) * il; }
                bf16x8 pa0, pa1, pa2, pa3;
                PK4(p0, 0, pa0); PK4(p0, 8, pa1); PK4(p1, 0, pa2); PK4(p1, 8, pa3); SBAR();
                pv_tile(o, vb0 + buf * SHM_V, pa0, pa1, pa2, pa3);
#pragma unroll
                for (int r = 0; r < 16; r += 2) { const unsigned a = cvtpk(p0[r], p0[r + 1]), b = cvtpk(p1[r], p1[r + 1]);
                    p0[r] -= bflo(a); p0[r + 1] -= bfhi(a); p1[r] -= bflo(b); p1[r + 1] -= bfhi(b); }
                PK4(p0, 0, pa0); PK4(p0, 8, pa1); PK4(p1, 0, pa2); PK4(p1, 8, pa3); SBAR();
                pv_tile(o, vb0 + buf * SHM_V, pa0, pa1, pa2, pa3);
            }
        }
        if (more) AT_WRITE(t + 1, buf ^ 1);
        __syncthreads();
    }
#undef AT_LOAD
#undef AT_WRITE
}

template <class Cfg>
__device__ __forceinline__ void attn_tiles_s(const Cfg& c, LAS char* lds, const bf16x8 (&qr)[8], f32x16 (&o)[4], float& m_reg, float& l_reg, const int t_lo, const int t_hi, const int wv) {
    static_assert(Cfg::MODE == 0, "fixed-shift softmax tiles only");
    (void)m_reg;
    const int tid = opq_tid(wv), lane = tid & 63, wid = __builtin_amdgcn_readfirstlane(tid >> 6), r32 = lane & 31, hi = lane >> 5;
    LAS char* V_lds = lds + L_V; LAS char* K_lds = lds + L_K;
    const int sr = tid >> 4, sc = (tid & 15) * 8;
    const int vst0 = v_st(sr, sc), vst1 = v_st(32 + sr, sc), kws = KSWZ(sr, sc * 2);
    const int vb0 = (int)(unsigned)(uintptr_t)V_lds + v_rd_base(lane);
    bf16x8 sk0, sk1, sv0, sv1, pa0, pa1, pa2, pa3;
    const bf16_t *gk0 = nullptr, *gk1 = nullptr, *gv0 = nullptr, *gv1 = nullptr;
#define AS_LOAD(t) do { gk0 = c.krow((t), sr) + sc; gk1 = c.krow((t), sr + 32) + sc; sk0 = *(const bf16x8*)gk0; sk1 = *(const bf16x8*)gk1; \
        gv0 = c.vrow((t), sr) + sc; gv1 = c.vrow((t), sr + 32) + sc; sv0 = *(const bf16x8*)gv0; sv1 = *(const bf16x8*)gv1; asm volatile("" ::: "memory"); SBAR(); } while (0)
#define AS_WRITE(kbf, vbf) do { asm volatile("" :: "v"(gk0), "v"(gk1), "v"(gv0), "v"(gv1)); *(LAS bf16x8*)(K_lds + (kbf) * SHM_K + kws) = sk0; *(LAS bf16x8*)(K_lds + (kbf) * SHM_K + kws + 32 * 256) = sk1; \
        *(LAS bf16x8*)(V_lds + (vbf) * SHM_V + vst0) = sv0; *(LAS bf16x8*)(V_lds + (vbf) * SHM_V + vst1) = sv1; } while (0)
#define AS_SCORE(t, kbf) do { f32x16 p0, p1; float mz_ = 0.f, mn_, al_; bool rok_; float rb_; \
        qkt(p0, p1, K_lds + (kbf) * SHM_K, r32, hi, qr); \
        if (c.rowconst((t), rok_, rb_)) partialSM_row(p0, p1, mz_, mn_, al_, rok_, rb_); else { c.mask(p0, p1, (t)); partialSM(p0, p1, mz_, mn_, al_); } \
        finishSM(p0, p1, 1.f, l_reg, pa0, pa1, pa2, pa3); SBAR(); } while (0)
    if (t_lo >= t_hi) return;
    __builtin_amdgcn_s_waitcnt(0x0F70);
    __syncthreads();
    AS_LOAD(t_lo); AS_WRITE(0, 0);
    __syncthreads();
    int kb = 0, vb = 0;
    if (wid < 4) {
        for (int t = t_lo; t < t_hi; ++t) {
            const bool more = (t + 1 < t_hi); const int vn = (vb == 2) ? 0 : vb + 1;
            if (more) AS_LOAD(t + 1);
            if (c.active(t)) { AS_SCORE(t, kb); pv_tile(o, vb0 + vb * SHM_V, pa0, pa1, pa2, pa3); }
            if (more) AS_WRITE(kb ^ 1, vn);
            __syncthreads();
            kb ^= 1; vb = vn;
        }
    } else {
        bool pend = false; int vp = 0;
        for (int t = t_lo; t < t_hi; ++t) {
            const bool more = (t + 1 < t_hi); const int vn = (vb == 2) ? 0 : vb + 1;
            if (more) AS_LOAD(t + 1);
            if (pend) pv_tile(o, vb0 + vp * SHM_V, pa0, pa1, pa2, pa3);
            const bool act = c.active(t);
            if (act) AS_SCORE(t, kb);
            pend = act; vp = vb;
            if (more) AS_WRITE(kb ^ 1, vn);
            __syncthreads();
            kb ^= 1; vb = vn;
        }
        if (pend) pv_tile(o, vb0 + vp * SHM_V, pa0, pa1, pa2, pa3);
    }
#undef AS_LOAD
#undef AS_WRITE
#undef AS_SCORE
}

struct DilCfg {
    static constexpr int MODE = 0;
    const bf16_t* Kb; const bf16_t* Vb;
    const LAS float* tbl; int dshift, res, u, dqm, s0;
    __device__ __forceinline__ const bf16_t* krow(int t, int kk) const { int s = 256 * u - 128 + 64 * t + kk; s = s < 0 ? 0 : s; return Kb + (size_t)((s << dshift) + res) * PC; }
    __device__ __forceinline__ const bf16_t* vrow(int t, int kk) const { int s = 256 * u - 128 + 64 * t + kk; s = s < 0 ? 0 : s; return Vb + (size_t)((s << dshift) + res) * PC; }
    __device__ __forceinline__ bool active(int t) const { const int kb = 256 * u - 128 + 64 * t; return kb <= s0 + 31 && kb + 63 >= s0 - 128; }
    __device__ __forceinline__ bool rowconst(int, bool&, float&) const { return false; }
    __device__ __forceinline__ void mask(f32x16& p0, f32x16& p1, int t) const {
        const int dq = dqm - (256 * u - 128 + 64 * t); const float NEG = -__builtin_inff();
        const LAS float* tb = tbl + (DT0 + dq - 63);
        float bb0[16], bb1[16];
#pragma unroll
        for (int r = 0; r < 16; ++r) { const int cc = (r & 3) + 8 * (r >> 2); bb0[r] = tb[63 - cc]; bb1[r] = tb[31 - cc]; }
#pragma unroll
        for (int r = 0; r < 16; ++r) asm volatile("" : "+v"(bb0[r]), "+v"(bb1[r]));
#pragma unroll
        for (int r = 0; r < 16; ++r) { const int cc = (r & 3) + 8 * (r >> 2); const unsigned d0 = (unsigned)(dq - cc), d1 = (unsigned)(dq - cc - 32);
            p0[r] = (d0 <= 128u) ? p0[r] + bb0[r] : NEG; p1[r] = (d1 <= 128u) ? p1[r] + bb1[r] : NEG; }
    }
};
struct CmpCfg {
    static constexpr int MODE = 0;
    const bf16_t* Kb; const bf16_t* Vb; int cmax, hi4, cfull;
    __device__ __forceinline__ bool rowconst(int t, bool& ok, float& bias) const { ok = true; bias = 0.f; return 64 * t + 63 <= cfull; }
    __device__ __forceinline__ const bf16_t* krow(int t, int kk) const { return Kb + (size_t)(64 * t + kk) * HD; }
    __device__ __forceinline__ const bf16_t* vrow(int t, int kk) const { return Vb + (size_t)(64 * t + kk) * HD; }
    __device__ __forceinline__ bool active(int) const { return true; }
    __device__ __forceinline__ void mask(f32x16& p0, f32x16& p1, int t) const {
        const int cb = 64 * t + hi4; const float NEG = -__builtin_inff();
#pragma unroll
        for (int r = 0; r < 16; ++r) { const int cc = cb + (r & 3) + 8 * (r >> 2); if (cc > cmax) p0[r] = NEG; if (cc + 32 > cmax) p1[r] = NEG; }
    }
};
struct CmpImpCfg {
    static constexpr int MODE = 1;
    const bf16_t* Kb; int cmax, hi4; float mfix, invl;
    __device__ __forceinline__ const bf16_t* krow(int t, int kk) const { return Kb + (size_t)(64 * t + kk) * HD; }
    __device__ __forceinline__ const bf16_t* vrow(int, int) const { return Kb; }
    __device__ __forceinline__ bool active(int) const { return true; }
    __device__ __forceinline__ void mask(f32x16& p0, f32x16& p1, int t) const {
        const int cb = 64 * t + hi4; const float NEG = -__builtin_inff();
#pragma unroll
        for (int r = 0; r < 16; ++r) { const int cc = cb + (r & 3) + 8 * (r >> 2); if (cc > cmax) p0[r] = NEG; if (cc + 32 > cmax) p1[r] = NEG; }
    }
};
struct SlcCfg {
    static constexpr int MODE = 0;
    const bf16_t* Kb; const bf16_t* Vb;
    const LAS float* tblh;
    unsigned s0, s1, s2, s3; int tqm, cur; float b31;
    __device__ __forceinline__ const bf16_t* krow(int t, int kk) const { return Kb + (size_t)(64 * t + kk) * PC; }
    __device__ __forceinline__ const bf16_t* vrow(int t, int kk) const { return Vb + (size_t)(64 * t + kk) * PC; }
    __device__ __forceinline__ bool selbit(int t) const { const unsigned q = (unsigned)t >> 5; const unsigned w = (q == 0u ? s0 + 0u : 0u) | (q == 1u ? s1 + 0u : 0u) | (q == 2u ? s2 + 0u : 0u) | (q == 3u ? s3 + 0u : 0u); return (w >> (t & 31)) & 1u; }
    __device__ __forceinline__ bool active(int t) const { return __any(selbit(t)); }
    __device__ __forceinline__ bool rowconst(int t, bool& ok, float& bias) const { ok = selbit(t); bias = b31; return 64 * (cur - t) - 63 >= 1513; }
    __device__ __forceinline__ void mask(f32x16& p0, f32x16& p1, int t) const {
        const bool sel = selbit(t); const int dq = tqm - 64 * t; const float NEG = -__builtin_inff();
        const LAS float* tb = tblh + (TBL0 + dq - 63);
        float bb0[16], bb1[16];
#pragma unroll
        for (int r = 0; r < 16; ++r) { const int cc = (r & 3) + 8 * (r >> 2); bb0[r] = tb[63 - cc]; bb1[r] = tb[31 - cc]; }
#pragma unroll
        for (int r = 0; r < 16; ++r) asm volatile("" : "+v"(bb0[r]), "+v"(bb1[r]));
#pragma unroll
        for (int r = 0; r < 16; ++r) { const int cc = (r & 3) + 8 * (r >> 2); const int d0 = dq - cc, d1 = dq - cc - 32;
            p0[r] = (sel && d0 >= 0) ? p0[r] + bb0[r] : NEG; p1[r] = (sel && d1 >= 0) ? p1[r] + bb1[r] : NEG; }
    }
};
struct WinCfg {
    static constexpr int MODE = 0;
    const bf16_t* Kb; const bf16_t* Vb; const LAS float* tblh; int tqm;
    __device__ __forceinline__ bool rowconst(int, bool&, float&) const { return false; }
    __device__ __forceinline__ const bf16_t* krow(int t, int kk) const { return Kb + (size_t)(64 * t + kk) * PC; }
    __device__ __forceinline__ const bf16_t* vrow(int t, int kk) const { return Vb + (size_t)(64 * t + kk) * PC; }
    __device__ __forceinline__ bool active(int) const { return true; }
    __device__ __forceinline__ void mask(f32x16& p0, f32x16& p1, int t) const {
        const int dq = tqm - 64 * t; const float NEG = -__builtin_inff();
        const LAS float* tb = tblh + (TBL0 + dq - 63);
        float bb0[16], bb1[16];
#pragma unroll
        for (int r = 0; r < 16; ++r) { const int cc = (r & 3) + 8 * (r >> 2); bb0[r] = tb[63 - cc]; bb1[r] = tb[31 - cc]; }
#pragma unroll
        for (int r = 0; r < 16; ++r) asm volatile("" : "+v"(bb0[r]), "+v"(bb1[r]));
#pragma unroll
        for (int r = 0; r < 16; ++r) { const int cc = (r & 3) + 8 * (r >> 2); const unsigned d0 = (unsigned)(dq - cc), d1 = (unsigned)(dq - cc - 32);
            p0[r] = (d0 < 512u) ? p0[r] + bb0[r] : NEG; p1[r] = (d1 < 512u) ? p1[r] + bb1[r] : NEG; }
    }
};
}

__device__ __forceinline__ void load_q_normed(const bf16_t* qp  , const float* gain  , bf16x8 (&qr)[8]) {
    u32x4 raw[8];
#pragma unroll
    for (int d0 = 0; d0 < 8; ++d0) raw[d0] = *(const u32x4*)(qp + d0 * 16);
    float ss = 0.f;
#pragma unroll
    for (int d0 = 0; d0 < 8; ++d0) { const u32x4 w = raw[d0]; const float a0 = bflo(w.x), a1 = bfhi(w.x), a2 = bflo(w.y), a3 = bfhi(w.y), a4 = bflo(w.z), a5 = bfhi(w.z), a6 = bflo(w.w), a7 = bfhi(w.w);
        ss += ((a0 * a0 + a1 * a1) + (a2 * a2 + a3 * a3)) + ((a4 * a4 + a5 * a5) + (a6 * a6 + a7 * a7)); }
    { auto rr = __builtin_amdgcn_permlane32_swap(__float_as_uint(ss), __float_as_uint(ss), false, false); ss = __uint_as_float(rr[0]) + __uint_as_float(rr[1]); }
    const float rs = QSCALE / sqrtf(ss * (1.f / HD) + EPS);
#pragma unroll
    for (int d0 = 0; d0 < 8; ++d0) { const u32x4 w = raw[d0]; const f32x4 g0 = *(const f32x4*)(gain + d0 * 16), g1 = *(const f32x4*)(gain + d0 * 16 + 4);
        u32x4 o; o.x = cvtpk(bflo(w.x) * rs * g0.x, bfhi(w.x) * rs * g0.y); o.y = cvtpk(bflo(w.y) * rs * g0.z, bfhi(w.y) * rs * g0.w);
        o.z = cvtpk(bflo(w.z) * rs * g1.x, bfhi(w.z) * rs * g1.y); o.w = cvtpk(bflo(w.w) * rs * g1.z, bfhi(w.w) * rs * g1.w);
        qr[d0] = *reinterpret_cast<bf16x8*>(&o); }
}

__device__ __forceinline__ void dil_tiles(const att::DilCfg& c, LAS char* lds, const bf16x8 (&qr)[8], f32x16 (&o)[4], float& l_reg, const int wv) {
    using namespace att;
    const int tid = opq_tid(wv), lane = tid & 63, wid = __builtin_amdgcn_readfirstlane(tid >> 6), r32 = lane & 31, hi = lane >> 5;
    LAS char* V_lds = lds + L_V; LAS char* K_lds = lds + L_K;
    const int sr = tid >> 4, sc = (tid & 15) * 8;
    const int vst0 = v_st(sr, sc), vst1 = v_st(32 + sr, sc), kws = KSWZ(sr, sc * 2);
    const int vb0 = (int)(unsigned)(uintptr_t)V_lds + v_rd_base(lane);
    bf16x8 sk0, sk1, sv0, sv1;
    const bf16_t *gk0 = nullptr, *gk1 = nullptr, *gv0 = nullptr, *gv1 = nullptr;
#define DT_LOAD(t) do { gk0 = c.krow((t), sr) + sc; gk1 = c.krow((t), sr + 32) + sc; sk0 = *(const bf16x8*)gk0; sk1 = *(const bf16x8*)gk1; \
        gv0 = c.vrow((t), sr) + sc; gv1 = c.vrow((t), sr + 32) + sc; sv0 = *(const bf16x8*)gv0; sv1 = *(const bf16x8*)gv1; asm volatile("" ::: "memory"); SBAR(); } while (0)
#define DT_WRITE(slot) do { asm volatile("" :: "v"(gk0), "v"(gk1), "v"(gv0), "v"(gv1)); *(LAS bf16x8*)(K_lds + (slot) * SHM_K + kws) = sk0; *(LAS bf16x8*)(K_lds + (slot) * SHM_K + kws + 32 * 256) = sk1; \
        *(LAS bf16x8*)(V_lds + (slot) * SHM_V + vst0) = sv0; *(LAS bf16x8*)(V_lds + (slot) * SHM_V + vst1) = sv1; } while (0)
#define DT_COMP(t, slot) do { f32x16 p0, p1; float mz_ = 0.f, mn_, al_; bf16x8 pa0, pa1, pa2, pa3; \
        qkt(p0, p1, K_lds + (slot) * SHM_K, r32, hi, qr); c.mask(p0, p1, (t)); partialSM(p0, p1, mz_, mn_, al_); \
        finishSM(p0, p1, 1.f, l_reg, pa0, pa1, pa2, pa3); SBAR(); pv_tile(o, vb0 + (slot) * SHM_V, pa0, pa1, pa2, pa3); } while (0)
    const bool first = (c.u == 0);
    __builtin_amdgcn_s_waitcnt(0x0F70);
    __syncthreads();
    if (!first) { DT_LOAD(1); DT_WRITE(0); }
    DT_LOAD(4); DT_WRITE(1);
    __syncthreads();
    DT_LOAD(2);
    if (wid < 4) { if (!first) DT_COMP(1, 0); } else DT_COMP(4, 1);
    DT_WRITE(2);
    __syncthreads();
    DT_LOAD(3);
    if (wid < 6) DT_COMP(2, 2);
    DT_WRITE(0);
    __syncthreads();
    DT_LOAD(5);
    if (wid >= 2) DT_COMP(3, 0);
    DT_WRITE(1);
    if (!first) { DT_LOAD(0); DT_WRITE(2); }
    __syncthreads();
    if (wid < 2) { if (!first) DT_COMP(0, 2); } else if (wid >= 6) DT_COMP(5, 1);
#undef DT_LOAD
#undef DT_WRITE
#undef DT_COMP
}

__device__ __forceinline__ void dil_unit(LAS char* lds, const bf16_t* P, bf16_t* OA, float* LSE, const float* dilT, const float* qgain, int pat, int dshift, int unit, const int wv) {
    using namespace att;
    const int tid = opq_tid(wv), lane = tid & 63, wid = __builtin_amdgcn_readfirstlane(tid >> 6), r32 = lane & 31, hi = lane >> 5;
    const int bh = unit >> 5, ru = unit & 31, b = bh >> 3, h = bh & 7;
    const int ncs = 5 - dshift, res = ru >> ncs, u = ru & ((1 << ncs) - 1);
    LAS float* tbl = (LAS float*)(lds + L_TBL);
    __syncthreads();
    if (tid < DTS) tbl[tid] = dilT[(pat * 8 + h) * DTS + tid];
    const int s0 = 256 * u + 32 * wid, s_row = s0 + r32;
    const size_t tokrow = (size_t)b * SEQ + (size_t)((s_row << dshift) + res);
    bf16x8 qr[8];
    load_q_normed(P + tokrow * PC + C_QA + h * HD + hi * 8, qgain + hi * 8, qr);
    f32x16 o[4]; float m_reg, l_reg;
    m_reg = 0.f;
    if (pat == 0) { l_reg = 0.f;
#pragma unroll
        for (int d0 = 0; d0 < 4; ++d0) o[d0] = f32x16{}; }
    else { l_reg = LSE[tokrow * 8 + h];
#pragma unroll
        for (int r = 0; r < 16; ++r) { const size_t tr = (size_t)b * SEQ + (size_t)(((s0 + crow(r, hi)) << dshift) + res); const bf16_t* op = OA + tr * 1024 + h * HD + r32;
#pragma unroll
            for (int d0 = 0; d0 < 4; ++d0) o[d0][r] = bf2f(op[d0 * 32]); } }
    DilCfg c; c.Kb = P + (size_t)b * SEQ * PC + C_KA + h * HD; c.Vb = P + (size_t)b * SEQ * PC + C_VA + h * HD; c.tbl = tbl; c.dshift = dshift; c.res = res; c.u = u; c.dqm = s_row - 4 * hi; c.s0 = s0;
    dil_tiles(c, lds, qr, o, l_reg, wv);
    LAS float* li_l = (LAS float*)(lds + L_WS) + wid * 64;
    if (hi == 0) { li_l[r32] = l_reg; LSE[tokrow * 8 + h] = l_reg; }
    LDS_WAIT();
#pragma unroll
    for (int r = 0; r < 16; ++r) { const int orow = crow(r, hi); const float rl = (pat == 2) ? 1.0f / li_l[orow] : 1.0f;
        const size_t tr = (size_t)b * SEQ + (size_t)(((s0 + orow) << dshift) + res); bf16_t* op = OA + tr * 1024 + h * HD;
#pragma unroll
        for (int d0 = 0; d0 < 4; ++d0) { const float v = o[d0][r] * rl; const float vn = shx(v, 1, lane);
            if ((r32 & 1) == 0) *(unsigned*)(op + d0 * 32 + r32) = cvtpk(v, vn); } }
}

__device__ __forceinline__ void nsa_finalize(LAS char* lds, const f32x16 (&o)[4], float l_reg, const bf16_t* P, bf16_t* ON, const float* gb, int b, int g, int tok0, int br, const int wv) {
    using namespace att;
    const int tid = opq_tid(wv), lane = tid & 63, wid = __builtin_amdgcn_readfirstlane(tid >> 6), r32 = lane & 31, hi = lane >> 5;
    LAS float* li_l = (LAS float*)(lds + L_WS) + wid * 64;
    if (hi == 0) li_l[r32] = l_reg;
    LDS_WAIT();
    bf16_t* ONb = ON + (size_t)br * NTOK * 1024;
    float glv[16], gbv[4];
#pragma unroll
    for (int j = 0; j < 4; ++j) gbv[j] = gb[(4 * g + j) * 3 + br];
#pragma unroll
    for (int r = 0; r < 16; ++r) { const int j = r & 3, k = r >> 2; const size_t tok = (size_t)b * SEQ + tok0 + 2 * k + hi; glv[r] = bf2f(P[tok * PC + C_GL + (4 * g + j) * 3 + br]); }
#pragma unroll
    for (int r = 0; r < 16; ++r) asm volatile("" : "+v"(glv[r]));
#pragma unroll
    for (int r = 0; r < 16; ++r) { const int j = r & 3, k = r >> 2; const float lr = li_l[crow(r, hi)]; const float rl = lr > 0.f ? 1.0f / lr : 0.f;
        const size_t tok = (size_t)b * SEQ + tok0 + 2 * k + hi; const int hh = 4 * g + j;
        const float gl = glv[r] + gbv[j];
        const float sc = rl * __builtin_amdgcn_rcpf(1.0f + __builtin_amdgcn_exp2f(-gl * LOG2E));
        bf16_t* op = ONb + tok * 1024 + hh * HD;
#pragma unroll
        for (int d0 = 0; d0 < 4; ++d0) { const float v = o[d0][r] * sc; const float vn = shx(v, 1, lane);
            if ((r32 & 1) == 0) *(unsigned*)(op + d0 * 32 + r32) = cvtpk(v, vn); } }
}
__device__ __forceinline__ void nsa_unit(LAS char* lds, const bf16_t* P, const bf16_t* KC, const bf16_t* VC, bf16_t* ON, const float* nsaT, const float* gb, const float* qgain, int b, int g, int qi, bool load_tbl, const int wv) {
    using namespace att;
    const int tid = opq_tid(wv), lane = tid & 63, wid = __builtin_amdgcn_readfirstlane(tid >> 6), r32 = lane & 31, hi = lane >> 5;
    LAS float* tbl = (LAS float*)(lds + L_TBL); LAS float* IMP = (LAS float*)(lds + L_IMP); LAS unsigned* SELM = (LAS unsigned*)(lds + L_SELM);
    __syncthreads();
    if (load_tbl) for (int i = tid; i < 4 * TBLS; i += NTHR) tbl[i] = nsaT[(size_t)(4 * g) * TBLS + i];
    const int tok0 = 64 * qi + 8 * wid, tq = tok0 + (r32 >> 2), hd = r32 & 3;
    const bf16_t* Pb = P + (size_t)b * SEQ * PC;
    bf16x8 qr[8];
    load_q_normed(Pb + (size_t)tq * PC + C_QN + (4 * g + hd) * HD + hi * 8, qgain + hi * 8, qr);
    const bf16_t* KCb = KC + (size_t)(b * 2 + g) * 512 * HD; const bf16_t* VCb = VC + (size_t)(b * 2 + g) * 512 * HD;
    const int ntc = (qi >> 4) + 1, cmax = (tq - 31) >> 4;
    f32x16 o[4]; float m_reg, l_reg;
#pragma unroll
    for (int d0 = 0; d0 < 4; ++d0) o[d0] = f32x16{};
    m_reg = 0.f; l_reg = 0.f;
    { CmpCfg c; c.Kb = KCb; c.Vb = VCb; c.cmax = cmax; c.hi4 = 4 * hi; c.cfull = (64 * qi - 31) >> 4; attn_tiles_s(c, lds, qr, o, m_reg, l_reg, 0, ntc, wv); }
    nsa_finalize(lds, o, l_reg, P, ON, gb, b, g, tok0, 0, wv);
    { CmpImpCfg c; c.Kb = KCb; c.cmax = cmax; c.hi4 = 4 * hi; c.mfix = 0.f; c.invl = l_reg > 0.f ? 1.0f / l_reg : 0.f;
#pragma unroll
      for (int d0 = 0; d0 < 4; ++d0) o[d0] = f32x16{};
      float md = 0.f, ld = 0.f; attn_tiles(c, lds, qr, o, md, ld, 0, ntc, wv); }
#pragma unroll
    for (int d0 = 0; d0 < 4; ++d0)
#pragma unroll
        for (int k = 0; k < 4; ++k) IMP[(8 * wid + 2 * k + hi) * 128 + 32 * d0 + r32] = (o[d0][4 * k] + o[d0][4 * k + 1]) + (o[d0][4 * k + 2] + o[d0][4 * k + 3]);
    __syncthreads();
    { const int cur = qi;
#pragma unroll 1
      for (int tl = 8 * wid; tl < 8 * wid + 8; ++tl) {
        const int n0 = lane, n1 = 64 + lane; bool sel0, sel1;
        if (cur <= 15) { sel0 = (n0 <= cur); sel1 = false; }
        else {
            const float v0 = IMP[tl * 128 + n0], v1 = IMP[tl * 128 + n1];
            const unsigned u0 = (n0 >= 1 && n0 <= cur - 2) ? __float_as_uint(v0) + 1u : 0u, u1 = (n1 <= cur - 2) ? __float_as_uint(v1) + 1u : 0u;
            unsigned T = 0u;
#pragma unroll 1
            for (int bit = 30; bit >= 0; --bit) { const unsigned cand = T | (1u << bit);
                const int cnt = __builtin_popcountll(__ballot(u0 >= cand)) + __builtin_popcountll(__ballot(u1 >= cand));
                if (cnt >= 13) T = cand; }
            const bool gt0 = u0 > T, gt1 = u1 > T;
            const int need = 13 - (__builtin_popcountll(__ballot(gt0)) + __builtin_popcountll(__ballot(gt1)));
            const bool eq0 = (u0 == T), eq1 = (u1 == T);
            const unsigned long long m0 = __ballot(eq0), m1 = __ballot(eq1);
            const int pre0 = (int)__builtin_amdgcn_mbcnt_hi((unsigned)(m0 >> 32), __builtin_amdgcn_mbcnt_lo((unsigned)m0, 0u));
            const int pre1 = __builtin_popcountll(m0) + (int)__builtin_amdgcn_mbcnt_hi((unsigned)(m1 >> 32), __builtin_amdgcn_mbcnt_lo((unsigned)m1, 0u));
            sel0 = (n0 == 0 || n0 == cur || n0 == cur - 1) || gt0 || (eq0 && pre0 < need);
            sel1 = (n1 == cur || n1 == cur - 1) || gt1 || (eq1 && pre1 < need);
        }
        const unsigned long long b0 = __ballot(sel0), b1 = __ballot(sel1);
        if (lane == 0) { SELM[tl * 4 + 0] = (unsigned)b0; SELM[tl * 4 + 1] = (unsigned)(b0 >> 32); SELM[tl * 4 + 2] = (unsigned)b1; SELM[tl * 4 + 3] = (unsigned)(b1 >> 32); } } }
    __syncthreads();
    int r32s = r32; asm volatile("" : "+v"(r32s));
    { SlcCfg c; c.Kb = Pb + C_KS + g * HD; c.Vb = Pb + C_VS + g * HD; c.tblh = tbl + (r32s & 3) * TBLS; c.tqm = tok0 + (r32s >> 2) - 4 * hi; c.cur = qi; c.b31 = tbl[(r32s & 3) * TBLS + TBL0 + 1600];
      const int tl = 8 * wid + (r32s >> 2); c.s0 = SELM[tl * 4 + 0]; c.s1 = SELM[tl * 4 + 1]; c.s2 = SELM[tl * 4 + 2]; c.s3 = SELM[tl * 4 + 3];
#pragma unroll
      for (int d0 = 0; d0 < 4; ++d0) o[d0] = f32x16{};
      m_reg = 0.f; l_reg = 0.f;
      attn_tiles_s(c, lds, qr, o, m_reg, l_reg, 0, qi + 1, wv); }
    nsa_finalize(lds, o, l_reg, P, ON, gb, b, g, tok0, 1, wv);
    int r32w = r32; asm volatile("" : "+v"(r32w));
    { WinCfg c; c.Kb = Pb + C_KW + g * HD; c.Vb = Pb + C_VW + g * HD; c.tblh = tbl + (r32w & 3) * TBLS; c.tqm = tok0 + (r32w >> 2) - 4 * hi;
#pragma unroll
      for (int d0 = 0; d0 < 4; ++d0) o[d0] = f32x16{};
      m_reg = 0.f; l_reg = 0.f;
      attn_tiles_s(c, lds, qr, o, m_reg, l_reg, qi >= 8 ? qi - 8 : 0, qi + 1, wv); }
    nsa_finalize(lds, o, l_reg, P, ON, gb, b, g, tok0, 2, wv);
}

constexpr int LDS_BYTES = 147456;
constexpr int LDS_MISC = 131072;
constexpr int LDS_ARGS = LDS_MISC + 64;
__device__ __forceinline__ unsigned long long arg_u64(LAS unsigned char* lds, int i) {
    const LAS unsigned* p = (const LAS unsigned*)(opq_lds(lds) + LDS_ARGS) + 2 * i;
    const unsigned lo = __builtin_amdgcn_readfirstlane(p[0]), hi = __builtin_amdgcn_readfirstlane(p[1]);
    return ((unsigned long long)hi << 32) | lo;
}
#define GAS __attribute__((address_space(1)))
__device__ __forceinline__ const float* arg_in(LAS unsigned char* lds, int i) { return (const float*)(GAS const float*)arg_u64(lds, i); }
__device__ __forceinline__ float* arg_out(LAS unsigned char* lds) { return (float*)(GAS float*)arg_u64(lds, 24); }
__device__ __forceinline__ unsigned char* arg_ws(LAS unsigned char* lds) { return (unsigned char*)(GAS unsigned char*)arg_u64(lds, 25); }
__device__ __forceinline__ int opq_bx() { int b = blockIdx.x; asm volatile("" : "+s"(b)); return b; }
__device__ __forceinline__ int opq_g() { int b = gridDim.x; asm volatile("" : "+s"(b)); return b; }

__device__ __forceinline__ void ph_prologue(LAS unsigned char* lds, const int wv) {
    lds = opq_lds(lds);
    const int tid = opq_tid(wv), lane = tid & 63, wave = __builtin_amdgcn_readfirstlane(tid >> 6), G = opq_g(), bx = opq_bx();
    const int gw = bx * NWAVES + wave, NGW = G * NWAVES;
    unsigned char* ws = arg_ws(lds);
    LAS float* scr = (LAS float*)(lds + wave * 16384);
    constexpr int I_UP = 32 * 176, I_DN = 88 * 64, I_IN = 32 * 177, I_OUT = 32 * 64, I_C1 = 64 * 16, I_Z = 928;
    constexpr int I_FFN = 2 * I_UP + I_DN, I_LAYER = 2 * I_FFN + I_IN + I_OUT + 2 * I_C1 + I_Z;
#pragma unroll 1
    for (int it = gw; it < DEPTH * I_LAYER; it += NGW) {
        const int l = it / I_LAYER; int r = it - l * I_LAYER;
        if (r < 2 * I_FFN) { const int half = r >= I_FFN; r -= half * I_FFN;
            bf16_t* WUP = (bf16_t*)(ws + WS_WUP + (size_t)(l * 2 + half) * SZ_WUP); bf16_t* WDN = (bf16_t*)(ws + WS_WDN + (size_t)(l * 2 + half) * SZ_WDN);
            const float* gn = arg_in(lds, half ? I_F2N : I_F1N) + (size_t)l * DM;
            if (r < I_UP) { transpose_item(arg_in(lds, half ? I_F2W1 : I_F1W1) + (size_t)l * DM * DFF, DM, DFF, WUP, 1, 0, scr, r, lane, gn); continue; } r -= I_UP;
            if (r < I_UP) { transpose_item(arg_in(lds, half ? I_F2W3 : I_F1W3) + (size_t)l * DM * DFF, DM, DFF, WUP, 1, 128, scr, r, lane, gn); continue; } r -= I_UP;
            transpose_item(arg_in(lds, half ? I_F2W2 : I_F1W2) + (size_t)l * DFF * DM, DFF, DM, WDN, 0, 0, scr, r, lane, nullptr); continue; }
        r -= 2 * I_FFN;
        bf16_t* WIN = (bf16_t*)(ws + WS_WIN + (size_t)l * SZ_WIN); bf16_t* WOUT = (bf16_t*)(ws + WS_WOUT + (size_t)l * SZ_WOUT); bf16_t* WC1 = (bf16_t*)(ws + WS_WC1 + (size_t)l * SZ_WC1);
        if (r < I_IN) { transpose_item(arg_in(lds, I_WIN) + (size_t)l * DM * IN_COLS, DM, IN_COLS, WIN, 0, 0, scr, r, lane, arg_in(lds, I_MIXN) + (size_t)l * DM); continue; } r -= I_IN;
        if (r < I_OUT) { transpose_item(arg_in(lds, I_WOUT) + (size_t)l * DM * DM, DM, DM, WOUT, 0, 0, scr, r, lane, nullptr); continue; } r -= I_OUT;
        if (r < I_C1) { transpose_item(arg_in(lds, I_CKW1) + (size_t)l * 4096 * 512, 4096, 512, WC1, 0, 0, scr, r, lane, nullptr); continue; } r -= I_C1;
        if (r < I_C1) { transpose_item(arg_in(lds, I_CVW1) + (size_t)l * 4096 * 512, 4096, 512, WC1, 0, 512, scr, r, lane, nullptr); continue; } r -= I_C1;
        { const int q = r * 64 + lane, kt = q / 1856, rem = q - kt * 1856; u32x4* z = (u32x4*)(WIN + ((size_t)(22 * 32 + kt) * 256 + 24) * 64) + rem; unsigned zr = 0u; asm volatile("" : "+v"(zr)); *z = (u32x4){zr, zr, zr, zr}; }
    }
    const float* xs = arg_in(lds, I_X); bf16_t* XB = (bf16_t*)(ws + WS_HB); float* SSQ = (float*)(ws + WS_SSQ);
    for (int m = gw; m < NTOK; m += NGW) {
        const f32x4* xr = (const f32x4*)(xs + (size_t)m * DM) + lane; f32x4 v[8]; float s = 0.f;
#pragma unroll
        for (int j = 0; j < 8; ++j) { v[j] = xr[64 * j]; s += (v[j].x * v[j].x + v[j].y * v[j].y) + (v[j].z * v[j].z + v[j].w * v[j].w); }
        s = wave_sum(s, lane);
#pragma unroll
        for (int j = 0; j < 8; ++j) { u32x2 w; w.x = cvtpk(v[j].x, v[j].y); w.y = cvtpk(v[j].z, v[j].w); *(u32x2*)(XB + kt_off(m, 256 * j + 4 * lane, DM)) = w; }
        if (lane < 32) SSQ[(size_t)m * 32 + lane] = (lane == 0) ? s : 0.f;
    }
}
__device__ __forceinline__ void ph_rstd(LAS unsigned char* lds, const int wv) {
    lds = opq_lds(lds);
    const int tid = opq_tid(wv), G = opq_g(), bx = opq_bx();
    unsigned char* ws = arg_ws(lds); const float* SSQ = (const float*)(ws + WS_SSQ); float* RSTD = (float*)(ws + WS_RSTD);
    for (int m = bx * NTHR + tid; m < NTOK; m += G * NTHR) { const f32x4* p = (const f32x4*)(SSQ + (size_t)m * 32); f32x4 a = p[0];
#pragma unroll
        for (int j = 1; j < 8; ++j) a = a + p[j];
        RSTD[m] = 1.0f / sqrtf(((a.x + a.y) + (a.z + a.w)) * (1.f / DM) + EPS); }
}
__device__ __forceinline__ void ph_headnorm(LAS unsigned char* lds, int l, const int wv) {
    lds = opq_lds(lds);
    const int tid = opq_tid(wv), lane = tid & 63, wave = __builtin_amdgcn_readfirstlane(tid >> 6), G = opq_g(), bx = opq_bx();
    const int gw = bx * NWAVES + wave, NGW = G * NWAVES;
    unsigned char* ws = arg_ws(lds); bf16_t* HP = (bf16_t*)(ws + WS_HP); bf16_t* ACMP = (bf16_t*)(ws + WS_ACMP);
    const float* qna = arg_in(lds, I_QNA) + l * HD; const float* kna = arg_in(lds, I_KNA) + l * HD; const float* qnn = arg_in(lds, I_QNN) + l * HD; const float* knn = arg_in(lds, I_KNN) + l * HD;
    const float* pos = arg_in(lds, I_POS) + (size_t)l * 32 * HD;
    const int e0 = (lane & 15) * 8;
    const f32x4 ga0 = *(const f32x4*)(kna + e0), ga1 = *(const f32x4*)(kna + e0 + 4), gn0 = *(const f32x4*)(knn + e0), gn1 = *(const f32x4*)(knn + e0 + 4);
    for (int m = gw; m < NTOK; m += NGW) {
        bf16_t* prow = HP + (size_t)m * PC;
        const int jt = m & 15;
        const f32x4 pa0 = *(const f32x4*)(pos + jt * HD + e0), pa1 = *(const f32x4*)(pos + jt * HD + e0 + 4), pb0 = *(const f32x4*)(pos + (jt + 16) * HD + e0), pb1 = *(const f32x4*)(pos + (jt + 16) * HD + e0 + 4);
        int cols[3]; u32x4 wl[3];
#pragma unroll
        for (int ch = 0; ch < 3; ++ch) { cols[ch] = (ch < 2) ? C_KA + ch * 512 + lane * 8 : (lane < 32 ? C_KS + lane * 8 : C_KW + (lane - 32) * 8);
            wl[ch] = *(const u32x4*)(prow + cols[ch]); }
        const u32x4 wcv = *(const u32x4*)(prow + C_KC + lane * 8);
#pragma unroll
        for (int ch = 0; ch < 3; ++ch) {
            const float sc = 1.f;
            const u32x4 w = wl[ch];
            float v[8] = {bflo(w.x), bfhi(w.x), bflo(w.y), bfhi(w.y), bflo(w.z), bfhi(w.z), bflo(w.w), bfhi(w.w)};
            float s = 0.f;
#pragma unroll
            for (int i = 0; i < 8; ++i) s += v[i] * v[i];
            s += shx(s, 1, lane); s += shx(s, 2, lane); s += shx(s, 4, lane); s += shx(s, 8, lane);
            const float rs = sc / sqrtf(s * (1.f / HD) + EPS);
            const f32x4 g0 = (ch < 2) ? ga0 : gn0, g1 = (ch < 2) ? ga1 : gn1;
            u32x4 o; o.x = cvtpk(v[0] * rs * g0.x, v[1] * rs * g0.y); o.y = cvtpk(v[2] * rs * g0.z, v[3] * rs * g0.w); o.z = cvtpk(v[4] * rs * g1.x, v[5] * rs * g1.y); o.w = cvtpk(v[6] * rs * g1.z, v[7] * rs * g1.w);
            *(u32x4*)(prow + cols[ch]) = o;
        }
        { const int b = m / SEQ, t = m % SEQ, kv = lane >> 5, gg = (lane >> 4) & 1, c1 = t >> 4, j1 = t & 15;
          const u32x4 w = wcv;
          const float v[8] = {bflo(w.x), bfhi(w.x), bflo(w.y), bfhi(w.y), bflo(w.z), bfhi(w.z), bflo(w.w), bfhi(w.w)};
          const int arow0 = kv * 4096 + (b * 2 + gg) * 512;
          if (c1 <= 510) { const f32x4 p0 = pa0, p1 = pa1;
              u32x4 o; o.x = cvtpk(v[0] + p0.x, v[1] + p0.y); o.y = cvtpk(v[2] + p0.z, v[3] + p0.w); o.z = cvtpk(v[4] + p1.x, v[5] + p1.y); o.w = cvtpk(v[6] + p1.z, v[7] + p1.w);
              *(u32x4*)(ACMP + kt_off(arow0 + c1, j1 * HD + e0, 4096)) = o; }
          else { const u32x4 z = {0u, 0u, 0u, 0u}; *(u32x4*)(ACMP + kt_off(arow0 + 511, j1 * HD + e0, 4096)) = z; *(u32x4*)(ACMP + kt_off(arow0 + 511, (j1 + 16) * HD + e0, 4096)) = z; }
          if (c1 >= 1) { const int j2 = j1 + 16; const f32x4 p0 = pb0, p1 = pb1;
              u32x4 o; o.x = cvtpk(v[0] + p0.x, v[1] + p0.y); o.y = cvtpk(v[2] + p0.z, v[3] + p0.w); o.z = cvtpk(v[4] + p1.x, v[5] + p1.y); o.w = cvtpk(v[6] + p1.z, v[7] + p1.w);
              *(u32x4*)(ACMP + kt_off(arow0 + c1 - 1, j2 * HD + e0, 4096)) = o; } }
    }
}
__device__ __forceinline__ float gelu_tanh(float v) { const float u3 = 0.7978845608028654f * (v + 0.044715f * v * v * v); return 0.5f * v * (2.0f - 2.0f / (__expf(2.0f * u3) + 1.0f)); }
__device__ __forceinline__ void ph_cmp2(LAS unsigned char* lds, int l, const int wv) {
    lds = opq_lds(lds);
    const int tid = opq_tid(wv), lane = tid & 63, wave = __builtin_amdgcn_readfirstlane(tid >> 6), G = opq_g(), bx = opq_bx();
    unsigned char* ws = arg_ws(lds); const float* CP = (const float*)(ws + WS_CP);
    LAS float* CH = (LAS float*)lds;
    LAS float* RED = (LAS float*)(lds + 65536);
    const float* knn = arg_in(lds, I_KNN) + l * HD;
    for (int it = bx; it < 256; it += G) {
        const int R0 = it * 32, kv = R0 >> 12, rl0 = R0 & 4095;
        __syncthreads();
        for (int i4 = tid; i4 < 32 * 128; i4 += NTHR) { const int rr = i4 >> 7, k4 = (i4 & 127) * 4; f32x4 v = {0.f, 0.f, 0.f, 0.f};
#pragma unroll
            for (int ks = 0; ks < 4; ++ks) v = v + *(const f32x4*)(CP + ((size_t)(kv * 4 + ks) * 4096 + rl0 + rr) * 512 + k4);
            f32x4 o; o.x = gelu_tanh(v.x); o.y = gelu_tanh(v.y); o.z = gelu_tanh(v.z); o.w = gelu_tanh(v.w);
            *(LAS f32x4*)(CH + rr * 512 + k4) = o; }
        __syncthreads();
        const int n = tid & 127, rq = tid >> 7;
        const float* w2 = arg_in(lds, kv ? I_CVW2 : I_CKW2) + (size_t)l * 512 * HD + n;
        float acc[8];
#pragma unroll
        for (int i = 0; i < 8; ++i) acc[i] = 0.f;
#pragma unroll 4
        for (int k = 0; k < 512; k += 4) { const float w0 = w2[(size_t)k * HD], w1 = w2[(size_t)(k + 1) * HD], w2v = w2[(size_t)(k + 2) * HD], w3 = w2[(size_t)(k + 3) * HD];
#pragma unroll
            for (int i = 0; i < 8; ++i) { const f32x4 c = *(const LAS f32x4*)(CH + (rq * 8 + i) * 512 + k); acc[i] += (c.x * w0 + c.y * w1) + (c.z * w2v + c.w * w3); } }
        if (kv == 0) {
            float ss[8];
#pragma unroll
            for (int i = 0; i < 8; ++i) ss[i] = wave_sum(acc[i] * acc[i], lane);
            if (lane == 0) {
#pragma unroll
                for (int i = 0; i < 8; ++i) RED[wave * 8 + i] = ss[i]; }
            __syncthreads();
            const float gn = knn[n];
#pragma unroll
            for (int i = 0; i < 8; ++i) { const float tot = RED[(2 * rq) * 8 + i] + RED[(2 * rq + 1) * 8 + i]; acc[i] = acc[i] / sqrtf(tot * (1.f / HD) + EPS) * gn; }
        }
        bf16_t* dst = (bf16_t*)(ws + (kv ? WS_VC + 0 : WS_KC + 0)) + (size_t)(rl0 + rq * 8) * HD + n;
#pragma unroll
        for (int i = 0; i < 8; ++i) dst[(size_t)i * HD] = (bf16_t)f2bf(acc[i]);
    }
}
__device__ __forceinline__ void ph_outnorm(LAS unsigned char* lds, int l, const int wv) {
    lds = opq_lds(lds);
    const int tid = opq_tid(wv), lane = tid & 63, wave = __builtin_amdgcn_readfirstlane(tid >> 6), G = opq_g(), bx = opq_bx();
    const int gw = bx * NWAVES + wave, NGW = G * NWAVES;
    unsigned char* ws = arg_ws(lds); const bf16_t* OA = (const bf16_t*)(ws + WS_OA); const bf16_t* ON = (const bf16_t*)(ws + WS_ON); bf16_t* HB = (bf16_t*)(ws + WS_HP);
    const float* gn = arg_in(lds, I_ON) + (size_t)l * DM;
    const f32x4 ga0 = *(const f32x4*)(gn + lane * 8), ga1 = *(const f32x4*)(gn + lane * 8 + 4), ga2 = *(const f32x4*)(gn + 512 + lane * 8), ga3 = *(const f32x4*)(gn + 512 + lane * 8 + 4);
    const f32x4 gb0 = *(const f32x4*)(gn + 1024 + lane * 8), gb1 = *(const f32x4*)(gn + 1024 + lane * 8 + 4), gb2 = *(const f32x4*)(gn + 1536 + lane * 8), gb3 = *(const f32x4*)(gn + 1536 + lane * 8 + 4);
    for (int m = gw; m < NTOK; m += NGW) {
        const bf16_t* oa = OA + (size_t)m * 1024; bf16_t* y = HB;
        const u32x4 wa = *(const u32x4*)(oa + lane * 8), wb = *(const u32x4*)(oa + 512 + lane * 8);
        u32x4 wn[6];
#pragma unroll
        for (int br = 0; br < 3; ++br) { const bf16_t* onb = ON + ((size_t)br * NTOK + m) * 1024; wn[2 * br] = *(const u32x4*)(onb + lane * 8); wn[2 * br + 1] = *(const u32x4*)(onb + 512 + lane * 8); }
        float va[16] = {bflo(wa.x), bfhi(wa.x), bflo(wa.y), bfhi(wa.y), bflo(wa.z), bfhi(wa.z), bflo(wa.w), bfhi(wa.w), bflo(wb.x), bfhi(wb.x), bflo(wb.y), bfhi(wb.y), bflo(wb.z), bfhi(wb.z), bflo(wb.w), bfhi(wb.w)};
        float sa = 0.f;
#pragma unroll
        for (int i = 0; i < 16; ++i) sa += va[i] * va[i];
        float vs[16]; float sn = 0.f;
#pragma unroll
        for (int i = 0; i < 16; ++i) vs[i] = 0.f;
#pragma unroll
        for (int br = 0; br < 3; ++br) { const u32x4 wc = wn[2 * br], wd = wn[2 * br + 1];
            vs[0] += bflo(wc.x); vs[1] += bfhi(wc.x); vs[2] += bflo(wc.y); vs[3] += bfhi(wc.y); vs[4] += bflo(wc.z); vs[5] += bfhi(wc.z); vs[6] += bflo(wc.w); vs[7] += bfhi(wc.w);
            vs[8] += bflo(wd.x); vs[9] += bfhi(wd.x); vs[10] += bflo(wd.y); vs[11] += bfhi(wd.y); vs[12] += bflo(wd.z); vs[13] += bfhi(wd.z); vs[14] += bflo(wd.w); vs[15] += bfhi(wd.w); }
        const float ra = 1.0f / sqrtf(wave_sum(sa, lane) * (1.f / 1024.f) + EPS);
        { const f32x4 g0 = ga0, g1 = ga1, g2 = ga2, g3 = ga3;
          u32x4 o; o.x = cvtpk(va[0] * ra * g0.x, va[1] * ra * g0.y); o.y = cvtpk(va[2] * ra * g0.z, va[3] * ra * g0.w); o.z = cvtpk(va[4] * ra * g1.x, va[5] * ra * g1.y); o.w = cvtpk(va[6] * ra * g1.z, va[7] * ra * g1.w);
          *(u32x4*)(y + kt_off(m, lane * 8, DM)) = o;
          o.x = cvtpk(va[8] * ra * g2.x, va[9] * ra * g2.y); o.y = cvtpk(va[10] * ra * g2.z, va[11] * ra * g2.w); o.z = cvtpk(va[12] * ra * g3.x, va[13] * ra * g3.y); o.w = cvtpk(va[14] * ra * g3.z, va[15] * ra * g3.w);
          *(u32x4*)(y + kt_off(m, 512 + lane * 8, DM)) = o; }
#pragma unroll
        for (int i = 0; i < 16; ++i) sn += vs[i] * vs[i];
        const float rn = 1.0f / sqrtf(wave_sum(sn, lane) * (1.f / 1024.f) + EPS);
        { const f32x4 g0 = gb0, g1 = gb1, g2a = gb2, g3 = gb3;
          u32x4 o; o.x = cvtpk(vs[0] * rn * g0.x, vs[1] * rn * g0.y); o.y = cvtpk(vs[2] * rn * g0.z, vs[3] * rn * g0.w); o.z = cvtpk(vs[4] * rn * g1.x, vs[5] * rn * g1.y); o.w = cvtpk(vs[6] * rn * g1.z, vs[7] * rn * g1.w);
          *(u32x4*)(y + kt_off(m, 1024 + lane * 8, DM)) = o;
          o.x = cvtpk(vs[8] * rn * g2a.x, vs[9] * rn * g2a.y); o.y = cvtpk(vs[10] * rn * g2a.z, vs[11] * rn * g2a.w); o.z = cvtpk(vs[12] * rn * g3.x, vs[13] * rn * g3.y); o.w = cvtpk(vs[14] * rn * g3.z, vs[15] * rn * g3.w);
          *(u32x4*)(y + kt_off(m, 1536 + lane * 8, DM)) = o; }
    }
}

#define GRID_BAR() do { XcdBarrier bar_; bar_.bar = (unsigned*)(arg_ws(lds) + WS_CTL) + CW_BAR; bar_.x = xb_xcc_id(); bar_.st = (volatile LAS unsigned*)(opq_lds(lds) + LDS_MISC + 32); xcd_barrier(bar_, wv); } while (0)
__global__ void __launch_bounds__(NTHR, 2) mega_fwd(Args a) {
    extern __shared__ __attribute__((aligned(16))) unsigned char lds_raw[];
    LAS unsigned char* lds = (LAS unsigned char*)lds_raw;
    const int wv = __builtin_amdgcn_readfirstlane((int)threadIdx.x >> 6);
    {
        const int tid = threadIdx.x;
        for (int u = tid; u < (LDS_BYTES - LDS_MISC) / 4; u += NTHR) ((LAS unsigned*)(lds + LDS_MISC))[u] = 0u;
        __syncthreads();
        if (tid == 0) { LAS unsigned long long* t = (LAS unsigned long long*)(lds + LDS_ARGS);
#pragma unroll
            for (int i = 0; i < 24; ++i) t[i] = (unsigned long long)(uintptr_t)a.in[i];
            t[24] = (unsigned long long)(uintptr_t)a.out; t[25] = (unsigned long long)(uintptr_t)a.ws; }
        __syncthreads();
    }
    (void)xcd_barrier_post((unsigned*)(arg_ws(lds) + WS_CTL) + CW_BAR, (volatile LAS unsigned*)(lds + LDS_MISC + 32));

    { const int tid = opq_tid(wv), G = opq_g(), bx = opq_bx(); const float* rb = arg_in(lds, I_RB); unsigned char* ws = arg_ws(lds);
      float* dilT = (float*)(ws + WS_TBL); float* nsaT = (float*)(ws + WS_TBL + 65536);
      for (int i = bx * NTHR + tid; i < 3 * 8 * DTS + 8 * TBLS; i += G * NTHR) {
          if (i < 3 * 8 * DTS) { const int p = i / (8 * DTS), h = (i / DTS) % 8, df = i % DTS - DT0; const int d = (p == 0) ? 1 : (p == 1 ? 4 : 16);
              dilT[i] = (df >= 0 && df <= 128) ? rb[rel_bucket_dev(df * d) * 16 + h] : 0.f; }
          else { const int j = i - 3 * 8 * DTS, hh = j / TBLS, ds = j % TBLS - TBL0; nsaT[j] = (ds >= 0) ? rb[rel_bucket_dev(ds) * 16 + 8 + hh] : 0.f; } } }

    ph_prologue(lds, wv);
    GRID_BAR();
#pragma unroll 1
    for (int step = 0; step < 2 * DEPTH; ++step) {
        const int l = step >> 1, half = step & 1;
        { unsigned char* ws = arg_ws(lds); const int G = opq_g(), bx = opq_bx();
          pg8::Gemm g{64, 64, DM}; pg8::SchedStd S; S.init(ws + WS_HB, ws + WS_WUP + (size_t)step * SZ_WUP, NTOK, 2 * DFF, DM, DM, G, bx); const pg8::EpiSwiGLU E{(bf16_t*)(ws + WS_HP), DFF, (const float*)(ws + WS_SSQ)};
          pg8::gemm_phase<pg8::EpiSwiGLU, pg8::SchedStd, 32768, 32768>(opq_lds(lds), g, S, E, wv);
        }
        GRID_BAR();
        { unsigned char* ws = arg_ws(lds); const int G = opq_g(), bx = opq_bx(); float* X = arg_out(lds);
          pg8::Gemm g{64, 64, DFF}; pg8::SchedStd S; S.init(ws + WS_HP, ws + WS_WDN + (size_t)step * SZ_WDN, NTOK, DM, DFF, DFF, G, bx, 4, 1);
          pg8::EpiResid E{(step == 2 * DEPTH - 1) ? X : (float*)nullptr, (bf16_t*)(ws + WS_HB), (float*)(ws + WS_SSQ), DM, 0.5f};
          pg8::gemm_phase<pg8::EpiResid, pg8::SchedStd, 32768, 32768>(opq_lds(lds), g, S, E, wv);
        }
        if (step == 2 * DEPTH - 1) break;
        GRID_BAR();
        if (half == 0) {
            { unsigned char* ws = arg_ws(lds); const int G = opq_g(), bx = opq_bx();
              pg8::Gemm g{64, 64, DM}; pg8::SchedStd S; S.init(ws + WS_HB, ws + WS_WIN + (size_t)l * SZ_WIN, NTOK, PC, DM, DM, G, bx); const pg8::EpiBf16 E{(bf16_t*)(ws + WS_HP), PC, (const float*)(ws + WS_SSQ)};
              pg8::gemm_phase<pg8::EpiBf16, pg8::SchedStd, 32768, 32768>(opq_lds(lds), g, S, E, wv);
            }
            GRID_BAR();
            ph_headnorm(lds, l, wv);
            GRID_BAR();
#pragma unroll 1
            for (int pat3 = 0; pat3 < 3; ++pat3) { const int pat = pat3 % 3;
                if (pat3 == 0) { unsigned char* ws = arg_ws(lds); const int G = opq_g(), bx = opq_bx();
                  pg8::Gemm g{64, 64, 1024}; pg8::SchedCmp S; S.A = (const char*)(ws + WS_ACMP); S.Bt = (const char*)(ws + WS_WC1 + (size_t)l * SZ_WC1); S.G = G; S.c = bx; pg8::EpiF32Z E{(float*)(ws + WS_CP), 512, (size_t)4096 * 512};
                  pg8::gemm_phase<pg8::EpiF32Z, pg8::SchedCmp, 32768, 32768>(opq_lds(lds), g, S, E, wv); }
                if (pat3 == 1) ph_cmp2(lds, l, wv);
                { unsigned char* ws = arg_ws(lds); const int G = opq_g(), bx = opq_bx();
                  for (int u0 = bx; u0 < 1024; u0 += G) { const int w_ = u0 & 255, k_ = u0 >> 8; const int unit = (((w_ & 7) + 8 * k_) << 5) | (w_ >> 3);
                    dil_unit((LAS char*)opq_lds(lds), (const bf16_t*)(ws + WS_HP), (bf16_t*)(ws + WS_OA), (float*)(ws + WS_LSE), (const float*)(ws + WS_TBL), arg_in(lds, I_QNA) + l * HD, pat, 2 * pat, unit, wv); } }
                if (pat3 + 1 < 3) GRID_BAR();
            }
            { unsigned char* ws = arg_ws(lds); const int G = opq_g(), bx = opq_bx();
              const float* gb = arg_in(lds, I_GB) + l * 24; const float* qgn = arg_in(lds, I_QNN) + l * HD;
              int last_bg = -1;
#pragma unroll 1
              for (int i4 = 0; i4 < 4; ++i4)
#pragma unroll 1
                  for (int w = bx; w < 256; w += G) { const int i = i4 & 3; const int bg = w & 7, j = w >> 3;
                      const int qi = (i == 0) ? 127 - j : (i == 1 ? j : (i == 2 ? 64 + j : 63 - j));
                      nsa_unit((LAS char*)opq_lds(lds), (const bf16_t*)(ws + WS_HP), (const bf16_t*)(ws + WS_KC), (const bf16_t*)(ws + WS_VC), (bf16_t*)(ws + WS_ON), (const float*)(ws + WS_TBL + 65536), gb, qgn, bg >> 1, bg & 1, qi, bg != last_bg, wv); last_bg = bg; } }
            GRID_BAR();
            ph_outnorm(lds, l, wv);
            GRID_BAR();
            { unsigned char* ws = arg_ws(lds); const int G = opq_g(), bx = opq_bx(); float* X = arg_out(lds);
              pg8::Gemm g{64, 64, DM}; pg8::SchedStd S; S.init(ws + WS_HP, ws + WS_WOUT + (size_t)l * SZ_WOUT, NTOK, DM, DM, DM, G, bx, 4); pg8::EpiResid E{(float*)nullptr, (bf16_t*)(ws + WS_HB), (float*)(ws + WS_SSQ), DM, 1.0f};
              pg8::gemm_phase<pg8::EpiResid, pg8::SchedStd, 32768, 32768>(opq_lds(lds), g, S, E, wv);
            }
            GRID_BAR();
        }
    }
}

extern "C" void kernel_launch(void* const* d_in, const int* in_sizes, int n_in, void* d_out, int out_size, void* d_ws, size_t ws_size, hipStream_t stream) {
    static int grid = 0;
    if (grid == 0) {
        if (n_in != 24 || in_sizes[0] != NTOK * DM || out_size != NTOK * DM || ws_size < WS_END) { fprintf(stderr, "kernel_launch: shape mismatch n_in %d in0 %d out %d ws %zu (need %zu)\n", n_in, n_in > 0 ? in_sizes[0] : -1, out_size, ws_size, (size_t)WS_END); grid = -1; return; }
        int dev = 0, cus = 0, per_cu = 0;
        if (hipGetDevice(&dev) != hipSuccess || hipDeviceGetAttribute(&cus, hipDeviceAttributeMultiprocessorCount, dev) != hipSuccess) { grid = -1; return; }
        if (hipFuncSetAttribute((const void*)mega_fwd, hipFuncAttributeMaxDynamicSharedMemorySize, LDS_BYTES) != hipSuccess) { fprintf(stderr, "kernel_launch: hipFuncSetAttribute failed\n"); grid = -1; return; }
        if (hipOccupancyMaxActiveBlocksPerMultiprocessor(&per_cu, (const void*)mega_fwd, NTHR, LDS_BYTES) != hipSuccess || per_cu < 1) { fprintf(stderr, "kernel_launch: occupancy query says %d\n", per_cu); (void)hipGetLastError(); if (per_cu < 1) { grid = -1; return; } }
        grid = cus;
    }
    if (grid < 0) return;
    if (hipMemsetAsync((char*)d_ws + WS_CTL, 0, CTL_ZERO_BYTES, stream) != hipSuccess) return;
    Args a{};
    for (int i = 0; i < 24; ++i) a.in[i] = (const float*)d_in[i];
    a.out = (float*)d_out; a.ws = (unsigned char*)d_ws;
    hipLaunchKernelGGL(mega_fwd, dim3(grid), dim3(NTHR), LDS_BYTES, stream, a);
    const hipError_t le = hipPeekAtLastError();
    if (le != hipSuccess) fprintf(stderr, "kernel_launch: launch failed: %s\n", hipGetErrorName(le));
}
```

```cpp
#include <hip/hip_runtime.h>
#include <cstdio>
#include <cstdint>

#define LAS __attribute__((address_space(3)))
typedef unsigned short bf16_t;
typedef short bf16x8 __attribute__((ext_vector_type(8)));
typedef short s16x4 __attribute__((ext_vector_type(4)));
typedef float f32x2 __attribute__((ext_vector_type(2)));
typedef float f32x4 __attribute__((ext_vector_type(4)));
typedef float f32x16 __attribute__((ext_vector_type(16)));
typedef unsigned u32x2 __attribute__((ext_vector_type(2)));
typedef unsigned u32x4 __attribute__((ext_vector_type(4)));

constexpr int BATCH = 4, SEQ = 8192, DM = 2048, DFF = 5632, NTOK = BATCH * SEQ, DEPTH = 4, HD = 128;
constexpr int IN_COLS = 5656, PC = 5888;
constexpr int C_QA = 0, C_KA = 1024, C_VA = 2048, C_QN = 3072, C_KC = 4096, C_VC = 4352, C_KS = 4608, C_VS = 4864, C_KW = 5120, C_VW = 5376, C_GL = 5632;
constexpr float EPS = 1e-6f, QSCALE = 0.08838834764831845f, LOG2E = 1.4426950408889634f;
constexpr int TBLS = 1704, TBL0 = 64;
constexpr int DTS = 320, DT0 = 96;
constexpr int NWAVES = 8, NTHR = 512;

constexpr size_t MiB = 1u << 20;
constexpr size_t WS_CTL = 0, CTL_ZERO_BYTES = 1 * MiB;
constexpr size_t WS_TBL = 1 * MiB;
constexpr size_t SZ_WUP = 44 * MiB, SZ_WDN = 22 * MiB, SZ_WIN = 23 * MiB, SZ_WOUT = 8 * MiB, SZ_WC1 = 8 * MiB;
constexpr size_t WS_WUP = 2 * MiB;
constexpr size_t WS_WDN = WS_WUP + 8 * SZ_WUP;
constexpr size_t WS_WIN = WS_WDN + 8 * SZ_WDN;
constexpr size_t WS_WOUT = WS_WIN + 4 * SZ_WIN;
constexpr size_t WS_WC1 = WS_WOUT + 4 * SZ_WOUT;
constexpr size_t WS_HB = WS_WC1 + 4 * SZ_WC1;
constexpr size_t WS_HP = WS_HB + 128 * MiB;
constexpr size_t WS_OA = WS_HP + 368 * MiB;
constexpr size_t WS_LSE = WS_OA + 64 * MiB;
constexpr size_t WS_ON = WS_LSE + 1 * MiB;
constexpr size_t WS_ACMP = WS_ON + 192 * MiB;
constexpr size_t WS_CP = WS_ACMP + 64 * MiB;
constexpr size_t WS_KC = WS_CP + 64 * MiB;
constexpr size_t WS_VC = WS_KC + 1 * MiB;
constexpr size_t WS_SSQ = WS_VC + 1 * MiB;
constexpr size_t WS_RSTD = WS_SSQ + 4 * MiB;
constexpr size_t WS_END = WS_RSTD + 1 * MiB;
constexpr int CW_BAR = 4096;

__device__ __forceinline__ unsigned f2bf(float f) { unsigned u = __builtin_bit_cast(unsigned, f); return (u + 0x7fffu + ((u >> 16) & 1u)) >> 16; }
__device__ __forceinline__ unsigned pk2(float lo, float hi) { return f2bf(lo) | (f2bf(hi) << 16); }
__device__ __forceinline__ float bf2f(bf16_t b) { return __builtin_bit_cast(float, ((unsigned)b) << 16); }
__device__ __forceinline__ float bflo(unsigned w) { return __builtin_bit_cast(float, w << 16); }
__device__ __forceinline__ float bfhi(unsigned w) { return __builtin_bit_cast(float, w & 0xffff0000u); }
__device__ __forceinline__ unsigned cvtpk(float lo, float hi) { unsigned r; asm volatile("v_cvt_pk_bf16_f32 %0, %1, %2" : "=v"(r) : "v"(lo), "v"(hi)); return r; }
__device__ __forceinline__ float shx(float v, int m, int lane) { return __builtin_bit_cast(float, __builtin_amdgcn_ds_bpermute((lane ^ m) << 2, __builtin_bit_cast(int, v))); }
__device__ __forceinline__ float wave_sum(float v, int lane) {
#pragma unroll
    for (int o = 1; o < 64; o <<= 1) v += shx(v, o, lane);
    return v;
}
__device__ __forceinline__ LAS unsigned char* opq_lds(LAS unsigned char* p) { unsigned a = (unsigned)(uintptr_t)p; asm volatile("" : "+s"(a)); return (LAS unsigned char*)(uintptr_t)a; }
__device__ __forceinline__ int opq_tid(int wv) { int l; asm volatile("v_mbcnt_lo_u32_b32 %0, -1, 0\n\tv_mbcnt_hi_u32_b32 %0, -1, %0" : "=v"(l)); return wv * 64 + l; }
__device__ __forceinline__ size_t kt_off(int r, int k, int K) { return (((size_t)(r >> 8) * (K >> 6) + (k >> 6)) * 256 + (r & 255)) * 64 + (k & 63); }
#define LDS_WAIT() asm volatile("s_waitcnt lgkmcnt(0)" ::: "memory")
#define VM_WAIT() asm volatile("s_waitcnt vmcnt(0)" ::: "memory")
#define SBAR() __builtin_amdgcn_sched_barrier(0)

#define XB_TMO      128
#define XB_XCNT(j)  (256  + 64 * (j))
#define XB_XSUB(j)  (1280 + 64 * (j))
#define XB_XGEN(j)  (2304 + 64 * (j))
#define XB_TOP      3328
#define XB_TOPGEN   3392
#define XCD_BAR_WORDS 3456
#define XB_SPIN_CAP (1u << 18)
__device__ __forceinline__ unsigned xb_ld(unsigned* p)              { return __hip_atomic_load(p, __ATOMIC_RELAXED, __HIP_MEMORY_SCOPE_AGENT); }
__device__ __forceinline__ unsigned xb_add(unsigned* p, unsigned v) { return __hip_atomic_fetch_add(p, v, __ATOMIC_RELAXED, __HIP_MEMORY_SCOPE_AGENT); }
__device__ __forceinline__ unsigned xb_xcc_id() { return (unsigned)__builtin_amdgcn_s_getreg((3 << 11) | 20) & 0xFu; }
#define XB_SPIN(cond, bar) do { unsigned _sp = 0; while (cond) { __builtin_amdgcn_s_sleep(1); \
    if ((++_sp & 255u) == 0u) { if (xb_ld(&(bar)[XB_TMO])) break; if (_sp > XB_SPIN_CAP) { atomicAdd(&(bar)[XB_TMO], 1u); break; } } } } while (0)
struct XcdBarrier { unsigned* bar; unsigned x; volatile LAS unsigned* st; };
__device__ __forceinline__ XcdBarrier xcd_barrier_post(unsigned* bar, volatile LAS unsigned* st) {
    XcdBarrier b; b.bar = bar; b.x = xb_xcc_id(); b.st = st;
    if (threadIdx.x == 0) (void)xb_add(&bar[XB_XCNT(b.x)], 1u);
    return b;
}
__device__ __forceinline__ void xcd_barrier_complete(unsigned* bar, unsigned x, unsigned& nloc, unsigned& nx) {
    const unsigned G = gridDim.x * gridDim.y * gridDim.z;
    unsigned sum, cnt, mine, sp = 0u;
    for (;;) {
        sum = 0u; cnt = 0u; mine = 0u;
#pragma unroll
        for (unsigned j = 0; j < 16; ++j) { const unsigned c = xb_ld(&bar[XB_XCNT(j)]); sum += c; cnt += (c > 0u) ? 1u : 0u; mine = (j == x) ? c : mine; }
        if (sum == G) break;
        __builtin_amdgcn_s_sleep(1);
        if ((++sp & 255u) == 0u) { if (xb_ld(&bar[XB_TMO])) break; if (sp > XB_SPIN_CAP) { atomicAdd(&bar[XB_TMO], 1u); break; } }
    }
    nloc = mine > 0u ? mine : 1u; nx = cnt > 0u ? cnt : 1u;
}
__device__ __forceinline__ void xcd_barrier(const XcdBarrier& b, const int wv) {
    asm volatile("s_waitcnt vmcnt(0)" ::: "memory");
    __syncthreads();
    if (opq_tid(wv) == 0) {
        unsigned* bar = b.bar; asm volatile("" : "+s"(bar));
        __builtin_amdgcn_s_waitcnt(0);
        unsigned nloc = b.st[0], nx = b.st[1];
        if (nloc == 0u) { xcd_barrier_complete(bar, b.x, nloc, nx); b.st[0] = nloc; b.st[1] = nx; }
        const unsigned old = xb_add(&bar[XB_XSUB(b.x)], 1u);
        const unsigned gen = old / nloc;
        if (old + 1u == (gen + 1u) * nloc) {
            __builtin_amdgcn_fence(__ATOMIC_RELEASE, "agent");
            asm volatile("s_waitcnt vmcnt(0)" ::: "memory");
            const unsigned og = xb_add(&bar[XB_TOP], 1u);
            const unsigned tg = og / nx;
            if (og + 1u == (tg + 1u) * nx) xb_add(&bar[XB_TOPGEN], 1u);
            else XB_SPIN(xb_ld(&bar[XB_TOPGEN]) == tg, bar);
            __builtin_amdgcn_fence(__ATOMIC_ACQUIRE, "agent");
            xb_add(&bar[XB_XGEN(b.x)], 1u);
            asm volatile("s_waitcnt vmcnt(0)" ::: "memory");
        } else {
            XB_SPIN(xb_ld(&bar[XB_XGEN(b.x)]) == gen, bar);
            __builtin_amdgcn_fence(__ATOMIC_ACQUIRE, "agent");
            asm volatile("s_waitcnt vmcnt(0)" ::: "memory");
        }
    }
    __syncthreads();
}

namespace pg8 {
constexpr int BM = 256, BK = 64, HALF = 128, HTB = HALF * BK * 2, STAGE_BYTES = 8 * HTB, NXCD = 8, WGM = 8;
__host__ __device__ __forceinline__ int lds_byte(int r, int c) { const int st = (r >> 4) * 2 + (c >> 5), rr = r & 15, cc = c & 31, ob = rr * 64 + cc * 2; return st * 1024 + (ob ^ (((ob >> 9) & 1) << 5)); }
__host__ __device__ __forceinline__ void stage_rc(int b, int& R, int& C) { const int st = b / 1024, sb = b % 1024, swz = sb ^ (((sb >> 9) & 1) << 5); R = (st >> 1) * 16 + swz / 64; C = (st & 1) * 32 + (swz % 64) / 2; }
__host__ __device__ __forceinline__ int perm32(int rho) { const int n = rho >> 4, i = rho & 15; return 8 * (i >> 2) + 4 * n + (i & 3); }
struct Unit { int pm, pn, z; };
struct Gemm { int lda, ldb, K; };
struct SchedStd {
    const char* A; const char* Bt; size_t atile, btile; int nM, nN, nwg, G, c, wgm, flip;
    __device__ __forceinline__ void init(const void* A_, const void* Bt_, int M, int N, int lda, int ldb, int G_, int c_, int wgm_ = WGM, int flip_ = 0) { wgm = wgm_; flip = flip_;
        A = (const char*)A_; Bt = (const char*)Bt_; atile = (size_t)BM * lda * 2; btile = (size_t)BM * ldb * 2; nM = M / BM; nN = N / BM; nwg = nM * nN; G = G_; c = c_; }
    __device__ __forceinline__ bool next(int i, Unit& u) const {
        const long L = (long)i * G + c; if (L >= nwg) return false;
        int wgid = (int)L; { const int q = nwg / NXCD, r = nwg % NXCD, xcd = wgid % NXCD, off = wgid / NXCD; wgid = (xcd < r ? xcd * (q + 1) : r * (q + 1) + (xcd - r) * q) + off; }
        const int nig = wgm * nN, gid = wgid / nig, fm = gid * wgm, gsz = (nM - fm) < wgm ? (nM - fm) : wgm;
        u.pm = fm + ((wgid % nig) % gsz); u.pn = (wgid % nig) / gsz; u.z = 0; if (flip) u.pm = nM - 1 - u.pm; return true;
    }
    __device__ __forceinline__ const char* a_ptr(const Unit& u) const { return A + (size_t)u.pm * atile; }
    __device__ __forceinline__ const char* b_ptr(const Unit& u) const { return Bt + (size_t)u.pn * btile; }
};
struct SchedCmp {
    const char* A; const char* Bt; int G, c;
    __device__ __forceinline__ bool next(int i, Unit& u) const { const int L = i * G + c; if (L >= 256) return false; u.z = L >> 5; u.pm = (L & 31) >> 1; u.pn = L & 1; return true; }
    __device__ __forceinline__ const char* a_ptr(const Unit& u) const { const int kv = u.z >> 2, ks = u.z & 3; return A + ((size_t)(kv * 16 + u.pm) * 64 + (size_t)ks * 16) * 32768; }
    __device__ __forceinline__ const char* b_ptr(const Unit& u) const { const int kv = u.z >> 2, ks = u.z & 3; return Bt + ((size_t)(kv * 2 + u.pn) * 64 + (size_t)ks * 16) * 32768; }
};
constexpr int EX_LDS = 131072 + 4096;
struct EpiBf16 {
    static constexpr bool PERM = true;
    static constexpr bool ROWS = true;
    bf16_t* O; int ldc; const float* ssq; const float* kna; const float* knn; const float* pos; bf16_t* acmp; LAS unsigned char* xl;
    __device__ __forceinline__ void operator()(const f32x4 (&acc)[2][2][4][2], const Unit& u, int wr, int wc, int fr, int fq, const float (&pre)[8]) const {
        const int pn = u.pn, e0 = wc * 32 + 8 * fq, lane = fq * 16 + fr;
        const int row0 = u.pm * BM + wr * 64 + fr, col0 = pn * BM + e0;
        if ((pn >= 4 && pn < 8) || pn == 18 || pn == 20) {
            const float* ga = kna + e0; const float* gb = knn + e0; const float* gp = (pn < 8) ? ga + 0 : gb + 0;
            const f32x4 g0 = *(const f32x4*)gp, g1 = *(const f32x4*)(gp + 4);
            LAS float* X = (LAS float*)xl + ((wr * 256 + fr) * 4);
#pragma unroll
            for (int ai = 0; ai < 2; ++ai)
#pragma unroll
                for (int m = 0; m < 4; ++m) { const float rs = pre[ai * 4 + m];
#pragma unroll
                    for (int bj = 0; bj < 2; ++bj) { const f32x4 v0 = acc[ai][bj][m][0] * rs, v1 = acc[ai][bj][m][1] * rs;
                        float s = ((v0[0] * v0[0] + v0[1] * v0[1]) + (v0[2] * v0[2] + v0[3] * v0[3])) + ((v1[0] * v1[0] + v1[1] * v1[1]) + (v1[2] * v1[2] + v1[3] * v1[3]));
                        s += shx(s, 16, lane); s += shx(s, 32, lane);
                        if (fq == 0) X[((ai * 4 + m) * 2 + bj) * 64 + wc] = s; } }
            asm volatile("s_waitcnt lgkmcnt(0)" ::: "memory"); __builtin_amdgcn_s_barrier(); asm volatile("" ::: "memory");
#pragma unroll
            for (int ai = 0; ai < 2; ++ai)
#pragma unroll
                for (int m = 0; m < 4; ++m) { bf16_t* rowp = O + (size_t)(row0 + ai * HALF + m * 16) * ldc + col0; const float rs = pre[ai * 4 + m];
#pragma unroll
                    for (int bj = 0; bj < 2; ++bj) { const f32x4 t4 = *(const LAS f32x4*)(X + ((ai * 4 + m) * 2 + bj) * 64);
                        const float rh = rs / sqrtf(((t4[0] + t4[1]) + (t4[2] + t4[3])) * (1.f / 128.f) + 1e-6f);
                        const f32x4 v0 = acc[ai][bj][m][0] * rh * g0, v1 = acc[ai][bj][m][1] * rh * g1;
                        u32x4 w; w.x = cvtpk(v0[0], v0[1]); w.y = cvtpk(v0[2], v0[3]); w.z = cvtpk(v1[0], v1[1]); w.w = cvtpk(v1[2], v1[3]);
                        *(u32x4*)(rowp + bj * HALF) = w; } }
        } else if (pn == 16 || pn == 17) {
            const int kv = pn - 16;
            const float* pp = pos + fr * 128 + e0;
            const f32x4 pa0 = *(const f32x4*)pp, pa1 = *(const f32x4*)(pp + 4), pb0 = *(const f32x4*)(pp + 16 * 128), pb1 = *(const f32x4*)(pp + 16 * 128 + 4);
#pragma unroll
            for (int ai = 0; ai < 2; ++ai)
#pragma unroll
                for (int m = 0; m < 4; ++m) { const int rowb = u.pm * BM + ai * HALF + wr * 64 + m * 16, b = rowb >> 13, c1 = (rowb & 8191) >> 4; const float rs = pre[ai * 4 + m];
#pragma unroll
                    for (int bj = 0; bj < 2; ++bj) { const f32x4 v0 = acc[ai][bj][m][0] * rs, v1 = acc[ai][bj][m][1] * rs;
                        const int arow0 = kv * 4096 + (b * 2 + bj) * 512;
                        if (c1 <= 510) { u32x4 w; w.x = cvtpk(v0[0] + pa0[0], v0[1] + pa0[1]); w.y = cvtpk(v0[2] + pa0[2], v0[3] + pa0[3]); w.z = cvtpk(v1[0] + pa1[0], v1[1] + pa1[1]); w.w = cvtpk(v1[2] + pa1[2], v1[3] + pa1[3]);
                            *(u32x4*)(acmp + kt_off(arow0 + c1, fr * 128 + e0, 4096)) = w; }
                        else { unsigned zr = 0u; asm volatile("" : "+v"(zr)); const u32x4 z = {zr, zr, zr, zr}; *(u32x4*)(acmp + kt_off(arow0 + 511, fr * 128 + e0, 4096)) = z; *(u32x4*)(acmp + kt_off(arow0 + 511, (fr + 16) * 128 + e0, 4096)) = z; }
                        if (c1 >= 1) { u32x4 w; w.x = cvtpk(v0[0] + pb0[0], v0[1] + pb0[1]); w.y = cvtpk(v0[2] + pb0[2], v0[3] + pb0[3]); w.z = cvtpk(v1[0] + pb1[0], v1[1] + pb1[1]); w.w = cvtpk(v1[2] + pb1[2], v1[3] + pb1[3]);
                            *(u32x4*)(acmp + kt_off(arow0 + c1 - 1, (fr + 16) * 128 + e0, 4096)) = w; } } }
        } else {
#pragma unroll
            for (int ai = 0; ai < 2; ++ai)
#pragma unroll
                for (int m = 0; m < 4; ++m) { bf16_t* rowp = O + (size_t)(row0 + ai * HALF + m * 16) * ldc + col0; const float rs = pre[ai * 4 + m];
#pragma unroll
                    for (int bj = 0; bj < 2; ++bj) { const f32x4 v0 = acc[ai][bj][m][0] * rs, v1 = acc[ai][bj][m][1] * rs;
                        u32x4 w; w.x = cvtpk(v0[0], v0[1]); w.y = cvtpk(v0[2], v0[3]); w.z = cvtpk(v1[0], v1[1]); w.w = cvtpk(v1[2], v1[3]);
                        *(u32x4*)(rowp + bj * HALF) = w; } }
        }
    }
};
struct EpiSwiGLU {
    static constexpr bool PERM = true;
    static constexpr bool ROWS = true;
    bf16_t* O; int ldc; const float* ssq;
    __device__ __forceinline__ void operator()(const f32x4 (&acc)[2][2][4][2], const Unit& u, int wr, int wc, int fr, int fq, const float (&pre)[8]) const {
        const int rowp0 = wr * 64 + fr, kt = 2 * u.pn + (wc >> 1), cit = (wc & 1) * 32 + 8 * fq;
        bf16_t* tile = O + ((size_t)u.pm * (ldc / 64) + kt) * (256 * 64) + cit;
#pragma unroll
        for (int ai = 0; ai < 2; ++ai)
#pragma unroll
            for (int m = 0; m < 4; ++m) { bf16_t* rowp = tile + (size_t)(rowp0 + ai * HALF + m * 16) * 64; const float rs = pre[ai * 4 + m];
                float v[8];
#pragma unroll
                for (int n = 0; n < 2; ++n)
#pragma unroll
                    for (int j = 0; j < 4; ++j) { const float g = acc[ai][0][m][n][j] * rs, up = acc[ai][1][m][n][j] * rs;
                        const float s = g * __builtin_amdgcn_rcpf(1.0f + __builtin_amdgcn_exp2f(-g * LOG2E)); v[n * 4 + j] = s * up; }
                u32x4 w; w.x = cvtpk(v[0], v[1]); w.y = cvtpk(v[2], v[3]); w.z = cvtpk(v[4], v[5]); w.w = cvtpk(v[6], v[7]);
                *(u32x4*)rowp = w; }
    }
};
struct EpiResid {
    static constexpr bool PERM = false;
    static constexpr bool ROWS = false;
    float* out; bf16_t* xb; float* ssq; int ldc; float alpha;
    __device__ __forceinline__ void operator()(const f32x4 (&acc)[2][2][4][2], const Unit& u, int wr, int wc, int fr, int fq, const float (&pre)[8]) const {
        const int row0 = u.pm * BM + wr * 64 + fr, col0 = u.pn * BM + wc * 32 + 4 * fq;
        u32x2 bs[4][4];
#define ER_LOAD(g) do { const int row_ = row0 + ((g) >> 2) * HALF + ((g) & 3) * 16; \
        _Pragma("unroll") for (int q_ = 0; q_ < 4; ++q_) bs[(g) & 3][q_] = *(const u32x2*)(xb + kt_off(row_, col0 + (q_ >> 1) * HALF + (q_ & 1) * 16, ldc)); } while (0)
        ER_LOAD(0); ER_LOAD(1); ER_LOAD(2); ER_LOAD(3);
#pragma unroll
        for (int g = 0; g < 8; ++g) { const int ai = g >> 2, m = g & 3; const int row = row0 + ai * HALF + m * 16; float ss = 0.f;
#pragma unroll
            for (int q = 0; q < 4; ++q) { const int bj = q >> 1, n = q & 1; const u32x2 b = bs[g & 3][q];
                const f32x4 o = (f32x4){bflo(b.x), bfhi(b.x), bflo(b.y), bfhi(b.y)} + acc[ai][bj][m][n] * alpha;
                ss += (o.x * o.x + o.y * o.y) + (o.z * o.z + o.w * o.w);
                u32x2 w; w.x = cvtpk(o.x, o.y); w.y = cvtpk(o.z, o.w); *(u32x2*)(xb + kt_off(row, col0 + bj * HALF + n * 16, ldc)) = w;
                if (out) *(f32x4*)(out + (size_t)row * ldc + col0 + bj * HALF + n * 16) = o; }
            if (g + 4 < 8) ER_LOAD(g + 4);
            const int lane = fq * 16 + fr; ss += shx(ss, 16, lane); ss += shx(ss, 32, lane);
            if (fq == 0) ssq[(size_t)row * 32 + u.pn * 4 + wc] = ss; }
#undef ER_LOAD
    }
};
struct EpiF32Z {
    static constexpr bool PERM = false;
    float* C; int ldc; size_t zstride;
    static constexpr bool ROWS = false;
    __device__ __forceinline__ void operator()(const f32x4 (&acc)[2][2][4][2], const Unit& u, int wr, int wc, int fr, int fq, const float (&pre)[8]) const {
        float* Cz = C + (size_t)u.z * zstride;
        const int row0 = u.pm * BM + wr * 64 + fr, col0 = u.pn * BM + wc * 32 + 4 * fq;
#pragma unroll
        for (int ai = 0; ai < 2; ++ai)
#pragma unroll
            for (int m = 0; m < 4; ++m) { float* rowp = Cz + (size_t)(row0 + ai * HALF + m * 16) * ldc + col0;
#pragma unroll
                for (int bj = 0; bj < 2; ++bj)
#pragma unroll
                    for (int n = 0; n < 2; ++n) *(f32x4*)(rowp + bj * HALF + n * 16) = acc[ai][bj][m][n]; }
    }
};

constexpr int RS_LDS = 131072 + 1024;
__device__ __forceinline__ void rows_to_lds(LAS unsigned char* lds, const float* ssq, int pm, int slot, int tid) {
    const int row = tid >> 1, half = tid & 1;
    const f32x4* p = (const f32x4*)(ssq + ((size_t)pm * BM + row) * 32 + half * 16);
    f32x4 a = p[0]; a = a + p[1]; a = a + p[2]; a = a + p[3];
    float s = (a.x + a.y) + (a.z + a.w); s += shx(s, 1, tid & 63);
    const float rs = 1.0f / sqrtf(s * (1.f / 2048.f) + 1e-6f);
    if (half == 0) *(LAS float*)(lds + RS_LDS + slot * 1024 + row * 4) = rs;
}
template <class Epi, class Sched, int KSTEP_A = 128, int KSTEP_B = 128>
__device__ __forceinline__ void gemm_phase(LAS unsigned char* lds, const Gemm g, const Sched& S, const Epi& E, const int wv) {
    const int tid = opq_tid(wv), wid = __builtin_amdgcn_readfirstlane(tid >> 6), lane = tid & 63, wr = wid >> 2, wc = wid & 3, fr = lane & 15, fq = lane >> 4;
    const int K = g.K, nt = K / BK;
    unsigned voffA[2], voffB[2];
#pragma unroll
    for (int i = 0; i < 2; ++i) { int R, C; stage_rc(tid * 16 + i * 8192, R, C); const int Rb = Epi::PERM ? ((R & ~31) + perm32(R & 31)) : R;
        voffA[i] = (unsigned)(R * g.lda + C) * 2u; voffB[i] = (unsigned)(Rb * g.ldb + C) * 2u; }
    constexpr size_t kstepA = (size_t)KSTEP_A, kstepB = (size_t)KSTEP_B;
    const size_t hstepA = (size_t)HALF * g.lda * 2, hstepB = (size_t)HALF * g.ldb * 2;
    const unsigned ldsw = (unsigned)wid * 1024u;
    const int aoff = lds_byte(wr * 64 + fr, fq * 8), boff = lds_byte(wc * 32 + fr, fq * 8);
#define PG8_SA(b, h) (((b) * 2 + (h)) * HTB)
#define PG8_SB(b, h) ((4 + (b) * 2 + (h)) * HTB)
#define PG8_STAGE(bufoff, gbase, voff) do { _Pragma("unroll") for (int _i = 0; _i < 2; ++_i) \
        __builtin_amdgcn_global_load_lds((const unsigned*)((const char*)(gbase) + (voff)[_i]), (LAS unsigned*)(lds + (bufoff) + ldsw + _i * 8192), 16, 0, 0); } while (0)
#define PG8_LDA(dst, b, h) do { _Pragma("unroll") for (int m = 0; m < 4; ++m) _Pragma("unroll") for (int k = 0; k < 2; ++k) dst[m][k] = *(const LAS bf16x8*)(lds + PG8_SA(b, h) + aoff + m * 2048 + k * 1024); } while (0)
#define PG8_LDB(dst, b, h) do { _Pragma("unroll") for (int n = 0; n < 2; ++n) _Pragma("unroll") for (int k = 0; k < 2; ++k) dst[n][k] = *(const LAS bf16x8*)(lds + PG8_SB(b, h) + boff + n * 2048 + k * 1024); } while (0)
#define PG8_MMA(ai, bj, At, Bt) do { __builtin_amdgcn_s_setprio(1); _Pragma("unroll") for (int m = 0; m < 4; ++m) _Pragma("unroll") for (int n = 0; n < 2; ++n) _Pragma("unroll") for (int k = 0; k < 2; ++k) \
        acc[ai][bj][m][n] = __builtin_amdgcn_mfma_f32_16x16x32_bf16(Bt[n][k], At[m][k], acc[ai][bj][m][n], 0, 0, 0); __builtin_amdgcn_s_setprio(0); } while (0)
#define PG8_WAIT_V(n) asm volatile("s_waitcnt vmcnt(" #n ")" ::: "memory")
#define PG8_WAIT_L(n) asm volatile("s_waitcnt lgkmcnt(" #n ")" ::: "memory")
#define PG8_BAR __builtin_amdgcn_s_barrier()
#define PG8_SCHED __builtin_amdgcn_sched_barrier(0)
    Unit cur, nxt; int ui = 0;
    if (!S.next(0, cur)) return;
    f32x4 acc[2][2][4][2];
#pragma unroll
    for (int a = 0; a < 2; ++a)
#pragma unroll
        for (int b = 0; b < 2; ++b)
#pragma unroll
            for (int m = 0; m < 4; ++m)
#pragma unroll
                for (int n = 0; n < 2; ++n) acc[a][b][m][n] = (f32x4){0.f, 0.f, 0.f, 0.f};
    bf16x8 At[4][2], B0[2][2], B1[2][2];
    const char* cA = S.a_ptr(cur); const char* cB = S.b_ptr(cur);
    float pre[8]; int rslot = 0; if constexpr (Epi::ROWS) rows_to_lds(lds, E.ssq, cur.pm, 0, tid);
    PG8_STAGE(PG8_SB(0, 0), cB, voffB); PG8_STAGE(PG8_SA(0, 0), cA, voffA); PG8_STAGE(PG8_SB(0, 1), cB + hstepB, voffB); PG8_STAGE(PG8_SA(0, 1), cA + hstepA, voffA);
    if (wr == 1) PG8_BAR;
    PG8_WAIT_V(4); PG8_BAR;
    PG8_STAGE(PG8_SB(1, 0), cB + kstepB, voffB); PG8_STAGE(PG8_SA(1, 0), cA + kstepA, voffA); PG8_STAGE(PG8_SB(1, 1), cB + hstepB + kstepB, voffB);
    PG8_WAIT_V(6); PG8_BAR;
    for (;;) {
        const bool has_next = S.next(ui + 1, nxt);
        const char* nA = has_next ? S.a_ptr(nxt) : cA; const char* nB = has_next ? S.b_ptr(nxt) : cB;
        for (int t = 0; t < nt; t += 2) {
            const bool last = (t == nt - 2);
            const char* a1 = cA + (size_t)(t + 1) * kstepA;
            const char* a2 = last ? nA : cA + (size_t)(t + 2) * kstepA; const char* b2 = last ? nB : cB + (size_t)(t + 2) * kstepB;
            const char* a3 = a2 + kstepA; const char* b3 = b2 + kstepB;
            PG8_LDB(B0, 0, 0); PG8_SCHED; PG8_LDA(At, 0, 0); PG8_STAGE(PG8_SA(1, 1), a1 + hstepA, voffA);
            PG8_WAIT_L(8); PG8_BAR; PG8_WAIT_L(0); PG8_MMA(0, 0, At, B0); PG8_BAR; PG8_SCHED;
            PG8_LDB(B1, 0, 1); PG8_STAGE(PG8_SB(0, 0), b2, voffB);
            PG8_BAR; PG8_WAIT_L(0); PG8_MMA(0, 1, At, B1); PG8_BAR;
            PG8_LDA(At, 0, 1); PG8_STAGE(PG8_SA(0, 0), a2, voffA);
            PG8_BAR; PG8_WAIT_L(0); PG8_MMA(1, 0, At, B0); PG8_BAR; PG8_SCHED;
            PG8_STAGE(PG8_SB(0, 1), b2 + hstepB, voffB);
            PG8_WAIT_V(6); PG8_BAR; PG8_MMA(1, 1, At, B1); PG8_BAR;
            PG8_LDB(B0, 1, 0); PG8_SCHED; PG8_LDA(At, 1, 0); PG8_STAGE(PG8_SA(0, 1), a2 + hstepA, voffA);
            PG8_WAIT_L(8); PG8_BAR; PG8_WAIT_L(0); PG8_MMA(0, 0, At, B0); PG8_BAR; PG8_SCHED;
            PG8_LDB(B1, 1, 1); PG8_STAGE(PG8_SB(1, 0), b3, voffB);
            PG8_BAR; PG8_WAIT_L(0); PG8_MMA(0, 1, At, B1); PG8_BAR;
            PG8_LDA(At, 1, 1); PG8_STAGE(PG8_SA(1, 0), a3, voffA);
            PG8_BAR; PG8_WAIT_L(0); PG8_MMA(1, 0, At, B0); PG8_BAR; PG8_SCHED;
            PG8_STAGE(PG8_SB(1, 1), b3 + hstepB, voffB);
            PG8_WAIT_V(6); PG8_BAR; PG8_MMA(1, 1, At, B1); PG8_BAR;
        }
        if constexpr (Epi::ROWS) {
#pragma unroll
            for (int i = 0; i < 8; ++i) pre[i] = *(const LAS float*)(lds + RS_LDS + rslot * 1024 + (wr * 64 + fr + (i >> 2) * HALF + (i & 3) * 16) * 4); }
        E(acc, cur, wr, wc, fr, fq, pre);
        if constexpr (Epi::ROWS) { if (has_next && nxt.pm != cur.pm) { rslot ^= 1; rows_to_lds(lds, E.ssq, nxt.pm, rslot, tid); } }
        if (!has_next) break;
#pragma unroll
        for (int a = 0; a < 2; ++a)
#pragma unroll
            for (int b = 0; b < 2; ++b)
#pragma unroll
                for (int m = 0; m < 4; ++m)
#pragma unroll
                    for (int n = 0; n < 2; ++n) acc[a][b][m][n] = (f32x4){0.f, 0.f, 0.f, 0.f};
        cur = nxt; cA = nA; cB = nB; ++ui;
    }
    PG8_WAIT_V(0);
    if (wr == 0) PG8_BAR;
    PG8_BAR;
#undef PG8_SA
#undef PG8_SB
#undef PG8_STAGE
#undef PG8_LDA
#undef PG8_LDB
#undef PG8_MMA
#undef PG8_WAIT_V
#undef PG8_WAIT_L
#undef PG8_BAR
#undef PG8_SCHED
}
}

struct Args { const float* in[24]; float* out; unsigned char* ws; };
enum { I_X = 0, I_F1N, I_F1W1, I_F1W3, I_F1W2, I_MIXN, I_WIN, I_GB, I_QNA, I_KNA, I_QNN, I_KNN, I_POS, I_CKW1, I_CKW2, I_CVW1, I_CVW2, I_ON, I_WOUT, I_F2N, I_F2W1, I_F2W3, I_F2W2, I_RB };

__device__ __forceinline__ void transpose_item(const float* W, int K, int N, bf16_t* WT, int mode, int off, LAS float* scr, int item, int lane, const float* gain) {
    const int nblk = (N + 31) / 32, kb = item / nblk, nb = item % nblk, k0 = 64 * kb, n0 = 32 * nb;
    const int c4 = 4 * (lane & 7), nn = n0 + c4;
    f32x4 ld[8];
#pragma unroll
    for (int i = 0; i < 8; ++i) { const int kk = 8 * i + (lane >> 3); ld[i] = (nn < N) ? *(const f32x4*)(W + (size_t)(k0 + kk) * N + nn) : (f32x4){0.f, 0.f, 0.f, 0.f}; if (gain) ld[i] = ld[i] * gain[k0 + kk]; }
#pragma unroll
    for (int i = 0; i < 8; ++i) { const int kk = 8 * i + (lane >> 3); LAS float* d = scr + kk * 33 + c4; d[0] = ld[i].x; d[1] = ld[i].y; d[2] = ld[i].z; d[3] = ld[i].w; }
    LDS_WAIT(); asm volatile("" ::: "memory");
    const int c = lane & 7;
#pragma unroll
    for (int j = 0; j < 4; ++j) { const int n = (lane >> 3) + 8 * j; const LAS float* s = scr + (8 * c) * 33 + n;
        u32x4 o; o.x = pk2(s[0 * 33], s[1 * 33]); o.y = pk2(s[2 * 33], s[3 * 33]); o.z = pk2(s[4 * 33], s[5 * 33]); o.w = pk2(s[6 * 33], s[7 * 33]);
        const int ng = n0 + n; const int dr = mode ? ((ng >> 7) * 256 + (ng & 127) + off) : (ng + off);
        if (ng < N) *(u32x4*)(WT + kt_off(dr, k0 + 8 * c, K)) = o; }
    LDS_WAIT(); asm volatile("" ::: "memory");
}
__device__ __forceinline__ int rel_bucket_dev(int n) {
    if (n < 16) return n;
    const float v = logf((float)n / 16.0f) / 4.852030263919617f * 16.0f;
    int b = 16 + (int)v; return b < 31 ? b : 31;
}
namespace att {
constexpr int SHM_V = 16384, SHM_K = 16384;
constexpr int L_V = 0  , L_K = 49152  , L_WS = 98304, L_TBL = 100352, L_SELM = L_TBL + 4 * TBLS * 4  , L_END = L_SELM + 1024;
constexpr int L_IMP = 0;
static_assert(L_END <= 131072, "attention LDS map");
constexpr float THR = 8.f;
#define KSWZ(row, colB) ((row) * 256 + ((colB) ^ (((row) & 7) << 4)))
__device__ __forceinline__ int v_st(int k, int c) { const int kk = (k & ~0xC) | ((k & 4) << 1) | ((k & 8) >> 1); return ((kk >> 3) * 4 + (c >> 5)) * 512 + ((kk & 7) * 32 + (c & 31)) * 2; }
__device__ __forceinline__ int v_rd_base(int lane) { return ((lane & 3) << 3) | (((lane >> 2) & 3) << 6) | (((lane >> 4) & 1) << 5) | (((lane >> 5) & 1) << 8); }
__device__ __forceinline__ int crow(int r, int hi) { return (r & 3) + 8 * (r >> 2) + 4 * hi; }

__device__ __forceinline__ void partialSM(f32x16& p0, f32x16& p1, float& m_reg, float& mn, float& alpha) {
    (void)m_reg; mn = 0.f; alpha = 1.f;
#pragma unroll
    for (int r = 0; r < 16; ++r) p0[r] = __builtin_amdgcn_exp2f(p0[r] * LOG2E);
#pragma unroll
    for (int r = 0; r < 16; ++r) p1[r] = p1[r] * LOG2E;
}
__device__ __forceinline__ void partialSM_row(f32x16& p0, f32x16& p1, float& m_reg, float& mn, float& alpha, bool ok, float bias) {
    (void)m_reg; mn = 0.f; alpha = 1.f;
    const float mnL = ok ? bias * LOG2E : -__builtin_inff();
#pragma unroll
    for (int r = 0; r < 16; ++r) p0[r] = __builtin_amdgcn_exp2f(fmaf(p0[r], LOG2E, mnL));
#pragma unroll
    for (int r = 0; r < 16; ++r) p1[r] = fmaf(p1[r], LOG2E, mnL);
}
#define PK4(P, B_, OUT) do { unsigned a0 = cvtpk(P[B_+0], P[B_+1]), a1 = cvtpk(P[B_+2], P[B_+3]);                          \
        unsigned b0 = cvtpk(P[B_+4], P[B_+5]), b1 = cvtpk(P[B_+6], P[B_+7]);                                             \
        auto r0 = __builtin_amdgcn_permlane32_swap(a0, b0, false, false); auto r1 = __builtin_amdgcn_permlane32_swap(a1, b1, false, false); \
        u32x4 w = {r0[0], r1[0], r0[1], r1[1]}; OUT = *reinterpret_cast<bf16x8*>(&w); } while (0)
__device__ __forceinline__ void finishSM(f32x16& p0, f32x16& p1, float alpha, float& l_reg, bf16x8& pa0, bf16x8& pa1, bf16x8& pa2, bf16x8& pa3) {
#pragma unroll
    for (int r = 0; r < 16; ++r) p1[r] = __builtin_amdgcn_exp2f(p1[r]);
    float ps = 0;
#pragma unroll
    for (int r = 0; r < 16; ++r) ps += p0[r];
#pragma unroll
    for (int r = 0; r < 16; ++r) ps += p1[r];
    { auto rr = __builtin_amdgcn_permlane32_swap(__float_as_uint(ps), __float_as_uint(ps), false, false);
      ps = __uint_as_float(rr[0]) + __uint_as_float(rr[1]); }
    l_reg = l_reg * alpha + ps;
    PK4(p0, 0, pa0); PK4(p0, 8, pa1); PK4(p1, 0, pa2); PK4(p1, 8, pa3);
}
__device__ __forceinline__ void qkt(f32x16& p0, f32x16& p1, const LAS char* Kb, int r32, int hi, const bf16x8 (&qr)[8]) {
    p0 = f32x16{}; p1 = f32x16{};
    const LAS char* kb4[4];
#pragma unroll
    for (int dd = 0; dd < 4; ++dd) kb4[dd] = Kb + KSWZ(r32, (dd * 16 + hi * 8) * 2);
#pragma unroll
    for (int d0 = 0; d0 < 8; ++d0) { const LAS char* a = kb4[d0 & 3] + (d0 >> 2) * 128;
        const bf16x8 b0 = *reinterpret_cast<const LAS bf16x8*>(a);
        const bf16x8 b1 = *reinterpret_cast<const LAS bf16x8*>(a + 32 * 256);
        p0 = __builtin_amdgcn_mfma_f32_32x32x16_bf16(b0, qr[d0], p0, 0, 0, 0);
        p1 = __builtin_amdgcn_mfma_f32_32x32x16_bf16(b1, qr[d0], p1, 0, 0, 0); }
}
__device__ __forceinline__ void pv_tile(f32x16 (&o)[4], int vb, bf16x8 pa0, bf16x8 pa1, bf16x8 pa2, bf16x8 pa3) {
#define TRRD(dst, off) asm volatile("ds_read_b64_tr_b16 %0, %1 offset:%2" : "=&v"(dst) : "v"(vb), "i"(off) : "memory")
#define PV_D0(d0) do { s16x4 l0, l1, l2, l3, h0, h1, h2, h3; constexpr int b_ = (d0) * 512; \
        TRRD(l0, b_); TRRD(h0, b_ + 2048); TRRD(l1, b_ + 4096); TRRD(h1, b_ + 6144); TRRD(l2, b_ + 8192); TRRD(h2, b_ + 10240); TRRD(l3, b_ + 12288); TRRD(h3, b_ + 14336); \
        asm volatile("s_waitcnt lgkmcnt(0)" ::: "memory"); SBAR(); \
        o[d0] = __builtin_amdgcn_mfma_f32_32x32x16_bf16(pa0, (bf16x8){l0[0], l0[1], l0[2], l0[3], h0[0], h0[1], h0[2], h0[3]}, o[d0], 0, 0, 0);   \
        o[d0] = __builtin_amdgcn_mfma_f32_32x32x16_bf16(pa1, (bf16x8){l1[0], l1[1], l1[2], l1[3], h1[0], h1[1], h1[2], h1[3]}, o[d0], 0, 0, 0);   \
        o[d0] = __builtin_amdgcn_mfma_f32_32x32x16_bf16(pa2, (bf16x8){l2[0], l2[1], l2[2], l2[3], h2[0], h2[1], h2[2], h2[3]}, o[d0], 0, 0, 0);   \
        o[d0] = __builtin_amdgcn_mfma_f32_32x32x16_bf16(pa3, (bf16x8){l3[0], l3[1], l3[2], l3[3], h3[0], h3[1], h3[2], h3[3]}, o[d0], 0, 0, 0); } while (0)
    PV_D0(0); PV_D0(1); PV_D0(2); PV_D0(3);
#undef PV_D0
#undef TRRD
}

template <class Cfg>
__device__ __forceinline__ void attn_tiles(const Cfg& c, LAS char* lds, const bf16x8 (&qr)[8], f32x16 (&o)[4], float& m_reg, float& l_reg, const int t_lo, const int t_hi, const int wv) {
    const int tid = opq_tid(wv), lane = tid & 63, wid = __builtin_amdgcn_readfirstlane(tid >> 6), r32 = lane & 31, hi = lane >> 5;
    LAS char* V_lds = lds + L_V; LAS char* K_lds = lds + L_K;
    LAS float* al_l = (LAS float*)(lds + L_WS) + wid * 64 + 32;
    const int sr = tid >> 4, sc = (tid & 15) * 8;
    const int vst0 = v_st(sr, sc), vst1 = v_st(32 + sr, sc), kws = KSWZ(sr, sc * 2);
    const int vb0 = (int)(unsigned)(uintptr_t)V_lds + v_rd_base(lane);
    bf16x8 sk0, sk1, sv0, sv1;
    const bf16_t *gk0 = nullptr, *gk1 = nullptr, *gv0 = nullptr, *gv1 = nullptr;
#define AT_LOAD(t) do { gk0 = c.krow((t), sr) + sc; gk1 = c.krow((t), sr + 32) + sc; sk0 = *(const bf16x8*)gk0; sk1 = *(const bf16x8*)gk1; \
        if constexpr (Cfg::MODE == 0) { gv0 = c.vrow((t), sr) + sc; gv1 = c.vrow((t), sr + 32) + sc; sv0 = *(const bf16x8*)gv0; sv1 = *(const bf16x8*)gv1; } \
        asm volatile("" ::: "memory"); SBAR(); } while (0)
#define AT_WRITE(t, bf) do { asm volatile("" :: "v"(gk0), "v"(gk1), "v"(gv0), "v"(gv1)); *(LAS bf16x8*)(K_lds + (bf) * SHM_K + kws) = sk0; *(LAS bf16x8*)(K_lds + (bf) * SHM_K + kws + 32 * 256) = sk1; \
        if constexpr (Cfg::MODE == 1) { \
            _Pragma("unroll") for (int i_ = 0; i_ < 8; ++i_) { const int n_ = sc + i_, c0_ = 64 * (t) + sr, c1_ = c0_ + 32; \
                sv0[i_] = (c0_ >= 4 * n_ - 1 && c0_ <= 4 * n_ + 3) ? (short)0x3F80 : (short)0; sv1[i_] = (c1_ >= 4 * n_ - 1 && c1_ <= 4 * n_ + 3) ? (short)0x3F80 : (short)0; } } \
        *(LAS bf16x8*)(V_lds + (bf) * SHM_V + vst0) = sv0; *(LAS bf16x8*)(V_lds + (bf) * SHM_V + vst1) = sv1; } while (0)
    __builtin_amdgcn_s_waitcnt(0x0F70);
    __syncthreads();
    if (t_lo < t_hi) { AT_LOAD(t_lo); AT_WRITE(t_lo, 0); }
    __syncthreads();
    for (int t = t_lo; t < t_hi; ++t) {
        const int buf = (t - t_lo) & 1; const bool more = (t + 1 < t_hi);
        if (more) AT_LOAD(t + 1);
        if (c.active(t)) {
            f32x16 p0, p1;
            qkt(p0, p1, K_lds + buf * SHM_K, r32, hi, qr);
            if constexpr (Cfg::MODE == 0) {
                float mn, alpha; bf16x8 pa0, pa1, pa2, pa3;
                bool rok; float rbias;
                if (c.rowconst(t, rok, rbias)) partialSM_row(p0, p1, m_reg, mn, alpha, rok, rbias);
                else { c.mask(p0, p1, t); partialSM(p0, p1, m_reg, mn, alpha); }
                if (__any(alpha < 1.f)) { if (hi == 0) al_l[r32] = alpha; LDS_WAIT();
#pragma unroll
                    for (int d_ = 0; d_ < 4; ++d_)
#pragma unroll
                        for (int r = 0; r < 16; ++r) o[d_][r] *= al_l[crow(r, hi)]; }
                finishSM(p0, p1, alpha, l_reg, pa0, pa1, pa2, pa3); SBAR();
                pv_tile(o, vb0 + buf * SHM_V, pa0, pa1, pa2, pa3);
            } else {
                c.mask(p0, p1, t);
                const float mL = -c.mfix * LOG2E; const float il = c.invl;
#pragma unroll
                for (int r = 0; r < 16; ++r) { p0[r] = __builtin_amdgcn_exp2f(fmaf(p0[r], LOG2E, mL)) * il; p1[r] = __builtin_amdgcn_exp2f(fmaf(p1[r], LOG2E, mL)) * il; }
                bf16x8 pa0, pa1, pa2, pa3;
                PK4(p0, 0, pa0); PK4(p0, 8, pa1); PK4(p1, 0, pa2); PK4(p1, 8, pa3); SBAR();
                pv_tile(o, vb0 + buf * SHM_V, pa0, pa1, pa2, pa3);
#pragma unroll
                for (int r = 0; r < 16; r += 2) { const unsigned a = cvtpk(p0[r], p0[r + 1]), b = cvtpk(p1[r], p1[r + 1]);
                    p0[r] -= bflo(a); p0[r + 1] -= bfhi(a); p1[r] -= bflo(b); p1[r + 1] -= bfhi(b); }
                PK4(p0, 0, pa0); PK4(p0, 8, pa1); PK4(p1, 0, pa2); PK4(p1, 8, pa3); SBAR();
                pv_tile(o, vb0 + buf * SHM_V, pa0, pa1, pa2, pa3);
            }
        }
        if (more) AT_WRITE(t + 1, buf ^ 1);
        __syncthreads();
    }
#undef AT_LOAD
#undef AT_WRITE
}

template <class Cfg>
__device__ __forceinline__ void attn_tiles_s(const Cfg& c, LAS char* lds, const bf16x8 (&qr)[8], f32x16 (&o)[4], float& m_reg, float& l_reg, const int t_lo, const int t_hi, const int wv) {
    static_assert(Cfg::MODE == 0, "fixed-shift softmax tiles only");
    (void)m_reg;
    const int tid = opq_tid(wv), lane = tid & 63, wid = __builtin_amdgcn_readfirstlane(tid >> 6), r32 = lane & 31, hi = lane >> 5;
    LAS char* V_lds = lds + L_V; LAS char* K_lds = lds + L_K;
    const int sr = tid >> 4, sc = (tid & 15) * 8;
    const int vst0 = v_st(sr, sc), vst1 = v_st(32 + sr, sc), kws = KSWZ(sr, sc * 2);
    const int vb0 = (int)(unsigned)(uintptr_t)V_lds + v_rd_base(lane);
    bf16x8 sk0, sk1, sv0, sv1, pa0, pa1, pa2, pa3;
    const bf16_t *gk0 = nullptr, *gk1 = nullptr, *gv0 = nullptr, *gv1 = nullptr;
#define AS_LOAD(t) do { gk0 = c.krow((t), sr) + sc; gk1 = c.krow((t), sr + 32) + sc; sk0 = *(const bf16x8*)gk0; sk1 = *(const bf16x8*)gk1; \
        gv0 = c.vrow((t), sr) + sc; gv1 = c.vrow((t), sr + 32) + sc; sv0 = *(const bf16x8*)gv0; sv1 = *(const bf16x8*)gv1; asm volatile("" ::: "memory"); SBAR(); } while (0)
#define AS_WRITE(kbf, vbf) do { asm volatile("" :: "v"(gk0), "v"(gk1), "v"(gv0), "v"(gv1)); *(LAS bf16x8*)(K_lds + (kbf) * SHM_K + kws) = sk0; *(LAS bf16x8*)(K_lds + (kbf) * SHM_K + kws + 32 * 256) = sk1; \
        *(LAS bf16x8*)(V_lds + (vbf) * SHM_V + vst0) = sv0; *(LAS bf16x8*)(V_lds + (vbf) * SHM_V + vst1) = sv1; } while (0)
#define AS_SCORE(t, kbf) do { f32x16 p0, p1; float mz_ = 0.f, mn_, al_; bool rok_; float rb_; \
        qkt(p0, p1, K_lds + (kbf) * SHM_K, r32, hi, qr); \
        if (c.rowconst((t), rok_, rb_)) partialSM_row(p0, p1, mz_, mn_, al_, rok_, rb_); else { c.mask(p0, p1, (t)); partialSM(p0, p1, mz_, mn_, al_); } \
        finishSM(p0, p1, 1.f, l_reg, pa0, pa1, pa2, pa3); SBAR(); } while (0)
    if (t_lo >= t_hi) return;
    __builtin_amdgcn_s_waitcnt(0x0F70);
    __syncthreads();
    AS_LOAD(t_lo); AS_WRITE(0, 0);
    __syncthreads();
    int kb = 0, vb = 0;
    if (wid < 4) {
        for (int t = t_lo; t < t_hi; ++t) {
            const bool more = (t + 1 < t_hi); const int vn = (vb == 2) ? 0 : vb + 1;
            if (more) AS_LOAD(t + 1);
            if (c.active(t)) { AS_SCORE(t, kb); pv_tile(o, vb0 + vb * SHM_V, pa0, pa1, pa2, pa3); }
            if (more) AS_WRITE(kb ^ 1, vn);
            __syncthreads();
            kb ^= 1; vb = vn;
        }
    } else {
        bool pend = false; int vp = 0;
        for (int t = t_lo; t < t_hi; ++t) {
            const bool more = (t + 1 < t_hi); const int vn = (vb == 2) ? 0 : vb + 1;
            if (more) AS_LOAD(t + 1);
            if (pend) pv_tile(o, vb0 + vp * SHM_V, pa0, pa1, pa2, pa3);
            const bool act = c.active(t);
            if (act) AS_SCORE(t, kb);
            pend = act; vp = vb;
            if (more) AS_WRITE(kb ^ 1, vn);
            __syncthreads();
            kb ^= 1; vb = vn;
        }
        if (pend) pv_tile(o, vb0 + vp * SHM_V, pa0, pa1, pa2, pa3);
    }
#undef AS_LOAD
#undef AS_WRITE
#undef AS_SCORE
}

struct DilCfg {
    static constexpr int MODE = 0;
    const bf16_t* Kb; const bf16_t* Vb;
    const LAS float* tbl; int dshift, res, u, dqm, s0;
    __device__ __forceinline__ const bf16_t* krow(int t, int kk) const { int s = 256 * u - 128 + 64 * t + kk; s = s < 0 ? 0 : s; return Kb + (size_t)((s << dshift) + res) * PC; }
    __device__ __forceinline__ const bf16_t* vrow(int t, int kk) const { int s = 256 * u - 128 + 64 * t + kk; s = s < 0 ? 0 : s; return Vb + (size_t)((s << dshift) + res) * PC; }
    __device__ __forceinline__ bool active(int t) const { const int kb = 256 * u - 128 + 64 * t; return kb <= s0 + 31 && kb + 63 >= s0 - 128; }
    __device__ __forceinline__ bool rowconst(int, bool&, float&) const { return false; }
    __device__ __forceinline__ void mask(f32x16& p0, f32x16& p1, int t) const {
        const int dq = dqm - (256 * u - 128 + 64 * t); const float NEG = -__builtin_inff();
        const LAS float* tb = tbl + (DT0 + dq - 63);
        float bb0[16], bb1[16];
#pragma unroll
        for (int r = 0; r < 16; ++r) { const int cc = (r & 3) + 8 * (r >> 2); bb0[r] = tb[63 - cc]; bb1[r] = tb[31 - cc]; }
#pragma unroll
        for (int r = 0; r < 16; ++r) asm volatile("" : "+v"(bb0[r]), "+v"(bb1[r]));
#pragma unroll
        for (int r = 0; r < 16; ++r) { const int cc = (r & 3) + 8 * (r >> 2); const unsigned d0 = (unsigned)(dq - cc), d1 = (unsigned)(dq - cc - 32);
            p0[r] = (d0 <= 128u) ? p0[r] + bb0[r] : NEG; p1[r] = (d1 <= 128u) ? p1[r] + bb1[r] : NEG; }
    }
};
struct CmpCfg {
    static constexpr int MODE = 0;
    const bf16_t* Kb; const bf16_t* Vb; int cmax, hi4, cfull;
    __device__ __forceinline__ bool rowconst(int t, bool& ok, float& bias) const { ok = true; bias = 0.f; return 64 * t + 63 <= cfull; }
    __device__ __forceinline__ const bf16_t* krow(int t, int kk) const { return Kb + (size_t)(64 * t + kk) * HD; }
    __device__ __forceinline__ const bf16_t* vrow(int t, int kk) const { return Vb + (size_t)(64 * t + kk) * HD; }
    __device__ __forceinline__ bool active(int) const { return true; }
    __device__ __forceinline__ void mask(f32x16& p0, f32x16& p1, int t) const {
        const int cb = 64 * t + hi4; const float NEG = -__builtin_inff();
#pragma unroll
        for (int r = 0; r < 16; ++r) { const int cc = cb + (r & 3) + 8 * (r >> 2); if (cc > cmax) p0[r] = NEG; if (cc + 32 > cmax) p1[r] = NEG; }
    }
};
struct CmpImpCfg {
    static constexpr int MODE = 1;
    const bf16_t* Kb; int cmax, hi4; float mfix, invl;
    __device__ __forceinline__ const bf16_t* krow(int t, int kk) const { return Kb + (size_t)(64 * t + kk) * HD; }
    __device__ __forceinline__ const bf16_t* vrow(int, int) const { return Kb; }
    __device__ __forceinline__ bool active(int) const { return true; }
    __device__ __forceinline__ void mask(f32x16& p0, f32x16& p1, int t) const {
        const int cb = 64 * t + hi4; const float NEG = -__builtin_inff();
#pragma unroll
        for (int r = 0; r < 16; ++r) { const int cc = cb + (r & 3) + 8 * (r >> 2); if (cc > cmax) p0[r] = NEG; if (cc + 32 > cmax) p1[r] = NEG; }
    }
};
struct SlcCfg {
    static constexpr int MODE = 0;
    const bf16_t* Kb; const bf16_t* Vb;
    const LAS float* tblh;
    unsigned s0, s1, s2, s3; int tqm, cur; float b31;
    __device__ __forceinline__ const bf16_t* krow(int t, int kk) const { return Kb + (size_t)(64 * t + kk) * PC; }
    __device__ __forceinline__ const bf16_t* vrow(int t, int kk) const { return Vb + (size_t)(64 * t + kk) * PC; }
    __device__ __forceinline__ bool selbit(int t) const { const unsigned q = (unsigned)t >> 5; const unsigned w = (q == 0u ? s0 + 0u : 0u) | (q == 1u ? s1 + 0u : 0u) | (q == 2u ? s2 + 0u : 0u) | (q == 3u ? s3 + 0u : 0u); return (w >> (t & 31)) & 1u; }
    __device__ __forceinline__ bool active(int t) const { return __any(selbit(t)); }
    __device__ __forceinline__ bool rowconst(int t, bool& ok, float& bias) const { ok = selbit(t); bias = b31; return 64 * (cur - t) - 63 >= 1513; }
    __device__ __forceinline__ void mask(f32x16& p0, f32x16& p1, int t) const {
        const bool sel = selbit(t); const int dq = tqm - 64 * t; const float NEG = -__builtin_inff();
        const LAS float* tb = tblh + (TBL0 + dq - 63);
        float bb0[16], bb1[16];
#pragma unroll
        for (int r = 0; r < 16; ++r) { const int cc = (r & 3) + 8 * (r >> 2); bb0[r] = tb[63 - cc]; bb1[r] = tb[31 - cc]; }
#pragma unroll
        for (int r = 0; r < 16; ++r) asm volatile("" : "+v"(bb0[r]), "+v"(bb1[r]));
#pragma unroll
        for (int r = 0; r < 16; ++r) { const int cc = (r & 3) + 8 * (r >> 2); const int d0 = dq - cc, d1 = dq - cc - 32;
            p0[r] = (sel && d0 >= 0) ? p0[r] + bb0[r] : NEG; p1[r] = (sel && d1 >= 0) ? p1[r] + bb1[r] : NEG; }
    }
};
struct WinCfg {
    static constexpr int MODE = 0;
    const bf16_t* Kb; const bf16_t* Vb; const LAS float* tblh; int tqm;
    __device__ __forceinline__ bool rowconst(int, bool&, float&) const { return false; }
    __device__ __forceinline__ const bf16_t* krow(int t, int kk) const { return Kb + (size_t)(64 * t + kk) * PC; }
    __device__ __forceinline__ const bf16_t* vrow(int t, int kk) const { return Vb + (size_t)(64 * t + kk) * PC; }
    __device__ __forceinline__ bool active(int) const { return true; }
    __device__ __forceinline__ void mask(f32x16& p0, f32x16& p1, int t) const {
        const int dq = tqm - 64 * t; const float NEG = -__builtin_inff();
        const LAS float* tb = tblh + (TBL0 + dq - 63);
        float bb0[16], bb1[16];
#pragma unroll
        for (int r = 0; r < 16; ++r) { const int cc = (r & 3) + 8 * (r >> 2); bb0[r] = tb[63 - cc]; bb1[r] = tb[31 - cc]; }
#pragma unroll
        for (int r = 0; r < 16; ++r) asm volatile("" : "+v"(bb0[r]), "+v"(bb1[r]));
#pragma unroll
        for (int r = 0; r < 16; ++r) { const int cc = (r & 3) + 8 * (r >> 2); const unsigned d0 = (unsigned)(dq - cc), d1 = (unsigned)(dq - cc - 32);
            p0[r] = (d0 < 512u) ? p0[r] + bb0[r] : NEG; p1[r] = (d1 < 512u) ? p1[r] + bb1[r] : NEG; }
    }
};
}

__device__ __forceinline__ void load_q_normed(const bf16_t* qp  , const float* gain  , bf16x8 (&qr)[8]) {
    u32x4 raw[8];
#pragma unroll
    for (int d0 = 0; d0 < 8; ++d0) raw[d0] = *(const u32x4*)(qp + d0 * 16);
    float ss = 0.f;
#pragma unroll
    for (int d0 = 0; d0 < 8; ++d0) { const u32x4 w = raw[d0]; const float a0 = bflo(w.x), a1 = bfhi(w.x), a2 = bflo(w.y), a3 = bfhi(w.y), a4 = bflo(w.z), a5 = bfhi(w.z), a6 = bflo(w.w), a7 = bfhi(w.w);
        ss += ((a0 * a0 + a1 * a1) + (a2 * a2 + a3 * a3)) + ((a4 * a4 + a5 * a5) + (a6 * a6 + a7 * a7)); }
    { auto rr = __builtin_amdgcn_permlane32_swap(__float_as_uint(ss), __float_as_uint(ss), false, false); ss = __uint_as_float(rr[0]) + __uint_as_float(rr[1]); }
    const float rs = QSCALE / sqrtf(ss * (1.f / HD) + EPS);
#pragma unroll
    for (int d0 = 0; d0 < 8; ++d0) { const u32x4 w = raw[d0]; const f32x4 g0 = *(const f32x4*)(gain + d0 * 16), g1 = *(const f32x4*)(gain + d0 * 16 + 4);
        u32x4 o; o.x = cvtpk(bflo(w.x) * rs * g0.x, bfhi(w.x) * rs * g0.y); o.y = cvtpk(bflo(w.y) * rs * g0.z, bfhi(w.y) * rs * g0.w);
        o.z = cvtpk(bflo(w.z) * rs * g1.x, bfhi(w.z) * rs * g1.y); o.w = cvtpk(bflo(w.w) * rs * g1.z, bfhi(w.w) * rs * g1.w);
        qr[d0] = *reinterpret_cast<bf16x8*>(&o); }
}

__device__ __forceinline__ void dil_tiles(const att::DilCfg& c, LAS char* lds, const bf16x8 (&qr)[8], f32x16 (&o)[4], float& l_reg, const int wv) {
    using namespace att;
    const int tid = opq_tid(wv), lane = tid & 63, wid = __builtin_amdgcn_readfirstlane(tid >> 6), r32 = lane & 31, hi = lane >> 5;
    LAS char* V_lds = lds + L_V; LAS char* K_lds = lds + L_K;
    const int sr = tid >> 4, sc = (tid & 15) * 8;
    const int vst0 = v_st(sr, sc), vst1 = v_st(32 + sr, sc), kws = KSWZ(sr, sc * 2);
    const int vb0 = (int)(unsigned)(uintptr_t)V_lds + v_rd_base(lane);
    bf16x8 sk0, sk1, sv0, sv1;
    const bf16_t *gk0 = nullptr, *gk1 = nullptr, *gv0 = nullptr, *gv1 = nullptr;
#define DT_LOAD(t) do { gk0 = c.krow((t), sr) + sc; gk1 = c.krow((t), sr + 32) + sc; sk0 = *(const bf16x8*)gk0; sk1 = *(const bf16x8*)gk1; \
        gv0 = c.vrow((t), sr) + sc; gv1 = c.vrow((t), sr + 32) + sc; sv0 = *(const bf16x8*)gv0; sv1 = *(const bf16x8*)gv1; asm volatile("" ::: "memory"); SBAR(); } while (0)
#define DT_WRITE(slot) do { asm volatile("" :: "v"(gk0), "v"(gk1), "v"(gv0), "v"(gv1)); *(LAS bf16x8*)(K_lds + (slot) * SHM_K + kws) = sk0; *(LAS bf16x8*)(K_lds + (slot) * SHM_K + kws + 32 * 256) = sk1; \
        *(LAS bf16x8*)(V_lds + (slot) * SHM_V + vst0) = sv0; *(LAS bf16x8*)(V_lds + (slot) * SHM_V + vst1) = sv1; } while (0)
#define DT_COMP(t, slot) do { f32x16 p0, p1; float mz_ = 0.f, mn_, al_; bf16x8 pa0, pa1, pa2, pa3; \
        qkt(p0, p1, K_lds + (slot) * SHM_K, r32, hi, qr); c.mask(p0, p1, (t)); partialSM(p0, p1, mz_, mn_, al_); \
        finishSM(p0, p1, 1.f, l_reg, pa0, pa1, pa2, pa3); SBAR(); pv_tile(o, vb0 + (slot) * SHM_V, pa0, pa1, pa2, pa3); } while (0)
    const bool first = (c.u == 0);
    __builtin_amdgcn_s_waitcnt(0x0F70);
    __syncthreads();
    if (!first) { DT_LOAD(1); DT_WRITE(0); }
    DT_LOAD(4); DT_WRITE(1);
    __syncthreads();
    DT_LOAD(2);
    if (wid < 4) { if (!first) DT_COMP(1, 0); } else DT_COMP(4, 1);
    DT_WRITE(2);
    __syncthreads();
    DT_LOAD(3);
    if (wid < 6) DT_COMP(2, 2);
    DT_WRITE(0);
    __syncthreads();
    DT_LOAD(5);
    if (wid >= 2) DT_COMP(3, 0);
    DT_WRITE(1);
    if (!first) { DT_LOAD(0); DT_WRITE(2); }
    __syncthreads();
    if (wid < 2) { if (!first) DT_COMP(0, 2); } else if (wid >= 6) DT_COMP(5, 1);
#undef DT_LOAD
#undef DT_WRITE
#undef DT_COMP
}

__device__ __forceinline__ void dil_unit(LAS char* lds, const bf16_t* P, bf16_t* OA, float* LSE, const float* dilT, const float* qgain, int pat, int dshift, int unit, const int wv) {
    using namespace att;
    const int tid = opq_tid(wv), lane = tid & 63, wid = __builtin_amdgcn_readfirstlane(tid >> 6), r32 = lane & 31, hi = lane >> 5;
    const int bh = unit >> 5, ru = unit & 31, b = bh >> 3, h = bh & 7;
    const int ncs = 5 - dshift, res = ru >> ncs, u = ru & ((1 << ncs) - 1);
    LAS float* tbl = (LAS float*)(lds + L_TBL);
    __syncthreads();
    if (tid < DTS) tbl[tid] = dilT[(pat * 8 + h) * DTS + tid];
    const int s0 = 256 * u + 32 * wid, s_row = s0 + r32;
    const size_t tokrow = (size_t)b * SEQ + (size_t)((s_row << dshift) + res);
    bf16x8 qr[8];
    load_q_normed(P + tokrow * PC + C_QA + h * HD + hi * 8, qgain + hi * 8, qr);
    f32x16 o[4]; float m_reg, l_reg;
    m_reg = 0.f;
    if (pat == 0) { l_reg = 0.f;
#pragma unroll
        for (int d0 = 0; d0 < 4; ++d0) o[d0] = f32x16{}; }
    else { l_reg = LSE[tokrow * 8 + h];
#pragma unroll
        for (int r = 0; r < 16; ++r) { const size_t tr = (size_t)b * SEQ + (size_t)(((s0 + crow(r, hi)) << dshift) + res); const bf16_t* op = OA + tr * 1024 + h * HD + r32;
#pragma unroll
            for (int d0 = 0; d0 < 4; ++d0) o[d0][r] = bf2f(op[d0 * 32]); } }
    DilCfg c; c.Kb = P + (size_t)b * SEQ * PC + C_KA + h * HD; c.Vb = P + (size_t)b * SEQ * PC + C_VA + h * HD; c.tbl = tbl; c.dshift = dshift; c.res = res; c.u = u; c.dqm = s_row - 4 * hi; c.s0 = s0;
    dil_tiles(c, lds, qr, o, l_reg, wv);
    LAS float* li_l = (LAS float*)(lds + L_WS) + wid * 64;
    if (hi == 0) { li_l[r32] = l_reg; LSE[tokrow * 8 + h] = l_reg; }
    LDS_WAIT();
#pragma unroll
    for (int r = 0; r < 16; ++r) { const int orow = crow(r, hi); const float rl = (pat == 2) ? 1.0f / li_l[orow] : 1.0f;
        const size_t tr = (size_t)b * SEQ + (size_t)(((s0 + orow) << dshift) + res); bf16_t* op = OA + tr * 1024 + h * HD;
#pragma unroll
        for (int d0 = 0; d0 < 4; ++d0) { const float v = o[d0][r] * rl; const float vn = shx(v, 1, lane);
            if ((r32 & 1) == 0) *(unsigned*)(op + d0 * 32 + r32) = cvtpk(v, vn); } }
}

__device__ __forceinline__ void nsa_finalize(LAS char* lds, const f32x16 (&o)[4], float l_reg, const bf16_t* P, bf16_t* ON, const float* gb, int b, int g, int tok0, int br, const int wv) {
    using namespace att;
    const int tid = opq_tid(wv), lane = tid & 63, wid = __builtin_amdgcn_readfirstlane(tid >> 6), r32 = lane & 31, hi = lane >> 5;
    LAS float* li_l = (LAS float*)(lds + L_WS) + wid * 64;
    if (hi == 0) li_l[r32] = l_reg;
    LDS_WAIT();
    bf16_t* ONb = ON + (size_t)br * NTOK * 1024;
    float glv[16], gbv[4];
#pragma unroll
    for (int j = 0; j < 4; ++j) gbv[j] = gb[(4 * g + j) * 3 + br];
#pragma unroll
    for (int r = 0; r < 16; ++r) { const int j = r & 3, k = r >> 2; const size_t tok = (size_t)b * SEQ + tok0 + 2 * k + hi; glv[r] = bf2f(P[tok * PC + C_GL + (4 * g + j) * 3 + br]); }
#pragma unroll
    for (int r = 0; r < 16; ++r) asm volatile("" : "+v"(glv[r]));
#pragma unroll
    for (int r = 0; r < 16; ++r) { const int j = r & 3, k = r >> 2; const float lr = li_l[crow(r, hi)]; const float rl = lr > 0.f ? 1.0f / lr : 0.f;
        const size_t tok = (size_t)b * SEQ + tok0 + 2 * k + hi; const int hh = 4 * g + j;
        const float gl = glv[r] + gbv[j];
        const float sc = rl * __builtin_amdgcn_rcpf(1.0f + __builtin_amdgcn_exp2f(-gl * LOG2E));
        bf16_t* op = ONb + tok * 1024 + hh * HD;
#pragma unroll
        for (int d0 = 0; d0 < 4; ++d0) { const float v = o[d0][r] * sc; const float vn = shx(v, 1, lane);
            if ((r32 & 1) == 0) *(unsigned*)(op + d0 * 32 + r32) = cvtpk(v, vn); } }
}
__device__ __forceinline__ void nsa_unit(LAS char* lds, const bf16_t* P, const bf16_t* KC, const bf16_t* VC, bf16_t* ON, const float* nsaT, const float* gb, const float* qgain, int b, int g, int qi, bool load_tbl, const int wv) {
    using namespace att;
    const int tid = opq_tid(wv), lane = tid & 63, wid = __builtin_amdgcn_readfirstlane(tid >> 6), r32 = lane & 31, hi = lane >> 5;
    LAS float* tbl = (LAS float*)(lds + L_TBL); LAS float* IMP = (LAS float*)(lds + L_IMP); LAS unsigned* SELM = (LAS unsigned*)(lds + L_SELM);
    __syncthreads();
    if (load_tbl) for (int i = tid; i < 4 * TBLS; i += NTHR) tbl[i] = nsaT[(size_t)(4 * g) * TBLS + i];
    const int tok0 = 64 * qi + 8 * wid, tq = tok0 + (r32 >> 2), hd = r32 & 3;
    const bf16_t* Pb = P + (size_t)b * SEQ * PC;
    bf16x8 qr[8];
    load_q_normed(Pb + (size_t)tq * PC + C_QN + (4 * g + hd) * HD + hi * 8, qgain + hi * 8, qr);
    const bf16_t* KCb = KC + (size_t)(b * 2 + g) * 512 * HD; const bf16_t* VCb = VC + (size_t)(b * 2 + g) * 512 * HD;
    const int ntc = (qi >> 4) + 1, cmax = (tq - 31) >> 4;
    f32x16 o[4]; float m_reg, l_reg;
#pragma unroll
    for (int d0 = 0; d0 < 4; ++d0) o[d0] = f32x16{};
    m_reg = 0.f; l_reg = 0.f;
    { CmpCfg c; c.Kb = KCb; c.Vb = VCb; c.cmax = cmax; c.hi4 = 4 * hi; c.cfull = (64 * qi - 31) >> 4; attn_tiles_s(c, lds, qr, o, m_reg, l_reg, 0, ntc, wv); }
    nsa_finalize(lds, o, l_reg, P, ON, gb, b, g, tok0, 0, wv);
    { CmpImpCfg c; c.Kb = KCb; c.cmax = cmax; c.hi4 = 4 * hi; c.mfix = 0.f; c.invl = l_reg > 0.f ? 1.0f / l_reg : 0.f;
#pragma unroll
      for (int d0 = 0; d0 < 4; ++d0) o[d0] = f32x16{};
      float md = 0.f, ld = 0.f; attn_tiles(c, lds, qr, o, md, ld, 0, ntc, wv); }
#pragma unroll
    for (int d0 = 0; d0 < 4; ++d0)
#pragma unroll
        for (int k = 0; k < 4; ++k) IMP[(8 * wid + 2 * k + hi) * 128 + 32 * d0 + r32] = (o[d0][4 * k] + o[d0][4 * k + 1]) + (o[d0][4 * k + 2] + o[d0][4 * k + 3]);
    __syncthreads();
    { const int cur = qi;
#pragma unroll 1
      for (int tl = 8 * wid; tl < 8 * wid + 8; ++tl) {
        const int n0 = lane, n1 = 64 + lane; bool sel0, sel1;
        if (cur <= 15) { sel0 = (n0 <= cur); sel1 = false; }
        else {
            const float v0 = IMP[tl * 128 + n0], v1 = IMP[tl * 128 + n1];
            const unsigned u0 = (n0 >= 1 && n0 <= cur - 2) ? __float_as_uint(v0) + 1u : 0u, u1 = (n1 <= cur - 2) ? __float_as_uint(v1) + 1u : 0u;
            unsigned T = 0u;
#pragma unroll 1
            for (int bit = 30; bit >= 0; --bit) { const unsigned cand = T | (1u << bit);
                const int cnt = __builtin_popcountll(__ballot(u0 >= cand)) + __builtin_popcountll(__ballot(u1 >= cand));
                if (cnt >= 13) T = cand; }
            const bool gt0 = u0 > T, gt1 = u1 > T;
            const int need = 13 - (__builtin_popcountll(__ballot(gt0)) + __builtin_popcountll(__ballot(gt1)));
            const bool eq0 = (u0 == T), eq1 = (u1 == T);
            const unsigned long long m0 = __ballot(eq0), m1 = __ballot(eq1);
            const int pre0 = (int)__builtin_amdgcn_mbcnt_hi((unsigned)(m0 >> 32), __builtin_amdgcn_mbcnt_lo((unsigned)m0, 0u));
            const int pre1 = __builtin_popcountll(m0) + (int)__builtin_amdgcn_mbcnt_hi((unsigned)(m1 >> 32), __builtin_amdgcn_mbcnt_lo((unsigned)m1, 0u));
            sel0 = (n0 == 0 || n0 == cur || n0 == cur - 1) || gt0 || (eq0 && pre0 < need);
            sel1 = (n1 == cur || n1 == cur - 1) || gt1 || (eq1 && pre1 < need);
        }
        const unsigned long long b0 = __ballot(sel0), b1 = __ballot(sel1);
        if (lane == 0) { SELM[tl * 4 + 0] = (unsigned)b0; SELM[tl * 4 + 1] = (unsigned)(b0 >> 32); SELM[tl * 4 + 2] = (unsigned)b1; SELM[tl * 4 + 3] = (unsigned)(b1 >> 32); } } }
    __syncthreads();
    int r32s = r32; asm volatile("" : "+v"(r32s));
    { SlcCfg c; c.Kb = Pb + C_KS + g * HD; c.Vb = Pb + C_VS + g * HD; c.tblh = tbl + (r32s & 3) * TBLS; c.tqm = tok0 + (r32s >> 2) - 4 * hi; c.cur = qi; c.b31 = tbl[(r32s & 3) * TBLS + TBL0 + 1600];
      const int tl = 8 * wid + (r32s >> 2); c.s0 = SELM[tl * 4 + 0]; c.s1 = SELM[tl * 4 + 1]; c.s2 = SELM[tl * 4 + 2]; c.s3 = SELM[tl * 4 + 3];
#pragma unroll
      for (int d0 = 0; d0 < 4; ++d0) o[d0] = f32x16{};
      m_reg = 0.f; l_reg = 0.f;
      attn_tiles_s(c, lds, qr, o, m_reg, l_reg, 0, qi + 1, wv); }
    nsa_finalize(lds, o, l_reg, P, ON, gb, b, g, tok0, 1, wv);
    int r32w = r32; asm volatile("" : "+v"(r32w));
    { WinCfg c; c.Kb = Pb + C_KW + g * HD; c.Vb = Pb + C_VW + g * HD; c.tblh = tbl + (r32w & 3) * TBLS; c.tqm = tok0 + (r32w >> 2) - 4 * hi;
#pragma unroll
      for (int d0 = 0; d0 < 4; ++d0) o[d0] = f32x16{};
      m_reg = 0.f; l_reg = 0.f;
      attn_tiles_s(c, lds, qr, o, m_reg, l_reg, qi >= 8 ? qi - 8 : 0, qi + 1, wv); }
    nsa_finalize(lds, o, l_reg, P, ON, gb, b, g, tok0, 2, wv);
}

constexpr int LDS_BYTES = 147456;
constexpr int LDS_MISC = 131072;
constexpr int LDS_ARGS = LDS_MISC + 64;
__device__ __forceinline__ unsigned long long arg_u64(LAS unsigned char* lds, int i) {
    const LAS unsigned* p = (const LAS unsigned*)(opq_lds(lds) + LDS_ARGS) + 2 * i;
    const unsigned lo = __builtin_amdgcn_readfirstlane(p[0]), hi = __builtin_amdgcn_readfirstlane(p[1]);
    return ((unsigned long long)hi << 32) | lo;
}
#define GAS __attribute__((address_space(1)))
__device__ __forceinline__ const float* arg_in(LAS unsigned char* lds, int i) { return (const float*)(GAS const float*)arg_u64(lds, i); }
__device__ __forceinline__ float* arg_out(LAS unsigned char* lds) { return (float*)(GAS float*)arg_u64(lds, 24); }
__device__ __forceinline__ unsigned char* arg_ws(LAS unsigned char* lds) { return (unsigned char*)(GAS unsigned char*)arg_u64(lds, 25); }
__device__ __forceinline__ int opq_bx() { int b = blockIdx.x; asm volatile("" : "+s"(b)); return b; }
__device__ __forceinline__ int opq_g() { int b = gridDim.x; asm volatile("" : "+s"(b)); return b; }

__device__ __forceinline__ void ph_prologue(LAS unsigned char* lds, const int wv) {
    lds = opq_lds(lds);
    const int tid = opq_tid(wv), lane = tid & 63, wave = __builtin_amdgcn_readfirstlane(tid >> 6), G = opq_g(), bx = opq_bx();
    const int gw = bx * NWAVES + wave, NGW = G * NWAVES;
    unsigned char* ws = arg_ws(lds);
    LAS float* scr = (LAS float*)(lds + wave * 16384);
    constexpr int I_UP = 32 * 176, I_DN = 88 * 64, I_IN = 32 * 177, I_OUT = 32 * 64, I_C1 = 64 * 16, I_Z = 928;
    constexpr int I_FFN = 2 * I_UP + I_DN, I_LAYER = 2 * I_FFN + I_IN + I_OUT + 2 * I_C1 + I_Z;
#pragma unroll 1
    for (int it = gw; it < DEPTH * I_LAYER; it += NGW) {
        const int l = it / I_LAYER; int r = it - l * I_LAYER;
        if (r < 2 * I_FFN) { const int half = r >= I_FFN; r -= half * I_FFN;
            bf16_t* WUP = (bf16_t*)(ws + WS_WUP + (size_t)(l * 2 + half) * SZ_WUP); bf16_t* WDN = (bf16_t*)(ws + WS_WDN + (size_t)(l * 2 + half) * SZ_WDN);
            const float* gn = arg_in(lds, half ? I_F2N : I_F1N) + (size_t)l * DM;
            if (r < I_UP) { transpose_item(arg_in(lds, half ? I_F2W1 : I_F1W1) + (size_t)l * DM * DFF, DM, DFF, WUP, 1, 0, scr, r, lane, gn); continue; } r -= I_UP;
            if (r < I_UP) { transpose_item(arg_in(lds, half ? I_F2W3 : I_F1W3) + (size_t)l * DM * DFF, DM, DFF, WUP, 1, 128, scr, r, lane, gn); continue; } r -= I_UP;
            transpose_item(arg_in(lds, half ? I_F2W2 : I_F1W2) + (size_t)l * DFF * DM, DFF, DM, WDN, 0, 0, scr, r, lane, nullptr); continue; }
        r -= 2 * I_FFN;
        bf16_t* WIN = (bf16_t*)(ws + WS_WIN + (size_t)l * SZ_WIN); bf16_t* WOUT = (bf16_t*)(ws + WS_WOUT + (size_t)l * SZ_WOUT); bf16_t* WC1 = (bf16_t*)(ws + WS_WC1 + (size_t)l * SZ_WC1);
        if (r < I_IN) { transpose_item(arg_in(lds, I_WIN) + (size_t)l * DM * IN_COLS, DM, IN_COLS, WIN, 0, 0, scr, r, lane, arg_in(lds, I_MIXN) + (size_t)l * DM); continue; } r -= I_IN;
        if (r < I_OUT) { transpose_item(arg_in(lds, I_WOUT) + (size_t)l * DM * DM, DM, DM, WOUT, 0, 0, scr, r, lane, nullptr); continue; } r -= I_OUT;
        if (r < I_C1) { transpose_item(arg_in(lds, I_CKW1) + (size_t)l * 4096 * 512, 4096, 512, WC1, 0, 0, scr, r, lane, nullptr); continue; } r -= I_C1;
        if (r < I_C1) { transpose_item(arg_in(lds, I_CVW1) + (size_t)l * 4096 * 512, 4096, 512, WC1, 0, 512, scr, r, lane, nullptr); continue; } r -= I_C1;
        { const int q = r * 64 + lane, kt = q / 1856, rem = q - kt * 1856; u32x4* z = (u32x4*)(WIN + ((size_t)(22 * 32 + kt) * 256 + 24) * 64) + rem; unsigned zr = 0u; asm volatile("" : "+v"(zr)); *z = (u32x4){zr, zr, zr, zr}; }
    }
    const float* xs = arg_in(lds, I_X); bf16_t* XB = (bf16_t*)(ws + WS_HB); float* SSQ = (float*)(ws + WS_SSQ);
    for (int m = gw; m < NTOK; m += NGW) {
        const f32x4* xr = (const f32x4*)(xs + (size_t)m * DM) + lane; f32x4 v[8]; float s = 0.f;
#pragma unroll
        for (int j = 0; j < 8; ++j) { v[j] = xr[64 * j]; s += (v[j].x * v[j].x + v[j].y * v[j].y) + (v[j].z * v[j].z + v[j].w * v[j].w); }
        s = wave_sum(s, lane);
#pragma unroll
        for (int j = 0; j < 8; ++j) { u32x2 w; w.x = cvtpk(v[j].x, v[j].y); w.y = cvtpk(v[j].z, v[j].w); *(u32x2*)(XB + kt_off(m, 256 * j + 4 * lane, DM)) = w; }
        if (lane < 32) SSQ[(size_t)m * 32 + lane] = (lane == 0) ? s : 0.f;
    }
}
__device__ __forceinline__ void ph_headnorm(LAS unsigned char* lds, int l, const int wv) {
    lds = opq_lds(lds);
    const int tid = opq_tid(wv), lane = tid & 63, wave = __builtin_amdgcn_readfirstlane(tid >> 6), G = opq_g(), bx = opq_bx();
    const int gw = bx * NWAVES + wave, NGW = G * NWAVES;
    unsigned char* ws = arg_ws(lds); bf16_t* HP = (bf16_t*)(ws + WS_HP); bf16_t* ACMP = (bf16_t*)(ws + WS_ACMP);
    const float* qna = arg_in(lds, I_QNA) + l * HD; const float* kna = arg_in(lds, I_KNA) + l * HD; const float* qnn = arg_in(lds, I_QNN) + l * HD; const float* knn = arg_in(lds, I_KNN) + l * HD;
    const float* pos = arg_in(lds, I_POS) + (size_t)l * 32 * HD;
    const int e0 = (lane & 15) * 8;
    const f32x4 ga0 = *(const f32x4*)(kna + e0), ga1 = *(const f32x4*)(kna + e0 + 4), gn0 = *(const f32x4*)(knn + e0), gn1 = *(const f32x4*)(knn + e0 + 4);
    const int col0 = C_KA + lane * 8, col1 = C_KA + 512 + lane * 8, col2 = (lane < 32) ? C_KS + lane * 8 : C_KW + (lane - 32) * 8;
    for (int m0 = gw; m0 < NTOK; m0 += 4 * NGW) {
        const int jt = m0 & 15;
        const f32x4 pa0 = *(const f32x4*)(pos + jt * HD + e0), pa1 = *(const f32x4*)(pos + jt * HD + e0 + 4), pb0 = *(const f32x4*)(pos + (jt + 16) * HD + e0), pb1 = *(const f32x4*)(pos + (jt + 16) * HD + e0 + 4);
        u32x4 wl[4][3], wcv[4];
#pragma unroll
        for (int q = 0; q < 4; ++q) { const int mq = m0 + q * NGW; const bf16_t* prow = HP + (size_t)(mq < NTOK ? mq : NTOK - 1) * PC;
            wl[q][0] = *(const u32x4*)(prow + col0); wl[q][1] = *(const u32x4*)(prow + col1); wl[q][2] = *(const u32x4*)(prow + col2);
            wcv[q] = *(const u32x4*)(prow + C_KC + lane * 8); }
#pragma unroll
        for (int q = 0; q < 4; ++q) asm volatile("" : "+v"(wl[q][0]), "+v"(wl[q][1]), "+v"(wl[q][2]), "+v"(wcv[q]));
#pragma unroll
        for (int q = 0; q < 4; ++q) { const int m = m0 + q * NGW; if (m >= NTOK) break;
            bf16_t* prow = HP + (size_t)m * PC;
#pragma unroll
            for (int ch = 0; ch < 3; ++ch) {
                const u32x4 w = wl[q][ch];
                float v[8] = {bflo(w.x), bfhi(w.x), bflo(w.y), bfhi(w.y), bflo(w.z), bfhi(w.z), bflo(w.w), bfhi(w.w)};
                float s = 0.f;
#pragma unroll
                for (int i = 0; i < 8; ++i) s += v[i] * v[i];
                s += shx(s, 1, lane); s += shx(s, 2, lane); s += shx(s, 4, lane); s += shx(s, 8, lane);
                const float rs = 1.f / sqrtf(s * (1.f / HD) + EPS);
                const f32x4 g0 = (ch < 2) ? ga0 : gn0, g1 = (ch < 2) ? ga1 : gn1;
                u32x4 o; o.x = cvtpk(v[0] * rs * g0.x, v[1] * rs * g0.y); o.y = cvtpk(v[2] * rs * g0.z, v[3] * rs * g0.w); o.z = cvtpk(v[4] * rs * g1.x, v[5] * rs * g1.y); o.w = cvtpk(v[6] * rs * g1.z, v[7] * rs * g1.w);
                *(u32x4*)(prow + (ch == 0 ? col0 : ch == 1 ? col1 : col2)) = o;
            }
            { const int b = m / SEQ, t = m % SEQ, kv = lane >> 5, gg = (lane >> 4) & 1, c1 = t >> 4, j1 = t & 15;
              const u32x4 w = wcv[q];
              const float v[8] = {bflo(w.x), bfhi(w.x), bflo(w.y), bfhi(w.y), bflo(w.z), bfhi(w.z), bflo(w.w), bfhi(w.w)};
              const int arow0 = kv * 4096 + (b * 2 + gg) * 512;
              if (c1 <= 510) { const f32x4 p0 = pa0, p1 = pa1;
                  u32x4 o; o.x = cvtpk(v[0] + p0.x, v[1] + p0.y); o.y = cvtpk(v[2] + p0.z, v[3] + p0.w); o.z = cvtpk(v[4] + p1.x, v[5] + p1.y); o.w = cvtpk(v[6] + p1.z, v[7] + p1.w);
                  *(u32x4*)(ACMP + kt_off(arow0 + c1, j1 * HD + e0, 4096)) = o; }
              else { const u32x4 z = {0u, 0u, 0u, 0u}; *(u32x4*)(ACMP + kt_off(arow0 + 511, j1 * HD + e0, 4096)) = z; *(u32x4*)(ACMP + kt_off(arow0 + 511, (j1 + 16) * HD + e0, 4096)) = z; }
              if (c1 >= 1) { const int j2 = j1 + 16; const f32x4 p0 = pb0, p1 = pb1;
                  u32x4 o; o.x = cvtpk(v[0] + p0.x, v[1] + p0.y); o.y = cvtpk(v[2] + p0.z, v[3] + p0.w); o.z = cvtpk(v[4] + p1.x, v[5] + p1.y); o.w = cvtpk(v[6] + p1.z, v[7] + p1.w);
                  *(u32x4*)(ACMP + kt_off(arow0 + c1 - 1, j2 * HD + e0, 4096)) = o; } }
        }
    }
}
__device__ __forceinline__ float gelu_tanh(float v) { const float u3 = 0.7978845608028654f * (v + 0.044715f * v * v * v); return 0.5f * v * (2.0f - 2.0f / (__expf(2.0f * u3) + 1.0f)); }
__device__ __forceinline__ void ph_cmp2(LAS unsigned char* lds, int l, const int wv) {
    lds = opq_lds(lds);
    const int tid = opq_tid(wv), lane = tid & 63, wave = __builtin_amdgcn_readfirstlane(tid >> 6), G = opq_g(), bx = opq_bx();
    unsigned char* ws = arg_ws(lds); const float* CP = (const float*)(ws + WS_CP);
    LAS float* CH = (LAS float*)lds;
    LAS float* RED = (LAS float*)(lds + 65536);
    const float* knn = arg_in(lds, I_KNN) + l * HD;
    for (int it = bx; it < 256; it += G) {
        const int R0 = it * 32, kv = R0 >> 12, rl0 = R0 & 4095;
        __syncthreads();
        for (int i4 = tid; i4 < 32 * 128; i4 += NTHR) { const int rr = i4 >> 7, k4 = (i4 & 127) * 4; f32x4 v = {0.f, 0.f, 0.f, 0.f};
#pragma unroll
            for (int ks = 0; ks < 4; ++ks) v = v + *(const f32x4*)(CP + ((size_t)(kv * 4 + ks) * 4096 + rl0 + rr) * 512 + k4);
            f32x4 o; o.x = gelu_tanh(v.x); o.y = gelu_tanh(v.y); o.z = gelu_tanh(v.z); o.w = gelu_tanh(v.w);
            *(LAS f32x4*)(CH + rr * 512 + k4) = o; }
        __syncthreads();
        const int n = tid & 127, rq = tid >> 7;
        const float* w2 = arg_in(lds, kv ? I_CVW2 : I_CKW2) + (size_t)l * 512 * HD + n;
        float acc[8];
#pragma unroll
        for (int i = 0; i < 8; ++i) acc[i] = 0.f;
#pragma unroll 4
        for (int k = 0; k < 512; k += 4) { const float w0 = w2[(size_t)k * HD], w1 = w2[(size_t)(k + 1) * HD], w2v = w2[(size_t)(k + 2) * HD], w3 = w2[(size_t)(k + 3) * HD];
#pragma unroll
            for (int i = 0; i < 8; ++i) { const f32x4 c = *(const LAS f32x4*)(CH + (rq * 8 + i) * 512 + k); acc[i] += (c.x * w0 + c.y * w1) + (c.z * w2v + c.w * w3); } }
        if (kv == 0) {
            float ss[8];
#pragma unroll
            for (int i = 0; i < 8; ++i) ss[i] = wave_sum(acc[i] * acc[i], lane);
            if (lane == 0) {
#pragma unroll
                for (int i = 0; i < 8; ++i) RED[wave * 8 + i] = ss[i]; }
            __syncthreads();
            const float gn = knn[n];
#pragma unroll
            for (int i = 0; i < 8; ++i) { const float tot = RED[(2 * rq) * 8 + i] + RED[(2 * rq + 1) * 8 + i]; acc[i] = acc[i] / sqrtf(tot * (1.f / HD) + EPS) * gn; }
        }
        bf16_t* dst = (bf16_t*)(ws + (kv ? WS_VC + 0 : WS_KC + 0)) + (size_t)(rl0 + rq * 8) * HD + n;
#pragma unroll
        for (int i = 0; i < 8; ++i) dst[(size_t)i * HD] = (bf16_t)f2bf(acc[i]);
    }
}
__device__ __forceinline__ void ph_outnorm(LAS unsigned char* lds, int l, const int wv) {
    lds = opq_lds(lds);
    const int tid = opq_tid(wv), lane = tid & 63, wave = __builtin_amdgcn_readfirstlane(tid >> 6), G = opq_g(), bx = opq_bx();
    const int gw = bx * NWAVES + wave, NGW = G * NWAVES;
    unsigned char* ws = arg_ws(lds); const bf16_t* OA = (const bf16_t*)(ws + WS_OA); const bf16_t* ON = (const bf16_t*)(ws + WS_ON); bf16_t* HB = (bf16_t*)(ws + WS_HP);
    const float* gn = arg_in(lds, I_ON) + (size_t)l * DM;
    const f32x4 ga0 = *(const f32x4*)(gn + lane * 8), ga1 = *(const f32x4*)(gn + lane * 8 + 4), ga2 = *(const f32x4*)(gn + 512 + lane * 8), ga3 = *(const f32x4*)(gn + 512 + lane * 8 + 4);
    const f32x4 gb0 = *(const f32x4*)(gn + 1024 + lane * 8), gb1 = *(const f32x4*)(gn + 1024 + lane * 8 + 4), gb2 = *(const f32x4*)(gn + 1536 + lane * 8), gb3 = *(const f32x4*)(gn + 1536 + lane * 8 + 4);
    bf16_t* y = HB;
    for (int m0 = gw; m0 < NTOK; m0 += 2 * NGW) {
        u32x4 wab[2][2], wn[2][6];
#pragma unroll
        for (int q = 0; q < 2; ++q) { const int mq = m0 + q * NGW; const size_t mc = (size_t)(mq < NTOK ? mq : NTOK - 1);
            const bf16_t* oa = OA + mc * 1024; wab[q][0] = *(const u32x4*)(oa + lane * 8); wab[q][1] = *(const u32x4*)(oa + 512 + lane * 8);
#pragma unroll
            for (int br = 0; br < 3; ++br) { const bf16_t* onb = ON + ((size_t)br * NTOK + mc) * 1024; wn[q][2 * br] = *(const u32x4*)(onb + lane * 8); wn[q][2 * br + 1] = *(const u32x4*)(onb + 512 + lane * 8); } }
#pragma unroll
        for (int q = 0; q < 2; ++q) asm volatile("" : "+v"(wab[q][0]), "+v"(wab[q][1]), "+v"(wn[q][0]), "+v"(wn[q][1]), "+v"(wn[q][2]), "+v"(wn[q][3]), "+v"(wn[q][4]), "+v"(wn[q][5]));
#pragma unroll
        for (int q = 0; q < 2; ++q) { const int m = m0 + q * NGW; if (m >= NTOK) break;
        const u32x4 wa = wab[q][0], wb = wab[q][1];
        float va[16] = {bflo(wa.x), bfhi(wa.x), bflo(wa.y), bfhi(wa.y), bflo(wa.z), bfhi(wa.z), bflo(wa.w), bfhi(wa.w), bflo(wb.x), bfhi(wb.x), bflo(wb.y), bfhi(wb.y), bflo(wb.z), bfhi(wb.z), bflo(wb.w), bfhi(wb.w)};
        float sa = 0.f;
#pragma unroll
        for (int i = 0; i < 16; ++i) sa += va[i] * va[i];
        float vs[16]; float sn = 0.f;
#pragma unroll
        for (int i = 0; i < 16; ++i) vs[i] = 0.f;
#pragma unroll
        for (int br = 0; br < 3; ++br) { const u32x4 wc = wn[q][2 * br], wd = wn[q][2 * br + 1];
            vs[0] += bflo(wc.x); vs[1] += bfhi(wc.x); vs[2] += bflo(wc.y); vs[3] += bfhi(wc.y); vs[4] += bflo(wc.z); vs[5] += bfhi(wc.z); vs[6] += bflo(wc.w); vs[7] += bfhi(wc.w);
            vs[8] += bflo(wd.x); vs[9] += bfhi(wd.x); vs[10] += bflo(wd.y); vs[11] += bfhi(wd.y); vs[12] += bflo(wd.z); vs[13] += bfhi(wd.z); vs[14] += bflo(wd.w); vs[15] += bfhi(wd.w); }
        const float ra = 1.0f / sqrtf(wave_sum(sa, lane) * (1.f / 1024.f) + EPS);
        { const f32x4 g0 = ga0, g1 = ga1, g2 = ga2, g3 = ga3;
          u32x4 o; o.x = cvtpk(va[0] * ra * g0.x, va[1] * ra * g0.y); o.y = cvtpk(va[2] * ra * g0.z, va[3] * ra * g0.w); o.z = cvtpk(va[4] * ra * g1.x, va[5] * ra * g1.y); o.w = cvtpk(va[6] * ra * g1.z, va[7] * ra * g1.w);
          *(u32x4*)(y + kt_off(m, lane * 8, DM)) = o;
          o.x = cvtpk(va[8] * ra * g2.x, va[9] * ra * g2.y); o.y = cvtpk(va[10] * ra * g2.z, va[11] * ra * g2.w); o.z = cvtpk(va[12] * ra * g3.x, va[13] * ra * g3.y); o.w = cvtpk(va[14] * ra * g3.z, va[15] * ra * g3.w);
          *(u32x4*)(y + kt_off(m, 512 + lane * 8, DM)) = o; }
#pragma unroll
        for (int i = 0; i < 16; ++i) sn += vs[i] * vs[i];
        const float rn = 1.0f / sqrtf(wave_sum(sn, lane) * (1.f / 1024.f) + EPS);
        { const f32x4 g0 = gb0, g1 = gb1, g2a = gb2, g3 = gb3;
          u32x4 o; o.x = cvtpk(vs[0] * rn * g0.x, vs[1] * rn * g0.y); o.y = cvtpk(vs[2] * rn * g0.z, vs[3] * rn * g0.w); o.z = cvtpk(vs[4] * rn * g1.x, vs[5] * rn * g1.y); o.w = cvtpk(vs[6] * rn * g1.z, vs[7] * rn * g1.w);
          *(u32x4*)(y + kt_off(m, 1024 + lane * 8, DM)) = o;
          o.x = cvtpk(vs[8] * rn * g2a.x, vs[9] * rn * g2a.y); o.y = cvtpk(vs[10] * rn * g2a.z, vs[11] * rn * g2a.w); o.z = cvtpk(vs[12] * rn * g3.x, vs[13] * rn * g3.y); o.w = cvtpk(vs[14] * rn * g3.z, vs[15] * rn * g3.w);
          *(u32x4*)(y + kt_off(m, 1536 + lane * 8, DM)) = o; }
        }
    }
}

#define GRID_BAR() do { XcdBarrier bar_; bar_.bar = (unsigned*)(arg_ws(lds) + WS_CTL) + CW_BAR; bar_.x = xb_xcc_id(); bar_.st = (volatile LAS unsigned*)(opq_lds(lds) + LDS_MISC + 32); xcd_barrier(bar_, wv); } while (0)
__global__ void __launch_bounds__(NTHR, 2) mega_fwd(Args a) {
    extern __shared__ __attribute__((aligned(16))) unsigned char lds_raw[];
    LAS unsigned char* lds = (LAS unsigned char*)lds_raw;
    const int wv = __builtin_amdgcn_readfirstlane((int)threadIdx.x >> 6);
    {
        const int tid = threadIdx.x;
        for (int u = tid; u < (LDS_BYTES - LDS_MISC) / 4; u += NTHR) ((LAS unsigned*)(lds + LDS_MISC))[u] = 0u;
        __syncthreads();
        if (tid == 0) { LAS unsigned long long* t = (LAS unsigned long long*)(lds + LDS_ARGS);
#pragma unroll
            for (int i = 0; i < 24; ++i) t[i] = (unsigned long long)(uintptr_t)a.in[i];
            t[24] = (unsigned long long)(uintptr_t)a.out; t[25] = (unsigned long long)(uintptr_t)a.ws; }
        __syncthreads();
    }
    (void)xcd_barrier_post((unsigned*)(arg_ws(lds) + WS_CTL) + CW_BAR, (volatile LAS unsigned*)(lds + LDS_MISC + 32));

    { const int tid = opq_tid(wv), G = opq_g(), bx = opq_bx(); const float* rb = arg_in(lds, I_RB); unsigned char* ws = arg_ws(lds);
      float* dilT = (float*)(ws + WS_TBL); float* nsaT = (float*)(ws + WS_TBL + 65536);
      for (int i = bx * NTHR + tid; i < 3 * 8 * DTS + 8 * TBLS; i += G * NTHR) {
          if (i < 3 * 8 * DTS) { const int p = i / (8 * DTS), h = (i / DTS) % 8, df = i % DTS - DT0; const int d = (p == 0) ? 1 : (p == 1 ? 4 : 16);
              dilT[i] = (df >= 0 && df <= 128) ? rb[rel_bucket_dev(df * d) * 16 + h] : 0.f; }
          else { const int j = i - 3 * 8 * DTS, hh = j / TBLS, ds = j % TBLS - TBL0; nsaT[j] = (ds >= 0) ? rb[rel_bucket_dev(ds) * 16 + 8 + hh] : 0.f; } } }

    ph_prologue(lds, wv);
    GRID_BAR();
#pragma unroll 1
    for (int step = 0; step < 2 * DEPTH; ++step) {
        const int l = step >> 1, half = step & 1;
        { unsigned char* ws = arg_ws(lds); const int G = opq_g(), bx = opq_bx();
          pg8::Gemm g{64, 64, DM}; pg8::SchedStd S; S.init(ws + WS_HB, ws + WS_WUP + (size_t)step * SZ_WUP, NTOK, 2 * DFF, DM, DM, G, bx); const pg8::EpiSwiGLU E{(bf16_t*)(ws + WS_HP), DFF, (const float*)(ws + WS_SSQ)};
          pg8::gemm_phase<pg8::EpiSwiGLU, pg8::SchedStd, 32768, 32768>(opq_lds(lds), g, S, E, wv);
        }
        GRID_BAR();
        { unsigned char* ws = arg_ws(lds); const int G = opq_g(), bx = opq_bx(); float* X = arg_out(lds);
          pg8::Gemm g{64, 64, DFF}; pg8::SchedStd S; S.init(ws + WS_HP, ws + WS_WDN + (size_t)step * SZ_WDN, NTOK, DM, DFF, DFF, G, bx, 4, 1);
          pg8::EpiResid E{(step == 2 * DEPTH - 1) ? X : (float*)nullptr, (bf16_t*)(ws + WS_HB), (float*)(ws + WS_SSQ), DM, 0.5f};
          pg8::gemm_phase<pg8::EpiResid, pg8::SchedStd, 32768, 32768>(opq_lds(lds), g, S, E, wv);
        }
        if (step == 2 * DEPTH - 1) break;
        GRID_BAR();
        if (half == 0) {
            { unsigned char* ws = arg_ws(lds); const int G = opq_g(), bx = opq_bx();
              pg8::Gemm g{64, 64, DM}; pg8::SchedStd S; S.init(ws + WS_HB, ws + WS_WIN + (size_t)l * SZ_WIN, NTOK, PC, DM, DM, G, bx); const pg8::EpiBf16 E{(bf16_t*)(ws + WS_HP), PC, (const float*)(ws + WS_SSQ), arg_in(lds, I_KNA) + l * HD, arg_in(lds, I_KNN) + l * HD, arg_in(lds, I_POS) + (size_t)l * 32 * HD, (bf16_t*)(ws + WS_ACMP), opq_lds(lds) + pg8::EX_LDS};
              pg8::gemm_phase<pg8::EpiBf16, pg8::SchedStd, 32768, 32768>(opq_lds(lds), g, S, E, wv);
            }
            GRID_BAR();
#pragma unroll 1
            for (int pat3 = 0; pat3 < 3; ++pat3) { const int pat = pat3 % 3;
                if (pat3 == 0) { unsigned char* ws = arg_ws(lds); const int G = opq_g(), bx = opq_bx();
                  pg8::Gemm g{64, 64, 1024}; pg8::SchedCmp S; S.A = (const char*)(ws + WS_ACMP); S.Bt = (const char*)(ws + WS_WC1 + (size_t)l * SZ_WC1); S.G = G; S.c = bx; pg8::EpiF32Z E{(float*)(ws + WS_CP), 512, (size_t)4096 * 512};
                  pg8::gemm_phase<pg8::EpiF32Z, pg8::SchedCmp, 32768, 32768>(opq_lds(lds), g, S, E, wv); }
                if (pat3 == 1) ph_cmp2(lds, l, wv);
                { unsigned char* ws = arg_ws(lds); const int G = opq_g(), bx = opq_bx();
                  for (int u0 = bx; u0 < 1024; u0 += G) { const int w_ = u0 & 255, k_ = u0 >> 8; const int unit = (((w_ & 7) + 8 * k_) << 5) | (w_ >> 3);
                    dil_unit((LAS char*)opq_lds(lds), (const bf16_t*)(ws + WS_HP), (bf16_t*)(ws + WS_OA), (float*)(ws + WS_LSE), (const float*)(ws + WS_TBL), arg_in(lds, I_QNA) + l * HD, pat, 2 * pat, unit, wv); } }
                if (pat3 + 1 < 3) GRID_BAR();
            }
            { unsigned char* ws = arg_ws(lds); const int G = opq_g(), bx = opq_bx();
              const float* gb = arg_in(lds, I_GB) + l * 24; const float* qgn = arg_in(lds, I_QNN) + l * HD;
              int last_bg = -1;
#pragma unroll 1
              for (int i4 = 0; i4 < 4; ++i4)
#pragma unroll 1
                  for (int w = bx; w < 256; w += G) { const int i = i4 & 3; const int bg = w & 7, j = w >> 3;
                      const int qi = (i == 0) ? 127 - j : (i == 1 ? j : (i == 2 ? 64 + j : 63 - j));
                      nsa_unit((LAS char*)opq_lds(lds), (const bf16_t*)(ws + WS_HP), (const bf16_t*)(ws + WS_KC), (const bf16_t*)(ws + WS_VC), (bf16_t*)(ws + WS_ON), (const float*)(ws + WS_TBL + 65536), gb, qgn, bg >> 1, bg & 1, qi, bg != last_bg, wv); last_bg = bg; } }
            GRID_BAR();
            ph_outnorm(lds, l, wv);
            GRID_BAR();
            { unsigned char* ws = arg_ws(lds); const int G = opq_g(), bx = opq_bx(); float* X = arg_out(lds);
              pg8::Gemm g{64, 64, DM}; pg8::SchedStd S; S.init(ws + WS_HP, ws + WS_WOUT + (size_t)l * SZ_WOUT, NTOK, DM, DM, DM, G, bx, 4); pg8::EpiResid E{(float*)nullptr, (bf16_t*)(ws + WS_HB), (float*)(ws + WS_SSQ), DM, 1.0f};
              pg8::gemm_phase<pg8::EpiResid, pg8::SchedStd, 32768, 32768>(opq_lds(lds), g, S, E, wv);
            }
            GRID_BAR();
        }
    }
}

extern "C" void kernel_launch(void* const* d_in, const int* in_sizes, int n_in, void* d_out, int out_size, void* d_ws, size_t ws_size, hipStream_t stream) {
    static int grid = 0;
    if (grid == 0) {
        if (n_in != 24 || in_sizes[0] != NTOK * DM || out_size != NTOK * DM || ws_size < WS_END) { fprintf(stderr, "kernel_launch: shape mismatch n_in %d in0 %d out %d ws %zu (need %zu)\n", n_in, n_in > 0 ? in_sizes[0] : -1, out_size, ws_size, (size_t)WS_END); grid = -1; return; }
        int dev = 0, cus = 0, per_cu = 0;
        if (hipGetDevice(&dev) != hipSuccess || hipDeviceGetAttribute(&cus, hipDeviceAttributeMultiprocessorCount, dev) != hipSuccess) { grid = -1; return; }
        if (hipFuncSetAttribute((const void*)mega_fwd, hipFuncAttributeMaxDynamicSharedMemorySize, LDS_BYTES) != hipSuccess) { fprintf(stderr, "kernel_launch: hipFuncSetAttribute failed\n"); grid = -1; return; }
        if (hipOccupancyMaxActiveBlocksPerMultiprocessor(&per_cu, (const void*)mega_fwd, NTHR, LDS_BYTES) != hipSuccess || per_cu < 1) { fprintf(stderr, "kernel_launch: occupancy query says %d\n", per_cu); (void)hipGetLastError(); if (per_cu < 1) { grid = -1; return; } }
        grid = cus;
    }
    if (grid < 0) return;
    if (hipMemsetAsync((char*)d_ws + WS_CTL, 0, CTL_ZERO_BYTES, stream) != hipSuccess) return;
    Args a{};
    for (int i = 0; i < 24; ++i) a.in[i] = (const float*)d_in[i];
    a.out = (float*)d_out; a.ws = (unsigned char*)d_ws;
    hipLaunchKernelGGL(mega_fwd, dim3(grid), dim3(NTHR), LDS_BYTES, stream, a);
    const hipError_t le = hipPeekAtLastError();
    if (le != hipSuccess) fprintf(stderr, "kernel_launch: launch failed: %s\n", hipGetErrorName(le));
}
```

```cpp
#include <hip/hip_runtime.h>
#include <cstdio>
#include <cstdint>

#define LAS __attribute__((address_space(3)))
typedef unsigned short bf16_t;
typedef short bf16x8 __attribute__((ext_vector_type(8)));
typedef short s16x4 __attribute__((ext_vector_type(4)));
typedef float f32x2 __attribute__((ext_vector_type(2)));
typedef float f32x4 __attribute__((ext_vector_type(4)));
typedef float f32x16 __attribute__((ext_vector_type(16)));
typedef unsigned u32x2 __attribute__((ext_vector_type(2)));
typedef unsigned u32x4 __attribute__((ext_vector_type(4)));

constexpr int BATCH = 4, SEQ = 8192, DM = 2048, DFF = 5632, NTOK = BATCH * SEQ, DEPTH = 4, HD = 128;
constexpr int IN_COLS = 5656, PC = 5888;
constexpr int C_QA = 0, C_KA = 1024, C_VA = 2048, C_QN = 3072, C_KC = 4096, C_VC = 4352, C_KS = 4608, C_VS = 4864, C_KW = 5120, C_VW = 5376, C_GL = 5632;
constexpr float EPS = 1e-6f, QSCALE = 0.08838834764831845f, LOG2E = 1.4426950408889634f;
constexpr int TBLS = 1704, TBL0 = 64;
constexpr int DTS = 320, DT0 = 96;
constexpr int NWAVES = 8, NTHR = 512;

constexpr size_t MiB = 1u << 20;
constexpr size_t WS_CTL = 0, CTL_ZERO_BYTES = 1 * MiB;
constexpr size_t WS_TBL = 1 * MiB;
constexpr size_t SZ_WUP = 44 * MiB, SZ_WDN = 22 * MiB, SZ_WIN = 23 * MiB, SZ_WOUT = 8 * MiB, SZ_WC1 = 8 * MiB;
constexpr size_t WS_WUP = 2 * MiB;
constexpr size_t WS_WDN = WS_WUP + 8 * SZ_WUP;
constexpr size_t WS_WIN = WS_WDN + 8 * SZ_WDN;
constexpr size_t WS_WOUT = WS_WIN + 4 * SZ_WIN;
constexpr size_t WS_WC1 = WS_WOUT + 4 * SZ_WOUT;
constexpr size_t WS_HB = WS_WC1 + 4 * SZ_WC1;
constexpr size_t WS_HP = WS_HB + 128 * MiB;
constexpr size_t WS_OA = WS_HP + 368 * MiB;
constexpr size_t WS_LSE = WS_OA + 64 * MiB;
constexpr size_t WS_ON = WS_LSE + 1 * MiB;
constexpr size_t WS_ACMP = WS_ON + 192 * MiB;
constexpr size_t WS_CP = WS_ACMP + 64 * MiB;
constexpr size_t WS_KC = WS_CP + 64 * MiB;
constexpr size_t WS_VC = WS_KC + 1 * MiB;
constexpr size_t WS_SSQ = WS_VC + 1 * MiB;
constexpr size_t WS_RSTD = WS_SSQ + 4 * MiB;
constexpr size_t WS_END = WS_RSTD + 1 * MiB;
constexpr int CW_BAR = 4096;

__device__ __forceinline__ unsigned f2bf(float f) { unsigned u = __builtin_bit_cast(unsigned, f); return (u + 0x7fffu + ((u >> 16) & 1u)) >> 16; }
__device__ __forceinline__ unsigned pk2(float lo, float hi) { return f2bf(lo) | (f2bf(hi) << 16); }
__device__ __forceinline__ float bf2f(bf16_t b) { return __builtin_bit_cast(float, ((unsigned)b) << 16); }
__device__ __forceinline__ float bflo(unsigned w) { return __builtin_bit_cast(float, w << 16); }
__device__ __forceinline__ float bfhi(unsigned w) { return __builtin_bit_cast(float, w & 0xffff0000u); }
__device__ __forceinline__ unsigned cvtpk(float lo, float hi) { unsigned r; asm volatile("v_cvt_pk_bf16_f32 %0, %1, %2" : "=v"(r) : "v"(lo), "v"(hi)); return r; }
__device__ __forceinline__ float shx(float v, int m, int lane) { return __builtin_bit_cast(float, __builtin_amdgcn_ds_bpermute((lane ^ m) << 2, __builtin_bit_cast(int, v))); }
__device__ __forceinline__ float wave_sum(float v, int lane) {
#pragma unroll
    for (int o = 1; o < 64; o <<= 1) v += shx(v, o, lane);
    return v;
}
__device__ __forceinline__ LAS unsigned char* opq_lds(LAS unsigned char* p) { unsigned a = (unsigned)(uintptr_t)p; asm volatile("" : "+s"(a)); return (LAS unsigned char*)(uintptr_t)a; }
__device__ __forceinline__ int opq_tid(int wv) { int l; asm volatile("v_mbcnt_lo_u32_b32 %0, -1, 0\n\tv_mbcnt_hi_u32_b32 %0, -1, %0" : "=v"(l)); return wv * 64 + l; }
__device__ __forceinline__ size_t kt_off(int r, int k, int K) { return (((size_t)(r >> 8) * (K >> 6) + (k >> 6)) * 256 + (r & 255)) * 64 + (k & 63); }
#define LDS_WAIT() asm volatile("s_waitcnt lgkmcnt(0)" ::: "memory")
#define VM_WAIT() asm volatile("s_waitcnt vmcnt(0)" ::: "memory")
#define SBAR() __builtin_amdgcn_sched_barrier(0)

#define XB_TMO      128
#define XB_XCNT(j)  (256  + 64 * (j))
#define XB_XSUB(j)  (1280 + 64 * (j))
#define XB_XGEN(j)  (2304 + 64 * (j))
#define XB_TOP      3328
#define XB_TOPGEN   3392
#define XCD_BAR_WORDS 3456
#define XB_SPIN_CAP (1u << 18)
__device__ __forceinline__ unsigned xb_ld(unsigned* p)              { return __hip_atomic_load(p, __ATOMIC_RELAXED, __HIP_MEMORY_SCOPE_AGENT); }
__device__ __forceinline__ unsigned xb_add(unsigned* p, unsigned v) { return __hip_atomic_fetch_add(p, v, __ATOMIC_RELAXED, __HIP_MEMORY_SCOPE_AGENT); }
__device__ __forceinline__ unsigned xb_xcc_id() { return (unsigned)__builtin_amdgcn_s_getreg((3 << 11) | 20) & 0xFu; }
#define XB_SPIN(cond, bar) do { unsigned _sp = 0; while (cond) { __builtin_amdgcn_s_sleep(1); \
    if ((++_sp & 255u) == 0u) { if (xb_ld(&(bar)[XB_TMO])) break; if (_sp > XB_SPIN_CAP) { atomicAdd(&(bar)[XB_TMO], 1u); break; } } } } while (0)
struct XcdBarrier { unsigned* bar; unsigned x; volatile LAS unsigned* st; };
__device__ __forceinline__ XcdBarrier xcd_barrier_post(unsigned* bar, volatile LAS unsigned* st) {
    XcdBarrier b; b.bar = bar; b.x = xb_xcc_id(); b.st = st;
    if (threadIdx.x == 0) (void)xb_add(&bar[XB_XCNT(b.x)], 1u);
    return b;
}
__device__ __forceinline__ void xcd_barrier_complete(unsigned* bar, unsigned x, unsigned& nloc, unsigned& nx) {
    const unsigned G = gridDim.x * gridDim.y * gridDim.z;
    unsigned sum, cnt, mine, sp = 0u;
    for (;;) {
        sum = 0u; cnt = 0u; mine = 0u;
#pragma unroll
        for (unsigned j = 0; j < 16; ++j) { const unsigned c = xb_ld(&bar[XB_XCNT(j)]); sum += c; cnt += (c > 0u) ? 1u : 0u; mine = (j == x) ? c : mine; }
        if (sum == G) break;
        __builtin_amdgcn_s_sleep(1);
        if ((++sp & 255u) == 0u) { if (xb_ld(&bar[XB_TMO])) break; if (sp > XB_SPIN_CAP) { atomicAdd(&bar[XB_TMO], 1u); break; } }
    }
    nloc = mine > 0u ? mine : 1u; nx = cnt > 0u ? cnt : 1u;
}
__device__ __forceinline__ void xcd_barrier(const XcdBarrier& b, const int wv) {
    asm volatile("s_waitcnt vmcnt(0)" ::: "memory");
    __syncthreads();
    if (opq_tid(wv) == 0) {
        unsigned* bar = b.bar; asm volatile("" : "+s"(bar));
        __builtin_amdgcn_s_waitcnt(0);
        unsigned nloc = b.st[0], nx = b.st[1];
        if (nloc == 0u) { xcd_barrier_complete(bar, b.x, nloc, nx); b.st[0] = nloc; b.st[1] = nx; }
        const unsigned old = xb_add(&bar[XB_XSUB(b.x)], 1u);
        const unsigned gen = old / nloc;
        if (old + 1u == (gen + 1u) * nloc) {
            __builtin_amdgcn_fence(__ATOMIC_RELEASE, "agent");
            asm volatile("s_waitcnt vmcnt(0)" ::: "memory");
            const unsigned og = xb_add(&bar[XB_TOP], 1u);
            const unsigned tg = og / nx;
            if (og + 1u == (tg + 1u) * nx) xb_add(&bar[XB_TOPGEN], 1u);
            else XB_SPIN(xb_ld(&bar[XB_TOPGEN]) == tg, bar);
            __builtin_amdgcn_fence(__ATOMIC_ACQUIRE, "agent");
            xb_add(&bar[XB_XGEN(b.x)], 1u);
            asm volatile("s_waitcnt vmcnt(0)" ::: "memory");
        } else {
            XB_SPIN(xb_ld(&bar[XB_XGEN(b.x)]) == gen, bar);
            __builtin_amdgcn_fence(__ATOMIC_ACQUIRE, "agent");
            asm volatile("s_waitcnt vmcnt(0)" ::: "memory");
        }
    }
    __syncthreads();
}

namespace pg8 {
constexpr int BM = 256, BK = 64, HALF = 128, HTB = HALF * BK * 2, STAGE_BYTES = 8 * HTB, NXCD = 8, WGM = 8;
__host__ __device__ __forceinline__ int lds_byte(int r, int c) { const int st = (r >> 4) * 2 + (c >> 5), rr = r & 15, cc = c & 31, ob = rr * 64 + cc * 2; return st * 1024 + (ob ^ (((ob >> 9) & 1) << 5)); }
__host__ __device__ __forceinline__ void stage_rc(int b, int& R, int& C) { const int st = b / 1024, sb = b % 1024, swz = sb ^ (((sb >> 9) & 1) << 5); R = (st >> 1) * 16 + swz / 64; C = (st & 1) * 32 + (swz % 64) / 2; }
__host__ __device__ __forceinline__ int perm32(int rho) { const int n = rho >> 4, i = rho & 15; return 8 * (i >> 2) + 4 * n + (i & 3); }
struct Unit { int pm, pn, z; };
struct Gemm { int lda, ldb, K; };
struct SchedStd {
    const char* A; const char* Bt; size_t atile, btile; int nM, nN, nwg, G, c, wgm, flip;
    __device__ __forceinline__ void init(const void* A_, const void* Bt_, int M, int N, int lda, int ldb, int G_, int c_, int wgm_ = WGM, int flip_ = 0) { wgm = wgm_; flip = flip_;
        A = (const char*)A_; Bt = (const char*)Bt_; atile = (size_t)BM * lda * 2; btile = (size_t)BM * ldb * 2; nM = M / BM; nN = N / BM; nwg = nM * nN; G = G_; c = c_; }
    __device__ __forceinline__ bool next(int i, Unit& u) const {
        const long L = (long)i * G + c; if (L >= nwg) return false;
        int wgid = (int)L; { const int q = nwg / NXCD, r = nwg % NXCD, xcd = wgid % NXCD, off = wgid / NXCD; wgid = (xcd < r ? xcd * (q + 1) : r * (q + 1) + (xcd - r) * q) + off; }
        const int nig = wgm * nN, gid = wgid / nig, fm = gid * wgm, gsz = (nM - fm) < wgm ? (nM - fm) : wgm;
        u.pm = fm + ((wgid % nig) % gsz); u.pn = (wgid % nig) / gsz; u.z = 0; if (flip) u.pm = nM - 1 - u.pm; return true;
    }
    __device__ __forceinline__ const char* a_ptr(const Unit& u) const { return A + (size_t)u.pm * atile; }
    __device__ __forceinline__ const char* b_ptr(const Unit& u) const { return Bt + (size_t)u.pn * btile; }
};
struct SchedCmp {
    const char* A; const char* Bt; int G, c;
    __device__ __forceinline__ bool next(int i, Unit& u) const { const int L = i * G + c; if (L >= 256) return false; u.z = L >> 5; u.pm = (L & 31) >> 1; u.pn = L & 1; return true; }
    __device__ __forceinline__ const char* a_ptr(const Unit& u) const { const int kv = u.z >> 2, ks = u.z & 3; return A + ((size_t)(kv * 16 + u.pm) * 64 + (size_t)ks * 16) * 32768; }
    __device__ __forceinline__ const char* b_ptr(const Unit& u) const { const int kv = u.z >> 2, ks = u.z & 3; return Bt + ((size_t)(kv * 2 + u.pn) * 64 + (size_t)ks * 16) * 32768; }
};
constexpr int EX_LDS = 131072 + 4096;
struct EpiBf16 {
    static constexpr bool PERM = true;
    static constexpr bool ROWS = true;
    bf16_t* O; int ldc; const float* ssq; const float* kna; const float* knn; const float* pos; bf16_t* acmp; LAS unsigned char* xl;
    __device__ __forceinline__ void operator()(const f32x4 (&acc)[2][2][4][2], const Unit& u, int wr, int wc, int fr, int fq, const float (&pre)[8]) const {
        const int pn = u.pn, e0 = wc * 32 + 8 * fq, lane = fq * 16 + fr;
        const int row0 = u.pm * BM + wr * 64 + fr, col0 = pn * BM + e0;
        if ((pn >= 4 && pn < 8) || pn == 18 || pn == 20) {
            const float* ga = kna + e0; const float* gb = knn + e0; const float* gp = (pn < 8) ? ga + 0 : gb + 0;
            const f32x4 g0 = *(const f32x4*)gp, g1 = *(const f32x4*)(gp + 4);
            LAS float* X = (LAS float*)xl + ((wr * 256 + fr) * 4);
#pragma unroll
            for (int ai = 0; ai < 2; ++ai)
#pragma unroll
                for (int m = 0; m < 4; ++m) { const float rs = pre[ai * 4 + m];
#pragma unroll
                    for (int bj = 0; bj < 2; ++bj) { const f32x4 v0 = acc[ai][bj][m][0] * rs, v1 = acc[ai][bj][m][1] * rs;
                        float s = ((v0[0] * v0[0] + v0[1] * v0[1]) + (v0[2] * v0[2] + v0[3] * v0[3])) + ((v1[0] * v1[0] + v1[1] * v1[1]) + (v1[2] * v1[2] + v1[3] * v1[3]));
                        s += shx(s, 16, lane); s += shx(s, 32, lane);
                        if (fq == 0) X[((ai * 4 + m) * 2 + bj) * 64 + wc] = s; } }
            asm volatile("s_waitcnt lgkmcnt(0)" ::: "memory"); __builtin_amdgcn_s_barrier(); asm volatile("" ::: "memory");
#pragma unroll
            for (int ai = 0; ai < 2; ++ai)
#pragma unroll
                for (int m = 0; m < 4; ++m) { bf16_t* rowp = O + (size_t)(row0 + ai * HALF + m * 16) * ldc + col0; const float rs = pre[ai * 4 + m];
#pragma unroll
                    for (int bj = 0; bj < 2; ++bj) { const f32x4 t4 = *(const LAS f32x4*)(X + ((ai * 4 + m) * 2 + bj) * 64);
                        const float rh = rs / sqrtf(((t4[0] + t4[1]) + (t4[2] + t4[3])) * (1.f / 128.f) + 1e-6f);
                        const f32x4 v0 = acc[ai][bj][m][0] * rh * g0, v1 = acc[ai][bj][m][1] * rh * g1;
                        u32x4 w; w.x = cvtpk(v0[0], v0[1]); w.y = cvtpk(v0[2], v0[3]); w.z = cvtpk(v1[0], v1[1]); w.w = cvtpk(v1[2], v1[3]);
                        *(u32x4*)(rowp + bj * HALF) = w; } }
        } else if (pn == 16 || pn == 17) {
            const int kv = pn - 16;
            const float* pp = pos + fr * 128 + e0;
            const f32x4 pa0 = *(const f32x4*)pp, pa1 = *(const f32x4*)(pp + 4), pb0 = *(const f32x4*)(pp + 16 * 128), pb1 = *(const f32x4*)(pp + 16 * 128 + 4);
#pragma unroll
            for (int ai = 0; ai < 2; ++ai)
#pragma unroll
                for (int m = 0; m < 4; ++m) { const int rowb = u.pm * BM + ai * HALF + wr * 64 + m * 16, b = rowb >> 13, c1 = (rowb & 8191) >> 4; const float rs = pre[ai * 4 + m];
#pragma unroll
                    for (int bj = 0; bj < 2; ++bj) { const f32x4 v0 = acc[ai][bj][m][0] * rs, v1 = acc[ai][bj][m][1] * rs;
                        const int arow0 = kv * 4096 + (b * 2 + bj) * 512;
                        if (c1 <= 510) { u32x4 w; w.x = cvtpk(v0[0] + pa0[0], v0[1] + pa0[1]); w.y = cvtpk(v0[2] + pa0[2], v0[3] + pa0[3]); w.z = cvtpk(v1[0] + pa1[0], v1[1] + pa1[1]); w.w = cvtpk(v1[2] + pa1[2], v1[3] + pa1[3]);
                            *(u32x4*)(acmp + kt_off(arow0 + c1, fr * 128 + e0, 4096)) = w; }
                        else { unsigned zr = 0u; asm volatile("" : "+v"(zr)); const u32x4 z = {zr, zr, zr, zr}; *(u32x4*)(acmp + kt_off(arow0 + 511, fr * 128 + e0, 4096)) = z; *(u32x4*)(acmp + kt_off(arow0 + 511, (fr + 16) * 128 + e0, 4096)) = z; }
                        if (c1 >= 1) { u32x4 w; w.x = cvtpk(v0[0] + pb0[0], v0[1] + pb0[1]); w.y = cvtpk(v0[2] + pb0[2], v0[3] + pb0[3]); w.z = cvtpk(v1[0] + pb1[0], v1[1] + pb1[1]); w.w = cvtpk(v1[2] + pb1[2], v1[3] + pb1[3]);
                            *(u32x4*)(acmp + kt_off(arow0 + c1 - 1, (fr + 16) * 128 + e0, 4096)) = w; } } }
        } else {
#pragma unroll
            for (int ai = 0; ai < 2; ++ai)
#pragma unroll
                for (int m = 0; m < 4; ++m) { bf16_t* rowp = O + (size_t)(row0 + ai * HALF + m * 16) * ldc + col0; const float rs = pre[ai * 4 + m];
#pragma unroll
                    for (int bj = 0; bj < 2; ++bj) { const f32x4 v0 = acc[ai][bj][m][0] * rs, v1 = acc[ai][bj][m][1] * rs;
                        u32x4 w; w.x = cvtpk(v0[0], v0[1]); w.y = cvtpk(v0[2], v0[3]); w.z = cvtpk(v1[0], v1[1]); w.w = cvtpk(v1[2], v1[3]);
                        *(u32x4*)(rowp + bj * HALF) = w; } }
        }
    }
};
struct EpiSwiGLU {
    static constexpr bool PERM = true;
    static constexpr bool ROWS = true;
    bf16_t* O; int ldc; const float* ssq;
    __device__ __forceinline__ void operator()(const f32x4 (&acc)[2][2][4][2], const Unit& u, int wr, int wc, int fr, int fq, const float (&pre)[8]) const {
        const int rowp0 = wr * 64 + fr, kt = 2 * u.pn + (wc >> 1), cit = (wc & 1) * 32 + 8 * fq;
        bf16_t* tile = O + ((size_t)u.pm * (ldc / 64) + kt) * (256 * 64) + cit;
#pragma unroll
        for (int ai = 0; ai < 2; ++ai)
#pragma unroll
            for (int m = 0; m < 4; ++m) { bf16_t* rowp = tile + (size_t)(rowp0 + ai * HALF + m * 16) * 64; const float rs = pre[ai * 4 + m];
                const float c2 = -rs * LOG2E, rs2 = rs * rs;
                f32x4 v[2];
#pragma unroll
                for (int n = 0; n < 2; ++n) { const f32x4 a = acc[ai][0][m][n], b = acc[ai][1][m][n];
                    const f32x4 t = a * c2, ab = a * b;
                    f32x4 d = {__builtin_amdgcn_exp2f(t[0]), __builtin_amdgcn_exp2f(t[1]), __builtin_amdgcn_exp2f(t[2]), __builtin_amdgcn_exp2f(t[3])};
                    d = d + 1.0f;
                    f32x4 r = {__builtin_amdgcn_rcpf(d[0]), __builtin_amdgcn_rcpf(d[1]), __builtin_amdgcn_rcpf(d[2]), __builtin_amdgcn_rcpf(d[3])};
                    r = r * rs2;
                    v[n] = ab * r; }
                u32x4 w; w.x = cvtpk(v[0][0], v[0][1]); w.y = cvtpk(v[0][2], v[0][3]); w.z = cvtpk(v[1][0], v[1][1]); w.w = cvtpk(v[1][2], v[1][3]);
                *(u32x4*)rowp = w; }
    }
};
struct EpiResid {
    static constexpr bool PERM = false;
    static constexpr bool ROWS = false;
    float* out; bf16_t* xb; float* ssq; int ldc; float alpha;
    __device__ __forceinline__ void operator()(const f32x4 (&acc)[2][2][4][2], const Unit& u, int wr, int wc, int fr, int fq, const float (&pre)[8]) const {
        const int row0 = u.pm * BM + wr * 64 + fr, col0 = u.pn * BM + wc * 32 + 4 * fq;
        u32x2 bs[4][4];
#define ER_LOAD(g) do { const int row_ = row0 + ((g) >> 2) * HALF + ((g) & 3) * 16; \
        _Pragma("unroll") for (int q_ = 0; q_ < 4; ++q_) bs[(g) & 3][q_] = *(const u32x2*)(xb + kt_off(row_, col0 + (q_ >> 1) * HALF + (q_ & 1) * 16, ldc)); } while (0)
        ER_LOAD(0); ER_LOAD(1); ER_LOAD(2); ER_LOAD(3);
#pragma unroll
        for (int g = 0; g < 8; ++g) { const int ai = g >> 2, m = g & 3; const int row = row0 + ai * HALF + m * 16; float ss = 0.f;
#pragma unroll
            for (int q = 0; q < 4; ++q) { const int bj = q >> 1, n = q & 1; const u32x2 b = bs[g & 3][q];
                const f32x4 o = (f32x4){bflo(b.x), bfhi(b.x), bflo(b.y), bfhi(b.y)} + acc[ai][bj][m][n] * alpha;
                ss += (o.x * o.x + o.y * o.y) + (o.z * o.z + o.w * o.w);
                u32x2 w; w.x = cvtpk(o.x, o.y); w.y = cvtpk(o.z, o.w); *(u32x2*)(xb + kt_off(row, col0 + bj * HALF + n * 16, ldc)) = w;
                if (out) *(f32x4*)(out + (size_t)row * ldc + col0 + bj * HALF + n * 16) = o; }
            if (g + 4 < 8) ER_LOAD(g + 4);
            const int lane = fq * 16 + fr; ss += shx(ss, 16, lane); ss += shx(ss, 32, lane);
            if (fq == 0) ssq[(size_t)row * 32 + u.pn * 4 + wc] = ss; }
#undef ER_LOAD
    }
};
struct EpiF32Z {
    static constexpr bool PERM = false;
    float* C; int ldc; size_t zstride;
    static constexpr bool ROWS = false;
    __device__ __forceinline__ void operator()(const f32x4 (&acc)[2][2][4][2], const Unit& u, int wr, int wc, int fr, int fq, const float (&pre)[8]) const {
        float* Cz = C + (size_t)u.z * zstride;
        const int row0 = u.pm * BM + wr * 64 + fr, col0 = u.pn * BM + wc * 32 + 4 * fq;
#pragma unroll
        for (int ai = 0; ai < 2; ++ai)
#pragma unroll
            for (int m = 0; m < 4; ++m) { float* rowp = Cz + (size_t)(row0 + ai * HALF + m * 16) * ldc + col0;
#pragma unroll
                for (int bj = 0; bj < 2; ++bj)
#pragma unroll
                    for (int n = 0; n < 2; ++n) *(f32x4*)(rowp + bj * HALF + n * 16) = acc[ai][bj][m][n]; }
    }
};

constexpr int RS_LDS = 131072 + 1024;
__device__ __forceinline__ void rows_to_lds(LAS unsigned char* lds, const float* ssq, int pm, int slot, int tid) {
    const int row = tid >> 1, half = tid & 1;
    const f32x4* p = (const f32x4*)(ssq + ((size_t)pm * BM + row) * 32 + half * 16);
    f32x4 a = p[0]; a = a + p[1]; a = a + p[2]; a = a + p[3];
    float s = (a.x + a.y) + (a.z + a.w); s += shx(s, 1, tid & 63);
    const float rs = 1.0f / sqrtf(s * (1.f / 2048.f) + 1e-6f);
    if (half == 0) *(LAS float*)(lds + RS_LDS + slot * 1024 + row * 4) = rs;
}
template <class Epi, class Sched, int KSTEP_A = 128, int KSTEP_B = 128>
__device__ __forceinline__ void gemm_phase(LAS unsigned char* lds, const Gemm g, const Sched& S, const Epi& E, const int wv) {
    const int tid = opq_tid(wv), wid = __builtin_amdgcn_readfirstlane(tid >> 6), lane = tid & 63, wr = wid >> 2, wc = wid & 3, fr = lane & 15, fq = lane >> 4;
    const int K = g.K, nt = K / BK;
    unsigned voffA[2], voffB[2];
#pragma unroll
    for (int i = 0; i < 2; ++i) { int R, C; stage_rc(tid * 16 + i * 8192, R, C); const int Rb = Epi::PERM ? ((R & ~31) + perm32(R & 31)) : R;
        voffA[i] = (unsigned)(R * g.lda + C) * 2u; voffB[i] = (unsigned)(Rb * g.ldb + C) * 2u; }
    constexpr size_t kstepA = (size_t)KSTEP_A, kstepB = (size_t)KSTEP_B;
    const size_t hstepA = (size_t)HALF * g.lda * 2, hstepB = (size_t)HALF * g.ldb * 2;
    const unsigned ldsw = (unsigned)wid * 1024u;
    const int aoff = lds_byte(wr * 64 + fr, fq * 8), boff = lds_byte(wc * 32 + fr, fq * 8);
#define PG8_SA(b, h) (((b) * 2 + (h)) * HTB)
#define PG8_SB(b, h) ((4 + (b) * 2 + (h)) * HTB)
#define PG8_STAGE(bufoff, gbase, voff) do { _Pragma("unroll") for (int _i = 0; _i < 2; ++_i) \
        __builtin_amdgcn_global_load_lds((const unsigned*)((const char*)(gbase) + (voff)[_i]), (LAS unsigned*)(lds + (bufoff) + ldsw + _i * 8192), 16, 0, 0); } while (0)
#define PG8_LDA(dst, b, h) do { _Pragma("unroll") for (int m = 0; m < 4; ++m) _Pragma("unroll") for (int k = 0; k < 2; ++k) dst[m][k] = *(const LAS bf16x8*)(lds + PG8_SA(b, h) + aoff + m * 2048 + k * 1024); } while (0)
#define PG8_LDB(dst, b, h) do { _Pragma("unroll") for (int n = 0; n < 2; ++n) _Pragma("unroll") for (int k = 0; k < 2; ++k) dst[n][k] = *(const LAS bf16x8*)(lds + PG8_SB(b, h) + boff + n * 2048 + k * 1024); } while (0)
#define PG8_MMA(ai, bj, At, Bt) do { __builtin_amdgcn_s_setprio(1); _Pragma("unroll") for (int m = 0; m < 4; ++m) _Pragma("unroll") for (int n = 0; n < 2; ++n) _Pragma("unroll") for (int k = 0; k < 2; ++k) \
        acc[ai][bj][m][n] = __builtin_amdgcn_mfma_f32_16x16x32_bf16(Bt[n][k], At[m][k], acc[ai][bj][m][n], 0, 0, 0); __builtin_amdgcn_s_setprio(0); } while (0)
#define PG8_WAIT_V(n) asm volatile("s_waitcnt vmcnt(" #n ")" ::: "memory")
#define PG8_WAIT_L(n) asm volatile("s_waitcnt lgkmcnt(" #n ")" ::: "memory")
#define PG8_BAR __builtin_amdgcn_s_barrier()
#define PG8_SCHED __builtin_amdgcn_sched_barrier(0)
    Unit cur, nxt; int ui = 0;
    if (!S.next(0, cur)) return;
    f32x4 acc[2][2][4][2];
#pragma unroll
    for (int a = 0; a < 2; ++a)
#pragma unroll
        for (int b = 0; b < 2; ++b)
#pragma unroll
            for (int m = 0; m < 4; ++m)
#pragma unroll
                for (int n = 0; n < 2; ++n) acc[a][b][m][n] = (f32x4){0.f, 0.f, 0.f, 0.f};
    bf16x8 At[4][2], B0[2][2], B1[2][2];
    const char* cA = S.a_ptr(cur); const char* cB = S.b_ptr(cur);
    float pre[8]; int rslot = 0; if constexpr (Epi::ROWS) rows_to_lds(lds, E.ssq, cur.pm, 0, tid);
    PG8_STAGE(PG8_SB(0, 0), cB, voffB); PG8_STAGE(PG8_SA(0, 0), cA, voffA); PG8_STAGE(PG8_SB(0, 1), cB + hstepB, voffB); PG8_STAGE(PG8_SA(0, 1), cA + hstepA, voffA);
    if (wr == 1) PG8_BAR;
    PG8_WAIT_V(4); PG8_BAR;
    PG8_STAGE(PG8_SB(1, 0), cB + kstepB, voffB); PG8_STAGE(PG8_SA(1, 0), cA + kstepA, voffA); PG8_STAGE(PG8_SB(1, 1), cB + hstepB + kstepB, voffB);
    PG8_WAIT_V(6); PG8_BAR;
    for (;;) {
        const bool has_next = S.next(ui + 1, nxt);
        const char* nA = has_next ? S.a_ptr(nxt) : cA; const char* nB = has_next ? S.b_ptr(nxt) : cB;
        for (int t = 0; t < nt; t += 2) {
            const bool last = (t == nt - 2);
            const char* a1 = cA + (size_t)(t + 1) * kstepA;
            const char* a2 = last ? nA : cA + (size_t)(t + 2) * kstepA; const char* b2 = last ? nB : cB + (size_t)(t + 2) * kstepB;
            const char* a3 = a2 + kstepA; const char* b3 = b2 + kstepB;
            PG8_LDB(B0, 0, 0); PG8_SCHED; PG8_LDA(At, 0, 0); PG8_STAGE(PG8_SA(1, 1), a1 + hstepA, voffA);
            PG8_WAIT_L(8); PG8_BAR; PG8_WAIT_L(0); PG8_MMA(0, 0, At, B0); PG8_BAR; PG8_SCHED;
            PG8_LDB(B1, 0, 1); PG8_STAGE(PG8_SB(0, 0), b2, voffB);
            PG8_BAR; PG8_WAIT_L(0); PG8_MMA(0, 1, At, B1); PG8_BAR;
            PG8_LDA(At, 0, 1); PG8_STAGE(PG8_SA(0, 0), a2, voffA);
            PG8_BAR; PG8_WAIT_L(0); PG8_MMA(1, 0, At, B0); PG8_BAR; PG8_SCHED;
            PG8_STAGE(PG8_SB(0, 1), b2 + hstepB, voffB);
            PG8_WAIT_V(6); PG8_BAR; PG8_MMA(1, 1, At, B1); PG8_BAR;
            PG8_LDB(B0, 1, 0); PG8_SCHED; PG8_LDA(At, 1, 0); PG8_STAGE(PG8_SA(0, 1), a2 + hstepA, voffA);
            PG8_WAIT_L(8); PG8_BAR; PG8_WAIT_L(0); PG8_MMA(0, 0, At, B0); PG8_BAR; PG8_SCHED;
            PG8_LDB(B1, 1, 1); PG8_STAGE(PG8_SB(1, 0), b3, voffB);
            PG8_BAR; PG8_WAIT_L(0); PG8_MMA(0, 1, At, B1); PG8_BAR;
            PG8_LDA(At, 1, 1); PG8_STAGE(PG8_SA(1, 0), a3, voffA);
            PG8_BAR; PG8_WAIT_L(0); PG8_MMA(1, 0, At, B0); PG8_BAR; PG8_SCHED;
            PG8_STAGE(PG8_SB(1, 1), b3 + hstepB, voffB);
            PG8_WAIT_V(6); PG8_BAR; PG8_MMA(1, 1, At, B1); PG8_BAR;
        }
        if constexpr (Epi::ROWS) {
#pragma unroll
            for (int i = 0; i < 8; ++i) pre[i] = *(const LAS float*)(lds + RS_LDS + rslot * 1024 + (wr * 64 + fr + (i >> 2) * HALF + (i & 3) * 16) * 4); }
        E(acc, cur, wr, wc, fr, fq, pre);
        if constexpr (Epi::ROWS) { if (has_next && nxt.pm != cur.pm) { rslot ^= 1; rows_to_lds(lds, E.ssq, nxt.pm, rslot, tid); } }
        if (!has_next) break;
#pragma unroll
        for (int a = 0; a < 2; ++a)
#pragma unroll
            for (int b = 0; b < 2; ++b)
#pragma unroll
                for (int m = 0; m < 4; ++m)
#pragma unroll
                    for (int n = 0; n < 2; ++n) acc[a][b][m][n] = (f32x4){0.f, 0.f, 0.f, 0.f};
        cur = nxt; cA = nA; cB = nB; ++ui;
    }
    PG8_WAIT_V(0);
    if (wr == 0) PG8_BAR;
    PG8_BAR;
#undef PG8_SA
#undef PG8_SB
#undef PG8_STAGE
#undef PG8_LDA
#undef PG8_LDB
#undef PG8_MMA
#undef PG8_WAIT_V
#undef PG8_WAIT_L
#undef PG8_BAR
#undef PG8_SCHED
}
}

struct Args { const float* in[24]; float* out; unsigned char* ws; };
enum { I_X = 0, I_F1N, I_F1W1, I_F1W3, I_F1W2, I_MIXN, I_WIN, I_GB, I_QNA, I_KNA, I_QNN, I_KNN, I_POS, I_CKW1, I_CKW2, I_CVW1, I_CVW2, I_ON, I_WOUT, I_F2N, I_F2W1, I_F2W3, I_F2W2, I_RB };

__device__ __forceinline__ void transpose_item(const float* W, int K, int N, bf16_t* WT, int mode, int off, LAS float* scr, int item, int lane, const float* gain) {
    const int nblk = (N + 31) / 32, kb = item / nblk, nb = item % nblk, k0 = 64 * kb, n0 = 32 * nb;
    const int c4 = 4 * (lane & 7), nn = n0 + c4;
    f32x4 ld[8];
#pragma unroll
    for (int i = 0; i < 8; ++i) { const int kk = 8 * i + (lane >> 3); ld[i] = (nn < N) ? *(const f32x4*)(W + (size_t)(k0 + kk) * N + nn) : (f32x4){0.f, 0.f, 0.f, 0.f}; if (gain) ld[i] = ld[i] * gain[k0 + kk]; }
#pragma unroll
    for (int i = 0; i < 8; ++i) { const int kk = 8 * i + (lane >> 3); LAS float* d = scr + kk * 33 + c4; d[0] = ld[i].x; d[1] = ld[i].y; d[2] = ld[i].z; d[3] = ld[i].w; }
    LDS_WAIT(); asm volatile("" ::: "memory");
    const int c = lane & 7;
#pragma unroll
    for (int j = 0; j < 4; ++j) { const int n = (lane >> 3) + 8 * j; const LAS float* s = scr + (8 * c) * 33 + n;
        u32x4 o; o.x = pk2(s[0 * 33], s[1 * 33]); o.y = pk2(s[2 * 33], s[3 * 33]); o.z = pk2(s[4 * 33], s[5 * 33]); o.w = pk2(s[6 * 33], s[7 * 33]);
        const int ng = n0 + n; const int dr = mode ? ((ng >> 7) * 256 + (ng & 127) + off) : (ng + off);
        if (ng < N) *(u32x4*)(WT + kt_off(dr, k0 + 8 * c, K)) = o; }
    LDS_WAIT(); asm volatile("" ::: "memory");
}
__device__ __forceinline__ int rel_bucket_dev(int n) {
    if (n < 16) return n;
    const float v = logf((float)n / 16.0f) / 4.852030263919617f * 16.0f;
    int b = 16 + (int)v; return b < 31 ? b : 31;
}
namespace att {
constexpr int SHM_V = 16384, SHM_K = 16384;
constexpr int L_V = 0  , L_K = 49152  , L_WS = 98304, L_TBL = 100352, L_SELM = L_TBL + 4 * TBLS * 4  , L_END = L_SELM + 1024;
constexpr int L_IMP = 0;
static_assert(L_END <= 131072, "attention LDS map");
constexpr float THR = 8.f;
#define KSWZ(row, colB) ((row) * 256 + ((colB) ^ (((row) & 7) << 4)))
__device__ __forceinline__ int v_st(int k, int c) { const int kk = (k & ~0xC) | ((k & 4) << 1) | ((k & 8) >> 1); return ((kk >> 3) * 4 + (c >> 5)) * 512 + ((kk & 7) * 32 + (c & 31)) * 2; }
__device__ __forceinline__ int v_rd_base(int lane) { return ((lane & 3) << 3) | (((lane >> 2) & 3) << 6) | (((lane >> 4) & 1) << 5) | (((lane >> 5) & 1) << 8); }
__device__ __forceinline__ int crow(int r, int hi) { return (r & 3) + 8 * (r >> 2) + 4 * hi; }

__device__ __forceinline__ void partialSM(f32x16& p0, f32x16& p1, float& m_reg, float& mn, float& alpha) {
    (void)m_reg; mn = 0.f; alpha = 1.f;
#pragma unroll
    for (int r = 0; r < 16; ++r) p0[r] = __builtin_amdgcn_exp2f(p0[r] * LOG2E);
#pragma unroll
    for (int r = 0; r < 16; ++r) p1[r] = p1[r] * LOG2E;
}
__device__ __forceinline__ void partialSM_row(f32x16& p0, f32x16& p1, float& m_reg, float& mn, float& alpha, bool ok, float bias) {
    (void)m_reg; mn = 0.f; alpha = 1.f;
    const float mnL = ok ? bias * LOG2E : -__builtin_inff();
#pragma unroll
    for (int r = 0; r < 16; ++r) p0[r] = __builtin_amdgcn_exp2f(fmaf(p0[r], LOG2E, mnL));
#pragma unroll
    for (int r = 0; r < 16; ++r) p1[r] = fmaf(p1[r], LOG2E, mnL);
}
#define PK4(P, B_, OUT) do { unsigned a0 = cvtpk(P[B_+0], P[B_+1]), a1 = cvtpk(P[B_+2], P[B_+3]);                          \
        unsigned b0 = cvtpk(P[B_+4], P[B_+5]), b1 = cvtpk(P[B_+6], P[B_+7]);                                             \
        auto r0 = __builtin_amdgcn_permlane32_swap(a0, b0, false, false); auto r1 = __builtin_amdgcn_permlane32_swap(a1, b1, false, false); \
        u32x4 w = {r0[0], r1[0], r0[1], r1[1]}; OUT = *reinterpret_cast<bf16x8*>(&w); } while (0)
__device__ __forceinline__ void finishSM(f32x16& p0, f32x16& p1, float alpha, float& l_reg, bf16x8& pa0, bf16x8& pa1, bf16x8& pa2, bf16x8& pa3) {
#pragma unroll
    for (int r = 0; r < 16; ++r) p1[r] = __builtin_amdgcn_exp2f(p1[r]);
    float ps = 0;
#pragma unroll
    for (int r = 0; r < 16; ++r) ps += p0[r];
#pragma unroll
    for (int r = 0; r < 16; ++r) ps += p1[r];
    { auto rr = __builtin_amdgcn_permlane32_swap(__float_as_uint(ps), __float_as_uint(ps), false, false);
      ps = __uint_as_float(rr[0]) + __uint_as_float(rr[1]); }
    l_reg = l_reg * alpha + ps;
    PK4(p0, 0, pa0); PK4(p0, 8, pa1); PK4(p1, 0, pa2); PK4(p1, 8, pa3);
}
__device__ __forceinline__ void qkt(f32x16& p0, f32x16& p1, const LAS char* Kb, int r32, int hi, const bf16x8 (&qr)[8]) {
    p0 = f32x16{}; p1 = f32x16{};
    const LAS char* kb4[4];
#pragma unroll
    for (int dd = 0; dd < 4; ++dd) kb4[dd] = Kb + KSWZ(r32, (dd * 16 + hi * 8) * 2);
#pragma unroll
    for (int d0 = 0; d0 < 8; ++d0) { const LAS char* a = kb4[d0 & 3] + (d0 >> 2) * 128;
        const bf16x8 b0 = *reinterpret_cast<const LAS bf16x8*>(a);
        const bf16x8 b1 = *reinterpret_cast<const LAS bf16x8*>(a + 32 * 256);
        p0 = __builtin_amdgcn_mfma_f32_32x32x16_bf16(b0, qr[d0], p0, 0, 0, 0);
        p1 = __builtin_amdgcn_mfma_f32_32x32x16_bf16(b1, qr[d0], p1, 0, 0, 0); }
}
__device__ __forceinline__ void pv_tile(f32x16 (&o)[4], int vb, bf16x8 pa0, bf16x8 pa1, bf16x8 pa2, bf16x8 pa3) {
#define TRRD(dst, off) asm volatile("ds_read_b64_tr_b16 %0, %1 offset:%2" : "=&v"(dst) : "v"(vb), "i"(off) : "memory")
#define PV_D0(d0) do { s16x4 l0, l1, l2, l3, h0, h1, h2, h3; constexpr int b_ = (d0) * 512; \
        TRRD(l0, b_); TRRD(h0, b_ + 2048); TRRD(l1, b_ + 4096); TRRD(h1, b_ + 6144); TRRD(l2, b_ + 8192); TRRD(h2, b_ + 10240); TRRD(l3, b_ + 12288); TRRD(h3, b_ + 14336); \
        asm volatile("s_waitcnt lgkmcnt(0)" ::: "memory"); SBAR(); \
        o[d0] = __builtin_amdgcn_mfma_f32_32x32x16_bf16(pa0, (bf16x8){l0[0], l0[1], l0[2], l0[3], h0[0], h0[1], h0[2], h0[3]}, o[d0], 0, 0, 0);   \
        o[d0] = __builtin_amdgcn_mfma_f32_32x32x16_bf16(pa1, (bf16x8){l1[0], l1[1], l1[2], l1[3], h1[0], h1[1], h1[2], h1[3]}, o[d0], 0, 0, 0);   \
        o[d0] = __builtin_amdgcn_mfma_f32_32x32x16_bf16(pa2, (bf16x8){l2[0], l2[1], l2[2], l2[3], h2[0], h2[1], h2[2], h2[3]}, o[d0], 0, 0, 0);   \
        o[d0] = __builtin_amdgcn_mfma_f32_32x32x16_bf16(pa3, (bf16x8){l3[0], l3[1], l3[2], l3[3], h3[0], h3[1], h3[2], h3[3]}, o[d0], 0, 0, 0); } while (0)
    PV_D0(0); PV_D0(1); PV_D0(2); PV_D0(3);
#undef PV_D0
#undef TRRD
}

template <class Cfg>
__device__ __forceinline__ void attn_tiles(const Cfg& c, LAS char* lds, const bf16x8 (&qr)[8], f32x16 (&o)[4], float& m_reg, float& l_reg, const int t_lo, const int t_hi, const int wv) {
    const int tid = opq_tid(wv), lane = tid & 63, wid = __builtin_amdgcn_readfirstlane(tid >> 6), r32 = lane & 31, hi = lane >> 5;
    LAS char* V_lds = lds + L_V; LAS char* K_lds = lds + L_K;
    LAS float* al_l = (LAS float*)(lds + L_WS) + wid * 64 + 32;
    const int sr = tid >> 4, sc = (tid & 15) * 8;
    const int vst0 = v_st(sr, sc), vst1 = v_st(32 + sr, sc), kws = KSWZ(sr, sc * 2);
    const int vb0 = (int)(unsigned)(uintptr_t)V_lds + v_rd_base(lane);
    bf16x8 sk0, sk1, sv0, sv1;
    const bf16_t *gk0 = nullptr, *gk1 = nullptr, *gv0 = nullptr, *gv1 = nullptr;
#define AT_LOAD(t) do { gk0 = c.krow((t), sr) + sc; gk1 = c.krow((t), sr + 32) + sc; sk0 = *(const bf16x8*)gk0; sk1 = *(const bf16x8*)gk1; \
        if constexpr (Cfg::MODE == 0) { gv0 = c.vrow((t), sr) + sc; gv1 = c.vrow((t), sr + 32) + sc; sv0 = *(const bf16x8*)gv0; sv1 = *(const bf16x8*)gv1; } \
        asm volatile("" ::: "memory"); SBAR(); } while (0)
#define AT_WRITE(t, bf) do { asm volatile("" :: "v"(gk0), "v"(gk1), "v"(gv0), "v"(gv1)); *(LAS bf16x8*)(K_lds + (bf) * SHM_K + kws) = sk0; *(LAS bf16x8*)(K_lds + (bf) * SHM_K + kws + 32 * 256) = sk1; \
        if constexpr (Cfg::MODE == 1) { \
            _Pragma("unroll") for (int i_ = 0; i_ < 8; ++i_) { const int n_ = sc + i_, c0_ = 64 * (t) + sr, c1_ = c0_ + 32; \
                sv0[i_] = (c0_ >= 4 * n_ - 1 && c0_ <= 4 * n_ + 3) ? (short)0x3F80 : (short)0; sv1[i_] = (c1_ >= 4 * n_ - 1 && c1_ <= 4 * n_ + 3) ? (short)0x3F80 : (short)0; } } \
        *(LAS bf16x8*)(V_lds + (bf) * SHM_V + vst0) = sv0; *(LAS bf16x8*)(V_lds + (bf) * SHM_V + vst1) = sv1; } while (0)
    __builtin_amdgcn_s_waitcnt(0x0F70);
    __syncthreads();
    if (t_lo < t_hi) { AT_LOAD(t_lo); AT_WRITE(t_lo, 0); }
    __syncthreads();
    for (int t = t_lo; t < t_hi; ++t) {
        const int buf = (t - t_lo) & 1; const bool more = (t + 1 < t_hi);
        if (more) AT_LOAD(t + 1);
        if (c.active(t)) {
            f32x16 p0, p1;
            qkt(p0, p1, K_lds + buf * SHM_K, r32, hi, qr);
            if constexpr (Cfg::MODE == 0) {
                float mn, alpha; bf16x8 pa0, pa1, pa2, pa3;
                bool rok; float rbias;
                if (c.rowconst(t, rok, rbias)) partialSM_row(p0, p1, m_reg, mn, alpha, rok, rbias);
                else { c.mask(p0, p1, t); partialSM(p0, p1, m_reg, mn, alpha); }
                if (__any(alpha < 1.f)) { if (hi == 0) al_l[r32] = alpha; LDS_WAIT();
#pragma unroll
                    for (int d_ = 0; d_ < 4; ++d_)
#pragma unroll
                        for (int r = 0; r < 16; ++r) o[d_][r] *= al_l[crow(r, hi)]; }
                finishSM(p0, p1, alpha, l_reg, pa0, pa1, pa2, pa3); SBAR();
                pv_tile(o, vb0 + buf * SHM_V, pa0, pa1, pa2, pa3);
            } else {
                c.mask(p0, p1, t);
                const float mL = -c.mfix * LOG2E; const float il = c.invl;
#pragma unroll
                for (int r = 0; r < 16; ++r) { p0[r] = __builtin_amdgcn_exp2f(fmaf(p0[r], LOG2E, mL)) * il; p1[r] = __builtin_amdgcn_exp2f(fmaf(p1[r], LOG2E, mL)) * il; }
                bf16x8 pa0, pa1, pa2, pa3;
                PK4(p0, 0, pa0); PK4(p0, 8, pa1); PK4(p1, 0, pa2); PK4(p1, 8, pa3); SBAR();
                pv_tile(o, vb0 + buf * SHM_V, pa0, pa1, pa2, pa3);
#pragma unroll
                for (int r = 0; r < 16; r += 2) { const unsigned a = cvtpk(p0[r], p0[r + 1]), b = cvtpk(p1[r], p1[r + 1]);
                    p0[r] -= bflo(a); p0[r + 1] -= bfhi(a); p1[r] -= bflo(b); p1[r + 1] -= bfhi(b); }
                PK4(p0, 0, pa0); PK4(p0, 8, pa1); PK4(p1, 0, pa2); PK4(p1, 8, pa3); SBAR();
                pv_tile(o, vb0 + buf * SHM_V, pa0, pa1, pa2, pa3);
            }
        }
        if (more) AT_WRITE(t + 1, buf ^ 1);
        __syncthreads();
    }
#undef AT_LOAD
#undef AT_WRITE
}

template <class Cfg>
__device__ __forceinline__ void attn_tiles_s(const Cfg& c, LAS char* lds, const bf16x8 (&qr)[8], f32x16 (&o)[4], float& m_reg, float& l_reg, const int t_lo, const int t_hi, const int wv) {
    static_assert(Cfg::MODE == 0, "fixed-shift softmax tiles only");
    (void)m_reg;
    const int tid = opq_tid(wv), lane = tid & 63, wid = __builtin_amdgcn_readfirstlane(tid >> 6), r32 = lane & 31, hi = lane >> 5;
    LAS char* V_lds = lds + L_V; LAS char* K_lds = lds + L_K;
    const int sr = tid >> 4, sc = (tid & 15) * 8;
    const int vst0 = v_st(sr, sc), vst1 = v_st(32 + sr, sc), kws = KSWZ(sr, sc * 2);
    const int vb0 = (int)(unsigned)(uintptr_t)V_lds + v_rd_base(lane);
    bf16x8 sk0, sk1, sv0, sv1, pa0, pa1, pa2, pa3;
    const bf16_t *gk0 = nullptr, *gk1 = nullptr, *gv0 = nullptr, *gv1 = nullptr;
#define AS_LOAD(t) do { gk0 = c.krow((t), sr) + sc; gk1 = c.krow((t), sr + 32) + sc; sk0 = *(const bf16x8*)gk0; sk1 = *(const bf16x8*)gk1; \
        gv0 = c.vrow((t), sr) + sc; gv1 = c.vrow((t), sr + 32) + sc; sv0 = *(const bf16x8*)gv0; sv1 = *(const bf16x8*)gv1; asm volatile("" ::: "memory"); SBAR(); } while (0)
#define AS_WRITE(kbf, vbf) do { asm volatile("" :: "v"(gk0), "v"(gk1), "v"(gv0), "v"(gv1)); *(LAS bf16x8*)(K_lds + (kbf) * SHM_K + kws) = sk0; *(LAS bf16x8*)(K_lds + (kbf) * SHM_K + kws + 32 * 256) = sk1; \
        *(LAS bf16x8*)(V_lds + (vbf) * SHM_V + vst0) = sv0; *(LAS bf16x8*)(V_lds + (vbf) * SHM_V + vst1) = sv1; } while (0)
#define AS_SCORE(t, kbf) do { f32x16 p0, p1; float mz_ = 0.f, mn_, al_; bool rok_; float rb_; \
        qkt(p0, p1, K_lds + (kbf) * SHM_K, r32, hi, qr); \
        if (c.rowconst((t), rok_, rb_)) partialSM_row(p0, p1, mz_, mn_, al_, rok_, rb_); else { c.mask(p0, p1, (t)); partialSM(p0, p1, mz_, mn_, al_); } \
        finishSM(p0, p1, 1.f, l_reg, pa0, pa1, pa2, pa3); SBAR(); } while (0)
    if (t_lo >= t_hi) return;
    __builtin_amdgcn_s_waitcnt(0x0F70);
    __syncthreads();
    AS_LOAD(t_lo); AS_WRITE(0, 0);
    __syncthreads();
    int kb = 0, vb = 0;
    if (wid < 4) {
        for (int t = t_lo; t < t_hi; ++t) {
            const bool more = (t + 1 < t_hi); const int vn = (vb == 2) ? 0 : vb + 1;
            if (more) AS_LOAD(t + 1);
            if (c.active(t)) { AS_SCORE(t, kb); pv_tile(o, vb0 + vb * SHM_V, pa0, pa1, pa2, pa3); }
            if (more) AS_WRITE(kb ^ 1, vn);
            __syncthreads();
            kb ^= 1; vb = vn;
        }
    } else {
        bool pend = false; int vp = 0;
        for (int t = t_lo; t < t_hi; ++t) {
            const bool more = (t + 1 < t_hi); const int vn = (vb == 2) ? 0 : vb + 1;
            if (more) AS_LOAD(t + 1);
            if (pend) pv_tile(o, vb0 + vp * SHM_V, pa0, pa1, pa2, pa3);
            const bool act = c.active(t);
            if (act) AS_SCORE(t, kb);
            pend = act; vp = vb;
            if (more) AS_WRITE(kb ^ 1, vn);
            __syncthreads();
            kb ^= 1; vb = vn;
        }
        if (pend) pv_tile(o, vb0 + vp * SHM_V, pa0, pa1, pa2, pa3);
    }
#undef AS_LOAD
#undef AS_WRITE
#undef AS_SCORE
}

struct DilCfg {
    static constexpr int MODE = 0;
    const bf16_t* Kb; const bf16_t* Vb;
    const LAS float* tbl; int dshift, res, u, dqm, s0;
    __device__ __forceinline__ const bf16_t* krow(int t, int kk) const { int s = 256 * u - 128 + 64 * t + kk; s = s < 0 ? 0 : s; return Kb + (size_t)((s << dshift) + res) * PC; }
    __device__ __forceinline__ const bf16_t* vrow(int t, int kk) const { int s = 256 * u - 128 + 64 * t + kk; s = s < 0 ? 0 : s; return Vb + (size_t)((s << dshift) + res) * PC; }
    __device__ __forceinline__ bool active(int t) const { const int kb = 256 * u - 128 + 64 * t; return kb <= s0 + 31 && kb + 63 >= s0 - 128; }
    __device__ __forceinline__ bool rowconst(int, bool&, float&) const { return false; }
    __device__ __forceinline__ void mask(f32x16& p0, f32x16& p1, int t) const {
        const int dq = dqm - (256 * u - 128 + 64 * t); const float NEG = -__builtin_inff();
        const LAS float* tb = tbl + (DT0 + dq - 63);
        float bb0[16], bb1[16];
#pragma unroll
        for (int r = 0; r < 16; ++r) { const int cc = (r & 3) + 8 * (r >> 2); bb0[r] = tb[63 - cc]; bb1[r] = tb[31 - cc]; }
#pragma unroll
        for (int r = 0; r < 16; ++r) asm volatile("" : "+v"(bb0[r]), "+v"(bb1[r]));
#pragma unroll
        for (int r = 0; r < 16; ++r) { const int cc = (r & 3) + 8 * (r >> 2); const unsigned d0 = (unsigned)(dq - cc), d1 = (unsigned)(dq - cc - 32);
            p0[r] = (d0 <= 128u) ? p0[r] + bb0[r] : NEG; p1[r] = (d1 <= 128u) ? p1[r] + bb1[r] : NEG; }
    }
};
struct CmpCfg {
    static constexpr int MODE = 0;
    const bf16_t* Kb; const bf16_t* Vb; int cmax, hi4, cfull;
    __device__ __forceinline__ bool rowconst(int t, bool& ok, float& bias) const { ok = true; bias = 0.f; return 64 * t + 63 <= cfull; }
    __device__ __forceinline__ const bf16_t* krow(int t, int kk) const { return Kb + (size_t)(64 * t + kk) * HD; }
    __device__ __forceinline__ const bf16_t* vrow(int t, int kk) const { return Vb + (size_t)(64 * t + kk) * HD; }
    __device__ __forceinline__ bool active(int) const { return true; }
    __device__ __forceinline__ void mask(f32x16& p0, f32x16& p1, int t) const {
        const int cb = 64 * t + hi4; const float NEG = -__builtin_inff();
#pragma unroll
        for (int r = 0; r < 16; ++r) { const int cc = cb + (r & 3) + 8 * (r >> 2); if (cc > cmax) p0[r] = NEG; if (cc + 32 > cmax) p1[r] = NEG; }
    }
};
struct CmpImpCfg {
    static constexpr int MODE = 1;
    const bf16_t* Kb; int cmax, hi4; float mfix, invl;
    __device__ __forceinline__ const bf16_t* krow(int t, int kk) const { return Kb + (size_t)(64 * t + kk) * HD; }
    __device__ __forceinline__ const bf16_t* vrow(int, int) const { return Kb; }
    __device__ __forceinline__ bool active(int) const { return true; }
    __device__ __forceinline__ void mask(f32x16& p0, f32x16& p1, int t) const {
        const int cb = 64 * t + hi4; const float NEG = -__builtin_inff();
#pragma unroll
        for (int r = 0; r < 16; ++r) { const int cc = cb + (r & 3) + 8 * (r >> 2); if (cc > cmax) p0[r] = NEG; if (cc + 32 > cmax) p1[r] = NEG; }
    }
};
struct SlcCfg {
    static constexpr int MODE = 0;
    const bf16_t* Kb; const bf16_t* Vb;
    const LAS float* tblh;
    unsigned s0, s1, s2, s3; int tqm, cur; float b31;
    __device__ __forceinline__ const bf16_t* krow(int t, int kk) const { return Kb + (size_t)(64 * t + kk) * PC; }
    __device__ __forceinline__ const bf16_t* vrow(int t, int kk) const { return Vb + (size_t)(64 * t + kk) * PC; }
    __device__ __forceinline__ bool selbit(int t) const { const unsigned q = (unsigned)t >> 5; const unsigned w = (q == 0u ? s0 + 0u : 0u) | (q == 1u ? s1 + 0u : 0u) | (q == 2u ? s2 + 0u : 0u) | (q == 3u ? s3 + 0u : 0u); return (w >> (t & 31)) & 1u; }
    __device__ __forceinline__ bool active(int t) const { return __any(selbit(t)); }
    __device__ __forceinline__ bool rowconst(int t, bool& ok, float& bias) const { ok = selbit(t); bias = b31; return 64 * (cur - t) - 63 >= 1513; }
    __device__ __forceinline__ void mask(f32x16& p0, f32x16& p1, int t) const {
        const bool sel = selbit(t); const int dq = tqm - 64 * t; const float NEG = -__builtin_inff();
        const LAS float* tb = tblh + (TBL0 + dq - 63);
        float bb0[16], bb1[16];
#pragma unroll
        for (int r = 0; r < 16; ++r) { const int cc = (r & 3) + 8 * (r >> 2); bb0[r] = tb[63 - cc]; bb1[r] = tb[31 - cc]; }
#pragma unroll
        for (int r = 0; r < 16; ++r) asm volatile("" : "+v"(bb0[r]), "+v"(bb1[r]));
#pragma unroll
        for (int r = 0; r < 16; ++r) { const int cc = (r & 3) + 8 * (r >> 2); const int d0 = dq - cc, d1 = dq - cc - 32;
            p0[r] = (sel && d0 >= 0) ? p0[r] + bb0[r] : NEG; p1[r] = (sel && d1 >= 0) ? p1[r] + bb1[r] : NEG; }
    }
};
struct WinCfg {
    static constexpr int MODE = 0;
    const bf16_t* Kb; const bf16_t* Vb; const LAS float* tblh; int tqm;
    __device__ __forceinline__ bool rowconst(int, bool&, float&) const { return false; }
    __device__ __forceinline__ const bf16_t* krow(int t, int kk) const { return Kb + (size_t)(64 * t + kk) * PC; }
    __device__ __forceinline__ const bf16_t* vrow(int t, int kk) const { return Vb + (size_t)(64 * t + kk) * PC; }
    __device__ __forceinline__ bool active(int) const { return true; }
    __device__ __forceinline__ void mask(f32x16& p0, f32x16& p1, int t) const {
        const int dq = tqm - 64 * t; const float NEG = -__builtin_inff();
        const LAS float* tb = tblh + (TBL0 + dq - 63);
        float bb0[16], bb1[16];
#pragma unroll
        for (int r = 0; r < 16; ++r) { const int cc = (r & 3) + 8 * (r >> 2); bb0[r] = tb[63 - cc]; bb1[r] = tb[31 - cc]; }
#pragma unroll
        for (int r = 0; r < 16; ++r) asm volatile("" : "+v"(bb0[r]), "+v"(bb1[r]));
#pragma unroll
        for (int r = 0; r < 16; ++r) { const int cc = (r & 3) + 8 * (r >> 2); const unsigned d0 = (unsigned)(dq - cc), d1 = (unsigned)(dq - cc - 32);
            p0[r] = (d0 < 512u) ? p0[r] + bb0[r] : NEG; p1[r] = (d1 < 512u) ? p1[r] + bb1[r] : NEG; }
    }
};
}

__device__ __forceinline__ void load_q_normed(const bf16_t* qp  , const float* gain  , bf16x8 (&qr)[8]) {
    u32x4 raw[8];
#pragma unroll
    for (int d0 = 0; d0 < 8; ++d0) raw[d0] = *(const u32x4*)(qp + d0 * 16);
    float ss = 0.f;
#pragma unroll
    for (int d0 = 0; d0 < 8; ++d0) { const u32x4 w = raw[d0]; const float a0 = bflo(w.x), a1 = bfhi(w.x), a2 = bflo(w.y), a3 = bfhi(w.y), a4 = bflo(w.z), a5 = bfhi(w.z), a6 = bflo(w.w), a7 = bfhi(w.w);
        ss += ((a0 * a0 + a1 * a1) + (a2 * a2 + a3 * a3)) + ((a4 * a4 + a5 * a5) + (a6 * a6 + a7 * a7)); }
    { auto rr = __builtin_amdgcn_permlane32_swap(__float_as_uint(ss), __float_as_uint(ss), false, false); ss = __uint_as_float(rr[0]) + __uint_as_float(rr[1]); }
    const float rs = QSCALE / sqrtf(ss * (1.f / HD) + EPS);
#pragma unroll
    for (int d0 = 0; d0 < 8; ++d0) { const u32x4 w = raw[d0]; const f32x4 g0 = *(const f32x4*)(gain + d0 * 16), g1 = *(const f32x4*)(gain + d0 * 16 + 4);
        u32x4 o; o.x = cvtpk(bflo(w.x) * rs * g0.x, bfhi(w.x) * rs * g0.y); o.y = cvtpk(bflo(w.y) * rs * g0.z, bfhi(w.y) * rs * g0.w);
        o.z = cvtpk(bflo(w.z) * rs * g1.x, bfhi(w.z) * rs * g1.y); o.w = cvtpk(bflo(w.w) * rs * g1.z, bfhi(w.w) * rs * g1.w);
        qr[d0] = *reinterpret_cast<bf16x8*>(&o); }
}

__device__ __forceinline__ void dil_tiles(const att::DilCfg& c, LAS char* lds, const bf16x8 (&qr)[8], f32x16 (&o)[4], float& l_reg, const int wv) {
    using namespace att;
    const int tid = opq_tid(wv), lane = tid & 63, wid = __builtin_amdgcn_readfirstlane(tid >> 6), r32 = lane & 31, hi = lane >> 5;
    LAS char* V_lds = lds + L_V; LAS char* K_lds = lds + L_K;
    const int sr = tid >> 4, sc = (tid & 15) * 8;
    const int vst0 = v_st(sr, sc), vst1 = v_st(32 + sr, sc), kws = KSWZ(sr, sc * 2);
    const int vb0 = (int)(unsigned)(uintptr_t)V_lds + v_rd_base(lane);
    bf16x8 sk0, sk1, sv0, sv1;
    const bf16_t *gk0 = nullptr, *gk1 = nullptr, *gv0 = nullptr, *gv1 = nullptr;
#define DT_LOAD(t) do { gk0 = c.krow((t), sr) + sc; gk1 = c.krow((t), sr + 32) + sc; sk0 = *(const bf16x8*)gk0; sk1 = *(const bf16x8*)gk1; \
        gv0 = c.vrow((t), sr) + sc; gv1 = c.vrow((t), sr + 32) + sc; sv0 = *(const bf16x8*)gv0; sv1 = *(const bf16x8*)gv1; asm volatile("" ::: "memory"); SBAR(); } while (0)
#define DT_WRITE(slot) do { asm volatile("" :: "v"(gk0), "v"(gk1), "v"(gv0), "v"(gv1)); *(LAS bf16x8*)(K_lds + (slot) * SHM_K + kws) = sk0; *(LAS bf16x8*)(K_lds + (slot) * SHM_K + kws + 32 * 256) = sk1; \
        *(LAS bf16x8*)(V_lds + (slot) * SHM_V + vst0) = sv0; *(LAS bf16x8*)(V_lds + (slot) * SHM_V + vst1) = sv1; } while (0)
#define DT_COMP(t, slot) do { f32x16 p0, p1; float mz_ = 0.f, mn_, al_; bf16x8 pa0, pa1, pa2, pa3; \
        qkt(p0, p1, K_lds + (slot) * SHM_K, r32, hi, qr); c.mask(p0, p1, (t)); partialSM(p0, p1, mz_, mn_, al_); \
        finishSM(p0, p1, 1.f, l_reg, pa0, pa1, pa2, pa3); SBAR(); pv_tile(o, vb0 + (slot) * SHM_V, pa0, pa1, pa2, pa3); } while (0)
    const bool first = (c.u == 0);
    __builtin_amdgcn_s_waitcnt(0x0F70);
    __syncthreads();
    if (!first) { DT_LOAD(1); DT_WRITE(0); }
    DT_LOAD(4); DT_WRITE(1);
    __syncthreads();
    DT_LOAD(2);
    if (wid < 4) { if (!first) DT_COMP(1, 0); } else DT_COMP(4, 1);
    DT_WRITE(2);
    __syncthreads();
    DT_LOAD(3);
    if (wid < 6) DT_COMP(2, 2);
    DT_WRITE(0);
    __syncthreads();
    DT_LOAD(5);
    if (wid >= 2) DT_COMP(3, 0);
    DT_WRITE(1);
    if (!first) { DT_LOAD(0); DT_WRITE(2); }
    __syncthreads();
    if (wid < 2) { if (!first) DT_COMP(0, 2); } else if (wid >= 6) DT_COMP(5, 1);
#undef DT_LOAD
#undef DT_WRITE
#undef DT_COMP
}

__device__ __forceinline__ void dil_unit(LAS char* lds, const bf16_t* P, bf16_t* OA, float* LSE, const float* dilT, const float* qgain, int pat, int dshift, int unit, const int wv) {
    using namespace att;
    const int tid = opq_tid(wv), lane = tid & 63, wid = __builtin_amdgcn_readfirstlane(tid >> 6), r32 = lane & 31, hi = lane >> 5;
    const int bh = unit >> 5, ru = unit & 31, b = bh >> 3, h = bh & 7;
    const int ncs = 5 - dshift, res = ru >> ncs, u = ru & ((1 << ncs) - 1);
    LAS float* tbl = (LAS float*)(lds + L_TBL);
    __syncthreads();
    if (tid < DTS) tbl[tid] = dilT[(pat * 8 + h) * DTS + tid];
    const int s0 = 256 * u + 32 * wid, s_row = s0 + r32;
    const size_t tokrow = (size_t)b * SEQ + (size_t)((s_row << dshift) + res);
    bf16x8 qr[8];
    load_q_normed(P + tokrow * PC + C_QA + h * HD + hi * 8, qgain + hi * 8, qr);
    f32x16 o[4]; float m_reg, l_reg;
    m_reg = 0.f;
    if (pat == 0) { l_reg = 0.f;
#pragma unroll
        for (int d0 = 0; d0 < 4; ++d0) o[d0] = f32x16{}; }
    else { l_reg = LSE[tokrow * 8 + h];
#pragma unroll
        for (int r = 0; r < 16; ++r) { const size_t tr = (size_t)b * SEQ + (size_t)(((s0 + crow(r, hi)) << dshift) + res); const bf16_t* op = OA + tr * 1024 + h * HD + r32;
#pragma unroll
            for (int d0 = 0; d0 < 4; ++d0) o[d0][r] = bf2f(op[d0 * 32]); } }
    DilCfg c; c.Kb = P + (size_t)b * SEQ * PC + C_KA + h * HD; c.Vb = P + (size_t)b * SEQ * PC + C_VA + h * HD; c.tbl = tbl; c.dshift = dshift; c.res = res; c.u = u; c.dqm = s_row - 4 * hi; c.s0 = s0;
    dil_tiles(c, lds, qr, o, l_reg, wv);
    LAS float* li_l = (LAS float*)(lds + L_WS) + wid * 64;
    if (hi == 0) { li_l[r32] = l_reg; LSE[tokrow * 8 + h] = l_reg; }
    LDS_WAIT();
#pragma unroll
    for (int r = 0; r < 16; ++r) { const int orow = crow(r, hi); const float rl = (pat == 2) ? 1.0f / li_l[orow] : 1.0f;
        const size_t tr = (size_t)b * SEQ + (size_t)(((s0 + orow) << dshift) + res); bf16_t* op = OA + tr * 1024 + h * HD;
#pragma unroll
        for (int d0 = 0; d0 < 4; ++d0) { const float v = o[d0][r] * rl; const float vn = shx(v, 1, lane);
            if ((r32 & 1) == 0) *(unsigned*)(op + d0 * 32 + r32) = cvtpk(v, vn); } }
}

__device__ __forceinline__ void nsa_finalize(LAS char* lds, const f32x16 (&o)[4], float l_reg, const bf16_t* P, bf16_t* ON, const float* gb, int b, int g, int tok0, int br, const int wv) {
    using namespace att;
    const int tid = opq_tid(wv), lane = tid & 63, wid = __builtin_amdgcn_readfirstlane(tid >> 6), r32 = lane & 31, hi = lane >> 5;
    LAS float* li_l = (LAS float*)(lds + L_WS) + wid * 64;
    if (hi == 0) li_l[r32] = l_reg;
    LDS_WAIT();
    bf16_t* ONb = ON + (size_t)br * NTOK * 1024;
    float glv[16], gbv[4];
#pragma unroll
    for (int j = 0; j < 4; ++j) gbv[j] = gb[(4 * g + j) * 3 + br];
#pragma unroll
    for (int r = 0; r < 16; ++r) { const int j = r & 3, k = r >> 2; const size_t tok = (size_t)b * SEQ + tok0 + 2 * k + hi; glv[r] = bf2f(P[tok * PC + C_GL + (4 * g + j) * 3 + br]); }
#pragma unroll
    for (int r = 0; r < 16; ++r) asm volatile("" : "+v"(glv[r]));
#pragma unroll
    for (int r = 0; r < 16; ++r) { const int j = r & 3, k = r >> 2; const float lr = li_l[crow(r, hi)]; const float rl = lr > 0.f ? 1.0f / lr : 0.f;
        const size_t tok = (size_t)b * SEQ + tok0 + 2 * k + hi; const int hh = 4 * g + j;
        const float gl = glv[r] + gbv[j];
        const float sc = rl * __builtin_amdgcn_rcpf(1.0f + __builtin_amdgcn_exp2f(-gl * LOG2E));
        bf16_t* op = ONb + tok * 1024 + hh * HD;
#pragma unroll
        for (int d0 = 0; d0 < 4; ++d0) { const float v = o[d0][r] * sc; const float vn = shx(v, 1, lane);
            if ((r32 & 1) == 0) *(unsigned*)(op + d0 * 32 + r32) = cvtpk(v, vn); } }
}
__device__ __forceinline__ void nsa_unit(LAS char* lds, const bf16_t* P, const bf16_t* KC, const bf16_t* VC, bf16_t* ON, const float* nsaT, const float* gb, const float* qgain, int b, int g, int qi, bool load_tbl, const int wv) {
    using namespace att;
    const int tid = opq_tid(wv), lane = tid & 63, wid = __builtin_amdgcn_readfirstlane(tid >> 6), r32 = lane & 31, hi = lane >> 5;
    LAS float* tbl = (LAS float*)(lds + L_TBL); LAS float* IMP = (LAS float*)(lds + L_IMP); LAS unsigned* SELM = (LAS unsigned*)(lds + L_SELM);
    __syncthreads();
    if (load_tbl) for (int i = tid; i < 4 * TBLS; i += NTHR) tbl[i] = nsaT[(size_t)(4 * g) * TBLS + i];
    const int tok0 = 64 * qi + 8 * wid, tq = tok0 + (r32 >> 2), hd = r32 & 3;
    const bf16_t* Pb = P + (size_t)b * SEQ * PC;
    bf16x8 qr[8];
    load_q_normed(Pb + (size_t)tq * PC + C_QN + (4 * g + hd) * HD + hi * 8, qgain + hi * 8, qr);
    const bf16_t* KCb = KC + (size_t)(b * 2 + g) * 512 * HD; const bf16_t* VCb = VC + (size_t)(b * 2 + g) * 512 * HD;
    const int ntc = (qi >> 4) + 1, cmax = (tq - 31) >> 4;
    f32x16 o[4]; float m_reg, l_reg;
#pragma unroll
    for (int d0 = 0; d0 < 4; ++d0) o[d0] = f32x16{};
    m_reg = 0.f; l_reg = 0.f;
    { CmpCfg c; c.Kb = KCb; c.Vb = VCb; c.cmax = cmax; c.hi4 = 4 * hi; c.cfull = (64 * qi - 31) >> 4; attn_tiles_s(c, lds, qr, o, m_reg, l_reg, 0, ntc, wv); }
    nsa_finalize(lds, o, l_reg, P, ON, gb, b, g, tok0, 0, wv);
    { CmpImpCfg c; c.Kb = KCb; c.cmax = cmax; c.hi4 = 4 * hi; c.mfix = 0.f; c.invl = l_reg > 0.f ? 1.0f / l_reg : 0.f;
#pragma unroll
      for (int d0 = 0; d0 < 4; ++d0) o[d0] = f32x16{};
      float md = 0.f, ld = 0.f; attn_tiles(c, lds, qr, o, md, ld, 0, ntc, wv); }
#pragma unroll
    for (int d0 = 0; d0 < 4; ++d0)
#pragma unroll
        for (int k = 0; k < 4; ++k) IMP[(8 * wid + 2 * k + hi) * 128 + 32 * d0 + r32] = (o[d0][4 * k] + o[d0][4 * k + 1]) + (o[d0][4 * k + 2] + o[d0][4 * k + 3]);
    __syncthreads();
    { const int cur = qi;
#pragma unroll 1
      for (int tl = 8 * wid; tl < 8 * wid + 8; ++tl) {
        const int n0 = lane, n1 = 64 + lane; bool sel0, sel1;
        if (cur <= 15) { sel0 = (n0 <= cur); sel1 = false; }
        else {
            const float v0 = IMP[tl * 128 + n0], v1 = IMP[tl * 128 + n1];
            const unsigned u0 = (n0 >= 1 && n0 <= cur - 2) ? __float_as_uint(v0) + 1u : 0u, u1 = (n1 <= cur - 2) ? __float_as_uint(v1) + 1u : 0u;
            unsigned T = 0u;
#pragma unroll 1
            for (int bit = 30; bit >= 0; --bit) { const unsigned cand = T | (1u << bit);
                const int cnt = __builtin_popcountll(__ballot(u0 >= cand)) + __builtin_popcountll(__ballot(u1 >= cand));
                if (cnt >= 13) T = cand; }
            const bool gt0 = u0 > T, gt1 = u1 > T;
            const int need = 13 - (__builtin_popcountll(__ballot(gt0)) + __builtin_popcountll(__ballot(gt1)));
            const bool eq0 = (u0 == T), eq1 = (u1 == T);
            const unsigned long long m0 = __ballot(eq0), m1 = __ballot(eq1);
            const int pre0 = (int)__builtin_amdgcn_mbcnt_hi((unsigned)(m0 >> 32), __builtin_amdgcn_mbcnt_lo((unsigned)m0, 0u));
            const int pre1 = __builtin_popcountll(m0) + (int)__builtin_amdgcn_mbcnt_hi((unsigned)(m1 >> 32), __builtin_amdgcn_mbcnt_lo((unsigned)m1, 0u));
            sel0 = (n0 == 0 || n0 == cur || n0 == cur - 1) || gt0 || (eq0 && pre0 < need);
            sel1 = (n1 == cur || n1 == cur - 1) || gt1 || (eq1 && pre1 < need);
        }
        const unsigned long long b0 = __ballot(sel0), b1 = __ballot(sel1);
        if (lane == 0) { SELM[tl * 4 + 0] = (unsigned)b0; SELM[tl * 4 + 1] = (unsigned)(b0 >> 32); SELM[tl * 4 + 2] = (unsigned)b1; SELM[tl * 4 + 3] = (unsigned)(b1 >> 32); } } }
    __syncthreads();
    int r32s = r32; asm volatile("" : "+v"(r32s));
    { SlcCfg c; c.Kb = Pb + C_KS + g * HD; c.Vb = Pb + C_VS + g * HD; c.tblh = tbl + (r32s & 3) * TBLS; c.tqm = tok0 + (r32s >> 2) - 4 * hi; c.cur = qi; c.b31 = tbl[(r32s & 3) * TBLS + TBL0 + 1600];
      const int tl = 8 * wid + (r32s >> 2); c.s0 = SELM[tl * 4 + 0]; c.s1 = SELM[tl * 4 + 1]; c.s2 = SELM[tl * 4 + 2]; c.s3 = SELM[tl * 4 + 3];
#pragma unroll
      for (int d0 = 0; d0 < 4; ++d0) o[d0] = f32x16{};
      m_reg = 0.f; l_reg = 0.f;
      attn_tiles_s(c, lds, qr, o, m_reg, l_reg, 0, qi + 1, wv); }
    nsa_finalize(lds, o, l_reg, P, ON, gb, b, g, tok0, 1, wv);
    int r32w = r32; asm volatile("" : "+v"(r32w));
    { WinCfg c; c.Kb = Pb + C_KW + g * HD; c.Vb = Pb + C_VW + g * HD; c.tblh = tbl + (r32w & 3) * TBLS; c.tqm = tok0 + (r32w >> 2) - 4 * hi;
#pragma unroll
      for (int d0 = 0; d0 < 4; ++d0) o[d0] = f32x16{};
      m_reg = 0.f; l_reg = 0.f;
      attn_tiles_s(c, lds, qr, o, m_reg, l_reg, qi >= 8 ? qi - 8 : 0, qi + 1, wv); }
    nsa_finalize(lds, o, l_reg, P, ON, gb, b, g, tok0, 2, wv);
}

constexpr int LDS_BYTES = 147456;
constexpr int LDS_MISC = 131072;
constexpr int LDS_ARGS = LDS_MISC + 64;
__device__ __forceinline__ unsigned long long arg_u64(LAS unsigned char* lds, int i) {
    const LAS unsigned* p = (const LAS unsigned*)(opq_lds(lds) + LDS_ARGS) + 2 * i;
    const unsigned lo = __builtin_amdgcn_readfirstlane(p[0]), hi = __builtin_amdgcn_readfirstlane(p[1]);
    return ((unsigned long long)hi << 32) | lo;
}
#define GAS __attribute__((address_space(1)))
__device__ __forceinline__ const float* arg_in(LAS unsigned char* lds, int i) { return (const float*)(GAS const float*)arg_u64(lds, i); }
__device__ __forceinline__ float* arg_out(LAS unsigned char* lds) { return (float*)(GAS float*)arg_u64(lds, 24); }
__device__ __forceinline__ unsigned char* arg_ws(LAS unsigned char* lds) { return (unsigned char*)(GAS unsigned char*)arg_u64(lds, 25); }
__device__ __forceinline__ int opq_bx() { int b = blockIdx.x; asm volatile("" : "+s"(b)); return b; }
__device__ __forceinline__ int opq_g() { int b = gridDim.x; asm volatile("" : "+s"(b)); return b; }

__device__ __forceinline__ void ph_prologue(LAS unsigned char* lds, const int wv) {
    lds = opq_lds(lds);
    const int tid = opq_tid(wv), lane = tid & 63, wave = __builtin_amdgcn_readfirstlane(tid >> 6), G = opq_g(), bx = opq_bx();
    const int gw = bx * NWAVES + wave, NGW = G * NWAVES;
    unsigned char* ws = arg_ws(lds);
    LAS float* scr = (LAS float*)(lds + wave * 16384);
    constexpr int I_UP = 32 * 176, I_DN = 88 * 64, I_IN = 32 * 177, I_OUT = 32 * 64, I_C1 = 64 * 16, I_Z = 928;
    constexpr int I_FFN = 2 * I_UP + I_DN, I_LAYER = 2 * I_FFN + I_IN + I_OUT + 2 * I_C1 + I_Z;
#pragma unroll 1
    for (int it = gw; it < DEPTH * I_LAYER; it += NGW) {
        const int l = it / I_LAYER; int r = it - l * I_LAYER;
        if (r < 2 * I_FFN) { const int half = r >= I_FFN; r -= half * I_FFN;
            bf16_t* WUP = (bf16_t*)(ws + WS_WUP + (size_t)(l * 2 + half) * SZ_WUP); bf16_t* WDN = (bf16_t*)(ws + WS_WDN + (size_t)(l * 2 + half) * SZ_WDN);
            const float* gn = arg_in(lds, half ? I_F2N : I_F1N) + (size_t)l * DM;
            if (r < I_UP) { transpose_item(arg_in(lds, half ? I_F2W1 : I_F1W1) + (size_t)l * DM * DFF, DM, DFF, WUP, 1, 0, scr, r, lane, gn); continue; } r -= I_UP;
            if (r < I_UP) { transpose_item(arg_in(lds, half ? I_F2W3 : I_F1W3) + (size_t)l * DM * DFF, DM, DFF, WUP, 1, 128, scr, r, lane, gn); continue; } r -= I_UP;
            transpose_item(arg_in(lds, half ? I_F2W2 : I_F1W2) + (size_t)l * DFF * DM, DFF, DM, WDN, 0, 0, scr, r, lane, nullptr); continue; }
        r -= 2 * I_FFN;
        bf16_t* WIN = (bf16_t*)(ws + WS_WIN + (size_t)l * SZ_WIN); bf16_t* WOUT = (bf16_t*)(ws + WS_WOUT + (size_t)l * SZ_WOUT); bf16_t* WC1 = (bf16_t*)(ws + WS_WC1 + (size_t)l * SZ_WC1);
        if (r < I_IN) { transpose_item(arg_in(lds, I_WIN) + (size_t)l * DM * IN_COLS, DM, IN_COLS, WIN, 0, 0, scr, r, lane, arg_in(lds, I_MIXN) + (size_t)l * DM); continue; } r -= I_IN;
        if (r < I_OUT) { transpose_item(arg_in(lds, I_WOUT) + (size_t)l * DM * DM, DM, DM, WOUT, 0, 0, scr, r, lane, nullptr); continue; } r -= I_OUT;
        if (r < I_C1) { transpose_item(arg_in(lds, I_CKW1) + (size_t)l * 4096 * 512, 4096, 512, WC1, 0, 0, scr, r, lane, nullptr); continue; } r -= I_C1;
        if (r < I_C1) { transpose_item(arg_in(lds, I_CVW1) + (size_t)l * 4096 * 512, 4096, 512, WC1, 0, 512, scr, r, lane, nullptr); continue; } r -= I_C1;
        { const int q = r * 64 + lane, kt = q / 1856, rem = q - kt * 1856; u32x4* z = (u32x4*)(WIN + ((size_t)(22 * 32 + kt) * 256 + 24) * 64) + rem; unsigned zr = 0u; asm volatile("" : "+v"(zr)); *z = (u32x4){zr, zr, zr, zr}; }
    }
    const float* xs = arg_in(lds, I_X); bf16_t* XB = (bf16_t*)(ws + WS_HB); float* SSQ = (float*)(ws + WS_SSQ);
    for (int m = gw; m < NTOK; m += NGW) {
        const f32x4* xr = (const f32x4*)(xs + (size_t)m * DM) + lane; f32x4 v[8]; float s = 0.f;
#pragma unroll
        for (int j = 0; j < 8; ++j) { v[j] = xr[64 * j]; s += (v[j].x * v[j].x + v[j].y * v[j].y) + (v[j].z * v[j].z + v[j].w * v[j].w); }
        s = wave_sum(s, lane);
#pragma unroll
        for (int j = 0; j < 8; ++j) { u32x2 w; w.x = cvtpk(v[j].x, v[j].y); w.y = cvtpk(v[j].z, v[j].w); *(u32x2*)(XB + kt_off(m, 256 * j + 4 * lane, DM)) = w; }
        if (lane < 32) SSQ[(size_t)m * 32 + lane] = (lane == 0) ? s : 0.f;
    }
}
__device__ __forceinline__ void ph_headnorm(LAS unsigned char* lds, int l, const int wv) {
    lds = opq_lds(lds);
    const int tid = opq_tid(wv), lane = tid & 63, wave = __builtin_amdgcn_readfirstlane(tid >> 6), G = opq_g(), bx = opq_bx();
    const int gw = bx * NWAVES + wave, NGW = G * NWAVES;
    unsigned char* ws = arg_ws(lds); bf16_t* HP = (bf16_t*)(ws + WS_HP); bf16_t* ACMP = (bf16_t*)(ws + WS_ACMP);
    const float* qna = arg_in(lds, I_QNA) + l * HD; const float* kna = arg_in(lds, I_KNA) + l * HD; const float* qnn = arg_in(lds, I_QNN) + l * HD; const float* knn = arg_in(lds, I_KNN) + l * HD;
    const float* pos = arg_in(lds, I_POS) + (size_t)l * 32 * HD;
    const int e0 = (lane & 15) * 8;
    const f32x4 ga0 = *(const f32x4*)(kna + e0), ga1 = *(const f32x4*)(kna + e0 + 4), gn0 = *(const f32x4*)(knn + e0), gn1 = *(const f32x4*)(knn + e0 + 4);
    const int col0 = C_KA + lane * 8, col1 = C_KA + 512 + lane * 8, col2 = (lane < 32) ? C_KS + lane * 8 : C_KW + (lane - 32) * 8;
    for (int m0 = gw; m0 < NTOK; m0 += 4 * NGW) {
        const int jt = m0 & 15;
        const f32x4 pa0 = *(const f32x4*)(pos + jt * HD + e0), pa1 = *(const f32x4*)(pos + jt * HD + e0 + 4), pb0 = *(const f32x4*)(pos + (jt + 16) * HD + e0), pb1 = *(const f32x4*)(pos + (jt + 16) * HD + e0 + 4);
        u32x4 wl[4][3], wcv[4];
#pragma unroll
        for (int q = 0; q < 4; ++q) { const int mq = m0 + q * NGW; const bf16_t* prow = HP + (size_t)(mq < NTOK ? mq : NTOK - 1) * PC;
            wl[q][0] = *(const u32x4*)(prow + col0); wl[q][1] = *(const u32x4*)(prow + col1); wl[q][2] = *(const u32x4*)(prow + col2);
            wcv[q] = *(const u32x4*)(prow + C_KC + lane * 8); }
#pragma unroll
        for (int q = 0; q < 4; ++q) asm volatile("" : "+v"(wl[q][0]), "+v"(wl[q][1]), "+v"(wl[q][2]), "+v"(wcv[q]));
#pragma unroll
        for (int q = 0; q < 4; ++q) { const int m = m0 + q * NGW; if (m >= NTOK) break;
            bf16_t* prow = HP + (size_t)m * PC;
#pragma unroll
            for (int ch = 0; ch < 3; ++ch) {
                const u32x4 w = wl[q][ch];
                float v[8] = {bflo(w.x), bfhi(w.x), bflo(w.y), bfhi(w.y), bflo(w.z), bfhi(w.z), bflo(w.w), bfhi(w.w)};
                float s = 0.f;
#pragma unroll
                for (int i = 0; i < 8; ++i) s += v[i] * v[i];
                s += shx(s, 1, lane); s += shx(s, 2, lane); s += shx(s, 4, lane); s += shx(s, 8, lane);
                const float rs = 1.f / sqrtf(s * (1.f / HD) + EPS);
                const f32x4 g0 = (ch < 2) ? ga0 : gn0, g1 = (ch < 2) ? ga1 : gn1;
                u32x4 o; o.x = cvtpk(v[0] * rs * g0.x, v[1] * rs * g0.y); o.y = cvtpk(v[2] * rs * g0.z, v[3] * rs * g0.w); o.z = cvtpk(v[4] * rs * g1.x, v[5] * rs * g1.y); o.w = cvtpk(v[6] * rs * g1.z, v[7] * rs * g1.w);
                *(u32x4*)(prow + (ch == 0 ? col0 : ch == 1 ? col1 : col2)) = o;
            }
            { const int b = m / SEQ, t = m % SEQ, kv = lane >> 5, gg = (lane >> 4) & 1, c1 = t >> 4, j1 = t & 15;
              const u32x4 w = wcv[q];
              const float v[8] = {bflo(w.x), bfhi(w.x), bflo(w.y), bfhi(w.y), bflo(w.z), bfhi(w.z), bflo(w.w), bfhi(w.w)};
              const int arow0 = kv * 4096 + (b * 2 + gg) * 512;
              if (c1 <= 510) { const f32x4 p0 = pa0, p1 = pa1;
                  u32x4 o; o.x = cvtpk(v[0] + p0.x, v[1] + p0.y); o.y = cvtpk(v[2] + p0.z, v[3] + p0.w); o.z = cvtpk(v[4] + p1.x, v[5] + p1.y); o.w = cvtpk(v[6] + p1.z, v[7] + p1.w);
                  *(u32x4*)(ACMP + kt_off(arow0 + c1, j1 * HD + e0, 4096)) = o; }
              else { const u32x4 z = {0u, 0u, 0u, 0u}; *(u32x4*)(ACMP + kt_off(arow0 + 511, j1 * HD + e0, 4096)) = z; *(u32x4*)(ACMP + kt_off(arow0 + 511, (j1 + 16) * HD + e0, 4096)) = z; }
              if (c1 >= 1) { const int j2 = j1 + 16; const f32x4 p0 = pb0, p1 = pb1;
                  u32x4 o; o.x = cvtpk(v[0] + p0.x, v[1] + p0.y); o.y = cvtpk(v[2] + p0.z, v[3] + p0.w); o.z = cvtpk(v[4] + p1.x, v[5] + p1.y); o.w = cvtpk(v[6] + p1.z, v[7] + p1.w);
                  *(u32x4*)(ACMP + kt_off(arow0 + c1 - 1, j2 * HD + e0, 4096)) = o; } }
        }
    }
}
__device__ __forceinline__ float gelu_tanh(float v) { const float u3 = 0.7978845608028654f * (v + 0.044715f * v * v * v); return 0.5f * v * (2.0f - 2.0f / (__expf(2.0f * u3) + 1.0f)); }
__device__ __forceinline__ void ph_cmp2(LAS unsigned char* lds, int l, const int wv) {
    lds = opq_lds(lds);
    const int tid = opq_tid(wv), lane = tid & 63, wave = __builtin_amdgcn_readfirstlane(tid >> 6), G = opq_g(), bx = opq_bx();
    unsigned char* ws = arg_ws(lds); const float* CP = (const float*)(ws + WS_CP);
    LAS float* CH = (LAS float*)lds;
    LAS float* RED = (LAS float*)(lds + 65536);
    const float* knn = arg_in(lds, I_KNN) + l * HD;
    for (int it = bx; it < 256; it += G) {
        const int R0 = it * 32, kv = R0 >> 12, rl0 = R0 & 4095;
        __syncthreads();
        for (int i4 = tid; i4 < 32 * 128; i4 += NTHR) { const int rr = i4 >> 7, k4 = (i4 & 127) * 4; f32x4 v = {0.f, 0.f, 0.f, 0.f};
#pragma unroll
            for (int ks = 0; ks < 4; ++ks) v = v + *(const f32x4*)(CP + ((size_t)(kv * 4 + ks) * 4096 + rl0 + rr) * 512 + k4);
            f32x4 o; o.x = gelu_tanh(v.x); o.y = gelu_tanh(v.y); o.z = gelu_tanh(v.z); o.w = gelu_tanh(v.w);
            *(LAS f32x4*)(CH + rr * 512 + k4) = o; }
        __syncthreads();
        const int n = tid & 127, rq = tid >> 7;
        const float* w2 = arg_in(lds, kv ? I_CVW2 : I_CKW2) + (size_t)l * 512 * HD + n;
        float acc[8];
#pragma unroll
        for (int i = 0; i < 8; ++i) acc[i] = 0.f;
#pragma unroll 4
        for (int k = 0; k < 512; k += 4) { const float w0 = w2[(size_t)k * HD], w1 = w2[(size_t)(k + 1) * HD], w2v = w2[(size_t)(k + 2) * HD], w3 = w2[(size_t)(k + 3) * HD];
#pragma unroll
            for (int i = 0; i < 8; ++i) { const f32x4 c = *(const LAS f32x4*)(CH + (rq * 8 + i) * 512 + k); acc[i] += (c.x * w0 + c.y * w1) + (c.z * w2v + c.w * w3); } }
        if (kv == 0) {
            float ss[8];
#pragma unroll
            for (int i = 0; i < 8; ++i) ss[i] = wave_sum(acc[i] * acc[i], lane);
            if (lane == 0) {
#pragma unroll
                for (int i = 0; i < 8; ++i) RED[wave * 8 + i] = ss[i]; }
            __syncthreads();
            const float gn = knn[n];
#pragma unroll
            for (int i = 0; i < 8; ++i) { const float tot = RED[(2 * rq) * 8 + i] + RED[(2 * rq + 1) * 8 + i]; acc[i] = acc[i] / sqrtf(tot * (1.f / HD) + EPS) * gn; }
        }
        bf16_t* dst = (bf16_t*)(ws + (kv ? WS_VC + 0 : WS_KC + 0)) + (size_t)(rl0 + rq * 8) * HD + n;
#pragma unroll
        for (int i = 0; i < 8; ++i) dst[(size_t)i * HD] = (bf16_t)f2bf(acc[i]);
    }
}
__device__ __forceinline__ void ph_outnorm(LAS unsigned char* lds, int l, const int wv) {
    lds = opq_lds(lds);
    const int tid = opq_tid(wv), lane = tid & 63, wave = __builtin_amdgcn_readfirstlane(tid >> 6), G = opq_g(), bx = opq_bx();
    const int gw = bx * NWAVES + wave, NGW = G * NWAVES;
    unsigned char* ws = arg_ws(lds); const bf16_t* OA = (const bf16_t*)(ws + WS_OA); const bf16_t* ON = (const bf16_t*)(ws + WS_ON); bf16_t* HB = (bf16_t*)(ws + WS_HP);
    const float* gn = arg_in(lds, I_ON) + (size_t)l * DM;
    const f32x4 ga0 = *(const f32x4*)(gn + lane * 8), ga1 = *(const f32x4*)(gn + lane * 8 + 4), ga2 = *(const f32x4*)(gn + 512 + lane * 8), ga3 = *(const f32x4*)(gn + 512 + lane * 8 + 4);
    const f32x4 gb0 = *(const f32x4*)(gn + 1024 + lane * 8), gb1 = *(const f32x4*)(gn + 1024 + lane * 8 + 4), gb2 = *(const f32x4*)(gn + 1536 + lane * 8), gb3 = *(const f32x4*)(gn + 1536 + lane * 8 + 4);
    bf16_t* y = HB;
    for (int m0 = gw; m0 < NTOK; m0 += 2 * NGW) {
        u32x4 wab[2][2], wn[2][6];
#pragma unroll
        for (int q = 0; q < 2; ++q) { const int mq = m0 + q * NGW; const size_t mc = (size_t)(mq < NTOK ? mq : NTOK - 1);
            const bf16_t* oa = OA + mc * 1024; wab[q][0] = *(const u32x4*)(oa + lane * 8); wab[q][1] = *(const u32x4*)(oa + 512 + lane * 8);
#pragma unroll
            for (int br = 0; br < 3; ++br) { const bf16_t* onb = ON + ((size_t)br * NTOK + mc) * 1024; wn[q][2 * br] = *(const u32x4*)(onb + lane * 8); wn[q][2 * br + 1] = *(const u32x4*)(onb + 512 + lane * 8); } }
#pragma unroll
        for (int q = 0; q < 2; ++q) asm volatile("" : "+v"(wab[q][0]), "+v"(wab[q][1]), "+v"(wn[q][0]), "+v"(wn[q][1]), "+v"(wn[q][2]), "+v"(wn[q][3]), "+v"(wn[q][4]), "+v"(wn[q][5]));
#pragma unroll
        for (int q = 0; q < 2; ++q) { const int m = m0 + q * NGW; if (m >= NTOK) break;
        const u32x4 wa = wab[q][0], wb = wab[q][1];
        float va[16] = {bflo(wa.x), bfhi(wa.x), bflo(wa.y), bfhi(wa.y), bflo(wa.z), bfhi(wa.z), bflo(wa.w), bfhi(wa.w), bflo(wb.x), bfhi(wb.x), bflo(wb.y), bfhi(wb.y), bflo(wb.z), bfhi(wb.z), bflo(wb.w), bfhi(wb.w)};
        float sa = 0.f;
#pragma unroll
        for (int i = 0; i < 16; ++i) sa += va[i] * va[i];
        float vs[16]; float sn = 0.f;
#pragma unroll
        for (int i = 0; i < 16; ++i) vs[i] = 0.f;
#pragma unroll
        for (int br = 0; br < 3; ++br) { const u32x4 wc = wn[q][2 * br], wd = wn[q][2 * br + 1];
            vs[0] += bflo(wc.x); vs[1] += bfhi(wc.x); vs[2] += bflo(wc.y); vs[3] += bfhi(wc.y); vs[4] += bflo(wc.z); vs[5] += bfhi(wc.z); vs[6] += bflo(wc.w); vs[7] += bfhi(wc.w);
            vs[8] += bflo(wd.x); vs[9] += bfhi(wd.x); vs[10] += bflo(wd.y); vs[11] += bfhi(wd.y); vs[12] += bflo(wd.z); vs[13] += bfhi(wd.z); vs[14] += bflo(wd.w); vs[15] += bfhi(wd.w); }
        const float ra = 1.0f / sqrtf(wave_sum(sa, lane) * (1.f / 1024.f) + EPS);
        { const f32x4 g0 = ga0, g1 = ga1, g2 = ga2, g3 = ga3;
          u32x4 o; o.x = cvtpk(va[0] * ra * g0.x, va[1] * ra * g0.y); o.y = cvtpk(va[2] * ra * g0.z, va[3] * ra * g0.w); o.z = cvtpk(va[4] * ra * g1.x, va[5] * ra * g1.y); o.w = cvtpk(va[6] * ra * g1.z, va[7] * ra * g1.w);
          *(u32x4*)(y + kt_off(m, lane * 8, DM)) = o;
          o.x = cvtpk(va[8] * ra * g2.x, va[9] * ra * g2.y); o.y = cvtpk(va[10] * ra * g2.z, va[11] * ra * g2.w); o.z = cvtpk(va[12] * ra * g3.x, va[13] * ra * g3.y); o.w = cvtpk(va[14] * ra * g3.z, va[15] * ra * g3.w);
          *(u32x4*)(y + kt_off(m, 512 + lane * 8, DM)) = o; }
#pragma unroll
        for (int i = 0; i < 16; ++i) sn += vs[i] * vs[i];
        const float rn = 1.0f / sqrtf(wave_sum(sn, lane) * (1.f / 1024.f) + EPS);
        { const f32x4 g0 = gb0, g1 = gb1, g2a = gb2, g3 = gb3;
          u32x4 o; o.x = cvtpk(vs[0] * rn * g0.x, vs[1] * rn * g0.y); o.y = cvtpk(vs[2] * rn * g0.z, vs[3] * rn * g0.w); o.z = cvtpk(vs[4] * rn * g1.x, vs[5] * rn * g1.y); o.w = cvtpk(vs[6] * rn * g1.z, vs[7] * rn * g1.w);
          *(u32x4*)(y + kt_off(m, 1024 + lane * 8, DM)) = o;
          o.x = cvtpk(vs[8] * rn * g2a.x, vs[9] * rn * g2a.y); o.y = cvtpk(vs[10] * rn * g2a.z, vs[11] * rn * g2a.w); o.z = cvtpk(vs[12] * rn * g3.x, vs[13] * rn * g3.y); o.w = cvtpk(vs[14] * rn * g3.z, vs[15] * rn * g3.w);
          *(u32x4*)(y + kt_off(m, 1536 + lane * 8, DM)) = o; }
        }
    }
}

#define GRID_BAR() do { XcdBarrier bar_; bar_.bar = (unsigned*)(arg_ws(lds) + WS_CTL) + CW_BAR; bar_.x = xb_xcc_id(); bar_.st = (volatile LAS unsigned*)(opq_lds(lds) + LDS_MISC + 32); xcd_barrier(bar_, wv); } while (0)
__global__ void __launch_bounds__(NTHR, 2) mega_fwd(Args a) {
    extern __shared__ __attribute__((aligned(16))) unsigned char lds_raw[];
    LAS unsigned char* lds = (LAS unsigned char*)lds_raw;
    const int wv = __builtin_amdgcn_readfirstlane((int)threadIdx.x >> 6);
    {
        const int tid = threadIdx.x;
        for (int u = tid; u < (LDS_BYTES - LDS_MISC) / 4; u += NTHR) ((LAS unsigned*)(lds + LDS_MISC))[u] = 0u;
        __syncthreads();
        if (tid == 0) { LAS unsigned long long* t = (LAS unsigned long long*)(lds + LDS_ARGS);
#pragma unroll
            for (int i = 0; i < 24; ++i) t[i] = (unsigned long long)(uintptr_t)a.in[i];
            t[24] = (unsigned long long)(uintptr_t)a.out; t[25] = (unsigned long long)(uintptr_t)a.ws; }
        __syncthreads();
    }
    (void)xcd_barrier_post((unsigned*)(arg_ws(lds) + WS_CTL) + CW_BAR, (volatile LAS unsigned*)(lds + LDS_MISC + 32));

    { const int tid = opq_tid(wv), G = opq_g(), bx = opq_bx(); const float* rb = arg_in(lds, I_RB); unsigned char* ws = arg_ws(lds);
      float* dilT = (float*)(ws + WS_TBL); float* nsaT = (float*)(ws + WS_TBL + 65536);
      for (int i = bx * NTHR + tid; i < 3 * 8 * DTS + 8 * TBLS; i += G * NTHR) {
          if (i < 3 * 8 * DTS) { const int p = i / (8 * DTS), h = (i / DTS) % 8, df = i % DTS - DT0; const int d = (p == 0) ? 1 : (p == 1 ? 4 : 16);
              dilT[i] = (df >= 0 && df <= 128) ? rb[rel_bucket_dev(df * d) * 16 + h] : 0.f; }
          else { const int j = i - 3 * 8 * DTS, hh = j / TBLS, ds = j % TBLS - TBL0; nsaT[j] = (ds >= 0) ? rb[rel_bucket_dev(ds) * 16 + 8 + hh] : 0.f; } } }

    ph_prologue(lds, wv);
    GRID_BAR();
#pragma unroll 1
    for (int step = 0; step < 2 * DEPTH; ++step) {
        const int l = step >> 1, half = step & 1;
        { unsigned char* ws = arg_ws(lds); const int G = opq_g(), bx = opq_bx();
          pg8::Gemm g{64, 64, DM}; pg8::SchedStd S; S.init(ws + WS_HB, ws + WS_WUP + (size_t)step * SZ_WUP, NTOK, 2 * DFF, DM, DM, G, bx); const pg8::EpiSwiGLU E{(bf16_t*)(ws + WS_HP), DFF, (const float*)(ws + WS_SSQ)};
          pg8::gemm_phase<pg8::EpiSwiGLU, pg8::SchedStd, 32768, 32768>(opq_lds(lds), g, S, E, wv);
        }
        GRID_BAR();
        { unsigned char* ws = arg_ws(lds); const int G = opq_g(), bx = opq_bx(); float* X = arg_out(lds);
          pg8::Gemm g{64, 64, DFF}; pg8::SchedStd S; S.init(ws + WS_HP, ws + WS_WDN + (size_t)step * SZ_WDN, NTOK, DM, DFF, DFF, G, bx, 4, 1);
          pg8::EpiResid E{(step == 2 * DEPTH - 1) ? X : (float*)nullptr, (bf16_t*)(ws + WS_HB), (float*)(ws + WS_SSQ), DM, 0.5f};
          pg8::gemm_phase<pg8::EpiResid, pg8::SchedStd, 32768, 32768>(opq_lds(lds), g, S, E, wv);
        }
        if (step == 2 * DEPTH - 1) break;
        GRID_BAR();
        if (half == 0) {
            { unsigned char* ws = arg_ws(lds); const int G = opq_g(), bx = opq_bx();
              pg8::Gemm g{64, 64, DM}; pg8::SchedStd S; S.init(ws + WS_HB, ws + WS_WIN + (size_t)l * SZ_WIN, NTOK, PC, DM, DM, G, bx); const pg8::EpiBf16 E{(bf16_t*)(ws + WS_HP), PC, (const float*)(ws + WS_SSQ), arg_in(lds, I_KNA) + l * HD, arg_in(lds, I_KNN) + l * HD, arg_in(lds, I_POS) + (size_t)l * 32 * HD, (bf16_t*)(ws + WS_ACMP), opq_lds(lds) + pg8::EX_LDS};
              pg8::gemm_phase<pg8::EpiBf16, pg8::SchedStd, 32768, 32768>(opq_lds(lds), g, S, E, wv);
            }
            GRID_BAR();
#pragma unroll 1
            for (int pat3 = 0; pat3 < 3; ++pat3) { const int pat = pat3 % 3;
                if (pat3 == 0) { unsigned char* ws = arg_ws(lds); const int G = opq_g(), bx = opq_bx();
                  pg8::Gemm g{64, 64, 1024}; pg8::SchedCmp S; S.A = (const char*)(ws + WS_ACMP); S.Bt = (const char*)(ws + WS_WC1 + (size_t)l * SZ_WC1); S.G = G; S.c = bx; pg8::EpiF32Z E{(float*)(ws + WS_CP), 512, (size_t)4096 * 512};
                  pg8::gemm_phase<pg8::EpiF32Z, pg8::SchedCmp, 32768, 32768>(opq_lds(lds), g, S, E, wv); }
                if (pat3 == 1) ph_cmp2(lds, l, wv);
                { unsigned char* ws = arg_ws(lds); const int G = opq_g(), bx = opq_bx();
                  for (int u0 = bx; u0 < 1024; u0 += G) { const int w_ = u0 & 255, k_ = u0 >> 8; const int unit = (((w_ & 7) + 8 * k_) << 5) | (w_ >> 3);
                    dil_unit((LAS char*)opq_lds(lds), (const bf16_t*)(ws + WS_HP), (bf16_t*)(ws + WS_OA), (float*)(ws + WS_LSE), (const float*)(ws + WS_TBL), arg_in(lds, I_QNA) + l * HD, pat, 2 * pat, unit, wv); } }
                if (pat3 + 1 < 3) GRID_BAR();
            }
            { unsigned char* ws = arg_ws(lds); const int G = opq_g(), bx = opq_bx();
              const float* gb = arg_in(lds, I_GB) + l * 24; const float* qgn = arg_in(lds, I_QNN) + l * HD;
              int last_bg = -1;
#pragma unroll 1
              for (int i4 = 0; i4 < 4; ++i4)
#pragma unroll 1
                  for (int w = bx; w < 256; w += G) { const int i = i4 & 3; const int bg = w & 7, j = w >> 3;
                      const int qi = (i == 0) ? 127 - j : (i == 1 ? j : (i == 2 ? 64 + j : 63 - j));
                      nsa_unit((LAS char*)opq_lds(lds), (const bf16_t*)(ws + WS_HP), (const bf16_t*)(ws + WS_KC), (const bf16_t*)(ws + WS_VC), (bf16_t*)(ws + WS_ON), (const float*)(ws + WS_TBL + 65536), gb, qgn, bg >> 1, bg & 1, qi, bg != last_bg, wv); last_bg = bg; } }
            GRID_BAR();
            ph_outnorm(lds, l, wv);
            GRID_BAR();
            { unsigned char* ws = arg_ws(lds); const int G = opq_g(), bx = opq_bx(); float* X = arg_out(lds);
              pg8::Gemm g{64, 64, DM}; pg8::SchedStd S; S.init(ws + WS_HP, ws + WS_WOUT + (size_t)l * SZ_WOUT, NTOK, DM, DM, DM, G, bx, 4); pg8::EpiResid E{(float*)nullptr, (bf16_t*)(ws + WS_HB), (float*)(ws + WS_SSQ), DM, 1.0f};
              pg8::gemm_phase<pg8::EpiResid, pg8::SchedStd, 32768, 32768>(opq_lds(lds), g, S, E, wv);
            }
            GRID_BAR();
        }
    }
}

extern "C" void kernel_launch(void* const* d_in, const int* in_sizes, int n_in, void* d_out, int out_size, void* d_ws, size_t ws_size, hipStream_t stream) {
    static int grid = 0;
    if (grid == 0) {
        if (n_in != 24 || in_sizes[0] != NTOK * DM || out_size != NTOK * DM || ws_size < WS_END) { fprintf(stderr, "kernel_launch: shape mismatch n_in %d in0 %d out %d ws %zu (need %zu)\n", n_in, n_in > 0 ? in_sizes[0] : -1, out_size, ws_size, (size_t)WS_END); grid = -1; return; }
        int dev = 0, cus = 0, per_cu = 0;
        if (hipGetDevice(&dev) != hipSuccess || hipDeviceGetAttribute(&cus, hipDeviceAttributeMultiprocessorCount, dev) != hipSuccess) { grid = -1; return; }
        if (hipFuncSetAttribute((const void*)mega_fwd, hipFuncAttributeMaxDynamicSharedMemorySize, LDS_BYTES) != hipSuccess) { fprintf(stderr, "kernel_launch: hipFuncSetAttribute failed\n"); grid = -1; return; }
        if (hipOccupancyMaxActiveBlocksPerMultiprocessor(&per_cu, (const void*)mega_fwd, NTHR, LDS_BYTES) != hipSuccess || per_cu < 1) { fprintf(stderr, "kernel_launch: occupancy query says %d\n", per_cu); (void)hipGetLastError(); if (per_cu < 1) { grid = -1; return; } }
        grid = cus;
    }
    if (grid < 0) return;
    if (hipMemsetAsync((char*)d_ws + WS_CTL, 0, CTL_ZERO_BYTES, stream) != hipSuccess) return;
    Args a{};
    for (int i = 0; i < 24; ++i) a.in[i] = (const float*)d_in[i];
    a.out = (float*)d_out; a.ws = (unsigned char*)d_ws;
    hipLaunchKernelGGL(mega_fwd, dim3(grid), dim3(NTHR), LDS_BYTES, stream, a);
    const hipError_t le = hipPeekAtLastError();
    if (le != hipSuccess) fprintf(stderr, "kernel_launch: launch failed: %s\n", hipGetErrorName(le));
}
```

```cpp
#include <hip/hip_runtime.h>
#include <cstdio>
#include <cstdint>

#define LAS __attribute__((address_space(3)))
typedef unsigned short bf16_t;
typedef short bf16x8 __attribute__((ext_vector_type(8)));
typedef short s16x4 __attribute__((ext_vector_type(4)));
typedef float f32x2 __attribute__((ext_vector_type(2)));
typedef float f32x4 __attribute__((ext_vector_type(4)));
typedef float f32x16 __attribute__((ext_vector_type(16)));
typedef unsigned u32x2 __attribute__((ext_vector_type(2)));
typedef unsigned u32x4 __attribute__((ext_vector_type(4)));

constexpr int BATCH = 4, SEQ = 8192, DM = 2048, DFF = 5632, NTOK = BATCH * SEQ, DEPTH = 4, HD = 128;
constexpr int IN_COLS = 5656, PC = 5888;
constexpr int C_QA = 0, C_KA = 1024, C_VA = 2048, C_QN = 3072, C_KC = 4096, C_VC = 4352, C_KS = 4608, C_VS = 4864, C_KW = 5120, C_VW = 5376, C_GL = 5632;
constexpr float EPS = 1e-6f, QSCALE = 0.08838834764831845f, LOG2E = 1.4426950408889634f;
constexpr int TBLS = 1704, TBL0 = 64;
constexpr int DTS = 320, DT0 = 96;
constexpr int NWAVES = 8, NTHR = 512;

constexpr size_t MiB = 1u << 20;
constexpr size_t WS_CTL = 0, CTL_ZERO_BYTES = 1 * MiB;
constexpr size_t WS_TBL = 1 * MiB;
constexpr size_t SZ_WUP = 44 * MiB, SZ_WDN = 22 * MiB, SZ_WIN = 23 * MiB, SZ_WOUT = 8 * MiB, SZ_WC1 = 8 * MiB;
constexpr size_t WS_WUP = 2 * MiB;
constexpr size_t WS_WDN = WS_WUP + 8 * SZ_WUP;
constexpr size_t WS_WIN = WS_WDN + 8 * SZ_WDN;
constexpr size_t WS_WOUT = WS_WIN + 4 * SZ_WIN;
constexpr size_t WS_WC1 = WS_WOUT + 4 * SZ_WOUT;
constexpr size_t WS_HB = WS_WC1 + 4 * SZ_WC1;
constexpr size_t WS_HP = WS_HB + 128 * MiB;
constexpr size_t WS_OA = WS_HP + 368 * MiB;
constexpr size_t WS_LSE = WS_OA + 64 * MiB;
constexpr size_t WS_ON = WS_LSE + 1 * MiB;
constexpr size_t WS_ACMP = WS_ON + 192 * MiB;
constexpr size_t WS_CP = WS_ACMP + 64 * MiB;
constexpr size_t WS_KC = WS_CP + 64 * MiB;
constexpr size_t WS_VC = WS_KC + 1 * MiB;
constexpr size_t WS_SSQ = WS_VC + 1 * MiB;
constexpr size_t WS_RSTD = WS_SSQ + 4 * MiB;
constexpr size_t WS_END = WS_RSTD + 1 * MiB;
constexpr int CW_BAR = 4096;

__device__ __forceinline__ unsigned f2bf(float f) { unsigned u = __builtin_bit_cast(unsigned, f); return (u + 0x7fffu + ((u >> 16) & 1u)) >> 16; }
__device__ __forceinline__ unsigned pk2(float lo, float hi) { return f2bf(lo) | (f2bf(hi) << 16); }
__device__ __forceinline__ float bf2f(bf16_t b) { return __builtin_bit_cast(float, ((unsigned)b) << 16); }
__device__ __forceinline__ float bflo(unsigned w) { return __builtin_bit_cast(float, w << 16); }
__device__ __forceinline__ float bfhi(unsigned w) { return __builtin_bit_cast(float, w & 0xffff0000u); }
__device__ __forceinline__ unsigned cvtpk(float lo, float hi) { unsigned r; asm volatile("v_cvt_pk_bf16_f32 %0, %1, %2" : "=v"(r) : "v"(lo), "v"(hi)); return r; }
__device__ __forceinline__ float shx(float v, int m, int lane) { return __builtin_bit_cast(float, __builtin_amdgcn_ds_bpermute((lane ^ m) << 2, __builtin_bit_cast(int, v))); }
__device__ __forceinline__ float wave_sum(float v, int lane) {
#pragma unroll
    for (int o = 1; o < 64; o <<= 1) v += shx(v, o, lane);
    return v;
}
__device__ __forceinline__ LAS unsigned char* opq_lds(LAS unsigned char* p) { unsigned a = (unsigned)(uintptr_t)p; asm volatile("" : "+s"(a)); return (LAS unsigned char*)(uintptr_t)a; }
__device__ __forceinline__ int opq_tid(int wv) { int l; asm volatile("v_mbcnt_lo_u32_b32 %0, -1, 0\n\tv_mbcnt_hi_u32_b32 %0, -1, %0" : "=v"(l)); return wv * 64 + l; }
__device__ __forceinline__ size_t kt_off(int r, int k, int K) { return (((size_t)(r >> 8) * (K >> 6) + (k >> 6)) * 256 + (r & 255)) * 64 + (k & 63); }
#define LDS_WAIT() asm volatile("s_waitcnt lgkmcnt(0)" ::: "memory")
#define VM_WAIT() asm volatile("s_waitcnt vmcnt(0)" ::: "memory")
#define SBAR() __builtin_amdgcn_sched_barrier(0)

#define XB_TMO      128
#define XB_XCNT(j)  (256  + 64 * (j))
#define XB_XSUB(j)  (1280 + 64 * (j))
#define XB_XGEN(j)  (2304 + 64 * (j))
#define XB_TOP      3328
#define XB_TOPGEN   3392
#define XCD_BAR_WORDS 3456
#define XB_SPIN_CAP (1u << 18)
__device__ __forceinline__ unsigned xb_ld(unsigned* p)              { return __hip_atomic_load(p, __ATOMIC_RELAXED, __HIP_MEMORY_SCOPE_AGENT); }
__device__ __forceinline__ unsigned xb_add(unsigned* p, unsigned v) { return __hip_atomic_fetch_add(p, v, __ATOMIC_RELAXED, __HIP_MEMORY_SCOPE_AGENT); }
__device__ __forceinline__ unsigned xb_xcc_id() { return (unsigned)__builtin_amdgcn_s_getreg((3 << 11) | 20) & 0xFu; }
#define XB_SPIN(cond, bar) do { unsigned _sp = 0; while (cond) { __builtin_amdgcn_s_sleep(1); \
    if ((++_sp & 255u) == 0u) { if (xb_ld(&(bar)[XB_TMO])) break; if (_sp > XB_SPIN_CAP) { atomicAdd(&(bar)[XB_TMO], 1u); break; } } } } while (0)
struct XcdBarrier { unsigned* bar; unsigned x; volatile LAS unsigned* st; };
__device__ __forceinline__ XcdBarrier xcd_barrier_post(unsigned* bar, volatile LAS unsigned* st) {
    XcdBarrier b; b.bar = bar; b.x = xb_xcc_id(); b.st = st;
    if (threadIdx.x == 0) (void)xb_add(&bar[XB_XCNT(b.x)], 1u);
    return b;
}
__device__ __forceinline__ void xcd_barrier_complete(unsigned* bar, unsigned x, unsigned& nloc, unsigned& nx) {
    const unsigned G = gridDim.x * gridDim.y * gridDim.z;
    unsigned sum, cnt, mine, sp = 0u;
    for (;;) {
        sum = 0u; cnt = 0u; mine = 0u;
#pragma unroll
        for (unsigned j = 0; j < 16; ++j) { const unsigned c = xb_ld(&bar[XB_XCNT(j)]); sum += c; cnt += (c > 0u) ? 1u : 0u; mine = (j == x) ? c : mine; }
        if (sum == G) break;
        __builtin_amdgcn_s_sleep(1);
        if ((++sp & 255u) == 0u) { if (xb_ld(&bar[XB_TMO])) break; if (sp > XB_SPIN_CAP) { atomicAdd(&bar[XB_TMO], 1u); break; } }
    }
    nloc = mine > 0u ? mine : 1u; nx = cnt > 0u ? cnt : 1u;
}
__device__ __forceinline__ void xcd_barrier(const XcdBarrier& b, const int wv) {
    asm volatile("s_waitcnt vmcnt(0)" ::: "memory");
    __syncthreads();
    if (opq_tid(wv) == 0) {
        unsigned* bar = b.bar; asm volatile("" : "+s"(bar));
        __builtin_amdgcn_s_waitcnt(0);
        unsigned nloc = b.st[0], nx = b.st[1];
        if (nloc == 0u) { xcd_barrier_complete(bar, b.x, nloc, nx); b.st[0] = nloc; b.st[1] = nx; }
        const unsigned old = xb_add(&bar[XB_XSUB(b.x)], 1u);
        const unsigned gen = old / nloc;
        if (old + 1u == (gen + 1u) * nloc) {
            __builtin_amdgcn_fence(__ATOMIC_RELEASE, "agent");
            asm volatile("s_waitcnt vmcnt(0)" ::: "memory");
            const unsigned og = xb_add(&bar[XB_TOP], 1u);
            const unsigned tg = og / nx;
            if (og + 1u == (tg + 1u) * nx) xb_add(&bar[XB_TOPGEN], 1u);
            else XB_SPIN(xb_ld(&bar[XB_TOPGEN]) == tg, bar);
            __builtin_amdgcn_fence(__ATOMIC_ACQUIRE, "agent");
            xb_add(&bar[XB_XGEN(b.x)], 1u);
            asm volatile("s_waitcnt vmcnt(0)" ::: "memory");
        } else {
            XB_SPIN(xb_ld(&bar[XB_XGEN(b.x)]) == gen, bar);
            __builtin_amdgcn_fence(__ATOMIC_ACQUIRE, "agent");
            asm volatile("s_waitcnt vmcnt(0)" ::: "memory");
        }
    }
    __syncthreads();
}

namespace pg8 {
constexpr int BM = 256, BK = 64, HALF = 128, HTB = HALF * BK * 2, STAGE_BYTES = 8 * HTB, NXCD = 8, WGM = 8;
__host__ __device__ __forceinline__ int lds_byte(int r, int c) { const int st = (r >> 4) * 2 + (c >> 5), rr = r & 15, cc = c & 31, ob = rr * 64 + cc * 2; return st * 1024 + (ob ^ (((ob >> 9) & 1) << 5)); }
__host__ __device__ __forceinline__ void stage_rc(int b, int& R, int& C) { const int st = b / 1024, sb = b % 1024, swz = sb ^ (((sb >> 9) & 1) << 5); R = (st >> 1) * 16 + swz / 64; C = (st & 1) * 32 + (swz % 64) / 2; }
__host__ __device__ __forceinline__ int perm32(int rho) { const int n = rho >> 4, i = rho & 15; return 8 * (i >> 2) + 4 * n + (i & 3); }
struct Unit { int pm, pn, z; };
struct Gemm { int lda, ldb, K; };
struct SchedStd {
    const char* A; const char* Bt; size_t atile, btile; int nM, nN, nwg, G, c, wgm, flip;
    __device__ __forceinline__ void init(const void* A_, const void* Bt_, int M, int N, int lda, int ldb, int G_, int c_, int wgm_ = WGM, int flip_ = 0) { wgm = wgm_; flip = flip_;
        A = (const char*)A_; Bt = (const char*)Bt_; atile = (size_t)BM * lda * 2; btile = (size_t)BM * ldb * 2; nM = M / BM; nN = N / BM; nwg = nM * nN; G = G_; c = c_; }
    __device__ __forceinline__ bool next(int i, Unit& u) const {
        const long L = (long)i * G + c; if (L >= nwg) return false;
        int wgid = (int)L; { const int q = nwg / NXCD, r = nwg % NXCD, xcd = wgid % NXCD, off = wgid / NXCD; wgid = (xcd < r ? xcd * (q + 1) : r * (q + 1) + (xcd - r) * q) + off; }
        const int nig = wgm * nN, gid = wgid / nig, fm = gid * wgm, gsz = (nM - fm) < wgm ? (nM - fm) : wgm;
        u.pm = fm + ((wgid % nig) % gsz); u.pn = (wgid % nig) / gsz; u.z = 0; if (flip) u.pm = nM - 1 - u.pm; return true;
    }
    __device__ __forceinline__ const char* a_ptr(const Unit& u) const { return A + (size_t)u.pm * atile; }
    __device__ __forceinline__ const char* b_ptr(const Unit& u) const { return Bt + (size_t)u.pn * btile; }
};
struct SchedCmp {
    const char* A; const char* Bt; int G, c;
    __device__ __forceinline__ bool next(int i, Unit& u) const { const int L = i * G + c; if (L >= 256) return false; u.z = L >> 5; u.pm = (L & 31) >> 1; u.pn = L & 1; return true; }
    __device__ __forceinline__ const char* a_ptr(const Unit& u) const { const int kv = u.z >> 2, ks = u.z & 3; return A + ((size_t)(kv * 16 + u.pm) * 64 + (size_t)ks * 16) * 32768; }
    __device__ __forceinline__ const char* b_ptr(const Unit& u) const { const int kv = u.z >> 2, ks = u.z & 3; return Bt + ((size_t)(kv * 2 + u.pn) * 64 + (size_t)ks * 16) * 32768; }
};
constexpr int EX_LDS = 131072 + 4096;
struct EpiBf16 {
    static constexpr bool PERM = true;
    static constexpr bool ROWS = true;
    bf16_t* O; int ldc; const float* ssq; const float* kna; const float* knn; const float* pos; bf16_t* acmp; LAS unsigned char* xl;
    __device__ __forceinline__ void operator()(const f32x4 (&acc)[2][2][4][2], const Unit& u, int wr, int wc, int fr, int fq, const float (&pre)[8]) const {
        const int pn = u.pn, e0 = wc * 32 + 8 * fq, lane = fq * 16 + fr;
        const int row0 = u.pm * BM + wr * 64 + fr, col0 = pn * BM + e0;
        if ((pn >= 4 && pn < 8) || pn == 18 || pn == 20) {
            const float* ga = kna + e0; const float* gb = knn + e0; const float* gp = (pn < 8) ? ga + 0 : gb + 0;
            const f32x4 g0 = *(const f32x4*)gp, g1 = *(const f32x4*)(gp + 4);
            LAS float* X = (LAS float*)xl + ((wr * 256 + fr) * 4);
#pragma unroll
            for (int ai = 0; ai < 2; ++ai)
#pragma unroll
                for (int m = 0; m < 4; ++m) { const float rs = pre[ai * 4 + m];
#pragma unroll
                    for (int bj = 0; bj < 2; ++bj) { const f32x4 v0 = acc[ai][bj][m][0] * rs, v1 = acc[ai][bj][m][1] * rs;
                        float s = ((v0[0] * v0[0] + v0[1] * v0[1]) + (v0[2] * v0[2] + v0[3] * v0[3])) + ((v1[0] * v1[0] + v1[1] * v1[1]) + (v1[2] * v1[2] + v1[3] * v1[3]));
                        s += shx(s, 16, lane); s += shx(s, 32, lane);
                        if (fq == 0) X[((ai * 4 + m) * 2 + bj) * 64 + wc] = s; } }
            asm volatile("s_waitcnt lgkmcnt(0)" ::: "memory"); __builtin_amdgcn_s_barrier(); asm volatile("" ::: "memory");
#pragma unroll
            for (int ai = 0; ai < 2; ++ai)
#pragma unroll
                for (int m = 0; m < 4; ++m) { bf16_t* rowp = O + (size_t)(row0 + ai * HALF + m * 16) * ldc + col0; const float rs = pre[ai * 4 + m];
#pragma unroll
                    for (int bj = 0; bj < 2; ++bj) { const f32x4 t4 = *(const LAS f32x4*)(X + ((ai * 4 + m) * 2 + bj) * 64);
                        const float rh = rs / sqrtf(((t4[0] + t4[1]) + (t4[2] + t4[3])) * (1.f / 128.f) + 1e-6f);
                        const f32x4 v0 = acc[ai][bj][m][0] * rh * g0, v1 = acc[ai][bj][m][1] * rh * g1;
                        u32x4 w; w.x = cvtpk(v0[0], v0[1]); w.y = cvtpk(v0[2], v0[3]); w.z = cvtpk(v1[0], v1[1]); w.w = cvtpk(v1[2], v1[3]);
                        *(u32x4*)(rowp + bj * HALF) = w; } }
        } else if (pn == 16 || pn == 17) {
            const int kv = pn - 16;
            const float* pp = pos + fr * 128 + e0;
            const f32x4 pa0 = *(const f32x4*)pp, pa1 = *(const f32x4*)(pp + 4), pb0 = *(const f32x4*)(pp + 16 * 128), pb1 = *(const f32x4*)(pp + 16 * 128 + 4);
#pragma unroll
            for (int ai = 0; ai < 2; ++ai)
#pragma unroll
                for (int m = 0; m < 4; ++m) { const int rowb = u.pm * BM + ai * HALF + wr * 64 + m * 16, b = rowb >> 13, c1 = (rowb & 8191) >> 4; const float rs = pre[ai * 4 + m];
#pragma unroll
                    for (int bj = 0; bj < 2; ++bj) { const f32x4 v0 = acc[ai][bj][m][0] * rs, v1 = acc[ai][bj][m][1] * rs;
                        const int arow0 = kv * 4096 + (b * 2 + bj) * 512;
                        if (c1 <= 510) { u32x4 w; w.x = cvtpk(v0[0] + pa0[0], v0[1] + pa0[1]); w.y = cvtpk(v0[2] + pa0[2], v0[3] + pa0[3]); w.z = cvtpk(v1[0] + pa1[0], v1[1] + pa1[1]); w.w = cvtpk(v1[2] + pa1[2], v1[3] + pa1[3]);
                            *(u32x4*)(acmp + kt_off(arow0 + c1, fr * 128 + e0, 4096)) = w; }
                        else { unsigned zr = 0u; asm volatile("" : "+v"(zr)); const u32x4 z = {zr, zr, zr, zr}; *(u32x4*)(acmp + kt_off(arow0 + 511, fr * 128 + e0, 4096)) = z; *(u32x4*)(acmp + kt_off(arow0 + 511, (fr + 16) * 128 + e0, 4096)) = z; }
                        if (c1 >= 1) { u32x4 w; w.x = cvtpk(v0[0] + pb0[0], v0[1] + pb0[1]); w.y = cvtpk(v0[2] + pb0[2], v0[3] + pb0[3]); w.z = cvtpk(v1[0] + pb1[0], v1[1] + pb1[1]); w.w = cvtpk(v1[2] + pb1[2], v1[3] + pb1[3]);
                            *(u32x4*)(acmp + kt_off(arow0 + c1 - 1, (fr + 16) * 128 + e0, 4096)) = w; } } }
        } else {
#pragma unroll
            for (int ai = 0; ai < 2; ++ai)
#pragma unroll
                for (int m = 0; m < 4; ++m) { bf16_t* rowp = O + (size_t)(row0 + ai * HALF + m * 16) * ldc + col0; const float rs = pre[ai * 4 + m];
#pragma unroll
                    for (int bj = 0; bj < 2; ++bj) { const f32x4 v0 = acc[ai][bj][m][0] * rs, v1 = acc[ai][bj][m][1] * rs;
                        u32x4 w; w.x = cvtpk(v0[0], v0[1]); w.y = cvtpk(v0[2], v0[3]); w.z = cvtpk(v1[0], v1[1]); w.w = cvtpk(v1[2], v1[3]);
                        *(u32x4*)(rowp + bj * HALF) = w; } }
        }
    }
};
struct EpiSwiGLU {
    static constexpr bool PERM = true;
    static constexpr bool ROWS = true;
    bf16_t* O; int ldc; const float* ssq;
    __device__ __forceinline__ void operator()(const f32x4 (&acc)[2][2][4][2], const Unit& u, int wr, int wc, int fr, int fq, const float (&pre)[8]) const {
        const int rowp0 = wr * 64 + fr, kt = 2 * u.pn + (wc >> 1), cit = (wc & 1) * 32 + 8 * fq;
        bf16_t* tile = O + ((size_t)u.pm * (ldc / 64) + kt) * (256 * 64) + cit;
#pragma unroll
        for (int ai = 0; ai < 2; ++ai)
#pragma unroll
            for (int m = 0; m < 4; ++m) { bf16_t* rowp = tile + (size_t)(rowp0 + ai * HALF + m * 16) * 64; const float rs = pre[ai * 4 + m];
                const float c2 = -rs * LOG2E, rs2 = rs * rs;
                f32x4 v[2];
#pragma unroll
                for (int n = 0; n < 2; ++n) { const f32x4 a = acc[ai][0][m][n], b = acc[ai][1][m][n];
                    const f32x4 t = a * c2, ab = a * b;
                    f32x4 d = {__builtin_amdgcn_exp2f(t[0]), __builtin_amdgcn_exp2f(t[1]), __builtin_amdgcn_exp2f(t[2]), __builtin_amdgcn_exp2f(t[3])};
                    d = d + 1.0f;
                    f32x4 r = {__builtin_amdgcn_rcpf(d[0]), __builtin_amdgcn_rcpf(d[1]), __builtin_amdgcn_rcpf(d[2]), __builtin_amdgcn_rcpf(d[3])};
                    r = r * rs2;
                    v[n] = ab * r; }
                u32x4 w; w.x = cvtpk(v[0][0], v[0][1]); w.y = cvtpk(v[0][2], v[0][3]); w.z = cvtpk(v[1][0], v[1][1]); w.w = cvtpk(v[1][2], v[1][3]);
                *(u32x4*)rowp = w; }
    }
};
struct EpiResid {
    static constexpr bool PERM = true;
    static constexpr bool ROWS = false;
    float* out; bf16_t* xb; float* ssq; int ldc; float alpha;
    __device__ __forceinline__ void operator()(const f32x4 (&acc)[2][2][4][2], const Unit& u, int wr, int wc, int fr, int fq, const float (&pre)[8]) const {
        const int row0 = u.pm * BM + wr * 64 + fr, col0 = u.pn * BM + wc * 32 + 8 * fq;
        u32x4 bs[4][2];
#define ER_LOAD(g) do { const int row_ = row0 + ((g) >> 2) * HALF + ((g) & 3) * 16; \
        _Pragma("unroll") for (int q_ = 0; q_ < 2; ++q_) bs[(g) & 3][q_] = *(const u32x4*)(xb + kt_off(row_, col0 + q_ * HALF, ldc)); } while (0)
        ER_LOAD(0); ER_LOAD(1); ER_LOAD(2); ER_LOAD(3);
#pragma unroll
        for (int g = 0; g < 8; ++g) { const int ai = g >> 2, m = g & 3; const int row = row0 + ai * HALF + m * 16; float ss = 0.f;
#pragma unroll
            for (int bj = 0; bj < 2; ++bj) { const u32x4 b = bs[g & 3][bj];
                const f32x4 o0 = (f32x4){bflo(b.x), bfhi(b.x), bflo(b.y), bfhi(b.y)} + acc[ai][bj][m][0] * alpha, o1 = (f32x4){bflo(b.z), bfhi(b.z), bflo(b.w), bfhi(b.w)} + acc[ai][bj][m][1] * alpha;
                ss += ((o0.x * o0.x + o0.y * o0.y) + (o0.z * o0.z + o0.w * o0.w)) + ((o1.x * o1.x + o1.y * o1.y) + (o1.z * o1.z + o1.w * o1.w));
                u32x4 w; w.x = cvtpk(o0.x, o0.y); w.y = cvtpk(o0.z, o0.w); w.z = cvtpk(o1.x, o1.y); w.w = cvtpk(o1.z, o1.w); *(u32x4*)(xb + kt_off(row, col0 + bj * HALF, ldc)) = w;
                if (out) { float* op_ = out + (size_t)row * ldc + col0 + bj * HALF; *(f32x4*)op_ = o0; *(f32x4*)(op_ + 4) = o1; } }
            if (g + 4 < 8) ER_LOAD(g + 4);
            const int lane = fq * 16 + fr; ss += shx(ss, 16, lane); ss += shx(ss, 32, lane);
            if (fq == 0) ssq[(size_t)row * 32 + u.pn * 4 + wc] = ss; }
#undef ER_LOAD
    }
};
struct EpiF32Z {
    static constexpr bool PERM = false;
    float* C; int ldc; size_t zstride;
    static constexpr bool ROWS = false;
    __device__ __forceinline__ void operator()(const f32x4 (&acc)[2][2][4][2], const Unit& u, int wr, int wc, int fr, int fq, const float (&pre)[8]) const {
        float* Cz = C + (size_t)u.z * zstride;
        const int row0 = u.pm * BM + wr * 64 + fr, col0 = u.pn * BM + wc * 32 + 4 * fq;
#pragma unroll
        for (int ai = 0; ai < 2; ++ai)
#pragma unroll
            for (int m = 0; m < 4; ++m) { float* rowp = Cz + (size_t)(row0 + ai * HALF + m * 16) * ldc + col0;
#pragma unroll
                for (int bj = 0; bj < 2; ++bj)
#pragma unroll
                    for (int n = 0; n < 2; ++n) *(f32x4*)(rowp + bj * HALF + n * 16) = acc[ai][bj][m][n]; }
    }
};

constexpr int RS_LDS = 131072 + 1024;
__device__ __forceinline__ void rows_to_lds(LAS unsigned char* lds, const float* ssq, int pm, int slot, int tid) {
    const int row = tid >> 1, half = tid & 1;
    const f32x4* p = (const f32x4*)(ssq + ((size_t)pm * BM + row) * 32 + half * 16);
    f32x4 a = p[0]; a = a + p[1]; a = a + p[2]; a = a + p[3];
    float s = (a.x + a.y) + (a.z + a.w); s += shx(s, 1, tid & 63);
    const float rs = 1.0f / sqrtf(s * (1.f / 2048.f) + 1e-6f);
    if (half == 0) *(LAS float*)(lds + RS_LDS + slot * 1024 + row * 4) = rs;
}
template <class Epi, class Sched, int KSTEP_A = 128, int KSTEP_B = 128>
__device__ __forceinline__ void gemm_phase(LAS unsigned char* lds, const Gemm g, const Sched& S, const Epi& E, const int wv) {
    const int tid = opq_tid(wv), wid = __builtin_amdgcn_readfirstlane(tid >> 6), lane = tid & 63, wr = wid >> 2, wc = wid & 3, fr = lane & 15, fq = lane >> 4;
    const int K = g.K, nt = K / BK;
    unsigned voffA[2], voffB[2];
#pragma unroll
    for (int i = 0; i < 2; ++i) { int R, C; stage_rc(tid * 16 + i * 8192, R, C); const int Rb = Epi::PERM ? ((R & ~31) + perm32(R & 31)) : R;
        voffA[i] = (unsigned)(R * g.lda + C) * 2u; voffB[i] = (unsigned)(Rb * g.ldb + C) * 2u; }
    constexpr size_t kstepA = (size_t)KSTEP_A, kstepB = (size_t)KSTEP_B;
    const size_t hstepA = (size_t)HALF * g.lda * 2, hstepB = (size_t)HALF * g.ldb * 2;
    const unsigned ldsw = (unsigned)wid * 1024u;
    const int aoff = lds_byte(wr * 64 + fr, fq * 8), boff = lds_byte(wc * 32 + fr, fq * 8);
#define PG8_SA(b, h) (((b) * 2 + (h)) * HTB)
#define PG8_SB(b, h) ((4 + (b) * 2 + (h)) * HTB)
#define PG8_STAGE(bufoff, gbase, voff) do { _Pragma("unroll") for (int _i = 0; _i < 2; ++_i) \
        __builtin_amdgcn_global_load_lds((const unsigned*)((const char*)(gbase) + (voff)[_i]), (LAS unsigned*)(lds + (bufoff) + ldsw + _i * 8192), 16, 0, 0); } while (0)
#define PG8_LDA(dst, b, h) do { _Pragma("unroll") for (int m = 0; m < 4; ++m) _Pragma("unroll") for (int k = 0; k < 2; ++k) dst[m][k] = *(const LAS bf16x8*)(lds + PG8_SA(b, h) + aoff + m * 2048 + k * 1024); } while (0)
#define PG8_LDB(dst, b, h) do { _Pragma("unroll") for (int n = 0; n < 2; ++n) _Pragma("unroll") for (int k = 0; k < 2; ++k) dst[n][k] = *(const LAS bf16x8*)(lds + PG8_SB(b, h) + boff + n * 2048 + k * 1024); } while (0)
#define PG8_MMA(ai, bj, At, Bt) do { __builtin_amdgcn_s_setprio(1); _Pragma("unroll") for (int m = 0; m < 4; ++m) _Pragma("unroll") for (int n = 0; n < 2; ++n) _Pragma("unroll") for (int k = 0; k < 2; ++k) \
        acc[ai][bj][m][n] = __builtin_amdgcn_mfma_f32_16x16x32_bf16(Bt[n][k], At[m][k], acc[ai][bj][m][n], 0, 0, 0); __builtin_amdgcn_s_setprio(0); } while (0)
#define PG8_WAIT_V(n) asm volatile("s_waitcnt vmcnt(" #n ")" ::: "memory")
#define PG8_WAIT_L(n) asm volatile("s_waitcnt lgkmcnt(" #n ")" ::: "memory")
#define PG8_BAR __builtin_amdgcn_s_barrier()
#define PG8_SCHED __builtin_amdgcn_sched_barrier(0)
    Unit cur, nxt; int ui = 0;
    if (!S.next(0, cur)) return;
    f32x4 acc[2][2][4][2];
#pragma unroll
    for (int a = 0; a < 2; ++a)
#pragma unroll
        for (int b = 0; b < 2; ++b)
#pragma unroll
            for (int m = 0; m < 4; ++m)
#pragma unroll
                for (int n = 0; n < 2; ++n) acc[a][b][m][n] = (f32x4){0.f, 0.f, 0.f, 0.f};
    bf16x8 At[4][2], B0[2][2], B1[2][2];
    const char* cA = S.a_ptr(cur); const char* cB = S.b_ptr(cur);
    float pre[8]; int rslot = 0; if constexpr (Epi::ROWS) rows_to_lds(lds, E.ssq, cur.pm, 0, tid);
    PG8_STAGE(PG8_SB(0, 0), cB, voffB); PG8_STAGE(PG8_SA(0, 0), cA, voffA); PG8_STAGE(PG8_SB(0, 1), cB + hstepB, voffB); PG8_STAGE(PG8_SA(0, 1), cA + hstepA, voffA);
    if (wr == 1) PG8_BAR;
    PG8_WAIT_V(4); PG8_BAR;
    PG8_STAGE(PG8_SB(1, 0), cB + kstepB, voffB); PG8_STAGE(PG8_SA(1, 0), cA + kstepA, voffA); PG8_STAGE(PG8_SB(1, 1), cB + hstepB + kstepB, voffB);
    PG8_WAIT_V(6); PG8_BAR;
    for (;;) {
        const bool has_next = S.next(ui + 1, nxt);
        const char* nA = has_next ? S.a_ptr(nxt) : cA; const char* nB = has_next ? S.b_ptr(nxt) : cB;
        for (int t = 0; t < nt; t += 2) {
            const bool last = (t == nt - 2);
            const char* a1 = cA + (size_t)(t + 1) * kstepA;
            const char* a2 = last ? nA : cA + (size_t)(t + 2) * kstepA; const char* b2 = last ? nB : cB + (size_t)(t + 2) * kstepB;
            const char* a3 = a2 + kstepA; const char* b3 = b2 + kstepB;
            PG8_LDB(B0, 0, 0); PG8_SCHED; PG8_LDA(At, 0, 0); PG8_STAGE(PG8_SA(1, 1), a1 + hstepA, voffA);
            PG8_WAIT_L(8); PG8_BAR; PG8_WAIT_L(0); PG8_MMA(0, 0, At, B0); PG8_BAR; PG8_SCHED;
            PG8_LDB(B1, 0, 1); PG8_STAGE(PG8_SB(0, 0), b2, voffB);
            PG8_BAR; PG8_WAIT_L(0); PG8_MMA(0, 1, At, B1); PG8_BAR;
            PG8_LDA(At, 0, 1); PG8_STAGE(PG8_SA(0, 0), a2, voffA);
            PG8_BAR; PG8_WAIT_L(0); PG8_MMA(1, 0, At, B0); PG8_BAR; PG8_SCHED;
            PG8_STAGE(PG8_SB(0, 1), b2 + hstepB, voffB);
            PG8_WAIT_V(6); PG8_BAR; PG8_MMA(1, 1, At, B1); PG8_BAR;
            PG8_LDB(B0, 1, 0); PG8_SCHED; PG8_LDA(At, 1, 0); PG8_STAGE(PG8_SA(0, 1), a2 + hstepA, voffA);
            PG8_WAIT_L(8); PG8_BAR; PG8_WAIT_L(0); PG8_MMA(0, 0, At, B0); PG8_BAR; PG8_SCHED;
            PG8_LDB(B1, 1, 1); PG8_STAGE(PG8_SB(1, 0), b3, voffB);
            PG8_BAR; PG8_WAIT_L(0); PG8_MMA(0, 1, At, B1); PG8_BAR;
            PG8_LDA(At, 1, 1); PG8_STAGE(PG8_SA(1, 0), a3, voffA);
            PG8_BAR; PG8_WAIT_L(0); PG8_MMA(1, 0, At, B0); PG8_BAR; PG8_SCHED;
            PG8_STAGE(PG8_SB(1, 1), b3 + hstepB, voffB);
            PG8_WAIT_V(6); PG8_BAR; PG8_MMA(1, 1, At, B1); PG8_BAR;
        }
        if constexpr (Epi::ROWS) {
#pragma unroll
            for (int i = 0; i < 8; ++i) pre[i] = *(const LAS float*)(lds + RS_LDS + rslot * 1024 + (wr * 64 + fr + (i >> 2) * HALF + (i & 3) * 16) * 4); }
        E(acc, cur, wr, wc, fr, fq, pre);
        if constexpr (Epi::ROWS) { if (has_next && nxt.pm != cur.pm) { rslot ^= 1; rows_to_lds(lds, E.ssq, nxt.pm, rslot, tid); } }
        if (!has_next) break;
#pragma unroll
        for (int a = 0; a < 2; ++a)
#pragma unroll
            for (int b = 0; b < 2; ++b)
#pragma unroll
                for (int m = 0; m < 4; ++m)
#pragma unroll
                    for (int n = 0; n < 2; ++n) acc[a][b][m][n] = (f32x4){0.f, 0.f, 0.f, 0.f};
        cur = nxt; cA = nA; cB = nB; ++ui;
    }
    PG8_WAIT_V(0);
    if (wr == 0) PG8_BAR;
    PG8_BAR;
#undef PG8_SA
#undef PG8_SB
#undef PG8_STAGE
#undef PG8_LDA
#undef PG8_LDB
#undef PG8_MMA
#undef PG8_WAIT_V
#undef PG8_WAIT_L
#undef PG8_BAR
#undef PG8_SCHED
}
}

struct Args { const float* in[24]; float* out; unsigned char* ws; };
enum { I_X = 0, I_F1N, I_F1W1, I_F1W3, I_F1W2, I_MIXN, I_WIN, I_GB, I_QNA, I_KNA, I_QNN, I_KNN, I_POS, I_CKW1, I_CKW2, I_CVW1, I_CVW2, I_ON, I_WOUT, I_F2N, I_F2W1, I_F2W3, I_F2W2, I_RB };

__device__ __forceinline__ void ti_issue(const float* W, int K, int N, int item, int lane, const float* gain, f32x4 (&ld)[8], float (&gv)[8]) {
    const int nblk = (N + 31) / 32, kb = item / nblk, nb = item % nblk, k0 = 64 * kb, n0 = 32 * nb;
    const int c4 = 4 * (lane & 7), nn = n0 + c4;
    (void)K;
#pragma unroll
    for (int i = 0; i < 8; ++i) { const int kk = 8 * i + (lane >> 3); ld[i] = (nn < N) ? *(const f32x4*)(W + (size_t)(k0 + kk) * N + nn) : (f32x4){0.f, 0.f, 0.f, 0.f}; gv[i] = gain ? gain[k0 + kk] : 1.0f; }
}
__device__ __forceinline__ void ti_finish(int K, int N, bf16_t* WT, int mode, int off, LAS float* scr, int item, int lane, const f32x4 (&ld)[8], const float (&gv)[8]) {
    const int nblk = (N + 31) / 32, kb = item / nblk, nb = item % nblk, k0 = 64 * kb, n0 = 32 * nb;
    const int c4 = 4 * (lane & 7);
#pragma unroll
    for (int i = 0; i < 8; ++i) { const int kk = 8 * i + (lane >> 3); const f32x4 v = ld[i] * gv[i]; LAS float* d = scr + kk * 33 + c4; d[0] = v.x; d[1] = v.y; d[2] = v.z; d[3] = v.w; }
    LDS_WAIT(); asm volatile("" ::: "memory");
    const int c = lane & 7;
#pragma unroll
    for (int j = 0; j < 4; ++j) { const int n = (lane >> 3) + 8 * j; const LAS float* sp = scr + (8 * c) * 33 + n;
        u32x4 o; o.x = pk2(sp[0 * 33], sp[1 * 33]); o.y = pk2(sp[2 * 33], sp[3 * 33]); o.z = pk2(sp[4 * 33], sp[5 * 33]); o.w = pk2(sp[6 * 33], sp[7 * 33]);
        const int ng = n0 + n; int dr = (mode == 1) ? ((ng >> 7) * 256 + (ng & 127) + off) : (ng + off);
        if (mode == 2) { const bool isv = (ng >= C_VA && ng < C_VA + 1024) || (ng >= C_VS && ng < C_VS + 256) || (ng >= C_VW && ng < C_VW + 256);
            dr = isv ? ((ng & ~127) | (32 * (ng & 3) + ((ng & 127) >> 2))) : ng; }
        if (ng < N) *(u32x4*)(WT + kt_off(dr, k0 + 8 * c, K)) = o; }
    LDS_WAIT(); asm volatile("" ::: "memory");
}
__device__ __forceinline__ int rel_bucket_dev(int n) {
    if (n < 16) return n;
    const float v = logf((float)n / 16.0f) / 4.852030263919617f * 16.0f;
    int b = 16 + (int)v; return b < 31 ? b : 31;
}
namespace att {
constexpr int SHM_V = 16384, SHM_K = 16384;
constexpr int L_V = 0  , L_K = 49152  , L_WS = 98304, L_TBL = 100352, L_SELM = L_TBL + 4 * TBLS * 4  , L_NEG = L_SELM + 1024  , L_TBLW = L_NEG + 256  , L_END = L_TBLW + 4 * 136 * 4;
constexpr int L_GATE = 131072 + 4096;
constexpr int L_IMP = 0;
static_assert(L_END <= 131072, "attention LDS map");
constexpr float THR = 8.f;
#define KSWZ(row, colB) ((row) * 256 + ((colB) ^ (((row) & 7) << 4)))
__device__ __forceinline__ int v_st(int k, int c) { const int kk = (k & ~0xC) | ((k & 4) << 1) | ((k & 8) >> 1); return ((kk >> 3) * 4 + (c >> 5)) * 512 + ((kk & 7) * 32 + (c & 31)) * 2; }
__device__ __forceinline__ int v_rd_base(int lane) { return ((lane & 3) << 3) | (((lane >> 2) & 3) << 6) | (((lane >> 4) & 1) << 5) | (((lane >> 5) & 1) << 8); }
__device__ __forceinline__ int crow(int r, int hi) { return (r & 3) + 8 * (r >> 2) + 4 * hi; }

__device__ __forceinline__ void partialSM(f32x16& p0, f32x16& p1, float& m_reg, float& mn, float& alpha) {
    (void)m_reg; mn = 0.f; alpha = 1.f;
#pragma unroll
    for (int r = 0; r < 16; ++r) p0[r] = __builtin_amdgcn_exp2f(p0[r]);
}
__device__ __forceinline__ void partialSM_row(f32x16& p0, f32x16& p1, float& m_reg, float& mn, float& alpha, bool ok, float bias) {
    (void)m_reg; mn = 0.f; alpha = 1.f;
    const float mnL = ok ? bias : -__builtin_inff();
#pragma unroll
    for (int r = 0; r < 16; ++r) p0[r] = __builtin_amdgcn_exp2f(p0[r] + mnL);
#pragma unroll
    for (int r = 0; r < 16; ++r) p1[r] = p1[r] + mnL;
}
#define PK4(P, B_, OUT) do { unsigned a0 = cvtpk(P[B_+0], P[B_+1]), a1 = cvtpk(P[B_+2], P[B_+3]);                          \
        unsigned b0 = cvtpk(P[B_+4], P[B_+5]), b1 = cvtpk(P[B_+6], P[B_+7]);                                             \
        auto r0 = __builtin_amdgcn_permlane32_swap(a0, b0, false, false); auto r1 = __builtin_amdgcn_permlane32_swap(a1, b1, false, false); \
        u32x4 w = {r0[0], r1[0], r0[1], r1[1]}; OUT = *reinterpret_cast<bf16x8*>(&w); } while (0)
__device__ __forceinline__ void finishSM(f32x16& p0, f32x16& p1, float alpha, float& l_reg, bf16x8& pa0, bf16x8& pa1, bf16x8& pa2, bf16x8& pa3) {
#pragma unroll
    for (int r = 0; r < 16; ++r) p1[r] = __builtin_amdgcn_exp2f(p1[r]);
    float ps = 0;
#pragma unroll
    for (int r = 0; r < 16; ++r) ps += p0[r];
#pragma unroll
    for (int r = 0; r < 16; ++r) ps += p1[r];
    { auto rr = __builtin_amdgcn_permlane32_swap(__float_as_uint(ps), __float_as_uint(ps), false, false);
      ps = __uint_as_float(rr[0]) + __uint_as_float(rr[1]); }
    l_reg = l_reg * alpha + ps;
    PK4(p0, 0, pa0); PK4(p0, 8, pa1); PK4(p1, 0, pa2); PK4(p1, 8, pa3);
}
__device__ __forceinline__ void qkt(f32x16& p0, f32x16& p1, const LAS char* Kb, int r32, int hi, const bf16x8 (&qr)[8]) {
    p0 = f32x16{}; p1 = f32x16{};
    const LAS char* kb4[4];
#pragma unroll
    for (int dd = 0; dd < 4; ++dd) kb4[dd] = Kb + KSWZ(r32, (dd * 16 + hi * 8) * 2);
#pragma unroll
    for (int d0 = 0; d0 < 8; ++d0) { const LAS char* a = kb4[d0 & 3] + (d0 >> 2) * 128;
        const bf16x8 b0 = *reinterpret_cast<const LAS bf16x8*>(a);
        const bf16x8 b1 = *reinterpret_cast<const LAS bf16x8*>(a + 32 * 256);
        p0 = __builtin_amdgcn_mfma_f32_32x32x16_bf16(b0, qr[d0], p0, 0, 0, 0);
        p1 = __builtin_amdgcn_mfma_f32_32x32x16_bf16(b1, qr[d0], p1, 0, 0, 0); }
}
__device__ __forceinline__ void pv_tile(f32x16 (&o)[4], int vb, bf16x8 pa0, bf16x8 pa1, bf16x8 pa2, bf16x8 pa3) {
#define TRRD(dst, off) asm volatile("ds_read_b64_tr_b16 %0, %1 offset:%2" : "=&v"(dst) : "v"(vb), "i"(off) : "memory")
#define PV_RD(S, d0) do { constexpr int b_ = (d0) * 512; TRRD(S##l0, b_); TRRD(S##h0, b_ + 2048); TRRD(S##l1, b_ + 4096); TRRD(S##h1, b_ + 6144); TRRD(S##l2, b_ + 8192); TRRD(S##h2, b_ + 10240); TRRD(S##l3, b_ + 12288); TRRD(S##h3, b_ + 14336); } while (0)
#define PV_MM(S, d0) do { \
        o[d0] = __builtin_amdgcn_mfma_f32_32x32x16_bf16(pa0, (bf16x8){S##l0[0], S##l0[1], S##l0[2], S##l0[3], S##h0[0], S##h0[1], S##h0[2], S##h0[3]}, o[d0], 0, 0, 0);   \
        o[d0] = __builtin_amdgcn_mfma_f32_32x32x16_bf16(pa1, (bf16x8){S##l1[0], S##l1[1], S##l1[2], S##l1[3], S##h1[0], S##h1[1], S##h1[2], S##h1[3]}, o[d0], 0, 0, 0);   \
        o[d0] = __builtin_amdgcn_mfma_f32_32x32x16_bf16(pa2, (bf16x8){S##l2[0], S##l2[1], S##l2[2], S##l2[3], S##h2[0], S##h2[1], S##h2[2], S##h2[3]}, o[d0], 0, 0, 0);   \
        o[d0] = __builtin_amdgcn_mfma_f32_32x32x16_bf16(pa3, (bf16x8){S##l3[0], S##l3[1], S##l3[2], S##l3[3], S##h3[0], S##h3[1], S##h3[2], S##h3[3]}, o[d0], 0, 0, 0); } while (0)
    s16x4 Al0, Al1, Al2, Al3, Ah0, Ah1, Ah2, Ah3, Bl0, Bl1, Bl2, Bl3, Bh0, Bh1, Bh2, Bh3;
    PV_RD(A, 0); PV_RD(B, 1);
    asm volatile("s_waitcnt lgkmcnt(8)" ::: "memory"); SBAR(); PV_MM(A, 0); SBAR();
    PV_RD(A, 2);
    asm volatile("s_waitcnt lgkmcnt(8)" ::: "memory"); SBAR(); PV_MM(B, 1); SBAR();
    PV_RD(B, 3);
    asm volatile("s_waitcnt lgkmcnt(8)" ::: "memory"); SBAR(); PV_MM(A, 2); SBAR();
    asm volatile("s_waitcnt lgkmcnt(0)" ::: "memory"); SBAR(); PV_MM(B, 3);
#undef PV_RD
#undef PV_MM
#undef TRRD
}

template <class Cfg>
__device__ __forceinline__ void attn_tiles(const Cfg& c, LAS char* lds, const bf16x8 (&qr)[8], f32x16 (&o)[4], float& m_reg, float& l_reg, const int t_lo, const int t_hi, const int wv) {
    const int tid = opq_tid(wv), lane = tid & 63, wid = __builtin_amdgcn_readfirstlane(tid >> 6), r32 = lane & 31, hi = lane >> 5;
    LAS char* V_lds = lds + L_V; LAS char* K_lds = lds + L_K;
    LAS float* al_l = (LAS float*)(lds + L_WS) + wid * 64 + 32;
    const int sr = tid >> 4, sc = (tid & 15) * 8;
    const int vst0 = v_st(sr, sc), vst1 = v_st(32 + sr, sc), kws = KSWZ(sr, sc * 2);
    const int vb0 = (int)(unsigned)(uintptr_t)V_lds + v_rd_base(lane);
    bf16x8 sk0, sk1, sv0, sv1;
    const bf16_t *gk0 = nullptr, *gk1 = nullptr, *gv0 = nullptr, *gv1 = nullptr;
#define AT_LOAD(t) do { gk0 = c.krow((t), sr) + sc; gk1 = c.krow((t), sr + 32) + sc; sk0 = *(const bf16x8*)gk0; sk1 = *(const bf16x8*)gk1; \
        if constexpr (Cfg::MODE == 0) { gv0 = c.vrow((t), sr) + sc; gv1 = c.vrow((t), sr + 32) + sc; sv0 = *(const bf16x8*)gv0; sv1 = *(const bf16x8*)gv1; } \
        asm volatile("" ::: "memory"); SBAR(); } while (0)
#define AT_WRITE(t, bf) do { asm volatile("" :: "v"(gk0), "v"(gk1), "v"(gv0), "v"(gv1)); *(LAS bf16x8*)(K_lds + (bf) * SHM_K + kws) = sk0; *(LAS bf16x8*)(K_lds + (bf) * SHM_K + kws + 32 * 256) = sk1; \
        if constexpr (Cfg::MODE == 1) { \
            _Pragma("unroll") for (int i_ = 0; i_ < 8; ++i_) { const int n_ = sc + i_, c0_ = 64 * (t) + sr, c1_ = c0_ + 32; \
                sv0[i_] = (c0_ >= 4 * n_ - 1 && c0_ <= 4 * n_ + 3) ? (short)0x3F80 : (short)0; sv1[i_] = (c1_ >= 4 * n_ - 1 && c1_ <= 4 * n_ + 3) ? (short)0x3F80 : (short)0; } } \
        *(LAS bf16x8*)(V_lds + (bf) * SHM_V + vst0) = sv0; *(LAS bf16x8*)(V_lds + (bf) * SHM_V + vst1) = sv1; } while (0)
    __builtin_amdgcn_s_waitcnt(0x0F70);
    __syncthreads();
    if (t_lo < t_hi) { AT_LOAD(t_lo); AT_WRITE(t_lo, 0); }
    __syncthreads();
    for (int t = t_lo; t < t_hi; ++t) {
        const int buf = (t - t_lo) & 1; const bool more = (t + 1 < t_hi);
        if (more) AT_LOAD(t + 1);
        if (c.active(t)) {
            f32x16 p0, p1;
            qkt(p0, p1, K_lds + buf * SHM_K, r32, hi, qr);
            if constexpr (Cfg::MODE == 0) {
                float mn, alpha; bf16x8 pa0, pa1, pa2, pa3;
                bool rok; float rbias;
                if (c.rowconst(t, rok, rbias)) partialSM_row(p0, p1, m_reg, mn, alpha, rok, rbias);
                else { c.mask(p0, p1, t); partialSM(p0, p1, m_reg, mn, alpha); }
                if (__any(alpha < 1.f)) { if (hi == 0) al_l[r32] = alpha; LDS_WAIT();
#pragma unroll
                    for (int d_ = 0; d_ < 4; ++d_)
#pragma unroll
                        for (int r = 0; r < 16; ++r) o[d_][r] *= al_l[crow(r, hi)]; }
                finishSM(p0, p1, alpha, l_reg, pa0, pa1, pa2, pa3); SBAR();
                pv_tile(o, vb0 + buf * SHM_V, pa0, pa1, pa2, pa3);
            } else {
                c.mask(p0, p1, t);
                const float mL = -c.mfix * LOG2E; const float il = c.invl;
#pragma unroll
                for (int r = 0; r < 16; ++r) { p0[r] = __builtin_amdgcn_exp2f(p0[r] + mL) * il; p1[r] = __builtin_amdgcn_exp2f(p1[r] + mL) * il; }
                bf16x8 pa0, pa1, pa2, pa3;
                PK4(p0, 0, pa0); PK4(p0, 8, pa1); PK4(p1, 0, pa2); PK4(p1, 8, pa3); SBAR();
                pv_tile(o, vb0 + buf * SHM_V, pa0, pa1, pa2, pa3);
#pragma unroll
                for (int r = 0; r < 16; r += 2) { const unsigned a = cvtpk(p0[r], p0[r + 1]), b = cvtpk(p1[r], p1[r + 1]);
                    p0[r] -= bflo(a); p0[r + 1] -= bfhi(a); p1[r] -= bflo(b); p1[r + 1] -= bfhi(b); }
                PK4(p0, 0, pa0); PK4(p0, 8, pa1); PK4(p1, 0, pa2); PK4(p1, 8, pa3); SBAR();
                pv_tile(o, vb0 + buf * SHM_V, pa0, pa1, pa2, pa3);
            }
        }
        if (more) AT_WRITE(t + 1, buf ^ 1);
        __syncthreads();
    }
#undef AT_LOAD
#undef AT_WRITE
}

template <class Cfg>
__device__ __forceinline__ void attn_tiles_s(const Cfg& c, LAS char* lds, const bf16x8 (&qr)[8], f32x16 (&o)[4], float& m_reg, float& l_reg, const int t_lo, const int t_hi, const int wv) {
    static_assert(Cfg::MODE == 0, "fixed-shift softmax tiles only");
    (void)m_reg;
    const int tid = opq_tid(wv), lane = tid & 63, wid = __builtin_amdgcn_readfirstlane(tid >> 6), r32 = lane & 31, hi = lane >> 5;
    LAS char* V_lds = lds + L_V; LAS char* K_lds = lds + L_K;
    const int sr = tid >> 4, sc = (tid & 15) * 8;
    const int vst0 = v_st(sr, sc), vst1 = v_st(32 + sr, sc), kws = KSWZ(sr, sc * 2);
    const int vb0 = (int)(unsigned)(uintptr_t)V_lds + v_rd_base(lane);
    bf16x8 sk0, sk1, sv0, sv1, pa0, pa1, pa2, pa3;
    const bf16_t *gk0 = nullptr, *gk1 = nullptr, *gv0 = nullptr, *gv1 = nullptr;
#define AS_LOAD(t) do { gk0 = c.krow((t), sr) + sc; gk1 = c.krow((t), sr + 32) + sc; sk0 = *(const bf16x8*)gk0; sk1 = *(const bf16x8*)gk1; \
        gv0 = c.vrow((t), sr) + sc; gv1 = c.vrow((t), sr + 32) + sc; sv0 = *(const bf16x8*)gv0; sv1 = *(const bf16x8*)gv1; asm volatile("" ::: "memory"); SBAR(); } while (0)
#define AS_WRITE(kbf, vbf) do { asm volatile("" :: "v"(gk0), "v"(gk1), "v"(gv0), "v"(gv1)); *(LAS bf16x8*)(K_lds + (kbf) * SHM_K + kws) = sk0; *(LAS bf16x8*)(K_lds + (kbf) * SHM_K + kws + 32 * 256) = sk1; \
        *(LAS bf16x8*)(V_lds + (vbf) * SHM_V + vst0) = sv0; *(LAS bf16x8*)(V_lds + (vbf) * SHM_V + vst1) = sv1; } while (0)
#define AS_SCORE(t, kbf) do { f32x16 p0, p1; float mz_ = 0.f, mn_, al_; bool rok_; float rb_; \
        qkt(p0, p1, K_lds + (kbf) * SHM_K, r32, hi, qr); \
        if (c.rowconst((t), rok_, rb_)) partialSM_row(p0, p1, mz_, mn_, al_, rok_, rb_); else { c.mask(p0, p1, (t)); partialSM(p0, p1, mz_, mn_, al_); } \
        finishSM(p0, p1, 1.f, l_reg, pa0, pa1, pa2, pa3); SBAR(); } while (0)
    if (t_lo >= t_hi) return;
    __builtin_amdgcn_s_waitcnt(0x0F70);
    __syncthreads();
    AS_LOAD(t_lo); AS_WRITE(0, 0);
    __syncthreads();
    int kb = 0, vb = 0;
    if (wid < 4) {
        for (int t = t_lo; t < t_hi; ++t) {
            const bool more = (t + 1 < t_hi); const int vn = (vb == 2) ? 0 : vb + 1;
            if (more) AS_LOAD(t + 1);
            if (c.active(t)) { AS_SCORE(t, kb); pv_tile(o, vb0 + vb * SHM_V, pa0, pa1, pa2, pa3); }
            if (more) AS_WRITE(kb ^ 1, vn);
            __syncthreads();
            kb ^= 1; vb = vn;
        }
    } else {
        bool pend = false; int vp = 0;
        for (int t = t_lo; t < t_hi; ++t) {
            const bool more = (t + 1 < t_hi); const int vn = (vb == 2) ? 0 : vb + 1;
            if (more) AS_LOAD(t + 1);
            if (pend) pv_tile(o, vb0 + vp * SHM_V, pa0, pa1, pa2, pa3);
            const bool act = c.active(t);
            if (act) AS_SCORE(t, kb);
            pend = act; vp = vb;
            if (more) AS_WRITE(kb ^ 1, vn);
            __syncthreads();
            kb ^= 1; vb = vn;
        }
        if (pend) pv_tile(o, vb0 + vp * SHM_V, pa0, pa1, pa2, pa3);
    }
#undef AS_LOAD
#undef AS_WRITE
#undef AS_SCORE
}

struct DilCfg {
    static constexpr int MODE = 0;
    const bf16_t* Kb; const bf16_t* Vb;
    const LAS float* tbl; int dshift, res, u, dqm, s0;
    __device__ __forceinline__ const bf16_t* krow(int t, int kk) const { int s = 256 * u - 128 + 64 * t + kk; s = s < 0 ? 0 : s; return Kb + (size_t)((s << dshift) + res) * PC; }
    __device__ __forceinline__ const bf16_t* vrow(int t, int kk) const { int s = 256 * u - 128 + 64 * t + kk; s = s < 0 ? 0 : s; return Vb + (size_t)((s << dshift) + res) * PC; }
    __device__ __forceinline__ bool active(int t) const { const int kb = 256 * u - 128 + 64 * t; return kb <= s0 + 31 && kb + 63 >= s0 - 128; }
    __device__ __forceinline__ bool rowconst(int, bool&, float&) const { return false; }
    __device__ __forceinline__ void mask(f32x16& p0, f32x16& p1, int t) const {
        const int dq = dqm - (256 * u - 128 + 64 * t);
        const LAS float* tb = tbl + (DT0 + dq - 63);
        float bb0[16], bb1[16];
#pragma unroll
        for (int r = 0; r < 16; ++r) { const int cc = (r & 3) + 8 * (r >> 2); bb0[r] = tb[63 - cc]; bb1[r] = tb[31 - cc]; }
#pragma unroll
        for (int r = 0; r < 16; ++r) asm volatile("" : "+v"(bb0[r]), "+v"(bb1[r]));
#pragma unroll
        for (int r = 0; r < 16; ++r) { p0[r] = p0[r] + bb0[r]; p1[r] = p1[r] + bb1[r]; }
    }
};
struct CmpCfg {
    static constexpr int MODE = 0;
    const bf16_t* Kb; const bf16_t* Vb; int cmax, hi4, cfull;
    __device__ __forceinline__ bool rowconst(int t, bool& ok, float& bias) const { ok = true; bias = 0.f; return 64 * t + 63 <= cfull; }
    __device__ __forceinline__ const bf16_t* krow(int t, int kk) const { return Kb + (size_t)(64 * t + kk) * HD; }
    __device__ __forceinline__ const bf16_t* vrow(int t, int kk) const { return Vb + (size_t)(64 * t + kk) * HD; }
    __device__ __forceinline__ bool active(int) const { return true; }
    __device__ __forceinline__ void mask(f32x16& p0, f32x16& p1, int t) const {
        const int cb = 64 * t + hi4; const float NEG = -__builtin_inff();
#pragma unroll
        for (int r = 0; r < 16; ++r) { const int cc = cb + (r & 3) + 8 * (r >> 2); if (cc > cmax) p0[r] = NEG; if (cc + 32 > cmax) p1[r] = NEG; }
    }
};
struct CmpImpCfg {
    static constexpr int MODE = 1;
    const bf16_t* Kb; int cmax, hi4; float mfix, invl;
    __device__ __forceinline__ const bf16_t* krow(int t, int kk) const { return Kb + (size_t)(64 * t + kk) * HD; }
    __device__ __forceinline__ const bf16_t* vrow(int, int) const { return Kb; }
    __device__ __forceinline__ bool active(int) const { return true; }
    __device__ __forceinline__ void mask(f32x16& p0, f32x16& p1, int t) const {
        const int cb = 64 * t + hi4; const float NEG = -__builtin_inff();
#pragma unroll
        for (int r = 0; r < 16; ++r) { const int cc = cb + (r & 3) + 8 * (r >> 2); if (cc > cmax) p0[r] = NEG; if (cc + 32 > cmax) p1[r] = NEG; }
    }
};
struct SlcCfg {
    static constexpr int MODE = 0;
    const bf16_t* Kb; const bf16_t* Vb;
    const LAS float* tblh;
    const LAS float* negt;
    unsigned s0, s1, s2, s3; int tqm, cur; float b31;
    __device__ __forceinline__ const bf16_t* krow(int t, int kk) const { return Kb + (size_t)(64 * t + kk) * PC; }
    __device__ __forceinline__ const bf16_t* vrow(int t, int kk) const { return Vb + (size_t)(64 * t + kk) * PC; }
    __device__ __forceinline__ bool selbit(int t) const { const unsigned q = (unsigned)t >> 5; const unsigned w = (q == 0u ? s0 + 0u : 0u) | (q == 1u ? s1 + 0u : 0u) | (q == 2u ? s2 + 0u : 0u) | (q == 3u ? s3 + 0u : 0u); return (w >> (t & 31)) & 1u; }
    __device__ __forceinline__ bool active(int t) const { return __any(selbit(t)); }
    __device__ __forceinline__ bool rowconst(int t, bool& ok, float& bias) const { ok = selbit(t); bias = b31; return 64 * (cur - t) - 63 >= 1513; }
    __device__ __forceinline__ void mask(f32x16& p0, f32x16& p1, int t) const {
        const bool sel = selbit(t); const int dq = tqm - 64 * t;
        const LAS float* tsel = tblh + (TBL0 + dq - 63); const LAS float* tb = sel ? tsel + 0 : negt + 0;
        float bb0[16], bb1[16];
#pragma unroll
        for (int r = 0; r < 16; ++r) { const int cc = (r & 3) + 8 * (r >> 2); bb0[r] = tb[63 - cc]; bb1[r] = tb[31 - cc]; }
#pragma unroll
        for (int r = 0; r < 16; ++r) asm volatile("" : "+v"(bb0[r]), "+v"(bb1[r]));
#pragma unroll
        for (int r = 0; r < 16; ++r) { p0[r] = p0[r] + bb0[r]; p1[r] = p1[r] + bb1[r]; }
    }
};
struct WinCfg {
    static constexpr int MODE = 0;
    const bf16_t* Kb; const bf16_t* Vb; const LAS float* tblh; const LAS float* tblw; int tqm, cur;
    __device__ __forceinline__ bool rowconst(int, bool&, float&) const { return false; }
    __device__ __forceinline__ const bf16_t* krow(int t, int kk) const { return Kb + (size_t)(64 * t + kk) * PC; }
    __device__ __forceinline__ const bf16_t* vrow(int t, int kk) const { return Vb + (size_t)(64 * t + kk) * PC; }
    __device__ __forceinline__ bool active(int) const { return true; }
    __device__ __forceinline__ void mask(f32x16& p0, f32x16& p1, int t) const {
        const int dq = tqm - 64 * t;
        const LAS float* ta = tblh + (TBL0 + dq - 63); const LAS float* tw = tblw + (dq - 63 - 440);
        const LAS float* tb = (t + 8 <= cur) ? tw + 0 : ta + 0;
        float bb0[16], bb1[16];
#pragma unroll
        for (int r = 0; r < 16; ++r) { const int cc = (r & 3) + 8 * (r >> 2); bb0[r] = tb[63 - cc]; bb1[r] = tb[31 - cc]; }
#pragma unroll
        for (int r = 0; r < 16; ++r) asm volatile("" : "+v"(bb0[r]), "+v"(bb1[r]));
#pragma unroll
        for (int r = 0; r < 16; ++r) { p0[r] = p0[r] + bb0[r]; p1[r] = p1[r] + bb1[r]; }
    }
};
template <class Cfg>
__device__ __forceinline__ void imp_tiles(const Cfg& c, LAS char* lds, const bf16x8 (&qr)[8], const int ntc, const int wv) {
    const int tid = opq_tid(wv), lane = tid & 63, wid = __builtin_amdgcn_readfirstlane(tid >> 6), r32 = lane & 31, hi = lane >> 5;
    LAS char* K_lds = lds + L_K;
    const int sr = tid >> 4, sc = (tid & 15) * 8;
    const int kws = KSWZ(sr, sc * 2);
    bf16x8 sk0, sk1; const bf16_t *gk0 = nullptr, *gk1 = nullptr;
#define IT_LOAD(t) do { gk0 = c.krow((t), sr) + sc; gk1 = c.krow((t), sr + 32) + sc; sk0 = *(const bf16x8*)gk0; sk1 = *(const bf16x8*)gk1; asm volatile("" ::: "memory"); SBAR(); } while (0)
#define IT_WRITE(bf) do { asm volatile("" :: "v"(gk0), "v"(gk1)); *(LAS bf16x8*)(K_lds + (bf) * SHM_K + kws) = sk0; *(LAS bf16x8*)(K_lds + (bf) * SHM_K + kws + 32 * 256) = sk1; } while (0)
#define IT_BLOCK(P, k, aval, dst) do { float g_ = (P[4 * (k)] + P[4 * (k) + 1]) + (P[4 * (k) + 2] + P[4 * (k) + 3]); \
        auto rr_ = __builtin_amdgcn_permlane32_swap(__float_as_uint(aval), __float_as_uint(P[4 * (k) + 3]), false, false); \
        g_ = (g_ + __uint_as_float(hi ? rr_[0] : rr_[1])) * il; \
        g_ += __int_as_float(__builtin_amdgcn_update_dpp(0, __float_as_int(g_), 0xB1, 0xF, 0xF, true)); g_ += __int_as_float(__builtin_amdgcn_update_dpp(0, __float_as_int(g_), 0x4E, 0xF, 0xF, true)); \
        if ((r32 & 3) == 0) irow[(dst)] = g_; } while (0)
    __builtin_amdgcn_s_waitcnt(0x0F70);
    __syncthreads();
    IT_LOAD(0); IT_WRITE(0);
    __syncthreads();
    float carry = 0.f;
    const float mL = -c.mfix * LOG2E, il = c.invl;
    LAS float* irow = (LAS float*)(lds + L_IMP) + (8 * wid + (r32 >> 2)) * 128 + hi;
    for (int t = 0; t < ntc; ++t) {
        const int buf = t & 1; const bool more = (t + 1 < ntc);
        if (more) IT_LOAD(t + 1);
        f32x16 p0, p1;
        qkt(p0, p1, K_lds + buf * SHM_K, r32, hi, qr);
        c.mask(p0, p1, t);
#pragma unroll
        for (int r = 0; r < 16; ++r) { p0[r] = __builtin_amdgcn_exp2f(p0[r] + mL); p1[r] = __builtin_amdgcn_exp2f(p1[r] + mL); }
        IT_BLOCK(p0, 0, carry, 16 * t + 0); IT_BLOCK(p0, 1, p0[3], 16 * t + 2); IT_BLOCK(p0, 2, p0[7], 16 * t + 4); IT_BLOCK(p0, 3, p0[11], 16 * t + 6);
        IT_BLOCK(p1, 0, p0[15], 16 * t + 8); IT_BLOCK(p1, 1, p1[3], 16 * t + 10); IT_BLOCK(p1, 2, p1[7], 16 * t + 12); IT_BLOCK(p1, 3, p1[11], 16 * t + 14);
        carry = p1[15];
        if (more) IT_WRITE(buf ^ 1);
        __syncthreads();
    }
#undef IT_LOAD
#undef IT_WRITE
#undef IT_BLOCK
}

}

__device__ __forceinline__ void load_q_normed(const bf16_t* qp  , const float* gain  , bf16x8 (&qr)[8]) {
    u32x4 raw[8];
#pragma unroll
    for (int d0 = 0; d0 < 8; ++d0) raw[d0] = *(const u32x4*)(qp + d0 * 16);
    float ss = 0.f;
#pragma unroll
    for (int d0 = 0; d0 < 8; ++d0) { const u32x4 w = raw[d0]; const float a0 = bflo(w.x), a1 = bfhi(w.x), a2 = bflo(w.y), a3 = bfhi(w.y), a4 = bflo(w.z), a5 = bfhi(w.z), a6 = bflo(w.w), a7 = bfhi(w.w);
        ss += ((a0 * a0 + a1 * a1) + (a2 * a2 + a3 * a3)) + ((a4 * a4 + a5 * a5) + (a6 * a6 + a7 * a7)); }
    { auto rr = __builtin_amdgcn_permlane32_swap(__float_as_uint(ss), __float_as_uint(ss), false, false); ss = __uint_as_float(rr[0]) + __uint_as_float(rr[1]); }
    const float rs = (QSCALE * LOG2E) / sqrtf(ss * (1.f / HD) + EPS);
#pragma unroll
    for (int d0 = 0; d0 < 8; ++d0) { const u32x4 w = raw[d0]; const f32x4 g0 = *(const f32x4*)(gain + d0 * 16), g1 = *(const f32x4*)(gain + d0 * 16 + 4);
        u32x4 o; o.x = cvtpk(bflo(w.x) * rs * g0.x, bfhi(w.x) * rs * g0.y); o.y = cvtpk(bflo(w.y) * rs * g0.z, bfhi(w.y) * rs * g0.w);
        o.z = cvtpk(bflo(w.z) * rs * g1.x, bfhi(w.z) * rs * g1.y); o.w = cvtpk(bflo(w.w) * rs * g1.z, bfhi(w.w) * rs * g1.w);
        qr[d0] = *reinterpret_cast<bf16x8*>(&o); }
}

__device__ __forceinline__ void dil_tiles(const att::DilCfg& c, LAS char* lds, const bf16x8 (&qr)[8], f32x16 (&o)[4], float& l_reg, const int wv) {
    using namespace att;
    const int tid = opq_tid(wv), lane = tid & 63, wid = __builtin_amdgcn_readfirstlane(tid >> 6), r32 = lane & 31, hi = lane >> 5;
    LAS char* V_lds = lds + L_V; LAS char* K_lds = lds + L_K;
    const int sr = tid >> 4, sc = (tid & 15) * 8;
    const int vst0 = v_st(sr, sc), vst1 = v_st(32 + sr, sc), kws = KSWZ(sr, sc * 2);
    const int vb0 = (int)(unsigned)(uintptr_t)V_lds + v_rd_base(lane);
    bf16x8 sk0, sk1, sv0, sv1;
    const bf16_t *gk0 = nullptr, *gk1 = nullptr, *gv0 = nullptr, *gv1 = nullptr;
#define DT_LOAD(t) do { gk0 = c.krow((t), sr) + sc; gk1 = c.krow((t), sr + 32) + sc; sk0 = *(const bf16x8*)gk0; sk1 = *(const bf16x8*)gk1; \
        gv0 = c.vrow((t), sr) + sc; gv1 = c.vrow((t), sr + 32) + sc; sv0 = *(const bf16x8*)gv0; sv1 = *(const bf16x8*)gv1; asm volatile("" ::: "memory"); SBAR(); } while (0)
#define DT_WRITE(slot) do { asm volatile("" :: "v"(gk0), "v"(gk1), "v"(gv0), "v"(gv1)); *(LAS bf16x8*)(K_lds + (slot) * SHM_K + kws) = sk0; *(LAS bf16x8*)(K_lds + (slot) * SHM_K + kws + 32 * 256) = sk1; \
        *(LAS bf16x8*)(V_lds + (slot) * SHM_V + vst0) = sv0; *(LAS bf16x8*)(V_lds + (slot) * SHM_V + vst1) = sv1; } while (0)
#define DT_COMP(t, slot) do { f32x16 p0, p1; float mz_ = 0.f, mn_, al_; bf16x8 pa0, pa1, pa2, pa3; \
        qkt(p0, p1, K_lds + (slot) * SHM_K, r32, hi, qr); c.mask(p0, p1, (t)); partialSM(p0, p1, mz_, mn_, al_); \
        finishSM(p0, p1, 1.f, l_reg, pa0, pa1, pa2, pa3); SBAR(); pv_tile(o, vb0 + (slot) * SHM_V, pa0, pa1, pa2, pa3); } while (0)
    const bool first = (c.u == 0);
    __builtin_amdgcn_s_waitcnt(0x0F70);
    __syncthreads();
    if (!first) { DT_LOAD(1); DT_WRITE(0); }
    DT_LOAD(4); DT_WRITE(1);
    __syncthreads();
    DT_LOAD(2);
    if (wid < 4) { if (!first) DT_COMP(1, 0); } else DT_COMP(4, 1);
    DT_WRITE(2);
    __syncthreads();
    DT_LOAD(3);
    if (wid < 6) DT_COMP(2, 2);
    DT_WRITE(0);
    __syncthreads();
    DT_LOAD(5);
    if (wid >= 2) DT_COMP(3, 0);
    DT_WRITE(1);
    if (!first) { DT_LOAD(0); DT_WRITE(2); }
    __syncthreads();
    if (wid < 2) { if (!first) DT_COMP(0, 2); } else if (wid >= 6) DT_COMP(5, 1);
#undef DT_LOAD
#undef DT_WRITE
#undef DT_COMP
}

__device__ __forceinline__ void dil_unit(LAS char* lds, const bf16_t* P, bf16_t* OA, float* LSE, const float* dilT, const float* qgain, int pat, int dshift, int unit, const int wv) {
    using namespace att;
    const int tid = opq_tid(wv), lane = tid & 63, wid = __builtin_amdgcn_readfirstlane(tid >> 6), r32 = lane & 31, hi = lane >> 5;
    const int bh = unit >> 5, ru = unit & 31, b = bh >> 3, h = bh & 7;
    const int ncs = 5 - dshift, res = ru >> ncs, u = ru & ((1 << ncs) - 1);
    LAS float* tbl = (LAS float*)(lds + L_TBL);
    __syncthreads();
    if (tid < DTS) tbl[tid] = dilT[(pat * 8 + h) * DTS + tid];
    const int s0 = 256 * u + 32 * wid, s_row = s0 + r32;
    const size_t tokrow = (size_t)b * SEQ + (size_t)((s_row << dshift) + res);
    bf16x8 qr[8];
    load_q_normed(P + tokrow * PC + C_QA + h * HD + hi * 8, qgain + hi * 8, qr);
    f32x16 o[4]; float m_reg, l_reg;
    m_reg = 0.f;
    if (pat == 0) { l_reg = 0.f;
#pragma unroll
        for (int d0 = 0; d0 < 4; ++d0) o[d0] = f32x16{}; }
    else { l_reg = LSE[tokrow * 8 + h];
#pragma unroll
        for (int r = 0; r < 16; ++r) { const size_t tr = (size_t)b * SEQ + (size_t)(((s0 + crow(r, hi)) << dshift) + res); const bf16_t* op = OA + tr * 1024 + h * HD + 4 * r32;
            { const u32x2 w = *(const u32x2*)op; o[0][r] = bflo(w.x); o[1][r] = bfhi(w.x); o[2][r] = bflo(w.y); o[3][r] = bfhi(w.y); } } }
    DilCfg c; c.Kb = P + (size_t)b * SEQ * PC + C_KA + h * HD; c.Vb = P + (size_t)b * SEQ * PC + C_VA + h * HD; c.tbl = tbl; c.dshift = dshift; c.res = res; c.u = u; c.dqm = s_row - 4 * hi; c.s0 = s0;
    dil_tiles(c, lds, qr, o, l_reg, wv);
    LAS float* li_l = (LAS float*)(lds + L_WS) + wid * 64;
    if (hi == 0) { li_l[r32] = l_reg; LSE[tokrow * 8 + h] = l_reg; }
    LDS_WAIT();
#pragma unroll
    for (int r = 0; r < 16; ++r) { const int orow = crow(r, hi); const float rl = (pat == 2) ? 1.0f / li_l[orow] : 1.0f;
        const size_t tr = (size_t)b * SEQ + (size_t)(((s0 + orow) << dshift) + res); bf16_t* op = OA + tr * 1024 + h * HD;
        { u32x2 w; w.x = cvtpk(o[0][r] * rl, o[1][r] * rl); w.y = cvtpk(o[2][r] * rl, o[3][r] * rl); *(u32x2*)(op + 4 * r32) = w; } }
}

__device__ __forceinline__ void nsa_finalize(LAS char* lds, const f32x16 (&o)[4], float l_reg, bf16_t* ON, int b, int g, int tok0, int br, const int wv) {
    using namespace att;
    const int tid = opq_tid(wv), lane = tid & 63, wid = __builtin_amdgcn_readfirstlane(tid >> 6), r32 = lane & 31, hi = lane >> 5;
    LAS float* li_l = (LAS float*)(lds + L_WS) + wid * 64;
    if (hi == 0) li_l[r32] = l_reg;
    LDS_WAIT();
    bf16_t* ONb = ON + (size_t)br * NTOK * 1024;
    const LAS float* GT = (const LAS float*)(lds + L_GATE) + (8 * wid + hi) * 12 + br;
#pragma unroll
    for (int r = 0; r < 16; ++r) { const int j = r & 3, k = r >> 2; const float lr = li_l[crow(r, hi)]; const float rl = lr > 0.f ? 1.0f / lr : 0.f;
        const size_t tok = (size_t)b * SEQ + tok0 + 2 * k + hi; const int hh = 4 * g + j;
        const float sc = rl * GT[(2 * k) * 12 + j * 3];
        bf16_t* op = ONb + tok * 1024 + hh * HD;
        { u32x2 w; w.x = cvtpk(o[0][r] * sc, o[1][r] * sc); w.y = cvtpk(o[2][r] * sc, o[3][r] * sc); *(u32x2*)(op + 4 * r32) = w; } }
}
__device__ __forceinline__ void nsa_unit(LAS char* lds, const bf16_t* P, const bf16_t* KC, const bf16_t* VC, bf16_t* ON, const float* nsaT, const float* gb, const float* qgain, int b, int g, int qi, bool load_tbl, const int wv) {
    using namespace att;
    const int tid = opq_tid(wv), lane = tid & 63, wid = __builtin_amdgcn_readfirstlane(tid >> 6), r32 = lane & 31, hi = lane >> 5;
    LAS float* tbl = (LAS float*)(lds + L_TBL); LAS float* IMP = (LAS float*)(lds + L_IMP); LAS unsigned* SELM = (LAS unsigned*)(lds + L_SELM);
    __syncthreads();
    if (load_tbl) for (int i = tid; i < 4 * TBLS; i += NTHR) tbl[i] = nsaT[(size_t)(4 * g) * TBLS + i];
    if (tid < 64) ((LAS float*)(lds + L_NEG))[tid] = -__builtin_inff();
    if (load_tbl) for (int i = tid; i < 4 * 136; i += NTHR) { const int h_ = i / 136, d_ = 440 + i % 136; ((LAS float*)(lds + L_TBLW))[i] = (d_ < 512) ? nsaT[(size_t)(4 * g + h_) * TBLS + TBL0 + d_] : -__builtin_inff(); }
    const int tok0 = 64 * qi + 8 * wid, tq = tok0 + (r32 >> 2), hd = r32 & 3;
    const bf16_t* Pb = P + (size_t)b * SEQ * PC;
    const int gi0 = tid, gi1 = (tid + NTHR < 768) ? tid + NTHR : 767;
    const bf16_t graw0 = Pb[(size_t)(64 * qi + gi0 / 12) * PC + C_GL + 12 * g + gi0 % 12], graw1 = Pb[(size_t)(64 * qi + gi1 / 12) * PC + C_GL + 12 * g + gi1 % 12];
    const float gbb0 = gb[12 * g + gi0 % 12], gbb1 = gb[12 * g + gi1 % 12];
    asm volatile("" ::: "memory"); SBAR();
    bf16x8 qr[8];
    load_q_normed(Pb + (size_t)tq * PC + C_QN + (4 * g + hd) * HD + hi * 8, qgain + hi * 8, qr);
    { LAS float* GTw = (LAS float*)(lds + L_GATE);
      GTw[gi0] = __builtin_amdgcn_rcpf(1.0f + __builtin_amdgcn_exp2f(-(bf2f(graw0) + gbb0) * LOG2E));
      if (tid + NTHR < 768) GTw[gi1] = __builtin_amdgcn_rcpf(1.0f + __builtin_amdgcn_exp2f(-(bf2f(graw1) + gbb1) * LOG2E)); }
    const bf16_t* KCb = KC + (size_t)(b * 2 + g) * 512 * HD; const bf16_t* VCb = VC + (size_t)(b * 2 + g) * 512 * HD;
    const int ntc = (qi >> 4) + 1, cmax = (tq - 31) >> 4;
    f32x16 o[4]; float m_reg, l_reg;
#pragma unroll
    for (int d0 = 0; d0 < 4; ++d0) o[d0] = f32x16{};
    m_reg = 0.f; l_reg = 0.f;
    { CmpCfg c; c.Kb = KCb; c.Vb = VCb; c.cmax = cmax; c.hi4 = 4 * hi; c.cfull = (64 * qi - 31) >> 4; attn_tiles_s(c, lds, qr, o, m_reg, l_reg, 0, ntc, wv); }
    nsa_finalize(lds, o, l_reg, ON, b, g, tok0, 0, wv);
    { CmpImpCfg c; c.Kb = KCb; c.cmax = cmax; c.hi4 = 4 * hi; c.mfix = 0.f; c.invl = l_reg > 0.f ? 1.0f / l_reg : 0.f;
      imp_tiles(c, lds, qr, ntc, wv); }
    { const int cur = qi;
#pragma unroll 1
      for (int t4 = 8 * wid; t4 < 8 * wid + 8; t4 += 4) {
        const int n0 = lane, n1 = 64 + lane;
        unsigned long long b0[4], b1[4];
        if (cur <= 15) {
#pragma unroll
            for (int q = 0; q < 4; ++q) { b0[q] = __ballot(n0 <= cur); b1[q] = 0ull; }
        } else {
            unsigned u0[4], u1[4], T[4];
#pragma unroll
            for (int q = 0; q < 4; ++q) { const float v0 = IMP[(t4 + q) * 128 + n0], v1 = IMP[(t4 + q) * 128 + n1];
                u0[q] = (n0 >= 1 && n0 <= cur - 2) ? __float_as_uint(v0) + 1u : 0u; u1[q] = (n1 <= cur - 2) ? __float_as_uint(v1) + 1u : 0u; T[q] = 0u; }
#pragma unroll 1
            for (int bit = 30; bit >= 0; --bit) {
#pragma unroll
                for (int q = 0; q < 4; ++q) { const unsigned cand = T[q] | (1u << bit);
                    const int cnt = __builtin_popcountll(__ballot(u0[q] >= cand)) + __builtin_popcountll(__ballot(u1[q] >= cand));
                    T[q] = (cnt >= 13) ? cand : T[q]; } }
#pragma unroll
            for (int q = 0; q < 4; ++q) {
                const bool gt0 = u0[q] > T[q], gt1 = u1[q] > T[q];
                const int need = 13 - (__builtin_popcountll(__ballot(gt0)) + __builtin_popcountll(__ballot(gt1)));
                const bool eq0 = (u0[q] == T[q]), eq1 = (u1[q] == T[q]);
                const unsigned long long m0 = __ballot(eq0), m1 = __ballot(eq1);
                const int pre0 = (int)__builtin_amdgcn_mbcnt_hi((unsigned)(m0 >> 32), __builtin_amdgcn_mbcnt_lo((unsigned)m0, 0u));
                const int pre1 = __builtin_popcountll(m0) + (int)__builtin_amdgcn_mbcnt_hi((unsigned)(m1 >> 32), __builtin_amdgcn_mbcnt_lo((unsigned)m1, 0u));
                const bool sel0 = (n0 == 0 || n0 == cur || n0 == cur - 1) || gt0 || (eq0 && pre0 < need);
                const bool sel1 = (n1 == cur || n1 == cur - 1) || gt1 || (eq1 && pre1 < need);
                b0[q] = __ballot(sel0); b1[q] = __ballot(sel1); }
        }
        if (lane == 0) {
#pragma unroll
            for (int q = 0; q < 4; ++q) { SELM[(t4 + q) * 4 + 0] = (unsigned)b0[q]; SELM[(t4 + q) * 4 + 1] = (unsigned)(b0[q] >> 32); SELM[(t4 + q) * 4 + 2] = (unsigned)b1[q]; SELM[(t4 + q) * 4 + 3] = (unsigned)(b1[q] >> 32); } } } }
    __syncthreads();
    int r32s = r32; asm volatile("" : "+v"(r32s));
    { SlcCfg c; c.Kb = Pb + C_KS + g * HD; c.Vb = Pb + C_VS + g * HD; c.tblh = tbl + (r32s & 3) * TBLS; c.negt = (const LAS float*)(lds + L_NEG); c.tqm = tok0 + (r32s >> 2) - 4 * hi; c.cur = qi; c.b31 = tbl[(r32s & 3) * TBLS + TBL0 + 1600];
      const int tl = 8 * wid + (r32s >> 2); c.s0 = SELM[tl * 4 + 0]; c.s1 = SELM[tl * 4 + 1]; c.s2 = SELM[tl * 4 + 2]; c.s3 = SELM[tl * 4 + 3];
#pragma unroll
      for (int d0 = 0; d0 < 4; ++d0) o[d0] = f32x16{};
      m_reg = 0.f; l_reg = 0.f;
      attn_tiles_s(c, lds, qr, o, m_reg, l_reg, 0, qi + 1, wv); }
    nsa_finalize(lds, o, l_reg, ON, b, g, tok0, 1, wv);
    int r32w = r32; asm volatile("" : "+v"(r32w));
    { WinCfg c; c.Kb = Pb + C_KW + g * HD; c.Vb = Pb + C_VW + g * HD; c.tblh = tbl + (r32w & 3) * TBLS; c.tblw = (const LAS float*)(lds + L_TBLW) + (r32w & 3) * 136; c.tqm = tok0 + (r32w >> 2) - 4 * hi; c.cur = qi;
#pragma unroll
      for (int d0 = 0; d0 < 4; ++d0) o[d0] = f32x16{};
      m_reg = 0.f; l_reg = 0.f;
      attn_tiles_s(c, lds, qr, o, m_reg, l_reg, qi >= 8 ? qi - 8 : 0, qi + 1, wv); }
    nsa_finalize(lds, o, l_reg, ON, b, g, tok0, 2, wv);
}

constexpr int LDS_BYTES = 147456;
constexpr int LDS_MISC = 131072;
constexpr int LDS_ARGS = LDS_MISC + 64;
__device__ __forceinline__ unsigned long long arg_u64(LAS unsigned char* lds, int i) {
    const LAS unsigned* p = (const LAS unsigned*)(opq_lds(lds) + LDS_ARGS) + 2 * i;
    const unsigned lo = __builtin_amdgcn_readfirstlane(p[0]), hi = __builtin_amdgcn_readfirstlane(p[1]);
    return ((unsigned long long)hi << 32) | lo;
}
#define GAS __attribute__((address_space(1)))
__device__ __forceinline__ const float* arg_in(LAS unsigned char* lds, int i) { return (const float*)(GAS const float*)arg_u64(lds, i); }
__device__ __forceinline__ float* arg_out(LAS unsigned char* lds) { return (float*)(GAS float*)arg_u64(lds, 24); }
__device__ __forceinline__ unsigned char* arg_ws(LAS unsigned char* lds) { return (unsigned char*)(GAS unsigned char*)arg_u64(lds, 25); }
__device__ __forceinline__ int opq_bx() { int b = blockIdx.x; asm volatile("" : "+s"(b)); return b; }
__device__ __forceinline__ int opq_g() { int b = gridDim.x; asm volatile("" : "+s"(b)); return b; }

__device__ __forceinline__ void ph_prologue(LAS unsigned char* lds, const int wv) {
    lds = opq_lds(lds);
    const int tid = opq_tid(wv), lane = tid & 63, wave = __builtin_amdgcn_readfirstlane(tid >> 6), G = opq_g(), bx = opq_bx();
    const int gw = bx * NWAVES + wave, NGW = G * NWAVES;
    unsigned char* ws = arg_ws(lds);
    LAS float* scr = (LAS float*)(lds + wave * 16384);
    constexpr int I_UP = 32 * 176, I_DN = 88 * 64, I_IN = 32 * 177, I_OUT = 32 * 64, I_C1 = 64 * 16, I_Z = 928;
    constexpr int I_FFN = 2 * I_UP + I_DN, I_LAYER = 2 * I_FFN + I_IN + I_OUT + 2 * I_C1 + I_Z;
#define PRO_DECODE(it_, W_, K_, N_, WT_, mode_, off_, gain_, r_) do { const int l_ = (it_) / I_LAYER; int q_ = (it_) - l_ * I_LAYER; gain_ = nullptr; off_ = 0; mode_ = 0; \
        if (q_ < 2 * I_FFN) { const int half_ = q_ >= I_FFN; q_ -= half_ * I_FFN; \
            if (q_ < 2 * I_UP) { const int w3_ = q_ >= I_UP; q_ -= w3_ * I_UP; W_ = arg_in(lds, w3_ ? (half_ ? I_F2W3 : I_F1W3) : (half_ ? I_F2W1 : I_F1W1)) + (size_t)l_ * DM * DFF; K_ = DM; N_ = DFF; \
                WT_ = (bf16_t*)(ws + WS_WUP + (size_t)(l_ * 2 + half_) * SZ_WUP); mode_ = 1; off_ = w3_ * 128; gain_ = arg_in(lds, half_ ? I_F2N : I_F1N) + (size_t)l_ * DM; } \
            else { q_ -= 2 * I_UP; W_ = arg_in(lds, half_ ? I_F2W2 : I_F1W2) + (size_t)l_ * DFF * DM; K_ = DFF; N_ = DM; WT_ = (bf16_t*)(ws + WS_WDN + (size_t)(l_ * 2 + half_) * SZ_WDN); } } \
        else { q_ -= 2 * I_FFN; \
            if (q_ < I_IN) { W_ = arg_in(lds, I_WIN) + (size_t)l_ * DM * IN_COLS; K_ = DM; N_ = IN_COLS; WT_ = (bf16_t*)(ws + WS_WIN + (size_t)l_ * SZ_WIN); mode_ = 2; gain_ = arg_in(lds, I_MIXN) + (size_t)l_ * DM; } \
            else if (q_ < I_IN + I_OUT) { q_ -= I_IN; W_ = arg_in(lds, I_WOUT) + (size_t)l_ * DM * DM; K_ = DM; N_ = DM; WT_ = (bf16_t*)(ws + WS_WOUT + (size_t)l_ * SZ_WOUT); } \
            else if (q_ < I_IN + I_OUT + 2 * I_C1) { q_ -= I_IN + I_OUT; const int cv_ = q_ >= I_C1; q_ -= cv_ * I_C1; W_ = arg_in(lds, cv_ ? I_CVW1 : I_CKW1) + (size_t)l_ * 4096 * 512; K_ = 4096; N_ = 512; \
                WT_ = (bf16_t*)(ws + WS_WC1 + (size_t)l_ * SZ_WC1); off_ = cv_ * 512; } \
            else { q_ -= I_IN + I_OUT + 2 * I_C1; W_ = nullptr; K_ = 0; N_ = 0; WT_ = (bf16_t*)(ws + WS_WIN + (size_t)l_ * SZ_WIN); } } \
        r_ = q_; } while (0)
#define PRO_ZERO(WT_, r_) do { const int q = (r_) * 64 + lane, kt = q / 1856, rem = q - kt * 1856; u32x4* z = (u32x4*)((WT_) + ((size_t)(22 * 32 + kt) * 256 + 24) * 64) + rem; unsigned zr = 0u; asm volatile("" : "+v"(zr)); *z = (u32x4){zr, zr, zr, zr}; } while (0)
#pragma unroll 1
    for (int it = gw; it < DEPTH * I_LAYER; it += 2 * NGW) {
        const int itb = it + NGW; const bool hasb = itb < DEPTH * I_LAYER;
        const float *Wa, *Wb, *ga, *gb_; int Ka, Na, Kb, Nb, ma, mb, oa, ob, ra, rb; bf16_t *Ta, *Tb;
        PRO_DECODE(it, Wa, Ka, Na, Ta, ma, oa, ga, ra);
        PRO_DECODE((hasb ? itb : it), Wb, Kb, Nb, Tb, mb, ob, gb_, rb);
        f32x4 lda[8], ldb[8]; float gva[8], gvb[8];
        if (Wa) ti_issue(Wa, Ka, Na, ra, lane, ga, lda, gva);
        if (hasb && Wb) ti_issue(Wb, Kb, Nb, rb, lane, gb_, ldb, gvb);
        if (Wa) ti_finish(Ka, Na, Ta, ma, oa, scr, ra, lane, lda, gva); else PRO_ZERO(Ta, ra);
        if (hasb) { if (Wb) ti_finish(Kb, Nb, Tb, mb, ob, scr, rb, lane, ldb, gvb); else PRO_ZERO(Tb, rb); }
    }
#undef PRO_DECODE
#undef PRO_ZERO
    const float* xs = arg_in(lds, I_X); bf16_t* XB = (bf16_t*)(ws + WS_HB); float* SSQ = (float*)(ws + WS_SSQ);
    for (int m = gw; m < NTOK; m += NGW) {
        const f32x4* xr = (const f32x4*)(xs + (size_t)m * DM) + lane; f32x4 v[8]; float s = 0.f;
#pragma unroll
        for (int j = 0; j < 8; ++j) { v[j] = xr[64 * j]; s += (v[j].x * v[j].x + v[j].y * v[j].y) + (v[j].z * v[j].z + v[j].w * v[j].w); }
        s = wave_sum(s, lane);
#pragma unroll
        for (int j = 0; j < 8; ++j) { u32x2 w; w.x = cvtpk(v[j].x, v[j].y); w.y = cvtpk(v[j].z, v[j].w); *(u32x2*)(XB + kt_off(m, 256 * j + 4 * lane, DM)) = w; }
        if (lane < 32) SSQ[(size_t)m * 32 + lane] = (lane == 0) ? s : 0.f;
    }
}
__device__ __forceinline__ float gelu_tanh(float v) { const float u3 = 0.7978845608028654f * (v + 0.044715f * v * v * v); return 0.5f * v * (2.0f - 2.0f / (__expf(2.0f * u3) + 1.0f)); }
__device__ __forceinline__ void ph_cmp2(LAS unsigned char* lds, int l, const int wv) {
    lds = opq_lds(lds);
    const int tid = opq_tid(wv), lane = tid & 63, wave = __builtin_amdgcn_readfirstlane(tid >> 6), G = opq_g(), bx = opq_bx();
    unsigned char* ws = arg_ws(lds); const float* CP = (const float*)(ws + WS_CP);
    LAS float* CH = (LAS float*)lds;
    LAS float* RED = (LAS float*)(lds + 65536);
    const float* knn = arg_in(lds, I_KNN) + l * HD;
    for (int it = bx; it < 256; it += G) {
        const int R0 = it * 32, kv = R0 >> 12, rl0 = R0 & 4095;
        __syncthreads();
#pragma unroll 1
        for (int hb = 0; hb < 2; ++hb) {
            f32x4 pv[4][4];
#pragma unroll
            for (int q = 0; q < 4; ++q) { const int i4 = tid + (hb * 4 + q) * NTHR, rr = i4 >> 7, k4 = (i4 & 127) * 4;
#pragma unroll
                for (int ks = 0; ks < 4; ++ks) pv[q][ks] = *(const f32x4*)(CP + ((size_t)(kv * 4 + ks) * 4096 + rl0 + rr) * 512 + k4); }
            asm volatile("" ::: "memory"); SBAR();
#pragma unroll
            for (int q = 0; q < 4; ++q) { const int i4 = tid + (hb * 4 + q) * NTHR, rr = i4 >> 7, k4 = (i4 & 127) * 4;
                const f32x4 v = (pv[q][0] + pv[q][1]) + (pv[q][2] + pv[q][3]);
                f32x4 o; o.x = gelu_tanh(v.x); o.y = gelu_tanh(v.y); o.z = gelu_tanh(v.z); o.w = gelu_tanh(v.w);
                *(LAS f32x4*)(CH + rr * 512 + k4) = o; } }
        __syncthreads();
        const int n = tid & 127, rq = tid >> 7;
        const float* w2 = arg_in(lds, kv ? I_CVW2 : I_CKW2) + (size_t)l * 512 * HD + n;
        float acc[8];
#pragma unroll
        for (int i = 0; i < 8; ++i) acc[i] = 0.f;
#pragma unroll 4
        for (int k = 0; k < 512; k += 4) { const float w0 = w2[(size_t)k * HD], w1 = w2[(size_t)(k + 1) * HD], w2v = w2[(size_t)(k + 2) * HD], w3 = w2[(size_t)(k + 3) * HD];
#pragma unroll
            for (int i = 0; i < 8; ++i) { const f32x4 c = *(const LAS f32x4*)(CH + (rq * 8 + i) * 512 + k); acc[i] += (c.x * w0 + c.y * w1) + (c.z * w2v + c.w * w3); } }
        if (kv == 0) {
            float ss[8];
#pragma unroll
            for (int i = 0; i < 8; ++i) ss[i] = wave_sum(acc[i] * acc[i], lane);
            if (lane == 0) {
#pragma unroll
                for (int i = 0; i < 8; ++i) RED[wave * 8 + i] = ss[i]; }
            __syncthreads();
            const float gn = knn[n];
#pragma unroll
            for (int i = 0; i < 8; ++i) { const float tot = RED[(2 * rq) * 8 + i] + RED[(2 * rq + 1) * 8 + i]; acc[i] = acc[i] / sqrtf(tot * (1.f / HD) + EPS) * gn; }
        }
        bf16_t* dst = (bf16_t*)(ws + (kv ? WS_VC + 0 : WS_KC + 0)) + (size_t)(rl0 + rq * 8) * HD + (kv ? 32 * (n & 3) + (n >> 2) : n);
#pragma unroll
        for (int i = 0; i < 8; ++i) dst[(size_t)i * HD] = (bf16_t)f2bf(acc[i]);
    }
}
__device__ __forceinline__ void ph_outnorm(LAS unsigned char* lds, int l, const int wv) {
    lds = opq_lds(lds);
    const int tid = opq_tid(wv), lane = tid & 63, wave = __builtin_amdgcn_readfirstlane(tid >> 6), G = opq_g(), bx = opq_bx();
    const int gw = bx * NWAVES + wave, NGW = G * NWAVES;
    unsigned char* ws = arg_ws(lds); const bf16_t* OA = (const bf16_t*)(ws + WS_OA); const bf16_t* ON = (const bf16_t*)(ws + WS_ON); bf16_t* HB = (bf16_t*)(ws + WS_HP);
    const float* gn = arg_in(lds, I_ON) + (size_t)l * DM;
    const f32x4 ga0 = *(const f32x4*)(gn + lane * 8), ga1 = *(const f32x4*)(gn + lane * 8 + 4), ga2 = *(const f32x4*)(gn + 512 + lane * 8), ga3 = *(const f32x4*)(gn + 512 + lane * 8 + 4);
    const f32x4 gb0 = *(const f32x4*)(gn + 1024 + lane * 8), gb1 = *(const f32x4*)(gn + 1024 + lane * 8 + 4), gb2 = *(const f32x4*)(gn + 1536 + lane * 8), gb3 = *(const f32x4*)(gn + 1536 + lane * 8 + 4);
    bf16_t* y = HB;
    for (int m0 = gw; m0 < NTOK; m0 += 2 * NGW) {
        u32x4 wab[2][2], wn[2][6];
#pragma unroll
        for (int q = 0; q < 2; ++q) { const int mq = m0 + q * NGW; const size_t mc = (size_t)(mq < NTOK ? mq : NTOK - 1);
            const bf16_t* oa = OA + mc * 1024; wab[q][0] = *(const u32x4*)(oa + lane * 8); wab[q][1] = *(const u32x4*)(oa + 512 + lane * 8);
#pragma unroll
            for (int br = 0; br < 3; ++br) { const bf16_t* onb = ON + ((size_t)br * NTOK + mc) * 1024; wn[q][2 * br] = *(const u32x4*)(onb + lane * 8); wn[q][2 * br + 1] = *(const u32x4*)(onb + 512 + lane * 8); } }
#pragma unroll
        for (int q = 0; q < 2; ++q) asm volatile("" : "+v"(wab[q][0]), "+v"(wab[q][1]), "+v"(wn[q][0]), "+v"(wn[q][1]), "+v"(wn[q][2]), "+v"(wn[q][3]), "+v"(wn[q][4]), "+v"(wn[q][5]));
#pragma unroll
        for (int q = 0; q < 2; ++q) { const int m = m0 + q * NGW; if (m >= NTOK) break;
        const u32x4 wa = wab[q][0], wb = wab[q][1];
        float va[16] = {bflo(wa.x), bfhi(wa.x), bflo(wa.y), bfhi(wa.y), bflo(wa.z), bfhi(wa.z), bflo(wa.w), bfhi(wa.w), bflo(wb.x), bfhi(wb.x), bflo(wb.y), bfhi(wb.y), bflo(wb.z), bfhi(wb.z), bflo(wb.w), bfhi(wb.w)};
        float sa = 0.f;
#pragma unroll
        for (int i = 0; i < 16; ++i) sa += va[i] * va[i];
        float vs[16]; float sn = 0.f;
#pragma unroll
        for (int i = 0; i < 16; ++i) vs[i] = 0.f;
#pragma unroll
        for (int br = 0; br < 3; ++br) { const u32x4 wc = wn[q][2 * br], wd = wn[q][2 * br + 1];
            vs[0] += bflo(wc.x); vs[1] += bfhi(wc.x); vs[2] += bflo(wc.y); vs[3] += bfhi(wc.y); vs[4] += bflo(wc.z); vs[5] += bfhi(wc.z); vs[6] += bflo(wc.w); vs[7] += bfhi(wc.w);
            vs[8] += bflo(wd.x); vs[9] += bfhi(wd.x); vs[10] += bflo(wd.y); vs[11] += bfhi(wd.y); vs[12] += bflo(wd.z); vs[13] += bfhi(wd.z); vs[14] += bflo(wd.w); vs[15] += bfhi(wd.w); }
        const float ra = 1.0f / sqrtf(wave_sum(sa, lane) * (1.f / 1024.f) + EPS);
        { const f32x4 g0 = ga0, g1 = ga1, g2 = ga2, g3 = ga3;
          u32x4 o; o.x = cvtpk(va[0] * ra * g0.x, va[1] * ra * g0.y); o.y = cvtpk(va[2] * ra * g0.z, va[3] * ra * g0.w); o.z = cvtpk(va[4] * ra * g1.x, va[5] * ra * g1.y); o.w = cvtpk(va[6] * ra * g1.z, va[7] * ra * g1.w);
          *(u32x4*)(y + kt_off(m, lane * 8, DM)) = o;
          o.x = cvtpk(va[8] * ra * g2.x, va[9] * ra * g2.y); o.y = cvtpk(va[10] * ra * g2.z, va[11] * ra * g2.w); o.z = cvtpk(va[12] * ra * g3.x, va[13] * ra * g3.y); o.w = cvtpk(va[14] * ra * g3.z, va[15] * ra * g3.w);
          *(u32x4*)(y + kt_off(m, 512 + lane * 8, DM)) = o; }
#pragma unroll
        for (int i = 0; i < 16; ++i) sn += vs[i] * vs[i];
        const float rn = 1.0f / sqrtf(wave_sum(sn, lane) * (1.f / 1024.f) + EPS);
        { const f32x4 g0 = gb0, g1 = gb1, g2a = gb2, g3 = gb3;
          u32x4 o; o.x = cvtpk(vs[0] * rn * g0.x, vs[1] * rn * g0.y); o.y = cvtpk(vs[2] * rn * g0.z, vs[3] * rn * g0.w); o.z = cvtpk(vs[4] * rn * g1.x, vs[5] * rn * g1.y); o.w = cvtpk(vs[6] * rn * g1.z, vs[7] * rn * g1.w);
          *(u32x4*)(y + kt_off(m, 1024 + lane * 8, DM)) = o;
          o.x = cvtpk(vs[8] * rn * g2a.x, vs[9] * rn * g2a.y); o.y = cvtpk(vs[10] * rn * g2a.z, vs[11] * rn * g2a.w); o.z = cvtpk(vs[12] * rn * g3.x, vs[13] * rn * g3.y); o.w = cvtpk(vs[14] * rn * g3.z, vs[15] * rn * g3.w);
          *(u32x4*)(y + kt_off(m, 1536 + lane * 8, DM)) = o; }
        }
    }
}

#define GRID_BAR() do { XcdBarrier bar_; bar_.bar = (unsigned*)(arg_ws(lds) + WS_CTL) + CW_BAR; bar_.x = xb_xcc_id(); bar_.st = (volatile LAS unsigned*)(opq_lds(lds) + LDS_MISC + 32); xcd_barrier(bar_, wv); } while (0)
__global__ void __launch_bounds__(NTHR, 2) mega_fwd(Args a) {
    extern __shared__ __attribute__((aligned(16))) unsigned char lds_raw[];
    LAS unsigned char* lds = (LAS unsigned char*)lds_raw;
    const int wv = __builtin_amdgcn_readfirstlane((int)threadIdx.x >> 6);
    {
        const int tid = threadIdx.x;
        for (int u = tid; u < (LDS_BYTES - LDS_MISC) / 4; u += NTHR) ((LAS unsigned*)(lds + LDS_MISC))[u] = 0u;
        __syncthreads();
        if (tid == 0) { LAS unsigned long long* t = (LAS unsigned long long*)(lds + LDS_ARGS);
#pragma unroll
            for (int i = 0; i < 24; ++i) t[i] = (unsigned long long)(uintptr_t)a.in[i];
            t[24] = (unsigned long long)(uintptr_t)a.out; t[25] = (unsigned long long)(uintptr_t)a.ws; }
        __syncthreads();
    }
    (void)xcd_barrier_post((unsigned*)(arg_ws(lds) + WS_CTL) + CW_BAR, (volatile LAS unsigned*)(lds + LDS_MISC + 32));

    { const int tid = opq_tid(wv), G = opq_g(), bx = opq_bx(); const float* rb = arg_in(lds, I_RB); unsigned char* ws = arg_ws(lds);
      float* dilT = (float*)(ws + WS_TBL); float* nsaT = (float*)(ws + WS_TBL + 65536);
      for (int i = bx * NTHR + tid; i < 3 * 8 * DTS + 8 * TBLS; i += G * NTHR) {
          if (i < 3 * 8 * DTS) { const int p = i / (8 * DTS), h = (i / DTS) % 8, df = i % DTS - DT0; const int d = (p == 0) ? 1 : (p == 1 ? 4 : 16);
              dilT[i] = (df >= 0 && df <= 128) ? rb[rel_bucket_dev(df * d) * 16 + h] * LOG2E : -__builtin_inff(); }
          else { const int j = i - 3 * 8 * DTS, hh = j / TBLS, ds = j % TBLS - TBL0; nsaT[j] = (ds >= 0) ? rb[rel_bucket_dev(ds) * 16 + 8 + hh] * LOG2E : -__builtin_inff();     } } }

    ph_prologue(lds, wv);
    GRID_BAR();
#pragma unroll 1
    for (int step = 0; step < 2 * DEPTH; ++step) {
        const int l = step >> 1, half = step & 1;
        { unsigned char* ws = arg_ws(lds); const int G = opq_g(), bx = opq_bx();
          pg8::Gemm g{64, 64, DM}; pg8::SchedStd S; S.init(ws + WS_HB, ws + WS_WUP + (size_t)step * SZ_WUP, NTOK, 2 * DFF, DM, DM, G, bx); const pg8::EpiSwiGLU E{(bf16_t*)(ws + WS_HP), DFF, (const float*)(ws + WS_SSQ)};
          pg8::gemm_phase<pg8::EpiSwiGLU, pg8::SchedStd, 32768, 32768>(opq_lds(lds), g, S, E, wv);
        }
        GRID_BAR();
        { unsigned char* ws = arg_ws(lds); const int G = opq_g(), bx = opq_bx(); float* X = arg_out(lds);
          pg8::Gemm g{64, 64, DFF}; pg8::SchedStd S; S.init(ws + WS_HP, ws + WS_WDN + (size_t)step * SZ_WDN, NTOK, DM, DFF, DFF, G, bx, 4, 1);
          pg8::EpiResid E{(step == 2 * DEPTH - 1) ? X : (float*)nullptr, (bf16_t*)(ws + WS_HB), (float*)(ws + WS_SSQ), DM, 0.5f};
          pg8::gemm_phase<pg8::EpiResid, pg8::SchedStd, 32768, 32768>(opq_lds(lds), g, S, E, wv);
        }
        if (step == 2 * DEPTH - 1) break;
        GRID_BAR();
        if (half == 0) {
            { unsigned char* ws = arg_ws(lds); const int G = opq_g(), bx = opq_bx();
              pg8::Gemm g{64, 64, DM}; pg8::SchedStd S; S.init(ws + WS_HB, ws + WS_WIN + (size_t)l * SZ_WIN, NTOK, PC, DM, DM, G, bx); const pg8::EpiBf16 E{(bf16_t*)(ws + WS_HP), PC, (const float*)(ws + WS_SSQ), arg_in(lds, I_KNA) + l * HD, arg_in(lds, I_KNN) + l * HD, arg_in(lds, I_POS) + (size_t)l * 32 * HD, (bf16_t*)(ws + WS_ACMP), opq_lds(lds) + pg8::EX_LDS};
              pg8::gemm_phase<pg8::EpiBf16, pg8::SchedStd, 32768, 32768>(opq_lds(lds), g, S, E, wv);
            }
            GRID_BAR();
#pragma unroll 1
            for (int pat3 = 0; pat3 < 3; ++pat3) { const int pat = pat3 % 3;
                if (pat3 == 0) { unsigned char* ws = arg_ws(lds); const int G = opq_g(), bx = opq_bx();
                  pg8::Gemm g{64, 64, 1024}; pg8::SchedCmp S; S.A = (const char*)(ws + WS_ACMP); S.Bt = (const char*)(ws + WS_WC1 + (size_t)l * SZ_WC1); S.G = G; S.c = bx; pg8::EpiF32Z E{(float*)(ws + WS_CP), 512, (size_t)4096 * 512};
                  pg8::gemm_phase<pg8::EpiF32Z, pg8::SchedCmp, 32768, 32768>(opq_lds(lds), g, S, E, wv); }
                if (pat3 == 1) ph_cmp2(lds, l, wv);
                { unsigned char* ws = arg_ws(lds); const int G = opq_g(), bx = opq_bx();
                  for (int u0 = bx; u0 < 1024; u0 += G) { const int w_ = u0 & 255, k_ = u0 >> 8; const int unit = (((w_ & 7) + 8 * k_) << 5) | (w_ >> 3);
                    dil_unit((LAS char*)opq_lds(lds), (const bf16_t*)(ws + WS_HP), (bf16_t*)(ws + WS_OA), (float*)(ws + WS_LSE), (const float*)(ws + WS_TBL), arg_in(lds, I_QNA) + l * HD, pat, 2 * pat, unit, wv); } }
                if (pat3 + 1 < 3) GRID_BAR();
            }
            { unsigned char* ws = arg_ws(lds); const int G = opq_g(), bx = opq_bx();
              const float* gb = arg_in(lds, I_GB) + l * 24; const float* qgn = arg_in(lds, I_QNN) + l * HD;
              int last_bg = -1;
#pragma unroll 1
              for (int i4 = 0; i4 < 4; ++i4)
#pragma unroll 1
                  for (int w = bx; w < 256; w += G) { const int i = i4 & 3; const int bg = w & 7, j = w >> 3;
                      const int qi = (i == 0) ? 127 - j : (i == 1 ? j : (i == 2 ? 64 + j : 63 - j));
                      nsa_unit((LAS char*)opq_lds(lds), (const bf16_t*)(ws + WS_HP), (const bf16_t*)(ws + WS_KC), (const bf16_t*)(ws + WS_VC), (bf16_t*)(ws + WS_ON), (const float*)(ws + WS_TBL + 65536), gb, qgn, bg >> 1, bg & 1, qi, bg != last_bg, wv); last_bg = bg; } }
            GRID_BAR();
            ph_outnorm(lds, l, wv);
            GRID_BAR();
            { unsigned char* ws = arg_ws(lds); const int G = opq_g(), bx = opq_bx(); float* X = arg_out(lds);
              pg8::Gemm g{64, 64, DM}; pg8::SchedStd S; S.init(ws + WS_HP, ws + WS_WOUT + (size_t)l * SZ_WOUT, NTOK, DM, DM, DM, G, bx, 4); pg8::EpiResid E{(float*)nullptr, (bf16_t*)(ws + WS_HB), (float*)(ws + WS_SSQ), DM, 1.0f};
              pg8::gemm_phase<pg8::EpiResid, pg8::SchedStd, 32768, 32768>(opq_lds(lds), g, S, E, wv);
            }
            GRID_BAR();
        }
    }
}

extern "C" void kernel_launch(void* const* d_in, const int* in_sizes, int n_in, void* d_out, int out_size, void* d_ws, size_t ws_size, hipStream_t stream) {
    static int grid = 0;
    if (grid == 0) {
        if (n_in != 24 || in_sizes[0] != NTOK * DM || out_size != NTOK * DM || ws_size < WS_END) { fprintf(stderr, "kernel_launch: shape mismatch n_in %d in0 %d out %d ws %zu (need %zu)\n", n_in, n_in > 0 ? in_sizes[0] : -1, out_size, ws_size, (size_t)WS_END); grid = -1; return; }
        int dev = 0, cus = 0, per_cu = 0;
        if (hipGetDevice(&dev) != hipSuccess || hipDeviceGetAttribute(&cus, hipDeviceAttributeMultiprocessorCount, dev) != hipSuccess) { grid = -1; return; }
        if (hipFuncSetAttribute((const void*)mega_fwd, hipFuncAttributeMaxDynamicSharedMemorySize, LDS_BYTES) != hipSuccess) { fprintf(stderr, "kernel_launch: hipFuncSetAttribute failed\n"); grid = -1; return; }
        if (hipOccupancyMaxActiveBlocksPerMultiprocessor(&per_cu, (const void*)mega_fwd, NTHR, LDS_BYTES) != hipSuccess || per_cu < 1) { fprintf(stderr, "kernel_launch: occupancy query says %d\n", per_cu); (void)hipGetLastError(); if (per_cu < 1) { grid = -1; return; } }
        grid = cus;
    }
    if (grid < 0) return;
    if (hipMemsetAsync((char*)d_ws + WS_CTL, 0, CTL_ZERO_BYTES, stream) != hipSuccess) return;
    Args a{};
    for (int i = 0; i < 24; ++i) a.in[i] = (const float*)d_in[i];
    a.out = (float*)d_out; a.ws = (unsigned char*)d_ws;
    hipLaunchKernelGGL(mega_fwd, dim3(grid), dim3(NTHR), LDS_BYTES, stream, a);
    const hipError_t le = hipPeekAtLastError();
    if (le != hipSuccess) fprintf(stderr, "kernel_launch: launch failed: %s\n", hipGetErrorName(le));
}
```

```cpp
#include <hip/hip_runtime.h>
#include <cstdio>
#include <cstdint>

#define LAS __attribute__((address_space(3)))
typedef unsigned short bf16_t;
typedef short bf16x8 __attribute__((ext_vector_type(8)));
typedef short s16x4 __attribute__((ext_vector_type(4)));
typedef float f32x2 __attribute__((ext_vector_type(2)));
typedef float f32x4 __attribute__((ext_vector_type(4)));
typedef float f32x16 __attribute__((ext_vector_type(16)));
typedef unsigned u32x2 __attribute__((ext_vector_type(2)));
typedef unsigned u32x4 __attribute__((ext_vector_type(4)));

constexpr int BATCH = 4, SEQ = 8192, DM = 2048, DFF = 5632, NTOK = BATCH * SEQ, DEPTH = 4, HD = 128;
constexpr int IN_COLS = 5656, PC = 5888;
constexpr int C_QA = 0, C_KA = 1024, C_VA = 2048, C_QN = 3072, C_KC = 4096, C_VC = 4352, C_KS = 4608, C_VS = 4864, C_KW = 5120, C_VW = 5376, C_GL = 5632;
constexpr float EPS = 1e-6f, QSCALE = 0.08838834764831845f, LOG2E = 1.4426950408889634f;
constexpr int TBLS = 1704, TBL0 = 64;
constexpr int DTS = 320, DT0 = 96;
constexpr int NWAVES = 8, NTHR = 512;

constexpr size_t MiB = 1u << 20;
constexpr size_t WS_CTL = 0, CTL_ZERO_BYTES = 1 * MiB;
constexpr size_t WS_TBL = 1 * MiB;
constexpr size_t SZ_WUP = 44 * MiB, SZ_WDN = 22 * MiB, SZ_WIN = 23 * MiB, SZ_WOUT = 8 * MiB, SZ_WC1 = 8 * MiB;
constexpr size_t WS_WUP = 2 * MiB;
constexpr size_t WS_WDN = WS_WUP + 8 * SZ_WUP;
constexpr size_t WS_WIN = WS_WDN + 8 * SZ_WDN;
constexpr size_t WS_WOUT = WS_WIN + 4 * SZ_WIN;
constexpr size_t WS_WC1 = WS_WOUT + 4 * SZ_WOUT;
constexpr size_t WS_HB = WS_WC1 + 4 * SZ_WC1;
constexpr size_t WS_HP = WS_HB + 128 * MiB;
constexpr size_t WS_OA = WS_HP + 368 * MiB;
constexpr size_t WS_LSE = WS_OA + 64 * MiB;
constexpr size_t WS_ON = WS_LSE + 1 * MiB;
constexpr size_t WS_ACMP = WS_ON + 192 * MiB;
constexpr size_t WS_CP = WS_ACMP + 64 * MiB;
constexpr size_t WS_KC = WS_CP + 64 * MiB;
constexpr size_t WS_VC = WS_KC + 1 * MiB;
constexpr size_t WS_SSQ = WS_VC + 1 * MiB;
constexpr size_t WS_RSTD = WS_SSQ + 4 * MiB;
constexpr size_t WS_END = WS_RSTD + 1 * MiB;
constexpr int CW_BAR = 4096;

__device__ __forceinline__ unsigned f2bf(float f) { unsigned u = __builtin_bit_cast(unsigned, f); return (u + 0x7fffu + ((u >> 16) & 1u)) >> 16; }
__device__ __forceinline__ unsigned pk2(float lo, float hi) { return f2bf(lo) | (f2bf(hi) << 16); }
__device__ __forceinline__ float bf2f(bf16_t b) { return __builtin_bit_cast(float, ((unsigned)b) << 16); }
__device__ __forceinline__ float bflo(unsigned w) { return __builtin_bit_cast(float, w << 16); }
__device__ __forceinline__ float bfhi(unsigned w) { return __builtin_bit_cast(float, w & 0xffff0000u); }
__device__ __forceinline__ unsigned cvtpk(float lo, float hi) { unsigned r; asm volatile("v_cvt_pk_bf16_f32 %0, %1, %2" : "=v"(r) : "v"(lo), "v"(hi)); return r; }
__device__ __forceinline__ float shx(float v, int m, int lane) { return __builtin_bit_cast(float, __builtin_amdgcn_ds_bpermute((lane ^ m) << 2, __builtin_bit_cast(int, v))); }
__device__ __forceinline__ float wave_sum(float v, int lane) {
#pragma unroll
    for (int o = 1; o < 64; o <<= 1) v += shx(v, o, lane);
    return v;
}
__device__ __forceinline__ LAS unsigned char* opq_lds(LAS unsigned char* p) { unsigned a = (unsigned)(uintptr_t)p; asm volatile("" : "+s"(a)); return (LAS unsigned char*)(uintptr_t)a; }
__device__ __forceinline__ int opq_tid(int wv) { int l; asm volatile("v_mbcnt_lo_u32_b32 %0, -1, 0\n\tv_mbcnt_hi_u32_b32 %0, -1, %0" : "=v"(l)); return wv * 64 + l; }
__device__ __forceinline__ size_t kt_off(int r, int k, int K) { return (((size_t)(r >> 8) * (K >> 6) + (k >> 6)) * 256 + (r & 255)) * 64 + (k & 63); }
#define LDS_WAIT() asm volatile("s_waitcnt lgkmcnt(0)" ::: "memory")
#define VM_WAIT() asm volatile("s_waitcnt vmcnt(0)" ::: "memory")
#define SBAR() __builtin_amdgcn_sched_barrier(0)

#define XB_TMO      128
#define XB_XCNT(j)  (256  + 64 * (j))
#define XB_XSUB(j)  (1280 + 64 * (j))
#define XB_XGEN(j)  (2304 + 64 * (j))
#define XB_TOP      3328
#define XB_TOPGEN   3392
#define XCD_BAR_WORDS 3456
#define XB_SPIN_CAP (1u << 18)
__device__ __forceinline__ unsigned xb_ld(unsigned* p)              { return __hip_atomic_load(p, __ATOMIC_RELAXED, __HIP_MEMORY_SCOPE_AGENT); }
__device__ __forceinline__ unsigned xb_add(unsigned* p, unsigned v) { return __hip_atomic_fetch_add(p, v, __ATOMIC_RELAXED, __HIP_MEMORY_SCOPE_AGENT); }
__device__ __forceinline__ unsigned xb_xcc_id() { return (unsigned)__builtin_amdgcn_s_getreg((3 << 11) | 20) & 0xFu; }
#define XB_SPIN(cond, bar) do { unsigned _sp = 0; while (cond) { __builtin_amdgcn_s_sleep(1); \
    if ((++_sp & 255u) == 0u) { if (xb_ld(&(bar)[XB_TMO])) break; if (_sp > XB_SPIN_CAP) { atomicAdd(&(bar)[XB_TMO], 1u); break; } } } } while (0)
struct XcdBarrier { unsigned* bar; unsigned x; volatile LAS unsigned* st; };
__device__ __forceinline__ XcdBarrier xcd_barrier_post(unsigned* bar, volatile LAS unsigned* st) {
    XcdBarrier b; b.bar = bar; b.x = xb_xcc_id(); b.st = st;
    if (threadIdx.x == 0) (void)xb_add(&bar[XB_XCNT(b.x)], 1u);
    return b;
}
__device__ __forceinline__ void xcd_barrier_complete(unsigned* bar, unsigned x, unsigned& nloc, unsigned& nx) {
    const unsigned G = gridDim.x * gridDim.y * gridDim.z;
    unsigned sum, cnt, mine, sp = 0u;
    for (;;) {
        sum = 0u; cnt = 0u; mine = 0u;
#pragma unroll
        for (unsigned j = 0; j < 16; ++j) { const unsigned c = xb_ld(&bar[XB_XCNT(j)]); sum += c; cnt += (c > 0u) ? 1u : 0u; mine = (j == x) ? c : mine; }
        if (sum == G) break;
        __builtin_amdgcn_s_sleep(1);
        if ((++sp & 255u) == 0u) { if (xb_ld(&bar[XB_TMO])) break; if (sp > XB_SPIN_CAP) { atomicAdd(&bar[XB_TMO], 1u); break; } }
    }
    nloc = mine > 0u ? mine : 1u; nx = cnt > 0u ? cnt : 1u;
}
__device__ __forceinline__ void xcd_barrier(const XcdBarrier& b, const int wv) {
    asm volatile("s_waitcnt vmcnt(0)" ::: "memory");
    __syncthreads();
    if (opq_tid(wv) == 0) {
        unsigned* bar = b.bar; asm volatile("" : "+s"(bar));
        __builtin_amdgcn_s_waitcnt(0);
        unsigned nloc = b.st[0], nx = b.st[1];
        if (nloc == 0u) { xcd_barrier_complete(bar, b.x, nloc, nx); b.st[0] = nloc; b.st[1] = nx; }
        const unsigned old = xb_add(&bar[XB_XSUB(b.x)], 1u);
        const unsigned gen = old / nloc;
        if (old + 1u == (gen + 1u) * nloc) {
            __builtin_amdgcn_fence(__ATOMIC_RELEASE, "agent");
            asm volatile("s_waitcnt vmcnt(0)" ::: "memory");
            const unsigned og = xb_add(&bar[XB_TOP], 1u);
            const unsigned tg = og / nx;
            if (og + 1u == (tg + 1u) * nx) xb_add(&bar[XB_TOPGEN], 1u);
            else XB_SPIN(xb_ld(&bar[XB_TOPGEN]) == tg, bar);
            __builtin_amdgcn_fence(__ATOMIC_ACQUIRE, "agent");
            xb_add(&bar[XB_XGEN(b.x)], 1u);
            asm volatile("s_waitcnt vmcnt(0)" ::: "memory");
        } else {
            XB_SPIN(xb_ld(&bar[XB_XGEN(b.x)]) == gen, bar);
            __builtin_amdgcn_fence(__ATOMIC_ACQUIRE, "agent");
            asm volatile("s_waitcnt vmcnt(0)" ::: "memory");
        }
    }
    __syncthreads();
}

namespace pg8 {
constexpr int BM = 256, BK = 64, HALF = 128, HTB = HALF * BK * 2, STAGE_BYTES = 8 * HTB, NXCD = 8, WGM = 8;
__host__ __device__ __forceinline__ int lds_byte(int r, int c) { const int st = (r >> 4) * 2 + (c >> 5), rr = r & 15, cc = c & 31, ob = rr * 64 + cc * 2; return st * 1024 + (ob ^ (((ob >> 9) & 1) << 5)); }
__host__ __device__ __forceinline__ void stage_rc(int b, int& R, int& C) { const int st = b / 1024, sb = b % 1024, swz = sb ^ (((sb >> 9) & 1) << 5); R = (st >> 1) * 16 + swz / 64; C = (st & 1) * 32 + (swz % 64) / 2; }
__host__ __device__ __forceinline__ int perm32(int rho) { const int n = rho >> 4, i = rho & 15; return 8 * (i >> 2) + 4 * n + (i & 3); }
struct Unit { int pm, pn, z; };
struct Gemm { int lda, ldb, K; };
struct SchedStd {
    const char* A; const char* Bt; size_t atile, btile; int nM, nN, nwg, G, c, wgm, flip;
    __device__ __forceinline__ void init(const void* A_, const void* Bt_, int M, int N, int lda, int ldb, int G_, int c_, int wgm_ = WGM, int flip_ = 0) { wgm = wgm_; flip = flip_;
        A = (const char*)A_; Bt = (const char*)Bt_; atile = (size_t)BM * lda * 2; btile = (size_t)BM * ldb * 2; nM = M / BM; nN = N / BM; nwg = nM * nN; G = G_; c = c_; }
    __device__ __forceinline__ bool next(int i, Unit& u) const {
        const long L = (long)i * G + c; if (L >= nwg) return false;
        int wgid = (int)L; { const int q = nwg / NXCD, r = nwg % NXCD, xcd = wgid % NXCD, off = wgid / NXCD; wgid = (xcd < r ? xcd * (q + 1) : r * (q + 1) + (xcd - r) * q) + off; }
        const int nig = wgm * nN, gid = wgid / nig, fm = gid * wgm, gsz = (nM - fm) < wgm ? (nM - fm) : wgm;
        u.pm = fm + ((wgid % nig) % gsz); u.pn = (wgid % nig) / gsz; u.z = 0; if (flip) u.pm = nM - 1 - u.pm; return true;
    }
    __device__ __forceinline__ const char* a_ptr(const Unit& u) const { return A + (size_t)u.pm * atile; }
    __device__ __forceinline__ const char* b_ptr(const Unit& u) const { return Bt + (size_t)u.pn * btile; }
};
struct SchedCmp {
    const char* A; const char* Bt; int G, c;
    __device__ __forceinline__ bool next(int i, Unit& u) const { const int L = i * G + c; if (L >= 256) return false; u.z = L >> 5; u.pm = (L & 31) >> 1; u.pn = L & 1; return true; }
    __device__ __forceinline__ const char* a_ptr(const Unit& u) const { const int kv = u.z >> 2, ks = u.z & 3; return A + ((size_t)(kv * 16 + u.pm) * 64 + (size_t)ks * 16) * 32768; }
    __device__ __forceinline__ const char* b_ptr(const Unit& u) const { const int kv = u.z >> 2, ks = u.z & 3; return Bt + ((size_t)(kv * 2 + u.pn) * 64 + (size_t)ks * 16) * 32768; }
};
struct SchedGate {
    const char* A; const char* Bt; int G, c;
    __device__ __forceinline__ bool next(int i, Unit& u) const { const int L = i * G + c; if (L >= 256) return false; u.pm = L >> 1; u.pn = C_GL >> 8; u.z = L & 1; return true; }
    __device__ __forceinline__ const char* a_ptr(const Unit& u) const { return A + ((size_t)u.pm * 32 + (size_t)u.z * 16) * 32768; }
    __device__ __forceinline__ const char* b_ptr(const Unit& u) const { return Bt + ((size_t)u.pn * 32 + (size_t)u.z * 16) * 32768; }
};
constexpr int EX_LDS = 131072 + 4096;
struct EpiBf16 {
    static constexpr bool PERM = true;
    static constexpr bool ROWS = true;
    bf16_t* O; int ldc; const float* ssq; const float* kna; const float* knn; const float* pos; bf16_t* acmp; LAS unsigned char* xl;
    __device__ __forceinline__ void operator()(const f32x4 (&acc)[2][2][4][2], const Unit& u, int wr, int wc, int fr, int fq, const float (&pre)[8]) const {
        const int pn = u.pn, e0 = wc * 32 + 8 * fq, lane = fq * 16 + fr;
        const int row0 = u.pm * BM + wr * 64 + fr, col0 = pn * BM + e0;
        if ((pn >= 4 && pn < 8) || pn == 18 || pn == 20) {
            const float* ga = kna + e0; const float* gb = knn + e0; const float* gp = (pn < 8) ? ga + 0 : gb + 0;
            const f32x4 g0 = *(const f32x4*)gp, g1 = *(const f32x4*)(gp + 4);
            LAS float* X = (LAS float*)xl + ((wr * 256 + fr) * 4);
#pragma unroll
            for (int ai = 0; ai < 2; ++ai)
#pragma unroll
                for (int m = 0; m < 4; ++m) { const float rs = pre[ai * 4 + m];
#pragma unroll
                    for (int bj = 0; bj < 2; ++bj) { const f32x4 v0 = acc[ai][bj][m][0] * rs, v1 = acc[ai][bj][m][1] * rs;
                        float s = ((v0[0] * v0[0] + v0[1] * v0[1]) + (v0[2] * v0[2] + v0[3] * v0[3])) + ((v1[0] * v1[0] + v1[1] * v1[1]) + (v1[2] * v1[2] + v1[3] * v1[3]));
                        { auto r16 = __builtin_amdgcn_permlane16_swap(__float_as_uint(s), __float_as_uint(s), false, false); s = __uint_as_float(r16[0]) + __uint_as_float(r16[1]);
                          auto r32_ = __builtin_amdgcn_permlane32_swap(__float_as_uint(s), __float_as_uint(s), false, false); s = __uint_as_float(r32_[0]) + __uint_as_float(r32_[1]); }
                        if (fq == 0) X[((ai * 4 + m) * 2 + bj) * 64 + wc] = s; } }
            asm volatile("s_waitcnt lgkmcnt(0)" ::: "memory"); __builtin_amdgcn_s_barrier(); asm volatile("" ::: "memory");
#pragma unroll
            for (int ai = 0; ai < 2; ++ai)
#pragma unroll
                for (int m = 0; m < 4; ++m) { bf16_t* rowp = O + (size_t)(row0 + ai * HALF + m * 16) * ldc + col0; const float rs = pre[ai * 4 + m];
#pragma unroll
                    for (int bj = 0; bj < 2; ++bj) { const f32x4 t4 = *(const LAS f32x4*)(X + ((ai * 4 + m) * 2 + bj) * 64);
                        const float rh = rs / sqrtf(((t4[0] + t4[1]) + (t4[2] + t4[3])) * (1.f / 128.f) + 1e-6f);
                        const f32x4 v0 = acc[ai][bj][m][0] * rh * g0, v1 = acc[ai][bj][m][1] * rh * g1;
                        u32x4 w; w.x = cvtpk(v0[0], v0[1]); w.y = cvtpk(v0[2], v0[3]); w.z = cvtpk(v1[0], v1[1]); w.w = cvtpk(v1[2], v1[3]);
                        *(u32x4*)(rowp + bj * HALF) = w; } }
        } else if (pn == 16 || pn == 17) {
            const int kv = pn - 16;
            const float* pp = pos + fr * 128 + e0;
            const f32x4 pa0 = *(const f32x4*)pp, pa1 = *(const f32x4*)(pp + 4), pb0 = *(const f32x4*)(pp + 16 * 128), pb1 = *(const f32x4*)(pp + 16 * 128 + 4);
#pragma unroll
            for (int ai = 0; ai < 2; ++ai)
#pragma unroll
                for (int m = 0; m < 4; ++m) { const int rowb = u.pm * BM + ai * HALF + wr * 64 + m * 16, b = rowb >> 13, c1 = (rowb & 8191) >> 4; const float rs = pre[ai * 4 + m];
#pragma unroll
                    for (int bj = 0; bj < 2; ++bj) { const f32x4 v0 = acc[ai][bj][m][0] * rs, v1 = acc[ai][bj][m][1] * rs;
                        const int arow0 = kv * 4096 + (b * 2 + bj) * 512;
                        if (c1 <= 510) { u32x4 w; w.x = cvtpk(v0[0] + pa0[0], v0[1] + pa0[1]); w.y = cvtpk(v0[2] + pa0[2], v0[3] + pa0[3]); w.z = cvtpk(v1[0] + pa1[0], v1[1] + pa1[1]); w.w = cvtpk(v1[2] + pa1[2], v1[3] + pa1[3]);
                            *(u32x4*)(acmp + kt_off(arow0 + c1, fr * 128 + e0, 4096)) = w; }
                        else { unsigned zr = 0u; asm volatile("" : "+v"(zr)); const u32x4 z = {zr, zr, zr, zr}; *(u32x4*)(acmp + kt_off(arow0 + 511, fr * 128 + e0, 4096)) = z; *(u32x4*)(acmp + kt_off(arow0 + 511, (fr + 16) * 128 + e0, 4096)) = z; }
                        if (c1 >= 1) { u32x4 w; w.x = cvtpk(v0[0] + pb0[0], v0[1] + pb0[1]); w.y = cvtpk(v0[2] + pb0[2], v0[3] + pb0[3]); w.z = cvtpk(v1[0] + pb1[0], v1[1] + pb1[1]); w.w = cvtpk(v1[2] + pb1[2], v1[3] + pb1[3]);
                            *(u32x4*)(acmp + kt_off(arow0 + c1 - 1, (fr + 16) * 128 + e0, 4096)) = w; } } }
        } else {
#pragma unroll
            for (int ai = 0; ai < 2; ++ai)
#pragma unroll
                for (int m = 0; m < 4; ++m) { bf16_t* rowp = O + (size_t)(row0 + ai * HALF + m * 16) * ldc + col0; const float rs = pre[ai * 4 + m];
#pragma unroll
                    for (int bj = 0; bj < 2; ++bj) { const f32x4 v0 = acc[ai][bj][m][0] * rs, v1 = acc[ai][bj][m][1] * rs;
                        u32x4 w; w.x = cvtpk(v0[0], v0[1]); w.y = cvtpk(v0[2], v0[3]); w.z = cvtpk(v1[0], v1[1]); w.w = cvtpk(v1[2], v1[3]);
                        *(u32x4*)(rowp + bj * HALF) = w; } }
        }
    }
};
struct EpiGate {
    static constexpr bool PERM = true;
    static constexpr bool ROWS = true;
    bf16_t* O; int ldc; const float* ssq;
    __device__ __forceinline__ void operator()(const f32x4 (&acc)[2][2][4][2], const Unit& u, int wr, int wc, int fr, int fq, const float (&pre)[8]) const {
        if (wc != 0) return;
        const int row0 = u.pm * BM + wr * 64 + fr, col0 = C_GL + 32 * u.z + 8 * fq;
#pragma unroll
        for (int ai = 0; ai < 2; ++ai)
#pragma unroll
            for (int m = 0; m < 4; ++m) { const float rs = pre[ai * 4 + m]; const f32x4 v0 = acc[ai][0][m][0] * rs, v1 = acc[ai][0][m][1] * rs;
                u32x4 w; w.x = cvtpk(v0[0], v0[1]); w.y = cvtpk(v0[2], v0[3]); w.z = cvtpk(v1[0], v1[1]); w.w = cvtpk(v1[2], v1[3]);
                *(u32x4*)(O + (size_t)(row0 + ai * HALF + m * 16) * ldc + col0) = w; }
    }
};
struct EpiSwiGLU {
    static constexpr bool PERM = true;
    static constexpr bool ROWS = true;
    bf16_t* O; int ldc; const float* ssq;
    __device__ __forceinline__ void operator()(const f32x4 (&acc)[2][2][4][2], const Unit& u, int wr, int wc, int fr, int fq, const float (&pre)[8]) const {
        const int rowp0 = wr * 64 + fr, kt = 2 * u.pn + (wc >> 1), cit = (wc & 1) * 32 + 8 * fq;
        bf16_t* tile = O + ((size_t)u.pm * (ldc / 64) + kt) * (256 * 64) + cit;
#pragma unroll
        for (int ai = 0; ai < 2; ++ai)
#pragma unroll
            for (int m = 0; m < 4; ++m) { bf16_t* rowp = tile + (size_t)(rowp0 + ai * HALF + m * 16) * 64; const float rs = pre[ai * 4 + m];
                const float c2 = -rs * LOG2E, rs2 = rs * rs;
                f32x4 v[2];
#pragma unroll
                for (int n = 0; n < 2; ++n) { const f32x4 a = acc[ai][0][m][n], b = acc[ai][1][m][n];
                    const f32x4 t = a * c2, ab = a * b;
                    f32x4 d = {__builtin_amdgcn_exp2f(t[0]), __builtin_amdgcn_exp2f(t[1]), __builtin_amdgcn_exp2f(t[2]), __builtin_amdgcn_exp2f(t[3])};
                    d = d + 1.0f;
                    f32x4 r = {__builtin_amdgcn_rcpf(d[0]), __builtin_amdgcn_rcpf(d[1]), __builtin_amdgcn_rcpf(d[2]), __builtin_amdgcn_rcpf(d[3])};
                    r = r * rs2;
                    v[n] = ab * r; }
                u32x4 w; w.x = cvtpk(v[0][0], v[0][1]); w.y = cvtpk(v[0][2], v[0][3]); w.z = cvtpk(v[1][0], v[1][1]); w.w = cvtpk(v[1][2], v[1][3]);
                *(u32x4*)rowp = w; }
    }
};
struct EpiResid {
    static constexpr bool PERM = true;
    static constexpr bool ROWS = false;
    float* out; bf16_t* xb; float* ssq; int ldc; float alpha;
    __device__ __forceinline__ void operator()(const f32x4 (&acc)[2][2][4][2], const Unit& u, int wr, int wc, int fr, int fq, const float (&pre)[8]) const {
        const int row0 = u.pm * BM + wr * 64 + fr, col0 = u.pn * BM + wc * 32 + 8 * fq;
        u32x4 bs[4][2];
#define ER_LOAD(g) do { const int row_ = row0 + ((g) >> 2) * HALF + ((g) & 3) * 16; \
        _Pragma("unroll") for (int q_ = 0; q_ < 2; ++q_) bs[(g) & 3][q_] = *(const u32x4*)(xb + kt_off(row_, col0 + q_ * HALF, ldc)); } while (0)
        ER_LOAD(0); ER_LOAD(1); ER_LOAD(2); ER_LOAD(3);
        float ssg[8];
#pragma unroll
        for (int g = 0; g < 8; ++g) { const int ai = g >> 2, m = g & 3; const int row = row0 + ai * HALF + m * 16; float ss = 0.f;
#pragma unroll
            for (int bj = 0; bj < 2; ++bj) { const u32x4 b = bs[g & 3][bj];
                const f32x4 o0 = (f32x4){bflo(b.x), bfhi(b.x), bflo(b.y), bfhi(b.y)} + acc[ai][bj][m][0] * alpha, o1 = (f32x4){bflo(b.z), bfhi(b.z), bflo(b.w), bfhi(b.w)} + acc[ai][bj][m][1] * alpha;
                ss += ((o0.x * o0.x + o0.y * o0.y) + (o0.z * o0.z + o0.w * o0.w)) + ((o1.x * o1.x + o1.y * o1.y) + (o1.z * o1.z + o1.w * o1.w));
                u32x4 w; w.x = cvtpk(o0.x, o0.y); w.y = cvtpk(o0.z, o0.w); w.z = cvtpk(o1.x, o1.y); w.w = cvtpk(o1.z, o1.w); *(u32x4*)(xb + kt_off(row, col0 + bj * HALF, ldc)) = w;
                if (out) { float* op_ = out + (size_t)row * ldc + col0 + bj * HALF; *(f32x4*)op_ = o0; *(f32x4*)(op_ + 4) = o1; } }
            if (g + 4 < 8) ER_LOAD(g + 4);
            ssg[g] = ss; }
#pragma unroll
        for (int g = 0; g < 8; ++g) { auto r16 = __builtin_amdgcn_permlane16_swap(__float_as_uint(ssg[g]), __float_as_uint(ssg[g]), false, false); ssg[g] = __uint_as_float(r16[0]) + __uint_as_float(r16[1]);
            auto r32_ = __builtin_amdgcn_permlane32_swap(__float_as_uint(ssg[g]), __float_as_uint(ssg[g]), false, false); ssg[g] = __uint_as_float(r32_[0]) + __uint_as_float(r32_[1]); }
        if (fq == 0) {
#pragma unroll
            for (int g = 0; g < 8; ++g) ssq[(size_t)(row0 + (g >> 2) * HALF + (g & 3) * 16) * 32 + u.pn * 4 + wc] = ssg[g]; }
#undef ER_LOAD
    }
};
struct EpiF32Z {
    static constexpr bool PERM = false;
    float* C; int ldc; size_t zstride;
    static constexpr bool ROWS = false;
    __device__ __forceinline__ void operator()(const f32x4 (&acc)[2][2][4][2], const Unit& u, int wr, int wc, int fr, int fq, const float (&pre)[8]) const {
        float* Cz = C + (size_t)u.z * zstride;
        const int row0 = u.pm * BM + wr * 64 + fr, col0 = u.pn * BM + wc * 32 + 4 * fq;
#pragma unroll
        for (int ai = 0; ai < 2; ++ai)
#pragma unroll
            for (int m = 0; m < 4; ++m) { float* rowp = Cz + (size_t)(row0 + ai * HALF + m * 16) * ldc + col0;
#pragma unroll
                for (int bj = 0; bj < 2; ++bj)
#pragma unroll
                    for (int n = 0; n < 2; ++n) *(f32x4*)(rowp + bj * HALF + n * 16) = acc[ai][bj][m][n]; }
    }
};

constexpr int RS_LDS = 131072 + 1024;
__device__ __forceinline__ void rows_to_lds(LAS unsigned char* lds, const float* ssq, int pm, int slot, int tid) {
    const int row = tid >> 1, half = tid & 1;
    const f32x4* p = (const f32x4*)(ssq + ((size_t)pm * BM + row) * 32 + half * 16);
    f32x4 a = p[0]; a = a + p[1]; a = a + p[2]; a = a + p[3];
    float s = (a.x + a.y) + (a.z + a.w); s += shx(s, 1, tid & 63);
    const float rs = 1.0f / sqrtf(s * (1.f / 2048.f) + 1e-6f);
    if (half == 0) *(LAS float*)(lds + RS_LDS + slot * 1024 + row * 4) = rs;
}
template <class Epi, class Sched, int KSTEP_A = 128, int KSTEP_B = 128>
__device__ __forceinline__ void gemm_phase(LAS unsigned char* lds, const Gemm g, const Sched& S, const Epi& E, const int wv) {
    const int tid = opq_tid(wv), wid = __builtin_amdgcn_readfirstlane(tid >> 6), lane = tid & 63, wr = wid >> 2, wc = wid & 3, fr = lane & 15, fq = lane >> 4;
    const int K = g.K, nt = K / BK;
    unsigned voffA[2], voffB[2];
#pragma unroll
    for (int i = 0; i < 2; ++i) { int R, C; stage_rc(tid * 16 + i * 8192, R, C); const int Rb = Epi::PERM ? ((R & ~31) + perm32(R & 31)) : R;
        voffA[i] = (unsigned)(R * g.lda + C) * 2u; voffB[i] = (unsigned)(Rb * g.ldb + C) * 2u; }
    constexpr size_t kstepA = (size_t)KSTEP_A, kstepB = (size_t)KSTEP_B;
    const size_t hstepA = (size_t)HALF * g.lda * 2, hstepB = (size_t)HALF * g.ldb * 2;
    const unsigned ldsw = (unsigned)wid * 1024u;
    const int aoff = lds_byte(wr * 64 + fr, fq * 8), boff = lds_byte(wc * 32 + fr, fq * 8);
#define PG8_SA(b, h) (((b) * 2 + (h)) * HTB)
#define PG8_SB(b, h) ((4 + (b) * 2 + (h)) * HTB)
#define PG8_STAGE(bufoff, gbase, voff) do { _Pragma("unroll") for (int _i = 0; _i < 2; ++_i) \
        __builtin_amdgcn_global_load_lds((const unsigned*)((const char*)(gbase) + (voff)[_i]), (LAS unsigned*)(lds + (bufoff) + ldsw + _i * 8192), 16, 0, 0); } while (0)
#define PG8_LDA(dst, b, h) do { _Pragma("unroll") for (int m = 0; m < 4; ++m) _Pragma("unroll") for (int k = 0; k < 2; ++k) dst[m][k] = *(const LAS bf16x8*)(lds + PG8_SA(b, h) + aoff + m * 2048 + k * 1024); } while (0)
#define PG8_LDB(dst, b, h) do { _Pragma("unroll") for (int n = 0; n < 2; ++n) _Pragma("unroll") for (int k = 0; k < 2; ++k) dst[n][k] = *(const LAS bf16x8*)(lds + PG8_SB(b, h) + boff + n * 2048 + k * 1024); } while (0)
#define PG8_MMA(ai, bj, At, Bt) do { __builtin_amdgcn_s_setprio(1); _Pragma("unroll") for (int m = 0; m < 4; ++m) _Pragma("unroll") for (int n = 0; n < 2; ++n) _Pragma("unroll") for (int k = 0; k < 2; ++k) \
        acc[ai][bj][m][n] = __builtin_amdgcn_mfma_f32_16x16x32_bf16(Bt[n][k], At[m][k], acc[ai][bj][m][n], 0, 0, 0); __builtin_amdgcn_s_setprio(0); } while (0)
#define PG8_WAIT_V(n) asm volatile("s_waitcnt vmcnt(" #n ")" ::: "memory")
#define PG8_WAIT_L(n) asm volatile("s_waitcnt lgkmcnt(" #n ")" ::: "memory")
#define PG8_BAR __builtin_amdgcn_s_barrier()
#define PG8_SCHED __builtin_amdgcn_sched_barrier(0)
    Unit cur, nxt; int ui = 0;
    if (!S.next(0, cur)) return;
    f32x4 acc[2][2][4][2];
#pragma unroll
    for (int a = 0; a < 2; ++a)
#pragma unroll
        for (int b = 0; b < 2; ++b)
#pragma unroll
            for (int m = 0; m < 4; ++m)
#pragma unroll
                for (int n = 0; n < 2; ++n) acc[a][b][m][n] = (f32x4){0.f, 0.f, 0.f, 0.f};
    bf16x8 At[4][2], B0[2][2], B1[2][2];
    const char* cA = S.a_ptr(cur); const char* cB = S.b_ptr(cur);
    float pre[8]; int rslot = 0; if constexpr (Epi::ROWS) rows_to_lds(lds, E.ssq, cur.pm, 0, tid);
    PG8_STAGE(PG8_SB(0, 0), cB, voffB); PG8_STAGE(PG8_SA(0, 0), cA, voffA); PG8_STAGE(PG8_SB(0, 1), cB + hstepB, voffB); PG8_STAGE(PG8_SA(0, 1), cA + hstepA, voffA);
    if (wr == 1) PG8_BAR;
    PG8_WAIT_V(4); PG8_BAR;
    PG8_STAGE(PG8_SB(1, 0), cB + kstepB, voffB); PG8_STAGE(PG8_SA(1, 0), cA + kstepA, voffA); PG8_STAGE(PG8_SB(1, 1), cB + hstepB + kstepB, voffB);
    PG8_WAIT_V(6); PG8_BAR;
    for (;;) {
        const bool has_next = S.next(ui + 1, nxt);
        const char* nA = has_next ? S.a_ptr(nxt) : cA; const char* nB = has_next ? S.b_ptr(nxt) : cB;
        for (int t = 0; t < nt; t += 2) {
            const bool last = (t == nt - 2);
            const char* a1 = cA + (size_t)(t + 1) * kstepA;
            const char* a2 = last ? nA : cA + (size_t)(t + 2) * kstepA; const char* b2 = last ? nB : cB + (size_t)(t + 2) * kstepB;
            const char* a3 = a2 + kstepA; const char* b3 = b2 + kstepB;
            PG8_LDB(B0, 0, 0); PG8_SCHED; PG8_LDA(At, 0, 0); PG8_STAGE(PG8_SA(1, 1), a1 + hstepA, voffA);
            PG8_WAIT_L(8); PG8_BAR; PG8_WAIT_L(0); PG8_MMA(0, 0, At, B0); PG8_BAR; PG8_SCHED;
            PG8_LDB(B1, 0, 1); PG8_STAGE(PG8_SB(0, 0), b2, voffB);
            PG8_BAR; PG8_WAIT_L(0); PG8_MMA(0, 1, At, B1); PG8_BAR;
            PG8_LDA(At, 0, 1); PG8_STAGE(PG8_SA(0, 0), a2, voffA);
            PG8_BAR; PG8_WAIT_L(0); PG8_MMA(1, 0, At, B0); PG8_BAR; PG8_SCHED;
            PG8_STAGE(PG8_SB(0, 1), b2 + hstepB, voffB);
            PG8_WAIT_V(6); PG8_BAR; PG8_MMA(1, 1, At, B1); PG8_BAR;
            PG8_LDB(B0, 1, 0); PG8_SCHED; PG8_LDA(At, 1, 0); PG8_STAGE(PG8_SA(0, 1), a2 + hstepA, voffA);
            PG8_WAIT_L(8); PG8_BAR; PG8_WAIT_L(0); PG8_MMA(0, 0, At, B0); PG8_BAR; PG8_SCHED;
            PG8_LDB(B1, 1, 1); PG8_STAGE(PG8_SB(1, 0), b3, voffB);
            PG8_BAR; PG8_WAIT_L(0); PG8_MMA(0, 1, At, B1); PG8_BAR;
            PG8_LDA(At, 1, 1); PG8_STAGE(PG8_SA(1, 0), a3, voffA);
            PG8_BAR; PG8_WAIT_L(0); PG8_MMA(1, 0, At, B0); PG8_BAR; PG8_SCHED;
            PG8_STAGE(PG8_SB(1, 1), b3 + hstepB, voffB);
            PG8_WAIT_V(6); PG8_BAR; PG8_MMA(1, 1, At, B1); PG8_BAR;
        }
        if constexpr (Epi::ROWS) {
#pragma unroll
            for (int i = 0; i < 8; ++i) pre[i] = *(const LAS float*)(lds + RS_LDS + rslot * 1024 + (wr * 64 + fr + (i >> 2) * HALF + (i & 3) * 16) * 4); }
        E(acc, cur, wr, wc, fr, fq, pre);
        if constexpr (Epi::ROWS) { if (has_next && nxt.pm != cur.pm) { rslot ^= 1; rows_to_lds(lds, E.ssq, nxt.pm, rslot, tid); } }
        if (!has_next) break;
#pragma unroll
        for (int a = 0; a < 2; ++a)
#pragma unroll
            for (int b = 0; b < 2; ++b)
#pragma unroll
                for (int m = 0; m < 4; ++m)
#pragma unroll
                    for (int n = 0; n < 2; ++n) acc[a][b][m][n] = (f32x4){0.f, 0.f, 0.f, 0.f};
        cur = nxt; cA = nA; cB = nB; ++ui;
    }
    PG8_WAIT_V(0);
    if (wr == 0) PG8_BAR;
    PG8_BAR;
#undef PG8_SA
#undef PG8_SB
#undef PG8_STAGE
#undef PG8_LDA
#undef PG8_LDB
#undef PG8_MMA
#undef PG8_WAIT_V
#undef PG8_WAIT_L
#undef PG8_BAR
#undef PG8_SCHED
}
}

struct Args { const float* in[24]; float* out; unsigned char* ws; };
enum { I_X = 0, I_F1N, I_F1W1, I_F1W3, I_F1W2, I_MIXN, I_WIN, I_GB, I_QNA, I_KNA, I_QNN, I_KNN, I_POS, I_CKW1, I_CKW2, I_CVW1, I_CVW2, I_ON, I_WOUT, I_F2N, I_F2W1, I_F2W3, I_F2W2, I_RB };

__device__ __forceinline__ void ti_issue(const float* W, int K, int N, int item, int lane, const float* gain, f32x4 (&ld)[8], float (&gv)[8]) {
    const int nblk = (N + 31) / 32, kb = item / nblk, nb = item % nblk, k0 = 64 * kb, n0 = 32 * nb;
    const int c4 = 4 * (lane & 7), nn = n0 + c4;
    (void)K;
#pragma unroll
    for (int i = 0; i < 8; ++i) { const int kk = 8 * i + (lane >> 3); ld[i] = (nn < N) ? *(const f32x4*)(W + (size_t)(k0 + kk) * N + nn) : (f32x4){0.f, 0.f, 0.f, 0.f}; gv[i] = gain ? gain[k0 + kk] : 1.0f; }
}
__device__ __forceinline__ void ti_finish(int K, int N, bf16_t* WT, int mode, int off, LAS float* scr, int item, int lane, const f32x4 (&ld)[8], const float (&gv)[8]) {
    const int nblk = (N + 31) / 32, kb = item / nblk, nb = item % nblk, k0 = 64 * kb, n0 = 32 * nb;
    const int c4 = 4 * (lane & 7);
#pragma unroll
    for (int i = 0; i < 8; ++i) { const int kk = 8 * i + (lane >> 3); const f32x4 v = ld[i] * gv[i]; LAS float* d = scr + kk * 33 + c4; d[0] = v.x; d[1] = v.y; d[2] = v.z; d[3] = v.w; }
    LDS_WAIT(); asm volatile("" ::: "memory");
    const int c = lane & 7;
#pragma unroll
    for (int j = 0; j < 4; ++j) { const int n = (lane >> 3) + 8 * j; const LAS float* sp = scr + (8 * c) * 33 + n;
        u32x4 o; o.x = pk2(sp[0 * 33], sp[1 * 33]); o.y = pk2(sp[2 * 33], sp[3 * 33]); o.z = pk2(sp[4 * 33], sp[5 * 33]); o.w = pk2(sp[6 * 33], sp[7 * 33]);
        const int ng = n0 + n; int dr = (mode == 1) ? ((ng >> 7) * 256 + (ng & 127) + off) : (ng + off);
        if (mode == 2) { const bool isv = (ng >= C_VA && ng < C_VA + 1024) || (ng >= C_VS && ng < C_VS + 256) || (ng >= C_VW && ng < C_VW + 256);
            dr = isv ? ((ng & ~127) | (32 * (ng & 3) + ((ng & 127) >> 2))) : ng; }
        if (ng < N) *(u32x4*)(WT + kt_off(dr, k0 + 8 * c, K)) = o; }
    LDS_WAIT(); asm volatile("" ::: "memory");
}
__device__ __forceinline__ int rel_bucket_dev(int n) {
    if (n < 16) return n;
    const float v = logf((float)n / 16.0f) / 4.852030263919617f * 16.0f;
    int b = 16 + (int)v; return b < 31 ? b : 31;
}
namespace att {
constexpr int SHM_V = 16384, SHM_K = 16384;
constexpr int L_V = 0  , L_K = 49152  , L_WS = 98304, L_TBL = 100352, L_SELM = L_TBL + 4 * TBLS * 4  , L_NEG = L_SELM + 1024  , L_TBLW = L_NEG + 256  , L_END = L_TBLW + 4 * 136 * 4;
constexpr int L_GATE = 131072 + 4096;
constexpr int L_IMP = 0;
static_assert(L_END <= 131072, "attention LDS map");
constexpr float THR = 8.f;
#define KSWZ(row, colB) ((row) * 256 + ((colB) ^ (((row) & 7) << 4)))
__device__ __forceinline__ int v_st(int k, int c) { const int kk = (k & ~0xC) | ((k & 4) << 1) | ((k & 8) >> 1); return ((kk >> 3) * 4 + (c >> 5)) * 512 + ((kk & 7) * 32 + (c & 31)) * 2; }
__device__ __forceinline__ int v_rd_base(int lane) { return ((lane & 3) << 3) | (((lane >> 2) & 3) << 6) | (((lane >> 4) & 1) << 5) | (((lane >> 5) & 1) << 8); }
__device__ __forceinline__ int crow(int r, int hi) { return (r & 3) + 8 * (r >> 2) + 4 * hi; }

__device__ __forceinline__ void partialSM(f32x16& p0, f32x16& p1, float& m_reg, float& mn, float& alpha) {
    (void)m_reg; mn = 0.f; alpha = 1.f;
#pragma unroll
    for (int r = 0; r < 16; ++r) p0[r] = __builtin_amdgcn_exp2f(p0[r]);
}
__device__ __forceinline__ void partialSM_row(f32x16& p0, f32x16& p1, float& m_reg, float& mn, float& alpha, bool ok, float bias) {
    (void)m_reg; mn = 0.f; alpha = 1.f;
    const float mnL = ok ? bias : -__builtin_inff();
#pragma unroll
    for (int r = 0; r < 16; ++r) p0[r] = __builtin_amdgcn_exp2f(p0[r] + mnL);
#pragma unroll
    for (int r = 0; r < 16; ++r) p1[r] = p1[r] + mnL;
}
#define PK4(P, B_, OUT) do { unsigned a0 = cvtpk(P[B_+0], P[B_+1]), a1 = cvtpk(P[B_+2], P[B_+3]);                          \
        unsigned b0 = cvtpk(P[B_+4], P[B_+5]), b1 = cvtpk(P[B_+6], P[B_+7]);                                             \
        auto r0 = __builtin_amdgcn_permlane32_swap(a0, b0, false, false); auto r1 = __builtin_amdgcn_permlane32_swap(a1, b1, false, false); \
        u32x4 w = {r0[0], r1[0], r0[1], r1[1]}; OUT = *reinterpret_cast<bf16x8*>(&w); } while (0)
__device__ __forceinline__ void finishSM(f32x16& p0, f32x16& p1, float alpha, float& l_reg, bf16x8& pa0, bf16x8& pa1, bf16x8& pa2, bf16x8& pa3) {
#pragma unroll
    for (int r = 0; r < 16; ++r) p1[r] = __builtin_amdgcn_exp2f(p1[r]);
    float ps = 0;
#pragma unroll
    for (int r = 0; r < 16; ++r) ps += p0[r];
#pragma unroll
    for (int r = 0; r < 16; ++r) ps += p1[r];
    { auto rr = __builtin_amdgcn_permlane32_swap(__float_as_uint(ps), __float_as_uint(ps), false, false);
      ps = __uint_as_float(rr[0]) + __uint_as_float(rr[1]); }
    l_reg = l_reg * alpha + ps;
    PK4(p0, 0, pa0); PK4(p0, 8, pa1); PK4(p1, 0, pa2); PK4(p1, 8, pa3);
}
__device__ __forceinline__ void qkt(f32x16& p0, f32x16& p1, const LAS char* Kb, int r32, int hi, const bf16x8 (&qr)[8]) {
    p0 = f32x16{}; p1 = f32x16{};
    const LAS char* kb4[4];
#pragma unroll
    for (int dd = 0; dd < 4; ++dd) kb4[dd] = Kb + KSWZ(r32, (dd * 16 + hi * 8) * 2);
#pragma unroll
    for (int d0 = 0; d0 < 8; ++d0) { const LAS char* a = kb4[d0 & 3] + (d0 >> 2) * 128;
        const bf16x8 b0 = *reinterpret_cast<const LAS bf16x8*>(a);
        const bf16x8 b1 = *reinterpret_cast<const LAS bf16x8*>(a + 32 * 256);
        p0 = __builtin_amdgcn_mfma_f32_32x32x16_bf16(b0, qr[d0], p0, 0, 0, 0);
        p1 = __builtin_amdgcn_mfma_f32_32x32x16_bf16(b1, qr[d0], p1, 0, 0, 0); }
}
__device__ __forceinline__ void pv_tile(f32x16 (&o)[4], int vb, bf16x8 pa0, bf16x8 pa1, bf16x8 pa2, bf16x8 pa3) {
#define TRRD(dst, off) asm volatile("ds_read_b64_tr_b16 %0, %1 offset:%2" : "=&v"(dst) : "v"(vb), "i"(off) : "memory")
#define PV_RD(S, d0) do { constexpr int b_ = (d0) * 512; TRRD(S##l0, b_); TRRD(S##h0, b_ + 2048); TRRD(S##l1, b_ + 4096); TRRD(S##h1, b_ + 6144); TRRD(S##l2, b_ + 8192); TRRD(S##h2, b_ + 10240); TRRD(S##l3, b_ + 12288); TRRD(S##h3, b_ + 14336); } while (0)
#define PV_MM(S, d0) do { \
        o[d0] = __builtin_amdgcn_mfma_f32_32x32x16_bf16(pa0, (bf16x8){S##l0[0], S##l0[1], S##l0[2], S##l0[3], S##h0[0], S##h0[1], S##h0[2], S##h0[3]}, o[d0], 0, 0, 0);   \
        o[d0] = __builtin_amdgcn_mfma_f32_32x32x16_bf16(pa1, (bf16x8){S##l1[0], S##l1[1], S##l1[2], S##l1[3], S##h1[0], S##h1[1], S##h1[2], S##h1[3]}, o[d0], 0, 0, 0);   \
        o[d0] = __builtin_amdgcn_mfma_f32_32x32x16_bf16(pa2, (bf16x8){S##l2[0], S##l2[1], S##l2[2], S##l2[3], S##h2[0], S##h2[1], S##h2[2], S##h2[3]}, o[d0], 0, 0, 0);   \
        o[d0] = __builtin_amdgcn_mfma_f32_32x32x16_bf16(pa3, (bf16x8){S##l3[0], S##l3[1], S##l3[2], S##l3[3], S##h3[0], S##h3[1], S##h3[2], S##h3[3]}, o[d0], 0, 0, 0); } while (0)
    s16x4 Al0, Al1, Al2, Al3, Ah0, Ah1, Ah2, Ah3, Bl0, Bl1, Bl2, Bl3, Bh0, Bh1, Bh2, Bh3;
    PV_RD(A, 0); PV_RD(B, 1);
    asm volatile("s_waitcnt lgkmcnt(8)" ::: "memory"); SBAR(); PV_MM(A, 0); SBAR();
    PV_RD(A, 2);
    asm volatile("s_waitcnt lgkmcnt(8)" ::: "memory"); SBAR(); PV_MM(B, 1); SBAR();
    PV_RD(B, 3);
    asm volatile("s_waitcnt lgkmcnt(8)" ::: "memory"); SBAR(); PV_MM(A, 2); SBAR();
    asm volatile("s_waitcnt lgkmcnt(0)" ::: "memory"); SBAR(); PV_MM(B, 3);
#undef PV_RD
#undef PV_MM
#undef TRRD
}

template <class Cfg>
__device__ __forceinline__ void attn_tiles(const Cfg& c, LAS char* lds, const bf16x8 (&qr)[8], f32x16 (&o)[4], float& m_reg, float& l_reg, const int t_lo, const int t_hi, const int wv) {
    const int tid = opq_tid(wv), lane = tid & 63, wid = __builtin_amdgcn_readfirstlane(tid >> 6), r32 = lane & 31, hi = lane >> 5;
    LAS char* V_lds = lds + L_V; LAS char* K_lds = lds + L_K;
    LAS float* al_l = (LAS float*)(lds + L_WS) + wid * 64 + 32;
    const int sr = tid >> 4, sc = (tid & 15) * 8;
    const int vst0 = v_st(sr, sc), vst1 = v_st(32 + sr, sc), kws = KSWZ(sr, sc * 2);
    const int vb0 = (int)(unsigned)(uintptr_t)V_lds + v_rd_base(lane);
    bf16x8 sk0, sk1, sv0, sv1;
    const bf16_t *gk0 = nullptr, *gk1 = nullptr, *gv0 = nullptr, *gv1 = nullptr;
#define AT_LOAD(t) do { gk0 = c.krow((t), sr) + sc; gk1 = c.krow((t), sr + 32) + sc; sk0 = *(const bf16x8*)gk0; sk1 = *(const bf16x8*)gk1; \
        if constexpr (Cfg::MODE == 0) { gv0 = c.vrow((t), sr) + sc; gv1 = c.vrow((t), sr + 32) + sc; sv0 = *(const bf16x8*)gv0; sv1 = *(const bf16x8*)gv1; } \
        asm volatile("" ::: "memory"); SBAR(); } while (0)
#define AT_WRITE(t, bf) do { asm volatile("" :: "v"(gk0), "v"(gk1), "v"(gv0), "v"(gv1)); *(LAS bf16x8*)(K_lds + (bf) * SHM_K + kws) = sk0; *(LAS bf16x8*)(K_lds + (bf) * SHM_K + kws + 32 * 256) = sk1; \
        if constexpr (Cfg::MODE == 1) { \
            _Pragma("unroll") for (int i_ = 0; i_ < 8; ++i_) { const int n_ = sc + i_, c0_ = 64 * (t) + sr, c1_ = c0_ + 32; \
                sv0[i_] = (c0_ >= 4 * n_ - 1 && c0_ <= 4 * n_ + 3) ? (short)0x3F80 : (short)0; sv1[i_] = (c1_ >= 4 * n_ - 1 && c1_ <= 4 * n_ + 3) ? (short)0x3F80 : (short)0; } } \
        *(LAS bf16x8*)(V_lds + (bf) * SHM_V + vst0) = sv0; *(LAS bf16x8*)(V_lds + (bf) * SHM_V + vst1) = sv1; } while (0)
    __builtin_amdgcn_s_waitcnt(0x0F70);
    __syncthreads();
    if (t_lo < t_hi) { AT_LOAD(t_lo); AT_WRITE(t_lo, 0); }
    __syncthreads();
    for (int t = t_lo; t < t_hi; ++t) {
        const int buf = (t - t_lo) & 1; const bool more = (t + 1 < t_hi);
        if (more) AT_LOAD(t + 1);
        if (c.active(t)) {
            f32x16 p0, p1;
            qkt(p0, p1, K_lds + buf * SHM_K, r32, hi, qr);
            if constexpr (Cfg::MODE == 0) {
                float mn, alpha; bf16x8 pa0, pa1, pa2, pa3;
                bool rok; float rbias;
                if (c.rowconst(t, rok, rbias)) partialSM_row(p0, p1, m_reg, mn, alpha, rok, rbias);
                else { c.mask(p0, p1, t); partialSM(p0, p1, m_reg, mn, alpha); }
                if (__any(alpha < 1.f)) { if (hi == 0) al_l[r32] = alpha; LDS_WAIT();
#pragma unroll
                    for (int d_ = 0; d_ < 4; ++d_)
#pragma unroll
                        for (int r = 0; r < 16; ++r) o[d_][r] *= al_l[crow(r, hi)]; }
                finishSM(p0, p1, alpha, l_reg, pa0, pa1, pa2, pa3); SBAR();
                pv_tile(o, vb0 + buf * SHM_V, pa0, pa1, pa2, pa3);
            } else {
                c.mask(p0, p1, t);
                const float mL = -c.mfix * LOG2E; const float il = c.invl;
#pragma unroll
                for (int r = 0; r < 16; ++r) { p0[r] = __builtin_amdgcn_exp2f(p0[r] + mL) * il; p1[r] = __builtin_amdgcn_exp2f(p1[r] + mL) * il; }
                bf16x8 pa0, pa1, pa2, pa3;
                PK4(p0, 0, pa0); PK4(p0, 8, pa1); PK4(p1, 0, pa2); PK4(p1, 8, pa3); SBAR();
                pv_tile(o, vb0 + buf * SHM_V, pa0, pa1, pa2, pa3);
#pragma unroll
                for (int r = 0; r < 16; r += 2) { const unsigned a = cvtpk(p0[r], p0[r + 1]), b = cvtpk(p1[r], p1[r + 1]);
                    p0[r] -= bflo(a); p0[r + 1] -= bfhi(a); p1[r] -= bflo(b); p1[r + 1] -= bfhi(b); }
                PK4(p0, 0, pa0); PK4(p0, 8, pa1); PK4(p1, 0, pa2); PK4(p1, 8, pa3); SBAR();
                pv_tile(o, vb0 + buf * SHM_V, pa0, pa1, pa2, pa3);
            }
        }
        if (more) AT_WRITE(t + 1, buf ^ 1);
        __syncthreads();
    }
#undef AT_LOAD
#undef AT_WRITE
}

template <class Cfg>
__device__ __forceinline__ void attn_tiles_s(const Cfg& c, LAS char* lds, const bf16x8 (&qr)[8], f32x16 (&o)[4], float& m_reg, float& l_reg, const int t_lo, const int t_hi, const int wv) {
    static_assert(Cfg::MODE == 0, "fixed-shift softmax tiles only");
    (void)m_reg;
    const int tid = opq_tid(wv), lane = tid & 63, wid = __builtin_amdgcn_readfirstlane(tid >> 6), r32 = lane & 31, hi = lane >> 5;
    LAS char* V_lds = lds + L_V; LAS char* K_lds = lds + L_K;
    const int sr = tid >> 4, sc = (tid & 15) * 8;
    const int vst0 = v_st(sr, sc), vst1 = v_st(32 + sr, sc), kws = KSWZ(sr, sc * 2);
    const int vb0 = (int)(unsigned)(uintptr_t)V_lds + v_rd_base(lane);
    bf16x8 sk0, sk1, sv0, sv1, pa0, pa1, pa2, pa3;
    const bf16_t *gk0 = nullptr, *gk1 = nullptr, *gv0 = nullptr, *gv1 = nullptr;
#define AS_LOAD(t) do { gk0 = c.krow((t), sr) + sc; gk1 = c.krow((t), sr + 32) + sc; sk0 = *(const bf16x8*)gk0; sk1 = *(const bf16x8*)gk1; \
        gv0 = c.vrow((t), sr) + sc; gv1 = c.vrow((t), sr + 32) + sc; sv0 = *(const bf16x8*)gv0; sv1 = *(const bf16x8*)gv1; asm volatile("" ::: "memory"); SBAR(); } while (0)
#define AS_WRITE(kbf, vbf) do { asm volatile("" :: "v"(gk0), "v"(gk1), "v"(gv0), "v"(gv1)); *(LAS bf16x8*)(K_lds + (kbf) * SHM_K + kws) = sk0; *(LAS bf16x8*)(K_lds + (kbf) * SHM_K + kws + 32 * 256) = sk1; \
        *(LAS bf16x8*)(V_lds + (vbf) * SHM_V + vst0) = sv0; *(LAS bf16x8*)(V_lds + (vbf) * SHM_V + vst1) = sv1; } while (0)
#define AS_SCORE(t, kbf) do { f32x16 p0, p1; float mz_ = 0.f, mn_, al_; bool rok_; float rb_; \
        qkt(p0, p1, K_lds + (kbf) * SHM_K, r32, hi, qr); \
        if (c.rowconst((t), rok_, rb_)) partialSM_row(p0, p1, mz_, mn_, al_, rok_, rb_); else { c.mask(p0, p1, (t)); partialSM(p0, p1, mz_, mn_, al_); } \
        finishSM(p0, p1, 1.f, l_reg, pa0, pa1, pa2, pa3); SBAR(); } while (0)
    if (t_lo >= t_hi) return;
    __builtin_amdgcn_s_waitcnt(0x0F70);
    __syncthreads();
    AS_LOAD(t_lo); AS_WRITE(0, 0);
    __syncthreads();
    int kb = 0, vb = 0;
    if (wid < 4) {
        for (int t = t_lo; t < t_hi; ++t) {
            const bool more = (t + 1 < t_hi); const int vn = (vb == 2) ? 0 : vb + 1;
            if (more) AS_LOAD(t + 1);
            if (c.active(t)) { AS_SCORE(t, kb); pv_tile(o, vb0 + vb * SHM_V, pa0, pa1, pa2, pa3); }
            if (more) AS_WRITE(kb ^ 1, vn);
            __syncthreads();
            kb ^= 1; vb = vn;
        }
    } else {
        bool pend = false; int vp = 0;
        for (int t = t_lo; t < t_hi; ++t) {
            const bool more = (t + 1 < t_hi); const int vn = (vb == 2) ? 0 : vb + 1;
            if (more) AS_LOAD(t + 1);
            if (pend) pv_tile(o, vb0 + vp * SHM_V, pa0, pa1, pa2, pa3);
            const bool act = c.active(t);
            if (act) AS_SCORE(t, kb);
            pend = act; vp = vb;
            if (more) AS_WRITE(kb ^ 1, vn);
            __syncthreads();
            kb ^= 1; vb = vn;
        }
        if (pend) pv_tile(o, vb0 + vp * SHM_V, pa0, pa1, pa2, pa3);
    }
#undef AS_LOAD
#undef AS_WRITE
#undef AS_SCORE
}

struct DilCfg {
    static constexpr int MODE = 0;
    const bf16_t* Kb; const bf16_t* Vb;
    const LAS float* tbl; int dshift, res, u, dqm, s0;
    __device__ __forceinline__ const bf16_t* krow(int t, int kk) const { int s = 256 * u - 128 + 64 * t + kk; s = s < 0 ? 0 : s; return Kb + (size_t)((s << dshift) + res) * PC; }
    __device__ __forceinline__ const bf16_t* vrow(int t, int kk) const { int s = 256 * u - 128 + 64 * t + kk; s = s < 0 ? 0 : s; return Vb + (size_t)((s << dshift) + res) * PC; }
    __device__ __forceinline__ bool active(int t) const { const int kb = 256 * u - 128 + 64 * t; return kb <= s0 + 31 && kb + 63 >= s0 - 128; }
    __device__ __forceinline__ bool rowconst(int, bool&, float&) const { return false; }
    __device__ __forceinline__ void mask(f32x16& p0, f32x16& p1, int t) const {
        const int dq = dqm - (256 * u - 128 + 64 * t);
        const LAS float* tb = tbl + (DT0 + dq - 63);
        float bb0[16], bb1[16];
#pragma unroll
        for (int r = 0; r < 16; ++r) { const int cc = (r & 3) + 8 * (r >> 2); bb0[r] = tb[63 - cc]; bb1[r] = tb[31 - cc]; }
#pragma unroll
        for (int r = 0; r < 16; ++r) asm volatile("" : "+v"(bb0[r]), "+v"(bb1[r]));
#pragma unroll
        for (int r = 0; r < 16; ++r) { p0[r] = p0[r] + bb0[r]; p1[r] = p1[r] + bb1[r]; }
    }
};
struct CmpCfg {
    static constexpr int MODE = 0;
    const bf16_t* Kb; const bf16_t* Vb; int cmax, hi4, cfull;
    __device__ __forceinline__ bool rowconst(int t, bool& ok, float& bias) const { ok = true; bias = 0.f; return 64 * t + 63 <= cfull; }
    __device__ __forceinline__ const bf16_t* krow(int t, int kk) const { return Kb + (size_t)(64 * t + kk) * HD; }
    __device__ __forceinline__ const bf16_t* vrow(int t, int kk) const { return Vb + (size_t)(64 * t + kk) * HD; }
    __device__ __forceinline__ bool active(int) const { return true; }
    __device__ __forceinline__ void mask(f32x16& p0, f32x16& p1, int t) const {
        const int cb = 64 * t + hi4; const float NEG = -__builtin_inff();
#pragma unroll
        for (int r = 0; r < 16; ++r) { const int cc = cb + (r & 3) + 8 * (r >> 2); if (cc > cmax) p0[r] = NEG; if (cc + 32 > cmax) p1[r] = NEG; }
    }
};
struct CmpImpCfg {
    static constexpr int MODE = 1;
    const bf16_t* Kb; int cmax, hi4; float mfix, invl;
    __device__ __forceinline__ const bf16_t* krow(int t, int kk) const { return Kb + (size_t)(64 * t + kk) * HD; }
    __device__ __forceinline__ const bf16_t* vrow(int, int) const { return Kb; }
    __device__ __forceinline__ bool active(int) const { return true; }
    __device__ __forceinline__ void mask(f32x16& p0, f32x16& p1, int t) const {
        const int cb = 64 * t + hi4; const float NEG = -__builtin_inff();
#pragma unroll
        for (int r = 0; r < 16; ++r) { const int cc = cb + (r & 3) + 8 * (r >> 2); if (cc > cmax) p0[r] = NEG; if (cc + 32 > cmax) p1[r] = NEG; }
    }
};
struct SlcCfg {
    static constexpr int MODE = 0;
    const bf16_t* Kb; const bf16_t* Vb;
    const LAS float* tblh;
    const LAS float* negt;
    unsigned s0, s1, s2, s3; int tqm, cur; float b31;
    __device__ __forceinline__ const bf16_t* krow(int t, int kk) const { return Kb + (size_t)(64 * t + kk) * PC; }
    __device__ __forceinline__ const bf16_t* vrow(int t, int kk) const { return Vb + (size_t)(64 * t + kk) * PC; }
    __device__ __forceinline__ bool selbit(int t) const { const unsigned q = (unsigned)t >> 5; const unsigned w = (q == 0u ? s0 + 0u : 0u) | (q == 1u ? s1 + 0u : 0u) | (q == 2u ? s2 + 0u : 0u) | (q == 3u ? s3 + 0u : 0u); return (w >> (t & 31)) & 1u; }
    __device__ __forceinline__ bool active(int t) const { return __any(selbit(t)); }
    __device__ __forceinline__ bool rowconst(int t, bool& ok, float& bias) const { ok = selbit(t); bias = b31; return 64 * (cur - t) - 63 >= 1513; }
    __device__ __forceinline__ void mask(f32x16& p0, f32x16& p1, int t) const {
        const bool sel = selbit(t); const int dq = tqm - 64 * t;
        const LAS float* tsel = tblh + (TBL0 + dq - 63); const LAS float* tb = sel ? tsel + 0 : negt + 0;
        float bb0[16], bb1[16];
#pragma unroll
        for (int r = 0; r < 16; ++r) { const int cc = (r & 3) + 8 * (r >> 2); bb0[r] = tb[63 - cc]; bb1[r] = tb[31 - cc]; }
#pragma unroll
        for (int r = 0; r < 16; ++r) asm volatile("" : "+v"(bb0[r]), "+v"(bb1[r]));
#pragma unroll
        for (int r = 0; r < 16; ++r) { p0[r] = p0[r] + bb0[r]; p1[r] = p1[r] + bb1[r]; }
    }
};
struct WinCfg {
    static constexpr int MODE = 0;
    const bf16_t* Kb; const bf16_t* Vb; const LAS float* tblh; const LAS float* tblw; int tqm, cur;
    __device__ __forceinline__ bool rowconst(int, bool&, float&) const { return false; }
    __device__ __forceinline__ const bf16_t* krow(int t, int kk) const { return Kb + (size_t)(64 * t + kk) * PC; }
    __device__ __forceinline__ const bf16_t* vrow(int t, int kk) const { return Vb + (size_t)(64 * t + kk) * PC; }
    __device__ __forceinline__ bool active(int) const { return true; }
    __device__ __forceinline__ void mask(f32x16& p0, f32x16& p1, int t) const {
        const int dq = tqm - 64 * t;
        const LAS float* ta = tblh + (TBL0 + dq - 63); const LAS float* tw = tblw + (dq - 63 - 440);
        const LAS float* tb = (t + 8 <= cur) ? tw + 0 : ta + 0;
        float bb0[16], bb1[16];
#pragma unroll
        for (int r = 0; r < 16; ++r) { const int cc = (r & 3) + 8 * (r >> 2); bb0[r] = tb[63 - cc]; bb1[r] = tb[31 - cc]; }
#pragma unroll
        for (int r = 0; r < 16; ++r) asm volatile("" : "+v"(bb0[r]), "+v"(bb1[r]));
#pragma unroll
        for (int r = 0; r < 16; ++r) { p0[r] = p0[r] + bb0[r]; p1[r] = p1[r] + bb1[r]; }
    }
};
template <class Cfg>
__device__ __forceinline__ void imp_tiles(const Cfg& c, LAS char* lds, const bf16x8 (&qr)[8], const int ntc, const int wv) {
    const int tid = opq_tid(wv), lane = tid & 63, wid = __builtin_amdgcn_readfirstlane(tid >> 6), r32 = lane & 31, hi = lane >> 5;
    LAS char* K_lds = lds + L_K;
    const int sr = tid >> 4, sc = (tid & 15) * 8;
    const int kws = KSWZ(sr, sc * 2);
    bf16x8 sk0, sk1; const bf16_t *gk0 = nullptr, *gk1 = nullptr;
#define IT_LOAD(t) do { gk0 = c.krow((t), sr) + sc; gk1 = c.krow((t), sr + 32) + sc; sk0 = *(const bf16x8*)gk0; sk1 = *(const bf16x8*)gk1; asm volatile("" ::: "memory"); SBAR(); } while (0)
#define IT_WRITE(bf) do { asm volatile("" :: "v"(gk0), "v"(gk1)); *(LAS bf16x8*)(K_lds + (bf) * SHM_K + kws) = sk0; *(LAS bf16x8*)(K_lds + (bf) * SHM_K + kws + 32 * 256) = sk1; } while (0)
#define IT_BLOCK(P, k, aval, dst) do { float g_ = (P[4 * (k)] + P[4 * (k) + 1]) + (P[4 * (k) + 2] + P[4 * (k) + 3]); \
        auto rr_ = __builtin_amdgcn_permlane32_swap(__float_as_uint(aval), __float_as_uint(P[4 * (k) + 3]), false, false); \
        g_ = (g_ + __uint_as_float(hi ? rr_[0] : rr_[1])) * il; \
        g_ += __int_as_float(__builtin_amdgcn_update_dpp(0, __float_as_int(g_), 0xB1, 0xF, 0xF, true)); g_ += __int_as_float(__builtin_amdgcn_update_dpp(0, __float_as_int(g_), 0x4E, 0xF, 0xF, true)); \
        if ((r32 & 3) == 0) irow[(dst)] = g_; } while (0)
    __builtin_amdgcn_s_waitcnt(0x0F70);
    __syncthreads();
    IT_LOAD(0); IT_WRITE(0);
    __syncthreads();
    float carry = 0.f;
    const float mL = -c.mfix * LOG2E, il = c.invl;
    LAS float* irow = (LAS float*)(lds + L_IMP) + (8 * wid + (r32 >> 2)) * 128 + hi;
    for (int t = 0; t < ntc; ++t) {
        const int buf = t & 1; const bool more = (t + 1 < ntc);
        if (more) IT_LOAD(t + 1);
        f32x16 p0, p1;
        qkt(p0, p1, K_lds + buf * SHM_K, r32, hi, qr);
        c.mask(p0, p1, t);
#pragma unroll
        for (int r = 0; r < 16; ++r) { p0[r] = __builtin_amdgcn_exp2f(p0[r] + mL); p1[r] = __builtin_amdgcn_exp2f(p1[r] + mL); }
        IT_BLOCK(p0, 0, carry, 16 * t + 0); IT_BLOCK(p0, 1, p0[3], 16 * t + 2); IT_BLOCK(p0, 2, p0[7], 16 * t + 4); IT_BLOCK(p0, 3, p0[11], 16 * t + 6);
        IT_BLOCK(p1, 0, p0[15], 16 * t + 8); IT_BLOCK(p1, 1, p1[3], 16 * t + 10); IT_BLOCK(p1, 2, p1[7], 16 * t + 12); IT_BLOCK(p1, 3, p1[11], 16 * t + 14);
        carry = p1[15];
        if (more) IT_WRITE(buf ^ 1);
        __syncthreads();
    }
#undef IT_LOAD
#undef IT_WRITE
#undef IT_BLOCK
}

}

__device__ __forceinline__ void load_q_normed(const bf16_t* qp  , const float* gain  , bf16x8 (&qr)[8]) {
    u32x4 raw[8];
#pragma unroll
    for (int d0 = 0; d0 < 8; ++d0) raw[d0] = *(const u32x4*)(qp + d0 * 16);
    float ss = 0.f;
#pragma unroll
    for (int d0 = 0; d0 < 8; ++d0) { const u32x4 w = raw[d0]; const float a0 = bflo(w.x), a1 = bfhi(w.x), a2 = bflo(w.y), a3 = bfhi(w.y), a4 = bflo(w.z), a5 = bfhi(w.z), a6 = bflo(w.w), a7 = bfhi(w.w);
        ss += ((a0 * a0 + a1 * a1) + (a2 * a2 + a3 * a3)) + ((a4 * a4 + a5 * a5) + (a6 * a6 + a7 * a7)); }
    { auto rr = __builtin_amdgcn_permlane32_swap(__float_as_uint(ss), __float_as_uint(ss), false, false); ss = __uint_as_float(rr[0]) + __uint_as_float(rr[1]); }
    const float rs = (QSCALE * LOG2E) / sqrtf(ss * (1.f / HD) + EPS);
#pragma unroll
    for (int d0 = 0; d0 < 8; ++d0) { const u32x4 w = raw[d0]; const f32x4 g0 = *(const f32x4*)(gain + d0 * 16), g1 = *(const f32x4*)(gain + d0 * 16 + 4);
        u32x4 o; o.x = cvtpk(bflo(w.x) * rs * g0.x, bfhi(w.x) * rs * g0.y); o.y = cvtpk(bflo(w.y) * rs * g0.z, bfhi(w.y) * rs * g0.w);
        o.z = cvtpk(bflo(w.z) * rs * g1.x, bfhi(w.z) * rs * g1.y); o.w = cvtpk(bflo(w.w) * rs * g1.z, bfhi(w.w) * rs * g1.w);
        qr[d0] = *reinterpret_cast<bf16x8*>(&o); }
}

__device__ __forceinline__ void dil_tiles(const att::DilCfg& c, LAS char* lds, const bf16x8 (&qr)[8], f32x16 (&o)[4], float& l_reg, const int wv) {
    using namespace att;
    const int tid = opq_tid(wv), lane = tid & 63, wid = __builtin_amdgcn_readfirstlane(tid >> 6), r32 = lane & 31, hi = lane >> 5;
    LAS char* V_lds = lds + L_V; LAS char* K_lds = lds + L_K;
    const int sr = tid >> 4, sc = (tid & 15) * 8;
    const int vst0 = v_st(sr, sc), vst1 = v_st(32 + sr, sc), kws = KSWZ(sr, sc * 2);
    const int vb0 = (int)(unsigned)(uintptr_t)V_lds + v_rd_base(lane);
    bf16x8 sk0, sk1, sv0, sv1;
    const bf16_t *gk0 = nullptr, *gk1 = nullptr, *gv0 = nullptr, *gv1 = nullptr;
#define DT_LOAD(t) do { gk0 = c.krow((t), sr) + sc; gk1 = c.krow((t), sr + 32) + sc; sk0 = *(const bf16x8*)gk0; sk1 = *(const bf16x8*)gk1; \
        gv0 = c.vrow((t), sr) + sc; gv1 = c.vrow((t), sr + 32) + sc; sv0 = *(const bf16x8*)gv0; sv1 = *(const bf16x8*)gv1; asm volatile("" ::: "memory"); SBAR(); } while (0)
#define DT_WRITE(slot) do { asm volatile("" :: "v"(gk0), "v"(gk1), "v"(gv0), "v"(gv1)); *(LAS bf16x8*)(K_lds + (slot) * SHM_K + kws) = sk0; *(LAS bf16x8*)(K_lds + (slot) * SHM_K + kws + 32 * 256) = sk1; \
        *(LAS bf16x8*)(V_lds + (slot) * SHM_V + vst0) = sv0; *(LAS bf16x8*)(V_lds + (slot) * SHM_V + vst1) = sv1; } while (0)
#define DT_COMP(t, slot) do { f32x16 p0, p1; float mz_ = 0.f, mn_, al_; bf16x8 pa0, pa1, pa2, pa3; \
        qkt(p0, p1, K_lds + (slot) * SHM_K, r32, hi, qr); c.mask(p0, p1, (t)); partialSM(p0, p1, mz_, mn_, al_); \
        finishSM(p0, p1, 1.f, l_reg, pa0, pa1, pa2, pa3); SBAR(); pv_tile(o, vb0 + (slot) * SHM_V, pa0, pa1, pa2, pa3); } while (0)
    const bool first = (c.u == 0);
    __builtin_amdgcn_s_waitcnt(0x0F70);
    __syncthreads();
    if (!first) { DT_LOAD(1); DT_WRITE(0); }
    DT_LOAD(4); DT_WRITE(1);
    __syncthreads();
    DT_LOAD(2);
    if (wid < 4) { if (!first) DT_COMP(1, 0); } else DT_COMP(4, 1);
    DT_WRITE(2);
    __syncthreads();
    DT_LOAD(3);
    if (wid < 6) DT_COMP(2, 2);
    DT_WRITE(0);
    __syncthreads();
    DT_LOAD(5);
    if (wid >= 2) DT_COMP(3, 0);
    DT_WRITE(1);
    if (!first) { DT_LOAD(0); DT_WRITE(2); }
    __syncthreads();
    if (wid < 2) { if (!first) DT_COMP(0, 2); } else if (wid >= 6) DT_COMP(5, 1);
#undef DT_LOAD
#undef DT_WRITE
#undef DT_COMP
}

__device__ __forceinline__ void dil_unit(LAS char* lds, const bf16_t* P, bf16_t* OA, float* LSE, const float* dilT, const float* qgain, int pat, int dshift, int unit, const int wv) {
    using namespace att;
    const int tid = opq_tid(wv), lane = tid & 63, wid = __builtin_amdgcn_readfirstlane(tid >> 6), r32 = lane & 31, hi = lane >> 5;
    const int bh = unit >> 5, ru = unit & 31, b = bh >> 3, h = bh & 7;
    const int ncs = 5 - dshift, res = ru >> ncs, u = ru & ((1 << ncs) - 1);
    LAS float* tbl = (LAS float*)(lds + L_TBL);
    __syncthreads();
    if (tid < DTS) tbl[tid] = dilT[(pat * 8 + h) * DTS + tid];
    const int s0 = 256 * u + 32 * wid, s_row = s0 + r32;
    const size_t tokrow = (size_t)b * SEQ + (size_t)((s_row << dshift) + res);
    bf16x8 qr[8];
    load_q_normed(P + tokrow * PC + C_QA + h * HD + hi * 8, qgain + hi * 8, qr);
    f32x16 o[4]; float m_reg, l_reg;
    m_reg = 0.f;
    if (pat == 0) { l_reg = 0.f;
#pragma unroll
        for (int d0 = 0; d0 < 4; ++d0) o[d0] = f32x16{}; }
    else { l_reg = LSE[tokrow * 8 + h];
#pragma unroll
        for (int r = 0; r < 16; ++r) { const size_t tr = (size_t)b * SEQ + (size_t)(((s0 + crow(r, hi)) << dshift) + res); const bf16_t* op = OA + tr * 1024 + h * HD + 4 * r32;
            { const u32x2 w = *(const u32x2*)op; o[0][r] = bflo(w.x); o[1][r] = bfhi(w.x); o[2][r] = bflo(w.y); o[3][r] = bfhi(w.y); } } }
    DilCfg c; c.Kb = P + (size_t)b * SEQ * PC + C_KA + h * HD; c.Vb = P + (size_t)b * SEQ * PC + C_VA + h * HD; c.tbl = tbl; c.dshift = dshift; c.res = res; c.u = u; c.dqm = s_row - 4 * hi; c.s0 = s0;
    dil_tiles(c, lds, qr, o, l_reg, wv);
    LAS float* li_l = (LAS float*)(lds + L_WS) + wid * 64;
    if (hi == 0) { li_l[r32] = l_reg; LSE[tokrow * 8 + h] = l_reg; }
    LDS_WAIT();
#pragma unroll
    for (int r = 0; r < 16; ++r) { const int orow = crow(r, hi); const float rl = (pat == 2) ? 1.0f / li_l[orow] : 1.0f;
        const size_t tr = (size_t)b * SEQ + (size_t)(((s0 + orow) << dshift) + res); bf16_t* op = OA + tr * 1024 + h * HD;
        { u32x2 w; w.x = cvtpk(o[0][r] * rl, o[1][r] * rl); w.y = cvtpk(o[2][r] * rl, o[3][r] * rl); *(u32x2*)(op + 4 * r32) = w; } }
}

__device__ __forceinline__ void nsa_finalize(LAS char* lds, const f32x16 (&o)[4], float l_reg, bf16_t* ON, int b, int g, int tok0, int br, const int wv) {
    using namespace att;
    const int tid = opq_tid(wv), lane = tid & 63, wid = __builtin_amdgcn_readfirstlane(tid >> 6), r32 = lane & 31, hi = lane >> 5;
    LAS float* li_l = (LAS float*)(lds + L_WS) + wid * 64;
    if (hi == 0) li_l[r32] = l_reg;
    LDS_WAIT();
    bf16_t* ONb = ON + (size_t)br * NTOK * 1024;
    const LAS float* GT = (const LAS float*)(lds + L_GATE) + (8 * wid + hi) * 12 + br;
#pragma unroll
    for (int r = 0; r < 16; ++r) { const int j = r & 3, k = r >> 2; const float lr = li_l[crow(r, hi)]; const float rl = lr > 0.f ? 1.0f / lr : 0.f;
        const size_t tok = (size_t)b * SEQ + tok0 + 2 * k + hi; const int hh = 4 * g + j;
        const float sc = rl * GT[(2 * k) * 12 + j * 3];
        bf16_t* op = ONb + tok * 1024 + hh * HD;
        { u32x2 w; w.x = cvtpk(o[0][r] * sc, o[1][r] * sc); w.y = cvtpk(o[2][r] * sc, o[3][r] * sc); *(u32x2*)(op + 4 * r32) = w; } }
}
__device__ __forceinline__ void nsa_unit(LAS char* lds, const bf16_t* P, const bf16_t* KC, const bf16_t* VC, bf16_t* ON, const float* nsaT, const float* gb, const float* qgain, int b, int g, int qi, bool load_tbl, const int wv) {
    using namespace att;
    const int tid = opq_tid(wv), lane = tid & 63, wid = __builtin_amdgcn_readfirstlane(tid >> 6), r32 = lane & 31, hi = lane >> 5;
    LAS float* tbl = (LAS float*)(lds + L_TBL); LAS float* IMP = (LAS float*)(lds + L_IMP); LAS unsigned* SELM = (LAS unsigned*)(lds + L_SELM);
    __syncthreads();
    if (load_tbl) for (int i = tid; i < 4 * TBLS; i += NTHR) tbl[i] = nsaT[(size_t)(4 * g) * TBLS + i];
    if (tid < 64) ((LAS float*)(lds + L_NEG))[tid] = -__builtin_inff();
    if (load_tbl) for (int i = tid; i < 4 * 136; i += NTHR) { const int h_ = i / 136, d_ = 440 + i % 136; ((LAS float*)(lds + L_TBLW))[i] = (d_ < 512) ? nsaT[(size_t)(4 * g + h_) * TBLS + TBL0 + d_] : -__builtin_inff(); }
    const int tok0 = 64 * qi + 8 * wid, tq = tok0 + (r32 >> 2), hd = r32 & 3;
    const bf16_t* Pb = P + (size_t)b * SEQ * PC;
    const int gi0 = tid, gi1 = (tid + NTHR < 768) ? tid + NTHR : 767;
    const bf16_t graw0 = Pb[(size_t)(64 * qi + gi0 / 12) * PC + C_GL + 12 * g + gi0 % 12], graw1 = Pb[(size_t)(64 * qi + gi1 / 12) * PC + C_GL + 12 * g + gi1 % 12];
    const bf16_t grbw0 = Pb[(size_t)(64 * qi + gi0 / 12) * PC + C_GL + 32 + 12 * g + gi0 % 12], grbw1 = Pb[(size_t)(64 * qi + gi1 / 12) * PC + C_GL + 32 + 12 * g + gi1 % 12];
    const float gbb0 = gb[12 * g + gi0 % 12], gbb1 = gb[12 * g + gi1 % 12];
    asm volatile("" ::: "memory"); SBAR();
    bf16x8 qr[8];
    load_q_normed(Pb + (size_t)tq * PC + C_QN + (4 * g + hd) * HD + hi * 8, qgain + hi * 8, qr);
    { LAS float* GTw = (LAS float*)(lds + L_GATE);
      GTw[gi0] = __builtin_amdgcn_rcpf(1.0f + __builtin_amdgcn_exp2f(-((bf2f(graw0) + bf2f(grbw0)) + gbb0) * LOG2E));
      if (tid + NTHR < 768) GTw[gi1] = __builtin_amdgcn_rcpf(1.0f + __builtin_amdgcn_exp2f(-((bf2f(graw1) + bf2f(grbw1)) + gbb1) * LOG2E)); }
    const bf16_t* KCb = KC + (size_t)(b * 2 + g) * 512 * HD; const bf16_t* VCb = VC + (size_t)(b * 2 + g) * 512 * HD;
    const int ntc = (qi >> 4) + 1, cmax = (tq - 31) >> 4;
    f32x16 o[4]; float m_reg, l_reg;
#pragma unroll
    for (int d0 = 0; d0 < 4; ++d0) o[d0] = f32x16{};
    m_reg = 0.f; l_reg = 0.f;
    { CmpCfg c; c.Kb = KCb; c.Vb = VCb; c.cmax = cmax; c.hi4 = 4 * hi; c.cfull = (64 * qi - 31) >> 4; attn_tiles_s(c, lds, qr, o, m_reg, l_reg, 0, ntc, wv); }
    nsa_finalize(lds, o, l_reg, ON, b, g, tok0, 0, wv);
    { CmpImpCfg c; c.Kb = KCb; c.cmax = cmax; c.hi4 = 4 * hi; c.mfix = 0.f; c.invl = l_reg > 0.f ? 1.0f / l_reg : 0.f;
      imp_tiles(c, lds, qr, ntc, wv); }
    { const int cur = qi;
#pragma unroll 1
      for (int t4 = 8 * wid; t4 < 8 * wid + 8; t4 += 4) {
        const int n0 = lane, n1 = 64 + lane;
        unsigned long long b0[4], b1[4];
        if (cur <= 15) {
#pragma unroll
            for (int q = 0; q < 4; ++q) { b0[q] = __ballot(n0 <= cur); b1[q] = 0ull; }
        } else {
            unsigned u0[4], u1[4], T[4];
#pragma unroll
            for (int q = 0; q < 4; ++q) { const float v0 = IMP[(t4 + q) * 128 + n0], v1 = IMP[(t4 + q) * 128 + n1];
                u0[q] = (n0 >= 1 && n0 <= cur - 2) ? __float_as_uint(v0) + 1u : 0u; u1[q] = (n1 <= cur - 2) ? __float_as_uint(v1) + 1u : 0u; T[q] = 0u; }
#pragma unroll 1
            for (int bit = 30; bit >= 0; --bit) {
#pragma unroll
                for (int q = 0; q < 4; ++q) { const unsigned cand = T[q] | (1u << bit);
                    const int cnt = __builtin_popcountll(__ballot(u0[q] >= cand)) + __builtin_popcountll(__ballot(u1[q] >= cand));
                    T[q] = (cnt >= 13) ? cand : T[q]; } }
#pragma unroll
            for (int q = 0; q < 4; ++q) {
                const bool gt0 = u0[q] > T[q], gt1 = u1[q] > T[q];
                const int need = 13 - (__builtin_popcountll(__ballot(gt0)) + __builtin_popcountll(__ballot(gt1)));
                const bool eq0 = (u0[q] == T[q]), eq1 = (u1[q] == T[q]);
                const unsigned long long m0 = __ballot(eq0), m1 = __ballot(eq1);
                const int pre0 = (int)__builtin_amdgcn_mbcnt_hi((unsigned)(m0 >> 32), __builtin_amdgcn_mbcnt_lo((unsigned)m0, 0u));
                const int pre1 = __builtin_popcountll(m0) + (int)__builtin_amdgcn_mbcnt_hi((unsigned)(m1 >> 32), __builtin_amdgcn_mbcnt_lo((unsigned)m1, 0u));
                const bool sel0 = (n0 == 0 || n0 == cur || n0 == cur - 1) || gt0 || (eq0 && pre0 < need);
                const bool sel1 = (n1 == cur || n1 == cur - 1) || gt1 || (eq1 && pre1 < need);
                b0[q] = __ballot(sel0); b1[q] = __ballot(sel1); }
        }
        if (lane == 0) {
#pragma unroll
            for (int q = 0; q < 4; ++q) { SELM[(t4 + q) * 4 + 0] = (unsigned)b0[q]; SELM[(t4 + q) * 4 + 1] = (unsigned)(b0[q] >> 32); SELM[(t4 + q) * 4 + 2] = (unsigned)b1[q]; SELM[(t4 + q) * 4 + 3] = (unsigned)(b1[q] >> 32); } } } }
    __syncthreads();
    int r32s = r32; asm volatile("" : "+v"(r32s));
    { SlcCfg c; c.Kb = Pb + C_KS + g * HD; c.Vb = Pb + C_VS + g * HD; c.tblh = tbl + (r32s & 3) * TBLS; c.negt = (const LAS float*)(lds + L_NEG); c.tqm = tok0 + (r32s >> 2) - 4 * hi; c.cur = qi; c.b31 = tbl[(r32s & 3) * TBLS + TBL0 + 1600];
      const int tl = 8 * wid + (r32s >> 2); c.s0 = SELM[tl * 4 + 0]; c.s1 = SELM[tl * 4 + 1]; c.s2 = SELM[tl * 4 + 2]; c.s3 = SELM[tl * 4 + 3];
#pragma unroll
      for (int d0 = 0; d0 < 4; ++d0) o[d0] = f32x16{};
      m_reg = 0.f; l_reg = 0.f;
      attn_tiles_s(c, lds, qr, o, m_reg, l_reg, 0, qi + 1, wv); }
    nsa_finalize(lds, o, l_reg, ON, b, g, tok0, 1, wv);
    int r32w = r32; asm volatile("" : "+v"(r32w));
    { WinCfg c; c.Kb = Pb + C_KW + g * HD; c.Vb = Pb + C_VW + g * HD; c.tblh = tbl + (r32w & 3) * TBLS; c.tblw = (const LAS float*)(lds + L_TBLW) + (r32w & 3) * 136; c.tqm = tok0 + (r32w >> 2) - 4 * hi; c.cur = qi;
#pragma unroll
      for (int d0 = 0; d0 < 4; ++d0) o[d0] = f32x16{};
      m_reg = 0.f; l_reg = 0.f;
      attn_tiles_s(c, lds, qr, o, m_reg, l_reg, qi >= 8 ? qi - 8 : 0, qi + 1, wv); }
    nsa_finalize(lds, o, l_reg, ON, b, g, tok0, 2, wv);
}

constexpr int LDS_BYTES = 147456;
constexpr int LDS_MISC = 131072;
constexpr int LDS_ARGS = LDS_MISC + 64;
__device__ __forceinline__ unsigned long long arg_u64(LAS unsigned char* lds, int i) {
    const LAS unsigned* p = (const LAS unsigned*)(opq_lds(lds) + LDS_ARGS) + 2 * i;
    const unsigned lo = __builtin_amdgcn_readfirstlane(p[0]), hi = __builtin_amdgcn_readfirstlane(p[1]);
    return ((unsigned long long)hi << 32) | lo;
}
#define GAS __attribute__((address_space(1)))
__device__ __forceinline__ const float* arg_in(LAS unsigned char* lds, int i) { return (const float*)(GAS const float*)arg_u64(lds, i); }
__device__ __forceinline__ float* arg_out(LAS unsigned char* lds) { return (float*)(GAS float*)arg_u64(lds, 24); }
__device__ __forceinline__ unsigned char* arg_ws(LAS unsigned char* lds) { return (unsigned char*)(GAS unsigned char*)arg_u64(lds, 25); }
__device__ __forceinline__ int opq_bx() { int b = blockIdx.x; asm volatile("" : "+s"(b)); return b; }
__device__ __forceinline__ int opq_g() { int b = gridDim.x; asm volatile("" : "+s"(b)); return b; }

__device__ __forceinline__ void ph_prologue(LAS unsigned char* lds, const int wv) {
    lds = opq_lds(lds);
    const int tid = opq_tid(wv), lane = tid & 63, wave = __builtin_amdgcn_readfirstlane(tid >> 6), G = opq_g(), bx = opq_bx();
    const int gw = bx * NWAVES + wave, NGW = G * NWAVES;
    unsigned char* ws = arg_ws(lds);
    LAS float* scr = (LAS float*)(lds + wave * 16384);
    constexpr int I_UP = 32 * 176, I_DN = 88 * 64, I_IN = 32 * 177, I_OUT = 32 * 64, I_C1 = 64 * 16, I_Z = 928;
    constexpr int I_FFN = 2 * I_UP + I_DN, I_LAYER = 2 * I_FFN + I_IN + I_OUT + 2 * I_C1 + I_Z;
#define PRO_DECODE(it_, W_, K_, N_, WT_, mode_, off_, gain_, r_) do { const int l_ = (it_) / I_LAYER; int q_ = (it_) - l_ * I_LAYER; gain_ = nullptr; off_ = 0; mode_ = 0; \
        if (q_ < 2 * I_FFN) { const int half_ = q_ >= I_FFN; q_ -= half_ * I_FFN; \
            if (q_ < 2 * I_UP) { const int w3_ = q_ >= I_UP; q_ -= w3_ * I_UP; W_ = arg_in(lds, w3_ ? (half_ ? I_F2W3 : I_F1W3) : (half_ ? I_F2W1 : I_F1W1)) + (size_t)l_ * DM * DFF; K_ = DM; N_ = DFF; \
                WT_ = (bf16_t*)(ws + WS_WUP + (size_t)(l_ * 2 + half_) * SZ_WUP); mode_ = 1; off_ = w3_ * 128; gain_ = arg_in(lds, half_ ? I_F2N : I_F1N) + (size_t)l_ * DM; } \
            else { q_ -= 2 * I_UP; W_ = arg_in(lds, half_ ? I_F2W2 : I_F1W2) + (size_t)l_ * DFF * DM; K_ = DFF; N_ = DM; WT_ = (bf16_t*)(ws + WS_WDN + (size_t)(l_ * 2 + half_) * SZ_WDN); } } \
        else { q_ -= 2 * I_FFN; \
            if (q_ < I_IN) { W_ = arg_in(lds, I_WIN) + (size_t)l_ * DM * IN_COLS; K_ = DM; N_ = IN_COLS; WT_ = (bf16_t*)(ws + WS_WIN + (size_t)l_ * SZ_WIN); mode_ = 2; gain_ = arg_in(lds, I_MIXN) + (size_t)l_ * DM; } \
            else if (q_ < I_IN + I_OUT) { q_ -= I_IN; W_ = arg_in(lds, I_WOUT) + (size_t)l_ * DM * DM; K_ = DM; N_ = DM; WT_ = (bf16_t*)(ws + WS_WOUT + (size_t)l_ * SZ_WOUT); } \
            else if (q_ < I_IN + I_OUT + 2 * I_C1) { q_ -= I_IN + I_OUT; const int cv_ = q_ >= I_C1; q_ -= cv_ * I_C1; W_ = arg_in(lds, cv_ ? I_CVW1 : I_CKW1) + (size_t)l_ * 4096 * 512; K_ = 4096; N_ = 512; \
                WT_ = (bf16_t*)(ws + WS_WC1 + (size_t)l_ * SZ_WC1); off_ = cv_ * 512; } \
            else { q_ -= I_IN + I_OUT + 2 * I_C1; W_ = nullptr; K_ = 0; N_ = 0; WT_ = (bf16_t*)(ws + WS_WIN + (size_t)l_ * SZ_WIN); } } \
        r_ = q_; } while (0)
#define PRO_ZERO(WT_, r_) do { const int q = (r_) * 64 + lane, kt = q / 1856, rem = q - kt * 1856; u32x4* z = (u32x4*)((WT_) + ((size_t)(22 * 32 + kt) * 256 + 24) * 64) + rem; unsigned zr = 0u; asm volatile("" : "+v"(zr)); *z = (u32x4){zr, zr, zr, zr}; } while (0)
#pragma unroll 1
    for (int it = gw; it < DEPTH * I_LAYER; it += 2 * NGW) {
        const int itb = it + NGW; const bool hasb = itb < DEPTH * I_LAYER;
        const float *Wa, *Wb, *ga, *gb_; int Ka, Na, Kb, Nb, ma, mb, oa, ob, ra, rb; bf16_t *Ta, *Tb;
        PRO_DECODE(it, Wa, Ka, Na, Ta, ma, oa, ga, ra);
        PRO_DECODE((hasb ? itb : it), Wb, Kb, Nb, Tb, mb, ob, gb_, rb);
        f32x4 lda[8], ldb[8]; float gva[8], gvb[8];
        if (Wa) ti_issue(Wa, Ka, Na, ra, lane, ga, lda, gva);
        if (hasb && Wb) ti_issue(Wb, Kb, Nb, rb, lane, gb_, ldb, gvb);
        if (Wa) ti_finish(Ka, Na, Ta, ma, oa, scr, ra, lane, lda, gva); else PRO_ZERO(Ta, ra);
        if (hasb) { if (Wb) ti_finish(Kb, Nb, Tb, mb, ob, scr, rb, lane, ldb, gvb); else PRO_ZERO(Tb, rb); }
    }
#undef PRO_DECODE
#undef PRO_ZERO
    const float* xs = arg_in(lds, I_X); bf16_t* XB = (bf16_t*)(ws + WS_HB); float* SSQ = (float*)(ws + WS_SSQ);
    for (int m = gw; m < NTOK; m += NGW) {
        const f32x4* xr = (const f32x4*)(xs + (size_t)m * DM) + lane; f32x4 v[8]; float s = 0.f;
#pragma unroll
        for (int j = 0; j < 8; ++j) { v[j] = xr[64 * j]; s += (v[j].x * v[j].x + v[j].y * v[j].y) + (v[j].z * v[j].z + v[j].w * v[j].w); }
        s = wave_sum(s, lane);
#pragma unroll
        for (int j = 0; j < 8; ++j) { u32x2 w; w.x = cvtpk(v[j].x, v[j].y); w.y = cvtpk(v[j].z, v[j].w); *(u32x2*)(XB + kt_off(m, 256 * j + 4 * lane, DM)) = w; }
        if (lane < 32) SSQ[(size_t)m * 32 + lane] = (lane == 0) ? s : 0.f;
    }
}
__device__ __forceinline__ float gelu_tanh(float v) { const float u3 = 0.7978845608028654f * (v + 0.044715f * v * v * v); return 0.5f * v * (2.0f - 2.0f / (__expf(2.0f * u3) + 1.0f)); }
__device__ __forceinline__ void ph_cmp2(LAS unsigned char* lds, int l, const int wv) {
    lds = opq_lds(lds);
    const int tid = opq_tid(wv), lane = tid & 63, wave = __builtin_amdgcn_readfirstlane(tid >> 6), G = opq_g(), bx = opq_bx();
    unsigned char* ws = arg_ws(lds); const float* CP = (const float*)(ws + WS_CP);
    LAS float* CH = (LAS float*)lds;
    LAS float* RED = (LAS float*)(lds + 65536);
    const float* knn = arg_in(lds, I_KNN) + l * HD;
    for (int it = bx; it < 256; it += G) {
        const int R0 = it * 32, kv = R0 >> 12, rl0 = R0 & 4095;
        __syncthreads();
#pragma unroll 1
        for (int hb = 0; hb < 2; ++hb) {
            f32x4 pv[4][4];
#pragma unroll
            for (int q = 0; q < 4; ++q) { const int i4 = tid + (hb * 4 + q) * NTHR, rr = i4 >> 7, k4 = (i4 & 127) * 4;
#pragma unroll
                for (int ks = 0; ks < 4; ++ks) pv[q][ks] = *(const f32x4*)(CP + ((size_t)(kv * 4 + ks) * 4096 + rl0 + rr) * 512 + k4); }
            asm volatile("" ::: "memory"); SBAR();
#pragma unroll
            for (int q = 0; q < 4; ++q) { const int i4 = tid + (hb * 4 + q) * NTHR, rr = i4 >> 7, k4 = (i4 & 127) * 4;
                const f32x4 v = (pv[q][0] + pv[q][1]) + (pv[q][2] + pv[q][3]);
                f32x4 o; o.x = gelu_tanh(v.x); o.y = gelu_tanh(v.y); o.z = gelu_tanh(v.z); o.w = gelu_tanh(v.w);
                *(LAS f32x4*)(CH + rr * 512 + k4) = o; } }
        __syncthreads();
        const int n = tid & 127, rq = tid >> 7;
        const float* w2 = arg_in(lds, kv ? I_CVW2 : I_CKW2) + (size_t)l * 512 * HD + n;
        float acc[8];
#pragma unroll
        for (int i = 0; i < 8; ++i) acc[i] = 0.f;
#pragma unroll 4
        for (int k = 0; k < 512; k += 4) { const float w0 = w2[(size_t)k * HD], w1 = w2[(size_t)(k + 1) * HD], w2v = w2[(size_t)(k + 2) * HD], w3 = w2[(size_t)(k + 3) * HD];
#pragma unroll
            for (int i = 0; i < 8; ++i) { const f32x4 c = *(const LAS f32x4*)(CH + (rq * 8 + i) * 512 + k); acc[i] += (c.x * w0 + c.y * w1) + (c.z * w2v + c.w * w3); } }
        if (kv == 0) {
            float ss[8];
#pragma unroll
            for (int i = 0; i < 8; ++i) ss[i] = wave_sum(acc[i] * acc[i], lane);
            if (lane == 0) {
#pragma unroll
                for (int i = 0; i < 8; ++i) RED[wave * 8 + i] = ss[i]; }
            __syncthreads();
            const float gn = knn[n];
#pragma unroll
            for (int i = 0; i < 8; ++i) { const float tot = RED[(2 * rq) * 8 + i] + RED[(2 * rq + 1) * 8 + i]; acc[i] = acc[i] / sqrtf(tot * (1.f / HD) + EPS) * gn; }
        }
        bf16_t* dst = (bf16_t*)(ws + (kv ? WS_VC + 0 : WS_KC + 0)) + (size_t)(rl0 + rq * 8) * HD + (kv ? 32 * (n & 3) + (n >> 2) : n);
#pragma unroll
        for (int i = 0; i < 8; ++i) dst[(size_t)i * HD] = (bf16_t)f2bf(acc[i]);
    }
}
__device__ __forceinline__ void ph_outnorm(LAS unsigned char* lds, int l, const int wv) {
    lds = opq_lds(lds);
    const int tid = opq_tid(wv), lane = tid & 63, wave = __builtin_amdgcn_readfirstlane(tid >> 6), G = opq_g(), bx = opq_bx();
    const int gw = bx * NWAVES + wave, NGW = G * NWAVES;
    unsigned char* ws = arg_ws(lds); const bf16_t* OA = (const bf16_t*)(ws + WS_OA); const bf16_t* ON = (const bf16_t*)(ws + WS_ON); bf16_t* HB = (bf16_t*)(ws + WS_HP);
    const float* gn = arg_in(lds, I_ON) + (size_t)l * DM;
    const f32x4 ga0 = *(const f32x4*)(gn + lane * 8), ga1 = *(const f32x4*)(gn + lane * 8 + 4), ga2 = *(const f32x4*)(gn + 512 + lane * 8), ga3 = *(const f32x4*)(gn + 512 + lane * 8 + 4);
    const f32x4 gb0 = *(const f32x4*)(gn + 1024 + lane * 8), gb1 = *(const f32x4*)(gn + 1024 + lane * 8 + 4), gb2 = *(const f32x4*)(gn + 1536 + lane * 8), gb3 = *(const f32x4*)(gn + 1536 + lane * 8 + 4);
    bf16_t* y = HB;
    for (int m0 = gw; m0 < NTOK; m0 += 2 * NGW) {
        u32x4 wab[2][2], wn[2][6];
#pragma unroll
        for (int q = 0; q < 2; ++q) { const int mq = m0 + q * NGW; const size_t mc = (size_t)(mq < NTOK ? mq : NTOK - 1);
            const bf16_t* oa = OA + mc * 1024; wab[q][0] = *(const u32x4*)(oa + lane * 8); wab[q][1] = *(const u32x4*)(oa + 512 + lane * 8);
#pragma unroll
            for (int br = 0; br < 3; ++br) { const bf16_t* onb = ON + ((size_t)br * NTOK + mc) * 1024; wn[q][2 * br] = *(const u32x4*)(onb + lane * 8); wn[q][2 * br + 1] = *(const u32x4*)(onb + 512 + lane * 8); } }
#pragma unroll
        for (int q = 0; q < 2; ++q) asm volatile("" : "+v"(wab[q][0]), "+v"(wab[q][1]), "+v"(wn[q][0]), "+v"(wn[q][1]), "+v"(wn[q][2]), "+v"(wn[q][3]), "+v"(wn[q][4]), "+v"(wn[q][5]));
#pragma unroll
        for (int q = 0; q < 2; ++q) { const int m = m0 + q * NGW; if (m >= NTOK) break;
        const u32x4 wa = wab[q][0], wb = wab[q][1];
        float va[16] = {bflo(wa.x), bfhi(wa.x), bflo(wa.y), bfhi(wa.y), bflo(wa.z), bfhi(wa.z), bflo(wa.w), bfhi(wa.w), bflo(wb.x), bfhi(wb.x), bflo(wb.y), bfhi(wb.y), bflo(wb.z), bfhi(wb.z), bflo(wb.w), bfhi(wb.w)};
        float sa = 0.f;
#pragma unroll
        for (int i = 0; i < 16; ++i) sa += va[i] * va[i];
        float vs[16]; float sn = 0.f;
#pragma unroll
        for (int i = 0; i < 16; ++i) vs[i] = 0.f;
#pragma unroll
        for (int br = 0; br < 3; ++br) { const u32x4 wc = wn[q][2 * br], wd = wn[q][2 * br + 1];
            vs[0] += bflo(wc.x); vs[1] += bfhi(wc.x); vs[2] += bflo(wc.y); vs[3] += bfhi(wc.y); vs[4] += bflo(wc.z); vs[5] += bfhi(wc.z); vs[6] += bflo(wc.w); vs[7] += bfhi(wc.w);
            vs[8] += bflo(wd.x); vs[9] += bfhi(wd.x); vs[10] += bflo(wd.y); vs[11] += bfhi(wd.y); vs[12] += bflo(wd.z); vs[13] += bfhi(wd.z); vs[14] += bflo(wd.w); vs[15] += bfhi(wd.w); }
        const float ra = 1.0f / sqrtf(wave_sum(sa, lane) * (1.f / 1024.f) + EPS);
        { const f32x4 g0 = ga0, g1 = ga1, g2 = ga2, g3 = ga3;
          u32x4 o; o.x = cvtpk(va[0] * ra * g0.x, va[1] * ra * g0.y); o.y = cvtpk(va[2] * ra * g0.z, va[3] * ra * g0.w); o.z = cvtpk(va[4] * ra * g1.x, va[5] * ra * g1.y); o.w = cvtpk(va[6] * ra * g1.z, va[7] * ra * g1.w);
          *(u32x4*)(y + kt_off(m, lane * 8, DM)) = o;
          o.x = cvtpk(va[8] * ra * g2.x, va[9] * ra * g2.y); o.y = cvtpk(va[10] * ra * g2.z, va[11] * ra * g2.w); o.z = cvtpk(va[12] * ra * g3.x, va[13] * ra * g3.y); o.w = cvtpk(va[14] * ra * g3.z, va[15] * ra * g3.w);
          *(u32x4*)(y + kt_off(m, 512 + lane * 8, DM)) = o; }
#pragma unroll
        for (int i = 0; i < 16; ++i) sn += vs[i] * vs[i];
        const float rn = 1.0f / sqrtf(wave_sum(sn, lane) * (1.f / 1024.f) + EPS);
        { const f32x4 g0 = gb0, g1 = gb1, g2a = gb2, g3 = gb3;
          u32x4 o; o.x = cvtpk(vs[0] * rn * g0.x, vs[1] * rn * g0.y); o.y = cvtpk(vs[2] * rn * g0.z, vs[3] * rn * g0.w); o.z = cvtpk(vs[4] * rn * g1.x, vs[5] * rn * g1.y); o.w = cvtpk(vs[6] * rn * g1.z, vs[7] * rn * g1.w);
          *(u32x4*)(y + kt_off(m, 1024 + lane * 8, DM)) = o;
          o.x = cvtpk(vs[8] * rn * g2a.x, vs[9] * rn * g2a.y); o.y = cvtpk(vs[10] * rn * g2a.z, vs[11] * rn * g2a.w); o.z = cvtpk(vs[12] * rn * g3.x, vs[13] * rn * g3.y); o.w = cvtpk(vs[14] * rn * g3.z, vs[15] * rn * g3.w);
          *(u32x4*)(y + kt_off(m, 1536 + lane * 8, DM)) = o; }
        }
    }
}

#define GRID_BAR() do { XcdBarrier bar_; bar_.bar = (unsigned*)(arg_ws(lds) + WS_CTL) + CW_BAR; bar_.x = xb_xcc_id(); bar_.st = (volatile LAS unsigned*)(opq_lds(lds) + LDS_MISC + 32); xcd_barrier(bar_, wv); } while (0)
__global__ void __launch_bounds__(NTHR, 2) mega_fwd(Args a) {
    extern __shared__ __attribute__((aligned(16))) unsigned char lds_raw[];
    LAS unsigned char* lds = (LAS unsigned char*)lds_raw;
    const int wv = __builtin_amdgcn_readfirstlane((int)threadIdx.x >> 6);
    {
        const int tid = threadIdx.x;
        for (int u = tid; u < (LDS_BYTES - LDS_MISC) / 4; u += NTHR) ((LAS unsigned*)(lds + LDS_MISC))[u] = 0u;
        __syncthreads();
        if (tid == 0) { LAS unsigned long long* t = (LAS unsigned long long*)(lds + LDS_ARGS);
#pragma unroll
            for (int i = 0; i < 24; ++i) t[i] = (unsigned long long)(uintptr_t)a.in[i];
            t[24] = (unsigned long long)(uintptr_t)a.out; t[25] = (unsigned long long)(uintptr_t)a.ws; }
        __syncthreads();
    }
    (void)xcd_barrier_post((unsigned*)(arg_ws(lds) + WS_CTL) + CW_BAR, (volatile LAS unsigned*)(lds + LDS_MISC + 32));

    { const int tid = opq_tid(wv), G = opq_g(), bx = opq_bx(); const float* rb = arg_in(lds, I_RB); unsigned char* ws = arg_ws(lds);
      float* dilT = (float*)(ws + WS_TBL); float* nsaT = (float*)(ws + WS_TBL + 65536);
      for (int i = bx * NTHR + tid; i < 3 * 8 * DTS + 8 * TBLS; i += G * NTHR) {
          if (i < 3 * 8 * DTS) { const int p = i / (8 * DTS), h = (i / DTS) % 8, df = i % DTS - DT0; const int d = (p == 0) ? 1 : (p == 1 ? 4 : 16);
              dilT[i] = (df >= 0 && df <= 128) ? rb[rel_bucket_dev(df * d) * 16 + h] * LOG2E : -__builtin_inff(); }
          else { const int j = i - 3 * 8 * DTS, hh = j / TBLS, ds = j % TBLS - TBL0; nsaT[j] = (ds >= 0) ? rb[rel_bucket_dev(ds) * 16 + 8 + hh] * LOG2E : -__builtin_inff();     } } }

    ph_prologue(lds, wv);
    GRID_BAR();
#pragma unroll 1
    for (int step = 0; step < 2 * DEPTH; ++step) {
        const int l = step >> 1, half = step & 1;
        { unsigned char* ws = arg_ws(lds); const int G = opq_g(), bx = opq_bx();
          pg8::Gemm g{64, 64, DM}; pg8::SchedStd S; S.init(ws + WS_HB, ws + WS_WUP + (size_t)step * SZ_WUP, NTOK, 2 * DFF, DM, DM, G, bx); const pg8::EpiSwiGLU E{(bf16_t*)(ws + WS_HP), DFF, (const float*)(ws + WS_SSQ)};
          pg8::gemm_phase<pg8::EpiSwiGLU, pg8::SchedStd, 32768, 32768>(opq_lds(lds), g, S, E, wv);
        }
        GRID_BAR();
        { unsigned char* ws = arg_ws(lds); const int G = opq_g(), bx = opq_bx(); float* X = arg_out(lds);
          pg8::Gemm g{64, 64, DFF}; pg8::SchedStd S; S.init(ws + WS_HP, ws + WS_WDN + (size_t)step * SZ_WDN, NTOK, DM, DFF, DFF, G, bx, 4, 1);
          pg8::EpiResid E{(step == 2 * DEPTH - 1) ? X : (float*)nullptr, (bf16_t*)(ws + WS_HB), (float*)(ws + WS_SSQ), DM, 0.5f};
          pg8::gemm_phase<pg8::EpiResid, pg8::SchedStd, 32768, 32768>(opq_lds(lds), g, S, E, wv);
        }
        if (step == 2 * DEPTH - 1) break;
        GRID_BAR();
        if (half == 0) {
            { unsigned char* ws = arg_ws(lds); const int G = opq_g(), bx = opq_bx();
              pg8::Gemm g{64, 64, DM}; pg8::SchedStd S; S.init(ws + WS_HB, ws + WS_WIN + (size_t)l * SZ_WIN, NTOK, C_GL, DM, DM, G, bx); const pg8::EpiBf16 E{(bf16_t*)(ws + WS_HP), PC, (const float*)(ws + WS_SSQ), arg_in(lds, I_KNA) + l * HD, arg_in(lds, I_KNN) + l * HD, arg_in(lds, I_POS) + (size_t)l * 32 * HD, (bf16_t*)(ws + WS_ACMP), opq_lds(lds) + pg8::EX_LDS};
              pg8::gemm_phase<pg8::EpiBf16, pg8::SchedStd, 32768, 32768>(opq_lds(lds), g, S, E, wv);
            }
            { unsigned char* ws = arg_ws(lds); const int G = opq_g(), bx = opq_bx();
              pg8::Gemm g{64, 64, DM / 2}; pg8::SchedGate S; S.A = (const char*)(ws + WS_HB); S.Bt = (const char*)(ws + WS_WIN + (size_t)l * SZ_WIN); S.G = G; S.c = bx;
              const pg8::EpiGate E{(bf16_t*)(ws + WS_HP), PC, (const float*)(ws + WS_SSQ)};
              pg8::gemm_phase<pg8::EpiGate, pg8::SchedGate, 32768, 32768>(opq_lds(lds), g, S, E, wv);
            }
            GRID_BAR();
#pragma unroll 1
            for (int pat3 = 0; pat3 < 3; ++pat3) { const int pat = pat3 % 3;
                if (pat3 == 0) { unsigned char* ws = arg_ws(lds); const int G = opq_g(), bx = opq_bx();
                  pg8::Gemm g{64, 64, 1024}; pg8::SchedCmp S; S.A = (const char*)(ws + WS_ACMP); S.Bt = (const char*)(ws + WS_WC1 + (size_t)l * SZ_WC1); S.G = G; S.c = bx; pg8::EpiF32Z E{(float*)(ws + WS_CP), 512, (size_t)4096 * 512};
                  pg8::gemm_phase<pg8::EpiF32Z, pg8::SchedCmp, 32768, 32768>(opq_lds(lds), g, S, E, wv); }
                if (pat3 == 1) ph_cmp2(lds, l, wv);
                { unsigned char* ws = arg_ws(lds); const int G = opq_g(), bx = opq_bx();
                  for (int u0 = bx; u0 < 1024; u0 += G) { const int w_ = u0 & 255, k_ = u0 >> 8; const int unit = (((w_ & 7) + 8 * k_) << 5) | (w_ >> 3);
                    dil_unit((LAS char*)opq_lds(lds), (const bf16_t*)(ws + WS_HP), (bf16_t*)(ws + WS_OA), (float*)(ws + WS_LSE), (const float*)(ws + WS_TBL), arg_in(lds, I_QNA) + l * HD, pat, 2 * pat, unit, wv); } }
                if (pat3 + 1 < 3) GRID_BAR();
            }
            { unsigned char* ws = arg_ws(lds); const int G = opq_g(), bx = opq_bx();
              const float* gb = arg_in(lds, I_GB) + l * 24; const float* qgn = arg_in(lds, I_QNN) + l * HD;
              int last_bg = -1;
#pragma unroll 1
              for (int i4 = 0; i4 < 4; ++i4)
#pragma unroll 1
                  for (int w = bx; w < 256; w += G) { const int i = i4 & 3; const int bg = w & 7, j = w >> 3;
                      const int qi = (i == 0) ? 127 - j : (i == 1 ? j : (i == 2 ? 64 + j : 63 - j));
                      nsa_unit((LAS char*)opq_lds(lds), (const bf16_t*)(ws + WS_HP), (const bf16_t*)(ws + WS_KC), (const bf16_t*)(ws + WS_VC), (bf16_t*)(ws + WS_ON), (const float*)(ws + WS_TBL + 65536), gb, qgn, bg >> 1, bg & 1, qi, bg != last_bg, wv); last_bg = bg; } }
            GRID_BAR();
            ph_outnorm(lds, l, wv);
            GRID_BAR();
            { unsigned char* ws = arg_ws(lds); const int G = opq_g(), bx = opq_bx(); float* X = arg_out(lds);
              pg8::Gemm g{64, 64, DM}; pg8::SchedStd S; S.init(ws + WS_HP, ws + WS_WOUT + (size_t)l * SZ_WOUT, NTOK, DM, DM, DM, G, bx, 4); pg8::EpiResid E{(float*)nullptr, (bf16_t*)(ws + WS_HB), (float*)(ws + WS_SSQ), DM, 1.0f};
              pg8::gemm_phase<pg8::EpiResid, pg8::SchedStd, 32768, 32768>(opq_lds(lds), g, S, E, wv);
            }
            GRID_BAR();
        }
    }
}

extern "C" void kernel_launch(void* const* d_in, const int* in_sizes, int n_in, void* d_out, int out_size, void* d_ws, size_t ws_size, hipStream_t stream) {
    static int grid = 0;
    if (grid == 0) {
        if (n_in != 24 || in_sizes[0] != NTOK * DM || out_size != NTOK * DM || ws_size < WS_END) { fprintf(stderr, "kernel_launch: shape mismatch n_in %d in0 %d out %d ws %zu (need %zu)\n", n_in, n_in > 0 ? in_sizes[0] : -1, out_size, ws_size, (size_t)WS_END); grid = -1; return; }
        int dev = 0, cus = 0, per_cu = 0;
        if (hipGetDevice(&dev) != hipSuccess || hipDeviceGetAttribute(&cus, hipDeviceAttributeMultiprocessorCount, dev) != hipSuccess) { grid = -1; return; }
        if (hipFuncSetAttribute((const void*)mega_fwd, hipFuncAttributeMaxDynamicSharedMemorySize, LDS_BYTES) != hipSuccess) { fprintf(stderr, "kernel_launch: hipFuncSetAttribute failed\n"); grid = -1; return; }
        if (hipOccupancyMaxActiveBlocksPerMultiprocessor(&per_cu, (const void*)mega_fwd, NTHR, LDS_BYTES) != hipSuccess || per_cu < 1) { fprintf(stderr, "kernel_launch: occupancy query says %d\n", per_cu); (void)hipGetLastError(); if (per_cu < 1) { grid = -1; return; } }
        grid = cus;
    }
    if (grid < 0) return;
    if (hipMemsetAsync((char*)d_ws + WS_CTL, 0, CTL_ZERO_BYTES, stream) != hipSuccess) return;
    Args a{};
    for (int i = 0; i < 24; ++i) a.in[i] = (const float*)d_in[i];
    a.out = (float*)d_out; a.ws = (unsigned char*)d_ws;
    hipLaunchKernelGGL(mega_fwd, dim3(grid), dim3(NTHR), LDS_BYTES, stream, a);
    const hipError_t le = hipPeekAtLastError();
    if (le != hipSuccess) fprintf(stderr, "kernel_launch: launch failed: %s\n", hipGetErrorName(le));
}
```

```cpp
#include <hip/hip_runtime.h>
#include <cstdio>
#include <cstdint>

#define LAS __attribute__((address_space(3)))
typedef unsigned short bf16_t;
typedef short bf16x8 __attribute__((ext_vector_type(8)));
typedef short s16x4 __attribute__((ext_vector_type(4)));
typedef float f32x2 __attribute__((ext_vector_type(2)));
typedef float f32x4 __attribute__((ext_vector_type(4)));
typedef float f32x16 __attribute__((ext_vector_type(16)));
typedef unsigned u32x2 __attribute__((ext_vector_type(2)));
typedef unsigned u32x4 __attribute__((ext_vector_type(4)));

constexpr int BATCH = 4, SEQ = 8192, DM = 2048, DFF = 5632, NTOK = BATCH * SEQ, DEPTH = 4, HD = 128;
constexpr int IN_COLS = 5656, PC = 5888;
constexpr int C_QA = 0, C_KA = 1024, C_VA = 2048, C_QN = 3072, C_KC = 4096, C_VC = 4352, C_KS = 4608, C_VS = 4864, C_KW = 5120, C_VW = 5376, C_GL = 5632;
constexpr float EPS = 1e-6f, QSCALE = 0.08838834764831845f, LOG2E = 1.4426950408889634f;
constexpr int TBLS = 1704, TBL0 = 64;
constexpr int DTS = 320, DT0 = 96;
constexpr int NWAVES = 8, NTHR = 512;

constexpr size_t MiB = 1u << 20;
constexpr size_t WS_CTL = 0, CTL_ZERO_BYTES = 1 * MiB;
constexpr size_t WS_TBL = 1 * MiB;
constexpr size_t SZ_WUP = 44 * MiB, SZ_WDN = 22 * MiB, SZ_WIN = 23 * MiB, SZ_WOUT = 8 * MiB, SZ_WC1 = 8 * MiB;
constexpr size_t WS_WUP = 2 * MiB;
constexpr size_t WS_WDN = WS_WUP + 8 * SZ_WUP;
constexpr size_t WS_WIN = WS_WDN + 8 * SZ_WDN;
constexpr size_t WS_WOUT = WS_WIN + 4 * SZ_WIN;
constexpr size_t WS_WC1 = WS_WOUT + 4 * SZ_WOUT;
constexpr size_t WS_HB = WS_WC1 + 4 * SZ_WC1;
constexpr size_t WS_HP = WS_HB + 128 * MiB;
constexpr size_t WS_OA = WS_HP + 368 * MiB;
constexpr size_t WS_LSE = WS_OA + 64 * MiB;
constexpr size_t WS_ON = WS_LSE + 1 * MiB;
constexpr size_t WS_ACMP = WS_ON + 192 * MiB;
constexpr size_t WS_CP = WS_ACMP + 64 * MiB;
constexpr size_t WS_KC = WS_CP + 64 * MiB;
constexpr size_t WS_VC = WS_KC + 1 * MiB;
constexpr size_t WS_SSQ = WS_VC + 1 * MiB;
constexpr size_t WS_RSTD = WS_SSQ + 4 * MiB;
constexpr size_t WS_END = WS_RSTD + 1 * MiB;
constexpr int CW_BAR = 4096;

__device__ __forceinline__ unsigned f2bf(float f) { unsigned u = __builtin_bit_cast(unsigned, f); return (u + 0x7fffu + ((u >> 16) & 1u)) >> 16; }
__device__ __forceinline__ unsigned pk2(float lo, float hi) { return f2bf(lo) | (f2bf(hi) << 16); }
__device__ __forceinline__ float bf2f(bf16_t b) { return __builtin_bit_cast(float, ((unsigned)b) << 16); }
__device__ __forceinline__ float bflo(unsigned w) { return __builtin_bit_cast(float, w << 16); }
__device__ __forceinline__ float bfhi(unsigned w) { return __builtin_bit_cast(float, w & 0xffff0000u); }
__device__ __forceinline__ unsigned cvtpk(float lo, float hi) { unsigned r; asm volatile("v_cvt_pk_bf16_f32 %0, %1, %2" : "=v"(r) : "v"(lo), "v"(hi)); return r; }
__device__ __forceinline__ float shx(float v, int m, int lane) { return __builtin_bit_cast(float, __builtin_amdgcn_ds_bpermute((lane ^ m) << 2, __builtin_bit_cast(int, v))); }
__device__ __forceinline__ float wave_sum(float v, int lane) {
#pragma unroll
    for (int o = 1; o < 64; o <<= 1) v += shx(v, o, lane);
    return v;
}
__device__ __forceinline__ LAS unsigned char* opq_lds(LAS unsigned char* p) { unsigned a = (unsigned)(uintptr_t)p; asm volatile("" : "+s"(a)); return (LAS unsigned char*)(uintptr_t)a; }
__device__ __forceinline__ int opq_tid(int wv) { int l; asm volatile("v_mbcnt_lo_u32_b32 %0, -1, 0\n\tv_mbcnt_hi_u32_b32 %0, -1, %0" : "=v"(l)); return wv * 64 + l; }
__device__ __forceinline__ size_t kt_off(int r, int k, int K) { return (((size_t)(r >> 8) * (K >> 6) + (k >> 6)) * 256 + (r & 255)) * 64 + (k & 63); }
#define LDS_WAIT() asm volatile("s_waitcnt lgkmcnt(0)" ::: "memory")
#define VM_WAIT() asm volatile("s_waitcnt vmcnt(0)" ::: "memory")
#define SBAR() __builtin_amdgcn_sched_barrier(0)

#define XB_TMO      128
#define XB_XCNT(j)  (256  + 64 * (j))
#define XB_XSUB(j)  (1280 + 64 * (j))
#define XB_XGEN(j)  (2304 + 64 * (j))
#define XB_TOP      3328
#define XB_TOPGEN   3392
#define XCD_BAR_WORDS 3456
#define XB_SPIN_CAP (1u << 18)
__device__ __forceinline__ unsigned xb_ld(unsigned* p)              { return __hip_atomic_load(p, __ATOMIC_RELAXED, __HIP_MEMORY_SCOPE_AGENT); }
__device__ __forceinline__ unsigned xb_add(unsigned* p, unsigned v) { return __hip_atomic_fetch_add(p, v, __ATOMIC_RELAXED, __HIP_MEMORY_SCOPE_AGENT); }
__device__ __forceinline__ unsigned xb_xcc_id() { return (unsigned)__builtin_amdgcn_s_getreg((3 << 11) | 20) & 0xFu; }
#define XB_SPIN(cond, bar) do { unsigned _sp = 0; while (cond) { __builtin_amdgcn_s_sleep(1); \
    if ((++_sp & 255u) == 0u) { if (xb_ld(&(bar)[XB_TMO])) break; if (_sp > XB_SPIN_CAP) { atomicAdd(&(bar)[XB_TMO], 1u); break; } } } } while (0)
struct XcdBarrier { unsigned* bar; unsigned x; volatile LAS unsigned* st; };
__device__ __forceinline__ XcdBarrier xcd_barrier_post(unsigned* bar, volatile LAS unsigned* st) {
    XcdBarrier b; b.bar = bar; b.x = xb_xcc_id(); b.st = st;
    if (threadIdx.x == 0) (void)xb_add(&bar[XB_XCNT(b.x)], 1u);
    return b;
}
__device__ __forceinline__ void xcd_barrier_complete(unsigned* bar, unsigned x, unsigned& nloc, unsigned& nx) {
    const unsigned G = gridDim.x * gridDim.y * gridDim.z;
    unsigned sum, cnt, mine, sp = 0u;
    for (;;) {
        sum = 0u; cnt = 0u; mine = 0u;
#pragma unroll
        for (unsigned j = 0; j < 16; ++j) { const unsigned c = xb_ld(&bar[XB_XCNT(j)]); sum += c; cnt += (c > 0u) ? 1u : 0u; mine = (j == x) ? c : mine; }
        if (sum == G) break;
        __builtin_amdgcn_s_sleep(1);
        if ((++sp & 255u) == 0u) { if (xb_ld(&bar[XB_TMO])) break; if (sp > XB_SPIN_CAP) { atomicAdd(&bar[XB_TMO], 1u); break; } }
    }
    nloc = mine > 0u ? mine : 1u; nx = cnt > 0u ? cnt : 1u;
}
__device__ __forceinline__ void xcd_barrier(const XcdBarrier& b, const int wv) {
    asm volatile("s_waitcnt vmcnt(0)" ::: "memory");
    __syncthreads();
    if (opq_tid(wv) == 0) {
        unsigned* bar = b.bar; asm volatile("" : "+s"(bar));
        __builtin_amdgcn_s_waitcnt(0);
        unsigned nloc = b.st[0], nx = b.st[1];
        if (nloc == 0u) { xcd_barrier_complete(bar, b.x, nloc, nx); b.st[0] = nloc; b.st[1] = nx; }
        const unsigned old = xb_add(&bar[XB_XSUB(b.x)], 1u);
        const unsigned gen = old / nloc;
        if (old + 1u == (gen + 1u) * nloc) {
            __builtin_amdgcn_fence(__ATOMIC_RELEASE, "agent");
            asm volatile("s_waitcnt vmcnt(0)" ::: "memory");
            const unsigned og = xb_add(&bar[XB_TOP], 1u);
            const unsigned tg = og / nx;
            if (og + 1u == (tg + 1u) * nx) xb_add(&bar[XB_TOPGEN], 1u);
            else XB_SPIN(xb_ld(&bar[XB_TOPGEN]) == tg, bar);
            __builtin_amdgcn_fence(__ATOMIC_ACQUIRE, "agent");
            xb_add(&bar[XB_XGEN(b.x)], 1u);
            asm volatile("s_waitcnt vmcnt(0)" ::: "memory");
        } else {
            XB_SPIN(xb_ld(&bar[XB_XGEN(b.x)]) == gen, bar);
            __builtin_amdgcn_fence(__ATOMIC_ACQUIRE, "agent");
            asm volatile("s_waitcnt vmcnt(0)" ::: "memory");
        }
    }
    __syncthreads();
}

namespace pg8 {
constexpr int BM = 256, BK = 64, HALF = 128, HTB = HALF * BK * 2, STAGE_BYTES = 8 * HTB, NXCD = 8, WGM = 8;
__host__ __device__ __forceinline__ int lds_byte(int r, int c) { const int st = (r >> 4) * 2 + (c >> 5), rr = r & 15, cc = c & 31, ob = rr * 64 + cc * 2; return st * 1024 + (ob ^ (((ob >> 9) & 1) << 5)); }
__host__ __device__ __forceinline__ void stage_rc(int b, int& R, int& C) { const int st = b / 1024, sb = b % 1024, swz = sb ^ (((sb >> 9) & 1) << 5); R = (st >> 1) * 16 + swz / 64; C = (st & 1) * 32 + (swz % 64) / 2; }
__host__ __device__ __forceinline__ int perm32(int rho) { const int n = rho >> 4, i = rho & 15; return 8 * (i >> 2) + 4 * n + (i & 3); }
struct Unit { int pm, pn, z; };
struct Gemm { int lda, ldb, K; };
struct SchedStd {
    const char* A; const char* Bt; size_t atile, btile; int nM, nN, nwg, G, c, wgm, flip;
    __device__ __forceinline__ void init(const void* A_, const void* Bt_, int M, int N, int lda, int ldb, int G_, int c_, int wgm_ = WGM, int flip_ = 0) { wgm = wgm_; flip = flip_;
        A = (const char*)A_; Bt = (const char*)Bt_; atile = (size_t)BM * lda * 2; btile = (size_t)BM * ldb * 2; nM = M / BM; nN = N / BM; nwg = nM * nN; G = G_; c = c_; }
    __device__ __forceinline__ bool next(int i, Unit& u) const {
        const long L = (long)i * G + c; if (L >= nwg) return false;
        int wgid = (int)L; { const int q = nwg / NXCD, r = nwg % NXCD, xcd = wgid % NXCD, off = wgid / NXCD; wgid = (xcd < r ? xcd * (q + 1) : r * (q + 1) + (xcd - r) * q) + off; }
        const int nig = wgm * nN, gid = wgid / nig, fm = gid * wgm, gsz = (nM - fm) < wgm ? (nM - fm) : wgm;
        u.pm = fm + ((wgid % nig) % gsz); u.pn = (wgid % nig) / gsz; u.z = 0; if (flip) u.pm = nM - 1 - u.pm; return true;
    }
    __device__ __forceinline__ const char* a_ptr(const Unit& u) const { return A + (size_t)u.pm * atile; }
    __device__ __forceinline__ const char* b_ptr(const Unit& u) const { return Bt + (size_t)u.pn * btile; }
};
struct SchedCmp {
    const char* A; const char* Bt; int G, c;
    __device__ __forceinline__ bool next(int i, Unit& u) const { const int L = i * G + c; if (L >= 256) return false; u.z = L >> 5; u.pm = (L & 31) >> 1; u.pn = L & 1; return true; }
    __device__ __forceinline__ const char* a_ptr(const Unit& u) const { const int kv = u.z >> 2, ks = u.z & 3; return A + ((size_t)(kv * 16 + u.pm) * 64 + (size_t)ks * 16) * 32768; }
    __device__ __forceinline__ const char* b_ptr(const Unit& u) const { const int kv = u.z >> 2, ks = u.z & 3; return Bt + ((size_t)(kv * 2 + u.pn) * 64 + (size_t)ks * 16) * 32768; }
};
struct SchedGate {
    const char* A; const char* Bt; int G, c;
    __device__ __forceinline__ bool next(int i, Unit& u) const { const int L = i * G + c; if (L >= 256) return false; u.pm = L >> 1; u.pn = C_GL >> 8; u.z = L & 1; return true; }
    __device__ __forceinline__ const char* a_ptr(const Unit& u) const { return A + ((size_t)u.pm * 32 + (size_t)u.z * 16) * 32768; }
    __device__ __forceinline__ const char* b_ptr(const Unit& u) const { return Bt + ((size_t)u.pn * 32 + (size_t)u.z * 16) * 32768; }
};
constexpr int EX_LDS = 131072 + 4096;
struct EpiBf16 {
    static constexpr bool PERM = true;
    static constexpr bool ROWS = true;
    bf16_t* O; int ldc; const float* ssq; const float* kna; const float* knn; const float* pos; bf16_t* acmp; LAS unsigned char* xl;
    __device__ __forceinline__ void operator()(const f32x4 (&acc)[2][2][4][2], const Unit& u, int wr, int wc, int fr, int fq, const float (&pre)[8]) const {
        const int pn = u.pn, e0 = wc * 32 + 8 * fq, lane = fq * 16 + fr;
        const int row0 = u.pm * BM + wr * 64 + fr, col0 = pn * BM + e0;
        if ((pn >= 4 && pn < 8) || pn == 18 || pn == 20) {
            const float* ga = kna + e0; const float* gb = knn + e0; const float* gp = (pn < 8) ? ga + 0 : gb + 0;
            const f32x4 g0 = *(const f32x4*)gp, g1 = *(const f32x4*)(gp + 4);
            LAS float* X = (LAS float*)xl + ((wr * 256 + fr) * 4);
#pragma unroll
            for (int ai = 0; ai < 2; ++ai)
#pragma unroll
                for (int m = 0; m < 4; ++m) { const float rs = pre[ai * 4 + m];
#pragma unroll
                    for (int bj = 0; bj < 2; ++bj) { const f32x4 v0 = acc[ai][bj][m][0] * rs, v1 = acc[ai][bj][m][1] * rs;
                        float s = ((v0[0] * v0[0] + v0[1] * v0[1]) + (v0[2] * v0[2] + v0[3] * v0[3])) + ((v1[0] * v1[0] + v1[1] * v1[1]) + (v1[2] * v1[2] + v1[3] * v1[3]));
                        { auto r16 = __builtin_amdgcn_permlane16_swap(__float_as_uint(s), __float_as_uint(s), false, false); s = __uint_as_float(r16[0]) + __uint_as_float(r16[1]);
                          auto r32_ = __builtin_amdgcn_permlane32_swap(__float_as_uint(s), __float_as_uint(s), false, false); s = __uint_as_float(r32_[0]) + __uint_as_float(r32_[1]); }
                        if (fq == 0) X[((ai * 4 + m) * 2 + bj) * 64 + wc] = s; } }
            asm volatile("s_waitcnt lgkmcnt(0)" ::: "memory"); __builtin_amdgcn_s_barrier(); asm volatile("" ::: "memory");
#pragma unroll
            for (int ai = 0; ai < 2; ++ai)
#pragma unroll
                for (int m = 0; m < 4; ++m) { bf16_t* rowp = O + (size_t)(row0 + ai * HALF + m * 16) * ldc + col0; const float rs = pre[ai * 4 + m];
#pragma unroll
                    for (int bj = 0; bj < 2; ++bj) { const f32x4 t4 = *(const LAS f32x4*)(X + ((ai * 4 + m) * 2 + bj) * 64);
                        const float rh = rs / sqrtf(((t4[0] + t4[1]) + (t4[2] + t4[3])) * (1.f / 128.f) + 1e-6f);
                        const f32x4 v0 = acc[ai][bj][m][0] * rh * g0, v1 = acc[ai][bj][m][1] * rh * g1;
                        u32x4 w; w.x = cvtpk(v0[0], v0[1]); w.y = cvtpk(v0[2], v0[3]); w.z = cvtpk(v1[0], v1[1]); w.w = cvtpk(v1[2], v1[3]);
                        *(u32x4*)(rowp + bj * HALF) = w; } }
        } else if (pn == 16 || pn == 17) {
            const int kv = pn - 16;
            const float* pp = pos + fr * 128 + e0;
            const f32x4 pa0 = *(const f32x4*)pp, pa1 = *(const f32x4*)(pp + 4), pb0 = *(const f32x4*)(pp + 16 * 128), pb1 = *(const f32x4*)(pp + 16 * 128 + 4);
#pragma unroll
            for (int ai = 0; ai < 2; ++ai)
#pragma unroll
                for (int m = 0; m < 4; ++m) { const int rowb = u.pm * BM + ai * HALF + wr * 64 + m * 16, b = rowb >> 13, c1 = (rowb & 8191) >> 4; const float rs = pre[ai * 4 + m];
#pragma unroll
                    for (int bj = 0; bj < 2; ++bj) { const f32x4 v0 = acc[ai][bj][m][0] * rs, v1 = acc[ai][bj][m][1] * rs;
                        const int arow0 = kv * 4096 + (b * 2 + bj) * 512;
                        if (c1 <= 510) { u32x4 w; w.x = cvtpk(v0[0] + pa0[0], v0[1] + pa0[1]); w.y = cvtpk(v0[2] + pa0[2], v0[3] + pa0[3]); w.z = cvtpk(v1[0] + pa1[0], v1[1] + pa1[1]); w.w = cvtpk(v1[2] + pa1[2], v1[3] + pa1[3]);
                            *(u32x4*)(acmp + kt_off(arow0 + c1, fr * 128 + e0, 4096)) = w; }
                        else { unsigned zr = 0u; asm volatile("" : "+v"(zr)); const u32x4 z = {zr, zr, zr, zr}; *(u32x4*)(acmp + kt_off(arow0 + 511, fr * 128 + e0, 4096)) = z; *(u32x4*)(acmp + kt_off(arow0 + 511, (fr + 16) * 128 + e0, 4096)) = z; }
                        if (c1 >= 1) { u32x4 w; w.x = cvtpk(v0[0] + pb0[0], v0[1] + pb0[1]); w.y = cvtpk(v0[2] + pb0[2], v0[3] + pb0[3]); w.z = cvtpk(v1[0] + pb1[0], v1[1] + pb1[1]); w.w = cvtpk(v1[2] + pb1[2], v1[3] + pb1[3]);
                            *(u32x4*)(acmp + kt_off(arow0 + c1 - 1, (fr + 16) * 128 + e0, 4096)) = w; } } }
        } else {
#pragma unroll
            for (int ai = 0; ai < 2; ++ai)
#pragma unroll
                for (int m = 0; m < 4; ++m) { bf16_t* rowp = O + (size_t)(row0 + ai * HALF + m * 16) * ldc + col0; const float rs = pre[ai * 4 + m];
#pragma unroll
                    for (int bj = 0; bj < 2; ++bj) { const f32x4 v0 = acc[ai][bj][m][0] * rs, v1 = acc[ai][bj][m][1] * rs;
                        u32x4 w; w.x = cvtpk(v0[0], v0[1]); w.y = cvtpk(v0[2], v0[3]); w.z = cvtpk(v1[0], v1[1]); w.w = cvtpk(v1[2], v1[3]);
                        *(u32x4*)(rowp + bj * HALF) = w; } }
        }
    }
};
struct EpiGate {
    static constexpr bool PERM = true;
    static constexpr bool ROWS = true;
    bf16_t* O; int ldc; const float* ssq;
    __device__ __forceinline__ void operator()(const f32x4 (&acc)[2][2][4][2], const Unit& u, int wr, int wc, int fr, int fq, const float (&pre)[8]) const {
        if (wc != 0) return;
        const int row0 = u.pm * BM + wr * 64 + fr, col0 = C_GL + 32 * u.z + 8 * fq;
#pragma unroll
        for (int ai = 0; ai < 2; ++ai)
#pragma unroll
            for (int m = 0; m < 4; ++m) { const float rs = pre[ai * 4 + m]; const f32x4 v0 = acc[ai][0][m][0] * rs, v1 = acc[ai][0][m][1] * rs;
                u32x4 w; w.x = cvtpk(v0[0], v0[1]); w.y = cvtpk(v0[2], v0[3]); w.z = cvtpk(v1[0], v1[1]); w.w = cvtpk(v1[2], v1[3]);
                *(u32x4*)(O + (size_t)(row0 + ai * HALF + m * 16) * ldc + col0) = w; }
    }
};
struct EpiSwiGLU {
    static constexpr bool PERM = true;
    static constexpr bool ROWS = true;
    bf16_t* O; int ldc; const float* ssq;
    __device__ __forceinline__ void operator()(const f32x4 (&acc)[2][2][4][2], const Unit& u, int wr, int wc, int fr, int fq, const float (&pre)[8]) const {
        const int rowp0 = wr * 64 + fr, kt = 2 * u.pn + (wc >> 1), cit = (wc & 1) * 32 + 8 * fq;
        bf16_t* tile = O + ((size_t)u.pm * (ldc / 64) + kt) * (256 * 64) + cit;
#pragma unroll
        for (int ai = 0; ai < 2; ++ai)
#pragma unroll
            for (int m = 0; m < 4; ++m) { bf16_t* rowp = tile + (size_t)(rowp0 + ai * HALF + m * 16) * 64; const float rs = pre[ai * 4 + m];
                const float c2 = -rs * LOG2E, rs2 = rs * rs;
                f32x4 v[2];
#pragma unroll
                for (int n = 0; n < 2; ++n) { const f32x4 a = acc[ai][0][m][n], b = acc[ai][1][m][n];
                    const f32x4 t = a * c2, ab = a * b;
                    f32x4 d = {__builtin_amdgcn_exp2f(t[0]), __builtin_amdgcn_exp2f(t[1]), __builtin_amdgcn_exp2f(t[2]), __builtin_amdgcn_exp2f(t[3])};
                    d = d + 1.0f;
                    f32x4 r = {__builtin_amdgcn_rcpf(d[0]), __builtin_amdgcn_rcpf(d[1]), __builtin_amdgcn_rcpf(d[2]), __builtin_amdgcn_rcpf(d[3])};
                    r = r * rs2;
                    v[n] = ab * r; }
                u32x4 w; w.x = cvtpk(v[0][0], v[0][1]); w.y = cvtpk(v[0][2], v[0][3]); w.z = cvtpk(v[1][0], v[1][1]); w.w = cvtpk(v[1][2], v[1][3]);
                *(u32x4*)rowp = w; }
    }
};
struct EpiResid {
    static constexpr bool PERM = true;
    static constexpr bool ROWS = false;
    float* out; bf16_t* xb; float* ssq; int ldc; float alpha;
    __device__ __forceinline__ void operator()(const f32x4 (&acc)[2][2][4][2], const Unit& u, int wr, int wc, int fr, int fq, const float (&pre)[8]) const {
        const int row0 = u.pm * BM + wr * 64 + fr, col0 = u.pn * BM + wc * 32 + 8 * fq;
        u32x4 bs[4][2];
#define ER_LOAD(g) do { const int row_ = row0 + ((g) >> 2) * HALF + ((g) & 3) * 16; \
        _Pragma("unroll") for (int q_ = 0; q_ < 2; ++q_) bs[(g) & 3][q_] = *(const u32x4*)(xb + kt_off(row_, col0 + q_ * HALF, ldc)); } while (0)
        ER_LOAD(0); ER_LOAD(1); ER_LOAD(2); ER_LOAD(3);
        float ssg[8];
#pragma unroll
        for (int g = 0; g < 8; ++g) { const int ai = g >> 2, m = g & 3; const int row = row0 + ai * HALF + m * 16; float ss = 0.f;
#pragma unroll
            for (int bj = 0; bj < 2; ++bj) { const u32x4 b = bs[g & 3][bj];
                const f32x4 o0 = (f32x4){bflo(b.x), bfhi(b.x), bflo(b.y), bfhi(b.y)} + acc[ai][bj][m][0] * alpha, o1 = (f32x4){bflo(b.z), bfhi(b.z), bflo(b.w), bfhi(b.w)} + acc[ai][bj][m][1] * alpha;
                ss += ((o0.x * o0.x + o0.y * o0.y) + (o0.z * o0.z + o0.w * o0.w)) + ((o1.x * o1.x + o1.y * o1.y) + (o1.z * o1.z + o1.w * o1.w));
                if (out) { float* op_ = out + (size_t)row * ldc + col0 + bj * HALF; *(f32x4*)op_ = o0; *(f32x4*)(op_ + 4) = o1; }
                else { u32x4 w; w.x = cvtpk(o0.x, o0.y); w.y = cvtpk(o0.z, o0.w); w.z = cvtpk(o1.x, o1.y); w.w = cvtpk(o1.z, o1.w); *(u32x4*)(xb + kt_off(row, col0 + bj * HALF, ldc)) = w; } }
            if (g + 4 < 8) ER_LOAD(g + 4);
            ssg[g] = ss; }
#pragma unroll
        for (int g = 0; g < 8; ++g) { auto r16 = __builtin_amdgcn_permlane16_swap(__float_as_uint(ssg[g]), __float_as_uint(ssg[g]), false, false); ssg[g] = __uint_as_float(r16[0]) + __uint_as_float(r16[1]);
            auto r32_ = __builtin_amdgcn_permlane32_swap(__float_as_uint(ssg[g]), __float_as_uint(ssg[g]), false, false); ssg[g] = __uint_as_float(r32_[0]) + __uint_as_float(r32_[1]); }
        if (fq == 0 && !out) {
#pragma unroll
            for (int g = 0; g < 8; ++g) ssq[(size_t)(row0 + (g >> 2) * HALF + (g & 3) * 16) * 32 + u.pn * 4 + wc] = ssg[g]; }
#undef ER_LOAD
    }
};
struct EpiF32Z {
    static constexpr bool PERM = false;
    float* C; int ldc; size_t zstride;
    static constexpr bool ROWS = false;
    __device__ __forceinline__ void operator()(const f32x4 (&acc)[2][2][4][2], const Unit& u, int wr, int wc, int fr, int fq, const float (&pre)[8]) const {
        float* Cz = C + (size_t)u.z * zstride;
        const int row0 = u.pm * BM + wr * 64 + fr, col0 = u.pn * BM + wc * 32 + 4 * fq;
#pragma unroll
        for (int ai = 0; ai < 2; ++ai)
#pragma unroll
            for (int m = 0; m < 4; ++m) { float* rowp = Cz + (size_t)(row0 + ai * HALF + m * 16) * ldc + col0;
#pragma unroll
                for (int bj = 0; bj < 2; ++bj)
#pragma unroll
                    for (int n = 0; n < 2; ++n) *(f32x4*)(rowp + bj * HALF + n * 16) = acc[ai][bj][m][n]; }
    }
};

constexpr int RS_LDS = 131072 + 1024;
__device__ __forceinline__ void rows_to_lds(LAS unsigned char* lds, const float* ssq, int pm, int slot, int tid) {
    const int row = tid >> 1, half = tid & 1;
    const f32x4* p = (const f32x4*)(ssq + ((size_t)pm * BM + row) * 32 + half * 16);
    f32x4 a = p[0]; a = a + p[1]; a = a + p[2]; a = a + p[3];
    float s = (a.x + a.y) + (a.z + a.w); s += shx(s, 1, tid & 63);
    const float rs = 1.0f / sqrtf(s * (1.f / 2048.f) + 1e-6f);
    if (half == 0) *(LAS float*)(lds + RS_LDS + slot * 1024 + row * 4) = rs;
}
template <class Epi, class Sched, int KSTEP_A = 128, int KSTEP_B = 128>
__device__ __forceinline__ void gemm_phase(LAS unsigned char* lds, const Gemm g, const Sched& S, const Epi& E, const int wv) {
    const int tid = opq_tid(wv), wid = __builtin_amdgcn_readfirstlane(tid >> 6), lane = tid & 63, wr = wid >> 2, wc = wid & 3, fr = lane & 15, fq = lane >> 4;
    const int K = g.K, nt = K / BK;
    unsigned voffA[2], voffB[2];
#pragma unroll
    for (int i = 0; i < 2; ++i) { int R, C; stage_rc(tid * 16 + i * 8192, R, C); const int Rb = Epi::PERM ? ((R & ~31) + perm32(R & 31)) : R;
        voffA[i] = (unsigned)(R * g.lda + C) * 2u; voffB[i] = (unsigned)(Rb * g.ldb + C) * 2u; }
    constexpr size_t kstepA = (size_t)KSTEP_A, kstepB = (size_t)KSTEP_B;
    const size_t hstepA = (size_t)HALF * g.lda * 2, hstepB = (size_t)HALF * g.ldb * 2;
    const unsigned ldsw = (unsigned)wid * 1024u;
    const int aoff = lds_byte(wr * 64 + fr, fq * 8), boff = lds_byte(wc * 32 + fr, fq * 8);
#define PG8_SA(b, h) (((b) * 2 + (h)) * HTB)
#define PG8_SB(b, h) ((4 + (b) * 2 + (h)) * HTB)
#define PG8_STAGE(bufoff, gbase, voff) do { _Pragma("unroll") for (int _i = 0; _i < 2; ++_i) \
        __builtin_amdgcn_global_load_lds((const unsigned*)((const char*)(gbase) + (voff)[_i]), (LAS unsigned*)(lds + (bufoff) + ldsw + _i * 8192), 16, 0, 0); } while (0)
#define PG8_LDA(dst, b, h) do { _Pragma("unroll") for (int m = 0; m < 4; ++m) _Pragma("unroll") for (int k = 0; k < 2; ++k) dst[m][k] = *(const LAS bf16x8*)(lds + PG8_SA(b, h) + aoff + m * 2048 + k * 1024); } while (0)
#define PG8_LDB(dst, b, h) do { _Pragma("unroll") for (int n = 0; n < 2; ++n) _Pragma("unroll") for (int k = 0; k < 2; ++k) dst[n][k] = *(const LAS bf16x8*)(lds + PG8_SB(b, h) + boff + n * 2048 + k * 1024); } while (0)
#define PG8_MMA(ai, bj, At, Bt) do { __builtin_amdgcn_s_setprio(1); _Pragma("unroll") for (int m = 0; m < 4; ++m) _Pragma("unroll") for (int n = 0; n < 2; ++n) _Pragma("unroll") for (int k = 0; k < 2; ++k) \
        acc[ai][bj][m][n] = __builtin_amdgcn_mfma_f32_16x16x32_bf16(Bt[n][k], At[m][k], acc[ai][bj][m][n], 0, 0, 0); __builtin_amdgcn_s_setprio(0); } while (0)
#define PG8_WAIT_V(n) asm volatile("s_waitcnt vmcnt(" #n ")" ::: "memory")
#define PG8_WAIT_L(n) asm volatile("s_waitcnt lgkmcnt(" #n ")" ::: "memory")
#define PG8_BAR __builtin_amdgcn_s_barrier()
#define PG8_SCHED __builtin_amdgcn_sched_barrier(0)
    Unit cur, nxt; int ui = 0;
    if (!S.next(0, cur)) return;
    f32x4 acc[2][2][4][2];
#pragma unroll
    for (int a = 0; a < 2; ++a)
#pragma unroll
        for (int b = 0; b < 2; ++b)
#pragma unroll
            for (int m = 0; m < 4; ++m)
#pragma unroll
                for (int n = 0; n < 2; ++n) acc[a][b][m][n] = (f32x4){0.f, 0.f, 0.f, 0.f};
    bf16x8 At[4][2], B0[2][2], B1[2][2];
    const char* cA = S.a_ptr(cur); const char* cB = S.b_ptr(cur);
    float pre[8]; int rslot = 0; if constexpr (Epi::ROWS) rows_to_lds(lds, E.ssq, cur.pm, 0, tid);
    PG8_STAGE(PG8_SB(0, 0), cB, voffB); PG8_STAGE(PG8_SA(0, 0), cA, voffA); PG8_STAGE(PG8_SB(0, 1), cB + hstepB, voffB); PG8_STAGE(PG8_SA(0, 1), cA + hstepA, voffA);
    if (wr == 1) PG8_BAR;
    PG8_WAIT_V(4); PG8_BAR;
    PG8_STAGE(PG8_SB(1, 0), cB + kstepB, voffB); PG8_STAGE(PG8_SA(1, 0), cA + kstepA, voffA); PG8_STAGE(PG8_SB(1, 1), cB + hstepB + kstepB, voffB);
    PG8_WAIT_V(6); PG8_BAR;
    for (;;) {
        const bool has_next = S.next(ui + 1, nxt);
        const char* nA = has_next ? S.a_ptr(nxt) : cA; const char* nB = has_next ? S.b_ptr(nxt) : cB;
        for (int t = 0; t < nt; t += 2) {
            const bool last = (t == nt - 2);
            const char* a1 = cA + (size_t)(t + 1) * kstepA;
            const char* a2 = last ? nA : cA + (size_t)(t + 2) * kstepA; const char* b2 = last ? nB : cB + (size_t)(t + 2) * kstepB;
            const char* a3 = a2 + kstepA; const char* b3 = b2 + kstepB;
            PG8_LDB(B0, 0, 0); PG8_SCHED; PG8_LDA(At, 0, 0); PG8_STAGE(PG8_SA(1, 1), a1 + hstepA, voffA);
            PG8_WAIT_L(8); PG8_BAR; PG8_WAIT_L(0); PG8_MMA(0, 0, At, B0); PG8_BAR; PG8_SCHED;
            PG8_LDB(B1, 0, 1); PG8_STAGE(PG8_SB(0, 0), b2, voffB);
            PG8_BAR; PG8_WAIT_L(0); PG8_MMA(0, 1, At, B1); PG8_BAR;
            PG8_LDA(At, 0, 1); PG8_STAGE(PG8_SA(0, 0), a2, voffA);
            PG8_BAR; PG8_WAIT_L(0); PG8_MMA(1, 0, At, B0); PG8_BAR; PG8_SCHED;
            PG8_STAGE(PG8_SB(0, 1), b2 + hstepB, voffB);
            PG8_WAIT_V(6); PG8_BAR; PG8_MMA(1, 1, At, B1); PG8_BAR;
            PG8_LDB(B0, 1, 0); PG8_SCHED; PG8_LDA(At, 1, 0); PG8_STAGE(PG8_SA(0, 1), a2 + hstepA, voffA);
            PG8_WAIT_L(8); PG8_BAR; PG8_WAIT_L(0); PG8_MMA(0, 0, At, B0); PG8_BAR; PG8_SCHED;
            PG8_LDB(B1, 1, 1); PG8_STAGE(PG8_SB(1, 0), b3, voffB);
            PG8_BAR; PG8_WAIT_L(0); PG8_MMA(0, 1, At, B1); PG8_BAR;
            PG8_LDA(At, 1, 1); PG8_STAGE(PG8_SA(1, 0), a3, voffA);
            PG8_BAR; PG8_WAIT_L(0); PG8_MMA(1, 0, At, B0); PG8_BAR; PG8_SCHED;
            PG8_STAGE(PG8_SB(1, 1), b3 + hstepB, voffB);
            PG8_WAIT_V(6); PG8_BAR; PG8_MMA(1, 1, At, B1); PG8_BAR;
        }
        if constexpr (Epi::ROWS) {
#pragma unroll
            for (int i = 0; i < 8; ++i) pre[i] = *(const LAS float*)(lds + RS_LDS + rslot * 1024 + (wr * 64 + fr + (i >> 2) * HALF + (i & 3) * 16) * 4); }
        E(acc, cur, wr, wc, fr, fq, pre);
        if constexpr (Epi::ROWS) { if (has_next && nxt.pm != cur.pm) { rslot ^= 1; rows_to_lds(lds, E.ssq, nxt.pm, rslot, tid); } }
        if (!has_next) break;
#pragma unroll
        for (int a = 0; a < 2; ++a)
#pragma unroll
            for (int b = 0; b < 2; ++b)
#pragma unroll
                for (int m = 0; m < 4; ++m)
#pragma unroll
                    for (int n = 0; n < 2; ++n) acc[a][b][m][n] = (f32x4){0.f, 0.f, 0.f, 0.f};
        cur = nxt; cA = nA; cB = nB; ++ui;
    }
    PG8_WAIT_V(0);
    if (wr == 0) PG8_BAR;
    PG8_BAR;
#undef PG8_SA
#undef PG8_SB
#undef PG8_STAGE
#undef PG8_LDA
#undef PG8_LDB
#undef PG8_MMA
#undef PG8_WAIT_V
#undef PG8_WAIT_L
#undef PG8_BAR
#undef PG8_SCHED
}
}

struct Args { const float* in[24]; float* out; unsigned char* ws; };
enum { I_X = 0, I_F1N, I_F1W1, I_F1W3, I_F1W2, I_MIXN, I_WIN, I_GB, I_QNA, I_KNA, I_QNN, I_KNN, I_POS, I_CKW1, I_CKW2, I_CVW1, I_CVW2, I_ON, I_WOUT, I_F2N, I_F2W1, I_F2W3, I_F2W2, I_RB };

__device__ __forceinline__ void ti_issue(const float* W, int K, int N, int item, int lane, const float* gain, f32x4 (&ld)[8], float (&gv)[8]) {
    const int nblk = (N + 31) / 32, kb = item / nblk, nb = item % nblk, k0 = 64 * kb, n0 = 32 * nb;
    const int c4 = 4 * (lane & 7), nn = n0 + c4;
    (void)K;
#pragma unroll
    for (int i = 0; i < 8; ++i) { const int kk = 8 * i + (lane >> 3); ld[i] = (nn < N) ? *(const f32x4*)(W + (size_t)(k0 + kk) * N + nn) : (f32x4){0.f, 0.f, 0.f, 0.f}; gv[i] = gain ? gain[k0 + kk] : 1.0f; }
}
__device__ __forceinline__ void ti_finish(int K, int N, bf16_t* WT, int mode, int off, LAS float* scr, int item, int lane, const f32x4 (&ld)[8], const float (&gv)[8]) {
    const int nblk = (N + 31) / 32, kb = item / nblk, nb = item % nblk, k0 = 64 * kb, n0 = 32 * nb;
    const int c4 = 4 * (lane & 7);
#pragma unroll
    for (int i = 0; i < 8; ++i) { const int kk = 8 * i + (lane >> 3); const f32x4 v = ld[i] * gv[i]; LAS float* d = scr + kk * 33 + c4; d[0] = v.x; d[1] = v.y; d[2] = v.z; d[3] = v.w; }
    LDS_WAIT(); asm volatile("" ::: "memory");
    const int c = lane & 7;
#pragma unroll
    for (int j = 0; j < 4; ++j) { const int n = (lane >> 3) + 8 * j; const LAS float* sp = scr + (8 * c) * 33 + n;
        u32x4 o; o.x = pk2(sp[0 * 33], sp[1 * 33]); o.y = pk2(sp[2 * 33], sp[3 * 33]); o.z = pk2(sp[4 * 33], sp[5 * 33]); o.w = pk2(sp[6 * 33], sp[7 * 33]);
        const int ng = n0 + n; int dr = (mode == 1) ? ((ng >> 7) * 256 + (ng & 127) + off) : (ng + off);
        if (mode == 2) { const bool isv = (ng >= C_VA && ng < C_VA + 1024) || (ng >= C_VS && ng < C_VS + 256) || (ng >= C_VW && ng < C_VW + 256);
            dr = isv ? ((ng & ~127) | (32 * (ng & 3) + ((ng & 127) >> 2))) : ng; }
        if (ng < N) *(u32x4*)(WT + kt_off(dr, k0 + 8 * c, K)) = o; }
    LDS_WAIT(); asm volatile("" ::: "memory");
}
__device__ __forceinline__ int rel_bucket_dev(int n) {
    if (n < 16) return n;
    const float v = logf((float)n / 16.0f) / 4.852030263919617f * 16.0f;
    int b = 16 + (int)v; return b < 31 ? b : 31;
}
namespace att {
constexpr int SHM_V = 16384, SHM_K = 16384;
constexpr int L_V = 0  , L_K = 49152  , L_WS = 98304, L_TBL = 100352, L_SELM = L_TBL + 4 * TBLS * 4  , L_NEG = L_SELM + 1024  , L_TBLW = L_NEG + 256  , L_END = L_TBLW + 4 * 136 * 4;
constexpr int L_GATE = 131072 + 4096;
constexpr int L_IMP = 0;
static_assert(L_END <= 131072, "attention LDS map");
constexpr float THR = 8.f;
#define KSWZ(row, colB) ((row) * 256 + ((colB) ^ (((row) & 7) << 4)))
__device__ __forceinline__ int v_st(int k, int c) { const int kk = (k & ~0xC) | ((k & 4) << 1) | ((k & 8) >> 1); return ((kk >> 3) * 4 + (c >> 5)) * 512 + ((kk & 7) * 32 + (c & 31)) * 2; }
__device__ __forceinline__ int v_rd_base(int lane) { return ((lane & 3) << 3) | (((lane >> 2) & 3) << 6) | (((lane >> 4) & 1) << 5) | (((lane >> 5) & 1) << 8); }
__device__ __forceinline__ int crow(int r, int hi) { return (r & 3) + 8 * (r >> 2) + 4 * hi; }

__device__ __forceinline__ void partialSM(f32x16& p0, f32x16& p1, float& m_reg, float& mn, float& alpha) {
    (void)m_reg; mn = 0.f; alpha = 1.f;
#pragma unroll
    for (int r = 0; r < 16; ++r) p0[r] = __builtin_amdgcn_exp2f(p0[r]);
}
__device__ __forceinline__ void partialSM_row(f32x16& p0, f32x16& p1, float& m_reg, float& mn, float& alpha, bool ok, float bias) {
    (void)m_reg; mn = 0.f; alpha = 1.f;
    const float mnL = ok ? bias : -__builtin_inff();
#pragma unroll
    for (int r = 0; r < 16; ++r) p0[r] = __builtin_amdgcn_exp2f(p0[r] + mnL);
#pragma unroll
    for (int r = 0; r < 16; ++r) p1[r] = p1[r] + mnL;
}
#define PK4(P, B_, OUT) do { unsigned a0 = cvtpk(P[B_+0], P[B_+1]), a1 = cvtpk(P[B_+2], P[B_+3]);                          \
        unsigned b0 = cvtpk(P[B_+4], P[B_+5]), b1 = cvtpk(P[B_+6], P[B_+7]);                                             \
        auto r0 = __builtin_amdgcn_permlane32_swap(a0, b0, false, false); auto r1 = __builtin_amdgcn_permlane32_swap(a1, b1, false, false); \
        u32x4 w = {r0[0], r1[0], r0[1], r1[1]}; OUT = *reinterpret_cast<bf16x8*>(&w); } while (0)
__device__ __forceinline__ void finishSM(f32x16& p0, f32x16& p1, float alpha, float& l_reg, bf16x8& pa0, bf16x8& pa1, bf16x8& pa2, bf16x8& pa3) {
#pragma unroll
    for (int r = 0; r < 16; ++r) p1[r] = __builtin_amdgcn_exp2f(p1[r]);
    float ps = 0;
#pragma unroll
    for (int r = 0; r < 16; ++r) ps += p0[r];
#pragma unroll
    for (int r = 0; r < 16; ++r) ps += p1[r];
    { auto rr = __builtin_amdgcn_permlane32_swap(__float_as_uint(ps), __float_as_uint(ps), false, false);
      ps = __uint_as_float(rr[0]) + __uint_as_float(rr[1]); }
    l_reg = l_reg * alpha + ps;
    PK4(p0, 0, pa0); PK4(p0, 8, pa1); PK4(p1, 0, pa2); PK4(p1, 8, pa3);
}
__device__ __forceinline__ void qkt(f32x16& p0, f32x16& p1, const LAS char* Kb, int r32, int hi, const bf16x8 (&qr)[8]) {
    p0 = f32x16{}; p1 = f32x16{};
    const LAS char* kb4[4];
#pragma unroll
    for (int dd = 0; dd < 4; ++dd) kb4[dd] = Kb + KSWZ(r32, (dd * 16 + hi * 8) * 2);
#pragma unroll
    for (int d0 = 0; d0 < 8; ++d0) { const LAS char* a = kb4[d0 & 3] + (d0 >> 2) * 128;
        const bf16x8 b0 = *reinterpret_cast<const LAS bf16x8*>(a);
        const bf16x8 b1 = *reinterpret_cast<const LAS bf16x8*>(a + 32 * 256);
        p0 = __builtin_amdgcn_mfma_f32_32x32x16_bf16(b0, qr[d0], p0, 0, 0, 0);
        p1 = __builtin_amdgcn_mfma_f32_32x32x16_bf16(b1, qr[d0], p1, 0, 0, 0); }
}
__device__ __forceinline__ void pv_tile(f32x16 (&o)[4], int vb, bf16x8 pa0, bf16x8 pa1, bf16x8 pa2, bf16x8 pa3) {
#define TRRD(dst, off) asm volatile("ds_read_b64_tr_b16 %0, %1 offset:%2" : "=&v"(dst) : "v"(vb), "i"(off) : "memory")
#define PV_RD(S, d0) do { constexpr int b_ = (d0) * 512; TRRD(S##l0, b_); TRRD(S##h0, b_ + 2048); TRRD(S##l1, b_ + 4096); TRRD(S##h1, b_ + 6144); TRRD(S##l2, b_ + 8192); TRRD(S##h2, b_ + 10240); TRRD(S##l3, b_ + 12288); TRRD(S##h3, b_ + 14336); } while (0)
#define PV_MM(S, d0) do { \
        o[d0] = __builtin_amdgcn_mfma_f32_32x32x16_bf16(pa0, (bf16x8){S##l0[0], S##l0[1], S##l0[2], S##l0[3], S##h0[0], S##h0[1], S##h0[2], S##h0[3]}, o[d0], 0, 0, 0);   \
        o[d0] = __builtin_amdgcn_mfma_f32_32x32x16_bf16(pa1, (bf16x8){S##l1[0], S##l1[1], S##l1[2], S##l1[3], S##h1[0], S##h1[1], S##h1[2], S##h1[3]}, o[d0], 0, 0, 0);   \
        o[d0] = __builtin_amdgcn_mfma_f32_32x32x16_bf16(pa2, (bf16x8){S##l2[0], S##l2[1], S##l2[2], S##l2[3], S##h2[0], S##h2[1], S##h2[2], S##h2[3]}, o[d0], 0, 0, 0);   \
        o[d0] = __builtin_amdgcn_mfma_f32_32x32x16_bf16(pa3, (bf16x8){S##l3[0], S##l3[1], S##l3[2], S##l3[3], S##h3[0], S##h3[1], S##h3[2], S##h3[3]}, o[d0], 0, 0, 0); } while (0)
    s16x4 Al0, Al1, Al2, Al3, Ah0, Ah1, Ah2, Ah3, Bl0, Bl1, Bl2, Bl3, Bh0, Bh1, Bh2, Bh3;
    PV_RD(A, 0); PV_RD(B, 1);
    asm volatile("s_waitcnt lgkmcnt(8)" ::: "memory"); SBAR(); PV_MM(A, 0); SBAR();
    PV_RD(A, 2);
    asm volatile("s_waitcnt lgkmcnt(8)" ::: "memory"); SBAR(); PV_MM(B, 1); SBAR();
    PV_RD(B, 3);
    asm volatile("s_waitcnt lgkmcnt(8)" ::: "memory"); SBAR(); PV_MM(A, 2); SBAR();
    asm volatile("s_waitcnt lgkmcnt(0)" ::: "memory"); SBAR(); PV_MM(B, 3);
#undef PV_RD
#undef PV_MM
#undef TRRD
}

template <class Cfg>
__device__ __forceinline__ void attn_tiles(const Cfg& c, LAS char* lds, const bf16x8 (&qr)[8], f32x16 (&o)[4], float& m_reg, float& l_reg, const int t_lo, const int t_hi, const int wv) {
    const int tid = opq_tid(wv), lane = tid & 63, wid = __builtin_amdgcn_readfirstlane(tid >> 6), r32 = lane & 31, hi = lane >> 5;
    LAS char* V_lds = lds + L_V; LAS char* K_lds = lds + L_K;
    LAS float* al_l = (LAS float*)(lds + L_WS) + wid * 64 + 32;
    const int sr = tid >> 4, sc = (tid & 15) * 8;
    const int vst0 = v_st(sr, sc), vst1 = v_st(32 + sr, sc), kws = KSWZ(sr, sc * 2);
    const int vb0 = (int)(unsigned)(uintptr_t)V_lds + v_rd_base(lane);
    bf16x8 sk0, sk1, sv0, sv1;
    const bf16_t *gk0 = nullptr, *gk1 = nullptr, *gv0 = nullptr, *gv1 = nullptr;
#define AT_LOAD(t) do { gk0 = c.krow((t), sr) + sc; gk1 = c.krow((t), sr + 32) + sc; sk0 = *(const bf16x8*)gk0; sk1 = *(const bf16x8*)gk1; \
        if constexpr (Cfg::MODE == 0) { gv0 = c.vrow((t), sr) + sc; gv1 = c.vrow((t), sr + 32) + sc; sv0 = *(const bf16x8*)gv0; sv1 = *(const bf16x8*)gv1; } \
        asm volatile("" ::: "memory"); SBAR(); } while (0)
#define AT_WRITE(t, bf) do { asm volatile("" :: "v"(gk0), "v"(gk1), "v"(gv0), "v"(gv1)); *(LAS bf16x8*)(K_lds + (bf) * SHM_K + kws) = sk0; *(LAS bf16x8*)(K_lds + (bf) * SHM_K + kws + 32 * 256) = sk1; \
        if constexpr (Cfg::MODE == 1) { \
            _Pragma("unroll") for (int i_ = 0; i_ < 8; ++i_) { const int n_ = sc + i_, c0_ = 64 * (t) + sr, c1_ = c0_ + 32; \
                sv0[i_] = (c0_ >= 4 * n_ - 1 && c0_ <= 4 * n_ + 3) ? (short)0x3F80 : (short)0; sv1[i_] = (c1_ >= 4 * n_ - 1 && c1_ <= 4 * n_ + 3) ? (short)0x3F80 : (short)0; } } \
        *(LAS bf16x8*)(V_lds + (bf) * SHM_V + vst0) = sv0; *(LAS bf16x8*)(V_lds + (bf) * SHM_V + vst1) = sv1; } while (0)
    __builtin_amdgcn_s_waitcnt(0x0F70);
    __syncthreads();
    if (t_lo < t_hi) { AT_LOAD(t_lo); AT_WRITE(t_lo, 0); }
    __syncthreads();
    for (int t = t_lo; t < t_hi; ++t) {
        const int buf = (t - t_lo) & 1; const bool more = (t + 1 < t_hi);
        if (more) AT_LOAD(t + 1);
        if (c.active(t)) {
            f32x16 p0, p1;
            qkt(p0, p1, K_lds + buf * SHM_K, r32, hi, qr);
            if constexpr (Cfg::MODE == 0) {
                float mn, alpha; bf16x8 pa0, pa1, pa2, pa3;
                bool rok; float rbias;
                if (c.rowconst(t, rok, rbias)) partialSM_row(p0, p1, m_reg, mn, alpha, rok, rbias);
                else { c.mask(p0, p1, t); partialSM(p0, p1, m_reg, mn, alpha); }
                if (__any(alpha < 1.f)) { if (hi == 0) al_l[r32] = alpha; LDS_WAIT();
#pragma unroll
                    for (int d_ = 0; d_ < 4; ++d_)
#pragma unroll
                        for (int r = 0; r < 16; ++r) o[d_][r] *= al_l[crow(r, hi)]; }
                finishSM(p0, p1, alpha, l_reg, pa0, pa1, pa2, pa3); SBAR();
                pv_tile(o, vb0 + buf * SHM_V, pa0, pa1, pa2, pa3);
            } else {
                c.mask(p0, p1, t);
                const float mL = -c.mfix * LOG2E; const float il = c.invl;
#pragma unroll
                for (int r = 0; r < 16; ++r) { p0[r] = __builtin_amdgcn_exp2f(p0[r] + mL) * il; p1[r] = __builtin_amdgcn_exp2f(p1[r] + mL) * il; }
                bf16x8 pa0, pa1, pa2, pa3;
                PK4(p0, 0, pa0); PK4(p0, 8, pa1); PK4(p1, 0, pa2); PK4(p1, 8, pa3); SBAR();
                pv_tile(o, vb0 + buf * SHM_V, pa0, pa1, pa2, pa3);
#pragma unroll
                for (int r = 0; r < 16; r += 2) { const unsigned a = cvtpk(p0[r], p0[r + 1]), b = cvtpk(p1[r], p1[r + 1]);
                    p0[r] -= bflo(a); p0[r + 1] -= bfhi(a); p1[r] -= bflo(b); p1[r + 1] -= bfhi(b); }
                PK4(p0, 0, pa0); PK4(p0, 8, pa1); PK4(p1, 0, pa2); PK4(p1, 8, pa3); SBAR();
                pv_tile(o, vb0 + buf * SHM_V, pa0, pa1, pa2, pa3);
            }
        }
        if (more) AT_WRITE(t + 1, buf ^ 1);
        __syncthreads();
    }
#undef AT_LOAD
#undef AT_WRITE
}

template <class Cfg>
__device__ __forceinline__ void attn_tiles_s(const Cfg& c, LAS char* lds, const bf16x8 (&qr)[8], f32x16 (&o)[4], float& m_reg, float& l_reg, const int t_lo, const int t_hi, const int wv) {
    static_assert(Cfg::MODE == 0, "fixed-shift softmax tiles only");
    (void)m_reg;
    const int tid = opq_tid(wv), lane = tid & 63, wid = __builtin_amdgcn_readfirstlane(tid >> 6), r32 = lane & 31, hi = lane >> 5;
    LAS char* V_lds = lds + L_V; LAS char* K_lds = lds + L_K;
    const int sr = tid >> 4, sc = (tid & 15) * 8;
    const int vst0 = v_st(sr, sc), vst1 = v_st(32 + sr, sc), kws = KSWZ(sr, sc * 2);
    const int vb0 = (int)(unsigned)(uintptr_t)V_lds + v_rd_base(lane);
    bf16x8 sk0, sk1, sv0, sv1, pa0, pa1, pa2, pa3;
    const bf16_t *gk0 = nullptr, *gk1 = nullptr, *gv0 = nullptr, *gv1 = nullptr;
#define AS_LOAD(t) do { gk0 = c.krow((t), sr) + sc; gk1 = c.krow((t), sr + 32) + sc; sk0 = *(const bf16x8*)gk0; sk1 = *(const bf16x8*)gk1; \
        gv0 = c.vrow((t), sr) + sc; gv1 = c.vrow((t), sr + 32) + sc; sv0 = *(const bf16x8*)gv0; sv1 = *(const bf16x8*)gv1; asm volatile("" ::: "memory"); SBAR(); } while (0)
#define AS_WRITE(kbf, vbf) do { asm volatile("" :: "v"(gk0), "v"(gk1), "v"(gv0), "v"(gv1)); *(LAS bf16x8*)(K_lds + (kbf) * SHM_K + kws) = sk0; *(LAS bf16x8*)(K_lds + (kbf) * SHM_K + kws + 32 * 256) = sk1; \
        *(LAS bf16x8*)(V_lds + (vbf) * SHM_V + vst0) = sv0; *(LAS bf16x8*)(V_lds + (vbf) * SHM_V + vst1) = sv1; } while (0)
#define AS_SCORE(t, kbf) do { f32x16 p0, p1; float mz_ = 0.f, mn_, al_; bool rok_; float rb_; \
        qkt(p0, p1, K_lds + (kbf) * SHM_K, r32, hi, qr); \
        if (c.rowconst((t), rok_, rb_)) partialSM_row(p0, p1, mz_, mn_, al_, rok_, rb_); else { c.mask(p0, p1, (t)); partialSM(p0, p1, mz_, mn_, al_); } \
        finishSM(p0, p1, 1.f, l_reg, pa0, pa1, pa2, pa3); SBAR(); } while (0)
    if (t_lo >= t_hi) return;
    __builtin_amdgcn_s_waitcnt(0x0F70);
    __syncthreads();
    AS_LOAD(t_lo); AS_WRITE(0, 0);
    __syncthreads();
    int kb = 0, vb = 0;
    if (wid < 4) {
        for (int t = t_lo; t < t_hi; ++t) {
            const bool more = (t + 1 < t_hi); const int vn = (vb == 2) ? 0 : vb + 1;
            if (more) AS_LOAD(t + 1);
            if (c.active(t)) { AS_SCORE(t, kb); pv_tile(o, vb0 + vb * SHM_V, pa0, pa1, pa2, pa3); }
            if (more) AS_WRITE(kb ^ 1, vn);
            __syncthreads();
            kb ^= 1; vb = vn;
        }
    } else {
        bool pend = false; int vp = 0;
        for (int t = t_lo; t < t_hi; ++t) {
            const bool more = (t + 1 < t_hi); const int vn = (vb == 2) ? 0 : vb + 1;
            if (more) AS_LOAD(t + 1);
            if (pend) pv_tile(o, vb0 + vp * SHM_V, pa0, pa1, pa2, pa3);
            const bool act = c.active(t);
            if (act) AS_SCORE(t, kb);
            pend = act; vp = vb;
            if (more) AS_WRITE(kb ^ 1, vn);
            __syncthreads();
            kb ^= 1; vb = vn;
        }
        if (pend) pv_tile(o, vb0 + vp * SHM_V, pa0, pa1, pa2, pa3);
    }
#undef AS_LOAD
#undef AS_WRITE
#undef AS_SCORE
}

struct DilCfg {
    static constexpr int MODE = 0;
    const bf16_t* Kb; const bf16_t* Vb;
    const LAS float* tbl; int dshift, res, u, dqm, s0;
    __device__ __forceinline__ const bf16_t* krow(int t, int kk) const { int s = 256 * u - 128 + 64 * t + kk; s = s < 0 ? 0 : s; return Kb + (size_t)((s << dshift) + res) * PC; }
    __device__ __forceinline__ const bf16_t* vrow(int t, int kk) const { int s = 256 * u - 128 + 64 * t + kk; s = s < 0 ? 0 : s; return Vb + (size_t)((s << dshift) + res) * PC; }
    __device__ __forceinline__ bool active(int t) const { const int kb = 256 * u - 128 + 64 * t; return kb <= s0 + 31 && kb + 63 >= s0 - 128; }
    __device__ __forceinline__ bool rowconst(int, bool&, float&) const { return false; }
    __device__ __forceinline__ void mask(f32x16& p0, f32x16& p1, int t) const {
        const int dq = dqm - (256 * u - 128 + 64 * t);
        const LAS float* tb = tbl + (DT0 + dq - 63);
        float bb0[16], bb1[16];
#pragma unroll
        for (int r = 0; r < 16; ++r) { const int cc = (r & 3) + 8 * (r >> 2); bb0[r] = tb[63 - cc]; bb1[r] = tb[31 - cc]; }
#pragma unroll
        for (int r = 0; r < 16; ++r) asm volatile("" : "+v"(bb0[r]), "+v"(bb1[r]));
#pragma unroll
        for (int r = 0; r < 16; ++r) { p0[r] = p0[r] + bb0[r]; p1[r] = p1[r] + bb1[r]; }
    }
};
struct CmpCfg {
    static constexpr int MODE = 0;
    const bf16_t* Kb; const bf16_t* Vb; int cmax, hi4, cfull;
    __device__ __forceinline__ bool rowconst(int t, bool& ok, float& bias) const { ok = true; bias = 0.f; return 64 * t + 63 <= cfull; }
    __device__ __forceinline__ const bf16_t* krow(int t, int kk) const { return Kb + (size_t)(64 * t + kk) * HD; }
    __device__ __forceinline__ const bf16_t* vrow(int t, int kk) const { return Vb + (size_t)(64 * t + kk) * HD; }
    __device__ __forceinline__ bool active(int) const { return true; }
    __device__ __forceinline__ void mask(f32x16& p0, f32x16& p1, int t) const {
        const int cb = 64 * t + hi4; const float NEG = -__builtin_inff();
#pragma unroll
        for (int r = 0; r < 16; ++r) { const int cc = cb + (r & 3) + 8 * (r >> 2); if (cc > cmax) p0[r] = NEG; if (cc + 32 > cmax) p1[r] = NEG; }
    }
};
struct CmpImpCfg {
    static constexpr int MODE = 1;
    const bf16_t* Kb; int cmax, hi4; float mfix, invl;
    __device__ __forceinline__ const bf16_t* krow(int t, int kk) const { return Kb + (size_t)(64 * t + kk) * HD; }
    __device__ __forceinline__ const bf16_t* vrow(int, int) const { return Kb; }
    __device__ __forceinline__ bool active(int) const { return true; }
    __device__ __forceinline__ void mask(f32x16& p0, f32x16& p1, int t) const {
        const int cb = 64 * t + hi4; const float NEG = -__builtin_inff();
#pragma unroll
        for (int r = 0; r < 16; ++r) { const int cc = cb + (r & 3) + 8 * (r >> 2); if (cc > cmax) p0[r] = NEG; if (cc + 32 > cmax) p1[r] = NEG; }
    }
};
struct SlcCfg {
    static constexpr int MODE = 0;
    const bf16_t* Kb; const bf16_t* Vb;
    const LAS float* tblh;
    const LAS float* negt;
    unsigned s0, s1, s2, s3; int tqm, cur; float b31;
    __device__ __forceinline__ const bf16_t* krow(int t, int kk) const { return Kb + (size_t)(64 * t + kk) * PC; }
    __device__ __forceinline__ const bf16_t* vrow(int t, int kk) const { return Vb + (size_t)(64 * t + kk) * PC; }
    __device__ __forceinline__ bool selbit(int t) const { const unsigned q = (unsigned)t >> 5; const unsigned w = (q == 0u ? s0 + 0u : 0u) | (q == 1u ? s1 + 0u : 0u) | (q == 2u ? s2 + 0u : 0u) | (q == 3u ? s3 + 0u : 0u); return (w >> (t & 31)) & 1u; }
    __device__ __forceinline__ bool active(int t) const { return __any(selbit(t)); }
    __device__ __forceinline__ bool rowconst(int t, bool& ok, float& bias) const { ok = selbit(t); bias = b31; return 64 * (cur - t) - 63 >= 1513; }
    __device__ __forceinline__ void mask(f32x16& p0, f32x16& p1, int t) const {
        const bool sel = selbit(t); const int dq = tqm - 64 * t;
        const LAS float* tsel = tblh + (TBL0 + dq - 63); const LAS float* tb = sel ? tsel + 0 : negt + 0;
        float bb0[16], bb1[16];
#pragma unroll
        for (int r = 0; r < 16; ++r) { const int cc = (r & 3) + 8 * (r >> 2); bb0[r] = tb[63 - cc]; bb1[r] = tb[31 - cc]; }
#pragma unroll
        for (int r = 0; r < 16; ++r) asm volatile("" : "+v"(bb0[r]), "+v"(bb1[r]));
#pragma unroll
        for (int r = 0; r < 16; ++r) { p0[r] = p0[r] + bb0[r]; p1[r] = p1[r] + bb1[r]; }
    }
};
struct WinCfg {
    static constexpr int MODE = 0;
    const bf16_t* Kb; const bf16_t* Vb; const LAS float* tblh; const LAS float* tblw; int tqm, cur;
    __device__ __forceinline__ bool rowconst(int, bool&, float&) const { return false; }
    __device__ __forceinline__ const bf16_t* krow(int t, int kk) const { return Kb + (size_t)(64 * t + kk) * PC; }
    __device__ __forceinline__ const bf16_t* vrow(int t, int kk) const { return Vb + (size_t)(64 * t + kk) * PC; }
    __device__ __forceinline__ bool active(int) const { return true; }
    __device__ __forceinline__ void mask(f32x16& p0, f32x16& p1, int t) const {
        const int dq = tqm - 64 * t;
        const LAS float* ta = tblh + (TBL0 + dq - 63); const LAS float* tw = tblw + (dq - 63 - 440);
        const LAS float* tb = (t + 8 <= cur) ? tw + 0 : ta + 0;
        float bb0[16], bb1[16];
#pragma unroll
        for (int r = 0; r < 16; ++r) { const int cc = (r & 3) + 8 * (r >> 2); bb0[r] = tb[63 - cc]; bb1[r] = tb[31 - cc]; }
#pragma unroll
        for (int r = 0; r < 16; ++r) asm volatile("" : "+v"(bb0[r]), "+v"(bb1[r]));
#pragma unroll
        for (int r = 0; r < 16; ++r) { p0[r] = p0[r] + bb0[r]; p1[r] = p1[r] + bb1[r]; }
    }
};
template <class Cfg>
__device__ __forceinline__ void imp_tiles(const Cfg& c, LAS char* lds, const bf16x8 (&qr)[8], const int ntc, const int wv) {
    const int tid = opq_tid(wv), lane = tid & 63, wid = __builtin_amdgcn_readfirstlane(tid >> 6), r32 = lane & 31, hi = lane >> 5;
    LAS char* K_lds = lds + L_K;
    const int sr = tid >> 4, sc = (tid & 15) * 8;
    const int kws = KSWZ(sr, sc * 2);
    bf16x8 sk0, sk1; const bf16_t *gk0 = nullptr, *gk1 = nullptr;
#define IT_LOAD(t) do { gk0 = c.krow((t), sr) + sc; gk1 = c.krow((t), sr + 32) + sc; sk0 = *(const bf16x8*)gk0; sk1 = *(const bf16x8*)gk1; asm volatile("" ::: "memory"); SBAR(); } while (0)
#define IT_WRITE(bf) do { asm volatile("" :: "v"(gk0), "v"(gk1)); *(LAS bf16x8*)(K_lds + (bf) * SHM_K + kws) = sk0; *(LAS bf16x8*)(K_lds + (bf) * SHM_K + kws + 32 * 256) = sk1; } while (0)
#define IT_BLOCK(P, k, aval, dst) do { float g_ = (P[4 * (k)] + P[4 * (k) + 1]) + (P[4 * (k) + 2] + P[4 * (k) + 3]); \
        auto rr_ = __builtin_amdgcn_permlane32_swap(__float_as_uint(aval), __float_as_uint(P[4 * (k) + 3]), false, false); \
        g_ = (g_ + __uint_as_float(hi ? rr_[0] : rr_[1])) * il; \
        g_ += __int_as_float(__builtin_amdgcn_update_dpp(0, __float_as_int(g_), 0xB1, 0xF, 0xF, true)); g_ += __int_as_float(__builtin_amdgcn_update_dpp(0, __float_as_int(g_), 0x4E, 0xF, 0xF, true)); \
        if ((r32 & 3) == 0) irow[(dst)] = g_; } while (0)
    __builtin_amdgcn_s_waitcnt(0x0F70);
    __syncthreads();
    IT_LOAD(0); IT_WRITE(0);
    __syncthreads();
    float carry = 0.f;
    const float mL = -c.mfix * LOG2E, il = c.invl;
    LAS float* irow = (LAS float*)(lds + L_IMP) + (8 * wid + (r32 >> 2)) * 128 + hi;
    for (int t = 0; t < ntc; ++t) {
        const int buf = t & 1; const bool more = (t + 1 < ntc);
        if (more) IT_LOAD(t + 1);
        f32x16 p0, p1;
        qkt(p0, p1, K_lds + buf * SHM_K, r32, hi, qr);
        c.mask(p0, p1, t);
#pragma unroll
        for (int r = 0; r < 16; ++r) { p0[r] = __builtin_amdgcn_exp2f(p0[r] + mL); p1[r] = __builtin_amdgcn_exp2f(p1[r] + mL); }
        IT_BLOCK(p0, 0, carry, 16 * t + 0); IT_BLOCK(p0, 1, p0[3], 16 * t + 2); IT_BLOCK(p0, 2, p0[7], 16 * t + 4); IT_BLOCK(p0, 3, p0[11], 16 * t + 6);
        IT_BLOCK(p1, 0, p0[15], 16 * t + 8); IT_BLOCK(p1, 1, p1[3], 16 * t + 10); IT_BLOCK(p1, 2, p1[7], 16 * t + 12); IT_BLOCK(p1, 3, p1[11], 16 * t + 14);
        carry = p1[15];
        if (more) IT_WRITE(buf ^ 1);
        __syncthreads();
    }
#undef IT_LOAD
#undef IT_WRITE
#undef IT_BLOCK
}

}

__device__ __forceinline__ void load_q_normed(const bf16_t* qp  , const float* gain  , bf16x8 (&qr)[8]) {
    u32x4 raw[8];
#pragma unroll
    for (int d0 = 0; d0 < 8; ++d0) raw[d0] = *(const u32x4*)(qp + d0 * 16);
    float ss = 0.f;
#pragma unroll
    for (int d0 = 0; d0 < 8; ++d0) { const u32x4 w = raw[d0]; const float a0 = bflo(w.x), a1 = bfhi(w.x), a2 = bflo(w.y), a3 = bfhi(w.y), a4 = bflo(w.z), a5 = bfhi(w.z), a6 = bflo(w.w), a7 = bfhi(w.w);
        ss += ((a0 * a0 + a1 * a1) + (a2 * a2 + a3 * a3)) + ((a4 * a4 + a5 * a5) + (a6 * a6 + a7 * a7)); }
    { auto rr = __builtin_amdgcn_permlane32_swap(__float_as_uint(ss), __float_as_uint(ss), false, false); ss = __uint_as_float(rr[0]) + __uint_as_float(rr[1]); }
    const float rs = (QSCALE * LOG2E) / sqrtf(ss * (1.f / HD) + EPS);
#pragma unroll
    for (int d0 = 0; d0 < 8; ++d0) { const u32x4 w = raw[d0]; const f32x4 g0 = *(const f32x4*)(gain + d0 * 16), g1 = *(const f32x4*)(gain + d0 * 16 + 4);
        u32x4 o; o.x = cvtpk(bflo(w.x) * rs * g0.x, bfhi(w.x) * rs * g0.y); o.y = cvtpk(bflo(w.y) * rs * g0.z, bfhi(w.y) * rs * g0.w);
        o.z = cvtpk(bflo(w.z) * rs * g1.x, bfhi(w.z) * rs * g1.y); o.w = cvtpk(bflo(w.w) * rs * g1.z, bfhi(w.w) * rs * g1.w);
        qr[d0] = *reinterpret_cast<bf16x8*>(&o); }
}

__device__ __forceinline__ void dil_tiles(const att::DilCfg& c, LAS char* lds, const bf16x8 (&qr)[8], f32x16 (&o)[4], float& l_reg, const int wv) {
    using namespace att;
    const int tid = opq_tid(wv), lane = tid & 63, wid = __builtin_amdgcn_readfirstlane(tid >> 6), r32 = lane & 31, hi = lane >> 5;
    LAS char* V_lds = lds + L_V; LAS char* K_lds = lds + L_K;
    const int sr = tid >> 4, sc = (tid & 15) * 8;
    const int vst0 = v_st(sr, sc), vst1 = v_st(32 + sr, sc), kws = KSWZ(sr, sc * 2);
    const int vb0 = (int)(unsigned)(uintptr_t)V_lds + v_rd_base(lane);
    bf16x8 sk0, sk1, sv0, sv1;
    const bf16_t *gk0 = nullptr, *gk1 = nullptr, *gv0 = nullptr, *gv1 = nullptr;
#define DT_LOAD(t) do { gk0 = c.krow((t), sr) + sc; gk1 = c.krow((t), sr + 32) + sc; sk0 = *(const bf16x8*)gk0; sk1 = *(const bf16x8*)gk1; \
        gv0 = c.vrow((t), sr) + sc; gv1 = c.vrow((t), sr + 32) + sc; sv0 = *(const bf16x8*)gv0; sv1 = *(const bf16x8*)gv1; asm volatile("" ::: "memory"); SBAR(); } while (0)
#define DT_WRITE(slot) do { asm volatile("" :: "v"(gk0), "v"(gk1), "v"(gv0), "v"(gv1)); *(LAS bf16x8*)(K_lds + (slot) * SHM_K + kws) = sk0; *(LAS bf16x8*)(K_lds + (slot) * SHM_K + kws + 32 * 256) = sk1; \
        *(LAS bf16x8*)(V_lds + (slot) * SHM_V + vst0) = sv0; *(LAS bf16x8*)(V_lds + (slot) * SHM_V + vst1) = sv1; } while (0)
#define DT_COMP(t, slot) do { f32x16 p0, p1; float mz_ = 0.f, mn_, al_; bf16x8 pa0, pa1, pa2, pa3; \
        qkt(p0, p1, K_lds + (slot) * SHM_K, r32, hi, qr); c.mask(p0, p1, (t)); partialSM(p0, p1, mz_, mn_, al_); \
        finishSM(p0, p1, 1.f, l_reg, pa0, pa1, pa2, pa3); SBAR(); pv_tile(o, vb0 + (slot) * SHM_V, pa0, pa1, pa2, pa3); } while (0)
    const bool first = (c.u == 0);
    __builtin_amdgcn_s_waitcnt(0x0F70);
    __syncthreads();
    if (!first) { DT_LOAD(1); DT_WRITE(0); }
    DT_LOAD(4); DT_WRITE(1);
    __syncthreads();
    DT_LOAD(2);
    if (wid < 4) { if (!first) DT_COMP(1, 0); } else DT_COMP(4, 1);
    DT_WRITE(2);
    __syncthreads();
    DT_LOAD(3);
    if (wid < 6) DT_COMP(2, 2);
    DT_WRITE(0);
    __syncthreads();
    DT_LOAD(5);
    if (wid >= 2) DT_COMP(3, 0);
    DT_WRITE(1);
    if (!first) { DT_LOAD(0); DT_WRITE(2); }
    __syncthreads();
    if (wid < 2) { if (!first) DT_COMP(0, 2); } else if (wid >= 6) DT_COMP(5, 1);
#undef DT_LOAD
#undef DT_WRITE
#undef DT_COMP
}

__device__ __forceinline__ void dil_unit(LAS char* lds, const bf16_t* P, bf16_t* OA, float* LSE, const float* dilT, const float* qgain, int pat, int dshift, int unit, const int wv) {
    using namespace att;
    const int tid = opq_tid(wv), lane = tid & 63, wid = __builtin_amdgcn_readfirstlane(tid >> 6), r32 = lane & 31, hi = lane >> 5;
    const int bh = unit >> 5, ru = unit & 31, b = bh >> 3, h = bh & 7;
    const int ncs = 5 - dshift, res = ru >> ncs, u = ru & ((1 << ncs) - 1);
    LAS float* tbl = (LAS float*)(lds + L_TBL);
    __syncthreads();
    if (tid < DTS) tbl[tid] = dilT[(pat * 8 + h) * DTS + tid];
    const int s0 = 256 * u + 32 * wid, s_row = s0 + r32;
    const size_t tokrow = (size_t)b * SEQ + (size_t)((s_row << dshift) + res);
    bf16x8 qr[8];
    load_q_normed(P + tokrow * PC + C_QA + h * HD + hi * 8, qgain + hi * 8, qr);
    f32x16 o[4]; float m_reg, l_reg;
    m_reg = 0.f;
    if (pat == 0) { l_reg = 0.f;
#pragma unroll
        for (int d0 = 0; d0 < 4; ++d0) o[d0] = f32x16{}; }
    else { l_reg = LSE[tokrow * 8 + h];
#pragma unroll
        for (int r = 0; r < 16; ++r) { const size_t tr = (size_t)b * SEQ + (size_t)(((s0 + crow(r, hi)) << dshift) + res); const bf16_t* op = OA + tr * 1024 + h * HD + 4 * r32;
            { const u32x2 w = *(const u32x2*)op; o[0][r] = bflo(w.x); o[1][r] = bfhi(w.x); o[2][r] = bflo(w.y); o[3][r] = bfhi(w.y); } } }
    DilCfg c; c.Kb = P + (size_t)b * SEQ * PC + C_KA + h * HD; c.Vb = P + (size_t)b * SEQ * PC + C_VA + h * HD; c.tbl = tbl; c.dshift = dshift; c.res = res; c.u = u; c.dqm = s_row - 4 * hi; c.s0 = s0;
    dil_tiles(c, lds, qr, o, l_reg, wv);
    LAS float* li_l = (LAS float*)(lds + L_WS) + wid * 64;
    if (hi == 0) { li_l[r32] = l_reg; LSE[tokrow * 8 + h] = l_reg; }
    LDS_WAIT();
#pragma unroll
    for (int r = 0; r < 16; ++r) { const int orow = crow(r, hi); const float rl = (pat == 2) ? 1.0f / li_l[orow] : 1.0f;
        const size_t tr = (size_t)b * SEQ + (size_t)(((s0 + orow) << dshift) + res); bf16_t* op = OA + tr * 1024 + h * HD;
        { u32x2 w; w.x = cvtpk(o[0][r] * rl, o[1][r] * rl); w.y = cvtpk(o[2][r] * rl, o[3][r] * rl); *(u32x2*)(op + 4 * r32) = w; } }
}

__device__ __forceinline__ void nsa_finalize(LAS char* lds, const f32x16 (&o)[4], float l_reg, bf16_t* ON, int b, int g, int tok0, int br, const int wv) {
    using namespace att;
    const int tid = opq_tid(wv), lane = tid & 63, wid = __builtin_amdgcn_readfirstlane(tid >> 6), r32 = lane & 31, hi = lane >> 5;
    LAS float* li_l = (LAS float*)(lds + L_WS) + wid * 64;
    if (hi == 0) li_l[r32] = l_reg;
    LDS_WAIT();
    bf16_t* ONb = ON + (size_t)br * NTOK * 1024;
    const LAS float* GT = (const LAS float*)(lds + L_GATE) + (8 * wid + hi) * 12 + br;
#pragma unroll
    for (int r = 0; r < 16; ++r) { const int j = r & 3, k = r >> 2; const float lr = li_l[crow(r, hi)]; const float rl = lr > 0.f ? 1.0f / lr : 0.f;
        const size_t tok = (size_t)b * SEQ + tok0 + 2 * k + hi; const int hh = 4 * g + j;
        const float sc = rl * GT[(2 * k) * 12 + j * 3];
        bf16_t* op = ONb + tok * 1024 + hh * HD;
        { u32x2 w; w.x = cvtpk(o[0][r] * sc, o[1][r] * sc); w.y = cvtpk(o[2][r] * sc, o[3][r] * sc); *(u32x2*)(op + 4 * r32) = w; } }
}
__device__ __forceinline__ void nsa_unit(LAS char* lds, const bf16_t* P, const bf16_t* KC, const bf16_t* VC, bf16_t* ON, const float* nsaT, const float* gb, const float* qgain, int b, int g, int qi, bool load_tbl, const int wv) {
    using namespace att;
    const int tid = opq_tid(wv), lane = tid & 63, wid = __builtin_amdgcn_readfirstlane(tid >> 6), r32 = lane & 31, hi = lane >> 5;
    LAS float* tbl = (LAS float*)(lds + L_TBL); LAS float* IMP = (LAS float*)(lds + L_IMP); LAS unsigned* SELM = (LAS unsigned*)(lds + L_SELM);
    __syncthreads();
    if (load_tbl) for (int i = tid; i < 4 * TBLS; i += NTHR) tbl[i] = nsaT[(size_t)(4 * g) * TBLS + i];
    if (tid < 64) ((LAS float*)(lds + L_NEG))[tid] = -__builtin_inff();
    if (load_tbl) for (int i = tid; i < 4 * 136; i += NTHR) { const int h_ = i / 136, d_ = 440 + i % 136; ((LAS float*)(lds + L_TBLW))[i] = (d_ < 512) ? nsaT[(size_t)(4 * g + h_) * TBLS + TBL0 + d_] : -__builtin_inff(); }
    const int tok0 = 64 * qi + 8 * wid, tq = tok0 + (r32 >> 2), hd = r32 & 3;
    const bf16_t* Pb = P + (size_t)b * SEQ * PC;
    const int gi0 = tid, gi1 = (tid + NTHR < 768) ? tid + NTHR : 767;
    const bf16_t graw0 = Pb[(size_t)(64 * qi + gi0 / 12) * PC + C_GL + 12 * g + gi0 % 12], graw1 = Pb[(size_t)(64 * qi + gi1 / 12) * PC + C_GL + 12 * g + gi1 % 12];
    const bf16_t grbw0 = Pb[(size_t)(64 * qi + gi0 / 12) * PC + C_GL + 32 + 12 * g + gi0 % 12], grbw1 = Pb[(size_t)(64 * qi + gi1 / 12) * PC + C_GL + 32 + 12 * g + gi1 % 12];
    const float gbb0 = gb[12 * g + gi0 % 12], gbb1 = gb[12 * g + gi1 % 12];
    asm volatile("" ::: "memory"); SBAR();
    bf16x8 qr[8];
    load_q_normed(Pb + (size_t)tq * PC + C_QN + (4 * g + hd) * HD + hi * 8, qgain + hi * 8, qr);
    { LAS float* GTw = (LAS float*)(lds + L_GATE);
      GTw[gi0] = __builtin_amdgcn_rcpf(1.0f + __builtin_amdgcn_exp2f(-((bf2f(graw0) + bf2f(grbw0)) + gbb0) * LOG2E));
      if (tid + NTHR < 768) GTw[gi1] = __builtin_amdgcn_rcpf(1.0f + __builtin_amdgcn_exp2f(-((bf2f(graw1) + bf2f(grbw1)) + gbb1) * LOG2E)); }
    const bf16_t* KCb = KC + (size_t)(b * 2 + g) * 512 * HD; const bf16_t* VCb = VC + (size_t)(b * 2 + g) * 512 * HD;
    const int ntc = (qi >> 4) + 1, cmax = (tq - 31) >> 4;
    f32x16 o[4]; float m_reg, l_reg;
#pragma unroll
    for (int d0 = 0; d0 < 4; ++d0) o[d0] = f32x16{};
    m_reg = 0.f; l_reg = 0.f;
    { CmpCfg c; c.Kb = KCb; c.Vb = VCb; c.cmax = cmax; c.hi4 = 4 * hi; c.cfull = (64 * qi - 31) >> 4; attn_tiles_s(c, lds, qr, o, m_reg, l_reg, 0, ntc, wv); }
    nsa_finalize(lds, o, l_reg, ON, b, g, tok0, 0, wv);
    { CmpImpCfg c; c.Kb = KCb; c.cmax = cmax; c.hi4 = 4 * hi; c.mfix = 0.f; c.invl = l_reg > 0.f ? 1.0f / l_reg : 0.f;
      imp_tiles(c, lds, qr, ntc, wv); }
    { const int cur = qi;
#pragma unroll 1
      for (int t4 = 8 * wid; t4 < 8 * wid + 8; t4 += 4) {
        const int n0 = lane, n1 = 64 + lane;
        unsigned long long b0[4], b1[4];
        if (cur <= 15) {
#pragma unroll
            for (int q = 0; q < 4; ++q) { b0[q] = __ballot(n0 <= cur); b1[q] = 0ull; }
        } else {
            unsigned u0[4], u1[4], T[4];
#pragma unroll
            for (int q = 0; q < 4; ++q) { const float v0 = IMP[(t4 + q) * 128 + n0], v1 = IMP[(t4 + q) * 128 + n1];
                u0[q] = (n0 >= 1 && n0 <= cur - 2) ? __float_as_uint(v0) + 1u : 0u; u1[q] = (n1 <= cur - 2) ? __float_as_uint(v1) + 1u : 0u; T[q] = 0u; }
#pragma unroll 1
            for (int bit = 30; bit >= 0; --bit) {
#pragma unroll
                for (int q = 0; q < 4; ++q) { const unsigned cand = T[q] | (1u << bit);
                    const int cnt = __builtin_popcountll(__ballot(u0[q] >= cand)) + __builtin_popcountll(__ballot(u1[q] >= cand));
                    T[q] = (cnt >= 13) ? cand : T[q]; } }
#pragma unroll
            for (int q = 0; q < 4; ++q) {
                const bool gt0 = u0[q] > T[q], gt1 = u1[q] > T[q];
                const int need = 13 - (__builtin_popcountll(__ballot(gt0)) + __builtin_popcountll(__ballot(gt1)));
                const bool eq0 = (u0[q] == T[q]), eq1 = (u1[q] == T[q]);
                const unsigned long long m0 = __ballot(eq0), m1 = __ballot(eq1);
                const int pre0 = (int)__builtin_amdgcn_mbcnt_hi((unsigned)(m0 >> 32), __builtin_amdgcn_mbcnt_lo((unsigned)m0, 0u));
                const int pre1 = __builtin_popcountll(m0) + (int)__builtin_amdgcn_mbcnt_hi((unsigned)(m1 >> 32), __builtin_amdgcn_mbcnt_lo((unsigned)m1, 0u));
                const bool sel0 = (n0 == 0 || n0 == cur || n0 == cur - 1) || gt0 || (eq0 && pre0 < need);
                const bool sel1 = (n1 == cur || n1 == cur - 1) || gt1 || (eq1 && pre1 < need);
                b0[q] = __ballot(sel0); b1[q] = __ballot(sel1); }
        }
        if (lane == 0) {
#pragma unroll
            for (int q = 0; q < 4; ++q) { SELM[(t4 + q) * 4 + 0] = (unsigned)b0[q]; SELM[(t4 + q) * 4 + 1] = (unsigned)(b0[q] >> 32); SELM[(t4 + q) * 4 + 2] = (unsigned)b1[q]; SELM[(t4 + q) * 4 + 3] = (unsigned)(b1[q] >> 32); } } } }
    __syncthreads();
    int r32s = r32; asm volatile("" : "+v"(r32s));
    { SlcCfg c; c.Kb = Pb + C_KS + g * HD; c.Vb = Pb + C_VS + g * HD; c.tblh = tbl + (r32s & 3) * TBLS; c.negt = (const LAS float*)(lds + L_NEG); c.tqm = tok0 + (r32s >> 2) - 4 * hi; c.cur = qi; c.b31 = tbl[(r32s & 3) * TBLS + TBL0 + 1600];
      const int tl = 8 * wid + (r32s >> 2); c.s0 = SELM[tl * 4 + 0]; c.s1 = SELM[tl * 4 + 1]; c.s2 = SELM[tl * 4 + 2]; c.s3 = SELM[tl * 4 + 3];
#pragma unroll
      for (int d0 = 0; d0 < 4; ++d0) o[d0] = f32x16{};
      m_reg = 0.f; l_reg = 0.f;
      attn_tiles_s(c, lds, qr, o, m_reg, l_reg, 0, qi + 1, wv); }
    nsa_finalize(lds, o, l_reg, ON, b, g, tok0, 1, wv);
    int r32w = r32; asm volatile("" : "+v"(r32w));
    { WinCfg c; c.Kb = Pb + C_KW + g * HD; c.Vb = Pb + C_VW + g * HD; c.tblh = tbl + (r32w & 3) * TBLS; c.tblw = (const LAS float*)(lds + L_TBLW) + (r32w & 3) * 136; c.tqm = tok0 + (r32w >> 2) - 4 * hi; c.cur = qi;
#pragma unroll
      for (int d0 = 0; d0 < 4; ++d0) o[d0] = f32x16{};
      m_reg = 0.f; l_reg = 0.f;
      attn_tiles_s(c, lds, qr, o, m_reg, l_reg, qi >= 8 ? qi - 8 : 0, qi + 1, wv); }
    nsa_finalize(lds, o, l_reg, ON, b, g, tok0, 2, wv);
}

constexpr int LDS_BYTES = 147456;
constexpr int LDS_MISC = 131072;
constexpr int LDS_ARGS = LDS_MISC + 64;
__device__ __forceinline__ unsigned long long arg_u64(LAS unsigned char* lds, int i) {
    const LAS unsigned* p = (const LAS unsigned*)(opq_lds(lds) + LDS_ARGS) + 2 * i;
    const unsigned lo = __builtin_amdgcn_readfirstlane(p[0]), hi = __builtin_amdgcn_readfirstlane(p[1]);
    return ((unsigned long long)hi << 32) | lo;
}
#define GAS __attribute__((address_space(1)))
__device__ __forceinline__ const float* arg_in(LAS unsigned char* lds, int i) { return (const float*)(GAS const float*)arg_u64(lds, i); }
__device__ __forceinline__ float* arg_out(LAS unsigned char* lds) { return (float*)(GAS float*)arg_u64(lds, 24); }
__device__ __forceinline__ unsigned char* arg_ws(LAS unsigned char* lds) { return (unsigned char*)(GAS unsigned char*)arg_u64(lds, 25); }
__device__ __forceinline__ int opq_bx() { int b = blockIdx.x; asm volatile("" : "+s"(b)); return b; }
__device__ __forceinline__ int opq_g() { int b = gridDim.x; asm volatile("" : "+s"(b)); return b; }

__device__ __forceinline__ void ph_prologue(LAS unsigned char* lds, const int wv) {
    lds = opq_lds(lds);
    const int tid = opq_tid(wv), lane = tid & 63, wave = __builtin_amdgcn_readfirstlane(tid >> 6), G = opq_g(), bx = opq_bx();
    const int gw = bx * NWAVES + wave, NGW = G * NWAVES;
    unsigned char* ws = arg_ws(lds);
    LAS float* scr = (LAS float*)(lds + wave * 16384);
    constexpr int I_UP = 32 * 176, I_DN = 88 * 64, I_IN = 32 * 177, I_OUT = 32 * 64, I_C1 = 64 * 16, I_Z = 928;
    constexpr int I_FFN = 2 * I_UP + I_DN, I_LAYER = 2 * I_FFN + I_IN + I_OUT + 2 * I_C1 + I_Z;
#define PRO_DECODE(it_, W_, K_, N_, WT_, mode_, off_, gain_, r_) do { const int l_ = (it_) / I_LAYER; int q_ = (it_) - l_ * I_LAYER; gain_ = nullptr; off_ = 0; mode_ = 0; \
        if (q_ < 2 * I_FFN) { const int half_ = q_ >= I_FFN; q_ -= half_ * I_FFN; \
            if (q_ < 2 * I_UP) { const int w3_ = q_ >= I_UP; q_ -= w3_ * I_UP; W_ = arg_in(lds, w3_ ? (half_ ? I_F2W3 : I_F1W3) : (half_ ? I_F2W1 : I_F1W1)) + (size_t)l_ * DM * DFF; K_ = DM; N_ = DFF; \
                WT_ = (bf16_t*)(ws + WS_WUP + (size_t)(l_ * 2 + half_) * SZ_WUP); mode_ = 1; off_ = w3_ * 128; gain_ = arg_in(lds, half_ ? I_F2N : I_F1N) + (size_t)l_ * DM; } \
            else { q_ -= 2 * I_UP; W_ = arg_in(lds, half_ ? I_F2W2 : I_F1W2) + (size_t)l_ * DFF * DM; K_ = DFF; N_ = DM; WT_ = (bf16_t*)(ws + WS_WDN + (size_t)(l_ * 2 + half_) * SZ_WDN); } } \
        else { q_ -= 2 * I_FFN; \
            if (q_ < I_IN) { W_ = arg_in(lds, I_WIN) + (size_t)l_ * DM * IN_COLS; K_ = DM; N_ = IN_COLS; WT_ = (bf16_t*)(ws + WS_WIN + (size_t)l_ * SZ_WIN); mode_ = 2; gain_ = arg_in(lds, I_MIXN) + (size_t)l_ * DM; } \
            else if (q_ < I_IN + I_OUT) { q_ -= I_IN; W_ = arg_in(lds, I_WOUT) + (size_t)l_ * DM * DM; K_ = DM; N_ = DM; WT_ = (bf16_t*)(ws + WS_WOUT + (size_t)l_ * SZ_WOUT); } \
            else if (q_ < I_IN + I_OUT + 2 * I_C1) { q_ -= I_IN + I_OUT; const int cv_ = q_ >= I_C1; q_ -= cv_ * I_C1; W_ = arg_in(lds, cv_ ? I_CVW1 : I_CKW1) + (size_t)l_ * 4096 * 512; K_ = 4096; N_ = 512; \
                WT_ = (bf16_t*)(ws + WS_WC1 + (size_t)l_ * SZ_WC1); off_ = cv_ * 512; } \
            else { q_ -= I_IN + I_OUT + 2 * I_C1; W_ = nullptr; K_ = 0; N_ = 0; WT_ = (bf16_t*)(ws + WS_WIN + (size_t)l_ * SZ_WIN); } } \
        r_ = q_; } while (0)
#define PRO_ZERO(WT_, r_) do { const int q = (r_) * 64 + lane, kt = q / 1856, rem = q - kt * 1856; u32x4* z = (u32x4*)((WT_) + ((size_t)(22 * 32 + kt) * 256 + 24) * 64) + rem; unsigned zr = 0u; asm volatile("" : "+v"(zr)); *z = (u32x4){zr, zr, zr, zr}; } while (0)
#pragma unroll 1
    for (int it = gw; it < DEPTH * I_LAYER; it += 2 * NGW) {
        const int itb = it + NGW; const bool hasb = itb < DEPTH * I_LAYER;
        const float *Wa, *Wb, *ga, *gb_; int Ka, Na, Kb, Nb, ma, mb, oa, ob, ra, rb; bf16_t *Ta, *Tb;
        PRO_DECODE(it, Wa, Ka, Na, Ta, ma, oa, ga, ra);
        PRO_DECODE((hasb ? itb : it), Wb, Kb, Nb, Tb, mb, ob, gb_, rb);
        f32x4 lda[8], ldb[8]; float gva[8], gvb[8];
        if (Wa) ti_issue(Wa, Ka, Na, ra, lane, ga, lda, gva);
        if (hasb && Wb) ti_issue(Wb, Kb, Nb, rb, lane, gb_, ldb, gvb);
        if (Wa) ti_finish(Ka, Na, Ta, ma, oa, scr, ra, lane, lda, gva); else PRO_ZERO(Ta, ra);
        if (hasb) { if (Wb) ti_finish(Kb, Nb, Tb, mb, ob, scr, rb, lane, ldb, gvb); else PRO_ZERO(Tb, rb); }
    }
#undef PRO_DECODE
#undef PRO_ZERO
    const float* xs = arg_in(lds, I_X); bf16_t* XB = (bf16_t*)(ws + WS_HB); float* SSQ = (float*)(ws + WS_SSQ);
    for (int m = gw; m < NTOK; m += NGW) {
        const f32x4* xr = (const f32x4*)(xs + (size_t)m * DM) + lane; f32x4 v[8]; float s = 0.f;
#pragma unroll
        for (int j = 0; j < 8; ++j) { v[j] = xr[64 * j]; s += (v[j].x * v[j].x + v[j].y * v[j].y) + (v[j].z * v[j].z + v[j].w * v[j].w); }
        s = wave_sum(s, lane);
#pragma unroll
        for (int j = 0; j < 8; ++j) { u32x2 w; w.x = cvtpk(v[j].x, v[j].y); w.y = cvtpk(v[j].z, v[j].w); *(u32x2*)(XB + kt_off(m, 256 * j + 4 * lane, DM)) = w; }
        if (lane < 32) SSQ[(size_t)m * 32 + lane] = (lane == 0) ? s : 0.f;
    }
}
__device__ __forceinline__ float gelu_tanh(float v) { const float u3 = 0.7978845608028654f * (v + 0.044715f * v * v * v); return 0.5f * v * (2.0f - 2.0f / (__expf(2.0f * u3) + 1.0f)); }
__device__ __forceinline__ void ph_cmp2(LAS unsigned char* lds, int l, const int wv) {
    lds = opq_lds(lds);
    const int tid = opq_tid(wv), lane = tid & 63, wave = __builtin_amdgcn_readfirstlane(tid >> 6), G = opq_g(), bx = opq_bx();
    unsigned char* ws = arg_ws(lds); const float* CP = (const float*)(ws + WS_CP);
    LAS float* CH = (LAS float*)lds;
    LAS float* RED = (LAS float*)(lds + 65536);
    const float* knn = arg_in(lds, I_KNN) + l * HD;
    for (int it = bx; it < 256; it += G) {
        const int R0 = it * 32, kv = R0 >> 12, rl0 = R0 & 4095;
        __syncthreads();
#pragma unroll 1
        for (int hb = 0; hb < 2; ++hb) {
            f32x4 pv[4][4];
#pragma unroll
            for (int q = 0; q < 4; ++q) { const int i4 = tid + (hb * 4 + q) * NTHR, rr = i4 >> 7, k4 = (i4 & 127) * 4;
#pragma unroll
                for (int ks = 0; ks < 4; ++ks) pv[q][ks] = *(const f32x4*)(CP + ((size_t)(kv * 4 + ks) * 4096 + rl0 + rr) * 512 + k4); }
            asm volatile("" ::: "memory"); SBAR();
#pragma unroll
            for (int q = 0; q < 4; ++q) { const int i4 = tid + (hb * 4 + q) * NTHR, rr = i4 >> 7, k4 = (i4 & 127) * 4;
                const f32x4 v = (pv[q][0] + pv[q][1]) + (pv[q][2] + pv[q][3]);
                f32x4 o; o.x = gelu_tanh(v.x); o.y = gelu_tanh(v.y); o.z = gelu_tanh(v.z); o.w = gelu_tanh(v.w);
                *(LAS f32x4*)(CH + rr * 512 + k4) = o; } }
        __syncthreads();
        const int n = tid & 127, rq = tid >> 7;
        const float* w2 = arg_in(lds, kv ? I_CVW2 : I_CKW2) + (size_t)l * 512 * HD + n;
        float acc[8];
#pragma unroll
        for (int i = 0; i < 8; ++i) acc[i] = 0.f;
#pragma unroll 4
        for (int k = 0; k < 512; k += 4) { const float w0 = w2[(size_t)k * HD], w1 = w2[(size_t)(k + 1) * HD], w2v = w2[(size_t)(k + 2) * HD], w3 = w2[(size_t)(k + 3) * HD];
#pragma unroll
            for (int i = 0; i < 8; ++i) { const f32x4 c = *(const LAS f32x4*)(CH + (rq * 8 + i) * 512 + k); acc[i] += (c.x * w0 + c.y * w1) + (c.z * w2v + c.w * w3); } }
        if (kv == 0) {
            float ss[8];
#pragma unroll
            for (int i = 0; i < 8; ++i) ss[i] = wave_sum(acc[i] * acc[i], lane);
            if (lane == 0) {
#pragma unroll
                for (int i = 0; i < 8; ++i) RED[wave * 8 + i] = ss[i]; }
            __syncthreads();
            const float gn = knn[n];
#pragma unroll
            for (int i = 0; i < 8; ++i) { const float tot = RED[(2 * rq) * 8 + i] + RED[(2 * rq + 1) * 8 + i]; acc[i] = acc[i] / sqrtf(tot * (1.f / HD) + EPS) * gn; }
        }
        bf16_t* dst = (bf16_t*)(ws + (kv ? WS_VC + 0 : WS_KC + 0)) + (size_t)(rl0 + rq * 8) * HD + (kv ? 32 * (n & 3) + (n >> 2) : n);
#pragma unroll
        for (int i = 0; i < 8; ++i) dst[(size_t)i * HD] = (bf16_t)f2bf(acc[i]);
    }
}
__device__ __forceinline__ void ph_outnorm(LAS unsigned char* lds, int l, const int wv) {
    lds = opq_lds(lds);
    const int tid = opq_tid(wv), lane = tid & 63, wave = __builtin_amdgcn_readfirstlane(tid >> 6), G = opq_g(), bx = opq_bx();
    const int gw = bx * NWAVES + wave, NGW = G * NWAVES;
    unsigned char* ws = arg_ws(lds); const bf16_t* OA = (const bf16_t*)(ws + WS_OA); const bf16_t* ON = (const bf16_t*)(ws + WS_ON); bf16_t* HB = (bf16_t*)(ws + WS_HP);
    const float* gn = arg_in(lds, I_ON) + (size_t)l * DM;
    const f32x4 ga0 = *(const f32x4*)(gn + lane * 8), ga1 = *(const f32x4*)(gn + lane * 8 + 4), ga2 = *(const f32x4*)(gn + 512 + lane * 8), ga3 = *(const f32x4*)(gn + 512 + lane * 8 + 4);
    const f32x4 gb0 = *(const f32x4*)(gn + 1024 + lane * 8), gb1 = *(const f32x4*)(gn + 1024 + lane * 8 + 4), gb2 = *(const f32x4*)(gn + 1536 + lane * 8), gb3 = *(const f32x4*)(gn + 1536 + lane * 8 + 4);
    bf16_t* y = HB;
    for (int m0 = gw; m0 < NTOK; m0 += 2 * NGW) {
        u32x4 wab[2][2], wn[2][6];
#pragma unroll
        for (int q = 0; q < 2; ++q) { const int mq = m0 + q * NGW; const size_t mc = (size_t)(mq < NTOK ? mq : NTOK - 1);
            const bf16_t* oa = OA + mc * 1024; wab[q][0] = *(const u32x4*)(oa + lane * 8); wab[q][1] = *(const u32x4*)(oa + 512 + lane * 8);
#pragma unroll
            for (int br = 0; br < 3; ++br) { const bf16_t* onb = ON + ((size_t)br * NTOK + mc) * 1024; wn[q][2 * br] = *(const u32x4*)(onb + lane * 8); wn[q][2 * br + 1] = *(const u32x4*)(onb + 512 + lane * 8); } }
#pragma unroll
        for (int q = 0; q < 2; ++q) asm volatile("" : "+v"(wab[q][0]), "+v"(wab[q][1]), "+v"(wn[q][0]), "+v"(wn[q][1]), "+v"(wn[q][2]), "+v"(wn[q][3]), "+v"(wn[q][4]), "+v"(wn[q][5]));
#pragma unroll
        for (int q = 0; q < 2; ++q) { const int m = m0 + q * NGW; if (m >= NTOK) break;
        const u32x4 wa = wab[q][0], wb = wab[q][1];
        float va[16] = {bflo(wa.x), bfhi(wa.x), bflo(wa.y), bfhi(wa.y), bflo(wa.z), bfhi(wa.z), bflo(wa.w), bfhi(wa.w), bflo(wb.x), bfhi(wb.x), bflo(wb.y), bfhi(wb.y), bflo(wb.z), bfhi(wb.z), bflo(wb.w), bfhi(wb.w)};
        float sa = 0.f;
#pragma unroll
        for (int i = 0; i < 16; ++i) sa += va[i] * va[i];
        float vs[16]; float sn = 0.f;
#pragma unroll
        for (int i = 0; i < 16; ++i) vs[i] = 0.f;
#pragma unroll
        for (int br = 0; br < 3; ++br) { const u32x4 wc = wn[q][2 * br], wd = wn[q][2 * br + 1];
            vs[0] += bflo(wc.x); vs[1] += bfhi(wc.x); vs[2] += bflo(wc.y); vs[3] += bfhi(wc.y); vs[4] += bflo(wc.z); vs[5] += bfhi(wc.z); vs[6] += bflo(wc.w); vs[7] += bfhi(wc.w);
            vs[8] += bflo(wd.x); vs[9] += bfhi(wd.x); vs[10] += bflo(wd.y); vs[11] += bfhi(wd.y); vs[12] += bflo(wd.z); vs[13] += bfhi(wd.z); vs[14] += bflo(wd.w); vs[15] += bfhi(wd.w); }
        const float ra = 1.0f / sqrtf(wave_sum(sa, lane) * (1.f / 1024.f) + EPS);
        { const f32x4 g0 = ga0, g1 = ga1, g2 = ga2, g3 = ga3;
          u32x4 o; o.x = cvtpk(va[0] * ra * g0.x, va[1] * ra * g0.y); o.y = cvtpk(va[2] * ra * g0.z, va[3] * ra * g0.w); o.z = cvtpk(va[4] * ra * g1.x, va[5] * ra * g1.y); o.w = cvtpk(va[6] * ra * g1.z, va[7] * ra * g1.w);
          *(u32x4*)(y + kt_off(m, lane * 8, DM)) = o;
          o.x = cvtpk(va[8] * ra * g2.x, va[9] * ra * g2.y); o.y = cvtpk(va[10] * ra * g2.z, va[11] * ra * g2.w); o.z = cvtpk(va[12] * ra * g3.x, va[13] * ra * g3.y); o.w = cvtpk(va[14] * ra * g3.z, va[15] * ra * g3.w);
          *(u32x4*)(y + kt_off(m, 512 + lane * 8, DM)) = o; }
#pragma unroll
        for (int i = 0; i < 16; ++i) sn += vs[i] * vs[i];
        const float rn = 1.0f / sqrtf(wave_sum(sn, lane) * (1.f / 1024.f) + EPS);
        { const f32x4 g0 = gb0, g1 = gb1, g2a = gb2, g3 = gb3;
          u32x4 o; o.x = cvtpk(vs[0] * rn * g0.x, vs[1] * rn * g0.y); o.y = cvtpk(vs[2] * rn * g0.z, vs[3] * rn * g0.w); o.z = cvtpk(vs[4] * rn * g1.x, vs[5] * rn * g1.y); o.w = cvtpk(vs[6] * rn * g1.z, vs[7] * rn * g1.w);
          *(u32x4*)(y + kt_off(m, 1024 + lane * 8, DM)) = o;
          o.x = cvtpk(vs[8] * rn * g2a.x, vs[9] * rn * g2a.y); o.y = cvtpk(vs[10] * rn * g2a.z, vs[11] * rn * g2a.w); o.z = cvtpk(vs[12] * rn * g3.x, vs[13] * rn * g3.y); o.w = cvtpk(vs[14] * rn * g3.z, vs[15] * rn * g3.w);
          *(u32x4*)(y + kt_off(m, 1536 + lane * 8, DM)) = o; }
        }
    }
}

#define GRID_BAR() do { XcdBarrier bar_; bar_.bar = (unsigned*)(arg_ws(lds) + WS_CTL) + CW_BAR; bar_.x = xb_xcc_id(); bar_.st = (volatile LAS unsigned*)(opq_lds(lds) + LDS_MISC + 32); xcd_barrier(bar_, wv); } while (0)
__global__ void __launch_bounds__(NTHR, 2) mega_fwd(Args a) {
    extern __shared__ __attribute__((aligned(16))) unsigned char lds_raw[];
    LAS unsigned char* lds = (LAS unsigned char*)lds_raw;
    const int wv = __builtin_amdgcn_readfirstlane((int)threadIdx.x >> 6);
    {
        const int tid = threadIdx.x;
        for (int u = tid; u < (LDS_BYTES - LDS_MISC) / 4; u += NTHR) ((LAS unsigned*)(lds + LDS_MISC))[u] = 0u;
        __syncthreads();
        if (tid == 0) { LAS unsigned long long* t = (LAS unsigned long long*)(lds + LDS_ARGS);
#pragma unroll
            for (int i = 0; i < 24; ++i) t[i] = (unsigned long long)(uintptr_t)a.in[i];
            t[24] = (unsigned long long)(uintptr_t)a.out; t[25] = (unsigned long long)(uintptr_t)a.ws; }
        __syncthreads();
    }
    (void)xcd_barrier_post((unsigned*)(arg_ws(lds) + WS_CTL) + CW_BAR, (volatile LAS unsigned*)(lds + LDS_MISC + 32));

    { const int tid = opq_tid(wv), G = opq_g(), bx = opq_bx(); const float* rb = arg_in(lds, I_RB); unsigned char* ws = arg_ws(lds);
      float* dilT = (float*)(ws + WS_TBL); float* nsaT = (float*)(ws + WS_TBL + 65536);
      for (int i = bx * NTHR + tid; i < 3 * 8 * DTS + 8 * TBLS; i += G * NTHR) {
          if (i < 3 * 8 * DTS) { const int p = i / (8 * DTS), h = (i / DTS) % 8, df = i % DTS - DT0; const int d = (p == 0) ? 1 : (p == 1 ? 4 : 16);
              dilT[i] = (df >= 0 && df <= 128) ? rb[rel_bucket_dev(df * d) * 16 + h] * LOG2E : -__builtin_inff(); }
          else { const int j = i - 3 * 8 * DTS, hh = j / TBLS, ds = j % TBLS - TBL0; nsaT[j] = (ds >= 0) ? rb[rel_bucket_dev(ds) * 16 + 8 + hh] * LOG2E : -__builtin_inff();     } } }

    ph_prologue(lds, wv);
    GRID_BAR();
#pragma unroll 1
    for (int step = 0; step < 2 * DEPTH; ++step) {
        const int l = step >> 1, half = step & 1;
        { unsigned char* ws = arg_ws(lds); const int G = opq_g(), bx = opq_bx();
          pg8::Gemm g{64, 64, DM}; pg8::SchedStd S; S.init(ws + WS_HB, ws + WS_WUP + (size_t)step * SZ_WUP, NTOK, 2 * DFF, DM, DM, G, bx); const pg8::EpiSwiGLU E{(bf16_t*)(ws + WS_HP), DFF, (const float*)(ws + WS_SSQ)};
          pg8::gemm_phase<pg8::EpiSwiGLU, pg8::SchedStd, 32768, 32768>(opq_lds(lds), g, S, E, wv);
        }
        GRID_BAR();
        { unsigned char* ws = arg_ws(lds); const int G = opq_g(), bx = opq_bx(); float* X = arg_out(lds);
          pg8::Gemm g{64, 64, DFF}; pg8::SchedStd S; S.init(ws + WS_HP, ws + WS_WDN + (size_t)step * SZ_WDN, NTOK, DM, DFF, DFF, G, bx, 4, 1);
          pg8::EpiResid E{(step == 2 * DEPTH - 1) ? X : (float*)nullptr, (bf16_t*)(ws + WS_HB), (float*)(ws + WS_SSQ), DM, 0.5f};
          pg8::gemm_phase<pg8::EpiResid, pg8::SchedStd, 32768, 32768>(opq_lds(lds), g, S, E, wv);
        }
        if (step == 2 * DEPTH - 1) break;
        GRID_BAR();
        if (half == 0) {
            { unsigned char* ws = arg_ws(lds); const int G = opq_g(), bx = opq_bx();
              pg8::Gemm g{64, 64, DM}; pg8::SchedStd S; S.init(ws + WS_HB, ws + WS_WIN + (size_t)l * SZ_WIN, NTOK, C_GL, DM, DM, G, bx); const pg8::EpiBf16 E{(bf16_t*)(ws + WS_HP), PC, (const float*)(ws + WS_SSQ), arg_in(lds, I_KNA) + l * HD, arg_in(lds, I_KNN) + l * HD, arg_in(lds, I_POS) + (size_t)l * 32 * HD, (bf16_t*)(ws + WS_ACMP), opq_lds(lds) + pg8::EX_LDS};
              pg8::gemm_phase<pg8::EpiBf16, pg8::SchedStd, 32768, 32768>(opq_lds(lds), g, S, E, wv);
            }
            { unsigned char* ws = arg_ws(lds); const int G = opq_g(), bx = opq_bx();
              pg8::Gemm g{64, 64, DM / 2}; pg8::SchedGate S; S.A = (const char*)(ws + WS_HB); S.Bt = (const char*)(ws + WS_WIN + (size_t)l * SZ_WIN); S.G = G; S.c = bx;
              const pg8::EpiGate E{(bf16_t*)(ws + WS_HP), PC, (const float*)(ws + WS_SSQ)};
              pg8::gemm_phase<pg8::EpiGate, pg8::SchedGate, 32768, 32768>(opq_lds(lds), g, S, E, wv);
            }
            GRID_BAR();
#pragma unroll 1
            for (int pat3 = 0; pat3 < 3; ++pat3) { const int pat = pat3 % 3;
                if (pat3 == 0) { unsigned char* ws = arg_ws(lds); const int G = opq_g(), bx = opq_bx();
                  pg8::Gemm g{64, 64, 1024}; pg8::SchedCmp S; S.A = (const char*)(ws + WS_ACMP); S.Bt = (const char*)(ws + WS_WC1 + (size_t)l * SZ_WC1); S.G = G; S.c = bx; pg8::EpiF32Z E{(float*)(ws + WS_CP), 512, (size_t)4096 * 512};
                  pg8::gemm_phase<pg8::EpiF32Z, pg8::SchedCmp, 32768, 32768>(opq_lds(lds), g, S, E, wv); }
                if (pat3 == 1) ph_cmp2(lds, l, wv);
                { unsigned char* ws = arg_ws(lds); const int G = opq_g(), bx = opq_bx();
                  for (int u0 = bx; u0 < 1024; u0 += G) { const int w_ = u0 & 255, k_ = u0 >> 8; const int unit = (((w_ & 7) + 8 * k_) << 5) | (w_ >> 3);
                    dil_unit((LAS char*)opq_lds(lds), (const bf16_t*)(ws + WS_HP), (bf16_t*)(ws + WS_OA), (float*)(ws + WS_LSE), (const float*)(ws + WS_TBL), arg_in(lds, I_QNA) + l * HD, pat, 2 * pat, unit, wv); } }
                if (pat3 + 1 < 3) GRID_BAR();
            }
            { unsigned char* ws = arg_ws(lds); const int G = opq_g(), bx = opq_bx();
              const float* gb = arg_in(lds, I_GB) + l * 24; const float* qgn = arg_in(lds, I_QNN) + l * HD;
              int last_bg = -1;
#pragma unroll 1
              for (int i4 = 0; i4 < 4; ++i4)
#pragma unroll 1
                  for (int w = bx; w < 256; w += G) { const int i = i4 & 3; const int bg = w & 7, j = w >> 3;
                      const int qi = (i == 0) ? 127 - j : (i == 1 ? j : (i == 2 ? 64 + j : 63 - j));
                      nsa_unit((LAS char*)opq_lds(lds), (const bf16_t*)(ws + WS_HP), (const bf16_t*)(ws + WS_KC), (const bf16_t*)(ws + WS_VC), (bf16_t*)(ws + WS_ON), (const float*)(ws + WS_TBL + 65536), gb, qgn, bg >> 1, bg & 1, qi, bg != last_bg, wv); last_bg = bg; } }
            GRID_BAR();
            ph_outnorm(lds, l, wv);
            GRID_BAR();
            { unsigned char* ws = arg_ws(lds); const int G = opq_g(), bx = opq_bx(); float* X = arg_out(lds);
              pg8::Gemm g{64, 64, DM}; pg8::SchedStd S; S.init(ws + WS_HP, ws + WS_WOUT + (size_t)l * SZ_WOUT, NTOK, DM, DM, DM, G, bx, 4); pg8::EpiResid E{(float*)nullptr, (bf16_t*)(ws + WS_HB), (float*)(ws + WS_SSQ), DM, 1.0f};
              pg8::gemm_phase<pg8::EpiResid, pg8::SchedStd, 32768, 32768>(opq_lds(lds), g, S, E, wv);
            }
            GRID_BAR();
        }
    }
}

extern "C" void kernel_launch(void* const* d_in, const int* in_sizes, int n_in, void* d_out, int out_size, void* d_ws, size_t ws_size, hipStream_t stream) {
    static int grid = 0;
    if (grid == 0) {
        if (n_in != 24 || in_sizes[0] != NTOK * DM || out_size != NTOK * DM || ws_size < WS_END) { fprintf(stderr, "kernel_launch: shape mismatch n_in %d in0 %d out %d ws %zu (need %zu)\n", n_in, n_in > 0 ? in_sizes[0] : -1, out_size, ws_size, (size_t)WS_END); grid = -1; return; }
        int dev = 0, cus = 0, per_cu = 0;
        if (hipGetDevice(&dev) != hipSuccess || hipDeviceGetAttribute(&cus, hipDeviceAttributeMultiprocessorCount, dev) != hipSuccess) { grid = -1; return; }
        if (hipFuncSetAttribute((const void*)mega_fwd, hipFuncAttributeMaxDynamicSharedMemorySize, LDS_BYTES) != hipSuccess) { fprintf(stderr, "kernel_launch: hipFuncSetAttribute failed\n"); grid = -1; return; }
        if (hipOccupancyMaxActiveBlocksPerMultiprocessor(&per_cu, (const void*)mega_fwd, NTHR, LDS_BYTES) != hipSuccess || per_cu < 1) { fprintf(stderr, "kernel_launch: occupancy query says %d\n", per_cu); (void)hipGetLastError(); if (per_cu < 1) { grid = -1; return; } }
        grid = cus;
    }
    if (grid < 0) return;
    if (hipMemsetAsync((char*)d_ws + WS_CTL, 0, CTL_ZERO_BYTES, stream) != hipSuccess) return;
    Args a{};
    for (int i = 0; i < 24; ++i) a.in[i] = (const float*)d_in[i];
    a.out = (float*)d_out; a.ws = (unsigned char*)d_ws;
    hipLaunchKernelGGL(mega_fwd, dim3(grid), dim3(NTHR), LDS_BYTES, stream, a);
    const hipError_t le = hipPeekAtLastError();
    if (le != hipSuccess) fprintf(stderr, "kernel_launch: launch failed: %s\n", hipGetErrorName(le));
}
```
